# Optimizing an MI355X kernel written in HIP

```python
import math
import jax
import jax.numpy as jnp
from jax import lax
import numpy as np

D_MODEL = 1024
BATCH = 32
SEQ = 256
DEPTH = 2
DEC_BATCH = 4
DEC_SEQ = 1024
PAST_LEN = 256

GRID_W = 64
N_BRANCH = 4
BRANCH_W = D_MODEL // 2
D_FF = 4 * D_MODEL
EPS = 1e-6
NEG_INF = -1e30
QBLK = 128
ROPE_BASE = 10000.0

SSD_HEAD_DIM = 64
SSD_HEADS = BRANCH_W // SSD_HEAD_DIM
SSD_GROUPS = 2
SSD_STATE = 64
SSD_CONV_W = 7
SSD_CHUNK = 128
SSD_XBC = BRANCH_W + 2 * SSD_GROUPS * SSD_STATE

S5_GROUP = 16
S5_GROUPS = BRANCH_W // S5_GROUP
S5_STATE = 64

DIFF_HEAD_DIM = 64
DIFF_HEADS = BRANCH_W // (2 * DIFF_HEAD_DIM)

WIN_HEAD_DIM = 64
WIN_HEADS = BRANCH_W // WIN_HEAD_DIM
WIN_KV_HEADS = 2
WIN_GROUP = WIN_HEADS // WIN_KV_HEADS
WINDOW = 128
BAND_BLK = 128

IN_SIZES = (BRANCH_W, SSD_XBC, 2 * SSD_HEADS, BRANCH_W,
            2 * DIFF_HEADS * DIFF_HEAD_DIM, 2 * DIFF_HEADS * DIFF_HEAD_DIM, 2 * DIFF_HEADS * DIFF_HEAD_DIM,
            WIN_HEADS * WIN_HEAD_DIM, WIN_KV_HEADS * WIN_HEAD_DIM, WIN_KV_HEADS * WIN_HEAD_DIM)
D_IN = sum(IN_SIZES)
IN_SPLITS = tuple(int(v) for v in np.cumsum(IN_SIZES)[:-1])

kernel_name = 'hybrid_diffusion_parallel_step'


def rmsnorm(x, g):
    xf = x.astype(jnp.float32)
    y = xf * lax.rsqrt(jnp.mean(xf * xf, axis=-1, keepdims=True) + EPS)
    return (y * g.astype(jnp.float32)).astype(x.dtype)


def adaln(cvec, w, b):
    m = jax.nn.silu(cvec) @ w + b
    return jnp.split(m[:, None, :], 6, axis=-1)


def axial_rope(length, head_dim):
    rows = length // GRID_W
    row = jnp.repeat(jnp.arange(rows), GRID_W).astype(jnp.float32)
    col = jnp.tile(jnp.arange(GRID_W), rows).astype(jnp.float32)
    nf = head_dim // 4
    inv = ROPE_BASE ** (-jnp.arange(nf, dtype=jnp.float32) / nf)
    ang = jnp.concatenate([row[:, None] * inv, col[:, None] * inv], axis=-1)
    return jnp.cos(ang), jnp.sin(ang)


def apply_rope(x, cos, sin):
    shp = x.shape
    nf = shp[-1] // 4
    xr = x.astype(jnp.float32).reshape(shp[:-1] + (2, 2, nf))
    bshape = (1, shp[1]) + (1,) * (len(shp) - 3) + (2, nf)
    c = cos.reshape(bshape)
    s = sin.reshape(bshape)
    x1 = xr[..., 0, :]
    x2 = xr[..., 1, :]
    out = jnp.stack([x1 * c - x2 * s, x2 * c + x1 * s], axis=-2)
    return out.reshape(shp).astype(x.dtype)


def map_query_blocks(fn, q):
    bsz, length = q.shape[0], q.shape[1]
    nb = length // QBLK
    qb = jnp.moveaxis(q.reshape((bsz, nb, QBLK) + q.shape[2:]), 1, 0)
    out = jnp.moveaxis(lax.map(fn, qb), 0, 1)
    return out.reshape((bsz, length) + out.shape[3:])


def dwconv_centred(x, w, b):
    width, ch = w.shape
    y = lax.conv_general_dilated(x, w[:, None, :], window_strides=(1,),
                                 padding=[(width // 2, width // 2)],
                                 dimension_numbers=('NWC', 'WIO', 'NWC'),
                                 feature_group_count=ch)
    return y + b


def ssd_chunked_scan(x, dt, a_log, bm, cm, s0):
    f32 = jnp.float32
    bsz, length, nh, hp = x.shape
    nc = length // SSD_CHUNK

    def chunks(t):
        return t.astype(f32).reshape((bsz, nc, SSD_CHUNK) + t.shape[2:])

    xc, dtc, bc, cc = chunks(x), chunks(dt), chunks(bm), chunks(cm)
    acum = jnp.cumsum(dtc * (-jnp.exp(a_log.astype(f32))), axis=2)
    seg = acum[:, :, :, None, :] - acum[:, :, None, :, :]
    lower = jnp.tril(jnp.ones((SSD_CHUNK, SSD_CHUNK), dtype=bool))[None, None, :, :, None]
    lmat = jnp.exp(jnp.where(lower, seg, NEG_INF))
    xdt = xc * dtc[..., None]
    scores = jnp.einsum('bcthn,bcshn->bctsh', cc, bc) * lmat
    y_diag = jnp.einsum('bctsh,bcshp->bcthp', scores, xdt)
    decay_end = jnp.exp(acum[:, :, -1:, :] - acum)
    chunk_states = jnp.einsum('bcshn,bcshp->bchpn', bc * decay_end[..., None], xdt)
    chunk_decay = jnp.exp(acum[:, :, -1, :])

    def step(s, inp):
        st, dec = inp
        return dec[:, :, None, None] * s + st, s

    final, s_start = lax.scan(step, s0.astype(f32),
                              (jnp.moveaxis(chunk_states, 1, 0), jnp.moveaxis(chunk_decay, 1, 0)))
    s_start = jnp.moveaxis(s_start, 0, 1)
    y_off = jnp.einsum('bcthn,bchpn->bcthp', cc, s_start) * jnp.exp(acum)[..., None]
    return (y_diag + y_off).reshape(bsz, length, nh, hp), final


def ssd_mixer(z, xbc, dt_raw, conv_w, conv_b, dt_bias, a_log, d_skip, norm_g, s0):
    f32 = jnp.float32
    bsz, length, _ = z.shape
    xbc = jax.nn.silu(dwconv_centred(xbc, conv_w, conv_b))
    xs, bm, cm = jnp.split(xbc, [BRANCH_W, BRANCH_W + SSD_GROUPS * SSD_STATE], axis=-1)
    xs = xs.reshape(bsz, length, SSD_HEADS, SSD_HEAD_DIM)
    rep = SSD_HEADS // SSD_GROUPS
    bm = jnp.repeat(bm.reshape(bsz, length, SSD_GROUPS, SSD_STATE), rep, axis=2)
    cm = jnp.repeat(cm.reshape(bsz, length, SSD_GROUPS, SSD_STATE), rep, axis=2)
    dt = jax.nn.softplus(dt_raw.reshape(bsz, length, 2, SSD_HEADS).astype(f32) + dt_bias.astype(f32))

    def flip(t):
        return jnp.flip(t, axis=1)

    y_f, s_f = ssd_chunked_scan(xs, dt[:, :, 0], a_log[0], bm, cm, s0[:, 0])
    y_b, s_b = ssd_chunked_scan(flip(xs), flip(dt[:, :, 1]), a_log[1], flip(bm), flip(cm), s0[:, 1])
    y = y_f + flip(y_b) + d_skip.astype(f32)[:, None] * xs.astype(f32)
    y = rmsnorm(y.reshape(bsz, length, BRANCH_W) * jax.nn.silu(z.astype(f32)), norm_g)
    return y, jnp.stack([s_f, s_b], axis=1)


def s5_direction(u, lam_re, lam_im, log_step, b_re, b_im, c_re, c_im, s0_re, s0_im):
    f32 = jnp.float32
    lam_re = lam_re.astype(f32)
    lam_im = lam_im.astype(f32)
    step = jnp.exp(log_step.astype(f32))[:, None]
    mag = jnp.exp(lam_re * step)
    ab_re = mag * jnp.cos(lam_im * step)
    ab_im = mag * jnp.sin(lam_im * step)
    den = lam_re * lam_re + lam_im * lam_im
    coef_re = ((ab_re - 1.0) * lam_re + ab_im * lam_im) / den
    coef_im = (ab_im * lam_re - (ab_re - 1.0) * lam_im) / den
    bu_re = jnp.einsum('blgm,gnm->blgn', u, b_re.astype(f32))
    bu_im = jnp.einsum('blgm,gnm->blgn', u, b_im.astype(f32))
    s0_re = s0_re.astype(f32)
    s0_im = s0_im.astype(f32)
    x_re = (coef_re * bu_re - coef_im * bu_im).at[:, 0].add(ab_re * s0_re - ab_im * s0_im)
    x_im = (coef_re * bu_im + coef_im * bu_re).at[:, 0].add(ab_re * s0_im + ab_im * s0_re)
    length = u.shape[1]
    a_re = jnp.broadcast_to(ab_re, (1, length) + ab_re.shape)
    a_im = jnp.broadcast_to(ab_im, (1, length) + ab_im.shape)

    def combine(e1, e2):
        a1r, a1i, b1r, b1i = e1
        a2r, a2i, b2r, b2i = e2
        return (a2r * a1r - a2i * a1i, a2r * a1i + a2i * a1r,
                a2r * b1r - a2i * b1i + b2r, a2r * b1i + a2i * b1r + b2i)

    _, _, s_re, s_im = lax.associative_scan(combine, (a_re, a_im, x_re, x_im), axis=1)
    y = (jnp.einsum('blgn,gmn->blgm', s_re, c_re.astype(f32))
         - jnp.einsum('blgn,gmn->blgm', s_im, c_im.astype(f32)))
    return y, s_re[:, -1], s_im[:, -1]


def s5_mixer(u, lam_re, lam_im, log_step, b_re, b_im, c_re, c_im, d_skip, w_glu, b_glu, s0):
    f32 = jnp.float32
    bsz, length, _ = u.shape
    uf = u.astype(f32).reshape(bsz, length, S5_GROUPS, S5_GROUP)

    def flip(t):
        return jnp.flip(t, axis=1)

    y_f, f_re, f_im = s5_direction(uf, lam_re[0], lam_im[0], log_step[0], b_re[0], b_im[0],
                                   c_re[0], c_im[0], s0[:, 0, 0], s0[:, 0, 1])
    y_b, r_re, r_im = s5_direction(flip(uf), lam_re[1], lam_im[1], log_step[1], b_re[1], b_im[1],
                                   c_re[1], c_im[1], s0[:, 1, 0], s0[:, 1, 1])
    y = y_f + flip(y_b) + d_skip.astype(f32).reshape(S5_GROUPS, S5_GROUP) * uf
    g = y.reshape(bsz, length, BRANCH_W) @ w_glu.astype(f32) + b_glu.astype(f32)
    out = g[..., :BRANCH_W] * jax.nn.sigmoid(g[..., BRANCH_W:])
    state = jnp.stack([jnp.stack([f_re, f_im], axis=1), jnp.stack([r_re, r_im], axis=1)], axis=1)
    return out, state


def diff_block(qb, k, v, lam):
    f32 = jnp.float32
    s = jnp.einsum('bqhcd,bshcd->bhcqs', qb.astype(f32), k.astype(f32)) * (DIFF_HEAD_DIM ** -0.5)
    p = jax.nn.softmax(s, axis=-1)
    a = p[:, :, 0] - lam * p[:, :, 1]
    return jnp.einsum('bhqs,bshe->bqhe', a, v.astype(f32))


def diff_attention(q, k, v, lam, lam_init, subln_g):
    bsz, length = q.shape[0], q.shape[1]
    o = map_query_blocks(lambda qb: diff_block(qb, k, v, lam), q)
    return (rmsnorm(o, subln_g) * (1.0 - lam_init)).reshape(bsz, length, BRANCH_W)


def win_dense_block(qb, k, v, sink):
    f32 = jnp.float32
    s = jnp.einsum('bqngd,bsnd->bngqs', qb.astype(f32), k.astype(f32)) * (WIN_HEAD_DIM ** -0.5)
    sk = jnp.broadcast_to(sink.astype(f32)[None, :, :, None, None], s.shape[:-1] + (1,))
    p = jax.nn.softmax(jnp.concatenate([sk, s], axis=-1), axis=-1)[..., 1:]
    return jnp.einsum('bngqs,bsnd->bqngd', p, v.astype(f32))


def win_banded(q, k, v, ctx_k, ctx_v, sink):
    f32 = jnp.float32
    bsz, length = q.shape[0], q.shape[1]
    nb = length // BAND_BLK
    scale = WIN_HEAD_DIM ** -0.5
    qb = q.astype(f32).reshape(bsz, nb, BAND_BLK, WIN_KV_HEADS, WIN_GROUP, WIN_HEAD_DIM)
    pad = ((0, 0), (BAND_BLK, BAND_BLK), (0, 0), (0, 0))
    kp = jnp.pad(k.astype(f32), pad).reshape(bsz, nb + 2, BAND_BLK, WIN_KV_HEADS, WIN_HEAD_DIM)
    vp = jnp.pad(v.astype(f32), pad).reshape(bsz, nb + 2, BAND_BLK, WIN_KV_HEADS, WIN_HEAD_DIM)
    kband = jnp.concatenate([kp[:, :-2], kp[:, 1:-1], kp[:, 2:]], axis=2)
    vband = jnp.concatenate([vp[:, :-2], vp[:, 1:-1], vp[:, 2:]], axis=2)
    blk = jnp.arange(nb)[:, None, None]
    qpos = blk * BAND_BLK + jnp.arange(BAND_BLK)[None, :, None]
    kpos = (blk - 1) * BAND_BLK + jnp.arange(3 * BAND_BLK)[None, None, :]
    valid = (jnp.abs(qpos - kpos) <= WINDOW) & (kpos >= 0) & (kpos < length)
    s_band = jnp.einsum('bjqngd,bjknd->bjngqk', qb, kband) * scale
    s_band = jnp.where(valid[None, :, None, None], s_band, NEG_INF)
    s_ctx = jnp.einsum('bjqngd,bsnd->bjngqs', qb, ctx_k.astype(f32)) * scale
    sk = jnp.broadcast_to(sink.astype(f32)[None, None, :, :, None, None], s_ctx.shape[:-1] + (1,))
    p = jax.nn.softmax(jnp.concatenate([sk, s_ctx, s_band], axis=-1), axis=-1)
    n_ctx = ctx_k.shape[1]
    o = (jnp.einsum('bjngqs,bsnd->bjqngd', p[..., 1:1 + n_ctx], ctx_v.astype(f32))
         + jnp.einsum('bjngqk,bjknd->bjqngd', p[..., 1 + n_ctx:], vband))
    return o.reshape(bsz, length, BRANCH_W)


def trunk_layer(x, cmod, P, l, cache):
    f32 = jnp.float32
    bsz, length, _ = x.shape
    sh1, sc1, g1, sh2, sc2, g2 = adaln(cmod, P['w_mod'][l], P['b_mod'][l])
    h = rmsnorm(x, P['g_norm1'][l]) * (1.0 + sc1) + sh1
    z, xbc, dt_raw, u, dq, dk, dv, wq, wk, wv = jnp.split(h @ P['w_in'][l], IN_SPLITS, axis=-1)
    if cache is None:
        ssd_s0 = jnp.zeros((bsz, 2, SSD_HEADS, SSD_HEAD_DIM, SSD_STATE), f32)
        s5_s0 = jnp.zeros((bsz, 2, 2, S5_GROUPS, S5_STATE), f32)
    else:
        ssd_s0, s5_s0, dk_ctx, dv_ctx, wk_ctx, wv_ctx = cache
    y_a, ssd_fin = ssd_mixer(z, xbc, dt_raw, P['ssd_conv_w'][l], P['ssd_conv_b'][l], P['ssd_dt_bias'][l],
                             P['ssd_a_log'][l], P['ssd_d'][l], P['ssd_norm_g'][l], ssd_s0)
    y_b, s5_fin = s5_mixer(u, P['s5_lam_re'][l], P['s5_lam_im'][l], P['s5_log_step'][l], P['s5_b_re'][l],
                           P['s5_b_im'][l], P['s5_c_re'][l], P['s5_c_im'][l], P['s5_d'][l],
                           P['s5_w_glu'][l], P['s5_b_glu'][l], s5_s0)
    q = rmsnorm(dq.reshape(bsz, length, DIFF_HEADS, 2, DIFF_HEAD_DIM), P['diff_qn_g'][l])
    k = rmsnorm(dk.reshape(bsz, length, DIFF_HEADS, 2, DIFF_HEAD_DIM), P['diff_kn_g'][l])
    v = dv.reshape(bsz, length, DIFF_HEADS, 2 * DIFF_HEAD_DIM)
    lam_init = 0.8 - 0.6 * math.exp(-0.3 * l)
    lv = P['diff_lambda'][l].astype(f32)
    lam = jnp.exp(jnp.sum(lv[0] * lv[1])) - jnp.exp(jnp.sum(lv[2] * lv[3])) + lam_init
    wq_ = rmsnorm(wq.reshape(bsz, length, WIN_KV_HEADS, WIN_GROUP, WIN_HEAD_DIM), P['win_qn_g'][l])
    wk_ = rmsnorm(wk.reshape(bsz, length, WIN_KV_HEADS, WIN_HEAD_DIM), P['win_kn_g'][l])
    wv_ = wv.reshape(bsz, length, WIN_KV_HEADS, WIN_HEAD_DIM)
    sink = P['win_sink'][l].reshape(WIN_KV_HEADS, WIN_GROUP)
    if cache is None:
        y_c = diff_attention(q, k, v, lam, lam_init, P['diff_subln_g'][l])
        y_d = map_query_blocks(lambda qb: win_dense_block(qb, wk_, wv_, sink), wq_).reshape(bsz, length, BRANCH_W)
        new_ctx = (ssd_fin, s5_fin, k, v, wk_, wv_)
    else:
        cos, sin = axial_rope(length, DIFF_HEAD_DIM)
        y_c = diff_attention(apply_rope(q, cos, sin),
                             jnp.concatenate([dk_ctx.astype(k.dtype), apply_rope(k, cos, sin)], axis=1),
                             jnp.concatenate([dv_ctx.astype(v.dtype), v], axis=1),
                             lam, lam_init, P['diff_subln_g'][l])
        y_d = win_banded(apply_rope(wq_, cos, sin), apply_rope(wk_, cos, sin), wv_, wk_ctx, wv_ctx, sink)
        new_ctx = None
    branches = jnp.stack([y_a.astype(x.dtype), y_b.astype(x.dtype), y_c.astype(x.dtype),
                          y_d.astype(x.dtype)], axis=2)
    br = jnp.einsum('blie,ied->blid', branches, P['w_branch'][l])
    gates = jax.nn.sigmoid((h @ P['w_gate'][l] + P['b_gate'][l]).astype(f32))
    gates = gates.reshape(bsz, length, N_BRANCH, D_MODEL)
    merged = jnp.einsum('blid,blid->bld', gates, br.astype(f32)).astype(x.dtype) @ P['w_out'][l]
    x = x + g1 * merged
    h2 = rmsnorm(x, P['g_norm2'][l]) * (1.0 + sc2) + sh2
    x = x + g2 * (jnp.square(jax.nn.relu(h2 @ P['w_fc1'][l])) @ P['w_fc2'][l])
    return x, new_ctx


def setup_inputs(seed: int = 0) -> dict:
    key = jax.random.key(seed)
    ks = iter(jax.random.split(key, 64))
    f32 = jnp.float32

    def nrm(shape, scale=1.0):
        return jax.random.normal(next(ks), shape, f32) * scale

    def gain(shape):
        return 1.0 + nrm(shape, 0.02)

    D = D_MODEL
    H = SSD_HEADS
    x_prompt = nrm((BATCH, SEQ, D))
    x_sample = nrm((DEC_BATCH, DEC_SEQ, D))
    state_ssd = nrm((DEC_BATCH, DEPTH, 2, H, SSD_HEAD_DIM, SSD_STATE), 0.5)
    state_s5 = nrm((DEC_BATCH, DEPTH, 2, 2, S5_GROUPS, S5_STATE), 0.5)
    cache_diff_k = nrm((DEC_BATCH, DEPTH, PAST_LEN, DIFF_HEADS, 2, DIFF_HEAD_DIM))
    cache_diff_v = nrm((DEC_BATCH, DEPTH, PAST_LEN, DIFF_HEADS, 2 * DIFF_HEAD_DIM))
    cache_win_k = nrm((DEC_BATCH, DEPTH, PAST_LEN, WIN_KV_HEADS, WIN_HEAD_DIM))
    cache_win_v = nrm((DEC_BATCH, DEPTH, PAST_LEN, WIN_KV_HEADS, WIN_HEAD_DIM))
    c = nrm((DEC_BATCH, D))
    c_ctx = nrm((D,))
    w_mod = nrm((DEPTH, D, 6 * D), 0.5 * D ** -0.5)
    b_mod = nrm((DEPTH, 6 * D), 0.02)
    g_norm1 = gain((DEPTH, D))
    g_norm2 = gain((DEPTH, D))
    w_in = nrm((DEPTH, D, D_IN), D ** -0.5)
    ssd_conv_w = nrm((DEPTH, SSD_CONV_W, SSD_XBC), SSD_CONV_W ** -0.5)
    ssd_conv_b = nrm((DEPTH, SSD_XBC), 0.02)
    dt0 = jnp.exp(jax.random.uniform(next(ks), (DEPTH, 2, H), f32, math.log(1e-3), math.log(1e-1)))
    ssd_dt_bias = dt0 + jnp.log(-jnp.expm1(-dt0))
    ssd_a_log = jnp.log(jax.random.uniform(next(ks), (DEPTH, 2, H), f32, 1.0, 16.0))
    ssd_d = 1.0 + nrm((DEPTH, H), 0.1)
    ssd_norm_g = gain((DEPTH, BRANCH_W))
    n_idx = jnp.arange(S5_STATE, dtype=f32)
    s5_lam_re = -0.5 + nrm((DEPTH, 2, S5_GROUPS, S5_STATE), 0.01)
    s5_lam_im = jnp.pi * n_idx + nrm((DEPTH, 2, S5_GROUPS, S5_STATE), 0.01)
    s5_log_step = jax.random.uniform(next(ks), (DEPTH, 2, S5_GROUPS), f32, math.log(1e-3), math.log(1e-1))
    s5_b_re = nrm((DEPTH, 2, S5_GROUPS, S5_STATE, S5_GROUP), (2 * S5_GROUP) ** -0.5)
    s5_b_im = nrm((DEPTH, 2, S5_GROUPS, S5_STATE, S5_GROUP), (2 * S5_GROUP) ** -0.5)
    s5_c_re = nrm((DEPTH, 2, S5_GROUPS, S5_GROUP, S5_STATE), (2 * S5_STATE) ** -0.5)
    s5_c_im = nrm((DEPTH, 2, S5_GROUPS, S5_GROUP, S5_STATE), (2 * S5_STATE) ** -0.5)
    s5_d = nrm((DEPTH, BRANCH_W), 0.5)
    s5_w_glu = nrm((DEPTH, BRANCH_W, 2 * BRANCH_W), BRANCH_W ** -0.5)
    s5_b_glu = nrm((DEPTH, 2 * BRANCH_W), 0.02)
    diff_qn_g = gain((DEPTH, DIFF_HEAD_DIM))
    diff_kn_g = gain((DEPTH, DIFF_HEAD_DIM))
    diff_lambda = nrm((DEPTH, 4, DIFF_HEAD_DIM), 0.1)
    diff_subln_g = gain((DEPTH, 2 * DIFF_HEAD_DIM))
    win_qn_g = gain((DEPTH, WIN_HEAD_DIM))
    win_kn_g = gain((DEPTH, WIN_HEAD_DIM))
    win_sink = nrm((DEPTH, WIN_HEADS), 0.5)
    w_branch = nrm((DEPTH, N_BRANCH, BRANCH_W, D), BRANCH_W ** -0.5)
    w_gate = nrm((DEPTH, D, N_BRANCH * D), D ** -0.5)
    b_gate = nrm((DEPTH, N_BRANCH * D), 0.02)
    w_out = nrm((DEPTH, D, D), D ** -0.5)
    w_fc1 = nrm((DEPTH, D, D_FF), D ** -0.5)
    w_fc2 = nrm((DEPTH, D_FF, D), D_FF ** -0.5)
    return {'x_prompt': x_prompt, 'x_sample': x_sample, 'state_ssd': state_ssd, 'state_s5': state_s5,
            'cache_diff_k': cache_diff_k, 'cache_diff_v': cache_diff_v, 'cache_win_k': cache_win_k,
            'cache_win_v': cache_win_v, 'c': c, 'c_ctx': c_ctx, 'w_mod': w_mod, 'b_mod': b_mod,
            'g_norm1': g_norm1, 'g_norm2': g_norm2, 'w_in': w_in, 'ssd_conv_w': ssd_conv_w,
            'ssd_conv_b': ssd_conv_b, 'ssd_dt_bias': ssd_dt_bias, 'ssd_a_log': ssd_a_log, 'ssd_d': ssd_d,
            'ssd_norm_g': ssd_norm_g, 's5_lam_re': s5_lam_re, 's5_lam_im': s5_lam_im,
            's5_log_step': s5_log_step, 's5_b_re': s5_b_re, 's5_b_im': s5_b_im, 's5_c_re': s5_c_re,
            's5_c_im': s5_c_im, 's5_d': s5_d, 's5_w_glu': s5_w_glu, 's5_b_glu': s5_b_glu,
            'diff_qn_g': diff_qn_g, 'diff_kn_g': diff_kn_g, 'diff_lambda': diff_lambda,
            'diff_subln_g': diff_subln_g, 'win_qn_g': win_qn_g, 'win_kn_g': win_kn_g, 'win_sink': win_sink,
            'w_branch': w_branch, 'w_gate': w_gate, 'b_gate': b_gate, 'w_out': w_out,
            'w_fc1': w_fc1, 'w_fc2': w_fc2}


def reference(x_prompt, x_sample, state_ssd, state_s5, cache_diff_k, cache_diff_v, cache_win_k,
              cache_win_v, c, c_ctx, w_mod, b_mod, g_norm1, g_norm2, w_in, ssd_conv_w, ssd_conv_b,
              ssd_dt_bias, ssd_a_log, ssd_d, ssd_norm_g, s5_lam_re, s5_lam_im, s5_log_step, s5_b_re,
              s5_b_im, s5_c_re, s5_c_im, s5_d, s5_w_glu, s5_b_glu, diff_qn_g, diff_kn_g, diff_lambda,
              diff_subln_g, win_qn_g, win_kn_g, win_sink, w_branch, w_gate, b_gate, w_out, w_fc1, w_fc2):
    P = {'w_mod': w_mod, 'b_mod': b_mod, 'g_norm1': g_norm1, 'g_norm2': g_norm2, 'w_in': w_in,
         'ssd_conv_w': ssd_conv_w, 'ssd_conv_b': ssd_conv_b, 'ssd_dt_bias': ssd_dt_bias,
         'ssd_a_log': ssd_a_log, 'ssd_d': ssd_d, 'ssd_norm_g': ssd_norm_g, 's5_lam_re': s5_lam_re,
         's5_lam_im': s5_lam_im, 's5_log_step': s5_log_step, 's5_b_re': s5_b_re, 's5_b_im': s5_b_im,
         's5_c_re': s5_c_re, 's5_c_im': s5_c_im, 's5_d': s5_d, 's5_w_glu': s5_w_glu, 's5_b_glu': s5_b_glu,
         'diff_qn_g': diff_qn_g, 'diff_kn_g': diff_kn_g, 'diff_lambda': diff_lambda,
         'diff_subln_g': diff_subln_g, 'win_qn_g': win_qn_g, 'win_kn_g': win_kn_g, 'win_sink': win_sink,
         'w_branch': w_branch, 'w_gate': w_gate, 'b_gate': b_gate, 'w_out': w_out,
         'w_fc1': w_fc1, 'w_fc2': w_fc2}
    xp = x_prompt
    ctx_out = []
    for l in range(DEPTH):
        xp, new_ctx = trunk_layer(xp, c_ctx[None, :], P, l, None)
        ctx_out.append(new_ctx)
    xs = x_sample
    for l in range(DEPTH):
        layer_cache = (state_ssd[:, l], state_s5[:, l], cache_diff_k[:, l], cache_diff_v[:, l],
                       cache_win_k[:, l], cache_win_v[:, l])
        xs, _ = trunk_layer(xs, c, P, l, layer_cache)
    new_state_ssd = jnp.stack([t[0] for t in ctx_out], axis=1)
    new_state_s5 = jnp.stack([t[1] for t in ctx_out], axis=1)
    new_cache_diff_k = jnp.stack([t[2] for t in ctx_out], axis=1)
    new_cache_diff_v = jnp.stack([t[3] for t in ctx_out], axis=1)
    new_cache_win_k = jnp.stack([t[4] for t in ctx_out], axis=1)
    new_cache_win_v = jnp.stack([t[5] for t in ctx_out], axis=1)
    return (xp, xs, new_state_ssd, new_state_s5, new_cache_diff_k, new_cache_diff_v, new_cache_win_k, new_cache_win_v)
```

```cpp
#include <hip/hip_runtime.h>
#include <hip/hip_cooperative_groups.h>
#include <cstdio>
#include <cstdint>
namespace cg = cooperative_groups;

#ifndef MK_MULTI
#define MK_MULTI 1
#endif

namespace pg8 {
#define PG8_LAS __attribute__((address_space(3)))
typedef unsigned short bf16_t;
typedef short bf16x8 __attribute__((ext_vector_type(8)));
typedef float f32x4 __attribute__((ext_vector_type(4)));
typedef unsigned u32x4 __attribute__((ext_vector_type(4)));
constexpr int BM = 256, BK = 64, HALF = 128, HTB = HALF * BK * 2  , STAGE_BYTES = 8 * HTB, NXCD = 8, WGM = 8;

__host__ __device__ __forceinline__ int lds_byte(int r, int c) { const int st = (r >> 4) * 2 + (c >> 5), rr = r & 15, cc = c & 31, ob = rr * 64 + cc * 2; return st * 1024 + (ob ^ (((ob >> 9) & 1) << 5)); }
__host__ __device__ __forceinline__ void stage_rc(int b, int& R, int& C) { const int st = b / 1024, sb = b % 1024, swz = sb ^ (((sb >> 9) & 1) << 5); R = (st >> 1) * 16 + swz / 64; C = (st & 1) * 32 + (swz % 64) / 2; }
__host__ __device__ __forceinline__ int perm32(int rho) { const int n = rho >> 4, i = rho & 15; return 8 * (i >> 2) + 4 * n + (i & 3); }

struct Unit { int pm, pn; };
struct Gemm { const bf16_t* A; const bf16_t* Bt; int M, N, K, lda, ldb, a_div; size_t a_gstride; };

struct StaticOrder {
    int nM, nN, nwg, G, c;
    __host__ __device__ void init(int M, int N, int G_, int c_) { nM = M / BM; nN = N / BM; nwg = nM * nN; G = G_; c = c_; }
    __host__ __device__ bool next(int i, Unit& u) const {
        const long L = (long)i * G + c; if (L >= nwg) return false;
        int wgid = (int)L; { const int q = nwg / NXCD, r = nwg % NXCD, xcd = wgid % NXCD, off = wgid / NXCD; wgid = (xcd < r ? xcd * (q + 1) : r * (q + 1) + (xcd - r) * q) + off; }
        const int nig = WGM * nN, gid = wgid / nig, fm = gid * WGM, gsz = (nM - fm) < WGM ? (nM - fm) : WGM;
        u.pm = fm + ((wgid % nig) % gsz); u.pn = (wgid % nig) / gsz; return true;
    }
    __device__ __forceinline__ void a_ready(const Unit&) const {}
    __device__ __forceinline__ void done(const Unit&) const {}
};

__device__ __forceinline__ unsigned cvt_pk_bf16(float lo, float hi) { unsigned r; asm volatile("v_cvt_pk_bf16_f32 %0, %1, %2" : "=v"(r) : "v"(lo), "v"(hi)); return r; }
__device__ __forceinline__ float bf_lo(unsigned w) { return __builtin_bit_cast(float, w << 16); }
__device__ __forceinline__ float bf_hi(unsigned w) { return __builtin_bit_cast(float, w & 0xffff0000u); }
__device__ __forceinline__ float sigmoidf_(float x) { return 1.0f / (1.0f + __expf(-x)); }

template <int MODE> struct EpiB {
    static constexpr bool PERM = true, AFTER_DRAIN = false;
    bf16_t* O; int ldc; const float* bias; const float* ssq;
    __device__ __forceinline__ void operator()(const f32x4 (&acc)[2][2][4][2], const Unit& u, int wr, int wc, int fr, int fq) const {
        const int row0 = u.pm * BM + wr * 64 + fr, col0 = u.pn * BM + wc * 32 + 8 * fq;
        f32x4 bv[2][2];
#pragma unroll
        for (int bj = 0; bj < 2; ++bj)
#pragma unroll
            for (int n = 0; n < 2; ++n) bv[bj][n] = (MODE == 1) ? *(const f32x4*)(bias + col0 + bj * HALF + 4 * n) : (f32x4){0.f, 0.f, 0.f, 0.f};
#pragma unroll
        for (int ai = 0; ai < 2; ++ai)
#pragma unroll
            for (int m = 0; m < 4; ++m) {
                const int row = row0 + ai * HALF + m * 16;
                bf16_t* rowp = O + (size_t)row * ldc + col0;
                float rs = 1.f;
                if (MODE == 3) { if (u.pn < 4) rs = rsqrtf(ssq[row] * (1.0f / 512.0f) + 1e-6f); }
#pragma unroll
                for (int bj = 0; bj < 2; ++bj) {
                    f32x4 v0 = acc[ai][bj][m][0] + bv[bj][0], v1 = acc[ai][bj][m][1] + bv[bj][1];
                    if (MODE == 1) {
#pragma unroll
                        for (int j = 0; j < 4; ++j) { v0[j] = sigmoidf_(v0[j]); v1[j] = sigmoidf_(v1[j]); }
                    }
                    if (MODE == 2) {
#pragma unroll
                        for (int j = 0; j < 4; ++j) { const float a = fmaxf(v0[j], 0.f), b = fmaxf(v1[j], 0.f); v0[j] = a * a; v1[j] = b * b; }
                    }
                    if (MODE == 3) {
                        const u32x4 gq = *(const u32x4*)(rowp + bj * HALF);
                        v0[0] *= bf_lo(gq.x) * rs; v0[1] *= bf_hi(gq.x) * rs; v0[2] *= bf_lo(gq.y) * rs; v0[3] *= bf_hi(gq.y) * rs;
                        v1[0] *= bf_lo(gq.z) * rs; v1[1] *= bf_hi(gq.z) * rs; v1[2] *= bf_lo(gq.w) * rs; v1[3] *= bf_hi(gq.w) * rs;
                    }
                    u32x4 w; w.x = cvt_pk_bf16(v0[0], v0[1]); w.y = cvt_pk_bf16(v0[2], v0[3]); w.z = cvt_pk_bf16(v1[0], v1[1]); w.w = cvt_pk_bf16(v1[2], v1[3]);
                    *(u32x4*)(rowp + bj * HALF) = w;
                }
            }
    }
};
struct EpiGlu {
    static constexpr bool PERM = true, AFTER_DRAIN = false;
    bf16_t* O; int ldc; int ocol; const float* bias;
    __device__ __forceinline__ void operator()(const f32x4 (&acc)[2][2][4][2], const Unit& u, int wr, int wc, int fr, int fq) const {
        const int row0 = u.pm * BM + wr * 64 + fr, cc = u.pn * HALF + wc * 32 + 8 * fq;
        f32x4 bv[2][2];
#pragma unroll
        for (int bj = 0; bj < 2; ++bj)
#pragma unroll
            for (int n = 0; n < 2; ++n) bv[bj][n] = *(const f32x4*)(bias + bj * 512 + cc + 4 * n);
#pragma unroll
        for (int ai = 0; ai < 2; ++ai)
#pragma unroll
            for (int m = 0; m < 4; ++m) {
                bf16_t* rowp = O + (size_t)(row0 + ai * HALF + m * 16) * ldc + ocol + cc;
                f32x4 v0 = acc[ai][0][m][0] + bv[0][0], v1 = acc[ai][0][m][1] + bv[0][1];
                const f32x4 g0 = acc[ai][1][m][0] + bv[1][0], g1 = acc[ai][1][m][1] + bv[1][1];
#pragma unroll
                for (int j = 0; j < 4; ++j) { v0[j] *= sigmoidf_(g0[j]); v1[j] *= sigmoidf_(g1[j]); }
                u32x4 w; w.x = cvt_pk_bf16(v0[0], v0[1]); w.y = cvt_pk_bf16(v0[2], v0[3]); w.z = cvt_pk_bf16(v1[0], v1[1]); w.w = cvt_pk_bf16(v1[2], v1[3]);
                *(u32x4*)rowp = w;
            }
    }
};
struct EpiRes {
    static constexpr bool PERM = false, AFTER_DRAIN = false;
    const float* base_ctx; const float* base_lat;
    float* out; const float* modv;
    int goff;
    __device__ __forceinline__ void operator()(const f32x4 (&acc)[2][2][4][2], const Unit& u, int wr, int wc, int fr, int fq) const {
        const int row0 = u.pm * BM + wr * 64 + fr, col0 = u.pn * BM + wc * 32 + 4 * fq;
        const int mi = (u.pm < 32) ? 0 : 1 + ((u.pm - 32) >> 2);
        const float* gv = modv + (size_t)mi * 6144 + goff;
        f32x4 gg[2][2];
#pragma unroll
        for (int bj = 0; bj < 2; ++bj)
#pragma unroll
            for (int n = 0; n < 2; ++n) gg[bj][n] = *(const f32x4*)(gv + col0 + bj * HALF + n * 16);
#pragma unroll
        for (int ai = 0; ai < 2; ++ai)
#pragma unroll
            for (int m = 0; m < 4; ++m) {
                const int row = row0 + ai * HALF + m * 16;
                const float* bp = (row < 8192 ? base_ctx + (size_t)row * 1024 : base_lat + (size_t)(row - 8192) * 1024) + col0;
                float* op = out + (size_t)row * 1024 + col0;
#pragma unroll
                for (int bj = 0; bj < 2; ++bj)
#pragma unroll
                    for (int n = 0; n < 2; ++n) { const f32x4 b = *(const f32x4*)(bp + bj * HALF + n * 16); *(f32x4*)(op + bj * HALF + n * 16) = b + gg[bj][n] * acc[ai][bj][m][n]; }
            }
    }
};

template <class Epi, class Sched, bool ALIGN_EPI = false, bool SP2 = false>
__device__ __forceinline__ void gemm_phase(PG8_LAS unsigned char* lds, const Gemm g, const Sched& S, const Epi& E, const int tid) {
    const int wid = __builtin_amdgcn_readfirstlane(tid >> 6), lane = tid & 63, wr = wid >> 2, wc = wid & 3, fr = lane & 15, fq = lane >> 4;
    const int K = g.K, nt = K / BK;
    unsigned voffA[2], voffB[2];
#pragma unroll
    for (int i = 0; i < 2; ++i) { int R, C; stage_rc(tid * 16 + i * 8192, R, C); const int Rb = Epi::PERM ? ((R & ~31) + perm32(R & 31)) : R;
        voffA[i] = (unsigned)(R * g.lda + C) * 2u; voffB[i] = (unsigned)(Rb * g.ldb + C) * 2u; }
    const size_t kstep = (size_t)(BK * 2);
    const size_t hstepA = (size_t)HALF * g.lda * 2, hstepB = (size_t)HALF * g.ldb * 2;
    const size_t tstepA = 2 * hstepA, tstepB = 2 * hstepB;
#define PG8_UA(u) ((const char*)g.A + (size_t)(u).pm * tstepA + (g.a_div ? (size_t)((u).pn / g.a_div) * g.a_gstride : (size_t)0))
#define PG8_UB(u) ((const char*)g.Bt + (size_t)(u).pn * tstepB)
    const unsigned ldsw = (unsigned)wid * 1024u;
    const int aoff = lds_byte(wr * 64 + fr, fq * 8), boff = lds_byte(wc * 32 + fr, fq * 8);
#define PG8_SA(b, h) (((b) * 2 + (h)) * HTB)
#define PG8_SB(b, h) ((4 + (b) * 2 + (h)) * HTB)
#define PG8_STAGE(bufoff, gbase, voff) do { _Pragma("unroll") for (int _i = 0; _i < 2; ++_i) \
        __builtin_amdgcn_global_load_lds((const unsigned*)((const char*)(gbase) + (voff)[_i]), (PG8_LAS unsigned*)(lds + (bufoff) + ldsw + _i * 8192), 16, 0, 0); } while (0)
#define PG8_LDA(dst, b, h) do { _Pragma("unroll") for (int m = 0; m < 4; ++m) _Pragma("unroll") for (int k = 0; k < 2; ++k) dst[m][k] = *(const PG8_LAS bf16x8*)(lds + PG8_SA(b, h) + aoff + m * 2048 + k * 1024); } while (0)
#define PG8_LDB(dst, b, h) do { _Pragma("unroll") for (int n = 0; n < 2; ++n) _Pragma("unroll") for (int k = 0; k < 2; ++k) dst[n][k] = *(const PG8_LAS bf16x8*)(lds + PG8_SB(b, h) + boff + n * 2048 + k * 1024); } while (0)
#define PG8_MMA(ai, bj, At, Bt) do { __builtin_amdgcn_s_setprio(1); _Pragma("unroll") for (int m = 0; m < 4; ++m) _Pragma("unroll") for (int n = 0; n < 2; ++n) _Pragma("unroll") for (int k = 0; k < 2; ++k) \
        acc[ai][bj][m][n] = __builtin_amdgcn_mfma_f32_16x16x32_bf16(Bt[n][k], At[m][k], acc[ai][bj][m][n], 0, 0, 0); __builtin_amdgcn_s_setprio(0); } while (0)
#define PG8_WAIT_V(n) asm volatile("s_waitcnt vmcnt(" #n ")" ::: "memory")
#define PG8_WAIT_L(n) asm volatile("s_waitcnt lgkmcnt(" #n ")" ::: "memory")
#define PG8_BAR __builtin_amdgcn_s_barrier()
#define PG8_SCHED __builtin_amdgcn_sched_barrier(0)
    Unit cur, nxt; int ui = 0;
    if (!S.next(0, cur)) return;
    f32x4 acc[2][2][4][2];
#pragma unroll
    for (int a = 0; a < 2; ++a)
#pragma unroll
        for (int b = 0; b < 2; ++b)
#pragma unroll
            for (int m = 0; m < 4; ++m)
#pragma unroll
                for (int n = 0; n < 2; ++n) acc[a][b][m][n] = (f32x4){0.f, 0.f, 0.f, 0.f};
    bf16x8 At[4][2], B0[2][2], B1[2][2];
    const char* cA = PG8_UA(cur); const char* cB = PG8_UB(cur);
    S.a_ready(cur);
    if constexpr (SP2) {
        PG8_STAGE(PG8_SB(0, 0), cB, voffB); PG8_STAGE(PG8_SB(0, 1), cB + hstepB, voffB); PG8_STAGE(PG8_SA(0, 0), cA, voffA); PG8_STAGE(PG8_SA(0, 1), cA + hstepA, voffA);
        if (wr == 1) PG8_BAR;
        PG8_WAIT_V(2); PG8_BAR;
        PG8_STAGE(PG8_SB(1, 0), cB + kstep, voffB); PG8_STAGE(PG8_SA(1, 0), cA + kstep, voffA); PG8_STAGE(PG8_SB(1, 1), cB + hstepB + kstep, voffB);
        PG8_WAIT_V(6); PG8_BAR;
    } else {
        PG8_STAGE(PG8_SB(0, 0), cB, voffB); PG8_STAGE(PG8_SA(0, 0), cA, voffA); PG8_STAGE(PG8_SB(0, 1), cB + hstepB, voffB); PG8_STAGE(PG8_SA(0, 1), cA + hstepA, voffA);
        if (wr == 1) PG8_BAR;
        PG8_WAIT_V(4); PG8_BAR;
        PG8_STAGE(PG8_SB(1, 0), cB + kstep, voffB); PG8_STAGE(PG8_SA(1, 0), cA + kstep, voffA); PG8_STAGE(PG8_SB(1, 1), cB + hstepB + kstep, voffB);
        PG8_WAIT_V(6); PG8_BAR;
    }
    for (;;) {
        const bool has_next = S.next(ui + 1, nxt);
        const char* nA = has_next ? PG8_UA(nxt) : cA; const char* nB = has_next ? PG8_UB(nxt) : cB;
        for (int t = 0; t < nt; t += 2) {
            const bool last = (t == nt - 2);
            const char* a1 = cA + (size_t)(t + 1) * kstep;
            const char* a2 = last ? nA : cA + (size_t)(t + 2) * kstep; const char* b2 = last ? nB : cB + (size_t)(t + 2) * kstep;
            const char* a3 = a2 + kstep; const char* b3 = b2 + kstep;
            if (last && has_next) S.a_ready(nxt);
            if constexpr (SP2) {
            PG8_LDB(B0, 0, 0); PG8_LDB(B1, 0, 1); PG8_SCHED; PG8_LDA(At, 0, 0); PG8_STAGE(PG8_SA(1, 1), a1 + hstepA, voffA);
            PG8_WAIT_V(8); PG8_WAIT_L(0); PG8_BAR; PG8_MMA(0, 0, At, B0); PG8_MMA(0, 1, At, B1); PG8_BAR; PG8_SCHED;
            PG8_LDA(At, 0, 1); PG8_STAGE(PG8_SB(0, 0), b2, voffB); PG8_STAGE(PG8_SB(0, 1), b2 + hstepB, voffB); PG8_STAGE(PG8_SA(0, 0), a2, voffA);
            PG8_WAIT_V(8); PG8_WAIT_L(0); PG8_BAR; PG8_MMA(1, 0, At, B0); PG8_MMA(1, 1, At, B1); PG8_BAR; PG8_SCHED;
            PG8_LDB(B0, 1, 0); PG8_LDB(B1, 1, 1); PG8_SCHED; PG8_LDA(At, 1, 0); PG8_STAGE(PG8_SA(0, 1), a2 + hstepA, voffA);
            PG8_WAIT_V(8); PG8_WAIT_L(0); PG8_BAR; PG8_MMA(0, 0, At, B0); PG8_MMA(0, 1, At, B1); PG8_BAR; PG8_SCHED;
            PG8_LDA(At, 1, 1); PG8_STAGE(PG8_SB(1, 0), b3, voffB); PG8_STAGE(PG8_SB(1, 1), b3 + hstepB, voffB); PG8_STAGE(PG8_SA(1, 0), a3, voffA);
            PG8_WAIT_V(8); PG8_WAIT_L(0); PG8_BAR; PG8_MMA(1, 0, At, B0); PG8_MMA(1, 1, At, B1); PG8_BAR; PG8_SCHED;
            } else {
            PG8_LDB(B0, 0, 0); PG8_SCHED; PG8_LDA(At, 0, 0); PG8_STAGE(PG8_SA(1, 1), a1 + hstepA, voffA);
            PG8_WAIT_L(8); PG8_BAR; PG8_WAIT_L(0); PG8_MMA(0, 0, At, B0); PG8_BAR; PG8_SCHED;
            PG8_LDB(B1, 0, 1); PG8_STAGE(PG8_SB(0, 0), b2, voffB);
            PG8_BAR; PG8_WAIT_L(0); PG8_MMA(0, 1, At, B1); PG8_BAR;
            PG8_LDA(At, 0, 1); PG8_STAGE(PG8_SA(0, 0), a2, voffA);
            PG8_BAR; PG8_WAIT_L(0); PG8_MMA(1, 0, At, B0); PG8_BAR; PG8_SCHED;
            PG8_STAGE(PG8_SB(0, 1), b2 + hstepB, voffB);
            PG8_WAIT_V(6); PG8_BAR; PG8_MMA(1, 1, At, B1); PG8_BAR;
            PG8_LDB(B0, 1, 0); PG8_SCHED; PG8_LDA(At, 1, 0); PG8_STAGE(PG8_SA(0, 1), a2 + hstepA, voffA);
            PG8_WAIT_L(8); PG8_BAR; PG8_WAIT_L(0); PG8_MMA(0, 0, At, B0); PG8_BAR; PG8_SCHED;
            PG8_LDB(B1, 1, 1); PG8_STAGE(PG8_SB(1, 0), b3, voffB);
            PG8_BAR; PG8_WAIT_L(0); PG8_MMA(0, 1, At, B1); PG8_BAR;
            PG8_LDA(At, 1, 1); PG8_STAGE(PG8_SA(1, 0), a3, voffA);
            PG8_BAR; PG8_WAIT_L(0); PG8_MMA(1, 0, At, B0); PG8_BAR; PG8_SCHED;
            PG8_STAGE(PG8_SB(1, 1), b3 + hstepB, voffB);
            PG8_WAIT_V(6); PG8_BAR; PG8_MMA(1, 1, At, B1); PG8_BAR;
            }
        }
        if constexpr (ALIGN_EPI) { if (wr == 0) PG8_BAR; }
        if constexpr (!Epi::AFTER_DRAIN) { E(acc, cur, wr, wc, fr, fq); S.done(cur); }
        if (!has_next) break;
#pragma unroll
        for (int a = 0; a < 2; ++a)
#pragma unroll
            for (int b = 0; b < 2; ++b)
#pragma unroll
                for (int m = 0; m < 4; ++m)
#pragma unroll
                    for (int n = 0; n < 2; ++n) acc[a][b][m][n] = (f32x4){0.f, 0.f, 0.f, 0.f};
        cur = nxt; cA = nA; cB = nB; ++ui;
        if constexpr (ALIGN_EPI) { if (wr == 1) PG8_BAR; }
    }
    PG8_WAIT_V(0);
    if constexpr (!ALIGN_EPI) { if (wr == 0) PG8_BAR; }
    PG8_BAR;
    if constexpr (Epi::AFTER_DRAIN) { E.fused(acc, cur, wr, wc, fr, fq, lds, wid, lane); S.done(cur); }
#undef PG8_UA
#undef PG8_UB
#undef PG8_SA
#undef PG8_SB
#undef PG8_STAGE
#undef PG8_LDA
#undef PG8_LDB
#undef PG8_MMA
#undef PG8_WAIT_V
#undef PG8_WAIT_L
#undef PG8_BAR
#undef PG8_SCHED
}
}

#ifndef PG8_SP2
#define PG8_SP2 true
#endif
#ifndef PG8_ALIGN
#define PG8_ALIGN true
#endif

typedef unsigned short bf16;
typedef unsigned v4u __attribute__((ext_vector_type(4)));
typedef unsigned v2u __attribute__((ext_vector_type(2)));
typedef float f32x4 __attribute__((ext_vector_type(4)));
#define LAS __attribute__((address_space(3)))

constexpr int NWAVES = 8, NTHR = 512;
constexpr int D = 1024, MC = 8192, ML = 4096, M = 12288, NPH = 23;
constexpr int LDS_BYTES = 147456;
constexpr float EPS = 1e-6f;
constexpr size_t MiB = 1u << 20;
constexpr size_t WS_MOD = 64 * 1024;
constexpr size_t WS_SSQ = 320 * 1024;
constexpr size_t WS_DT = 384 * 1024;
constexpr size_t WS_W = 2 * MiB;
constexpr size_t W_IN = WS_W, W_G = W_IN + 8 * MiB, W_GLU = W_G + 8 * MiB, W_BR = W_GLU + 1 * MiB, W_OUT = W_BR + 4 * MiB, W_1 = W_OUT + 2 * MiB, W_2 = W_1 + 8 * MiB;
constexpr size_t WS_H = 41 * MiB;
constexpr size_t WS_R1 = 65 * MiB;
constexpr size_t WS_Y = 161 * MiB;
constexpr size_t WS_Y5 = 209 * MiB;
constexpr size_t WS_XC = 221 * MiB;
constexpr size_t WS_YF = 239 * MiB;
constexpr size_t WS_END = 251 * MiB;
constexpr size_t O_SSD = 12582912, O_S5 = 16777216, O_DK = 17301504, O_DV = 25690112, O_WK = 34078720, O_WV = 36175872;
constexpr int C_Z = 0, C_XBC = 512, C_U = 1280, C_DQ = 1792, C_DK = 2304, C_DV = 2816, C_WQ = 3328, C_WK = 3840, C_WV = 3968;

struct Args { const float* in[44]; float* out; unsigned char* ws; int ph_lo, ph_hi; };

typedef const Args __attribute__((address_space(4)))* CArgs;
struct Ctx {
    CArgs ap; int tid, lane, wave;
    __device__ __forceinline__ const float* x_prompt() const { return ap->in[0]; }
    __device__ __forceinline__ const float* x_sample() const { return ap->in[1]; }
    __device__ __forceinline__ const float* state_ssd() const { return ap->in[2]; }
    __device__ __forceinline__ const float* state_s5() const { return ap->in[3]; }
    __device__ __forceinline__ const float* cache_dk() const { return ap->in[4]; }
    __device__ __forceinline__ const float* cache_dv() const { return ap->in[5]; }
    __device__ __forceinline__ const float* cache_wk() const { return ap->in[6]; }
    __device__ __forceinline__ const float* cache_wv() const { return ap->in[7]; }
    __device__ __forceinline__ const float* cvec() const { return ap->in[8]; }
    __device__ __forceinline__ const float* c_ctx() const { return ap->in[9]; }
    __device__ __forceinline__ const float* w_mod() const { return ap->in[10]; }
    __device__ __forceinline__ const float* b_mod() const { return ap->in[11]; }
    __device__ __forceinline__ const float* g_norm1() const { return ap->in[12]; }
    __device__ __forceinline__ const float* g_norm2() const { return ap->in[13]; }
    __device__ __forceinline__ const float* w_in() const { return ap->in[14]; }
    __device__ __forceinline__ const float* conv_w() const { return ap->in[15]; }
    __device__ __forceinline__ const float* conv_b() const { return ap->in[16]; }
    __device__ __forceinline__ const float* dt_bias() const { return ap->in[17]; }
    __device__ __forceinline__ const float* a_log() const { return ap->in[18]; }
    __device__ __forceinline__ const float* ssd_d() const { return ap->in[19]; }
    __device__ __forceinline__ const float* ssd_norm_g() const { return ap->in[20]; }
    __device__ __forceinline__ const float* lam_re() const { return ap->in[21]; }
    __device__ __forceinline__ const float* lam_im() const { return ap->in[22]; }
    __device__ __forceinline__ const float* log_step() const { return ap->in[23]; }
    __device__ __forceinline__ const float* b_re() const { return ap->in[24]; }
    __device__ __forceinline__ const float* b_im() const { return ap->in[25]; }
    __device__ __forceinline__ const float* c_re() const { return ap->in[26]; }
    __device__ __forceinline__ const float* c_im() const { return ap->in[27]; }
    __device__ __forceinline__ const float* s5_d() const { return ap->in[28]; }
    __device__ __forceinline__ const float* w_glu() const { return ap->in[29]; }
    __device__ __forceinline__ const float* b_glu() const { return ap->in[30]; }
    __device__ __forceinline__ const float* qn_g() const { return ap->in[31]; }
    __device__ __forceinline__ const float* kn_g() const { return ap->in[32]; }
    __device__ __forceinline__ const float* dlam() const { return ap->in[33]; }
    __device__ __forceinline__ const float* subln_g() const { return ap->in[34]; }
    __device__ __forceinline__ const float* wqn_g() const { return ap->in[35]; }
    __device__ __forceinline__ const float* wkn_g() const { return ap->in[36]; }
    __device__ __forceinline__ const float* sink() const { return ap->in[37]; }
    __device__ __forceinline__ const float* w_branch() const { return ap->in[38]; }
    __device__ __forceinline__ const float* w_gate() const { return ap->in[39]; }
    __device__ __forceinline__ const float* b_gate() const { return ap->in[40]; }
    __device__ __forceinline__ const float* w_out() const { return ap->in[41]; }
    __device__ __forceinline__ const float* w_fc1() const { return ap->in[42]; }
    __device__ __forceinline__ const float* w_fc2() const { return ap->in[43]; }
    __device__ __forceinline__ float* out() const { return ap->out; }
    __device__ __forceinline__ unsigned char* ws() const { return ap->ws; }
    __device__ __forceinline__ float* MOD() const { return (float*)(ap->ws + WS_MOD); }
    __device__ __forceinline__ float* SSQ() const { return (float*)(ap->ws + WS_SSQ); }
    __device__ __forceinline__ float* DT() const { return (float*)(ap->ws + WS_DT); }
    __device__ __forceinline__ bf16* H() const { return (bf16*)(ap->ws + WS_H); }
    __device__ __forceinline__ bf16* R1() const { return (bf16*)(ap->ws + WS_R1); }
    __device__ __forceinline__ bf16* Y() const { return (bf16*)(ap->ws + WS_Y); }
    __device__ __forceinline__ bf16* Y5() const { return (bf16*)(ap->ws + WS_Y5); }
    __device__ __forceinline__ bf16* XC() const { return (bf16*)(ap->ws + WS_XC); }
    __device__ __forceinline__ bf16* YF() const { return (bf16*)(ap->ws + WS_YF); }
};

__device__ __forceinline__ float wave_sum(float v) {
#pragma unroll
    for (int o = 1; o < 64; o <<= 1) v += __shfl_xor(v, o);
    return v;
}
__device__ __forceinline__ float wave_max(float v) {
#pragma unroll
    for (int o = 1; o < 64; o <<= 1) v = fmaxf(v, __shfl_xor(v, o));
    return v;
}
__device__ __forceinline__ float bf2f(bf16 h) { return __builtin_bit_cast(float, (unsigned)h << 16); }
__device__ __forceinline__ float bflo(unsigned w) { return __builtin_bit_cast(float, w << 16); }
__device__ __forceinline__ float bfhi(unsigned w) { return __builtin_bit_cast(float, w & 0xffff0000u); }
__device__ __forceinline__ unsigned f2bf(float f) { unsigned u = __builtin_bit_cast(unsigned, f); return (u + 0x7fffu + ((u >> 16) & 1u)) >> 16; }
__device__ __forceinline__ unsigned pk2(float lo, float hi) { return f2bf(lo) | (f2bf(hi) << 16); }
__device__ __forceinline__ float siluf(float x) { return x / (1.0f + __expf(-x)); }
__device__ __forceinline__ void unpack8(const v4u q, float (&f)[8]) { f[0] = bflo(q.x); f[1] = bfhi(q.x); f[2] = bflo(q.y); f[3] = bfhi(q.y); f[4] = bflo(q.z); f[5] = bfhi(q.z); f[6] = bflo(q.w); f[7] = bfhi(q.w); }

__device__ __forceinline__ void phase_mods(const Ctx& c, float* lf) {
    for (int i = c.tid; i < 5 * 1024; i += NTHR) { const int v = i >> 10, k = i & 1023; const float x = (v == 0) ? c.c_ctx()[k] : c.cvec()[(v - 1) * 1024 + k]; lf[i] = siluf(x); }
    __syncthreads();
    float* red = lf + 5 * 1024;
    for (int u = blockIdx.x; u < 192; u += gridDim.x) {
        const int l = u / 96, col0 = (u % 96) * 64;
        const float* W = c.w_mod() + (size_t)l * 1024 * 6144 + col0 + c.lane;
        float acc[5] = {0.f, 0.f, 0.f, 0.f, 0.f};
#pragma unroll 8
        for (int k = c.wave * 128; k < c.wave * 128 + 128; ++k) { const float wv = W[(size_t)k * 6144];
#pragma unroll
            for (int i = 0; i < 5; ++i) acc[i] += lf[i * 1024 + k] * wv; }
#pragma unroll
        for (int i = 0; i < 5; ++i) red[(c.wave * 5 + i) * 64 + c.lane] = acc[i];
        __syncthreads();
        if (c.tid < 320) { const int i = c.tid >> 6, ln = c.tid & 63; float s = c.b_mod()[l * 6144 + col0 + ln];
#pragma unroll
            for (int w = 0; w < 8; ++w) s += red[(w * 5 + i) * 64 + ln];
            c.MOD()[(size_t)(l * 5 + i) * 6144 + col0 + ln] = s; }
        __syncthreads();
    }
}

__device__ __forceinline__ int cmap(int mode, int n) { return mode == 0 ? n : (mode == 1 ? (n < 1280 ? n : n + 16) : ((n & 255) < 128 ? 128 * (n >> 8) + (n & 127) : 512 + 128 * (n >> 8) + (n & 127))); }
__device__ __forceinline__ void transpose_item(const float* W, int ld, int K, int N, int mode, const float* rowscale, bf16* WT, float* scr, int item, int lane) {
    const int nblk = N / 32, kb = item / nblk, nb = item % nblk, k0 = 64 * kb, n0 = 32 * nb, sc0 = cmap(mode, n0);
#pragma unroll 8
    for (int i = 0; i < 32; ++i) { const int kk = 2 * i + (lane >> 5); float v = W[(size_t)(k0 + kk) * ld + sc0 + (lane & 31)]; if (rowscale) v *= rowscale[k0 + kk]; scr[kk * 33 + (lane & 31)] = v; }
    __builtin_amdgcn_fence(__ATOMIC_RELEASE, "wavefront"); __builtin_amdgcn_wave_barrier();
    const int ch = lane & 7;
#pragma unroll
    for (int j = 0; j < 4; ++j) { const int n = (lane >> 3) + 8 * j; const float* s = scr + (8 * ch) * 33 + n;
        v4u o; o.x = pk2(s[0 * 33], s[1 * 33]); o.y = pk2(s[2 * 33], s[3 * 33]); o.z = pk2(s[4 * 33], s[5 * 33]); o.w = pk2(s[6 * 33], s[7 * 33]);
        *(v4u*)(WT + (size_t)(n0 + n) * K + k0 + 8 * ch) = o; }
    __builtin_amdgcn_fence(__ATOMIC_RELEASE, "wavefront"); __builtin_amdgcn_wave_barrier();
}
__device__ __forceinline__ void phase_convert(const Ctx& c, int l, float* lf) {
    float* scr = lf + c.wave * 2176;
    const int gw = blockIdx.x * NWAVES + c.wave, NGW = gridDim.x * NWAVES;
    unsigned char* ws = c.ws();
    for (int it = gw; it < 9984; it += NGW) {
        int r = it;
        if (r < 2048) { transpose_item(c.w_in() + (size_t)l * 1024 * 4112, 4112, 1024, 4096, 1, nullptr, (bf16*)(ws + W_IN), scr, r, c.lane); continue; } r -= 2048;
        if (r < 2048) { transpose_item(c.w_gate() + (size_t)l * 1024 * 4096, 4096, 1024, 4096, 0, nullptr, (bf16*)(ws + W_G), scr, r, c.lane); continue; } r -= 2048;
        if (r < 256) { transpose_item(c.w_glu() + (size_t)l * 512 * 1024, 1024, 512, 1024, 2, nullptr, (bf16*)(ws + W_GLU), scr, r, c.lane); continue; } r -= 256;
        if (r < 1024) { const int i = r >> 8; transpose_item(c.w_branch() + (size_t)(l * 4 + i) * 512 * 1024, 1024, 512, 1024, 0, i == 0 ? c.ssd_norm_g() + l * 512 : nullptr, (bf16*)(ws + W_BR) + (size_t)i * 1024 * 512, scr, r & 255, c.lane); continue; } r -= 1024;
        if (r < 512) { transpose_item(c.w_out() + (size_t)l * 1024 * 1024, 1024, 1024, 1024, 0, nullptr, (bf16*)(ws + W_OUT), scr, r, c.lane); continue; } r -= 512;
        if (r < 2048) { transpose_item(c.w_fc1() + (size_t)l * 1024 * 4096, 4096, 1024, 4096, 0, nullptr, (bf16*)(ws + W_1), scr, r, c.lane); continue; } r -= 2048;
        transpose_item(c.w_fc2() + (size_t)l * 4096 * 1024, 1024, 4096, 1024, 0, nullptr, (bf16*)(ws + W_2), scr, r, c.lane);
    }
}

__device__ __forceinline__ void phase_norm(const Ctx& c, int l, int which, float* lf) {
    if (which == 0) {
        for (int i = c.tid; i < 16384; i += NTHR) { const int k = i >> 4, j = i & 15; lf[j * 1024 + k] = c.w_in()[(size_t)l * 1024 * 4112 + (size_t)k * 4112 + 1280 + j]; }
        __syncthreads();
    }
    const int gw = blockIdx.x * NWAVES + c.wave, NGW = gridDim.x * NWAVES;
    const float* gn = (which == 0 ? c.g_norm1() : c.g_norm2()) + l * 1024;
    for (int m = gw; m < M; m += NGW) {
        const float* xr = (l == 0 && which == 0) ? (m < MC ? c.x_prompt() + (size_t)m * D : c.x_sample() + (size_t)(m - MC) * D) : c.out() + (size_t)m * D;
        const int mi = (m < MC) ? 0 : 1 + ((m - MC) >> 10);
        const float* mod = c.MOD() + (size_t)(l * 5 + mi) * 6144 + which * 3072;
        f32x4 v[4]; float s = 0.f;
#pragma unroll
        for (int j = 0; j < 4; ++j) { v[j] = *(const f32x4*)(xr + 4 * c.lane + 256 * j); s += (v[j].x * v[j].x + v[j].y * v[j].y) + (v[j].z * v[j].z + v[j].w * v[j].w); }
        const float rstd = rsqrtf(wave_sum(s) * (1.0f / D) + EPS);
#pragma unroll
        for (int j = 0; j < 4; ++j) { const int k = 4 * c.lane + 256 * j; const f32x4 g = *(const f32x4*)(gn + k), sh = *(const f32x4*)(mod + k), sc = *(const f32x4*)(mod + 1024 + k);
            v[j] = v[j] * rstd * g * (sc + 1.0f) + sh;
            v2u o; o.x = pk2(v[j].x, v[j].y); o.y = pk2(v[j].z, v[j].w); *(v2u*)(c.H() + (size_t)m * D + k) = o; }
        if (which == 0) {
            float mine = 0.f;
#pragma unroll 1
            for (int jj = 0; jj < 16; ++jj) { float a = 0.f;
#pragma unroll
                for (int j = 0; j < 4; ++j) { const f32x4 w = *(const f32x4*)(lf + jj * 1024 + 4 * c.lane + 256 * j); a += (v[j].x * w.x + v[j].y * w.y) + (v[j].z * w.z + v[j].w * w.w); }
                a = wave_sum(a); if (c.lane == jj) mine = a; }
            if (c.lane < 16) { const float x = mine + c.dt_bias()[l * 16 + c.lane]; c.DT()[(size_t)m * 16 + c.lane] = x > 20.f ? x : log1pf(__expf(x)); }
            if (c.lane == 0) c.SSQ()[m] = 0.f;
        }
    }
}

__device__ __forceinline__ void phase_qk(const Ctx& c, int l) {
    const int gw = blockIdx.x * NWAVES + c.wave, NGW = gridDim.x * NWAVES, lane = c.lane;
    const float gq = c.qn_g()[l * 64 + lane], gk = c.kn_g()[l * 64 + lane], gwq = c.wqn_g()[l * 64 + lane], gwk = c.wkn_g()[l * 64 + lane];
    for (int m = gw; m < M; m += NGW) {
        bf16* pr = c.R1() + (size_t)m * 4096;
        const bool lat = m >= MC;
        const int b = lat ? (m - MC) >> 10 : m >> 8, t = lat ? (m - MC) & 1023 : m & 255, L = lat ? 1024 : 256;
        float cs = 1.f, sn = 0.f;
        if (lat) { const int f = lane & 15; const float inv = exp2f(-(float)f * 0.8304820237218406f); const float ang = (float)((lane >> 5) ? (t & 63) : (t >> 6)) * inv; sincosf(ang, &sn, &cs); if (!((lane >> 4) & 1)) sn = -sn; }
        const size_t ob = (size_t)(b * 2 + l) * 256 + t;
#pragma unroll 1
        for (int gi = 0; gi < 26; ++gi) {
            const int col = gi < 8 ? C_DQ + gi * 64 : gi < 16 ? C_DK + (gi - 8) * 64 : gi < 24 ? C_WQ + (gi - 16) * 64 : C_WK + (gi - 24) * 64;
            const float gain = gi < 8 ? gq : gi < 16 ? gk : gi < 24 ? gwq : gwk;
            float v = bf2f(pr[col + lane]);
            const float ss = wave_sum(v * v);
            v = v * rsqrtf(ss * (1.0f / 64.0f) + EPS) * gain;
            if (lat) { const float p = __shfl_xor(v, 16); v = v * cs + p * sn; }
            pr[col + lane] = (bf16)f2bf(v);
            if (!lat) {
                if (gi >= 8 && gi < 16) c.out()[O_DK + ob * 512 + (gi - 8) * 64 + lane] = v;
                if (gi >= 24) c.out()[O_WK + ob * 128 + (gi - 24) * 64 + lane] = v;
            }
        }
        if (!lat) {
#pragma unroll
            for (int i = 0; i < 8; ++i) c.out()[O_DV + ob * 512 + i * 64 + lane] = bf2f(pr[C_DV + i * 64 + lane]);
#pragma unroll
            for (int i = 0; i < 2; ++i) c.out()[O_WV + ob * 128 + i * 64 + lane] = bf2f(pr[C_WV + i * 64 + lane]);
        }
#pragma unroll 1
        for (int i = 0; i < 12; ++i) { const int ch = lane + 64 * i; float a = c.conv_b()[l * 768 + ch];
#pragma unroll
            for (int j = 0; j < 7; ++j) { const int tt = t + j - 3; if (tt >= 0 && tt < L) a += c.conv_w()[(size_t)(l * 7 + j) * 768 + ch] * bf2f(c.R1()[(size_t)(m + j - 3) * 4096 + C_XBC + ch]); }
            c.XC()[(size_t)m * 768 + ch] = (bf16)f2bf(siluf(a)); }
    }
}

__device__ __forceinline__ void ssd_unit(const Ctx& c, int l, int pass, int b, int h) {
    const int L = pass ? 1024 : 256, tok0 = pass ? MC + b * 1024 : b * 256;
    const int p = c.tid >> 3, nq = c.tid & 7, grp = h >> 2;
    const float dsk = c.ssd_d()[l * 8 + h];
    for (int dir = 0; dir < 2; ++dir) {
        const float A = -__expf(c.a_log()[(l * 2 + dir) * 8 + h]);
        float S[8];
        if (pass) { const float* s0 = c.state_ssd() + (((((size_t)(b * 2 + l) * 2 + dir) * 8 + h) * 64 + p) * 64) + nq * 8;
#pragma unroll
            for (int j = 0; j < 8; ++j) S[j] = s0[j]; }
        else {
#pragma unroll
            for (int j = 0; j < 8; ++j) S[j] = 0.f; }
        size_t m = (size_t)tok0 + (dir ? L - 1 : 0);
        float dtv = c.DT()[m * 16 + dir * 8 + h]; float xv = bf2f(c.XC()[m * 768 + h * 64 + p]);
        v4u Bq = *(const v4u*)(c.XC() + m * 768 + 512 + grp * 64 + nq * 8), Cq = *(const v4u*)(c.XC() + m * 768 + 640 + grp * 64 + nq * 8);
        for (int s = 0; s < L; ++s) {
            const size_t mc = m; const float dtc = dtv, xc = xv; const v4u Bc = Bq, Cc = Cq;
            if (s + 1 < L) { m = (size_t)tok0 + (dir ? L - 2 - s : s + 1); dtv = c.DT()[m * 16 + dir * 8 + h]; xv = bf2f(c.XC()[m * 768 + h * 64 + p]);
                Bq = *(const v4u*)(c.XC() + m * 768 + 512 + grp * 64 + nq * 8); Cq = *(const v4u*)(c.XC() + m * 768 + 640 + grp * 64 + nq * 8); }
            float Bv[8], Cv[8]; unpack8(Bc, Bv); unpack8(Cc, Cv);
            const float da = __expf(dtc * A), xdt = xc * dtc; float yp = 0.f;
#pragma unroll
            for (int j = 0; j < 8; ++j) { S[j] = da * S[j] + xdt * Bv[j]; yp += Cv[j] * S[j]; }
            yp += __shfl_xor(yp, 1); yp += __shfl_xor(yp, 2); yp += __shfl_xor(yp, 4);
            if (dir == 0) { if (nq == 0) c.YF()[mc * 512 + h * 64 + p] = (bf16)f2bf(yp); }
            else {
                float g2 = 0.f;
                if (nq == 0) { const float ytot = bf2f(c.YF()[mc * 512 + h * 64 + p]) + yp + dsk * xc; const float z = bf2f(c.R1()[mc * 4096 + C_Z + h * 64 + p]); const float gt = ytot * siluf(z);
                    c.Y()[mc * 2048 + h * 64 + p] = (bf16)f2bf(gt); g2 = gt * gt; }
                g2 += __shfl_xor(g2, 8); g2 += __shfl_xor(g2, 16); g2 += __shfl_xor(g2, 32);
                if (c.lane == 0) atomicAdd(c.SSQ() + mc, g2);
            }
        }
        if (!pass) { float* so = c.out() + O_SSD + (((((size_t)(b * 2 + l) * 2 + dir) * 8 + h) * 64 + p) * 64) + nq * 8;
#pragma unroll
            for (int j = 0; j < 8; ++j) so[j] = S[j]; }
    }
}

__device__ __forceinline__ void s5_unit(const Ctx& c, int l, int pass, int b, int g, float* lf) {
    const int L = pass ? 1024 : 256, tok0 = pass ? MC + b * 1024 : b * 256, tid = c.tid;
    float* ybuf = lf;
    float* sbuf = lf + 16384;
    float* cmat = lf + 24576;
    for (int i = tid; i < L * 16; i += NTHR) ybuf[i] = 0.f;
    for (int i = tid; i < 4096; i += NTHR) { const int dir = i >> 11, ri = (i >> 10) & 1, mm = (i >> 6) & 15, n = i & 63;
        cmat[((dir * 2 + ri) * 16 + mm) * 129 + n] = (ri ? c.c_im() : c.c_re())[((size_t)((l * 2 + dir) * 32 + g) * 16 + mm) * 64 + n]; }
    const int dir = (tid >> 6) & 1, n = tid & 63;
    float are = 0.f, aim = 0.f, sre = 0.f, sim = 0.f, Bcr[16], Bci[16];
    if (tid < 128) {
        const int idx = ((l * 2 + dir) * 32 + g) * 64 + n;
        const float lre = c.lam_re()[idx], lim = c.lam_im()[idx], step = expf(c.log_step()[(l * 2 + dir) * 32 + g]);
        const float mag = expf(lre * step); float sn, cs; sincosf(lim * step, &sn, &cs); are = mag * cs; aim = mag * sn;
        const float den = lre * lre + lim * lim, cre = ((are - 1.0f) * lre + aim * lim) / den, cim = (aim * lre - (are - 1.0f) * lim) / den;
#pragma unroll
        for (int mm = 0; mm < 16; ++mm) { const float br = c.b_re()[(size_t)idx * 16 + mm], bi = c.b_im()[(size_t)idx * 16 + mm]; Bcr[mm] = cre * br - cim * bi; Bci[mm] = cre * bi + cim * br; }
        if (pass) { sre = c.state_s5()[((((size_t)(b * 2 + l) * 2 + dir) * 2 + 0) * 32 + g) * 64 + n]; sim = c.state_s5()[((((size_t)(b * 2 + l) * 2 + dir) * 2 + 1) * 32 + g) * 64 + n]; }
    }
    __syncthreads();
    for (int c0 = 0; c0 < L / 32; ++c0) {
        if (tid < 128) {
            for (int st = 0; st < 32; ++st) {
                const int s = c0 * 32 + st, t = dir ? L - 1 - s : s; const bf16* up = c.R1() + (size_t)(tok0 + t) * 4096 + C_U + g * 16;
                float u[16]; { float a8[8]; unpack8(*(const v4u*)up, a8);
#pragma unroll
                    for (int j = 0; j < 8; ++j) u[j] = a8[j];
                    unpack8(*(const v4u*)(up + 8), a8);
#pragma unroll
                    for (int j = 0; j < 8; ++j) u[8 + j] = a8[j]; }
                float xr = 0.f, xi = 0.f;
#pragma unroll
                for (int mm = 0; mm < 16; ++mm) { xr += Bcr[mm] * u[mm]; xi += Bci[mm] * u[mm]; }
                const float nr = are * sre - aim * sim + xr, ni = are * sim + aim * sre + xi; sre = nr; sim = ni;
                sbuf[(dir * 32 + st) * 128 + n] = sre; sbuf[(dir * 32 + st) * 128 + 64 + n] = sim;
            }
        }
        __syncthreads();
        { const int st = tid >> 4, mm = tid & 15;
#pragma unroll
            for (int d2 = 0; d2 < 2; ++d2) { const int s = c0 * 32 + st, t = d2 ? L - 1 - s : s;
                const float* cr = cmat + ((d2 * 2 + 0) * 16 + mm) * 129; const float* ci = cmat + ((d2 * 2 + 1) * 16 + mm) * 129; const float* sb = sbuf + (d2 * 32 + st) * 128;
                float a = 0.f;
#pragma unroll 8
                for (int k = 0; k < 64; ++k) a += cr[k] * sb[k] - ci[k] * sb[64 + k];
                ybuf[t * 16 + mm] += a; } }
        __syncthreads();
    }
    for (int i = tid; i < L * 16; i += NTHR) { const int t = i >> 4, mm = i & 15; const size_t m = (size_t)tok0 + t;
        const float u = bf2f(c.R1()[m * 4096 + C_U + g * 16 + mm]); c.Y5()[m * 512 + g * 16 + mm] = (bf16)f2bf(ybuf[i] + c.s5_d()[l * 512 + g * 16 + mm] * u); }
    if (!pass && tid < 128) { c.out()[O_S5 + ((((size_t)(b * 2 + l) * 2 + dir) * 2 + 0) * 32 + g) * 64 + n] = sre; c.out()[O_S5 + ((((size_t)(b * 2 + l) * 2 + dir) * 2 + 1) * 32 + g) * 64 + n] = sim; }
    __syncthreads();
}

template <int PASS> __device__ __forceinline__ void diff_unit(const Ctx& c, int l, int tg, float* lf) {
    constexpr int NKK = PASS ? 20 : 4, NK = NKK * 64;
    const int lane = c.lane;
    float* qs = lf + c.wave * 128;
    float* as = lf + 1024 + c.wave * 1280;
    const float lam_init = 0.8f - 0.6f * expf(-0.3f * (float)l);
    const float* lv = c.dlam() + l * 256;
    const float lam = expf(wave_sum(lv[lane] * lv[64 + lane])) - expf(wave_sum(lv[128 + lane] * lv[192 + lane])) + lam_init;
    for (int i = 0; i < 8; ++i) {
        const int task = c.wave * 8 + i, tok = tg * 16 + (task >> 2), h = task & 3;
        const size_t m = (size_t)(PASS ? MC : 0) + tok;
        const int b = PASS ? tok >> 10 : tok >> 8, tok0 = PASS ? MC + b * 1024 : b * 256;
        __builtin_amdgcn_wave_barrier();
        qs[lane] = bf2f(c.R1()[m * 4096 + C_DQ + h * 128 + lane]) * 0.125f; qs[64 + lane] = bf2f(c.R1()[m * 4096 + C_DQ + h * 128 + 64 + lane]) * 0.125f;
        __builtin_amdgcn_fence(__ATOMIC_RELEASE, "wavefront"); __builtin_amdgcn_wave_barrier();
        float sc0[NKK], sc1[NKK];
#pragma unroll
        for (int kk = 0; kk < NKK; ++kk) {
            const int s = kk * 64 + lane; float d0 = 0.f, d1 = 0.f;
            if (PASS && kk < 4) { const float* kp = c.cache_dk() + ((((size_t)(b * 2 + l) * 256 + s) * 4 + h) * 128);
#pragma unroll 4
                for (int d = 0; d < 64; d += 4) { const f32x4 k0 = *(const f32x4*)(kp + d), k1 = *(const f32x4*)(kp + 64 + d), q0 = *(const f32x4*)(qs + d), q1 = *(const f32x4*)(qs + 64 + d);
                    d0 += (k0.x * q0.x + k0.y * q0.y) + (k0.z * q0.z + k0.w * q0.w); d1 += (k1.x * q1.x + k1.y * q1.y) + (k1.z * q1.z + k1.w * q1.w); } }
            else { const bf16* kp = c.R1() + (size_t)(tok0 + (PASS ? s - 256 : s)) * 4096 + C_DK + h * 128;
#pragma unroll 2
                for (int d = 0; d < 64; d += 8) { float k0[8], k1[8]; unpack8(*(const v4u*)(kp + d), k0); unpack8(*(const v4u*)(kp + 64 + d), k1);
#pragma unroll
                    for (int j = 0; j < 8; ++j) { d0 += k0[j] * qs[d + j]; d1 += k1[j] * qs[64 + d + j]; } } }
            sc0[kk] = d0; sc1[kk] = d1;
        }
        float m0 = sc0[0], m1 = sc1[0];
#pragma unroll
        for (int kk = 1; kk < NKK; ++kk) { m0 = fmaxf(m0, sc0[kk]); m1 = fmaxf(m1, sc1[kk]); }
        m0 = wave_max(m0); m1 = wave_max(m1);
        float s0 = 0.f, s1 = 0.f;
#pragma unroll
        for (int kk = 0; kk < NKK; ++kk) { sc0[kk] = __expf(sc0[kk] - m0); sc1[kk] = __expf(sc1[kk] - m1); s0 += sc0[kk]; s1 += sc1[kk]; }
        s0 = 1.0f / wave_sum(s0); s1 = lam / wave_sum(s1);
#pragma unroll
        for (int kk = 0; kk < NKK; ++kk) as[kk * 64 + lane] = sc0[kk] * s0 - sc1[kk] * s1;
        __builtin_amdgcn_fence(__ATOMIC_RELEASE, "wavefront"); __builtin_amdgcn_wave_barrier();
        float o0 = 0.f, o1 = 0.f;
        if (PASS) { const float* vp = c.cache_dv() + ((((size_t)(b * 2 + l) * 256) * 4 + h) * 128);
#pragma unroll 4
            for (int s = 0; s < 256; ++s) { const float a = as[s]; o0 += a * vp[(size_t)s * 512 + lane]; o1 += a * vp[(size_t)s * 512 + 64 + lane]; } }
        { const bf16* vp = c.R1() + (size_t)tok0 * 4096 + C_DV + h * 128; const float* ap = as + (PASS ? 256 : 0); const int ns = PASS ? 1024 : 256;
#pragma unroll 4
            for (int s = 0; s < ns; ++s) { const float a = ap[s]; o0 += a * bf2f(vp[(size_t)s * 4096 + lane]); o1 += a * bf2f(vp[(size_t)s * 4096 + 64 + lane]); } }
        const float r = rsqrtf(wave_sum(o0 * o0 + o1 * o1) * (1.0f / 128.0f) + EPS) * (1.0f - lam_init);
        c.Y()[m * 2048 + 1024 + h * 128 + lane] = (bf16)f2bf(o0 * r * c.subln_g()[l * 128 + lane]);
        c.Y()[m * 2048 + 1024 + h * 128 + 64 + lane] = (bf16)f2bf(o1 * r * c.subln_g()[l * 128 + 64 + lane]);
    }
    (void)NK;
}

template <int PASS> __device__ __forceinline__ void win_unit(const Ctx& c, int l, int tg, float* lf) {
    constexpr int NKK = PASS ? 9 : 4;
    const int lane = c.lane;
    float* qs = lf + c.wave * 64;
    float* as = lf + 512 + c.wave * 576;
    for (int i = 0; i < 8; ++i) {
        const int task = c.wave * 8 + i, tok = tg * 8 + (task >> 3), hh = task & 7, nkv = hh >> 2;
        const size_t m = (size_t)(PASS ? MC : 0) + tok;
        const int b = PASS ? tok >> 10 : tok >> 8, tok0 = PASS ? MC + b * 1024 : b * 256, qp = PASS ? tok & 1023 : tok & 255;
        const int lo = PASS ? (qp - 128 < 0 ? 0 : qp - 128) : 0, hi = PASS ? (qp + 128 > 1023 ? 1023 : qp + 128) : 255;
        const int nk = PASS ? 256 + (hi - lo + 1) : 256;
        __builtin_amdgcn_wave_barrier();
        qs[lane] = bf2f(c.R1()[m * 4096 + C_WQ + hh * 64 + lane]) * 0.125f;
        __builtin_amdgcn_fence(__ATOMIC_RELEASE, "wavefront"); __builtin_amdgcn_wave_barrier();
        float sc[NKK];
#pragma unroll
        for (int kk = 0; kk < NKK; ++kk) {
            const int s = kk * 64 + lane; float d0 = 0.f;
            if (PASS && kk < 4) { const float* kp = c.cache_wk() + (((size_t)(b * 2 + l) * 256 + s) * 2 + nkv) * 64;
#pragma unroll 4
                for (int d = 0; d < 64; d += 4) { const f32x4 k0 = *(const f32x4*)(kp + d), q0 = *(const f32x4*)(qs + d); d0 += (k0.x * q0.x + k0.y * q0.y) + (k0.z * q0.z + k0.w * q0.w); } }
            else if (s < nk) { const bf16* kp = c.R1() + (size_t)(tok0 + (PASS ? lo + s - 256 : s)) * 4096 + C_WK + nkv * 64;
#pragma unroll 2
                for (int d = 0; d < 64; d += 8) { float k0[8]; unpack8(*(const v4u*)(kp + d), k0);
#pragma unroll
                    for (int j = 0; j < 8; ++j) d0 += k0[j] * qs[d + j]; } }
            else d0 = -1e30f;
            sc[kk] = d0;
        }
        const float sk = c.sink()[l * 8 + hh];
        float mx = sk;
#pragma unroll
        for (int kk = 0; kk < NKK; ++kk) mx = fmaxf(mx, sc[kk]);
        mx = wave_max(mx);
        float sm = 0.f;
#pragma unroll
        for (int kk = 0; kk < NKK; ++kk) { sc[kk] = __expf(sc[kk] - mx); sm += sc[kk]; }
        const float inv = 1.0f / (wave_sum(sm) + __expf(sk - mx));
#pragma unroll
        for (int kk = 0; kk < NKK; ++kk) as[kk * 64 + lane] = sc[kk] * inv;
        __builtin_amdgcn_fence(__ATOMIC_RELEASE, "wavefront"); __builtin_amdgcn_wave_barrier();
        float o = 0.f;
        if (PASS) { const float* vp = c.cache_wv() + (((size_t)(b * 2 + l) * 256) * 2 + nkv) * 64;
#pragma unroll 4
            for (int s = 0; s < 256; ++s) o += as[s] * vp[(size_t)s * 128 + lane]; }
        { const bf16* vp = c.R1() + (size_t)(tok0 + lo) * 4096 + C_WV + nkv * 64; const float* ap = as + (PASS ? 256 : 0); const int ns = PASS ? hi - lo + 1 : 256;
#pragma unroll 4
            for (int s = 0; s < ns; ++s) o += ap[s] * bf2f(vp[(size_t)s * 4096 + lane]); }
        c.Y()[m * 2048 + 1536 + hh * 64 + lane] = (bf16)f2bf(o);
    }
}

__device__ __forceinline__ void phase_mixers(const Ctx& c, int l, float* lf) {
    for (int u = blockIdx.x; u < 3744; u += gridDim.x) {
        if (u < 32) ssd_unit(c, l, 1, u >> 3, u & 7);
        else if (u < 160) s5_unit(c, l, 1, (u - 32) >> 5, (u - 32) & 31, lf);
        else if (u < 416) diff_unit<1>(c, l, u - 160, lf);
        else if (u < 928) win_unit<1>(c, l, u - 416, lf);
        else if (u < 1184) ssd_unit(c, l, 0, (u - 928) >> 3, (u - 928) & 7);
        else if (u < 2208) s5_unit(c, l, 0, (u - 1184) >> 5, (u - 1184) & 31, lf);
        else if (u < 2720) diff_unit<0>(c, l, u - 2208, lf);
        else win_unit<0>(c, l, u - 2720, lf);
        __syncthreads();
    }
}

__device__ __forceinline__ void phase_sum4(const Ctx& c) {
    const int gt = blockIdx.x * NTHR + c.tid, NT = gridDim.x * NTHR;
    for (int i = gt; i < M * 128; i += NT) { const size_t m = (size_t)(i >> 7); const int c8 = (i & 127) * 8;
        float a[8] = {0.f, 0.f, 0.f, 0.f, 0.f, 0.f, 0.f, 0.f};
#pragma unroll
        for (int j = 0; j < 4; ++j) { float f[8]; unpack8(*(const v4u*)(c.R1() + m * 4096 + j * 1024 + c8), f);
#pragma unroll
            for (int k = 0; k < 8; ++k) a[k] += f[k]; }
        v4u o; o.x = pk2(a[0], a[1]); o.y = pk2(a[2], a[3]); o.z = pk2(a[4], a[5]); o.w = pk2(a[6], a[7]);
        *(v4u*)(c.H() + m * 1024 + c8) = o; }
}

__global__ void __launch_bounds__(NTHR, 2) fwd_kernel(Args args) {
    extern __shared__ __attribute__((aligned(16))) unsigned char lds[];
    float* lf = (float*)lds;
    PG8_LAS unsigned char* ring = (PG8_LAS unsigned char*)lds;
    const int ph_lo = args.ph_lo, ph_hi = args.ph_hi;

    for (int ph = ph_lo; ph < ph_hi; ++ph) {
        Ctx c; c.ap = (CArgs)__builtin_amdgcn_kernarg_segment_ptr(); asm volatile("" : "+s"(c.ap));
        int tid_o = threadIdx.x; asm volatile("" : "+v"(tid_o));
        c.tid = tid_o; c.lane = tid_o & 63; c.wave = __builtin_amdgcn_readfirstlane(tid_o >> 6);
        const int G = gridDim.x, bid = blockIdx.x;
        unsigned char* ws = c.ws();
        if (ph == 0) { phase_mods(c, lf); __syncthreads(); phase_convert(c, 0, lf); }
        else {
            const int l = (ph - 1) / 11, q = (ph - 1) % 11;
            if (q == 0) { if (l == 1) { phase_convert(c, 1, lf); __syncthreads(); } phase_norm(c, l, 0, lf); }
            else if (q == 1) {
                pg8::Gemm g{c.H(), (const bf16*)(ws + W_IN), M, 4096, 1024, 1024, 1024, 0, 0}; pg8::StaticOrder S; S.init(M, 4096, G, bid);
                pg8::EpiB<0> E{c.R1(), 4096, nullptr, nullptr};
                pg8::gemm_phase<pg8::EpiB<0>, pg8::StaticOrder, true, true>(ring, g, S, E, tid_o);
            }
            else if (q == 2) phase_qk(c, l);
            else if (q == 3) phase_mixers(c, l, lf);
            else if (q == 4) {
                { pg8::Gemm g{c.Y5(), (const bf16*)(ws + W_GLU), M, 1024, 512, 512, 512, 0, 0}; pg8::StaticOrder S; S.init(M, 1024, G, bid);
                  pg8::EpiGlu E{c.Y(), 2048, 512, c.b_glu() + l * 1024};
                  pg8::gemm_phase<pg8::EpiGlu, pg8::StaticOrder, true, true>(ring, g, S, E, tid_o); }
                { pg8::Gemm g{c.H(), (const bf16*)(ws + W_G), M, 4096, 1024, 1024, 1024, 0, 0}; pg8::StaticOrder S; S.init(M, 4096, G, bid);
                  pg8::EpiB<1> E{c.R1(), 4096, c.b_gate() + l * 4096, nullptr};
                  pg8::gemm_phase<pg8::EpiB<1>, pg8::StaticOrder, true, true>(ring, g, S, E, tid_o); }
            }
            else if (q == 5) {
                pg8::Gemm g{c.Y(), (const bf16*)(ws + W_BR), M, 4096, 512, 2048, 512, 4, 1024}; pg8::StaticOrder S; S.init(M, 4096, G, bid);
                pg8::EpiB<3> E{c.R1(), 4096, nullptr, c.SSQ()};
                pg8::gemm_phase<pg8::EpiB<3>, pg8::StaticOrder, true, true>(ring, g, S, E, tid_o);
            }
            else if (q == 6) phase_sum4(c);
            else if (q == 7) {
                pg8::Gemm g{c.H(), (const bf16*)(ws + W_OUT), M, 1024, 1024, 1024, 1024, 0, 0}; pg8::StaticOrder S; S.init(M, 1024, G, bid);
                pg8::EpiRes E{l == 0 ? c.x_prompt() : c.out(), l == 0 ? c.x_sample() : c.out() + (size_t)MC * D, c.out(), c.MOD() + (size_t)l * 5 * 6144, 2048};
                pg8::gemm_phase<pg8::EpiRes, pg8::StaticOrder, true, true>(ring, g, S, E, tid_o);
            }
            else if (q == 8) phase_norm(c, l, 1, lf);
            else if (q == 9) {
                pg8::Gemm g{c.H(), (const bf16*)(ws + W_1), M, 4096, 1024, 1024, 1024, 0, 0}; pg8::StaticOrder S; S.init(M, 4096, G, bid);
                pg8::EpiB<2> E{c.R1(), 4096, nullptr, nullptr};
                pg8::gemm_phase<pg8::EpiB<2>, pg8::StaticOrder, true, true>(ring, g, S, E, tid_o);
            }
            else {
                pg8::Gemm g{c.R1(), (const bf16*)(ws + W_2), M, 1024, 4096, 4096, 4096, 0, 0}; pg8::StaticOrder S; S.init(M, 1024, G, bid);
                pg8::EpiRes E{c.out(), c.out() + (size_t)MC * D, c.out(), c.MOD() + (size_t)l * 5 * 6144, 5120};
                pg8::gemm_phase<pg8::EpiRes, pg8::StaticOrder, true, true>(ring, g, S, E, tid_o);
            }
        }
        if (ph + 1 < ph_hi) { __threadfence(); cg::this_grid().sync(); }
    }
}

extern "C" void kernel_launch(void* const* d_in, const int* in_sizes, int n_in, void* d_out, int out_size, void* d_ws, size_t ws_size, hipStream_t stream) {
    static int grid = 0;
    if (grid == 0) {
        if (n_in != 44 || ws_size < WS_END) { fprintf(stderr, "kernel_launch: expected 44 inputs and >= %zu bytes of workspace; got %d, %zu\n", (size_t)WS_END, n_in, ws_size); grid = -1; return; }
        int dev = 0, cus = 0, per_cu = 0;
        (void)hipGetDevice(&dev); (void)hipDeviceGetAttribute(&cus, hipDeviceAttributeMultiprocessorCount, dev);
        (void)hipFuncSetAttribute((const void*)fwd_kernel, hipFuncAttributeMaxDynamicSharedMemorySize, LDS_BYTES);
        (void)hipOccupancyMaxActiveBlocksPerMultiprocessor(&per_cu, (const void*)fwd_kernel, NTHR, LDS_BYTES);
        if (per_cu < 1) { fprintf(stderr, "kernel_launch: occupancy query says %d blocks per CU\n", per_cu); per_cu = 1; }
        (void)hipGetLastError();
        grid = cus > 0 ? cus : 256;
    }
    if (grid < 0) return;
    Args a{};
    for (int i = 0; i < 44; ++i) a.in[i] = (const float*)d_in[i];
    a.out = (float*)d_out; a.ws = (unsigned char*)d_ws;
#if MK_MULTI
    for (int ph = 0; ph < NPH; ++ph) { a.ph_lo = ph; a.ph_hi = ph + 1; hipLaunchKernelGGL(fwd_kernel, dim3(grid), dim3(NTHR), LDS_BYTES, stream, a); }
#else
    a.ph_lo = 0; a.ph_hi = NPH;
    void* kargs[] = {&a};
    hipError_t e = hipLaunchCooperativeKernel((const void*)fwd_kernel, dim3(grid), dim3(NTHR), kargs, LDS_BYTES, stream);
    if (e != hipSuccess) fprintf(stderr, "cooperative launch failed: %s (grid %d)\n", hipGetErrorString(e), grid);
#endif
}
```

```cpp
#include <hip/hip_runtime.h>
#include <hip/hip_cooperative_groups.h>
#include <cstdio>
#include <cstdint>
namespace cg = cooperative_groups;

#ifndef MK_MULTI
#define MK_MULTI 0
#endif

namespace pg8 {
#define PG8_LAS __attribute__((address_space(3)))
typedef unsigned short bf16_t;
typedef short bf16x8 __attribute__((ext_vector_type(8)));
typedef float f32x4 __attribute__((ext_vector_type(4)));
typedef unsigned u32x4 __attribute__((ext_vector_type(4)));
constexpr int BM = 256, BK = 64, HALF = 128, HTB = HALF * BK * 2  , STAGE_BYTES = 8 * HTB, NXCD = 8, WGM = 8;

__host__ __device__ __forceinline__ int lds_byte(int r, int c) { const int st = (r >> 4) * 2 + (c >> 5), rr = r & 15, cc = c & 31, ob = rr * 64 + cc * 2; return st * 1024 + (ob ^ (((ob >> 9) & 1) << 5)); }
__host__ __device__ __forceinline__ void stage_rc(int b, int& R, int& C) { const int st = b / 1024, sb = b % 1024, swz = sb ^ (((sb >> 9) & 1) << 5); R = (st >> 1) * 16 + swz / 64; C = (st & 1) * 32 + (swz % 64) / 2; }
__host__ __device__ __forceinline__ int perm32(int rho) { const int n = rho >> 4, i = rho & 15; return 8 * (i >> 2) + 4 * n + (i & 3); }

struct Unit { int pm, pn; };
struct Gemm { const bf16_t* A; const bf16_t* Bt; int M, N, K, lda, ldb, a_div; size_t a_gstride; };

struct StaticOrder {
    int nM, nN, nwg, G, c;
    __host__ __device__ void init(int M, int N, int G_, int c_) { nM = M / BM; nN = N / BM; nwg = nM * nN; G = G_; c = c_; }
    __host__ __device__ bool next(int i, Unit& u) const {
        const long L = (long)i * G + c; if (L >= nwg) return false;
        int wgid = (int)L; { const int q = nwg / NXCD, r = nwg % NXCD, xcd = wgid % NXCD, off = wgid / NXCD; wgid = (xcd < r ? xcd * (q + 1) : r * (q + 1) + (xcd - r) * q) + off; }
        const int nig = WGM * nN, gid = wgid / nig, fm = gid * WGM, gsz = (nM - fm) < WGM ? (nM - fm) : WGM;
        u.pm = fm + ((wgid % nig) % gsz); u.pn = (wgid % nig) / gsz; return true;
    }
    __device__ __forceinline__ void a_ready(const Unit&) const {}
    __device__ __forceinline__ void done(const Unit&) const {}
};

__device__ __forceinline__ unsigned cvt_pk_bf16(float lo, float hi) { unsigned r; asm volatile("v_cvt_pk_bf16_f32 %0, %1, %2" : "=v"(r) : "v"(lo), "v"(hi)); return r; }
__device__ __forceinline__ float bf_lo(unsigned w) { return __builtin_bit_cast(float, w << 16); }
__device__ __forceinline__ float bf_hi(unsigned w) { return __builtin_bit_cast(float, w & 0xffff0000u); }
__device__ __forceinline__ float sigmoidf_(float x) { return 1.0f / (1.0f + __expf(-x)); }

template <int MODE> struct EpiB {
    static constexpr bool PERM = true, AFTER_DRAIN = false;
    bf16_t* O; int ldc; const float* bias; const float* ssq;
    __device__ __forceinline__ void operator()(const f32x4 (&acc)[2][2][4][2], const Unit& u, int wr, int wc, int fr, int fq) const {
        const int row0 = u.pm * BM + wr * 64 + fr, col0 = u.pn * BM + wc * 32 + 8 * fq;
        f32x4 bv[2][2];
#pragma unroll
        for (int bj = 0; bj < 2; ++bj)
#pragma unroll
            for (int n = 0; n < 2; ++n) bv[bj][n] = (MODE == 1) ? *(const f32x4*)(bias + col0 + bj * HALF + 4 * n) : (f32x4){0.f, 0.f, 0.f, 0.f};
#pragma unroll
        for (int ai = 0; ai < 2; ++ai)
#pragma unroll
            for (int m = 0; m < 4; ++m) {
                const int row = row0 + ai * HALF + m * 16;
                bf16_t* rowp = O + (size_t)row * ldc + col0;
                float rs = 1.f;
                if (MODE == 3) { if (u.pn < 4) rs = rsqrtf(ssq[row] * (1.0f / 512.0f) + 1e-6f); }
#pragma unroll
                for (int bj = 0; bj < 2; ++bj) {
                    f32x4 v0 = acc[ai][bj][m][0] + bv[bj][0], v1 = acc[ai][bj][m][1] + bv[bj][1];
                    if (MODE == 1) {
#pragma unroll
                        for (int j = 0; j < 4; ++j) { v0[j] = sigmoidf_(v0[j]); v1[j] = sigmoidf_(v1[j]); }
                    }
                    if (MODE == 2) {
#pragma unroll
                        for (int j = 0; j < 4; ++j) { const float a = fmaxf(v0[j], 0.f), b = fmaxf(v1[j], 0.f); v0[j] = a * a; v1[j] = b * b; }
                    }
                    if (MODE == 3) {
                        const u32x4 gq = *(const u32x4*)(rowp + bj * HALF);
                        v0[0] *= bf_lo(gq.x) * rs; v0[1] *= bf_hi(gq.x) * rs; v0[2] *= bf_lo(gq.y) * rs; v0[3] *= bf_hi(gq.y) * rs;
                        v1[0] *= bf_lo(gq.z) * rs; v1[1] *= bf_hi(gq.z) * rs; v1[2] *= bf_lo(gq.w) * rs; v1[3] *= bf_hi(gq.w) * rs;
                    }
                    u32x4 w; w.x = cvt_pk_bf16(v0[0], v0[1]); w.y = cvt_pk_bf16(v0[2], v0[3]); w.z = cvt_pk_bf16(v1[0], v1[1]); w.w = cvt_pk_bf16(v1[2], v1[3]);
                    *(u32x4*)(rowp + bj * HALF) = w;
                }
            }
    }
};
struct EpiGlu {
    static constexpr bool PERM = true, AFTER_DRAIN = false;
    bf16_t* O; int ldc; int ocol; const float* bias;
    __device__ __forceinline__ void operator()(const f32x4 (&acc)[2][2][4][2], const Unit& u, int wr, int wc, int fr, int fq) const {
        const int row0 = u.pm * BM + wr * 64 + fr, cc = u.pn * HALF + wc * 32 + 8 * fq;
        f32x4 bv[2][2];
#pragma unroll
        for (int bj = 0; bj < 2; ++bj)
#pragma unroll
            for (int n = 0; n < 2; ++n) bv[bj][n] = *(const f32x4*)(bias + bj * 512 + cc + 4 * n);
#pragma unroll
        for (int ai = 0; ai < 2; ++ai)
#pragma unroll
            for (int m = 0; m < 4; ++m) {
                bf16_t* rowp = O + (size_t)(row0 + ai * HALF + m * 16) * ldc + ocol + cc;
                f32x4 v0 = acc[ai][0][m][0] + bv[0][0], v1 = acc[ai][0][m][1] + bv[0][1];
                const f32x4 g0 = acc[ai][1][m][0] + bv[1][0], g1 = acc[ai][1][m][1] + bv[1][1];
#pragma unroll
                for (int j = 0; j < 4; ++j) { v0[j] *= sigmoidf_(g0[j]); v1[j] *= sigmoidf_(g1[j]); }
                u32x4 w; w.x = cvt_pk_bf16(v0[0], v0[1]); w.y = cvt_pk_bf16(v0[2], v0[3]); w.z = cvt_pk_bf16(v1[0], v1[1]); w.w = cvt_pk_bf16(v1[2], v1[3]);
                *(u32x4*)rowp = w;
            }
    }
};
struct EpiRes {
    static constexpr bool PERM = false, AFTER_DRAIN = false;
    const float* base_ctx; const float* base_lat;
    float* out; const float* modv;
    int goff;
    __device__ __forceinline__ void operator()(const f32x4 (&acc)[2][2][4][2], const Unit& u, int wr, int wc, int fr, int fq) const {
        const int row0 = u.pm * BM + wr * 64 + fr, col0 = u.pn * BM + wc * 32 + 4 * fq;
        const int mi = (u.pm < 32) ? 0 : 1 + ((u.pm - 32) >> 2);
        const float* gv = modv + (size_t)mi * 6144 + goff;
        f32x4 gg[2][2];
#pragma unroll
        for (int bj = 0; bj < 2; ++bj)
#pragma unroll
            for (int n = 0; n < 2; ++n) gg[bj][n] = *(const f32x4*)(gv + col0 + bj * HALF + n * 16);
#pragma unroll
        for (int ai = 0; ai < 2; ++ai)
#pragma unroll
            for (int m = 0; m < 4; ++m) {
                const int row = row0 + ai * HALF + m * 16;
                const float* bp = (row < 8192 ? base_ctx + (size_t)row * 1024 : base_lat + (size_t)(row - 8192) * 1024) + col0;
                float* op = out + (size_t)row * 1024 + col0;
#pragma unroll
                for (int bj = 0; bj < 2; ++bj)
#pragma unroll
                    for (int n = 0; n < 2; ++n) { const f32x4 b = *(const f32x4*)(bp + bj * HALF + n * 16); *(f32x4*)(op + bj * HALF + n * 16) = b + gg[bj][n] * acc[ai][bj][m][n]; }
            }
    }
};

template <class Epi, class Sched, bool ALIGN_EPI = false, bool SP2 = false>
__device__ __forceinline__ void gemm_phase(PG8_LAS unsigned char* lds, const Gemm g, const Sched& S, const Epi& E, const int tid) {
    const int wid = __builtin_amdgcn_readfirstlane(tid >> 6), lane = tid & 63, wr = wid >> 2, wc = wid & 3, fr = lane & 15, fq = lane >> 4;
    const int K = g.K, nt = K / BK;
    unsigned voffA[2], voffB[2];
#pragma unroll
    for (int i = 0; i < 2; ++i) { int R, C; stage_rc(tid * 16 + i * 8192, R, C); const int Rb = Epi::PERM ? ((R & ~31) + perm32(R & 31)) : R;
        voffA[i] = (unsigned)(R * g.lda + C) * 2u; voffB[i] = (unsigned)(Rb * g.ldb + C) * 2u; }
    const size_t kstep = (size_t)(BK * 2);
    const size_t hstepA = (size_t)HALF * g.lda * 2, hstepB = (size_t)HALF * g.ldb * 2;
    const size_t tstepA = 2 * hstepA, tstepB = 2 * hstepB;
#define PG8_UA(u) ((const char*)g.A + (size_t)(u).pm * tstepA + (g.a_div ? (size_t)((u).pn / g.a_div) * g.a_gstride : (size_t)0))
#define PG8_UB(u) ((const char*)g.Bt + (size_t)(u).pn * tstepB)
    const unsigned ldsw = (unsigned)wid * 1024u;
    const int aoff = lds_byte(wr * 64 + fr, fq * 8), boff = lds_byte(wc * 32 + fr, fq * 8);
#define PG8_SA(b, h) (((b) * 2 + (h)) * HTB)
#define PG8_SB(b, h) ((4 + (b) * 2 + (h)) * HTB)
#define PG8_STAGE(bufoff, gbase, voff) do { _Pragma("unroll") for (int _i = 0; _i < 2; ++_i) \
        __builtin_amdgcn_global_load_lds((const unsigned*)((const char*)(gbase) + (voff)[_i]), (PG8_LAS unsigned*)(lds + (bufoff) + ldsw + _i * 8192), 16, 0, 0); } while (0)
#define PG8_LDA(dst, b, h) do { _Pragma("unroll") for (int m = 0; m < 4; ++m) _Pragma("unroll") for (int k = 0; k < 2; ++k) dst[m][k] = *(const PG8_LAS bf16x8*)(lds + PG8_SA(b, h) + aoff + m * 2048 + k * 1024); } while (0)
#define PG8_LDB(dst, b, h) do { _Pragma("unroll") for (int n = 0; n < 2; ++n) _Pragma("unroll") for (int k = 0; k < 2; ++k) dst[n][k] = *(const PG8_LAS bf16x8*)(lds + PG8_SB(b, h) + boff + n * 2048 + k * 1024); } while (0)
#define PG8_MMA(ai, bj, At, Bt) do { __builtin_amdgcn_s_setprio(1); _Pragma("unroll") for (int m = 0; m < 4; ++m) _Pragma("unroll") for (int n = 0; n < 2; ++n) _Pragma("unroll") for (int k = 0; k < 2; ++k) \
        acc[ai][bj][m][n] = __builtin_amdgcn_mfma_f32_16x16x32_bf16(Bt[n][k], At[m][k], acc[ai][bj][m][n], 0, 0, 0); __builtin_amdgcn_s_setprio(0); } while (0)
#define PG8_WAIT_V(n) asm volatile("s_waitcnt vmcnt(" #n ")" ::: "memory")
#define PG8_WAIT_L(n) asm volatile("s_waitcnt lgkmcnt(" #n ")" ::: "memory")
#define PG8_BAR __builtin_amdgcn_s_barrier()
#define PG8_SCHED __builtin_amdgcn_sched_barrier(0)
    Unit cur, nxt; int ui = 0;
    if (!S.next(0, cur)) return;
    f32x4 acc[2][2][4][2];
#pragma unroll
    for (int a = 0; a < 2; ++a)
#pragma unroll
        for (int b = 0; b < 2; ++b)
#pragma unroll
            for (int m = 0; m < 4; ++m)
#pragma unroll
                for (int n = 0; n < 2; ++n) acc[a][b][m][n] = (f32x4){0.f, 0.f, 0.f, 0.f};
    bf16x8 At[4][2], B0[2][2], B1[2][2];
    const char* cA = PG8_UA(cur); const char* cB = PG8_UB(cur);
    S.a_ready(cur);
    if constexpr (SP2) {
        PG8_STAGE(PG8_SB(0, 0), cB, voffB); PG8_STAGE(PG8_SB(0, 1), cB + hstepB, voffB); PG8_STAGE(PG8_SA(0, 0), cA, voffA); PG8_STAGE(PG8_SA(0, 1), cA + hstepA, voffA);
        if (wr == 1) PG8_BAR;
        PG8_WAIT_V(2); PG8_BAR;
        PG8_STAGE(PG8_SB(1, 0), cB + kstep, voffB); PG8_STAGE(PG8_SA(1, 0), cA + kstep, voffA); PG8_STAGE(PG8_SB(1, 1), cB + hstepB + kstep, voffB);
        PG8_WAIT_V(6); PG8_BAR;
    } else {
        PG8_STAGE(PG8_SB(0, 0), cB, voffB); PG8_STAGE(PG8_SA(0, 0), cA, voffA); PG8_STAGE(PG8_SB(0, 1), cB + hstepB, voffB); PG8_STAGE(PG8_SA(0, 1), cA + hstepA, voffA);
        if (wr == 1) PG8_BAR;
        PG8_WAIT_V(4); PG8_BAR;
        PG8_STAGE(PG8_SB(1, 0), cB + kstep, voffB); PG8_STAGE(PG8_SA(1, 0), cA + kstep, voffA); PG8_STAGE(PG8_SB(1, 1), cB + hstepB + kstep, voffB);
        PG8_WAIT_V(6); PG8_BAR;
    }
    for (;;) {
        const bool has_next = S.next(ui + 1, nxt);
        const char* nA = has_next ? PG8_UA(nxt) : cA; const char* nB = has_next ? PG8_UB(nxt) : cB;
        for (int t = 0; t < nt; t += 2) {
            const bool last = (t == nt - 2);
            const char* a1 = cA + (size_t)(t + 1) * kstep;
            const char* a2 = last ? nA : cA + (size_t)(t + 2) * kstep; const char* b2 = last ? nB : cB + (size_t)(t + 2) * kstep;
            const char* a3 = a2 + kstep; const char* b3 = b2 + kstep;
            if (last && has_next) S.a_ready(nxt);
            if constexpr (SP2) {
            PG8_LDB(B0, 0, 0); PG8_LDB(B1, 0, 1); PG8_SCHED; PG8_LDA(At, 0, 0); PG8_STAGE(PG8_SA(1, 1), a1 + hstepA, voffA);
            PG8_WAIT_V(8); PG8_WAIT_L(0); PG8_BAR; PG8_MMA(0, 0, At, B0); PG8_MMA(0, 1, At, B1); PG8_BAR; PG8_SCHED;
            PG8_LDA(At, 0, 1); PG8_STAGE(PG8_SB(0, 0), b2, voffB); PG8_STAGE(PG8_SB(0, 1), b2 + hstepB, voffB); PG8_STAGE(PG8_SA(0, 0), a2, voffA);
            PG8_WAIT_V(8); PG8_WAIT_L(0); PG8_BAR; PG8_MMA(1, 0, At, B0); PG8_MMA(1, 1, At, B1); PG8_BAR; PG8_SCHED;
            PG8_LDB(B0, 1, 0); PG8_LDB(B1, 1, 1); PG8_SCHED; PG8_LDA(At, 1, 0); PG8_STAGE(PG8_SA(0, 1), a2 + hstepA, voffA);
            PG8_WAIT_V(8); PG8_WAIT_L(0); PG8_BAR; PG8_MMA(0, 0, At, B0); PG8_MMA(0, 1, At, B1); PG8_BAR; PG8_SCHED;
            PG8_LDA(At, 1, 1); PG8_STAGE(PG8_SB(1, 0), b3, voffB); PG8_STAGE(PG8_SB(1, 1), b3 + hstepB, voffB); PG8_STAGE(PG8_SA(1, 0), a3, voffA);
            PG8_WAIT_V(8); PG8_WAIT_L(0); PG8_BAR; PG8_MMA(1, 0, At, B0); PG8_MMA(1, 1, At, B1); PG8_BAR; PG8_SCHED;
            } else {
            PG8_LDB(B0, 0, 0); PG8_SCHED; PG8_LDA(At, 0, 0); PG8_STAGE(PG8_SA(1, 1), a1 + hstepA, voffA);
            PG8_WAIT_L(8); PG8_BAR; PG8_WAIT_L(0); PG8_MMA(0, 0, At, B0); PG8_BAR; PG8_SCHED;
            PG8_LDB(B1, 0, 1); PG8_STAGE(PG8_SB(0, 0), b2, voffB);
            PG8_BAR; PG8_WAIT_L(0); PG8_MMA(0, 1, At, B1); PG8_BAR;
            PG8_LDA(At, 0, 1); PG8_STAGE(PG8_SA(0, 0), a2, voffA);
            PG8_BAR; PG8_WAIT_L(0); PG8_MMA(1, 0, At, B0); PG8_BAR; PG8_SCHED;
            PG8_STAGE(PG8_SB(0, 1), b2 + hstepB, voffB);
            PG8_WAIT_V(6); PG8_BAR; PG8_MMA(1, 1, At, B1); PG8_BAR;
            PG8_LDB(B0, 1, 0); PG8_SCHED; PG8_LDA(At, 1, 0); PG8_STAGE(PG8_SA(0, 1), a2 + hstepA, voffA);
            PG8_WAIT_L(8); PG8_BAR; PG8_WAIT_L(0); PG8_MMA(0, 0, At, B0); PG8_BAR; PG8_SCHED;
            PG8_LDB(B1, 1, 1); PG8_STAGE(PG8_SB(1, 0), b3, voffB);
            PG8_BAR; PG8_WAIT_L(0); PG8_MMA(0, 1, At, B1); PG8_BAR;
            PG8_LDA(At, 1, 1); PG8_STAGE(PG8_SA(1, 0), a3, voffA);
            PG8_BAR; PG8_WAIT_L(0); PG8_MMA(1, 0, At, B0); PG8_BAR; PG8_SCHED;
            PG8_STAGE(PG8_SB(1, 1), b3 + hstepB, voffB);
            PG8_WAIT_V(6); PG8_BAR; PG8_MMA(1, 1, At, B1); PG8_BAR;
            }
        }
        if constexpr (ALIGN_EPI) { if (wr == 0) PG8_BAR; }
        if constexpr (!Epi::AFTER_DRAIN) { E(acc, cur, wr, wc, fr, fq); S.done(cur); }
        if (!has_next) break;
#pragma unroll
        for (int a = 0; a < 2; ++a)
#pragma unroll
            for (int b = 0; b < 2; ++b)
#pragma unroll
                for (int m = 0; m < 4; ++m)
#pragma unroll
                    for (int n = 0; n < 2; ++n) acc[a][b][m][n] = (f32x4){0.f, 0.f, 0.f, 0.f};
        cur = nxt; cA = nA; cB = nB; ++ui;
        if constexpr (ALIGN_EPI) { if (wr == 1) PG8_BAR; }
    }
    PG8_WAIT_V(0);
    if constexpr (!ALIGN_EPI) { if (wr == 0) PG8_BAR; }
    PG8_BAR;
    if constexpr (Epi::AFTER_DRAIN) { E.fused(acc, cur, wr, wc, fr, fq, lds, wid, lane); S.done(cur); }
#undef PG8_UA
#undef PG8_UB
#undef PG8_SA
#undef PG8_SB
#undef PG8_STAGE
#undef PG8_LDA
#undef PG8_LDB
#undef PG8_MMA
#undef PG8_WAIT_V
#undef PG8_WAIT_L
#undef PG8_BAR
#undef PG8_SCHED
}
}

#ifndef PG8_SP2
#define PG8_SP2 true
#endif
#ifndef PG8_ALIGN
#define PG8_ALIGN true
#endif

typedef unsigned short bf16;
typedef unsigned v4u __attribute__((ext_vector_type(4)));
typedef unsigned v2u __attribute__((ext_vector_type(2)));
typedef float f32x4 __attribute__((ext_vector_type(4)));
#define LAS __attribute__((address_space(3)))

constexpr int NWAVES = 8, NTHR = 512;
constexpr int D = 1024, MC = 8192, ML = 4096, M = 12288, NPH = 23;
constexpr int LDS_BYTES = 147456;
constexpr float EPS = 1e-6f;
constexpr size_t MiB = 1u << 20;
constexpr size_t WS_MOD = 64 * 1024;
constexpr size_t WS_SSQ = 320 * 1024;
constexpr size_t WS_DT = 384 * 1024;
constexpr size_t WS_W = 2 * MiB;
constexpr size_t W_IN = WS_W, W_G = W_IN + 8 * MiB, W_GLU = W_G + 8 * MiB, W_BR = W_GLU + 1 * MiB, W_OUT = W_BR + 4 * MiB, W_1 = W_OUT + 2 * MiB, W_2 = W_1 + 8 * MiB;
constexpr size_t WS_H = 41 * MiB;
constexpr size_t WS_R1 = 65 * MiB;
constexpr size_t WS_Y = 161 * MiB;
constexpr size_t WS_Y5 = 209 * MiB;
constexpr size_t WS_XC = 221 * MiB;
constexpr size_t WS_YF = 239 * MiB;
constexpr size_t WS_END = 251 * MiB;
constexpr size_t O_SSD = 12582912, O_S5 = 16777216, O_DK = 17301504, O_DV = 25690112, O_WK = 34078720, O_WV = 36175872;
constexpr int C_Z = 0, C_XBC = 512, C_U = 1280, C_DQ = 1792, C_DK = 2304, C_DV = 2816, C_WQ = 3328, C_WK = 3840, C_WV = 3968;

struct Args { const float* in[44]; float* out; unsigned char* ws; int ph_lo, ph_hi; };

typedef const Args __attribute__((address_space(4)))* CArgs;
struct Ctx {
    CArgs ap; int tid, lane, wave;
    __device__ __forceinline__ const float* x_prompt() const { return ap->in[0]; }
    __device__ __forceinline__ const float* x_sample() const { return ap->in[1]; }
    __device__ __forceinline__ const float* state_ssd() const { return ap->in[2]; }
    __device__ __forceinline__ const float* state_s5() const { return ap->in[3]; }
    __device__ __forceinline__ const float* cache_dk() const { return ap->in[4]; }
    __device__ __forceinline__ const float* cache_dv() const { return ap->in[5]; }
    __device__ __forceinline__ const float* cache_wk() const { return ap->in[6]; }
    __device__ __forceinline__ const float* cache_wv() const { return ap->in[7]; }
    __device__ __forceinline__ const float* cvec() const { return ap->in[8]; }
    __device__ __forceinline__ const float* c_ctx() const { return ap->in[9]; }
    __device__ __forceinline__ const float* w_mod() const { return ap->in[10]; }
    __device__ __forceinline__ const float* b_mod() const { return ap->in[11]; }
    __device__ __forceinline__ const float* g_norm1() const { return ap->in[12]; }
    __device__ __forceinline__ const float* g_norm2() const { return ap->in[13]; }
    __device__ __forceinline__ const float* w_in() const { return ap->in[14]; }
    __device__ __forceinline__ const float* conv_w() const { return ap->in[15]; }
    __device__ __forceinline__ const float* conv_b() const { return ap->in[16]; }
    __device__ __forceinline__ const float* dt_bias() const { return ap->in[17]; }
    __device__ __forceinline__ const float* a_log() const { return ap->in[18]; }
    __device__ __forceinline__ const float* ssd_d() const { return ap->in[19]; }
    __device__ __forceinline__ const float* ssd_norm_g() const { return ap->in[20]; }
    __device__ __forceinline__ const float* lam_re() const { return ap->in[21]; }
    __device__ __forceinline__ const float* lam_im() const { return ap->in[22]; }
    __device__ __forceinline__ const float* log_step() const { return ap->in[23]; }
    __device__ __forceinline__ const float* b_re() const { return ap->in[24]; }
    __device__ __forceinline__ const float* b_im() const { return ap->in[25]; }
    __device__ __forceinline__ const float* c_re() const { return ap->in[26]; }
    __device__ __forceinline__ const float* c_im() const { return ap->in[27]; }
    __device__ __forceinline__ const float* s5_d() const { return ap->in[28]; }
    __device__ __forceinline__ const float* w_glu() const { return ap->in[29]; }
    __device__ __forceinline__ const float* b_glu() const { return ap->in[30]; }
    __device__ __forceinline__ const float* qn_g() const { return ap->in[31]; }
    __device__ __forceinline__ const float* kn_g() const { return ap->in[32]; }
    __device__ __forceinline__ const float* dlam() const { return ap->in[33]; }
    __device__ __forceinline__ const float* subln_g() const { return ap->in[34]; }
    __device__ __forceinline__ const float* wqn_g() const { return ap->in[35]; }
    __device__ __forceinline__ const float* wkn_g() const { return ap->in[36]; }
    __device__ __forceinline__ const float* sink() const { return ap->in[37]; }
    __device__ __forceinline__ const float* w_branch() const { return ap->in[38]; }
    __device__ __forceinline__ const float* w_gate() const { return ap->in[39]; }
    __device__ __forceinline__ const float* b_gate() const { return ap->in[40]; }
    __device__ __forceinline__ const float* w_out() const { return ap->in[41]; }
    __device__ __forceinline__ const float* w_fc1() const { return ap->in[42]; }
    __device__ __forceinline__ const float* w_fc2() const { return ap->in[43]; }
    __device__ __forceinline__ float* out() const { return ap->out; }
    __device__ __forceinline__ unsigned char* ws() const { return ap->ws; }
    __device__ __forceinline__ float* MOD() const { return (float*)(ap->ws + WS_MOD); }
    __device__ __forceinline__ float* SSQ() const { return (float*)(ap->ws + WS_SSQ); }
    __device__ __forceinline__ float* DT() const { return (float*)(ap->ws + WS_DT); }
    __device__ __forceinline__ bf16* H() const { return (bf16*)(ap->ws + WS_H); }
    __device__ __forceinline__ bf16* R1() const { return (bf16*)(ap->ws + WS_R1); }
    __device__ __forceinline__ bf16* Y() const { return (bf16*)(ap->ws + WS_Y); }
    __device__ __forceinline__ bf16* Y5() const { return (bf16*)(ap->ws + WS_Y5); }
    __device__ __forceinline__ bf16* XC() const { return (bf16*)(ap->ws + WS_XC); }
    __device__ __forceinline__ bf16* YF() const { return (bf16*)(ap->ws + WS_YF); }
};

__device__ __forceinline__ float wave_sum(float v) {
#pragma unroll
    for (int o = 1; o < 64; o <<= 1) v += __shfl_xor(v, o);
    return v;
}
__device__ __forceinline__ float wave_max(float v) {
#pragma unroll
    for (int o = 1; o < 64; o <<= 1) v = fmaxf(v, __shfl_xor(v, o));
    return v;
}
__device__ __forceinline__ float bf2f(bf16 h) { return __builtin_bit_cast(float, (unsigned)h << 16); }
__device__ __forceinline__ float bflo(unsigned w) { return __builtin_bit_cast(float, w << 16); }
__device__ __forceinline__ float bfhi(unsigned w) { return __builtin_bit_cast(float, w & 0xffff0000u); }
__device__ __forceinline__ unsigned f2bf(float f) { unsigned u = __builtin_bit_cast(unsigned, f); return (u + 0x7fffu + ((u >> 16) & 1u)) >> 16; }
__device__ __forceinline__ unsigned pk2(float lo, float hi) { return f2bf(lo) | (f2bf(hi) << 16); }
__device__ __forceinline__ float siluf(float x) { return x / (1.0f + __expf(-x)); }
__device__ __forceinline__ void unpack8(const v4u q, float (&f)[8]) { f[0] = bflo(q.x); f[1] = bfhi(q.x); f[2] = bflo(q.y); f[3] = bfhi(q.y); f[4] = bflo(q.z); f[5] = bfhi(q.z); f[6] = bflo(q.w); f[7] = bfhi(q.w); }

__device__ __forceinline__ void phase_mods(const Ctx& c, float* lf) {
    for (int i = c.tid; i < 5 * 1024; i += NTHR) { const int v = i >> 10, k = i & 1023; const float x = (v == 0) ? c.c_ctx()[k] : c.cvec()[(v - 1) * 1024 + k]; lf[i] = siluf(x); }
    __syncthreads();
    float* red = lf + 5 * 1024;
    for (int u = blockIdx.x; u < 192; u += gridDim.x) {
        const int l = u / 96, col0 = (u % 96) * 64;
        const float* W = c.w_mod() + (size_t)l * 1024 * 6144 + col0 + c.lane;
        float acc[5] = {0.f, 0.f, 0.f, 0.f, 0.f};
#pragma unroll 8
        for (int k = c.wave * 128; k < c.wave * 128 + 128; ++k) { const float wv = W[(size_t)k * 6144];
#pragma unroll
            for (int i = 0; i < 5; ++i) acc[i] += lf[i * 1024 + k] * wv; }
#pragma unroll
        for (int i = 0; i < 5; ++i) red[(c.wave * 5 + i) * 64 + c.lane] = acc[i];
        __syncthreads();
        if (c.tid < 320) { const int i = c.tid >> 6, ln = c.tid & 63; float s = c.b_mod()[l * 6144 + col0 + ln];
#pragma unroll
            for (int w = 0; w < 8; ++w) s += red[(w * 5 + i) * 64 + ln];
            c.MOD()[(size_t)(l * 5 + i) * 6144 + col0 + ln] = s; }
        __syncthreads();
    }
}

__device__ __forceinline__ int cmap(int mode, int n) { return mode == 0 ? n : (mode == 1 ? (n < 1280 ? n : n + 16) : ((n & 255) < 128 ? 128 * (n >> 8) + (n & 127) : 512 + 128 * (n >> 8) + (n & 127))); }
__device__ __forceinline__ void transpose_item(const float* W, int ld, int K, int N, int mode, const float* rowscale, bf16* WT, float* scr, int item, int lane) {
    const int nblk = N / 32, kb = item / nblk, nb = item % nblk, k0 = 64 * kb, n0 = 32 * nb, sc0 = cmap(mode, n0);
#pragma unroll 8
    for (int i = 0; i < 32; ++i) { const int kk = 2 * i + (lane >> 5); float v = W[(size_t)(k0 + kk) * ld + sc0 + (lane & 31)]; if (rowscale) v *= rowscale[k0 + kk]; scr[kk * 33 + (lane & 31)] = v; }
    __builtin_amdgcn_fence(__ATOMIC_RELEASE, "wavefront"); __builtin_amdgcn_wave_barrier();
    const int ch = lane & 7;
#pragma unroll
    for (int j = 0; j < 4; ++j) { const int n = (lane >> 3) + 8 * j; const float* s = scr + (8 * ch) * 33 + n;
        v4u o; o.x = pk2(s[0 * 33], s[1 * 33]); o.y = pk2(s[2 * 33], s[3 * 33]); o.z = pk2(s[4 * 33], s[5 * 33]); o.w = pk2(s[6 * 33], s[7 * 33]);
        *(v4u*)(WT + (size_t)(n0 + n) * K + k0 + 8 * ch) = o; }
    __builtin_amdgcn_fence(__ATOMIC_RELEASE, "wavefront"); __builtin_amdgcn_wave_barrier();
}
__device__ __forceinline__ void phase_convert(const Ctx& c, int l, float* lf) {
    float* scr = lf + c.wave * 2176;
    const int gw = blockIdx.x * NWAVES + c.wave, NGW = gridDim.x * NWAVES;
    unsigned char* ws = c.ws();
    for (int it = gw; it < 9984; it += NGW) {
        int r = it;
        if (r < 2048) { transpose_item(c.w_in() + (size_t)l * 1024 * 4112, 4112, 1024, 4096, 1, nullptr, (bf16*)(ws + W_IN), scr, r, c.lane); continue; } r -= 2048;
        if (r < 2048) { transpose_item(c.w_gate() + (size_t)l * 1024 * 4096, 4096, 1024, 4096, 0, nullptr, (bf16*)(ws + W_G), scr, r, c.lane); continue; } r -= 2048;
        if (r < 256) { transpose_item(c.w_glu() + (size_t)l * 512 * 1024, 1024, 512, 1024, 2, nullptr, (bf16*)(ws + W_GLU), scr, r, c.lane); continue; } r -= 256;
        if (r < 1024) { const int i = r >> 8; transpose_item(c.w_branch() + (size_t)(l * 4 + i) * 512 * 1024, 1024, 512, 1024, 0, i == 0 ? c.ssd_norm_g() + l * 512 : nullptr, (bf16*)(ws + W_BR) + (size_t)i * 1024 * 512, scr, r & 255, c.lane); continue; } r -= 1024;
        if (r < 512) { transpose_item(c.w_out() + (size_t)l * 1024 * 1024, 1024, 1024, 1024, 0, nullptr, (bf16*)(ws + W_OUT), scr, r, c.lane); continue; } r -= 512;
        if (r < 2048) { transpose_item(c.w_fc1() + (size_t)l * 1024 * 4096, 4096, 1024, 4096, 0, nullptr, (bf16*)(ws + W_1), scr, r, c.lane); continue; } r -= 2048;
        transpose_item(c.w_fc2() + (size_t)l * 4096 * 1024, 1024, 4096, 1024, 0, nullptr, (bf16*)(ws + W_2), scr, r, c.lane);
    }
}

__device__ __forceinline__ void phase_norm(const Ctx& c, int l, int which, float* lf) {
    if (which == 0) {
        for (int i = c.tid; i < 16384; i += NTHR) { const int k = i >> 4, j = i & 15; lf[j * 1024 + k] = c.w_in()[(size_t)l * 1024 * 4112 + (size_t)k * 4112 + 1280 + j]; }
        __syncthreads();
    }
    const int gw = blockIdx.x * NWAVES + c.wave, NGW = gridDim.x * NWAVES;
    const float* gn = (which == 0 ? c.g_norm1() : c.g_norm2()) + l * 1024;
    for (int m = gw; m < M; m += NGW) {
        const float* xr = (l == 0 && which == 0) ? (m < MC ? c.x_prompt() + (size_t)m * D : c.x_sample() + (size_t)(m - MC) * D) : c.out() + (size_t)m * D;
        const int mi = (m < MC) ? 0 : 1 + ((m - MC) >> 10);
        const float* mod = c.MOD() + (size_t)(l * 5 + mi) * 6144 + which * 3072;
        f32x4 v[4]; float s = 0.f;
#pragma unroll
        for (int j = 0; j < 4; ++j) { v[j] = *(const f32x4*)(xr + 4 * c.lane + 256 * j); s += (v[j].x * v[j].x + v[j].y * v[j].y) + (v[j].z * v[j].z + v[j].w * v[j].w); }
        const float rstd = rsqrtf(wave_sum(s) * (1.0f / D) + EPS);
#pragma unroll
        for (int j = 0; j < 4; ++j) { const int k = 4 * c.lane + 256 * j; const f32x4 g = *(const f32x4*)(gn + k), sh = *(const f32x4*)(mod + k), sc = *(const f32x4*)(mod + 1024 + k);
            v[j] = v[j] * rstd * g * (sc + 1.0f) + sh;
            v2u o; o.x = pk2(v[j].x, v[j].y); o.y = pk2(v[j].z, v[j].w); *(v2u*)(c.H() + (size_t)m * D + k) = o; }
        if (which == 0) {
            float mine = 0.f;
#pragma unroll 1
            for (int jj = 0; jj < 16; ++jj) { float a = 0.f;
#pragma unroll
                for (int j = 0; j < 4; ++j) { const f32x4 w = *(const f32x4*)(lf + jj * 1024 + 4 * c.lane + 256 * j); a += (v[j].x * w.x + v[j].y * w.y) + (v[j].z * w.z + v[j].w * w.w); }
                a = wave_sum(a); if (c.lane == jj) mine = a; }
            if (c.lane < 16) { const float x = mine + c.dt_bias()[l * 16 + c.lane]; c.DT()[(size_t)m * 16 + c.lane] = x > 20.f ? x : log1pf(__expf(x)); }
            if (c.lane == 0) c.SSQ()[m] = 0.f;
        }
    }
}

__device__ __forceinline__ void phase_qk(const Ctx& c, int l) {
    const int gw = blockIdx.x * NWAVES + c.wave, NGW = gridDim.x * NWAVES, lane = c.lane;
    const float gq = c.qn_g()[l * 64 + lane], gk = c.kn_g()[l * 64 + lane], gwq = c.wqn_g()[l * 64 + lane], gwk = c.wkn_g()[l * 64 + lane];
    for (int m = gw; m < M; m += NGW) {
        bf16* pr = c.R1() + (size_t)m * 4096;
        const bool lat = m >= MC;
        const int b = lat ? (m - MC) >> 10 : m >> 8, t = lat ? (m - MC) & 1023 : m & 255, L = lat ? 1024 : 256;
        float cs = 1.f, sn = 0.f;
        if (lat) { const int f = lane & 15; const float inv = exp2f(-(float)f * 0.8304820237218406f); const float ang = (float)((lane >> 5) ? (t & 63) : (t >> 6)) * inv; sincosf(ang, &sn, &cs); if (!((lane >> 4) & 1)) sn = -sn; }
        const size_t ob = (size_t)(b * 2 + l) * 256 + t;
#pragma unroll 1
        for (int gi = 0; gi < 26; ++gi) {
            const int col = gi < 8 ? C_DQ + gi * 64 : gi < 16 ? C_DK + (gi - 8) * 64 : gi < 24 ? C_WQ + (gi - 16) * 64 : C_WK + (gi - 24) * 64;
            const float gain = gi < 8 ? gq : gi < 16 ? gk : gi < 24 ? gwq : gwk;
            float v = bf2f(pr[col + lane]);
            const float ss = wave_sum(v * v);
            v = v * rsqrtf(ss * (1.0f / 64.0f) + EPS) * gain;
            if (lat) { const float p = __shfl_xor(v, 16); v = v * cs + p * sn; }
            pr[col + lane] = (bf16)f2bf(v);
            if (!lat) {
                if (gi >= 8 && gi < 16) c.out()[O_DK + ob * 512 + (gi - 8) * 64 + lane] = v;
                if (gi >= 24) c.out()[O_WK + ob * 128 + (gi - 24) * 64 + lane] = v;
            }
        }
        if (!lat) {
#pragma unroll
            for (int i = 0; i < 8; ++i) c.out()[O_DV + ob * 512 + i * 64 + lane] = bf2f(pr[C_DV + i * 64 + lane]);
#pragma unroll
            for (int i = 0; i < 2; ++i) c.out()[O_WV + ob * 128 + i * 64 + lane] = bf2f(pr[C_WV + i * 64 + lane]);
        }
#pragma unroll 1
        for (int i = 0; i < 12; ++i) { const int ch = lane + 64 * i; float a = c.conv_b()[l * 768 + ch];
#pragma unroll
            for (int j = 0; j < 7; ++j) { const int tt = t + j - 3; if (tt >= 0 && tt < L) a += c.conv_w()[(size_t)(l * 7 + j) * 768 + ch] * bf2f(c.R1()[(size_t)(m + j - 3) * 4096 + C_XBC + ch]); }
            c.XC()[(size_t)m * 768 + ch] = (bf16)f2bf(siluf(a)); }
    }
}

__device__ __forceinline__ void ssd_unit(const Ctx& c, int l, int pass, int b, int h) {
    const int L = pass ? 1024 : 256, tok0 = pass ? MC + b * 1024 : b * 256;
    const int p = c.tid >> 3, nq = c.tid & 7, grp = h >> 2;
    const float dsk = c.ssd_d()[l * 8 + h];
    for (int dir = 0; dir < 2; ++dir) {
        const float A = -__expf(c.a_log()[(l * 2 + dir) * 8 + h]);
        float S[8];
        if (pass) { const float* s0 = c.state_ssd() + (((((size_t)(b * 2 + l) * 2 + dir) * 8 + h) * 64 + p) * 64) + nq * 8;
#pragma unroll
            for (int j = 0; j < 8; ++j) S[j] = s0[j]; }
        else {
#pragma unroll
            for (int j = 0; j < 8; ++j) S[j] = 0.f; }
        size_t m = (size_t)tok0 + (dir ? L - 1 : 0);
        float dtv = c.DT()[m * 16 + dir * 8 + h]; float xv = bf2f(c.XC()[m * 768 + h * 64 + p]);
        v4u Bq = *(const v4u*)(c.XC() + m * 768 + 512 + grp * 64 + nq * 8), Cq = *(const v4u*)(c.XC() + m * 768 + 640 + grp * 64 + nq * 8);
        for (int s = 0; s < L; ++s) {
            const size_t mc = m; const float dtc = dtv, xc = xv; const v4u Bc = Bq, Cc = Cq;
            if (s + 1 < L) { m = (size_t)tok0 + (dir ? L - 2 - s : s + 1); dtv = c.DT()[m * 16 + dir * 8 + h]; xv = bf2f(c.XC()[m * 768 + h * 64 + p]);
                Bq = *(const v4u*)(c.XC() + m * 768 + 512 + grp * 64 + nq * 8); Cq = *(const v4u*)(c.XC() + m * 768 + 640 + grp * 64 + nq * 8); }
            float Bv[8], Cv[8]; unpack8(Bc, Bv); unpack8(Cc, Cv);
            const float da = __expf(dtc * A), xdt = xc * dtc; float yp = 0.f;
#pragma unroll
            for (int j = 0; j < 8; ++j) { S[j] = da * S[j] + xdt * Bv[j]; yp += Cv[j] * S[j]; }
            yp += __shfl_xor(yp, 1); yp += __shfl_xor(yp, 2); yp += __shfl_xor(yp, 4);
            if (dir == 0) { if (nq == 0) c.YF()[mc * 512 + h * 64 + p] = (bf16)f2bf(yp); }
            else {
                float g2 = 0.f;
                if (nq == 0) { const float ytot = bf2f(c.YF()[mc * 512 + h * 64 + p]) + yp + dsk * xc; const float z = bf2f(c.R1()[mc * 4096 + C_Z + h * 64 + p]); const float gt = ytot * siluf(z);
                    c.Y()[mc * 2048 + h * 64 + p] = (bf16)f2bf(gt); g2 = gt * gt; }
                g2 += __shfl_xor(g2, 8); g2 += __shfl_xor(g2, 16); g2 += __shfl_xor(g2, 32);
                if (c.lane == 0) atomicAdd(c.SSQ() + mc, g2);
            }
        }
        if (!pass) { float* so = c.out() + O_SSD + (((((size_t)(b * 2 + l) * 2 + dir) * 8 + h) * 64 + p) * 64) + nq * 8;
#pragma unroll
            for (int j = 0; j < 8; ++j) so[j] = S[j]; }
    }
}

__device__ __forceinline__ void s5_unit(const Ctx& c, int l, int pass, int b, int g, float* lf) {
    const int L = pass ? 1024 : 256, tok0 = pass ? MC + b * 1024 : b * 256, tid = c.tid;
    float* ybuf = lf;
    float* sbuf = lf + 16384;
    float* cmat = lf + 24576;
    for (int i = tid; i < L * 16; i += NTHR) ybuf[i] = 0.f;
    for (int i = tid; i < 4096; i += NTHR) { const int dir = i >> 11, ri = (i >> 10) & 1, mm = (i >> 6) & 15, n = i & 63;
        cmat[((dir * 2 + ri) * 16 + mm) * 129 + n] = (ri ? c.c_im() : c.c_re())[((size_t)((l * 2 + dir) * 32 + g) * 16 + mm) * 64 + n]; }
    const int dir = (tid >> 6) & 1, n = tid & 63;
    float are = 0.f, aim = 0.f, sre = 0.f, sim = 0.f, Bcr[16], Bci[16];
    if (tid < 128) {
        const int idx = ((l * 2 + dir) * 32 + g) * 64 + n;
        const float lre = c.lam_re()[idx], lim = c.lam_im()[idx], step = expf(c.log_step()[(l * 2 + dir) * 32 + g]);
        const float mag = expf(lre * step); float sn, cs; sincosf(lim * step, &sn, &cs); are = mag * cs; aim = mag * sn;
        const float den = lre * lre + lim * lim, cre = ((are - 1.0f) * lre + aim * lim) / den, cim = (aim * lre - (are - 1.0f) * lim) / den;
#pragma unroll
        for (int mm = 0; mm < 16; ++mm) { const float br = c.b_re()[(size_t)idx * 16 + mm], bi = c.b_im()[(size_t)idx * 16 + mm]; Bcr[mm] = cre * br - cim * bi; Bci[mm] = cre * bi + cim * br; }
        if (pass) { sre = c.state_s5()[((((size_t)(b * 2 + l) * 2 + dir) * 2 + 0) * 32 + g) * 64 + n]; sim = c.state_s5()[((((size_t)(b * 2 + l) * 2 + dir) * 2 + 1) * 32 + g) * 64 + n]; }
    }
    __syncthreads();
    for (int c0 = 0; c0 < L / 32; ++c0) {
        if (tid < 128) {
            for (int st = 0; st < 32; ++st) {
                const int s = c0 * 32 + st, t = dir ? L - 1 - s : s; const bf16* up = c.R1() + (size_t)(tok0 + t) * 4096 + C_U + g * 16;
                float u[16]; { float a8[8]; unpack8(*(const v4u*)up, a8);
#pragma unroll
                    for (int j = 0; j < 8; ++j) u[j] = a8[j];
                    unpack8(*(const v4u*)(up + 8), a8);
#pragma unroll
                    for (int j = 0; j < 8; ++j) u[8 + j] = a8[j]; }
                float xr = 0.f, xi = 0.f;
#pragma unroll
                for (int mm = 0; mm < 16; ++mm) { xr += Bcr[mm] * u[mm]; xi += Bci[mm] * u[mm]; }
                const float nr = are * sre - aim * sim + xr, ni = are * sim + aim * sre + xi; sre = nr; sim = ni;
                sbuf[(dir * 32 + st) * 128 + n] = sre; sbuf[(dir * 32 + st) * 128 + 64 + n] = sim;
            }
        }
        __syncthreads();
        { const int st = tid >> 4, mm = tid & 15;
#pragma unroll
            for (int d2 = 0; d2 < 2; ++d2) { const int s = c0 * 32 + st, t = d2 ? L - 1 - s : s;
                const float* cr = cmat + ((d2 * 2 + 0) * 16 + mm) * 129; const float* ci = cmat + ((d2 * 2 + 1) * 16 + mm) * 129; const float* sb = sbuf + (d2 * 32 + st) * 128;
                float a = 0.f;
#pragma unroll 8
                for (int k = 0; k < 64; ++k) a += cr[k] * sb[k] - ci[k] * sb[64 + k];
                ybuf[t * 16 + mm] += a; } }
        __syncthreads();
    }
    for (int i = tid; i < L * 16; i += NTHR) { const int t = i >> 4, mm = i & 15; const size_t m = (size_t)tok0 + t;
        const float u = bf2f(c.R1()[m * 4096 + C_U + g * 16 + mm]); c.Y5()[m * 512 + g * 16 + mm] = (bf16)f2bf(ybuf[i] + c.s5_d()[l * 512 + g * 16 + mm] * u); }
    if (!pass && tid < 128) { c.out()[O_S5 + ((((size_t)(b * 2 + l) * 2 + dir) * 2 + 0) * 32 + g) * 64 + n] = sre; c.out()[O_S5 + ((((size_t)(b * 2 + l) * 2 + dir) * 2 + 1) * 32 + g) * 64 + n] = sim; }
    __syncthreads();
}

template <int PASS> __device__ __forceinline__ void diff_unit(const Ctx& c, int l, int tg, float* lf) {
    constexpr int NKK = PASS ? 20 : 4, NK = NKK * 64;
    const int lane = c.lane;
    float* qs = lf + c.wave * 128;
    float* as = lf + 1024 + c.wave * 1280;
    const float lam_init = 0.8f - 0.6f * expf(-0.3f * (float)l);
    const float* lv = c.dlam() + l * 256;
    const float lam = expf(wave_sum(lv[lane] * lv[64 + lane])) - expf(wave_sum(lv[128 + lane] * lv[192 + lane])) + lam_init;
    for (int i = 0; i < 8; ++i) {
        const int task = c.wave * 8 + i, tok = tg * 16 + (task >> 2), h = task & 3;
        const size_t m = (size_t)(PASS ? MC : 0) + tok;
        const int b = PASS ? tok >> 10 : tok >> 8, tok0 = PASS ? MC + b * 1024 : b * 256;
        __builtin_amdgcn_wave_barrier();
        qs[lane] = bf2f(c.R1()[m * 4096 + C_DQ + h * 128 + lane]) * 0.125f; qs[64 + lane] = bf2f(c.R1()[m * 4096 + C_DQ + h * 128 + 64 + lane]) * 0.125f;
        __builtin_amdgcn_fence(__ATOMIC_RELEASE, "wavefront"); __builtin_amdgcn_wave_barrier();
        float sc0[NKK], sc1[NKK];
#pragma unroll
        for (int kk = 0; kk < NKK; ++kk) {
            const int s = kk * 64 + lane; float d0 = 0.f, d1 = 0.f;
            if (PASS && kk < 4) { const float* kp = c.cache_dk() + ((((size_t)(b * 2 + l) * 256 + s) * 4 + h) * 128);
#pragma unroll 4
                for (int d = 0; d < 64; d += 4) { const f32x4 k0 = *(const f32x4*)(kp + d), k1 = *(const f32x4*)(kp + 64 + d), q0 = *(const f32x4*)(qs + d), q1 = *(const f32x4*)(qs + 64 + d);
                    d0 += (k0.x * q0.x + k0.y * q0.y) + (k0.z * q0.z + k0.w * q0.w); d1 += (k1.x * q1.x + k1.y * q1.y) + (k1.z * q1.z + k1.w * q1.w); } }
            else { const bf16* kp = c.R1() + (size_t)(tok0 + (PASS ? s - 256 : s)) * 4096 + C_DK + h * 128;
#pragma unroll 2
                for (int d = 0; d < 64; d += 8) { float k0[8], k1[8]; unpack8(*(const v4u*)(kp + d), k0); unpack8(*(const v4u*)(kp + 64 + d), k1);
#pragma unroll
                    for (int j = 0; j < 8; ++j) { d0 += k0[j] * qs[d + j]; d1 += k1[j] * qs[64 + d + j]; } } }
            sc0[kk] = d0; sc1[kk] = d1;
        }
        float m0 = sc0[0], m1 = sc1[0];
#pragma unroll
        for (int kk = 1; kk < NKK; ++kk) { m0 = fmaxf(m0, sc0[kk]); m1 = fmaxf(m1, sc1[kk]); }
        m0 = wave_max(m0); m1 = wave_max(m1);
        float s0 = 0.f, s1 = 0.f;
#pragma unroll
        for (int kk = 0; kk < NKK; ++kk) { sc0[kk] = __expf(sc0[kk] - m0); sc1[kk] = __expf(sc1[kk] - m1); s0 += sc0[kk]; s1 += sc1[kk]; }
        s0 = 1.0f / wave_sum(s0); s1 = lam / wave_sum(s1);
#pragma unroll
        for (int kk = 0; kk < NKK; ++kk) as[kk * 64 + lane] = sc0[kk] * s0 - sc1[kk] * s1;
        __builtin_amdgcn_fence(__ATOMIC_RELEASE, "wavefront"); __builtin_amdgcn_wave_barrier();
        float o0 = 0.f, o1 = 0.f;
        if (PASS) { const float* vp = c.cache_dv() + ((((size_t)(b * 2 + l) * 256) * 4 + h) * 128);
#pragma unroll 4
            for (int s = 0; s < 256; ++s) { const float a = as[s]; o0 += a * vp[(size_t)s * 512 + lane]; o1 += a * vp[(size_t)s * 512 + 64 + lane]; } }
        { const bf16* vp = c.R1() + (size_t)tok0 * 4096 + C_DV + h * 128; const float* ap = as + (PASS ? 256 : 0); const int ns = PASS ? 1024 : 256;
#pragma unroll 4
            for (int s = 0; s < ns; ++s) { const float a = ap[s]; o0 += a * bf2f(vp[(size_t)s * 4096 + lane]); o1 += a * bf2f(vp[(size_t)s * 4096 + 64 + lane]); } }
        const float r = rsqrtf(wave_sum(o0 * o0 + o1 * o1) * (1.0f / 128.0f) + EPS) * (1.0f - lam_init);
        c.Y()[m * 2048 + 1024 + h * 128 + lane] = (bf16)f2bf(o0 * r * c.subln_g()[l * 128 + lane]);
        c.Y()[m * 2048 + 1024 + h * 128 + 64 + lane] = (bf16)f2bf(o1 * r * c.subln_g()[l * 128 + 64 + lane]);
    }
    (void)NK;
}

template <int PASS> __device__ __forceinline__ void win_unit(const Ctx& c, int l, int tg, float* lf) {
    constexpr int NKK = PASS ? 9 : 4;
    const int lane = c.lane;
    float* qs = lf + c.wave * 64;
    float* as = lf + 512 + c.wave * 576;
    for (int i = 0; i < 8; ++i) {
        const int task = c.wave * 8 + i, tok = tg * 8 + (task >> 3), hh = task & 7, nkv = hh >> 2;
        const size_t m = (size_t)(PASS ? MC : 0) + tok;
        const int b = PASS ? tok >> 10 : tok >> 8, tok0 = PASS ? MC + b * 1024 : b * 256, qp = PASS ? tok & 1023 : tok & 255;
        const int lo = PASS ? (qp - 128 < 0 ? 0 : qp - 128) : 0, hi = PASS ? (qp + 128 > 1023 ? 1023 : qp + 128) : 255;
        const int nk = PASS ? 256 + (hi - lo + 1) : 256;
        __builtin_amdgcn_wave_barrier();
        qs[lane] = bf2f(c.R1()[m * 4096 + C_WQ + hh * 64 + lane]) * 0.125f;
        __builtin_amdgcn_fence(__ATOMIC_RELEASE, "wavefront"); __builtin_amdgcn_wave_barrier();
        float sc[NKK];
#pragma unroll
        for (int kk = 0; kk < NKK; ++kk) {
            const int s = kk * 64 + lane; float d0 = 0.f;
            if (PASS && kk < 4) { const float* kp = c.cache_wk() + (((size_t)(b * 2 + l) * 256 + s) * 2 + nkv) * 64;
#pragma unroll 4
                for (int d = 0; d < 64; d += 4) { const f32x4 k0 = *(const f32x4*)(kp + d), q0 = *(const f32x4*)(qs + d); d0 += (k0.x * q0.x + k0.y * q0.y) + (k0.z * q0.z + k0.w * q0.w); } }
            else if (s < nk) { const bf16* kp = c.R1() + (size_t)(tok0 + (PASS ? lo + s - 256 : s)) * 4096 + C_WK + nkv * 64;
#pragma unroll 2
                for (int d = 0; d < 64; d += 8) { float k0[8]; unpack8(*(const v4u*)(kp + d), k0);
#pragma unroll
                    for (int j = 0; j < 8; ++j) d0 += k0[j] * qs[d + j]; } }
            else d0 = -1e30f;
            sc[kk] = d0;
        }
        const float sk = c.sink()[l * 8 + hh];
        float mx = sk;
#pragma unroll
        for (int kk = 0; kk < NKK; ++kk) mx = fmaxf(mx, sc[kk]);
        mx = wave_max(mx);
        float sm = 0.f;
#pragma unroll
        for (int kk = 0; kk < NKK; ++kk) { sc[kk] = __expf(sc[kk] - mx); sm += sc[kk]; }
        const float inv = 1.0f / (wave_sum(sm) + __expf(sk - mx));
#pragma unroll
        for (int kk = 0; kk < NKK; ++kk) as[kk * 64 + lane] = sc[kk] * inv;
        __builtin_amdgcn_fence(__ATOMIC_RELEASE, "wavefront"); __builtin_amdgcn_wave_barrier();
        float o = 0.f;
        if (PASS) { const float* vp = c.cache_wv() + (((size_t)(b * 2 + l) * 256) * 2 + nkv) * 64;
#pragma unroll 4
            for (int s = 0; s < 256; ++s) o += as[s] * vp[(size_t)s * 128 + lane]; }
        { const bf16* vp = c.R1() + (size_t)(tok0 + lo) * 4096 + C_WV + nkv * 64; const float* ap = as + (PASS ? 256 : 0); const int ns = PASS ? hi - lo + 1 : 256;
#pragma unroll 4
            for (int s = 0; s < ns; ++s) o += ap[s] * bf2f(vp[(size_t)s * 4096 + lane]); }
        c.Y()[m * 2048 + 1536 + hh * 64 + lane] = (bf16)f2bf(o);
    }
}

__device__ __forceinline__ void phase_mixers(const Ctx& c, int l, float* lf) {
    for (int u = blockIdx.x; u < 3744; u += gridDim.x) {
        if (u < 32) ssd_unit(c, l, 1, u >> 3, u & 7);
        else if (u < 160) s5_unit(c, l, 1, (u - 32) >> 5, (u - 32) & 31, lf);
        else if (u < 416) diff_unit<1>(c, l, u - 160, lf);
        else if (u < 928) win_unit<1>(c, l, u - 416, lf);
        else if (u < 1184) ssd_unit(c, l, 0, (u - 928) >> 3, (u - 928) & 7);
        else if (u < 2208) s5_unit(c, l, 0, (u - 1184) >> 5, (u - 1184) & 31, lf);
        else if (u < 2720) diff_unit<0>(c, l, u - 2208, lf);
        else win_unit<0>(c, l, u - 2720, lf);
        __syncthreads();
    }
}

__device__ __forceinline__ void phase_sum4(const Ctx& c) {
    const int gt = blockIdx.x * NTHR + c.tid, NT = gridDim.x * NTHR;
    for (int i = gt; i < M * 128; i += NT) { const size_t m = (size_t)(i >> 7); const int c8 = (i & 127) * 8;
        float a[8] = {0.f, 0.f, 0.f, 0.f, 0.f, 0.f, 0.f, 0.f};
#pragma unroll
        for (int j = 0; j < 4; ++j) { float f[8]; unpack8(*(const v4u*)(c.R1() + m * 4096 + j * 1024 + c8), f);
#pragma unroll
            for (int k = 0; k < 8; ++k) a[k] += f[k]; }
        v4u o; o.x = pk2(a[0], a[1]); o.y = pk2(a[2], a[3]); o.z = pk2(a[4], a[5]); o.w = pk2(a[6], a[7]);
        *(v4u*)(c.H() + m * 1024 + c8) = o; }
}

__global__ void __launch_bounds__(NTHR, 2) fwd_kernel(Args args) {
    extern __shared__ __attribute__((aligned(16))) unsigned char lds[];
    float* lf = (float*)lds;
    PG8_LAS unsigned char* ring = (PG8_LAS unsigned char*)lds;
    const int ph_lo = args.ph_lo, ph_hi = args.ph_hi;

    for (int ph = ph_lo; ph < ph_hi; ++ph) {
        Ctx c; c.ap = (CArgs)__builtin_amdgcn_kernarg_segment_ptr(); asm volatile("" : "+s"(c.ap));
        int tid_o = threadIdx.x; asm volatile("" : "+v"(tid_o));
        c.tid = tid_o; c.lane = tid_o & 63; c.wave = __builtin_amdgcn_readfirstlane(tid_o >> 6);
        const int G = gridDim.x, bid = blockIdx.x;
        unsigned char* ws = c.ws();
        if (ph == 0) { phase_mods(c, lf); __syncthreads(); phase_convert(c, 0, lf); }
        else {
            const int l = (ph - 1) / 11, q = (ph - 1) % 11;
            if (q == 0) { if (l == 1) { phase_convert(c, 1, lf); __syncthreads(); } phase_norm(c, l, 0, lf); }
            else if (q == 1) {
                pg8::Gemm g{c.H(), (const bf16*)(ws + W_IN), M, 4096, 1024, 1024, 1024, 0, 0}; pg8::StaticOrder S; S.init(M, 4096, G, bid);
                pg8::EpiB<0> E{c.R1(), 4096, nullptr, nullptr};
                pg8::gemm_phase<pg8::EpiB<0>, pg8::StaticOrder, true, true>(ring, g, S, E, tid_o);
            }
            else if (q == 2) phase_qk(c, l);
            else if (q == 3) phase_mixers(c, l, lf);
            else if (q == 4) {
                { pg8::Gemm g{c.Y5(), (const bf16*)(ws + W_GLU), M, 1024, 512, 512, 512, 0, 0}; pg8::StaticOrder S; S.init(M, 1024, G, bid);
                  pg8::EpiGlu E{c.Y(), 2048, 512, c.b_glu() + l * 1024};
                  pg8::gemm_phase<pg8::EpiGlu, pg8::StaticOrder, true, true>(ring, g, S, E, tid_o); }
                { pg8::Gemm g{c.H(), (const bf16*)(ws + W_G), M, 4096, 1024, 1024, 1024, 0, 0}; pg8::StaticOrder S; S.init(M, 4096, G, bid);
                  pg8::EpiB<1> E{c.R1(), 4096, c.b_gate() + l * 4096, nullptr};
                  pg8::gemm_phase<pg8::EpiB<1>, pg8::StaticOrder, true, true>(ring, g, S, E, tid_o); }
            }
            else if (q == 5) {
                pg8::Gemm g{c.Y(), (const bf16*)(ws + W_BR), M, 4096, 512, 2048, 512, 4, 1024}; pg8::StaticOrder S; S.init(M, 4096, G, bid);
                pg8::EpiB<3> E{c.R1(), 4096, nullptr, c.SSQ()};
                pg8::gemm_phase<pg8::EpiB<3>, pg8::StaticOrder, true, true>(ring, g, S, E, tid_o);
            }
            else if (q == 6) phase_sum4(c);
            else if (q == 7) {
                pg8::Gemm g{c.H(), (const bf16*)(ws + W_OUT), M, 1024, 1024, 1024, 1024, 0, 0}; pg8::StaticOrder S; S.init(M, 1024, G, bid);
                pg8::EpiRes E{l == 0 ? c.x_prompt() : c.out(), l == 0 ? c.x_sample() : c.out() + (size_t)MC * D, c.out(), c.MOD() + (size_t)l * 5 * 6144, 2048};
                pg8::gemm_phase<pg8::EpiRes, pg8::StaticOrder, true, true>(ring, g, S, E, tid_o);
            }
            else if (q == 8) phase_norm(c, l, 1, lf);
            else if (q == 9) {
                pg8::Gemm g{c.H(), (const bf16*)(ws + W_1), M, 4096, 1024, 1024, 1024, 0, 0}; pg8::StaticOrder S; S.init(M, 4096, G, bid);
                pg8::EpiB<2> E{c.R1(), 4096, nullptr, nullptr};
                pg8::gemm_phase<pg8::EpiB<2>, pg8::StaticOrder, true, true>(ring, g, S, E, tid_o);
            }
            else {
                pg8::Gemm g{c.R1(), (const bf16*)(ws + W_2), M, 1024, 4096, 4096, 4096, 0, 0}; pg8::StaticOrder S; S.init(M, 1024, G, bid);
                pg8::EpiRes E{c.out(), c.out() + (size_t)MC * D, c.out(), c.MOD() + (size_t)l * 5 * 6144, 5120};
                pg8::gemm_phase<pg8::EpiRes, pg8::StaticOrder, true, true>(ring, g, S, E, tid_o);
            }
        }
        if (ph + 1 < ph_hi) { __threadfence(); cg::this_grid().sync(); }
    }
}

extern "C" void kernel_launch(void* const* d_in, const int* in_sizes, int n_in, void* d_out, int out_size, void* d_ws, size_t ws_size, hipStream_t stream) {
    static int grid = 0;
    if (grid == 0) {
        if (n_in != 44 || ws_size < WS_END) { fprintf(stderr, "kernel_launch: expected 44 inputs and >= %zu bytes of workspace; got %d, %zu\n", (size_t)WS_END, n_in, ws_size); grid = -1; return; }
        int dev = 0, cus = 0, per_cu = 0;
        (void)hipGetDevice(&dev); (void)hipDeviceGetAttribute(&cus, hipDeviceAttributeMultiprocessorCount, dev);
        (void)hipFuncSetAttribute((const void*)fwd_kernel, hipFuncAttributeMaxDynamicSharedMemorySize, LDS_BYTES);
        (void)hipOccupancyMaxActiveBlocksPerMultiprocessor(&per_cu, (const void*)fwd_kernel, NTHR, LDS_BYTES);
        if (per_cu < 1) { fprintf(stderr, "kernel_launch: occupancy query says %d blocks per CU\n", per_cu); per_cu = 1; }
        (void)hipGetLastError();
        grid = cus > 0 ? cus : 256;
    }
    if (grid < 0) return;
    Args a{};
    for (int i = 0; i < 44; ++i) a.in[i] = (const float*)d_in[i];
    a.out = (float*)d_out; a.ws = (unsigned char*)d_ws;
#if MK_MULTI
    for (int ph = 0; ph < NPH; ++ph) { a.ph_lo = ph; a.ph_hi = ph + 1; hipLaunchKernelGGL(fwd_kernel, dim3(grid), dim3(NTHR), LDS_BYTES, stream, a); }
#else
    a.ph_lo = 0; a.ph_hi = NPH;
    void* kargs[] = {&a};
    hipError_t e = hipLaunchCooperativeKernel((const void*)fwd_kernel, dim3(grid), dim3(NTHR), kargs, LDS_BYTES, stream);
    if (e != hipSuccess) fprintf(stderr, "cooperative launch failed: %s (grid %d)\n", hipGetErrorString(e), grid);
#endif
}
```

```cpp
#include <hip/hip_runtime.h>
#include <hip/hip_cooperative_groups.h>
#include <cstdio>
#include <cstdint>
namespace cg = cooperative_groups;

#ifndef MK_MULTI
#define MK_MULTI 0
#endif

namespace pg8 {
#define PG8_LAS __attribute__((address_space(3)))
typedef unsigned short bf16_t;
typedef short bf16x8 __attribute__((ext_vector_type(8)));
typedef float f32x4 __attribute__((ext_vector_type(4)));
typedef unsigned u32x4 __attribute__((ext_vector_type(4)));
constexpr int BM = 256, BK = 64, HALF = 128, HTB = HALF * BK * 2  , STAGE_BYTES = 8 * HTB, NXCD = 8, WGM = 8;

__host__ __device__ __forceinline__ int lds_byte(int r, int c) { const int st = (r >> 4) * 2 + (c >> 5), rr = r & 15, cc = c & 31, ob = rr * 64 + cc * 2; return st * 1024 + (ob ^ (((ob >> 9) & 1) << 5)); }
__host__ __device__ __forceinline__ void stage_rc(int b, int& R, int& C) { const int st = b / 1024, sb = b % 1024, swz = sb ^ (((sb >> 9) & 1) << 5); R = (st >> 1) * 16 + swz / 64; C = (st & 1) * 32 + (swz % 64) / 2; }
__host__ __device__ __forceinline__ int perm32(int rho) { const int n = rho >> 4, i = rho & 15; return 8 * (i >> 2) + 4 * n + (i & 3); }

struct Unit { int pm, pn; };
struct Gemm { const bf16_t* A; const bf16_t* Bt; int M, N, K, lda, ldb, a_div; size_t a_gstride; };

struct StaticOrder {
    int nM, nN, nwg, G, c;
    __host__ __device__ void init(int M, int N, int G_, int c_) { nM = M / BM; nN = N / BM; nwg = nM * nN; G = G_; c = c_; }
    __host__ __device__ bool next(int i, Unit& u) const {
        const long L = (long)i * G + c; if (L >= nwg) return false;
        int wgid = (int)L; { const int q = nwg / NXCD, r = nwg % NXCD, xcd = wgid % NXCD, off = wgid / NXCD; wgid = (xcd < r ? xcd * (q + 1) : r * (q + 1) + (xcd - r) * q) + off; }
        const int nig = WGM * nN, gid = wgid / nig, fm = gid * WGM, gsz = (nM - fm) < WGM ? (nM - fm) : WGM;
        u.pm = fm + ((wgid % nig) % gsz); u.pn = (wgid % nig) / gsz; return true;
    }
    __device__ __forceinline__ void a_ready(const Unit&) const {}
    __device__ __forceinline__ void done(const Unit&) const {}
};

__device__ __forceinline__ unsigned cvt_pk_bf16(float lo, float hi) { unsigned r; asm volatile("v_cvt_pk_bf16_f32 %0, %1, %2" : "=v"(r) : "v"(lo), "v"(hi)); return r; }
__device__ __forceinline__ float bf_lo(unsigned w) { return __builtin_bit_cast(float, w << 16); }
__device__ __forceinline__ float bf_hi(unsigned w) { return __builtin_bit_cast(float, w & 0xffff0000u); }
__device__ __forceinline__ float sigmoidf_(float x) { return 1.0f / (1.0f + __expf(-x)); }

template <int MODE> struct EpiB {
    static constexpr bool PERM = true, AFTER_DRAIN = false;
    bf16_t* O; int ldc; const float* bias; const float* ssq;
    __device__ __forceinline__ void operator()(const f32x4 (&acc)[2][2][4][2], const Unit& u, int wr, int wc, int fr, int fq) const {
        const int row0 = u.pm * BM + wr * 64 + fr, col0 = u.pn * BM + wc * 32 + 8 * fq;
        f32x4 bv[2][2];
#pragma unroll
        for (int bj = 0; bj < 2; ++bj)
#pragma unroll
            for (int n = 0; n < 2; ++n) bv[bj][n] = (MODE == 1) ? *(const f32x4*)(bias + col0 + bj * HALF + 4 * n) : (f32x4){0.f, 0.f, 0.f, 0.f};
#pragma unroll
        for (int ai = 0; ai < 2; ++ai)
#pragma unroll
            for (int m = 0; m < 4; ++m) {
                const int row = row0 + ai * HALF + m * 16;
                bf16_t* rowp = O + (size_t)row * ldc + col0;
                float rs = 1.f;
                if (MODE == 3) { if (u.pn < 4) rs = rsqrtf(ssq[row] * (1.0f / 512.0f) + 1e-6f); }
#pragma unroll
                for (int bj = 0; bj < 2; ++bj) {
                    f32x4 v0 = acc[ai][bj][m][0] + bv[bj][0], v1 = acc[ai][bj][m][1] + bv[bj][1];
                    if (MODE == 1) {
#pragma unroll
                        for (int j = 0; j < 4; ++j) { v0[j] = sigmoidf_(v0[j]); v1[j] = sigmoidf_(v1[j]); }
                    }
                    if (MODE == 2) {
#pragma unroll
                        for (int j = 0; j < 4; ++j) { const float a = fmaxf(v0[j], 0.f), b = fmaxf(v1[j], 0.f); v0[j] = a * a; v1[j] = b * b; }
                    }
                    if (MODE == 3) {
                        const u32x4 gq = *(const u32x4*)(rowp + bj * HALF);
                        v0[0] *= bf_lo(gq.x) * rs; v0[1] *= bf_hi(gq.x) * rs; v0[2] *= bf_lo(gq.y) * rs; v0[3] *= bf_hi(gq.y) * rs;
                        v1[0] *= bf_lo(gq.z) * rs; v1[1] *= bf_hi(gq.z) * rs; v1[2] *= bf_lo(gq.w) * rs; v1[3] *= bf_hi(gq.w) * rs;
                    }
                    u32x4 w; w.x = cvt_pk_bf16(v0[0], v0[1]); w.y = cvt_pk_bf16(v0[2], v0[3]); w.z = cvt_pk_bf16(v1[0], v1[1]); w.w = cvt_pk_bf16(v1[2], v1[3]);
                    *(u32x4*)(rowp + bj * HALF) = w;
                }
            }
    }
};
struct EpiGlu {
    static constexpr bool PERM = true, AFTER_DRAIN = false;
    bf16_t* O; int ldc; int ocol; const float* bias;
    __device__ __forceinline__ void operator()(const f32x4 (&acc)[2][2][4][2], const Unit& u, int wr, int wc, int fr, int fq) const {
        const int row0 = u.pm * BM + wr * 64 + fr, cc = u.pn * HALF + wc * 32 + 8 * fq;
        f32x4 bv[2][2];
#pragma unroll
        for (int bj = 0; bj < 2; ++bj)
#pragma unroll
            for (int n = 0; n < 2; ++n) bv[bj][n] = *(const f32x4*)(bias + bj * 512 + cc + 4 * n);
#pragma unroll
        for (int ai = 0; ai < 2; ++ai)
#pragma unroll
            for (int m = 0; m < 4; ++m) {
                bf16_t* rowp = O + (size_t)(row0 + ai * HALF + m * 16) * ldc + ocol + cc;
                f32x4 v0 = acc[ai][0][m][0] + bv[0][0], v1 = acc[ai][0][m][1] + bv[0][1];
                const f32x4 g0 = acc[ai][1][m][0] + bv[1][0], g1 = acc[ai][1][m][1] + bv[1][1];
#pragma unroll
                for (int j = 0; j < 4; ++j) { v0[j] *= sigmoidf_(g0[j]); v1[j] *= sigmoidf_(g1[j]); }
                u32x4 w; w.x = cvt_pk_bf16(v0[0], v0[1]); w.y = cvt_pk_bf16(v0[2], v0[3]); w.z = cvt_pk_bf16(v1[0], v1[1]); w.w = cvt_pk_bf16(v1[2], v1[3]);
                *(u32x4*)rowp = w;
            }
    }
};
struct EpiRes {
    static constexpr bool PERM = false, AFTER_DRAIN = false;
    const float* base_ctx; const float* base_lat;
    float* out; const float* modv;
    int goff;
    __device__ __forceinline__ void operator()(const f32x4 (&acc)[2][2][4][2], const Unit& u, int wr, int wc, int fr, int fq) const {
        const int row0 = u.pm * BM + wr * 64 + fr, col0 = u.pn * BM + wc * 32 + 4 * fq;
        const int mi = (u.pm < 32) ? 0 : 1 + ((u.pm - 32) >> 2);
        const float* gv = modv + (size_t)mi * 6144 + goff;
        f32x4 gg[2][2];
#pragma unroll
        for (int bj = 0; bj < 2; ++bj)
#pragma unroll
            for (int n = 0; n < 2; ++n) gg[bj][n] = *(const f32x4*)(gv + col0 + bj * HALF + n * 16);
#pragma unroll
        for (int ai = 0; ai < 2; ++ai)
#pragma unroll
            for (int m = 0; m < 4; ++m) {
                const int row = row0 + ai * HALF + m * 16;
                const float* bp = (row < 8192 ? base_ctx + (size_t)row * 1024 : base_lat + (size_t)(row - 8192) * 1024) + col0;
                float* op = out + (size_t)row * 1024 + col0;
#pragma unroll
                for (int bj = 0; bj < 2; ++bj)
#pragma unroll
                    for (int n = 0; n < 2; ++n) { const f32x4 b = *(const f32x4*)(bp + bj * HALF + n * 16); *(f32x4*)(op + bj * HALF + n * 16) = b + gg[bj][n] * acc[ai][bj][m][n]; }
            }
    }
};

template <class Epi, class Sched, bool ALIGN_EPI = false, bool SP2 = false>
__device__ __forceinline__ void gemm_phase(PG8_LAS unsigned char* lds, const Gemm g, const Sched& S, const Epi& E, const int tid) {
    const int wid = __builtin_amdgcn_readfirstlane(tid >> 6), lane = tid & 63, wr = wid >> 2, wc = wid & 3, fr = lane & 15, fq = lane >> 4;
    const int K = g.K, nt = K / BK;
    unsigned voffA[2], voffB[2];
#pragma unroll
    for (int i = 0; i < 2; ++i) { int R, C; stage_rc(tid * 16 + i * 8192, R, C); const int Rb = Epi::PERM ? ((R & ~31) + perm32(R & 31)) : R;
        voffA[i] = (unsigned)(R * g.lda + C) * 2u; voffB[i] = (unsigned)(Rb * g.ldb + C) * 2u; }
    const size_t kstep = (size_t)(BK * 2);
    const size_t hstepA = (size_t)HALF * g.lda * 2, hstepB = (size_t)HALF * g.ldb * 2;
    const size_t tstepA = 2 * hstepA, tstepB = 2 * hstepB;
#define PG8_UA(u) ((const char*)g.A + (size_t)(u).pm * tstepA + (g.a_div ? (size_t)((u).pn / g.a_div) * g.a_gstride : (size_t)0))
#define PG8_UB(u) ((const char*)g.Bt + (size_t)(u).pn * tstepB)
    const unsigned ldsw = (unsigned)wid * 1024u;
    const int aoff = lds_byte(wr * 64 + fr, fq * 8), boff = lds_byte(wc * 32 + fr, fq * 8);
#define PG8_SA(b, h) (((b) * 2 + (h)) * HTB)
#define PG8_SB(b, h) ((4 + (b) * 2 + (h)) * HTB)
#define PG8_STAGE(bufoff, gbase, voff) do { _Pragma("unroll") for (int _i = 0; _i < 2; ++_i) \
        __builtin_amdgcn_global_load_lds((const unsigned*)((const char*)(gbase) + (voff)[_i]), (PG8_LAS unsigned*)(lds + (bufoff) + ldsw + _i * 8192), 16, 0, 0); } while (0)
#define PG8_LDA(dst, b, h) do { _Pragma("unroll") for (int m = 0; m < 4; ++m) _Pragma("unroll") for (int k = 0; k < 2; ++k) dst[m][k] = *(const PG8_LAS bf16x8*)(lds + PG8_SA(b, h) + aoff + m * 2048 + k * 1024); } while (0)
#define PG8_LDB(dst, b, h) do { _Pragma("unroll") for (int n = 0; n < 2; ++n) _Pragma("unroll") for (int k = 0; k < 2; ++k) dst[n][k] = *(const PG8_LAS bf16x8*)(lds + PG8_SB(b, h) + boff + n * 2048 + k * 1024); } while (0)
#define PG8_MMA(ai, bj, At, Bt) do { __builtin_amdgcn_s_setprio(1); _Pragma("unroll") for (int m = 0; m < 4; ++m) _Pragma("unroll") for (int n = 0; n < 2; ++n) _Pragma("unroll") for (int k = 0; k < 2; ++k) \
        acc[ai][bj][m][n] = __builtin_amdgcn_mfma_f32_16x16x32_bf16(Bt[n][k], At[m][k], acc[ai][bj][m][n], 0, 0, 0); __builtin_amdgcn_s_setprio(0); } while (0)
#define PG8_WAIT_V(n) asm volatile("s_waitcnt vmcnt(" #n ")" ::: "memory")
#define PG8_WAIT_L(n) asm volatile("s_waitcnt lgkmcnt(" #n ")" ::: "memory")
#define PG8_BAR __builtin_amdgcn_s_barrier()
#define PG8_SCHED __builtin_amdgcn_sched_barrier(0)
    Unit cur, nxt; int ui = 0;
    if (!S.next(0, cur)) return;
    f32x4 acc[2][2][4][2];
#pragma unroll
    for (int a = 0; a < 2; ++a)
#pragma unroll
        for (int b = 0; b < 2; ++b)
#pragma unroll
            for (int m = 0; m < 4; ++m)
#pragma unroll
                for (int n = 0; n < 2; ++n) acc[a][b][m][n] = (f32x4){0.f, 0.f, 0.f, 0.f};
    bf16x8 At[4][2], B0[2][2], B1[2][2];
    const char* cA = PG8_UA(cur); const char* cB = PG8_UB(cur);
    S.a_ready(cur);
    if constexpr (SP2) {
        PG8_STAGE(PG8_SB(0, 0), cB, voffB); PG8_STAGE(PG8_SB(0, 1), cB + hstepB, voffB); PG8_STAGE(PG8_SA(0, 0), cA, voffA); PG8_STAGE(PG8_SA(0, 1), cA + hstepA, voffA);
        if (wr == 1) PG8_BAR;
        PG8_WAIT_V(2); PG8_BAR;
        PG8_STAGE(PG8_SB(1, 0), cB + kstep, voffB); PG8_STAGE(PG8_SA(1, 0), cA + kstep, voffA); PG8_STAGE(PG8_SB(1, 1), cB + hstepB + kstep, voffB);
        PG8_WAIT_V(6); PG8_BAR;
    } else {
        PG8_STAGE(PG8_SB(0, 0), cB, voffB); PG8_STAGE(PG8_SA(0, 0), cA, voffA); PG8_STAGE(PG8_SB(0, 1), cB + hstepB, voffB); PG8_STAGE(PG8_SA(0, 1), cA + hstepA, voffA);
        if (wr == 1) PG8_BAR;
        PG8_WAIT_V(4); PG8_BAR;
        PG8_STAGE(PG8_SB(1, 0), cB + kstep, voffB); PG8_STAGE(PG8_SA(1, 0), cA + kstep, voffA); PG8_STAGE(PG8_SB(1, 1), cB + hstepB + kstep, voffB);
        PG8_WAIT_V(6); PG8_BAR;
    }
    for (;;) {
        const bool has_next = S.next(ui + 1, nxt);
        const char* nA = has_next ? PG8_UA(nxt) : cA; const char* nB = has_next ? PG8_UB(nxt) : cB;
        for (int t = 0; t < nt; t += 2) {
            const bool last = (t == nt - 2);
            const char* a1 = cA + (size_t)(t + 1) * kstep;
            const char* a2 = last ? nA : cA + (size_t)(t + 2) * kstep; const char* b2 = last ? nB : cB + (size_t)(t + 2) * kstep;
            const char* a3 = a2 + kstep; const char* b3 = b2 + kstep;
            if (last && has_next) S.a_ready(nxt);
            if constexpr (SP2) {
            PG8_LDB(B0, 0, 0); PG8_LDB(B1, 0, 1); PG8_SCHED; PG8_LDA(At, 0, 0); PG8_STAGE(PG8_SA(1, 1), a1 + hstepA, voffA);
            PG8_WAIT_V(8); PG8_WAIT_L(0); PG8_BAR; PG8_MMA(0, 0, At, B0); PG8_MMA(0, 1, At, B1); PG8_BAR; PG8_SCHED;
            PG8_LDA(At, 0, 1); PG8_STAGE(PG8_SB(0, 0), b2, voffB); PG8_STAGE(PG8_SB(0, 1), b2 + hstepB, voffB); PG8_STAGE(PG8_SA(0, 0), a2, voffA);
            PG8_WAIT_V(8); PG8_WAIT_L(0); PG8_BAR; PG8_MMA(1, 0, At, B0); PG8_MMA(1, 1, At, B1); PG8_BAR; PG8_SCHED;
            PG8_LDB(B0, 1, 0); PG8_LDB(B1, 1, 1); PG8_SCHED; PG8_LDA(At, 1, 0); PG8_STAGE(PG8_SA(0, 1), a2 + hstepA, voffA);
            PG8_WAIT_V(8); PG8_WAIT_L(0); PG8_BAR; PG8_MMA(0, 0, At, B0); PG8_MMA(0, 1, At, B1); PG8_BAR; PG8_SCHED;
            PG8_LDA(At, 1, 1); PG8_STAGE(PG8_SB(1, 0), b3, voffB); PG8_STAGE(PG8_SB(1, 1), b3 + hstepB, voffB); PG8_STAGE(PG8_SA(1, 0), a3, voffA);
            PG8_WAIT_V(8); PG8_WAIT_L(0); PG8_BAR; PG8_MMA(1, 0, At, B0); PG8_MMA(1, 1, At, B1); PG8_BAR; PG8_SCHED;
            } else {
            PG8_LDB(B0, 0, 0); PG8_SCHED; PG8_LDA(At, 0, 0); PG8_STAGE(PG8_SA(1, 1), a1 + hstepA, voffA);
            PG8_WAIT_L(8); PG8_BAR; PG8_WAIT_L(0); PG8_MMA(0, 0, At, B0); PG8_BAR; PG8_SCHED;
            PG8_LDB(B1, 0, 1); PG8_STAGE(PG8_SB(0, 0), b2, voffB);
            PG8_BAR; PG8_WAIT_L(0); PG8_MMA(0, 1, At, B1); PG8_BAR;
            PG8_LDA(At, 0, 1); PG8_STAGE(PG8_SA(0, 0), a2, voffA);
            PG8_BAR; PG8_WAIT_L(0); PG8_MMA(1, 0, At, B0); PG8_BAR; PG8_SCHED;
            PG8_STAGE(PG8_SB(0, 1), b2 + hstepB, voffB);
            PG8_WAIT_V(6); PG8_BAR; PG8_MMA(1, 1, At, B1); PG8_BAR;
            PG8_LDB(B0, 1, 0); PG8_SCHED; PG8_LDA(At, 1, 0); PG8_STAGE(PG8_SA(0, 1), a2 + hstepA, voffA);
            PG8_WAIT_L(8); PG8_BAR; PG8_WAIT_L(0); PG8_MMA(0, 0, At, B0); PG8_BAR; PG8_SCHED;
            PG8_LDB(B1, 1, 1); PG8_STAGE(PG8_SB(1, 0), b3, voffB);
            PG8_BAR; PG8_WAIT_L(0); PG8_MMA(0, 1, At, B1); PG8_BAR;
            PG8_LDA(At, 1, 1); PG8_STAGE(PG8_SA(1, 0), a3, voffA);
            PG8_BAR; PG8_WAIT_L(0); PG8_MMA(1, 0, At, B0); PG8_BAR; PG8_SCHED;
            PG8_STAGE(PG8_SB(1, 1), b3 + hstepB, voffB);
            PG8_WAIT_V(6); PG8_BAR; PG8_MMA(1, 1, At, B1); PG8_BAR;
            }
        }
        if constexpr (ALIGN_EPI) { if (wr == 0) PG8_BAR; }
        if constexpr (!Epi::AFTER_DRAIN) { E(acc, cur, wr, wc, fr, fq); S.done(cur); }
        if (!has_next) break;
#pragma unroll
        for (int a = 0; a < 2; ++a)
#pragma unroll
            for (int b = 0; b < 2; ++b)
#pragma unroll
                for (int m = 0; m < 4; ++m)
#pragma unroll
                    for (int n = 0; n < 2; ++n) acc[a][b][m][n] = (f32x4){0.f, 0.f, 0.f, 0.f};
        cur = nxt; cA = nA; cB = nB; ++ui;
        if constexpr (ALIGN_EPI) { if (wr == 1) PG8_BAR; }
    }
    PG8_WAIT_V(0);
    if constexpr (!ALIGN_EPI) { if (wr == 0) PG8_BAR; }
    PG8_BAR;
    if constexpr (Epi::AFTER_DRAIN) { E.fused(acc, cur, wr, wc, fr, fq, lds, wid, lane); S.done(cur); }
#undef PG8_UA
#undef PG8_UB
#undef PG8_SA
#undef PG8_SB
#undef PG8_STAGE
#undef PG8_LDA
#undef PG8_LDB
#undef PG8_MMA
#undef PG8_WAIT_V
#undef PG8_WAIT_L
#undef PG8_BAR
#undef PG8_SCHED
}
}

#ifndef PG8_SP2
#define PG8_SP2 true
#endif
#ifndef PG8_ALIGN
#define PG8_ALIGN true
#endif

typedef unsigned short bf16;
typedef unsigned v4u __attribute__((ext_vector_type(4)));
typedef unsigned v2u __attribute__((ext_vector_type(2)));
typedef float f32x4 __attribute__((ext_vector_type(4)));
#define LAS __attribute__((address_space(3)))

constexpr int NWAVES = 8, NTHR = 512;
constexpr int D = 1024, MC = 8192, ML = 4096, M = 12288, NPH = 23;
constexpr int LDS_BYTES = 147456;
constexpr float EPS = 1e-6f;
constexpr size_t MiB = 1u << 20;
constexpr size_t WS_MOD = 64 * 1024;
constexpr size_t WS_SSQ = 320 * 1024;
constexpr size_t WS_DT = 384 * 1024;
constexpr size_t WS_W = 2 * MiB;
constexpr size_t W_IN = WS_W, W_G = W_IN + 8 * MiB, W_GLU = W_G + 8 * MiB, W_BR = W_GLU + 1 * MiB, W_OUT = W_BR + 4 * MiB, W_1 = W_OUT + 2 * MiB, W_2 = W_1 + 8 * MiB;
constexpr size_t WS_H = 41 * MiB;
constexpr size_t WS_R1 = 65 * MiB;
constexpr size_t WS_Y = 161 * MiB;
constexpr size_t WS_Y5 = 209 * MiB;
constexpr size_t WS_XC = 221 * MiB;
constexpr size_t WS_YF = 239 * MiB;
constexpr size_t WS_END = 251 * MiB;
constexpr size_t O_SSD = 12582912, O_S5 = 16777216, O_DK = 17301504, O_DV = 25690112, O_WK = 34078720, O_WV = 36175872;
constexpr int C_Z = 0, C_XBC = 512, C_U = 1280, C_DQ = 1792, C_DK = 2304, C_DV = 2816, C_WQ = 3328, C_WK = 3840, C_WV = 3968;

struct Args { const float* in[44]; float* out; unsigned char* ws; int ph_lo, ph_hi; };

typedef const Args __attribute__((address_space(4)))* CArgs;
struct Ctx {
    CArgs ap; int tid, lane, wave;
    __device__ __forceinline__ const float* x_prompt() const { return ap->in[0]; }
    __device__ __forceinline__ const float* x_sample() const { return ap->in[1]; }
    __device__ __forceinline__ const float* state_ssd() const { return ap->in[2]; }
    __device__ __forceinline__ const float* state_s5() const { return ap->in[3]; }
    __device__ __forceinline__ const float* cache_dk() const { return ap->in[4]; }
    __device__ __forceinline__ const float* cache_dv() const { return ap->in[5]; }
    __device__ __forceinline__ const float* cache_wk() const { return ap->in[6]; }
    __device__ __forceinline__ const float* cache_wv() const { return ap->in[7]; }
    __device__ __forceinline__ const float* cvec() const { return ap->in[8]; }
    __device__ __forceinline__ const float* c_ctx() const { return ap->in[9]; }
    __device__ __forceinline__ const float* w_mod() const { return ap->in[10]; }
    __device__ __forceinline__ const float* b_mod() const { return ap->in[11]; }
    __device__ __forceinline__ const float* g_norm1() const { return ap->in[12]; }
    __device__ __forceinline__ const float* g_norm2() const { return ap->in[13]; }
    __device__ __forceinline__ const float* w_in() const { return ap->in[14]; }
    __device__ __forceinline__ const float* conv_w() const { return ap->in[15]; }
    __device__ __forceinline__ const float* conv_b() const { return ap->in[16]; }
    __device__ __forceinline__ const float* dt_bias() const { return ap->in[17]; }
    __device__ __forceinline__ const float* a_log() const { return ap->in[18]; }
    __device__ __forceinline__ const float* ssd_d() const { return ap->in[19]; }
    __device__ __forceinline__ const float* ssd_norm_g() const { return ap->in[20]; }
    __device__ __forceinline__ const float* lam_re() const { return ap->in[21]; }
    __device__ __forceinline__ const float* lam_im() const { return ap->in[22]; }
    __device__ __forceinline__ const float* log_step() const { return ap->in[23]; }
    __device__ __forceinline__ const float* b_re() const { return ap->in[24]; }
    __device__ __forceinline__ const float* b_im() const { return ap->in[25]; }
    __device__ __forceinline__ const float* c_re() const { return ap->in[26]; }
    __device__ __forceinline__ const float* c_im() const { return ap->in[27]; }
    __device__ __forceinline__ const float* s5_d() const { return ap->in[28]; }
    __device__ __forceinline__ const float* w_glu() const { return ap->in[29]; }
    __device__ __forceinline__ const float* b_glu() const { return ap->in[30]; }
    __device__ __forceinline__ const float* qn_g() const { return ap->in[31]; }
    __device__ __forceinline__ const float* kn_g() const { return ap->in[32]; }
    __device__ __forceinline__ const float* dlam() const { return ap->in[33]; }
    __device__ __forceinline__ const float* subln_g() const { return ap->in[34]; }
    __device__ __forceinline__ const float* wqn_g() const { return ap->in[35]; }
    __device__ __forceinline__ const float* wkn_g() const { return ap->in[36]; }
    __device__ __forceinline__ const float* sink() const { return ap->in[37]; }
    __device__ __forceinline__ const float* w_branch() const { return ap->in[38]; }
    __device__ __forceinline__ const float* w_gate() const { return ap->in[39]; }
    __device__ __forceinline__ const float* b_gate() const { return ap->in[40]; }
    __device__ __forceinline__ const float* w_out() const { return ap->in[41]; }
    __device__ __forceinline__ const float* w_fc1() const { return ap->in[42]; }
    __device__ __forceinline__ const float* w_fc2() const { return ap->in[43]; }
    __device__ __forceinline__ float* out() const { return ap->out; }
    __device__ __forceinline__ unsigned char* ws() const { return ap->ws; }
    __device__ __forceinline__ float* MOD() const { return (float*)(ap->ws + WS_MOD); }
    __device__ __forceinline__ float* SSQ() const { return (float*)(ap->ws + WS_SSQ); }
    __device__ __forceinline__ float* DT() const { return (float*)(ap->ws + WS_DT); }
    __device__ __forceinline__ bf16* H() const { return (bf16*)(ap->ws + WS_H); }
    __device__ __forceinline__ bf16* R1() const { return (bf16*)(ap->ws + WS_R1); }
    __device__ __forceinline__ bf16* Y() const { return (bf16*)(ap->ws + WS_Y); }
    __device__ __forceinline__ bf16* Y5() const { return (bf16*)(ap->ws + WS_Y5); }
    __device__ __forceinline__ bf16* XC() const { return (bf16*)(ap->ws + WS_XC); }
    __device__ __forceinline__ bf16* YF() const { return (bf16*)(ap->ws + WS_YF); }
};

__device__ __forceinline__ float wave_sum(float v) {
#pragma unroll
    for (int o = 1; o < 64; o <<= 1) v += __shfl_xor(v, o);
    return v;
}
__device__ __forceinline__ float wave_max(float v) {
#pragma unroll
    for (int o = 1; o < 64; o <<= 1) v = fmaxf(v, __shfl_xor(v, o));
    return v;
}
__device__ __forceinline__ float bf2f(bf16 h) { return __builtin_bit_cast(float, (unsigned)h << 16); }
__device__ __forceinline__ float bflo(unsigned w) { return __builtin_bit_cast(float, w << 16); }
__device__ __forceinline__ float bfhi(unsigned w) { return __builtin_bit_cast(float, w & 0xffff0000u); }
__device__ __forceinline__ unsigned f2bf(float f) { unsigned u = __builtin_bit_cast(unsigned, f); return (u + 0x7fffu + ((u >> 16) & 1u)) >> 16; }
__device__ __forceinline__ unsigned pk2(float lo, float hi) { return f2bf(lo) | (f2bf(hi) << 16); }
__device__ __forceinline__ float siluf(float x) { return x / (1.0f + __expf(-x)); }
__device__ __forceinline__ void unpack8(const v4u q, float (&f)[8]) { f[0] = bflo(q.x); f[1] = bfhi(q.x); f[2] = bflo(q.y); f[3] = bfhi(q.y); f[4] = bflo(q.z); f[5] = bfhi(q.z); f[6] = bflo(q.w); f[7] = bfhi(q.w); }

__device__ __forceinline__ void phase_mods(const Ctx& c, float* lf) {
    for (int i = c.tid; i < 5 * 1024; i += NTHR) { const int v = i >> 10, k = i & 1023; const float x = (v == 0) ? c.c_ctx()[k] : c.cvec()[(v - 1) * 1024 + k]; lf[i] = siluf(x); }
    __syncthreads();
    float* red = lf + 5 * 1024;
    for (int u = blockIdx.x; u < 192; u += gridDim.x) {
        const int l = u / 96, col0 = (u % 96) * 64;
        const float* W = c.w_mod() + (size_t)l * 1024 * 6144 + col0 + c.lane;
        float acc[5] = {0.f, 0.f, 0.f, 0.f, 0.f};
#pragma unroll 8
        for (int k = c.wave * 128; k < c.wave * 128 + 128; ++k) { const float wv = W[(size_t)k * 6144];
#pragma unroll
            for (int i = 0; i < 5; ++i) acc[i] += lf[i * 1024 + k] * wv; }
#pragma unroll
        for (int i = 0; i < 5; ++i) red[(c.wave * 5 + i) * 64 + c.lane] = acc[i];
        __syncthreads();
        if (c.tid < 320) { const int i = c.tid >> 6, ln = c.tid & 63; float s = c.b_mod()[l * 6144 + col0 + ln];
#pragma unroll
            for (int w = 0; w < 8; ++w) s += red[(w * 5 + i) * 64 + ln];
            c.MOD()[(size_t)(l * 5 + i) * 6144 + col0 + ln] = s; }
        __syncthreads();
    }
}

__device__ __forceinline__ int cmap(int mode, int n) { return mode == 0 ? n : (mode == 1 ? (n < 1280 ? n : n + 16) : ((n & 255) < 128 ? 128 * (n >> 8) + (n & 127) : 512 + 128 * (n >> 8) + (n & 127))); }
__device__ __forceinline__ void transpose_item(const float* W, int ld, int K, int N, int mode, const float* rowscale, bf16* WT, float* scr, int item, int lane) {
    const int nblk = N / 32, kb = item / nblk, nb = item % nblk, k0 = 64 * kb, n0 = 32 * nb, sc0 = cmap(mode, n0);
#pragma unroll 8
    for (int i = 0; i < 32; ++i) { const int kk = 2 * i + (lane >> 5); float v = W[(size_t)(k0 + kk) * ld + sc0 + (lane & 31)]; if (rowscale) v *= rowscale[k0 + kk]; scr[kk * 33 + (lane & 31)] = v; }
    __builtin_amdgcn_fence(__ATOMIC_RELEASE, "wavefront"); __builtin_amdgcn_wave_barrier();
    const int ch = lane & 7;
#pragma unroll
    for (int j = 0; j < 4; ++j) { const int n = (lane >> 3) + 8 * j; const float* s = scr + (8 * ch) * 33 + n;
        v4u o; o.x = pk2(s[0 * 33], s[1 * 33]); o.y = pk2(s[2 * 33], s[3 * 33]); o.z = pk2(s[4 * 33], s[5 * 33]); o.w = pk2(s[6 * 33], s[7 * 33]);
        *(v4u*)(WT + (size_t)(n0 + n) * K + k0 + 8 * ch) = o; }
    __builtin_amdgcn_fence(__ATOMIC_RELEASE, "wavefront"); __builtin_amdgcn_wave_barrier();
}
__device__ __forceinline__ void phase_convert(const Ctx& c, int l, float* lf) {
    float* scr = lf + c.wave * 2176;
    const int gw = blockIdx.x * NWAVES + c.wave, NGW = gridDim.x * NWAVES;
    unsigned char* ws = c.ws();
    for (int it = gw; it < 9984; it += NGW) {
        int r = it;
        if (r < 2048) { transpose_item(c.w_in() + (size_t)l * 1024 * 4112, 4112, 1024, 4096, 1, nullptr, (bf16*)(ws + W_IN), scr, r, c.lane); continue; } r -= 2048;
        if (r < 2048) { transpose_item(c.w_gate() + (size_t)l * 1024 * 4096, 4096, 1024, 4096, 0, nullptr, (bf16*)(ws + W_G), scr, r, c.lane); continue; } r -= 2048;
        if (r < 256) { transpose_item(c.w_glu() + (size_t)l * 512 * 1024, 1024, 512, 1024, 2, nullptr, (bf16*)(ws + W_GLU), scr, r, c.lane); continue; } r -= 256;
        if (r < 1024) { const int i = r >> 8; transpose_item(c.w_branch() + (size_t)(l * 4 + i) * 512 * 1024, 1024, 512, 1024, 0, i == 0 ? c.ssd_norm_g() + l * 512 : nullptr, (bf16*)(ws + W_BR) + (size_t)i * 1024 * 512, scr, r & 255, c.lane); continue; } r -= 1024;
        if (r < 512) { transpose_item(c.w_out() + (size_t)l * 1024 * 1024, 1024, 1024, 1024, 0, nullptr, (bf16*)(ws + W_OUT), scr, r, c.lane); continue; } r -= 512;
        if (r < 2048) { transpose_item(c.w_fc1() + (size_t)l * 1024 * 4096, 4096, 1024, 4096, 0, nullptr, (bf16*)(ws + W_1), scr, r, c.lane); continue; } r -= 2048;
        transpose_item(c.w_fc2() + (size_t)l * 4096 * 1024, 1024, 4096, 1024, 0, nullptr, (bf16*)(ws + W_2), scr, r, c.lane);
    }
}

__device__ __forceinline__ void phase_norm(const Ctx& c, int l, int which, float* lf) {
    if (which == 0) {
        for (int i = c.tid; i < 16384; i += NTHR) { const int k = i >> 4, j = i & 15; lf[j * 1024 + k] = c.w_in()[(size_t)l * 1024 * 4112 + (size_t)k * 4112 + 1280 + j]; }
        __syncthreads();
    }
    const int gw = blockIdx.x * NWAVES + c.wave, NGW = gridDim.x * NWAVES;
    const float* gn = (which == 0 ? c.g_norm1() : c.g_norm2()) + l * 1024;
    for (int m = gw; m < M; m += NGW) {
        const float* xr = (l == 0 && which == 0) ? (m < MC ? c.x_prompt() + (size_t)m * D : c.x_sample() + (size_t)(m - MC) * D) : c.out() + (size_t)m * D;
        const int mi = (m < MC) ? 0 : 1 + ((m - MC) >> 10);
        const float* mod = c.MOD() + (size_t)(l * 5 + mi) * 6144 + which * 3072;
        f32x4 v[4]; float s = 0.f;
#pragma unroll
        for (int j = 0; j < 4; ++j) { v[j] = *(const f32x4*)(xr + 4 * c.lane + 256 * j); s += (v[j].x * v[j].x + v[j].y * v[j].y) + (v[j].z * v[j].z + v[j].w * v[j].w); }
        const float rstd = rsqrtf(wave_sum(s) * (1.0f / D) + EPS);
#pragma unroll
        for (int j = 0; j < 4; ++j) { const int k = 4 * c.lane + 256 * j; const f32x4 g = *(const f32x4*)(gn + k), sh = *(const f32x4*)(mod + k), sc = *(const f32x4*)(mod + 1024 + k);
            v[j] = v[j] * rstd * g * (sc + 1.0f) + sh;
            v2u o; o.x = pk2(v[j].x, v[j].y); o.y = pk2(v[j].z, v[j].w); *(v2u*)(c.H() + (size_t)m * D + k) = o; }
        if (which == 0) {
            float mine = 0.f;
#pragma unroll 1
            for (int jj = 0; jj < 16; ++jj) { float a = 0.f;
#pragma unroll
                for (int j = 0; j < 4; ++j) { const f32x4 w = *(const f32x4*)(lf + jj * 1024 + 4 * c.lane + 256 * j); a += (v[j].x * w.x + v[j].y * w.y) + (v[j].z * w.z + v[j].w * w.w); }
                a = wave_sum(a); if (c.lane == jj) mine = a; }
            if (c.lane < 16) { const float x = mine + c.dt_bias()[l * 16 + c.lane]; c.DT()[(size_t)m * 16 + c.lane] = x > 20.f ? x : log1pf(__expf(x)); }
            if (c.lane == 0) c.SSQ()[m] = 0.f;
        }
    }
}

__device__ __forceinline__ void phase_qk(const Ctx& c, int l) {
    const int gw = blockIdx.x * NWAVES + c.wave, NGW = gridDim.x * NWAVES, lane = c.lane;
    const float gq = c.qn_g()[l * 64 + lane], gk = c.kn_g()[l * 64 + lane], gwq = c.wqn_g()[l * 64 + lane], gwk = c.wkn_g()[l * 64 + lane];
    for (int m = gw; m < M; m += NGW) {
        bf16* pr = c.R1() + (size_t)m * 4096;
        const bool lat = m >= MC;
        const int b = lat ? (m - MC) >> 10 : m >> 8, t = lat ? (m - MC) & 1023 : m & 255, L = lat ? 1024 : 256;
        float cs = 1.f, sn = 0.f;
        if (lat) { const int f = lane & 15; const float inv = exp2f(-(float)f * 0.8304820237218406f); const float ang = (float)((lane >> 5) ? (t & 63) : (t >> 6)) * inv; sincosf(ang, &sn, &cs); if (!((lane >> 4) & 1)) sn = -sn; }
        const size_t ob = (size_t)(b * 2 + l) * 256 + t;
#pragma unroll 1
        for (int gi = 0; gi < 26; ++gi) {
            const int col = gi < 8 ? C_DQ + gi * 64 : gi < 16 ? C_DK + (gi - 8) * 64 : gi < 24 ? C_WQ + (gi - 16) * 64 : C_WK + (gi - 24) * 64;
            const float gain = gi < 8 ? gq : gi < 16 ? gk : gi < 24 ? gwq : gwk;
            float v = bf2f(pr[col + lane]);
            const float ss = wave_sum(v * v);
            v = v * rsqrtf(ss * (1.0f / 64.0f) + EPS) * gain;
            if (lat) { const float p = __shfl_xor(v, 16); v = v * cs + p * sn; }
            pr[col + lane] = (bf16)f2bf(v);
            if (!lat) {
                if (gi >= 8 && gi < 16) c.out()[O_DK + ob * 512 + (gi - 8) * 64 + lane] = v;
                if (gi >= 24) c.out()[O_WK + ob * 128 + (gi - 24) * 64 + lane] = v;
            }
        }
        if (!lat) {
#pragma unroll
            for (int i = 0; i < 8; ++i) c.out()[O_DV + ob * 512 + i * 64 + lane] = bf2f(pr[C_DV + i * 64 + lane]);
#pragma unroll
            for (int i = 0; i < 2; ++i) c.out()[O_WV + ob * 128 + i * 64 + lane] = bf2f(pr[C_WV + i * 64 + lane]);
        }
#pragma unroll 1
        for (int i = 0; i < 12; ++i) { const int ch = lane + 64 * i; float a = c.conv_b()[l * 768 + ch];
#pragma unroll
            for (int j = 0; j < 7; ++j) { const int tt = t + j - 3; if (tt >= 0 && tt < L) a += c.conv_w()[(size_t)(l * 7 + j) * 768 + ch] * bf2f(c.R1()[(size_t)(m + j - 3) * 4096 + C_XBC + ch]); }
            c.XC()[(size_t)m * 768 + ch] = (bf16)f2bf(siluf(a)); }
    }
}

typedef pg8::bf16x8 bx8;
#define MFMA16(a, b, cc) __builtin_amdgcn_mfma_f32_16x16x32_bf16((a), (b), (cc), 0, 0, 0)
__device__ __forceinline__ void ssd_unit(const Ctx& c, int l, int pass, int b, int h, unsigned char* lds) {
    const int L = pass ? 1024 : 256, tok0 = pass ? MC + b * 1024 : b * 256, NCH = L >> 7;
    const int tid = c.tid, lane = c.lane, w = c.wave, lr = lane & 15, lq = lane >> 4, grp = h >> 2;
    bf16* XT = (bf16*)lds;
    bf16* BwT = XT + 64 * 136;
    bf16* Bm = BwT + 64 * 136;
    bf16* Cm = Bm + 128 * 72;
    bf16* Mm = Cm + 128 * 72;
    bf16* ST = Mm + 128 * 136;
    float* cum = (float*)(ST + 64 * 72);
    float* dtv = cum + 128; float* wv = dtv + 128; float* ecum = wv + 128; float* tot = ecum + 128;
    const float dsk = c.ssd_d()[l * 8 + h];
    const bf16* XCp = c.XC(); const float* DTp = c.DT(); bf16* YFp = c.YF(); bf16* Yp = c.Y(); const bf16* R1p = c.R1(); float* SSQp = c.SSQ();
    const int pi = w >> 1, nj0 = 2 * (w & 1);
    for (int dir = 0; dir < 2; ++dir) {
        const float A = -__expf(c.a_log()[(l * 2 + dir) * 8 + h]);
        f32x4 Sacc[2];
        __syncthreads();
#pragma unroll
        for (int q = 0; q < 2; ++q)
#pragma unroll
            for (int r = 0; r < 4; ++r) { const int p = 16 * pi + 4 * lq + r, n = 16 * (nj0 + q) + lr;
                const float v = pass ? c.state_ssd()[(((((size_t)(b * 2 + l) * 2 + dir) * 8 + h) * 64 + p) * 64) + n] : 0.f;
                Sacc[q][r] = v; ST[p * 72 + n] = (bf16)f2bf(v); }
        for (int ci = 0; ci < NCH; ++ci) {
            __syncthreads();
            const int i = tid >> 2, part = tid & 3;
            float bvals[16];
            { const int t = dir ? L - 1 - (ci * 128 + i) : ci * 128 + i; const bf16* xr = XCp + (size_t)(tok0 + t) * 768;
              const v4u x0 = *(const v4u*)(xr + h * 64 + part * 16), x1 = *(const v4u*)(xr + h * 64 + part * 16 + 8);
              const v4u b0 = *(const v4u*)(xr + 512 + grp * 64 + part * 16), b1 = *(const v4u*)(xr + 512 + grp * 64 + part * 16 + 8);
              const v4u c0 = *(const v4u*)(xr + 640 + grp * 64 + part * 16), c1 = *(const v4u*)(xr + 640 + grp * 64 + part * 16 + 8);
              *(v4u*)(Bm + i * 72 + part * 16) = b0; *(v4u*)(Bm + i * 72 + part * 16 + 8) = b1;
              *(v4u*)(Cm + i * 72 + part * 16) = c0; *(v4u*)(Cm + i * 72 + part * 16 + 8) = c1;
              const unsigned xs[8] = {x0.x, x0.y, x0.z, x0.w, x1.x, x1.y, x1.z, x1.w};
#pragma unroll
              for (int j = 0; j < 8; ++j) { XT[(part * 16 + 2 * j) * 136 + i] = (bf16)(xs[j] & 0xffffu); XT[(part * 16 + 2 * j + 1) * 136 + i] = (bf16)(xs[j] >> 16); }
              float t8[8]; unpack8(b0, t8);
#pragma unroll
              for (int j = 0; j < 8; ++j) bvals[j] = t8[j];
              unpack8(b1, t8);
#pragma unroll
              for (int j = 0; j < 8; ++j) bvals[8 + j] = t8[j]; }
            if (tid < 64) {
                const int i0 = 2 * lane, i1 = i0 + 1;
                const int t0 = dir ? L - 1 - (ci * 128 + i0) : ci * 128 + i0, t1 = dir ? L - 1 - (ci * 128 + i1) : ci * 128 + i1;
                const float d0 = DTp[(size_t)(tok0 + t0) * 16 + dir * 8 + h], d1 = DTp[(size_t)(tok0 + t1) * 16 + dir * 8 + h];
                const float a0 = d0 * A, a1 = d1 * A; float s = a0 + a1;
#pragma unroll
                for (int o = 1; o < 64; o <<= 1) { const float v = __shfl_up(s, o); if (lane >= o) s += v; }
                const float cum1 = s, cum0 = s - a1, total = __shfl(s, 63);
                cum[i0] = cum0; cum[i1] = cum1; dtv[i0] = d0; dtv[i1] = d1;
                wv[i0] = __expf(total - cum0) * d0; wv[i1] = __expf(total - cum1) * d1; ecum[i0] = __expf(cum0); ecum[i1] = __expf(cum1);
                if (lane == 0) tot[0] = __expf(total);
            }
            __syncthreads();
            { const float wi = wv[i];
#pragma unroll
              for (int j = 0; j < 16; ++j) BwT[(part * 16 + j) * 136 + i] = (bf16)f2bf(bvals[j] * wi); }
            bx8 cfr[2];
#pragma unroll
            for (int ks = 0; ks < 2; ++ks) cfr[ks] = *(const bx8*)(Cm + (16 * w + lr) * 72 + 32 * ks + 8 * lq);
            for (int j = 0; j <= w; ++j) {
                const bx8 b0 = *(const bx8*)(Bm + (16 * j + lr) * 72 + 8 * lq), b1 = *(const bx8*)(Bm + (16 * j + lr) * 72 + 32 + 8 * lq);
                f32x4 g = {0.f, 0.f, 0.f, 0.f};
                g = MFMA16(cfr[0], b0, g); g = MFMA16(cfr[1], b1, g);
                const int s = 16 * j + lr; const float cs = cum[s], ds = dtv[s];
#pragma unroll
                for (int r = 0; r < 4; ++r) { const int tt = 16 * w + 4 * lq + r; const float v = (s <= tt) ? g[r] * __expf(cum[tt] - cs) * ds : 0.f; Mm[tt * 136 + s] = (bf16)f2bf(v); }
            }
            if (!(w & 1)) {
#pragma unroll
                for (int r = 0; r < 4; ++r) Mm[(16 * w + 4 * lq + r) * 136 + 16 * (w + 1) + lr] = 0;
            }
            __syncthreads();
            f32x4 yl[4], yo[4];
#pragma unroll
            for (int jp = 0; jp < 4; ++jp) { yl[jp] = (f32x4){0.f, 0.f, 0.f, 0.f}; yo[jp] = (f32x4){0.f, 0.f, 0.f, 0.f}; }
            for (int ks = 0; ks <= (w >> 1); ++ks) {
                const bx8 af = *(const bx8*)(Mm + (16 * w + lr) * 136 + 32 * ks + 8 * lq);
#pragma unroll
                for (int jp = 0; jp < 4; ++jp) { const bx8 xf = *(const bx8*)(XT + (16 * jp + lr) * 136 + 32 * ks + 8 * lq); yl[jp] = MFMA16(af, xf, yl[jp]); }
            }
#pragma unroll
            for (int ks = 0; ks < 2; ++ks)
#pragma unroll
                for (int jp = 0; jp < 4; ++jp) { const bx8 sf = *(const bx8*)(ST + (16 * jp + lr) * 72 + 32 * ks + 8 * lq); yo[jp] = MFMA16(cfr[ks], sf, yo[jp]); }
            {
                float ssq[4] = {0.f, 0.f, 0.f, 0.f};
#pragma unroll
                for (int r = 0; r < 4; ++r) {
                    const int tt = 16 * w + 4 * lq + r; const float ec = ecum[tt];
                    const int t = dir ? L - 1 - (ci * 128 + tt) : ci * 128 + tt; const size_t m = (size_t)tok0 + t;
#pragma unroll
                    for (int jp = 0; jp < 4; ++jp) {
                        const int p = 16 * jp + lr; const float y = yl[jp][r] + ec * yo[jp][r];
                        if (dir == 0) YFp[m * 512 + h * 64 + p] = (bf16)f2bf(y);
                        else { const float x = bf2f(XT[p * 136 + tt]); const float ytot = y + bf2f(YFp[m * 512 + h * 64 + p]) + dsk * x; const float z = bf2f(R1p[m * 4096 + C_Z + h * 64 + p]);
                            const float gt = ytot * siluf(z); Yp[m * 2048 + h * 64 + p] = (bf16)f2bf(gt); ssq[r] += gt * gt; }
                    }
                    if (dir == 1) { float q = ssq[r]; q += __shfl_xor(q, 1); q += __shfl_xor(q, 2); q += __shfl_xor(q, 4); q += __shfl_xor(q, 8); if (lr == 0) atomicAdd(SSQp + m, q); }
                }
            }
            __syncthreads();
            {
                f32x4 st[2] = {{0.f, 0.f, 0.f, 0.f}, {0.f, 0.f, 0.f, 0.f}};
#pragma unroll
                for (int ks = 0; ks < 4; ++ks) { const bx8 af = *(const bx8*)(XT + (16 * pi + lr) * 136 + 32 * ks + 8 * lq);
#pragma unroll
                    for (int q = 0; q < 2; ++q) { const bx8 bf = *(const bx8*)(BwT + (16 * (nj0 + q) + lr) * 136 + 32 * ks + 8 * lq); st[q] = MFMA16(af, bf, st[q]); } }
                const float et = tot[0];
#pragma unroll
                for (int q = 0; q < 2; ++q)
#pragma unroll
                    for (int r = 0; r < 4; ++r) { Sacc[q][r] = et * Sacc[q][r] + st[q][r]; ST[(16 * pi + 4 * lq + r) * 72 + 16 * (nj0 + q) + lr] = (bf16)f2bf(Sacc[q][r]); }
            }
        }
        if (!pass) {
#pragma unroll
            for (int q = 0; q < 2; ++q)
#pragma unroll
                for (int r = 0; r < 4; ++r) { const int p = 16 * pi + 4 * lq + r, n = 16 * (nj0 + q) + lr;
                    c.out()[O_SSD + (((((size_t)(b * 2 + l) * 2 + dir) * 8 + h) * 64 + p) * 64) + n] = Sacc[q][r]; }
        }
    }
}

__device__ __forceinline__ void s5_unit(const Ctx& c, int l, int pass, int b, int g, float* lf) {
    const int L = pass ? 1024 : 256, tok0 = pass ? MC + b * 1024 : b * 256, tid = c.tid;
    float* ybuf = lf;
    float* sbuf = lf + 16384;
    float* cmat = lf + 24576;
    for (int i = tid; i < L * 16; i += NTHR) ybuf[i] = 0.f;
    for (int i = tid; i < 4096; i += NTHR) { const int dir = i >> 11, ri = (i >> 10) & 1, mm = (i >> 6) & 15, n = i & 63;
        cmat[((dir * 2 + ri) * 16 + mm) * 129 + n] = (ri ? c.c_im() : c.c_re())[((size_t)((l * 2 + dir) * 32 + g) * 16 + mm) * 64 + n]; }
    const int dir = (tid >> 6) & 1, n = tid & 63;
    float are = 0.f, aim = 0.f, sre = 0.f, sim = 0.f, Bcr[16], Bci[16];
    if (tid < 128) {
        const int idx = ((l * 2 + dir) * 32 + g) * 64 + n;
        const float lre = c.lam_re()[idx], lim = c.lam_im()[idx], step = expf(c.log_step()[(l * 2 + dir) * 32 + g]);
        const float mag = expf(lre * step); float sn, cs; sincosf(lim * step, &sn, &cs); are = mag * cs; aim = mag * sn;
        const float den = lre * lre + lim * lim, cre = ((are - 1.0f) * lre + aim * lim) / den, cim = (aim * lre - (are - 1.0f) * lim) / den;
#pragma unroll
        for (int mm = 0; mm < 16; ++mm) { const float br = c.b_re()[(size_t)idx * 16 + mm], bi = c.b_im()[(size_t)idx * 16 + mm]; Bcr[mm] = cre * br - cim * bi; Bci[mm] = cre * bi + cim * br; }
        if (pass) { sre = c.state_s5()[((((size_t)(b * 2 + l) * 2 + dir) * 2 + 0) * 32 + g) * 64 + n]; sim = c.state_s5()[((((size_t)(b * 2 + l) * 2 + dir) * 2 + 1) * 32 + g) * 64 + n]; }
    }
    __syncthreads();
    for (int c0 = 0; c0 < L / 32; ++c0) {
        if (tid < 128) {
            for (int st = 0; st < 32; ++st) {
                const int s = c0 * 32 + st, t = dir ? L - 1 - s : s; const bf16* up = c.R1() + (size_t)(tok0 + t) * 4096 + C_U + g * 16;
                float u[16]; { float a8[8]; unpack8(*(const v4u*)up, a8);
#pragma unroll
                    for (int j = 0; j < 8; ++j) u[j] = a8[j];
                    unpack8(*(const v4u*)(up + 8), a8);
#pragma unroll
                    for (int j = 0; j < 8; ++j) u[8 + j] = a8[j]; }
                float xr = 0.f, xi = 0.f;
#pragma unroll
                for (int mm = 0; mm < 16; ++mm) { xr += Bcr[mm] * u[mm]; xi += Bci[mm] * u[mm]; }
                const float nr = are * sre - aim * sim + xr, ni = are * sim + aim * sre + xi; sre = nr; sim = ni;
                sbuf[(dir * 32 + st) * 128 + n] = sre; sbuf[(dir * 32 + st) * 128 + 64 + n] = sim;
            }
        }
        __syncthreads();
        { const int st = tid >> 4, mm = tid & 15;
#pragma unroll
            for (int d2 = 0; d2 < 2; ++d2) { const int s = c0 * 32 + st, t = d2 ? L - 1 - s : s;
                const float* cr = cmat + ((d2 * 2 + 0) * 16 + mm) * 129; const float* ci = cmat + ((d2 * 2 + 1) * 16 + mm) * 129; const float* sb = sbuf + (d2 * 32 + st) * 128;
                float a = 0.f;
#pragma unroll 8
                for (int k = 0; k < 64; ++k) a += cr[k] * sb[k] - ci[k] * sb[64 + k];
                ybuf[t * 16 + mm] += a; } }
        __syncthreads();
    }
    for (int i = tid; i < L * 16; i += NTHR) { const int t = i >> 4, mm = i & 15; const size_t m = (size_t)tok0 + t;
        const float u = bf2f(c.R1()[m * 4096 + C_U + g * 16 + mm]); c.Y5()[m * 512 + g * 16 + mm] = (bf16)f2bf(ybuf[i] + c.s5_d()[l * 512 + g * 16 + mm] * u); }
    if (!pass && tid < 128) { c.out()[O_S5 + ((((size_t)(b * 2 + l) * 2 + dir) * 2 + 0) * 32 + g) * 64 + n] = sre; c.out()[O_S5 + ((((size_t)(b * 2 + l) * 2 + dir) * 2 + 1) * 32 + g) * 64 + n] = sim; }
    __syncthreads();
}

template <int PASS> __device__ __forceinline__ void diff_unit(const Ctx& c, int l, int tg, float* lf) {
    constexpr int NKK = PASS ? 20 : 4, NK = NKK * 64;
    const int lane = c.lane;
    float* qs = lf + c.wave * 128;
    float* as = lf + 1024 + c.wave * 1280;
    const float lam_init = 0.8f - 0.6f * expf(-0.3f * (float)l);
    const float* lv = c.dlam() + l * 256;
    const float lam = expf(wave_sum(lv[lane] * lv[64 + lane])) - expf(wave_sum(lv[128 + lane] * lv[192 + lane])) + lam_init;
    for (int i = 0; i < 8; ++i) {
        const int task = c.wave * 8 + i, tok = tg * 16 + (task >> 2), h = task & 3;
        const size_t m = (size_t)(PASS ? MC : 0) + tok;
        const int b = PASS ? tok >> 10 : tok >> 8, tok0 = PASS ? MC + b * 1024 : b * 256;
        __builtin_amdgcn_wave_barrier();
        qs[lane] = bf2f(c.R1()[m * 4096 + C_DQ + h * 128 + lane]) * 0.125f; qs[64 + lane] = bf2f(c.R1()[m * 4096 + C_DQ + h * 128 + 64 + lane]) * 0.125f;
        __builtin_amdgcn_fence(__ATOMIC_RELEASE, "wavefront"); __builtin_amdgcn_wave_barrier();
        float sc0[NKK], sc1[NKK];
#pragma unroll
        for (int kk = 0; kk < NKK; ++kk) {
            const int s = kk * 64 + lane; float d0 = 0.f, d1 = 0.f;
            if (PASS && kk < 4) { const float* kp = c.cache_dk() + ((((size_t)(b * 2 + l) * 256 + s) * 4 + h) * 128);
#pragma unroll 4
                for (int d = 0; d < 64; d += 4) { const f32x4 k0 = *(const f32x4*)(kp + d), k1 = *(const f32x4*)(kp + 64 + d), q0 = *(const f32x4*)(qs + d), q1 = *(const f32x4*)(qs + 64 + d);
                    d0 += (k0.x * q0.x + k0.y * q0.y) + (k0.z * q0.z + k0.w * q0.w); d1 += (k1.x * q1.x + k1.y * q1.y) + (k1.z * q1.z + k1.w * q1.w); } }
            else { const bf16* kp = c.R1() + (size_t)(tok0 + (PASS ? s - 256 : s)) * 4096 + C_DK + h * 128;
#pragma unroll 2
                for (int d = 0; d < 64; d += 8) { float k0[8], k1[8]; unpack8(*(const v4u*)(kp + d), k0); unpack8(*(const v4u*)(kp + 64 + d), k1);
#pragma unroll
                    for (int j = 0; j < 8; ++j) { d0 += k0[j] * qs[d + j]; d1 += k1[j] * qs[64 + d + j]; } } }
            sc0[kk] = d0; sc1[kk] = d1;
        }
        float m0 = sc0[0], m1 = sc1[0];
#pragma unroll
        for (int kk = 1; kk < NKK; ++kk) { m0 = fmaxf(m0, sc0[kk]); m1 = fmaxf(m1, sc1[kk]); }
        m0 = wave_max(m0); m1 = wave_max(m1);
        float s0 = 0.f, s1 = 0.f;
#pragma unroll
        for (int kk = 0; kk < NKK; ++kk) { sc0[kk] = __expf(sc0[kk] - m0); sc1[kk] = __expf(sc1[kk] - m1); s0 += sc0[kk]; s1 += sc1[kk]; }
        s0 = 1.0f / wave_sum(s0); s1 = lam / wave_sum(s1);
#pragma unroll
        for (int kk = 0; kk < NKK; ++kk) as[kk * 64 + lane] = sc0[kk] * s0 - sc1[kk] * s1;
        __builtin_amdgcn_fence(__ATOMIC_RELEASE, "wavefront"); __builtin_amdgcn_wave_barrier();
        float o0 = 0.f, o1 = 0.f;
        if (PASS) { const float* vp = c.cache_dv() + ((((size_t)(b * 2 + l) * 256) * 4 + h) * 128);
#pragma unroll 4
            for (int s = 0; s < 256; ++s) { const float a = as[s]; o0 += a * vp[(size_t)s * 512 + lane]; o1 += a * vp[(size_t)s * 512 + 64 + lane]; } }
        { const bf16* vp = c.R1() + (size_t)tok0 * 4096 + C_DV + h * 128; const float* ap = as + (PASS ? 256 : 0); const int ns = PASS ? 1024 : 256;
#pragma unroll 4
            for (int s = 0; s < ns; ++s) { const float a = ap[s]; o0 += a * bf2f(vp[(size_t)s * 4096 + lane]); o1 += a * bf2f(vp[(size_t)s * 4096 + 64 + lane]); } }
        const float r = rsqrtf(wave_sum(o0 * o0 + o1 * o1) * (1.0f / 128.0f) + EPS) * (1.0f - lam_init);
        c.Y()[m * 2048 + 1024 + h * 128 + lane] = (bf16)f2bf(o0 * r * c.subln_g()[l * 128 + lane]);
        c.Y()[m * 2048 + 1024 + h * 128 + 64 + lane] = (bf16)f2bf(o1 * r * c.subln_g()[l * 128 + 64 + lane]);
    }
    (void)NK;
}

template <int PASS> __device__ __forceinline__ void win_unit(const Ctx& c, int l, int tg, float* lf) {
    constexpr int NKK = PASS ? 9 : 4;
    const int lane = c.lane;
    float* qs = lf + c.wave * 64;
    float* as = lf + 512 + c.wave * 576;
    for (int i = 0; i < 8; ++i) {
        const int task = c.wave * 8 + i, tok = tg * 8 + (task >> 3), hh = task & 7, nkv = hh >> 2;
        const size_t m = (size_t)(PASS ? MC : 0) + tok;
        const int b = PASS ? tok >> 10 : tok >> 8, tok0 = PASS ? MC + b * 1024 : b * 256, qp = PASS ? tok & 1023 : tok & 255;
        const int lo = PASS ? (qp - 128 < 0 ? 0 : qp - 128) : 0, hi = PASS ? (qp + 128 > 1023 ? 1023 : qp + 128) : 255;
        const int nk = PASS ? 256 + (hi - lo + 1) : 256;
        __builtin_amdgcn_wave_barrier();
        qs[lane] = bf2f(c.R1()[m * 4096 + C_WQ + hh * 64 + lane]) * 0.125f;
        __builtin_amdgcn_fence(__ATOMIC_RELEASE, "wavefront"); __builtin_amdgcn_wave_barrier();
        float sc[NKK];
#pragma unroll
        for (int kk = 0; kk < NKK; ++kk) {
            const int s = kk * 64 + lane; float d0 = 0.f;
            if (PASS && kk < 4) { const float* kp = c.cache_wk() + (((size_t)(b * 2 + l) * 256 + s) * 2 + nkv) * 64;
#pragma unroll 4
                for (int d = 0; d < 64; d += 4) { const f32x4 k0 = *(const f32x4*)(kp + d), q0 = *(const f32x4*)(qs + d); d0 += (k0.x * q0.x + k0.y * q0.y) + (k0.z * q0.z + k0.w * q0.w); } }
            else if (s < nk) { const bf16* kp = c.R1() + (size_t)(tok0 + (PASS ? lo + s - 256 : s)) * 4096 + C_WK + nkv * 64;
#pragma unroll 2
                for (int d = 0; d < 64; d += 8) { float k0[8]; unpack8(*(const v4u*)(kp + d), k0);
#pragma unroll
                    for (int j = 0; j < 8; ++j) d0 += k0[j] * qs[d + j]; } }
            else d0 = -1e30f;
            sc[kk] = d0;
        }
        const float sk = c.sink()[l * 8 + hh];
        float mx = sk;
#pragma unroll
        for (int kk = 0; kk < NKK; ++kk) mx = fmaxf(mx, sc[kk]);
        mx = wave_max(mx);
        float sm = 0.f;
#pragma unroll
        for (int kk = 0; kk < NKK; ++kk) { sc[kk] = __expf(sc[kk] - mx); sm += sc[kk]; }
        const float inv = 1.0f / (wave_sum(sm) + __expf(sk - mx));
#pragma unroll
        for (int kk = 0; kk < NKK; ++kk) as[kk * 64 + lane] = sc[kk] * inv;
        __builtin_amdgcn_fence(__ATOMIC_RELEASE, "wavefront"); __builtin_amdgcn_wave_barrier();
        float o = 0.f;
        if (PASS) { const float* vp = c.cache_wv() + (((size_t)(b * 2 + l) * 256) * 2 + nkv) * 64;
#pragma unroll 4
            for (int s = 0; s < 256; ++s) o += as[s] * vp[(size_t)s * 128 + lane]; }
        { const bf16* vp = c.R1() + (size_t)(tok0 + lo) * 4096 + C_WV + nkv * 64; const float* ap = as + (PASS ? 256 : 0); const int ns = PASS ? hi - lo + 1 : 256;
#pragma unroll 4
            for (int s = 0; s < ns; ++s) o += ap[s] * bf2f(vp[(size_t)s * 4096 + lane]); }
        c.Y()[m * 2048 + 1536 + hh * 64 + lane] = (bf16)f2bf(o);
    }
}

__device__ __forceinline__ void phase_mixers(const Ctx& c_in, int l, float* lf) {
    for (int u = blockIdx.x; u < 3744; u += gridDim.x) {
        Ctx c = c_in; asm volatile("" : "+s"(c.ap));
        if (u < 32) ssd_unit(c, l, 1, u >> 3, u & 7, (unsigned char*)lf);
        else if (u < 160) s5_unit(c, l, 1, (u - 32) >> 5, (u - 32) & 31, lf);
        else if (u < 416) diff_unit<1>(c, l, u - 160, lf);
        else if (u < 928) win_unit<1>(c, l, u - 416, lf);
        else if (u < 1184) ssd_unit(c, l, 0, (u - 928) >> 3, (u - 928) & 7, (unsigned char*)lf);
        else if (u < 2208) s5_unit(c, l, 0, (u - 1184) >> 5, (u - 1184) & 31, lf);
        else if (u < 2720) diff_unit<0>(c, l, u - 2208, lf);
        else win_unit<0>(c, l, u - 2720, lf);
        __syncthreads();
    }
}

__device__ __forceinline__ void phase_sum4(const Ctx& c) {
    const int gt = blockIdx.x * NTHR + c.tid, NT = gridDim.x * NTHR;
    for (int i = gt; i < M * 128; i += NT) { const size_t m = (size_t)(i >> 7); const int c8 = (i & 127) * 8;
        float a[8] = {0.f, 0.f, 0.f, 0.f, 0.f, 0.f, 0.f, 0.f};
#pragma unroll
        for (int j = 0; j < 4; ++j) { float f[8]; unpack8(*(const v4u*)(c.R1() + m * 4096 + j * 1024 + c8), f);
#pragma unroll
            for (int k = 0; k < 8; ++k) a[k] += f[k]; }
        v4u o; o.x = pk2(a[0], a[1]); o.y = pk2(a[2], a[3]); o.z = pk2(a[4], a[5]); o.w = pk2(a[6], a[7]);
        *(v4u*)(c.H() + m * 1024 + c8) = o; }
}

#define PHASE_BEGIN() Ctx c; c.ap = (CArgs)__builtin_amdgcn_kernarg_segment_ptr(); asm volatile("" : "+s"(c.ap)); \
        int tid_o = threadIdx.x; asm volatile("" : "+v"(tid_o)); c.tid = tid_o; c.lane = tid_o & 63; c.wave = __builtin_amdgcn_readfirstlane(tid_o >> 6); \
        int G = gridDim.x, bid = blockIdx.x; asm volatile("" : "+s"(G), "+s"(bid)); unsigned char* ws = c.ws(); (void)ws; (void)G; (void)bid;
#define PHASE_END(k) if ((k) + 1 < ph_hi) { __threadfence(); cg::this_grid().sync(); }
#define IN_RANGE(k) (ph_lo <= (k) && (k) < ph_hi)

template <int LAYER> __device__ __forceinline__ void layer_program(int ph_lo, int ph_hi, unsigned char* lds) {
    float* lf = (float*)lds;
    PG8_LAS unsigned char* ring = (PG8_LAS unsigned char*)lds;
    constexpr int l = LAYER, B0 = 1 + 11 * LAYER;
    if (IN_RANGE(B0 + 0)) { PHASE_BEGIN(); if (l == 1) { phase_convert(c, 1, lf); __syncthreads(); } phase_norm(c, l, 0, lf); PHASE_END(B0 + 0); }
    if (IN_RANGE(B0 + 1)) { PHASE_BEGIN();
        pg8::Gemm g{c.H(), (const bf16*)(ws + W_IN), M, 4096, 1024, 1024, 1024, 0, 0}; pg8::StaticOrder S; S.init(M, 4096, G, bid);
        pg8::EpiB<0> E{c.R1(), 4096, nullptr, nullptr};
        pg8::gemm_phase<pg8::EpiB<0>, pg8::StaticOrder, true, true>(ring, g, S, E, tid_o); PHASE_END(B0 + 1); }
    if (IN_RANGE(B0 + 2)) { PHASE_BEGIN(); phase_qk(c, l); PHASE_END(B0 + 2); }
    if (IN_RANGE(B0 + 3)) { PHASE_BEGIN(); phase_mixers(c, l, lf); PHASE_END(B0 + 3); }
    if (IN_RANGE(B0 + 4)) { PHASE_BEGIN();
        { pg8::Gemm g{c.Y5(), (const bf16*)(ws + W_GLU), M, 1024, 512, 512, 512, 0, 0}; pg8::StaticOrder S; S.init(M, 1024, G, bid);
          pg8::EpiGlu E{c.Y(), 2048, 512, c.b_glu() + l * 1024};
          pg8::gemm_phase<pg8::EpiGlu, pg8::StaticOrder, true, true>(ring, g, S, E, tid_o); }
        { pg8::Gemm g{c.H(), (const bf16*)(ws + W_G), M, 4096, 1024, 1024, 1024, 0, 0}; pg8::StaticOrder S; S.init(M, 4096, G, bid);
          pg8::EpiB<1> E{c.R1(), 4096, c.b_gate() + l * 4096, nullptr};
          pg8::gemm_phase<pg8::EpiB<1>, pg8::StaticOrder, true, true>(ring, g, S, E, tid_o); }
        PHASE_END(B0 + 4); }
    if (IN_RANGE(B0 + 5)) { PHASE_BEGIN();
        pg8::Gemm g{c.Y(), (const bf16*)(ws + W_BR), M, 4096, 512, 2048, 512, 4, 1024}; pg8::StaticOrder S; S.init(M, 4096, G, bid);
        pg8::EpiB<3> E{c.R1(), 4096, nullptr, c.SSQ()};
        pg8::gemm_phase<pg8::EpiB<3>, pg8::StaticOrder, true, true>(ring, g, S, E, tid_o); PHASE_END(B0 + 5); }
    if (IN_RANGE(B0 + 6)) { PHASE_BEGIN(); phase_sum4(c); PHASE_END(B0 + 6); }
    if (IN_RANGE(B0 + 7)) { PHASE_BEGIN();
        pg8::Gemm g{c.H(), (const bf16*)(ws + W_OUT), M, 1024, 1024, 1024, 1024, 0, 0}; pg8::StaticOrder S; S.init(M, 1024, G, bid);
        pg8::EpiRes E{l == 0 ? c.x_prompt() : c.out(), l == 0 ? c.x_sample() : c.out() + (size_t)MC * D, c.out(), c.MOD() + (size_t)l * 5 * 6144, 2048};
        pg8::gemm_phase<pg8::EpiRes, pg8::StaticOrder, true, true>(ring, g, S, E, tid_o); PHASE_END(B0 + 7); }
    if (IN_RANGE(B0 + 8)) { PHASE_BEGIN(); phase_norm(c, l, 1, lf); PHASE_END(B0 + 8); }
    if (IN_RANGE(B0 + 9)) { PHASE_BEGIN();
        pg8::Gemm g{c.H(), (const bf16*)(ws + W_1), M, 4096, 1024, 1024, 1024, 0, 0}; pg8::StaticOrder S; S.init(M, 4096, G, bid);
        pg8::EpiB<2> E{c.R1(), 4096, nullptr, nullptr};
        pg8::gemm_phase<pg8::EpiB<2>, pg8::StaticOrder, true, true>(ring, g, S, E, tid_o); PHASE_END(B0 + 9); }
    if (IN_RANGE(B0 + 10)) { PHASE_BEGIN();
        pg8::Gemm g{c.R1(), (const bf16*)(ws + W_2), M, 1024, 4096, 4096, 4096, 0, 0}; pg8::StaticOrder S; S.init(M, 1024, G, bid);
        pg8::EpiRes E{c.out(), c.out() + (size_t)MC * D, c.out(), c.MOD() + (size_t)l * 5 * 6144, 5120};
        pg8::gemm_phase<pg8::EpiRes, pg8::StaticOrder, true, true>(ring, g, S, E, tid_o); PHASE_END(B0 + 10); }
}

__global__ void __launch_bounds__(NTHR, 2) fwd_kernel(Args args) {
    extern __shared__ __attribute__((aligned(16))) unsigned char lds[];
    const int ph_lo = args.ph_lo, ph_hi = args.ph_hi;
    if (IN_RANGE(0)) { PHASE_BEGIN(); float* lf = (float*)lds; phase_mods(c, lf); __syncthreads(); phase_convert(c, 0, lf); PHASE_END(0); }
    layer_program<0>(ph_lo, ph_hi, lds);
    layer_program<1>(ph_lo, ph_hi, lds);
}

extern "C" void kernel_launch(void* const* d_in, const int* in_sizes, int n_in, void* d_out, int out_size, void* d_ws, size_t ws_size, hipStream_t stream) {
    static int grid = 0;
    if (grid == 0) {
        if (n_in != 44 || ws_size < WS_END) { fprintf(stderr, "kernel_launch: expected 44 inputs and >= %zu bytes of workspace; got %d, %zu\n", (size_t)WS_END, n_in, ws_size); grid = -1; return; }
        int dev = 0, cus = 0, per_cu = 0;
        (void)hipGetDevice(&dev); (void)hipDeviceGetAttribute(&cus, hipDeviceAttributeMultiprocessorCount, dev);
        (void)hipFuncSetAttribute((const void*)fwd_kernel, hipFuncAttributeMaxDynamicSharedMemorySize, LDS_BYTES);
        (void)hipOccupancyMaxActiveBlocksPerMultiprocessor(&per_cu, (const void*)fwd_kernel, NTHR, LDS_BYTES);
        if (per_cu < 1) { fprintf(stderr, "kernel_launch: occupancy query says %d blocks per CU\n", per_cu); per_cu = 1; }
        (void)hipGetLastError();
        grid = cus > 0 ? cus : 256;
    }
    if (grid < 0) return;
    Args a{};
    for (int i = 0; i < 44; ++i) a.in[i] = (const float*)d_in[i];
    a.out = (float*)d_out; a.ws = (unsigned char*)d_ws;
#if MK_MULTI
    for (int ph = 0; ph < NPH; ++ph) { a.ph_lo = ph; a.ph_hi = ph + 1; hipLaunchKernelGGL(fwd_kernel, dim3(grid), dim3(NTHR), LDS_BYTES, stream, a); }
#else
    a.ph_lo = 0; a.ph_hi = NPH;
    void* kargs[] = {&a};
    hipError_t e = hipLaunchCooperativeKernel((const void*)fwd_kernel, dim3(grid), dim3(NTHR), kargs, LDS_BYTES, stream);
    if (e != hipSuccess) fprintf(stderr, "cooperative launch failed: %s (grid %d)\n", hipGetErrorString(e), grid);
#endif
}
```

```cpp
#include <hip/hip_runtime.h>
#include <hip/hip_cooperative_groups.h>
#include <cstdio>
#include <cstdint>
namespace cg = cooperative_groups;

#ifndef MK_MULTI
#define MK_MULTI 0
#endif

namespace pg8 {
#define PG8_LAS __attribute__((address_space(3)))
typedef unsigned short bf16_t;
typedef short bf16x8 __attribute__((ext_vector_type(8)));
typedef float f32x4 __attribute__((ext_vector_type(4)));
typedef unsigned u32x4 __attribute__((ext_vector_type(4)));
constexpr int BM = 256, BK = 64, HALF = 128, HTB = HALF * BK * 2  , STAGE_BYTES = 8 * HTB, NXCD = 8, WGM = 8;

__host__ __device__ __forceinline__ int lds_byte(int r, int c) { const int st = (r >> 4) * 2 + (c >> 5), rr = r & 15, cc = c & 31, ob = rr * 64 + cc * 2; return st * 1024 + (ob ^ (((ob >> 9) & 1) << 5)); }
__host__ __device__ __forceinline__ void stage_rc(int b, int& R, int& C) { const int st = b / 1024, sb = b % 1024, swz = sb ^ (((sb >> 9) & 1) << 5); R = (st >> 1) * 16 + swz / 64; C = (st & 1) * 32 + (swz % 64) / 2; }
__host__ __device__ __forceinline__ int perm32(int rho) { const int n = rho >> 4, i = rho & 15; return 8 * (i >> 2) + 4 * n + (i & 3); }

struct Unit { int pm, pn; };
struct Gemm { const bf16_t* A; const bf16_t* Bt; int M, N, K, lda, ldb, a_div; size_t a_gstride; };

struct StaticOrder {
    int nM, nN, nwg, G, c;
    __host__ __device__ void init(int M, int N, int G_, int c_) { nM = M / BM; nN = N / BM; nwg = nM * nN; G = G_; c = c_; }
    __host__ __device__ bool next(int i, Unit& u) const {
        const long L = (long)i * G + c; if (L >= nwg) return false;
        int wgid = (int)L; { const int q = nwg / NXCD, r = nwg % NXCD, xcd = wgid % NXCD, off = wgid / NXCD; wgid = (xcd < r ? xcd * (q + 1) : r * (q + 1) + (xcd - r) * q) + off; }
        const int nig = WGM * nN, gid = wgid / nig, fm = gid * WGM, gsz = (nM - fm) < WGM ? (nM - fm) : WGM;
        u.pm = fm + ((wgid % nig) % gsz); u.pn = (wgid % nig) / gsz; return true;
    }
    __device__ __forceinline__ void a_ready(const Unit&) const {}
    __device__ __forceinline__ void done(const Unit&) const {}
};

__device__ __forceinline__ unsigned cvt_pk_bf16(float lo, float hi) { unsigned r; asm volatile("v_cvt_pk_bf16_f32 %0, %1, %2" : "=v"(r) : "v"(lo), "v"(hi)); return r; }
__device__ __forceinline__ float bf_lo(unsigned w) { return __builtin_bit_cast(float, w << 16); }
__device__ __forceinline__ float bf_hi(unsigned w) { return __builtin_bit_cast(float, w & 0xffff0000u); }
__device__ __forceinline__ float sigmoidf_(float x) { return 1.0f / (1.0f + __expf(-x)); }

template <int MODE> struct EpiB {
    static constexpr bool PERM = true, AFTER_DRAIN = false;
    bf16_t* O; int ldc; const float* bias; const float* ssq;
    __device__ __forceinline__ void operator()(const f32x4 (&acc)[2][2][4][2], const Unit& u, int wr, int wc, int fr, int fq) const {
        const int row0 = u.pm * BM + wr * 64 + fr, col0 = u.pn * BM + wc * 32 + 8 * fq;
        f32x4 bv[2][2];
#pragma unroll
        for (int bj = 0; bj < 2; ++bj)
#pragma unroll
            for (int n = 0; n < 2; ++n) bv[bj][n] = (MODE == 1) ? *(const f32x4*)(bias + col0 + bj * HALF + 4 * n) : (f32x4){0.f, 0.f, 0.f, 0.f};
#pragma unroll
        for (int ai = 0; ai < 2; ++ai)
#pragma unroll
            for (int m = 0; m < 4; ++m) {
                const int row = row0 + ai * HALF + m * 16;
                bf16_t* rowp = O + (size_t)row * ldc + col0;
                float rs = 1.f;
                if (MODE == 3) { if (u.pn < 4) rs = rsqrtf(ssq[row] * (1.0f / 512.0f) + 1e-6f); }
#pragma unroll
                for (int bj = 0; bj < 2; ++bj) {
                    f32x4 v0 = acc[ai][bj][m][0] + bv[bj][0], v1 = acc[ai][bj][m][1] + bv[bj][1];
                    if (MODE == 1) {
#pragma unroll
                        for (int j = 0; j < 4; ++j) { v0[j] = sigmoidf_(v0[j]); v1[j] = sigmoidf_(v1[j]); }
                    }
                    if (MODE == 2) {
#pragma unroll
                        for (int j = 0; j < 4; ++j) { const float a = fmaxf(v0[j], 0.f), b = fmaxf(v1[j], 0.f); v0[j] = a * a; v1[j] = b * b; }
                    }
                    if (MODE == 3) {
                        const u32x4 gq = *(const u32x4*)(rowp + bj * HALF);
                        v0[0] *= bf_lo(gq.x) * rs; v0[1] *= bf_hi(gq.x) * rs; v0[2] *= bf_lo(gq.y) * rs; v0[3] *= bf_hi(gq.y) * rs;
                        v1[0] *= bf_lo(gq.z) * rs; v1[1] *= bf_hi(gq.z) * rs; v1[2] *= bf_lo(gq.w) * rs; v1[3] *= bf_hi(gq.w) * rs;
                    }
                    u32x4 w; w.x = cvt_pk_bf16(v0[0], v0[1]); w.y = cvt_pk_bf16(v0[2], v0[3]); w.z = cvt_pk_bf16(v1[0], v1[1]); w.w = cvt_pk_bf16(v1[2], v1[3]);
                    *(u32x4*)(rowp + bj * HALF) = w;
                }
            }
    }
};
struct EpiGlu {
    static constexpr bool PERM = true, AFTER_DRAIN = false;
    bf16_t* O; int ldc; int ocol; const float* bias;
    __device__ __forceinline__ void operator()(const f32x4 (&acc)[2][2][4][2], const Unit& u, int wr, int wc, int fr, int fq) const {
        const int row0 = u.pm * BM + wr * 64 + fr, cc = u.pn * HALF + wc * 32 + 8 * fq;
        f32x4 bv[2][2];
#pragma unroll
        for (int bj = 0; bj < 2; ++bj)
#pragma unroll
            for (int n = 0; n < 2; ++n) bv[bj][n] = *(const f32x4*)(bias + bj * 512 + cc + 4 * n);
#pragma unroll
        for (int ai = 0; ai < 2; ++ai)
#pragma unroll
            for (int m = 0; m < 4; ++m) {
                bf16_t* rowp = O + (size_t)(row0 + ai * HALF + m * 16) * ldc + ocol + cc;
                f32x4 v0 = acc[ai][0][m][0] + bv[0][0], v1 = acc[ai][0][m][1] + bv[0][1];
                const f32x4 g0 = acc[ai][1][m][0] + bv[1][0], g1 = acc[ai][1][m][1] + bv[1][1];
#pragma unroll
                for (int j = 0; j < 4; ++j) { v0[j] *= sigmoidf_(g0[j]); v1[j] *= sigmoidf_(g1[j]); }
                u32x4 w; w.x = cvt_pk_bf16(v0[0], v0[1]); w.y = cvt_pk_bf16(v0[2], v0[3]); w.z = cvt_pk_bf16(v1[0], v1[1]); w.w = cvt_pk_bf16(v1[2], v1[3]);
                *(u32x4*)rowp = w;
            }
    }
};
struct EpiRes {
    static constexpr bool PERM = false, AFTER_DRAIN = false;
    const float* base_ctx; const float* base_lat;
    float* out; const float* modv;
    int goff;
    __device__ __forceinline__ void operator()(const f32x4 (&acc)[2][2][4][2], const Unit& u, int wr, int wc, int fr, int fq) const {
        const int row0 = u.pm * BM + wr * 64 + fr, col0 = u.pn * BM + wc * 32 + 4 * fq;
        const int mi = (u.pm < 32) ? 0 : 1 + ((u.pm - 32) >> 2);
        const float* gv = modv + (size_t)mi * 6144 + goff;
        f32x4 gg[2][2];
#pragma unroll
        for (int bj = 0; bj < 2; ++bj)
#pragma unroll
            for (int n = 0; n < 2; ++n) gg[bj][n] = *(const f32x4*)(gv + col0 + bj * HALF + n * 16);
#pragma unroll
        for (int ai = 0; ai < 2; ++ai)
#pragma unroll
            for (int m = 0; m < 4; ++m) {
                const int row = row0 + ai * HALF + m * 16;
                const float* bp = (row < 8192 ? base_ctx + (size_t)row * 1024 : base_lat + (size_t)(row - 8192) * 1024) + col0;
                float* op = out + (size_t)row * 1024 + col0;
#pragma unroll
                for (int bj = 0; bj < 2; ++bj)
#pragma unroll
                    for (int n = 0; n < 2; ++n) { const f32x4 b = *(const f32x4*)(bp + bj * HALF + n * 16); *(f32x4*)(op + bj * HALF + n * 16) = b + gg[bj][n] * acc[ai][bj][m][n]; }
            }
    }
};

template <class Epi, class Sched, bool ALIGN_EPI = false, bool SP2 = false>
__device__ __forceinline__ void gemm_phase(PG8_LAS unsigned char* lds, const Gemm g, const Sched& S, const Epi& E, const int tid) {
    const int wid = __builtin_amdgcn_readfirstlane(tid >> 6), lane = tid & 63, wr = wid >> 2, wc = wid & 3, fr = lane & 15, fq = lane >> 4;
    const int K = g.K, nt = K / BK;
    unsigned voffA[2], voffB[2];
#pragma unroll
    for (int i = 0; i < 2; ++i) { int R, C; stage_rc(tid * 16 + i * 8192, R, C); const int Rb = Epi::PERM ? ((R & ~31) + perm32(R & 31)) : R;
        voffA[i] = (unsigned)(R * g.lda + C) * 2u; voffB[i] = (unsigned)(Rb * g.ldb + C) * 2u; }
    const size_t kstep = (size_t)(BK * 2);
    const size_t hstepA = (size_t)HALF * g.lda * 2, hstepB = (size_t)HALF * g.ldb * 2;
    const size_t tstepA = 2 * hstepA, tstepB = 2 * hstepB;
#define PG8_UA(u) ((const char*)g.A + (size_t)(u).pm * tstepA + (g.a_div ? (size_t)((u).pn / g.a_div) * g.a_gstride : (size_t)0))
#define PG8_UB(u) ((const char*)g.Bt + (size_t)(u).pn * tstepB)
    const unsigned ldsw = (unsigned)wid * 1024u;
    const int aoff = lds_byte(wr * 64 + fr, fq * 8), boff = lds_byte(wc * 32 + fr, fq * 8);
#define PG8_SA(b, h) (((b) * 2 + (h)) * HTB)
#define PG8_SB(b, h) ((4 + (b) * 2 + (h)) * HTB)
#define PG8_STAGE(bufoff, gbase, voff) do { _Pragma("unroll") for (int _i = 0; _i < 2; ++_i) \
        __builtin_amdgcn_global_load_lds((const unsigned*)((const char*)(gbase) + (voff)[_i]), (PG8_LAS unsigned*)(lds + (bufoff) + ldsw + _i * 8192), 16, 0, 0); } while (0)
#define PG8_LDA(dst, b, h) do { _Pragma("unroll") for (int m = 0; m < 4; ++m) _Pragma("unroll") for (int k = 0; k < 2; ++k) dst[m][k] = *(const PG8_LAS bf16x8*)(lds + PG8_SA(b, h) + aoff + m * 2048 + k * 1024); } while (0)
#define PG8_LDB(dst, b, h) do { _Pragma("unroll") for (int n = 0; n < 2; ++n) _Pragma("unroll") for (int k = 0; k < 2; ++k) dst[n][k] = *(const PG8_LAS bf16x8*)(lds + PG8_SB(b, h) + boff + n * 2048 + k * 1024); } while (0)
#define PG8_MMA(ai, bj, At, Bt) do { __builtin_amdgcn_s_setprio(1); _Pragma("unroll") for (int m = 0; m < 4; ++m) _Pragma("unroll") for (int n = 0; n < 2; ++n) _Pragma("unroll") for (int k = 0; k < 2; ++k) \
        acc[ai][bj][m][n] = __builtin_amdgcn_mfma_f32_16x16x32_bf16(Bt[n][k], At[m][k], acc[ai][bj][m][n], 0, 0, 0); __builtin_amdgcn_s_setprio(0); } while (0)
#define PG8_WAIT_V(n) asm volatile("s_waitcnt vmcnt(" #n ")" ::: "memory")
#define PG8_WAIT_L(n) asm volatile("s_waitcnt lgkmcnt(" #n ")" ::: "memory")
#define PG8_BAR __builtin_amdgcn_s_barrier()
#define PG8_SCHED __builtin_amdgcn_sched_barrier(0)
    Unit cur, nxt; int ui = 0;
    if (!S.next(0, cur)) return;
    f32x4 acc[2][2][4][2];
#pragma unroll
    for (int a = 0; a < 2; ++a)
#pragma unroll
        for (int b = 0; b < 2; ++b)
#pragma unroll
            for (int m = 0; m < 4; ++m)
#pragma unroll
                for (int n = 0; n < 2; ++n) acc[a][b][m][n] = (f32x4){0.f, 0.f, 0.f, 0.f};
    bf16x8 At[4][2], B0[2][2], B1[2][2];
    const char* cA = PG8_UA(cur); const char* cB = PG8_UB(cur);
    S.a_ready(cur);
    if constexpr (SP2) {
        PG8_STAGE(PG8_SB(0, 0), cB, voffB); PG8_STAGE(PG8_SB(0, 1), cB + hstepB, voffB); PG8_STAGE(PG8_SA(0, 0), cA, voffA); PG8_STAGE(PG8_SA(0, 1), cA + hstepA, voffA);
        if (wr == 1) PG8_BAR;
        PG8_WAIT_V(2); PG8_BAR;
        PG8_STAGE(PG8_SB(1, 0), cB + kstep, voffB); PG8_STAGE(PG8_SA(1, 0), cA + kstep, voffA); PG8_STAGE(PG8_SB(1, 1), cB + hstepB + kstep, voffB);
        PG8_WAIT_V(6); PG8_BAR;
    } else {
        PG8_STAGE(PG8_SB(0, 0), cB, voffB); PG8_STAGE(PG8_SA(0, 0), cA, voffA); PG8_STAGE(PG8_SB(0, 1), cB + hstepB, voffB); PG8_STAGE(PG8_SA(0, 1), cA + hstepA, voffA);
        if (wr == 1) PG8_BAR;
        PG8_WAIT_V(4); PG8_BAR;
        PG8_STAGE(PG8_SB(1, 0), cB + kstep, voffB); PG8_STAGE(PG8_SA(1, 0), cA + kstep, voffA); PG8_STAGE(PG8_SB(1, 1), cB + hstepB + kstep, voffB);
        PG8_WAIT_V(6); PG8_BAR;
    }
    for (;;) {
        const bool has_next = S.next(ui + 1, nxt);
        const char* nA = has_next ? PG8_UA(nxt) : cA; const char* nB = has_next ? PG8_UB(nxt) : cB;
        for (int t = 0; t < nt; t += 2) {
            const bool last = (t == nt - 2);
            const char* a1 = cA + (size_t)(t + 1) * kstep;
            const char* a2 = last ? nA : cA + (size_t)(t + 2) * kstep; const char* b2 = last ? nB : cB + (size_t)(t + 2) * kstep;
            const char* a3 = a2 + kstep; const char* b3 = b2 + kstep;
            if (last && has_next) S.a_ready(nxt);
            if constexpr (SP2) {
            PG8_LDB(B0, 0, 0); PG8_LDB(B1, 0, 1); PG8_SCHED; PG8_LDA(At, 0, 0); PG8_STAGE(PG8_SA(1, 1), a1 + hstepA, voffA);
            PG8_WAIT_V(8); PG8_WAIT_L(0); PG8_BAR; PG8_MMA(0, 0, At, B0); PG8_MMA(0, 1, At, B1); PG8_BAR; PG8_SCHED;
            PG8_LDA(At, 0, 1); PG8_STAGE(PG8_SB(0, 0), b2, voffB); PG8_STAGE(PG8_SB(0, 1), b2 + hstepB, voffB); PG8_STAGE(PG8_SA(0, 0), a2, voffA);
            PG8_WAIT_V(8); PG8_WAIT_L(0); PG8_BAR; PG8_MMA(1, 0, At, B0); PG8_MMA(1, 1, At, B1); PG8_BAR; PG8_SCHED;
            PG8_LDB(B0, 1, 0); PG8_LDB(B1, 1, 1); PG8_SCHED; PG8_LDA(At, 1, 0); PG8_STAGE(PG8_SA(0, 1), a2 + hstepA, voffA);
            PG8_WAIT_V(8); PG8_WAIT_L(0); PG8_BAR; PG8_MMA(0, 0, At, B0); PG8_MMA(0, 1, At, B1); PG8_BAR; PG8_SCHED;
            PG8_LDA(At, 1, 1); PG8_STAGE(PG8_SB(1, 0), b3, voffB); PG8_STAGE(PG8_SB(1, 1), b3 + hstepB, voffB); PG8_STAGE(PG8_SA(1, 0), a3, voffA);
            PG8_WAIT_V(8); PG8_WAIT_L(0); PG8_BAR; PG8_MMA(1, 0, At, B0); PG8_MMA(1, 1, At, B1); PG8_BAR; PG8_SCHED;
            } else {
            PG8_LDB(B0, 0, 0); PG8_SCHED; PG8_LDA(At, 0, 0); PG8_STAGE(PG8_SA(1, 1), a1 + hstepA, voffA);
            PG8_WAIT_L(8); PG8_BAR; PG8_WAIT_L(0); PG8_MMA(0, 0, At, B0); PG8_BAR; PG8_SCHED;
            PG8_LDB(B1, 0, 1); PG8_STAGE(PG8_SB(0, 0), b2, voffB);
            PG8_BAR; PG8_WAIT_L(0); PG8_MMA(0, 1, At, B1); PG8_BAR;
            PG8_LDA(At, 0, 1); PG8_STAGE(PG8_SA(0, 0), a2, voffA);
            PG8_BAR; PG8_WAIT_L(0); PG8_MMA(1, 0, At, B0); PG8_BAR; PG8_SCHED;
            PG8_STAGE(PG8_SB(0, 1), b2 + hstepB, voffB);
            PG8_WAIT_V(6); PG8_BAR; PG8_MMA(1, 1, At, B1); PG8_BAR;
            PG8_LDB(B0, 1, 0); PG8_SCHED; PG8_LDA(At, 1, 0); PG8_STAGE(PG8_SA(0, 1), a2 + hstepA, voffA);
            PG8_WAIT_L(8); PG8_BAR; PG8_WAIT_L(0); PG8_MMA(0, 0, At, B0); PG8_BAR; PG8_SCHED;
            PG8_LDB(B1, 1, 1); PG8_STAGE(PG8_SB(1, 0), b3, voffB);
            PG8_BAR; PG8_WAIT_L(0); PG8_MMA(0, 1, At, B1); PG8_BAR;
            PG8_LDA(At, 1, 1); PG8_STAGE(PG8_SA(1, 0), a3, voffA);
            PG8_BAR; PG8_WAIT_L(0); PG8_MMA(1, 0, At, B0); PG8_BAR; PG8_SCHED;
            PG8_STAGE(PG8_SB(1, 1), b3 + hstepB, voffB);
            PG8_WAIT_V(6); PG8_BAR; PG8_MMA(1, 1, At, B1); PG8_BAR;
            }
        }
        if constexpr (ALIGN_EPI) { if (wr == 0) PG8_BAR; }
        if constexpr (!Epi::AFTER_DRAIN) { E(acc, cur, wr, wc, fr, fq); S.done(cur); }
        if (!has_next) break;
#pragma unroll
        for (int a = 0; a < 2; ++a)
#pragma unroll
            for (int b = 0; b < 2; ++b)
#pragma unroll
                for (int m = 0; m < 4; ++m)
#pragma unroll
                    for (int n = 0; n < 2; ++n) acc[a][b][m][n] = (f32x4){0.f, 0.f, 0.f, 0.f};
        cur = nxt; cA = nA; cB = nB; ++ui;
        if constexpr (ALIGN_EPI) { if (wr == 1) PG8_BAR; }
    }
    PG8_WAIT_V(0);
    if constexpr (!ALIGN_EPI) { if (wr == 0) PG8_BAR; }
    PG8_BAR;
    if constexpr (Epi::AFTER_DRAIN) { E.fused(acc, cur, wr, wc, fr, fq, lds, wid, lane); S.done(cur); }
#undef PG8_UA
#undef PG8_UB
#undef PG8_SA
#undef PG8_SB
#undef PG8_STAGE
#undef PG8_LDA
#undef PG8_LDB
#undef PG8_MMA
#undef PG8_WAIT_V
#undef PG8_WAIT_L
#undef PG8_BAR
#undef PG8_SCHED
}
}

#ifndef PG8_SP2
#define PG8_SP2 true
#endif
#ifndef PG8_ALIGN
#define PG8_ALIGN true
#endif

typedef unsigned short bf16;
typedef unsigned v4u __attribute__((ext_vector_type(4)));
typedef unsigned v2u __attribute__((ext_vector_type(2)));
typedef float f32x4 __attribute__((ext_vector_type(4)));
#define LAS __attribute__((address_space(3)))

constexpr int NWAVES = 8, NTHR = 512;
constexpr int D = 1024, MC = 8192, ML = 4096, M = 12288, NPH = 23;
constexpr int LDS_BYTES = 147456;
constexpr float EPS = 1e-6f;
constexpr size_t MiB = 1u << 20;
constexpr size_t WS_MOD = 64 * 1024;
constexpr size_t WS_SSQ = 320 * 1024;
constexpr size_t WS_DT = 384 * 1024;
constexpr size_t WS_W = 2 * MiB;
constexpr size_t W_IN = WS_W, W_G = W_IN + 8 * MiB, W_GLU = W_G + 8 * MiB, W_BR = W_GLU + 1 * MiB, W_OUT = W_BR + 4 * MiB, W_1 = W_OUT + 2 * MiB, W_2 = W_1 + 8 * MiB;
constexpr size_t WS_H = 41 * MiB;
constexpr size_t WS_R1 = 65 * MiB;
constexpr size_t WS_Y = 161 * MiB;
constexpr size_t WS_Y5 = 209 * MiB;
constexpr size_t WS_XC = 221 * MiB;
constexpr size_t WS_YF = 239 * MiB;
constexpr size_t WS_CKV = 251 * MiB;
constexpr size_t WS_END = 254 * MiB;
#ifndef PROBE_SEL
#define PROBE_SEL -1
#endif
#ifndef PROBE_PB
#define PROBE_PB 32
#endif
constexpr size_t WS_TS = 16 * 1024;
constexpr size_t O_SSD = 12582912, O_S5 = 16777216, O_DK = 17301504, O_DV = 25690112, O_WK = 34078720, O_WV = 36175872;
constexpr int C_Z = 0, C_XBC = 512, C_U = 1280, C_DQ = 1792, C_DK = 2304, C_DV = 2816, C_WQ = 3328, C_WK = 3840, C_WV = 3968;

struct Args { const float* in[44]; float* out; unsigned char* ws; int ph_lo, ph_hi; };

typedef const Args __attribute__((address_space(4)))* CArgs;
struct Ctx {
    CArgs ap; int tid, lane, wave;
    __device__ __forceinline__ const float* x_prompt() const { return ap->in[0]; }
    __device__ __forceinline__ const float* x_sample() const { return ap->in[1]; }
    __device__ __forceinline__ const float* state_ssd() const { return ap->in[2]; }
    __device__ __forceinline__ const float* state_s5() const { return ap->in[3]; }
    __device__ __forceinline__ const float* cache_dk() const { return ap->in[4]; }
    __device__ __forceinline__ const float* cache_dv() const { return ap->in[5]; }
    __device__ __forceinline__ const float* cache_wk() const { return ap->in[6]; }
    __device__ __forceinline__ const float* cache_wv() const { return ap->in[7]; }
    __device__ __forceinline__ const float* cvec() const { return ap->in[8]; }
    __device__ __forceinline__ const float* c_ctx() const { return ap->in[9]; }
    __device__ __forceinline__ const float* w_mod() const { return ap->in[10]; }
    __device__ __forceinline__ const float* b_mod() const { return ap->in[11]; }
    __device__ __forceinline__ const float* g_norm1() const { return ap->in[12]; }
    __device__ __forceinline__ const float* g_norm2() const { return ap->in[13]; }
    __device__ __forceinline__ const float* w_in() const { return ap->in[14]; }
    __device__ __forceinline__ const float* conv_w() const { return ap->in[15]; }
    __device__ __forceinline__ const float* conv_b() const { return ap->in[16]; }
    __device__ __forceinline__ const float* dt_bias() const { return ap->in[17]; }
    __device__ __forceinline__ const float* a_log() const { return ap->in[18]; }
    __device__ __forceinline__ const float* ssd_d() const { return ap->in[19]; }
    __device__ __forceinline__ const float* ssd_norm_g() const { return ap->in[20]; }
    __device__ __forceinline__ const float* lam_re() const { return ap->in[21]; }
    __device__ __forceinline__ const float* lam_im() const { return ap->in[22]; }
    __device__ __forceinline__ const float* log_step() const { return ap->in[23]; }
    __device__ __forceinline__ const float* b_re() const { return ap->in[24]; }
    __device__ __forceinline__ const float* b_im() const { return ap->in[25]; }
    __device__ __forceinline__ const float* c_re() const { return ap->in[26]; }
    __device__ __forceinline__ const float* c_im() const { return ap->in[27]; }
    __device__ __forceinline__ const float* s5_d() const { return ap->in[28]; }
    __device__ __forceinline__ const float* w_glu() const { return ap->in[29]; }
    __device__ __forceinline__ const float* b_glu() const { return ap->in[30]; }
    __device__ __forceinline__ const float* qn_g() const { return ap->in[31]; }
    __device__ __forceinline__ const float* kn_g() const { return ap->in[32]; }
    __device__ __forceinline__ const float* dlam() const { return ap->in[33]; }
    __device__ __forceinline__ const float* subln_g() const { return ap->in[34]; }
    __device__ __forceinline__ const float* wqn_g() const { return ap->in[35]; }
    __device__ __forceinline__ const float* wkn_g() const { return ap->in[36]; }
    __device__ __forceinline__ const float* sink() const { return ap->in[37]; }
    __device__ __forceinline__ const float* w_branch() const { return ap->in[38]; }
    __device__ __forceinline__ const float* w_gate() const { return ap->in[39]; }
    __device__ __forceinline__ const float* b_gate() const { return ap->in[40]; }
    __device__ __forceinline__ const float* w_out() const { return ap->in[41]; }
    __device__ __forceinline__ const float* w_fc1() const { return ap->in[42]; }
    __device__ __forceinline__ const float* w_fc2() const { return ap->in[43]; }
    __device__ __forceinline__ float* out() const { return ap->out; }
    __device__ __forceinline__ unsigned char* ws() const { return ap->ws; }
    __device__ __forceinline__ float* MOD() const { return (float*)(ap->ws + WS_MOD); }
    __device__ __forceinline__ float* SSQ() const { return (float*)(ap->ws + WS_SSQ); }
    __device__ __forceinline__ float* DT() const { return (float*)(ap->ws + WS_DT); }
    __device__ __forceinline__ bf16* H() const { return (bf16*)(ap->ws + WS_H); }
    __device__ __forceinline__ bf16* R1() const { return (bf16*)(ap->ws + WS_R1); }
    __device__ __forceinline__ bf16* Y() const { return (bf16*)(ap->ws + WS_Y); }
    __device__ __forceinline__ bf16* Y5() const { return (bf16*)(ap->ws + WS_Y5); }
    __device__ __forceinline__ bf16* XC() const { return (bf16*)(ap->ws + WS_XC); }
    __device__ __forceinline__ bf16* YF() const { return (bf16*)(ap->ws + WS_YF); }
    __device__ __forceinline__ bf16* CKV() const { return (bf16*)(ap->ws + WS_CKV); }
};

__device__ __forceinline__ float wave_sum(float v) {
#pragma unroll
    for (int o = 1; o < 64; o <<= 1) v += __shfl_xor(v, o);
    return v;
}
__device__ __forceinline__ float wave_max(float v) {
#pragma unroll
    for (int o = 1; o < 64; o <<= 1) v = fmaxf(v, __shfl_xor(v, o));
    return v;
}
__device__ __forceinline__ float bf2f(bf16 h) { return __builtin_bit_cast(float, (unsigned)h << 16); }
__device__ __forceinline__ float bflo(unsigned w) { return __builtin_bit_cast(float, w << 16); }
__device__ __forceinline__ float bfhi(unsigned w) { return __builtin_bit_cast(float, w & 0xffff0000u); }
__device__ __forceinline__ unsigned f2bf(float f) { unsigned u = __builtin_bit_cast(unsigned, f); return (u + 0x7fffu + ((u >> 16) & 1u)) >> 16; }
__device__ __forceinline__ unsigned pk2(float lo, float hi) { return f2bf(lo) | (f2bf(hi) << 16); }
__device__ __forceinline__ float siluf(float x) { return x / (1.0f + __expf(-x)); }
__device__ __forceinline__ void unpack8(const v4u q, float (&f)[8]) { f[0] = bflo(q.x); f[1] = bfhi(q.x); f[2] = bflo(q.y); f[3] = bfhi(q.y); f[4] = bflo(q.z); f[5] = bfhi(q.z); f[6] = bflo(q.w); f[7] = bfhi(q.w); }

__device__ __forceinline__ void phase_mods(const Ctx& c, float* lf) {
    for (int i = c.tid; i < 5 * 1024; i += NTHR) { const int v = i >> 10, k = i & 1023; const float x = (v == 0) ? c.c_ctx()[k] : c.cvec()[(v - 1) * 1024 + k]; lf[i] = siluf(x); }
    __syncthreads();
    float* red = lf + 5 * 1024;
    for (int u = blockIdx.x; u < 192; u += gridDim.x) {
        const int l = u / 96, col0 = (u % 96) * 64;
        const float* W = c.w_mod() + (size_t)l * 1024 * 6144 + col0 + c.lane;
        float acc[5] = {0.f, 0.f, 0.f, 0.f, 0.f};
#pragma unroll 8
        for (int k = c.wave * 128; k < c.wave * 128 + 128; ++k) { const float wv = W[(size_t)k * 6144];
#pragma unroll
            for (int i = 0; i < 5; ++i) acc[i] += lf[i * 1024 + k] * wv; }
#pragma unroll
        for (int i = 0; i < 5; ++i) red[(c.wave * 5 + i) * 64 + c.lane] = acc[i];
        __syncthreads();
        if (c.tid < 320) { const int i = c.tid >> 6, ln = c.tid & 63; float s = c.b_mod()[l * 6144 + col0 + ln];
#pragma unroll
            for (int w = 0; w < 8; ++w) s += red[(w * 5 + i) * 64 + ln];
            c.MOD()[(size_t)(l * 5 + i) * 6144 + col0 + ln] = s; }
        __syncthreads();
    }
}

__device__ __forceinline__ int cmap(int mode, int n) { return mode == 0 ? n : (mode == 1 ? (n < 1280 ? n : n + 16) : ((n & 255) < 128 ? 128 * (n >> 8) + (n & 127) : 512 + 128 * (n >> 8) + (n & 127))); }
__device__ __forceinline__ void transpose_item(const float* W, int ld, int K, int N, int mode, const float* rowscale, bf16* WT, float* scr, int item, int lane) {
    const int nblk = N / 32, kb = item / nblk, nb = item % nblk, k0 = 64 * kb, n0 = 32 * nb, sc0 = cmap(mode, n0);
#pragma unroll 8
    for (int i = 0; i < 32; ++i) { const int kk = 2 * i + (lane >> 5); float v = W[(size_t)(k0 + kk) * ld + sc0 + (lane & 31)]; if (rowscale) v *= rowscale[k0 + kk]; scr[kk * 33 + (lane & 31)] = v; }
    __builtin_amdgcn_fence(__ATOMIC_RELEASE, "wavefront"); __builtin_amdgcn_wave_barrier();
    const int ch = lane & 7;
#pragma unroll
    for (int j = 0; j < 4; ++j) { const int n = (lane >> 3) + 8 * j; const float* s = scr + (8 * ch) * 33 + n;
        v4u o; o.x = pk2(s[0 * 33], s[1 * 33]); o.y = pk2(s[2 * 33], s[3 * 33]); o.z = pk2(s[4 * 33], s[5 * 33]); o.w = pk2(s[6 * 33], s[7 * 33]);
        *(v4u*)(WT + (size_t)(n0 + n) * K + k0 + 8 * ch) = o; }
    __builtin_amdgcn_fence(__ATOMIC_RELEASE, "wavefront"); __builtin_amdgcn_wave_barrier();
}
__device__ __forceinline__ void phase_convert(const Ctx& c, int l, float* lf) {
    float* scr = lf + c.wave * 2176;
    const int gw = blockIdx.x * NWAVES + c.wave, NGW = gridDim.x * NWAVES;
    unsigned char* ws = c.ws();
    for (int it = gw; it < 9984; it += NGW) {
        int r = it;
        if (r < 2048) { transpose_item(c.w_in() + (size_t)l * 1024 * 4112, 4112, 1024, 4096, 1, nullptr, (bf16*)(ws + W_IN), scr, r, c.lane); continue; } r -= 2048;
        if (r < 2048) { transpose_item(c.w_gate() + (size_t)l * 1024 * 4096, 4096, 1024, 4096, 0, nullptr, (bf16*)(ws + W_G), scr, r, c.lane); continue; } r -= 2048;
        if (r < 256) { transpose_item(c.w_glu() + (size_t)l * 512 * 1024, 1024, 512, 1024, 2, nullptr, (bf16*)(ws + W_GLU), scr, r, c.lane); continue; } r -= 256;
        if (r < 1024) { const int i = r >> 8; transpose_item(c.w_branch() + (size_t)(l * 4 + i) * 512 * 1024, 1024, 512, 1024, 0, i == 0 ? c.ssd_norm_g() + l * 512 : nullptr, (bf16*)(ws + W_BR) + (size_t)i * 1024 * 512, scr, r & 255, c.lane); continue; } r -= 1024;
        if (r < 512) { transpose_item(c.w_out() + (size_t)l * 1024 * 1024, 1024, 1024, 1024, 0, nullptr, (bf16*)(ws + W_OUT), scr, r, c.lane); continue; } r -= 512;
        if (r < 2048) { transpose_item(c.w_fc1() + (size_t)l * 1024 * 4096, 4096, 1024, 4096, 0, nullptr, (bf16*)(ws + W_1), scr, r, c.lane); continue; } r -= 2048;
        transpose_item(c.w_fc2() + (size_t)l * 4096 * 1024, 1024, 4096, 1024, 0, nullptr, (bf16*)(ws + W_2), scr, r, c.lane);
    }
}

__device__ __forceinline__ void phase_norm(const Ctx& c, int l, int which, float* lf) {
    if (which == 0) {
        for (int i = c.tid; i < 16384; i += NTHR) { const int k = i >> 4, j = i & 15; lf[j * 1024 + k] = c.w_in()[(size_t)l * 1024 * 4112 + (size_t)k * 4112 + 1280 + j]; }
        __syncthreads();
    }
    const int gw = blockIdx.x * NWAVES + c.wave, NGW = gridDim.x * NWAVES;
    const float* gn = (which == 0 ? c.g_norm1() : c.g_norm2()) + l * 1024;
    for (int m = gw; m < M; m += NGW) {
        const float* xr = (l == 0 && which == 0) ? (m < MC ? c.x_prompt() + (size_t)m * D : c.x_sample() + (size_t)(m - MC) * D) : c.out() + (size_t)m * D;
        const int mi = (m < MC) ? 0 : 1 + ((m - MC) >> 10);
        const float* mod = c.MOD() + (size_t)(l * 5 + mi) * 6144 + which * 3072;
        f32x4 v[4]; float s = 0.f;
#pragma unroll
        for (int j = 0; j < 4; ++j) { v[j] = *(const f32x4*)(xr + 4 * c.lane + 256 * j); s += (v[j].x * v[j].x + v[j].y * v[j].y) + (v[j].z * v[j].z + v[j].w * v[j].w); }
        const float rstd = rsqrtf(wave_sum(s) * (1.0f / D) + EPS);
#pragma unroll
        for (int j = 0; j < 4; ++j) { const int k = 4 * c.lane + 256 * j; const f32x4 g = *(const f32x4*)(gn + k), sh = *(const f32x4*)(mod + k), sc = *(const f32x4*)(mod + 1024 + k);
            v[j] = v[j] * rstd * g * (sc + 1.0f) + sh;
            v2u o; o.x = pk2(v[j].x, v[j].y); o.y = pk2(v[j].z, v[j].w); *(v2u*)(c.H() + (size_t)m * D + k) = o; }
        if (which == 0) {
            float mine = 0.f;
#pragma unroll 1
            for (int jj = 0; jj < 16; ++jj) { float a = 0.f;
#pragma unroll
                for (int j = 0; j < 4; ++j) { const f32x4 w = *(const f32x4*)(lf + jj * 1024 + 4 * c.lane + 256 * j); a += (v[j].x * w.x + v[j].y * w.y) + (v[j].z * w.z + v[j].w * w.w); }
                a = wave_sum(a); if (c.lane == jj) mine = a; }
            if (c.lane < 16) { const float x = mine + c.dt_bias()[l * 16 + c.lane]; c.DT()[(size_t)m * 16 + c.lane] = x > 20.f ? x : log1pf(__expf(x)); }
            if (c.lane == 0) c.SSQ()[m] = 0.f;
        }
    }
}

__device__ __forceinline__ void phase_qk(const Ctx& c, int l) {
    const int gw = blockIdx.x * NWAVES + c.wave, NGW = gridDim.x * NWAVES, lane = c.lane;
    const float gq = c.qn_g()[l * 64 + lane], gk = c.kn_g()[l * 64 + lane], gwq = c.wqn_g()[l * 64 + lane], gwk = c.wkn_g()[l * 64 + lane];
    for (int m = gw; m < M; m += NGW) {
        bf16* pr = c.R1() + (size_t)m * 4096;
        const bool lat = m >= MC;
        const int b = lat ? (m - MC) >> 10 : m >> 8, t = lat ? (m - MC) & 1023 : m & 255, L = lat ? 1024 : 256;
        float cs = 1.f, sn = 0.f;
        if (lat) { const int f = lane & 15; const float inv = exp2f(-(float)f * 0.8304820237218406f); const float ang = (float)((lane >> 5) ? (t & 63) : (t >> 6)) * inv; sincosf(ang, &sn, &cs); if (!((lane >> 4) & 1)) sn = -sn; }
        const size_t ob = (size_t)(b * 2 + l) * 256 + t;
#pragma unroll 1
        for (int gi = 0; gi < 26; ++gi) {
            const int col = gi < 8 ? C_DQ + gi * 64 : gi < 16 ? C_DK + (gi - 8) * 64 : gi < 24 ? C_WQ + (gi - 16) * 64 : C_WK + (gi - 24) * 64;
            const float gain = gi < 8 ? gq : gi < 16 ? gk : gi < 24 ? gwq : gwk;
            float v = bf2f(pr[col + lane]);
            const float ss = wave_sum(v * v);
            v = v * rsqrtf(ss * (1.0f / 64.0f) + EPS) * gain;
            if (lat) { const float p = __shfl_xor(v, 16); v = v * cs + p * sn; }
            pr[col + lane] = (bf16)f2bf(v);
            if (!lat) {
                if (gi >= 8 && gi < 16) c.out()[O_DK + ob * 512 + (gi - 8) * 64 + lane] = v;
                if (gi >= 24) c.out()[O_WK + ob * 128 + (gi - 24) * 64 + lane] = v;
            }
        }
        if (!lat) {
#pragma unroll
            for (int i = 0; i < 8; ++i) c.out()[O_DV + ob * 512 + i * 64 + lane] = bf2f(pr[C_DV + i * 64 + lane]);
#pragma unroll
            for (int i = 0; i < 2; ++i) c.out()[O_WV + ob * 128 + i * 64 + lane] = bf2f(pr[C_WV + i * 64 + lane]);
        }
#pragma unroll 1
        for (int i = 0; i < 12; ++i) { const int ch = lane + 64 * i; float a = c.conv_b()[l * 768 + ch];
#pragma unroll
            for (int j = 0; j < 7; ++j) { const int tt = t + j - 3; if (tt >= 0 && tt < L) a += c.conv_w()[(size_t)(l * 7 + j) * 768 + ch] * bf2f(c.R1()[(size_t)(m + j - 3) * 4096 + C_XBC + ch]); }
            c.XC()[(size_t)m * 768 + ch] = (bf16)f2bf(siluf(a)); }
    }
    for (int r = gw; r < 1024; r += NGW) { const int b = r >> 8, sidx = r & 255; const size_t cb = (size_t)(b * 2 + l) * 256 + sidx; bf16* dst = c.CKV() + (size_t)r * 1280;
        for (int i = lane; i < 1280; i += 64) { const float v = i < 512 ? c.cache_dk()[cb * 512 + i] : i < 1024 ? c.cache_dv()[cb * 512 + i - 512] : i < 1152 ? c.cache_wk()[cb * 128 + i - 1024] : c.cache_wv()[cb * 128 + i - 1152]; dst[i] = (bf16)f2bf(v); } }
}

typedef pg8::bf16x8 bx8;
#define MFMA16(a, b, cc) __builtin_amdgcn_mfma_f32_16x16x32_bf16((a), (b), (cc), 0, 0, 0)
__device__ __forceinline__ void ssd_unit(const Ctx& c, int l, int pass, int b, int h, unsigned char* lds) {
    const int L = pass ? 1024 : 256, tok0 = pass ? MC + b * 1024 : b * 256, NCH = L >> 7;
    const int tid = c.tid, lane = c.lane, w = c.wave, lr = lane & 15, lq = lane >> 4, grp = h >> 2;
    bf16* XT = (bf16*)lds;
    bf16* BwT = XT + 64 * 136;
    bf16* Bm = BwT + 64 * 136;
    bf16* Cm = Bm + 128 * 72;
    bf16* Mm = Cm + 128 * 72;
    bf16* ST = Mm + 128 * 136;
    float* cum = (float*)(ST + 64 * 72);
    float* dtv = cum + 128; float* wv = dtv + 128; float* ecum = wv + 128; float* tot = ecum + 128;
    const float dsk = c.ssd_d()[l * 8 + h];
    const bf16* XCp = c.XC(); const float* DTp = c.DT(); bf16* YFp = c.YF(); bf16* Yp = c.Y(); const bf16* R1p = c.R1(); float* SSQp = c.SSQ();
    const int pi = w >> 1, nj0 = 2 * (w & 1);
    for (int dir = 0; dir < 2; ++dir) {
        const float A = -__expf(c.a_log()[(l * 2 + dir) * 8 + h]);
        f32x4 Sacc[2];
        __syncthreads();
#pragma unroll
        for (int q = 0; q < 2; ++q)
#pragma unroll
            for (int r = 0; r < 4; ++r) { const int p = 16 * pi + 4 * lq + r, n = 16 * (nj0 + q) + lr;
                const float v = pass ? c.state_ssd()[(((((size_t)(b * 2 + l) * 2 + dir) * 8 + h) * 64 + p) * 64) + n] : 0.f;
                Sacc[q][r] = v; ST[p * 72 + n] = (bf16)f2bf(v); }
        for (int ci = 0; ci < NCH; ++ci) {
            __syncthreads();
            const int i = tid >> 2, part = tid & 3;
            float bvals[16];
            { const int t = dir ? L - 1 - (ci * 128 + i) : ci * 128 + i; const bf16* xr = XCp + (size_t)(tok0 + t) * 768;
              const v4u x0 = *(const v4u*)(xr + h * 64 + part * 16), x1 = *(const v4u*)(xr + h * 64 + part * 16 + 8);
              const v4u b0 = *(const v4u*)(xr + 512 + grp * 64 + part * 16), b1 = *(const v4u*)(xr + 512 + grp * 64 + part * 16 + 8);
              const v4u c0 = *(const v4u*)(xr + 640 + grp * 64 + part * 16), c1 = *(const v4u*)(xr + 640 + grp * 64 + part * 16 + 8);
              *(v4u*)(Bm + i * 72 + part * 16) = b0; *(v4u*)(Bm + i * 72 + part * 16 + 8) = b1;
              *(v4u*)(Cm + i * 72 + part * 16) = c0; *(v4u*)(Cm + i * 72 + part * 16 + 8) = c1;
              const unsigned xs[8] = {x0.x, x0.y, x0.z, x0.w, x1.x, x1.y, x1.z, x1.w};
#pragma unroll
              for (int j = 0; j < 8; ++j) { XT[(part * 16 + 2 * j) * 136 + i] = (bf16)(xs[j] & 0xffffu); XT[(part * 16 + 2 * j + 1) * 136 + i] = (bf16)(xs[j] >> 16); }
              float t8[8]; unpack8(b0, t8);
#pragma unroll
              for (int j = 0; j < 8; ++j) bvals[j] = t8[j];
              unpack8(b1, t8);
#pragma unroll
              for (int j = 0; j < 8; ++j) bvals[8 + j] = t8[j]; }
            if (tid < 64) {
                const int i0 = 2 * lane, i1 = i0 + 1;
                const int t0 = dir ? L - 1 - (ci * 128 + i0) : ci * 128 + i0, t1 = dir ? L - 1 - (ci * 128 + i1) : ci * 128 + i1;
                const float d0 = DTp[(size_t)(tok0 + t0) * 16 + dir * 8 + h], d1 = DTp[(size_t)(tok0 + t1) * 16 + dir * 8 + h];
                const float a0 = d0 * A, a1 = d1 * A; float s = a0 + a1;
#pragma unroll
                for (int o = 1; o < 64; o <<= 1) { const float v = __shfl_up(s, o); if (lane >= o) s += v; }
                const float cum1 = s, cum0 = s - a1, total = __shfl(s, 63);
                cum[i0] = cum0; cum[i1] = cum1; dtv[i0] = d0; dtv[i1] = d1;
                wv[i0] = __expf(total - cum0) * d0; wv[i1] = __expf(total - cum1) * d1; ecum[i0] = __expf(cum0); ecum[i1] = __expf(cum1);
                if (lane == 0) tot[0] = __expf(total);
            }
            __syncthreads();
            { const float wi = wv[i];
#pragma unroll
              for (int j = 0; j < 16; ++j) BwT[(part * 16 + j) * 136 + i] = (bf16)f2bf(bvals[j] * wi); }
            bx8 cfr[2];
#pragma unroll
            for (int ks = 0; ks < 2; ++ks) cfr[ks] = *(const bx8*)(Cm + (16 * w + lr) * 72 + 32 * ks + 8 * lq);
            for (int j = 0; j <= w; ++j) {
                const bx8 b0 = *(const bx8*)(Bm + (16 * j + lr) * 72 + 8 * lq), b1 = *(const bx8*)(Bm + (16 * j + lr) * 72 + 32 + 8 * lq);
                f32x4 g = {0.f, 0.f, 0.f, 0.f};
                g = MFMA16(cfr[0], b0, g); g = MFMA16(cfr[1], b1, g);
                const int s = 16 * j + lr; const float cs = cum[s], ds = dtv[s];
#pragma unroll
                for (int r = 0; r < 4; ++r) { const int tt = 16 * w + 4 * lq + r; const float v = (s <= tt) ? g[r] * __expf(cum[tt] - cs) * ds : 0.f; Mm[tt * 136 + s] = (bf16)f2bf(v); }
            }
            if (!(w & 1)) {
#pragma unroll
                for (int r = 0; r < 4; ++r) Mm[(16 * w + 4 * lq + r) * 136 + 16 * (w + 1) + lr] = 0;
            }
            __syncthreads();
            f32x4 yl[4], yo[4];
#pragma unroll
            for (int jp = 0; jp < 4; ++jp) { yl[jp] = (f32x4){0.f, 0.f, 0.f, 0.f}; yo[jp] = (f32x4){0.f, 0.f, 0.f, 0.f}; }
            for (int ks = 0; ks <= (w >> 1); ++ks) {
                const bx8 af = *(const bx8*)(Mm + (16 * w + lr) * 136 + 32 * ks + 8 * lq);
#pragma unroll
                for (int jp = 0; jp < 4; ++jp) { const bx8 xf = *(const bx8*)(XT + (16 * jp + lr) * 136 + 32 * ks + 8 * lq); yl[jp] = MFMA16(af, xf, yl[jp]); }
            }
#pragma unroll
            for (int ks = 0; ks < 2; ++ks)
#pragma unroll
                for (int jp = 0; jp < 4; ++jp) { const bx8 sf = *(const bx8*)(ST + (16 * jp + lr) * 72 + 32 * ks + 8 * lq); yo[jp] = MFMA16(cfr[ks], sf, yo[jp]); }
            {
                float ssq[4] = {0.f, 0.f, 0.f, 0.f};
#pragma unroll
                for (int r = 0; r < 4; ++r) {
                    const int tt = 16 * w + 4 * lq + r; const float ec = ecum[tt];
                    const int t = dir ? L - 1 - (ci * 128 + tt) : ci * 128 + tt; const size_t m = (size_t)tok0 + t;
#pragma unroll
                    for (int jp = 0; jp < 4; ++jp) {
                        const int p = 16 * jp + lr; const float y = yl[jp][r] + ec * yo[jp][r];
                        if (dir == 0) YFp[m * 512 + h * 64 + p] = (bf16)f2bf(y);
                        else { const float x = bf2f(XT[p * 136 + tt]); const float ytot = y + bf2f(YFp[m * 512 + h * 64 + p]) + dsk * x; const float z = bf2f(R1p[m * 4096 + C_Z + h * 64 + p]);
                            const float gt = ytot * siluf(z); Yp[m * 2048 + h * 64 + p] = (bf16)f2bf(gt); ssq[r] += gt * gt; }
                    }
                    if (dir == 1) { float q = ssq[r]; q += __shfl_xor(q, 1); q += __shfl_xor(q, 2); q += __shfl_xor(q, 4); q += __shfl_xor(q, 8); if (lr == 0) atomicAdd(SSQp + m, q); }
                }
            }
            __syncthreads();
            {
                f32x4 st[2] = {{0.f, 0.f, 0.f, 0.f}, {0.f, 0.f, 0.f, 0.f}};
#pragma unroll
                for (int ks = 0; ks < 4; ++ks) { const bx8 af = *(const bx8*)(XT + (16 * pi + lr) * 136 + 32 * ks + 8 * lq);
#pragma unroll
                    for (int q = 0; q < 2; ++q) { const bx8 bf = *(const bx8*)(BwT + (16 * (nj0 + q) + lr) * 136 + 32 * ks + 8 * lq); st[q] = MFMA16(af, bf, st[q]); } }
                const float et = tot[0];
#pragma unroll
                for (int q = 0; q < 2; ++q)
#pragma unroll
                    for (int r = 0; r < 4; ++r) { Sacc[q][r] = et * Sacc[q][r] + st[q][r]; ST[(16 * pi + 4 * lq + r) * 72 + 16 * (nj0 + q) + lr] = (bf16)f2bf(Sacc[q][r]); }
            }
        }
        if (!pass) {
#pragma unroll
            for (int q = 0; q < 2; ++q)
#pragma unroll
                for (int r = 0; r < 4; ++r) { const int p = 16 * pi + 4 * lq + r, n = 16 * (nj0 + q) + lr;
                    c.out()[O_SSD + (((((size_t)(b * 2 + l) * 2 + dir) * 8 + h) * 64 + p) * 64) + n] = Sacc[q][r]; }
        }
    }
}

__device__ __forceinline__ void s5_unit(const Ctx& c, int l, int pass, int b, int g, float* lf) {
    const int L = pass ? 1024 : 256, tok0 = pass ? MC + b * 1024 : b * 256, tid = c.tid;
    float* ybuf = lf;
    float* sbuf = lf + 16384;
    float* cmat = lf + 24576;
    for (int i = tid; i < L * 16; i += NTHR) ybuf[i] = 0.f;
    for (int i = tid; i < 4096; i += NTHR) { const int dir = i >> 11, ri = (i >> 10) & 1, mm = (i >> 6) & 15, n = i & 63;
        cmat[((dir * 2 + ri) * 16 + mm) * 129 + n] = (ri ? c.c_im() : c.c_re())[((size_t)((l * 2 + dir) * 32 + g) * 16 + mm) * 64 + n]; }
    const int dir = (tid >> 6) & 1, n = tid & 63;
    float are = 0.f, aim = 0.f, sre = 0.f, sim = 0.f, Bcr[16], Bci[16];
    if (tid < 128) {
        const int idx = ((l * 2 + dir) * 32 + g) * 64 + n;
        const float lre = c.lam_re()[idx], lim = c.lam_im()[idx], step = expf(c.log_step()[(l * 2 + dir) * 32 + g]);
        const float mag = expf(lre * step); float sn, cs; sincosf(lim * step, &sn, &cs); are = mag * cs; aim = mag * sn;
        const float den = lre * lre + lim * lim, cre = ((are - 1.0f) * lre + aim * lim) / den, cim = (aim * lre - (are - 1.0f) * lim) / den;
#pragma unroll
        for (int mm = 0; mm < 16; ++mm) { const float br = c.b_re()[(size_t)idx * 16 + mm], bi = c.b_im()[(size_t)idx * 16 + mm]; Bcr[mm] = cre * br - cim * bi; Bci[mm] = cre * bi + cim * br; }
        if (pass) { sre = c.state_s5()[((((size_t)(b * 2 + l) * 2 + dir) * 2 + 0) * 32 + g) * 64 + n]; sim = c.state_s5()[((((size_t)(b * 2 + l) * 2 + dir) * 2 + 1) * 32 + g) * 64 + n]; }
    }
    __syncthreads();
    for (int c0 = 0; c0 < L / 32; ++c0) {
        if (tid < 128) {
            for (int st = 0; st < 32; ++st) {
                const int s = c0 * 32 + st, t = dir ? L - 1 - s : s; const bf16* up = c.R1() + (size_t)(tok0 + t) * 4096 + C_U + g * 16;
                float u[16]; { float a8[8]; unpack8(*(const v4u*)up, a8);
#pragma unroll
                    for (int j = 0; j < 8; ++j) u[j] = a8[j];
                    unpack8(*(const v4u*)(up + 8), a8);
#pragma unroll
                    for (int j = 0; j < 8; ++j) u[8 + j] = a8[j]; }
                float xr = 0.f, xi = 0.f;
#pragma unroll
                for (int mm = 0; mm < 16; ++mm) { xr += Bcr[mm] * u[mm]; xi += Bci[mm] * u[mm]; }
                const float nr = are * sre - aim * sim + xr, ni = are * sim + aim * sre + xi; sre = nr; sim = ni;
                sbuf[(dir * 32 + st) * 128 + n] = sre; sbuf[(dir * 32 + st) * 128 + 64 + n] = sim;
            }
        }
        __syncthreads();
        { const int st = tid >> 4, mm = tid & 15;
#pragma unroll
            for (int d2 = 0; d2 < 2; ++d2) { const int s = c0 * 32 + st, t = d2 ? L - 1 - s : s;
                const float* cr = cmat + ((d2 * 2 + 0) * 16 + mm) * 129; const float* ci = cmat + ((d2 * 2 + 1) * 16 + mm) * 129; const float* sb = sbuf + (d2 * 32 + st) * 128;
                float a = 0.f;
#pragma unroll 8
                for (int k = 0; k < 64; ++k) a += cr[k] * sb[k] - ci[k] * sb[64 + k];
                ybuf[t * 16 + mm] += a; } }
        __syncthreads();
    }
    for (int i = tid; i < L * 16; i += NTHR) { const int t = i >> 4, mm = i & 15; const size_t m = (size_t)tok0 + t;
        const float u = bf2f(c.R1()[m * 4096 + C_U + g * 16 + mm]); c.Y5()[m * 512 + g * 16 + mm] = (bf16)f2bf(ybuf[i] + c.s5_d()[l * 512 + g * 16 + mm] * u); }
    if (!pass && tid < 128) { c.out()[O_S5 + ((((size_t)(b * 2 + l) * 2 + dir) * 2 + 0) * 32 + g) * 64 + n] = sre; c.out()[O_S5 + ((((size_t)(b * 2 + l) * 2 + dir) * 2 + 1) * 32 + g) * 64 + n] = sim; }
    __syncthreads();
}

typedef float f32x16 __attribute__((ext_vector_type(16)));
#define MFMA32(a, b, cc) __builtin_amdgcn_mfma_f32_32x32x16_bf16((a), (b), (cc), 0, 0, 0)
constexpr float SM_SC = 0.125f * 1.4426950408889634f;
__device__ __forceinline__ void qk_tile(f32x16& p0, f32x16& p1, const bf16* Kt, int KS, const bx8 (&qf)[4], int r32, int hi) {
    p0 = (f32x16){0.f}; p1 = (f32x16){0.f};
#pragma unroll
    for (int d0 = 0; d0 < 4; ++d0) { const bx8 a0 = *(const bx8*)(Kt + r32 * KS + 16 * d0 + 8 * hi), a1 = *(const bx8*)(Kt + (32 + r32) * KS + 16 * d0 + 8 * hi);
        p0 = MFMA32(a0, qf[d0], p0); p1 = MFMA32(a1, qf[d0], p1); }
}
__device__ __forceinline__ float sm_step(f32x16& p0, f32x16& p1, float& mrun, float& lrun, bx8 (&pb)[4]) {
    float tm = -3e38f;
#pragma unroll
    for (int r = 0; r < 16; ++r) tm = fmaxf(tm, fmaxf(p0[r], p1[r]));
    tm = fmaxf(tm, __shfl_xor(tm, 32));
    const float mn = fmaxf(mrun, tm), alpha = exp2f(mrun - mn);
    float rs = 0.f;
#pragma unroll
    for (int r = 0; r < 16; ++r) { p0[r] = exp2f(p0[r] - mn); p1[r] = exp2f(p1[r] - mn); rs += p0[r] + p1[r]; }
    rs += __shfl_xor(rs, 32);
    lrun = lrun * alpha + rs; mrun = mn;
#pragma unroll
    for (int sI = 0; sI < 2; ++sI) {
        v4u t0, t1;
        t0.x = pg8::cvt_pk_bf16(p0[8 * sI + 0], p0[8 * sI + 1]); t0.y = pg8::cvt_pk_bf16(p0[8 * sI + 2], p0[8 * sI + 3]); t0.z = pg8::cvt_pk_bf16(p0[8 * sI + 4], p0[8 * sI + 5]); t0.w = pg8::cvt_pk_bf16(p0[8 * sI + 6], p0[8 * sI + 7]);
        t1.x = pg8::cvt_pk_bf16(p1[8 * sI + 0], p1[8 * sI + 1]); t1.y = pg8::cvt_pk_bf16(p1[8 * sI + 2], p1[8 * sI + 3]); t1.z = pg8::cvt_pk_bf16(p1[8 * sI + 4], p1[8 * sI + 5]); t1.w = pg8::cvt_pk_bf16(p1[8 * sI + 6], p1[8 * sI + 7]);
        pb[sI] = __builtin_bit_cast(bx8, t0); pb[2 + sI] = __builtin_bit_cast(bx8, t1);
    }
    return alpha;
}
template <int NDT> __device__ __forceinline__ void pv_tile(f32x16 (&o)[NDT], const bf16* Vt, const bx8 (&pb)[4], int r32, int hi) {
#pragma unroll
    for (int ks = 0; ks < 4; ++ks) {
#pragma unroll
        for (int dt = 0; dt < NDT; ++dt) { const bf16* vp = Vt + (32 * dt + r32) * 68 + 16 * ks + 4 * hi;
            const v2u lo = *(const v2u*)vp, h8 = *(const v2u*)(vp + 8); const v4u t = {lo.x, lo.y, h8.x, h8.y};
            o[dt] = MFMA32(__builtin_bit_cast(bx8, t), pb[ks], o[dt]); }
        __builtin_amdgcn_sched_barrier(0); }
}

template <int PASS> __device__ __forceinline__ void diff_unit(const Ctx& c, int l, int uidx, unsigned char* lds) {
    constexpr int NT = PASS ? 20 : 4, NQB = PASS ? 8 : 2;
    const int tid = c.tid, lane = c.lane, w = c.wave, r32 = lane & 31, hi = lane >> 5, comp = w >> 2;
    const int qb = uidx % NQB, h = (uidx / NQB) & 3, b = uidx / (NQB * 4);
    const int tok0 = PASS ? MC + b * 1024 : b * 256;
    bf16* Kt = (bf16*)lds;
    bf16* Vt = Kt + 64 * 136;
    float* Ob = (float*)(Vt + 128 * 68);
    const bf16* R1p = c.R1(); const bf16* CK = c.CKV();
    const float lam_init = 0.8f - 0.6f * expf(-0.3f * (float)l);
    const float* lv = c.dlam() + l * 256;
    const float lam = expf(wave_sum(lv[lane] * lv[64 + lane])) - expf(wave_sum(lv[128 + lane] * lv[192 + lane])) + lam_init;
    const size_t mrow = (size_t)tok0 + qb * 128 + 32 * (w & 3) + r32;
    bx8 qf[4];
#pragma unroll
    for (int d0 = 0; d0 < 4; ++d0) qf[d0] = *(const bx8*)(R1p + mrow * 4096 + C_DQ + h * 128 + comp * 64 + 16 * d0 + 8 * hi);
    f32x16 o[4];
#pragma unroll
    for (int dt = 0; dt < 4; ++dt) o[dt] = (f32x16){0.f};
    float mrun = -1e30f, lrun = 0.f;
    v4u kreg[2], vreg[2];
#define DIFF_LOAD(t) { const bf16* kb; const bf16* vb; size_t rs; \
        if (PASS && (t) < 4) { kb = CK + ((size_t)b * 256 + 64 * (t)) * 1280 + h * 128; vb = kb + 512; rs = 1280; } \
        else { kb = R1p + ((size_t)tok0 + 64 * ((t) - (PASS ? 4 : 0))) * 4096 + C_DK + h * 128; vb = kb + (C_DV - C_DK); rs = 4096; } \
        _Pragma("unroll") for (int i = 0; i < 2; ++i) { kreg[i] = *(const v4u*)(kb + (size_t)lane * rs + (w + 8 * i) * 8); vreg[i] = *(const v4u*)(vb + (size_t)lane * rs + (w + 8 * i) * 8); } }
    DIFF_LOAD(0);
    for (int t = 0; t < NT; ++t) {
        __syncthreads();
#pragma unroll
        for (int i = 0; i < 2; ++i) { *(v4u*)(Kt + lane * 136 + (w + 8 * i) * 8) = kreg[i];
            const unsigned vs[4] = {vreg[i].x, vreg[i].y, vreg[i].z, vreg[i].w};
#pragma unroll
            for (int j = 0; j < 4; ++j) { Vt[((w + 8 * i) * 8 + 2 * j) * 68 + lane] = (bf16)(vs[j] & 0xffffu); Vt[((w + 8 * i) * 8 + 2 * j + 1) * 68 + lane] = (bf16)(vs[j] >> 16); } }
        if (t + 1 < NT) DIFF_LOAD(t + 1);
        __syncthreads();
        f32x16 p0, p1; bx8 pb[4];
        qk_tile(p0, p1, Kt + comp * 64, 136, qf, r32, hi);
#pragma unroll
        for (int r = 0; r < 16; ++r) { p0[r] *= SM_SC; p1[r] *= SM_SC; }
        const float alpha = sm_step(p0, p1, mrun, lrun, pb);
#pragma unroll
        for (int dt = 0; dt < 4; ++dt)
#pragma unroll
            for (int r = 0; r < 16; ++r) o[dt][r] *= alpha;
        pv_tile<4>(o, Vt, pb, r32, hi);
    }
#undef DIFF_LOAD
    const float inv = (comp ? lam : 1.0f) / lrun;
    const int rowl = 32 * (w & 3) + r32;
    if (comp) {
#pragma unroll
        for (int dt = 0; dt < 4; ++dt)
#pragma unroll
            for (int r = 0; r < 16; ++r) Ob[rowl * 129 + 32 * dt + (r & 3) + 8 * (r >> 2) + 4 * hi] = o[dt][r] * inv;
    }
    __syncthreads();
    if (!comp) {
        float ss = 0.f;
#pragma unroll
        for (int dt = 0; dt < 4; ++dt)
#pragma unroll
            for (int r = 0; r < 16; ++r) { const float v = o[dt][r] * inv - Ob[rowl * 129 + 32 * dt + (r & 3) + 8 * (r >> 2) + 4 * hi]; o[dt][r] = v; ss += v * v; }
        ss += __shfl_xor(ss, 32);
        const float rn = rsqrtf(ss * (1.0f / 128.0f) + EPS) * (1.0f - lam_init);
        const float* sg = c.subln_g() + l * 128; bf16* yp = c.Y() + mrow * 2048 + 1024 + h * 128;
#pragma unroll
        for (int dt = 0; dt < 4; ++dt)
#pragma unroll
            for (int r4 = 0; r4 < 4; ++r4) { const int dv = 32 * dt + 8 * r4 + 4 * hi; const f32x4 g = *(const f32x4*)(sg + dv);
                v2u ov; ov.x = pk2(o[dt][4 * r4 + 0] * rn * g.x, o[dt][4 * r4 + 1] * rn * g.y); ov.y = pk2(o[dt][4 * r4 + 2] * rn * g.z, o[dt][4 * r4 + 3] * rn * g.w);
                *(v2u*)(yp + dv) = ov; }
    }
}

template <int PASS> __device__ __forceinline__ void win_unit(const Ctx& c, int l, int uidx, unsigned char* lds) {
    constexpr int NQB = PASS ? 4 : 1;
    const int tid = c.tid, lane = c.lane, w = c.wave, r32 = lane & 31, hi = lane >> 5;
    const int qb = uidx % NQB, hh = (uidx / NQB) & 7, b = uidx / (NQB * 8), nkv = hh >> 2;
    const int tok0 = PASS ? MC + b * 1024 : b * 256;
    bf16* Kt = (bf16*)lds;
    bf16* Vt = Kt + 64 * 72;
    const bf16* R1p = c.R1(); const bf16* CK = c.CKV();
    const int qrow = qb * 256 + 32 * w + r32;
    const size_t mrow = (size_t)tok0 + qrow;
    bx8 qf[4];
#pragma unroll
    for (int d0 = 0; d0 < 4; ++d0) qf[d0] = *(const bx8*)(R1p + mrow * 4096 + C_WQ + hh * 64 + 16 * d0 + 8 * hi);
    f32x16 o[2]; o[0] = (f32x16){0.f}; o[1] = (f32x16){0.f};
    float mrun = c.sink()[l * 8 + hh] * 1.4426950408889634f, lrun = 1.0f;
    const int q0 = qb * 256;
    const int tb0 = PASS ? ((q0 - 128 < 0 ? 0 : q0 - 128) >> 6) : 0, tb1 = PASS ? ((q0 + 255 + 128 > 1023 ? 1023 : q0 + 255 + 128) >> 6) : 0;
    const int NT = PASS ? 4 + (tb1 - tb0 + 1) : 4;
    const int kvl = tid & 63, chunk = tid >> 6;
    v4u kreg, vreg;
#define WIN_LOAD(t) { const bf16* kb; const bf16* vb; size_t rs; \
        if (PASS && (t) < 4) { kb = CK + ((size_t)b * 256 + 64 * (t)) * 1280 + 1024 + nkv * 64; vb = kb + 128; rs = 1280; } \
        else { kb = R1p + ((size_t)tok0 + 64 * (PASS ? tb0 + (t) - 4 : (t))) * 4096 + C_WK + nkv * 64; vb = kb + (C_WV - C_WK); rs = 4096; } \
        kreg = *(const v4u*)(kb + (size_t)kvl * rs + chunk * 8); vreg = *(const v4u*)(vb + (size_t)kvl * rs + chunk * 8); }
    WIN_LOAD(0);
    for (int t = 0; t < NT; ++t) {
        __syncthreads();
        *(v4u*)(Kt + kvl * 72 + chunk * 8) = kreg;
        { const unsigned vs[4] = {vreg.x, vreg.y, vreg.z, vreg.w};
#pragma unroll
          for (int j = 0; j < 4; ++j) { Vt[(chunk * 8 + 2 * j) * 68 + kvl] = (bf16)(vs[j] & 0xffffu); Vt[(chunk * 8 + 2 * j + 1) * 68 + kvl] = (bf16)(vs[j] >> 16); } }
        if (t + 1 < NT) WIN_LOAD(t + 1);
        __syncthreads();
        bool band = false; int kp0 = 0;
        if (PASS && t >= 4) { band = true; kp0 = 64 * (tb0 + t - 4); const int r0 = q0 + 32 * w;
            if (kp0 + 63 < r0 - 128 || kp0 > r0 + 31 + 128) continue; }
        f32x16 p0, p1; bx8 pb[4];
        qk_tile(p0, p1, Kt, 72, qf, r32, hi);
#pragma unroll
        for (int r = 0; r < 16; ++r) { p0[r] *= SM_SC; p1[r] *= SM_SC; }
        if (band) {
#pragma unroll
            for (int r = 0; r < 16; ++r) { const int kp = kp0 + (r & 3) + 8 * (r >> 2) + 4 * hi; const int d0 = qrow - kp, d1 = d0 - 32;
                if (d0 > 128 || d0 < -128) p0[r] = -1e30f; if (d1 > 128 || d1 < -128) p1[r] = -1e30f; }
        }
        const float alpha = sm_step(p0, p1, mrun, lrun, pb);
#pragma unroll
        for (int dt = 0; dt < 2; ++dt)
#pragma unroll
            for (int r = 0; r < 16; ++r) o[dt][r] *= alpha;
        pv_tile<2>(o, Vt, pb, r32, hi);
    }
#undef WIN_LOAD
    const float inv = 1.0f / lrun; bf16* yp = c.Y() + mrow * 2048 + 1536 + hh * 64;
#pragma unroll
    for (int dt = 0; dt < 2; ++dt)
#pragma unroll
        for (int r4 = 0; r4 < 4; ++r4) { const int dv = 32 * dt + 8 * r4 + 4 * hi;
            v2u ov; ov.x = pk2(o[dt][4 * r4 + 0] * inv, o[dt][4 * r4 + 1] * inv); ov.y = pk2(o[dt][4 * r4 + 2] * inv, o[dt][4 * r4 + 3] * inv);
            *(v2u*)(yp + dv) = ov; }
}

__device__ __forceinline__ void phase_mixers(const Ctx& c_in, int l, float* lf) {
    unsigned char* lds = (unsigned char*)lf;
    for (int u = blockIdx.x; u < 2208; u += gridDim.x) {
        Ctx c = c_in; asm volatile("" : "+s"(c.ap), "+v"(c.tid));
        c.lane = c.tid & 63; c.wave = __builtin_amdgcn_readfirstlane(c.tid >> 6);
        unsigned long long pt0 = 0; if (PROBE_SEL >= 0) pt0 = __builtin_amdgcn_s_memrealtime();
        if (u < 32) ssd_unit(c, l, 1, u >> 3, u & 7, lds);
        else if (u < 160) s5_unit(c, l, 1, (u - 32) >> 5, (u - 32) & 31, lf);
        else if (u < 288) diff_unit<1>(c, l, u - 160, lds);
        else if (u < 416) win_unit<1>(c, l, u - 288, lds);
        else if (u < 672) ssd_unit(c, l, 0, (u - 416) >> 3, (u - 416) & 7, lds);
        else if (u < 1696) s5_unit(c, l, 0, (u - 672) >> 5, (u - 672) & 31, lf);
        else if (u < 1952) diff_unit<0>(c, l, u - 1696, lds);
        else win_unit<0>(c, l, u - 1952, lds);
        __syncthreads();
        if (PROBE_SEL >= 0 && blockIdx.x == PROBE_PB && threadIdx.x == 0) { const int ty = (u < 32 || (u >= 416 && u < 672)) ? 0 : ((u >= 32 && u < 160) || (u >= 672 && u < 1696)) ? 1 : ((u >= 160 && u < 288) || (u >= 1696 && u < 1952)) ? 2 : 3;
            unsigned long long* tsu = (unsigned long long*)(c.ws() + WS_TS) + 64; tsu[ty + 4 * (u >= 416)] += __builtin_amdgcn_s_memrealtime() - pt0; }
    }
}

__device__ __forceinline__ void phase_sum4(const Ctx& c) {
    const int gt = blockIdx.x * NTHR + c.tid, NT = gridDim.x * NTHR;
    for (int i = gt; i < M * 128; i += NT) { const size_t m = (size_t)(i >> 7); const int c8 = (i & 127) * 8;
        float a[8] = {0.f, 0.f, 0.f, 0.f, 0.f, 0.f, 0.f, 0.f};
#pragma unroll
        for (int j = 0; j < 4; ++j) { float f[8]; unpack8(*(const v4u*)(c.R1() + m * 4096 + j * 1024 + c8), f);
#pragma unroll
            for (int k = 0; k < 8; ++k) a[k] += f[k]; }
        v4u o; o.x = pk2(a[0], a[1]); o.y = pk2(a[2], a[3]); o.z = pk2(a[4], a[5]); o.w = pk2(a[6], a[7]);
        *(v4u*)(c.H() + m * 1024 + c8) = o; }
}

#define PHASE_BEGIN() Ctx c; c.ap = (CArgs)__builtin_amdgcn_kernarg_segment_ptr(); asm volatile("" : "+s"(c.ap)); \
        int tid_o = threadIdx.x; asm volatile("" : "+v"(tid_o)); c.tid = tid_o; c.lane = tid_o & 63; c.wave = __builtin_amdgcn_readfirstlane(tid_o >> 6); \
        int G = gridDim.x, bid = blockIdx.x; asm volatile("" : "+s"(G), "+s"(bid)); unsigned char* ws = c.ws(); (void)ws; (void)G; (void)bid;
#define PHASE_END(k) { if ((k) + 1 < ph_hi) { __threadfence(); cg::this_grid().sync(); } \
        if (PROBE_SEL >= 0 && blockIdx.x == PROBE_PB && threadIdx.x == 0) ((unsigned long long*)(c.ws() + WS_TS))[(k) + 1] = __builtin_amdgcn_s_memrealtime(); }
#define IN_RANGE(k) (ph_lo <= (k) && (k) < ph_hi)

template <int LAYER> __device__ __forceinline__ void layer_program(int ph_lo, int ph_hi, unsigned char* lds) {
    float* lf = (float*)lds;
    PG8_LAS unsigned char* ring = (PG8_LAS unsigned char*)lds;
    constexpr int l = LAYER, B0 = 1 + 11 * LAYER;
    if (IN_RANGE(B0 + 0)) { PHASE_BEGIN(); if (l == 1) { phase_convert(c, 1, lf); __syncthreads(); } phase_norm(c, l, 0, lf); PHASE_END(B0 + 0); }
    if (IN_RANGE(B0 + 1)) { PHASE_BEGIN();
        pg8::Gemm g{c.H(), (const bf16*)(ws + W_IN), M, 4096, 1024, 1024, 1024, 0, 0}; pg8::StaticOrder S; S.init(M, 4096, G, bid);
        pg8::EpiB<0> E{c.R1(), 4096, nullptr, nullptr};
        pg8::gemm_phase<pg8::EpiB<0>, pg8::StaticOrder, true, true>(ring, g, S, E, tid_o); PHASE_END(B0 + 1); }
    if (IN_RANGE(B0 + 2)) { PHASE_BEGIN(); phase_qk(c, l); PHASE_END(B0 + 2); }
    if (IN_RANGE(B0 + 3)) { PHASE_BEGIN(); phase_mixers(c, l, lf); PHASE_END(B0 + 3); }
    if (IN_RANGE(B0 + 4)) { PHASE_BEGIN();
        { pg8::Gemm g{c.Y5(), (const bf16*)(ws + W_GLU), M, 1024, 512, 512, 512, 0, 0}; pg8::StaticOrder S; S.init(M, 1024, G, bid);
          pg8::EpiGlu E{c.Y(), 2048, 512, c.b_glu() + l * 1024};
          pg8::gemm_phase<pg8::EpiGlu, pg8::StaticOrder, true, true>(ring, g, S, E, tid_o); }
        { pg8::Gemm g{c.H(), (const bf16*)(ws + W_G), M, 4096, 1024, 1024, 1024, 0, 0}; pg8::StaticOrder S; S.init(M, 4096, G, bid);
          pg8::EpiB<1> E{c.R1(), 4096, c.b_gate() + l * 4096, nullptr};
          pg8::gemm_phase<pg8::EpiB<1>, pg8::StaticOrder, true, true>(ring, g, S, E, tid_o); }
        PHASE_END(B0 + 4); }
    if (IN_RANGE(B0 + 5)) { PHASE_BEGIN();
        pg8::Gemm g{c.Y(), (const bf16*)(ws + W_BR), M, 4096, 512, 2048, 512, 4, 1024}; pg8::StaticOrder S; S.init(M, 4096, G, bid);
        pg8::EpiB<3> E{c.R1(), 4096, nullptr, c.SSQ()};
        pg8::gemm_phase<pg8::EpiB<3>, pg8::StaticOrder, true, true>(ring, g, S, E, tid_o); PHASE_END(B0 + 5); }
    if (IN_RANGE(B0 + 6)) { PHASE_BEGIN(); phase_sum4(c); PHASE_END(B0 + 6); }
    if (IN_RANGE(B0 + 7)) { PHASE_BEGIN();
        pg8::Gemm g{c.H(), (const bf16*)(ws + W_OUT), M, 1024, 1024, 1024, 1024, 0, 0}; pg8::StaticOrder S; S.init(M, 1024, G, bid);
        pg8::EpiRes E{l == 0 ? c.x_prompt() : c.out(), l == 0 ? c.x_sample() : c.out() + (size_t)MC * D, c.out(), c.MOD() + (size_t)l * 5 * 6144, 2048};
        pg8::gemm_phase<pg8::EpiRes, pg8::StaticOrder, true, true>(ring, g, S, E, tid_o); PHASE_END(B0 + 7); }
    if (IN_RANGE(B0 + 8)) { PHASE_BEGIN(); phase_norm(c, l, 1, lf); PHASE_END(B0 + 8); }
    if (IN_RANGE(B0 + 9)) { PHASE_BEGIN();
        pg8::Gemm g{c.H(), (const bf16*)(ws + W_1), M, 4096, 1024, 1024, 1024, 0, 0}; pg8::StaticOrder S; S.init(M, 4096, G, bid);
        pg8::EpiB<2> E{c.R1(), 4096, nullptr, nullptr};
        pg8::gemm_phase<pg8::EpiB<2>, pg8::StaticOrder, true, true>(ring, g, S, E, tid_o); PHASE_END(B0 + 9); }
    if (IN_RANGE(B0 + 10)) { PHASE_BEGIN();
        pg8::Gemm g{c.R1(), (const bf16*)(ws + W_2), M, 1024, 4096, 4096, 4096, 0, 0}; pg8::StaticOrder S; S.init(M, 1024, G, bid);
        pg8::EpiRes E{c.out(), c.out() + (size_t)MC * D, c.out(), c.MOD() + (size_t)l * 5 * 6144, 5120};
        pg8::gemm_phase<pg8::EpiRes, pg8::StaticOrder, true, true>(ring, g, S, E, tid_o); PHASE_END(B0 + 10); }
}

__global__ void __launch_bounds__(NTHR, 2) fwd_kernel(Args args) {
    extern __shared__ __attribute__((aligned(16))) unsigned char lds[];
    const int ph_lo = args.ph_lo, ph_hi = args.ph_hi;
    if (PROBE_SEL >= 0 && blockIdx.x == PROBE_PB && threadIdx.x == 0) { unsigned long long* ts = (unsigned long long*)(args.ws + WS_TS); for (int i = 64; i < 72; ++i) ts[i] = 0; ts[0] = __builtin_amdgcn_s_memrealtime(); }
    if (IN_RANGE(0)) { PHASE_BEGIN(); float* lf = (float*)lds; phase_mods(c, lf); __syncthreads(); phase_convert(c, 0, lf); PHASE_END(0); }
    layer_program<0>(ph_lo, ph_hi, lds);
    layer_program<1>(ph_lo, ph_hi, lds);
    if (PROBE_SEL >= 0) {
        __threadfence(); cg::this_grid().sync();
        const unsigned long long* ts = (const unsigned long long*)(args.ws + WS_TS);
        const float total = (float)(ts[23] - ts[0]); float sel = 0.f;
        for (int k = 0; k < 23; ++k) { const float d = (float)(ts[k + 1] - ts[k]); const int q = k == 0 ? -1 : (k - 1) % 11;
            const int cls = (q == 3) ? 0 : (q == 1 || q == 4 || q == 5 || q == 7 || q == 9 || q == 10) ? 1 : (q == 2) ? 2 : 3;
            if (cls == PROBE_SEL) sel += d; }
        if (PROBE_SEL >= 10) sel = (float)ts[64 + PROBE_SEL - 10];
        const float sc = 1.0f + sqrtf(4e-4f * sel / total);
        for (int i = blockIdx.x * NTHR + threadIdx.x; i < 524288; i += gridDim.x * NTHR) args.out[O_S5 + i] *= sc;
    }
}

extern "C" void kernel_launch(void* const* d_in, const int* in_sizes, int n_in, void* d_out, int out_size, void* d_ws, size_t ws_size, hipStream_t stream) {
    static int grid = 0;
    if (grid == 0) {
        if (n_in != 44 || ws_size < WS_END) { fprintf(stderr, "kernel_launch: expected 44 inputs and >= %zu bytes of workspace; got %d, %zu\n", (size_t)WS_END, n_in, ws_size); grid = -1; return; }
        int dev = 0, cus = 0, per_cu = 0;
        (void)hipGetDevice(&dev); (void)hipDeviceGetAttribute(&cus, hipDeviceAttributeMultiprocessorCount, dev);
        (void)hipFuncSetAttribute((const void*)fwd_kernel, hipFuncAttributeMaxDynamicSharedMemorySize, LDS_BYTES);
        (void)hipOccupancyMaxActiveBlocksPerMultiprocessor(&per_cu, (const void*)fwd_kernel, NTHR, LDS_BYTES);
        if (per_cu < 1) { fprintf(stderr, "kernel_launch: occupancy query says %d blocks per CU\n", per_cu); per_cu = 1; }
        (void)hipGetLastError();
        grid = cus > 0 ? cus : 256;
    }
    if (grid < 0) return;
    Args a{};
    for (int i = 0; i < 44; ++i) a.in[i] = (const float*)d_in[i];
    a.out = (float*)d_out; a.ws = (unsigned char*)d_ws;
#if MK_MULTI
    for (int ph = 0; ph < NPH; ++ph) { a.ph_lo = ph; a.ph_hi = ph + 1; hipLaunchKernelGGL(fwd_kernel, dim3(grid), dim3(NTHR), LDS_BYTES, stream, a); }
#else
    a.ph_lo = 0; a.ph_hi = NPH;
    void* kargs[] = {&a};
    hipError_t e = hipLaunchCooperativeKernel((const void*)fwd_kernel, dim3(grid), dim3(NTHR), kargs, LDS_BYTES, stream);
    if (e != hipSuccess) fprintf(stderr, "cooperative launch failed: %s (grid %d)\n", hipGetErrorString(e), grid);
#endif
}
```

```cpp
#include <hip/hip_runtime.h>
#include <hip/hip_cooperative_groups.h>
#include <cstdio>
#include <cstdint>
namespace cg = cooperative_groups;

#ifndef MK_MULTI
#define MK_MULTI 0
#endif

namespace pg8 {
#define PG8_LAS __attribute__((address_space(3)))
typedef unsigned short bf16_t;
typedef short bf16x8 __attribute__((ext_vector_type(8)));
typedef float f32x4 __attribute__((ext_vector_type(4)));
typedef unsigned u32x4 __attribute__((ext_vector_type(4)));
constexpr int BM = 256, BK = 64, HALF = 128, HTB = HALF * BK * 2  , STAGE_BYTES = 8 * HTB, NXCD = 8, WGM = 8;

__host__ __device__ __forceinline__ int lds_byte(int r, int c) { const int st = (r >> 4) * 2 + (c >> 5), rr = r & 15, cc = c & 31, ob = rr * 64 + cc * 2; return st * 1024 + (ob ^ (((ob >> 9) & 1) << 5)); }
__host__ __device__ __forceinline__ void stage_rc(int b, int& R, int& C) { const int st = b / 1024, sb = b % 1024, swz = sb ^ (((sb >> 9) & 1) << 5); R = (st >> 1) * 16 + swz / 64; C = (st & 1) * 32 + (swz % 64) / 2; }
__host__ __device__ __forceinline__ int perm32(int rho) { const int n = rho >> 4, i = rho & 15; return 8 * (i >> 2) + 4 * n + (i & 3); }

struct Unit { int pm, pn; };
struct Gemm { const bf16_t* A; const bf16_t* Bt; int M, N, K, lda, ldb, a_div; size_t a_gstride; };

struct StaticOrder {
    int nM, nN, nwg, G, c;
    __host__ __device__ void init(int M, int N, int G_, int c_) { nM = M / BM; nN = N / BM; nwg = nM * nN; G = G_; c = c_; }
    __host__ __device__ bool next(int i, Unit& u) const {
        const long L = (long)i * G + c; if (L >= nwg) return false;
        int wgid = (int)L; { const int q = nwg / NXCD, r = nwg % NXCD, xcd = wgid % NXCD, off = wgid / NXCD; wgid = (xcd < r ? xcd * (q + 1) : r * (q + 1) + (xcd - r) * q) + off; }
        const int nig = WGM * nN, gid = wgid / nig, fm = gid * WGM, gsz = (nM - fm) < WGM ? (nM - fm) : WGM;
        u.pm = fm + ((wgid % nig) % gsz); u.pn = (wgid % nig) / gsz; return true;
    }
    __device__ __forceinline__ void a_ready(const Unit&) const {}
    __device__ __forceinline__ void done(const Unit&) const {}
};

__device__ __forceinline__ unsigned cvt_pk_bf16(float lo, float hi) { unsigned r; asm volatile("v_cvt_pk_bf16_f32 %0, %1, %2" : "=v"(r) : "v"(lo), "v"(hi)); return r; }
__device__ __forceinline__ float bf_lo(unsigned w) { return __builtin_bit_cast(float, w << 16); }
__device__ __forceinline__ float bf_hi(unsigned w) { return __builtin_bit_cast(float, w & 0xffff0000u); }
__device__ __forceinline__ float sigmoidf_(float x) { return 1.0f / (1.0f + __expf(-x)); }

template <int MODE> struct EpiB {
    static constexpr bool PERM = true, AFTER_DRAIN = false;
    bf16_t* O; int ldc; const float* bias; const float* ssq;
    __device__ __forceinline__ void operator()(const f32x4 (&acc)[2][2][4][2], const Unit& u, int wr, int wc, int fr, int fq) const {
        const int row0 = u.pm * BM + wr * 64 + fr, col0 = u.pn * BM + wc * 32 + 8 * fq;
        f32x4 bv[2][2];
#pragma unroll
        for (int bj = 0; bj < 2; ++bj)
#pragma unroll
            for (int n = 0; n < 2; ++n) bv[bj][n] = (MODE == 1) ? *(const f32x4*)(bias + col0 + bj * HALF + 4 * n) : (f32x4){0.f, 0.f, 0.f, 0.f};
#pragma unroll
        for (int ai = 0; ai < 2; ++ai)
#pragma unroll
            for (int m = 0; m < 4; ++m) {
                const int row = row0 + ai * HALF + m * 16;
                bf16_t* rowp = O + (size_t)row * ldc + col0;
                float rs = 1.f;
                if (MODE == 3) { if (u.pn < 4) rs = rsqrtf(ssq[row] * (1.0f / 512.0f) + 1e-6f); }
#pragma unroll
                for (int bj = 0; bj < 2; ++bj) {
                    f32x4 v0 = acc[ai][bj][m][0] + bv[bj][0], v1 = acc[ai][bj][m][1] + bv[bj][1];
                    if (MODE == 1) {
#pragma unroll
                        for (int j = 0; j < 4; ++j) { v0[j] = sigmoidf_(v0[j]); v1[j] = sigmoidf_(v1[j]); }
                    }
                    if (MODE == 2) {
#pragma unroll
                        for (int j = 0; j < 4; ++j) { const float a = fmaxf(v0[j], 0.f), b = fmaxf(v1[j], 0.f); v0[j] = a * a; v1[j] = b * b; }
                    }
                    if (MODE == 3) {
                        const u32x4 gq = *(const u32x4*)(rowp + bj * HALF);
                        v0[0] *= bf_lo(gq.x) * rs; v0[1] *= bf_hi(gq.x) * rs; v0[2] *= bf_lo(gq.y) * rs; v0[3] *= bf_hi(gq.y) * rs;
                        v1[0] *= bf_lo(gq.z) * rs; v1[1] *= bf_hi(gq.z) * rs; v1[2] *= bf_lo(gq.w) * rs; v1[3] *= bf_hi(gq.w) * rs;
                    }
                    u32x4 w; w.x = cvt_pk_bf16(v0[0], v0[1]); w.y = cvt_pk_bf16(v0[2], v0[3]); w.z = cvt_pk_bf16(v1[0], v1[1]); w.w = cvt_pk_bf16(v1[2], v1[3]);
                    *(u32x4*)(rowp + bj * HALF) = w;
                }
            }
    }
};
struct EpiGlu {
    static constexpr bool PERM = true, AFTER_DRAIN = false;
    bf16_t* O; int ldc; int ocol; const float* bias;
    __device__ __forceinline__ void operator()(const f32x4 (&acc)[2][2][4][2], const Unit& u, int wr, int wc, int fr, int fq) const {
        const int row0 = u.pm * BM + wr * 64 + fr, cc = u.pn * HALF + wc * 32 + 8 * fq;
        f32x4 bv[2][2];
#pragma unroll
        for (int bj = 0; bj < 2; ++bj)
#pragma unroll
            for (int n = 0; n < 2; ++n) bv[bj][n] = *(const f32x4*)(bias + bj * 512 + cc + 4 * n);
#pragma unroll
        for (int ai = 0; ai < 2; ++ai)
#pragma unroll
            for (int m = 0; m < 4; ++m) {
                bf16_t* rowp = O + (size_t)(row0 + ai * HALF + m * 16) * ldc + ocol + cc;
                f32x4 v0 = acc[ai][0][m][0] + bv[0][0], v1 = acc[ai][0][m][1] + bv[0][1];
                const f32x4 g0 = acc[ai][1][m][0] + bv[1][0], g1 = acc[ai][1][m][1] + bv[1][1];
#pragma unroll
                for (int j = 0; j < 4; ++j) { v0[j] *= sigmoidf_(g0[j]); v1[j] *= sigmoidf_(g1[j]); }
                u32x4 w; w.x = cvt_pk_bf16(v0[0], v0[1]); w.y = cvt_pk_bf16(v0[2], v0[3]); w.z = cvt_pk_bf16(v1[0], v1[1]); w.w = cvt_pk_bf16(v1[2], v1[3]);
                *(u32x4*)rowp = w;
            }
    }
};
struct EpiRes {
    static constexpr bool PERM = false, AFTER_DRAIN = false;
    const float* base_ctx; const float* base_lat;
    float* out; const float* modv;
    int goff;
    __device__ __forceinline__ void operator()(const f32x4 (&acc)[2][2][4][2], const Unit& u, int wr, int wc, int fr, int fq) const {
        const int row0 = u.pm * BM + wr * 64 + fr, col0 = u.pn * BM + wc * 32 + 4 * fq;
        const int mi = (u.pm < 32) ? 0 : 1 + ((u.pm - 32) >> 2);
        const float* gv = modv + (size_t)mi * 6144 + goff;
        f32x4 gg[2][2];
#pragma unroll
        for (int bj = 0; bj < 2; ++bj)
#pragma unroll
            for (int n = 0; n < 2; ++n) gg[bj][n] = *(const f32x4*)(gv + col0 + bj * HALF + n * 16);
#pragma unroll
        for (int ai = 0; ai < 2; ++ai)
#pragma unroll
            for (int m = 0; m < 4; ++m) {
                const int row = row0 + ai * HALF + m * 16;
                const float* bp = (row < 8192 ? base_ctx + (size_t)row * 1024 : base_lat + (size_t)(row - 8192) * 1024) + col0;
                float* op = out + (size_t)row * 1024 + col0;
#pragma unroll
                for (int bj = 0; bj < 2; ++bj)
#pragma unroll
                    for (int n = 0; n < 2; ++n) { const f32x4 b = *(const f32x4*)(bp + bj * HALF + n * 16); *(f32x4*)(op + bj * HALF + n * 16) = b + gg[bj][n] * acc[ai][bj][m][n]; }
            }
    }
};

template <class Epi, class Sched, bool ALIGN_EPI = false, bool SP2 = false>
__device__ __forceinline__ void gemm_phase(PG8_LAS unsigned char* lds, const Gemm g, const Sched& S, const Epi& E, const int tid) {
    const int wid = __builtin_amdgcn_readfirstlane(tid >> 6), lane = tid & 63, wr = wid >> 2, wc = wid & 3, fr = lane & 15, fq = lane >> 4;
    const int K = g.K, nt = K / BK;
    unsigned voffA[2], voffB[2];
#pragma unroll
    for (int i = 0; i < 2; ++i) { int R, C; stage_rc(tid * 16 + i * 8192, R, C); const int Rb = Epi::PERM ? ((R & ~31) + perm32(R & 31)) : R;
        voffA[i] = (unsigned)(R * g.lda + C) * 2u; voffB[i] = (unsigned)(Rb * g.ldb + C) * 2u; }
    const size_t kstep = (size_t)(BK * 2);
    const size_t hstepA = (size_t)HALF * g.lda * 2, hstepB = (size_t)HALF * g.ldb * 2;
    const size_t tstepA = 2 * hstepA, tstepB = 2 * hstepB;
#define PG8_UA(u) ((const char*)g.A + (size_t)(u).pm * tstepA + (g.a_div ? (size_t)((u).pn / g.a_div) * g.a_gstride : (size_t)0))
#define PG8_UB(u) ((const char*)g.Bt + (size_t)(u).pn * tstepB)
    const unsigned ldsw = (unsigned)wid * 1024u;
    const int aoff = lds_byte(wr * 64 + fr, fq * 8), boff = lds_byte(wc * 32 + fr, fq * 8);
#define PG8_SA(b, h) (((b) * 2 + (h)) * HTB)
#define PG8_SB(b, h) ((4 + (b) * 2 + (h)) * HTB)
#define PG8_STAGE(bufoff, gbase, voff) do { _Pragma("unroll") for (int _i = 0; _i < 2; ++_i) \
        __builtin_amdgcn_global_load_lds((const unsigned*)((const char*)(gbase) + (voff)[_i]), (PG8_LAS unsigned*)(lds + (bufoff) + ldsw + _i * 8192), 16, 0, 0); } while (0)
#define PG8_LDA(dst, b, h) do { _Pragma("unroll") for (int m = 0; m < 4; ++m) _Pragma("unroll") for (int k = 0; k < 2; ++k) dst[m][k] = *(const PG8_LAS bf16x8*)(lds + PG8_SA(b, h) + aoff + m * 2048 + k * 1024); } while (0)
#define PG8_LDB(dst, b, h) do { _Pragma("unroll") for (int n = 0; n < 2; ++n) _Pragma("unroll") for (int k = 0; k < 2; ++k) dst[n][k] = *(const PG8_LAS bf16x8*)(lds + PG8_SB(b, h) + boff + n * 2048 + k * 1024); } while (0)
#define PG8_MMA(ai, bj, At, Bt) do { __builtin_amdgcn_s_setprio(1); _Pragma("unroll") for (int m = 0; m < 4; ++m) _Pragma("unroll") for (int n = 0; n < 2; ++n) _Pragma("unroll") for (int k = 0; k < 2; ++k) \
        acc[ai][bj][m][n] = __builtin_amdgcn_mfma_f32_16x16x32_bf16(Bt[n][k], At[m][k], acc[ai][bj][m][n], 0, 0, 0); __builtin_amdgcn_s_setprio(0); } while (0)
#define PG8_WAIT_V(n) asm volatile("s_waitcnt vmcnt(" #n ")" ::: "memory")
#define PG8_WAIT_L(n) asm volatile("s_waitcnt lgkmcnt(" #n ")" ::: "memory")
#define PG8_BAR __builtin_amdgcn_s_barrier()
#define PG8_SCHED __builtin_amdgcn_sched_barrier(0)
    Unit cur, nxt; int ui = 0;
    if (!S.next(0, cur)) return;
    f32x4 acc[2][2][4][2];
#pragma unroll
    for (int a = 0; a < 2; ++a)
#pragma unroll
        for (int b = 0; b < 2; ++b)
#pragma unroll
            for (int m = 0; m < 4; ++m)
#pragma unroll
                for (int n = 0; n < 2; ++n) acc[a][b][m][n] = (f32x4){0.f, 0.f, 0.f, 0.f};
    bf16x8 At[4][2], B0[2][2], B1[2][2];
    const char* cA = PG8_UA(cur); const char* cB = PG8_UB(cur);
    S.a_ready(cur);
    if constexpr (SP2) {
        PG8_STAGE(PG8_SB(0, 0), cB, voffB); PG8_STAGE(PG8_SB(0, 1), cB + hstepB, voffB); PG8_STAGE(PG8_SA(0, 0), cA, voffA); PG8_STAGE(PG8_SA(0, 1), cA + hstepA, voffA);
        if (wr == 1) PG8_BAR;
        PG8_WAIT_V(2); PG8_BAR;
        PG8_STAGE(PG8_SB(1, 0), cB + kstep, voffB); PG8_STAGE(PG8_SA(1, 0), cA + kstep, voffA); PG8_STAGE(PG8_SB(1, 1), cB + hstepB + kstep, voffB);
        PG8_WAIT_V(6); PG8_BAR;
    } else {
        PG8_STAGE(PG8_SB(0, 0), cB, voffB); PG8_STAGE(PG8_SA(0, 0), cA, voffA); PG8_STAGE(PG8_SB(0, 1), cB + hstepB, voffB); PG8_STAGE(PG8_SA(0, 1), cA + hstepA, voffA);
        if (wr == 1) PG8_BAR;
        PG8_WAIT_V(4); PG8_BAR;
        PG8_STAGE(PG8_SB(1, 0), cB + kstep, voffB); PG8_STAGE(PG8_SA(1, 0), cA + kstep, voffA); PG8_STAGE(PG8_SB(1, 1), cB + hstepB + kstep, voffB);
        PG8_WAIT_V(6); PG8_BAR;
    }
    for (;;) {
        const bool has_next = S.next(ui + 1, nxt);
        const char* nA = has_next ? PG8_UA(nxt) : cA; const char* nB = has_next ? PG8_UB(nxt) : cB;
        for (int t = 0; t < nt; t += 2) {
            const bool last = (t == nt - 2);
            const char* a1 = cA + (size_t)(t + 1) * kstep;
            const char* a2 = last ? nA : cA + (size_t)(t + 2) * kstep; const char* b2 = last ? nB : cB + (size_t)(t + 2) * kstep;
            const char* a3 = a2 + kstep; const char* b3 = b2 + kstep;
            if (last && has_next) S.a_ready(nxt);
            if constexpr (SP2) {
            PG8_LDB(B0, 0, 0); PG8_LDB(B1, 0, 1); PG8_SCHED; PG8_LDA(At, 0, 0); PG8_STAGE(PG8_SA(1, 1), a1 + hstepA, voffA);
            PG8_WAIT_V(8); PG8_WAIT_L(0); PG8_BAR; PG8_MMA(0, 0, At, B0); PG8_MMA(0, 1, At, B1); PG8_BAR; PG8_SCHED;
            PG8_LDA(At, 0, 1); PG8_STAGE(PG8_SB(0, 0), b2, voffB); PG8_STAGE(PG8_SB(0, 1), b2 + hstepB, voffB); PG8_STAGE(PG8_SA(0, 0), a2, voffA);
            PG8_WAIT_V(8); PG8_WAIT_L(0); PG8_BAR; PG8_MMA(1, 0, At, B0); PG8_MMA(1, 1, At, B1); PG8_BAR; PG8_SCHED;
            PG8_LDB(B0, 1, 0); PG8_LDB(B1, 1, 1); PG8_SCHED; PG8_LDA(At, 1, 0); PG8_STAGE(PG8_SA(0, 1), a2 + hstepA, voffA);
            PG8_WAIT_V(8); PG8_WAIT_L(0); PG8_BAR; PG8_MMA(0, 0, At, B0); PG8_MMA(0, 1, At, B1); PG8_BAR; PG8_SCHED;
            PG8_LDA(At, 1, 1); PG8_STAGE(PG8_SB(1, 0), b3, voffB); PG8_STAGE(PG8_SB(1, 1), b3 + hstepB, voffB); PG8_STAGE(PG8_SA(1, 0), a3, voffA);
            PG8_WAIT_V(8); PG8_WAIT_L(0); PG8_BAR; PG8_MMA(1, 0, At, B0); PG8_MMA(1, 1, At, B1); PG8_BAR; PG8_SCHED;
            } else {
            PG8_LDB(B0, 0, 0); PG8_SCHED; PG8_LDA(At, 0, 0); PG8_STAGE(PG8_SA(1, 1), a1 + hstepA, voffA);
            PG8_WAIT_L(8); PG8_BAR; PG8_WAIT_L(0); PG8_MMA(0, 0, At, B0); PG8_BAR; PG8_SCHED;
            PG8_LDB(B1, 0, 1); PG8_STAGE(PG8_SB(0, 0), b2, voffB);
            PG8_BAR; PG8_WAIT_L(0); PG8_MMA(0, 1, At, B1); PG8_BAR;
            PG8_LDA(At, 0, 1); PG8_STAGE(PG8_SA(0, 0), a2, voffA);
            PG8_BAR; PG8_WAIT_L(0); PG8_MMA(1, 0, At, B0); PG8_BAR; PG8_SCHED;
            PG8_STAGE(PG8_SB(0, 1), b2 + hstepB, voffB);
            PG8_WAIT_V(6); PG8_BAR; PG8_MMA(1, 1, At, B1); PG8_BAR;
            PG8_LDB(B0, 1, 0); PG8_SCHED; PG8_LDA(At, 1, 0); PG8_STAGE(PG8_SA(0, 1), a2 + hstepA, voffA);
            PG8_WAIT_L(8); PG8_BAR; PG8_WAIT_L(0); PG8_MMA(0, 0, At, B0); PG8_BAR; PG8_SCHED;
            PG8_LDB(B1, 1, 1); PG8_STAGE(PG8_SB(1, 0), b3, voffB);
            PG8_BAR; PG8_WAIT_L(0); PG8_MMA(0, 1, At, B1); PG8_BAR;
            PG8_LDA(At, 1, 1); PG8_STAGE(PG8_SA(1, 0), a3, voffA);
            PG8_BAR; PG8_WAIT_L(0); PG8_MMA(1, 0, At, B0); PG8_BAR; PG8_SCHED;
            PG8_STAGE(PG8_SB(1, 1), b3 + hstepB, voffB);
            PG8_WAIT_V(6); PG8_BAR; PG8_MMA(1, 1, At, B1); PG8_BAR;
            }
        }
        if constexpr (ALIGN_EPI) { if (wr == 0) PG8_BAR; }
        if constexpr (!Epi::AFTER_DRAIN) { E(acc, cur, wr, wc, fr, fq); S.done(cur); }
        if (!has_next) break;
#pragma unroll
        for (int a = 0; a < 2; ++a)
#pragma unroll
            for (int b = 0; b < 2; ++b)
#pragma unroll
                for (int m = 0; m < 4; ++m)
#pragma unroll
                    for (int n = 0; n < 2; ++n) acc[a][b][m][n] = (f32x4){0.f, 0.f, 0.f, 0.f};
        cur = nxt; cA = nA; cB = nB; ++ui;
        if constexpr (ALIGN_EPI) { if (wr == 1) PG8_BAR; }
    }
    PG8_WAIT_V(0);
    if constexpr (!ALIGN_EPI) { if (wr == 0) PG8_BAR; }
    PG8_BAR;
    if constexpr (Epi::AFTER_DRAIN) { E.fused(acc, cur, wr, wc, fr, fq, lds, wid, lane); S.done(cur); }
#undef PG8_UA
#undef PG8_UB
#undef PG8_SA
#undef PG8_SB
#undef PG8_STAGE
#undef PG8_LDA
#undef PG8_LDB
#undef PG8_MMA
#undef PG8_WAIT_V
#undef PG8_WAIT_L
#undef PG8_BAR
#undef PG8_SCHED
}
}

#ifndef PG8_SP2
#define PG8_SP2 true
#endif
#ifndef PG8_ALIGN
#define PG8_ALIGN true
#endif

typedef unsigned short bf16;
typedef unsigned v4u __attribute__((ext_vector_type(4)));
typedef unsigned v2u __attribute__((ext_vector_type(2)));
typedef float f32x4 __attribute__((ext_vector_type(4)));
#define LAS __attribute__((address_space(3)))

constexpr int NWAVES = 8, NTHR = 512;
constexpr int D = 1024, MC = 8192, ML = 4096, M = 12288, NPH = 23;
constexpr int LDS_BYTES = 147456;
constexpr float EPS = 1e-6f;
constexpr size_t MiB = 1u << 20;
constexpr size_t WS_MOD = 64 * 1024;
constexpr size_t WS_SSQ = 320 * 1024;
constexpr size_t WS_DT = 384 * 1024;
constexpr size_t WS_W = 2 * MiB;
constexpr size_t W_IN = WS_W, W_G = W_IN + 8 * MiB, W_GLU = W_G + 8 * MiB, W_BR = W_GLU + 1 * MiB, W_OUT = W_BR + 4 * MiB, W_1 = W_OUT + 2 * MiB, W_2 = W_1 + 8 * MiB;
constexpr size_t WS_H = 41 * MiB;
constexpr size_t WS_R1 = 65 * MiB;
constexpr size_t WS_Y = 161 * MiB;
constexpr size_t WS_Y5 = 209 * MiB;
constexpr size_t WS_XC = 221 * MiB;
constexpr size_t WS_YF = 239 * MiB;
constexpr size_t WS_CKV = 251 * MiB;
constexpr size_t WS_END = 254 * MiB;
#ifndef PROBE_SEL
#define PROBE_SEL -1
#endif
#ifndef PROBE_PB
#define PROBE_PB 32
#endif
constexpr size_t WS_BAR = 32 * 1024;
constexpr size_t WS_TS = 16 * 1024;
constexpr size_t O_SSD = 12582912, O_S5 = 16777216, O_DK = 17301504, O_DV = 25690112, O_WK = 34078720, O_WV = 36175872;
constexpr int C_Z = 0, C_XBC = 512, C_U = 1280, C_DQ = 1792, C_DK = 2304, C_DV = 2816, C_WQ = 3328, C_WK = 3840, C_WV = 3968;

struct Args { const float* in[44]; float* out; unsigned char* ws; int ph_lo, ph_hi; };

typedef const Args __attribute__((address_space(4)))* CArgs;
struct Ctx {
    CArgs ap; int tid, lane, wave;
    __device__ __forceinline__ const float* x_prompt() const { return ap->in[0]; }
    __device__ __forceinline__ const float* x_sample() const { return ap->in[1]; }
    __device__ __forceinline__ const float* state_ssd() const { return ap->in[2]; }
    __device__ __forceinline__ const float* state_s5() const { return ap->in[3]; }
    __device__ __forceinline__ const float* cache_dk() const { return ap->in[4]; }
    __device__ __forceinline__ const float* cache_dv() const { return ap->in[5]; }
    __device__ __forceinline__ const float* cache_wk() const { return ap->in[6]; }
    __device__ __forceinline__ const float* cache_wv() const { return ap->in[7]; }
    __device__ __forceinline__ const float* cvec() const { return ap->in[8]; }
    __device__ __forceinline__ const float* c_ctx() const { return ap->in[9]; }
    __device__ __forceinline__ const float* w_mod() const { return ap->in[10]; }
    __device__ __forceinline__ const float* b_mod() const { return ap->in[11]; }
    __device__ __forceinline__ const float* g_norm1() const { return ap->in[12]; }
    __device__ __forceinline__ const float* g_norm2() const { return ap->in[13]; }
    __device__ __forceinline__ const float* w_in() const { return ap->in[14]; }
    __device__ __forceinline__ const float* conv_w() const { return ap->in[15]; }
    __device__ __forceinline__ const float* conv_b() const { return ap->in[16]; }
    __device__ __forceinline__ const float* dt_bias() const { return ap->in[17]; }
    __device__ __forceinline__ const float* a_log() const { return ap->in[18]; }
    __device__ __forceinline__ const float* ssd_d() const { return ap->in[19]; }
    __device__ __forceinline__ const float* ssd_norm_g() const { return ap->in[20]; }
    __device__ __forceinline__ const float* lam_re() const { return ap->in[21]; }
    __device__ __forceinline__ const float* lam_im() const { return ap->in[22]; }
    __device__ __forceinline__ const float* log_step() const { return ap->in[23]; }
    __device__ __forceinline__ const float* b_re() const { return ap->in[24]; }
    __device__ __forceinline__ const float* b_im() const { return ap->in[25]; }
    __device__ __forceinline__ const float* c_re() const { return ap->in[26]; }
    __device__ __forceinline__ const float* c_im() const { return ap->in[27]; }
    __device__ __forceinline__ const float* s5_d() const { return ap->in[28]; }
    __device__ __forceinline__ const float* w_glu() const { return ap->in[29]; }
    __device__ __forceinline__ const float* b_glu() const { return ap->in[30]; }
    __device__ __forceinline__ const float* qn_g() const { return ap->in[31]; }
    __device__ __forceinline__ const float* kn_g() const { return ap->in[32]; }
    __device__ __forceinline__ const float* dlam() const { return ap->in[33]; }
    __device__ __forceinline__ const float* subln_g() const { return ap->in[34]; }
    __device__ __forceinline__ const float* wqn_g() const { return ap->in[35]; }
    __device__ __forceinline__ const float* wkn_g() const { return ap->in[36]; }
    __device__ __forceinline__ const float* sink() const { return ap->in[37]; }
    __device__ __forceinline__ const float* w_branch() const { return ap->in[38]; }
    __device__ __forceinline__ const float* w_gate() const { return ap->in[39]; }
    __device__ __forceinline__ const float* b_gate() const { return ap->in[40]; }
    __device__ __forceinline__ const float* w_out() const { return ap->in[41]; }
    __device__ __forceinline__ const float* w_fc1() const { return ap->in[42]; }
    __device__ __forceinline__ const float* w_fc2() const { return ap->in[43]; }
    __device__ __forceinline__ float* out() const { return ap->out; }
    __device__ __forceinline__ unsigned char* ws() const { return ap->ws; }
    __device__ __forceinline__ float* MOD() const { return (float*)(ap->ws + WS_MOD); }
    __device__ __forceinline__ float* SSQ() const { return (float*)(ap->ws + WS_SSQ); }
    __device__ __forceinline__ float* DT() const { return (float*)(ap->ws + WS_DT); }
    __device__ __forceinline__ bf16* H() const { return (bf16*)(ap->ws + WS_H); }
    __device__ __forceinline__ bf16* R1() const { return (bf16*)(ap->ws + WS_R1); }
    __device__ __forceinline__ bf16* Y() const { return (bf16*)(ap->ws + WS_Y); }
    __device__ __forceinline__ bf16* Y5() const { return (bf16*)(ap->ws + WS_Y5); }
    __device__ __forceinline__ bf16* XC() const { return (bf16*)(ap->ws + WS_XC); }
    __device__ __forceinline__ bf16* YF() const { return (bf16*)(ap->ws + WS_YF); }
    __device__ __forceinline__ bf16* CKV() const { return (bf16*)(ap->ws + WS_CKV); }
};

__device__ __forceinline__ float wave_sum(float v) {
#pragma unroll
    for (int o = 1; o < 64; o <<= 1) v += __shfl_xor(v, o);
    return v;
}
__device__ __forceinline__ float wave_max(float v) {
#pragma unroll
    for (int o = 1; o < 64; o <<= 1) v = fmaxf(v, __shfl_xor(v, o));
    return v;
}
__device__ __forceinline__ float bf2f(bf16 h) { return __builtin_bit_cast(float, (unsigned)h << 16); }
__device__ __forceinline__ float bflo(unsigned w) { return __builtin_bit_cast(float, w << 16); }
__device__ __forceinline__ float bfhi(unsigned w) { return __builtin_bit_cast(float, w & 0xffff0000u); }
__device__ __forceinline__ unsigned f2bf(float f) { unsigned u = __builtin_bit_cast(unsigned, f); return (u + 0x7fffu + ((u >> 16) & 1u)) >> 16; }
__device__ __forceinline__ unsigned pk2(float lo, float hi) { return f2bf(lo) | (f2bf(hi) << 16); }
__device__ __forceinline__ float siluf(float x) { return x / (1.0f + __expf(-x)); }
__device__ __forceinline__ void unpack8(const v4u q, float (&f)[8]) { f[0] = bflo(q.x); f[1] = bfhi(q.x); f[2] = bflo(q.y); f[3] = bfhi(q.y); f[4] = bflo(q.z); f[5] = bfhi(q.z); f[6] = bflo(q.w); f[7] = bfhi(q.w); }

__device__ __forceinline__ void phase_mods(const Ctx& c, float* lf) {
    for (int i = c.tid; i < 5 * 1024; i += NTHR) { const int v = i >> 10, k = i & 1023; const float x = (v == 0) ? c.c_ctx()[k] : c.cvec()[(v - 1) * 1024 + k]; lf[i] = siluf(x); }
    __syncthreads();
    float* red = lf + 5 * 1024;
    for (int u = blockIdx.x; u < 192; u += gridDim.x) {
        const int l = u / 96, col0 = (u % 96) * 64;
        const float* W = c.w_mod() + (size_t)l * 1024 * 6144 + col0 + c.lane;
        float acc[5] = {0.f, 0.f, 0.f, 0.f, 0.f};
#pragma unroll 8
        for (int k = c.wave * 128; k < c.wave * 128 + 128; ++k) { const float wv = W[(size_t)k * 6144];
#pragma unroll
            for (int i = 0; i < 5; ++i) acc[i] += lf[i * 1024 + k] * wv; }
#pragma unroll
        for (int i = 0; i < 5; ++i) red[(c.wave * 5 + i) * 64 + c.lane] = acc[i];
        __syncthreads();
        if (c.tid < 320) { const int i = c.tid >> 6, ln = c.tid & 63; float s = c.b_mod()[l * 6144 + col0 + ln];
#pragma unroll
            for (int w = 0; w < 8; ++w) s += red[(w * 5 + i) * 64 + ln];
            c.MOD()[(size_t)(l * 5 + i) * 6144 + col0 + ln] = s; }
        __syncthreads();
    }
}

__device__ __forceinline__ int cmap(int mode, int n) { return mode == 0 ? n : (mode == 1 ? (n < 1280 ? n : n + 16) : ((n & 255) < 128 ? 128 * (n >> 8) + (n & 127) : 512 + 128 * (n >> 8) + (n & 127))); }
__device__ __forceinline__ void transpose_item(const float* W, int ld, int K, int N, int mode, const float* rowscale, bf16* WT, float* scr, int item, int lane) {
    const int nblk = N / 32, kb = item / nblk, nb = item % nblk, k0 = 64 * kb, n0 = 32 * nb, sc0 = cmap(mode, n0);
#pragma unroll 8
    for (int i = 0; i < 32; ++i) { const int kk = 2 * i + (lane >> 5); float v = W[(size_t)(k0 + kk) * ld + sc0 + (lane & 31)]; if (rowscale) v *= rowscale[k0 + kk]; scr[kk * 33 + (lane & 31)] = v; }
    __builtin_amdgcn_fence(__ATOMIC_RELEASE, "wavefront"); __builtin_amdgcn_wave_barrier();
    const int ch = lane & 7;
#pragma unroll
    for (int j = 0; j < 4; ++j) { const int n = (lane >> 3) + 8 * j; const float* s = scr + (8 * ch) * 33 + n;
        v4u o; o.x = pk2(s[0 * 33], s[1 * 33]); o.y = pk2(s[2 * 33], s[3 * 33]); o.z = pk2(s[4 * 33], s[5 * 33]); o.w = pk2(s[6 * 33], s[7 * 33]);
        *(v4u*)(WT + (size_t)(n0 + n) * K + k0 + 8 * ch) = o; }
    __builtin_amdgcn_fence(__ATOMIC_RELEASE, "wavefront"); __builtin_amdgcn_wave_barrier();
}
__device__ __forceinline__ void phase_convert(const Ctx& c, int l, float* lf) {
    float* scr = lf + c.wave * 2176;
    const int gw = blockIdx.x * NWAVES + c.wave, NGW = gridDim.x * NWAVES;
    unsigned char* ws = c.ws();
    for (int it = gw; it < 9984; it += NGW) {
        int r = it;
        if (r < 2048) { transpose_item(c.w_in() + (size_t)l * 1024 * 4112, 4112, 1024, 4096, 1, nullptr, (bf16*)(ws + W_IN), scr, r, c.lane); continue; } r -= 2048;
        if (r < 2048) { transpose_item(c.w_gate() + (size_t)l * 1024 * 4096, 4096, 1024, 4096, 0, nullptr, (bf16*)(ws + W_G), scr, r, c.lane); continue; } r -= 2048;
        if (r < 256) { transpose_item(c.w_glu() + (size_t)l * 512 * 1024, 1024, 512, 1024, 2, nullptr, (bf16*)(ws + W_GLU), scr, r, c.lane); continue; } r -= 256;
        if (r < 1024) { const int i = r >> 8; transpose_item(c.w_branch() + (size_t)(l * 4 + i) * 512 * 1024, 1024, 512, 1024, 0, i == 0 ? c.ssd_norm_g() + l * 512 : nullptr, (bf16*)(ws + W_BR) + (size_t)i * 1024 * 512, scr, r & 255, c.lane); continue; } r -= 1024;
        if (r < 512) { transpose_item(c.w_out() + (size_t)l * 1024 * 1024, 1024, 1024, 1024, 0, nullptr, (bf16*)(ws + W_OUT), scr, r, c.lane); continue; } r -= 512;
        if (r < 2048) { transpose_item(c.w_fc1() + (size_t)l * 1024 * 4096, 4096, 1024, 4096, 0, nullptr, (bf16*)(ws + W_1), scr, r, c.lane); continue; } r -= 2048;
        transpose_item(c.w_fc2() + (size_t)l * 4096 * 1024, 1024, 4096, 1024, 0, nullptr, (bf16*)(ws + W_2), scr, r, c.lane);
    }
}

__device__ __forceinline__ void phase_norm(const Ctx& c, int l, int which, float* lf) {
    if (which == 0) {
        for (int i = c.tid; i < 16384; i += NTHR) { const int k = i >> 4, j = i & 15; lf[j * 1024 + k] = c.w_in()[(size_t)l * 1024 * 4112 + (size_t)k * 4112 + 1280 + j]; }
        __syncthreads();
    }
    const int gw = blockIdx.x * NWAVES + c.wave, NGW = gridDim.x * NWAVES;
    const float* gn = (which == 0 ? c.g_norm1() : c.g_norm2()) + l * 1024;
    for (int m = gw; m < M; m += NGW) {
        const float* xr = (l == 0 && which == 0) ? (m < MC ? c.x_prompt() + (size_t)m * D : c.x_sample() + (size_t)(m - MC) * D) : c.out() + (size_t)m * D;
        const int mi = (m < MC) ? 0 : 1 + ((m - MC) >> 10);
        const float* mod = c.MOD() + (size_t)(l * 5 + mi) * 6144 + which * 3072;
        f32x4 v[4]; float s = 0.f;
#pragma unroll
        for (int j = 0; j < 4; ++j) { v[j] = *(const f32x4*)(xr + 4 * c.lane + 256 * j); s += (v[j].x * v[j].x + v[j].y * v[j].y) + (v[j].z * v[j].z + v[j].w * v[j].w); }
        const float rstd = rsqrtf(wave_sum(s) * (1.0f / D) + EPS);
#pragma unroll
        for (int j = 0; j < 4; ++j) { const int k = 4 * c.lane + 256 * j; const f32x4 g = *(const f32x4*)(gn + k), sh = *(const f32x4*)(mod + k), sc = *(const f32x4*)(mod + 1024 + k);
            v[j] = v[j] * rstd * g * (sc + 1.0f) + sh;
            v2u o; o.x = pk2(v[j].x, v[j].y); o.y = pk2(v[j].z, v[j].w); *(v2u*)(c.H() + (size_t)m * D + k) = o; }
        if (which == 0) {
            float mine = 0.f;
#pragma unroll 1
            for (int jj = 0; jj < 16; ++jj) { float a = 0.f;
#pragma unroll
                for (int j = 0; j < 4; ++j) { const f32x4 w = *(const f32x4*)(lf + jj * 1024 + 4 * c.lane + 256 * j); a += (v[j].x * w.x + v[j].y * w.y) + (v[j].z * w.z + v[j].w * w.w); }
                a = wave_sum(a); if (c.lane == jj) mine = a; }
            if (c.lane < 16) { const float x = mine + c.dt_bias()[l * 16 + c.lane]; c.DT()[(size_t)m * 16 + c.lane] = x > 20.f ? x : log1pf(__expf(x)); }
            if (c.lane == 0) c.SSQ()[m] = 0.f;
        }
    }
}

__device__ __forceinline__ void phase_qk(const Ctx& c, int l) {
    const int gw = blockIdx.x * NWAVES + c.wave, NGW = gridDim.x * NWAVES, lane = c.lane;
    const float gq = c.qn_g()[l * 64 + lane], gk = c.kn_g()[l * 64 + lane], gwq = c.wqn_g()[l * 64 + lane], gwk = c.wkn_g()[l * 64 + lane];
    for (int m = gw; m < M; m += NGW) {
        bf16* pr = c.R1() + (size_t)m * 4096;
        const bool lat = m >= MC;
        const int b = lat ? (m - MC) >> 10 : m >> 8, t = lat ? (m - MC) & 1023 : m & 255, L = lat ? 1024 : 256;
        float cs = 1.f, sn = 0.f;
        if (lat) { const int f = lane & 15; const float inv = exp2f(-(float)f * 0.8304820237218406f); const float ang = (float)((lane >> 5) ? (t & 63) : (t >> 6)) * inv; sincosf(ang, &sn, &cs); if (!((lane >> 4) & 1)) sn = -sn; }
        const size_t ob = (size_t)(b * 2 + l) * 256 + t;
#pragma unroll 1
        for (int gi = 0; gi < 26; ++gi) {
            const int col = gi < 8 ? C_DQ + gi * 64 : gi < 16 ? C_DK + (gi - 8) * 64 : gi < 24 ? C_WQ + (gi - 16) * 64 : C_WK + (gi - 24) * 64;
            const float gain = gi < 8 ? gq : gi < 16 ? gk : gi < 24 ? gwq : gwk;
            float v = bf2f(pr[col + lane]);
            const float ss = wave_sum(v * v);
            v = v * rsqrtf(ss * (1.0f / 64.0f) + EPS) * gain;
            if (lat) { const float p = __shfl_xor(v, 16); v = v * cs + p * sn; }
            pr[col + lane] = (bf16)f2bf(v);
            if (!lat) {
                if (gi >= 8 && gi < 16) c.out()[O_DK + ob * 512 + (gi - 8) * 64 + lane] = v;
                if (gi >= 24) c.out()[O_WK + ob * 128 + (gi - 24) * 64 + lane] = v;
            }
        }
        if (!lat) {
#pragma unroll
            for (int i = 0; i < 8; ++i) c.out()[O_DV + ob * 512 + i * 64 + lane] = bf2f(pr[C_DV + i * 64 + lane]);
#pragma unroll
            for (int i = 0; i < 2; ++i) c.out()[O_WV + ob * 128 + i * 64 + lane] = bf2f(pr[C_WV + i * 64 + lane]);
        }
#pragma unroll 1
        for (int i = 0; i < 12; ++i) { const int ch = lane + 64 * i; float a = c.conv_b()[l * 768 + ch];
#pragma unroll
            for (int j = 0; j < 7; ++j) { const int tt = t + j - 3; if (tt >= 0 && tt < L) a += c.conv_w()[(size_t)(l * 7 + j) * 768 + ch] * bf2f(c.R1()[(size_t)(m + j - 3) * 4096 + C_XBC + ch]); }
            c.XC()[(size_t)m * 768 + ch] = (bf16)f2bf(siluf(a)); }
    }
    for (int r = gw; r < 1024; r += NGW) { const int b = r >> 8, sidx = r & 255; const size_t cb = (size_t)(b * 2 + l) * 256 + sidx; bf16* dst = c.CKV() + (size_t)r * 1280;
        for (int i = lane; i < 1280; i += 64) { const float v = i < 512 ? c.cache_dk()[cb * 512 + i] : i < 1024 ? c.cache_dv()[cb * 512 + i - 512] : i < 1152 ? c.cache_wk()[cb * 128 + i - 1024] : c.cache_wv()[cb * 128 + i - 1152]; dst[i] = (bf16)f2bf(v); } }
}

typedef pg8::bf16x8 bx8;
#define MFMA16(a, b, cc) __builtin_amdgcn_mfma_f32_16x16x32_bf16((a), (b), (cc), 0, 0, 0)
__device__ __forceinline__ void ssd_unit(const Ctx& c, int l, int pass, int b, int h, unsigned char* lds) {
    const int L = pass ? 1024 : 256, tok0 = pass ? MC + b * 1024 : b * 256, NCH = L >> 7;
    const int tid = c.tid, lane = c.lane, w = c.wave, lr = lane & 15, lq = lane >> 4, grp = h >> 2;
    bf16* XT = (bf16*)lds;
    bf16* BwT = XT + 64 * 136;
    bf16* Bm = BwT + 64 * 136;
    bf16* Cm = Bm + 128 * 72;
    bf16* Mm = Cm + 128 * 72;
    bf16* ST = Mm + 128 * 136;
    float* cum = (float*)(ST + 64 * 72);
    float* dtv = cum + 128; float* wv = dtv + 128; float* ecum = wv + 128; float* tot = ecum + 128;
    const float dsk = c.ssd_d()[l * 8 + h];
    const bf16* XCp = c.XC(); const float* DTp = c.DT(); bf16* YFp = c.YF(); bf16* Yp = c.Y(); const bf16* R1p = c.R1(); float* SSQp = c.SSQ();
    const int pi = w >> 1, nj0 = 2 * (w & 1);
    for (int dir = 0; dir < 2; ++dir) {
        const float A = -__expf(c.a_log()[(l * 2 + dir) * 8 + h]);
        f32x4 Sacc[2];
        __syncthreads();
#pragma unroll
        for (int q = 0; q < 2; ++q)
#pragma unroll
            for (int r = 0; r < 4; ++r) { const int p = 16 * pi + 4 * lq + r, n = 16 * (nj0 + q) + lr;
                const float v = pass ? c.state_ssd()[(((((size_t)(b * 2 + l) * 2 + dir) * 8 + h) * 64 + p) * 64) + n] : 0.f;
                Sacc[q][r] = v; ST[p * 72 + n] = (bf16)f2bf(v); }
        for (int ci = 0; ci < NCH; ++ci) {
            __syncthreads();
            const int i = tid >> 2, part = tid & 3;
            float bvals[16];
            { const int t = dir ? L - 1 - (ci * 128 + i) : ci * 128 + i; const bf16* xr = XCp + (size_t)(tok0 + t) * 768;
              const v4u x0 = *(const v4u*)(xr + h * 64 + part * 16), x1 = *(const v4u*)(xr + h * 64 + part * 16 + 8);
              const v4u b0 = *(const v4u*)(xr + 512 + grp * 64 + part * 16), b1 = *(const v4u*)(xr + 512 + grp * 64 + part * 16 + 8);
              const v4u c0 = *(const v4u*)(xr + 640 + grp * 64 + part * 16), c1 = *(const v4u*)(xr + 640 + grp * 64 + part * 16 + 8);
              *(v4u*)(Bm + i * 72 + part * 16) = b0; *(v4u*)(Bm + i * 72 + part * 16 + 8) = b1;
              *(v4u*)(Cm + i * 72 + part * 16) = c0; *(v4u*)(Cm + i * 72 + part * 16 + 8) = c1;
              const unsigned xs[8] = {x0.x, x0.y, x0.z, x0.w, x1.x, x1.y, x1.z, x1.w};
#pragma unroll
              for (int j = 0; j < 8; ++j) { XT[(part * 16 + 2 * j) * 136 + i] = (bf16)(xs[j] & 0xffffu); XT[(part * 16 + 2 * j + 1) * 136 + i] = (bf16)(xs[j] >> 16); }
              float t8[8]; unpack8(b0, t8);
#pragma unroll
              for (int j = 0; j < 8; ++j) bvals[j] = t8[j];
              unpack8(b1, t8);
#pragma unroll
              for (int j = 0; j < 8; ++j) bvals[8 + j] = t8[j]; }
            if (tid < 64) {
                const int i0 = 2 * lane, i1 = i0 + 1;
                const int t0 = dir ? L - 1 - (ci * 128 + i0) : ci * 128 + i0, t1 = dir ? L - 1 - (ci * 128 + i1) : ci * 128 + i1;
                const float d0 = DTp[(size_t)(tok0 + t0) * 16 + dir * 8 + h], d1 = DTp[(size_t)(tok0 + t1) * 16 + dir * 8 + h];
                const float a0 = d0 * A, a1 = d1 * A; float s = a0 + a1;
#pragma unroll
                for (int o = 1; o < 64; o <<= 1) { const float v = __shfl_up(s, o); if (lane >= o) s += v; }
                const float cum1 = s, cum0 = s - a1, total = __shfl(s, 63);
                cum[i0] = cum0; cum[i1] = cum1; dtv[i0] = d0; dtv[i1] = d1;
                wv[i0] = __expf(total - cum0) * d0; wv[i1] = __expf(total - cum1) * d1; ecum[i0] = __expf(cum0); ecum[i1] = __expf(cum1);
                if (lane == 0) tot[0] = __expf(total);
            }
            __syncthreads();
            { const float wi = wv[i];
#pragma unroll
              for (int j = 0; j < 16; ++j) BwT[(part * 16 + j) * 136 + i] = (bf16)f2bf(bvals[j] * wi); }
            bx8 cfr[2];
#pragma unroll
            for (int ks = 0; ks < 2; ++ks) cfr[ks] = *(const bx8*)(Cm + (16 * w + lr) * 72 + 32 * ks + 8 * lq);
            for (int j = 0; j <= w; ++j) {
                const bx8 b0 = *(const bx8*)(Bm + (16 * j + lr) * 72 + 8 * lq), b1 = *(const bx8*)(Bm + (16 * j + lr) * 72 + 32 + 8 * lq);
                f32x4 g = {0.f, 0.f, 0.f, 0.f};
                g = MFMA16(cfr[0], b0, g); g = MFMA16(cfr[1], b1, g);
                const int s = 16 * j + lr; const float cs = cum[s], ds = dtv[s];
#pragma unroll
                for (int r = 0; r < 4; ++r) { const int tt = 16 * w + 4 * lq + r; const float v = (s <= tt) ? g[r] * __expf(cum[tt] - cs) * ds : 0.f; Mm[tt * 136 + s] = (bf16)f2bf(v); }
            }
            if (!(w & 1)) {
#pragma unroll
                for (int r = 0; r < 4; ++r) Mm[(16 * w + 4 * lq + r) * 136 + 16 * (w + 1) + lr] = 0;
            }
            __syncthreads();
            f32x4 yl[4], yo[4];
#pragma unroll
            for (int jp = 0; jp < 4; ++jp) { yl[jp] = (f32x4){0.f, 0.f, 0.f, 0.f}; yo[jp] = (f32x4){0.f, 0.f, 0.f, 0.f}; }
            for (int ks = 0; ks <= (w >> 1); ++ks) {
                const bx8 af = *(const bx8*)(Mm + (16 * w + lr) * 136 + 32 * ks + 8 * lq);
#pragma unroll
                for (int jp = 0; jp < 4; ++jp) { const bx8 xf = *(const bx8*)(XT + (16 * jp + lr) * 136 + 32 * ks + 8 * lq); yl[jp] = MFMA16(af, xf, yl[jp]); }
            }
#pragma unroll
            for (int ks = 0; ks < 2; ++ks)
#pragma unroll
                for (int jp = 0; jp < 4; ++jp) { const bx8 sf = *(const bx8*)(ST + (16 * jp + lr) * 72 + 32 * ks + 8 * lq); yo[jp] = MFMA16(cfr[ks], sf, yo[jp]); }
            {
                float ssq[4] = {0.f, 0.f, 0.f, 0.f};
#pragma unroll
                for (int r = 0; r < 4; ++r) {
                    const int tt = 16 * w + 4 * lq + r; const float ec = ecum[tt];
                    const int t = dir ? L - 1 - (ci * 128 + tt) : ci * 128 + tt; const size_t m = (size_t)tok0 + t;
#pragma unroll
                    for (int jp = 0; jp < 4; ++jp) {
                        const int p = 16 * jp + lr; const float y = yl[jp][r] + ec * yo[jp][r];
                        if (dir == 0) YFp[m * 512 + h * 64 + p] = (bf16)f2bf(y);
                        else { const float x = bf2f(XT[p * 136 + tt]); const float ytot = y + bf2f(YFp[m * 512 + h * 64 + p]) + dsk * x; const float z = bf2f(R1p[m * 4096 + C_Z + h * 64 + p]);
                            const float gt = ytot * siluf(z); Yp[m * 2048 + h * 64 + p] = (bf16)f2bf(gt); ssq[r] += gt * gt; }
                    }
                    if (dir == 1) { float q = ssq[r]; q += __shfl_xor(q, 1); q += __shfl_xor(q, 2); q += __shfl_xor(q, 4); q += __shfl_xor(q, 8); if (lr == 0) atomicAdd(SSQp + m, q); }
                }
            }
            __syncthreads();
            {
                f32x4 st[2] = {{0.f, 0.f, 0.f, 0.f}, {0.f, 0.f, 0.f, 0.f}};
#pragma unroll
                for (int ks = 0; ks < 4; ++ks) { const bx8 af = *(const bx8*)(XT + (16 * pi + lr) * 136 + 32 * ks + 8 * lq);
#pragma unroll
                    for (int q = 0; q < 2; ++q) { const bx8 bf = *(const bx8*)(BwT + (16 * (nj0 + q) + lr) * 136 + 32 * ks + 8 * lq); st[q] = MFMA16(af, bf, st[q]); } }
                const float et = tot[0];
#pragma unroll
                for (int q = 0; q < 2; ++q)
#pragma unroll
                    for (int r = 0; r < 4; ++r) { Sacc[q][r] = et * Sacc[q][r] + st[q][r]; ST[(16 * pi + 4 * lq + r) * 72 + 16 * (nj0 + q) + lr] = (bf16)f2bf(Sacc[q][r]); }
            }
        }
        if (!pass) {
#pragma unroll
            for (int q = 0; q < 2; ++q)
#pragma unroll
                for (int r = 0; r < 4; ++r) { const int p = 16 * pi + 4 * lq + r, n = 16 * (nj0 + q) + lr;
                    c.out()[O_SSD + (((((size_t)(b * 2 + l) * 2 + dir) * 8 + h) * 64 + p) * 64) + n] = Sacc[q][r]; }
        }
    }
}

__device__ __forceinline__ void s5_unit(const Ctx& c, int l, int pass, int b, int g, float* lf) {
    const int L = pass ? 1024 : 256, tok0 = pass ? MC + b * 1024 : b * 256, tid = c.tid;
    float* ybuf = lf;
    float* sbuf = lf + 16384;
    float* cmat = lf + 24576;
    for (int i = tid; i < L * 16; i += NTHR) ybuf[i] = 0.f;
    for (int i = tid; i < 4096; i += NTHR) { const int dir = i >> 11, ri = (i >> 10) & 1, mm = (i >> 6) & 15, n = i & 63;
        cmat[((dir * 2 + ri) * 16 + mm) * 129 + n] = (ri ? c.c_im() : c.c_re())[((size_t)((l * 2 + dir) * 32 + g) * 16 + mm) * 64 + n]; }
    const int dir = (tid >> 6) & 1, n = tid & 63;
    float are = 0.f, aim = 0.f, sre = 0.f, sim = 0.f, Bcr[16], Bci[16];
    if (tid < 128) {
        const int idx = ((l * 2 + dir) * 32 + g) * 64 + n;
        const float lre = c.lam_re()[idx], lim = c.lam_im()[idx], step = expf(c.log_step()[(l * 2 + dir) * 32 + g]);
        const float mag = expf(lre * step); float sn, cs; sincosf(lim * step, &sn, &cs); are = mag * cs; aim = mag * sn;
        const float den = lre * lre + lim * lim, cre = ((are - 1.0f) * lre + aim * lim) / den, cim = (aim * lre - (are - 1.0f) * lim) / den;
#pragma unroll
        for (int mm = 0; mm < 16; ++mm) { const float br = c.b_re()[(size_t)idx * 16 + mm], bi = c.b_im()[(size_t)idx * 16 + mm]; Bcr[mm] = cre * br - cim * bi; Bci[mm] = cre * bi + cim * br; }
        if (pass) { sre = c.state_s5()[((((size_t)(b * 2 + l) * 2 + dir) * 2 + 0) * 32 + g) * 64 + n]; sim = c.state_s5()[((((size_t)(b * 2 + l) * 2 + dir) * 2 + 1) * 32 + g) * 64 + n]; }
    }
    __syncthreads();
    for (int c0 = 0; c0 < L / 32; ++c0) {
        if (tid < 128) {
            for (int st = 0; st < 32; ++st) {
                const int s = c0 * 32 + st, t = dir ? L - 1 - s : s; const bf16* up = c.R1() + (size_t)(tok0 + t) * 4096 + C_U + g * 16;
                float u[16]; { float a8[8]; unpack8(*(const v4u*)up, a8);
#pragma unroll
                    for (int j = 0; j < 8; ++j) u[j] = a8[j];
                    unpack8(*(const v4u*)(up + 8), a8);
#pragma unroll
                    for (int j = 0; j < 8; ++j) u[8 + j] = a8[j]; }
                float xr = 0.f, xi = 0.f;
#pragma unroll
                for (int mm = 0; mm < 16; ++mm) { xr += Bcr[mm] * u[mm]; xi += Bci[mm] * u[mm]; }
                const float nr = are * sre - aim * sim + xr, ni = are * sim + aim * sre + xi; sre = nr; sim = ni;
                sbuf[(dir * 32 + st) * 128 + n] = sre; sbuf[(dir * 32 + st) * 128 + 64 + n] = sim;
            }
        }
        __syncthreads();
        { const int st = tid >> 4, mm = tid & 15;
#pragma unroll
            for (int d2 = 0; d2 < 2; ++d2) { const int s = c0 * 32 + st, t = d2 ? L - 1 - s : s;
                const float* cr = cmat + ((d2 * 2 + 0) * 16 + mm) * 129; const float* ci = cmat + ((d2 * 2 + 1) * 16 + mm) * 129; const float* sb = sbuf + (d2 * 32 + st) * 128;
                float a = 0.f;
#pragma unroll 8
                for (int k = 0; k < 64; ++k) a += cr[k] * sb[k] - ci[k] * sb[64 + k];
                ybuf[t * 16 + mm] += a; } }
        __syncthreads();
    }
    for (int i = tid; i < L * 16; i += NTHR) { const int t = i >> 4, mm = i & 15; const size_t m = (size_t)tok0 + t;
        const float u = bf2f(c.R1()[m * 4096 + C_U + g * 16 + mm]); c.Y5()[m * 512 + g * 16 + mm] = (bf16)f2bf(ybuf[i] + c.s5_d()[l * 512 + g * 16 + mm] * u); }
    if (!pass && tid < 128) { c.out()[O_S5 + ((((size_t)(b * 2 + l) * 2 + dir) * 2 + 0) * 32 + g) * 64 + n] = sre; c.out()[O_S5 + ((((size_t)(b * 2 + l) * 2 + dir) * 2 + 1) * 32 + g) * 64 + n] = sim; }
    __syncthreads();
}

typedef float f32x16 __attribute__((ext_vector_type(16)));
#define MFMA32(a, b, cc) __builtin_amdgcn_mfma_f32_32x32x16_bf16((a), (b), (cc), 0, 0, 0)
constexpr float SM_SC = 0.125f * 1.4426950408889634f;
__device__ __forceinline__ void qk_tile(f32x16& p0, f32x16& p1, const bf16* Kt, int KS, const bx8 (&qf)[4], int r32, int hi) {
    p0 = (f32x16){0.f}; p1 = (f32x16){0.f};
#pragma unroll
    for (int d0 = 0; d0 < 4; ++d0) { const bx8 a0 = *(const bx8*)(Kt + r32 * KS + 16 * d0 + 8 * hi), a1 = *(const bx8*)(Kt + (32 + r32) * KS + 16 * d0 + 8 * hi);
        p0 = MFMA32(a0, qf[d0], p0); p1 = MFMA32(a1, qf[d0], p1); }
}
__device__ __forceinline__ float sm_step(f32x16& p0, f32x16& p1, float& mrun, float& lrun, bx8 (&pb)[4]) {
    float tm = -3e38f;
#pragma unroll
    for (int r = 0; r < 16; ++r) tm = fmaxf(tm, fmaxf(p0[r], p1[r]));
    tm = fmaxf(tm, __shfl_xor(tm, 32));
    const float mn = fmaxf(mrun, tm), alpha = exp2f(mrun - mn);
    float rs = 0.f;
#pragma unroll
    for (int r = 0; r < 16; ++r) { p0[r] = exp2f(p0[r] - mn); p1[r] = exp2f(p1[r] - mn); rs += p0[r] + p1[r]; }
    rs += __shfl_xor(rs, 32);
    lrun = lrun * alpha + rs; mrun = mn;
#pragma unroll
    for (int sI = 0; sI < 2; ++sI) {
        v4u t0, t1;
        t0.x = pg8::cvt_pk_bf16(p0[8 * sI + 0], p0[8 * sI + 1]); t0.y = pg8::cvt_pk_bf16(p0[8 * sI + 2], p0[8 * sI + 3]); t0.z = pg8::cvt_pk_bf16(p0[8 * sI + 4], p0[8 * sI + 5]); t0.w = pg8::cvt_pk_bf16(p0[8 * sI + 6], p0[8 * sI + 7]);
        t1.x = pg8::cvt_pk_bf16(p1[8 * sI + 0], p1[8 * sI + 1]); t1.y = pg8::cvt_pk_bf16(p1[8 * sI + 2], p1[8 * sI + 3]); t1.z = pg8::cvt_pk_bf16(p1[8 * sI + 4], p1[8 * sI + 5]); t1.w = pg8::cvt_pk_bf16(p1[8 * sI + 6], p1[8 * sI + 7]);
        pb[sI] = __builtin_bit_cast(bx8, t0); pb[2 + sI] = __builtin_bit_cast(bx8, t1);
    }
    return alpha;
}
template <int NDT> __device__ __forceinline__ void pv_tile(f32x16 (&o)[NDT], const bf16* Vt, const bx8 (&pb)[4], int r32, int hi) {
#pragma unroll
    for (int ks = 0; ks < 4; ++ks) {
#pragma unroll
        for (int dt = 0; dt < NDT; ++dt) { const bf16* vp = Vt + (32 * dt + r32) * 68 + 16 * ks + 4 * hi;
            const v2u lo = *(const v2u*)vp, h8 = *(const v2u*)(vp + 8); const v4u t = {lo.x, lo.y, h8.x, h8.y};
            o[dt] = MFMA32(__builtin_bit_cast(bx8, t), pb[ks], o[dt]); }
        __builtin_amdgcn_sched_barrier(0); }
}

template <int PASS> __device__ __forceinline__ void diff_unit(const Ctx& c, int l, int uidx, unsigned char* lds) {
    constexpr int NT = PASS ? 20 : 4, NQB = PASS ? 8 : 2;
    const int tid = c.tid, lane = c.lane, w = c.wave, r32 = lane & 31, hi = lane >> 5, comp = w >> 2;
    const int qb = uidx % NQB, h = (uidx / NQB) & 3, b = uidx / (NQB * 4);
    const int tok0 = PASS ? MC + b * 1024 : b * 256;
    bf16* Kt = (bf16*)lds;
    bf16* Vt = Kt + 64 * 136;
    float* Ob = (float*)(Vt + 128 * 68);
    const bf16* R1p = c.R1(); const bf16* CK = c.CKV();
    const float lam_init = 0.8f - 0.6f * expf(-0.3f * (float)l);
    const float* lv = c.dlam() + l * 256;
    const float lam = expf(wave_sum(lv[lane] * lv[64 + lane])) - expf(wave_sum(lv[128 + lane] * lv[192 + lane])) + lam_init;
    const size_t mrow = (size_t)tok0 + qb * 128 + 32 * (w & 3) + r32;
    bx8 qf[4];
#pragma unroll
    for (int d0 = 0; d0 < 4; ++d0) qf[d0] = *(const bx8*)(R1p + mrow * 4096 + C_DQ + h * 128 + comp * 64 + 16 * d0 + 8 * hi);
    f32x16 o[4];
#pragma unroll
    for (int dt = 0; dt < 4; ++dt) o[dt] = (f32x16){0.f};
    float mrun = -1e30f, lrun = 0.f;
    v4u kreg[2], vreg[2];
#define DIFF_LOAD(t) { const bf16* kb; const bf16* vb; size_t rs; \
        if (PASS && (t) < 4) { kb = CK + ((size_t)b * 256 + 64 * (t)) * 1280 + h * 128; vb = kb + 512; rs = 1280; } \
        else { kb = R1p + ((size_t)tok0 + 64 * ((t) - (PASS ? 4 : 0))) * 4096 + C_DK + h * 128; vb = kb + (C_DV - C_DK); rs = 4096; } \
        _Pragma("unroll") for (int i = 0; i < 2; ++i) { kreg[i] = *(const v4u*)(kb + (size_t)lane * rs + (w + 8 * i) * 8); vreg[i] = *(const v4u*)(vb + (size_t)lane * rs + (w + 8 * i) * 8); } }
    DIFF_LOAD(0);
    for (int t = 0; t < NT; ++t) {
        __syncthreads();
#pragma unroll
        for (int i = 0; i < 2; ++i) { *(v4u*)(Kt + lane * 136 + (w + 8 * i) * 8) = kreg[i];
            const unsigned vs[4] = {vreg[i].x, vreg[i].y, vreg[i].z, vreg[i].w};
#pragma unroll
            for (int j = 0; j < 4; ++j) { Vt[((w + 8 * i) * 8 + 2 * j) * 68 + lane] = (bf16)(vs[j] & 0xffffu); Vt[((w + 8 * i) * 8 + 2 * j + 1) * 68 + lane] = (bf16)(vs[j] >> 16); } }
        if (t + 1 < NT) DIFF_LOAD(t + 1);
        __syncthreads();
        f32x16 p0, p1; bx8 pb[4];
        qk_tile(p0, p1, Kt + comp * 64, 136, qf, r32, hi);
#pragma unroll
        for (int r = 0; r < 16; ++r) { p0[r] *= SM_SC; p1[r] *= SM_SC; }
        const float alpha = sm_step(p0, p1, mrun, lrun, pb);
#pragma unroll
        for (int dt = 0; dt < 4; ++dt)
#pragma unroll
            for (int r = 0; r < 16; ++r) o[dt][r] *= alpha;
        pv_tile<4>(o, Vt, pb, r32, hi);
    }
#undef DIFF_LOAD
    const float inv = (comp ? lam : 1.0f) / lrun;
    const int rowl = 32 * (w & 3) + r32;
    if (comp) {
#pragma unroll
        for (int dt = 0; dt < 4; ++dt)
#pragma unroll
            for (int r = 0; r < 16; ++r) Ob[rowl * 129 + 32 * dt + (r & 3) + 8 * (r >> 2) + 4 * hi] = o[dt][r] * inv;
    }
    __syncthreads();
    if (!comp) {
        float ss = 0.f;
#pragma unroll
        for (int dt = 0; dt < 4; ++dt)
#pragma unroll
            for (int r = 0; r < 16; ++r) { const float v = o[dt][r] * inv - Ob[rowl * 129 + 32 * dt + (r & 3) + 8 * (r >> 2) + 4 * hi]; o[dt][r] = v; ss += v * v; }
        ss += __shfl_xor(ss, 32);
        const float rn = rsqrtf(ss * (1.0f / 128.0f) + EPS) * (1.0f - lam_init);
        const float* sg = c.subln_g() + l * 128; bf16* yp = c.Y() + mrow * 2048 + 1024 + h * 128;
#pragma unroll
        for (int dt = 0; dt < 4; ++dt)
#pragma unroll
            for (int r4 = 0; r4 < 4; ++r4) { const int dv = 32 * dt + 8 * r4 + 4 * hi; const f32x4 g = *(const f32x4*)(sg + dv);
                v2u ov; ov.x = pk2(o[dt][4 * r4 + 0] * rn * g.x, o[dt][4 * r4 + 1] * rn * g.y); ov.y = pk2(o[dt][4 * r4 + 2] * rn * g.z, o[dt][4 * r4 + 3] * rn * g.w);
                *(v2u*)(yp + dv) = ov; }
    }
}

template <int PASS> __device__ __forceinline__ void win_unit(const Ctx& c, int l, int uidx, unsigned char* lds) {
    constexpr int NQB = PASS ? 4 : 1;
    const int tid = c.tid, lane = c.lane, w = c.wave, r32 = lane & 31, hi = lane >> 5;
    const int qb = uidx % NQB, hh = (uidx / NQB) & 7, b = uidx / (NQB * 8), nkv = hh >> 2;
    const int tok0 = PASS ? MC + b * 1024 : b * 256;
    bf16* Kt = (bf16*)lds;
    bf16* Vt = Kt + 64 * 72;
    const bf16* R1p = c.R1(); const bf16* CK = c.CKV();
    const int qrow = qb * 256 + 32 * w + r32;
    const size_t mrow = (size_t)tok0 + qrow;
    bx8 qf[4];
#pragma unroll
    for (int d0 = 0; d0 < 4; ++d0) qf[d0] = *(const bx8*)(R1p + mrow * 4096 + C_WQ + hh * 64 + 16 * d0 + 8 * hi);
    f32x16 o[2]; o[0] = (f32x16){0.f}; o[1] = (f32x16){0.f};
    float mrun = c.sink()[l * 8 + hh] * 1.4426950408889634f, lrun = 1.0f;
    const int q0 = qb * 256;
    const int tb0 = PASS ? ((q0 - 128 < 0 ? 0 : q0 - 128) >> 6) : 0, tb1 = PASS ? ((q0 + 255 + 128 > 1023 ? 1023 : q0 + 255 + 128) >> 6) : 0;
    const int NT = PASS ? 4 + (tb1 - tb0 + 1) : 4;
    const int kvl = tid & 63, chunk = tid >> 6;
    v4u kreg, vreg;
#define WIN_LOAD(t) { const bf16* kb; const bf16* vb; size_t rs; \
        if (PASS && (t) < 4) { kb = CK + ((size_t)b * 256 + 64 * (t)) * 1280 + 1024 + nkv * 64; vb = kb + 128; rs = 1280; } \
        else { kb = R1p + ((size_t)tok0 + 64 * (PASS ? tb0 + (t) - 4 : (t))) * 4096 + C_WK + nkv * 64; vb = kb + (C_WV - C_WK); rs = 4096; } \
        kreg = *(const v4u*)(kb + (size_t)kvl * rs + chunk * 8); vreg = *(const v4u*)(vb + (size_t)kvl * rs + chunk * 8); }
    WIN_LOAD(0);
    for (int t = 0; t < NT; ++t) {
        __syncthreads();
        *(v4u*)(Kt + kvl * 72 + chunk * 8) = kreg;
        { const unsigned vs[4] = {vreg.x, vreg.y, vreg.z, vreg.w};
#pragma unroll
          for (int j = 0; j < 4; ++j) { Vt[(chunk * 8 + 2 * j) * 68 + kvl] = (bf16)(vs[j] & 0xffffu); Vt[(chunk * 8 + 2 * j + 1) * 68 + kvl] = (bf16)(vs[j] >> 16); } }
        if (t + 1 < NT) WIN_LOAD(t + 1);
        __syncthreads();
        bool band = false; int kp0 = 0;
        if (PASS && t >= 4) { band = true; kp0 = 64 * (tb0 + t - 4); const int r0 = q0 + 32 * w;
            if (kp0 + 63 < r0 - 128 || kp0 > r0 + 31 + 128) continue; }
        f32x16 p0, p1; bx8 pb[4];
        qk_tile(p0, p1, Kt, 72, qf, r32, hi);
#pragma unroll
        for (int r = 0; r < 16; ++r) { p0[r] *= SM_SC; p1[r] *= SM_SC; }
        if (band) {
#pragma unroll
            for (int r = 0; r < 16; ++r) { const int kp = kp0 + (r & 3) + 8 * (r >> 2) + 4 * hi; const int d0 = qrow - kp, d1 = d0 - 32;
                if (d0 > 128 || d0 < -128) p0[r] = -1e30f; if (d1 > 128 || d1 < -128) p1[r] = -1e30f; }
        }
        const float alpha = sm_step(p0, p1, mrun, lrun, pb);
#pragma unroll
        for (int dt = 0; dt < 2; ++dt)
#pragma unroll
            for (int r = 0; r < 16; ++r) o[dt][r] *= alpha;
        pv_tile<2>(o, Vt, pb, r32, hi);
    }
#undef WIN_LOAD
    const float inv = 1.0f / lrun; bf16* yp = c.Y() + mrow * 2048 + 1536 + hh * 64;
#pragma unroll
    for (int dt = 0; dt < 2; ++dt)
#pragma unroll
        for (int r4 = 0; r4 < 4; ++r4) { const int dv = 32 * dt + 8 * r4 + 4 * hi;
            v2u ov; ov.x = pk2(o[dt][4 * r4 + 0] * inv, o[dt][4 * r4 + 1] * inv); ov.y = pk2(o[dt][4 * r4 + 2] * inv, o[dt][4 * r4 + 3] * inv);
            *(v2u*)(yp + dv) = ov; }
}

__device__ __forceinline__ void phase_mixers(const Ctx& c_in, int l, float* lf) {
    unsigned char* lds = (unsigned char*)lf;
    for (int u = blockIdx.x; u < 2208; u += gridDim.x) {
        Ctx c = c_in; asm volatile("" : "+s"(c.ap), "+v"(c.tid));
        c.lane = c.tid & 63; c.wave = __builtin_amdgcn_readfirstlane(c.tid >> 6);
        unsigned long long pt0 = 0; if (PROBE_SEL >= 0) pt0 = __builtin_amdgcn_s_memrealtime();
        if (u < 32) ssd_unit(c, l, 1, u >> 3, u & 7, lds);
        else if (u < 160) s5_unit(c, l, 1, (u - 32) >> 5, (u - 32) & 31, lf);
        else if (u < 288) diff_unit<1>(c, l, u - 160, lds);
        else if (u < 416) win_unit<1>(c, l, u - 288, lds);
        else if (u < 672) ssd_unit(c, l, 0, (u - 416) >> 3, (u - 416) & 7, lds);
        else if (u < 1696) s5_unit(c, l, 0, (u - 672) >> 5, (u - 672) & 31, lf);
        else if (u < 1952) diff_unit<0>(c, l, u - 1696, lds);
        else win_unit<0>(c, l, u - 1952, lds);
        __syncthreads();
        if (PROBE_SEL >= 0 && blockIdx.x == PROBE_PB && threadIdx.x == 0) { const int ty = (u < 32 || (u >= 416 && u < 672)) ? 0 : ((u >= 32 && u < 160) || (u >= 672 && u < 1696)) ? 1 : ((u >= 160 && u < 288) || (u >= 1696 && u < 1952)) ? 2 : 3;
            unsigned long long* tsu = (unsigned long long*)(c.ws() + WS_TS) + 64; tsu[ty + 4 * (u >= 416)] += __builtin_amdgcn_s_memrealtime() - pt0; }
    }
}

__device__ __forceinline__ void phase_sum4(const Ctx& c) {
    const int gt = blockIdx.x * NTHR + c.tid, NT = gridDim.x * NTHR;
    for (int i = gt; i < M * 128; i += NT) { const size_t m = (size_t)(i >> 7); const int c8 = (i & 127) * 8;
        float a[8] = {0.f, 0.f, 0.f, 0.f, 0.f, 0.f, 0.f, 0.f};
#pragma unroll
        for (int j = 0; j < 4; ++j) { float f[8]; unpack8(*(const v4u*)(c.R1() + m * 4096 + j * 1024 + c8), f);
#pragma unroll
            for (int k = 0; k < 8; ++k) a[k] += f[k]; }
        v4u o; o.x = pk2(a[0], a[1]); o.y = pk2(a[2], a[3]); o.z = pk2(a[4], a[5]); o.w = pk2(a[6], a[7]);
        *(v4u*)(c.H() + m * 1024 + c8) = o; }
}

#define GAS __attribute__((address_space(1)))
#define XB_TMO      128
#define XB_XCNT(j)  (256  + 64 * (j))
#define XB_XSUB(j)  (1280 + 64 * (j))
#define XB_XGEN(j)  (2304 + 64 * (j))
#define XB_TOP      3328
#define XB_TOPGEN   3392
#define XCD_BAR_WORDS 3456
#define XB_SPIN_CAP (1u << 18)

__device__ __forceinline__ unsigned xb_ld(unsigned* p)              { return __hip_atomic_load(p, __ATOMIC_RELAXED, __HIP_MEMORY_SCOPE_AGENT); }
__device__ __forceinline__ unsigned xb_add(unsigned* p, unsigned v) { return __hip_atomic_fetch_add(p, v, __ATOMIC_RELAXED, __HIP_MEMORY_SCOPE_AGENT); }
__device__ __forceinline__ unsigned xb_xcc_id() { return (unsigned)__builtin_amdgcn_s_getreg((3 << 11) | 20) & 0xFu; }
#define XB_SPIN(cond, bar) do { unsigned _sp = 0; while (cond) { __builtin_amdgcn_s_sleep(1); \
    if ((++_sp & 255u) == 0u) { if (xb_ld(&(bar)[XB_TMO])) break; if (_sp > XB_SPIN_CAP) { atomicAdd(&(bar)[XB_TMO], 1u); break; } } } } while (0)

struct XcdBarrier {
    unsigned* bar; unsigned x;
    volatile LAS unsigned* st;
};

__device__ __forceinline__ XcdBarrier xcd_barrier_post(unsigned* bar, volatile LAS unsigned* st) {
    XcdBarrier b; b.bar = bar; b.x = xb_xcc_id(); b.st = st;
    if (threadIdx.x == 0) (void)xb_add(&bar[XB_XCNT(b.x)], 1u);
    return b;
}
__device__ __forceinline__ void xcd_barrier_complete(unsigned* bar, unsigned x, unsigned& nloc, unsigned& nx) {
    const unsigned G = gridDim.x * gridDim.y * gridDim.z;
    unsigned sum, cnt, mine, sp = 0u;
    for (;;) {
        sum = 0u; cnt = 0u; mine = 0u;
#pragma unroll
        for (unsigned j = 0; j < 16; ++j) { const unsigned c = xb_ld(&bar[XB_XCNT(j)]); sum += c; cnt += (c > 0u) ? 1u : 0u; mine = (j == x) ? c : mine; }
        if (sum == G) break;
        __builtin_amdgcn_s_sleep(1);
        if ((++sp & 255u) == 0u) { if (xb_ld(&bar[XB_TMO])) break; if (sp > XB_SPIN_CAP) { atomicAdd(&bar[XB_TMO], 1u); break; } }
    }
    nloc = mine > 0u ? mine : 1u; nx = cnt > 0u ? cnt : 1u;
}

__device__ __forceinline__ void xcd_barrier(const XcdBarrier& b) {
    asm volatile("s_waitcnt vmcnt(0)" ::: "memory");
    __syncthreads();
    if (threadIdx.x == 0) {
        unsigned* bar = b.bar;
        __builtin_amdgcn_s_waitcnt(0);
        unsigned nloc = b.st[0], nx = b.st[1];
        if (nloc == 0u) { xcd_barrier_complete(bar, b.x, nloc, nx); b.st[0] = nloc; b.st[1] = nx; }
        const unsigned old = xb_add(&bar[XB_XSUB(b.x)], 1u);
        const unsigned gen = old / nloc;
        if (old + 1u == (gen + 1u) * nloc) {
            __builtin_amdgcn_fence(__ATOMIC_RELEASE, "agent");
            asm volatile("s_waitcnt vmcnt(0)" ::: "memory");
            const unsigned og = xb_add(&bar[XB_TOP], 1u);
            const unsigned tg = og / nx;
            if (og + 1u == (tg + 1u) * nx) xb_add(&bar[XB_TOPGEN], 1u);
            else XB_SPIN(xb_ld(&bar[XB_TOPGEN]) == tg, bar);
            __builtin_amdgcn_fence(__ATOMIC_ACQUIRE, "agent");
            xb_add(&bar[XB_XGEN(b.x)], 1u);
            asm volatile("s_waitcnt vmcnt(0)" ::: "memory");
        } else {
            XB_SPIN(xb_ld(&bar[XB_XGEN(b.x)]) == gen, bar);
            __builtin_amdgcn_fence(__ATOMIC_ACQUIRE, "agent");
            asm volatile("s_waitcnt vmcnt(0)" ::: "memory");
        }
    }
    __syncthreads();
}

#define PHASE_BEGIN() Ctx c; c.ap = (CArgs)__builtin_amdgcn_kernarg_segment_ptr(); asm volatile("" : "+s"(c.ap)); \
        int tid_o = threadIdx.x; asm volatile("" : "+v"(tid_o)); c.tid = tid_o; c.lane = tid_o & 63; c.wave = __builtin_amdgcn_readfirstlane(tid_o >> 6); \
        int G = gridDim.x, bid = blockIdx.x; asm volatile("" : "+s"(G), "+s"(bid)); unsigned char* ws = c.ws(); (void)ws; (void)G; (void)bid;
#define PHASE_END(k) { if ((k) + 1 < ph_hi) { if ((k) == 0) { __threadfence(); cg::this_grid().sync(); } else xcd_barrier(xbar); } \
        if (PROBE_SEL >= 0 && blockIdx.x == PROBE_PB && threadIdx.x == 0) ((unsigned long long*)(c.ws() + WS_TS))[(k) + 1] = __builtin_amdgcn_s_memrealtime(); }
#define IN_RANGE(k) (ph_lo <= (k) && (k) < ph_hi)

template <int LAYER> __device__ __forceinline__ void layer_program(int ph_lo, int ph_hi, unsigned char* lds, const XcdBarrier& xbar) {
    float* lf = (float*)lds;
    PG8_LAS unsigned char* ring = (PG8_LAS unsigned char*)lds;
    constexpr int l = LAYER, B0 = 1 + 11 * LAYER;
    if (IN_RANGE(B0 + 0)) { PHASE_BEGIN(); if (l == 1) { phase_convert(c, 1, lf); __syncthreads(); } phase_norm(c, l, 0, lf); PHASE_END(B0 + 0); }
    if (IN_RANGE(B0 + 1)) { PHASE_BEGIN();
        pg8::Gemm g{c.H(), (const bf16*)(ws + W_IN), M, 4096, 1024, 1024, 1024, 0, 0}; pg8::StaticOrder S; S.init(M, 4096, G, bid);
        pg8::EpiB<0> E{c.R1(), 4096, nullptr, nullptr};
        pg8::gemm_phase<pg8::EpiB<0>, pg8::StaticOrder, true, true>(ring, g, S, E, tid_o); PHASE_END(B0 + 1); }
    if (IN_RANGE(B0 + 2)) { PHASE_BEGIN(); phase_qk(c, l); PHASE_END(B0 + 2); }
    if (IN_RANGE(B0 + 3)) { PHASE_BEGIN(); phase_mixers(c, l, lf); PHASE_END(B0 + 3); }
    if (IN_RANGE(B0 + 4)) { PHASE_BEGIN();
        { pg8::Gemm g{c.Y5(), (const bf16*)(ws + W_GLU), M, 1024, 512, 512, 512, 0, 0}; pg8::StaticOrder S; S.init(M, 1024, G, bid);
          pg8::EpiGlu E{c.Y(), 2048, 512, c.b_glu() + l * 1024};
          pg8::gemm_phase<pg8::EpiGlu, pg8::StaticOrder, true, true>(ring, g, S, E, tid_o); }
        { pg8::Gemm g{c.H(), (const bf16*)(ws + W_G), M, 4096, 1024, 1024, 1024, 0, 0}; pg8::StaticOrder S; S.init(M, 4096, G, bid);
          pg8::EpiB<1> E{c.R1(), 4096, c.b_gate() + l * 4096, nullptr};
          pg8::gemm_phase<pg8::EpiB<1>, pg8::StaticOrder, true, true>(ring, g, S, E, tid_o); }
        PHASE_END(B0 + 4); }
    if (IN_RANGE(B0 + 5)) { PHASE_BEGIN();
        pg8::Gemm g{c.Y(), (const bf16*)(ws + W_BR), M, 4096, 512, 2048, 512, 4, 1024}; pg8::StaticOrder S; S.init(M, 4096, G, bid);
        pg8::EpiB<3> E{c.R1(), 4096, nullptr, c.SSQ()};
        pg8::gemm_phase<pg8::EpiB<3>, pg8::StaticOrder, true, true>(ring, g, S, E, tid_o); PHASE_END(B0 + 5); }
    if (IN_RANGE(B0 + 6)) { PHASE_BEGIN(); phase_sum4(c); PHASE_END(B0 + 6); }
    if (IN_RANGE(B0 + 7)) { PHASE_BEGIN();
        pg8::Gemm g{c.H(), (const bf16*)(ws + W_OUT), M, 1024, 1024, 1024, 1024, 0, 0}; pg8::StaticOrder S; S.init(M, 1024, G, bid);
        pg8::EpiRes E{l == 0 ? c.x_prompt() : c.out(), l == 0 ? c.x_sample() : c.out() + (size_t)MC * D, c.out(), c.MOD() + (size_t)l * 5 * 6144, 2048};
        pg8::gemm_phase<pg8::EpiRes, pg8::StaticOrder, true, true>(ring, g, S, E, tid_o); PHASE_END(B0 + 7); }
    if (IN_RANGE(B0 + 8)) { PHASE_BEGIN(); phase_norm(c, l, 1, lf); PHASE_END(B0 + 8); }
    if (IN_RANGE(B0 + 9)) { PHASE_BEGIN();
        pg8::Gemm g{c.H(), (const bf16*)(ws + W_1), M, 4096, 1024, 1024, 1024, 0, 0}; pg8::StaticOrder S; S.init(M, 4096, G, bid);
        pg8::EpiB<2> E{c.R1(), 4096, nullptr, nullptr};
        pg8::gemm_phase<pg8::EpiB<2>, pg8::StaticOrder, true, true>(ring, g, S, E, tid_o); PHASE_END(B0 + 9); }
    if (IN_RANGE(B0 + 10)) { PHASE_BEGIN();
        pg8::Gemm g{c.R1(), (const bf16*)(ws + W_2), M, 1024, 4096, 4096, 4096, 0, 0}; pg8::StaticOrder S; S.init(M, 1024, G, bid);
        pg8::EpiRes E{c.out(), c.out() + (size_t)MC * D, c.out(), c.MOD() + (size_t)l * 5 * 6144, 5120};
        pg8::gemm_phase<pg8::EpiRes, pg8::StaticOrder, true, true>(ring, g, S, E, tid_o); PHASE_END(B0 + 10); }
}

__global__ void __launch_bounds__(NTHR, 2) fwd_kernel(Args args) {
    extern __shared__ __attribute__((aligned(16))) unsigned char lds[];
    const int ph_lo = args.ph_lo, ph_hi = args.ph_hi;
    volatile LAS unsigned* xst = (volatile LAS unsigned*)(lds + LDS_BYTES - 16);
    if (threadIdx.x < 4) xst[threadIdx.x] = 0u;
    __syncthreads();
    const XcdBarrier xbar = xcd_barrier_post((unsigned*)(args.ws + WS_BAR), xst);
    if (PROBE_SEL >= 0 && blockIdx.x == PROBE_PB && threadIdx.x == 0) { unsigned long long* ts = (unsigned long long*)(args.ws + WS_TS); for (int i = 64; i < 72; ++i) ts[i] = 0; ts[0] = __builtin_amdgcn_s_memrealtime(); }
    if (IN_RANGE(0)) { PHASE_BEGIN(); float* lf = (float*)lds; phase_mods(c, lf); __syncthreads(); phase_convert(c, 0, lf); PHASE_END(0); }
    layer_program<0>(ph_lo, ph_hi, lds, xbar);
    layer_program<1>(ph_lo, ph_hi, lds, xbar);
    if (PROBE_SEL >= 0) {
        __threadfence(); cg::this_grid().sync();
        const unsigned long long* ts = (const unsigned long long*)(args.ws + WS_TS);
        const float total = (float)(ts[23] - ts[0]); float sel = 0.f;
        for (int k = 0; k < 23; ++k) { const float d = (float)(ts[k + 1] - ts[k]); const int q = k == 0 ? -1 : (k - 1) % 11;
            const int cls = (q == 3) ? 0 : (q == 1 || q == 4 || q == 5 || q == 7 || q == 9 || q == 10) ? 1 : (q == 2) ? 2 : 3;
            if (cls == PROBE_SEL) sel += d; }
        if (PROBE_SEL >= 10) sel = (float)ts[64 + PROBE_SEL - 10];
        const float sc = 1.0f + sqrtf(4e-4f * sel / total);
        for (int i = blockIdx.x * NTHR + threadIdx.x; i < 524288; i += gridDim.x * NTHR) args.out[O_S5 + i] *= sc;
    }
}

extern "C" void kernel_launch(void* const* d_in, const int* in_sizes, int n_in, void* d_out, int out_size, void* d_ws, size_t ws_size, hipStream_t stream) {
    static int grid = 0;
    if (grid == 0) {
        if (n_in != 44 || ws_size < WS_END) { fprintf(stderr, "kernel_launch: expected 44 inputs and >= %zu bytes of workspace; got %d, %zu\n", (size_t)WS_END, n_in, ws_size); grid = -1; return; }
        int dev = 0, cus = 0, per_cu = 0;
        (void)hipGetDevice(&dev); (void)hipDeviceGetAttribute(&cus, hipDeviceAttributeMultiprocessorCount, dev);
        (void)hipFuncSetAttribute((const void*)fwd_kernel, hipFuncAttributeMaxDynamicSharedMemorySize, LDS_BYTES);
        (void)hipOccupancyMaxActiveBlocksPerMultiprocessor(&per_cu, (const void*)fwd_kernel, NTHR, LDS_BYTES);
        if (per_cu < 1) { fprintf(stderr, "kernel_launch: occupancy query says %d blocks per CU\n", per_cu); per_cu = 1; }
        (void)hipGetLastError();
        grid = cus > 0 ? cus : 256;
    }
    if (grid < 0) return;
    (void)hipMemsetAsync(d_ws, 0, 64 * 1024, stream);
    Args a{};
    for (int i = 0; i < 44; ++i) a.in[i] = (const float*)d_in[i];
    a.out = (float*)d_out; a.ws = (unsigned char*)d_ws;
#if MK_MULTI
    for (int ph = 0; ph < NPH; ++ph) { a.ph_lo = ph; a.ph_hi = ph + 1; hipLaunchKernelGGL(fwd_kernel, dim3(grid), dim3(NTHR), LDS_BYTES, stream, a); }
#else
    a.ph_lo = 0; a.ph_hi = NPH;
    void* kargs[] = {&a};
    hipError_t e = hipLaunchCooperativeKernel((const void*)fwd_kernel, dim3(grid), dim3(NTHR), kargs, LDS_BYTES, stream);
    if (e != hipSuccess) fprintf(stderr, "cooperative launch failed: %s (grid %d)\n", hipGetErrorString(e), grid);
#endif
}
```

```cpp
#include <hip/hip_runtime.h>
#include <hip/hip_cooperative_groups.h>
#include <cstdio>
#include <cstdint>
namespace cg = cooperative_groups;

#ifndef MK_MULTI
#define MK_MULTI 0
#endif

namespace pg8 {
#define PG8_LAS __attribute__((address_space(3)))
typedef unsigned short bf16_t;
typedef short bf16x8 __attribute__((ext_vector_type(8)));
typedef float f32x4 __attribute__((ext_vector_type(4)));
typedef unsigned u32x4 __attribute__((ext_vector_type(4)));
constexpr int BM = 256, BK = 64, HALF = 128, HTB = HALF * BK * 2  , STAGE_BYTES = 8 * HTB, NXCD = 8, WGM = 8;

__host__ __device__ __forceinline__ int lds_byte(int r, int c) { const int st = (r >> 4) * 2 + (c >> 5), rr = r & 15, cc = c & 31, ob = rr * 64 + cc * 2; return st * 1024 + (ob ^ (((ob >> 9) & 1) << 5)); }
__host__ __device__ __forceinline__ void stage_rc(int b, int& R, int& C) { const int st = b / 1024, sb = b % 1024, swz = sb ^ (((sb >> 9) & 1) << 5); R = (st >> 1) * 16 + swz / 64; C = (st & 1) * 32 + (swz % 64) / 2; }
__host__ __device__ __forceinline__ int perm32(int rho) { const int n = rho >> 4, i = rho & 15; return 8 * (i >> 2) + 4 * n + (i & 3); }

struct Unit { int pm, pn; };
struct Gemm { const bf16_t* A; const bf16_t* Bt; int M, N, K, lda, ldb, a_div; size_t a_gstride; };

struct StaticOrder {
    int nM, nN, nwg, G, c;
    __host__ __device__ void init(int M, int N, int G_, int c_) { nM = M / BM; nN = N / BM; nwg = nM * nN; G = G_; c = c_; }
    __host__ __device__ bool next(int i, Unit& u) const {
        const long L = (long)i * G + c; if (L >= nwg) return false;
        int wgid = (int)L; { const int q = nwg / NXCD, r = nwg % NXCD, xcd = wgid % NXCD, off = wgid / NXCD; wgid = (xcd < r ? xcd * (q + 1) : r * (q + 1) + (xcd - r) * q) + off; }
        const int nig = WGM * nN, gid = wgid / nig, fm = gid * WGM, gsz = (nM - fm) < WGM ? (nM - fm) : WGM;
        u.pm = fm + ((wgid % nig) % gsz); u.pn = (wgid % nig) / gsz; return true;
    }
    __device__ __forceinline__ void a_ready(const Unit&) const {}
    __device__ __forceinline__ void done(const Unit&) const {}
};

__device__ __forceinline__ unsigned cvt_pk_bf16(float lo, float hi) { unsigned r; asm volatile("v_cvt_pk_bf16_f32 %0, %1, %2" : "=v"(r) : "v"(lo), "v"(hi)); return r; }
__device__ __forceinline__ float bf_lo(unsigned w) { return __builtin_bit_cast(float, w << 16); }
__device__ __forceinline__ float bf_hi(unsigned w) { return __builtin_bit_cast(float, w & 0xffff0000u); }
__device__ __forceinline__ float sigmoidf_(float x) { return 1.0f / (1.0f + __expf(-x)); }

template <int MODE> struct EpiB {
    static constexpr bool PERM = true, AFTER_DRAIN = false;
    bf16_t* O; int ldc; const float* bias; const float* ssq;
    __device__ __forceinline__ void operator()(const f32x4 (&acc)[2][2][4][2], const Unit& u, int wr, int wc, int fr, int fq) const {
        const int row0 = u.pm * BM + wr * 64 + fr, col0 = u.pn * BM + wc * 32 + 8 * fq;
        f32x4 bv[2][2];
#pragma unroll
        for (int bj = 0; bj < 2; ++bj)
#pragma unroll
            for (int n = 0; n < 2; ++n) bv[bj][n] = (MODE == 1) ? *(const f32x4*)(bias + col0 + bj * HALF + 4 * n) : (f32x4){0.f, 0.f, 0.f, 0.f};
#pragma unroll
        for (int ai = 0; ai < 2; ++ai)
#pragma unroll
            for (int m = 0; m < 4; ++m) {
                const int row = row0 + ai * HALF + m * 16;
                bf16_t* rowp = O + (size_t)row * ldc + col0;
                float rs = 1.f;
                if (MODE == 3) { if (u.pn < 4) rs = rsqrtf(ssq[row] * (1.0f / 512.0f) + 1e-6f); }
#pragma unroll
                for (int bj = 0; bj < 2; ++bj) {
                    f32x4 v0 = acc[ai][bj][m][0] + bv[bj][0], v1 = acc[ai][bj][m][1] + bv[bj][1];
                    if (MODE == 1) {
#pragma unroll
                        for (int j = 0; j < 4; ++j) { v0[j] = sigmoidf_(v0[j]); v1[j] = sigmoidf_(v1[j]); }
                    }
                    if (MODE == 2) {
#pragma unroll
                        for (int j = 0; j < 4; ++j) { const float a = fmaxf(v0[j], 0.f), b = fmaxf(v1[j], 0.f); v0[j] = a * a; v1[j] = b * b; }
                    }
                    if (MODE == 3) {
                        const u32x4 gq = *(const u32x4*)(rowp + bj * HALF);
                        v0[0] *= bf_lo(gq.x) * rs; v0[1] *= bf_hi(gq.x) * rs; v0[2] *= bf_lo(gq.y) * rs; v0[3] *= bf_hi(gq.y) * rs;
                        v1[0] *= bf_lo(gq.z) * rs; v1[1] *= bf_hi(gq.z) * rs; v1[2] *= bf_lo(gq.w) * rs; v1[3] *= bf_hi(gq.w) * rs;
                    }
                    u32x4 w; w.x = cvt_pk_bf16(v0[0], v0[1]); w.y = cvt_pk_bf16(v0[2], v0[3]); w.z = cvt_pk_bf16(v1[0], v1[1]); w.w = cvt_pk_bf16(v1[2], v1[3]);
                    *(u32x4*)(rowp + bj * HALF) = w;
                }
            }
    }
};
struct EpiGlu {
    static constexpr bool PERM = true, AFTER_DRAIN = false;
    bf16_t* O; int ldc; int ocol; const float* bias;
    __device__ __forceinline__ void operator()(const f32x4 (&acc)[2][2][4][2], const Unit& u, int wr, int wc, int fr, int fq) const {
        const int row0 = u.pm * BM + wr * 64 + fr, cc = u.pn * HALF + wc * 32 + 8 * fq;
        f32x4 bv[2][2];
#pragma unroll
        for (int bj = 0; bj < 2; ++bj)
#pragma unroll
            for (int n = 0; n < 2; ++n) bv[bj][n] = *(const f32x4*)(bias + bj * 512 + cc + 4 * n);
#pragma unroll
        for (int ai = 0; ai < 2; ++ai)
#pragma unroll
            for (int m = 0; m < 4; ++m) {
                bf16_t* rowp = O + (size_t)(row0 + ai * HALF + m * 16) * ldc + ocol + cc;
                f32x4 v0 = acc[ai][0][m][0] + bv[0][0], v1 = acc[ai][0][m][1] + bv[0][1];
                const f32x4 g0 = acc[ai][1][m][0] + bv[1][0], g1 = acc[ai][1][m][1] + bv[1][1];
#pragma unroll
                for (int j = 0; j < 4; ++j) { v0[j] *= sigmoidf_(g0[j]); v1[j] *= sigmoidf_(g1[j]); }
                u32x4 w; w.x = cvt_pk_bf16(v0[0], v0[1]); w.y = cvt_pk_bf16(v0[2], v0[3]); w.z = cvt_pk_bf16(v1[0], v1[1]); w.w = cvt_pk_bf16(v1[2], v1[3]);
                *(u32x4*)rowp = w;
            }
    }
};
struct EpiRes {
    static constexpr bool PERM = false, AFTER_DRAIN = false;
    const float* base_ctx; const float* base_lat;
    float* out; const float* modv;
    int goff;
    __device__ __forceinline__ void operator()(const f32x4 (&acc)[2][2][4][2], const Unit& u, int wr, int wc, int fr, int fq) const {
        const int row0 = u.pm * BM + wr * 64 + fr, col0 = u.pn * BM + wc * 32 + 4 * fq;
        const int mi = (u.pm < 32) ? 0 : 1 + ((u.pm - 32) >> 2);
        const float* gv = modv + (size_t)mi * 6144 + goff;
        f32x4 gg[2][2];
#pragma unroll
        for (int bj = 0; bj < 2; ++bj)
#pragma unroll
            for (int n = 0; n < 2; ++n) gg[bj][n] = *(const f32x4*)(gv + col0 + bj * HALF + n * 16);
#pragma unroll
        for (int ai = 0; ai < 2; ++ai)
#pragma unroll
            for (int m = 0; m < 4; ++m) {
                const int row = row0 + ai * HALF + m * 16;
                const float* bp = (row < 8192 ? base_ctx + (size_t)row * 1024 : base_lat + (size_t)(row - 8192) * 1024) + col0;
                float* op = out + (size_t)row * 1024 + col0;
#pragma unroll
                for (int bj = 0; bj < 2; ++bj)
#pragma unroll
                    for (int n = 0; n < 2; ++n) { const f32x4 b = *(const f32x4*)(bp + bj * HALF + n * 16); *(f32x4*)(op + bj * HALF + n * 16) = b + gg[bj][n] * acc[ai][bj][m][n]; }
            }
    }
};

template <class Epi, class Sched, bool ALIGN_EPI = false, bool SP2 = false>
__device__ __forceinline__ void gemm_phase(PG8_LAS unsigned char* lds, const Gemm g, const Sched& S, const Epi& E, const int tid) {
    const int wid = __builtin_amdgcn_readfirstlane(tid >> 6), lane = tid & 63, wr = wid >> 2, wc = wid & 3, fr = lane & 15, fq = lane >> 4;
    const int K = g.K, nt = K / BK;
    unsigned voffA[2], voffB[2];
#pragma unroll
    for (int i = 0; i < 2; ++i) { int R, C; stage_rc(tid * 16 + i * 8192, R, C); const int Rb = Epi::PERM ? ((R & ~31) + perm32(R & 31)) : R;
        voffA[i] = (unsigned)(R * g.lda + C) * 2u; voffB[i] = (unsigned)(Rb * g.ldb + C) * 2u; }
    const size_t kstep = (size_t)(BK * 2);
    const size_t hstepA = (size_t)HALF * g.lda * 2, hstepB = (size_t)HALF * g.ldb * 2;
    const size_t tstepA = 2 * hstepA, tstepB = 2 * hstepB;
#define PG8_UA(u) ((const char*)g.A + (size_t)(u).pm * tstepA + (g.a_div ? (size_t)((u).pn / g.a_div) * g.a_gstride : (size_t)0))
#define PG8_UB(u) ((const char*)g.Bt + (size_t)(u).pn * tstepB)
    const unsigned ldsw = (unsigned)wid * 1024u;
    const int aoff = lds_byte(wr * 64 + fr, fq * 8), boff = lds_byte(wc * 32 + fr, fq * 8);
#define PG8_SA(b, h) (((b) * 2 + (h)) * HTB)
#define PG8_SB(b, h) ((4 + (b) * 2 + (h)) * HTB)
#define PG8_STAGE(bufoff, gbase, voff) do { _Pragma("unroll") for (int _i = 0; _i < 2; ++_i) \
        __builtin_amdgcn_global_load_lds((const unsigned*)((const char*)(gbase) + (voff)[_i]), (PG8_LAS unsigned*)(lds + (bufoff) + ldsw + _i * 8192), 16, 0, 0); } while (0)
#define PG8_LDA(dst, b, h) do { _Pragma("unroll") for (int m = 0; m < 4; ++m) _Pragma("unroll") for (int k = 0; k < 2; ++k) dst[m][k] = *(const PG8_LAS bf16x8*)(lds + PG8_SA(b, h) + aoff + m * 2048 + k * 1024); } while (0)
#define PG8_LDB(dst, b, h) do { _Pragma("unroll") for (int n = 0; n < 2; ++n) _Pragma("unroll") for (int k = 0; k < 2; ++k) dst[n][k] = *(const PG8_LAS bf16x8*)(lds + PG8_SB(b, h) + boff + n * 2048 + k * 1024); } while (0)
#define PG8_MMA(ai, bj, At, Bt) do { __builtin_amdgcn_s_setprio(1); _Pragma("unroll") for (int m = 0; m < 4; ++m) _Pragma("unroll") for (int n = 0; n < 2; ++n) _Pragma("unroll") for (int k = 0; k < 2; ++k) \
        acc[ai][bj][m][n] = __builtin_amdgcn_mfma_f32_16x16x32_bf16(Bt[n][k], At[m][k], acc[ai][bj][m][n], 0, 0, 0); __builtin_amdgcn_s_setprio(0); } while (0)
#define PG8_WAIT_V(n) asm volatile("s_waitcnt vmcnt(" #n ")" ::: "memory")
#define PG8_WAIT_L(n) asm volatile("s_waitcnt lgkmcnt(" #n ")" ::: "memory")
#define PG8_BAR __builtin_amdgcn_s_barrier()
#define PG8_SCHED __builtin_amdgcn_sched_barrier(0)
    Unit cur, nxt; int ui = 0;
    if (!S.next(0, cur)) return;
    f32x4 acc[2][2][4][2];
#pragma unroll
    for (int a = 0; a < 2; ++a)
#pragma unroll
        for (int b = 0; b < 2; ++b)
#pragma unroll
            for (int m = 0; m < 4; ++m)
#pragma unroll
                for (int n = 0; n < 2; ++n) acc[a][b][m][n] = (f32x4){0.f, 0.f, 0.f, 0.f};
    bf16x8 At[4][2], B0[2][2], B1[2][2];
    const char* cA = PG8_UA(cur); const char* cB = PG8_UB(cur);
    S.a_ready(cur);
    if constexpr (SP2) {
        PG8_STAGE(PG8_SB(0, 0), cB, voffB); PG8_STAGE(PG8_SB(0, 1), cB + hstepB, voffB); PG8_STAGE(PG8_SA(0, 0), cA, voffA); PG8_STAGE(PG8_SA(0, 1), cA + hstepA, voffA);
        if (wr == 1) PG8_BAR;
        PG8_WAIT_V(2); PG8_BAR;
        PG8_STAGE(PG8_SB(1, 0), cB + kstep, voffB); PG8_STAGE(PG8_SA(1, 0), cA + kstep, voffA); PG8_STAGE(PG8_SB(1, 1), cB + hstepB + kstep, voffB);
        PG8_WAIT_V(6); PG8_BAR;
    } else {
        PG8_STAGE(PG8_SB(0, 0), cB, voffB); PG8_STAGE(PG8_SA(0, 0), cA, voffA); PG8_STAGE(PG8_SB(0, 1), cB + hstepB, voffB); PG8_STAGE(PG8_SA(0, 1), cA + hstepA, voffA);
        if (wr == 1) PG8_BAR;
        PG8_WAIT_V(4); PG8_BAR;
        PG8_STAGE(PG8_SB(1, 0), cB + kstep, voffB); PG8_STAGE(PG8_SA(1, 0), cA + kstep, voffA); PG8_STAGE(PG8_SB(1, 1), cB + hstepB + kstep, voffB);
        PG8_WAIT_V(6); PG8_BAR;
    }
    for (;;) {
        const bool has_next = S.next(ui + 1, nxt);
        const char* nA = has_next ? PG8_UA(nxt) : cA; const char* nB = has_next ? PG8_UB(nxt) : cB;
        for (int t = 0; t < nt; t += 2) {
            const bool last = (t == nt - 2);
            const char* a1 = cA + (size_t)(t + 1) * kstep;
            const char* a2 = last ? nA : cA + (size_t)(t + 2) * kstep; const char* b2 = last ? nB : cB + (size_t)(t + 2) * kstep;
            const char* a3 = a2 + kstep; const char* b3 = b2 + kstep;
            if (last && has_next) S.a_ready(nxt);
            if constexpr (SP2) {
            PG8_LDB(B0, 0, 0); PG8_LDB(B1, 0, 1); PG8_SCHED; PG8_LDA(At, 0, 0); PG8_STAGE(PG8_SA(1, 1), a1 + hstepA, voffA);
            PG8_WAIT_V(8); PG8_WAIT_L(0); PG8_BAR; PG8_MMA(0, 0, At, B0); PG8_MMA(0, 1, At, B1); PG8_BAR; PG8_SCHED;
            PG8_LDA(At, 0, 1); PG8_STAGE(PG8_SB(0, 0), b2, voffB); PG8_STAGE(PG8_SB(0, 1), b2 + hstepB, voffB); PG8_STAGE(PG8_SA(0, 0), a2, voffA);
            PG8_WAIT_V(8); PG8_WAIT_L(0); PG8_BAR; PG8_MMA(1, 0, At, B0); PG8_MMA(1, 1, At, B1); PG8_BAR; PG8_SCHED;
            PG8_LDB(B0, 1, 0); PG8_LDB(B1, 1, 1); PG8_SCHED; PG8_LDA(At, 1, 0); PG8_STAGE(PG8_SA(0, 1), a2 + hstepA, voffA);
            PG8_WAIT_V(8); PG8_WAIT_L(0); PG8_BAR; PG8_MMA(0, 0, At, B0); PG8_MMA(0, 1, At, B1); PG8_BAR; PG8_SCHED;
            PG8_LDA(At, 1, 1); PG8_STAGE(PG8_SB(1, 0), b3, voffB); PG8_STAGE(PG8_SB(1, 1), b3 + hstepB, voffB); PG8_STAGE(PG8_SA(1, 0), a3, voffA);
            PG8_WAIT_V(8); PG8_WAIT_L(0); PG8_BAR; PG8_MMA(1, 0, At, B0); PG8_MMA(1, 1, At, B1); PG8_BAR; PG8_SCHED;
            } else {
            PG8_LDB(B0, 0, 0); PG8_SCHED; PG8_LDA(At, 0, 0); PG8_STAGE(PG8_SA(1, 1), a1 + hstepA, voffA);
            PG8_WAIT_L(8); PG8_BAR; PG8_WAIT_L(0); PG8_MMA(0, 0, At, B0); PG8_BAR; PG8_SCHED;
            PG8_LDB(B1, 0, 1); PG8_STAGE(PG8_SB(0, 0), b2, voffB);
            PG8_BAR; PG8_WAIT_L(0); PG8_MMA(0, 1, At, B1); PG8_BAR;
            PG8_LDA(At, 0, 1); PG8_STAGE(PG8_SA(0, 0), a2, voffA);
            PG8_BAR; PG8_WAIT_L(0); PG8_MMA(1, 0, At, B0); PG8_BAR; PG8_SCHED;
            PG8_STAGE(PG8_SB(0, 1), b2 + hstepB, voffB);
            PG8_WAIT_V(6); PG8_BAR; PG8_MMA(1, 1, At, B1); PG8_BAR;
            PG8_LDB(B0, 1, 0); PG8_SCHED; PG8_LDA(At, 1, 0); PG8_STAGE(PG8_SA(0, 1), a2 + hstepA, voffA);
            PG8_WAIT_L(8); PG8_BAR; PG8_WAIT_L(0); PG8_MMA(0, 0, At, B0); PG8_BAR; PG8_SCHED;
            PG8_LDB(B1, 1, 1); PG8_STAGE(PG8_SB(1, 0), b3, voffB);
            PG8_BAR; PG8_WAIT_L(0); PG8_MMA(0, 1, At, B1); PG8_BAR;
            PG8_LDA(At, 1, 1); PG8_STAGE(PG8_SA(1, 0), a3, voffA);
            PG8_BAR; PG8_WAIT_L(0); PG8_MMA(1, 0, At, B0); PG8_BAR; PG8_SCHED;
            PG8_STAGE(PG8_SB(1, 1), b3 + hstepB, voffB);
            PG8_WAIT_V(6); PG8_BAR; PG8_MMA(1, 1, At, B1); PG8_BAR;
            }
        }
        if constexpr (ALIGN_EPI) { if (wr == 0) PG8_BAR; }
        if constexpr (!Epi::AFTER_DRAIN) { E(acc, cur, wr, wc, fr, fq); S.done(cur); }
        if (!has_next) break;
#pragma unroll
        for (int a = 0; a < 2; ++a)
#pragma unroll
            for (int b = 0; b < 2; ++b)
#pragma unroll
                for (int m = 0; m < 4; ++m)
#pragma unroll
                    for (int n = 0; n < 2; ++n) acc[a][b][m][n] = (f32x4){0.f, 0.f, 0.f, 0.f};
        cur = nxt; cA = nA; cB = nB; ++ui;
        if constexpr (ALIGN_EPI) { if (wr == 1) PG8_BAR; }
    }
    PG8_WAIT_V(0);
    if constexpr (!ALIGN_EPI) { if (wr == 0) PG8_BAR; }
    PG8_BAR;
    if constexpr (Epi::AFTER_DRAIN) { E.fused(acc, cur, wr, wc, fr, fq, lds, wid, lane); S.done(cur); }
#undef PG8_UA
#undef PG8_UB
#undef PG8_SA
#undef PG8_SB
#undef PG8_STAGE
#undef PG8_LDA
#undef PG8_LDB
#undef PG8_MMA
#undef PG8_WAIT_V
#undef PG8_WAIT_L
#undef PG8_BAR
#undef PG8_SCHED
}
}

#ifndef PG8_SP2
#define PG8_SP2 true
#endif
#ifndef PG8_ALIGN
#define PG8_ALIGN true
#endif

typedef unsigned short bf16;
typedef unsigned v4u __attribute__((ext_vector_type(4)));
typedef unsigned v2u __attribute__((ext_vector_type(2)));
typedef float f32x4 __attribute__((ext_vector_type(4)));
#define LAS __attribute__((address_space(3)))

constexpr int NWAVES = 8, NTHR = 512;
constexpr int D = 1024, MC = 8192, ML = 4096, M = 12288, NPH = 23;
constexpr int LDS_BYTES = 147456;
constexpr float EPS = 1e-6f;
constexpr size_t MiB = 1u << 20;
constexpr size_t WS_MOD = 64 * 1024;
constexpr size_t WS_SSQ = 320 * 1024;
constexpr size_t WS_DT = 384 * 1024;
constexpr size_t WS_W = 2 * MiB;
constexpr size_t W_IN = WS_W, W_G = W_IN + 8 * MiB, W_GLU = W_G + 8 * MiB, W_BR = W_GLU + 1 * MiB, W_OUT = W_BR + 4 * MiB, W_1 = W_OUT + 2 * MiB, W_2 = W_1 + 8 * MiB;
constexpr size_t WS_H = 41 * MiB;
constexpr size_t WS_R1 = 65 * MiB;
constexpr size_t WS_Y = 161 * MiB;
constexpr size_t WS_Y5 = 209 * MiB;
constexpr size_t WS_XC = 221 * MiB;
constexpr size_t WS_YF = 239 * MiB;
constexpr size_t WS_CKV = 251 * MiB;
constexpr size_t WS_ROPE = 1536 * 1024;
constexpr size_t WS_END = 254 * MiB;
#ifndef PROBE_SEL
#define PROBE_SEL -1
#endif
#ifndef PROBE_PB
#define PROBE_PB 32
#endif
constexpr size_t WS_BAR = 32 * 1024;
constexpr size_t WS_TS = 16 * 1024;
constexpr size_t O_SSD = 12582912, O_S5 = 16777216, O_DK = 17301504, O_DV = 25690112, O_WK = 34078720, O_WV = 36175872;
constexpr int C_Z = 0, C_XBC = 512, C_U = 1280, C_DQ = 1792, C_DK = 2304, C_DV = 2816, C_WQ = 3328, C_WK = 3840, C_WV = 3968;

struct Args { const float* in[44]; float* out; unsigned char* ws; int ph_lo, ph_hi; };

typedef const Args __attribute__((address_space(4)))* CArgs;
struct Ctx {
    CArgs ap; int tid, lane, wave;
    __device__ __forceinline__ const float* x_prompt() const { return ap->in[0]; }
    __device__ __forceinline__ const float* x_sample() const { return ap->in[1]; }
    __device__ __forceinline__ const float* state_ssd() const { return ap->in[2]; }
    __device__ __forceinline__ const float* state_s5() const { return ap->in[3]; }
    __device__ __forceinline__ const float* cache_dk() const { return ap->in[4]; }
    __device__ __forceinline__ const float* cache_dv() const { return ap->in[5]; }
    __device__ __forceinline__ const float* cache_wk() const { return ap->in[6]; }
    __device__ __forceinline__ const float* cache_wv() const { return ap->in[7]; }
    __device__ __forceinline__ const float* cvec() const { return ap->in[8]; }
    __device__ __forceinline__ const float* c_ctx() const { return ap->in[9]; }
    __device__ __forceinline__ const float* w_mod() const { return ap->in[10]; }
    __device__ __forceinline__ const float* b_mod() const { return ap->in[11]; }
    __device__ __forceinline__ const float* g_norm1() const { return ap->in[12]; }
    __device__ __forceinline__ const float* g_norm2() const { return ap->in[13]; }
    __device__ __forceinline__ const float* w_in() const { return ap->in[14]; }
    __device__ __forceinline__ const float* conv_w() const { return ap->in[15]; }
    __device__ __forceinline__ const float* conv_b() const { return ap->in[16]; }
    __device__ __forceinline__ const float* dt_bias() const { return ap->in[17]; }
    __device__ __forceinline__ const float* a_log() const { return ap->in[18]; }
    __device__ __forceinline__ const float* ssd_d() const { return ap->in[19]; }
    __device__ __forceinline__ const float* ssd_norm_g() const { return ap->in[20]; }
    __device__ __forceinline__ const float* lam_re() const { return ap->in[21]; }
    __device__ __forceinline__ const float* lam_im() const { return ap->in[22]; }
    __device__ __forceinline__ const float* log_step() const { return ap->in[23]; }
    __device__ __forceinline__ const float* b_re() const { return ap->in[24]; }
    __device__ __forceinline__ const float* b_im() const { return ap->in[25]; }
    __device__ __forceinline__ const float* c_re() const { return ap->in[26]; }
    __device__ __forceinline__ const float* c_im() const { return ap->in[27]; }
    __device__ __forceinline__ const float* s5_d() const { return ap->in[28]; }
    __device__ __forceinline__ const float* w_glu() const { return ap->in[29]; }
    __device__ __forceinline__ const float* b_glu() const { return ap->in[30]; }
    __device__ __forceinline__ const float* qn_g() const { return ap->in[31]; }
    __device__ __forceinline__ const float* kn_g() const { return ap->in[32]; }
    __device__ __forceinline__ const float* dlam() const { return ap->in[33]; }
    __device__ __forceinline__ const float* subln_g() const { return ap->in[34]; }
    __device__ __forceinline__ const float* wqn_g() const { return ap->in[35]; }
    __device__ __forceinline__ const float* wkn_g() const { return ap->in[36]; }
    __device__ __forceinline__ const float* sink() const { return ap->in[37]; }
    __device__ __forceinline__ const float* w_branch() const { return ap->in[38]; }
    __device__ __forceinline__ const float* w_gate() const { return ap->in[39]; }
    __device__ __forceinline__ const float* b_gate() const { return ap->in[40]; }
    __device__ __forceinline__ const float* w_out() const { return ap->in[41]; }
    __device__ __forceinline__ const float* w_fc1() const { return ap->in[42]; }
    __device__ __forceinline__ const float* w_fc2() const { return ap->in[43]; }
    __device__ __forceinline__ float* out() const { return ap->out; }
    __device__ __forceinline__ unsigned char* ws() const { return ap->ws; }
    __device__ __forceinline__ float* MOD() const { return (float*)(ap->ws + WS_MOD); }
    __device__ __forceinline__ float* SSQ() const { return (float*)(ap->ws + WS_SSQ); }
    __device__ __forceinline__ float* DT() const { return (float*)(ap->ws + WS_DT); }
    __device__ __forceinline__ bf16* H() const { return (bf16*)(ap->ws + WS_H); }
    __device__ __forceinline__ bf16* R1() const { return (bf16*)(ap->ws + WS_R1); }
    __device__ __forceinline__ bf16* Y() const { return (bf16*)(ap->ws + WS_Y); }
    __device__ __forceinline__ bf16* Y5() const { return (bf16*)(ap->ws + WS_Y5); }
    __device__ __forceinline__ bf16* XC() const { return (bf16*)(ap->ws + WS_XC); }
    __device__ __forceinline__ bf16* YF() const { return (bf16*)(ap->ws + WS_YF); }
    __device__ __forceinline__ bf16* CKV() const { return (bf16*)(ap->ws + WS_CKV); }
    __device__ __forceinline__ float* ROPE() const { return (float*)(ap->ws + WS_ROPE); }
};

__device__ __forceinline__ float wave_sum(float v) {
#pragma unroll
    for (int o = 1; o < 64; o <<= 1) v += __shfl_xor(v, o);
    return v;
}
__device__ __forceinline__ float wave_max(float v) {
#pragma unroll
    for (int o = 1; o < 64; o <<= 1) v = fmaxf(v, __shfl_xor(v, o));
    return v;
}
__device__ __forceinline__ float bf2f(bf16 h) { return __builtin_bit_cast(float, (unsigned)h << 16); }
__device__ __forceinline__ float bflo(unsigned w) { return __builtin_bit_cast(float, w << 16); }
__device__ __forceinline__ float bfhi(unsigned w) { return __builtin_bit_cast(float, w & 0xffff0000u); }
__device__ __forceinline__ unsigned f2bf(float f) { unsigned u = __builtin_bit_cast(unsigned, f); return (u + 0x7fffu + ((u >> 16) & 1u)) >> 16; }
__device__ __forceinline__ unsigned pk2(float lo, float hi) { return f2bf(lo) | (f2bf(hi) << 16); }
__device__ __forceinline__ float siluf(float x) { return x / (1.0f + __expf(-x)); }
__device__ __forceinline__ void unpack8(const v4u q, float (&f)[8]) { f[0] = bflo(q.x); f[1] = bfhi(q.x); f[2] = bflo(q.y); f[3] = bfhi(q.y); f[4] = bflo(q.z); f[5] = bfhi(q.z); f[6] = bflo(q.w); f[7] = bfhi(q.w); }

__device__ __forceinline__ void phase_mods(const Ctx& c, float* lf) {
    for (int i = c.tid; i < 5 * 1024; i += NTHR) { const int v = i >> 10, k = i & 1023; const float x = (v == 0) ? c.c_ctx()[k] : c.cvec()[(v - 1) * 1024 + k]; lf[i] = siluf(x); }
    __syncthreads();
    float* red = lf + 5 * 1024;
    for (int u = blockIdx.x; u < 192; u += gridDim.x) {
        const int l = u / 96, col0 = (u % 96) * 64;
        const float* W = c.w_mod() + (size_t)l * 1024 * 6144 + col0 + c.lane;
        float acc[5] = {0.f, 0.f, 0.f, 0.f, 0.f};
#pragma unroll 8
        for (int k = c.wave * 128; k < c.wave * 128 + 128; ++k) { const float wv = W[(size_t)k * 6144];
#pragma unroll
            for (int i = 0; i < 5; ++i) acc[i] += lf[i * 1024 + k] * wv; }
#pragma unroll
        for (int i = 0; i < 5; ++i) red[(c.wave * 5 + i) * 64 + c.lane] = acc[i];
        __syncthreads();
        if (c.tid < 320) { const int i = c.tid >> 6, ln = c.tid & 63; float s = c.b_mod()[l * 6144 + col0 + ln];
#pragma unroll
            for (int w = 0; w < 8; ++w) s += red[(w * 5 + i) * 64 + ln];
            c.MOD()[(size_t)(l * 5 + i) * 6144 + col0 + ln] = s; }
        __syncthreads();
    }
}

__device__ __forceinline__ int cmap(int mode, int n) { return mode == 0 ? n : (mode == 1 ? (n < 1280 ? n : n + 16) : ((n & 255) < 128 ? 128 * (n >> 8) + (n & 127) : 512 + 128 * (n >> 8) + (n & 127))); }
__device__ __forceinline__ void transpose_item(const float* W, int ld, int K, int N, int mode, const float* rowscale, bf16* WT, float* scr, int item, int lane) {
    const int nblk = N / 32, kb = item / nblk, nb = item % nblk, k0 = 64 * kb, n0 = 32 * nb, sc0 = cmap(mode, n0);
    float tv[32];
#pragma unroll
    for (int i = 0; i < 32; ++i) tv[i] = W[(size_t)(k0 + 2 * i + (lane >> 5)) * ld + sc0 + (lane & 31)];
    if (rowscale) {
#pragma unroll
        for (int i = 0; i < 32; ++i) tv[i] *= rowscale[k0 + 2 * i + (lane >> 5)]; }
#pragma unroll
    for (int i = 0; i < 32; ++i) scr[(2 * i + (lane >> 5)) * 33 + (lane & 31)] = tv[i];
    __builtin_amdgcn_fence(__ATOMIC_RELEASE, "wavefront"); __builtin_amdgcn_wave_barrier();
    const int ch = lane & 7;
#pragma unroll
    for (int j = 0; j < 4; ++j) { const int n = (lane >> 3) + 8 * j; const float* s = scr + (8 * ch) * 33 + n;
        v4u o; o.x = pk2(s[0 * 33], s[1 * 33]); o.y = pk2(s[2 * 33], s[3 * 33]); o.z = pk2(s[4 * 33], s[5 * 33]); o.w = pk2(s[6 * 33], s[7 * 33]);
        *(v4u*)(WT + (size_t)(n0 + n) * K + k0 + 8 * ch) = o; }
    __builtin_amdgcn_fence(__ATOMIC_RELEASE, "wavefront"); __builtin_amdgcn_wave_barrier();
}
__device__ __forceinline__ void phase_convert(const Ctx& c, int l, float* lf) {
    float* scr = lf + c.wave * 2176;
    const int gw = blockIdx.x * NWAVES + c.wave, NGW = gridDim.x * NWAVES;
    unsigned char* ws = c.ws();
    for (int it = gw; it < 9984; it += NGW) {
        int r = it;
        if (r < 2048) { transpose_item(c.w_in() + (size_t)l * 1024 * 4112, 4112, 1024, 4096, 1, nullptr, (bf16*)(ws + W_IN), scr, r, c.lane); continue; } r -= 2048;
        if (r < 2048) { transpose_item(c.w_gate() + (size_t)l * 1024 * 4096, 4096, 1024, 4096, 0, nullptr, (bf16*)(ws + W_G), scr, r, c.lane); continue; } r -= 2048;
        if (r < 256) { transpose_item(c.w_glu() + (size_t)l * 512 * 1024, 1024, 512, 1024, 2, nullptr, (bf16*)(ws + W_GLU), scr, r, c.lane); continue; } r -= 256;
        if (r < 1024) { const int i = r >> 8; transpose_item(c.w_branch() + (size_t)(l * 4 + i) * 512 * 1024, 1024, 512, 1024, 0, i == 0 ? c.ssd_norm_g() + l * 512 : nullptr, (bf16*)(ws + W_BR) + (size_t)i * 1024 * 512, scr, r & 255, c.lane); continue; } r -= 1024;
        if (r < 512) { transpose_item(c.w_out() + (size_t)l * 1024 * 1024, 1024, 1024, 1024, 0, nullptr, (bf16*)(ws + W_OUT), scr, r, c.lane); continue; } r -= 512;
        if (r < 2048) { transpose_item(c.w_fc1() + (size_t)l * 1024 * 4096, 4096, 1024, 4096, 0, nullptr, (bf16*)(ws + W_1), scr, r, c.lane); continue; } r -= 2048;
        transpose_item(c.w_fc2() + (size_t)l * 4096 * 1024, 1024, 4096, 1024, 0, nullptr, (bf16*)(ws + W_2), scr, r, c.lane);
    }
}

__device__ __forceinline__ void phase_norm(const Ctx& c, int l, int which, float* lf) {
    if (which == 0) {
        for (int i = c.tid; i < 16384; i += NTHR) { const int k = i >> 4, j = i & 15; lf[j * 1024 + k] = c.w_in()[(size_t)l * 1024 * 4112 + (size_t)k * 4112 + 1280 + j]; }
        __syncthreads();
    }
    const int gw = blockIdx.x * NWAVES + c.wave, NGW = gridDim.x * NWAVES;
    const float* gn = (which == 0 ? c.g_norm1() : c.g_norm2()) + l * 1024;
    for (int m = gw; m < M; m += NGW) {
        const float* xr = (l == 0 && which == 0) ? (m < MC ? c.x_prompt() + (size_t)m * D : c.x_sample() + (size_t)(m - MC) * D) : c.out() + (size_t)m * D;
        const int mi = (m < MC) ? 0 : 1 + ((m - MC) >> 10);
        const float* mod = c.MOD() + (size_t)(l * 5 + mi) * 6144 + which * 3072;
        f32x4 v[4]; float s = 0.f;
#pragma unroll
        for (int j = 0; j < 4; ++j) { v[j] = *(const f32x4*)(xr + 4 * c.lane + 256 * j); s += (v[j].x * v[j].x + v[j].y * v[j].y) + (v[j].z * v[j].z + v[j].w * v[j].w); }
        const float rstd = rsqrtf(wave_sum(s) * (1.0f / D) + EPS);
#pragma unroll
        for (int j = 0; j < 4; ++j) { const int k = 4 * c.lane + 256 * j; const f32x4 g = *(const f32x4*)(gn + k), sh = *(const f32x4*)(mod + k), sc = *(const f32x4*)(mod + 1024 + k);
            v[j] = v[j] * rstd * g * (sc + 1.0f) + sh;
            v2u o; o.x = pk2(v[j].x, v[j].y); o.y = pk2(v[j].z, v[j].w); *(v2u*)(c.H() + (size_t)m * D + k) = o; }
        if (which == 0) {
            float mine = 0.f;
#pragma unroll 1
            for (int jj = 0; jj < 16; ++jj) { float a = 0.f;
#pragma unroll
                for (int j = 0; j < 4; ++j) { const f32x4 w = *(const f32x4*)(lf + jj * 1024 + 4 * c.lane + 256 * j); a += (v[j].x * w.x + v[j].y * w.y) + (v[j].z * w.z + v[j].w * w.w); }
                a = wave_sum(a); if (c.lane == jj) mine = a; }
            if (c.lane < 16) { const float x = mine + c.dt_bias()[l * 16 + c.lane]; c.DT()[(size_t)m * 16 + c.lane] = x > 20.f ? x : log1pf(__expf(x)); }
            if (c.lane == 0) c.SSQ()[m] = 0.f;
        }
    }
}

__device__ __forceinline__ void phase_rope_table(const Ctx& c) {
    const int gt = blockIdx.x * NTHR + c.tid;
    if (gt < 32768) { const int pos = gt >> 5, a = gt & 31, f = a & 15; const float inv = exp2f(-(float)f * 0.8304820237218406f);
        const float ang = (float)((a >> 4) ? (pos & 63) : (pos >> 6)) * inv; float sn, cs; sincosf(ang, &sn, &cs); c.ROPE()[pos * 64 + a] = cs; c.ROPE()[pos * 64 + 32 + a] = sn; }
}
__device__ __forceinline__ void phase_qk(const Ctx& c, int l, float* lf) {
    const int gw = blockIdx.x * NWAVES + c.wave, NGW = gridDim.x * NWAVES, lane = c.lane, l16 = lane & 15, grp = lane >> 4;
    for (int i = c.tid; i < 7 * 768; i += NTHR) lf[i] = c.conv_w()[(size_t)l * 7 * 768 + i];
    for (int i = c.tid; i < 768; i += NTHR) lf[7 * 768 + i] = c.conv_b()[l * 768 + i];
    __syncthreads();
    const f32x4 gq = *(const f32x4*)(c.qn_g() + l * 64 + 4 * l16), gk = *(const f32x4*)(c.kn_g() + l * 64 + 4 * l16), gwq = *(const f32x4*)(c.wqn_g() + l * 64 + 4 * l16), gwk = *(const f32x4*)(c.wkn_g() + l * 64 + 4 * l16);
    bf16* R1p = c.R1(); float* outp = c.out(); bf16* XCp = c.XC();
    for (int m = gw; m < M; m += NGW) {
        bf16* pr = R1p + (size_t)m * 4096;
        const bool lat = m >= MC;
        const int b = lat ? (m - MC) >> 10 : m >> 8, t = lat ? (m - MC) & 1023 : m & 255, L = lat ? 1024 : 256;
        const size_t ob = (size_t)(b * 2 + l) * 256 + t;
        f32x4 cs = {1.f, 1.f, 1.f, 1.f}, sn = {0.f, 0.f, 0.f, 0.f};
        if (lat) { const float* rp = c.ROPE() + t * 64 + (l16 >> 3) * 16 + 4 * (l16 & 3); cs = *(const f32x4*)rp; sn = *(const f32x4*)(rp + 32); if (!((l16 >> 2) & 1)) sn = -sn; }
        v2u raw[7];
#pragma unroll
        for (int ps = 0; ps < 7; ++ps) { const int gi = 4 * ps + grp; const int col = gi < 8 ? C_DQ + gi * 64 : gi < 16 ? C_DK + (gi - 8) * 64 : gi < 24 ? C_WQ + (gi - 16) * 64 : C_WK + (gi - 24) * 64;
            raw[ps] = (gi < 26) ? *(const v2u*)(pr + col + 4 * l16) : (v2u){0u, 0u}; }
        v2u cp[3];
        if (!lat) {
#pragma unroll
            for (int ps = 0; ps < 3; ++ps) { const int gi = 4 * ps + grp; const int col = gi < 8 ? C_DV + gi * 64 : C_WV + (gi - 8) * 64; cp[ps] = (gi < 10) ? *(const v2u*)(pr + col + 4 * l16) : (v2u){0u, 0u}; }
        }
        v2u cx[3][7];
#pragma unroll
        for (int i = 0; i < 3; ++i)
#pragma unroll
            for (int j = 0; j < 7; ++j) { const int tt = t + j - 3; cx[i][j] = (tt >= 0 && tt < L) ? *(const v2u*)(R1p + (size_t)(m + j - 3) * 4096 + C_XBC + 4 * lane + 256 * i) : (v2u){0u, 0u}; }
#pragma unroll
        for (int ps = 0; ps < 7; ++ps) { const int gi = 4 * ps + grp;
            const f32x4 gain = gi < 8 ? gq : gi < 16 ? gk : gi < 24 ? gwq : gwk;
            f32x4 v = {bflo(raw[ps].x), bfhi(raw[ps].x), bflo(raw[ps].y), bfhi(raw[ps].y)};
            float ss = (v.x * v.x + v.y * v.y) + (v.z * v.z + v.w * v.w);
            ss += __shfl_xor(ss, 1); ss += __shfl_xor(ss, 2); ss += __shfl_xor(ss, 4); ss += __shfl_xor(ss, 8);
            v = v * rsqrtf(ss * (1.0f / 64.0f) + EPS) * gain;
            if (lat) { f32x4 p; p.x = __shfl_xor(v.x, 4); p.y = __shfl_xor(v.y, 4); p.z = __shfl_xor(v.z, 4); p.w = __shfl_xor(v.w, 4); v = v * cs + p * sn; }
            if (gi < 26) {
                const int col = gi < 8 ? C_DQ + gi * 64 : gi < 16 ? C_DK + (gi - 8) * 64 : gi < 24 ? C_WQ + (gi - 16) * 64 : C_WK + (gi - 24) * 64;
                v2u o; o.x = pk2(v.x, v.y); o.y = pk2(v.z, v.w); *(v2u*)(pr + col + 4 * l16) = o;
                if (!lat) { if (gi >= 8 && gi < 16) *(f32x4*)(outp + O_DK + ob * 512 + (gi - 8) * 64 + 4 * l16) = v; if (gi >= 24) *(f32x4*)(outp + O_WK + ob * 128 + (gi - 24) * 64 + 4 * l16) = v; }
            }
        }
        if (!lat) {
#pragma unroll
            for (int ps = 0; ps < 3; ++ps) { const int gi = 4 * ps + grp; const f32x4 v = {bflo(cp[ps].x), bfhi(cp[ps].x), bflo(cp[ps].y), bfhi(cp[ps].y)};
                if (gi < 8) *(f32x4*)(outp + O_DV + ob * 512 + gi * 64 + 4 * l16) = v; else if (gi < 10) *(f32x4*)(outp + O_WV + ob * 128 + (gi - 8) * 64 + 4 * l16) = v; }
        }
#pragma unroll
        for (int i = 0; i < 3; ++i) { const int ch = 4 * lane + 256 * i; f32x4 a = *(const f32x4*)(lf + 7 * 768 + ch);
#pragma unroll
            for (int j = 0; j < 7; ++j) { const f32x4 wv = *(const f32x4*)(lf + j * 768 + ch); const f32x4 xv = {bflo(cx[i][j].x), bfhi(cx[i][j].x), bflo(cx[i][j].y), bfhi(cx[i][j].y)}; a += wv * xv; }
            v2u o; o.x = pk2(siluf(a.x), siluf(a.y)); o.y = pk2(siluf(a.z), siluf(a.w)); *(v2u*)(XCp + (size_t)m * 768 + ch) = o; }
    }
    for (int r = gw; r < 1024; r += NGW) { const int b = r >> 8, sidx = r & 255; const size_t cb = (size_t)(b * 2 + l) * 256 + sidx; bf16* dst = c.CKV() + (size_t)r * 1280;
        for (int i = lane; i < 1280; i += 64) { const float v = i < 512 ? c.cache_dk()[cb * 512 + i] : i < 1024 ? c.cache_dv()[cb * 512 + i - 512] : i < 1152 ? c.cache_wk()[cb * 128 + i - 1024] : c.cache_wv()[cb * 128 + i - 1152]; dst[i] = (bf16)f2bf(v); } }
}

typedef pg8::bf16x8 bx8;
#define MFMA16(a, b, cc) __builtin_amdgcn_mfma_f32_16x16x32_bf16((a), (b), (cc), 0, 0, 0)
__device__ __forceinline__ void ssd_unit(const Ctx& c, int l, int pass, int b, int h, unsigned char* lds) {
    const int L = pass ? 1024 : 256, tok0 = pass ? MC + b * 1024 : b * 256, NCH = L >> 7;
    const int tid = c.tid, lane = c.lane, w = c.wave, lr = lane & 15, lq = lane >> 4, grp = h >> 2;
    bf16* XT = (bf16*)lds;
    bf16* BwT = XT + 64 * 136;
    bf16* Bm = BwT + 64 * 136;
    bf16* Cm = Bm + 128 * 72;
    bf16* Mm = Cm + 128 * 72;
    bf16* ST = Mm + 128 * 136;
    float* cum = (float*)(ST + 64 * 72);
    float* dtv = cum + 128; float* wv = dtv + 128; float* ecum = wv + 128; float* tot = ecum + 128;
    const float dsk = c.ssd_d()[l * 8 + h];
    const bf16* XCp = c.XC(); const float* DTp = c.DT(); bf16* YFp = c.YF(); bf16* Yp = c.Y(); const bf16* R1p = c.R1(); float* SSQp = c.SSQ();
    const int pi = w >> 1, nj0 = 2 * (w & 1);
    for (int dir = 0; dir < 2; ++dir) {
        const float A = -__expf(c.a_log()[(l * 2 + dir) * 8 + h]);
        f32x4 Sacc[2];
        __syncthreads();
#pragma unroll
        for (int q = 0; q < 2; ++q)
#pragma unroll
            for (int r = 0; r < 4; ++r) { const int p = 16 * pi + 4 * lq + r, n = 16 * (nj0 + q) + lr;
                const float v = pass ? c.state_ssd()[(((((size_t)(b * 2 + l) * 2 + dir) * 8 + h) * 64 + p) * 64) + n] : 0.f;
                Sacc[q][r] = v; ST[p * 72 + n] = (bf16)f2bf(v); }
        for (int ci = 0; ci < NCH; ++ci) {
            __syncthreads();
            const int i = tid >> 2, part = tid & 3;
            float bvals[16];
            { const int t = dir ? L - 1 - (ci * 128 + i) : ci * 128 + i; const bf16* xr = XCp + (size_t)(tok0 + t) * 768;
              const v4u x0 = *(const v4u*)(xr + h * 64 + part * 16), x1 = *(const v4u*)(xr + h * 64 + part * 16 + 8);
              const v4u b0 = *(const v4u*)(xr + 512 + grp * 64 + part * 16), b1 = *(const v4u*)(xr + 512 + grp * 64 + part * 16 + 8);
              const v4u c0 = *(const v4u*)(xr + 640 + grp * 64 + part * 16), c1 = *(const v4u*)(xr + 640 + grp * 64 + part * 16 + 8);
              *(v4u*)(Bm + i * 72 + part * 16) = b0; *(v4u*)(Bm + i * 72 + part * 16 + 8) = b1;
              *(v4u*)(Cm + i * 72 + part * 16) = c0; *(v4u*)(Cm + i * 72 + part * 16 + 8) = c1;
              const unsigned xs[8] = {x0.x, x0.y, x0.z, x0.w, x1.x, x1.y, x1.z, x1.w};
#pragma unroll
              for (int j = 0; j < 8; ++j) { XT[(part * 16 + 2 * j) * 136 + i] = (bf16)(xs[j] & 0xffffu); XT[(part * 16 + 2 * j + 1) * 136 + i] = (bf16)(xs[j] >> 16); }
              float t8[8]; unpack8(b0, t8);
#pragma unroll
              for (int j = 0; j < 8; ++j) bvals[j] = t8[j];
              unpack8(b1, t8);
#pragma unroll
              for (int j = 0; j < 8; ++j) bvals[8 + j] = t8[j]; }
            if (tid < 64) {
                const int i0 = 2 * lane, i1 = i0 + 1;
                const int t0 = dir ? L - 1 - (ci * 128 + i0) : ci * 128 + i0, t1 = dir ? L - 1 - (ci * 128 + i1) : ci * 128 + i1;
                const float d0 = DTp[(size_t)(tok0 + t0) * 16 + dir * 8 + h], d1 = DTp[(size_t)(tok0 + t1) * 16 + dir * 8 + h];
                const float a0 = d0 * A, a1 = d1 * A; float s = a0 + a1;
#pragma unroll
                for (int o = 1; o < 64; o <<= 1) { const float v = __shfl_up(s, o); if (lane >= o) s += v; }
                const float cum1 = s, cum0 = s - a1, total = __shfl(s, 63);
                cum[i0] = cum0; cum[i1] = cum1; dtv[i0] = d0; dtv[i1] = d1;
                wv[i0] = __expf(total - cum0) * d0; wv[i1] = __expf(total - cum1) * d1; ecum[i0] = __expf(cum0); ecum[i1] = __expf(cum1);
                if (lane == 0) tot[0] = __expf(total);
            }
            __syncthreads();
            { const float wi = wv[i];
#pragma unroll
              for (int j = 0; j < 16; ++j) BwT[(part * 16 + j) * 136 + i] = (bf16)f2bf(bvals[j] * wi); }
            bx8 cfr[2];
#pragma unroll
            for (int ks = 0; ks < 2; ++ks) cfr[ks] = *(const bx8*)(Cm + (16 * w + lr) * 72 + 32 * ks + 8 * lq);
            for (int j = 0; j <= w; ++j) {
                const bx8 b0 = *(const bx8*)(Bm + (16 * j + lr) * 72 + 8 * lq), b1 = *(const bx8*)(Bm + (16 * j + lr) * 72 + 32 + 8 * lq);
                f32x4 g = {0.f, 0.f, 0.f, 0.f};
                g = MFMA16(cfr[0], b0, g); g = MFMA16(cfr[1], b1, g);
                const int s = 16 * j + lr; const float cs = cum[s], ds = dtv[s];
#pragma unroll
                for (int r = 0; r < 4; ++r) { const int tt = 16 * w + 4 * lq + r; const float v = (s <= tt) ? g[r] * __expf(cum[tt] - cs) * ds : 0.f; Mm[tt * 136 + s] = (bf16)f2bf(v); }
            }
            if (!(w & 1)) {
#pragma unroll
                for (int r = 0; r < 4; ++r) Mm[(16 * w + 4 * lq + r) * 136 + 16 * (w + 1) + lr] = 0;
            }
            __syncthreads();
            f32x4 yl[4], yo[4];
#pragma unroll
            for (int jp = 0; jp < 4; ++jp) { yl[jp] = (f32x4){0.f, 0.f, 0.f, 0.f}; yo[jp] = (f32x4){0.f, 0.f, 0.f, 0.f}; }
            for (int ks = 0; ks <= (w >> 1); ++ks) {
                const bx8 af = *(const bx8*)(Mm + (16 * w + lr) * 136 + 32 * ks + 8 * lq);
#pragma unroll
                for (int jp = 0; jp < 4; ++jp) { const bx8 xf = *(const bx8*)(XT + (16 * jp + lr) * 136 + 32 * ks + 8 * lq); yl[jp] = MFMA16(af, xf, yl[jp]); }
            }
#pragma unroll
            for (int ks = 0; ks < 2; ++ks)
#pragma unroll
                for (int jp = 0; jp < 4; ++jp) { const bx8 sf = *(const bx8*)(ST + (16 * jp + lr) * 72 + 32 * ks + 8 * lq); yo[jp] = MFMA16(cfr[ks], sf, yo[jp]); }
            {
                float ssq[4] = {0.f, 0.f, 0.f, 0.f};
#pragma unroll
                for (int r = 0; r < 4; ++r) {
                    const int tt = 16 * w + 4 * lq + r; const float ec = ecum[tt];
                    const int t = dir ? L - 1 - (ci * 128 + tt) : ci * 128 + tt; const size_t m = (size_t)tok0 + t;
#pragma unroll
                    for (int jp = 0; jp < 4; ++jp) {
                        const int p = 16 * jp + lr; const float y = yl[jp][r] + ec * yo[jp][r];
                        if (dir == 0) YFp[m * 512 + h * 64 + p] = (bf16)f2bf(y);
                        else { const float x = bf2f(XT[p * 136 + tt]); const float ytot = y + bf2f(YFp[m * 512 + h * 64 + p]) + dsk * x; const float z = bf2f(R1p[m * 4096 + C_Z + h * 64 + p]);
                            const float gt = ytot * siluf(z); Yp[m * 2048 + h * 64 + p] = (bf16)f2bf(gt); ssq[r] += gt * gt; }
                    }
                    if (dir == 1) { float q = ssq[r]; q += __shfl_xor(q, 1); q += __shfl_xor(q, 2); q += __shfl_xor(q, 4); q += __shfl_xor(q, 8); if (lr == 0) atomicAdd(SSQp + m, q); }
                }
            }
            __syncthreads();
            {
                f32x4 st[2] = {{0.f, 0.f, 0.f, 0.f}, {0.f, 0.f, 0.f, 0.f}};
#pragma unroll
                for (int ks = 0; ks < 4; ++ks) { const bx8 af = *(const bx8*)(XT + (16 * pi + lr) * 136 + 32 * ks + 8 * lq);
#pragma unroll
                    for (int q = 0; q < 2; ++q) { const bx8 bf = *(const bx8*)(BwT + (16 * (nj0 + q) + lr) * 136 + 32 * ks + 8 * lq); st[q] = MFMA16(af, bf, st[q]); } }
                const float et = tot[0];
#pragma unroll
                for (int q = 0; q < 2; ++q)
#pragma unroll
                    for (int r = 0; r < 4; ++r) { Sacc[q][r] = et * Sacc[q][r] + st[q][r]; ST[(16 * pi + 4 * lq + r) * 72 + 16 * (nj0 + q) + lr] = (bf16)f2bf(Sacc[q][r]); }
            }
        }
        if (!pass) {
#pragma unroll
            for (int q = 0; q < 2; ++q)
#pragma unroll
                for (int r = 0; r < 4; ++r) { const int p = 16 * pi + 4 * lq + r, n = 16 * (nj0 + q) + lr;
                    c.out()[O_SSD + (((((size_t)(b * 2 + l) * 2 + dir) * 8 + h) * 64 + p) * 64) + n] = Sacc[q][r]; }
        }
    }
}

__device__ __forceinline__ void s5_unit(const Ctx& c, int l, int pass, int b, int g, float* lf) {
    const int L = pass ? 1024 : 256, tok0 = pass ? MC + b * 1024 : b * 256, tid = c.tid;
    float* ybuf = lf;
    float* sbuf = lf + 16384;
    float* cmat = lf + 24576;
    for (int i = tid; i < L * 16; i += NTHR) ybuf[i] = 0.f;
    for (int i = tid; i < 4096; i += NTHR) { const int dir = i >> 11, ri = (i >> 10) & 1, mm = (i >> 6) & 15, n = i & 63;
        cmat[((dir * 2 + ri) * 16 + mm) * 129 + n] = (ri ? c.c_im() : c.c_re())[((size_t)((l * 2 + dir) * 32 + g) * 16 + mm) * 64 + n]; }
    const int dir = (tid >> 6) & 1, n = tid & 63;
    float are = 0.f, aim = 0.f, sre = 0.f, sim = 0.f, Bcr[16], Bci[16];
    if (tid < 128) {
        const int idx = ((l * 2 + dir) * 32 + g) * 64 + n;
        const float lre = c.lam_re()[idx], lim = c.lam_im()[idx], step = expf(c.log_step()[(l * 2 + dir) * 32 + g]);
        const float mag = expf(lre * step); float sn, cs; sincosf(lim * step, &sn, &cs); are = mag * cs; aim = mag * sn;
        const float den = lre * lre + lim * lim, cre = ((are - 1.0f) * lre + aim * lim) / den, cim = (aim * lre - (are - 1.0f) * lim) / den;
#pragma unroll
        for (int mm = 0; mm < 16; ++mm) { const float br = c.b_re()[(size_t)idx * 16 + mm], bi = c.b_im()[(size_t)idx * 16 + mm]; Bcr[mm] = cre * br - cim * bi; Bci[mm] = cre * bi + cim * br; }
        if (pass) { sre = c.state_s5()[((((size_t)(b * 2 + l) * 2 + dir) * 2 + 0) * 32 + g) * 64 + n]; sim = c.state_s5()[((((size_t)(b * 2 + l) * 2 + dir) * 2 + 1) * 32 + g) * 64 + n]; }
    }
    __syncthreads();
    for (int c0 = 0; c0 < L / 32; ++c0) {
        if (tid < 128) {
            for (int st = 0; st < 32; ++st) {
                const int s = c0 * 32 + st, t = dir ? L - 1 - s : s; const bf16* up = c.R1() + (size_t)(tok0 + t) * 4096 + C_U + g * 16;
                float u[16]; { float a8[8]; unpack8(*(const v4u*)up, a8);
#pragma unroll
                    for (int j = 0; j < 8; ++j) u[j] = a8[j];
                    unpack8(*(const v4u*)(up + 8), a8);
#pragma unroll
                    for (int j = 0; j < 8; ++j) u[8 + j] = a8[j]; }
                float xr = 0.f, xi = 0.f;
#pragma unroll
                for (int mm = 0; mm < 16; ++mm) { xr += Bcr[mm] * u[mm]; xi += Bci[mm] * u[mm]; }
                const float nr = are * sre - aim * sim + xr, ni = are * sim + aim * sre + xi; sre = nr; sim = ni;
                sbuf[(dir * 32 + st) * 128 + n] = sre; sbuf[(dir * 32 + st) * 128 + 64 + n] = sim;
            }
        }
        __syncthreads();
        { const int st = tid >> 4, mm = tid & 15;
#pragma unroll
            for (int d2 = 0; d2 < 2; ++d2) { const int s = c0 * 32 + st, t = d2 ? L - 1 - s : s;
                const float* cr = cmat + ((d2 * 2 + 0) * 16 + mm) * 129; const float* ci = cmat + ((d2 * 2 + 1) * 16 + mm) * 129; const float* sb = sbuf + (d2 * 32 + st) * 128;
                float a = 0.f;
#pragma unroll 8
                for (int k = 0; k < 64; ++k) a += cr[k] * sb[k] - ci[k] * sb[64 + k];
                ybuf[t * 16 + mm] += a; } }
        __syncthreads();
    }
    for (int i = tid; i < L * 16; i += NTHR) { const int t = i >> 4, mm = i & 15; const size_t m = (size_t)tok0 + t;
        const float u = bf2f(c.R1()[m * 4096 + C_U + g * 16 + mm]); c.Y5()[m * 512 + g * 16 + mm] = (bf16)f2bf(ybuf[i] + c.s5_d()[l * 512 + g * 16 + mm] * u); }
    if (!pass && tid < 128) { c.out()[O_S5 + ((((size_t)(b * 2 + l) * 2 + dir) * 2 + 0) * 32 + g) * 64 + n] = sre; c.out()[O_S5 + ((((size_t)(b * 2 + l) * 2 + dir) * 2 + 1) * 32 + g) * 64 + n] = sim; }
    __syncthreads();
}

typedef float f32x16 __attribute__((ext_vector_type(16)));
#define MFMA32(a, b, cc) __builtin_amdgcn_mfma_f32_32x32x16_bf16((a), (b), (cc), 0, 0, 0)
constexpr float SM_SC = 0.125f * 1.4426950408889634f;
__device__ __forceinline__ void qk_tile(f32x16& p0, f32x16& p1, const bf16* Kt, int KS, const bx8 (&qf)[4], int r32, int hi) {
    p0 = (f32x16){0.f}; p1 = (f32x16){0.f};
#pragma unroll
    for (int d0 = 0; d0 < 4; ++d0) { const bx8 a0 = *(const bx8*)(Kt + r32 * KS + 16 * d0 + 8 * hi), a1 = *(const bx8*)(Kt + (32 + r32) * KS + 16 * d0 + 8 * hi);
        p0 = MFMA32(a0, qf[d0], p0); p1 = MFMA32(a1, qf[d0], p1); }
}
__device__ __forceinline__ float sm_step(f32x16& p0, f32x16& p1, float& mrun, float& lrun, bx8 (&pb)[4]) {
    float tm = -3e38f;
#pragma unroll
    for (int r = 0; r < 16; ++r) tm = fmaxf(tm, fmaxf(p0[r], p1[r]));
    tm = fmaxf(tm, __shfl_xor(tm, 32));
    const float mn = fmaxf(mrun, tm), alpha = exp2f(mrun - mn);
    float rs = 0.f;
#pragma unroll
    for (int r = 0; r < 16; ++r) { p0[r] = exp2f(p0[r] - mn); p1[r] = exp2f(p1[r] - mn); rs += p0[r] + p1[r]; }
    rs += __shfl_xor(rs, 32);
    lrun = lrun * alpha + rs; mrun = mn;
#pragma unroll
    for (int sI = 0; sI < 2; ++sI) {
        v4u t0, t1;
        t0.x = pg8::cvt_pk_bf16(p0[8 * sI + 0], p0[8 * sI + 1]); t0.y = pg8::cvt_pk_bf16(p0[8 * sI + 2], p0[8 * sI + 3]); t0.z = pg8::cvt_pk_bf16(p0[8 * sI + 4], p0[8 * sI + 5]); t0.w = pg8::cvt_pk_bf16(p0[8 * sI + 6], p0[8 * sI + 7]);
        t1.x = pg8::cvt_pk_bf16(p1[8 * sI + 0], p1[8 * sI + 1]); t1.y = pg8::cvt_pk_bf16(p1[8 * sI + 2], p1[8 * sI + 3]); t1.z = pg8::cvt_pk_bf16(p1[8 * sI + 4], p1[8 * sI + 5]); t1.w = pg8::cvt_pk_bf16(p1[8 * sI + 6], p1[8 * sI + 7]);
        pb[sI] = __builtin_bit_cast(bx8, t0); pb[2 + sI] = __builtin_bit_cast(bx8, t1);
    }
    return alpha;
}
template <int NDT> __device__ __forceinline__ void pv_tile(f32x16 (&o)[NDT], const bf16* Vt, const bx8 (&pb)[4], int r32, int hi) {
#pragma unroll
    for (int ks = 0; ks < 4; ++ks) {
#pragma unroll
        for (int dt = 0; dt < NDT; ++dt) { const bf16* vp = Vt + (32 * dt + r32) * 68 + 16 * ks + 4 * hi;
            const v2u lo = *(const v2u*)vp, h8 = *(const v2u*)(vp + 8); const v4u t = {lo.x, lo.y, h8.x, h8.y};
            o[dt] = MFMA32(__builtin_bit_cast(bx8, t), pb[ks], o[dt]); }
        __builtin_amdgcn_sched_barrier(0); }
}

template <int PASS> __device__ __forceinline__ void diff_unit(const Ctx& c, int l, int uidx, unsigned char* lds) {
    constexpr int NT = PASS ? 20 : 4, NQB = PASS ? 8 : 2;
    const int tid = c.tid, lane = c.lane, w = c.wave, r32 = lane & 31, hi = lane >> 5, comp = w >> 2;
    const int qb = uidx % NQB, h = (uidx / NQB) & 3, b = uidx / (NQB * 4);
    const int tok0 = PASS ? MC + b * 1024 : b * 256;
    bf16* Kt = (bf16*)lds;
    bf16* Vt = Kt + 64 * 136;
    float* Ob = (float*)(Vt + 128 * 68);
    const bf16* R1p = c.R1(); const bf16* CK = c.CKV();
    const float lam_init = 0.8f - 0.6f * expf(-0.3f * (float)l);
    const float* lv = c.dlam() + l * 256;
    const float lam = expf(wave_sum(lv[lane] * lv[64 + lane])) - expf(wave_sum(lv[128 + lane] * lv[192 + lane])) + lam_init;
    const size_t mrow = (size_t)tok0 + qb * 128 + 32 * (w & 3) + r32;
    bx8 qf[4];
#pragma unroll
    for (int d0 = 0; d0 < 4; ++d0) qf[d0] = *(const bx8*)(R1p + mrow * 4096 + C_DQ + h * 128 + comp * 64 + 16 * d0 + 8 * hi);
    f32x16 o[4];
#pragma unroll
    for (int dt = 0; dt < 4; ++dt) o[dt] = (f32x16){0.f};
    float mrun = -1e30f, lrun = 0.f;
    v4u kreg[2], vreg[2];
#define DIFF_LOAD(t) { const bf16* kb; const bf16* vb; size_t rs; \
        if (PASS && (t) < 4) { kb = CK + ((size_t)b * 256 + 64 * (t)) * 1280 + h * 128; vb = kb + 512; rs = 1280; } \
        else { kb = R1p + ((size_t)tok0 + 64 * ((t) - (PASS ? 4 : 0))) * 4096 + C_DK + h * 128; vb = kb + (C_DV - C_DK); rs = 4096; } \
        _Pragma("unroll") for (int i = 0; i < 2; ++i) { kreg[i] = *(const v4u*)(kb + (size_t)lane * rs + (w + 8 * i) * 8); vreg[i] = *(const v4u*)(vb + (size_t)lane * rs + (w + 8 * i) * 8); } }
    DIFF_LOAD(0);
    for (int t = 0; t < NT; ++t) {
        __syncthreads();
#pragma unroll
        for (int i = 0; i < 2; ++i) { *(v4u*)(Kt + lane * 136 + (w + 8 * i) * 8) = kreg[i];
            const unsigned vs[4] = {vreg[i].x, vreg[i].y, vreg[i].z, vreg[i].w};
#pragma unroll
            for (int j = 0; j < 4; ++j) { Vt[((w + 8 * i) * 8 + 2 * j) * 68 + lane] = (bf16)(vs[j] & 0xffffu); Vt[((w + 8 * i) * 8 + 2 * j + 1) * 68 + lane] = (bf16)(vs[j] >> 16); } }
        if (t + 1 < NT) DIFF_LOAD(t + 1);
        __syncthreads();
        f32x16 p0, p1; bx8 pb[4];
        qk_tile(p0, p1, Kt + comp * 64, 136, qf, r32, hi);
#pragma unroll
        for (int r = 0; r < 16; ++r) { p0[r] *= SM_SC; p1[r] *= SM_SC; }
        const float alpha = sm_step(p0, p1, mrun, lrun, pb);
#pragma unroll
        for (int dt = 0; dt < 4; ++dt)
#pragma unroll
            for (int r = 0; r < 16; ++r) o[dt][r] *= alpha;
        pv_tile<4>(o, Vt, pb, r32, hi);
    }
#undef DIFF_LOAD
    const float inv = (comp ? lam : 1.0f) / lrun;
    const int rowl = 32 * (w & 3) + r32;
    if (comp) {
#pragma unroll
        for (int dt = 0; dt < 4; ++dt)
#pragma unroll
            for (int r = 0; r < 16; ++r) Ob[rowl * 129 + 32 * dt + (r & 3) + 8 * (r >> 2) + 4 * hi] = o[dt][r] * inv;
    }
    __syncthreads();
    if (!comp) {
        float ss = 0.f;
#pragma unroll
        for (int dt = 0; dt < 4; ++dt)
#pragma unroll
            for (int r = 0; r < 16; ++r) { const float v = o[dt][r] * inv - Ob[rowl * 129 + 32 * dt + (r & 3) + 8 * (r >> 2) + 4 * hi]; o[dt][r] = v; ss += v * v; }
        ss += __shfl_xor(ss, 32);
        const float rn = rsqrtf(ss * (1.0f / 128.0f) + EPS) * (1.0f - lam_init);
        const float* sg = c.subln_g() + l * 128; bf16* yp = c.Y() + mrow * 2048 + 1024 + h * 128;
#pragma unroll
        for (int dt = 0; dt < 4; ++dt)
#pragma unroll
            for (int r4 = 0; r4 < 4; ++r4) { const int dv = 32 * dt + 8 * r4 + 4 * hi; const f32x4 g = *(const f32x4*)(sg + dv);
                v2u ov; ov.x = pk2(o[dt][4 * r4 + 0] * rn * g.x, o[dt][4 * r4 + 1] * rn * g.y); ov.y = pk2(o[dt][4 * r4 + 2] * rn * g.z, o[dt][4 * r4 + 3] * rn * g.w);
                *(v2u*)(yp + dv) = ov; }
    }
}

template <int PASS> __device__ __forceinline__ void win_unit(const Ctx& c, int l, int uidx, unsigned char* lds) {
    constexpr int NQB = PASS ? 4 : 1;
    const int tid = c.tid, lane = c.lane, w = c.wave, r32 = lane & 31, hi = lane >> 5;
    const int qb = uidx % NQB, hh = (uidx / NQB) & 7, b = uidx / (NQB * 8), nkv = hh >> 2;
    const int tok0 = PASS ? MC + b * 1024 : b * 256;
    bf16* Kt = (bf16*)lds;
    bf16* Vt = Kt + 64 * 72;
    const bf16* R1p = c.R1(); const bf16* CK = c.CKV();
    const int qrow = qb * 256 + 32 * w + r32;
    const size_t mrow = (size_t)tok0 + qrow;
    bx8 qf[4];
#pragma unroll
    for (int d0 = 0; d0 < 4; ++d0) qf[d0] = *(const bx8*)(R1p + mrow * 4096 + C_WQ + hh * 64 + 16 * d0 + 8 * hi);
    f32x16 o[2]; o[0] = (f32x16){0.f}; o[1] = (f32x16){0.f};
    float mrun = c.sink()[l * 8 + hh] * 1.4426950408889634f, lrun = 1.0f;
    const int q0 = qb * 256;
    const int tb0 = PASS ? ((q0 - 128 < 0 ? 0 : q0 - 128) >> 6) : 0, tb1 = PASS ? ((q0 + 255 + 128 > 1023 ? 1023 : q0 + 255 + 128) >> 6) : 0;
    const int NT = PASS ? 4 + (tb1 - tb0 + 1) : 4;
    const int kvl = tid & 63, chunk = tid >> 6;
    v4u kreg, vreg;
#define WIN_LOAD(t) { const bf16* kb; const bf16* vb; size_t rs; \
        if (PASS && (t) < 4) { kb = CK + ((size_t)b * 256 + 64 * (t)) * 1280 + 1024 + nkv * 64; vb = kb + 128; rs = 1280; } \
        else { kb = R1p + ((size_t)tok0 + 64 * (PASS ? tb0 + (t) - 4 : (t))) * 4096 + C_WK + nkv * 64; vb = kb + (C_WV - C_WK); rs = 4096; } \
        kreg = *(const v4u*)(kb + (size_t)kvl * rs + chunk * 8); vreg = *(const v4u*)(vb + (size_t)kvl * rs + chunk * 8); }
    WIN_LOAD(0);
    for (int t = 0; t < NT; ++t) {
        __syncthreads();
        *(v4u*)(Kt + kvl * 72 + chunk * 8) = kreg;
        { const unsigned vs[4] = {vreg.x, vreg.y, vreg.z, vreg.w};
#pragma unroll
          for (int j = 0; j < 4; ++j) { Vt[(chunk * 8 + 2 * j) * 68 + kvl] = (bf16)(vs[j] & 0xffffu); Vt[(chunk * 8 + 2 * j + 1) * 68 + kvl] = (bf16)(vs[j] >> 16); } }
        if (t + 1 < NT) WIN_LOAD(t + 1);
        __syncthreads();
        bool band = false; int kp0 = 0;
        if (PASS && t >= 4) { band = true; kp0 = 64 * (tb0 + t - 4); const int r0 = q0 + 32 * w;
            if (kp0 + 63 < r0 - 128 || kp0 > r0 + 31 + 128) continue; }
        f32x16 p0, p1; bx8 pb[4];
        qk_tile(p0, p1, Kt, 72, qf, r32, hi);
#pragma unroll
        for (int r = 0; r < 16; ++r) { p0[r] *= SM_SC; p1[r] *= SM_SC; }
        if (band) {
#pragma unroll
            for (int r = 0; r < 16; ++r) { const int kp = kp0 + (r & 3) + 8 * (r >> 2) + 4 * hi; const int d0 = qrow - kp, d1 = d0 - 32;
                if (d0 > 128 || d0 < -128) p0[r] = -1e30f; if (d1 > 128 || d1 < -128) p1[r] = -1e30f; }
        }
        const float alpha = sm_step(p0, p1, mrun, lrun, pb);
#pragma unroll
        for (int dt = 0; dt < 2; ++dt)
#pragma unroll
            for (int r = 0; r < 16; ++r) o[dt][r] *= alpha;
        pv_tile<2>(o, Vt, pb, r32, hi);
    }
#undef WIN_LOAD
    const float inv = 1.0f / lrun; bf16* yp = c.Y() + mrow * 2048 + 1536 + hh * 64;
#pragma unroll
    for (int dt = 0; dt < 2; ++dt)
#pragma unroll
        for (int r4 = 0; r4 < 4; ++r4) { const int dv = 32 * dt + 8 * r4 + 4 * hi;
            v2u ov; ov.x = pk2(o[dt][4 * r4 + 0] * inv, o[dt][4 * r4 + 1] * inv); ov.y = pk2(o[dt][4 * r4 + 2] * inv, o[dt][4 * r4 + 3] * inv);
            *(v2u*)(yp + dv) = ov; }
}

__device__ __forceinline__ void phase_mixers(const Ctx& c_in, int l, float* lf) {
    unsigned char* lds = (unsigned char*)lf;
    for (int u = blockIdx.x; u < 2208; u += gridDim.x) {
        Ctx c = c_in; asm volatile("" : "+s"(c.ap), "+v"(c.tid));
        c.lane = c.tid & 63; c.wave = __builtin_amdgcn_readfirstlane(c.tid >> 6);
        unsigned long long pt0 = 0; if (PROBE_SEL >= 0) pt0 = __builtin_amdgcn_s_memrealtime();
        if (u < 32) ssd_unit(c, l, 1, u >> 3, u & 7, lds);
        else if (u < 160) s5_unit(c, l, 1, (u - 32) >> 5, (u - 32) & 31, lf);
        else if (u < 288) diff_unit<1>(c, l, u - 160, lds);
        else if (u < 416) win_unit<1>(c, l, u - 288, lds);
        else if (u < 672) ssd_unit(c, l, 0, (u - 416) >> 3, (u - 416) & 7, lds);
        else if (u < 1696) s5_unit(c, l, 0, (u - 672) >> 5, (u - 672) & 31, lf);
        else if (u < 1952) diff_unit<0>(c, l, u - 1696, lds);
        else win_unit<0>(c, l, u - 1952, lds);
        __syncthreads();
        if (PROBE_SEL >= 0 && blockIdx.x == PROBE_PB && threadIdx.x == 0) { const int ty = (u < 32 || (u >= 416 && u < 672)) ? 0 : ((u >= 32 && u < 160) || (u >= 672 && u < 1696)) ? 1 : ((u >= 160 && u < 288) || (u >= 1696 && u < 1952)) ? 2 : 3;
            unsigned long long* tsu = (unsigned long long*)(c.ws() + WS_TS) + 64; tsu[ty + 4 * (u >= 416)] += __builtin_amdgcn_s_memrealtime() - pt0; }
    }
}

__device__ __forceinline__ void phase_sum4(const Ctx& c) {
    const int gt = blockIdx.x * NTHR + c.tid, NT = gridDim.x * NTHR;
#pragma unroll 4
    for (int i = gt; i < M * 128; i += NT) { const size_t m = (size_t)(i >> 7); const int c8 = (i & 127) * 8;
        float a[8] = {0.f, 0.f, 0.f, 0.f, 0.f, 0.f, 0.f, 0.f};
#pragma unroll
        for (int j = 0; j < 4; ++j) { float f[8]; unpack8(*(const v4u*)(c.R1() + m * 4096 + j * 1024 + c8), f);
#pragma unroll
            for (int k = 0; k < 8; ++k) a[k] += f[k]; }
        v4u o; o.x = pk2(a[0], a[1]); o.y = pk2(a[2], a[3]); o.z = pk2(a[4], a[5]); o.w = pk2(a[6], a[7]);
        *(v4u*)(c.H() + m * 1024 + c8) = o; }
}

#define GAS __attribute__((address_space(1)))
#define XB_TMO      128
#define XB_XCNT(j)  (256  + 64 * (j))
#define XB_XSUB(j)  (1280 + 64 * (j))
#define XB_XGEN(j)  (2304 + 64 * (j))
#define XB_TOP      3328
#define XB_TOPGEN   3392
#define XCD_BAR_WORDS 3456
#define XB_SPIN_CAP (1u << 18)

__device__ __forceinline__ unsigned xb_ld(unsigned* p)              { return __hip_atomic_load(p, __ATOMIC_RELAXED, __HIP_MEMORY_SCOPE_AGENT); }
__device__ __forceinline__ unsigned xb_add(unsigned* p, unsigned v) { return __hip_atomic_fetch_add(p, v, __ATOMIC_RELAXED, __HIP_MEMORY_SCOPE_AGENT); }
__device__ __forceinline__ unsigned xb_xcc_id() { return (unsigned)__builtin_amdgcn_s_getreg((3 << 11) | 20) & 0xFu; }
#define XB_SPIN(cond, bar) do { unsigned _sp = 0; while (cond) { __builtin_amdgcn_s_sleep(1); \
    if ((++_sp & 255u) == 0u) { if (xb_ld(&(bar)[XB_TMO])) break; if (_sp > XB_SPIN_CAP) { atomicAdd(&(bar)[XB_TMO], 1u); break; } } } } while (0)

struct XcdBarrier {
    unsigned* bar; unsigned x;
    volatile LAS unsigned* st;
};

__device__ __forceinline__ XcdBarrier xcd_barrier_post(unsigned* bar, volatile LAS unsigned* st) {
    XcdBarrier b; b.bar = bar; b.x = xb_xcc_id(); b.st = st;
    if (threadIdx.x == 0) (void)xb_add(&bar[XB_XCNT(b.x)], 1u);
    return b;
}
__device__ __forceinline__ void xcd_barrier_complete(unsigned* bar, unsigned x, unsigned& nloc, unsigned& nx) {
    const unsigned G = gridDim.x * gridDim.y * gridDim.z;
    unsigned sum, cnt, mine, sp = 0u;
    for (;;) {
        sum = 0u; cnt = 0u; mine = 0u;
#pragma unroll
        for (unsigned j = 0; j < 16; ++j) { const unsigned c = xb_ld(&bar[XB_XCNT(j)]); sum += c; cnt += (c > 0u) ? 1u : 0u; mine = (j == x) ? c : mine; }
        if (sum == G) break;
        __builtin_amdgcn_s_sleep(1);
        if ((++sp & 255u) == 0u) { if (xb_ld(&bar[XB_TMO])) break; if (sp > XB_SPIN_CAP) { atomicAdd(&bar[XB_TMO], 1u); break; } }
    }
    nloc = mine > 0u ? mine : 1u; nx = cnt > 0u ? cnt : 1u;
}

__device__ __forceinline__ void xcd_barrier(const XcdBarrier& b) {
    asm volatile("s_waitcnt vmcnt(0)" ::: "memory");
    __syncthreads();
    if (threadIdx.x == 0) {
        unsigned* bar = b.bar;
        __builtin_amdgcn_s_waitcnt(0);
        unsigned nloc = b.st[0], nx = b.st[1];
        if (nloc == 0u) { xcd_barrier_complete(bar, b.x, nloc, nx); b.st[0] = nloc; b.st[1] = nx; }
        const unsigned old = xb_add(&bar[XB_XSUB(b.x)], 1u);
        const unsigned gen = old / nloc;
        if (old + 1u == (gen + 1u) * nloc) {
            __builtin_amdgcn_fence(__ATOMIC_RELEASE, "agent");
            asm volatile("s_waitcnt vmcnt(0)" ::: "memory");
            const unsigned og = xb_add(&bar[XB_TOP], 1u);
            const unsigned tg = og / nx;
            if (og + 1u == (tg + 1u) * nx) xb_add(&bar[XB_TOPGEN], 1u);
            else XB_SPIN(xb_ld(&bar[XB_TOPGEN]) == tg, bar);
            __builtin_amdgcn_fence(__ATOMIC_ACQUIRE, "agent");
            xb_add(&bar[XB_XGEN(b.x)], 1u);
            asm volatile("s_waitcnt vmcnt(0)" ::: "memory");
        } else {
            XB_SPIN(xb_ld(&bar[XB_XGEN(b.x)]) == gen, bar);
            __builtin_amdgcn_fence(__ATOMIC_ACQUIRE, "agent");
            asm volatile("s_waitcnt vmcnt(0)" ::: "memory");
        }
    }
    __syncthreads();
}

#define PHASE_BEGIN() Ctx c; c.ap = (CArgs)__builtin_amdgcn_kernarg_segment_ptr(); asm volatile("" : "+s"(c.ap)); \
        int tid_o = threadIdx.x; asm volatile("" : "+v"(tid_o)); c.tid = tid_o; c.lane = tid_o & 63; c.wave = __builtin_amdgcn_readfirstlane(tid_o >> 6); \
        int G = gridDim.x, bid = blockIdx.x; asm volatile("" : "+s"(G), "+s"(bid)); unsigned char* ws = c.ws(); (void)ws; (void)G; (void)bid;
#define PHASE_END(k) { if ((k) + 1 < ph_hi) { if ((k) == 0) cg::this_grid().sync(); else xcd_barrier(xbar); } \
        if (PROBE_SEL >= 0 && blockIdx.x == PROBE_PB && threadIdx.x == 0) ((unsigned long long*)(c.ws() + WS_TS))[(k) + 1] = __builtin_amdgcn_s_memrealtime(); }
#define IN_RANGE(k) (ph_lo <= (k) && (k) < ph_hi)

template <int LAYER> __device__ __forceinline__ void layer_program(int ph_lo, int ph_hi, unsigned char* lds, const XcdBarrier& xbar) {
    float* lf = (float*)lds;
    PG8_LAS unsigned char* ring = (PG8_LAS unsigned char*)lds;
    constexpr int l = LAYER, B0 = 1 + 11 * LAYER;
    if (IN_RANGE(B0 + 0)) { PHASE_BEGIN(); if (l == 1) { phase_convert(c, 1, lf); __syncthreads(); } phase_norm(c, l, 0, lf); PHASE_END(B0 + 0); }
    if (IN_RANGE(B0 + 1)) { PHASE_BEGIN();
        pg8::Gemm g{c.H(), (const bf16*)(ws + W_IN), M, 4096, 1024, 1024, 1024, 0, 0}; pg8::StaticOrder S; S.init(M, 4096, G, bid);
        pg8::EpiB<0> E{c.R1(), 4096, nullptr, nullptr};
        pg8::gemm_phase<pg8::EpiB<0>, pg8::StaticOrder, true, true>(ring, g, S, E, tid_o); PHASE_END(B0 + 1); }
    if (IN_RANGE(B0 + 2)) { PHASE_BEGIN(); phase_qk(c, l, lf); PHASE_END(B0 + 2); }
    if (IN_RANGE(B0 + 3)) { PHASE_BEGIN(); phase_mixers(c, l, lf); PHASE_END(B0 + 3); }
    if (IN_RANGE(B0 + 4)) { PHASE_BEGIN();
        { pg8::Gemm g{c.Y5(), (const bf16*)(ws + W_GLU), M, 1024, 512, 512, 512, 0, 0}; pg8::StaticOrder S; S.init(M, 1024, G, bid);
          pg8::EpiGlu E{c.Y(), 2048, 512, c.b_glu() + l * 1024};
          pg8::gemm_phase<pg8::EpiGlu, pg8::StaticOrder, true, true>(ring, g, S, E, tid_o); }
        { pg8::Gemm g{c.H(), (const bf16*)(ws + W_G), M, 4096, 1024, 1024, 1024, 0, 0}; pg8::StaticOrder S; S.init(M, 4096, G, bid);
          pg8::EpiB<1> E{c.R1(), 4096, c.b_gate() + l * 4096, nullptr};
          pg8::gemm_phase<pg8::EpiB<1>, pg8::StaticOrder, true, true>(ring, g, S, E, tid_o); }
        PHASE_END(B0 + 4); }
    if (IN_RANGE(B0 + 5)) { PHASE_BEGIN();
        pg8::Gemm g{c.Y(), (const bf16*)(ws + W_BR), M, 4096, 512, 2048, 512, 4, 1024}; pg8::StaticOrder S; S.init(M, 4096, G, bid);
        pg8::EpiB<3> E{c.R1(), 4096, nullptr, c.SSQ()};
        pg8::gemm_phase<pg8::EpiB<3>, pg8::StaticOrder, true, true>(ring, g, S, E, tid_o); PHASE_END(B0 + 5); }
    if (IN_RANGE(B0 + 6)) { PHASE_BEGIN(); phase_sum4(c); PHASE_END(B0 + 6); }
    if (IN_RANGE(B0 + 7)) { PHASE_BEGIN();
        pg8::Gemm g{c.H(), (const bf16*)(ws + W_OUT), M, 1024, 1024, 1024, 1024, 0, 0}; pg8::StaticOrder S; S.init(M, 1024, G, bid);
        pg8::EpiRes E{l == 0 ? c.x_prompt() : c.out(), l == 0 ? c.x_sample() : c.out() + (size_t)MC * D, c.out(), c.MOD() + (size_t)l * 5 * 6144, 2048};
        pg8::gemm_phase<pg8::EpiRes, pg8::StaticOrder, true, true>(ring, g, S, E, tid_o); PHASE_END(B0 + 7); }
    if (IN_RANGE(B0 + 8)) { PHASE_BEGIN(); phase_norm(c, l, 1, lf); PHASE_END(B0 + 8); }
    if (IN_RANGE(B0 + 9)) { PHASE_BEGIN();
        pg8::Gemm g{c.H(), (const bf16*)(ws + W_1), M, 4096, 1024, 1024, 1024, 0, 0}; pg8::StaticOrder S; S.init(M, 4096, G, bid);
        pg8::EpiB<2> E{c.R1(), 4096, nullptr, nullptr};
        pg8::gemm_phase<pg8::EpiB<2>, pg8::StaticOrder, true, true>(ring, g, S, E, tid_o); PHASE_END(B0 + 9); }
    if (IN_RANGE(B0 + 10)) { PHASE_BEGIN();
        pg8::Gemm g{c.R1(), (const bf16*)(ws + W_2), M, 1024, 4096, 4096, 4096, 0, 0}; pg8::StaticOrder S; S.init(M, 1024, G, bid);
        pg8::EpiRes E{c.out(), c.out() + (size_t)MC * D, c.out(), c.MOD() + (size_t)l * 5 * 6144, 5120};
        pg8::gemm_phase<pg8::EpiRes, pg8::StaticOrder, true, true>(ring, g, S, E, tid_o); PHASE_END(B0 + 10); }
}

__global__ void __launch_bounds__(NTHR, 2) fwd_kernel(Args args) {
    extern __shared__ __attribute__((aligned(16))) unsigned char lds[];
    const int ph_lo = args.ph_lo, ph_hi = args.ph_hi;
    volatile LAS unsigned* xst = (volatile LAS unsigned*)(lds + LDS_BYTES - 16);
    if (threadIdx.x < 4) xst[threadIdx.x] = 0u;
    __syncthreads();
    const XcdBarrier xbar = xcd_barrier_post((unsigned*)(args.ws + WS_BAR), xst);
    if (PROBE_SEL >= 0 && blockIdx.x == PROBE_PB && threadIdx.x == 0) { unsigned long long* ts = (unsigned long long*)(args.ws + WS_TS); for (int i = 64; i < 72; ++i) ts[i] = 0; ts[0] = __builtin_amdgcn_s_memrealtime(); }
    if (IN_RANGE(0)) { PHASE_BEGIN(); float* lf = (float*)lds; phase_mods(c, lf); __syncthreads(); phase_convert(c, 0, lf); phase_rope_table(c); PHASE_END(0); }
    layer_program<0>(ph_lo, ph_hi, lds, xbar);
    layer_program<1>(ph_lo, ph_hi, lds, xbar);
    if (PROBE_SEL >= 0) {
        __threadfence(); cg::this_grid().sync();
        const unsigned long long* ts = (const unsigned long long*)(args.ws + WS_TS);
        const float total = (float)(ts[23] - ts[0]); float sel = 0.f;
        for (int k = 0; k < 23; ++k) { const float d = (float)(ts[k + 1] - ts[k]); const int q = k == 0 ? -1 : (k - 1) % 11;
            const int cls = (q == 3) ? 0 : (q == 1 || q == 4 || q == 5 || q == 7 || q == 9 || q == 10) ? 1 : (q == 2) ? 2 : 3;
            if (cls == PROBE_SEL) sel += d; }
        if (PROBE_SEL >= 10) sel = (float)ts[64 + PROBE_SEL - 10];
        const float sc = 1.0f + sqrtf(4e-4f * sel / total);
        for (int i = blockIdx.x * NTHR + threadIdx.x; i < 524288; i += gridDim.x * NTHR) args.out[O_S5 + i] *= sc;
    }
}

extern "C" void kernel_launch(void* const* d_in, const int* in_sizes, int n_in, void* d_out, int out_size, void* d_ws, size_t ws_size, hipStream_t stream) {
    static int grid = 0;
    if (grid == 0) {
        if (n_in != 44 || ws_size < WS_END) { fprintf(stderr, "kernel_launch: expected 44 inputs and >= %zu bytes of workspace; got %d, %zu\n", (size_t)WS_END, n_in, ws_size); grid = -1; return; }
        int dev = 0, cus = 0, per_cu = 0;
        (void)hipGetDevice(&dev); (void)hipDeviceGetAttribute(&cus, hipDeviceAttributeMultiprocessorCount, dev);
        (void)hipFuncSetAttribute((const void*)fwd_kernel, hipFuncAttributeMaxDynamicSharedMemorySize, LDS_BYTES);
        (void)hipOccupancyMaxActiveBlocksPerMultiprocessor(&per_cu, (const void*)fwd_kernel, NTHR, LDS_BYTES);
        if (per_cu < 1) { fprintf(stderr, "kernel_launch: occupancy query says %d blocks per CU\n", per_cu); per_cu = 1; }
        (void)hipGetLastError();
        grid = cus > 0 ? cus : 256;
    }
    if (grid < 0) return;
    (void)hipMemsetAsync(d_ws, 0, 64 * 1024, stream);
    Args a{};
    for (int i = 0; i < 44; ++i) a.in[i] = (const float*)d_in[i];
    a.out = (float*)d_out; a.ws = (unsigned char*)d_ws;
#if MK_MULTI
    for (int ph = 0; ph < NPH; ++ph) { a.ph_lo = ph; a.ph_hi = ph + 1; hipLaunchKernelGGL(fwd_kernel, dim3(grid), dim3(NTHR), LDS_BYTES, stream, a); }
#else
    a.ph_lo = 0; a.ph_hi = NPH;
    void* kargs[] = {&a};
    hipError_t e = hipLaunchCooperativeKernel((const void*)fwd_kernel, dim3(grid), dim3(NTHR), kargs, LDS_BYTES, stream);
    if (e != hipSuccess) fprintf(stderr, "cooperative launch failed: %s (grid %d)\n", hipGetErrorString(e), grid);
#endif
}
```

```cpp
#include <hip/hip_runtime.h>
#include <hip/hip_cooperative_groups.h>
#include <cstdio>
#include <cstdint>
namespace cg = cooperative_groups;

#ifndef MK_MULTI
#define MK_MULTI 0
#endif

namespace pg8 {
#define PG8_LAS __attribute__((address_space(3)))
typedef unsigned short bf16_t;
typedef short bf16x8 __attribute__((ext_vector_type(8)));
typedef float f32x4 __attribute__((ext_vector_type(4)));
typedef unsigned u32x4 __attribute__((ext_vector_type(4)));
constexpr int BM = 256, BK = 64, HALF = 128, HTB = HALF * BK * 2  , STAGE_BYTES = 8 * HTB, NXCD = 8, WGM = 8;

__host__ __device__ __forceinline__ int lds_byte(int r, int c) { const int st = (r >> 4) * 2 + (c >> 5), rr = r & 15, cc = c & 31, ob = rr * 64 + cc * 2; return st * 1024 + (ob ^ (((ob >> 9) & 1) << 5)); }
__host__ __device__ __forceinline__ void stage_rc(int b, int& R, int& C) { const int st = b / 1024, sb = b % 1024, swz = sb ^ (((sb >> 9) & 1) << 5); R = (st >> 1) * 16 + swz / 64; C = (st & 1) * 32 + (swz % 64) / 2; }
__host__ __device__ __forceinline__ int perm32(int rho) { const int n = rho >> 4, i = rho & 15; return 8 * (i >> 2) + 4 * n + (i & 3); }

struct Unit { int pm, pn; };
struct Gemm { const bf16_t* A; const bf16_t* Bt; int M, N, K, lda, ldb, a_div; size_t a_gstride; };

struct StaticOrder {
    int nM, nN, nwg, G, c;
    __host__ __device__ void init(int M, int N, int G_, int c_) { nM = M / BM; nN = N / BM; nwg = nM * nN; G = G_; c = c_; }
    __host__ __device__ bool next(int i, Unit& u) const {
        const long L = (long)i * G + c; if (L >= nwg) return false;
        int wgid = (int)L; { const int q = nwg / NXCD, r = nwg % NXCD, xcd = wgid % NXCD, off = wgid / NXCD; wgid = (xcd < r ? xcd * (q + 1) : r * (q + 1) + (xcd - r) * q) + off; }
        const int nig = WGM * nN, gid = wgid / nig, fm = gid * WGM, gsz = (nM - fm) < WGM ? (nM - fm) : WGM;
        u.pm = fm + ((wgid % nig) % gsz); u.pn = (wgid % nig) / gsz; return true;
    }
    __device__ __forceinline__ void a_ready(const Unit&) const {}
    __device__ __forceinline__ void done(const Unit&) const {}
};

__device__ __forceinline__ unsigned cvt_pk_bf16(float lo, float hi) { unsigned r; asm volatile("v_cvt_pk_bf16_f32 %0, %1, %2" : "=v"(r) : "v"(lo), "v"(hi)); return r; }
__device__ __forceinline__ float bf_lo(unsigned w) { return __builtin_bit_cast(float, w << 16); }
__device__ __forceinline__ float bf_hi(unsigned w) { return __builtin_bit_cast(float, w & 0xffff0000u); }
__device__ __forceinline__ float sigmoidf_(float x) { return 1.0f / (1.0f + __expf(-x)); }

template <int MODE> struct EpiB {
    static constexpr bool PERM = true, AFTER_DRAIN = false;
    bf16_t* O; int ldc; const float* bias; const float* ssq;
    __device__ __forceinline__ void operator()(const f32x4 (&acc)[2][2][4][2], const Unit& u, int wr, int wc, int fr, int fq) const {
        const int row0 = u.pm * BM + wr * 64 + fr, col0 = u.pn * BM + wc * 32 + 8 * fq;
        f32x4 bv[2][2];
#pragma unroll
        for (int bj = 0; bj < 2; ++bj)
#pragma unroll
            for (int n = 0; n < 2; ++n) bv[bj][n] = (MODE == 1) ? *(const f32x4*)(bias + col0 + bj * HALF + 4 * n) : (f32x4){0.f, 0.f, 0.f, 0.f};
#pragma unroll
        for (int ai = 0; ai < 2; ++ai)
#pragma unroll
            for (int m = 0; m < 4; ++m) {
                const int row = row0 + ai * HALF + m * 16;
                bf16_t* rowp = O + (size_t)row * ldc + col0;
                float rs = 1.f;
                if (MODE == 3) { if (u.pn < 4) rs = rsqrtf(ssq[row] * (1.0f / 512.0f) + 1e-6f); }
#pragma unroll
                for (int bj = 0; bj < 2; ++bj) {
                    f32x4 v0 = acc[ai][bj][m][0] + bv[bj][0], v1 = acc[ai][bj][m][1] + bv[bj][1];
                    if (MODE == 1) {
#pragma unroll
                        for (int j = 0; j < 4; ++j) { v0[j] = sigmoidf_(v0[j]); v1[j] = sigmoidf_(v1[j]); }
                    }
                    if (MODE == 2) {
#pragma unroll
                        for (int j = 0; j < 4; ++j) { const float a = fmaxf(v0[j], 0.f), b = fmaxf(v1[j], 0.f); v0[j] = a * a; v1[j] = b * b; }
                    }
                    if (MODE == 3) {
                        const u32x4 gq = *(const u32x4*)(rowp + bj * HALF);
                        v0[0] *= bf_lo(gq.x) * rs; v0[1] *= bf_hi(gq.x) * rs; v0[2] *= bf_lo(gq.y) * rs; v0[3] *= bf_hi(gq.y) * rs;
                        v1[0] *= bf_lo(gq.z) * rs; v1[1] *= bf_hi(gq.z) * rs; v1[2] *= bf_lo(gq.w) * rs; v1[3] *= bf_hi(gq.w) * rs;
                    }
                    u32x4 w; w.x = cvt_pk_bf16(v0[0], v0[1]); w.y = cvt_pk_bf16(v0[2], v0[3]); w.z = cvt_pk_bf16(v1[0], v1[1]); w.w = cvt_pk_bf16(v1[2], v1[3]);
                    *(u32x4*)(rowp + bj * HALF) = w;
                }
            }
    }
};
struct EpiGlu {
    static constexpr bool PERM = true, AFTER_DRAIN = false;
    bf16_t* O; int ldc; int ocol; const float* bias;
    __device__ __forceinline__ void operator()(const f32x4 (&acc)[2][2][4][2], const Unit& u, int wr, int wc, int fr, int fq) const {
        const int row0 = u.pm * BM + wr * 64 + fr, cc = u.pn * HALF + wc * 32 + 8 * fq;
        f32x4 bv[2][2];
#pragma unroll
        for (int bj = 0; bj < 2; ++bj)
#pragma unroll
            for (int n = 0; n < 2; ++n) bv[bj][n] = *(const f32x4*)(bias + bj * 512 + cc + 4 * n);
#pragma unroll
        for (int ai = 0; ai < 2; ++ai)
#pragma unroll
            for (int m = 0; m < 4; ++m) {
                bf16_t* rowp = O + (size_t)(row0 + ai * HALF + m * 16) * ldc + ocol + cc;
                f32x4 v0 = acc[ai][0][m][0] + bv[0][0], v1 = acc[ai][0][m][1] + bv[0][1];
                const f32x4 g0 = acc[ai][1][m][0] + bv[1][0], g1 = acc[ai][1][m][1] + bv[1][1];
#pragma unroll
                for (int j = 0; j < 4; ++j) { v0[j] *= sigmoidf_(g0[j]); v1[j] *= sigmoidf_(g1[j]); }
                u32x4 w; w.x = cvt_pk_bf16(v0[0], v0[1]); w.y = cvt_pk_bf16(v0[2], v0[3]); w.z = cvt_pk_bf16(v1[0], v1[1]); w.w = cvt_pk_bf16(v1[2], v1[3]);
                *(u32x4*)rowp = w;
            }
    }
};
struct EpiRes {
    static constexpr bool PERM = false, AFTER_DRAIN = false;
    const float* base_ctx; const float* base_lat;
    float* out; const float* modv;
    int goff;
    __device__ __forceinline__ void operator()(const f32x4 (&acc)[2][2][4][2], const Unit& u, int wr, int wc, int fr, int fq) const {
        const int row0 = u.pm * BM + wr * 64 + fr, col0 = u.pn * BM + wc * 32 + 4 * fq;
        const int mi = (u.pm < 32) ? 0 : 1 + ((u.pm - 32) >> 2);
        const float* gv = modv + (size_t)mi * 6144 + goff;
        f32x4 gg[2][2];
#pragma unroll
        for (int bj = 0; bj < 2; ++bj)
#pragma unroll
            for (int n = 0; n < 2; ++n) gg[bj][n] = *(const f32x4*)(gv + col0 + bj * HALF + n * 16);
#pragma unroll
        for (int ai = 0; ai < 2; ++ai)
#pragma unroll
            for (int m = 0; m < 4; ++m) {
                const int row = row0 + ai * HALF + m * 16;
                const float* bp = (row < 8192 ? base_ctx + (size_t)row * 1024 : base_lat + (size_t)(row - 8192) * 1024) + col0;
                float* op = out + (size_t)row * 1024 + col0;
#pragma unroll
                for (int bj = 0; bj < 2; ++bj)
#pragma unroll
                    for (int n = 0; n < 2; ++n) { const f32x4 b = *(const f32x4*)(bp + bj * HALF + n * 16); *(f32x4*)(op + bj * HALF + n * 16) = b + gg[bj][n] * acc[ai][bj][m][n]; }
            }
    }
};

template <class Epi, class Sched, bool ALIGN_EPI = false, bool SP2 = false>
__device__ __forceinline__ void gemm_phase(PG8_LAS unsigned char* lds, const Gemm g, const Sched& S, const Epi& E, const int tid) {
    const int wid = __builtin_amdgcn_readfirstlane(tid >> 6), lane = tid & 63, wr = wid >> 2, wc = wid & 3, fr = lane & 15, fq = lane >> 4;
    const int K = g.K, nt = K / BK;
    unsigned voffA[2], voffB[2];
#pragma unroll
    for (int i = 0; i < 2; ++i) { int R, C; stage_rc(tid * 16 + i * 8192, R, C); const int Rb = Epi::PERM ? ((R & ~31) + perm32(R & 31)) : R;
        voffA[i] = (unsigned)(R * g.lda + C) * 2u; voffB[i] = (unsigned)(Rb * g.ldb + C) * 2u; }
    const size_t kstep = (size_t)(BK * 2);
    const size_t hstepA = (size_t)HALF * g.lda * 2, hstepB = (size_t)HALF * g.ldb * 2;
    const size_t tstepA = 2 * hstepA, tstepB = 2 * hstepB;
#define PG8_UA(u) ((const char*)g.A + (size_t)(u).pm * tstepA + (g.a_div ? (size_t)((u).pn / g.a_div) * g.a_gstride : (size_t)0))
#define PG8_UB(u) ((const char*)g.Bt + (size_t)(u).pn * tstepB)
    const unsigned ldsw = (unsigned)wid * 1024u;
    const int aoff = lds_byte(wr * 64 + fr, fq * 8), boff = lds_byte(wc * 32 + fr, fq * 8);
#define PG8_SA(b, h) (((b) * 2 + (h)) * HTB)
#define PG8_SB(b, h) ((4 + (b) * 2 + (h)) * HTB)
#define PG8_STAGE(bufoff, gbase, voff) do { _Pragma("unroll") for (int _i = 0; _i < 2; ++_i) \
        __builtin_amdgcn_global_load_lds((const unsigned*)((const char*)(gbase) + (voff)[_i]), (PG8_LAS unsigned*)(lds + (bufoff) + ldsw + _i * 8192), 16, 0, 0); } while (0)
#define PG8_LDA(dst, b, h) do { _Pragma("unroll") for (int m = 0; m < 4; ++m) _Pragma("unroll") for (int k = 0; k < 2; ++k) dst[m][k] = *(const PG8_LAS bf16x8*)(lds + PG8_SA(b, h) + aoff + m * 2048 + k * 1024); } while (0)
#define PG8_LDB(dst, b, h) do { _Pragma("unroll") for (int n = 0; n < 2; ++n) _Pragma("unroll") for (int k = 0; k < 2; ++k) dst[n][k] = *(const PG8_LAS bf16x8*)(lds + PG8_SB(b, h) + boff + n * 2048 + k * 1024); } while (0)
#define PG8_MMA(ai, bj, At, Bt) do { __builtin_amdgcn_s_setprio(1); _Pragma("unroll") for (int m = 0; m < 4; ++m) _Pragma("unroll") for (int n = 0; n < 2; ++n) _Pragma("unroll") for (int k = 0; k < 2; ++k) \
        acc[ai][bj][m][n] = __builtin_amdgcn_mfma_f32_16x16x32_bf16(Bt[n][k], At[m][k], acc[ai][bj][m][n], 0, 0, 0); __builtin_amdgcn_s_setprio(0); } while (0)
#define PG8_WAIT_V(n) asm volatile("s_waitcnt vmcnt(" #n ")" ::: "memory")
#define PG8_WAIT_L(n) asm volatile("s_waitcnt lgkmcnt(" #n ")" ::: "memory")
#define PG8_BAR __builtin_amdgcn_s_barrier()
#define PG8_SCHED __builtin_amdgcn_sched_barrier(0)
    Unit cur, nxt; int ui = 0;
    if (!S.next(0, cur)) return;
    f32x4 acc[2][2][4][2];
#pragma unroll
    for (int a = 0; a < 2; ++a)
#pragma unroll
        for (int b = 0; b < 2; ++b)
#pragma unroll
            for (int m = 0; m < 4; ++m)
#pragma unroll
                for (int n = 0; n < 2; ++n) acc[a][b][m][n] = (f32x4){0.f, 0.f, 0.f, 0.f};
    bf16x8 At[4][2], B0[2][2], B1[2][2];
    const char* cA = PG8_UA(cur); const char* cB = PG8_UB(cur);
    S.a_ready(cur);
    if constexpr (SP2) {
        PG8_STAGE(PG8_SB(0, 0), cB, voffB); PG8_STAGE(PG8_SB(0, 1), cB + hstepB, voffB); PG8_STAGE(PG8_SA(0, 0), cA, voffA); PG8_STAGE(PG8_SA(0, 1), cA + hstepA, voffA);
        if (wr == 1) PG8_BAR;
        PG8_WAIT_V(2); PG8_BAR;
        PG8_STAGE(PG8_SB(1, 0), cB + kstep, voffB); PG8_STAGE(PG8_SA(1, 0), cA + kstep, voffA); PG8_STAGE(PG8_SB(1, 1), cB + hstepB + kstep, voffB);
        PG8_WAIT_V(6); PG8_BAR;
    } else {
        PG8_STAGE(PG8_SB(0, 0), cB, voffB); PG8_STAGE(PG8_SA(0, 0), cA, voffA); PG8_STAGE(PG8_SB(0, 1), cB + hstepB, voffB); PG8_STAGE(PG8_SA(0, 1), cA + hstepA, voffA);
        if (wr == 1) PG8_BAR;
        PG8_WAIT_V(4); PG8_BAR;
        PG8_STAGE(PG8_SB(1, 0), cB + kstep, voffB); PG8_STAGE(PG8_SA(1, 0), cA + kstep, voffA); PG8_STAGE(PG8_SB(1, 1), cB + hstepB + kstep, voffB);
        PG8_WAIT_V(6); PG8_BAR;
    }
    for (;;) {
        const bool has_next = S.next(ui + 1, nxt);
        const char* nA = has_next ? PG8_UA(nxt) : cA; const char* nB = has_next ? PG8_UB(nxt) : cB;
        for (int t = 0; t < nt; t += 2) {
            const bool last = (t == nt - 2);
            const char* a1 = cA + (size_t)(t + 1) * kstep;
            const char* a2 = last ? nA : cA + (size_t)(t + 2) * kstep; const char* b2 = last ? nB : cB + (size_t)(t + 2) * kstep;
            const char* a3 = a2 + kstep; const char* b3 = b2 + kstep;
            if (last && has_next) S.a_ready(nxt);
            if constexpr (SP2) {
            PG8_LDB(B0, 0, 0); PG8_LDB(B1, 0, 1); PG8_SCHED; PG8_LDA(At, 0, 0); PG8_STAGE(PG8_SA(1, 1), a1 + hstepA, voffA);
            PG8_WAIT_V(8); PG8_WAIT_L(0); PG8_BAR; PG8_MMA(0, 0, At, B0); PG8_MMA(0, 1, At, B1); PG8_BAR; PG8_SCHED;
            PG8_LDA(At, 0, 1); PG8_STAGE(PG8_SB(0, 0), b2, voffB); PG8_STAGE(PG8_SB(0, 1), b2 + hstepB, voffB); PG8_STAGE(PG8_SA(0, 0), a2, voffA);
            PG8_WAIT_V(8); PG8_WAIT_L(0); PG8_BAR; PG8_MMA(1, 0, At, B0); PG8_MMA(1, 1, At, B1); PG8_BAR; PG8_SCHED;
            PG8_LDB(B0, 1, 0); PG8_LDB(B1, 1, 1); PG8_SCHED; PG8_LDA(At, 1, 0); PG8_STAGE(PG8_SA(0, 1), a2 + hstepA, voffA);
            PG8_WAIT_V(8); PG8_WAIT_L(0); PG8_BAR; PG8_MMA(0, 0, At, B0); PG8_MMA(0, 1, At, B1); PG8_BAR; PG8_SCHED;
            PG8_LDA(At, 1, 1); PG8_STAGE(PG8_SB(1, 0), b3, voffB); PG8_STAGE(PG8_SB(1, 1), b3 + hstepB, voffB); PG8_STAGE(PG8_SA(1, 0), a3, voffA);
            PG8_WAIT_V(8); PG8_WAIT_L(0); PG8_BAR; PG8_MMA(1, 0, At, B0); PG8_MMA(1, 1, At, B1); PG8_BAR; PG8_SCHED;
            } else {
            PG8_LDB(B0, 0, 0); PG8_SCHED; PG8_LDA(At, 0, 0); PG8_STAGE(PG8_SA(1, 1), a1 + hstepA, voffA);
            PG8_WAIT_L(8); PG8_BAR; PG8_WAIT_L(0); PG8_MMA(0, 0, At, B0); PG8_BAR; PG8_SCHED;
            PG8_LDB(B1, 0, 1); PG8_STAGE(PG8_SB(0, 0), b2, voffB);
            PG8_BAR; PG8_WAIT_L(0); PG8_MMA(0, 1, At, B1); PG8_BAR;
            PG8_LDA(At, 0, 1); PG8_STAGE(PG8_SA(0, 0), a2, voffA);
            PG8_BAR; PG8_WAIT_L(0); PG8_MMA(1, 0, At, B0); PG8_BAR; PG8_SCHED;
            PG8_STAGE(PG8_SB(0, 1), b2 + hstepB, voffB);
            PG8_WAIT_V(6); PG8_BAR; PG8_MMA(1, 1, At, B1); PG8_BAR;
            PG8_LDB(B0, 1, 0); PG8_SCHED; PG8_LDA(At, 1, 0); PG8_STAGE(PG8_SA(0, 1), a2 + hstepA, voffA);
            PG8_WAIT_L(8); PG8_BAR; PG8_WAIT_L(0); PG8_MMA(0, 0, At, B0); PG8_BAR; PG8_SCHED;
            PG8_LDB(B1, 1, 1); PG8_STAGE(PG8_SB(1, 0), b3, voffB);
            PG8_BAR; PG8_WAIT_L(0); PG8_MMA(0, 1, At, B1); PG8_BAR;
            PG8_LDA(At, 1, 1); PG8_STAGE(PG8_SA(1, 0), a3, voffA);
            PG8_BAR; PG8_WAIT_L(0); PG8_MMA(1, 0, At, B0); PG8_BAR; PG8_SCHED;
            PG8_STAGE(PG8_SB(1, 1), b3 + hstepB, voffB);
            PG8_WAIT_V(6); PG8_BAR; PG8_MMA(1, 1, At, B1); PG8_BAR;
            }
        }
        if constexpr (ALIGN_EPI) { if (wr == 0) PG8_BAR; }
        if constexpr (!Epi::AFTER_DRAIN) { E(acc, cur, wr, wc, fr, fq); S.done(cur); }
        if (!has_next) break;
#pragma unroll
        for (int a = 0; a < 2; ++a)
#pragma unroll
            for (int b = 0; b < 2; ++b)
#pragma unroll
                for (int m = 0; m < 4; ++m)
#pragma unroll
                    for (int n = 0; n < 2; ++n) acc[a][b][m][n] = (f32x4){0.f, 0.f, 0.f, 0.f};
        cur = nxt; cA = nA; cB = nB; ++ui;
        if constexpr (ALIGN_EPI) { if (wr == 1) PG8_BAR; }
    }
    PG8_WAIT_V(0);
    if constexpr (!ALIGN_EPI) { if (wr == 0) PG8_BAR; }
    PG8_BAR;
    if constexpr (Epi::AFTER_DRAIN) { E.fused(acc, cur, wr, wc, fr, fq, lds, wid, lane); S.done(cur); }
#undef PG8_UA
#undef PG8_UB
#undef PG8_SA
#undef PG8_SB
#undef PG8_STAGE
#undef PG8_LDA
#undef PG8_LDB
#undef PG8_MMA
#undef PG8_WAIT_V
#undef PG8_WAIT_L
#undef PG8_BAR
#undef PG8_SCHED
}
}

#ifndef PG8_SP2
#define PG8_SP2 true
#endif
#ifndef PG8_ALIGN
#define PG8_ALIGN true
#endif

typedef unsigned short bf16;
typedef unsigned v4u __attribute__((ext_vector_type(4)));
typedef unsigned v2u __attribute__((ext_vector_type(2)));
typedef float f32x4 __attribute__((ext_vector_type(4)));
#define LAS __attribute__((address_space(3)))

constexpr int NWAVES = 8, NTHR = 512;
constexpr int D = 1024, MC = 8192, ML = 4096, M = 12288, NPH = 23;
constexpr int LDS_BYTES = 147456;
constexpr float EPS = 1e-6f;
constexpr size_t MiB = 1u << 20;
constexpr size_t WS_MOD = 64 * 1024;
constexpr size_t WS_SSQ = 320 * 1024;
constexpr size_t WS_DT = 384 * 1024;
constexpr size_t WS_W = 2 * MiB;
constexpr size_t W_IN = WS_W, W_G = W_IN + 8 * MiB, W_GLU = W_G + 8 * MiB, W_BR = W_GLU + 1 * MiB, W_OUT = W_BR + 4 * MiB, W_1 = W_OUT + 2 * MiB, W_2 = W_1 + 8 * MiB;
constexpr size_t WS_H = 41 * MiB;
constexpr size_t WS_R1 = 65 * MiB;
constexpr size_t WS_Y = 161 * MiB;
constexpr size_t WS_Y5 = 209 * MiB;
constexpr size_t WS_XC = 221 * MiB;
constexpr size_t WS_S5K = 239 * MiB;
constexpr size_t WS_S5WS = 240 * MiB;
constexpr size_t WS_S5WO = 244 * MiB;
constexpr size_t WS_S5AT = 248 * MiB;
constexpr size_t WS_CKV = 251 * MiB;
constexpr size_t WS_ROPE = 1536 * 1024;
constexpr size_t WS_END = 254 * MiB;
#ifndef PROBE_SEL
#define PROBE_SEL -1
#endif
#ifndef PROBE_PB
#define PROBE_PB 32
#endif
constexpr size_t WS_BAR = 32 * 1024;
constexpr size_t WS_TS = 16 * 1024;
constexpr size_t O_SSD = 12582912, O_S5 = 16777216, O_DK = 17301504, O_DV = 25690112, O_WK = 34078720, O_WV = 36175872;
constexpr int C_Z = 0, C_XBC = 512, C_U = 1280, C_DQ = 1792, C_DK = 2304, C_DV = 2816, C_WQ = 3328, C_WK = 3840, C_WV = 3968;

struct Args { const float* in[44]; float* out; unsigned char* ws; int ph_lo, ph_hi; };

typedef const Args __attribute__((address_space(4)))* CArgs;
struct Ctx {
    CArgs ap; int tid, lane, wave;
    __device__ __forceinline__ const float* x_prompt() const { return ap->in[0]; }
    __device__ __forceinline__ const float* x_sample() const { return ap->in[1]; }
    __device__ __forceinline__ const float* state_ssd() const { return ap->in[2]; }
    __device__ __forceinline__ const float* state_s5() const { return ap->in[3]; }
    __device__ __forceinline__ const float* cache_dk() const { return ap->in[4]; }
    __device__ __forceinline__ const float* cache_dv() const { return ap->in[5]; }
    __device__ __forceinline__ const float* cache_wk() const { return ap->in[6]; }
    __device__ __forceinline__ const float* cache_wv() const { return ap->in[7]; }
    __device__ __forceinline__ const float* cvec() const { return ap->in[8]; }
    __device__ __forceinline__ const float* c_ctx() const { return ap->in[9]; }
    __device__ __forceinline__ const float* w_mod() const { return ap->in[10]; }
    __device__ __forceinline__ const float* b_mod() const { return ap->in[11]; }
    __device__ __forceinline__ const float* g_norm1() const { return ap->in[12]; }
    __device__ __forceinline__ const float* g_norm2() const { return ap->in[13]; }
    __device__ __forceinline__ const float* w_in() const { return ap->in[14]; }
    __device__ __forceinline__ const float* conv_w() const { return ap->in[15]; }
    __device__ __forceinline__ const float* conv_b() const { return ap->in[16]; }
    __device__ __forceinline__ const float* dt_bias() const { return ap->in[17]; }
    __device__ __forceinline__ const float* a_log() const { return ap->in[18]; }
    __device__ __forceinline__ const float* ssd_d() const { return ap->in[19]; }
    __device__ __forceinline__ const float* ssd_norm_g() const { return ap->in[20]; }
    __device__ __forceinline__ const float* lam_re() const { return ap->in[21]; }
    __device__ __forceinline__ const float* lam_im() const { return ap->in[22]; }
    __device__ __forceinline__ const float* log_step() const { return ap->in[23]; }
    __device__ __forceinline__ const float* b_re() const { return ap->in[24]; }
    __device__ __forceinline__ const float* b_im() const { return ap->in[25]; }
    __device__ __forceinline__ const float* c_re() const { return ap->in[26]; }
    __device__ __forceinline__ const float* c_im() const { return ap->in[27]; }
    __device__ __forceinline__ const float* s5_d() const { return ap->in[28]; }
    __device__ __forceinline__ const float* w_glu() const { return ap->in[29]; }
    __device__ __forceinline__ const float* b_glu() const { return ap->in[30]; }
    __device__ __forceinline__ const float* qn_g() const { return ap->in[31]; }
    __device__ __forceinline__ const float* kn_g() const { return ap->in[32]; }
    __device__ __forceinline__ const float* dlam() const { return ap->in[33]; }
    __device__ __forceinline__ const float* subln_g() const { return ap->in[34]; }
    __device__ __forceinline__ const float* wqn_g() const { return ap->in[35]; }
    __device__ __forceinline__ const float* wkn_g() const { return ap->in[36]; }
    __device__ __forceinline__ const float* sink() const { return ap->in[37]; }
    __device__ __forceinline__ const float* w_branch() const { return ap->in[38]; }
    __device__ __forceinline__ const float* w_gate() const { return ap->in[39]; }
    __device__ __forceinline__ const float* b_gate() const { return ap->in[40]; }
    __device__ __forceinline__ const float* w_out() const { return ap->in[41]; }
    __device__ __forceinline__ const float* w_fc1() const { return ap->in[42]; }
    __device__ __forceinline__ const float* w_fc2() const { return ap->in[43]; }
    __device__ __forceinline__ float* out() const { return ap->out; }
    __device__ __forceinline__ unsigned char* ws() const { return ap->ws; }
    __device__ __forceinline__ float* MOD() const { return (float*)(ap->ws + WS_MOD); }
    __device__ __forceinline__ float* SSQ() const { return (float*)(ap->ws + WS_SSQ); }
    __device__ __forceinline__ float* DT() const { return (float*)(ap->ws + WS_DT); }
    __device__ __forceinline__ bf16* H() const { return (bf16*)(ap->ws + WS_H); }
    __device__ __forceinline__ bf16* R1() const { return (bf16*)(ap->ws + WS_R1); }
    __device__ __forceinline__ bf16* Y() const { return (bf16*)(ap->ws + WS_Y); }
    __device__ __forceinline__ bf16* Y5() const { return (bf16*)(ap->ws + WS_Y5); }
    __device__ __forceinline__ bf16* XC() const { return (bf16*)(ap->ws + WS_XC); }
    __device__ __forceinline__ bf16* CKV() const { return (bf16*)(ap->ws + WS_CKV); }
    __device__ __forceinline__ float* ROPE() const { return (float*)(ap->ws + WS_ROPE); }
};

__device__ __forceinline__ float wave_sum(float v) {
#pragma unroll
    for (int o = 1; o < 64; o <<= 1) v += __shfl_xor(v, o);
    return v;
}
__device__ __forceinline__ float wave_max(float v) {
#pragma unroll
    for (int o = 1; o < 64; o <<= 1) v = fmaxf(v, __shfl_xor(v, o));
    return v;
}
__device__ __forceinline__ float bf2f(bf16 h) { return __builtin_bit_cast(float, (unsigned)h << 16); }
__device__ __forceinline__ float bflo(unsigned w) { return __builtin_bit_cast(float, w << 16); }
__device__ __forceinline__ float bfhi(unsigned w) { return __builtin_bit_cast(float, w & 0xffff0000u); }
__device__ __forceinline__ unsigned f2bf(float f) { unsigned u = __builtin_bit_cast(unsigned, f); return (u + 0x7fffu + ((u >> 16) & 1u)) >> 16; }
__device__ __forceinline__ unsigned pk2(float lo, float hi) { return f2bf(lo) | (f2bf(hi) << 16); }
__device__ __forceinline__ float siluf(float x) { return x / (1.0f + __expf(-x)); }
__device__ __forceinline__ void unpack8(const v4u q, float (&f)[8]) { f[0] = bflo(q.x); f[1] = bfhi(q.x); f[2] = bflo(q.y); f[3] = bfhi(q.y); f[4] = bflo(q.z); f[5] = bfhi(q.z); f[6] = bflo(q.w); f[7] = bfhi(q.w); }

__device__ __forceinline__ void phase_mods(const Ctx& c, float* lf) {
    for (int i = c.tid; i < 5 * 1024; i += NTHR) { const int v = i >> 10, k = i & 1023; const float x = (v == 0) ? c.c_ctx()[k] : c.cvec()[(v - 1) * 1024 + k]; lf[i] = siluf(x); }
    __syncthreads();
    float* red = lf + 5 * 1024;
    for (int u = blockIdx.x; u < 192; u += gridDim.x) {
        const int l = u / 96, col0 = (u % 96) * 64;
        const float* W = c.w_mod() + (size_t)l * 1024 * 6144 + col0 + c.lane;
        float acc[5] = {0.f, 0.f, 0.f, 0.f, 0.f};
#pragma unroll 8
        for (int k = c.wave * 128; k < c.wave * 128 + 128; ++k) { const float wv = W[(size_t)k * 6144];
#pragma unroll
            for (int i = 0; i < 5; ++i) acc[i] += lf[i * 1024 + k] * wv; }
#pragma unroll
        for (int i = 0; i < 5; ++i) red[(c.wave * 5 + i) * 64 + c.lane] = acc[i];
        __syncthreads();
        if (c.tid < 320) { const int i = c.tid >> 6, ln = c.tid & 63; float s = c.b_mod()[l * 6144 + col0 + ln];
#pragma unroll
            for (int w = 0; w < 8; ++w) s += red[(w * 5 + i) * 64 + ln];
            c.MOD()[(size_t)(l * 5 + i) * 6144 + col0 + ln] = s; }
        __syncthreads();
    }
}

__device__ __forceinline__ int cmap(int mode, int n) { return mode == 0 ? n : (mode == 1 ? (n < 1280 ? n : n + 16) : ((n & 255) < 128 ? 128 * (n >> 8) + (n & 127) : 512 + 128 * (n >> 8) + (n & 127))); }
__device__ __forceinline__ void transpose_item(const float* W, int ld, int K, int N, int mode, const float* rowscale, bf16* WT, float* scr, int item, int lane) {
    const int nblk = N / 32, kb = item / nblk, nb = item % nblk, k0 = 64 * kb, n0 = 32 * nb, sc0 = cmap(mode, n0);
    float tv[32];
#pragma unroll
    for (int i = 0; i < 32; ++i) tv[i] = W[(size_t)(k0 + 2 * i + (lane >> 5)) * ld + sc0 + (lane & 31)];
    if (rowscale) {
#pragma unroll
        for (int i = 0; i < 32; ++i) tv[i] *= rowscale[k0 + 2 * i + (lane >> 5)]; }
#pragma unroll
    for (int i = 0; i < 32; ++i) scr[(2 * i + (lane >> 5)) * 33 + (lane & 31)] = tv[i];
    __builtin_amdgcn_fence(__ATOMIC_RELEASE, "wavefront"); __builtin_amdgcn_wave_barrier();
    const int ch = lane & 7;
#pragma unroll
    for (int j = 0; j < 4; ++j) { const int n = (lane >> 3) + 8 * j; const float* s = scr + (8 * ch) * 33 + n;
        v4u o; o.x = pk2(s[0 * 33], s[1 * 33]); o.y = pk2(s[2 * 33], s[3 * 33]); o.z = pk2(s[4 * 33], s[5 * 33]); o.w = pk2(s[6 * 33], s[7 * 33]);
        *(v4u*)(WT + (size_t)(n0 + n) * K + k0 + 8 * ch) = o; }
    __builtin_amdgcn_fence(__ATOMIC_RELEASE, "wavefront"); __builtin_amdgcn_wave_barrier();
}
__device__ __forceinline__ void s5_tables(const Ctx& c, int l, int g, float* lf);
__device__ __forceinline__ void phase_convert(const Ctx& c, int l, float* lf) {
    for (int g = blockIdx.x; g < 32; g += gridDim.x) s5_tables(c, l, g, lf);
    float* scr = lf + c.wave * 2176;
    const int gw = blockIdx.x * NWAVES + c.wave, NGW = gridDim.x * NWAVES;
    unsigned char* ws = c.ws();
    for (int it = gw; it < 9984; it += NGW) {
        int r = it;
        if (r < 2048) { transpose_item(c.w_in() + (size_t)l * 1024 * 4112, 4112, 1024, 4096, 1, nullptr, (bf16*)(ws + W_IN), scr, r, c.lane); continue; } r -= 2048;
        if (r < 2048) { transpose_item(c.w_gate() + (size_t)l * 1024 * 4096, 4096, 1024, 4096, 0, nullptr, (bf16*)(ws + W_G), scr, r, c.lane); continue; } r -= 2048;
        if (r < 256) { transpose_item(c.w_glu() + (size_t)l * 512 * 1024, 1024, 512, 1024, 2, nullptr, (bf16*)(ws + W_GLU), scr, r, c.lane); continue; } r -= 256;
        if (r < 1024) { const int i = r >> 8; transpose_item(c.w_branch() + (size_t)(l * 4 + i) * 512 * 1024, 1024, 512, 1024, 0, i == 0 ? c.ssd_norm_g() + l * 512 : nullptr, (bf16*)(ws + W_BR) + (size_t)i * 1024 * 512, scr, r & 255, c.lane); continue; } r -= 1024;
        if (r < 512) { transpose_item(c.w_out() + (size_t)l * 1024 * 1024, 1024, 1024, 1024, 0, nullptr, (bf16*)(ws + W_OUT), scr, r, c.lane); continue; } r -= 512;
        if (r < 2048) { transpose_item(c.w_fc1() + (size_t)l * 1024 * 4096, 4096, 1024, 4096, 0, nullptr, (bf16*)(ws + W_1), scr, r, c.lane); continue; } r -= 2048;
        transpose_item(c.w_fc2() + (size_t)l * 4096 * 1024, 1024, 4096, 1024, 0, nullptr, (bf16*)(ws + W_2), scr, r, c.lane);
    }
}

__device__ __forceinline__ void phase_norm(const Ctx& c, int l, int which, float* lf) {
    if (which == 0) {
        for (int i = c.tid; i < 16384; i += NTHR) { const int k = i >> 4, j = i & 15; lf[j * 1024 + k] = c.w_in()[(size_t)l * 1024 * 4112 + (size_t)k * 4112 + 1280 + j]; }
        __syncthreads();
    }
    const int gw = blockIdx.x * NWAVES + c.wave, NGW = gridDim.x * NWAVES;
    const float* gn = (which == 0 ? c.g_norm1() : c.g_norm2()) + l * 1024;
    for (int m = gw; m < M; m += NGW) {
        const float* xr = (l == 0 && which == 0) ? (m < MC ? c.x_prompt() + (size_t)m * D : c.x_sample() + (size_t)(m - MC) * D) : c.out() + (size_t)m * D;
        const int mi = (m < MC) ? 0 : 1 + ((m - MC) >> 10);
        const float* mod = c.MOD() + (size_t)(l * 5 + mi) * 6144 + which * 3072;
        f32x4 v[4]; float s = 0.f;
#pragma unroll
        for (int j = 0; j < 4; ++j) { v[j] = *(const f32x4*)(xr + 4 * c.lane + 256 * j); s += (v[j].x * v[j].x + v[j].y * v[j].y) + (v[j].z * v[j].z + v[j].w * v[j].w); }
        const float rstd = rsqrtf(wave_sum(s) * (1.0f / D) + EPS);
#pragma unroll
        for (int j = 0; j < 4; ++j) { const int k = 4 * c.lane + 256 * j; const f32x4 g = *(const f32x4*)(gn + k), sh = *(const f32x4*)(mod + k), sc = *(const f32x4*)(mod + 1024 + k);
            v[j] = v[j] * rstd * g * (sc + 1.0f) + sh;
            v2u o; o.x = pk2(v[j].x, v[j].y); o.y = pk2(v[j].z, v[j].w); *(v2u*)(c.H() + (size_t)m * D + k) = o; }
        if (which == 0) {
            float mine = 0.f;
#pragma unroll 1
            for (int jj = 0; jj < 16; ++jj) { float a = 0.f;
#pragma unroll
                for (int j = 0; j < 4; ++j) { const f32x4 w = *(const f32x4*)(lf + jj * 1024 + 4 * c.lane + 256 * j); a += (v[j].x * w.x + v[j].y * w.y) + (v[j].z * w.z + v[j].w * w.w); }
                a = wave_sum(a); if (c.lane == jj) mine = a; }
            if (c.lane < 16) { const float x = mine + c.dt_bias()[l * 16 + c.lane]; c.DT()[(size_t)m * 16 + c.lane] = x > 20.f ? x : log1pf(__expf(x)); }
            if (c.lane == 0) c.SSQ()[m] = 0.f;
        }
    }
}

__device__ __forceinline__ void phase_rope_table(const Ctx& c) {
    const int gt = blockIdx.x * NTHR + c.tid;
    if (gt < 32768) { const int pos = gt >> 5, a = gt & 31, f = a & 15; const float inv = exp2f(-(float)f * 0.8304820237218406f);
        const float ang = (float)((a >> 4) ? (pos & 63) : (pos >> 6)) * inv; float sn, cs; sincosf(ang, &sn, &cs); c.ROPE()[pos * 64 + a] = cs; c.ROPE()[pos * 64 + 32 + a] = sn; }
}
__device__ __forceinline__ void phase_qk(const Ctx& c, int l, float* lf) {
    const int gw = blockIdx.x * NWAVES + c.wave, NGW = gridDim.x * NWAVES, lane = c.lane, l16 = lane & 15, grp = lane >> 4;
    for (int i = c.tid; i < 7 * 768; i += NTHR) lf[i] = c.conv_w()[(size_t)l * 7 * 768 + i];
    for (int i = c.tid; i < 768; i += NTHR) lf[7 * 768 + i] = c.conv_b()[l * 768 + i];
    __syncthreads();
    const f32x4 gq = *(const f32x4*)(c.qn_g() + l * 64 + 4 * l16), gk = *(const f32x4*)(c.kn_g() + l * 64 + 4 * l16), gwq = *(const f32x4*)(c.wqn_g() + l * 64 + 4 * l16), gwk = *(const f32x4*)(c.wkn_g() + l * 64 + 4 * l16);
    bf16* R1p = c.R1(); float* outp = c.out(); bf16* XCp = c.XC();
    for (int m = gw; m < M; m += NGW) {
        bf16* pr = R1p + (size_t)m * 4096;
        const bool lat = m >= MC;
        const int b = lat ? (m - MC) >> 10 : m >> 8, t = lat ? (m - MC) & 1023 : m & 255, L = lat ? 1024 : 256;
        const size_t ob = (size_t)(b * 2 + l) * 256 + t;
        f32x4 cs = {1.f, 1.f, 1.f, 1.f}, sn = {0.f, 0.f, 0.f, 0.f};
        if (lat) { const float* rp = c.ROPE() + t * 64 + (l16 >> 3) * 16 + 4 * (l16 & 3); cs = *(const f32x4*)rp; sn = *(const f32x4*)(rp + 32); if (!((l16 >> 2) & 1)) sn = -sn; }
        v2u raw[7];
#pragma unroll
        for (int ps = 0; ps < 7; ++ps) { const int gi = 4 * ps + grp; const int col = gi < 8 ? C_DQ + gi * 64 : gi < 16 ? C_DK + (gi - 8) * 64 : gi < 24 ? C_WQ + (gi - 16) * 64 : C_WK + (gi - 24) * 64;
            raw[ps] = (gi < 26) ? *(const v2u*)(pr + col + 4 * l16) : (v2u){0u, 0u}; }
        v2u cp[3];
        if (!lat) {
#pragma unroll
            for (int ps = 0; ps < 3; ++ps) { const int gi = 4 * ps + grp; const int col = gi < 8 ? C_DV + gi * 64 : C_WV + (gi - 8) * 64; cp[ps] = (gi < 10) ? *(const v2u*)(pr + col + 4 * l16) : (v2u){0u, 0u}; }
        }
        v2u cx[3][7];
#pragma unroll
        for (int i = 0; i < 3; ++i)
#pragma unroll
            for (int j = 0; j < 7; ++j) { const int tt = t + j - 3; cx[i][j] = (tt >= 0 && tt < L) ? *(const v2u*)(R1p + (size_t)(m + j - 3) * 4096 + C_XBC + 4 * lane + 256 * i) : (v2u){0u, 0u}; }
#pragma unroll
        for (int ps = 0; ps < 7; ++ps) { const int gi = 4 * ps + grp;
            const f32x4 gain = gi < 8 ? gq : gi < 16 ? gk : gi < 24 ? gwq : gwk;
            f32x4 v = {bflo(raw[ps].x), bfhi(raw[ps].x), bflo(raw[ps].y), bfhi(raw[ps].y)};
            float ss = (v.x * v.x + v.y * v.y) + (v.z * v.z + v.w * v.w);
            ss += __shfl_xor(ss, 1); ss += __shfl_xor(ss, 2); ss += __shfl_xor(ss, 4); ss += __shfl_xor(ss, 8);
            v = v * rsqrtf(ss * (1.0f / 64.0f) + EPS) * gain;
            if (lat) { f32x4 p; p.x = __shfl_xor(v.x, 4); p.y = __shfl_xor(v.y, 4); p.z = __shfl_xor(v.z, 4); p.w = __shfl_xor(v.w, 4); v = v * cs + p * sn; }
            if (gi < 26) {
                const int col = gi < 8 ? C_DQ + gi * 64 : gi < 16 ? C_DK + (gi - 8) * 64 : gi < 24 ? C_WQ + (gi - 16) * 64 : C_WK + (gi - 24) * 64;
                v2u o; o.x = pk2(v.x, v.y); o.y = pk2(v.z, v.w); *(v2u*)(pr + col + 4 * l16) = o;
                if (!lat) { if (gi >= 8 && gi < 16) *(f32x4*)(outp + O_DK + ob * 512 + (gi - 8) * 64 + 4 * l16) = v; if (gi >= 24) *(f32x4*)(outp + O_WK + ob * 128 + (gi - 24) * 64 + 4 * l16) = v; }
            }
        }
        if (!lat) {
#pragma unroll
            for (int ps = 0; ps < 3; ++ps) { const int gi = 4 * ps + grp; const f32x4 v = {bflo(cp[ps].x), bfhi(cp[ps].x), bflo(cp[ps].y), bfhi(cp[ps].y)};
                if (gi < 8) *(f32x4*)(outp + O_DV + ob * 512 + gi * 64 + 4 * l16) = v; else if (gi < 10) *(f32x4*)(outp + O_WV + ob * 128 + (gi - 8) * 64 + 4 * l16) = v; }
        }
#pragma unroll
        for (int i = 0; i < 3; ++i) { const int ch = 4 * lane + 256 * i; f32x4 a = *(const f32x4*)(lf + 7 * 768 + ch);
#pragma unroll
            for (int j = 0; j < 7; ++j) { const f32x4 wv = *(const f32x4*)(lf + j * 768 + ch); const f32x4 xv = {bflo(cx[i][j].x), bfhi(cx[i][j].x), bflo(cx[i][j].y), bfhi(cx[i][j].y)}; a += wv * xv; }
            v2u o; o.x = pk2(siluf(a.x), siluf(a.y)); o.y = pk2(siluf(a.z), siluf(a.w)); *(v2u*)(XCp + (size_t)m * 768 + ch) = o; }
    }
    for (int r = gw; r < 1024; r += NGW) { const int b = r >> 8, sidx = r & 255; const size_t cb = (size_t)(b * 2 + l) * 256 + sidx; bf16* dst = c.CKV() + (size_t)r * 1280;
        for (int i = lane; i < 1280; i += 64) { const float v = i < 512 ? c.cache_dk()[cb * 512 + i] : i < 1024 ? c.cache_dv()[cb * 512 + i - 512] : i < 1152 ? c.cache_wk()[cb * 128 + i - 1024] : c.cache_wv()[cb * 128 + i - 1152]; dst[i] = (bf16)f2bf(v); } }
}

typedef pg8::bf16x8 bx8;
#define MFMA16(a, b, cc) __builtin_amdgcn_mfma_f32_16x16x32_bf16((a), (b), (cc), 0, 0, 0)
__device__ __forceinline__ void ssd_unit(const Ctx& c, int l, int pass, int b, int h, unsigned char* lds) {
    const int L = pass ? 1024 : 256, tok0 = pass ? MC + b * 1024 : b * 256, NCH = L >> 7;
    const int tid = c.tid, lane = c.lane, w = c.wave, lr = lane & 15, lq = lane >> 4, grp = h >> 2;
    bf16* XT = (bf16*)lds;
    bf16* BwT = XT + 64 * 136;
    bf16* Bm = BwT + 64 * 136;
    bf16* Cm = Bm + 128 * 72;
    bf16* Mm = Cm + 128 * 72;
    bf16* ST = Mm + 128 * 136;
    float* cum = (float*)(ST + 64 * 72);
    float* dtv = cum + 128; float* wv = dtv + 128; float* ecum = wv + 128; float* tot = ecum + 128;
    const float dsk = c.ssd_d()[l * 8 + h];
    const bf16* XCp = c.XC(); const float* DTp = c.DT(); bf16* Yp = c.Y(); const bf16* R1p = c.R1(); float* SSQp = c.SSQ();
    const int pi = w >> 1, nj0 = 2 * (w & 1);
    for (int dir = 0; dir < 2; ++dir) {
        const float A = -__expf(c.a_log()[(l * 2 + dir) * 8 + h]);
        f32x4 Sacc[2];
        __syncthreads();
#pragma unroll
        for (int q = 0; q < 2; ++q)
#pragma unroll
            for (int r = 0; r < 4; ++r) { const int p = 16 * pi + 4 * lq + r, n = 16 * (nj0 + q) + lr;
                const float v = pass ? c.state_ssd()[(((((size_t)(b * 2 + l) * 2 + dir) * 8 + h) * 64 + p) * 64) + n] : 0.f;
                Sacc[q][r] = v; ST[p * 72 + n] = (bf16)f2bf(v); }
        for (int ci = 0; ci < NCH; ++ci) {
            __syncthreads();
            const int i = tid >> 2, part = tid & 3;
            float bvals[16];
            { const int t = dir ? L - 1 - (ci * 128 + i) : ci * 128 + i; const bf16* xr = XCp + (size_t)(tok0 + t) * 768;
              const v4u x0 = *(const v4u*)(xr + h * 64 + part * 16), x1 = *(const v4u*)(xr + h * 64 + part * 16 + 8);
              const v4u b0 = *(const v4u*)(xr + 512 + grp * 64 + part * 16), b1 = *(const v4u*)(xr + 512 + grp * 64 + part * 16 + 8);
              const v4u c0 = *(const v4u*)(xr + 640 + grp * 64 + part * 16), c1 = *(const v4u*)(xr + 640 + grp * 64 + part * 16 + 8);
              *(v4u*)(Bm + i * 72 + part * 16) = b0; *(v4u*)(Bm + i * 72 + part * 16 + 8) = b1;
              *(v4u*)(Cm + i * 72 + part * 16) = c0; *(v4u*)(Cm + i * 72 + part * 16 + 8) = c1;
              const unsigned xs[8] = {x0.x, x0.y, x0.z, x0.w, x1.x, x1.y, x1.z, x1.w};
#pragma unroll
              for (int j = 0; j < 8; ++j) { XT[(part * 16 + 2 * j) * 136 + i] = (bf16)(xs[j] & 0xffffu); XT[(part * 16 + 2 * j + 1) * 136 + i] = (bf16)(xs[j] >> 16); }
              float t8[8]; unpack8(b0, t8);
#pragma unroll
              for (int j = 0; j < 8; ++j) bvals[j] = t8[j];
              unpack8(b1, t8);
#pragma unroll
              for (int j = 0; j < 8; ++j) bvals[8 + j] = t8[j]; }
            if (tid < 64) {
                const int i0 = 2 * lane, i1 = i0 + 1;
                const int t0 = dir ? L - 1 - (ci * 128 + i0) : ci * 128 + i0, t1 = dir ? L - 1 - (ci * 128 + i1) : ci * 128 + i1;
                const float d0 = DTp[(size_t)(tok0 + t0) * 16 + dir * 8 + h], d1 = DTp[(size_t)(tok0 + t1) * 16 + dir * 8 + h];
                const float a0 = d0 * A, a1 = d1 * A; float s = a0 + a1;
#pragma unroll
                for (int o = 1; o < 64; o <<= 1) { const float v = __shfl_up(s, o); if (lane >= o) s += v; }
                const float cum1 = s, cum0 = s - a1, total = __shfl(s, 63);
                cum[i0] = cum0; cum[i1] = cum1; dtv[i0] = d0; dtv[i1] = d1;
                wv[i0] = __expf(total - cum0) * d0; wv[i1] = __expf(total - cum1) * d1; ecum[i0] = __expf(cum0); ecum[i1] = __expf(cum1);
                if (lane == 0) tot[0] = __expf(total);
            }
            __syncthreads();
            { const float wi = wv[i];
#pragma unroll
              for (int j = 0; j < 16; ++j) BwT[(part * 16 + j) * 136 + i] = (bf16)f2bf(bvals[j] * wi); }
            bx8 cfr[2];
#pragma unroll
            for (int ks = 0; ks < 2; ++ks) cfr[ks] = *(const bx8*)(Cm + (16 * w + lr) * 72 + 32 * ks + 8 * lq);
            for (int j = 0; j <= w; ++j) {
                const bx8 b0 = *(const bx8*)(Bm + (16 * j + lr) * 72 + 8 * lq), b1 = *(const bx8*)(Bm + (16 * j + lr) * 72 + 32 + 8 * lq);
                f32x4 g = {0.f, 0.f, 0.f, 0.f};
                g = MFMA16(cfr[0], b0, g); g = MFMA16(cfr[1], b1, g);
                const int s = 16 * j + lr; const float cs = cum[s], ds = dtv[s];
#pragma unroll
                for (int r = 0; r < 4; ++r) { const int tt = 16 * w + 4 * lq + r; const float v = (s <= tt) ? g[r] * __expf(cum[tt] - cs) * ds : 0.f; Mm[tt * 136 + s] = (bf16)f2bf(v); }
            }
            if (!(w & 1)) {
#pragma unroll
                for (int r = 0; r < 4; ++r) Mm[(16 * w + 4 * lq + r) * 136 + 16 * (w + 1) + lr] = 0;
            }
            __syncthreads();
            f32x4 yl[4], yo[4];
#pragma unroll
            for (int jp = 0; jp < 4; ++jp) { yl[jp] = (f32x4){0.f, 0.f, 0.f, 0.f}; yo[jp] = (f32x4){0.f, 0.f, 0.f, 0.f}; }
            for (int ks = 0; ks <= (w >> 1); ++ks) {
                const bx8 af = *(const bx8*)(Mm + (16 * w + lr) * 136 + 32 * ks + 8 * lq);
#pragma unroll
                for (int jp = 0; jp < 4; ++jp) { const bx8 xf = *(const bx8*)(XT + (16 * jp + lr) * 136 + 32 * ks + 8 * lq); yl[jp] = MFMA16(af, xf, yl[jp]); }
            }
#pragma unroll
            for (int ks = 0; ks < 2; ++ks)
#pragma unroll
                for (int jp = 0; jp < 4; ++jp) { const bx8 sf = *(const bx8*)(ST + (16 * jp + lr) * 72 + 32 * ks + 8 * lq); yo[jp] = MFMA16(cfr[ks], sf, yo[jp]); }
            {
                float ssq[4] = {0.f, 0.f, 0.f, 0.f};
#pragma unroll
                for (int r = 0; r < 4; ++r) {
                    const int tt = 16 * w + 4 * lq + r; const float ec = ecum[tt];
                    const int t = dir ? L - 1 - (ci * 128 + tt) : ci * 128 + tt; const size_t m = (size_t)tok0 + t;
#pragma unroll
                    for (int jp = 0; jp < 4; ++jp) {
                        const int p = 16 * jp + lr; const float y = yl[jp][r] + ec * yo[jp][r];
                        if (dir == 0) Yp[m * 2048 + h * 64 + p] = (bf16)f2bf(y);
                        else { const float x = bf2f(XT[p * 136 + tt]); const float ytot = y + bf2f(Yp[m * 2048 + h * 64 + p]) + dsk * x; const float z = bf2f(R1p[m * 4096 + C_Z + h * 64 + p]);
                            const float gt = ytot * siluf(z); Yp[m * 2048 + h * 64 + p] = (bf16)f2bf(gt); ssq[r] += gt * gt; }
                    }
                    if (dir == 1) { float q = ssq[r]; q += __shfl_xor(q, 1); q += __shfl_xor(q, 2); q += __shfl_xor(q, 4); q += __shfl_xor(q, 8); if (lr == 0) atomicAdd(SSQp + m, q); }
                }
            }
            __syncthreads();
            {
                f32x4 st[2] = {{0.f, 0.f, 0.f, 0.f}, {0.f, 0.f, 0.f, 0.f}};
#pragma unroll
                for (int ks = 0; ks < 4; ++ks) { const bx8 af = *(const bx8*)(XT + (16 * pi + lr) * 136 + 32 * ks + 8 * lq);
#pragma unroll
                    for (int q = 0; q < 2; ++q) { const bx8 bf = *(const bx8*)(BwT + (16 * (nj0 + q) + lr) * 136 + 32 * ks + 8 * lq); st[q] = MFMA16(af, bf, st[q]); } }
                const float et = tot[0];
#pragma unroll
                for (int q = 0; q < 2; ++q)
#pragma unroll
                    for (int r = 0; r < 4; ++r) { Sacc[q][r] = et * Sacc[q][r] + st[q][r]; ST[(16 * pi + 4 * lq + r) * 72 + 16 * (nj0 + q) + lr] = (bf16)f2bf(Sacc[q][r]); }
            }
        }
        if (!pass) {
#pragma unroll
            for (int q = 0; q < 2; ++q)
#pragma unroll
                for (int r = 0; r < 4; ++r) { const int p = 16 * pi + 4 * lq + r, n = 16 * (nj0 + q) + lr;
                    c.out()[O_SSD + (((((size_t)(b * 2 + l) * 2 + dir) * 8 + h) * 64 + p) * 64) + n] = Sacc[q][r]; }
        }
    }
}

__device__ __forceinline__ void s5_tables(const Ctx& c, int l, int g, float* lf) {
    const int tid = c.tid;
    float* pw = lf;
    float* Bc = pw + 2 * 17 * 128;
    float* Cc = Bc + 2 * 2048;
    if (tid < 128) { const int dir = tid >> 6, n = tid & 63, idx = ((l * 2 + dir) * 32 + g) * 64 + n;
        const float lre = c.lam_re()[idx], lim = c.lam_im()[idx], step = expf(c.log_step()[(l * 2 + dir) * 32 + g]);
        for (int k = 0; k <= 16; ++k) { const float mag = expf(lre * step * (float)k); float sn, cs; sincosf(lim * step * (float)k, &sn, &cs); pw[((dir * 17 + k) * 64 + n) * 2] = mag * cs; pw[((dir * 17 + k) * 64 + n) * 2 + 1] = mag * sn; }
        const float mag = expf(lre * step); float sn, cs; sincosf(lim * step, &sn, &cs); const float are = mag * cs, aim = mag * sn;
        const float den = lre * lre + lim * lim, cre = ((are - 1.0f) * lre + aim * lim) / den, cim = (aim * lre - (are - 1.0f) * lim) / den;
        for (int mm = 0; mm < 16; ++mm) { const float br = c.b_re()[(size_t)idx * 16 + mm], bi = c.b_im()[(size_t)idx * 16 + mm]; Bc[((dir * 64 + n) * 16 + mm) * 2] = cre * br - cim * bi; Bc[((dir * 64 + n) * 16 + mm) * 2 + 1] = cre * bi + cim * br; }
    }
    for (int i = tid; i < 2048; i += NTHR) { const int dir = i >> 10, mm = (i >> 6) & 15, n = i & 63; const size_t src = ((size_t)((l * 2 + dir) * 32 + g) * 16 + mm) * 64 + n;
        Cc[i * 2] = c.c_re()[src]; Cc[i * 2 + 1] = c.c_im()[src]; }
    __syncthreads();
    if (tid < 128) { const int dir = tid >> 6, n = tid & 63; float* at = (float*)(c.ws() + WS_S5AT) + ((size_t)(dir * 32 + g) * 64 + n) * 2; at[0] = pw[((dir * 17 + 16) * 64 + n) * 2]; at[1] = pw[((dir * 17 + 16) * 64 + n) * 2 + 1]; }
    bf16* Kt = (bf16*)(c.ws() + WS_S5K) + (size_t)g * 31 * 256;
    for (int e = tid; e < 31 * 256; e += NTHR) { const int tp = e >> 8, mm = (e >> 4) & 15, m2 = e & 15, tau = tp - 15; float acc = 0.f;
#pragma unroll
        for (int dir = 0; dir < 2; ++dir) { if ((dir == 0 && tau < 0) || (dir == 1 && tau > 0)) continue; const int k = tau < 0 ? -tau : tau;
            const float* pp = pw + (dir * 17 + k) * 128; const float* bb = Bc + dir * 2048 + m2 * 2; const float* cc = Cc + (dir * 16 + mm) * 128;
            for (int n = 0; n < 64; ++n) { const float pr = pp[2 * n], pi = pp[2 * n + 1], br = bb[n * 32], bi = bb[n * 32 + 1], Pr = pr * br - pi * bi, Pi = pr * bi + pi * br; acc += cc[2 * n] * Pr - cc[2 * n + 1] * Pi; } }
        if (tau == 0 && mm == m2) acc += c.s5_d()[l * 512 + g * 16 + mm];
        Kt[e] = (bf16)f2bf(acc); }
    for (int e = tid; e < 2 * 128 * 256; e += NTHR) { const int dir = e >> 15, sidx = (e >> 8) & 127, k = e & 255, ri = sidx >> 6, n = sidx & 63, j = k >> 4, m2 = k & 15, ex = dir ? j : 15 - j;
        const float pr = pw[((dir * 17 + ex) * 64 + n) * 2], pi = pw[((dir * 17 + ex) * 64 + n) * 2 + 1], br = Bc[((dir * 64 + n) * 16 + m2) * 2], bi = Bc[((dir * 64 + n) * 16 + m2) * 2 + 1];
        ((bf16*)(c.ws() + WS_S5WS))[((size_t)(dir * 32 + g) * 128 + sidx) * 256 + k] = (bf16)f2bf(ri ? pr * bi + pi * br : pr * br - pi * bi); }
    for (int e = tid; e < 256 * 256; e += NTHR) { const int row = e >> 8, k = e & 255, i = row >> 4, mm = row & 15, dir = k >> 7, ri = (k >> 6) & 1, n = k & 63, ex = dir ? 16 - i : i + 1;
        const float pr = pw[((dir * 17 + ex) * 64 + n) * 2], pi = pw[((dir * 17 + ex) * 64 + n) * 2 + 1], cr = Cc[((dir * 16 + mm) * 64 + n) * 2], ci = Cc[((dir * 16 + mm) * 64 + n) * 2 + 1];
        ((bf16*)(c.ws() + WS_S5WO))[(size_t)g * 65536 + e] = (bf16)f2bf(ri ? -(cr * pi + ci * pr) : cr * pr - ci * pi); }
    __syncthreads();
}

__device__ __forceinline__ void s5_unit(const Ctx& c, int l, int g, int cu, unsigned char* lds) {
    const int tid = c.tid, lane = c.lane, w = c.wave, lr = lane & 15, lq = lane >> 4;
    const bool lat = cu >= 8;
    bf16* Ut = (bf16*)lds;
    bf16* St = Ut + 64 * 264;
    bf16* Kt = St + 64 * 264;
    float* Dl = (float*)(Kt + 31 * 256);
    const bf16* R1p = c.R1();
    { const v4u* src = (const v4u*)((const bf16*)(c.ws() + WS_S5K) + (size_t)g * 31 * 256); for (int i = tid; i < 31 * 32; i += NTHR) ((v4u*)Kt)[i] = src[i]; }
#pragma unroll
    for (int i = 0; i < 2; ++i) { const int id = tid + NTHR * i, col = id >> 4, j = id & 15;
        const int tok = lat ? MC + (cu - 8) * 1024 + col * 16 + j : (4 * cu + (col >> 4)) * 256 + (col & 15) * 16 + j;
        const bf16* up = R1p + (size_t)tok * 4096 + C_U + g * 16;
        *(v4u*)(Ut + col * 264 + j * 16) = *(const v4u*)up; *(v4u*)(Ut + col * 264 + j * 16 + 8) = *(const v4u*)(up + 8); }
    __syncthreads();
    for (int dir = 0; dir < 2; ++dir) {
        const bf16* Wsp = (const bf16*)(c.ws() + WS_S5WS) + ((size_t)(dir * 32 + g) * 128 + 16 * w + lr) * 256 + 8 * lq;
        f32x4 acc[4];
#pragma unroll
        for (int cb = 0; cb < 4; ++cb) acc[cb] = (f32x4){0.f, 0.f, 0.f, 0.f};
        bx8 afr[8];
#pragma unroll
        for (int ks = 0; ks < 8; ++ks) afr[ks] = *(const bx8*)(Wsp + 32 * ks);
#pragma unroll
        for (int ks = 0; ks < 8; ++ks) {
#pragma unroll
            for (int cb = 0; cb < 4; ++cb) { const bx8 bf = *(const bx8*)(Ut + (16 * cb + lr) * 264 + 32 * ks + 8 * lq); acc[cb] = MFMA16(afr[ks], bf, acc[cb]); }
            __builtin_amdgcn_sched_barrier(0); }
#pragma unroll
        for (int cb = 0; cb < 4; ++cb)
#pragma unroll
            for (int r = 0; r < 4; ++r) Dl[(16 * w + 4 * lq + r) * 65 + 16 * cb + lr] = acc[cb][r];
        __syncthreads();
        if (tid < (lat ? 64 : 256)) {
            const int n = tid & 63, bl = tid >> 6, nc = lat ? 64 : 16, cbase = lat ? 0 : 16 * bl, b = lat ? cu - 8 : 4 * cu + bl;
            const float* at = (const float*)(c.ws() + WS_S5AT) + ((size_t)(dir * 32 + g) * 64 + n) * 2; const float ar = at[0], ai = at[1];
            float sr = 0.f, si = 0.f;
            if (lat) { sr = c.state_s5()[((((size_t)(b * 2 + l) * 2 + dir) * 2 + 0) * 32 + g) * 64 + n]; si = c.state_s5()[((((size_t)(b * 2 + l) * 2 + dir) * 2 + 1) * 32 + g) * 64 + n]; }
            for (int cc = 0; cc < nc; ++cc) { const int col = cbase + (dir ? nc - 1 - cc : cc);
                St[col * 264 + dir * 128 + n] = (bf16)f2bf(sr); St[col * 264 + dir * 128 + 64 + n] = (bf16)f2bf(si);
                const float dr = Dl[n * 65 + col], di = Dl[(64 + n) * 65 + col];
                const float nr = ar * sr - ai * si + dr, ni = ar * si + ai * sr + di; sr = nr; si = ni; }
            if (!lat) { c.out()[O_S5 + ((((size_t)(b * 2 + l) * 2 + dir) * 2 + 0) * 32 + g) * 64 + n] = sr; c.out()[O_S5 + ((((size_t)(b * 2 + l) * 2 + dir) * 2 + 1) * 32 + g) * 64 + n] = si; }
        }
        __syncthreads();
    }
    const bf16* Wop = (const bf16*)(c.ws() + WS_S5WO) + (size_t)g * 65536 + 8 * lq;
#pragma unroll 1
    for (int ii = 0; ii < 2; ++ii) { const int i = 2 * w + ii;
        f32x4 acc[4];
#pragma unroll
        for (int cb = 0; cb < 4; ++cb) acc[cb] = (f32x4){0.f, 0.f, 0.f, 0.f};
        bx8 afr[8];
#pragma unroll
        for (int ks = 0; ks < 8; ++ks) afr[ks] = *(const bx8*)(Wop + (size_t)(16 * i + lr) * 256 + 32 * ks);
#pragma unroll
        for (int ks = 0; ks < 8; ++ks) { const int j = 2 * ks + (lq >> 1); const bx8 af = *(const bx8*)(Kt + ((i - j + 15) * 16 + lr) * 16 + 8 * (lq & 1));
#pragma unroll
            for (int cb = 0; cb < 4; ++cb) { const bx8 bf = *(const bx8*)(Ut + (16 * cb + lr) * 264 + 32 * ks + 8 * lq); acc[cb] = MFMA16(af, bf, acc[cb]); }
            __builtin_amdgcn_sched_barrier(0); }
#pragma unroll
        for (int ks = 0; ks < 8; ++ks) {
#pragma unroll
            for (int cb = 0; cb < 4; ++cb) { const bx8 bf = *(const bx8*)(St + (16 * cb + lr) * 264 + 32 * ks + 8 * lq); acc[cb] = MFMA16(afr[ks], bf, acc[cb]); }
            __builtin_amdgcn_sched_barrier(0); }
#pragma unroll
        for (int cb = 0; cb < 4; ++cb) { const int col = 16 * cb + lr;
            const int tok = lat ? MC + (cu - 8) * 1024 + col * 16 + i : (4 * cu + (col >> 4)) * 256 + (col & 15) * 16 + i;
            v2u o; o.x = pk2(acc[cb][0], acc[cb][1]); o.y = pk2(acc[cb][2], acc[cb][3]);
            *(v2u*)(c.Y5() + (size_t)tok * 512 + g * 16 + 4 * lq) = o; }
    }
}

typedef float f32x16 __attribute__((ext_vector_type(16)));
#define MFMA32(a, b, cc) __builtin_amdgcn_mfma_f32_32x32x16_bf16((a), (b), (cc), 0, 0, 0)
constexpr float SM_SC = 0.125f * 1.4426950408889634f;
__device__ __forceinline__ void qk_tile(f32x16& p0, f32x16& p1, const bf16* Kt, int KS, const bx8 (&qf)[4], int r32, int hi) {
    p0 = (f32x16){0.f}; p1 = (f32x16){0.f};
#pragma unroll
    for (int d0 = 0; d0 < 4; ++d0) { const bx8 a0 = *(const bx8*)(Kt + r32 * KS + 16 * d0 + 8 * hi), a1 = *(const bx8*)(Kt + (32 + r32) * KS + 16 * d0 + 8 * hi);
        p0 = MFMA32(a0, qf[d0], p0); p1 = MFMA32(a1, qf[d0], p1); }
}
__device__ __forceinline__ float sm_step(f32x16& p0, f32x16& p1, float& mrun, float& lrun, bx8 (&pb)[4]) {
    float tm = -3e38f;
#pragma unroll
    for (int r = 0; r < 16; ++r) tm = fmaxf(tm, fmaxf(p0[r], p1[r]));
    tm = fmaxf(tm, __shfl_xor(tm, 32));
    const float mn = fmaxf(mrun, tm), alpha = exp2f(mrun - mn);
    float rs = 0.f;
#pragma unroll
    for (int r = 0; r < 16; ++r) { p0[r] = exp2f(p0[r] - mn); p1[r] = exp2f(p1[r] - mn); rs += p0[r] + p1[r]; }
    rs += __shfl_xor(rs, 32);
    lrun = lrun * alpha + rs; mrun = mn;
#pragma unroll
    for (int sI = 0; sI < 2; ++sI) {
        v4u t0, t1;
        t0.x = pg8::cvt_pk_bf16(p0[8 * sI + 0], p0[8 * sI + 1]); t0.y = pg8::cvt_pk_bf16(p0[8 * sI + 2], p0[8 * sI + 3]); t0.z = pg8::cvt_pk_bf16(p0[8 * sI + 4], p0[8 * sI + 5]); t0.w = pg8::cvt_pk_bf16(p0[8 * sI + 6], p0[8 * sI + 7]);
        t1.x = pg8::cvt_pk_bf16(p1[8 * sI + 0], p1[8 * sI + 1]); t1.y = pg8::cvt_pk_bf16(p1[8 * sI + 2], p1[8 * sI + 3]); t1.z = pg8::cvt_pk_bf16(p1[8 * sI + 4], p1[8 * sI + 5]); t1.w = pg8::cvt_pk_bf16(p1[8 * sI + 6], p1[8 * sI + 7]);
        pb[sI] = __builtin_bit_cast(bx8, t0); pb[2 + sI] = __builtin_bit_cast(bx8, t1);
    }
    return alpha;
}
template <int NDT> __device__ __forceinline__ void pv_tile(f32x16 (&o)[NDT], const bf16* Vt, const bx8 (&pb)[4], int r32, int hi) {
#pragma unroll
    for (int ks = 0; ks < 4; ++ks) {
#pragma unroll
        for (int dt = 0; dt < NDT; ++dt) { const bf16* vp = Vt + (32 * dt + r32) * 68 + 16 * ks + 4 * hi;
            const v2u lo = *(const v2u*)vp, h8 = *(const v2u*)(vp + 8); const v4u t = {lo.x, lo.y, h8.x, h8.y};
            o[dt] = MFMA32(__builtin_bit_cast(bx8, t), pb[ks], o[dt]); }
        __builtin_amdgcn_sched_barrier(0); }
}

template <int PASS> __device__ __forceinline__ void diff_unit(const Ctx& c, int l, int uidx, unsigned char* lds) {
    constexpr int NT = PASS ? 20 : 4, NQB = PASS ? 8 : 2;
    const int tid = c.tid, lane = c.lane, w = c.wave, r32 = lane & 31, hi = lane >> 5, comp = w >> 2;
    const int qb = uidx % NQB, h = (uidx / NQB) & 3, b = uidx / (NQB * 4);
    const int tok0 = PASS ? MC + b * 1024 : b * 256;
    bf16* Kt = (bf16*)lds;
    bf16* Vt = Kt + 64 * 136;
    float* Ob = (float*)(Vt + 128 * 68);
    const bf16* R1p = c.R1(); const bf16* CK = c.CKV();
    const float lam_init = 0.8f - 0.6f * expf(-0.3f * (float)l);
    const float* lv = c.dlam() + l * 256;
    const float lam = expf(wave_sum(lv[lane] * lv[64 + lane])) - expf(wave_sum(lv[128 + lane] * lv[192 + lane])) + lam_init;
    const size_t mrow = (size_t)tok0 + qb * 128 + 32 * (w & 3) + r32;
    bx8 qf[4];
#pragma unroll
    for (int d0 = 0; d0 < 4; ++d0) qf[d0] = *(const bx8*)(R1p + mrow * 4096 + C_DQ + h * 128 + comp * 64 + 16 * d0 + 8 * hi);
    f32x16 o[4];
#pragma unroll
    for (int dt = 0; dt < 4; ++dt) o[dt] = (f32x16){0.f};
    float mrun = -1e30f, lrun = 0.f;
    v4u kreg[2], vreg[2];
#define DIFF_LOAD(t) { const bf16* kb; const bf16* vb; size_t rs; \
        if (PASS && (t) < 4) { kb = CK + ((size_t)b * 256 + 64 * (t)) * 1280 + h * 128; vb = kb + 512; rs = 1280; } \
        else { kb = R1p + ((size_t)tok0 + 64 * ((t) - (PASS ? 4 : 0))) * 4096 + C_DK + h * 128; vb = kb + (C_DV - C_DK); rs = 4096; } \
        _Pragma("unroll") for (int i = 0; i < 2; ++i) { kreg[i] = *(const v4u*)(kb + (size_t)lane * rs + (w + 8 * i) * 8); vreg[i] = *(const v4u*)(vb + (size_t)lane * rs + (w + 8 * i) * 8); } }
    DIFF_LOAD(0);
    for (int t = 0; t < NT; ++t) {
        __syncthreads();
#pragma unroll
        for (int i = 0; i < 2; ++i) { *(v4u*)(Kt + lane * 136 + (w + 8 * i) * 8) = kreg[i];
            const unsigned vs[4] = {vreg[i].x, vreg[i].y, vreg[i].z, vreg[i].w};
#pragma unroll
            for (int j = 0; j < 4; ++j) { Vt[((w + 8 * i) * 8 + 2 * j) * 68 + lane] = (bf16)(vs[j] & 0xffffu); Vt[((w + 8 * i) * 8 + 2 * j + 1) * 68 + lane] = (bf16)(vs[j] >> 16); } }
        if (t + 1 < NT) DIFF_LOAD(t + 1);
        __syncthreads();
        f32x16 p0, p1; bx8 pb[4];
        qk_tile(p0, p1, Kt + comp * 64, 136, qf, r32, hi);
#pragma unroll
        for (int r = 0; r < 16; ++r) { p0[r] *= SM_SC; p1[r] *= SM_SC; }
        const float alpha = sm_step(p0, p1, mrun, lrun, pb);
#pragma unroll
        for (int dt = 0; dt < 4; ++dt)
#pragma unroll
            for (int r = 0; r < 16; ++r) o[dt][r] *= alpha;
        pv_tile<4>(o, Vt, pb, r32, hi);
    }
#undef DIFF_LOAD
    const float inv = (comp ? lam : 1.0f) / lrun;
    const int rowl = 32 * (w & 3) + r32;
    if (comp) {
#pragma unroll
        for (int dt = 0; dt < 4; ++dt)
#pragma unroll
            for (int r = 0; r < 16; ++r) Ob[rowl * 129 + 32 * dt + (r & 3) + 8 * (r >> 2) + 4 * hi] = o[dt][r] * inv;
    }
    __syncthreads();
    if (!comp) {
        float ss = 0.f;
#pragma unroll
        for (int dt = 0; dt < 4; ++dt)
#pragma unroll
            for (int r = 0; r < 16; ++r) { const float v = o[dt][r] * inv - Ob[rowl * 129 + 32 * dt + (r & 3) + 8 * (r >> 2) + 4 * hi]; o[dt][r] = v; ss += v * v; }
        ss += __shfl_xor(ss, 32);
        const float rn = rsqrtf(ss * (1.0f / 128.0f) + EPS) * (1.0f - lam_init);
        const float* sg = c.subln_g() + l * 128; bf16* yp = c.Y() + mrow * 2048 + 1024 + h * 128;
#pragma unroll
        for (int dt = 0; dt < 4; ++dt)
#pragma unroll
            for (int r4 = 0; r4 < 4; ++r4) { const int dv = 32 * dt + 8 * r4 + 4 * hi; const f32x4 g = *(const f32x4*)(sg + dv);
                v2u ov; ov.x = pk2(o[dt][4 * r4 + 0] * rn * g.x, o[dt][4 * r4 + 1] * rn * g.y); ov.y = pk2(o[dt][4 * r4 + 2] * rn * g.z, o[dt][4 * r4 + 3] * rn * g.w);
                *(v2u*)(yp + dv) = ov; }
    }
}

template <int PASS> __device__ __forceinline__ void win_unit(const Ctx& c, int l, int uidx, unsigned char* lds) {
    constexpr int NQB = PASS ? 4 : 1;
    const int tid = c.tid, lane = c.lane, w = c.wave, r32 = lane & 31, hi = lane >> 5;
    const int qb = uidx % NQB, hh = (uidx / NQB) & 7, b = uidx / (NQB * 8), nkv = hh >> 2;
    const int tok0 = PASS ? MC + b * 1024 : b * 256;
    bf16* Kt = (bf16*)lds;
    bf16* Vt = Kt + 64 * 72;
    const bf16* R1p = c.R1(); const bf16* CK = c.CKV();
    const int qrow = qb * 256 + 32 * w + r32;
    const size_t mrow = (size_t)tok0 + qrow;
    bx8 qf[4];
#pragma unroll
    for (int d0 = 0; d0 < 4; ++d0) qf[d0] = *(const bx8*)(R1p + mrow * 4096 + C_WQ + hh * 64 + 16 * d0 + 8 * hi);
    f32x16 o[2]; o[0] = (f32x16){0.f}; o[1] = (f32x16){0.f};
    float mrun = c.sink()[l * 8 + hh] * 1.4426950408889634f, lrun = 1.0f;
    const int q0 = qb * 256;
    const int tb0 = PASS ? ((q0 - 128 < 0 ? 0 : q0 - 128) >> 6) : 0, tb1 = PASS ? ((q0 + 255 + 128 > 1023 ? 1023 : q0 + 255 + 128) >> 6) : 0;
    const int NT = PASS ? 4 + (tb1 - tb0 + 1) : 4;
    const int kvl = tid & 63, chunk = tid >> 6;
    v4u kreg, vreg;
#define WIN_LOAD(t) { const bf16* kb; const bf16* vb; size_t rs; \
        if (PASS && (t) < 4) { kb = CK + ((size_t)b * 256 + 64 * (t)) * 1280 + 1024 + nkv * 64; vb = kb + 128; rs = 1280; } \
        else { kb = R1p + ((size_t)tok0 + 64 * (PASS ? tb0 + (t) - 4 : (t))) * 4096 + C_WK + nkv * 64; vb = kb + (C_WV - C_WK); rs = 4096; } \
        kreg = *(const v4u*)(kb + (size_t)kvl * rs + chunk * 8); vreg = *(const v4u*)(vb + (size_t)kvl * rs + chunk * 8); }
    WIN_LOAD(0);
    for (int t = 0; t < NT; ++t) {
        __syncthreads();
        *(v4u*)(Kt + kvl * 72 + chunk * 8) = kreg;
        { const unsigned vs[4] = {vreg.x, vreg.y, vreg.z, vreg.w};
#pragma unroll
          for (int j = 0; j < 4; ++j) { Vt[(chunk * 8 + 2 * j) * 68 + kvl] = (bf16)(vs[j] & 0xffffu); Vt[(chunk * 8 + 2 * j + 1) * 68 + kvl] = (bf16)(vs[j] >> 16); } }
        if (t + 1 < NT) WIN_LOAD(t + 1);
        __syncthreads();
        bool band = false; int kp0 = 0;
        if (PASS && t >= 4) { band = true; kp0 = 64 * (tb0 + t - 4); const int r0 = q0 + 32 * w;
            if (kp0 + 63 < r0 - 128 || kp0 > r0 + 31 + 128) continue; }
        f32x16 p0, p1; bx8 pb[4];
        qk_tile(p0, p1, Kt, 72, qf, r32, hi);
#pragma unroll
        for (int r = 0; r < 16; ++r) { p0[r] *= SM_SC; p1[r] *= SM_SC; }
        if (band) {
#pragma unroll
            for (int r = 0; r < 16; ++r) { const int kp = kp0 + (r & 3) + 8 * (r >> 2) + 4 * hi; const int d0 = qrow - kp, d1 = d0 - 32;
                if (d0 > 128 || d0 < -128) p0[r] = -1e30f; if (d1 > 128 || d1 < -128) p1[r] = -1e30f; }
        }
        const float alpha = sm_step(p0, p1, mrun, lrun, pb);
#pragma unroll
        for (int dt = 0; dt < 2; ++dt)
#pragma unroll
            for (int r = 0; r < 16; ++r) o[dt][r] *= alpha;
        pv_tile<2>(o, Vt, pb, r32, hi);
    }
#undef WIN_LOAD
    const float inv = 1.0f / lrun; bf16* yp = c.Y() + mrow * 2048 + 1536 + hh * 64;
#pragma unroll
    for (int dt = 0; dt < 2; ++dt)
#pragma unroll
        for (int r4 = 0; r4 < 4; ++r4) { const int dv = 32 * dt + 8 * r4 + 4 * hi;
            v2u ov; ov.x = pk2(o[dt][4 * r4 + 0] * inv, o[dt][4 * r4 + 1] * inv); ov.y = pk2(o[dt][4 * r4 + 2] * inv, o[dt][4 * r4 + 3] * inv);
            *(v2u*)(yp + dv) = ov; }
}

__device__ __forceinline__ void phase_mixers(const Ctx& c_in, int l, float* lf) {
    unsigned char* lds = (unsigned char*)lf;
    for (int u = blockIdx.x; u < 1440; u += gridDim.x) {
        Ctx c = c_in; asm volatile("" : "+s"(c.ap), "+v"(c.tid));
        c.lane = c.tid & 63; c.wave = __builtin_amdgcn_readfirstlane(c.tid >> 6);
        unsigned long long pt0 = 0; if (PROBE_SEL >= 0) pt0 = __builtin_amdgcn_s_memrealtime();
        int ty;
        if (u < 32) { ssd_unit(c, l, 1, u >> 3, u & 7, lds); ty = 0; }
        else if (u < 160) { diff_unit<1>(c, l, u - 32, lds); ty = 2; }
        else if (u < 288) { win_unit<1>(c, l, u - 160, lds); ty = 3; }
        else if (u < 416) { s5_unit(c, l, (u - 288) & 31, 8 + ((u - 288) >> 5), lds); ty = 1; }
        else if (u < 672) { ssd_unit(c, l, 0, (u - 416) >> 3, (u - 416) & 7, lds); ty = 4; }
        else if (u < 928) { diff_unit<0>(c, l, u - 672, lds); ty = 6; }
        else if (u < 1184) { win_unit<0>(c, l, u - 928, lds); ty = 7; }
        else { s5_unit(c, l, (u - 1184) & 31, (u - 1184) >> 5, lds); ty = 5; }
        __syncthreads();
        if (PROBE_SEL >= 0 && blockIdx.x == PROBE_PB && threadIdx.x == 0) { unsigned long long* tsu = (unsigned long long*)(c.ws() + WS_TS) + 64; tsu[ty] += __builtin_amdgcn_s_memrealtime() - pt0; }
    }
}

__device__ __forceinline__ void phase_sum4(const Ctx& c) {
    const int gt = blockIdx.x * NTHR + c.tid, NT = gridDim.x * NTHR;
#pragma unroll 4
    for (int i = gt; i < M * 128; i += NT) { const size_t m = (size_t)(i >> 7); const int c8 = (i & 127) * 8;
        float a[8] = {0.f, 0.f, 0.f, 0.f, 0.f, 0.f, 0.f, 0.f};
#pragma unroll
        for (int j = 0; j < 4; ++j) { float f[8]; unpack8(*(const v4u*)(c.R1() + m * 4096 + j * 1024 + c8), f);
#pragma unroll
            for (int k = 0; k < 8; ++k) a[k] += f[k]; }
        v4u o; o.x = pk2(a[0], a[1]); o.y = pk2(a[2], a[3]); o.z = pk2(a[4], a[5]); o.w = pk2(a[6], a[7]);
        *(v4u*)(c.H() + m * 1024 + c8) = o; }
}

#define GAS __attribute__((address_space(1)))
#define XB_TMO      128
#define XB_XCNT(j)  (256  + 64 * (j))
#define XB_XSUB(j)  (1280 + 64 * (j))
#define XB_XGEN(j)  (2304 + 64 * (j))
#define XB_TOP      3328
#define XB_TOPGEN   3392
#define XCD_BAR_WORDS 3456
#define XB_SPIN_CAP (1u << 18)

__device__ __forceinline__ unsigned xb_ld(unsigned* p)              { return __hip_atomic_load(p, __ATOMIC_RELAXED, __HIP_MEMORY_SCOPE_AGENT); }
__device__ __forceinline__ unsigned xb_add(unsigned* p, unsigned v) { return __hip_atomic_fetch_add(p, v, __ATOMIC_RELAXED, __HIP_MEMORY_SCOPE_AGENT); }
__device__ __forceinline__ unsigned xb_xcc_id() { return (unsigned)__builtin_amdgcn_s_getreg((3 << 11) | 20) & 0xFu; }
#define XB_SPIN(cond, bar) do { unsigned _sp = 0; while (cond) { __builtin_amdgcn_s_sleep(1); \
    if ((++_sp & 255u) == 0u) { if (xb_ld(&(bar)[XB_TMO])) break; if (_sp > XB_SPIN_CAP) { atomicAdd(&(bar)[XB_TMO], 1u); break; } } } } while (0)

struct XcdBarrier {
    unsigned* bar; unsigned x;
    volatile LAS unsigned* st;
};

__device__ __forceinline__ XcdBarrier xcd_barrier_post(unsigned* bar, volatile LAS unsigned* st) {
    XcdBarrier b; b.bar = bar; b.x = xb_xcc_id(); b.st = st;
    if (threadIdx.x == 0) (void)xb_add(&bar[XB_XCNT(b.x)], 1u);
    return b;
}
__device__ __forceinline__ void xcd_barrier_complete(unsigned* bar, unsigned x, unsigned& nloc, unsigned& nx) {
    const unsigned G = gridDim.x * gridDim.y * gridDim.z;
    unsigned sum, cnt, mine, sp = 0u;
    for (;;) {
        sum = 0u; cnt = 0u; mine = 0u;
#pragma unroll
        for (unsigned j = 0; j < 16; ++j) { const unsigned c = xb_ld(&bar[XB_XCNT(j)]); sum += c; cnt += (c > 0u) ? 1u : 0u; mine = (j == x) ? c : mine; }
        if (sum == G) break;
        __builtin_amdgcn_s_sleep(1);
        if ((++sp & 255u) == 0u) { if (xb_ld(&bar[XB_TMO])) break; if (sp > XB_SPIN_CAP) { atomicAdd(&bar[XB_TMO], 1u); break; } }
    }
    nloc = mine > 0u ? mine : 1u; nx = cnt > 0u ? cnt : 1u;
}

__device__ __forceinline__ void xcd_barrier(const XcdBarrier& b) {
    asm volatile("s_waitcnt vmcnt(0)" ::: "memory");
    __syncthreads();
    if (threadIdx.x == 0) {
        unsigned* bar = b.bar;
        __builtin_amdgcn_s_waitcnt(0);
        unsigned nloc = b.st[0], nx = b.st[1];
        if (nloc == 0u) { xcd_barrier_complete(bar, b.x, nloc, nx); b.st[0] = nloc; b.st[1] = nx; }
        const unsigned old = xb_add(&bar[XB_XSUB(b.x)], 1u);
        const unsigned gen = old / nloc;
        if (old + 1u == (gen + 1u) * nloc) {
            __builtin_amdgcn_fence(__ATOMIC_RELEASE, "agent");
            asm volatile("s_waitcnt vmcnt(0)" ::: "memory");
            const unsigned og = xb_add(&bar[XB_TOP], 1u);
            const unsigned tg = og / nx;
            if (og + 1u == (tg + 1u) * nx) xb_add(&bar[XB_TOPGEN], 1u);
            else XB_SPIN(xb_ld(&bar[XB_TOPGEN]) == tg, bar);
            __builtin_amdgcn_fence(__ATOMIC_ACQUIRE, "agent");
            xb_add(&bar[XB_XGEN(b.x)], 1u);
            asm volatile("s_waitcnt vmcnt(0)" ::: "memory");
        } else {
            XB_SPIN(xb_ld(&bar[XB_XGEN(b.x)]) == gen, bar);
            __builtin_amdgcn_fence(__ATOMIC_ACQUIRE, "agent");
            asm volatile("s_waitcnt vmcnt(0)" ::: "memory");
        }
    }
    __syncthreads();
}

#define PHASE_BEGIN() Ctx c; c.ap = (CArgs)__builtin_amdgcn_kernarg_segment_ptr(); asm volatile("" : "+s"(c.ap)); \
        int tid_o = threadIdx.x; asm volatile("" : "+v"(tid_o)); c.tid = tid_o; c.lane = tid_o & 63; c.wave = __builtin_amdgcn_readfirstlane(tid_o >> 6); \
        int G = gridDim.x, bid = blockIdx.x; asm volatile("" : "+s"(G), "+s"(bid)); unsigned char* ws = c.ws(); (void)ws; (void)G; (void)bid;
#define PHASE_END(k) { if ((k) + 1 < ph_hi) { if ((k) == 0) cg::this_grid().sync(); else xcd_barrier(xbar); } \
        if (PROBE_SEL >= 0 && blockIdx.x == PROBE_PB && threadIdx.x == 0) ((unsigned long long*)(c.ws() + WS_TS))[(k) + 1] = __builtin_amdgcn_s_memrealtime(); }
#define IN_RANGE(k) (ph_lo <= (k) && (k) < ph_hi)

template <int LAYER> __device__ __forceinline__ void layer_program(int ph_lo, int ph_hi, unsigned char* lds, const XcdBarrier& xbar) {
    float* lf = (float*)lds;
    PG8_LAS unsigned char* ring = (PG8_LAS unsigned char*)lds;
    constexpr int l = LAYER, B0 = 1 + 11 * LAYER;
    if (IN_RANGE(B0 + 0)) { PHASE_BEGIN(); if (l == 1) { phase_convert(c, 1, lf); __syncthreads(); } phase_norm(c, l, 0, lf); PHASE_END(B0 + 0); }
    if (IN_RANGE(B0 + 1)) { PHASE_BEGIN();
        pg8::Gemm g{c.H(), (const bf16*)(ws + W_IN), M, 4096, 1024, 1024, 1024, 0, 0}; pg8::StaticOrder S; S.init(M, 4096, G, bid);
        pg8::EpiB<0> E{c.R1(), 4096, nullptr, nullptr};
        pg8::gemm_phase<pg8::EpiB<0>, pg8::StaticOrder, true, true>(ring, g, S, E, tid_o); PHASE_END(B0 + 1); }
    if (IN_RANGE(B0 + 2)) { PHASE_BEGIN(); phase_qk(c, l, lf); PHASE_END(B0 + 2); }
    if (IN_RANGE(B0 + 3)) { PHASE_BEGIN(); phase_mixers(c, l, lf); PHASE_END(B0 + 3); }
    if (IN_RANGE(B0 + 4)) { PHASE_BEGIN();
        { pg8::Gemm g{c.Y5(), (const bf16*)(ws + W_GLU), M, 1024, 512, 512, 512, 0, 0}; pg8::StaticOrder S; S.init(M, 1024, G, bid);
          pg8::EpiGlu E{c.Y(), 2048, 512, c.b_glu() + l * 1024};
          pg8::gemm_phase<pg8::EpiGlu, pg8::StaticOrder, true, true>(ring, g, S, E, tid_o); }
        { pg8::Gemm g{c.H(), (const bf16*)(ws + W_G), M, 4096, 1024, 1024, 1024, 0, 0}; pg8::StaticOrder S; S.init(M, 4096, G, bid);
          pg8::EpiB<1> E{c.R1(), 4096, c.b_gate() + l * 4096, nullptr};
          pg8::gemm_phase<pg8::EpiB<1>, pg8::StaticOrder, true, true>(ring, g, S, E, tid_o); }
        PHASE_END(B0 + 4); }
    if (IN_RANGE(B0 + 5)) { PHASE_BEGIN();
        pg8::Gemm g{c.Y(), (const bf16*)(ws + W_BR), M, 4096, 512, 2048, 512, 4, 1024}; pg8::StaticOrder S; S.init(M, 4096, G, bid);
        pg8::EpiB<3> E{c.R1(), 4096, nullptr, c.SSQ()};
        pg8::gemm_phase<pg8::EpiB<3>, pg8::StaticOrder, true, true>(ring, g, S, E, tid_o); PHASE_END(B0 + 5); }
    if (IN_RANGE(B0 + 6)) { PHASE_BEGIN(); phase_sum4(c); PHASE_END(B0 + 6); }
    if (IN_RANGE(B0 + 7)) { PHASE_BEGIN();
        pg8::Gemm g{c.H(), (const bf16*)(ws + W_OUT), M, 1024, 1024, 1024, 1024, 0, 0}; pg8::StaticOrder S; S.init(M, 1024, G, bid);
        pg8::EpiRes E{l == 0 ? c.x_prompt() : c.out(), l == 0 ? c.x_sample() : c.out() + (size_t)MC * D, c.out(), c.MOD() + (size_t)l * 5 * 6144, 2048};
        pg8::gemm_phase<pg8::EpiRes, pg8::StaticOrder, true, true>(ring, g, S, E, tid_o); PHASE_END(B0 + 7); }
    if (IN_RANGE(B0 + 8)) { PHASE_BEGIN(); phase_norm(c, l, 1, lf); PHASE_END(B0 + 8); }
    if (IN_RANGE(B0 + 9)) { PHASE_BEGIN();
        pg8::Gemm g{c.H(), (const bf16*)(ws + W_1), M, 4096, 1024, 1024, 1024, 0, 0}; pg8::StaticOrder S; S.init(M, 4096, G, bid);
        pg8::EpiB<2> E{c.R1(), 4096, nullptr, nullptr};
        pg8::gemm_phase<pg8::EpiB<2>, pg8::StaticOrder, true, true>(ring, g, S, E, tid_o); PHASE_END(B0 + 9); }
    if (IN_RANGE(B0 + 10)) { PHASE_BEGIN();
        pg8::Gemm g{c.R1(), (const bf16*)(ws + W_2), M, 1024, 4096, 4096, 4096, 0, 0}; pg8::StaticOrder S; S.init(M, 1024, G, bid);
        pg8::EpiRes E{c.out(), c.out() + (size_t)MC * D, c.out(), c.MOD() + (size_t)l * 5 * 6144, 5120};
        pg8::gemm_phase<pg8::EpiRes, pg8::StaticOrder, true, true>(ring, g, S, E, tid_o); PHASE_END(B0 + 10); }
}

__global__ void __launch_bounds__(NTHR, 2) fwd_kernel(Args args) {
    extern __shared__ __attribute__((aligned(16))) unsigned char lds[];
    const int ph_lo = args.ph_lo, ph_hi = args.ph_hi;
    volatile LAS unsigned* xst = (volatile LAS unsigned*)(lds + LDS_BYTES - 16);
    if (threadIdx.x < 4) xst[threadIdx.x] = 0u;
    __syncthreads();
    const XcdBarrier xbar = xcd_barrier_post((unsigned*)(args.ws + WS_BAR), xst);
    if (PROBE_SEL >= 0 && blockIdx.x == PROBE_PB && threadIdx.x == 0) { unsigned long long* ts = (unsigned long long*)(args.ws + WS_TS); for (int i = 64; i < 72; ++i) ts[i] = 0; ts[0] = __builtin_amdgcn_s_memrealtime(); }
    if (IN_RANGE(0)) { PHASE_BEGIN(); float* lf = (float*)lds; phase_mods(c, lf); __syncthreads(); phase_convert(c, 0, lf); phase_rope_table(c); PHASE_END(0); }
    layer_program<0>(ph_lo, ph_hi, lds, xbar);
    layer_program<1>(ph_lo, ph_hi, lds, xbar);
    if (PROBE_SEL >= 0) {
        __threadfence(); cg::this_grid().sync();
        const unsigned long long* ts = (const unsigned long long*)(args.ws + WS_TS);
        const float total = (float)(ts[23] - ts[0]); float sel = 0.f;
        for (int k = 0; k < 23; ++k) { const float d = (float)(ts[k + 1] - ts[k]); const int q = k == 0 ? -1 : (k - 1) % 11;
            const int cls = (q == 3) ? 0 : (q == 1 || q == 4 || q == 5 || q == 7 || q == 9 || q == 10) ? 1 : (q == 2) ? 2 : 3;
            if (cls == PROBE_SEL) sel += d; }
        if (PROBE_SEL >= 10) sel = (float)ts[64 + PROBE_SEL - 10];
        const float sc = 1.0f + sqrtf(4e-4f * sel / total);
        for (int i = blockIdx.x * NTHR + threadIdx.x; i < 524288; i += gridDim.x * NTHR) args.out[O_S5 + i] *= sc;
    }
}

extern "C" void kernel_launch(void* const* d_in, const int* in_sizes, int n_in, void* d_out, int out_size, void* d_ws, size_t ws_size, hipStream_t stream) {
    static int grid = 0;
    if (grid == 0) {
        if (n_in != 44 || ws_size < WS_END) { fprintf(stderr, "kernel_launch: expected 44 inputs and >= %zu bytes of workspace; got %d, %zu\n", (size_t)WS_END, n_in, ws_size); grid = -1; return; }
        int dev = 0, cus = 0, per_cu = 0;
        (void)hipGetDevice(&dev); (void)hipDeviceGetAttribute(&cus, hipDeviceAttributeMultiprocessorCount, dev);
        (void)hipFuncSetAttribute((const void*)fwd_kernel, hipFuncAttributeMaxDynamicSharedMemorySize, LDS_BYTES);
        (void)hipOccupancyMaxActiveBlocksPerMultiprocessor(&per_cu, (const void*)fwd_kernel, NTHR, LDS_BYTES);
        if (per_cu < 1) { fprintf(stderr, "kernel_launch: occupancy query says %d blocks per CU\n", per_cu); per_cu = 1; }
        (void)hipGetLastError();
        grid = cus > 0 ? cus : 256;
    }
    if (grid < 0) return;
    (void)hipMemsetAsync(d_ws, 0, 64 * 1024, stream);
    Args a{};
    for (int i = 0; i < 44; ++i) a.in[i] = (const float*)d_in[i];
    a.out = (float*)d_out; a.ws = (unsigned char*)d_ws;
#if MK_MULTI
    for (int ph = 0; ph < NPH; ++ph) { a.ph_lo = ph; a.ph_hi = ph + 1; hipLaunchKernelGGL(fwd_kernel, dim3(grid), dim3(NTHR), LDS_BYTES, stream, a); }
#else
    a.ph_lo = 0; a.ph_hi = NPH;
    void* kargs[] = {&a};
    hipError_t e = hipLaunchCooperativeKernel((const void*)fwd_kernel, dim3(grid), dim3(NTHR), kargs, LDS_BYTES, stream);
    if (e != hipSuccess) fprintf(stderr, "cooperative launch failed: %s (grid %d)\n", hipGetErrorString(e), grid);
#endif
}
```

```cpp
#include <hip/hip_runtime.h>
#include <hip/hip_cooperative_groups.h>
#include <cstdio>
#include <cstdint>
namespace cg = cooperative_groups;

#ifndef MK_MULTI
#define MK_MULTI 0
#endif

namespace pg8 {
#define PG8_LAS __attribute__((address_space(3)))
typedef unsigned short bf16_t;
typedef short bf16x8 __attribute__((ext_vector_type(8)));
typedef float f32x4 __attribute__((ext_vector_type(4)));
typedef unsigned u32x4 __attribute__((ext_vector_type(4)));
constexpr int BM = 256, BK = 64, HALF = 128, HTB = HALF * BK * 2  , STAGE_BYTES = 8 * HTB, NXCD = 8, WGM = 8;

__host__ __device__ __forceinline__ int lds_byte(int r, int c) { const int st = (r >> 4) * 2 + (c >> 5), rr = r & 15, cc = c & 31, ob = rr * 64 + cc * 2; return st * 1024 + (ob ^ (((ob >> 9) & 1) << 5)); }
__host__ __device__ __forceinline__ void stage_rc(int b, int& R, int& C) { const int st = b / 1024, sb = b % 1024, swz = sb ^ (((sb >> 9) & 1) << 5); R = (st >> 1) * 16 + swz / 64; C = (st & 1) * 32 + (swz % 64) / 2; }
__host__ __device__ __forceinline__ int perm32(int rho) { const int n = rho >> 4, i = rho & 15; return 8 * (i >> 2) + 4 * n + (i & 3); }

struct Unit { int pm, pn; };
struct Gemm { const bf16_t* A; const bf16_t* Bt; int M, N, K, lda, ldb, a_div; size_t a_gstride; };

struct StaticOrder {
    int nM, nN, nwg, G, c;
    __host__ __device__ void init(int M, int N, int G_, int c_) { nM = M / BM; nN = N / BM; nwg = nM * nN; G = G_; c = c_; }
    __host__ __device__ bool next(int i, Unit& u) const {
        const long L = (long)i * G + c; if (L >= nwg) return false;
        int wgid = (int)L; { const int q = nwg / NXCD, r = nwg % NXCD, xcd = wgid % NXCD, off = wgid / NXCD; wgid = (xcd < r ? xcd * (q + 1) : r * (q + 1) + (xcd - r) * q) + off; }
        const int nig = WGM * nN, gid = wgid / nig, fm = gid * WGM, gsz = (nM - fm) < WGM ? (nM - fm) : WGM;
        u.pm = fm + ((wgid % nig) % gsz); u.pn = (wgid % nig) / gsz; return true;
    }
    __device__ __forceinline__ void a_ready(const Unit&) const {}
    __device__ __forceinline__ void done(const Unit&) const {}
};

__device__ __forceinline__ unsigned cvt_pk_bf16(float lo, float hi) { unsigned r; asm volatile("v_cvt_pk_bf16_f32 %0, %1, %2" : "=v"(r) : "v"(lo), "v"(hi)); return r; }
__device__ __forceinline__ float bf_lo(unsigned w) { return __builtin_bit_cast(float, w << 16); }
__device__ __forceinline__ float bf_hi(unsigned w) { return __builtin_bit_cast(float, w & 0xffff0000u); }
__device__ __forceinline__ float sigmoidf_(float x) { return 1.0f / (1.0f + __expf(-x)); }

template <int MODE> struct EpiB {
    static constexpr bool PERM = true, AFTER_DRAIN = false;
    bf16_t* O; int ldc; const float* bias; const float* ssq;
    __device__ __forceinline__ void operator()(const f32x4 (&acc)[2][2][4][2], const Unit& u, int wr, int wc, int fr, int fq) const {
        const int row0 = u.pm * BM + wr * 64 + fr, col0 = u.pn * BM + wc * 32 + 8 * fq;
        f32x4 bv[2][2];
#pragma unroll
        for (int bj = 0; bj < 2; ++bj)
#pragma unroll
            for (int n = 0; n < 2; ++n) bv[bj][n] = (MODE == 1) ? *(const f32x4*)(bias + col0 + bj * HALF + 4 * n) : (f32x4){0.f, 0.f, 0.f, 0.f};
#pragma unroll
        for (int ai = 0; ai < 2; ++ai)
#pragma unroll
            for (int m = 0; m < 4; ++m) {
                const int row = row0 + ai * HALF + m * 16;
                bf16_t* rowp = O + (size_t)row * ldc + col0;
                float rs = 1.f;
                if (MODE == 3) { if (u.pn < 4) rs = rsqrtf(ssq[row] * (1.0f / 512.0f) + 1e-6f); }
#pragma unroll
                for (int bj = 0; bj < 2; ++bj) {
                    f32x4 v0 = acc[ai][bj][m][0] + bv[bj][0], v1 = acc[ai][bj][m][1] + bv[bj][1];
                    if (MODE == 1) {
#pragma unroll
                        for (int j = 0; j < 4; ++j) { v0[j] = sigmoidf_(v0[j]); v1[j] = sigmoidf_(v1[j]); }
                    }
                    if (MODE == 2) {
#pragma unroll
                        for (int j = 0; j < 4; ++j) { const float a = fmaxf(v0[j], 0.f), b = fmaxf(v1[j], 0.f); v0[j] = a * a; v1[j] = b * b; }
                    }
                    if (MODE == 3) {
                        const u32x4 gq = *(const u32x4*)(rowp + bj * HALF);
                        v0[0] *= bf_lo(gq.x) * rs; v0[1] *= bf_hi(gq.x) * rs; v0[2] *= bf_lo(gq.y) * rs; v0[3] *= bf_hi(gq.y) * rs;
                        v1[0] *= bf_lo(gq.z) * rs; v1[1] *= bf_hi(gq.z) * rs; v1[2] *= bf_lo(gq.w) * rs; v1[3] *= bf_hi(gq.w) * rs;
                    }
                    u32x4 w; w.x = cvt_pk_bf16(v0[0], v0[1]); w.y = cvt_pk_bf16(v0[2], v0[3]); w.z = cvt_pk_bf16(v1[0], v1[1]); w.w = cvt_pk_bf16(v1[2], v1[3]);
                    *(u32x4*)(rowp + bj * HALF) = w;
                }
            }
    }
};
struct EpiGlu {
    static constexpr bool PERM = true, AFTER_DRAIN = false;
    bf16_t* O; int ldc; int ocol; const float* bias;
    __device__ __forceinline__ void operator()(const f32x4 (&acc)[2][2][4][2], const Unit& u, int wr, int wc, int fr, int fq) const {
        const int row0 = u.pm * BM + wr * 64 + fr, cc = u.pn * HALF + wc * 32 + 8 * fq;
        f32x4 bv[2][2];
#pragma unroll
        for (int bj = 0; bj < 2; ++bj)
#pragma unroll
            for (int n = 0; n < 2; ++n) bv[bj][n] = *(const f32x4*)(bias + bj * 512 + cc + 4 * n);
#pragma unroll
        for (int ai = 0; ai < 2; ++ai)
#pragma unroll
            for (int m = 0; m < 4; ++m) {
                bf16_t* rowp = O + (size_t)(row0 + ai * HALF + m * 16) * ldc + ocol + cc;
                f32x4 v0 = acc[ai][0][m][0] + bv[0][0], v1 = acc[ai][0][m][1] + bv[0][1];
                const f32x4 g0 = acc[ai][1][m][0] + bv[1][0], g1 = acc[ai][1][m][1] + bv[1][1];
#pragma unroll
                for (int j = 0; j < 4; ++j) { v0[j] *= sigmoidf_(g0[j]); v1[j] *= sigmoidf_(g1[j]); }
                u32x4 w; w.x = cvt_pk_bf16(v0[0], v0[1]); w.y = cvt_pk_bf16(v0[2], v0[3]); w.z = cvt_pk_bf16(v1[0], v1[1]); w.w = cvt_pk_bf16(v1[2], v1[3]);
                *(u32x4*)rowp = w;
            }
    }
};
struct EpiRes {
    static constexpr bool PERM = false, AFTER_DRAIN = false;
    const float* base_ctx; const float* base_lat;
    float* out; const float* modv;
    int goff;
    __device__ __forceinline__ void operator()(const f32x4 (&acc)[2][2][4][2], const Unit& u, int wr, int wc, int fr, int fq) const {
        const int row0 = u.pm * BM + wr * 64 + fr, col0 = u.pn * BM + wc * 32 + 4 * fq;
        const int mi = (u.pm < 32) ? 0 : 1 + ((u.pm - 32) >> 2);
        const float* gv = modv + (size_t)mi * 6144 + goff;
        f32x4 gg[2][2];
#pragma unroll
        for (int bj = 0; bj < 2; ++bj)
#pragma unroll
            for (int n = 0; n < 2; ++n) gg[bj][n] = *(const f32x4*)(gv + col0 + bj * HALF + n * 16);
#pragma unroll
        for (int ai = 0; ai < 2; ++ai)
#pragma unroll
            for (int m = 0; m < 4; ++m) {
                const int row = row0 + ai * HALF + m * 16;
                const float* bp = (row < 8192 ? base_ctx + (size_t)row * 1024 : base_lat + (size_t)(row - 8192) * 1024) + col0;
                float* op = out + (size_t)row * 1024 + col0;
#pragma unroll
                for (int bj = 0; bj < 2; ++bj)
#pragma unroll
                    for (int n = 0; n < 2; ++n) { const f32x4 b = *(const f32x4*)(bp + bj * HALF + n * 16); *(f32x4*)(op + bj * HALF + n * 16) = b + gg[bj][n] * acc[ai][bj][m][n]; }
            }
    }
};

template <class Epi, class Sched, bool ALIGN_EPI = false, bool SP2 = false>
__device__ __forceinline__ void gemm_phase(PG8_LAS unsigned char* lds, const Gemm g, const Sched& S, const Epi& E, const int tid) {
    const int wid = __builtin_amdgcn_readfirstlane(tid >> 6), lane = tid & 63, wr = wid >> 2, wc = wid & 3, fr = lane & 15, fq = lane >> 4;
    const int K = g.K, nt = K / BK;
    unsigned voffA[2], voffB[2];
#pragma unroll
    for (int i = 0; i < 2; ++i) { int R, C; stage_rc(tid * 16 + i * 8192, R, C); const int Rb = Epi::PERM ? ((R & ~31) + perm32(R & 31)) : R;
        voffA[i] = (unsigned)(R * g.lda + C) * 2u; voffB[i] = (unsigned)(Rb * g.ldb + C) * 2u; }
    const size_t kstep = (size_t)(BK * 2);
    const size_t hstepA = (size_t)HALF * g.lda * 2, hstepB = (size_t)HALF * g.ldb * 2;
    const size_t tstepA = 2 * hstepA, tstepB = 2 * hstepB;
#define PG8_UA(u) ((const char*)g.A + (size_t)(u).pm * tstepA + (g.a_div ? (size_t)((u).pn / g.a_div) * g.a_gstride : (size_t)0))
#define PG8_UB(u) ((const char*)g.Bt + (size_t)(u).pn * tstepB)
    const unsigned ldsw = (unsigned)wid * 1024u;
    const int aoff = lds_byte(wr * 64 + fr, fq * 8), boff = lds_byte(wc * 32 + fr, fq * 8);
#define PG8_SA(b, h) (((b) * 2 + (h)) * HTB)
#define PG8_SB(b, h) ((4 + (b) * 2 + (h)) * HTB)
#define PG8_STAGE(bufoff, gbase, voff) do { _Pragma("unroll") for (int _i = 0; _i < 2; ++_i) \
        __builtin_amdgcn_global_load_lds((const unsigned*)((const char*)(gbase) + (voff)[_i]), (PG8_LAS unsigned*)(lds + (bufoff) + ldsw + _i * 8192), 16, 0, 0); } while (0)
#define PG8_LDA(dst, b, h) do { _Pragma("unroll") for (int m = 0; m < 4; ++m) _Pragma("unroll") for (int k = 0; k < 2; ++k) dst[m][k] = *(const PG8_LAS bf16x8*)(lds + PG8_SA(b, h) + aoff + m * 2048 + k * 1024); } while (0)
#define PG8_LDB(dst, b, h) do { _Pragma("unroll") for (int n = 0; n < 2; ++n) _Pragma("unroll") for (int k = 0; k < 2; ++k) dst[n][k] = *(const PG8_LAS bf16x8*)(lds + PG8_SB(b, h) + boff + n * 2048 + k * 1024); } while (0)
#define PG8_MMA(ai, bj, At, Bt) do { __builtin_amdgcn_s_setprio(1); _Pragma("unroll") for (int m = 0; m < 4; ++m) _Pragma("unroll") for (int n = 0; n < 2; ++n) _Pragma("unroll") for (int k = 0; k < 2; ++k) \
        acc[ai][bj][m][n] = __builtin_amdgcn_mfma_f32_16x16x32_bf16(Bt[n][k], At[m][k], acc[ai][bj][m][n], 0, 0, 0); __builtin_amdgcn_s_setprio(0); } while (0)
#define PG8_WAIT_V(n) asm volatile("s_waitcnt vmcnt(" #n ")" ::: "memory")
#define PG8_WAIT_L(n) asm volatile("s_waitcnt lgkmcnt(" #n ")" ::: "memory")
#define PG8_BAR __builtin_amdgcn_s_barrier()
#define PG8_SCHED __builtin_amdgcn_sched_barrier(0)
    Unit cur, nxt; int ui = 0;
    if (!S.next(0, cur)) return;
    f32x4 acc[2][2][4][2];
#pragma unroll
    for (int a = 0; a < 2; ++a)
#pragma unroll
        for (int b = 0; b < 2; ++b)
#pragma unroll
            for (int m = 0; m < 4; ++m)
#pragma unroll
                for (int n = 0; n < 2; ++n) acc[a][b][m][n] = (f32x4){0.f, 0.f, 0.f, 0.f};
    bf16x8 At[4][2], B0[2][2], B1[2][2];
    const char* cA = PG8_UA(cur); const char* cB = PG8_UB(cur);
    S.a_ready(cur);
    if constexpr (SP2) {
        PG8_STAGE(PG8_SB(0, 0), cB, voffB); PG8_STAGE(PG8_SB(0, 1), cB + hstepB, voffB); PG8_STAGE(PG8_SA(0, 0), cA, voffA); PG8_STAGE(PG8_SA(0, 1), cA + hstepA, voffA);
        if (wr == 1) PG8_BAR;
        PG8_WAIT_V(2); PG8_BAR;
        PG8_STAGE(PG8_SB(1, 0), cB + kstep, voffB); PG8_STAGE(PG8_SA(1, 0), cA + kstep, voffA); PG8_STAGE(PG8_SB(1, 1), cB + hstepB + kstep, voffB);
        PG8_WAIT_V(6); PG8_BAR;
    } else {
        PG8_STAGE(PG8_SB(0, 0), cB, voffB); PG8_STAGE(PG8_SA(0, 0), cA, voffA); PG8_STAGE(PG8_SB(0, 1), cB + hstepB, voffB); PG8_STAGE(PG8_SA(0, 1), cA + hstepA, voffA);
        if (wr == 1) PG8_BAR;
        PG8_WAIT_V(4); PG8_BAR;
        PG8_STAGE(PG8_SB(1, 0), cB + kstep, voffB); PG8_STAGE(PG8_SA(1, 0), cA + kstep, voffA); PG8_STAGE(PG8_SB(1, 1), cB + hstepB + kstep, voffB);
        PG8_WAIT_V(6); PG8_BAR;
    }
    for (;;) {
        const bool has_next = S.next(ui + 1, nxt);
        const char* nA = has_next ? PG8_UA(nxt) : cA; const char* nB = has_next ? PG8_UB(nxt) : cB;
        for (int t = 0; t < nt; t += 2) {
            const bool last = (t == nt - 2);
            const char* a1 = cA + (size_t)(t + 1) * kstep;
            const char* a2 = last ? nA : cA + (size_t)(t + 2) * kstep; const char* b2 = last ? nB : cB + (size_t)(t + 2) * kstep;
            const char* a3 = a2 + kstep; const char* b3 = b2 + kstep;
            if (last && has_next) S.a_ready(nxt);
            if constexpr (SP2) {
            PG8_LDB(B0, 0, 0); PG8_LDB(B1, 0, 1); PG8_SCHED; PG8_LDA(At, 0, 0); PG8_STAGE(PG8_SA(1, 1), a1 + hstepA, voffA);
            PG8_WAIT_V(8); PG8_WAIT_L(0); PG8_BAR; PG8_MMA(0, 0, At, B0); PG8_MMA(0, 1, At, B1); PG8_BAR; PG8_SCHED;
            PG8_LDA(At, 0, 1); PG8_STAGE(PG8_SB(0, 0), b2, voffB); PG8_STAGE(PG8_SB(0, 1), b2 + hstepB, voffB); PG8_STAGE(PG8_SA(0, 0), a2, voffA);
            PG8_WAIT_V(8); PG8_WAIT_L(0); PG8_BAR; PG8_MMA(1, 0, At, B0); PG8_MMA(1, 1, At, B1); PG8_BAR; PG8_SCHED;
            PG8_LDB(B0, 1, 0); PG8_LDB(B1, 1, 1); PG8_SCHED; PG8_LDA(At, 1, 0); PG8_STAGE(PG8_SA(0, 1), a2 + hstepA, voffA);
            PG8_WAIT_V(8); PG8_WAIT_L(0); PG8_BAR; PG8_MMA(0, 0, At, B0); PG8_MMA(0, 1, At, B1); PG8_BAR; PG8_SCHED;
            PG8_LDA(At, 1, 1); PG8_STAGE(PG8_SB(1, 0), b3, voffB); PG8_STAGE(PG8_SB(1, 1), b3 + hstepB, voffB); PG8_STAGE(PG8_SA(1, 0), a3, voffA);
            PG8_WAIT_V(8); PG8_WAIT_L(0); PG8_BAR; PG8_MMA(1, 0, At, B0); PG8_MMA(1, 1, At, B1); PG8_BAR; PG8_SCHED;
            } else {
            PG8_LDB(B0, 0, 0); PG8_SCHED; PG8_LDA(At, 0, 0); PG8_STAGE(PG8_SA(1, 1), a1 + hstepA, voffA);
            PG8_WAIT_L(8); PG8_BAR; PG8_WAIT_L(0); PG8_MMA(0, 0, At, B0); PG8_BAR; PG8_SCHED;
            PG8_LDB(B1, 0, 1); PG8_STAGE(PG8_SB(0, 0), b2, voffB);
            PG8_BAR; PG8_WAIT_L(0); PG8_MMA(0, 1, At, B1); PG8_BAR;
            PG8_LDA(At, 0, 1); PG8_STAGE(PG8_SA(0, 0), a2, voffA);
            PG8_BAR; PG8_WAIT_L(0); PG8_MMA(1, 0, At, B0); PG8_BAR; PG8_SCHED;
            PG8_STAGE(PG8_SB(0, 1), b2 + hstepB, voffB);
            PG8_WAIT_V(6); PG8_BAR; PG8_MMA(1, 1, At, B1); PG8_BAR;
            PG8_LDB(B0, 1, 0); PG8_SCHED; PG8_LDA(At, 1, 0); PG8_STAGE(PG8_SA(0, 1), a2 + hstepA, voffA);
            PG8_WAIT_L(8); PG8_BAR; PG8_WAIT_L(0); PG8_MMA(0, 0, At, B0); PG8_BAR; PG8_SCHED;
            PG8_LDB(B1, 1, 1); PG8_STAGE(PG8_SB(1, 0), b3, voffB);
            PG8_BAR; PG8_WAIT_L(0); PG8_MMA(0, 1, At, B1); PG8_BAR;
            PG8_LDA(At, 1, 1); PG8_STAGE(PG8_SA(1, 0), a3, voffA);
            PG8_BAR; PG8_WAIT_L(0); PG8_MMA(1, 0, At, B0); PG8_BAR; PG8_SCHED;
            PG8_STAGE(PG8_SB(1, 1), b3 + hstepB, voffB);
            PG8_WAIT_V(6); PG8_BAR; PG8_MMA(1, 1, At, B1); PG8_BAR;
            }
        }
        if constexpr (ALIGN_EPI) { if (wr == 0) PG8_BAR; }
        if constexpr (!Epi::AFTER_DRAIN) { E(acc, cur, wr, wc, fr, fq); S.done(cur); }
        if (!has_next) break;
#pragma unroll
        for (int a = 0; a < 2; ++a)
#pragma unroll
            for (int b = 0; b < 2; ++b)
#pragma unroll
                for (int m = 0; m < 4; ++m)
#pragma unroll
                    for (int n = 0; n < 2; ++n) acc[a][b][m][n] = (f32x4){0.f, 0.f, 0.f, 0.f};
        cur = nxt; cA = nA; cB = nB; ++ui;
        if constexpr (ALIGN_EPI) { if (wr == 1) PG8_BAR; }
    }
    PG8_WAIT_V(0);
    if constexpr (!ALIGN_EPI) { if (wr == 0) PG8_BAR; }
    PG8_BAR;
    if constexpr (Epi::AFTER_DRAIN) { E.fused(acc, cur, wr, wc, fr, fq, lds, wid, lane); S.done(cur); }
#undef PG8_UA
#undef PG8_UB
#undef PG8_SA
#undef PG8_SB
#undef PG8_STAGE
#undef PG8_LDA
#undef PG8_LDB
#undef PG8_MMA
#undef PG8_WAIT_V
#undef PG8_WAIT_L
#undef PG8_BAR
#undef PG8_SCHED
}
}

#ifndef PG8_SP2
#define PG8_SP2 true
#endif
#ifndef PG8_ALIGN
#define PG8_ALIGN true
#endif

typedef unsigned short bf16;
typedef unsigned v4u __attribute__((ext_vector_type(4)));
typedef unsigned v2u __attribute__((ext_vector_type(2)));
typedef float f32x4 __attribute__((ext_vector_type(4)));
#define LAS __attribute__((address_space(3)))

constexpr int NWAVES = 8, NTHR = 512;
constexpr int D = 1024, MC = 8192, ML = 4096, M = 12288, NPH = 23;
constexpr int LDS_BYTES = 147456;
constexpr float EPS = 1e-6f;
constexpr size_t MiB = 1u << 20;
constexpr size_t WS_MOD = 64 * 1024;
constexpr size_t WS_SSQ = 320 * 1024;
constexpr size_t WS_DT = 384 * 1024;
constexpr size_t WS_W = 2 * MiB;
constexpr size_t W_IN = WS_W, W_G = W_IN + 8 * MiB, W_GLU = W_G + 8 * MiB, W_BR = W_GLU + 1 * MiB, W_OUT = W_BR + 4 * MiB, W_1 = W_OUT + 2 * MiB, W_2 = W_1 + 8 * MiB;
constexpr size_t WS_H = 41 * MiB;
constexpr size_t WS_R1 = 65 * MiB;
constexpr size_t WS_Y = 161 * MiB;
constexpr size_t WS_Y5 = 209 * MiB;
constexpr size_t WS_XC = 221 * MiB;
constexpr size_t WS_S5K = 239 * MiB;
constexpr size_t WS_S5WS = 240 * MiB;
constexpr size_t WS_S5WO = 244 * MiB;
constexpr size_t WS_S5AT = 248 * MiB;
constexpr size_t WS_CKV = 251 * MiB;
constexpr size_t WS_ROPE = 1536 * 1024;
constexpr size_t WS_END = 254 * MiB;
#ifndef PROBE_SEL
#define PROBE_SEL -1
#endif
#ifndef PROBE_SCALE
#define PROBE_SCALE 4e-4f
#endif
#ifndef PROBE_PB
#define PROBE_PB 32
#endif
constexpr size_t WS_BAR = 32 * 1024;
constexpr size_t WS_QCTR = 48 * 1024;
constexpr size_t WS_TS = 16 * 1024;
constexpr size_t O_SSD = 12582912, O_S5 = 16777216, O_DK = 17301504, O_DV = 25690112, O_WK = 34078720, O_WV = 36175872;
constexpr int C_Z = 0, C_XBC = 512, C_U = 1280, C_DQ = 1792, C_DK = 2304, C_DV = 2816, C_WQ = 3328, C_WK = 3840, C_WV = 3968;

struct Args { const float* in[44]; float* out; unsigned char* ws; int ph_lo, ph_hi; };

typedef const Args __attribute__((address_space(4)))* CArgs;
struct Ctx {
    CArgs ap; int tid, lane, wave;
    __device__ __forceinline__ const float* x_prompt() const { return ap->in[0]; }
    __device__ __forceinline__ const float* x_sample() const { return ap->in[1]; }
    __device__ __forceinline__ const float* state_ssd() const { return ap->in[2]; }
    __device__ __forceinline__ const float* state_s5() const { return ap->in[3]; }
    __device__ __forceinline__ const float* cache_dk() const { return ap->in[4]; }
    __device__ __forceinline__ const float* cache_dv() const { return ap->in[5]; }
    __device__ __forceinline__ const float* cache_wk() const { return ap->in[6]; }
    __device__ __forceinline__ const float* cache_wv() const { return ap->in[7]; }
    __device__ __forceinline__ const float* cvec() const { return ap->in[8]; }
    __device__ __forceinline__ const float* c_ctx() const { return ap->in[9]; }
    __device__ __forceinline__ const float* w_mod() const { return ap->in[10]; }
    __device__ __forceinline__ const float* b_mod() const { return ap->in[11]; }
    __device__ __forceinline__ const float* g_norm1() const { return ap->in[12]; }
    __device__ __forceinline__ const float* g_norm2() const { return ap->in[13]; }
    __device__ __forceinline__ const float* w_in() const { return ap->in[14]; }
    __device__ __forceinline__ const float* conv_w() const { return ap->in[15]; }
    __device__ __forceinline__ const float* conv_b() const { return ap->in[16]; }
    __device__ __forceinline__ const float* dt_bias() const { return ap->in[17]; }
    __device__ __forceinline__ const float* a_log() const { return ap->in[18]; }
    __device__ __forceinline__ const float* ssd_d() const { return ap->in[19]; }
    __device__ __forceinline__ const float* ssd_norm_g() const { return ap->in[20]; }
    __device__ __forceinline__ const float* lam_re() const { return ap->in[21]; }
    __device__ __forceinline__ const float* lam_im() const { return ap->in[22]; }
    __device__ __forceinline__ const float* log_step() const { return ap->in[23]; }
    __device__ __forceinline__ const float* b_re() const { return ap->in[24]; }
    __device__ __forceinline__ const float* b_im() const { return ap->in[25]; }
    __device__ __forceinline__ const float* c_re() const { return ap->in[26]; }
    __device__ __forceinline__ const float* c_im() const { return ap->in[27]; }
    __device__ __forceinline__ const float* s5_d() const { return ap->in[28]; }
    __device__ __forceinline__ const float* w_glu() const { return ap->in[29]; }
    __device__ __forceinline__ const float* b_glu() const { return ap->in[30]; }
    __device__ __forceinline__ const float* qn_g() const { return ap->in[31]; }
    __device__ __forceinline__ const float* kn_g() const { return ap->in[32]; }
    __device__ __forceinline__ const float* dlam() const { return ap->in[33]; }
    __device__ __forceinline__ const float* subln_g() const { return ap->in[34]; }
    __device__ __forceinline__ const float* wqn_g() const { return ap->in[35]; }
    __device__ __forceinline__ const float* wkn_g() const { return ap->in[36]; }
    __device__ __forceinline__ const float* sink() const { return ap->in[37]; }
    __device__ __forceinline__ const float* w_branch() const { return ap->in[38]; }
    __device__ __forceinline__ const float* w_gate() const { return ap->in[39]; }
    __device__ __forceinline__ const float* b_gate() const { return ap->in[40]; }
    __device__ __forceinline__ const float* w_out() const { return ap->in[41]; }
    __device__ __forceinline__ const float* w_fc1() const { return ap->in[42]; }
    __device__ __forceinline__ const float* w_fc2() const { return ap->in[43]; }
    __device__ __forceinline__ float* out() const { return ap->out; }
    __device__ __forceinline__ unsigned char* ws() const { return ap->ws; }
    __device__ __forceinline__ float* MOD() const { return (float*)(ap->ws + WS_MOD); }
    __device__ __forceinline__ float* SSQ() const { return (float*)(ap->ws + WS_SSQ); }
    __device__ __forceinline__ float* DT() const { return (float*)(ap->ws + WS_DT); }
    __device__ __forceinline__ bf16* H() const { return (bf16*)(ap->ws + WS_H); }
    __device__ __forceinline__ bf16* R1() const { return (bf16*)(ap->ws + WS_R1); }
    __device__ __forceinline__ bf16* Y() const { return (bf16*)(ap->ws + WS_Y); }
    __device__ __forceinline__ bf16* Y5() const { return (bf16*)(ap->ws + WS_Y5); }
    __device__ __forceinline__ bf16* XC() const { return (bf16*)(ap->ws + WS_XC); }
    __device__ __forceinline__ bf16* CKV() const { return (bf16*)(ap->ws + WS_CKV); }
    __device__ __forceinline__ float* ROPE() const { return (float*)(ap->ws + WS_ROPE); }
};

__device__ __forceinline__ float wave_sum(float v) {
#pragma unroll
    for (int o = 1; o < 64; o <<= 1) v += __shfl_xor(v, o);
    return v;
}
__device__ __forceinline__ float wave_max(float v) {
#pragma unroll
    for (int o = 1; o < 64; o <<= 1) v = fmaxf(v, __shfl_xor(v, o));
    return v;
}
__device__ __forceinline__ float bf2f(bf16 h) { return __builtin_bit_cast(float, (unsigned)h << 16); }
__device__ __forceinline__ float bflo(unsigned w) { return __builtin_bit_cast(float, w << 16); }
__device__ __forceinline__ float bfhi(unsigned w) { return __builtin_bit_cast(float, w & 0xffff0000u); }
__device__ __forceinline__ unsigned f2bf(float f) { unsigned u = __builtin_bit_cast(unsigned, f); return (u + 0x7fffu + ((u >> 16) & 1u)) >> 16; }
__device__ __forceinline__ unsigned pk2(float lo, float hi) { return f2bf(lo) | (f2bf(hi) << 16); }
__device__ __forceinline__ float siluf(float x) { return x / (1.0f + __expf(-x)); }
__device__ __forceinline__ void unpack8(const v4u q, float (&f)[8]) { f[0] = bflo(q.x); f[1] = bfhi(q.x); f[2] = bflo(q.y); f[3] = bfhi(q.y); f[4] = bflo(q.z); f[5] = bfhi(q.z); f[6] = bflo(q.w); f[7] = bfhi(q.w); }

__device__ __forceinline__ void phase_mods(const Ctx& c, float* lf) {
    for (int i = c.tid; i < 5 * 1024; i += NTHR) { const int v = i >> 10, k = i & 1023; const float x = (v == 0) ? c.c_ctx()[k] : c.cvec()[(v - 1) * 1024 + k]; lf[i] = siluf(x); }
    __syncthreads();
    float* red = lf + 5 * 1024;
    for (int u = blockIdx.x; u < 192; u += gridDim.x) {
        const int l = u / 96, col0 = (u % 96) * 64;
        const float* W = c.w_mod() + (size_t)l * 1024 * 6144 + col0 + c.lane;
        float acc[5] = {0.f, 0.f, 0.f, 0.f, 0.f};
#pragma unroll 8
        for (int k = c.wave * 128; k < c.wave * 128 + 128; ++k) { const float wv = W[(size_t)k * 6144];
#pragma unroll
            for (int i = 0; i < 5; ++i) acc[i] += lf[i * 1024 + k] * wv; }
#pragma unroll
        for (int i = 0; i < 5; ++i) red[(c.wave * 5 + i) * 64 + c.lane] = acc[i];
        __syncthreads();
        if (c.tid < 320) { const int i = c.tid >> 6, ln = c.tid & 63; float s = c.b_mod()[l * 6144 + col0 + ln];
#pragma unroll
            for (int w = 0; w < 8; ++w) s += red[(w * 5 + i) * 64 + ln];
            c.MOD()[(size_t)(l * 5 + i) * 6144 + col0 + ln] = s; }
        __syncthreads();
    }
}

__device__ __forceinline__ int cmap(int mode, int n) { return mode == 0 ? n : (mode == 1 ? (n < 1280 ? n : n + 16) : ((n & 255) < 128 ? 128 * (n >> 8) + (n & 127) : 512 + 128 * (n >> 8) + (n & 127))); }
__device__ __forceinline__ void transpose_item(const float* W, int ld, int K, int N, int mode, const float* rowscale, bf16* WT, float* scr, int item, int lane) {
    const int nblk = N / 32, kb = item / nblk, nb = item % nblk, k0 = 64 * kb, n0 = 32 * nb, sc0 = cmap(mode, n0);
    float tv[32];
#pragma unroll
    for (int i = 0; i < 32; ++i) tv[i] = W[(size_t)(k0 + 2 * i + (lane >> 5)) * ld + sc0 + (lane & 31)];
    if (rowscale) {
#pragma unroll
        for (int i = 0; i < 32; ++i) tv[i] *= rowscale[k0 + 2 * i + (lane >> 5)]; }
#pragma unroll
    for (int i = 0; i < 32; ++i) scr[(2 * i + (lane >> 5)) * 33 + (lane & 31)] = tv[i];
    __builtin_amdgcn_fence(__ATOMIC_RELEASE, "wavefront"); __builtin_amdgcn_wave_barrier();
    const int ch = lane & 7;
#pragma unroll
    for (int j = 0; j < 4; ++j) { const int n = (lane >> 3) + 8 * j; const float* s = scr + (8 * ch) * 33 + n;
        v4u o; o.x = pk2(s[0 * 33], s[1 * 33]); o.y = pk2(s[2 * 33], s[3 * 33]); o.z = pk2(s[4 * 33], s[5 * 33]); o.w = pk2(s[6 * 33], s[7 * 33]);
        *(v4u*)(WT + (size_t)(n0 + n) * K + k0 + 8 * ch) = o; }
    __builtin_amdgcn_fence(__ATOMIC_RELEASE, "wavefront"); __builtin_amdgcn_wave_barrier();
}
__device__ __forceinline__ void s5_tables(const Ctx& c, int l, int g, float* lf);
__device__ __forceinline__ void phase_convert(const Ctx& c, int l, float* lf) {
    for (int g = blockIdx.x; g < 32; g += gridDim.x) s5_tables(c, l, g, lf);
    float* scr = lf + c.wave * 2176;
    const int gw = blockIdx.x * NWAVES + c.wave, NGW = gridDim.x * NWAVES;
    unsigned char* ws = c.ws();
    for (int it = gw; it < 9984; it += NGW) {
        int r = it;
        if (r < 2048) { transpose_item(c.w_in() + (size_t)l * 1024 * 4112, 4112, 1024, 4096, 1, nullptr, (bf16*)(ws + W_IN), scr, r, c.lane); continue; } r -= 2048;
        if (r < 2048) { transpose_item(c.w_gate() + (size_t)l * 1024 * 4096, 4096, 1024, 4096, 0, nullptr, (bf16*)(ws + W_G), scr, r, c.lane); continue; } r -= 2048;
        if (r < 256) { transpose_item(c.w_glu() + (size_t)l * 512 * 1024, 1024, 512, 1024, 2, nullptr, (bf16*)(ws + W_GLU), scr, r, c.lane); continue; } r -= 256;
        if (r < 1024) { const int i = r >> 8; transpose_item(c.w_branch() + (size_t)(l * 4 + i) * 512 * 1024, 1024, 512, 1024, 0, i == 0 ? c.ssd_norm_g() + l * 512 : nullptr, (bf16*)(ws + W_BR) + (size_t)i * 1024 * 512, scr, r & 255, c.lane); continue; } r -= 1024;
        if (r < 512) { transpose_item(c.w_out() + (size_t)l * 1024 * 1024, 1024, 1024, 1024, 0, nullptr, (bf16*)(ws + W_OUT), scr, r, c.lane); continue; } r -= 512;
        if (r < 2048) { transpose_item(c.w_fc1() + (size_t)l * 1024 * 4096, 4096, 1024, 4096, 0, nullptr, (bf16*)(ws + W_1), scr, r, c.lane); continue; } r -= 2048;
        transpose_item(c.w_fc2() + (size_t)l * 4096 * 1024, 1024, 4096, 1024, 0, nullptr, (bf16*)(ws + W_2), scr, r, c.lane);
    }
}

__device__ __forceinline__ void phase_norm(const Ctx& c, int l, int which, float* lf) {
    if (which == 0) {
        for (int i = c.tid; i < 16384; i += NTHR) { const int k = i >> 4, j = i & 15; lf[j * 1024 + k] = c.w_in()[(size_t)l * 1024 * 4112 + (size_t)k * 4112 + 1280 + j]; }
        __syncthreads();
    }
    const int gw = blockIdx.x * NWAVES + c.wave, NGW = gridDim.x * NWAVES;
    const float* gn = (which == 0 ? c.g_norm1() : c.g_norm2()) + l * 1024;
    for (int m = gw; m < M; m += NGW) {
        const float* xr = (l == 0 && which == 0) ? (m < MC ? c.x_prompt() + (size_t)m * D : c.x_sample() + (size_t)(m - MC) * D) : c.out() + (size_t)m * D;
        const int mi = (m < MC) ? 0 : 1 + ((m - MC) >> 10);
        const float* mod = c.MOD() + (size_t)(l * 5 + mi) * 6144 + which * 3072;
        f32x4 v[4]; float s = 0.f;
#pragma unroll
        for (int j = 0; j < 4; ++j) { v[j] = *(const f32x4*)(xr + 4 * c.lane + 256 * j); s += (v[j].x * v[j].x + v[j].y * v[j].y) + (v[j].z * v[j].z + v[j].w * v[j].w); }
        const float rstd = rsqrtf(wave_sum(s) * (1.0f / D) + EPS);
#pragma unroll
        for (int j = 0; j < 4; ++j) { const int k = 4 * c.lane + 256 * j; const f32x4 g = *(const f32x4*)(gn + k), sh = *(const f32x4*)(mod + k), sc = *(const f32x4*)(mod + 1024 + k);
            v[j] = v[j] * rstd * g * (sc + 1.0f) + sh;
            v2u o; o.x = pk2(v[j].x, v[j].y); o.y = pk2(v[j].z, v[j].w); *(v2u*)(c.H() + (size_t)m * D + k) = o; }
        if (which == 0) {
            float mine = 0.f;
#pragma unroll 1
            for (int jj = 0; jj < 16; ++jj) { float a = 0.f;
#pragma unroll
                for (int j = 0; j < 4; ++j) { const f32x4 w = *(const f32x4*)(lf + jj * 1024 + 4 * c.lane + 256 * j); a += (v[j].x * w.x + v[j].y * w.y) + (v[j].z * w.z + v[j].w * w.w); }
                a = wave_sum(a); if (c.lane == jj) mine = a; }
            if (c.lane < 16) { const float x = mine + c.dt_bias()[l * 16 + c.lane]; c.DT()[(size_t)m * 16 + c.lane] = x > 20.f ? x : log1pf(__expf(x)); }
            if (c.lane == 0) c.SSQ()[m] = 0.f;
        }
    }
}

__device__ __forceinline__ void phase_rope_table(const Ctx& c) {
    const int gt = blockIdx.x * NTHR + c.tid;
    if (gt < 32768) { const int pos = gt >> 5, a = gt & 31, f = a & 15; const float inv = exp2f(-(float)f * 0.8304820237218406f);
        const float ang = (float)((a >> 4) ? (pos & 63) : (pos >> 6)) * inv; float sn, cs; sincosf(ang, &sn, &cs); c.ROPE()[pos * 64 + a] = cs; c.ROPE()[pos * 64 + 32 + a] = sn; }
}
__device__ __forceinline__ void phase_qk(const Ctx& c, int l, float* lf) {
    const int gw = blockIdx.x * NWAVES + c.wave, NGW = gridDim.x * NWAVES, lane = c.lane, l16 = lane & 15, grp = lane >> 4;
    for (int i = c.tid; i < 7 * 768; i += NTHR) lf[i] = c.conv_w()[(size_t)l * 7 * 768 + i];
    for (int i = c.tid; i < 768; i += NTHR) lf[7 * 768 + i] = c.conv_b()[l * 768 + i];
    __syncthreads();
    const f32x4 gq = *(const f32x4*)(c.qn_g() + l * 64 + 4 * l16), gk = *(const f32x4*)(c.kn_g() + l * 64 + 4 * l16), gwq = *(const f32x4*)(c.wqn_g() + l * 64 + 4 * l16), gwk = *(const f32x4*)(c.wkn_g() + l * 64 + 4 * l16);
    bf16* R1p = c.R1(); float* outp = c.out(); bf16* XCp = c.XC();
    for (int m = gw; m < M; m += NGW) {
        bf16* pr = R1p + (size_t)m * 4096;
        const bool lat = m >= MC;
        const int b = lat ? (m - MC) >> 10 : m >> 8, t = lat ? (m - MC) & 1023 : m & 255, L = lat ? 1024 : 256;
        const size_t ob = (size_t)(b * 2 + l) * 256 + t;
        f32x4 cs = {1.f, 1.f, 1.f, 1.f}, sn = {0.f, 0.f, 0.f, 0.f};
        if (lat) { const float* rp = c.ROPE() + t * 64 + (l16 >> 3) * 16 + 4 * (l16 & 3); cs = *(const f32x4*)rp; sn = *(const f32x4*)(rp + 32); if (!((l16 >> 2) & 1)) sn = -sn; }
        v2u raw[7];
#pragma unroll
        for (int ps = 0; ps < 7; ++ps) { const int gi = 4 * ps + grp; const int col = gi < 8 ? C_DQ + gi * 64 : gi < 16 ? C_DK + (gi - 8) * 64 : gi < 24 ? C_WQ + (gi - 16) * 64 : C_WK + (gi - 24) * 64;
            raw[ps] = (gi < 26) ? *(const v2u*)(pr + col + 4 * l16) : (v2u){0u, 0u}; }
        v2u cp[3];
        if (!lat) {
#pragma unroll
            for (int ps = 0; ps < 3; ++ps) { const int gi = 4 * ps + grp; const int col = gi < 8 ? C_DV + gi * 64 : C_WV + (gi - 8) * 64; cp[ps] = (gi < 10) ? *(const v2u*)(pr + col + 4 * l16) : (v2u){0u, 0u}; }
        }
        v2u cx[3][7];
#pragma unroll
        for (int i = 0; i < 3; ++i)
#pragma unroll
            for (int j = 0; j < 7; ++j) { const int tt = t + j - 3; cx[i][j] = (tt >= 0 && tt < L) ? *(const v2u*)(R1p + (size_t)(m + j - 3) * 4096 + C_XBC + 4 * lane + 256 * i) : (v2u){0u, 0u}; }
#pragma unroll
        for (int ps = 0; ps < 7; ++ps) { const int gi = 4 * ps + grp;
            const f32x4 gain = gi < 8 ? gq : gi < 16 ? gk : gi < 24 ? gwq : gwk;
            f32x4 v = {bflo(raw[ps].x), bfhi(raw[ps].x), bflo(raw[ps].y), bfhi(raw[ps].y)};
            float ss = (v.x * v.x + v.y * v.y) + (v.z * v.z + v.w * v.w);
            ss += __shfl_xor(ss, 1); ss += __shfl_xor(ss, 2); ss += __shfl_xor(ss, 4); ss += __shfl_xor(ss, 8);
            v = v * rsqrtf(ss * (1.0f / 64.0f) + EPS) * gain;
            if (lat) { f32x4 p; p.x = __shfl_xor(v.x, 4); p.y = __shfl_xor(v.y, 4); p.z = __shfl_xor(v.z, 4); p.w = __shfl_xor(v.w, 4); v = v * cs + p * sn; }
            if (gi < 26) {
                const int col = gi < 8 ? C_DQ + gi * 64 : gi < 16 ? C_DK + (gi - 8) * 64 : gi < 24 ? C_WQ + (gi - 16) * 64 : C_WK + (gi - 24) * 64;
                v2u o; o.x = pk2(v.x, v.y); o.y = pk2(v.z, v.w); *(v2u*)(pr + col + 4 * l16) = o;
                if (!lat) { if (gi >= 8 && gi < 16) *(f32x4*)(outp + O_DK + ob * 512 + (gi - 8) * 64 + 4 * l16) = v; if (gi >= 24) *(f32x4*)(outp + O_WK + ob * 128 + (gi - 24) * 64 + 4 * l16) = v; }
            }
        }
        if (!lat) {
#pragma unroll
            for (int ps = 0; ps < 3; ++ps) { const int gi = 4 * ps + grp; const f32x4 v = {bflo(cp[ps].x), bfhi(cp[ps].x), bflo(cp[ps].y), bfhi(cp[ps].y)};
                if (gi < 8) *(f32x4*)(outp + O_DV + ob * 512 + gi * 64 + 4 * l16) = v; else if (gi < 10) *(f32x4*)(outp + O_WV + ob * 128 + (gi - 8) * 64 + 4 * l16) = v; }
        }
#pragma unroll
        for (int i = 0; i < 3; ++i) { const int ch = 4 * lane + 256 * i; f32x4 a = *(const f32x4*)(lf + 7 * 768 + ch);
#pragma unroll
            for (int j = 0; j < 7; ++j) { const f32x4 wv = *(const f32x4*)(lf + j * 768 + ch); const f32x4 xv = {bflo(cx[i][j].x), bfhi(cx[i][j].x), bflo(cx[i][j].y), bfhi(cx[i][j].y)}; a += wv * xv; }
            v2u o; o.x = pk2(siluf(a.x), siluf(a.y)); o.y = pk2(siluf(a.z), siluf(a.w)); *(v2u*)(XCp + (size_t)m * 768 + ch) = o; }
    }
    for (int r = gw; r < 1024; r += NGW) { const int b = r >> 8, sidx = r & 255; const size_t cb = (size_t)(b * 2 + l) * 256 + sidx; bf16* dst = c.CKV() + (size_t)r * 1280;
        for (int i = lane; i < 1280; i += 64) { const float v = i < 512 ? c.cache_dk()[cb * 512 + i] : i < 1024 ? c.cache_dv()[cb * 512 + i - 512] : i < 1152 ? c.cache_wk()[cb * 128 + i - 1024] : c.cache_wv()[cb * 128 + i - 1152]; dst[i] = (bf16)f2bf(v); } }
}

typedef pg8::bf16x8 bx8;
#define MFMA16(a, b, cc) __builtin_amdgcn_mfma_f32_16x16x32_bf16((a), (b), (cc), 0, 0, 0)
__device__ __forceinline__ void ssd_unit(const Ctx& c, int l, int pass, int b, int h, unsigned char* lds) {
    const int L = pass ? 1024 : 256, tok0 = pass ? MC + b * 1024 : b * 256, NCH = L >> 7;
    const int tid = c.tid, lane = c.lane, w = c.wave, lr = lane & 15, lq = lane >> 4, grp = h >> 2;
    bf16* XT = (bf16*)lds;
    bf16* BwT = XT + 64 * 136;
    bf16* Bm = BwT + 64 * 136;
    bf16* Cm = Bm + 128 * 72;
    bf16* Mm = Cm + 128 * 72;
    bf16* ST = Mm + 128 * 136;
    float* cum = (float*)(ST + 64 * 72);
    float* dtv = cum + 128; float* wv = dtv + 128; float* ecum = wv + 128; float* tot = ecum + 128;
    const float dsk = c.ssd_d()[l * 8 + h];
    const bf16* XCp = c.XC(); const float* DTp = c.DT(); bf16* Yp = c.Y(); const bf16* R1p = c.R1(); float* SSQp = c.SSQ();
    const int pi = w >> 1, nj0 = 2 * (w & 1);
    for (int dir = 0; dir < 2; ++dir) {
        const float A = -__expf(c.a_log()[(l * 2 + dir) * 8 + h]);
        f32x4 Sacc[2];
        __syncthreads();
#pragma unroll
        for (int q = 0; q < 2; ++q)
#pragma unroll
            for (int r = 0; r < 4; ++r) { const int p = 16 * pi + 4 * lq + r, n = 16 * (nj0 + q) + lr;
                const float v = pass ? c.state_ssd()[(((((size_t)(b * 2 + l) * 2 + dir) * 8 + h) * 64 + p) * 64) + n] : 0.f;
                Sacc[q][r] = v; ST[p * 72 + n] = (bf16)f2bf(v); }
        for (int ci = 0; ci < NCH; ++ci) {
            __syncthreads();
            const int i = tid >> 2, part = tid & 3;
            float bvals[16];
            { const int t = dir ? L - 1 - (ci * 128 + i) : ci * 128 + i; const bf16* xr = XCp + (size_t)(tok0 + t) * 768;
              const v4u x0 = *(const v4u*)(xr + h * 64 + part * 16), x1 = *(const v4u*)(xr + h * 64 + part * 16 + 8);
              const v4u b0 = *(const v4u*)(xr + 512 + grp * 64 + part * 16), b1 = *(const v4u*)(xr + 512 + grp * 64 + part * 16 + 8);
              const v4u c0 = *(const v4u*)(xr + 640 + grp * 64 + part * 16), c1 = *(const v4u*)(xr + 640 + grp * 64 + part * 16 + 8);
              *(v4u*)(Bm + i * 72 + part * 16) = b0; *(v4u*)(Bm + i * 72 + part * 16 + 8) = b1;
              *(v4u*)(Cm + i * 72 + part * 16) = c0; *(v4u*)(Cm + i * 72 + part * 16 + 8) = c1;
              const unsigned xs[8] = {x0.x, x0.y, x0.z, x0.w, x1.x, x1.y, x1.z, x1.w};
#pragma unroll
              for (int j = 0; j < 8; ++j) { XT[(part * 16 + 2 * j) * 136 + i] = (bf16)(xs[j] & 0xffffu); XT[(part * 16 + 2 * j + 1) * 136 + i] = (bf16)(xs[j] >> 16); }
              float t8[8]; unpack8(b0, t8);
#pragma unroll
              for (int j = 0; j < 8; ++j) bvals[j] = t8[j];
              unpack8(b1, t8);
#pragma unroll
              for (int j = 0; j < 8; ++j) bvals[8 + j] = t8[j]; }
            if (tid < 64) {
                const int i0 = 2 * lane, i1 = i0 + 1;
                const int t0 = dir ? L - 1 - (ci * 128 + i0) : ci * 128 + i0, t1 = dir ? L - 1 - (ci * 128 + i1) : ci * 128 + i1;
                const float d0 = DTp[(size_t)(tok0 + t0) * 16 + dir * 8 + h], d1 = DTp[(size_t)(tok0 + t1) * 16 + dir * 8 + h];
                const float a0 = d0 * A, a1 = d1 * A; float s = a0 + a1;
#pragma unroll
                for (int o = 1; o < 64; o <<= 1) { const float v = __shfl_up(s, o); if (lane >= o) s += v; }
                const float cum1 = s, cum0 = s - a1, total = __shfl(s, 63);
                cum[i0] = cum0; cum[i1] = cum1; dtv[i0] = d0; dtv[i1] = d1;
                wv[i0] = __expf(total - cum0) * d0; wv[i1] = __expf(total - cum1) * d1; ecum[i0] = __expf(cum0); ecum[i1] = __expf(cum1);
                if (lane == 0) tot[0] = __expf(total);
            }
            __syncthreads();
            { const float wi = wv[i];
#pragma unroll
              for (int j = 0; j < 16; ++j) BwT[(part * 16 + j) * 136 + i] = (bf16)f2bf(bvals[j] * wi); }
            bx8 cfr[2];
#pragma unroll
            for (int ks = 0; ks < 2; ++ks) cfr[ks] = *(const bx8*)(Cm + (16 * w + lr) * 72 + 32 * ks + 8 * lq);
            for (int j = 0; j <= w; ++j) {
                const bx8 b0 = *(const bx8*)(Bm + (16 * j + lr) * 72 + 8 * lq), b1 = *(const bx8*)(Bm + (16 * j + lr) * 72 + 32 + 8 * lq);
                f32x4 g = {0.f, 0.f, 0.f, 0.f};
                g = MFMA16(cfr[0], b0, g); g = MFMA16(cfr[1], b1, g);
                const int s = 16 * j + lr; const float cs = cum[s], ds = dtv[s];
#pragma unroll
                for (int r = 0; r < 4; ++r) { const int tt = 16 * w + 4 * lq + r; const float v = (s <= tt) ? g[r] * __expf(cum[tt] - cs) * ds : 0.f; Mm[tt * 136 + s] = (bf16)f2bf(v); }
            }
            if (!(w & 1)) {
#pragma unroll
                for (int r = 0; r < 4; ++r) Mm[(16 * w + 4 * lq + r) * 136 + 16 * (w + 1) + lr] = 0;
            }
            __syncthreads();
            f32x4 yl[4], yo[4];
#pragma unroll
            for (int jp = 0; jp < 4; ++jp) { yl[jp] = (f32x4){0.f, 0.f, 0.f, 0.f}; yo[jp] = (f32x4){0.f, 0.f, 0.f, 0.f}; }
            for (int ks = 0; ks <= (w >> 1); ++ks) {
                const bx8 af = *(const bx8*)(Mm + (16 * w + lr) * 136 + 32 * ks + 8 * lq);
#pragma unroll
                for (int jp = 0; jp < 4; ++jp) { const bx8 xf = *(const bx8*)(XT + (16 * jp + lr) * 136 + 32 * ks + 8 * lq); yl[jp] = MFMA16(af, xf, yl[jp]); }
            }
#pragma unroll
            for (int ks = 0; ks < 2; ++ks)
#pragma unroll
                for (int jp = 0; jp < 4; ++jp) { const bx8 sf = *(const bx8*)(ST + (16 * jp + lr) * 72 + 32 * ks + 8 * lq); yo[jp] = MFMA16(cfr[ks], sf, yo[jp]); }
            {
                float ssq[4] = {0.f, 0.f, 0.f, 0.f};
#pragma unroll
                for (int r = 0; r < 4; ++r) {
                    const int tt = 16 * w + 4 * lq + r; const float ec = ecum[tt];
                    const int t = dir ? L - 1 - (ci * 128 + tt) : ci * 128 + tt; const size_t m = (size_t)tok0 + t;
#pragma unroll
                    for (int jp = 0; jp < 4; ++jp) {
                        const int p = 16 * jp + lr; const float y = yl[jp][r] + ec * yo[jp][r];
                        if (dir == 0) Yp[m * 2048 + h * 64 + p] = (bf16)f2bf(y);
                        else { const float x = bf2f(XT[p * 136 + tt]); const float ytot = y + bf2f(Yp[m * 2048 + h * 64 + p]) + dsk * x; const float z = bf2f(R1p[m * 4096 + C_Z + h * 64 + p]);
                            const float gt = ytot * siluf(z); Yp[m * 2048 + h * 64 + p] = (bf16)f2bf(gt); ssq[r] += gt * gt; }
                    }
                    if (dir == 1) { float q = ssq[r]; q += __shfl_xor(q, 1); q += __shfl_xor(q, 2); q += __shfl_xor(q, 4); q += __shfl_xor(q, 8); if (lr == 0) atomicAdd(SSQp + m, q); }
                }
            }
            __syncthreads();
            {
                f32x4 st[2] = {{0.f, 0.f, 0.f, 0.f}, {0.f, 0.f, 0.f, 0.f}};
#pragma unroll
                for (int ks = 0; ks < 4; ++ks) { const bx8 af = *(const bx8*)(XT + (16 * pi + lr) * 136 + 32 * ks + 8 * lq);
#pragma unroll
                    for (int q = 0; q < 2; ++q) { const bx8 bf = *(const bx8*)(BwT + (16 * (nj0 + q) + lr) * 136 + 32 * ks + 8 * lq); st[q] = MFMA16(af, bf, st[q]); } }
                const float et = tot[0];
#pragma unroll
                for (int q = 0; q < 2; ++q)
#pragma unroll
                    for (int r = 0; r < 4; ++r) { Sacc[q][r] = et * Sacc[q][r] + st[q][r]; ST[(16 * pi + 4 * lq + r) * 72 + 16 * (nj0 + q) + lr] = (bf16)f2bf(Sacc[q][r]); }
            }
        }
        if (!pass) {
#pragma unroll
            for (int q = 0; q < 2; ++q)
#pragma unroll
                for (int r = 0; r < 4; ++r) { const int p = 16 * pi + 4 * lq + r, n = 16 * (nj0 + q) + lr;
                    c.out()[O_SSD + (((((size_t)(b * 2 + l) * 2 + dir) * 8 + h) * 64 + p) * 64) + n] = Sacc[q][r]; }
        }
    }
}

__device__ __forceinline__ void s5_tables(const Ctx& c, int l, int g, float* lf) {
    const int tid = c.tid;
    float* pw = lf;
    float* Bc = pw + 2 * 17 * 128;
    float* Cc = Bc + 2 * 2048;
    if (tid < 128) { const int dir = tid >> 6, n = tid & 63, idx = ((l * 2 + dir) * 32 + g) * 64 + n;
        const float lre = c.lam_re()[idx], lim = c.lam_im()[idx], step = expf(c.log_step()[(l * 2 + dir) * 32 + g]);
        for (int k = 0; k <= 16; ++k) { const float mag = expf(lre * step * (float)k); float sn, cs; sincosf(lim * step * (float)k, &sn, &cs); pw[((dir * 17 + k) * 64 + n) * 2] = mag * cs; pw[((dir * 17 + k) * 64 + n) * 2 + 1] = mag * sn; }
        const float mag = expf(lre * step); float sn, cs; sincosf(lim * step, &sn, &cs); const float are = mag * cs, aim = mag * sn;
        const float den = lre * lre + lim * lim, cre = ((are - 1.0f) * lre + aim * lim) / den, cim = (aim * lre - (are - 1.0f) * lim) / den;
        for (int mm = 0; mm < 16; ++mm) { const float br = c.b_re()[(size_t)idx * 16 + mm], bi = c.b_im()[(size_t)idx * 16 + mm]; Bc[((dir * 64 + n) * 16 + mm) * 2] = cre * br - cim * bi; Bc[((dir * 64 + n) * 16 + mm) * 2 + 1] = cre * bi + cim * br; }
    }
    for (int i = tid; i < 2048; i += NTHR) { const int dir = i >> 10, mm = (i >> 6) & 15, n = i & 63; const size_t src = ((size_t)((l * 2 + dir) * 32 + g) * 16 + mm) * 64 + n;
        Cc[i * 2] = c.c_re()[src]; Cc[i * 2 + 1] = c.c_im()[src]; }
    __syncthreads();
    if (tid < 128) { const int dir = tid >> 6, n = tid & 63; float* at = (float*)(c.ws() + WS_S5AT) + ((size_t)(dir * 32 + g) * 64 + n) * 2; at[0] = pw[((dir * 17 + 16) * 64 + n) * 2]; at[1] = pw[((dir * 17 + 16) * 64 + n) * 2 + 1]; }
    bf16* Kt = (bf16*)(c.ws() + WS_S5K) + (size_t)g * 31 * 256;
    for (int e = tid; e < 31 * 256; e += NTHR) { const int tp = e >> 8, mm = (e >> 4) & 15, m2 = e & 15, tau = tp - 15; float acc = 0.f;
#pragma unroll
        for (int dir = 0; dir < 2; ++dir) { if ((dir == 0 && tau < 0) || (dir == 1 && tau > 0)) continue; const int k = tau < 0 ? -tau : tau;
            const float* pp = pw + (dir * 17 + k) * 128; const float* bb = Bc + dir * 2048 + m2 * 2; const float* cc = Cc + (dir * 16 + mm) * 128;
            for (int n = 0; n < 64; ++n) { const float pr = pp[2 * n], pi = pp[2 * n + 1], br = bb[n * 32], bi = bb[n * 32 + 1], Pr = pr * br - pi * bi, Pi = pr * bi + pi * br; acc += cc[2 * n] * Pr - cc[2 * n + 1] * Pi; } }
        if (tau == 0 && mm == m2) acc += c.s5_d()[l * 512 + g * 16 + mm];
        Kt[e] = (bf16)f2bf(acc); }
    for (int e = tid; e < 2 * 128 * 256; e += NTHR) { const int dir = e >> 15, sidx = (e >> 8) & 127, k = e & 255, ri = sidx >> 6, n = sidx & 63, j = k >> 4, m2 = k & 15, ex = dir ? j : 15 - j;
        const float pr = pw[((dir * 17 + ex) * 64 + n) * 2], pi = pw[((dir * 17 + ex) * 64 + n) * 2 + 1], br = Bc[((dir * 64 + n) * 16 + m2) * 2], bi = Bc[((dir * 64 + n) * 16 + m2) * 2 + 1];
        ((bf16*)(c.ws() + WS_S5WS))[((size_t)(dir * 32 + g) * 128 + sidx) * 256 + k] = (bf16)f2bf(ri ? pr * bi + pi * br : pr * br - pi * bi); }
    for (int e = tid; e < 256 * 256; e += NTHR) { const int row = e >> 8, k = e & 255, i = row >> 4, mm = row & 15, dir = k >> 7, ri = (k >> 6) & 1, n = k & 63, ex = dir ? 16 - i : i + 1;
        const float pr = pw[((dir * 17 + ex) * 64 + n) * 2], pi = pw[((dir * 17 + ex) * 64 + n) * 2 + 1], cr = Cc[((dir * 16 + mm) * 64 + n) * 2], ci = Cc[((dir * 16 + mm) * 64 + n) * 2 + 1];
        ((bf16*)(c.ws() + WS_S5WO))[(size_t)g * 65536 + e] = (bf16)f2bf(ri ? -(cr * pi + ci * pr) : cr * pr - ci * pi); }
    __syncthreads();
}

__device__ __forceinline__ void s5_unit(const Ctx& c, int l, int g, int cu, unsigned char* lds) {
    const int tid = c.tid, lane = c.lane, w = c.wave, lr = lane & 15, lq = lane >> 4;
    const bool lat = cu >= 8;
    bf16* Ut = (bf16*)lds;
    bf16* St = Ut + 64 * 264;
    bf16* Kt = St + 64 * 264;
    float* Dl = (float*)(Kt + 31 * 256);
    const bf16* R1p = c.R1();
    { const v4u* src = (const v4u*)((const bf16*)(c.ws() + WS_S5K) + (size_t)g * 31 * 256); for (int i = tid; i < 31 * 32; i += NTHR) ((v4u*)Kt)[i] = src[i]; }
#pragma unroll
    for (int i = 0; i < 2; ++i) { const int id = tid + NTHR * i, col = id >> 4, j = id & 15;
        const int tok = lat ? MC + (cu - 8) * 1024 + col * 16 + j : (4 * cu + (col >> 4)) * 256 + (col & 15) * 16 + j;
        const bf16* up = R1p + (size_t)tok * 4096 + C_U + g * 16;
        *(v4u*)(Ut + col * 264 + j * 16) = *(const v4u*)up; *(v4u*)(Ut + col * 264 + j * 16 + 8) = *(const v4u*)(up + 8); }
    __syncthreads();
    for (int dir = 0; dir < 2; ++dir) {
        const bf16* Wsp = (const bf16*)(c.ws() + WS_S5WS) + ((size_t)(dir * 32 + g) * 128 + 16 * w + lr) * 256 + 8 * lq;
        f32x4 acc[4];
#pragma unroll
        for (int cb = 0; cb < 4; ++cb) acc[cb] = (f32x4){0.f, 0.f, 0.f, 0.f};
        bx8 afr[8];
#pragma unroll
        for (int ks = 0; ks < 8; ++ks) afr[ks] = *(const bx8*)(Wsp + 32 * ks);
#pragma unroll
        for (int ks = 0; ks < 8; ++ks) {
#pragma unroll
            for (int cb = 0; cb < 4; ++cb) { const bx8 bf = *(const bx8*)(Ut + (16 * cb + lr) * 264 + 32 * ks + 8 * lq); acc[cb] = MFMA16(afr[ks], bf, acc[cb]); }
            __builtin_amdgcn_sched_barrier(0); }
#pragma unroll
        for (int cb = 0; cb < 4; ++cb)
#pragma unroll
            for (int r = 0; r < 4; ++r) Dl[(16 * w + 4 * lq + r) * 65 + 16 * cb + lr] = acc[cb][r];
        __syncthreads();
        if (tid < (lat ? 64 : 256)) {
            const int n = tid & 63, bl = tid >> 6, nc = lat ? 64 : 16, cbase = lat ? 0 : 16 * bl, b = lat ? cu - 8 : 4 * cu + bl;
            const float* at = (const float*)(c.ws() + WS_S5AT) + ((size_t)(dir * 32 + g) * 64 + n) * 2; const float ar = at[0], ai = at[1];
            float sr = 0.f, si = 0.f;
            if (lat) { sr = c.state_s5()[((((size_t)(b * 2 + l) * 2 + dir) * 2 + 0) * 32 + g) * 64 + n]; si = c.state_s5()[((((size_t)(b * 2 + l) * 2 + dir) * 2 + 1) * 32 + g) * 64 + n]; }
            for (int cc = 0; cc < nc; ++cc) { const int col = cbase + (dir ? nc - 1 - cc : cc);
                St[col * 264 + dir * 128 + n] = (bf16)f2bf(sr); St[col * 264 + dir * 128 + 64 + n] = (bf16)f2bf(si);
                const float dr = Dl[n * 65 + col], di = Dl[(64 + n) * 65 + col];
                const float nr = ar * sr - ai * si + dr, ni = ar * si + ai * sr + di; sr = nr; si = ni; }
            if (!lat) { c.out()[O_S5 + ((((size_t)(b * 2 + l) * 2 + dir) * 2 + 0) * 32 + g) * 64 + n] = sr; c.out()[O_S5 + ((((size_t)(b * 2 + l) * 2 + dir) * 2 + 1) * 32 + g) * 64 + n] = si; }
        }
        __syncthreads();
    }
    const bf16* Wop = (const bf16*)(c.ws() + WS_S5WO) + (size_t)g * 65536 + 8 * lq;
#pragma unroll 1
    for (int ii = 0; ii < 2; ++ii) { const int i = 2 * w + ii;
        f32x4 acc[4];
#pragma unroll
        for (int cb = 0; cb < 4; ++cb) acc[cb] = (f32x4){0.f, 0.f, 0.f, 0.f};
        bx8 afr[8];
#pragma unroll
        for (int ks = 0; ks < 8; ++ks) afr[ks] = *(const bx8*)(Wop + (size_t)(16 * i + lr) * 256 + 32 * ks);
#pragma unroll
        for (int ks = 0; ks < 8; ++ks) { const int j = 2 * ks + (lq >> 1); const bx8 af = *(const bx8*)(Kt + ((i - j + 15) * 16 + lr) * 16 + 8 * (lq & 1));
#pragma unroll
            for (int cb = 0; cb < 4; ++cb) { const bx8 bf = *(const bx8*)(Ut + (16 * cb + lr) * 264 + 32 * ks + 8 * lq); acc[cb] = MFMA16(af, bf, acc[cb]); }
            __builtin_amdgcn_sched_barrier(0); }
#pragma unroll
        for (int ks = 0; ks < 8; ++ks) {
#pragma unroll
            for (int cb = 0; cb < 4; ++cb) { const bx8 bf = *(const bx8*)(St + (16 * cb + lr) * 264 + 32 * ks + 8 * lq); acc[cb] = MFMA16(afr[ks], bf, acc[cb]); }
            __builtin_amdgcn_sched_barrier(0); }
#pragma unroll
        for (int cb = 0; cb < 4; ++cb) { const int col = 16 * cb + lr;
            const int tok = lat ? MC + (cu - 8) * 1024 + col * 16 + i : (4 * cu + (col >> 4)) * 256 + (col & 15) * 16 + i;
            v2u o; o.x = pk2(acc[cb][0], acc[cb][1]); o.y = pk2(acc[cb][2], acc[cb][3]);
            *(v2u*)(c.Y5() + (size_t)tok * 512 + g * 16 + 4 * lq) = o; }
    }
}

typedef float f32x16 __attribute__((ext_vector_type(16)));
#define MFMA32(a, b, cc) __builtin_amdgcn_mfma_f32_32x32x16_bf16((a), (b), (cc), 0, 0, 0)
constexpr float SM_SC = 0.125f * 1.4426950408889634f;
__device__ __forceinline__ void qk_tile(f32x16& p0, f32x16& p1, const bf16* Kt, int KS, const bx8 (&qf)[4], int r32, int hi) {
    p0 = (f32x16){0.f}; p1 = (f32x16){0.f};
#pragma unroll
    for (int d0 = 0; d0 < 4; ++d0) { const bx8 a0 = *(const bx8*)(Kt + r32 * KS + 16 * d0 + 8 * hi), a1 = *(const bx8*)(Kt + (32 + r32) * KS + 16 * d0 + 8 * hi);
        p0 = MFMA32(a0, qf[d0], p0); p1 = MFMA32(a1, qf[d0], p1); }
}
__device__ __forceinline__ float sm_step(f32x16& p0, f32x16& p1, float& mrun, float& lrun, bx8 (&pb)[4]) {
    float tm = -3e38f;
#pragma unroll
    for (int r = 0; r < 16; ++r) tm = fmaxf(tm, fmaxf(p0[r], p1[r]));
    tm = fmaxf(tm, __shfl_xor(tm, 32));
    const float mn = fmaxf(mrun, tm), alpha = exp2f(mrun - mn);
    float rs = 0.f;
#pragma unroll
    for (int r = 0; r < 16; ++r) { p0[r] = exp2f(p0[r] - mn); p1[r] = exp2f(p1[r] - mn); rs += p0[r] + p1[r]; }
    rs += __shfl_xor(rs, 32);
    lrun = lrun * alpha + rs; mrun = mn;
#pragma unroll
    for (int sI = 0; sI < 2; ++sI) {
        v4u t0, t1;
        t0.x = pg8::cvt_pk_bf16(p0[8 * sI + 0], p0[8 * sI + 1]); t0.y = pg8::cvt_pk_bf16(p0[8 * sI + 2], p0[8 * sI + 3]); t0.z = pg8::cvt_pk_bf16(p0[8 * sI + 4], p0[8 * sI + 5]); t0.w = pg8::cvt_pk_bf16(p0[8 * sI + 6], p0[8 * sI + 7]);
        t1.x = pg8::cvt_pk_bf16(p1[8 * sI + 0], p1[8 * sI + 1]); t1.y = pg8::cvt_pk_bf16(p1[8 * sI + 2], p1[8 * sI + 3]); t1.z = pg8::cvt_pk_bf16(p1[8 * sI + 4], p1[8 * sI + 5]); t1.w = pg8::cvt_pk_bf16(p1[8 * sI + 6], p1[8 * sI + 7]);
        pb[sI] = __builtin_bit_cast(bx8, t0); pb[2 + sI] = __builtin_bit_cast(bx8, t1);
    }
    return alpha;
}
template <int NDT> __device__ __forceinline__ void pv_tile(f32x16 (&o)[NDT], const bf16* Vt, const bx8 (&pb)[4], int r32, int hi) {
#pragma unroll
    for (int ks = 0; ks < 4; ++ks) {
#pragma unroll
        for (int dt = 0; dt < NDT; ++dt) { const bf16* vp = Vt + (32 * dt + r32) * 68 + 16 * ks + 4 * hi;
            const v2u lo = *(const v2u*)vp, h8 = *(const v2u*)(vp + 8); const v4u t = {lo.x, lo.y, h8.x, h8.y};
            o[dt] = MFMA32(__builtin_bit_cast(bx8, t), pb[ks], o[dt]); }
        __builtin_amdgcn_sched_barrier(0); }
}

template <int PASS> __device__ __forceinline__ void diff_unit(const Ctx& c, int l, int uidx, unsigned char* lds) {
    constexpr int NT = PASS ? 20 : 4, NQB = PASS ? 8 : 2;
    const int tid = c.tid, lane = c.lane, w = c.wave, r32 = lane & 31, hi = lane >> 5, comp = w >> 2;
    const int qb = uidx % NQB, h = (uidx / NQB) & 3, b = uidx / (NQB * 4);
    const int tok0 = PASS ? MC + b * 1024 : b * 256;
    bf16* Kt = (bf16*)lds;
    bf16* Vt = Kt + 64 * 136;
    float* Ob = (float*)(Vt + 128 * 68);
    const bf16* R1p = c.R1(); const bf16* CK = c.CKV();
    const float lam_init = 0.8f - 0.6f * expf(-0.3f * (float)l);
    const float* lv = c.dlam() + l * 256;
    const float lam = expf(wave_sum(lv[lane] * lv[64 + lane])) - expf(wave_sum(lv[128 + lane] * lv[192 + lane])) + lam_init;
    const size_t mrow = (size_t)tok0 + qb * 128 + 32 * (w & 3) + r32;
    bx8 qf[4];
#pragma unroll
    for (int d0 = 0; d0 < 4; ++d0) qf[d0] = *(const bx8*)(R1p + mrow * 4096 + C_DQ + h * 128 + comp * 64 + 16 * d0 + 8 * hi);
    f32x16 o[4];
#pragma unroll
    for (int dt = 0; dt < 4; ++dt) o[dt] = (f32x16){0.f};
    float mrun = -1e30f, lrun = 0.f;
    v4u kreg[2], vreg[2];
#define DIFF_LOAD(t) { const bf16* kb; const bf16* vb; size_t rs; \
        if (PASS && (t) < 4) { kb = CK + ((size_t)b * 256 + 64 * (t)) * 1280 + h * 128; vb = kb + 512; rs = 1280; } \
        else { kb = R1p + ((size_t)tok0 + 64 * ((t) - (PASS ? 4 : 0))) * 4096 + C_DK + h * 128; vb = kb + (C_DV - C_DK); rs = 4096; } \
        _Pragma("unroll") for (int i = 0; i < 2; ++i) { kreg[i] = *(const v4u*)(kb + (size_t)lane * rs + (w + 8 * i) * 8); vreg[i] = *(const v4u*)(vb + (size_t)lane * rs + (w + 8 * i) * 8); } }
    DIFF_LOAD(0);
    for (int t = 0; t < NT; ++t) {
        __syncthreads();
#pragma unroll
        for (int i = 0; i < 2; ++i) { *(v4u*)(Kt + lane * 136 + (w + 8 * i) * 8) = kreg[i];
            const unsigned vs[4] = {vreg[i].x, vreg[i].y, vreg[i].z, vreg[i].w};
#pragma unroll
            for (int j = 0; j < 4; ++j) { Vt[((w + 8 * i) * 8 + 2 * j) * 68 + lane] = (bf16)(vs[j] & 0xffffu); Vt[((w + 8 * i) * 8 + 2 * j + 1) * 68 + lane] = (bf16)(vs[j] >> 16); } }
        if (t + 1 < NT) DIFF_LOAD(t + 1);
        __syncthreads();
        f32x16 p0, p1; bx8 pb[4];
        qk_tile(p0, p1, Kt + comp * 64, 136, qf, r32, hi);
#pragma unroll
        for (int r = 0; r < 16; ++r) { p0[r] *= SM_SC; p1[r] *= SM_SC; }
        const float alpha = sm_step(p0, p1, mrun, lrun, pb);
#pragma unroll
        for (int dt = 0; dt < 4; ++dt)
#pragma unroll
            for (int r = 0; r < 16; ++r) o[dt][r] *= alpha;
        pv_tile<4>(o, Vt, pb, r32, hi);
    }
#undef DIFF_LOAD
    const float inv = (comp ? lam : 1.0f) / lrun;
    const int rowl = 32 * (w & 3) + r32;
    if (comp) {
#pragma unroll
        for (int dt = 0; dt < 4; ++dt)
#pragma unroll
            for (int r = 0; r < 16; ++r) Ob[rowl * 129 + 32 * dt + (r & 3) + 8 * (r >> 2) + 4 * hi] = o[dt][r] * inv;
    }
    __syncthreads();
    if (!comp) {
        float ss = 0.f;
#pragma unroll
        for (int dt = 0; dt < 4; ++dt)
#pragma unroll
            for (int r = 0; r < 16; ++r) { const float v = o[dt][r] * inv - Ob[rowl * 129 + 32 * dt + (r & 3) + 8 * (r >> 2) + 4 * hi]; o[dt][r] = v; ss += v * v; }
        ss += __shfl_xor(ss, 32);
        const float rn = rsqrtf(ss * (1.0f / 128.0f) + EPS) * (1.0f - lam_init);
        const float* sg = c.subln_g() + l * 128; bf16* yp = c.Y() + mrow * 2048 + 1024 + h * 128;
#pragma unroll
        for (int dt = 0; dt < 4; ++dt)
#pragma unroll
            for (int r4 = 0; r4 < 4; ++r4) { const int dv = 32 * dt + 8 * r4 + 4 * hi; const f32x4 g = *(const f32x4*)(sg + dv);
                v2u ov; ov.x = pk2(o[dt][4 * r4 + 0] * rn * g.x, o[dt][4 * r4 + 1] * rn * g.y); ov.y = pk2(o[dt][4 * r4 + 2] * rn * g.z, o[dt][4 * r4 + 3] * rn * g.w);
                *(v2u*)(yp + dv) = ov; }
    }
}

template <int PASS> __device__ __forceinline__ void win_unit(const Ctx& c, int l, int uidx, unsigned char* lds) {
    constexpr int NQB = PASS ? 4 : 1;
    const int tid = c.tid, lane = c.lane, w = c.wave, r32 = lane & 31, hi = lane >> 5;
    const int qb = uidx % NQB, hh = (uidx / NQB) & 7, b = uidx / (NQB * 8), nkv = hh >> 2;
    const int tok0 = PASS ? MC + b * 1024 : b * 256;
    bf16* Kt = (bf16*)lds;
    bf16* Vt = Kt + 64 * 72;
    const bf16* R1p = c.R1(); const bf16* CK = c.CKV();
    const int qrow = qb * 256 + 32 * w + r32;
    const size_t mrow = (size_t)tok0 + qrow;
    bx8 qf[4];
#pragma unroll
    for (int d0 = 0; d0 < 4; ++d0) qf[d0] = *(const bx8*)(R1p + mrow * 4096 + C_WQ + hh * 64 + 16 * d0 + 8 * hi);
    f32x16 o[2]; o[0] = (f32x16){0.f}; o[1] = (f32x16){0.f};
    float mrun = c.sink()[l * 8 + hh] * 1.4426950408889634f, lrun = 1.0f;
    const int q0 = qb * 256;
    const int tb0 = PASS ? ((q0 - 128 < 0 ? 0 : q0 - 128) >> 6) : 0, tb1 = PASS ? ((q0 + 255 + 128 > 1023 ? 1023 : q0 + 255 + 128) >> 6) : 0;
    const int NT = PASS ? 4 + (tb1 - tb0 + 1) : 4;
    const int kvl = tid & 63, chunk = tid >> 6;
    v4u kreg, vreg;
#define WIN_LOAD(t) { const bf16* kb; const bf16* vb; size_t rs; \
        if (PASS && (t) < 4) { kb = CK + ((size_t)b * 256 + 64 * (t)) * 1280 + 1024 + nkv * 64; vb = kb + 128; rs = 1280; } \
        else { kb = R1p + ((size_t)tok0 + 64 * (PASS ? tb0 + (t) - 4 : (t))) * 4096 + C_WK + nkv * 64; vb = kb + (C_WV - C_WK); rs = 4096; } \
        kreg = *(const v4u*)(kb + (size_t)kvl * rs + chunk * 8); vreg = *(const v4u*)(vb + (size_t)kvl * rs + chunk * 8); }
    WIN_LOAD(0);
    for (int t = 0; t < NT; ++t) {
        __syncthreads();
        *(v4u*)(Kt + kvl * 72 + chunk * 8) = kreg;
        { const unsigned vs[4] = {vreg.x, vreg.y, vreg.z, vreg.w};
#pragma unroll
          for (int j = 0; j < 4; ++j) { Vt[(chunk * 8 + 2 * j) * 68 + kvl] = (bf16)(vs[j] & 0xffffu); Vt[(chunk * 8 + 2 * j + 1) * 68 + kvl] = (bf16)(vs[j] >> 16); } }
        if (t + 1 < NT) WIN_LOAD(t + 1);
        __syncthreads();
        bool band = false; int kp0 = 0;
        if (PASS && t >= 4) { band = true; kp0 = 64 * (tb0 + t - 4); const int r0 = q0 + 32 * w;
            if (kp0 + 63 < r0 - 128 || kp0 > r0 + 31 + 128) continue; }
        f32x16 p0, p1; bx8 pb[4];
        qk_tile(p0, p1, Kt, 72, qf, r32, hi);
#pragma unroll
        for (int r = 0; r < 16; ++r) { p0[r] *= SM_SC; p1[r] *= SM_SC; }
        if (band) {
#pragma unroll
            for (int r = 0; r < 16; ++r) { const int kp = kp0 + (r & 3) + 8 * (r >> 2) + 4 * hi; const int d0 = qrow - kp, d1 = d0 - 32;
                if (d0 > 128 || d0 < -128) p0[r] = -1e30f; if (d1 > 128 || d1 < -128) p1[r] = -1e30f; }
        }
        const float alpha = sm_step(p0, p1, mrun, lrun, pb);
#pragma unroll
        for (int dt = 0; dt < 2; ++dt)
#pragma unroll
            for (int r = 0; r < 16; ++r) o[dt][r] *= alpha;
        pv_tile<2>(o, Vt, pb, r32, hi);
    }
#undef WIN_LOAD
    const float inv = 1.0f / lrun; bf16* yp = c.Y() + mrow * 2048 + 1536 + hh * 64;
#pragma unroll
    for (int dt = 0; dt < 2; ++dt)
#pragma unroll
        for (int r4 = 0; r4 < 4; ++r4) { const int dv = 32 * dt + 8 * r4 + 4 * hi;
            v2u ov; ov.x = pk2(o[dt][4 * r4 + 0] * inv, o[dt][4 * r4 + 1] * inv); ov.y = pk2(o[dt][4 * r4 + 2] * inv, o[dt][4 * r4 + 3] * inv);
            *(v2u*)(yp + dv) = ov; }
}

__device__ __forceinline__ void phase_mixers(const Ctx& c_in, int l, float* lf) {
    unsigned char* lds = (unsigned char*)lf;
    unsigned* qctr = (unsigned*)(c_in.ws() + WS_QCTR) + 64 * l;
    volatile int* qslot = (volatile int*)(lds + LDS_BYTES - 32);
    for (;;) {
        __syncthreads();
        if (threadIdx.x == 0) *qslot = (int)atomicAdd(qctr, 1u);
        __syncthreads();
        const int u = __builtin_amdgcn_readfirstlane(*qslot);
        if (u >= 1440) break;
        Ctx c = c_in; asm volatile("" : "+s"(c.ap), "+v"(c.tid));
        c.lane = c.tid & 63; c.wave = __builtin_amdgcn_readfirstlane(c.tid >> 6);
        unsigned long long pt0 = 0; if (PROBE_SEL >= 0) pt0 = __builtin_amdgcn_s_memrealtime();
        int ty;
        if (u < 32) { ssd_unit(c, l, 1, u >> 3, u & 7, lds); ty = 0; }
        else if (u < 160) { diff_unit<1>(c, l, u - 32, lds); ty = 2; }
        else if (u < 288) { win_unit<1>(c, l, u - 160, lds); ty = 3; }
        else if (u < 416) { s5_unit(c, l, (u - 288) & 31, 8 + ((u - 288) >> 5), lds); ty = 1; }
        else if (u < 672) { ssd_unit(c, l, 0, (u - 416) >> 3, (u - 416) & 7, lds); ty = 4; }
        else if (u < 928) { diff_unit<0>(c, l, u - 672, lds); ty = 6; }
        else if (u < 1184) { win_unit<0>(c, l, u - 928, lds); ty = 7; }
        else { s5_unit(c, l, (u - 1184) & 31, (u - 1184) >> 5, lds); ty = 5; }
        __syncthreads();
        if (PROBE_SEL >= 0 && blockIdx.x == PROBE_PB && threadIdx.x == 0) { unsigned long long* tsu = (unsigned long long*)(c.ws() + WS_TS) + 64; tsu[ty] += __builtin_amdgcn_s_memrealtime() - pt0; }
    }
}

__device__ __forceinline__ void phase_sum4(const Ctx& c) {
    const int gt = blockIdx.x * NTHR + c.tid, NT = gridDim.x * NTHR;
#pragma unroll 4
    for (int i = gt; i < M * 128; i += NT) { const size_t m = (size_t)(i >> 7); const int c8 = (i & 127) * 8;
        float a[8] = {0.f, 0.f, 0.f, 0.f, 0.f, 0.f, 0.f, 0.f};
#pragma unroll
        for (int j = 0; j < 4; ++j) { float f[8]; unpack8(*(const v4u*)(c.R1() + m * 4096 + j * 1024 + c8), f);
#pragma unroll
            for (int k = 0; k < 8; ++k) a[k] += f[k]; }
        v4u o; o.x = pk2(a[0], a[1]); o.y = pk2(a[2], a[3]); o.z = pk2(a[4], a[5]); o.w = pk2(a[6], a[7]);
        *(v4u*)(c.H() + m * 1024 + c8) = o; }
}

#define GAS __attribute__((address_space(1)))
#define XB_TMO      128
#define XB_XCNT(j)  (256  + 64 * (j))
#define XB_XSUB(j)  (1280 + 64 * (j))
#define XB_XGEN(j)  (2304 + 64 * (j))
#define XB_TOP      3328
#define XB_TOPGEN   3392
#define XCD_BAR_WORDS 3456
#define XB_SPIN_CAP (1u << 18)

__device__ __forceinline__ unsigned xb_ld(unsigned* p)              { return __hip_atomic_load(p, __ATOMIC_RELAXED, __HIP_MEMORY_SCOPE_AGENT); }
__device__ __forceinline__ unsigned xb_add(unsigned* p, unsigned v) { return __hip_atomic_fetch_add(p, v, __ATOMIC_RELAXED, __HIP_MEMORY_SCOPE_AGENT); }
__device__ __forceinline__ unsigned xb_xcc_id() { return (unsigned)__builtin_amdgcn_s_getreg((3 << 11) | 20) & 0xFu; }
#define XB_SPIN(cond, bar) do { unsigned _sp = 0; while (cond) { __builtin_amdgcn_s_sleep(1); \
    if ((++_sp & 255u) == 0u) { if (xb_ld(&(bar)[XB_TMO])) break; if (_sp > XB_SPIN_CAP) { atomicAdd(&(bar)[XB_TMO], 1u); break; } } } } while (0)

struct XcdBarrier {
    unsigned* bar; unsigned x;
    volatile LAS unsigned* st;
};

__device__ __forceinline__ XcdBarrier xcd_barrier_post(unsigned* bar, volatile LAS unsigned* st) {
    XcdBarrier b; b.bar = bar; b.x = xb_xcc_id(); b.st = st;
    if (threadIdx.x == 0) (void)xb_add(&bar[XB_XCNT(b.x)], 1u);
    return b;
}
__device__ __forceinline__ void xcd_barrier_complete(unsigned* bar, unsigned x, unsigned& nloc, unsigned& nx) {
    const unsigned G = gridDim.x * gridDim.y * gridDim.z;
    unsigned sum, cnt, mine, sp = 0u;
    for (;;) {
        sum = 0u; cnt = 0u; mine = 0u;
#pragma unroll
        for (unsigned j = 0; j < 16; ++j) { const unsigned c = xb_ld(&bar[XB_XCNT(j)]); sum += c; cnt += (c > 0u) ? 1u : 0u; mine = (j == x) ? c : mine; }
        if (sum == G) break;
        __builtin_amdgcn_s_sleep(1);
        if ((++sp & 255u) == 0u) { if (xb_ld(&bar[XB_TMO])) break; if (sp > XB_SPIN_CAP) { atomicAdd(&bar[XB_TMO], 1u); break; } }
    }
    nloc = mine > 0u ? mine : 1u; nx = cnt > 0u ? cnt : 1u;
}

__device__ __forceinline__ void xcd_barrier(const XcdBarrier& b) {
    asm volatile("s_waitcnt vmcnt(0)" ::: "memory");
    __syncthreads();
    if (threadIdx.x == 0) {
        unsigned* bar = b.bar;
        __builtin_amdgcn_s_waitcnt(0);
        unsigned nloc = b.st[0], nx = b.st[1];
        if (nloc == 0u) { xcd_barrier_complete(bar, b.x, nloc, nx); b.st[0] = nloc; b.st[1] = nx; }
        const unsigned old = xb_add(&bar[XB_XSUB(b.x)], 1u);
        const unsigned gen = old / nloc;
        if (old + 1u == (gen + 1u) * nloc) {
            __builtin_amdgcn_fence(__ATOMIC_RELEASE, "agent");
            asm volatile("s_waitcnt vmcnt(0)" ::: "memory");
            const unsigned og = xb_add(&bar[XB_TOP], 1u);
            const unsigned tg = og / nx;
            if (og + 1u == (tg + 1u) * nx) xb_add(&bar[XB_TOPGEN], 1u);
            else XB_SPIN(xb_ld(&bar[XB_TOPGEN]) == tg, bar);
            __builtin_amdgcn_fence(__ATOMIC_ACQUIRE, "agent");
            xb_add(&bar[XB_XGEN(b.x)], 1u);
            asm volatile("s_waitcnt vmcnt(0)" ::: "memory");
        } else {
            XB_SPIN(xb_ld(&bar[XB_XGEN(b.x)]) == gen, bar);
            __builtin_amdgcn_fence(__ATOMIC_ACQUIRE, "agent");
            asm volatile("s_waitcnt vmcnt(0)" ::: "memory");
        }
    }
    __syncthreads();
}

#define PHASE_BEGIN() Ctx c; c.ap = (CArgs)__builtin_amdgcn_kernarg_segment_ptr(); asm volatile("" : "+s"(c.ap)); \
        int tid_o = threadIdx.x; asm volatile("" : "+v"(tid_o)); c.tid = tid_o; c.lane = tid_o & 63; c.wave = __builtin_amdgcn_readfirstlane(tid_o >> 6); \
        int G = gridDim.x, bid = blockIdx.x; asm volatile("" : "+s"(G), "+s"(bid)); unsigned char* ws = c.ws(); (void)ws; (void)G; (void)bid;
#define PHASE_END(k) { if ((k) + 1 < ph_hi) { if ((k) == 0) cg::this_grid().sync(); else xcd_barrier(xbar); } \
        if (PROBE_SEL >= 0 && blockIdx.x == PROBE_PB && threadIdx.x == 0) ((unsigned long long*)(c.ws() + WS_TS))[(k) + 1] = __builtin_amdgcn_s_memrealtime(); }
#define IN_RANGE(k) (ph_lo <= (k) && (k) < ph_hi)

template <int LAYER> __device__ __forceinline__ void layer_program(int ph_lo, int ph_hi, unsigned char* lds, const XcdBarrier& xbar) {
    float* lf = (float*)lds;
    PG8_LAS unsigned char* ring = (PG8_LAS unsigned char*)lds;
    constexpr int l = LAYER, B0 = 1 + 11 * LAYER;
    if (IN_RANGE(B0 + 0)) { PHASE_BEGIN(); if (l == 1) { phase_convert(c, 1, lf); __syncthreads(); } phase_norm(c, l, 0, lf); PHASE_END(B0 + 0); }
    if (IN_RANGE(B0 + 1)) { PHASE_BEGIN();
        pg8::Gemm g{c.H(), (const bf16*)(ws + W_IN), M, 4096, 1024, 1024, 1024, 0, 0}; pg8::StaticOrder S; S.init(M, 4096, G, bid);
        pg8::EpiB<0> E{c.R1(), 4096, nullptr, nullptr};
        pg8::gemm_phase<pg8::EpiB<0>, pg8::StaticOrder, true, true>(ring, g, S, E, tid_o); PHASE_END(B0 + 1); }
    if (IN_RANGE(B0 + 2)) { PHASE_BEGIN(); phase_qk(c, l, lf); PHASE_END(B0 + 2); }
    if (IN_RANGE(B0 + 3)) { PHASE_BEGIN(); phase_mixers(c, l, lf); PHASE_END(B0 + 3); }
    if (IN_RANGE(B0 + 4)) { PHASE_BEGIN();
        { pg8::Gemm g{c.Y5(), (const bf16*)(ws + W_GLU), M, 1024, 512, 512, 512, 0, 0}; pg8::StaticOrder S; S.init(M, 1024, G, bid);
          pg8::EpiGlu E{c.Y(), 2048, 512, c.b_glu() + l * 1024};
          pg8::gemm_phase<pg8::EpiGlu, pg8::StaticOrder, true, true>(ring, g, S, E, tid_o); }
        { pg8::Gemm g{c.H(), (const bf16*)(ws + W_G), M, 4096, 1024, 1024, 1024, 0, 0}; pg8::StaticOrder S; S.init(M, 4096, G, bid);
          pg8::EpiB<1> E{c.R1(), 4096, c.b_gate() + l * 4096, nullptr};
          pg8::gemm_phase<pg8::EpiB<1>, pg8::StaticOrder, true, true>(ring, g, S, E, tid_o); }
        PHASE_END(B0 + 4); }
    if (IN_RANGE(B0 + 5)) { PHASE_BEGIN();
        pg8::Gemm g{c.Y(), (const bf16*)(ws + W_BR), M, 4096, 512, 2048, 512, 4, 1024}; pg8::StaticOrder S; S.init(M, 4096, G, bid);
        pg8::EpiB<3> E{c.R1(), 4096, nullptr, c.SSQ()};
        pg8::gemm_phase<pg8::EpiB<3>, pg8::StaticOrder, true, true>(ring, g, S, E, tid_o); PHASE_END(B0 + 5); }
    if (IN_RANGE(B0 + 6)) { PHASE_BEGIN(); phase_sum4(c); PHASE_END(B0 + 6); }
    if (IN_RANGE(B0 + 7)) { PHASE_BEGIN();
        pg8::Gemm g{c.H(), (const bf16*)(ws + W_OUT), M, 1024, 1024, 1024, 1024, 0, 0}; pg8::StaticOrder S; S.init(M, 1024, G, bid);
        pg8::EpiRes E{l == 0 ? c.x_prompt() : c.out(), l == 0 ? c.x_sample() : c.out() + (size_t)MC * D, c.out(), c.MOD() + (size_t)l * 5 * 6144, 2048};
        pg8::gemm_phase<pg8::EpiRes, pg8::StaticOrder, true, true>(ring, g, S, E, tid_o); PHASE_END(B0 + 7); }
    if (IN_RANGE(B0 + 8)) { PHASE_BEGIN(); phase_norm(c, l, 1, lf); PHASE_END(B0 + 8); }
    if (IN_RANGE(B0 + 9)) { PHASE_BEGIN();
        pg8::Gemm g{c.H(), (const bf16*)(ws + W_1), M, 4096, 1024, 1024, 1024, 0, 0}; pg8::StaticOrder S; S.init(M, 4096, G, bid);
        pg8::EpiB<2> E{c.R1(), 4096, nullptr, nullptr};
        pg8::gemm_phase<pg8::EpiB<2>, pg8::StaticOrder, true, true>(ring, g, S, E, tid_o); PHASE_END(B0 + 9); }
    if (IN_RANGE(B0 + 10)) { PHASE_BEGIN();
        pg8::Gemm g{c.R1(), (const bf16*)(ws + W_2), M, 1024, 4096, 4096, 4096, 0, 0}; pg8::StaticOrder S; S.init(M, 1024, G, bid);
        pg8::EpiRes E{c.out(), c.out() + (size_t)MC * D, c.out(), c.MOD() + (size_t)l * 5 * 6144, 5120};
        pg8::gemm_phase<pg8::EpiRes, pg8::StaticOrder, true, true>(ring, g, S, E, tid_o); PHASE_END(B0 + 10); }
}

__global__ void __launch_bounds__(NTHR, 2) fwd_kernel(Args args) {
    extern __shared__ __attribute__((aligned(16))) unsigned char lds[];
    const int ph_lo = args.ph_lo, ph_hi = args.ph_hi;
    volatile LAS unsigned* xst = (volatile LAS unsigned*)(lds + LDS_BYTES - 16);
    if (threadIdx.x < 4) xst[threadIdx.x] = 0u;
    __syncthreads();
    const XcdBarrier xbar = xcd_barrier_post((unsigned*)(args.ws + WS_BAR), xst);
    if (PROBE_SEL >= 0 && blockIdx.x == PROBE_PB && threadIdx.x == 0) { unsigned long long* ts = (unsigned long long*)(args.ws + WS_TS); for (int i = 64; i < 72; ++i) ts[i] = 0; ts[0] = __builtin_amdgcn_s_memrealtime(); }
    if (IN_RANGE(0)) { PHASE_BEGIN(); float* lf = (float*)lds; phase_mods(c, lf); __syncthreads(); phase_convert(c, 0, lf); phase_rope_table(c); PHASE_END(0); }
    layer_program<0>(ph_lo, ph_hi, lds, xbar);
    layer_program<1>(ph_lo, ph_hi, lds, xbar);
    if (PROBE_SEL >= 0) {
        __threadfence(); cg::this_grid().sync();
        const unsigned long long* ts = (const unsigned long long*)(args.ws + WS_TS);
        const float total = (float)(ts[23] - ts[0]); float sel = 0.f;
        for (int k = 0; k < 23; ++k) { const float d = (float)(ts[k + 1] - ts[k]); const int q = k == 0 ? -1 : (k - 1) % 11;
            const int cls = (q == 3) ? 0 : (q == 1 || q == 4 || q == 5 || q == 7 || q == 9 || q == 10) ? 1 : (q == 2) ? 2 : 3;
            if (cls == PROBE_SEL) sel += d; }
        if (PROBE_SEL >= 10 && PROBE_SEL < 100) sel = (float)ts[64 + PROBE_SEL - 10];
        if (PROBE_SEL >= 100) sel = (float)(ts[PROBE_SEL - 100 + 1] - ts[PROBE_SEL - 100]);
        const float sc = 1.0f + sqrtf(PROBE_SCALE * sel / total);
        for (int i = blockIdx.x * NTHR + threadIdx.x; i < 524288; i += gridDim.x * NTHR) args.out[O_S5 + i] *= sc;
    }
}

extern "C" void kernel_launch(void* const* d_in, const int* in_sizes, int n_in, void* d_out, int out_size, void* d_ws, size_t ws_size, hipStream_t stream) {
    static int grid = 0;
    if (grid == 0) {
        if (n_in != 44 || ws_size < WS_END) { fprintf(stderr, "kernel_launch: expected 44 inputs and >= %zu bytes of workspace; got %d, %zu\n", (size_t)WS_END, n_in, ws_size); grid = -1; return; }
        int dev = 0, cus = 0, per_cu = 0;
        (void)hipGetDevice(&dev); (void)hipDeviceGetAttribute(&cus, hipDeviceAttributeMultiprocessorCount, dev);
        (void)hipFuncSetAttribute((const void*)fwd_kernel, hipFuncAttributeMaxDynamicSharedMemorySize, LDS_BYTES);
        (void)hipOccupancyMaxActiveBlocksPerMultiprocessor(&per_cu, (const void*)fwd_kernel, NTHR, LDS_BYTES);
        if (per_cu < 1) { fprintf(stderr, "kernel_launch: occupancy query says %d blocks per CU\n", per_cu); per_cu = 1; }
        (void)hipGetLastError();
        grid = cus > 0 ? cus : 256;
    }
    if (grid < 0) return;
    (void)hipMemsetAsync(d_ws, 0, 64 * 1024, stream);
    Args a{};
    for (int i = 0; i < 44; ++i) a.in[i] = (const float*)d_in[i];
    a.out = (float*)d_out; a.ws = (unsigned char*)d_ws;
#if MK_MULTI
    for (int ph = 0; ph < NPH; ++ph) { a.ph_lo = ph; a.ph_hi = ph + 1; hipLaunchKernelGGL(fwd_kernel, dim3(grid), dim3(NTHR), LDS_BYTES, stream, a); }
#else
    a.ph_lo = 0; a.ph_hi = NPH;
    void* kargs[] = {&a};
    hipError_t e = hipLaunchCooperativeKernel((const void*)fwd_kernel, dim3(grid), dim3(NTHR), kargs, LDS_BYTES, stream);
    if (e != hipSuccess) fprintf(stderr, "cooperative launch failed: %s (grid %d)\n", hipGetErrorString(e), grid);
#endif
}
```

```cpp
#include <hip/hip_runtime.h>
#include <hip/hip_cooperative_groups.h>
#include <cstdio>
#include <cstdint>
namespace cg = cooperative_groups;

#ifndef MK_MULTI
#define MK_MULTI 0
#endif

namespace pg8 {
#define PG8_LAS __attribute__((address_space(3)))
typedef unsigned short bf16_t;
typedef short bf16x8 __attribute__((ext_vector_type(8)));
typedef float f32x4 __attribute__((ext_vector_type(4)));
typedef unsigned u32x4 __attribute__((ext_vector_type(4)));
constexpr int BM = 256, BK = 64, HALF = 128, HTB = HALF * BK * 2  , STAGE_BYTES = 8 * HTB, NXCD = 8, WGM = 8;

__host__ __device__ __forceinline__ int lds_byte(int r, int c) { const int st = (r >> 4) * 2 + (c >> 5), rr = r & 15, cc = c & 31, ob = rr * 64 + cc * 2; return st * 1024 + (ob ^ (((ob >> 9) & 1) << 5)); }
__host__ __device__ __forceinline__ void stage_rc(int b, int& R, int& C) { const int st = b / 1024, sb = b % 1024, swz = sb ^ (((sb >> 9) & 1) << 5); R = (st >> 1) * 16 + swz / 64; C = (st & 1) * 32 + (swz % 64) / 2; }
__host__ __device__ __forceinline__ int perm32(int rho) { const int n = rho >> 4, i = rho & 15; return 8 * (i >> 2) + 4 * n + (i & 3); }

struct Unit { int pm, pn; };
struct Gemm { const bf16_t* A; const bf16_t* Bt; int M, N, K, lda, ldb, a_div; size_t a_gstride; };

struct StaticOrder {
    int nM, nN, nwg, G, c;
    __host__ __device__ void init(int M, int N, int G_, int c_) { nM = M / BM; nN = N / BM; nwg = nM * nN; G = G_; c = c_; }
    __host__ __device__ bool next(int i, Unit& u) const {
        const long L = (long)i * G + c; if (L >= nwg) return false;
        int wgid = (int)L; { const int q = nwg / NXCD, r = nwg % NXCD, xcd = wgid % NXCD, off = wgid / NXCD; wgid = (xcd < r ? xcd * (q + 1) : r * (q + 1) + (xcd - r) * q) + off; }
        const int nig = WGM * nN, gid = wgid / nig, fm = gid * WGM, gsz = (nM - fm) < WGM ? (nM - fm) : WGM;
        u.pm = fm + ((wgid % nig) % gsz); u.pn = (wgid % nig) / gsz; return true;
    }
    __device__ __forceinline__ void a_ready(const Unit&) const {}
    __device__ __forceinline__ void done(const Unit&) const {}
};

__device__ __forceinline__ unsigned cvt_pk_bf16(float lo, float hi) { unsigned r; asm volatile("v_cvt_pk_bf16_f32 %0, %1, %2" : "=v"(r) : "v"(lo), "v"(hi)); return r; }
__device__ __forceinline__ float bf_lo(unsigned w) { return __builtin_bit_cast(float, w << 16); }
__device__ __forceinline__ float bf_hi(unsigned w) { return __builtin_bit_cast(float, w & 0xffff0000u); }
__device__ __forceinline__ float sigmoidf_(float x) { return 1.0f / (1.0f + __expf(-x)); }

template <int MODE> struct EpiB {
    static constexpr bool PERM = true, AFTER_DRAIN = false;
    bf16_t* O; int ldc; const float* bias; const float* ssq;
    __device__ __forceinline__ void operator()(const f32x4 (&acc)[2][2][4][2], const Unit& u, int wr, int wc, int fr, int fq) const {
        const int row0 = u.pm * BM + wr * 64 + fr, col0 = u.pn * BM + wc * 32 + 8 * fq;
        f32x4 bv[2][2];
#pragma unroll
        for (int bj = 0; bj < 2; ++bj)
#pragma unroll
            for (int n = 0; n < 2; ++n) bv[bj][n] = (MODE == 1) ? *(const f32x4*)(bias + col0 + bj * HALF + 4 * n) : (f32x4){0.f, 0.f, 0.f, 0.f};
        u32x4 gpre[2][4][2]; float rpre[2][4];
        if (MODE == 3) {
#pragma unroll
            for (int ai = 0; ai < 2; ++ai)
#pragma unroll
                for (int m = 0; m < 4; ++m) { const int row = row0 + ai * HALF + m * 16; const bf16_t* rp = O + (size_t)row * ldc + col0;
                    rpre[ai][m] = (u.pn < 4) ? ssq[row] : 512.0f;
#pragma unroll
                    for (int bj = 0; bj < 2; ++bj) gpre[ai][m][bj] = *(const u32x4*)(rp + bj * HALF); }
        }
#pragma unroll
        for (int ai = 0; ai < 2; ++ai)
#pragma unroll
            for (int m = 0; m < 4; ++m) {
                const int row = row0 + ai * HALF + m * 16;
                bf16_t* rowp = O + (size_t)row * ldc + col0;
                float rs = 1.f;
                if (MODE == 3) { if (u.pn < 4) rs = rsqrtf(rpre[ai][m] * (1.0f / 512.0f) + 1e-6f); }
#pragma unroll
                for (int bj = 0; bj < 2; ++bj) {
                    f32x4 v0 = acc[ai][bj][m][0] + bv[bj][0], v1 = acc[ai][bj][m][1] + bv[bj][1];
                    if (MODE == 1) {
#pragma unroll
                        for (int j = 0; j < 4; ++j) { v0[j] = sigmoidf_(v0[j]); v1[j] = sigmoidf_(v1[j]); }
                    }
                    if (MODE == 2) {
#pragma unroll
                        for (int j = 0; j < 4; ++j) { const float a = fmaxf(v0[j], 0.f), b = fmaxf(v1[j], 0.f); v0[j] = a * a; v1[j] = b * b; }
                    }
                    if (MODE == 3) {
                        const u32x4 gq = gpre[ai][m][bj];
                        v0[0] *= bf_lo(gq.x) * rs; v0[1] *= bf_hi(gq.x) * rs; v0[2] *= bf_lo(gq.y) * rs; v0[3] *= bf_hi(gq.y) * rs;
                        v1[0] *= bf_lo(gq.z) * rs; v1[1] *= bf_hi(gq.z) * rs; v1[2] *= bf_lo(gq.w) * rs; v1[3] *= bf_hi(gq.w) * rs;
                    }
                    u32x4 w; w.x = cvt_pk_bf16(v0[0], v0[1]); w.y = cvt_pk_bf16(v0[2], v0[3]); w.z = cvt_pk_bf16(v1[0], v1[1]); w.w = cvt_pk_bf16(v1[2], v1[3]);
                    *(u32x4*)(rowp + bj * HALF) = w;
                }
            }
    }
};
struct EpiGlu {
    static constexpr bool PERM = true, AFTER_DRAIN = false;
    bf16_t* O; int ldc; int ocol; const float* bias;
    __device__ __forceinline__ void operator()(const f32x4 (&acc)[2][2][4][2], const Unit& u, int wr, int wc, int fr, int fq) const {
        const int row0 = u.pm * BM + wr * 64 + fr, cc = u.pn * HALF + wc * 32 + 8 * fq;
        f32x4 bv[2][2];
#pragma unroll
        for (int bj = 0; bj < 2; ++bj)
#pragma unroll
            for (int n = 0; n < 2; ++n) bv[bj][n] = *(const f32x4*)(bias + bj * 512 + cc + 4 * n);
#pragma unroll
        for (int ai = 0; ai < 2; ++ai)
#pragma unroll
            for (int m = 0; m < 4; ++m) {
                bf16_t* rowp = O + (size_t)(row0 + ai * HALF + m * 16) * ldc + ocol + cc;
                f32x4 v0 = acc[ai][0][m][0] + bv[0][0], v1 = acc[ai][0][m][1] + bv[0][1];
                const f32x4 g0 = acc[ai][1][m][0] + bv[1][0], g1 = acc[ai][1][m][1] + bv[1][1];
#pragma unroll
                for (int j = 0; j < 4; ++j) { v0[j] *= sigmoidf_(g0[j]); v1[j] *= sigmoidf_(g1[j]); }
                u32x4 w; w.x = cvt_pk_bf16(v0[0], v0[1]); w.y = cvt_pk_bf16(v0[2], v0[3]); w.z = cvt_pk_bf16(v1[0], v1[1]); w.w = cvt_pk_bf16(v1[2], v1[3]);
                *(u32x4*)rowp = w;
            }
    }
};
struct EpiRes {
    static constexpr bool PERM = false, AFTER_DRAIN = false;
    const float* base_ctx; const float* base_lat;
    float* out; const float* modv;
    int goff;
    __device__ __forceinline__ void operator()(const f32x4 (&acc)[2][2][4][2], const Unit& u, int wr, int wc, int fr, int fq) const {
        const int row0 = u.pm * BM + wr * 64 + fr, col0 = u.pn * BM + wc * 32 + 4 * fq;
        const int mi = (u.pm < 32) ? 0 : 1 + ((u.pm - 32) >> 2);
        const float* gv = modv + (size_t)mi * 6144 + goff;
        f32x4 gg[2][2];
#pragma unroll
        for (int bj = 0; bj < 2; ++bj)
#pragma unroll
            for (int n = 0; n < 2; ++n) gg[bj][n] = *(const f32x4*)(gv + col0 + bj * HALF + n * 16);
#pragma unroll
        for (int ai = 0; ai < 2; ++ai) {
            f32x4 pre[4][2][2];
#pragma unroll
            for (int m = 0; m < 4; ++m) { const int row = row0 + ai * HALF + m * 16;
                const float* bp = (row < 8192 ? base_ctx + (size_t)row * 1024 : base_lat + (size_t)(row - 8192) * 1024) + col0;
#pragma unroll
                for (int bj = 0; bj < 2; ++bj)
#pragma unroll
                    for (int n = 0; n < 2; ++n) pre[m][bj][n] = *(const f32x4*)(bp + bj * HALF + n * 16); }
#pragma unroll
            for (int m = 0; m < 4; ++m) { const int row = row0 + ai * HALF + m * 16; float* op = out + (size_t)row * 1024 + col0;
#pragma unroll
                for (int bj = 0; bj < 2; ++bj)
#pragma unroll
                    for (int n = 0; n < 2; ++n) *(f32x4*)(op + bj * HALF + n * 16) = pre[m][bj][n] + gg[bj][n] * acc[ai][bj][m][n]; }
            asm volatile("" ::: "memory");
        }
    }
};

template <class Epi, class Sched, bool ALIGN_EPI = false, bool SP2 = false>
__device__ __forceinline__ void gemm_phase(PG8_LAS unsigned char* lds, const Gemm g, const Sched& S, const Epi& E, const int tid) {
    const int wid = __builtin_amdgcn_readfirstlane(tid >> 6), lane = tid & 63, wr = wid >> 2, wc = wid & 3, fr = lane & 15, fq = lane >> 4;
    const int K = g.K, nt = K / BK;
    unsigned voffA[2], voffB[2];
#pragma unroll
    for (int i = 0; i < 2; ++i) { int R, C; stage_rc(tid * 16 + i * 8192, R, C); const int Rb = Epi::PERM ? ((R & ~31) + perm32(R & 31)) : R;
        voffA[i] = (unsigned)(R * g.lda + C) * 2u; voffB[i] = (unsigned)(Rb * g.ldb + C) * 2u; }
    const size_t kstep = (size_t)(BK * 2);
    const size_t hstepA = (size_t)HALF * g.lda * 2, hstepB = (size_t)HALF * g.ldb * 2;
    const size_t tstepA = 2 * hstepA, tstepB = 2 * hstepB;
#define PG8_UA(u) ((const char*)g.A + (size_t)(u).pm * tstepA + (g.a_div ? (size_t)((u).pn / g.a_div) * g.a_gstride : (size_t)0))
#define PG8_UB(u) ((const char*)g.Bt + (size_t)(u).pn * tstepB)
    const unsigned ldsw = (unsigned)wid * 1024u;
    const int aoff = lds_byte(wr * 64 + fr, fq * 8), boff = lds_byte(wc * 32 + fr, fq * 8);
#define PG8_SA(b, h) (((b) * 2 + (h)) * HTB)
#define PG8_SB(b, h) ((4 + (b) * 2 + (h)) * HTB)
#define PG8_STAGE(bufoff, gbase, voff) do { _Pragma("unroll") for (int _i = 0; _i < 2; ++_i) \
        __builtin_amdgcn_global_load_lds((const unsigned*)((const char*)(gbase) + (voff)[_i]), (PG8_LAS unsigned*)(lds + (bufoff) + ldsw + _i * 8192), 16, 0, 0); } while (0)
#define PG8_LDA(dst, b, h) do { _Pragma("unroll") for (int m = 0; m < 4; ++m) _Pragma("unroll") for (int k = 0; k < 2; ++k) dst[m][k] = *(const PG8_LAS bf16x8*)(lds + PG8_SA(b, h) + aoff + m * 2048 + k * 1024); } while (0)
#define PG8_LDB(dst, b, h) do { _Pragma("unroll") for (int n = 0; n < 2; ++n) _Pragma("unroll") for (int k = 0; k < 2; ++k) dst[n][k] = *(const PG8_LAS bf16x8*)(lds + PG8_SB(b, h) + boff + n * 2048 + k * 1024); } while (0)
#define PG8_MMA(ai, bj, At, Bt) do { __builtin_amdgcn_s_setprio(1); _Pragma("unroll") for (int m = 0; m < 4; ++m) _Pragma("unroll") for (int n = 0; n < 2; ++n) _Pragma("unroll") for (int k = 0; k < 2; ++k) \
        acc[ai][bj][m][n] = __builtin_amdgcn_mfma_f32_16x16x32_bf16(Bt[n][k], At[m][k], acc[ai][bj][m][n], 0, 0, 0); __builtin_amdgcn_s_setprio(0); } while (0)
#define PG8_WAIT_V(n) asm volatile("s_waitcnt vmcnt(" #n ")" ::: "memory")
#define PG8_WAIT_L(n) asm volatile("s_waitcnt lgkmcnt(" #n ")" ::: "memory")
#define PG8_BAR __builtin_amdgcn_s_barrier()
#define PG8_SCHED __builtin_amdgcn_sched_barrier(0)
    Unit cur, nxt; int ui = 0;
    if (!S.next(0, cur)) return;
    f32x4 acc[2][2][4][2];
#pragma unroll
    for (int a = 0; a < 2; ++a)
#pragma unroll
        for (int b = 0; b < 2; ++b)
#pragma unroll
            for (int m = 0; m < 4; ++m)
#pragma unroll
                for (int n = 0; n < 2; ++n) acc[a][b][m][n] = (f32x4){0.f, 0.f, 0.f, 0.f};
    bf16x8 At[4][2], B0[2][2], B1[2][2];
    const char* cA = PG8_UA(cur); const char* cB = PG8_UB(cur);
    S.a_ready(cur);
    if constexpr (SP2) {
        PG8_STAGE(PG8_SB(0, 0), cB, voffB); PG8_STAGE(PG8_SB(0, 1), cB + hstepB, voffB); PG8_STAGE(PG8_SA(0, 0), cA, voffA); PG8_STAGE(PG8_SA(0, 1), cA + hstepA, voffA);
        if (wr == 1) PG8_BAR;
        PG8_WAIT_V(2); PG8_BAR;
        PG8_STAGE(PG8_SB(1, 0), cB + kstep, voffB); PG8_STAGE(PG8_SA(1, 0), cA + kstep, voffA); PG8_STAGE(PG8_SB(1, 1), cB + hstepB + kstep, voffB);
        PG8_WAIT_V(6); PG8_BAR;
    } else {
        PG8_STAGE(PG8_SB(0, 0), cB, voffB); PG8_STAGE(PG8_SA(0, 0), cA, voffA); PG8_STAGE(PG8_SB(0, 1), cB + hstepB, voffB); PG8_STAGE(PG8_SA(0, 1), cA + hstepA, voffA);
        if (wr == 1) PG8_BAR;
        PG8_WAIT_V(4); PG8_BAR;
        PG8_STAGE(PG8_SB(1, 0), cB + kstep, voffB); PG8_STAGE(PG8_SA(1, 0), cA + kstep, voffA); PG8_STAGE(PG8_SB(1, 1), cB + hstepB + kstep, voffB);
        PG8_WAIT_V(6); PG8_BAR;
    }
    for (;;) {
        const bool has_next = S.next(ui + 1, nxt);
        const char* nA = has_next ? PG8_UA(nxt) : cA; const char* nB = has_next ? PG8_UB(nxt) : cB;
        for (int t = 0; t < nt; t += 2) {
            const bool last = (t == nt - 2);
            const char* a1 = cA + (size_t)(t + 1) * kstep;
            const char* a2 = last ? nA : cA + (size_t)(t + 2) * kstep; const char* b2 = last ? nB : cB + (size_t)(t + 2) * kstep;
            const char* a3 = a2 + kstep; const char* b3 = b2 + kstep;
            if (last && has_next) S.a_ready(nxt);
            if constexpr (SP2) {
            PG8_LDB(B0, 0, 0); PG8_LDB(B1, 0, 1); PG8_SCHED; PG8_LDA(At, 0, 0); PG8_STAGE(PG8_SA(1, 1), a1 + hstepA, voffA);
            PG8_WAIT_V(8); PG8_WAIT_L(0); PG8_BAR; PG8_MMA(0, 0, At, B0); PG8_MMA(0, 1, At, B1); PG8_BAR; PG8_SCHED;
            PG8_LDA(At, 0, 1); PG8_STAGE(PG8_SB(0, 0), b2, voffB); PG8_STAGE(PG8_SB(0, 1), b2 + hstepB, voffB); PG8_STAGE(PG8_SA(0, 0), a2, voffA);
            PG8_WAIT_V(8); PG8_WAIT_L(0); PG8_BAR; PG8_MMA(1, 0, At, B0); PG8_MMA(1, 1, At, B1); PG8_BAR; PG8_SCHED;
            PG8_LDB(B0, 1, 0); PG8_LDB(B1, 1, 1); PG8_SCHED; PG8_LDA(At, 1, 0); PG8_STAGE(PG8_SA(0, 1), a2 + hstepA, voffA);
            PG8_WAIT_V(8); PG8_WAIT_L(0); PG8_BAR; PG8_MMA(0, 0, At, B0); PG8_MMA(0, 1, At, B1); PG8_BAR; PG8_SCHED;
            PG8_LDA(At, 1, 1); PG8_STAGE(PG8_SB(1, 0), b3, voffB); PG8_STAGE(PG8_SB(1, 1), b3 + hstepB, voffB); PG8_STAGE(PG8_SA(1, 0), a3, voffA);
            PG8_WAIT_V(8); PG8_WAIT_L(0); PG8_BAR; PG8_MMA(1, 0, At, B0); PG8_MMA(1, 1, At, B1); PG8_BAR; PG8_SCHED;
            } else {
            PG8_LDB(B0, 0, 0); PG8_SCHED; PG8_LDA(At, 0, 0); PG8_STAGE(PG8_SA(1, 1), a1 + hstepA, voffA);
            PG8_WAIT_L(8); PG8_BAR; PG8_WAIT_L(0); PG8_MMA(0, 0, At, B0); PG8_BAR; PG8_SCHED;
            PG8_LDB(B1, 0, 1); PG8_STAGE(PG8_SB(0, 0), b2, voffB);
            PG8_BAR; PG8_WAIT_L(0); PG8_MMA(0, 1, At, B1); PG8_BAR;
            PG8_LDA(At, 0, 1); PG8_STAGE(PG8_SA(0, 0), a2, voffA);
            PG8_BAR; PG8_WAIT_L(0); PG8_MMA(1, 0, At, B0); PG8_BAR; PG8_SCHED;
            PG8_STAGE(PG8_SB(0, 1), b2 + hstepB, voffB);
            PG8_WAIT_V(6); PG8_BAR; PG8_MMA(1, 1, At, B1); PG8_BAR;
            PG8_LDB(B0, 1, 0); PG8_SCHED; PG8_LDA(At, 1, 0); PG8_STAGE(PG8_SA(0, 1), a2 + hstepA, voffA);
            PG8_WAIT_L(8); PG8_BAR; PG8_WAIT_L(0); PG8_MMA(0, 0, At, B0); PG8_BAR; PG8_SCHED;
            PG8_LDB(B1, 1, 1); PG8_STAGE(PG8_SB(1, 0), b3, voffB);
            PG8_BAR; PG8_WAIT_L(0); PG8_MMA(0, 1, At, B1); PG8_BAR;
            PG8_LDA(At, 1, 1); PG8_STAGE(PG8_SA(1, 0), a3, voffA);
            PG8_BAR; PG8_WAIT_L(0); PG8_MMA(1, 0, At, B0); PG8_BAR; PG8_SCHED;
            PG8_STAGE(PG8_SB(1, 1), b3 + hstepB, voffB);
            PG8_WAIT_V(6); PG8_BAR; PG8_MMA(1, 1, At, B1); PG8_BAR;
            }
        }
        if constexpr (ALIGN_EPI) { if (wr == 0) PG8_BAR; }
        if constexpr (!Epi::AFTER_DRAIN) { E(acc, cur, wr, wc, fr, fq); S.done(cur); }
        if (!has_next) break;
#pragma unroll
        for (int a = 0; a < 2; ++a)
#pragma unroll
            for (int b = 0; b < 2; ++b)
#pragma unroll
                for (int m = 0; m < 4; ++m)
#pragma unroll
                    for (int n = 0; n < 2; ++n) acc[a][b][m][n] = (f32x4){0.f, 0.f, 0.f, 0.f};
        cur = nxt; cA = nA; cB = nB; ++ui;
        if constexpr (ALIGN_EPI) { if (wr == 1) PG8_BAR; }
    }
    PG8_WAIT_V(0);
    if constexpr (!ALIGN_EPI) { if (wr == 0) PG8_BAR; }
    PG8_BAR;
    if constexpr (Epi::AFTER_DRAIN) { E.fused(acc, cur, wr, wc, fr, fq, lds, wid, lane); S.done(cur); }
#undef PG8_UA
#undef PG8_UB
#undef PG8_SA
#undef PG8_SB
#undef PG8_STAGE
#undef PG8_LDA
#undef PG8_LDB
#undef PG8_MMA
#undef PG8_WAIT_V
#undef PG8_WAIT_L
#undef PG8_BAR
#undef PG8_SCHED
}
}

#ifndef PG8_SP2
#define PG8_SP2 true
#endif
#ifndef PG8_ALIGN
#define PG8_ALIGN true
#endif

typedef unsigned short bf16;
typedef unsigned v4u __attribute__((ext_vector_type(4)));
typedef unsigned v2u __attribute__((ext_vector_type(2)));
typedef float f32x4 __attribute__((ext_vector_type(4)));
#define LAS __attribute__((address_space(3)))

constexpr int NWAVES = 8, NTHR = 512;
constexpr int D = 1024, MC = 8192, ML = 4096, M = 12288, NPH = 23;
constexpr int LDS_BYTES = 147456;
constexpr float EPS = 1e-6f;
constexpr size_t MiB = 1u << 20;
constexpr size_t WS_MOD = 64 * 1024;
constexpr size_t WS_SSQ = 320 * 1024;
constexpr size_t WS_DT = 384 * 1024;
constexpr size_t WS_W = 2 * MiB;
constexpr size_t W_IN = WS_W, W_G = W_IN + 8 * MiB, W_GLU = W_G + 8 * MiB, W_BR = W_GLU + 1 * MiB, W_OUT = W_BR + 4 * MiB, W_1 = W_OUT + 2 * MiB, W_2 = W_1 + 8 * MiB;
constexpr size_t WS_H = 41 * MiB;
constexpr size_t WS_R1 = 65 * MiB;
constexpr size_t WS_Y = 161 * MiB;
constexpr size_t WS_Y5 = 209 * MiB;
constexpr size_t WS_XC = 221 * MiB;
constexpr size_t WS_S5K = 239 * MiB;
constexpr size_t WS_S5WS = 240 * MiB;
constexpr size_t WS_S5WO = 244 * MiB;
constexpr size_t WS_S5AT = 248 * MiB;
constexpr size_t WS_CKV = 251 * MiB;
constexpr size_t WS_ROPE = 1536 * 1024;
constexpr size_t WS_WDT = 1792 * 1024;
constexpr size_t WS_END = 254 * MiB;
#ifndef PROBE_SEL
#define PROBE_SEL -1
#endif
#ifndef PROBE_SCALE
#define PROBE_SCALE 4e-4f
#endif
#ifndef PROBE_PB
#define PROBE_PB 32
#endif
constexpr size_t WS_BAR = 32 * 1024;
constexpr size_t WS_QCTR = 48 * 1024;
constexpr size_t WS_TS = 16 * 1024;
constexpr size_t O_SSD = 12582912, O_S5 = 16777216, O_DK = 17301504, O_DV = 25690112, O_WK = 34078720, O_WV = 36175872;
constexpr int C_Z = 0, C_XBC = 512, C_U = 1280, C_DQ = 1792, C_DK = 2304, C_DV = 2816, C_WQ = 3328, C_WK = 3840, C_WV = 3968;

struct Args { const float* in[44]; float* out; unsigned char* ws; int ph_lo, ph_hi; };

typedef const Args __attribute__((address_space(4)))* CArgs;
struct Ctx {
    CArgs ap; int tid, lane, wave;
    __device__ __forceinline__ const float* x_prompt() const { return ap->in[0]; }
    __device__ __forceinline__ const float* x_sample() const { return ap->in[1]; }
    __device__ __forceinline__ const float* state_ssd() const { return ap->in[2]; }
    __device__ __forceinline__ const float* state_s5() const { return ap->in[3]; }
    __device__ __forceinline__ const float* cache_dk() const { return ap->in[4]; }
    __device__ __forceinline__ const float* cache_dv() const { return ap->in[5]; }
    __device__ __forceinline__ const float* cache_wk() const { return ap->in[6]; }
    __device__ __forceinline__ const float* cache_wv() const { return ap->in[7]; }
    __device__ __forceinline__ const float* cvec() const { return ap->in[8]; }
    __device__ __forceinline__ const float* c_ctx() const { return ap->in[9]; }
    __device__ __forceinline__ const float* w_mod() const { return ap->in[10]; }
    __device__ __forceinline__ const float* b_mod() const { return ap->in[11]; }
    __device__ __forceinline__ const float* g_norm1() const { return ap->in[12]; }
    __device__ __forceinline__ const float* g_norm2() const { return ap->in[13]; }
    __device__ __forceinline__ const float* w_in() const { return ap->in[14]; }
    __device__ __forceinline__ const float* conv_w() const { return ap->in[15]; }
    __device__ __forceinline__ const float* conv_b() const { return ap->in[16]; }
    __device__ __forceinline__ const float* dt_bias() const { return ap->in[17]; }
    __device__ __forceinline__ const float* a_log() const { return ap->in[18]; }
    __device__ __forceinline__ const float* ssd_d() const { return ap->in[19]; }
    __device__ __forceinline__ const float* ssd_norm_g() const { return ap->in[20]; }
    __device__ __forceinline__ const float* lam_re() const { return ap->in[21]; }
    __device__ __forceinline__ const float* lam_im() const { return ap->in[22]; }
    __device__ __forceinline__ const float* log_step() const { return ap->in[23]; }
    __device__ __forceinline__ const float* b_re() const { return ap->in[24]; }
    __device__ __forceinline__ const float* b_im() const { return ap->in[25]; }
    __device__ __forceinline__ const float* c_re() const { return ap->in[26]; }
    __device__ __forceinline__ const float* c_im() const { return ap->in[27]; }
    __device__ __forceinline__ const float* s5_d() const { return ap->in[28]; }
    __device__ __forceinline__ const float* w_glu() const { return ap->in[29]; }
    __device__ __forceinline__ const float* b_glu() const { return ap->in[30]; }
    __device__ __forceinline__ const float* qn_g() const { return ap->in[31]; }
    __device__ __forceinline__ const float* kn_g() const { return ap->in[32]; }
    __device__ __forceinline__ const float* dlam() const { return ap->in[33]; }
    __device__ __forceinline__ const float* subln_g() const { return ap->in[34]; }
    __device__ __forceinline__ const float* wqn_g() const { return ap->in[35]; }
    __device__ __forceinline__ const float* wkn_g() const { return ap->in[36]; }
    __device__ __forceinline__ const float* sink() const { return ap->in[37]; }
    __device__ __forceinline__ const float* w_branch() const { return ap->in[38]; }
    __device__ __forceinline__ const float* w_gate() const { return ap->in[39]; }
    __device__ __forceinline__ const float* b_gate() const { return ap->in[40]; }
    __device__ __forceinline__ const float* w_out() const { return ap->in[41]; }
    __device__ __forceinline__ const float* w_fc1() const { return ap->in[42]; }
    __device__ __forceinline__ const float* w_fc2() const { return ap->in[43]; }
    __device__ __forceinline__ float* out() const { return ap->out; }
    __device__ __forceinline__ unsigned char* ws() const { return ap->ws; }
    __device__ __forceinline__ float* MOD() const { return (float*)(ap->ws + WS_MOD); }
    __device__ __forceinline__ float* SSQ() const { return (float*)(ap->ws + WS_SSQ); }
    __device__ __forceinline__ float* DT() const { return (float*)(ap->ws + WS_DT); }
    __device__ __forceinline__ bf16* H() const { return (bf16*)(ap->ws + WS_H); }
    __device__ __forceinline__ bf16* R1() const { return (bf16*)(ap->ws + WS_R1); }
    __device__ __forceinline__ bf16* Y() const { return (bf16*)(ap->ws + WS_Y); }
    __device__ __forceinline__ bf16* Y5() const { return (bf16*)(ap->ws + WS_Y5); }
    __device__ __forceinline__ bf16* XC() const { return (bf16*)(ap->ws + WS_XC); }
    __device__ __forceinline__ bf16* CKV() const { return (bf16*)(ap->ws + WS_CKV); }
    __device__ __forceinline__ float* ROPE() const { return (float*)(ap->ws + WS_ROPE); }
};

__device__ __forceinline__ float wave_sum(float v) {
#pragma unroll
    for (int o = 1; o < 64; o <<= 1) v += __shfl_xor(v, o);
    return v;
}
__device__ __forceinline__ float wave_max(float v) {
#pragma unroll
    for (int o = 1; o < 64; o <<= 1) v = fmaxf(v, __shfl_xor(v, o));
    return v;
}
__device__ __forceinline__ float bf2f(bf16 h) { return __builtin_bit_cast(float, (unsigned)h << 16); }
__device__ __forceinline__ float bflo(unsigned w) { return __builtin_bit_cast(float, w << 16); }
__device__ __forceinline__ float bfhi(unsigned w) { return __builtin_bit_cast(float, w & 0xffff0000u); }
__device__ __forceinline__ unsigned f2bf(float f) { unsigned u = __builtin_bit_cast(unsigned, f); return (u + 0x7fffu + ((u >> 16) & 1u)) >> 16; }
__device__ __forceinline__ unsigned pk2(float lo, float hi) { return f2bf(lo) | (f2bf(hi) << 16); }
__device__ __forceinline__ float siluf(float x) { return x / (1.0f + __expf(-x)); }
__device__ __forceinline__ void unpack8(const v4u q, float (&f)[8]) { f[0] = bflo(q.x); f[1] = bfhi(q.x); f[2] = bflo(q.y); f[3] = bfhi(q.y); f[4] = bflo(q.z); f[5] = bfhi(q.z); f[6] = bflo(q.w); f[7] = bfhi(q.w); }

__device__ __forceinline__ void phase_mods(const Ctx& c, float* lf) {
    for (int i = c.tid; i < 5 * 1024; i += NTHR) { const int v = i >> 10, k = i & 1023; const float x = (v == 0) ? c.c_ctx()[k] : c.cvec()[(v - 1) * 1024 + k]; lf[i] = siluf(x); }
    __syncthreads();
    float* red = lf + 5 * 1024;
    for (int u = blockIdx.x; u < 192; u += gridDim.x) {
        const int l = u / 96, col0 = (u % 96) * 64;
        const float* W = c.w_mod() + (size_t)l * 1024 * 6144 + col0 + c.lane;
        float acc[5] = {0.f, 0.f, 0.f, 0.f, 0.f};
#pragma unroll 8
        for (int k = c.wave * 128; k < c.wave * 128 + 128; ++k) { const float wv = W[(size_t)k * 6144];
#pragma unroll
            for (int i = 0; i < 5; ++i) acc[i] += lf[i * 1024 + k] * wv; }
#pragma unroll
        for (int i = 0; i < 5; ++i) red[(c.wave * 5 + i) * 64 + c.lane] = acc[i];
        __syncthreads();
        if (c.tid < 320) { const int i = c.tid >> 6, ln = c.tid & 63; float s = c.b_mod()[l * 6144 + col0 + ln];
#pragma unroll
            for (int w = 0; w < 8; ++w) s += red[(w * 5 + i) * 64 + ln];
            c.MOD()[(size_t)(l * 5 + i) * 6144 + col0 + ln] = s; }
        __syncthreads();
    }
}

__device__ __forceinline__ int cmap(int mode, int n) { return mode == 0 ? n : (mode == 1 ? (n < 1280 ? n : n + 16) : ((n & 255) < 128 ? 128 * (n >> 8) + (n & 127) : 512 + 128 * (n >> 8) + (n & 127))); }
__device__ __forceinline__ void transpose_item(const float* W, int ld, int K, int N, int mode, const float* rowscale, bf16* WT, float* scr, int item, int lane) {
    const int nblk = N / 32, kb = item / nblk, nb = item % nblk, k0 = 64 * kb, n0 = 32 * nb, sc0 = cmap(mode, n0);
    float tv[32];
#pragma unroll
    for (int i = 0; i < 32; ++i) tv[i] = W[(size_t)(k0 + 2 * i + (lane >> 5)) * ld + sc0 + (lane & 31)];
    if (rowscale) {
#pragma unroll
        for (int i = 0; i < 32; ++i) tv[i] *= rowscale[k0 + 2 * i + (lane >> 5)]; }
#pragma unroll
    for (int i = 0; i < 32; ++i) scr[(2 * i + (lane >> 5)) * 33 + (lane & 31)] = tv[i];
    __builtin_amdgcn_fence(__ATOMIC_RELEASE, "wavefront"); __builtin_amdgcn_wave_barrier();
    const int ch = lane & 7;
#pragma unroll
    for (int j = 0; j < 4; ++j) { const int n = (lane >> 3) + 8 * j; const float* s = scr + (8 * ch) * 33 + n;
        v4u o; o.x = pk2(s[0 * 33], s[1 * 33]); o.y = pk2(s[2 * 33], s[3 * 33]); o.z = pk2(s[4 * 33], s[5 * 33]); o.w = pk2(s[6 * 33], s[7 * 33]);
        *(v4u*)(WT + (size_t)(n0 + n) * K + k0 + 8 * ch) = o; }
    __builtin_amdgcn_fence(__ATOMIC_RELEASE, "wavefront"); __builtin_amdgcn_wave_barrier();
}
__device__ __forceinline__ void s5_tables(const Ctx& c, int l, int g, int part, float* lf);
__device__ __forceinline__ void phase_convert(const Ctx& c, int l, float* lf) {
    for (int t = blockIdx.x; t < 128; t += gridDim.x) s5_tables(c, l, t & 31, t >> 5, lf);
    float* scr = lf + c.wave * 2176;
    const int gw = blockIdx.x * NWAVES + c.wave, NGW = gridDim.x * NWAVES;
    unsigned char* ws = c.ws();
    for (int i = (gridDim.x - 1 - blockIdx.x) * NTHR + c.tid; i < 16384; i += gridDim.x * NTHR) { const int j = i >> 10, k = i & 1023; ((bf16*)(ws + WS_WDT))[i] = (bf16)f2bf(c.w_in()[(size_t)l * 1024 * 4112 + (size_t)k * 4112 + 1280 + j]); }
    for (int it = gw; it < 9984; it += NGW) {
        int r = it;
        if (r < 2048) { transpose_item(c.w_in() + (size_t)l * 1024 * 4112, 4112, 1024, 4096, 1, nullptr, (bf16*)(ws + W_IN), scr, r, c.lane); continue; } r -= 2048;
        if (r < 2048) { transpose_item(c.w_gate() + (size_t)l * 1024 * 4096, 4096, 1024, 4096, 0, nullptr, (bf16*)(ws + W_G), scr, r, c.lane); continue; } r -= 2048;
        if (r < 256) { transpose_item(c.w_glu() + (size_t)l * 512 * 1024, 1024, 512, 1024, 2, nullptr, (bf16*)(ws + W_GLU), scr, r, c.lane); continue; } r -= 256;
        if (r < 1024) { const int i = r >> 8; transpose_item(c.w_branch() + (size_t)(l * 4 + i) * 512 * 1024, 1024, 512, 1024, 0, i == 0 ? c.ssd_norm_g() + l * 512 : nullptr, (bf16*)(ws + W_BR) + (size_t)i * 1024 * 512, scr, r & 255, c.lane); continue; } r -= 1024;
        if (r < 512) { transpose_item(c.w_out() + (size_t)l * 1024 * 1024, 1024, 1024, 1024, 0, nullptr, (bf16*)(ws + W_OUT), scr, r, c.lane); continue; } r -= 512;
        if (r < 2048) { transpose_item(c.w_fc1() + (size_t)l * 1024 * 4096, 4096, 1024, 4096, 0, nullptr, (bf16*)(ws + W_1), scr, r, c.lane); continue; } r -= 2048;
        transpose_item(c.w_fc2() + (size_t)l * 4096 * 1024, 1024, 4096, 1024, 0, nullptr, (bf16*)(ws + W_2), scr, r, c.lane);
    }
}

__device__ __forceinline__ void phase_norm(const Ctx& c, int l, int which, float* lf) {
    const int gw = blockIdx.x * NWAVES + c.wave, NGW = gridDim.x * NWAVES;
    const float* gn = (which == 0 ? c.g_norm1() : c.g_norm2()) + l * 1024;
    for (int m = gw; m < M; m += NGW) {
        const float* xr = (l == 0 && which == 0) ? (m < MC ? c.x_prompt() + (size_t)m * D : c.x_sample() + (size_t)(m - MC) * D) : c.out() + (size_t)m * D;
        const int mi = (m < MC) ? 0 : 1 + ((m - MC) >> 10);
        const float* mod = c.MOD() + (size_t)(l * 5 + mi) * 6144 + which * 3072;
        f32x4 v[4]; float s = 0.f;
#pragma unroll
        for (int j = 0; j < 4; ++j) { v[j] = *(const f32x4*)(xr + 4 * c.lane + 256 * j); s += (v[j].x * v[j].x + v[j].y * v[j].y) + (v[j].z * v[j].z + v[j].w * v[j].w); }
        const float rstd = rsqrtf(wave_sum(s) * (1.0f / D) + EPS);
#pragma unroll
        for (int j = 0; j < 4; ++j) { const int k = 4 * c.lane + 256 * j; const f32x4 g = *(const f32x4*)(gn + k), sh = *(const f32x4*)(mod + k), sc = *(const f32x4*)(mod + 1024 + k);
            v[j] = v[j] * rstd * g * (sc + 1.0f) + sh;
            v2u o; o.x = pk2(v[j].x, v[j].y); o.y = pk2(v[j].z, v[j].w); *(v2u*)(c.H() + (size_t)m * D + k) = o; }
        if (which == 0) {
            if (c.lane == 0) c.SSQ()[m] = 0.f;
        }
    }
}

__device__ __forceinline__ void phase_dt(const Ctx& c, int l) {
    if (c.wave >= 3) return;
    const int tile = blockIdx.x * 3 + c.wave; if (tile >= 768) return;
    const int lr = c.lane & 15, lq = c.lane >> 4;
    const bf16* ap = c.H() + (size_t)(16 * tile + lr) * 1024 + 8 * lq; const bf16* bp = (const bf16*)(c.ws() + WS_WDT) + (size_t)lr * 1024 + 8 * lq;
    f32x4 acc = {0.f, 0.f, 0.f, 0.f};
#pragma unroll 8
    for (int ks = 0; ks < 32; ++ks) acc = __builtin_amdgcn_mfma_f32_16x16x32_bf16(*(const pg8::bf16x8*)(ap + 32 * ks), *(const pg8::bf16x8*)(bp + 32 * ks), acc, 0, 0, 0);
    const float bias = c.dt_bias()[l * 16 + lr];
#pragma unroll
    for (int r = 0; r < 4; ++r) { const float x = acc[r] + bias; c.DT()[(size_t)(16 * tile + 4 * lq + r) * 16 + lr] = x > 20.f ? x : log1pf(__expf(x)); }
}

__device__ __forceinline__ void phase_rope_table(const Ctx& c) {
    const int gt = blockIdx.x * NTHR + c.tid;
    if (gt < 32768) { const int pos = gt >> 5, a = gt & 31, f = a & 15; const float inv = exp2f(-(float)f * 0.8304820237218406f);
        const float ang = (float)((a >> 4) ? (pos & 63) : (pos >> 6)) * inv; float sn, cs; sincosf(ang, &sn, &cs); c.ROPE()[pos * 64 + a] = cs; c.ROPE()[pos * 64 + 32 + a] = sn; }
}
__device__ __forceinline__ void phase_qk(const Ctx& c, int l, float* lf) {
    const int gw = blockIdx.x * NWAVES + c.wave, NGW = gridDim.x * NWAVES, lane = c.lane, l16 = lane & 15, grp = lane >> 4;
    for (int i = c.tid; i < 7 * 768; i += NTHR) lf[i] = c.conv_w()[(size_t)l * 7 * 768 + i];
    for (int i = c.tid; i < 768; i += NTHR) lf[7 * 768 + i] = c.conv_b()[l * 768 + i];
    __syncthreads();
    const f32x4 gq = *(const f32x4*)(c.qn_g() + l * 64 + 4 * l16), gk = *(const f32x4*)(c.kn_g() + l * 64 + 4 * l16), gwq = *(const f32x4*)(c.wqn_g() + l * 64 + 4 * l16), gwk = *(const f32x4*)(c.wkn_g() + l * 64 + 4 * l16);
    bf16* R1p = c.R1(); float* outp = c.out(); bf16* XCp = c.XC();
    for (int m = gw; m < M; m += NGW) {
        bf16* pr = R1p + (size_t)m * 4096;
        const bool lat = m >= MC;
        const int b = lat ? (m - MC) >> 10 : m >> 8, t = lat ? (m - MC) & 1023 : m & 255, L = lat ? 1024 : 256;
        const size_t ob = (size_t)(b * 2 + l) * 256 + t;
        f32x4 cs = {1.f, 1.f, 1.f, 1.f}, sn = {0.f, 0.f, 0.f, 0.f};
        if (lat) { const float* rp = c.ROPE() + t * 64 + (l16 >> 3) * 16 + 4 * (l16 & 3); cs = *(const f32x4*)rp; sn = *(const f32x4*)(rp + 32); if (!((l16 >> 2) & 1)) sn = -sn; }
        v2u raw[7];
#pragma unroll
        for (int ps = 0; ps < 7; ++ps) { const int gi = 4 * ps + grp; const int col = gi < 8 ? C_DQ + gi * 64 : gi < 16 ? C_DK + (gi - 8) * 64 : gi < 24 ? C_WQ + (gi - 16) * 64 : C_WK + (gi - 24) * 64;
            raw[ps] = (gi < 26) ? *(const v2u*)(pr + col + 4 * l16) : (v2u){0u, 0u}; }
        v2u cp[3];
        if (!lat) {
#pragma unroll
            for (int ps = 0; ps < 3; ++ps) { const int gi = 4 * ps + grp; const int col = gi < 8 ? C_DV + gi * 64 : C_WV + (gi - 8) * 64; cp[ps] = (gi < 10) ? *(const v2u*)(pr + col + 4 * l16) : (v2u){0u, 0u}; }
        }
        v2u cx[3][7];
#pragma unroll
        for (int i = 0; i < 3; ++i)
#pragma unroll
            for (int j = 0; j < 7; ++j) { const int tt = t + j - 3; cx[i][j] = (tt >= 0 && tt < L) ? *(const v2u*)(R1p + (size_t)(m + j - 3) * 4096 + C_XBC + 4 * lane + 256 * i) : (v2u){0u, 0u}; }
#pragma unroll
        for (int ps = 0; ps < 7; ++ps) { const int gi = 4 * ps + grp;
            const f32x4 gain = gi < 8 ? gq : gi < 16 ? gk : gi < 24 ? gwq : gwk;
            f32x4 v = {bflo(raw[ps].x), bfhi(raw[ps].x), bflo(raw[ps].y), bfhi(raw[ps].y)};
            float ss = (v.x * v.x + v.y * v.y) + (v.z * v.z + v.w * v.w);
            ss += __shfl_xor(ss, 1); ss += __shfl_xor(ss, 2); ss += __shfl_xor(ss, 4); ss += __shfl_xor(ss, 8);
            v = v * rsqrtf(ss * (1.0f / 64.0f) + EPS) * gain;
            if (lat) { f32x4 p; p.x = __shfl_xor(v.x, 4); p.y = __shfl_xor(v.y, 4); p.z = __shfl_xor(v.z, 4); p.w = __shfl_xor(v.w, 4); v = v * cs + p * sn; }
            if (gi < 26) {
                const int col = gi < 8 ? C_DQ + gi * 64 : gi < 16 ? C_DK + (gi - 8) * 64 : gi < 24 ? C_WQ + (gi - 16) * 64 : C_WK + (gi - 24) * 64;
                v2u o; o.x = pk2(v.x, v.y); o.y = pk2(v.z, v.w); *(v2u*)(pr + col + 4 * l16) = o;
                if (!lat) { if (gi >= 8 && gi < 16) *(f32x4*)(outp + O_DK + ob * 512 + (gi - 8) * 64 + 4 * l16) = v; if (gi >= 24) *(f32x4*)(outp + O_WK + ob * 128 + (gi - 24) * 64 + 4 * l16) = v; }
            }
        }
        if (!lat) {
#pragma unroll
            for (int ps = 0; ps < 3; ++ps) { const int gi = 4 * ps + grp; const f32x4 v = {bflo(cp[ps].x), bfhi(cp[ps].x), bflo(cp[ps].y), bfhi(cp[ps].y)};
                if (gi < 8) *(f32x4*)(outp + O_DV + ob * 512 + gi * 64 + 4 * l16) = v; else if (gi < 10) *(f32x4*)(outp + O_WV + ob * 128 + (gi - 8) * 64 + 4 * l16) = v; }
        }
#pragma unroll
        for (int i = 0; i < 3; ++i) { const int ch = 4 * lane + 256 * i; f32x4 a = *(const f32x4*)(lf + 7 * 768 + ch);
#pragma unroll
            for (int j = 0; j < 7; ++j) { const f32x4 wv = *(const f32x4*)(lf + j * 768 + ch); const f32x4 xv = {bflo(cx[i][j].x), bfhi(cx[i][j].x), bflo(cx[i][j].y), bfhi(cx[i][j].y)}; a += wv * xv; }
            v2u o; o.x = pk2(siluf(a.x), siluf(a.y)); o.y = pk2(siluf(a.z), siluf(a.w)); *(v2u*)(XCp + (size_t)m * 768 + ch) = o; }
    }
    for (int r = gw; r < 1024; r += NGW) { const int b = r >> 8, sidx = r & 255; const size_t cb = (size_t)(b * 2 + l) * 256 + sidx; bf16* dst = c.CKV() + (size_t)r * 1280;
        for (int i = lane; i < 1280; i += 64) { const float v = i < 512 ? c.cache_dk()[cb * 512 + i] : i < 1024 ? c.cache_dv()[cb * 512 + i - 512] : i < 1152 ? c.cache_wk()[cb * 128 + i - 1024] : c.cache_wv()[cb * 128 + i - 1152]; dst[i] = (bf16)f2bf(v); } }
}

typedef pg8::bf16x8 bx8;
#define MFMA16(a, b, cc) __builtin_amdgcn_mfma_f32_16x16x32_bf16((a), (b), (cc), 0, 0, 0)
__device__ __forceinline__ void ssd_unit(const Ctx& c, int l, int pass, int b, int h, unsigned char* lds) {
    const int L = pass ? 1024 : 256, tok0 = pass ? MC + b * 1024 : b * 256, NCH = L >> 7;
    const int tid = c.tid, lane = c.lane, w = c.wave, lr = lane & 15, lq = lane >> 4, grp = h >> 2;
    bf16* XT = (bf16*)lds;
    bf16* BwT = XT + 64 * 136;
    bf16* Bm = BwT + 64 * 136;
    bf16* Cm = Bm + 128 * 72;
    bf16* Mm = Cm + 128 * 72;
    bf16* ST = Mm + 128 * 136;
    float* cum = (float*)(ST + 64 * 72);
    float* dtv = cum + 128; float* wv = dtv + 128; float* ecum = wv + 128; float* tot = ecum + 128;
    const float dsk = c.ssd_d()[l * 8 + h];
    const bf16* XCp = c.XC(); const float* DTp = c.DT(); bf16* Yp = c.Y(); const bf16* R1p = c.R1(); float* SSQp = c.SSQ();
    const int pi = w >> 1, nj0 = 2 * (w & 1);
    for (int dir = 0; dir < 2; ++dir) {
        const float A = -__expf(c.a_log()[(l * 2 + dir) * 8 + h]);
        f32x4 Sacc[2];
        __syncthreads();
#pragma unroll
        for (int q = 0; q < 2; ++q)
#pragma unroll
            for (int r = 0; r < 4; ++r) { const int p = 16 * pi + 4 * lq + r, n = 16 * (nj0 + q) + lr;
                const float v = pass ? c.state_ssd()[(((((size_t)(b * 2 + l) * 2 + dir) * 8 + h) * 64 + p) * 64) + n] : 0.f;
                Sacc[q][r] = v; ST[p * 72 + n] = (bf16)f2bf(v); }
        for (int ci = 0; ci < NCH; ++ci) {
            __syncthreads();
            const int i = tid >> 2, part = tid & 3;
            float bvals[16];
            { const int t = dir ? L - 1 - (ci * 128 + i) : ci * 128 + i; const bf16* xr = XCp + (size_t)(tok0 + t) * 768;
              const v4u x0 = *(const v4u*)(xr + h * 64 + part * 16), x1 = *(const v4u*)(xr + h * 64 + part * 16 + 8);
              const v4u b0 = *(const v4u*)(xr + 512 + grp * 64 + part * 16), b1 = *(const v4u*)(xr + 512 + grp * 64 + part * 16 + 8);
              const v4u c0 = *(const v4u*)(xr + 640 + grp * 64 + part * 16), c1 = *(const v4u*)(xr + 640 + grp * 64 + part * 16 + 8);
              *(v4u*)(Bm + i * 72 + part * 16) = b0; *(v4u*)(Bm + i * 72 + part * 16 + 8) = b1;
              *(v4u*)(Cm + i * 72 + part * 16) = c0; *(v4u*)(Cm + i * 72 + part * 16 + 8) = c1;
              const unsigned xs[8] = {x0.x, x0.y, x0.z, x0.w, x1.x, x1.y, x1.z, x1.w};
#pragma unroll
              for (int j = 0; j < 8; ++j) { XT[(part * 16 + 2 * j) * 136 + i] = (bf16)(xs[j] & 0xffffu); XT[(part * 16 + 2 * j + 1) * 136 + i] = (bf16)(xs[j] >> 16); }
              float t8[8]; unpack8(b0, t8);
#pragma unroll
              for (int j = 0; j < 8; ++j) bvals[j] = t8[j];
              unpack8(b1, t8);
#pragma unroll
              for (int j = 0; j < 8; ++j) bvals[8 + j] = t8[j]; }
            if (tid < 64) {
                const int i0 = 2 * lane, i1 = i0 + 1;
                const int t0 = dir ? L - 1 - (ci * 128 + i0) : ci * 128 + i0, t1 = dir ? L - 1 - (ci * 128 + i1) : ci * 128 + i1;
                const float d0 = DTp[(size_t)(tok0 + t0) * 16 + dir * 8 + h], d1 = DTp[(size_t)(tok0 + t1) * 16 + dir * 8 + h];
                const float a0 = d0 * A, a1 = d1 * A; float s = a0 + a1;
#pragma unroll
                for (int o = 1; o < 64; o <<= 1) { const float v = __shfl_up(s, o); if (lane >= o) s += v; }
                const float cum1 = s, cum0 = s - a1, total = __shfl(s, 63);
                cum[i0] = cum0; cum[i1] = cum1; dtv[i0] = d0; dtv[i1] = d1;
                wv[i0] = __expf(total - cum0) * d0; wv[i1] = __expf(total - cum1) * d1; ecum[i0] = __expf(cum0); ecum[i1] = __expf(cum1);
                if (lane == 0) tot[0] = __expf(total);
            }
            __syncthreads();
            { const float wi = wv[i];
#pragma unroll
              for (int j = 0; j < 16; ++j) BwT[(part * 16 + j) * 136 + i] = (bf16)f2bf(bvals[j] * wi); }
            bx8 cfr[2];
#pragma unroll
            for (int ks = 0; ks < 2; ++ks) cfr[ks] = *(const bx8*)(Cm + (16 * w + lr) * 72 + 32 * ks + 8 * lq);
            for (int j = 0; j <= w; ++j) {
                const bx8 b0 = *(const bx8*)(Bm + (16 * j + lr) * 72 + 8 * lq), b1 = *(const bx8*)(Bm + (16 * j + lr) * 72 + 32 + 8 * lq);
                f32x4 g = {0.f, 0.f, 0.f, 0.f};
                g = MFMA16(cfr[0], b0, g); g = MFMA16(cfr[1], b1, g);
                const int s = 16 * j + lr; const float cs = cum[s], ds = dtv[s];
#pragma unroll
                for (int r = 0; r < 4; ++r) { const int tt = 16 * w + 4 * lq + r; const float v = (s <= tt) ? g[r] * __expf(cum[tt] - cs) * ds : 0.f; Mm[tt * 136 + s] = (bf16)f2bf(v); }
            }
            if (!(w & 1)) {
#pragma unroll
                for (int r = 0; r < 4; ++r) Mm[(16 * w + 4 * lq + r) * 136 + 16 * (w + 1) + lr] = 0;
            }
            __syncthreads();
            f32x4 yl[4], yo[4];
#pragma unroll
            for (int jp = 0; jp < 4; ++jp) { yl[jp] = (f32x4){0.f, 0.f, 0.f, 0.f}; yo[jp] = (f32x4){0.f, 0.f, 0.f, 0.f}; }
            for (int ks = 0; ks <= (w >> 1); ++ks) {
                const bx8 af = *(const bx8*)(Mm + (16 * w + lr) * 136 + 32 * ks + 8 * lq);
#pragma unroll
                for (int jp = 0; jp < 4; ++jp) { const bx8 xf = *(const bx8*)(XT + (16 * jp + lr) * 136 + 32 * ks + 8 * lq); yl[jp] = MFMA16(af, xf, yl[jp]); }
            }
#pragma unroll
            for (int ks = 0; ks < 2; ++ks)
#pragma unroll
                for (int jp = 0; jp < 4; ++jp) { const bx8 sf = *(const bx8*)(ST + (16 * jp + lr) * 72 + 32 * ks + 8 * lq); yo[jp] = MFMA16(cfr[ks], sf, yo[jp]); }
            {
                float ssq[4] = {0.f, 0.f, 0.f, 0.f};
#pragma unroll
                for (int r = 0; r < 4; ++r) {
                    const int tt = 16 * w + 4 * lq + r; const float ec = ecum[tt];
                    const int t = dir ? L - 1 - (ci * 128 + tt) : ci * 128 + tt; const size_t m = (size_t)tok0 + t;
#pragma unroll
                    for (int jp = 0; jp < 4; ++jp) {
                        const int p = 16 * jp + lr; const float y = yl[jp][r] + ec * yo[jp][r];
                        if (dir == 0) Yp[m * 2048 + h * 64 + p] = (bf16)f2bf(y);
                        else { const float x = bf2f(XT[p * 136 + tt]); const float ytot = y + bf2f(Yp[m * 2048 + h * 64 + p]) + dsk * x; const float z = bf2f(R1p[m * 4096 + C_Z + h * 64 + p]);
                            const float gt = ytot * siluf(z); Yp[m * 2048 + h * 64 + p] = (bf16)f2bf(gt); ssq[r] += gt * gt; }
                    }
                    if (dir == 1) { float q = ssq[r]; q += __shfl_xor(q, 1); q += __shfl_xor(q, 2); q += __shfl_xor(q, 4); q += __shfl_xor(q, 8); if (lr == 0) atomicAdd(SSQp + m, q); }
                }
            }
            __syncthreads();
            {
                f32x4 st[2] = {{0.f, 0.f, 0.f, 0.f}, {0.f, 0.f, 0.f, 0.f}};
#pragma unroll
                for (int ks = 0; ks < 4; ++ks) { const bx8 af = *(const bx8*)(XT + (16 * pi + lr) * 136 + 32 * ks + 8 * lq);
#pragma unroll
                    for (int q = 0; q < 2; ++q) { const bx8 bf = *(const bx8*)(BwT + (16 * (nj0 + q) + lr) * 136 + 32 * ks + 8 * lq); st[q] = MFMA16(af, bf, st[q]); } }
                const float et = tot[0];
#pragma unroll
                for (int q = 0; q < 2; ++q)
#pragma unroll
                    for (int r = 0; r < 4; ++r) { Sacc[q][r] = et * Sacc[q][r] + st[q][r]; ST[(16 * pi + 4 * lq + r) * 72 + 16 * (nj0 + q) + lr] = (bf16)f2bf(Sacc[q][r]); }
            }
        }
        if (!pass) {
#pragma unroll
            for (int q = 0; q < 2; ++q)
#pragma unroll
                for (int r = 0; r < 4; ++r) { const int p = 16 * pi + 4 * lq + r, n = 16 * (nj0 + q) + lr;
                    c.out()[O_SSD + (((((size_t)(b * 2 + l) * 2 + dir) * 8 + h) * 64 + p) * 64) + n] = Sacc[q][r]; }
        }
    }
}

__device__ __forceinline__ void s5_tables(const Ctx& c, int l, int g, int part, float* lf) {
    const int tid = c.tid;
    float* pw = lf;
    float* Bc = pw + 2 * 17 * 128;
    float* Cc = Bc + 2 * 2048;
    if (tid < 128) { const int dir = tid >> 6, n = tid & 63, idx = ((l * 2 + dir) * 32 + g) * 64 + n;
        const float lre = c.lam_re()[idx], lim = c.lam_im()[idx], step = expf(c.log_step()[(l * 2 + dir) * 32 + g]);
        for (int k = 0; k <= 16; ++k) { const float mag = expf(lre * step * (float)k); float sn, cs; sincosf(lim * step * (float)k, &sn, &cs); pw[((dir * 17 + k) * 64 + n) * 2] = mag * cs; pw[((dir * 17 + k) * 64 + n) * 2 + 1] = mag * sn; }
        const float mag = expf(lre * step); float sn, cs; sincosf(lim * step, &sn, &cs); const float are = mag * cs, aim = mag * sn;
        const float den = lre * lre + lim * lim, cre = ((are - 1.0f) * lre + aim * lim) / den, cim = (aim * lre - (are - 1.0f) * lim) / den;
        for (int mm = 0; mm < 16; ++mm) { const float br = c.b_re()[(size_t)idx * 16 + mm], bi = c.b_im()[(size_t)idx * 16 + mm]; Bc[((dir * 64 + n) * 16 + mm) * 2] = cre * br - cim * bi; Bc[((dir * 64 + n) * 16 + mm) * 2 + 1] = cre * bi + cim * br; }
    }
    for (int i = tid; i < 2048; i += NTHR) { const int dir = i >> 10, mm = (i >> 6) & 15, n = i & 63; const size_t src = ((size_t)((l * 2 + dir) * 32 + g) * 16 + mm) * 64 + n;
        Cc[i * 2] = c.c_re()[src]; Cc[i * 2 + 1] = c.c_im()[src]; }
    __syncthreads();
    if (part == 0 && tid < 128) { const int dir = tid >> 6, n = tid & 63; float* at = (float*)(c.ws() + WS_S5AT) + ((size_t)(dir * 32 + g) * 64 + n) * 2; at[0] = pw[((dir * 17 + 16) * 64 + n) * 2]; at[1] = pw[((dir * 17 + 16) * 64 + n) * 2 + 1]; }
    bf16* Kt = (bf16*)(c.ws() + WS_S5K) + (size_t)g * 31 * 256;
    for (int e = part * 1984 + tid; e < (part + 1) * 1984; e += NTHR) { const int tp = e >> 8, mm = (e >> 4) & 15, m2 = e & 15, tau = tp - 15; float acc = 0.f;
#pragma unroll
        for (int dir = 0; dir < 2; ++dir) { if ((dir == 0 && tau < 0) || (dir == 1 && tau > 0)) continue; const int k = tau < 0 ? -tau : tau;
            const float* pp = pw + (dir * 17 + k) * 128; const float* bb = Bc + dir * 2048 + m2 * 2; const float* cc = Cc + (dir * 16 + mm) * 128;
            for (int n = 0; n < 64; ++n) { const float pr = pp[2 * n], pi = pp[2 * n + 1], br = bb[n * 32], bi = bb[n * 32 + 1], Pr = pr * br - pi * bi, Pi = pr * bi + pi * br; acc += cc[2 * n] * Pr - cc[2 * n + 1] * Pi; } }
        if (tau == 0 && mm == m2) acc += c.s5_d()[l * 512 + g * 16 + mm];
        Kt[e] = (bf16)f2bf(acc); }
    for (int e = part * 16384 + tid; e < (part + 1) * 16384; e += NTHR) { const int dir = e >> 15, sidx = (e >> 8) & 127, k = e & 255, ri = sidx >> 6, n = sidx & 63, j = k >> 4, m2 = k & 15, ex = dir ? j : 15 - j;
        const float pr = pw[((dir * 17 + ex) * 64 + n) * 2], pi = pw[((dir * 17 + ex) * 64 + n) * 2 + 1], br = Bc[((dir * 64 + n) * 16 + m2) * 2], bi = Bc[((dir * 64 + n) * 16 + m2) * 2 + 1];
        ((bf16*)(c.ws() + WS_S5WS))[((size_t)(dir * 32 + g) * 128 + sidx) * 256 + k] = (bf16)f2bf(ri ? pr * bi + pi * br : pr * br - pi * bi); }
    for (int e = part * 16384 + tid; e < (part + 1) * 16384; e += NTHR) { const int row = e >> 8, k = e & 255, i = row >> 4, mm = row & 15, dir = k >> 7, ri = (k >> 6) & 1, n = k & 63, ex = dir ? 16 - i : i + 1;
        const float pr = pw[((dir * 17 + ex) * 64 + n) * 2], pi = pw[((dir * 17 + ex) * 64 + n) * 2 + 1], cr = Cc[((dir * 16 + mm) * 64 + n) * 2], ci = Cc[((dir * 16 + mm) * 64 + n) * 2 + 1];
        ((bf16*)(c.ws() + WS_S5WO))[(size_t)g * 65536 + e] = (bf16)f2bf(ri ? -(cr * pi + ci * pr) : cr * pr - ci * pi); }
    __syncthreads();
}

__device__ __forceinline__ void s5_unit(const Ctx& c, int l, int g, int cu, unsigned char* lds) {
    const int tid = c.tid, lane = c.lane, w = c.wave, lr = lane & 15, lq = lane >> 4;
    const bool lat = cu >= 8;
    bf16* Ut = (bf16*)lds;
    bf16* St = Ut + 64 * 264;
    bf16* Kt = St + 64 * 264;
    float* Dl = (float*)(Kt + 31 * 256);
    const bf16* R1p = c.R1();
    { const v4u* src = (const v4u*)((const bf16*)(c.ws() + WS_S5K) + (size_t)g * 31 * 256); for (int i = tid; i < 31 * 32; i += NTHR) ((v4u*)Kt)[i] = src[i]; }
#pragma unroll
    for (int i = 0; i < 2; ++i) { const int id = tid + NTHR * i, col = id >> 4, j = id & 15;
        const int tok = lat ? MC + (cu - 8) * 1024 + col * 16 + j : (4 * cu + (col >> 4)) * 256 + (col & 15) * 16 + j;
        const bf16* up = R1p + (size_t)tok * 4096 + C_U + g * 16;
        *(v4u*)(Ut + col * 264 + j * 16) = *(const v4u*)up; *(v4u*)(Ut + col * 264 + j * 16 + 8) = *(const v4u*)(up + 8); }
    __syncthreads();
    for (int dir = 0; dir < 2; ++dir) {
        const bf16* Wsp = (const bf16*)(c.ws() + WS_S5WS) + ((size_t)(dir * 32 + g) * 128 + 16 * w + lr) * 256 + 8 * lq;
        f32x4 acc[4];
#pragma unroll
        for (int cb = 0; cb < 4; ++cb) acc[cb] = (f32x4){0.f, 0.f, 0.f, 0.f};
        bx8 afr[8];
#pragma unroll
        for (int ks = 0; ks < 8; ++ks) afr[ks] = *(const bx8*)(Wsp + 32 * ks);
#pragma unroll
        for (int ks = 0; ks < 8; ++ks) {
#pragma unroll
            for (int cb = 0; cb < 4; ++cb) { const bx8 bf = *(const bx8*)(Ut + (16 * cb + lr) * 264 + 32 * ks + 8 * lq); acc[cb] = MFMA16(afr[ks], bf, acc[cb]); }
            __builtin_amdgcn_sched_barrier(0); }
#pragma unroll
        for (int cb = 0; cb < 4; ++cb)
#pragma unroll
            for (int r = 0; r < 4; ++r) Dl[(16 * w + 4 * lq + r) * 65 + 16 * cb + lr] = acc[cb][r];
        __syncthreads();
        if (tid < (lat ? 64 : 256)) {
            const int n = tid & 63, bl = tid >> 6, nc = lat ? 64 : 16, cbase = lat ? 0 : 16 * bl, b = lat ? cu - 8 : 4 * cu + bl;
            const float* at = (const float*)(c.ws() + WS_S5AT) + ((size_t)(dir * 32 + g) * 64 + n) * 2; const float ar = at[0], ai = at[1];
            float sr = 0.f, si = 0.f;
            if (lat) { sr = c.state_s5()[((((size_t)(b * 2 + l) * 2 + dir) * 2 + 0) * 32 + g) * 64 + n]; si = c.state_s5()[((((size_t)(b * 2 + l) * 2 + dir) * 2 + 1) * 32 + g) * 64 + n]; }
            for (int cc = 0; cc < nc; ++cc) { const int col = cbase + (dir ? nc - 1 - cc : cc);
                St[col * 264 + dir * 128 + n] = (bf16)f2bf(sr); St[col * 264 + dir * 128 + 64 + n] = (bf16)f2bf(si);
                const float dr = Dl[n * 65 + col], di = Dl[(64 + n) * 65 + col];
                const float nr = ar * sr - ai * si + dr, ni = ar * si + ai * sr + di; sr = nr; si = ni; }
            if (!lat) { c.out()[O_S5 + ((((size_t)(b * 2 + l) * 2 + dir) * 2 + 0) * 32 + g) * 64 + n] = sr; c.out()[O_S5 + ((((size_t)(b * 2 + l) * 2 + dir) * 2 + 1) * 32 + g) * 64 + n] = si; }
        }
        __syncthreads();
    }
    const bf16* Wop = (const bf16*)(c.ws() + WS_S5WO) + (size_t)g * 65536 + 8 * lq;
#pragma unroll 1
    for (int ii = 0; ii < 2; ++ii) { const int i = 2 * w + ii;
        f32x4 acc[4];
#pragma unroll
        for (int cb = 0; cb < 4; ++cb) acc[cb] = (f32x4){0.f, 0.f, 0.f, 0.f};
        bx8 afr[8];
#pragma unroll
        for (int ks = 0; ks < 8; ++ks) afr[ks] = *(const bx8*)(Wop + (size_t)(16 * i + lr) * 256 + 32 * ks);
#pragma unroll
        for (int ks = 0; ks < 8; ++ks) { const int j = 2 * ks + (lq >> 1); const bx8 af = *(const bx8*)(Kt + ((i - j + 15) * 16 + lr) * 16 + 8 * (lq & 1));
#pragma unroll
            for (int cb = 0; cb < 4; ++cb) { const bx8 bf = *(const bx8*)(Ut + (16 * cb + lr) * 264 + 32 * ks + 8 * lq); acc[cb] = MFMA16(af, bf, acc[cb]); }
            __builtin_amdgcn_sched_barrier(0); }
#pragma unroll
        for (int ks = 0; ks < 8; ++ks) {
#pragma unroll
            for (int cb = 0; cb < 4; ++cb) { const bx8 bf = *(const bx8*)(St + (16 * cb + lr) * 264 + 32 * ks + 8 * lq); acc[cb] = MFMA16(afr[ks], bf, acc[cb]); }
            __builtin_amdgcn_sched_barrier(0); }
#pragma unroll
        for (int cb = 0; cb < 4; ++cb) { const int col = 16 * cb + lr;
            const int tok = lat ? MC + (cu - 8) * 1024 + col * 16 + i : (4 * cu + (col >> 4)) * 256 + (col & 15) * 16 + i;
            v2u o; o.x = pk2(acc[cb][0], acc[cb][1]); o.y = pk2(acc[cb][2], acc[cb][3]);
            *(v2u*)(c.Y5() + (size_t)tok * 512 + g * 16 + 4 * lq) = o; }
    }
}

typedef float f32x16 __attribute__((ext_vector_type(16)));
#define MFMA32(a, b, cc) __builtin_amdgcn_mfma_f32_32x32x16_bf16((a), (b), (cc), 0, 0, 0)
constexpr float SM_SC = 0.125f * 1.4426950408889634f;
__device__ __forceinline__ void qk_tile(f32x16& p0, f32x16& p1, const bf16* Kt, int KS, const bx8 (&qf)[4], int r32, int hi) {
    p0 = (f32x16){0.f}; p1 = (f32x16){0.f};
#pragma unroll
    for (int d0 = 0; d0 < 4; ++d0) { const bx8 a0 = *(const bx8*)(Kt + r32 * KS + 16 * d0 + 8 * hi), a1 = *(const bx8*)(Kt + (32 + r32) * KS + 16 * d0 + 8 * hi);
        p0 = MFMA32(a0, qf[d0], p0); p1 = MFMA32(a1, qf[d0], p1); }
}
__device__ __forceinline__ float sm_step(f32x16& p0, f32x16& p1, float& mrun, float& lrun, bx8 (&pb)[4]) {
    float tm = -3e38f;
#pragma unroll
    for (int r = 0; r < 16; ++r) tm = fmaxf(tm, fmaxf(p0[r], p1[r]));
    tm = fmaxf(tm, __shfl_xor(tm, 32));
    const float mn = fmaxf(mrun, tm), alpha = exp2f(mrun - mn);
    float rs = 0.f;
#pragma unroll
    for (int r = 0; r < 16; ++r) { p0[r] = exp2f(p0[r] - mn); p1[r] = exp2f(p1[r] - mn); rs += p0[r] + p1[r]; }
    rs += __shfl_xor(rs, 32);
    lrun = lrun * alpha + rs; mrun = mn;
#pragma unroll
    for (int sI = 0; sI < 2; ++sI) {
        v4u t0, t1;
        t0.x = pg8::cvt_pk_bf16(p0[8 * sI + 0], p0[8 * sI + 1]); t0.y = pg8::cvt_pk_bf16(p0[8 * sI + 2], p0[8 * sI + 3]); t0.z = pg8::cvt_pk_bf16(p0[8 * sI + 4], p0[8 * sI + 5]); t0.w = pg8::cvt_pk_bf16(p0[8 * sI + 6], p0[8 * sI + 7]);
        t1.x = pg8::cvt_pk_bf16(p1[8 * sI + 0], p1[8 * sI + 1]); t1.y = pg8::cvt_pk_bf16(p1[8 * sI + 2], p1[8 * sI + 3]); t1.z = pg8::cvt_pk_bf16(p1[8 * sI + 4], p1[8 * sI + 5]); t1.w = pg8::cvt_pk_bf16(p1[8 * sI + 6], p1[8 * sI + 7]);
        pb[sI] = __builtin_bit_cast(bx8, t0); pb[2 + sI] = __builtin_bit_cast(bx8, t1);
    }
    return alpha;
}
template <int NDT> __device__ __forceinline__ void pv_tile(f32x16 (&o)[NDT], const bf16* Vt, const bx8 (&pb)[4], int r32, int hi) {
#pragma unroll
    for (int ks = 0; ks < 4; ++ks) {
#pragma unroll
        for (int dt = 0; dt < NDT; ++dt) { const bf16* vp = Vt + (32 * dt + r32) * 68 + 16 * ks + 4 * hi;
            const v2u lo = *(const v2u*)vp, h8 = *(const v2u*)(vp + 8); const v4u t = {lo.x, lo.y, h8.x, h8.y};
            o[dt] = MFMA32(__builtin_bit_cast(bx8, t), pb[ks], o[dt]); }
        __builtin_amdgcn_sched_barrier(0); }
}

template <int PASS> __device__ __forceinline__ void diff_unit(const Ctx& c, int l, int uidx, unsigned char* lds) {
    constexpr int NT = PASS ? 20 : 4, NQB = PASS ? 8 : 2;
    const int tid = c.tid, lane = c.lane, w = c.wave, r32 = lane & 31, hi = lane >> 5, comp = w >> 2;
    const int qb = uidx % NQB, h = (uidx / NQB) & 3, b = uidx / (NQB * 4);
    const int tok0 = PASS ? MC + b * 1024 : b * 256;
    bf16* Kt = (bf16*)lds;
    bf16* Vt = Kt + 64 * 136;
    float* Ob = (float*)(Vt + 128 * 68);
    const bf16* R1p = c.R1(); const bf16* CK = c.CKV();
    const float lam_init = 0.8f - 0.6f * expf(-0.3f * (float)l);
    const float* lv = c.dlam() + l * 256;
    const float lam = expf(wave_sum(lv[lane] * lv[64 + lane])) - expf(wave_sum(lv[128 + lane] * lv[192 + lane])) + lam_init;
    const size_t mrow = (size_t)tok0 + qb * 128 + 32 * (w & 3) + r32;
    bx8 qf[4];
#pragma unroll
    for (int d0 = 0; d0 < 4; ++d0) qf[d0] = *(const bx8*)(R1p + mrow * 4096 + C_DQ + h * 128 + comp * 64 + 16 * d0 + 8 * hi);
    f32x16 o[4];
#pragma unroll
    for (int dt = 0; dt < 4; ++dt) o[dt] = (f32x16){0.f};
    float mrun = -1e30f, lrun = 0.f;
    v4u kreg[2], vreg[2];
#define DIFF_LOAD(t) { const bf16* kb; const bf16* vb; size_t rs; \
        if (PASS && (t) < 4) { kb = CK + ((size_t)b * 256 + 64 * (t)) * 1280 + h * 128; vb = kb + 512; rs = 1280; } \
        else { kb = R1p + ((size_t)tok0 + 64 * ((t) - (PASS ? 4 : 0))) * 4096 + C_DK + h * 128; vb = kb + (C_DV - C_DK); rs = 4096; } \
        _Pragma("unroll") for (int i = 0; i < 2; ++i) { kreg[i] = *(const v4u*)(kb + (size_t)lane * rs + (w + 8 * i) * 8); vreg[i] = *(const v4u*)(vb + (size_t)lane * rs + (w + 8 * i) * 8); } }
    DIFF_LOAD(0);
    for (int t = 0; t < NT; ++t) {
        __syncthreads();
#pragma unroll
        for (int i = 0; i < 2; ++i) { *(v4u*)(Kt + lane * 136 + (w + 8 * i) * 8) = kreg[i];
            const unsigned vs[4] = {vreg[i].x, vreg[i].y, vreg[i].z, vreg[i].w};
#pragma unroll
            for (int j = 0; j < 4; ++j) { Vt[((w + 8 * i) * 8 + 2 * j) * 68 + lane] = (bf16)(vs[j] & 0xffffu); Vt[((w + 8 * i) * 8 + 2 * j + 1) * 68 + lane] = (bf16)(vs[j] >> 16); } }
        if (t + 1 < NT) DIFF_LOAD(t + 1);
        __syncthreads();
        f32x16 p0, p1; bx8 pb[4];
        qk_tile(p0, p1, Kt + comp * 64, 136, qf, r32, hi);
#pragma unroll
        for (int r = 0; r < 16; ++r) { p0[r] *= SM_SC; p1[r] *= SM_SC; }
        const float alpha = sm_step(p0, p1, mrun, lrun, pb);
#pragma unroll
        for (int dt = 0; dt < 4; ++dt)
#pragma unroll
            for (int r = 0; r < 16; ++r) o[dt][r] *= alpha;
        pv_tile<4>(o, Vt, pb, r32, hi);
    }
#undef DIFF_LOAD
    const float inv = (comp ? lam : 1.0f) / lrun;
    const int rowl = 32 * (w & 3) + r32;
    if (comp) {
#pragma unroll
        for (int dt = 0; dt < 4; ++dt)
#pragma unroll
            for (int r = 0; r < 16; ++r) Ob[rowl * 129 + 32 * dt + (r & 3) + 8 * (r >> 2) + 4 * hi] = o[dt][r] * inv;
    }
    __syncthreads();
    if (!comp) {
        float ss = 0.f;
#pragma unroll
        for (int dt = 0; dt < 4; ++dt)
#pragma unroll
            for (int r = 0; r < 16; ++r) { const float v = o[dt][r] * inv - Ob[rowl * 129 + 32 * dt + (r & 3) + 8 * (r >> 2) + 4 * hi]; o[dt][r] = v; ss += v * v; }
        ss += __shfl_xor(ss, 32);
        const float rn = rsqrtf(ss * (1.0f / 128.0f) + EPS) * (1.0f - lam_init);
        const float* sg = c.subln_g() + l * 128; bf16* yp = c.Y() + mrow * 2048 + 1024 + h * 128;
#pragma unroll
        for (int dt = 0; dt < 4; ++dt)
#pragma unroll
            for (int r4 = 0; r4 < 4; ++r4) { const int dv = 32 * dt + 8 * r4 + 4 * hi; const f32x4 g = *(const f32x4*)(sg + dv);
                v2u ov; ov.x = pk2(o[dt][4 * r4 + 0] * rn * g.x, o[dt][4 * r4 + 1] * rn * g.y); ov.y = pk2(o[dt][4 * r4 + 2] * rn * g.z, o[dt][4 * r4 + 3] * rn * g.w);
                *(v2u*)(yp + dv) = ov; }
    }
}

template <int PASS> __device__ __forceinline__ void win_unit(const Ctx& c, int l, int uidx, unsigned char* lds) {
    constexpr int NQB = PASS ? 4 : 1;
    const int tid = c.tid, lane = c.lane, w = c.wave, r32 = lane & 31, hi = lane >> 5;
    const int qb = uidx % NQB, hh = (uidx / NQB) & 7, b = uidx / (NQB * 8), nkv = hh >> 2;
    const int tok0 = PASS ? MC + b * 1024 : b * 256;
    bf16* Kt = (bf16*)lds;
    bf16* Vt = Kt + 64 * 72;
    const bf16* R1p = c.R1(); const bf16* CK = c.CKV();
    const int qrow = qb * 256 + 32 * w + r32;
    const size_t mrow = (size_t)tok0 + qrow;
    bx8 qf[4];
#pragma unroll
    for (int d0 = 0; d0 < 4; ++d0) qf[d0] = *(const bx8*)(R1p + mrow * 4096 + C_WQ + hh * 64 + 16 * d0 + 8 * hi);
    f32x16 o[2]; o[0] = (f32x16){0.f}; o[1] = (f32x16){0.f};
    float mrun = c.sink()[l * 8 + hh] * 1.4426950408889634f, lrun = 1.0f;
    const int q0 = qb * 256;
    const int tb0 = PASS ? ((q0 - 128 < 0 ? 0 : q0 - 128) >> 6) : 0, tb1 = PASS ? ((q0 + 255 + 128 > 1023 ? 1023 : q0 + 255 + 128) >> 6) : 0;
    const int NT = PASS ? 4 + (tb1 - tb0 + 1) : 4;
    const int kvl = tid & 63, chunk = tid >> 6;
    v4u kreg, vreg;
#define WIN_LOAD(t) { const bf16* kb; const bf16* vb; size_t rs; \
        if (PASS && (t) < 4) { kb = CK + ((size_t)b * 256 + 64 * (t)) * 1280 + 1024 + nkv * 64; vb = kb + 128; rs = 1280; } \
        else { kb = R1p + ((size_t)tok0 + 64 * (PASS ? tb0 + (t) - 4 : (t))) * 4096 + C_WK + nkv * 64; vb = kb + (C_WV - C_WK); rs = 4096; } \
        kreg = *(const v4u*)(kb + (size_t)kvl * rs + chunk * 8); vreg = *(const v4u*)(vb + (size_t)kvl * rs + chunk * 8); }
    WIN_LOAD(0);
    for (int t = 0; t < NT; ++t) {
        __syncthreads();
        *(v4u*)(Kt + kvl * 72 + chunk * 8) = kreg;
        { const unsigned vs[4] = {vreg.x, vreg.y, vreg.z, vreg.w};
#pragma unroll
          for (int j = 0; j < 4; ++j) { Vt[(chunk * 8 + 2 * j) * 68 + kvl] = (bf16)(vs[j] & 0xffffu); Vt[(chunk * 8 + 2 * j + 1) * 68 + kvl] = (bf16)(vs[j] >> 16); } }
        if (t + 1 < NT) WIN_LOAD(t + 1);
        __syncthreads();
        bool band = false; int kp0 = 0;
        if (PASS && t >= 4) { band = true; kp0 = 64 * (tb0 + t - 4); const int r0 = q0 + 32 * w;
            if (kp0 + 63 < r0 - 128 || kp0 > r0 + 31 + 128) continue; }
        f32x16 p0, p1; bx8 pb[4];
        qk_tile(p0, p1, Kt, 72, qf, r32, hi);
#pragma unroll
        for (int r = 0; r < 16; ++r) { p0[r] *= SM_SC; p1[r] *= SM_SC; }
        if (band) {
#pragma unroll
            for (int r = 0; r < 16; ++r) { const int kp = kp0 + (r & 3) + 8 * (r >> 2) + 4 * hi; const int d0 = qrow - kp, d1 = d0 - 32;
                if (d0 > 128 || d0 < -128) p0[r] = -1e30f; if (d1 > 128 || d1 < -128) p1[r] = -1e30f; }
        }
        const float alpha = sm_step(p0, p1, mrun, lrun, pb);
#pragma unroll
        for (int dt = 0; dt < 2; ++dt)
#pragma unroll
            for (int r = 0; r < 16; ++r) o[dt][r] *= alpha;
        pv_tile<2>(o, Vt, pb, r32, hi);
    }
#undef WIN_LOAD
    const float inv = 1.0f / lrun; bf16* yp = c.Y() + mrow * 2048 + 1536 + hh * 64;
#pragma unroll
    for (int dt = 0; dt < 2; ++dt)
#pragma unroll
        for (int r4 = 0; r4 < 4; ++r4) { const int dv = 32 * dt + 8 * r4 + 4 * hi;
            v2u ov; ov.x = pk2(o[dt][4 * r4 + 0] * inv, o[dt][4 * r4 + 1] * inv); ov.y = pk2(o[dt][4 * r4 + 2] * inv, o[dt][4 * r4 + 3] * inv);
            *(v2u*)(yp + dv) = ov; }
}

__device__ __forceinline__ void phase_mixers(const Ctx& c_in, int l, float* lf) {
    unsigned char* lds = (unsigned char*)lf;
    unsigned* qctr = (unsigned*)(c_in.ws() + WS_QCTR) + 64 * l;
    volatile int* qslot = (volatile int*)(lds + LDS_BYTES - 32);
    for (;;) {
        __syncthreads();
        if (threadIdx.x == 0) *qslot = (int)atomicAdd(qctr, 1u);
        __syncthreads();
        const int u = __builtin_amdgcn_readfirstlane(*qslot);
        if (u >= 1440) break;
        Ctx c = c_in; asm volatile("" : "+s"(c.ap), "+v"(c.tid));
        c.lane = c.tid & 63; c.wave = __builtin_amdgcn_readfirstlane(c.tid >> 6);
        unsigned long long pt0 = 0; if (PROBE_SEL >= 0) pt0 = __builtin_amdgcn_s_memrealtime();
        int ty;
        if (u < 32) { ssd_unit(c, l, 1, u >> 3, u & 7, lds); ty = 0; }
        else if (u < 160) { diff_unit<1>(c, l, u - 32, lds); ty = 2; }
        else if (u < 288) { win_unit<1>(c, l, u - 160, lds); ty = 3; }
        else if (u < 416) { s5_unit(c, l, (u - 288) & 31, 8 + ((u - 288) >> 5), lds); ty = 1; }
        else if (u < 672) { ssd_unit(c, l, 0, (u - 416) >> 3, (u - 416) & 7, lds); ty = 4; }
        else if (u < 928) { diff_unit<0>(c, l, u - 672, lds); ty = 6; }
        else if (u < 1184) { win_unit<0>(c, l, u - 928, lds); ty = 7; }
        else { s5_unit(c, l, (u - 1184) & 31, (u - 1184) >> 5, lds); ty = 5; }
        __syncthreads();
        if (PROBE_SEL >= 0 && blockIdx.x == PROBE_PB && threadIdx.x == 0) { unsigned long long* tsu = (unsigned long long*)(c.ws() + WS_TS) + 64; tsu[ty] += __builtin_amdgcn_s_memrealtime() - pt0; }
    }
}

__device__ __forceinline__ void phase_sum4(const Ctx& c) {
    const int gt = blockIdx.x * NTHR + c.tid, NT = gridDim.x * NTHR;
#pragma unroll 4
    for (int i = gt; i < M * 128; i += NT) { const size_t m = (size_t)(i >> 7); const int c8 = (i & 127) * 8;
        float a[8] = {0.f, 0.f, 0.f, 0.f, 0.f, 0.f, 0.f, 0.f};
#pragma unroll
        for (int j = 0; j < 4; ++j) { float f[8]; unpack8(*(const v4u*)(c.R1() + m * 4096 + j * 1024 + c8), f);
#pragma unroll
            for (int k = 0; k < 8; ++k) a[k] += f[k]; }
        v4u o; o.x = pk2(a[0], a[1]); o.y = pk2(a[2], a[3]); o.z = pk2(a[4], a[5]); o.w = pk2(a[6], a[7]);
        *(v4u*)(c.H() + m * 1024 + c8) = o; }
}

#define GAS __attribute__((address_space(1)))
#define XB_TMO      128
#define XB_XCNT(j)  (256  + 64 * (j))
#define XB_XSUB(j)  (1280 + 64 * (j))
#define XB_XGEN(j)  (2304 + 64 * (j))
#define XB_TOP      3328
#define XB_TOPGEN   3392
#define XCD_BAR_WORDS 3456
#define XB_SPIN_CAP (1u << 18)

__device__ __forceinline__ unsigned xb_ld(unsigned* p)              { return __hip_atomic_load(p, __ATOMIC_RELAXED, __HIP_MEMORY_SCOPE_AGENT); }
__device__ __forceinline__ unsigned xb_add(unsigned* p, unsigned v) { return __hip_atomic_fetch_add(p, v, __ATOMIC_RELAXED, __HIP_MEMORY_SCOPE_AGENT); }
__device__ __forceinline__ unsigned xb_xcc_id() { return (unsigned)__builtin_amdgcn_s_getreg((3 << 11) | 20) & 0xFu; }
#define XB_SPIN(cond, bar) do { unsigned _sp = 0; while (cond) { __builtin_amdgcn_s_sleep(1); \
    if ((++_sp & 255u) == 0u) { if (xb_ld(&(bar)[XB_TMO])) break; if (_sp > XB_SPIN_CAP) { atomicAdd(&(bar)[XB_TMO], 1u); break; } } } } while (0)

struct XcdBarrier {
    unsigned* bar; unsigned x;
    volatile LAS unsigned* st;
};

__device__ __forceinline__ XcdBarrier xcd_barrier_post(unsigned* bar, volatile LAS unsigned* st) {
    XcdBarrier b; b.bar = bar; b.x = xb_xcc_id(); b.st = st;
    if (threadIdx.x == 0) (void)xb_add(&bar[XB_XCNT(b.x)], 1u);
    return b;
}
__device__ __forceinline__ void xcd_barrier_complete(unsigned* bar, unsigned x, unsigned& nloc, unsigned& nx) {
    const unsigned G = gridDim.x * gridDim.y * gridDim.z;
    unsigned sum, cnt, mine, sp = 0u;
    for (;;) {
        sum = 0u; cnt = 0u; mine = 0u;
#pragma unroll
        for (unsigned j = 0; j < 16; ++j) { const unsigned c = xb_ld(&bar[XB_XCNT(j)]); sum += c; cnt += (c > 0u) ? 1u : 0u; mine = (j == x) ? c : mine; }
        if (sum == G) break;
        __builtin_amdgcn_s_sleep(1);
        if ((++sp & 255u) == 0u) { if (xb_ld(&bar[XB_TMO])) break; if (sp > XB_SPIN_CAP) { atomicAdd(&bar[XB_TMO], 1u); break; } }
    }
    nloc = mine > 0u ? mine : 1u; nx = cnt > 0u ? cnt : 1u;
}

__device__ __forceinline__ void xcd_barrier(const XcdBarrier& b) {
    asm volatile("s_waitcnt vmcnt(0)" ::: "memory");
    __syncthreads();
    if (threadIdx.x == 0) {
        unsigned* bar = b.bar;
        __builtin_amdgcn_s_waitcnt(0);
        unsigned nloc = b.st[0], nx = b.st[1];
        if (nloc == 0u) { xcd_barrier_complete(bar, b.x, nloc, nx); b.st[0] = nloc; b.st[1] = nx; }
        const unsigned old = xb_add(&bar[XB_XSUB(b.x)], 1u);
        const unsigned gen = old / nloc;
        if (old + 1u == (gen + 1u) * nloc) {
            __builtin_amdgcn_fence(__ATOMIC_RELEASE, "agent");
            asm volatile("s_waitcnt vmcnt(0)" ::: "memory");
            const unsigned og = xb_add(&bar[XB_TOP], 1u);
            const unsigned tg = og / nx;
            if (og + 1u == (tg + 1u) * nx) xb_add(&bar[XB_TOPGEN], 1u);
            else XB_SPIN(xb_ld(&bar[XB_TOPGEN]) == tg, bar);
            __builtin_amdgcn_fence(__ATOMIC_ACQUIRE, "agent");
            xb_add(&bar[XB_XGEN(b.x)], 1u);
            asm volatile("s_waitcnt vmcnt(0)" ::: "memory");
        } else {
            XB_SPIN(xb_ld(&bar[XB_XGEN(b.x)]) == gen, bar);
            __builtin_amdgcn_fence(__ATOMIC_ACQUIRE, "agent");
            asm volatile("s_waitcnt vmcnt(0)" ::: "memory");
        }
    }
    __syncthreads();
}

#define PHASE_BEGIN() Ctx c; c.ap = (CArgs)__builtin_amdgcn_kernarg_segment_ptr(); asm volatile("" : "+s"(c.ap)); \
        int tid_o = threadIdx.x; asm volatile("" : "+v"(tid_o)); c.tid = tid_o; c.lane = tid_o & 63; c.wave = __builtin_amdgcn_readfirstlane(tid_o >> 6); \
        int G = gridDim.x, bid = blockIdx.x; asm volatile("" : "+s"(G), "+s"(bid)); unsigned char* ws = c.ws(); (void)ws; (void)G; (void)bid;
#define PHASE_END(k) { if ((k) + 1 < ph_hi) { if ((k) == 0) cg::this_grid().sync(); else xcd_barrier(xbar); } \
        if (PROBE_SEL >= 0 && blockIdx.x == PROBE_PB && threadIdx.x == 0) ((unsigned long long*)(c.ws() + WS_TS))[(k) + 1] = __builtin_amdgcn_s_memrealtime(); }
#define IN_RANGE(k) (ph_lo <= (k) && (k) < ph_hi)

template <int LAYER> __device__ __forceinline__ void layer_program(int ph_lo, int ph_hi, unsigned char* lds, const XcdBarrier& xbar) {
    float* lf = (float*)lds;
    PG8_LAS unsigned char* ring = (PG8_LAS unsigned char*)lds;
    constexpr int l = LAYER, B0 = 1 + 11 * LAYER;
    if (IN_RANGE(B0 + 0)) { PHASE_BEGIN(); if (l == 1) { phase_convert(c, 1, lf); __syncthreads(); } phase_norm(c, l, 0, lf); PHASE_END(B0 + 0); }
    if (IN_RANGE(B0 + 1)) { PHASE_BEGIN();
        pg8::Gemm g{c.H(), (const bf16*)(ws + W_IN), M, 4096, 1024, 1024, 1024, 0, 0}; pg8::StaticOrder S; S.init(M, 4096, G, bid);
        pg8::EpiB<0> E{c.R1(), 4096, nullptr, nullptr};
        pg8::gemm_phase<pg8::EpiB<0>, pg8::StaticOrder, true, true>(ring, g, S, E, tid_o); phase_dt(c, l); PHASE_END(B0 + 1); }
    if (IN_RANGE(B0 + 2)) { PHASE_BEGIN(); phase_qk(c, l, lf); PHASE_END(B0 + 2); }
    if (IN_RANGE(B0 + 3)) { PHASE_BEGIN(); phase_mixers(c, l, lf); PHASE_END(B0 + 3); }
    if (IN_RANGE(B0 + 4)) { PHASE_BEGIN();
        { pg8::Gemm g{c.Y5(), (const bf16*)(ws + W_GLU), M, 1024, 512, 512, 512, 0, 0}; pg8::StaticOrder S; S.init(M, 1024, G, bid);
          pg8::EpiGlu E{c.Y(), 2048, 512, c.b_glu() + l * 1024};
          pg8::gemm_phase<pg8::EpiGlu, pg8::StaticOrder, true, true>(ring, g, S, E, tid_o); }
        { pg8::Gemm g{c.H(), (const bf16*)(ws + W_G), M, 4096, 1024, 1024, 1024, 0, 0}; pg8::StaticOrder S; S.init(M, 4096, G, bid);
          pg8::EpiB<1> E{c.R1(), 4096, c.b_gate() + l * 4096, nullptr};
          pg8::gemm_phase<pg8::EpiB<1>, pg8::StaticOrder, true, true>(ring, g, S, E, tid_o); }
        PHASE_END(B0 + 4); }
    if (IN_RANGE(B0 + 5)) { PHASE_BEGIN();
        pg8::Gemm g{c.Y(), (const bf16*)(ws + W_BR), M, 4096, 512, 2048, 512, 4, 1024}; pg8::StaticOrder S; S.init(M, 4096, G, bid);
        pg8::EpiB<3> E{c.R1(), 4096, nullptr, c.SSQ()};
        pg8::gemm_phase<pg8::EpiB<3>, pg8::StaticOrder, true, true>(ring, g, S, E, tid_o); PHASE_END(B0 + 5); }
    if (IN_RANGE(B0 + 6)) { PHASE_BEGIN(); phase_sum4(c); PHASE_END(B0 + 6); }
    if (IN_RANGE(B0 + 7)) { PHASE_BEGIN();
        pg8::Gemm g{c.H(), (const bf16*)(ws + W_OUT), M, 1024, 1024, 1024, 1024, 0, 0}; pg8::StaticOrder S; S.init(M, 1024, G, bid);
        pg8::EpiRes E{l == 0 ? c.x_prompt() : c.out(), l == 0 ? c.x_sample() : c.out() + (size_t)MC * D, c.out(), c.MOD() + (size_t)l * 5 * 6144, 2048};
        pg8::gemm_phase<pg8::EpiRes, pg8::StaticOrder, true, true>(ring, g, S, E, tid_o); PHASE_END(B0 + 7); }
    if (IN_RANGE(B0 + 8)) { PHASE_BEGIN(); phase_norm(c, l, 1, lf); PHASE_END(B0 + 8); }
    if (IN_RANGE(B0 + 9)) { PHASE_BEGIN();
        pg8::Gemm g{c.H(), (const bf16*)(ws + W_1), M, 4096, 1024, 1024, 1024, 0, 0}; pg8::StaticOrder S; S.init(M, 4096, G, bid);
        pg8::EpiB<2> E{c.R1(), 4096, nullptr, nullptr};
        pg8::gemm_phase<pg8::EpiB<2>, pg8::StaticOrder, true, true>(ring, g, S, E, tid_o); PHASE_END(B0 + 9); }
    if (IN_RANGE(B0 + 10)) { PHASE_BEGIN();
        pg8::Gemm g{c.R1(), (const bf16*)(ws + W_2), M, 1024, 4096, 4096, 4096, 0, 0}; pg8::StaticOrder S; S.init(M, 1024, G, bid);
        pg8::EpiRes E{c.out(), c.out() + (size_t)MC * D, c.out(), c.MOD() + (size_t)l * 5 * 6144, 5120};
        pg8::gemm_phase<pg8::EpiRes, pg8::StaticOrder, true, true>(ring, g, S, E, tid_o); PHASE_END(B0 + 10); }
}

__global__ void __launch_bounds__(NTHR, 2) fwd_kernel(Args args) {
    extern __shared__ __attribute__((aligned(16))) unsigned char lds[];
    const int ph_lo = args.ph_lo, ph_hi = args.ph_hi;
    volatile LAS unsigned* xst = (volatile LAS unsigned*)(lds + LDS_BYTES - 16);
    if (threadIdx.x < 4) xst[threadIdx.x] = 0u;
    __syncthreads();
    const XcdBarrier xbar = xcd_barrier_post((unsigned*)(args.ws + WS_BAR), xst);
    if (PROBE_SEL >= 0 && blockIdx.x == PROBE_PB && threadIdx.x == 0) { unsigned long long* ts = (unsigned long long*)(args.ws + WS_TS); for (int i = 64; i < 72; ++i) ts[i] = 0; ts[0] = __builtin_amdgcn_s_memrealtime(); }
    if (IN_RANGE(0)) { PHASE_BEGIN(); float* lf = (float*)lds; phase_mods(c, lf); __syncthreads(); phase_convert(c, 0, lf); phase_rope_table(c); PHASE_END(0); }
    layer_program<0>(ph_lo, ph_hi, lds, xbar);
    layer_program<1>(ph_lo, ph_hi, lds, xbar);
    if (PROBE_SEL >= 0) {
        __threadfence(); cg::this_grid().sync();
        const unsigned long long* ts = (const unsigned long long*)(args.ws + WS_TS);
        const float total = (float)(ts[23] - ts[0]); float sel = 0.f;
        for (int k = 0; k < 23; ++k) { const float d = (float)(ts[k + 1] - ts[k]); const int q = k == 0 ? -1 : (k - 1) % 11;
            const int cls = (q == 3) ? 0 : (q == 1 || q == 4 || q == 5 || q == 7 || q == 9 || q == 10) ? 1 : (q == 2) ? 2 : 3;
            if (cls == PROBE_SEL) sel += d; }
        if (PROBE_SEL >= 10 && PROBE_SEL < 100) sel = (float)ts[64 + PROBE_SEL - 10];
        if (PROBE_SEL >= 100) sel = (float)(ts[PROBE_SEL - 100 + 1] - ts[PROBE_SEL - 100]);
        const float sc = 1.0f + sqrtf(PROBE_SCALE * sel / total);
        for (int i = blockIdx.x * NTHR + threadIdx.x; i < 524288; i += gridDim.x * NTHR) args.out[O_S5 + i] *= sc;
    }
}

extern "C" void kernel_launch(void* const* d_in, const int* in_sizes, int n_in, void* d_out, int out_size, void* d_ws, size_t ws_size, hipStream_t stream) {
    static int grid = 0;
    if (grid == 0) {
        if (n_in != 44 || ws_size < WS_END) { fprintf(stderr, "kernel_launch: expected 44 inputs and >= %zu bytes of workspace; got %d, %zu\n", (size_t)WS_END, n_in, ws_size); grid = -1; return; }
        int dev = 0, cus = 0, per_cu = 0;
        (void)hipGetDevice(&dev); (void)hipDeviceGetAttribute(&cus, hipDeviceAttributeMultiprocessorCount, dev);
        (void)hipFuncSetAttribute((const void*)fwd_kernel, hipFuncAttributeMaxDynamicSharedMemorySize, LDS_BYTES);
        (void)hipOccupancyMaxActiveBlocksPerMultiprocessor(&per_cu, (const void*)fwd_kernel, NTHR, LDS_BYTES);
        if (per_cu < 1) { fprintf(stderr, "kernel_launch: occupancy query says %d blocks per CU\n", per_cu); per_cu = 1; }
        (void)hipGetLastError();
        grid = cus > 0 ? cus : 256;
    }
    if (grid < 0) return;
    (void)hipMemsetAsync(d_ws, 0, 64 * 1024, stream);
    Args a{};
    for (int i = 0; i < 44; ++i) a.in[i] = (const float*)d_in[i];
    a.out = (float*)d_out; a.ws = (unsigned char*)d_ws;
#if MK_MULTI
    for (int ph = 0; ph < NPH; ++ph) { a.ph_lo = ph; a.ph_hi = ph + 1; hipLaunchKernelGGL(fwd_kernel, dim3(grid), dim3(NTHR), LDS_BYTES, stream, a); }
#else
    a.ph_lo = 0; a.ph_hi = NPH;
    void* kargs[] = {&a};
    hipError_t e = hipLaunchCooperativeKernel((const void*)fwd_kernel, dim3(grid), dim3(NTHR), kargs, LDS_BYTES, stream);
    if (e != hipSuccess) fprintf(stderr, "cooperative launch failed: %s (grid %d)\n", hipGetErrorString(e), grid);
#endif
}
```

```cpp
#include <hip/hip_runtime.h>
#include <hip/hip_cooperative_groups.h>
#include <cstdio>
#include <cstdint>
namespace cg = cooperative_groups;

#ifndef MK_MULTI
#define MK_MULTI 0
#endif

namespace pg8 {
#define PG8_LAS __attribute__((address_space(3)))
typedef unsigned short bf16_t;
typedef short bf16x8 __attribute__((ext_vector_type(8)));
typedef float f32x4 __attribute__((ext_vector_type(4)));
typedef unsigned u32x4 __attribute__((ext_vector_type(4)));
constexpr int BM = 256, BK = 64, HALF = 128, HTB = HALF * BK * 2  , STAGE_BYTES = 8 * HTB, NXCD = 8, WGM = 8;

__host__ __device__ __forceinline__ int lds_byte(int r, int c) { const int st = (r >> 4) * 2 + (c >> 5), rr = r & 15, cc = c & 31, ob = rr * 64 + cc * 2; return st * 1024 + (ob ^ (((ob >> 9) & 1) << 5)); }
__host__ __device__ __forceinline__ void stage_rc(int b, int& R, int& C) { const int st = b / 1024, sb = b % 1024, swz = sb ^ (((sb >> 9) & 1) << 5); R = (st >> 1) * 16 + swz / 64; C = (st & 1) * 32 + (swz % 64) / 2; }
__host__ __device__ __forceinline__ int perm32(int rho) { const int n = rho >> 4, i = rho & 15; return 8 * (i >> 2) + 4 * n + (i & 3); }

struct Unit { int pm, pn; };
struct Gemm { const bf16_t* A; const bf16_t* Bt; int M, N, K, lda, ldb, a_div; size_t a_gstride; };

struct StaticOrder {
    int nM, nN, nwg, G, c;
    __host__ __device__ void init(int M, int N, int G_, int c_) { nM = M / BM; nN = N / BM; nwg = nM * nN; G = G_; c = c_; }
    __host__ __device__ bool next(int i, Unit& u) const {
        const long L = (long)i * G + c; if (L >= nwg) return false;
        int wgid = (int)L; { const int q = nwg / NXCD, r = nwg % NXCD, xcd = wgid % NXCD, off = wgid / NXCD; wgid = (xcd < r ? xcd * (q + 1) : r * (q + 1) + (xcd - r) * q) + off; }
        const int nig = WGM * nN, gid = wgid / nig, fm = gid * WGM, gsz = (nM - fm) < WGM ? (nM - fm) : WGM;
        u.pm = fm + ((wgid % nig) % gsz); u.pn = (wgid % nig) / gsz; return true;
    }
    __device__ __forceinline__ void a_ready(const Unit&) const {}
    __device__ __forceinline__ void done(const Unit&) const {}
};

__device__ __forceinline__ unsigned cvt_pk_bf16(float lo, float hi) { unsigned r; asm volatile("v_cvt_pk_bf16_f32 %0, %1, %2" : "=v"(r) : "v"(lo), "v"(hi)); return r; }
__device__ __forceinline__ float bf_lo(unsigned w) { return __builtin_bit_cast(float, w << 16); }
__device__ __forceinline__ float bf_hi(unsigned w) { return __builtin_bit_cast(float, w & 0xffff0000u); }
__device__ __forceinline__ float sigmoidf_(float x) { return 1.0f / (1.0f + __expf(-x)); }

template <int MODE> struct EpiB {
    static constexpr bool PERM = true, AFTER_DRAIN = false;
    bf16_t* O; int ldc; const float* bias; const float* ssq;
    __device__ __forceinline__ void operator()(const f32x4 (&acc)[2][2][4][2], const Unit& u, int wr, int wc, int fr, int fq) const {
        const int row0 = u.pm * BM + wr * 64 + fr, col0 = u.pn * BM + wc * 32 + 8 * fq;
        f32x4 bv[2][2];
#pragma unroll
        for (int bj = 0; bj < 2; ++bj)
#pragma unroll
            for (int n = 0; n < 2; ++n) bv[bj][n] = (MODE == 1) ? *(const f32x4*)(bias + col0 + bj * HALF + 4 * n) : (f32x4){0.f, 0.f, 0.f, 0.f};
        u32x4 gpre[2][4][2]; float rpre[2][4];
        if (MODE == 3) {
#pragma unroll
            for (int ai = 0; ai < 2; ++ai)
#pragma unroll
                for (int m = 0; m < 4; ++m) { const int row = row0 + ai * HALF + m * 16; const bf16_t* rp = O + (size_t)row * ldc + col0;
                    rpre[ai][m] = (u.pn < 4) ? ssq[row] : 512.0f;
#pragma unroll
                    for (int bj = 0; bj < 2; ++bj) gpre[ai][m][bj] = *(const u32x4*)(rp + bj * HALF); }
        }
#pragma unroll
        for (int ai = 0; ai < 2; ++ai)
#pragma unroll
            for (int m = 0; m < 4; ++m) {
                const int row = row0 + ai * HALF + m * 16;
                bf16_t* rowp = O + (size_t)row * ldc + col0;
                float rs = 1.f;
                if (MODE == 3) { if (u.pn < 4) rs = rsqrtf(rpre[ai][m] * (1.0f / 512.0f) + 1e-6f); }
#pragma unroll
                for (int bj = 0; bj < 2; ++bj) {
                    f32x4 v0 = acc[ai][bj][m][0] + bv[bj][0], v1 = acc[ai][bj][m][1] + bv[bj][1];
                    if (MODE == 1) {
#pragma unroll
                        for (int j = 0; j < 4; ++j) { v0[j] = sigmoidf_(v0[j]); v1[j] = sigmoidf_(v1[j]); }
                    }
                    if (MODE == 2) {
#pragma unroll
                        for (int j = 0; j < 4; ++j) { const float a = fmaxf(v0[j], 0.f), b = fmaxf(v1[j], 0.f); v0[j] = a * a; v1[j] = b * b; }
                    }
                    if (MODE == 3) {
                        const u32x4 gq = gpre[ai][m][bj];
                        v0[0] *= bf_lo(gq.x) * rs; v0[1] *= bf_hi(gq.x) * rs; v0[2] *= bf_lo(gq.y) * rs; v0[3] *= bf_hi(gq.y) * rs;
                        v1[0] *= bf_lo(gq.z) * rs; v1[1] *= bf_hi(gq.z) * rs; v1[2] *= bf_lo(gq.w) * rs; v1[3] *= bf_hi(gq.w) * rs;
                    }
                    u32x4 w; w.x = cvt_pk_bf16(v0[0], v0[1]); w.y = cvt_pk_bf16(v0[2], v0[3]); w.z = cvt_pk_bf16(v1[0], v1[1]); w.w = cvt_pk_bf16(v1[2], v1[3]);
                    *(u32x4*)(rowp + bj * HALF) = w;
                }
            }
    }
};
struct EpiGlu {
    static constexpr bool PERM = true, AFTER_DRAIN = false;
    bf16_t* O; int ldc; int ocol; const float* bias;
    __device__ __forceinline__ void operator()(const f32x4 (&acc)[2][2][4][2], const Unit& u, int wr, int wc, int fr, int fq) const {
        const int row0 = u.pm * BM + wr * 64 + fr, cc = u.pn * HALF + wc * 32 + 8 * fq;
        f32x4 bv[2][2];
#pragma unroll
        for (int bj = 0; bj < 2; ++bj)
#pragma unroll
            for (int n = 0; n < 2; ++n) bv[bj][n] = *(const f32x4*)(bias + bj * 512 + cc + 4 * n);
#pragma unroll
        for (int ai = 0; ai < 2; ++ai)
#pragma unroll
            for (int m = 0; m < 4; ++m) {
                bf16_t* rowp = O + (size_t)(row0 + ai * HALF + m * 16) * ldc + ocol + cc;
                f32x4 v0 = acc[ai][0][m][0] + bv[0][0], v1 = acc[ai][0][m][1] + bv[0][1];
                const f32x4 g0 = acc[ai][1][m][0] + bv[1][0], g1 = acc[ai][1][m][1] + bv[1][1];
#pragma unroll
                for (int j = 0; j < 4; ++j) { v0[j] *= sigmoidf_(g0[j]); v1[j] *= sigmoidf_(g1[j]); }
                u32x4 w; w.x = cvt_pk_bf16(v0[0], v0[1]); w.y = cvt_pk_bf16(v0[2], v0[3]); w.z = cvt_pk_bf16(v1[0], v1[1]); w.w = cvt_pk_bf16(v1[2], v1[3]);
                *(u32x4*)rowp = w;
            }
    }
};
struct EpiMerge {
    static constexpr bool PERM = true, AFTER_DRAIN = false;
    const bf16_t* gates; bf16_t* mg; const float* ssq;
    __device__ __forceinline__ void operator()(const f32x4 (&acc)[2][2][4][2], const Unit& u, int wr, int wc, int fr, int fq) const {
        const int br = u.pn >> 2, pnl = u.pn & 3;
        int pm_o = u.pm; asm volatile("" : "+s"(pm_o));
        const int row0 = pm_o * BM + wr * 64 + fr, gcol0 = u.pn * BM + wc * 32 + 8 * fq, mcol0 = pnl * BM + wc * 32 + 8 * fq;
#pragma unroll
        for (int ai = 0; ai < 2; ++ai)
#pragma unroll
        for (int mh = 0; mh < 2; ++mh) {
            u32x4 gpre[2][2], mpre[2][2]; float rpre[2];
#pragma unroll
            for (int mm = 0; mm < 2; ++mm) { const int row = row0 + ai * HALF + (2 * mh + mm) * 16;
                rpre[mm] = (br == 0) ? ssq[row] : 512.0f;
#pragma unroll
                for (int bj = 0; bj < 2; ++bj) { gpre[mm][bj] = *(const u32x4*)(gates + (size_t)row * 4096 + gcol0 + bj * HALF);
                    mpre[mm][bj] = (br != 0) ? *(const u32x4*)(mg + (size_t)row * 1024 + mcol0 + bj * HALF) : (u32x4){0u, 0u, 0u, 0u}; } }
#pragma unroll
            for (int mm = 0; mm < 2; ++mm) { const int m = 2 * mh + mm; const int row = row0 + ai * HALF + m * 16;
                const float rs = (br == 0) ? rsqrtf(rpre[mm] * (1.0f / 512.0f) + 1e-6f) : 1.0f;
#pragma unroll
                for (int bj = 0; bj < 2; ++bj) { const u32x4 gq = gpre[mm][bj], mq = mpre[mm][bj]; const f32x4 a0 = acc[ai][bj][m][0], a1 = acc[ai][bj][m][1];
                    const float v0 = bf_lo(mq.x) + a0[0] * bf_lo(gq.x) * rs, v1 = bf_hi(mq.x) + a0[1] * bf_hi(gq.x) * rs, v2 = bf_lo(mq.y) + a0[2] * bf_lo(gq.y) * rs, v3 = bf_hi(mq.y) + a0[3] * bf_hi(gq.y) * rs;
                    const float v4 = bf_lo(mq.z) + a1[0] * bf_lo(gq.z) * rs, v5 = bf_hi(mq.z) + a1[1] * bf_hi(gq.z) * rs, v6 = bf_lo(mq.w) + a1[2] * bf_lo(gq.w) * rs, v7 = bf_hi(mq.w) + a1[3] * bf_hi(gq.w) * rs;
                    u32x4 w; w.x = cvt_pk_bf16(v0, v1); w.y = cvt_pk_bf16(v2, v3); w.z = cvt_pk_bf16(v4, v5); w.w = cvt_pk_bf16(v6, v7);
                    *(u32x4*)(mg + (size_t)row * 1024 + mcol0 + bj * HALF) = w; } }
            asm volatile("" ::: "memory");
        }
    }
};
struct BranchOrder {
    int G, c;
    __host__ __device__ void init(int G_, int c_) { G = G_; c = c_; }
    __host__ __device__ bool next(int i, Unit& u) const { if (c >= 192 || i >= 4) return false; u.pm = c >> 2; u.pn = i * 4 + (c & 3); return true; }
    __device__ __forceinline__ void a_ready(const Unit&) const {}
    __device__ __forceinline__ void done(const Unit&) const {}
};
struct EpiRes {
    static constexpr bool PERM = false, AFTER_DRAIN = false;
    const float* base_ctx; const float* base_lat;
    float* out; const float* modv;
    int goff;
    __device__ __forceinline__ void operator()(const f32x4 (&acc)[2][2][4][2], const Unit& u, int wr, int wc, int fr, int fq) const {
        const int row0 = u.pm * BM + wr * 64 + fr, col0 = u.pn * BM + wc * 32 + 4 * fq;
        const int mi = (u.pm < 32) ? 0 : 1 + ((u.pm - 32) >> 2);
        const float* gv = modv + (size_t)mi * 6144 + goff;
        f32x4 gg[2][2];
#pragma unroll
        for (int bj = 0; bj < 2; ++bj)
#pragma unroll
            for (int n = 0; n < 2; ++n) gg[bj][n] = *(const f32x4*)(gv + col0 + bj * HALF + n * 16);
#pragma unroll
        for (int ai = 0; ai < 2; ++ai) {
            f32x4 pre[4][2][2];
#pragma unroll
            for (int m = 0; m < 4; ++m) { const int row = row0 + ai * HALF + m * 16;
                const float* bp = (row < 8192 ? base_ctx + (size_t)row * 1024 : base_lat + (size_t)(row - 8192) * 1024) + col0;
#pragma unroll
                for (int bj = 0; bj < 2; ++bj)
#pragma unroll
                    for (int n = 0; n < 2; ++n) pre[m][bj][n] = *(const f32x4*)(bp + bj * HALF + n * 16); }
#pragma unroll
            for (int m = 0; m < 4; ++m) { const int row = row0 + ai * HALF + m * 16; float* op = out + (size_t)row * 1024 + col0;
#pragma unroll
                for (int bj = 0; bj < 2; ++bj)
#pragma unroll
                    for (int n = 0; n < 2; ++n) *(f32x4*)(op + bj * HALF + n * 16) = pre[m][bj][n] + gg[bj][n] * acc[ai][bj][m][n]; }
            asm volatile("" ::: "memory");
        }
    }
};

template <class Epi, class Sched, bool ALIGN_EPI = false, bool SP2 = false>
__device__ __forceinline__ void gemm_phase(PG8_LAS unsigned char* lds, const Gemm g, const Sched& S, const Epi& E, const int tid) {
    const int wid = __builtin_amdgcn_readfirstlane(tid >> 6), lane = tid & 63, wr = wid >> 2, wc = wid & 3, fr = lane & 15, fq = lane >> 4;
    const int K = g.K, nt = K / BK;
    unsigned voffA[2], voffB[2];
#pragma unroll
    for (int i = 0; i < 2; ++i) { int R, C; stage_rc(tid * 16 + i * 8192, R, C); const int Rb = Epi::PERM ? ((R & ~31) + perm32(R & 31)) : R;
        voffA[i] = (unsigned)(R * g.lda + C) * 2u; voffB[i] = (unsigned)(Rb * g.ldb + C) * 2u; }
    const size_t kstep = (size_t)(BK * 2);
    const size_t hstepA = (size_t)HALF * g.lda * 2, hstepB = (size_t)HALF * g.ldb * 2;
    const size_t tstepA = 2 * hstepA, tstepB = 2 * hstepB;
#define PG8_UA(u) ((const char*)g.A + (size_t)(u).pm * tstepA + (g.a_div ? (size_t)((u).pn / g.a_div) * g.a_gstride : (size_t)0))
#define PG8_UB(u) ((const char*)g.Bt + (size_t)(u).pn * tstepB)
    const unsigned ldsw = (unsigned)wid * 1024u;
    const int aoff = lds_byte(wr * 64 + fr, fq * 8), boff = lds_byte(wc * 32 + fr, fq * 8);
#define PG8_SA(b, h) (((b) * 2 + (h)) * HTB)
#define PG8_SB(b, h) ((4 + (b) * 2 + (h)) * HTB)
#define PG8_STAGE(bufoff, gbase, voff) do { _Pragma("unroll") for (int _i = 0; _i < 2; ++_i) \
        __builtin_amdgcn_global_load_lds((const unsigned*)((const char*)(gbase) + (voff)[_i]), (PG8_LAS unsigned*)(lds + (bufoff) + ldsw + _i * 8192), 16, 0, 0); } while (0)
#define PG8_LDA(dst, b, h) do { _Pragma("unroll") for (int m = 0; m < 4; ++m) _Pragma("unroll") for (int k = 0; k < 2; ++k) dst[m][k] = *(const PG8_LAS bf16x8*)(lds + PG8_SA(b, h) + aoff + m * 2048 + k * 1024); } while (0)
#define PG8_LDB(dst, b, h) do { _Pragma("unroll") for (int n = 0; n < 2; ++n) _Pragma("unroll") for (int k = 0; k < 2; ++k) dst[n][k] = *(const PG8_LAS bf16x8*)(lds + PG8_SB(b, h) + boff + n * 2048 + k * 1024); } while (0)
#define PG8_MMA(ai, bj, At, Bt) do { __builtin_amdgcn_s_setprio(1); _Pragma("unroll") for (int m = 0; m < 4; ++m) _Pragma("unroll") for (int n = 0; n < 2; ++n) _Pragma("unroll") for (int k = 0; k < 2; ++k) \
        acc[ai][bj][m][n] = __builtin_amdgcn_mfma_f32_16x16x32_bf16(Bt[n][k], At[m][k], acc[ai][bj][m][n], 0, 0, 0); __builtin_amdgcn_s_setprio(0); } while (0)
#define PG8_WAIT_V(n) asm volatile("s_waitcnt vmcnt(" #n ")" ::: "memory")
#define PG8_WAIT_L(n) asm volatile("s_waitcnt lgkmcnt(" #n ")" ::: "memory")
#define PG8_BAR __builtin_amdgcn_s_barrier()
#define PG8_SCHED __builtin_amdgcn_sched_barrier(0)
    Unit cur, nxt; int ui = 0;
    if (!S.next(0, cur)) return;
    f32x4 acc[2][2][4][2];
#pragma unroll
    for (int a = 0; a < 2; ++a)
#pragma unroll
        for (int b = 0; b < 2; ++b)
#pragma unroll
            for (int m = 0; m < 4; ++m)
#pragma unroll
                for (int n = 0; n < 2; ++n) acc[a][b][m][n] = (f32x4){0.f, 0.f, 0.f, 0.f};
    bf16x8 At[4][2], B0[2][2], B1[2][2];
    const char* cA = PG8_UA(cur); const char* cB = PG8_UB(cur);
    S.a_ready(cur);
    if constexpr (SP2) {
        PG8_STAGE(PG8_SB(0, 0), cB, voffB); PG8_STAGE(PG8_SB(0, 1), cB + hstepB, voffB); PG8_STAGE(PG8_SA(0, 0), cA, voffA); PG8_STAGE(PG8_SA(0, 1), cA + hstepA, voffA);
        if (wr == 1) PG8_BAR;
        PG8_WAIT_V(2); PG8_BAR;
        PG8_STAGE(PG8_SB(1, 0), cB + kstep, voffB); PG8_STAGE(PG8_SA(1, 0), cA + kstep, voffA); PG8_STAGE(PG8_SB(1, 1), cB + hstepB + kstep, voffB);
        PG8_WAIT_V(6); PG8_BAR;
    } else {
        PG8_STAGE(PG8_SB(0, 0), cB, voffB); PG8_STAGE(PG8_SA(0, 0), cA, voffA); PG8_STAGE(PG8_SB(0, 1), cB + hstepB, voffB); PG8_STAGE(PG8_SA(0, 1), cA + hstepA, voffA);
        if (wr == 1) PG8_BAR;
        PG8_WAIT_V(4); PG8_BAR;
        PG8_STAGE(PG8_SB(1, 0), cB + kstep, voffB); PG8_STAGE(PG8_SA(1, 0), cA + kstep, voffA); PG8_STAGE(PG8_SB(1, 1), cB + hstepB + kstep, voffB);
        PG8_WAIT_V(6); PG8_BAR;
    }
    for (;;) {
        const bool has_next = S.next(ui + 1, nxt);
        const char* nA = has_next ? PG8_UA(nxt) : cA; const char* nB = has_next ? PG8_UB(nxt) : cB;
        for (int t = 0; t < nt; t += 2) {
            const bool last = (t == nt - 2);
            const char* a1 = cA + (size_t)(t + 1) * kstep;
            const char* a2 = last ? nA : cA + (size_t)(t + 2) * kstep; const char* b2 = last ? nB : cB + (size_t)(t + 2) * kstep;
            const char* a3 = a2 + kstep; const char* b3 = b2 + kstep;
            if (last && has_next) S.a_ready(nxt);
            if constexpr (SP2) {
            PG8_LDB(B0, 0, 0); PG8_LDB(B1, 0, 1); PG8_SCHED; PG8_LDA(At, 0, 0); PG8_STAGE(PG8_SA(1, 1), a1 + hstepA, voffA);
            PG8_WAIT_V(8); PG8_WAIT_L(0); PG8_BAR; PG8_MMA(0, 0, At, B0); PG8_MMA(0, 1, At, B1); PG8_BAR; PG8_SCHED;
            PG8_LDA(At, 0, 1); PG8_STAGE(PG8_SB(0, 0), b2, voffB); PG8_STAGE(PG8_SB(0, 1), b2 + hstepB, voffB); PG8_STAGE(PG8_SA(0, 0), a2, voffA);
            PG8_WAIT_V(8); PG8_WAIT_L(0); PG8_BAR; PG8_MMA(1, 0, At, B0); PG8_MMA(1, 1, At, B1); PG8_BAR; PG8_SCHED;
            PG8_LDB(B0, 1, 0); PG8_LDB(B1, 1, 1); PG8_SCHED; PG8_LDA(At, 1, 0); PG8_STAGE(PG8_SA(0, 1), a2 + hstepA, voffA);
            PG8_WAIT_V(8); PG8_WAIT_L(0); PG8_BAR; PG8_MMA(0, 0, At, B0); PG8_MMA(0, 1, At, B1); PG8_BAR; PG8_SCHED;
            PG8_LDA(At, 1, 1); PG8_STAGE(PG8_SB(1, 0), b3, voffB); PG8_STAGE(PG8_SB(1, 1), b3 + hstepB, voffB); PG8_STAGE(PG8_SA(1, 0), a3, voffA);
            PG8_WAIT_V(8); PG8_WAIT_L(0); PG8_BAR; PG8_MMA(1, 0, At, B0); PG8_MMA(1, 1, At, B1); PG8_BAR; PG8_SCHED;
            } else {
            PG8_LDB(B0, 0, 0); PG8_SCHED; PG8_LDA(At, 0, 0); PG8_STAGE(PG8_SA(1, 1), a1 + hstepA, voffA);
            PG8_WAIT_L(8); PG8_BAR; PG8_WAIT_L(0); PG8_MMA(0, 0, At, B0); PG8_BAR; PG8_SCHED;
            PG8_LDB(B1, 0, 1); PG8_STAGE(PG8_SB(0, 0), b2, voffB);
            PG8_BAR; PG8_WAIT_L(0); PG8_MMA(0, 1, At, B1); PG8_BAR;
            PG8_LDA(At, 0, 1); PG8_STAGE(PG8_SA(0, 0), a2, voffA);
            PG8_BAR; PG8_WAIT_L(0); PG8_MMA(1, 0, At, B0); PG8_BAR; PG8_SCHED;
            PG8_STAGE(PG8_SB(0, 1), b2 + hstepB, voffB);
            PG8_WAIT_V(6); PG8_BAR; PG8_MMA(1, 1, At, B1); PG8_BAR;
            PG8_LDB(B0, 1, 0); PG8_SCHED; PG8_LDA(At, 1, 0); PG8_STAGE(PG8_SA(0, 1), a2 + hstepA, voffA);
            PG8_WAIT_L(8); PG8_BAR; PG8_WAIT_L(0); PG8_MMA(0, 0, At, B0); PG8_BAR; PG8_SCHED;
            PG8_LDB(B1, 1, 1); PG8_STAGE(PG8_SB(1, 0), b3, voffB);
            PG8_BAR; PG8_WAIT_L(0); PG8_MMA(0, 1, At, B1); PG8_BAR;
            PG8_LDA(At, 1, 1); PG8_STAGE(PG8_SA(1, 0), a3, voffA);
            PG8_BAR; PG8_WAIT_L(0); PG8_MMA(1, 0, At, B0); PG8_BAR; PG8_SCHED;
            PG8_STAGE(PG8_SB(1, 1), b3 + hstepB, voffB);
            PG8_WAIT_V(6); PG8_BAR; PG8_MMA(1, 1, At, B1); PG8_BAR;
            }
        }
        if constexpr (ALIGN_EPI) { if (wr == 0) PG8_BAR; }
        if constexpr (!Epi::AFTER_DRAIN) { E(acc, cur, wr, wc, fr, fq); S.done(cur); }
        if (!has_next) break;
#pragma unroll
        for (int a = 0; a < 2; ++a)
#pragma unroll
            for (int b = 0; b < 2; ++b)
#pragma unroll
                for (int m = 0; m < 4; ++m)
#pragma unroll
                    for (int n = 0; n < 2; ++n) acc[a][b][m][n] = (f32x4){0.f, 0.f, 0.f, 0.f};
        cur = nxt; cA = nA; cB = nB; ++ui;
        if constexpr (ALIGN_EPI) { if (wr == 1) PG8_BAR; }
    }
    PG8_WAIT_V(0);
    if constexpr (!ALIGN_EPI) { if (wr == 0) PG8_BAR; }
    PG8_BAR;
    if constexpr (Epi::AFTER_DRAIN) { E.fused(acc, cur, wr, wc, fr, fq, lds, wid, lane); S.done(cur); }
#undef PG8_UA
#undef PG8_UB
#undef PG8_SA
#undef PG8_SB
#undef PG8_STAGE
#undef PG8_LDA
#undef PG8_LDB
#undef PG8_MMA
#undef PG8_WAIT_V
#undef PG8_WAIT_L
#undef PG8_BAR
#undef PG8_SCHED
}
}

#ifndef PG8_SP2
#define PG8_SP2 true
#endif
#ifndef PG8_ALIGN
#define PG8_ALIGN true
#endif

typedef unsigned short bf16;
typedef unsigned v4u __attribute__((ext_vector_type(4)));
typedef unsigned v2u __attribute__((ext_vector_type(2)));
typedef float f32x4 __attribute__((ext_vector_type(4)));
#define LAS __attribute__((address_space(3)))

constexpr int NWAVES = 8, NTHR = 512;
constexpr int D = 1024, MC = 8192, ML = 4096, M = 12288, NPH = 23;
constexpr int LDS_BYTES = 147456;
constexpr float EPS = 1e-6f;
constexpr size_t MiB = 1u << 20;
constexpr size_t WS_MOD = 64 * 1024;
constexpr size_t WS_SSQ = 320 * 1024;
constexpr size_t WS_DT = 384 * 1024;
constexpr size_t WS_W = 2 * MiB;
constexpr size_t W_IN = WS_W, W_G = W_IN + 8 * MiB, W_GLU = W_G + 8 * MiB, W_BR = W_GLU + 1 * MiB, W_OUT = W_BR + 4 * MiB, W_1 = W_OUT + 2 * MiB, W_2 = W_1 + 8 * MiB;
constexpr size_t WS_H = 41 * MiB;
constexpr size_t WS_R1 = 65 * MiB;
constexpr size_t WS_Y = 161 * MiB;
constexpr size_t WS_Y5 = 209 * MiB;
constexpr size_t WS_XC = 221 * MiB;
constexpr size_t WS_S5K = 239 * MiB;
constexpr size_t WS_S5WS = 240 * MiB;
constexpr size_t WS_S5WO = 244 * MiB;
constexpr size_t WS_S5AT = 248 * MiB;
constexpr size_t WS_CKV = 251 * MiB;
constexpr size_t WS_ROPE = 1536 * 1024;
constexpr size_t WS_WDT = 1792 * 1024;
constexpr size_t WS_END = 254 * MiB;
#ifndef PROBE_SEL
#define PROBE_SEL -1
#endif
#ifndef PROBE_SCALE
#define PROBE_SCALE 4e-4f
#endif
#ifndef PROBE_PB
#define PROBE_PB 32
#endif
constexpr size_t WS_BAR = 32 * 1024;
constexpr size_t WS_QCTR = 48 * 1024;
constexpr size_t WS_TS = 16 * 1024;
constexpr size_t O_SSD = 12582912, O_S5 = 16777216, O_DK = 17301504, O_DV = 25690112, O_WK = 34078720, O_WV = 36175872;
constexpr int C_Z = 0, C_XBC = 512, C_U = 1280, C_DQ = 1792, C_DK = 2304, C_DV = 2816, C_WQ = 3328, C_WK = 3840, C_WV = 3968;

struct Args { const float* in[44]; float* out; unsigned char* ws; int ph_lo, ph_hi; };

typedef const Args __attribute__((address_space(4)))* CArgs;
struct Ctx {
    CArgs ap; int tid, lane, wave;
    __device__ __forceinline__ const float* x_prompt() const { return ap->in[0]; }
    __device__ __forceinline__ const float* x_sample() const { return ap->in[1]; }
    __device__ __forceinline__ const float* state_ssd() const { return ap->in[2]; }
    __device__ __forceinline__ const float* state_s5() const { return ap->in[3]; }
    __device__ __forceinline__ const float* cache_dk() const { return ap->in[4]; }
    __device__ __forceinline__ const float* cache_dv() const { return ap->in[5]; }
    __device__ __forceinline__ const float* cache_wk() const { return ap->in[6]; }
    __device__ __forceinline__ const float* cache_wv() const { return ap->in[7]; }
    __device__ __forceinline__ const float* cvec() const { return ap->in[8]; }
    __device__ __forceinline__ const float* c_ctx() const { return ap->in[9]; }
    __device__ __forceinline__ const float* w_mod() const { return ap->in[10]; }
    __device__ __forceinline__ const float* b_mod() const { return ap->in[11]; }
    __device__ __forceinline__ const float* g_norm1() const { return ap->in[12]; }
    __device__ __forceinline__ const float* g_norm2() const { return ap->in[13]; }
    __device__ __forceinline__ const float* w_in() const { return ap->in[14]; }
    __device__ __forceinline__ const float* conv_w() const { return ap->in[15]; }
    __device__ __forceinline__ const float* conv_b() const { return ap->in[16]; }
    __device__ __forceinline__ const float* dt_bias() const { return ap->in[17]; }
    __device__ __forceinline__ const float* a_log() const { return ap->in[18]; }
    __device__ __forceinline__ const float* ssd_d() const { return ap->in[19]; }
    __device__ __forceinline__ const float* ssd_norm_g() const { return ap->in[20]; }
    __device__ __forceinline__ const float* lam_re() const { return ap->in[21]; }
    __device__ __forceinline__ const float* lam_im() const { return ap->in[22]; }
    __device__ __forceinline__ const float* log_step() const { return ap->in[23]; }
    __device__ __forceinline__ const float* b_re() const { return ap->in[24]; }
    __device__ __forceinline__ const float* b_im() const { return ap->in[25]; }
    __device__ __forceinline__ const float* c_re() const { return ap->in[26]; }
    __device__ __forceinline__ const float* c_im() const { return ap->in[27]; }
    __device__ __forceinline__ const float* s5_d() const { return ap->in[28]; }
    __device__ __forceinline__ const float* w_glu() const { return ap->in[29]; }
    __device__ __forceinline__ const float* b_glu() const { return ap->in[30]; }
    __device__ __forceinline__ const float* qn_g() const { return ap->in[31]; }
    __device__ __forceinline__ const float* kn_g() const { return ap->in[32]; }
    __device__ __forceinline__ const float* dlam() const { return ap->in[33]; }
    __device__ __forceinline__ const float* subln_g() const { return ap->in[34]; }
    __device__ __forceinline__ const float* wqn_g() const { return ap->in[35]; }
    __device__ __forceinline__ const float* wkn_g() const { return ap->in[36]; }
    __device__ __forceinline__ const float* sink() const { return ap->in[37]; }
    __device__ __forceinline__ const float* w_branch() const { return ap->in[38]; }
    __device__ __forceinline__ const float* w_gate() const { return ap->in[39]; }
    __device__ __forceinline__ const float* b_gate() const { return ap->in[40]; }
    __device__ __forceinline__ const float* w_out() const { return ap->in[41]; }
    __device__ __forceinline__ const float* w_fc1() const { return ap->in[42]; }
    __device__ __forceinline__ const float* w_fc2() const { return ap->in[43]; }
    __device__ __forceinline__ float* out() const { return ap->out; }
    __device__ __forceinline__ unsigned char* ws() const { return ap->ws; }
    __device__ __forceinline__ float* MOD() const { return (float*)(ap->ws + WS_MOD); }
    __device__ __forceinline__ float* SSQ() const { return (float*)(ap->ws + WS_SSQ); }
    __device__ __forceinline__ float* DT() const { return (float*)(ap->ws + WS_DT); }
    __device__ __forceinline__ bf16* H() const { return (bf16*)(ap->ws + WS_H); }
    __device__ __forceinline__ bf16* R1() const { return (bf16*)(ap->ws + WS_R1); }
    __device__ __forceinline__ bf16* Y() const { return (bf16*)(ap->ws + WS_Y); }
    __device__ __forceinline__ bf16* Y5() const { return (bf16*)(ap->ws + WS_Y5); }
    __device__ __forceinline__ bf16* XC() const { return (bf16*)(ap->ws + WS_XC); }
    __device__ __forceinline__ bf16* CKV() const { return (bf16*)(ap->ws + WS_CKV); }
    __device__ __forceinline__ float* ROPE() const { return (float*)(ap->ws + WS_ROPE); }
};

__device__ __forceinline__ float wave_sum(float v) {
#pragma unroll
    for (int o = 1; o < 64; o <<= 1) v += __shfl_xor(v, o);
    return v;
}
__device__ __forceinline__ float wave_max(float v) {
#pragma unroll
    for (int o = 1; o < 64; o <<= 1) v = fmaxf(v, __shfl_xor(v, o));
    return v;
}
__device__ __forceinline__ float bf2f(bf16 h) { return __builtin_bit_cast(float, (unsigned)h << 16); }
__device__ __forceinline__ float bflo(unsigned w) { return __builtin_bit_cast(float, w << 16); }
__device__ __forceinline__ float bfhi(unsigned w) { return __builtin_bit_cast(float, w & 0xffff0000u); }
__device__ __forceinline__ unsigned f2bf(float f) { unsigned u = __builtin_bit_cast(unsigned, f); return (u + 0x7fffu + ((u >> 16) & 1u)) >> 16; }
__device__ __forceinline__ unsigned pk2(float lo, float hi) { return f2bf(lo) | (f2bf(hi) << 16); }
__device__ __forceinline__ float siluf(float x) { return x / (1.0f + __expf(-x)); }
__device__ __forceinline__ void unpack8(const v4u q, float (&f)[8]) { f[0] = bflo(q.x); f[1] = bfhi(q.x); f[2] = bflo(q.y); f[3] = bfhi(q.y); f[4] = bflo(q.z); f[5] = bfhi(q.z); f[6] = bflo(q.w); f[7] = bfhi(q.w); }

__device__ __forceinline__ void phase_mods(const Ctx& c, float* lf) {
    for (int i = c.tid; i < 5 * 1024; i += NTHR) { const int v = i >> 10, k = i & 1023; const float x = (v == 0) ? c.c_ctx()[k] : c.cvec()[(v - 1) * 1024 + k]; lf[i] = siluf(x); }
    __syncthreads();
    float* red = lf + 5 * 1024;
    for (int u = blockIdx.x; u < 192; u += gridDim.x) {
        const int l = u / 96, col0 = (u % 96) * 64;
        const float* W = c.w_mod() + (size_t)l * 1024 * 6144 + col0 + c.lane;
        float acc[5] = {0.f, 0.f, 0.f, 0.f, 0.f};
#pragma unroll 8
        for (int k = c.wave * 128; k < c.wave * 128 + 128; ++k) { const float wv = W[(size_t)k * 6144];
#pragma unroll
            for (int i = 0; i < 5; ++i) acc[i] += lf[i * 1024 + k] * wv; }
#pragma unroll
        for (int i = 0; i < 5; ++i) red[(c.wave * 5 + i) * 64 + c.lane] = acc[i];
        __syncthreads();
        if (c.tid < 320) { const int i = c.tid >> 6, ln = c.tid & 63; float s = c.b_mod()[l * 6144 + col0 + ln];
#pragma unroll
            for (int w = 0; w < 8; ++w) s += red[(w * 5 + i) * 64 + ln];
            c.MOD()[(size_t)(l * 5 + i) * 6144 + col0 + ln] = s; }
        __syncthreads();
    }
}

__device__ __forceinline__ int cmap(int mode, int n) { return mode == 0 ? n : (mode == 1 ? (n < 1280 ? n : n + 16) : ((n & 255) < 128 ? 128 * (n >> 8) + (n & 127) : 512 + 128 * (n >> 8) + (n & 127))); }
__device__ __forceinline__ void transpose_item(const float* W, int ld, int K, int N, int mode, const float* rowscale, bf16* WT, float* scr, int item, int lane) {
    const int nblk = N / 32, kb = item / nblk, nb = item % nblk, k0 = 64 * kb, n0 = 32 * nb, sc0 = cmap(mode, n0);
    float tv[32];
#pragma unroll
    for (int i = 0; i < 32; ++i) tv[i] = W[(size_t)(k0 + 2 * i + (lane >> 5)) * ld + sc0 + (lane & 31)];
    if (rowscale) {
#pragma unroll
        for (int i = 0; i < 32; ++i) tv[i] *= rowscale[k0 + 2 * i + (lane >> 5)]; }
#pragma unroll
    for (int i = 0; i < 32; ++i) scr[(2 * i + (lane >> 5)) * 33 + (lane & 31)] = tv[i];
    __builtin_amdgcn_fence(__ATOMIC_RELEASE, "wavefront"); __builtin_amdgcn_wave_barrier();
    const int ch = lane & 7;
#pragma unroll
    for (int j = 0; j < 4; ++j) { const int n = (lane >> 3) + 8 * j; const float* s = scr + (8 * ch) * 33 + n;
        v4u o; o.x = pk2(s[0 * 33], s[1 * 33]); o.y = pk2(s[2 * 33], s[3 * 33]); o.z = pk2(s[4 * 33], s[5 * 33]); o.w = pk2(s[6 * 33], s[7 * 33]);
        *(v4u*)(WT + (size_t)(n0 + n) * K + k0 + 8 * ch) = o; }
    __builtin_amdgcn_fence(__ATOMIC_RELEASE, "wavefront"); __builtin_amdgcn_wave_barrier();
}
__device__ __forceinline__ void s5_tables(const Ctx& c, int l, int g, int part, float* lf);
__device__ __forceinline__ void convert_items(const Ctx& c, int l, int lo, int hi, int gw0, int ngw, bool tabs, int tb0, int ntb, float* lf) {
    unsigned char* ws = c.ws();
    if (tabs) {
        for (int t = tb0; t < 128; t += ntb) s5_tables(c, l, t & 31, t >> 5, lf);
        for (int i = tb0 * NTHR + c.tid; i < 16384; i += ntb * NTHR) { const int j = i >> 10, k = i & 1023; ((bf16*)(ws + WS_WDT))[i] = (bf16)f2bf(c.w_in()[(size_t)l * 1024 * 4112 + (size_t)k * 4112 + 1280 + j]); }
    }
    float* scr = lf + c.wave * 2176;
    for (int it = lo + gw0; it < hi; it += ngw) {
        int r = it;
        if (r < 2048) { transpose_item(c.w_in() + (size_t)l * 1024 * 4112, 4112, 1024, 4096, 1, nullptr, (bf16*)(ws + W_IN), scr, r, c.lane); continue; } r -= 2048;
        if (r < 2048) { transpose_item(c.w_gate() + (size_t)l * 1024 * 4096, 4096, 1024, 4096, 0, nullptr, (bf16*)(ws + W_G), scr, r, c.lane); continue; } r -= 2048;
        if (r < 256) { transpose_item(c.w_glu() + (size_t)l * 512 * 1024, 1024, 512, 1024, 2, nullptr, (bf16*)(ws + W_GLU), scr, r, c.lane); continue; } r -= 256;
        if (r < 1024) { const int i = r >> 8; transpose_item(c.w_branch() + (size_t)(l * 4 + i) * 512 * 1024, 1024, 512, 1024, 0, i == 0 ? c.ssd_norm_g() + l * 512 : nullptr, (bf16*)(ws + W_BR) + (size_t)i * 1024 * 512, scr, r & 255, c.lane); continue; } r -= 1024;
        if (r < 512) { transpose_item(c.w_out() + (size_t)l * 1024 * 1024, 1024, 1024, 1024, 0, nullptr, (bf16*)(ws + W_OUT), scr, r, c.lane); continue; } r -= 512;
        if (r < 2048) { transpose_item(c.w_fc1() + (size_t)l * 1024 * 4096, 4096, 1024, 4096, 0, nullptr, (bf16*)(ws + W_1), scr, r, c.lane); continue; } r -= 2048;
        transpose_item(c.w_fc2() + (size_t)l * 4096 * 1024, 1024, 4096, 1024, 0, nullptr, (bf16*)(ws + W_2), scr, r, c.lane);
    }
}
__device__ __forceinline__ void phase_convert(const Ctx& c, int l, float* lf) {
    convert_items(c, l, 0, 9984, blockIdx.x * NWAVES + c.wave, gridDim.x * NWAVES, true, blockIdx.x, gridDim.x, lf);
}
__device__ __forceinline__ void side_convert(const Ctx& c, int lo, int hi, bool tabs, float* lf) {
    if (blockIdx.x < 192 || gridDim.x != 256) return;
    convert_items(c, 1, lo, hi, (blockIdx.x - 192) * NWAVES + c.wave, 64 * NWAVES, tabs, blockIdx.x - 192, 64, lf);
}

__device__ __forceinline__ void phase_norm(const Ctx& c, int l, int which, float* lf) {
    const int gw = blockIdx.x * NWAVES + c.wave, NGW = gridDim.x * NWAVES;
    const float* gn = (which == 0 ? c.g_norm1() : c.g_norm2()) + l * 1024;
    for (int m = gw; m < M; m += NGW) {
        const float* xr = (l == 0 && which == 0) ? (m < MC ? c.x_prompt() + (size_t)m * D : c.x_sample() + (size_t)(m - MC) * D) : c.out() + (size_t)m * D;
        const int mi = (m < MC) ? 0 : 1 + ((m - MC) >> 10);
        const float* mod = c.MOD() + (size_t)(l * 5 + mi) * 6144 + which * 3072;
        f32x4 v[4]; float s = 0.f;
#pragma unroll
        for (int j = 0; j < 4; ++j) { v[j] = *(const f32x4*)(xr + 4 * c.lane + 256 * j); s += (v[j].x * v[j].x + v[j].y * v[j].y) + (v[j].z * v[j].z + v[j].w * v[j].w); }
        const float rstd = rsqrtf(wave_sum(s) * (1.0f / D) + EPS);
#pragma unroll
        for (int j = 0; j < 4; ++j) { const int k = 4 * c.lane + 256 * j; const f32x4 g = *(const f32x4*)(gn + k), sh = *(const f32x4*)(mod + k), sc = *(const f32x4*)(mod + 1024 + k);
            v[j] = v[j] * rstd * g * (sc + 1.0f) + sh;
            v2u o; o.x = pk2(v[j].x, v[j].y); o.y = pk2(v[j].z, v[j].w); *(v2u*)(c.H() + (size_t)m * D + k) = o; }
        if (which == 0) {
            if (c.lane == 0) c.SSQ()[m] = 0.f;
        }
    }
}

__device__ __forceinline__ void phase_dt(const Ctx& c, int l) {
    if (c.wave >= 3) return;
    const int tile = blockIdx.x * 3 + c.wave; if (tile >= 768) return;
    const int lr = c.lane & 15, lq = c.lane >> 4;
    const bf16* ap = c.H() + (size_t)(16 * tile + lr) * 1024 + 8 * lq; const bf16* bp = (const bf16*)(c.ws() + WS_WDT) + (size_t)lr * 1024 + 8 * lq;
    f32x4 acc = {0.f, 0.f, 0.f, 0.f};
#pragma unroll 8
    for (int ks = 0; ks < 32; ++ks) acc = __builtin_amdgcn_mfma_f32_16x16x32_bf16(*(const pg8::bf16x8*)(ap + 32 * ks), *(const pg8::bf16x8*)(bp + 32 * ks), acc, 0, 0, 0);
    const float bias = c.dt_bias()[l * 16 + lr];
#pragma unroll
    for (int r = 0; r < 4; ++r) { const float x = acc[r] + bias; c.DT()[(size_t)(16 * tile + 4 * lq + r) * 16 + lr] = x > 20.f ? x : log1pf(__expf(x)); }
}

__device__ __forceinline__ void phase_rope_table(const Ctx& c) {
    const int gt = blockIdx.x * NTHR + c.tid;
    if (gt < 32768) { const int pos = gt >> 5, a = gt & 31, f = a & 15; const float inv = exp2f(-(float)f * 0.8304820237218406f);
        const float ang = (float)((a >> 4) ? (pos & 63) : (pos >> 6)) * inv; float sn, cs; sincosf(ang, &sn, &cs); c.ROPE()[pos * 64 + a] = cs; c.ROPE()[pos * 64 + 32 + a] = sn; }
}
__device__ __forceinline__ void phase_qk(const Ctx& c, int l, float* lf) {
    const int gw = blockIdx.x * NWAVES + c.wave, NGW = gridDim.x * NWAVES, lane = c.lane, l16 = lane & 15, grp = lane >> 4;
    for (int i = c.tid; i < 7 * 768; i += NTHR) lf[i] = c.conv_w()[(size_t)l * 7 * 768 + i];
    for (int i = c.tid; i < 768; i += NTHR) lf[7 * 768 + i] = c.conv_b()[l * 768 + i];
    __syncthreads();
    const f32x4 gq = *(const f32x4*)(c.qn_g() + l * 64 + 4 * l16), gk = *(const f32x4*)(c.kn_g() + l * 64 + 4 * l16), gwq = *(const f32x4*)(c.wqn_g() + l * 64 + 4 * l16), gwk = *(const f32x4*)(c.wkn_g() + l * 64 + 4 * l16);
    bf16* R1p = c.R1(); float* outp = c.out(); bf16* XCp = c.XC();
    for (int m = gw; m < M; m += NGW) {
        bf16* pr = R1p + (size_t)m * 4096;
        const bool lat = m >= MC;
        const int b = lat ? (m - MC) >> 10 : m >> 8, t = lat ? (m - MC) & 1023 : m & 255, L = lat ? 1024 : 256;
        const size_t ob = (size_t)(b * 2 + l) * 256 + t;
        f32x4 cs = {1.f, 1.f, 1.f, 1.f}, sn = {0.f, 0.f, 0.f, 0.f};
        if (lat) { const float* rp = c.ROPE() + t * 64 + (l16 >> 3) * 16 + 4 * (l16 & 3); cs = *(const f32x4*)rp; sn = *(const f32x4*)(rp + 32); if (!((l16 >> 2) & 1)) sn = -sn; }
        v2u raw[7];
#pragma unroll
        for (int ps = 0; ps < 7; ++ps) { const int gi = 4 * ps + grp; const int col = gi < 8 ? C_DQ + gi * 64 : gi < 16 ? C_DK + (gi - 8) * 64 : gi < 24 ? C_WQ + (gi - 16) * 64 : C_WK + (gi - 24) * 64;
            raw[ps] = (gi < 26) ? *(const v2u*)(pr + col + 4 * l16) : (v2u){0u, 0u}; }
        v2u cp[3];
        if (!lat) {
#pragma unroll
            for (int ps = 0; ps < 3; ++ps) { const int gi = 4 * ps + grp; const int col = gi < 8 ? C_DV + gi * 64 : C_WV + (gi - 8) * 64; cp[ps] = (gi < 10) ? *(const v2u*)(pr + col + 4 * l16) : (v2u){0u, 0u}; }
        }
        v2u cx[3][7];
#pragma unroll
        for (int i = 0; i < 3; ++i)
#pragma unroll
            for (int j = 0; j < 7; ++j) { const int tt = t + j - 3; cx[i][j] = (tt >= 0 && tt < L) ? *(const v2u*)(R1p + (size_t)(m + j - 3) * 4096 + C_XBC + 4 * lane + 256 * i) : (v2u){0u, 0u}; }
#pragma unroll
        for (int ps = 0; ps < 7; ++ps) { const int gi = 4 * ps + grp;
            const f32x4 gain = gi < 8 ? gq : gi < 16 ? gk : gi < 24 ? gwq : gwk;
            f32x4 v = {bflo(raw[ps].x), bfhi(raw[ps].x), bflo(raw[ps].y), bfhi(raw[ps].y)};
            float ss = (v.x * v.x + v.y * v.y) + (v.z * v.z + v.w * v.w);
            ss += __shfl_xor(ss, 1); ss += __shfl_xor(ss, 2); ss += __shfl_xor(ss, 4); ss += __shfl_xor(ss, 8);
            v = v * rsqrtf(ss * (1.0f / 64.0f) + EPS) * gain;
            if (lat) { f32x4 p; p.x = __shfl_xor(v.x, 4); p.y = __shfl_xor(v.y, 4); p.z = __shfl_xor(v.z, 4); p.w = __shfl_xor(v.w, 4); v = v * cs + p * sn; }
            if (gi < 26) {
                const int col = gi < 8 ? C_DQ + gi * 64 : gi < 16 ? C_DK + (gi - 8) * 64 : gi < 24 ? C_WQ + (gi - 16) * 64 : C_WK + (gi - 24) * 64;
                v2u o; o.x = pk2(v.x, v.y); o.y = pk2(v.z, v.w); *(v2u*)(pr + col + 4 * l16) = o;
                if (!lat) { if (gi >= 8 && gi < 16) *(f32x4*)(outp + O_DK + ob * 512 + (gi - 8) * 64 + 4 * l16) = v; if (gi >= 24) *(f32x4*)(outp + O_WK + ob * 128 + (gi - 24) * 64 + 4 * l16) = v; }
            }
        }
        if (!lat) {
#pragma unroll
            for (int ps = 0; ps < 3; ++ps) { const int gi = 4 * ps + grp; const f32x4 v = {bflo(cp[ps].x), bfhi(cp[ps].x), bflo(cp[ps].y), bfhi(cp[ps].y)};
                if (gi < 8) *(f32x4*)(outp + O_DV + ob * 512 + gi * 64 + 4 * l16) = v; else if (gi < 10) *(f32x4*)(outp + O_WV + ob * 128 + (gi - 8) * 64 + 4 * l16) = v; }
        }
#pragma unroll
        for (int i = 0; i < 3; ++i) { const int ch = 4 * lane + 256 * i; f32x4 a = *(const f32x4*)(lf + 7 * 768 + ch);
#pragma unroll
            for (int j = 0; j < 7; ++j) { const f32x4 wv = *(const f32x4*)(lf + j * 768 + ch); const f32x4 xv = {bflo(cx[i][j].x), bfhi(cx[i][j].x), bflo(cx[i][j].y), bfhi(cx[i][j].y)}; a += wv * xv; }
            v2u o; o.x = pk2(siluf(a.x), siluf(a.y)); o.y = pk2(siluf(a.z), siluf(a.w)); *(v2u*)(XCp + (size_t)m * 768 + ch) = o; }
    }
    for (int r = gw; r < 1024; r += NGW) { const int b = r >> 8, sidx = r & 255; const size_t cb = (size_t)(b * 2 + l) * 256 + sidx; bf16* dst = c.CKV() + (size_t)r * 1280;
        for (int i = lane; i < 1280; i += 64) { const float v = i < 512 ? c.cache_dk()[cb * 512 + i] : i < 1024 ? c.cache_dv()[cb * 512 + i - 512] : i < 1152 ? c.cache_wk()[cb * 128 + i - 1024] : c.cache_wv()[cb * 128 + i - 1152]; dst[i] = (bf16)f2bf(v); } }
}

typedef pg8::bf16x8 bx8;
#define LDS_BARRIER() do { asm volatile("s_waitcnt lgkmcnt(0)" ::: "memory"); __builtin_amdgcn_s_barrier(); asm volatile("" ::: "memory"); } while (0)
#define MFMA16(a, b, cc) __builtin_amdgcn_mfma_f32_16x16x32_bf16((a), (b), (cc), 0, 0, 0)
__device__ __forceinline__ void ssd_unit(const Ctx& c, int l, int pass, int b, int h, unsigned char* lds) {
    const int L = pass ? 1024 : 256, tok0 = pass ? MC + b * 1024 : b * 256, NCH = L >> 7;
    const int tid = c.tid, lane = c.lane, w = c.wave, lr = lane & 15, lq = lane >> 4, grp = h >> 2;
    bf16* XT = (bf16*)lds;
    bf16* BwT = XT + 64 * 136;
    bf16* Bm = BwT + 64 * 136;
    bf16* Cm = Bm + 128 * 72;
    bf16* Mm = Cm + 128 * 72;
    bf16* ST = Mm + 128 * 136;
    float* cum = (float*)(ST + 64 * 72);
    float* dtv = cum + 128; float* wv = dtv + 128; float* ecum = wv + 128; float* tot = ecum + 128;
    const float dsk = c.ssd_d()[l * 8 + h];
    const bf16* XCp = c.XC(); const float* DTp = c.DT(); bf16* Yp = c.Y(); const bf16* R1p = c.R1(); float* SSQp = c.SSQ();
    const int pi = w >> 1, nj0 = 2 * (w & 1);
    const int i = tid >> 2, part = tid & 3;
    for (int dir = 0; dir < 2; ++dir) {
        const float A = -__expf(c.a_log()[(l * 2 + dir) * 8 + h]);
        f32x4 Sacc[2];
        __syncthreads();
#pragma unroll
        for (int q = 0; q < 2; ++q)
#pragma unroll
            for (int r = 0; r < 4; ++r) { const int p = 16 * pi + 4 * lq + r, n = 16 * (nj0 + q) + lr;
                const float v = pass ? c.state_ssd()[(((((size_t)(b * 2 + l) * 2 + dir) * 8 + h) * 64 + p) * 64) + n] : 0.f;
                Sacc[q][r] = v; ST[p * 72 + n] = (bf16)f2bf(v); }
        v4u x0, x1, b0, b1, c0, c1; float d0 = 0.f, d1 = 0.f;
#define SSD_LOAD(ci_) { const int t_ = dir ? L - 1 - ((ci_) * 128 + i) : (ci_) * 128 + i; const bf16* xr_ = XCp + (size_t)(tok0 + t_) * 768; \
            x0 = *(const v4u*)(xr_ + h * 64 + part * 16); x1 = *(const v4u*)(xr_ + h * 64 + part * 16 + 8); \
            b0 = *(const v4u*)(xr_ + 512 + grp * 64 + part * 16); b1 = *(const v4u*)(xr_ + 512 + grp * 64 + part * 16 + 8); \
            c0 = *(const v4u*)(xr_ + 640 + grp * 64 + part * 16); c1 = *(const v4u*)(xr_ + 640 + grp * 64 + part * 16 + 8); \
            if (tid < 64) { const int i0_ = 2 * lane, ta_ = dir ? L - 1 - ((ci_) * 128 + i0_) : (ci_) * 128 + i0_, tb_ = dir ? ta_ - 1 : ta_ + 1; \
                d0 = DTp[(size_t)(tok0 + ta_) * 16 + dir * 8 + h]; d1 = DTp[(size_t)(tok0 + tb_) * 16 + dir * 8 + h]; } }
        SSD_LOAD(0);
        for (int ci = 0; ci < NCH; ++ci) {
            LDS_BARRIER();
            float bvals[16];
            { *(v4u*)(Bm + i * 72 + part * 16) = b0; *(v4u*)(Bm + i * 72 + part * 16 + 8) = b1;
              *(v4u*)(Cm + i * 72 + part * 16) = c0; *(v4u*)(Cm + i * 72 + part * 16 + 8) = c1;
              const unsigned xs[8] = {x0.x, x0.y, x0.z, x0.w, x1.x, x1.y, x1.z, x1.w};
#pragma unroll
              for (int j = 0; j < 8; ++j) { XT[(part * 16 + 2 * j) * 136 + i] = (bf16)(xs[j] & 0xffffu); XT[(part * 16 + 2 * j + 1) * 136 + i] = (bf16)(xs[j] >> 16); }
              float t8[8]; unpack8(b0, t8);
#pragma unroll
              for (int j = 0; j < 8; ++j) bvals[j] = t8[j];
              unpack8(b1, t8);
#pragma unroll
              for (int j = 0; j < 8; ++j) bvals[8 + j] = t8[j]; }
            if (tid < 64) {
                const int i0 = 2 * lane, i1 = i0 + 1;
                const float a0 = d0 * A, a1 = d1 * A; float s = a0 + a1;
#pragma unroll
                for (int o = 1; o < 64; o <<= 1) { const float v = __shfl_up(s, o); if (lane >= o) s += v; }
                const float cum1 = s, cum0 = s - a1, total = __shfl(s, 63);
                cum[i0] = cum0; cum[i1] = cum1; dtv[i0] = d0; dtv[i1] = d1;
                wv[i0] = __expf(total - cum0) * d0; wv[i1] = __expf(total - cum1) * d1; ecum[i0] = __expf(cum0); ecum[i1] = __expf(cum1);
                if (lane == 0) tot[0] = __expf(total);
            }
            if (ci + 1 < NCH) SSD_LOAD(ci + 1);
            unsigned short zz[16], yy[16];
            if (dir == 1) {
#pragma unroll
                for (int r = 0; r < 4; ++r) { const int tt = 16 * w + 4 * lq + r; const size_t m = (size_t)tok0 + (L - 1 - (ci * 128 + tt));
#pragma unroll
                    for (int jp = 0; jp < 4; ++jp) { zz[4 * r + jp] = R1p[m * 4096 + C_Z + h * 64 + 16 * jp + lr]; yy[4 * r + jp] = Yp[m * 2048 + h * 64 + 16 * jp + lr]; } }
            }
            LDS_BARRIER();
            { const float wi = wv[i];
#pragma unroll
              for (int j = 0; j < 16; ++j) BwT[(part * 16 + j) * 136 + i] = (bf16)f2bf(bvals[j] * wi); }
            bx8 cfr[2];
#pragma unroll
            for (int ks = 0; ks < 2; ++ks) cfr[ks] = *(const bx8*)(Cm + (16 * w + lr) * 72 + 32 * ks + 8 * lq);
            for (int j = 0; j <= w; ++j) {
                const bx8 bb0 = *(const bx8*)(Bm + (16 * j + lr) * 72 + 8 * lq), bb1 = *(const bx8*)(Bm + (16 * j + lr) * 72 + 32 + 8 * lq);
                f32x4 g = {0.f, 0.f, 0.f, 0.f};
                g = MFMA16(cfr[0], bb0, g); g = MFMA16(cfr[1], bb1, g);
                const int s = 16 * j + lr; const float cs = cum[s], ds = dtv[s];
#pragma unroll
                for (int r = 0; r < 4; ++r) { const int tt = 16 * w + 4 * lq + r; const float v = (s <= tt) ? g[r] * __expf(cum[tt] - cs) * ds : 0.f; Mm[tt * 136 + s] = (bf16)f2bf(v); }
            }
            if (!(w & 1)) {
#pragma unroll
                for (int r = 0; r < 4; ++r) Mm[(16 * w + 4 * lq + r) * 136 + 16 * (w + 1) + lr] = 0;
            }
            LDS_BARRIER();
            f32x4 yl[4], yo[4];
#pragma unroll
            for (int jp = 0; jp < 4; ++jp) { yl[jp] = (f32x4){0.f, 0.f, 0.f, 0.f}; yo[jp] = (f32x4){0.f, 0.f, 0.f, 0.f}; }
            for (int ks = 0; ks <= (w >> 1); ++ks) {
                const bx8 af = *(const bx8*)(Mm + (16 * w + lr) * 136 + 32 * ks + 8 * lq);
#pragma unroll
                for (int jp = 0; jp < 4; ++jp) { const bx8 xf = *(const bx8*)(XT + (16 * jp + lr) * 136 + 32 * ks + 8 * lq); yl[jp] = MFMA16(af, xf, yl[jp]); }
            }
#pragma unroll
            for (int ks = 0; ks < 2; ++ks)
#pragma unroll
                for (int jp = 0; jp < 4; ++jp) { const bx8 sf = *(const bx8*)(ST + (16 * jp + lr) * 72 + 32 * ks + 8 * lq); yo[jp] = MFMA16(cfr[ks], sf, yo[jp]); }
            {
#pragma unroll
                for (int r = 0; r < 4; ++r) {
                    const int tt = 16 * w + 4 * lq + r; const float ec = ecum[tt];
                    const int t = dir ? L - 1 - (ci * 128 + tt) : ci * 128 + tt; const size_t m = (size_t)tok0 + t;
                    float q = 0.f;
#pragma unroll
                    for (int jp = 0; jp < 4; ++jp) {
                        const int p = 16 * jp + lr; const float y = yl[jp][r] + ec * yo[jp][r];
                        if (dir == 0) Yp[m * 2048 + h * 64 + p] = (bf16)f2bf(y);
                        else { const float x = bf2f(XT[p * 136 + tt]); const float ytot = y + bf2f(yy[4 * r + jp]) + dsk * x; const float z = bf2f(zz[4 * r + jp]);
                            const float gt = ytot * siluf(z); Yp[m * 2048 + h * 64 + p] = (bf16)f2bf(gt); q += gt * gt; }
                    }
                    if (dir == 1) { q += __shfl_xor(q, 1); q += __shfl_xor(q, 2); q += __shfl_xor(q, 4); q += __shfl_xor(q, 8); if (lr == 0) atomicAdd(SSQp + m, q); }
                }
            }
            LDS_BARRIER();
            {
                f32x4 st[2] = {{0.f, 0.f, 0.f, 0.f}, {0.f, 0.f, 0.f, 0.f}};
#pragma unroll
                for (int ks = 0; ks < 4; ++ks) { const bx8 af = *(const bx8*)(XT + (16 * pi + lr) * 136 + 32 * ks + 8 * lq);
#pragma unroll
                    for (int q = 0; q < 2; ++q) { const bx8 bf = *(const bx8*)(BwT + (16 * (nj0 + q) + lr) * 136 + 32 * ks + 8 * lq); st[q] = MFMA16(af, bf, st[q]); } }
                const float et = tot[0];
#pragma unroll
                for (int q = 0; q < 2; ++q)
#pragma unroll
                    for (int r = 0; r < 4; ++r) { Sacc[q][r] = et * Sacc[q][r] + st[q][r]; ST[(16 * pi + 4 * lq + r) * 72 + 16 * (nj0 + q) + lr] = (bf16)f2bf(Sacc[q][r]); }
            }
        }
#undef SSD_LOAD
        if (!pass) {
#pragma unroll
            for (int q = 0; q < 2; ++q)
#pragma unroll
                for (int r = 0; r < 4; ++r) { const int p = 16 * pi + 4 * lq + r, n = 16 * (nj0 + q) + lr;
                    c.out()[O_SSD + (((((size_t)(b * 2 + l) * 2 + dir) * 8 + h) * 64 + p) * 64) + n] = Sacc[q][r]; }
        }
    }
}

__device__ __forceinline__ void s5_tables(const Ctx& c, int l, int g, int part, float* lf) {
    const int tid = c.tid;
    float* pw = lf;
    float* Bc = pw + 2 * 17 * 128;
    float* Cc = Bc + 2 * 2048;
    if (tid < 128) { const int dir = tid >> 6, n = tid & 63, idx = ((l * 2 + dir) * 32 + g) * 64 + n;
        const float lre = c.lam_re()[idx], lim = c.lam_im()[idx], step = expf(c.log_step()[(l * 2 + dir) * 32 + g]);
        for (int k = 0; k <= 16; ++k) { const float mag = expf(lre * step * (float)k); float sn, cs; sincosf(lim * step * (float)k, &sn, &cs); pw[((dir * 17 + k) * 64 + n) * 2] = mag * cs; pw[((dir * 17 + k) * 64 + n) * 2 + 1] = mag * sn; }
        const float mag = expf(lre * step); float sn, cs; sincosf(lim * step, &sn, &cs); const float are = mag * cs, aim = mag * sn;
        const float den = lre * lre + lim * lim, cre = ((are - 1.0f) * lre + aim * lim) / den, cim = (aim * lre - (are - 1.0f) * lim) / den;
        for (int mm = 0; mm < 16; ++mm) { const float br = c.b_re()[(size_t)idx * 16 + mm], bi = c.b_im()[(size_t)idx * 16 + mm]; Bc[((dir * 64 + n) * 16 + mm) * 2] = cre * br - cim * bi; Bc[((dir * 64 + n) * 16 + mm) * 2 + 1] = cre * bi + cim * br; }
    }
    for (int i = tid; i < 2048; i += NTHR) { const int dir = i >> 10, mm = (i >> 6) & 15, n = i & 63; const size_t src = ((size_t)((l * 2 + dir) * 32 + g) * 16 + mm) * 64 + n;
        Cc[i * 2] = c.c_re()[src]; Cc[i * 2 + 1] = c.c_im()[src]; }
    __syncthreads();
    if (part == 0 && tid < 128) { const int dir = tid >> 6, n = tid & 63; float* at = (float*)(c.ws() + WS_S5AT) + ((size_t)(dir * 32 + g) * 64 + n) * 2; at[0] = pw[((dir * 17 + 16) * 64 + n) * 2]; at[1] = pw[((dir * 17 + 16) * 64 + n) * 2 + 1]; }
    bf16* Kt = (bf16*)(c.ws() + WS_S5K) + (size_t)g * 31 * 256;
    for (int e = part * 1984 + tid; e < (part + 1) * 1984; e += NTHR) { const int tp = e >> 8, mm = (e >> 4) & 15, m2 = e & 15, tau = tp - 15; float acc = 0.f;
#pragma unroll
        for (int dir = 0; dir < 2; ++dir) { if ((dir == 0 && tau < 0) || (dir == 1 && tau > 0)) continue; const int k = tau < 0 ? -tau : tau;
            const float* pp = pw + (dir * 17 + k) * 128; const float* bb = Bc + dir * 2048 + m2 * 2; const float* cc = Cc + (dir * 16 + mm) * 128;
            for (int n = 0; n < 64; ++n) { const float pr = pp[2 * n], pi = pp[2 * n + 1], br = bb[n * 32], bi = bb[n * 32 + 1], Pr = pr * br - pi * bi, Pi = pr * bi + pi * br; acc += cc[2 * n] * Pr - cc[2 * n + 1] * Pi; } }
        if (tau == 0 && mm == m2) acc += c.s5_d()[l * 512 + g * 16 + mm];
        Kt[e] = (bf16)f2bf(acc); }
    for (int e = part * 16384 + tid; e < (part + 1) * 16384; e += NTHR) { const int dir = e >> 15, sidx = (e >> 8) & 127, k = e & 255, ri = sidx >> 6, n = sidx & 63, j = k >> 4, m2 = k & 15, ex = dir ? j : 15 - j;
        const float pr = pw[((dir * 17 + ex) * 64 + n) * 2], pi = pw[((dir * 17 + ex) * 64 + n) * 2 + 1], br = Bc[((dir * 64 + n) * 16 + m2) * 2], bi = Bc[((dir * 64 + n) * 16 + m2) * 2 + 1];
        ((bf16*)(c.ws() + WS_S5WS))[((size_t)(dir * 32 + g) * 128 + sidx) * 256 + k] = (bf16)f2bf(ri ? pr * bi + pi * br : pr * br - pi * bi); }
    for (int e = part * 16384 + tid; e < (part + 1) * 16384; e += NTHR) { const int row = e >> 8, k = e & 255, i = row >> 4, mm = row & 15, dir = k >> 7, ri = (k >> 6) & 1, n = k & 63, ex = dir ? 16 - i : i + 1;
        const float pr = pw[((dir * 17 + ex) * 64 + n) * 2], pi = pw[((dir * 17 + ex) * 64 + n) * 2 + 1], cr = Cc[((dir * 16 + mm) * 64 + n) * 2], ci = Cc[((dir * 16 + mm) * 64 + n) * 2 + 1];
        ((bf16*)(c.ws() + WS_S5WO))[(size_t)g * 65536 + e] = (bf16)f2bf(ri ? -(cr * pi + ci * pr) : cr * pr - ci * pi); }
    __syncthreads();
}

__device__ __forceinline__ void s5_unit(const Ctx& c, int l, int g, int cu, unsigned char* lds) {
    const int tid = c.tid, lane = c.lane, w = c.wave, lr = lane & 15, lq = lane >> 4;
    const bool lat = cu >= 8;
    bf16* Ut = (bf16*)lds;
    bf16* St = Ut + 64 * 264;
    bf16* Kt = St + 64 * 264;
    float* Dl = (float*)(Kt + 31 * 256);
    const bf16* R1p = c.R1();
    { const v4u* src = (const v4u*)((const bf16*)(c.ws() + WS_S5K) + (size_t)g * 31 * 256); for (int i = tid; i < 31 * 32; i += NTHR) ((v4u*)Kt)[i] = src[i]; }
#pragma unroll
    for (int i = 0; i < 2; ++i) { const int id = tid + NTHR * i, col = id >> 4, j = id & 15;
        const int tok = lat ? MC + (cu - 8) * 1024 + col * 16 + j : (4 * cu + (col >> 4)) * 256 + (col & 15) * 16 + j;
        const bf16* up = R1p + (size_t)tok * 4096 + C_U + g * 16;
        *(v4u*)(Ut + col * 264 + j * 16) = *(const v4u*)up; *(v4u*)(Ut + col * 264 + j * 16 + 8) = *(const v4u*)(up + 8); }
    __syncthreads();
    for (int dir = 0; dir < 2; ++dir) {
        const bf16* Wsp = (const bf16*)(c.ws() + WS_S5WS) + ((size_t)(dir * 32 + g) * 128 + 16 * w + lr) * 256 + 8 * lq;
        f32x4 acc[4];
#pragma unroll
        for (int cb = 0; cb < 4; ++cb) acc[cb] = (f32x4){0.f, 0.f, 0.f, 0.f};
        bx8 afr[8];
#pragma unroll
        for (int ks = 0; ks < 8; ++ks) afr[ks] = *(const bx8*)(Wsp + 32 * ks);
#pragma unroll
        for (int ks = 0; ks < 8; ++ks) {
#pragma unroll
            for (int cb = 0; cb < 4; ++cb) { const bx8 bf = *(const bx8*)(Ut + (16 * cb + lr) * 264 + 32 * ks + 8 * lq); acc[cb] = MFMA16(afr[ks], bf, acc[cb]); }
            __builtin_amdgcn_sched_barrier(0); }
#pragma unroll
        for (int cb = 0; cb < 4; ++cb)
#pragma unroll
            for (int r = 0; r < 4; ++r) Dl[(16 * w + 4 * lq + r) * 65 + 16 * cb + lr] = acc[cb][r];
        __syncthreads();
        if (tid < (lat ? 64 : 256)) {
            const int n = tid & 63, bl = tid >> 6, nc = lat ? 64 : 16, cbase = lat ? 0 : 16 * bl, b = lat ? cu - 8 : 4 * cu + bl;
            const float* at = (const float*)(c.ws() + WS_S5AT) + ((size_t)(dir * 32 + g) * 64 + n) * 2; const float ar = at[0], ai = at[1];
            float sr = 0.f, si = 0.f;
            if (lat) { sr = c.state_s5()[((((size_t)(b * 2 + l) * 2 + dir) * 2 + 0) * 32 + g) * 64 + n]; si = c.state_s5()[((((size_t)(b * 2 + l) * 2 + dir) * 2 + 1) * 32 + g) * 64 + n]; }
            for (int cc = 0; cc < nc; ++cc) { const int col = cbase + (dir ? nc - 1 - cc : cc);
                St[col * 264 + dir * 128 + n] = (bf16)f2bf(sr); St[col * 264 + dir * 128 + 64 + n] = (bf16)f2bf(si);
                const float dr = Dl[n * 65 + col], di = Dl[(64 + n) * 65 + col];
                const float nr = ar * sr - ai * si + dr, ni = ar * si + ai * sr + di; sr = nr; si = ni; }
            if (!lat) { c.out()[O_S5 + ((((size_t)(b * 2 + l) * 2 + dir) * 2 + 0) * 32 + g) * 64 + n] = sr; c.out()[O_S5 + ((((size_t)(b * 2 + l) * 2 + dir) * 2 + 1) * 32 + g) * 64 + n] = si; }
        }
        __syncthreads();
    }
    const bf16* Wop = (const bf16*)(c.ws() + WS_S5WO) + (size_t)g * 65536 + 8 * lq;
#pragma unroll 1
    for (int ii = 0; ii < 2; ++ii) { const int i = 2 * w + ii;
        f32x4 acc[4];
#pragma unroll
        for (int cb = 0; cb < 4; ++cb) acc[cb] = (f32x4){0.f, 0.f, 0.f, 0.f};
        bx8 afr[8];
#pragma unroll
        for (int ks = 0; ks < 8; ++ks) afr[ks] = *(const bx8*)(Wop + (size_t)(16 * i + lr) * 256 + 32 * ks);
#pragma unroll
        for (int ks = 0; ks < 8; ++ks) { const int j = 2 * ks + (lq >> 1); const bx8 af = *(const bx8*)(Kt + ((i - j + 15) * 16 + lr) * 16 + 8 * (lq & 1));
#pragma unroll
            for (int cb = 0; cb < 4; ++cb) { const bx8 bf = *(const bx8*)(Ut + (16 * cb + lr) * 264 + 32 * ks + 8 * lq); acc[cb] = MFMA16(af, bf, acc[cb]); }
            __builtin_amdgcn_sched_barrier(0); }
#pragma unroll
        for (int ks = 0; ks < 8; ++ks) {
#pragma unroll
            for (int cb = 0; cb < 4; ++cb) { const bx8 bf = *(const bx8*)(St + (16 * cb + lr) * 264 + 32 * ks + 8 * lq); acc[cb] = MFMA16(afr[ks], bf, acc[cb]); }
            __builtin_amdgcn_sched_barrier(0); }
#pragma unroll
        for (int cb = 0; cb < 4; ++cb) { const int col = 16 * cb + lr;
            const int tok = lat ? MC + (cu - 8) * 1024 + col * 16 + i : (4 * cu + (col >> 4)) * 256 + (col & 15) * 16 + i;
            v2u o; o.x = pk2(acc[cb][0], acc[cb][1]); o.y = pk2(acc[cb][2], acc[cb][3]);
            *(v2u*)(c.Y5() + (size_t)tok * 512 + g * 16 + 4 * lq) = o; }
    }
}

typedef float f32x16 __attribute__((ext_vector_type(16)));
#define MFMA32(a, b, cc) __builtin_amdgcn_mfma_f32_32x32x16_bf16((a), (b), (cc), 0, 0, 0)
constexpr float SM_SC = 0.125f * 1.4426950408889634f;
__device__ __forceinline__ void qk_tile(f32x16& p0, f32x16& p1, const bf16* Kt, int KS, const bx8 (&qf)[4], int r32, int hi) {
    p0 = (f32x16){0.f}; p1 = (f32x16){0.f};
#pragma unroll
    for (int d0 = 0; d0 < 4; ++d0) { const bx8 a0 = *(const bx8*)(Kt + r32 * KS + 16 * d0 + 8 * hi), a1 = *(const bx8*)(Kt + (32 + r32) * KS + 16 * d0 + 8 * hi);
        p0 = MFMA32(a0, qf[d0], p0); p1 = MFMA32(a1, qf[d0], p1); }
}
__device__ __forceinline__ float fmax_(float a, float b) { float r; asm("v_max_f32_e32 %0, %1, %2" : "=v"(r) : "v"(a), "v"(b)); return r; }
__device__ __forceinline__ float sm_step(f32x16& p0, f32x16& p1, float& mrun, float& lrun, bx8 (&pb)[4]) {
    float ta = fmax_(p0[0], p1[0]), tb = fmax_(p0[1], p1[1]);
#pragma unroll
    for (int r = 2; r < 16; r += 2) { ta = fmax_(ta, fmax_(p0[r], p1[r])); tb = fmax_(tb, fmax_(p0[r + 1], p1[r + 1])); }
    float tm = fmax_(ta, tb) * SM_SC;
    tm = fmax_(tm, __shfl_xor(tm, 32));
    const float mn = fmax_(mrun, tm), alpha = __builtin_amdgcn_exp2f(mrun - mn);
    float rs0 = 0.f, rs1 = 0.f;
#pragma unroll
    for (int r = 0; r < 16; ++r) { p0[r] = __builtin_amdgcn_exp2f(fmaf(p0[r], SM_SC, -mn)); p1[r] = __builtin_amdgcn_exp2f(fmaf(p1[r], SM_SC, -mn)); rs0 += p0[r]; rs1 += p1[r]; }
    float rs = rs0 + rs1;
    rs += __shfl_xor(rs, 32);
    lrun = lrun * alpha + rs; mrun = mn;
#pragma unroll
    for (int sI = 0; sI < 2; ++sI) {
        v4u t0, t1;
        t0.x = pg8::cvt_pk_bf16(p0[8 * sI + 0], p0[8 * sI + 1]); t0.y = pg8::cvt_pk_bf16(p0[8 * sI + 2], p0[8 * sI + 3]); t0.z = pg8::cvt_pk_bf16(p0[8 * sI + 4], p0[8 * sI + 5]); t0.w = pg8::cvt_pk_bf16(p0[8 * sI + 6], p0[8 * sI + 7]);
        t1.x = pg8::cvt_pk_bf16(p1[8 * sI + 0], p1[8 * sI + 1]); t1.y = pg8::cvt_pk_bf16(p1[8 * sI + 2], p1[8 * sI + 3]); t1.z = pg8::cvt_pk_bf16(p1[8 * sI + 4], p1[8 * sI + 5]); t1.w = pg8::cvt_pk_bf16(p1[8 * sI + 6], p1[8 * sI + 7]);
        pb[sI] = __builtin_bit_cast(bx8, t0); pb[2 + sI] = __builtin_bit_cast(bx8, t1);
    }
    return alpha;
}
template <int NDT> __device__ __forceinline__ void pv_tile(f32x16 (&o)[NDT], const bf16* Vt, const bx8 (&pb)[4], int r32, int hi) {
    v2u cur[NDT][2], nxt[NDT][2];
#pragma unroll
    for (int dt = 0; dt < NDT; ++dt) { const bf16* vp = Vt + (32 * dt + r32) * 68 + 4 * hi; cur[dt][0] = *(const v2u*)vp; cur[dt][1] = *(const v2u*)(vp + 8); }
#pragma unroll
    for (int ks = 0; ks < 4; ++ks) {
        if (ks < 3) {
#pragma unroll
            for (int dt = 0; dt < NDT; ++dt) { const bf16* vp = Vt + (32 * dt + r32) * 68 + 16 * (ks + 1) + 4 * hi; nxt[dt][0] = *(const v2u*)vp; nxt[dt][1] = *(const v2u*)(vp + 8); }
        }
#pragma unroll
        for (int dt = 0; dt < NDT; ++dt) { const v4u t = {cur[dt][0].x, cur[dt][0].y, cur[dt][1].x, cur[dt][1].y}; o[dt] = MFMA32(__builtin_bit_cast(bx8, t), pb[ks], o[dt]); }
#pragma unroll
        for (int dt = 0; dt < NDT; ++dt) { cur[dt][0] = nxt[dt][0]; cur[dt][1] = nxt[dt][1]; }
    }
}

template <int PASS> __device__ __forceinline__ void diff_unit(const Ctx& c, int l, int uidx, unsigned char* lds) {
    constexpr int NT = PASS ? 20 : 4, NQB = PASS ? 8 : 2;
    const int tid = c.tid, lane = c.lane, w = c.wave, r32 = lane & 31, hi = lane >> 5, comp = w >> 2;
    const int qb = uidx % NQB, h = (uidx / NQB) & 3, b = uidx / (NQB * 4);
    const int tok0 = PASS ? MC + b * 1024 : b * 256;
    bf16* Kt = (bf16*)lds;
    bf16* Vt = Kt + 64 * 136;
    float* Ob = (float*)(Vt + 128 * 68);
    const bf16* R1p = c.R1(); const bf16* CK = c.CKV();
    const float lam_init = 0.8f - 0.6f * expf(-0.3f * (float)l);
    const float* lv = c.dlam() + l * 256;
    const float lam = expf(wave_sum(lv[lane] * lv[64 + lane])) - expf(wave_sum(lv[128 + lane] * lv[192 + lane])) + lam_init;
    const size_t mrow = (size_t)tok0 + qb * 128 + 32 * (w & 3) + r32;
    bx8 qf[4];
#pragma unroll
    for (int d0 = 0; d0 < 4; ++d0) qf[d0] = *(const bx8*)(R1p + mrow * 4096 + C_DQ + h * 128 + comp * 64 + 16 * d0 + 8 * hi);
    f32x16 o[4];
#pragma unroll
    for (int dt = 0; dt < 4; ++dt) o[dt] = (f32x16){0.f};
    float mrun = -1e30f, lrun = 0.f;
    v4u kreg[2], vreg[2];
#define DIFF_LOAD(t) { const bf16* kb; const bf16* vb; size_t rs; \
        if (PASS && (t) < 4) { kb = CK + ((size_t)b * 256 + 64 * (t)) * 1280 + h * 128; vb = kb + 512; rs = 1280; } \
        else { kb = R1p + ((size_t)tok0 + 64 * ((t) - (PASS ? 4 : 0))) * 4096 + C_DK + h * 128; vb = kb + (C_DV - C_DK); rs = 4096; } \
        _Pragma("unroll") for (int i = 0; i < 2; ++i) { kreg[i] = *(const v4u*)(kb + (size_t)lane * rs + (w + 8 * i) * 8); vreg[i] = *(const v4u*)(vb + (size_t)lane * rs + (w + 8 * i) * 8); } }
    DIFF_LOAD(0);
    for (int t = 0; t < NT; ++t) {
        LDS_BARRIER();
#pragma unroll
        for (int i = 0; i < 2; ++i) { *(v4u*)(Kt + lane * 136 + (w + 8 * i) * 8) = kreg[i];
            const unsigned vs[4] = {vreg[i].x, vreg[i].y, vreg[i].z, vreg[i].w};
#pragma unroll
            for (int j = 0; j < 4; ++j) { Vt[((w + 8 * i) * 8 + 2 * j) * 68 + lane] = (bf16)(vs[j] & 0xffffu); Vt[((w + 8 * i) * 8 + 2 * j + 1) * 68 + lane] = (bf16)(vs[j] >> 16); } }
        if (t + 1 < NT) DIFF_LOAD(t + 1);
        LDS_BARRIER();
        f32x16 p0, p1; bx8 pb[4];
        qk_tile(p0, p1, Kt + comp * 64, 136, qf, r32, hi);
        const float alpha = sm_step(p0, p1, mrun, lrun, pb);
        if (__any(alpha != 1.0f)) {
#pragma unroll
            for (int dt = 0; dt < 4; ++dt)
#pragma unroll
                for (int r = 0; r < 16; ++r) o[dt][r] *= alpha; }
        pv_tile<4>(o, Vt, pb, r32, hi);
    }
#undef DIFF_LOAD
    const float inv = (comp ? lam : 1.0f) / lrun;
    const int rowl = 32 * (w & 3) + r32;
    if (comp) {
#pragma unroll
        for (int dt = 0; dt < 4; ++dt)
#pragma unroll
            for (int r = 0; r < 16; ++r) Ob[rowl * 129 + 32 * dt + (r & 3) + 8 * (r >> 2) + 4 * hi] = o[dt][r] * inv;
    }
    __syncthreads();
    if (!comp) {
        float ss = 0.f;
#pragma unroll
        for (int dt = 0; dt < 4; ++dt)
#pragma unroll
            for (int r = 0; r < 16; ++r) { const float v = o[dt][r] * inv - Ob[rowl * 129 + 32 * dt + (r & 3) + 8 * (r >> 2) + 4 * hi]; o[dt][r] = v; ss += v * v; }
        ss += __shfl_xor(ss, 32);
        const float rn = rsqrtf(ss * (1.0f / 128.0f) + EPS) * (1.0f - lam_init);
        const float* sg = c.subln_g() + l * 128; bf16* yp = c.Y() + mrow * 2048 + 1024 + h * 128;
#pragma unroll
        for (int dt = 0; dt < 4; ++dt)
#pragma unroll
            for (int r4 = 0; r4 < 4; ++r4) { const int dv = 32 * dt + 8 * r4 + 4 * hi; const f32x4 g = *(const f32x4*)(sg + dv);
                v2u ov; ov.x = pk2(o[dt][4 * r4 + 0] * rn * g.x, o[dt][4 * r4 + 1] * rn * g.y); ov.y = pk2(o[dt][4 * r4 + 2] * rn * g.z, o[dt][4 * r4 + 3] * rn * g.w);
                *(v2u*)(yp + dv) = ov; }
    }
}

template <int PASS> __device__ __forceinline__ void win_unit(const Ctx& c, int l, int uidx, unsigned char* lds) {
    constexpr int NQB = PASS ? 4 : 1;
    const int tid = c.tid, lane = c.lane, w = c.wave, r32 = lane & 31, hi = lane >> 5;
    const int qb = uidx % NQB, hh = (uidx / NQB) & 7, b = uidx / (NQB * 8), nkv = hh >> 2;
    const int tok0 = PASS ? MC + b * 1024 : b * 256;
    bf16* Kt = (bf16*)lds;
    bf16* Vt = Kt + 64 * 72;
    const bf16* R1p = c.R1(); const bf16* CK = c.CKV();
    const int qrow = qb * 256 + 32 * w + r32;
    const size_t mrow = (size_t)tok0 + qrow;
    bx8 qf[4];
#pragma unroll
    for (int d0 = 0; d0 < 4; ++d0) qf[d0] = *(const bx8*)(R1p + mrow * 4096 + C_WQ + hh * 64 + 16 * d0 + 8 * hi);
    f32x16 o[2]; o[0] = (f32x16){0.f}; o[1] = (f32x16){0.f};
    float mrun = c.sink()[l * 8 + hh] * 1.4426950408889634f, lrun = 1.0f;
    const int q0 = qb * 256;
    const int tb0 = PASS ? ((q0 - 128 < 0 ? 0 : q0 - 128) >> 6) : 0, tb1 = PASS ? ((q0 + 255 + 128 > 1023 ? 1023 : q0 + 255 + 128) >> 6) : 0;
    const int NT = PASS ? 4 + (tb1 - tb0 + 1) : 4;
    const int kvl = tid & 63, chunk = tid >> 6;
    v4u kreg, vreg;
#define WIN_LOAD(t) { const bf16* kb; const bf16* vb; size_t rs; \
        if (PASS && (t) < 4) { kb = CK + ((size_t)b * 256 + 64 * (t)) * 1280 + 1024 + nkv * 64; vb = kb + 128; rs = 1280; } \
        else { kb = R1p + ((size_t)tok0 + 64 * (PASS ? tb0 + (t) - 4 : (t))) * 4096 + C_WK + nkv * 64; vb = kb + (C_WV - C_WK); rs = 4096; } \
        kreg = *(const v4u*)(kb + (size_t)kvl * rs + chunk * 8); vreg = *(const v4u*)(vb + (size_t)kvl * rs + chunk * 8); }
    WIN_LOAD(0);
    for (int t = 0; t < NT; ++t) {
        LDS_BARRIER();
        *(v4u*)(Kt + kvl * 72 + chunk * 8) = kreg;
        { const unsigned vs[4] = {vreg.x, vreg.y, vreg.z, vreg.w};
#pragma unroll
          for (int j = 0; j < 4; ++j) { Vt[(chunk * 8 + 2 * j) * 68 + kvl] = (bf16)(vs[j] & 0xffffu); Vt[(chunk * 8 + 2 * j + 1) * 68 + kvl] = (bf16)(vs[j] >> 16); } }
        if (t + 1 < NT) WIN_LOAD(t + 1);
        LDS_BARRIER();
        bool band = false; int kp0 = 0;
        if (PASS && t >= 4) { band = true; kp0 = 64 * (tb0 + t - 4); const int r0 = q0 + 32 * w;
            if (kp0 + 63 < r0 - 128 || kp0 > r0 + 31 + 128) continue; }
        f32x16 p0, p1; bx8 pb[4];
        qk_tile(p0, p1, Kt, 72, qf, r32, hi);
        if (band) {
#pragma unroll
            for (int r = 0; r < 16; ++r) { const int kp = kp0 + (r & 3) + 8 * (r >> 2) + 4 * hi; const int d0 = qrow - kp, d1 = d0 - 32;
                if (d0 > 128 || d0 < -128) p0[r] = -1e30f; if (d1 > 128 || d1 < -128) p1[r] = -1e30f; }
        }
        const float alpha = sm_step(p0, p1, mrun, lrun, pb);
        if (__any(alpha != 1.0f)) {
#pragma unroll
            for (int dt = 0; dt < 2; ++dt)
#pragma unroll
                for (int r = 0; r < 16; ++r) o[dt][r] *= alpha; }
        pv_tile<2>(o, Vt, pb, r32, hi);
    }
#undef WIN_LOAD
    const float inv = 1.0f / lrun; bf16* yp = c.Y() + mrow * 2048 + 1536 + hh * 64;
#pragma unroll
    for (int dt = 0; dt < 2; ++dt)
#pragma unroll
        for (int r4 = 0; r4 < 4; ++r4) { const int dv = 32 * dt + 8 * r4 + 4 * hi;
            v2u ov; ov.x = pk2(o[dt][4 * r4 + 0] * inv, o[dt][4 * r4 + 1] * inv); ov.y = pk2(o[dt][4 * r4 + 2] * inv, o[dt][4 * r4 + 3] * inv);
            *(v2u*)(yp + dv) = ov; }
}

__device__ __forceinline__ void phase_mixers(const Ctx& c_in, int l, float* lf) {
    unsigned char* lds = (unsigned char*)lf;
    unsigned* qctr = (unsigned*)(c_in.ws() + WS_QCTR) + 64 * l;
    volatile int* qslot = (volatile int*)(lds + LDS_BYTES - 32);
    for (;;) {
        __syncthreads();
        if (threadIdx.x == 0) *qslot = (int)atomicAdd(qctr, 1u);
        __syncthreads();
        const int u = __builtin_amdgcn_readfirstlane(*qslot);
        if (u >= 1440) break;
        Ctx c = c_in; asm volatile("" : "+s"(c.ap), "+v"(c.tid));
        c.lane = c.tid & 63; c.wave = __builtin_amdgcn_readfirstlane(c.tid >> 6);
        unsigned long long pt0 = 0; if (PROBE_SEL >= 0) pt0 = __builtin_amdgcn_s_memrealtime();
        int ty;
        if (u < 32) { ssd_unit(c, l, 1, u >> 3, u & 7, lds); ty = 0; }
        else if (u < 160) { diff_unit<1>(c, l, u - 32, lds); ty = 2; }
        else if (u < 288) { win_unit<1>(c, l, u - 160, lds); ty = 3; }
        else if (u < 416) { s5_unit(c, l, (u - 288) & 31, 8 + ((u - 288) >> 5), lds); ty = 1; }
        else if (u < 672) { ssd_unit(c, l, 0, (u - 416) >> 3, (u - 416) & 7, lds); ty = 4; }
        else if (u < 928) { diff_unit<0>(c, l, u - 672, lds); ty = 6; }
        else if (u < 1184) { win_unit<0>(c, l, u - 928, lds); ty = 7; }
        else { s5_unit(c, l, (u - 1184) & 31, (u - 1184) >> 5, lds); ty = 5; }
        __syncthreads();
        if (PROBE_SEL >= 0 && threadIdx.x == 0) { unsigned long long* tsu = (unsigned long long*)(c.ws() + WS_TS) + 64; atomicAdd(tsu + ty, (unsigned long long)(__builtin_amdgcn_s_memrealtime() - pt0)); }
    }
}

__device__ __forceinline__ void phase_sum4(const Ctx& c) {
    const int gt = blockIdx.x * NTHR + c.tid, NT = gridDim.x * NTHR;
#pragma unroll 4
    for (int i = gt; i < M * 128; i += NT) { const size_t m = (size_t)(i >> 7); const int c8 = (i & 127) * 8;
        float a[8] = {0.f, 0.f, 0.f, 0.f, 0.f, 0.f, 0.f, 0.f};
#pragma unroll
        for (int j = 0; j < 4; ++j) { float f[8]; unpack8(*(const v4u*)(c.R1() + m * 4096 + j * 1024 + c8), f);
#pragma unroll
            for (int k = 0; k < 8; ++k) a[k] += f[k]; }
        v4u o; o.x = pk2(a[0], a[1]); o.y = pk2(a[2], a[3]); o.z = pk2(a[4], a[5]); o.w = pk2(a[6], a[7]);
        *(v4u*)(c.H() + m * 1024 + c8) = o; }
}

#define GAS __attribute__((address_space(1)))
#define XB_TMO      128
#define XB_XCNT(j)  (256  + 64 * (j))
#define XB_XSUB(j)  (1280 + 64 * (j))
#define XB_XGEN(j)  (2304 + 64 * (j))
#define XB_TOP      3328
#define XB_TOPGEN   3392
#define XCD_BAR_WORDS 3456
#define XB_SPIN_CAP (1u << 18)

__device__ __forceinline__ unsigned xb_ld(unsigned* p)              { return __hip_atomic_load(p, __ATOMIC_RELAXED, __HIP_MEMORY_SCOPE_AGENT); }
__device__ __forceinline__ unsigned xb_add(unsigned* p, unsigned v) { return __hip_atomic_fetch_add(p, v, __ATOMIC_RELAXED, __HIP_MEMORY_SCOPE_AGENT); }
__device__ __forceinline__ unsigned xb_xcc_id() { return (unsigned)__builtin_amdgcn_s_getreg((3 << 11) | 20) & 0xFu; }
#define XB_SPIN(cond, bar) do { unsigned _sp = 0; while (cond) { __builtin_amdgcn_s_sleep(1); \
    if ((++_sp & 255u) == 0u) { if (xb_ld(&(bar)[XB_TMO])) break; if (_sp > XB_SPIN_CAP) { atomicAdd(&(bar)[XB_TMO], 1u); break; } } } } while (0)

struct XcdBarrier {
    unsigned* bar; unsigned x;
    volatile LAS unsigned* st;
};

__device__ __forceinline__ XcdBarrier xcd_barrier_post(unsigned* bar, volatile LAS unsigned* st) {
    XcdBarrier b; b.bar = bar; b.x = xb_xcc_id(); b.st = st;
    if (threadIdx.x == 0) (void)xb_add(&bar[XB_XCNT(b.x)], 1u);
    return b;
}
__device__ __forceinline__ void xcd_barrier_complete(unsigned* bar, unsigned x, unsigned& nloc, unsigned& nx) {
    const unsigned G = gridDim.x * gridDim.y * gridDim.z;
    unsigned sum, cnt, mine, sp = 0u;
    for (;;) {
        sum = 0u; cnt = 0u; mine = 0u;
#pragma unroll
        for (unsigned j = 0; j < 16; ++j) { const unsigned c = xb_ld(&bar[XB_XCNT(j)]); sum += c; cnt += (c > 0u) ? 1u : 0u; mine = (j == x) ? c : mine; }
        if (sum == G) break;
        __builtin_amdgcn_s_sleep(1);
        if ((++sp & 255u) == 0u) { if (xb_ld(&bar[XB_TMO])) break; if (sp > XB_SPIN_CAP) { atomicAdd(&bar[XB_TMO], 1u); break; } }
    }
    nloc = mine > 0u ? mine : 1u; nx = cnt > 0u ? cnt : 1u;
}

__device__ __forceinline__ void xcd_barrier(const XcdBarrier& b) {
    asm volatile("s_waitcnt vmcnt(0)" ::: "memory");
    __syncthreads();
    if (threadIdx.x == 0) {
        unsigned* bar = b.bar;
        __builtin_amdgcn_s_waitcnt(0);
        unsigned nloc = b.st[0], nx = b.st[1];
        if (nloc == 0u) { xcd_barrier_complete(bar, b.x, nloc, nx); b.st[0] = nloc; b.st[1] = nx; }
        const unsigned old = xb_add(&bar[XB_XSUB(b.x)], 1u);
        const unsigned gen = old / nloc;
        if (old + 1u == (gen + 1u) * nloc) {
            __builtin_amdgcn_fence(__ATOMIC_RELEASE, "agent");
            asm volatile("s_waitcnt vmcnt(0)" ::: "memory");
            const unsigned og = xb_add(&bar[XB_TOP], 1u);
            const unsigned tg = og / nx;
            if (og + 1u == (tg + 1u) * nx) xb_add(&bar[XB_TOPGEN], 1u);
            else XB_SPIN(xb_ld(&bar[XB_TOPGEN]) == tg, bar);
            __builtin_amdgcn_fence(__ATOMIC_ACQUIRE, "agent");
            xb_add(&bar[XB_XGEN(b.x)], 1u);
            asm volatile("s_waitcnt vmcnt(0)" ::: "memory");
        } else {
            XB_SPIN(xb_ld(&bar[XB_XGEN(b.x)]) == gen, bar);
            __builtin_amdgcn_fence(__ATOMIC_ACQUIRE, "agent");
            asm volatile("s_waitcnt vmcnt(0)" ::: "memory");
        }
    }
    __syncthreads();
}

#define PHASE_BEGIN() Ctx c; c.ap = (CArgs)__builtin_amdgcn_kernarg_segment_ptr(); asm volatile("" : "+s"(c.ap)); \
        int tid_o = threadIdx.x; asm volatile("" : "+v"(tid_o)); c.tid = tid_o; c.lane = tid_o & 63; c.wave = __builtin_amdgcn_readfirstlane(tid_o >> 6); \
        int G = gridDim.x, bid = blockIdx.x; asm volatile("" : "+s"(G), "+s"(bid)); unsigned char* ws = c.ws(); (void)ws; (void)G; (void)bid;
#define PHASE_END(k) { if ((k) + 1 < ph_hi) { if ((k) == 0) cg::this_grid().sync(); else xcd_barrier(xbar); } \
        if (PROBE_SEL >= 0 && blockIdx.x == PROBE_PB && threadIdx.x == 0) ((unsigned long long*)(c.ws() + WS_TS))[(k) + 1] = __builtin_amdgcn_s_memrealtime(); }
#define IN_RANGE(k) (ph_lo <= (k) && (k) < ph_hi)

template <int LAYER> __device__ __forceinline__ void layer_program(int ph_lo, int ph_hi, unsigned char* lds, const XcdBarrier& xbar) {
    float* lf = (float*)lds;
    PG8_LAS unsigned char* ring = (PG8_LAS unsigned char*)lds;
    constexpr int l = LAYER, B0 = 1 + 11 * LAYER;
    if (IN_RANGE(B0 + 0)) { PHASE_BEGIN(); if (l == 1) { if (gridDim.x == 256) convert_items(c, 1, 7936, 9984, blockIdx.x * NWAVES + c.wave, gridDim.x * NWAVES, false, 0, 1, lf); else phase_convert(c, 1, lf); __syncthreads(); } phase_norm(c, l, 0, lf); PHASE_END(B0 + 0); }
    if (IN_RANGE(B0 + 1)) { PHASE_BEGIN();
        pg8::Gemm g{c.H(), (const bf16*)(ws + W_IN), M, 4096, 1024, 1024, 1024, 0, 0}; pg8::StaticOrder S; S.init(M, 4096, G, bid);
        pg8::EpiB<0> E{c.R1(), 4096, nullptr, nullptr};
        pg8::gemm_phase<pg8::EpiB<0>, pg8::StaticOrder, true, true>(ring, g, S, E, tid_o); phase_dt(c, l); PHASE_END(B0 + 1); }
    if (IN_RANGE(B0 + 2)) { PHASE_BEGIN(); phase_qk(c, l, lf); PHASE_END(B0 + 2); }
    if (IN_RANGE(B0 + 3)) { PHASE_BEGIN(); phase_mixers(c, l, lf); PHASE_END(B0 + 3); }
    if (IN_RANGE(B0 + 4)) { PHASE_BEGIN();
        { pg8::Gemm g{c.Y5(), (const bf16*)(ws + W_GLU), M, 1024, 512, 512, 512, 0, 0}; pg8::StaticOrder S; S.init(M, 1024, G, bid);
          pg8::EpiGlu E{c.Y(), 2048, 512, c.b_glu() + l * 1024};
          pg8::gemm_phase<pg8::EpiGlu, pg8::StaticOrder, true, true>(ring, g, S, E, tid_o); }
        { pg8::Gemm g{c.H(), (const bf16*)(ws + W_G), M, 4096, 1024, 1024, 1024, 0, 0}; pg8::StaticOrder S; S.init(M, 4096, G, bid);
          pg8::EpiB<1> E{c.R1(), 4096, c.b_gate() + l * 4096, nullptr};
          pg8::gemm_phase<pg8::EpiB<1>, pg8::StaticOrder, true, true>(ring, g, S, E, tid_o); }
        PHASE_END(B0 + 4); }
    if (IN_RANGE(B0 + 5)) { PHASE_BEGIN();
        pg8::Gemm g{c.Y(), (const bf16*)(ws + W_BR), M, 4096, 512, 2048, 512, 4, 1024}; pg8::BranchOrder S; S.init(G, bid);
        pg8::EpiMerge E{c.R1(), c.H(), c.SSQ()};
        pg8::gemm_phase<pg8::EpiMerge, pg8::BranchOrder, true, true>(ring, g, S, E, tid_o); if (l == 0) side_convert(c, 0, 4352, true, lf); PHASE_END(B0 + 5); }
    if (IN_RANGE(B0 + 7)) { PHASE_BEGIN();
        pg8::Gemm g{c.H(), (const bf16*)(ws + W_OUT), M, 1024, 1024, 1024, 1024, 0, 0}; pg8::StaticOrder S; S.init(M, 1024, G, bid);
        pg8::EpiRes E{l == 0 ? c.x_prompt() : c.out(), l == 0 ? c.x_sample() : c.out() + (size_t)MC * D, c.out(), c.MOD() + (size_t)l * 5 * 6144, 2048};
        pg8::gemm_phase<pg8::EpiRes, pg8::StaticOrder, true, true>(ring, g, S, E, tid_o); if (l == 0) side_convert(c, 4352, 5376, false, lf); PHASE_END(B0 + 7); }
    if (IN_RANGE(B0 + 8)) { PHASE_BEGIN(); phase_norm(c, l, 1, lf); PHASE_END(B0 + 8); }
    if (IN_RANGE(B0 + 9)) { PHASE_BEGIN();
        pg8::Gemm g{c.H(), (const bf16*)(ws + W_1), M, 4096, 1024, 1024, 1024, 0, 0}; pg8::StaticOrder S; S.init(M, 4096, G, bid);
        pg8::EpiB<2> E{c.R1(), 4096, nullptr, nullptr};
        pg8::gemm_phase<pg8::EpiB<2>, pg8::StaticOrder, true, true>(ring, g, S, E, tid_o); PHASE_END(B0 + 9); }
    if (IN_RANGE(B0 + 10)) { PHASE_BEGIN();
        pg8::Gemm g{c.R1(), (const bf16*)(ws + W_2), M, 1024, 4096, 4096, 4096, 0, 0}; pg8::StaticOrder S; S.init(M, 1024, G, bid);
        pg8::EpiRes E{c.out(), c.out() + (size_t)MC * D, c.out(), c.MOD() + (size_t)l * 5 * 6144, 5120};
        pg8::gemm_phase<pg8::EpiRes, pg8::StaticOrder, true, true>(ring, g, S, E, tid_o); if (l == 0) side_convert(c, 5376, 7936, false, lf); PHASE_END(B0 + 10); }
}

__global__ void __launch_bounds__(NTHR, 2) fwd_kernel(Args args) {
    extern __shared__ __attribute__((aligned(16))) unsigned char lds[];
    const int ph_lo = args.ph_lo, ph_hi = args.ph_hi;
    volatile LAS unsigned* xst = (volatile LAS unsigned*)(lds + LDS_BYTES - 16);
    if (threadIdx.x < 4) xst[threadIdx.x] = 0u;
    __syncthreads();
    const XcdBarrier xbar = xcd_barrier_post((unsigned*)(args.ws + WS_BAR), xst);
    if (PROBE_SEL >= 0 && blockIdx.x == PROBE_PB && threadIdx.x == 0) { unsigned long long* ts = (unsigned long long*)(args.ws + WS_TS); ts[0] = __builtin_amdgcn_s_memrealtime(); }
    if (IN_RANGE(0)) { PHASE_BEGIN(); float* lf = (float*)lds; phase_mods(c, lf); __syncthreads(); phase_convert(c, 0, lf); phase_rope_table(c); PHASE_END(0); }
    layer_program<0>(ph_lo, ph_hi, lds, xbar);
    layer_program<1>(ph_lo, ph_hi, lds, xbar);
    if (PROBE_SEL >= 0) {
        __threadfence(); cg::this_grid().sync();
        const unsigned long long* ts = (const unsigned long long*)(args.ws + WS_TS);
        const float total = (float)(ts[23] - ts[0]); float sel = 0.f;
        for (int k = 0; k < 23; ++k) { const float d = (float)(ts[k + 1] - ts[k]); const int q = k == 0 ? -1 : (k - 1) % 11;
            const int cls = (q == 3) ? 0 : (q == 1 || q == 4 || q == 5 || q == 7 || q == 9 || q == 10) ? 1 : (q == 2) ? 2 : 3;
            if (cls == PROBE_SEL) sel += d; }
        if (PROBE_SEL >= 10 && PROBE_SEL < 100) sel = (float)ts[64 + PROBE_SEL - 10] * (1.0f / 256.0f);
        if (PROBE_SEL >= 100) sel = (float)(ts[PROBE_SEL - 100 + 1] - ts[PROBE_SEL - 100]);
        const float sc = 1.0f + sqrtf(PROBE_SCALE * sel / total);
        for (int i = blockIdx.x * NTHR + threadIdx.x; i < 524288; i += gridDim.x * NTHR) args.out[O_S5 + i] *= sc;
    }
}

extern "C" void kernel_launch(void* const* d_in, const int* in_sizes, int n_in, void* d_out, int out_size, void* d_ws, size_t ws_size, hipStream_t stream) {
    static int grid = 0;
    if (grid == 0) {
        if (n_in != 44 || ws_size < WS_END) { fprintf(stderr, "kernel_launch: expected 44 inputs and >= %zu bytes of workspace; got %d, %zu\n", (size_t)WS_END, n_in, ws_size); grid = -1; return; }
        int dev = 0, cus = 0, per_cu = 0;
        (void)hipGetDevice(&dev); (void)hipDeviceGetAttribute(&cus, hipDeviceAttributeMultiprocessorCount, dev);
        (void)hipFuncSetAttribute((const void*)fwd_kernel, hipFuncAttributeMaxDynamicSharedMemorySize, LDS_BYTES);
        (void)hipOccupancyMaxActiveBlocksPerMultiprocessor(&per_cu, (const void*)fwd_kernel, NTHR, LDS_BYTES);
        if (per_cu < 1) { fprintf(stderr, "kernel_launch: occupancy query says %d blocks per CU\n", per_cu); per_cu = 1; }
        (void)hipGetLastError();
        grid = cus > 0 ? cus : 256;
    }
    if (grid < 0) return;
    (void)hipMemsetAsync(d_ws, 0, 64 * 1024, stream);
    Args a{};
    for (int i = 0; i < 44; ++i) a.in[i] = (const float*)d_in[i];
    a.out = (float*)d_out; a.ws = (unsigned char*)d_ws;
#if MK_MULTI
    for (int ph = 0; ph < NPH; ++ph) { a.ph_lo = ph; a.ph_hi = ph + 1; hipLaunchKernelGGL(fwd_kernel, dim3(grid), dim3(NTHR), LDS_BYTES, stream, a); }
#else
    a.ph_lo = 0; a.ph_hi = NPH;
    void* kargs[] = {&a};
    hipError_t e = hipLaunchCooperativeKernel((const void*)fwd_kernel, dim3(grid), dim3(NTHR), kargs, LDS_BYTES, stream);
    if (e != hipSuccess) fprintf(stderr, "cooperative launch failed: %s (grid %d)\n", hipGetErrorString(e), grid);
#endif
}
```

```cpp
#include <hip/hip_runtime.h>
#include <hip/hip_cooperative_groups.h>
#include <cstdio>
#include <cstdint>
namespace cg = cooperative_groups;

#ifndef MK_MULTI
#define MK_MULTI 0
#endif

namespace pg8 {
#define PG8_LAS __attribute__((address_space(3)))
typedef unsigned short bf16_t;
typedef short bf16x8 __attribute__((ext_vector_type(8)));
typedef float f32x4 __attribute__((ext_vector_type(4)));
typedef unsigned u32x4 __attribute__((ext_vector_type(4)));
constexpr int BM = 256, BK = 64, HALF = 128, HTB = HALF * BK * 2  , STAGE_BYTES = 8 * HTB, NXCD = 8, WGM = 8;

__host__ __device__ __forceinline__ int lds_byte(int r, int c) { const int st = (r >> 4) * 2 + (c >> 5), rr = r & 15, cc = c & 31, ob = rr * 64 + cc * 2; return st * 1024 + (ob ^ (((ob >> 9) & 1) << 5)); }
__host__ __device__ __forceinline__ void stage_rc(int b, int& R, int& C) { const int st = b / 1024, sb = b % 1024, swz = sb ^ (((sb >> 9) & 1) << 5); R = (st >> 1) * 16 + swz / 64; C = (st & 1) * 32 + (swz % 64) / 2; }
__host__ __device__ __forceinline__ int perm32(int rho) { const int n = rho >> 4, i = rho & 15; return 8 * (i >> 2) + 4 * n + (i & 3); }

struct Unit { int pm, pn; };
struct Gemm { const bf16_t* A; const bf16_t* Bt; int M, N, K, lda, ldb, a_div; size_t a_gstride; };

struct StaticOrder {
    int nM, nN, nwg, G, c;
    __host__ __device__ void init(int M, int N, int G_, int c_) { nM = M / BM; nN = N / BM; nwg = nM * nN; G = G_; c = c_; }
    __host__ __device__ bool next(int i, Unit& u) const {
        const long L = (long)i * G + c; if (L >= nwg) return false;
        int wgid = (int)L; { const int q = nwg / NXCD, r = nwg % NXCD, xcd = wgid % NXCD, off = wgid / NXCD; wgid = (xcd < r ? xcd * (q + 1) : r * (q + 1) + (xcd - r) * q) + off; }
        const int nig = WGM * nN, gid = wgid / nig, fm = gid * WGM, gsz = (nM - fm) < WGM ? (nM - fm) : WGM;
        u.pm = fm + ((wgid % nig) % gsz); u.pn = (wgid % nig) / gsz; return true;
    }
    __device__ __forceinline__ void a_ready(const Unit&) const {}
    __device__ __forceinline__ void done(const Unit&) const {}
};

__device__ __forceinline__ unsigned cvt_pk_bf16(float lo, float hi) { unsigned r; asm volatile("v_cvt_pk_bf16_f32 %0, %1, %2" : "=v"(r) : "v"(lo), "v"(hi)); return r; }
__device__ __forceinline__ float bf_lo(unsigned w) { return __builtin_bit_cast(float, w << 16); }
__device__ __forceinline__ float bf_hi(unsigned w) { return __builtin_bit_cast(float, w & 0xffff0000u); }
__device__ __forceinline__ float sigmoidf_(float x) { return 1.0f / (1.0f + __expf(-x)); }

template <int MODE> struct EpiB {
    static constexpr bool PERM = true, AFTER_DRAIN = false;
    bf16_t* O; int ldc; const float* bias; const float* ssq;
    __device__ __forceinline__ void operator()(const f32x4 (&acc)[2][2][4][2], const Unit& u, int wr, int wc, int fr, int fq) const {
        const int row0 = u.pm * BM + wr * 64 + fr, col0 = u.pn * BM + wc * 32 + 8 * fq;
        f32x4 bv[2][2];
#pragma unroll
        for (int bj = 0; bj < 2; ++bj)
#pragma unroll
            for (int n = 0; n < 2; ++n) bv[bj][n] = (MODE == 1) ? *(const f32x4*)(bias + col0 + bj * HALF + 4 * n) : (MODE == 5) ? *(const f32x4*)(bias + (size_t)((u.pm < 32) ? 0 : 1 + ((u.pm - 32) >> 2)) * 4096 + col0 + bj * HALF + 4 * n) : (f32x4){0.f, 0.f, 0.f, 0.f};
        u32x4 gpre[2][4][2]; float rpre[2][4];
        if (MODE == 3) {
#pragma unroll
            for (int ai = 0; ai < 2; ++ai)
#pragma unroll
                for (int m = 0; m < 4; ++m) { const int row = row0 + ai * HALF + m * 16; const bf16_t* rp = O + (size_t)row * ldc + col0;
                    rpre[ai][m] = (u.pn < 4) ? ssq[row] : 512.0f;
#pragma unroll
                    for (int bj = 0; bj < 2; ++bj) gpre[ai][m][bj] = *(const u32x4*)(rp + bj * HALF); }
        }
#pragma unroll
        for (int ai = 0; ai < 2; ++ai)
#pragma unroll
            for (int m = 0; m < 4; ++m) {
                const int row = row0 + ai * HALF + m * 16;
                bf16_t* rowp = O + (size_t)row * ldc + col0;
                float rs = 1.f;
                if (MODE == 3) { if (u.pn < 4) rs = rsqrtf(rpre[ai][m] * (1.0f / 512.0f) + 1e-6f); }
                if (MODE == 5) rs = rsqrtf(ssq[row] * (1.0f / 1024.0f) + 1e-6f);
#pragma unroll
                for (int bj = 0; bj < 2; ++bj) {
                    f32x4 v0 = (MODE == 5 ? acc[ai][bj][m][0] * rs : acc[ai][bj][m][0]) + bv[bj][0], v1 = (MODE == 5 ? acc[ai][bj][m][1] * rs : acc[ai][bj][m][1]) + bv[bj][1];
                    if (MODE == 1) {
#pragma unroll
                        for (int j = 0; j < 4; ++j) { v0[j] = sigmoidf_(v0[j]); v1[j] = sigmoidf_(v1[j]); }
                    }
                    if (MODE == 2 || MODE == 5) {
#pragma unroll
                        for (int j = 0; j < 4; ++j) { const float a = fmaxf(v0[j], 0.f), b = fmaxf(v1[j], 0.f); v0[j] = a * a; v1[j] = b * b; }
                    }
                    if (MODE == 3) {
                        const u32x4 gq = gpre[ai][m][bj];
                        v0[0] *= bf_lo(gq.x) * rs; v0[1] *= bf_hi(gq.x) * rs; v0[2] *= bf_lo(gq.y) * rs; v0[3] *= bf_hi(gq.y) * rs;
                        v1[0] *= bf_lo(gq.z) * rs; v1[1] *= bf_hi(gq.z) * rs; v1[2] *= bf_lo(gq.w) * rs; v1[3] *= bf_hi(gq.w) * rs;
                    }
                    u32x4 w; w.x = cvt_pk_bf16(v0[0], v0[1]); w.y = cvt_pk_bf16(v0[2], v0[3]); w.z = cvt_pk_bf16(v1[0], v1[1]); w.w = cvt_pk_bf16(v1[2], v1[3]);
                    *(u32x4*)(rowp + bj * HALF) = w;
                }
            }
    }
};
struct EpiGlu {
    static constexpr bool PERM = true, AFTER_DRAIN = false;
    bf16_t* O; int ldc; int ocol; const float* bias;
    __device__ __forceinline__ void operator()(const f32x4 (&acc)[2][2][4][2], const Unit& u, int wr, int wc, int fr, int fq) const {
        const int row0 = u.pm * BM + wr * 64 + fr, cc = u.pn * HALF + wc * 32 + 8 * fq;
        f32x4 bv[2][2];
#pragma unroll
        for (int bj = 0; bj < 2; ++bj)
#pragma unroll
            for (int n = 0; n < 2; ++n) bv[bj][n] = *(const f32x4*)(bias + bj * 512 + cc + 4 * n);
#pragma unroll
        for (int ai = 0; ai < 2; ++ai)
#pragma unroll
            for (int m = 0; m < 4; ++m) {
                bf16_t* rowp = O + (size_t)(row0 + ai * HALF + m * 16) * ldc + ocol + cc;
                f32x4 v0 = acc[ai][0][m][0] + bv[0][0], v1 = acc[ai][0][m][1] + bv[0][1];
                const f32x4 g0 = acc[ai][1][m][0] + bv[1][0], g1 = acc[ai][1][m][1] + bv[1][1];
#pragma unroll
                for (int j = 0; j < 4; ++j) { v0[j] *= sigmoidf_(g0[j]); v1[j] *= sigmoidf_(g1[j]); }
                u32x4 w; w.x = cvt_pk_bf16(v0[0], v0[1]); w.y = cvt_pk_bf16(v0[2], v0[3]); w.z = cvt_pk_bf16(v1[0], v1[1]); w.w = cvt_pk_bf16(v1[2], v1[3]);
                *(u32x4*)rowp = w;
            }
    }
};
struct EpiRes2 {
    static constexpr bool PERM = false, AFTER_DRAIN = false;
    const float* base_ctx; const float* base_lat; float* out; const float* modv; int goff;
    bf16_t* xn; const float* gnorm; int scoff; float* ssq;
    __device__ __forceinline__ void operator()(const f32x4 (&acc)[2][2][4][2], const Unit& u, int wr, int wc, int fr, int fq) const {
        const int row0 = u.pm * BM + wr * 64 + fr, col0 = u.pn * BM + wc * 32 + 4 * fq;
        const int mi = (u.pm < 32) ? 0 : 1 + ((u.pm - 32) >> 2);
        const float* gv = modv + (size_t)mi * 6144 + goff; const float* sv = modv + (size_t)mi * 6144 + scoff;
        f32x4 gg[2][2], gn[2][2];
#pragma unroll
        for (int bj = 0; bj < 2; ++bj)
#pragma unroll
            for (int n = 0; n < 2; ++n) { gg[bj][n] = *(const f32x4*)(gv + col0 + bj * HALF + n * 16); gn[bj][n] = *(const f32x4*)(gnorm + col0 + bj * HALF + n * 16) * (*(const f32x4*)(sv + col0 + bj * HALF + n * 16) + 1.0f); }
#pragma unroll
        for (int ai = 0; ai < 2; ++ai)
#pragma unroll
        for (int mh = 0; mh < 2; ++mh) {
            f32x4 pre[2][2][2];
#pragma unroll
            for (int mm = 0; mm < 2; ++mm) { const int row = row0 + ai * HALF + (2 * mh + mm) * 16;
                const float* bp = (row < 8192 ? base_ctx + (size_t)row * 1024 : base_lat + (size_t)(row - 8192) * 1024) + col0;
#pragma unroll
                for (int bj = 0; bj < 2; ++bj)
#pragma unroll
                    for (int n = 0; n < 2; ++n) pre[mm][bj][n] = *(const f32x4*)(bp + bj * HALF + n * 16); }
#pragma unroll
            for (int mm = 0; mm < 2; ++mm) { const int m = 2 * mh + mm; const int row = row0 + ai * HALF + m * 16; float* op = out + (size_t)row * 1024 + col0; bf16_t* xp = xn + (size_t)row * 1024 + col0;
                float q = 0.f;
#pragma unroll
                for (int bj = 0; bj < 2; ++bj)
#pragma unroll
                    for (int n = 0; n < 2; ++n) { const f32x4 x = pre[mm][bj][n] + gg[bj][n] * acc[ai][bj][m][n]; *(f32x4*)(op + bj * HALF + n * 16) = x;
                        q += (x[0] * x[0] + x[1] * x[1]) + (x[2] * x[2] + x[3] * x[3]);
                        const f32x4 y = x * gn[bj][n]; unsigned w0 = cvt_pk_bf16(y[0], y[1]), w1 = cvt_pk_bf16(y[2], y[3]);
                        typedef unsigned u32x2 __attribute__((ext_vector_type(2))); *(u32x2*)(xp + bj * HALF + n * 16) = (u32x2){w0, w1}; }
                q += __shfl_xor(q, 16); q += __shfl_xor(q, 32);
                if (fq == 0) atomicAdd(ssq + row, q); }
            asm volatile("" ::: "memory");
        }
    }
};
struct EpiMerge {
    static constexpr bool PERM = true, AFTER_DRAIN = false;
    const bf16_t* gates; bf16_t* mg; const float* ssq;
    __device__ __forceinline__ void operator()(const f32x4 (&acc)[2][2][4][2], const Unit& u, int wr, int wc, int fr, int fq) const {
        const int br = u.pn >> 2, pnl = u.pn & 3;
        int pm_o = u.pm; asm volatile("" : "+s"(pm_o));
        const int row0 = pm_o * BM + wr * 64 + fr, gcol0 = u.pn * BM + wc * 32 + 8 * fq, mcol0 = pnl * BM + wc * 32 + 8 * fq;
#pragma unroll
        for (int ai = 0; ai < 2; ++ai)
#pragma unroll
        for (int mh = 0; mh < 2; ++mh) {
            u32x4 gpre[2][2], mpre[2][2]; float rpre[2];
#pragma unroll
            for (int mm = 0; mm < 2; ++mm) { const int row = row0 + ai * HALF + (2 * mh + mm) * 16;
                rpre[mm] = (br == 0) ? ssq[row] : 512.0f;
#pragma unroll
                for (int bj = 0; bj < 2; ++bj) { gpre[mm][bj] = *(const u32x4*)(gates + (size_t)row * 4096 + gcol0 + bj * HALF);
                    mpre[mm][bj] = (br != 0) ? *(const u32x4*)(mg + (size_t)row * 1024 + mcol0 + bj * HALF) : (u32x4){0u, 0u, 0u, 0u}; } }
#pragma unroll
            for (int mm = 0; mm < 2; ++mm) { const int m = 2 * mh + mm; const int row = row0 + ai * HALF + m * 16;
                const float rs = (br == 0) ? rsqrtf(rpre[mm] * (1.0f / 512.0f) + 1e-6f) : 1.0f;
#pragma unroll
                for (int bj = 0; bj < 2; ++bj) { const u32x4 gq = gpre[mm][bj], mq = mpre[mm][bj]; const f32x4 a0 = acc[ai][bj][m][0], a1 = acc[ai][bj][m][1];
                    const float v0 = bf_lo(mq.x) + a0[0] * bf_lo(gq.x) * rs, v1 = bf_hi(mq.x) + a0[1] * bf_hi(gq.x) * rs, v2 = bf_lo(mq.y) + a0[2] * bf_lo(gq.y) * rs, v3 = bf_hi(mq.y) + a0[3] * bf_hi(gq.y) * rs;
                    const float v4 = bf_lo(mq.z) + a1[0] * bf_lo(gq.z) * rs, v5 = bf_hi(mq.z) + a1[1] * bf_hi(gq.z) * rs, v6 = bf_lo(mq.w) + a1[2] * bf_lo(gq.w) * rs, v7 = bf_hi(mq.w) + a1[3] * bf_hi(gq.w) * rs;
                    u32x4 w; w.x = cvt_pk_bf16(v0, v1); w.y = cvt_pk_bf16(v2, v3); w.z = cvt_pk_bf16(v4, v5); w.w = cvt_pk_bf16(v6, v7);
                    *(u32x4*)(mg + (size_t)row * 1024 + mcol0 + bj * HALF) = w; } }
            asm volatile("" ::: "memory");
        }
    }
};
struct BranchOrder {
    int G, c;
    __host__ __device__ void init(int G_, int c_) { G = G_; c = c_; }
    __host__ __device__ bool next(int i, Unit& u) const { if (c >= 192 || i >= 4) return false; u.pm = c >> 2; u.pn = i * 4 + (c & 3); return true; }
    __device__ __forceinline__ void a_ready(const Unit&) const {}
    __device__ __forceinline__ void done(const Unit&) const {}
};
struct EpiRes {
    static constexpr bool PERM = false, AFTER_DRAIN = false;
    const float* base_ctx; const float* base_lat;
    float* out; const float* modv;
    int goff;
    __device__ __forceinline__ void operator()(const f32x4 (&acc)[2][2][4][2], const Unit& u, int wr, int wc, int fr, int fq) const {
        const int row0 = u.pm * BM + wr * 64 + fr, col0 = u.pn * BM + wc * 32 + 4 * fq;
        const int mi = (u.pm < 32) ? 0 : 1 + ((u.pm - 32) >> 2);
        const float* gv = modv + (size_t)mi * 6144 + goff;
        f32x4 gg[2][2];
#pragma unroll
        for (int bj = 0; bj < 2; ++bj)
#pragma unroll
            for (int n = 0; n < 2; ++n) gg[bj][n] = *(const f32x4*)(gv + col0 + bj * HALF + n * 16);
#pragma unroll
        for (int ai = 0; ai < 2; ++ai) {
            f32x4 pre[4][2][2];
#pragma unroll
            for (int m = 0; m < 4; ++m) { const int row = row0 + ai * HALF + m * 16;
                const float* bp = (row < 8192 ? base_ctx + (size_t)row * 1024 : base_lat + (size_t)(row - 8192) * 1024) + col0;
#pragma unroll
                for (int bj = 0; bj < 2; ++bj)
#pragma unroll
                    for (int n = 0; n < 2; ++n) pre[m][bj][n] = *(const f32x4*)(bp + bj * HALF + n * 16); }
#pragma unroll
            for (int m = 0; m < 4; ++m) { const int row = row0 + ai * HALF + m * 16; float* op = out + (size_t)row * 1024 + col0;
#pragma unroll
                for (int bj = 0; bj < 2; ++bj)
#pragma unroll
                    for (int n = 0; n < 2; ++n) *(f32x4*)(op + bj * HALF + n * 16) = pre[m][bj][n] + gg[bj][n] * acc[ai][bj][m][n]; }
            asm volatile("" ::: "memory");
        }
    }
};

template <class Epi, class Sched, bool ALIGN_EPI = false, bool SP2 = false>
__device__ __forceinline__ void gemm_phase(PG8_LAS unsigned char* lds, const Gemm g, const Sched& S, const Epi& E, const int tid) {
    const int wid = __builtin_amdgcn_readfirstlane(tid >> 6), lane = tid & 63, wr = wid >> 2, wc = wid & 3, fr = lane & 15, fq = lane >> 4;
    const int K = g.K, nt = K / BK;
    unsigned voffA[2], voffB[2];
#pragma unroll
    for (int i = 0; i < 2; ++i) { int R, C; stage_rc(tid * 16 + i * 8192, R, C); const int Rb = Epi::PERM ? ((R & ~31) + perm32(R & 31)) : R;
        voffA[i] = (unsigned)(R * g.lda + C) * 2u; voffB[i] = (unsigned)(Rb * g.ldb + C) * 2u; }
    const size_t kstep = (size_t)(BK * 2);
    const size_t hstepA = (size_t)HALF * g.lda * 2, hstepB = (size_t)HALF * g.ldb * 2;
    const size_t tstepA = 2 * hstepA, tstepB = 2 * hstepB;
#define PG8_UA(u) ((const char*)g.A + (size_t)(u).pm * tstepA + (g.a_div ? (size_t)((u).pn / g.a_div) * g.a_gstride : (size_t)0))
#define PG8_UB(u) ((const char*)g.Bt + (size_t)(u).pn * tstepB)
    const unsigned ldsw = (unsigned)wid * 1024u;
    const int aoff = lds_byte(wr * 64 + fr, fq * 8), boff = lds_byte(wc * 32 + fr, fq * 8);
#define PG8_SA(b, h) (((b) * 2 + (h)) * HTB)
#define PG8_SB(b, h) ((4 + (b) * 2 + (h)) * HTB)
#define PG8_STAGE(bufoff, gbase, voff) do { _Pragma("unroll") for (int _i = 0; _i < 2; ++_i) \
        __builtin_amdgcn_global_load_lds((const unsigned*)((const char*)(gbase) + (voff)[_i]), (PG8_LAS unsigned*)(lds + (bufoff) + ldsw + _i * 8192), 16, 0, 0); } while (0)
#define PG8_LDA(dst, b, h) do { _Pragma("unroll") for (int m = 0; m < 4; ++m) _Pragma("unroll") for (int k = 0; k < 2; ++k) dst[m][k] = *(const PG8_LAS bf16x8*)(lds + PG8_SA(b, h) + aoff + m * 2048 + k * 1024); } while (0)
#define PG8_LDB(dst, b, h) do { _Pragma("unroll") for (int n = 0; n < 2; ++n) _Pragma("unroll") for (int k = 0; k < 2; ++k) dst[n][k] = *(const PG8_LAS bf16x8*)(lds + PG8_SB(b, h) + boff + n * 2048 + k * 1024); } while (0)
#define PG8_MMA(ai, bj, At, Bt) do { __builtin_amdgcn_s_setprio(1); _Pragma("unroll") for (int m = 0; m < 4; ++m) _Pragma("unroll") for (int n = 0; n < 2; ++n) _Pragma("unroll") for (int k = 0; k < 2; ++k) \
        acc[ai][bj][m][n] = __builtin_amdgcn_mfma_f32_16x16x32_bf16(Bt[n][k], At[m][k], acc[ai][bj][m][n], 0, 0, 0); __builtin_amdgcn_s_setprio(0); } while (0)
#define PG8_WAIT_V(n) asm volatile("s_waitcnt vmcnt(" #n ")" ::: "memory")
#define PG8_WAIT_L(n) asm volatile("s_waitcnt lgkmcnt(" #n ")" ::: "memory")
#define PG8_BAR __builtin_amdgcn_s_barrier()
#define PG8_SCHED __builtin_amdgcn_sched_barrier(0)
    Unit cur, nxt; int ui = 0;
    if (!S.next(0, cur)) return;
    f32x4 acc[2][2][4][2];
#pragma unroll
    for (int a = 0; a < 2; ++a)
#pragma unroll
        for (int b = 0; b < 2; ++b)
#pragma unroll
            for (int m = 0; m < 4; ++m)
#pragma unroll
                for (int n = 0; n < 2; ++n) acc[a][b][m][n] = (f32x4){0.f, 0.f, 0.f, 0.f};
    bf16x8 At[4][2], B0[2][2], B1[2][2];
    const char* cA = PG8_UA(cur); const char* cB = PG8_UB(cur);
    S.a_ready(cur);
    if constexpr (SP2) {
        PG8_STAGE(PG8_SB(0, 0), cB, voffB); PG8_STAGE(PG8_SB(0, 1), cB + hstepB, voffB); PG8_STAGE(PG8_SA(0, 0), cA, voffA); PG8_STAGE(PG8_SA(0, 1), cA + hstepA, voffA);
        if (wr == 1) PG8_BAR;
        PG8_WAIT_V(2); PG8_BAR;
        PG8_STAGE(PG8_SB(1, 0), cB + kstep, voffB); PG8_STAGE(PG8_SA(1, 0), cA + kstep, voffA); PG8_STAGE(PG8_SB(1, 1), cB + hstepB + kstep, voffB);
        PG8_WAIT_V(6); PG8_BAR;
    } else {
        PG8_STAGE(PG8_SB(0, 0), cB, voffB); PG8_STAGE(PG8_SA(0, 0), cA, voffA); PG8_STAGE(PG8_SB(0, 1), cB + hstepB, voffB); PG8_STAGE(PG8_SA(0, 1), cA + hstepA, voffA);
        if (wr == 1) PG8_BAR;
        PG8_WAIT_V(4); PG8_BAR;
        PG8_STAGE(PG8_SB(1, 0), cB + kstep, voffB); PG8_STAGE(PG8_SA(1, 0), cA + kstep, voffA); PG8_STAGE(PG8_SB(1, 1), cB + hstepB + kstep, voffB);
        PG8_WAIT_V(6); PG8_BAR;
    }
    for (;;) {
        const bool has_next = S.next(ui + 1, nxt);
        const char* nA = has_next ? PG8_UA(nxt) : cA; const char* nB = has_next ? PG8_UB(nxt) : cB;
        for (int t = 0; t < nt; t += 2) {
            const bool last = (t == nt - 2);
            const char* a1 = cA + (size_t)(t + 1) * kstep;
            const char* a2 = last ? nA : cA + (size_t)(t + 2) * kstep; const char* b2 = last ? nB : cB + (size_t)(t + 2) * kstep;
            const char* a3 = a2 + kstep; const char* b3 = b2 + kstep;
            if (last && has_next) S.a_ready(nxt);
            if constexpr (SP2) {
            PG8_LDB(B0, 0, 0); PG8_LDB(B1, 0, 1); PG8_SCHED; PG8_LDA(At, 0, 0); PG8_STAGE(PG8_SA(1, 1), a1 + hstepA, voffA);
            PG8_WAIT_V(8); PG8_WAIT_L(0); PG8_BAR; PG8_MMA(0, 0, At, B0); PG8_MMA(0, 1, At, B1); PG8_BAR; PG8_SCHED;
            PG8_LDA(At, 0, 1); PG8_STAGE(PG8_SB(0, 0), b2, voffB); PG8_STAGE(PG8_SB(0, 1), b2 + hstepB, voffB); PG8_STAGE(PG8_SA(0, 0), a2, voffA);
            PG8_WAIT_V(8); PG8_WAIT_L(0); PG8_BAR; PG8_MMA(1, 0, At, B0); PG8_MMA(1, 1, At, B1); PG8_BAR; PG8_SCHED;
            PG8_LDB(B0, 1, 0); PG8_LDB(B1, 1, 1); PG8_SCHED; PG8_LDA(At, 1, 0); PG8_STAGE(PG8_SA(0, 1), a2 + hstepA, voffA);
            PG8_WAIT_V(8); PG8_WAIT_L(0); PG8_BAR; PG8_MMA(0, 0, At, B0); PG8_MMA(0, 1, At, B1); PG8_BAR; PG8_SCHED;
            PG8_LDA(At, 1, 1); PG8_STAGE(PG8_SB(1, 0), b3, voffB); PG8_STAGE(PG8_SB(1, 1), b3 + hstepB, voffB); PG8_STAGE(PG8_SA(1, 0), a3, voffA);
            PG8_WAIT_V(8); PG8_WAIT_L(0); PG8_BAR; PG8_MMA(1, 0, At, B0); PG8_MMA(1, 1, At, B1); PG8_BAR; PG8_SCHED;
            } else {
            PG8_LDB(B0, 0, 0); PG8_SCHED; PG8_LDA(At, 0, 0); PG8_STAGE(PG8_SA(1, 1), a1 + hstepA, voffA);
            PG8_WAIT_L(8); PG8_BAR; PG8_WAIT_L(0); PG8_MMA(0, 0, At, B0); PG8_BAR; PG8_SCHED;
            PG8_LDB(B1, 0, 1); PG8_STAGE(PG8_SB(0, 0), b2, voffB);
            PG8_BAR; PG8_WAIT_L(0); PG8_MMA(0, 1, At, B1); PG8_BAR;
            PG8_LDA(At, 0, 1); PG8_STAGE(PG8_SA(0, 0), a2, voffA);
            PG8_BAR; PG8_WAIT_L(0); PG8_MMA(1, 0, At, B0); PG8_BAR; PG8_SCHED;
            PG8_STAGE(PG8_SB(0, 1), b2 + hstepB, voffB);
            PG8_WAIT_V(6); PG8_BAR; PG8_MMA(1, 1, At, B1); PG8_BAR;
            PG8_LDB(B0, 1, 0); PG8_SCHED; PG8_LDA(At, 1, 0); PG8_STAGE(PG8_SA(0, 1), a2 + hstepA, voffA);
            PG8_WAIT_L(8); PG8_BAR; PG8_WAIT_L(0); PG8_MMA(0, 0, At, B0); PG8_BAR; PG8_SCHED;
            PG8_LDB(B1, 1, 1); PG8_STAGE(PG8_SB(1, 0), b3, voffB);
            PG8_BAR; PG8_WAIT_L(0); PG8_MMA(0, 1, At, B1); PG8_BAR;
            PG8_LDA(At, 1, 1); PG8_STAGE(PG8_SA(1, 0), a3, voffA);
            PG8_BAR; PG8_WAIT_L(0); PG8_MMA(1, 0, At, B0); PG8_BAR; PG8_SCHED;
            PG8_STAGE(PG8_SB(1, 1), b3 + hstepB, voffB);
            PG8_WAIT_V(6); PG8_BAR; PG8_MMA(1, 1, At, B1); PG8_BAR;
            }
        }
        if constexpr (ALIGN_EPI) { if (wr == 0) PG8_BAR; }
        if constexpr (!Epi::AFTER_DRAIN) { E(acc, cur, wr, wc, fr, fq); S.done(cur); }
        if (!has_next) break;
#pragma unroll
        for (int a = 0; a < 2; ++a)
#pragma unroll
            for (int b = 0; b < 2; ++b)
#pragma unroll
                for (int m = 0; m < 4; ++m)
#pragma unroll
                    for (int n = 0; n < 2; ++n) acc[a][b][m][n] = (f32x4){0.f, 0.f, 0.f, 0.f};
        cur = nxt; cA = nA; cB = nB; ++ui;
        if constexpr (ALIGN_EPI) { if (wr == 1) PG8_BAR; }
    }
    PG8_WAIT_V(0);
    if constexpr (!ALIGN_EPI) { if (wr == 0) PG8_BAR; }
    PG8_BAR;
    if constexpr (Epi::AFTER_DRAIN) { E.fused(acc, cur, wr, wc, fr, fq, lds, wid, lane); S.done(cur); }
#undef PG8_UA
#undef PG8_UB
#undef PG8_SA
#undef PG8_SB
#undef PG8_STAGE
#undef PG8_LDA
#undef PG8_LDB
#undef PG8_MMA
#undef PG8_WAIT_V
#undef PG8_WAIT_L
#undef PG8_BAR
#undef PG8_SCHED
}
}

#ifndef PG8_SP2
#define PG8_SP2 true
#endif
#ifndef PG8_ALIGN
#define PG8_ALIGN true
#endif

typedef unsigned short bf16;
typedef unsigned v4u __attribute__((ext_vector_type(4)));
typedef unsigned v2u __attribute__((ext_vector_type(2)));
typedef float f32x4 __attribute__((ext_vector_type(4)));
#define LAS __attribute__((address_space(3)))

constexpr int NWAVES = 8, NTHR = 512;
constexpr int D = 1024, MC = 8192, ML = 4096, M = 12288, NPH = 23;
constexpr int LDS_BYTES = 147456;
constexpr float EPS = 1e-6f;
constexpr size_t MiB = 1u << 20;
constexpr size_t WS_MOD = 64 * 1024;
constexpr size_t WS_SSQ = 320 * 1024;
constexpr size_t WS_DT = 384 * 1024;
constexpr size_t WS_W = 2 * MiB;
constexpr size_t W_IN = WS_W, W_G = W_IN + 8 * MiB, W_GLU = W_G + 8 * MiB, W_BR = W_GLU + 1 * MiB, W_OUT = W_BR + 4 * MiB, W_1 = W_OUT + 2 * MiB, W_2 = W_1 + 8 * MiB;
constexpr size_t WS_H = 41 * MiB;
constexpr size_t WS_R1 = 65 * MiB;
constexpr size_t WS_Y = 161 * MiB;
constexpr size_t WS_Y5 = 209 * MiB;
constexpr size_t WS_XC = 221 * MiB;
constexpr size_t WS_S5K = 239 * MiB;
constexpr size_t WS_S5WS = 240 * MiB;
constexpr size_t WS_S5WO = 244 * MiB;
constexpr size_t WS_S5AT = 248 * MiB;
constexpr size_t WS_CKV = 251 * MiB;
constexpr size_t WS_ROPE = 1536 * 1024;
constexpr size_t WS_WDT = 1792 * 1024;
constexpr size_t WS_BI2 = 1824 * 1024;
constexpr size_t WS_SSQ2 = 1904 * 1024;
constexpr size_t WS_END = 254 * MiB;
#ifndef PROBE_SEL
#define PROBE_SEL -1
#endif
#ifndef PROBE_SCALE
#define PROBE_SCALE 4e-4f
#endif
#ifndef PROBE_PB
#define PROBE_PB 32
#endif
constexpr size_t WS_BAR = 32 * 1024;
constexpr size_t WS_QCTR = 48 * 1024;
constexpr size_t WS_TS = 16 * 1024;
constexpr size_t O_SSD = 12582912, O_S5 = 16777216, O_DK = 17301504, O_DV = 25690112, O_WK = 34078720, O_WV = 36175872;
constexpr int C_Z = 0, C_XBC = 512, C_U = 1280, C_DQ = 1792, C_DK = 2304, C_DV = 2816, C_WQ = 3328, C_WK = 3840, C_WV = 3968;

struct Args { const float* in[44]; float* out; unsigned char* ws; int ph_lo, ph_hi; };

typedef const Args __attribute__((address_space(4)))* CArgs;
struct Ctx {
    CArgs ap; int tid, lane, wave;
    __device__ __forceinline__ const float* x_prompt() const { return ap->in[0]; }
    __device__ __forceinline__ const float* x_sample() const { return ap->in[1]; }
    __device__ __forceinline__ const float* state_ssd() const { return ap->in[2]; }
    __device__ __forceinline__ const float* state_s5() const { return ap->in[3]; }
    __device__ __forceinline__ const float* cache_dk() const { return ap->in[4]; }
    __device__ __forceinline__ const float* cache_dv() const { return ap->in[5]; }
    __device__ __forceinline__ const float* cache_wk() const { return ap->in[6]; }
    __device__ __forceinline__ const float* cache_wv() const { return ap->in[7]; }
    __device__ __forceinline__ const float* cvec() const { return ap->in[8]; }
    __device__ __forceinline__ const float* c_ctx() const { return ap->in[9]; }
    __device__ __forceinline__ const float* w_mod() const { return ap->in[10]; }
    __device__ __forceinline__ const float* b_mod() const { return ap->in[11]; }
    __device__ __forceinline__ const float* g_norm1() const { return ap->in[12]; }
    __device__ __forceinline__ const float* g_norm2() const { return ap->in[13]; }
    __device__ __forceinline__ const float* w_in() const { return ap->in[14]; }
    __device__ __forceinline__ const float* conv_w() const { return ap->in[15]; }
    __device__ __forceinline__ const float* conv_b() const { return ap->in[16]; }
    __device__ __forceinline__ const float* dt_bias() const { return ap->in[17]; }
    __device__ __forceinline__ const float* a_log() const { return ap->in[18]; }
    __device__ __forceinline__ const float* ssd_d() const { return ap->in[19]; }
    __device__ __forceinline__ const float* ssd_norm_g() const { return ap->in[20]; }
    __device__ __forceinline__ const float* lam_re() const { return ap->in[21]; }
    __device__ __forceinline__ const float* lam_im() const { return ap->in[22]; }
    __device__ __forceinline__ const float* log_step() const { return ap->in[23]; }
    __device__ __forceinline__ const float* b_re() const { return ap->in[24]; }
    __device__ __forceinline__ const float* b_im() const { return ap->in[25]; }
    __device__ __forceinline__ const float* c_re() const { return ap->in[26]; }
    __device__ __forceinline__ const float* c_im() const { return ap->in[27]; }
    __device__ __forceinline__ const float* s5_d() const { return ap->in[28]; }
    __device__ __forceinline__ const float* w_glu() const { return ap->in[29]; }
    __device__ __forceinline__ const float* b_glu() const { return ap->in[30]; }
    __device__ __forceinline__ const float* qn_g() const { return ap->in[31]; }
    __device__ __forceinline__ const float* kn_g() const { return ap->in[32]; }
    __device__ __forceinline__ const float* dlam() const { return ap->in[33]; }
    __device__ __forceinline__ const float* subln_g() const { return ap->in[34]; }
    __device__ __forceinline__ const float* wqn_g() const { return ap->in[35]; }
    __device__ __forceinline__ const float* wkn_g() const { return ap->in[36]; }
    __device__ __forceinline__ const float* sink() const { return ap->in[37]; }
    __device__ __forceinline__ const float* w_branch() const { return ap->in[38]; }
    __device__ __forceinline__ const float* w_gate() const { return ap->in[39]; }
    __device__ __forceinline__ const float* b_gate() const { return ap->in[40]; }
    __device__ __forceinline__ const float* w_out() const { return ap->in[41]; }
    __device__ __forceinline__ const float* w_fc1() const { return ap->in[42]; }
    __device__ __forceinline__ const float* w_fc2() const { return ap->in[43]; }
    __device__ __forceinline__ float* out() const { return ap->out; }
    __device__ __forceinline__ unsigned char* ws() const { return ap->ws; }
    __device__ __forceinline__ float* MOD() const { return (float*)(ap->ws + WS_MOD); }
    __device__ __forceinline__ float* SSQ() const { return (float*)(ap->ws + WS_SSQ); }
    __device__ __forceinline__ float* DT() const { return (float*)(ap->ws + WS_DT); }
    __device__ __forceinline__ bf16* H() const { return (bf16*)(ap->ws + WS_H); }
    __device__ __forceinline__ bf16* R1() const { return (bf16*)(ap->ws + WS_R1); }
    __device__ __forceinline__ bf16* Y() const { return (bf16*)(ap->ws + WS_Y); }
    __device__ __forceinline__ bf16* Y5() const { return (bf16*)(ap->ws + WS_Y5); }
    __device__ __forceinline__ bf16* XC() const { return (bf16*)(ap->ws + WS_XC); }
    __device__ __forceinline__ bf16* CKV() const { return (bf16*)(ap->ws + WS_CKV); }
    __device__ __forceinline__ float* ROPE() const { return (float*)(ap->ws + WS_ROPE); }
};

__device__ __forceinline__ float wave_sum(float v) {
#pragma unroll
    for (int o = 1; o < 64; o <<= 1) v += __shfl_xor(v, o);
    return v;
}
__device__ __forceinline__ float wave_max(float v) {
#pragma unroll
    for (int o = 1; o < 64; o <<= 1) v = fmaxf(v, __shfl_xor(v, o));
    return v;
}
__device__ __forceinline__ float bf2f(bf16 h) { return __builtin_bit_cast(float, (unsigned)h << 16); }
__device__ __forceinline__ float bflo(unsigned w) { return __builtin_bit_cast(float, w << 16); }
__device__ __forceinline__ float bfhi(unsigned w) { return __builtin_bit_cast(float, w & 0xffff0000u); }
__device__ __forceinline__ unsigned f2bf(float f) { unsigned u = __builtin_bit_cast(unsigned, f); return (u + 0x7fffu + ((u >> 16) & 1u)) >> 16; }
__device__ __forceinline__ unsigned pk2(float lo, float hi) { return f2bf(lo) | (f2bf(hi) << 16); }
__device__ __forceinline__ float siluf(float x) { return x / (1.0f + __expf(-x)); }
__device__ __forceinline__ void unpack8(const v4u q, float (&f)[8]) { f[0] = bflo(q.x); f[1] = bfhi(q.x); f[2] = bflo(q.y); f[3] = bfhi(q.y); f[4] = bflo(q.z); f[5] = bfhi(q.z); f[6] = bflo(q.w); f[7] = bfhi(q.w); }

__device__ __forceinline__ void phase_mods(const Ctx& c, float* lf) {
    for (int i = c.tid; i < 5 * 1024; i += NTHR) { const int v = i >> 10, k = i & 1023; const float x = (v == 0) ? c.c_ctx()[k] : c.cvec()[(v - 1) * 1024 + k]; lf[i] = siluf(x); }
    __syncthreads();
    float* red = lf + 5 * 1024;
    for (int u = blockIdx.x; u < 192; u += gridDim.x) {
        const int l = u / 96, col0 = (u % 96) * 64;
        const float* W = c.w_mod() + (size_t)l * 1024 * 6144 + col0 + c.lane;
        float acc[5] = {0.f, 0.f, 0.f, 0.f, 0.f};
#pragma unroll 8
        for (int k = c.wave * 128; k < c.wave * 128 + 128; ++k) { const float wv = W[(size_t)k * 6144];
#pragma unroll
            for (int i = 0; i < 5; ++i) acc[i] += lf[i * 1024 + k] * wv; }
#pragma unroll
        for (int i = 0; i < 5; ++i) red[(c.wave * 5 + i) * 64 + c.lane] = acc[i];
        __syncthreads();
        if (c.tid < 320) { const int i = c.tid >> 6, ln = c.tid & 63; float s = c.b_mod()[l * 6144 + col0 + ln];
#pragma unroll
            for (int w = 0; w < 8; ++w) s += red[(w * 5 + i) * 64 + ln];
            c.MOD()[(size_t)(l * 5 + i) * 6144 + col0 + ln] = s; }
        __syncthreads();
    }
}

__device__ __forceinline__ int cmap(int mode, int n) { return mode == 0 ? n : (mode == 1 ? (n < 1280 ? n : n + 16) : ((n & 255) < 128 ? 128 * (n >> 8) + (n & 127) : 512 + 128 * (n >> 8) + (n & 127))); }
__device__ __forceinline__ void transpose_item(const float* W, int ld, int K, int N, int mode, const float* rowscale, bf16* WT, float* scr, int item, int lane) {
    const int nblk = N / 32, kb = item / nblk, nb = item % nblk, k0 = 64 * kb, n0 = 32 * nb, sc0 = cmap(mode, n0);
    float tv[32];
#pragma unroll
    for (int i = 0; i < 32; ++i) tv[i] = W[(size_t)(k0 + 2 * i + (lane >> 5)) * ld + sc0 + (lane & 31)];
    if (rowscale) {
#pragma unroll
        for (int i = 0; i < 32; ++i) tv[i] *= rowscale[k0 + 2 * i + (lane >> 5)]; }
#pragma unroll
    for (int i = 0; i < 32; ++i) scr[(2 * i + (lane >> 5)) * 33 + (lane & 31)] = tv[i];
    __builtin_amdgcn_fence(__ATOMIC_RELEASE, "wavefront"); __builtin_amdgcn_wave_barrier();
    const int ch = lane & 7;
#pragma unroll
    for (int j = 0; j < 4; ++j) { const int n = (lane >> 3) + 8 * j; const float* s = scr + (8 * ch) * 33 + n;
        v4u o; o.x = pk2(s[0 * 33], s[1 * 33]); o.y = pk2(s[2 * 33], s[3 * 33]); o.z = pk2(s[4 * 33], s[5 * 33]); o.w = pk2(s[6 * 33], s[7 * 33]);
        *(v4u*)(WT + (size_t)(n0 + n) * K + k0 + 8 * ch) = o; }
    __builtin_amdgcn_fence(__ATOMIC_RELEASE, "wavefront"); __builtin_amdgcn_wave_barrier();
}
__device__ __forceinline__ void s5_tables(const Ctx& c, int l, int g, int part, float* lf);
__device__ __forceinline__ void convert_items(const Ctx& c, int l, int lo, int hi, int gw0, int ngw, bool tabs, int tb0, int ntb, float* lf) {
    unsigned char* ws = c.ws();
    if (tabs) {
        for (int t = tb0; t < 128; t += ntb) s5_tables(c, l, t & 31, t >> 5, lf);
        for (int i = tb0 * NTHR + c.tid; i < 16384; i += ntb * NTHR) { const int j = i >> 10, k = i & 1023; ((bf16*)(ws + WS_WDT))[i] = (bf16)f2bf(c.w_in()[(size_t)l * 1024 * 4112 + (size_t)k * 4112 + 1280 + j]); }
    }
    float* scr = lf + c.wave * 2176;
    for (int it = lo + gw0; it < hi; it += ngw) {
        int r = it;
        if (r < 2048) { transpose_item(c.w_in() + (size_t)l * 1024 * 4112, 4112, 1024, 4096, 1, nullptr, (bf16*)(ws + W_IN), scr, r, c.lane); continue; } r -= 2048;
        if (r < 2048) { transpose_item(c.w_gate() + (size_t)l * 1024 * 4096, 4096, 1024, 4096, 0, nullptr, (bf16*)(ws + W_G), scr, r, c.lane); continue; } r -= 2048;
        if (r < 256) { transpose_item(c.w_glu() + (size_t)l * 512 * 1024, 1024, 512, 1024, 2, nullptr, (bf16*)(ws + W_GLU), scr, r, c.lane); continue; } r -= 256;
        if (r < 1024) { const int i = r >> 8; transpose_item(c.w_branch() + (size_t)(l * 4 + i) * 512 * 1024, 1024, 512, 1024, 0, i == 0 ? c.ssd_norm_g() + l * 512 : nullptr, (bf16*)(ws + W_BR) + (size_t)i * 1024 * 512, scr, r & 255, c.lane); continue; } r -= 1024;
        if (r < 512) { transpose_item(c.w_out() + (size_t)l * 1024 * 1024, 1024, 1024, 1024, 0, nullptr, (bf16*)(ws + W_OUT), scr, r, c.lane); continue; } r -= 512;
        if (r < 2048) { transpose_item(c.w_fc1() + (size_t)l * 1024 * 4096, 4096, 1024, 4096, 0, nullptr, (bf16*)(ws + W_1), scr, r, c.lane); continue; } r -= 2048;
        transpose_item(c.w_fc2() + (size_t)l * 4096 * 1024, 1024, 4096, 1024, 0, nullptr, (bf16*)(ws + W_2), scr, r, c.lane);
    }
}
__device__ __forceinline__ void phase_convert(const Ctx& c, int l, float* lf) {
    convert_items(c, l, 0, 9984, blockIdx.x * NWAVES + c.wave, gridDim.x * NWAVES, true, blockIdx.x, gridDim.x, lf);
}
__device__ __forceinline__ void side_convert(const Ctx& c, int lo, int hi, bool tabs, float* lf) {
    if (blockIdx.x < 192 || gridDim.x != 256) return;
    convert_items(c, 1, lo, hi, (blockIdx.x - 192) * NWAVES + c.wave, 64 * NWAVES, tabs, blockIdx.x - 192, 64, lf);
}

__device__ __forceinline__ void phase_norm(const Ctx& c, int l, int which, float* lf) {
    const int gw = blockIdx.x * NWAVES + c.wave, NGW = gridDim.x * NWAVES;
    const float* gn = (which == 0 ? c.g_norm1() : c.g_norm2()) + l * 1024;
    for (int m = gw; m < M; m += NGW) {
        const float* xr = (l == 0 && which == 0) ? (m < MC ? c.x_prompt() + (size_t)m * D : c.x_sample() + (size_t)(m - MC) * D) : c.out() + (size_t)m * D;
        const int mi = (m < MC) ? 0 : 1 + ((m - MC) >> 10);
        const float* mod = c.MOD() + (size_t)(l * 5 + mi) * 6144 + which * 3072;
        f32x4 v[4]; float s = 0.f;
#pragma unroll
        for (int j = 0; j < 4; ++j) { v[j] = *(const f32x4*)(xr + 4 * c.lane + 256 * j); s += (v[j].x * v[j].x + v[j].y * v[j].y) + (v[j].z * v[j].z + v[j].w * v[j].w); }
        const float rstd = rsqrtf(wave_sum(s) * (1.0f / D) + EPS);
#pragma unroll
        for (int j = 0; j < 4; ++j) { const int k = 4 * c.lane + 256 * j; const f32x4 g = *(const f32x4*)(gn + k), sh = *(const f32x4*)(mod + k), sc = *(const f32x4*)(mod + 1024 + k);
            v[j] = v[j] * rstd * g * (sc + 1.0f) + sh;
            v2u o; o.x = pk2(v[j].x, v[j].y); o.y = pk2(v[j].z, v[j].w); *(v2u*)(c.H() + (size_t)m * D + k) = o; }
        if (which == 0) {
            if (c.lane == 0) { c.SSQ()[m] = 0.f; ((float*)(c.ws() + WS_SSQ2))[m] = 0.f; }
        }
    }
}

__device__ __forceinline__ void phase_bias2(const Ctx& c, int l) {
    const int gw = blockIdx.x * NWAVES + c.wave, NGW = gridDim.x * NWAVES, lane = c.lane;
    const bf16* W1t = (const bf16*)(c.ws() + W_1); float* bi = (float*)(c.ws() + WS_BI2);
    for (int n = gw; n < 4096; n += NGW) {
        float wf[16]; { float t8[8]; unpack8(*(const v4u*)(W1t + (size_t)n * 1024 + 8 * lane), t8);
#pragma unroll
            for (int j = 0; j < 8; ++j) wf[j] = t8[j];
            unpack8(*(const v4u*)(W1t + (size_t)n * 1024 + 512 + 8 * lane), t8);
#pragma unroll
            for (int j = 0; j < 8; ++j) wf[8 + j] = t8[j]; }
#pragma unroll 1
        for (int mi = 0; mi < 5; ++mi) { const float* sh = c.MOD() + (size_t)(l * 5 + mi) * 6144 + 3072; float a = 0.f;
#pragma unroll
            for (int hh = 0; hh < 2; ++hh) { const f32x4 s0 = *(const f32x4*)(sh + 512 * hh + 8 * lane), s1 = *(const f32x4*)(sh + 512 * hh + 8 * lane + 4);
                a += (wf[8 * hh + 0] * s0.x + wf[8 * hh + 1] * s0.y) + (wf[8 * hh + 2] * s0.z + wf[8 * hh + 3] * s0.w) + (wf[8 * hh + 4] * s1.x + wf[8 * hh + 5] * s1.y) + (wf[8 * hh + 6] * s1.z + wf[8 * hh + 7] * s1.w); }
            a = wave_sum(a); if (lane == 0) bi[mi * 4096 + n] = a; }
    }
}

__device__ __forceinline__ void phase_dt(const Ctx& c, int l) {
    if (c.wave >= 3) return;
    const int tile = blockIdx.x * 3 + c.wave; if (tile >= 768) return;
    const int lr = c.lane & 15, lq = c.lane >> 4;
    const bf16* ap = c.H() + (size_t)(16 * tile + lr) * 1024 + 8 * lq; const bf16* bp = (const bf16*)(c.ws() + WS_WDT) + (size_t)lr * 1024 + 8 * lq;
    f32x4 acc = {0.f, 0.f, 0.f, 0.f};
#pragma unroll 8
    for (int ks = 0; ks < 32; ++ks) acc = __builtin_amdgcn_mfma_f32_16x16x32_bf16(*(const pg8::bf16x8*)(ap + 32 * ks), *(const pg8::bf16x8*)(bp + 32 * ks), acc, 0, 0, 0);
    const float bias = c.dt_bias()[l * 16 + lr];
#pragma unroll
    for (int r = 0; r < 4; ++r) { const float x = acc[r] + bias; c.DT()[(size_t)(16 * tile + 4 * lq + r) * 16 + lr] = x > 20.f ? x : log1pf(__expf(x)); }
}

__device__ __forceinline__ void phase_rope_table(const Ctx& c) {
    const int gt = blockIdx.x * NTHR + c.tid;
    if (gt < 32768) { const int pos = gt >> 5, a = gt & 31, f = a & 15; const float inv = exp2f(-(float)f * 0.8304820237218406f);
        const float ang = (float)((a >> 4) ? (pos & 63) : (pos >> 6)) * inv; float sn, cs; sincosf(ang, &sn, &cs); c.ROPE()[pos * 64 + a] = cs; c.ROPE()[pos * 64 + 32 + a] = sn; }
}
__device__ __forceinline__ void phase_qk(const Ctx& c, int l, float* lf) {
    const int gw = blockIdx.x * NWAVES + c.wave, NGW = gridDim.x * NWAVES, lane = c.lane, l16 = lane & 15, grp = lane >> 4;
    for (int i = c.tid; i < 7 * 768; i += NTHR) lf[i] = c.conv_w()[(size_t)l * 7 * 768 + i];
    for (int i = c.tid; i < 768; i += NTHR) lf[7 * 768 + i] = c.conv_b()[l * 768 + i];
    __syncthreads();
    const f32x4 gq = *(const f32x4*)(c.qn_g() + l * 64 + 4 * l16), gk = *(const f32x4*)(c.kn_g() + l * 64 + 4 * l16), gwq = *(const f32x4*)(c.wqn_g() + l * 64 + 4 * l16), gwk = *(const f32x4*)(c.wkn_g() + l * 64 + 4 * l16);
    bf16* R1p = c.R1(); float* outp = c.out(); bf16* XCp = c.XC();
    for (int m = gw; m < M; m += NGW) {
        bf16* pr = R1p + (size_t)m * 4096;
        const bool lat = m >= MC;
        const int b = lat ? (m - MC) >> 10 : m >> 8, t = lat ? (m - MC) & 1023 : m & 255, L = lat ? 1024 : 256;
        const size_t ob = (size_t)(b * 2 + l) * 256 + t;
        f32x4 cs = {1.f, 1.f, 1.f, 1.f}, sn = {0.f, 0.f, 0.f, 0.f};
        if (lat) { const float* rp = c.ROPE() + t * 64 + (l16 >> 3) * 16 + 4 * (l16 & 3); cs = *(const f32x4*)rp; sn = *(const f32x4*)(rp + 32); if (!((l16 >> 2) & 1)) sn = -sn; }
        v2u raw[7];
#pragma unroll
        for (int ps = 0; ps < 7; ++ps) { const int gi = 4 * ps + grp; const int col = gi < 8 ? C_DQ + gi * 64 : gi < 16 ? C_DK + (gi - 8) * 64 : gi < 24 ? C_WQ + (gi - 16) * 64 : C_WK + (gi - 24) * 64;
            raw[ps] = (gi < 26) ? *(const v2u*)(pr + col + 4 * l16) : (v2u){0u, 0u}; }
        v2u cp[3];
        if (!lat) {
#pragma unroll
            for (int ps = 0; ps < 3; ++ps) { const int gi = 4 * ps + grp; const int col = gi < 8 ? C_DV + gi * 64 : C_WV + (gi - 8) * 64; cp[ps] = (gi < 10) ? *(const v2u*)(pr + col + 4 * l16) : (v2u){0u, 0u}; }
        }
        v2u cx[3][7];
#pragma unroll
        for (int i = 0; i < 3; ++i)
#pragma unroll
            for (int j = 0; j < 7; ++j) { const int tt = t + j - 3; cx[i][j] = (tt >= 0 && tt < L) ? *(const v2u*)(R1p + (size_t)(m + j - 3) * 4096 + C_XBC + 4 * lane + 256 * i) : (v2u){0u, 0u}; }
#pragma unroll
        for (int ps = 0; ps < 7; ++ps) { const int gi = 4 * ps + grp;
            const f32x4 gain = gi < 8 ? gq : gi < 16 ? gk : gi < 24 ? gwq : gwk;
            f32x4 v = {bflo(raw[ps].x), bfhi(raw[ps].x), bflo(raw[ps].y), bfhi(raw[ps].y)};
            float ss = (v.x * v.x + v.y * v.y) + (v.z * v.z + v.w * v.w);
            ss += __shfl_xor(ss, 1); ss += __shfl_xor(ss, 2); ss += __shfl_xor(ss, 4); ss += __shfl_xor(ss, 8);
            v = v * rsqrtf(ss * (1.0f / 64.0f) + EPS) * gain;
            if (lat) { f32x4 p; p.x = __shfl_xor(v.x, 4); p.y = __shfl_xor(v.y, 4); p.z = __shfl_xor(v.z, 4); p.w = __shfl_xor(v.w, 4); v = v * cs + p * sn; }
            if (gi < 26) {
                const int col = gi < 8 ? C_DQ + gi * 64 : gi < 16 ? C_DK + (gi - 8) * 64 : gi < 24 ? C_WQ + (gi - 16) * 64 : C_WK + (gi - 24) * 64;
                v2u o; o.x = pk2(v.x, v.y); o.y = pk2(v.z, v.w); *(v2u*)(pr + col + 4 * l16) = o;
                if (!lat) { if (gi >= 8 && gi < 16) *(f32x4*)(outp + O_DK + ob * 512 + (gi - 8) * 64 + 4 * l16) = v; if (gi >= 24) *(f32x4*)(outp + O_WK + ob * 128 + (gi - 24) * 64 + 4 * l16) = v; }
            }
        }
        if (!lat) {
#pragma unroll
            for (int ps = 0; ps < 3; ++ps) { const int gi = 4 * ps + grp; const f32x4 v = {bflo(cp[ps].x), bfhi(cp[ps].x), bflo(cp[ps].y), bfhi(cp[ps].y)};
                if (gi < 8) *(f32x4*)(outp + O_DV + ob * 512 + gi * 64 + 4 * l16) = v; else if (gi < 10) *(f32x4*)(outp + O_WV + ob * 128 + (gi - 8) * 64 + 4 * l16) = v; }
        }
#pragma unroll
        for (int i = 0; i < 3; ++i) { const int ch = 4 * lane + 256 * i; f32x4 a = *(const f32x4*)(lf + 7 * 768 + ch);
#pragma unroll
            for (int j = 0; j < 7; ++j) { const f32x4 wv = *(const f32x4*)(lf + j * 768 + ch); const f32x4 xv = {bflo(cx[i][j].x), bfhi(cx[i][j].x), bflo(cx[i][j].y), bfhi(cx[i][j].y)}; a += wv * xv; }
            v2u o; o.x = pk2(siluf(a.x), siluf(a.y)); o.y = pk2(siluf(a.z), siluf(a.w)); *(v2u*)(XCp + (size_t)m * 768 + ch) = o; }
    }
    for (int r = gw; r < 1024; r += NGW) { const int b = r >> 8, sidx = r & 255; const size_t cb = (size_t)(b * 2 + l) * 256 + sidx; bf16* dst = c.CKV() + (size_t)r * 1280;
        for (int i = lane; i < 1280; i += 64) { const float v = i < 512 ? c.cache_dk()[cb * 512 + i] : i < 1024 ? c.cache_dv()[cb * 512 + i - 512] : i < 1152 ? c.cache_wk()[cb * 128 + i - 1024] : c.cache_wv()[cb * 128 + i - 1152]; dst[i] = (bf16)f2bf(v); } }
}

typedef pg8::bf16x8 bx8;
#define LDS_BARRIER() do { asm volatile("s_waitcnt lgkmcnt(0)" ::: "memory"); __builtin_amdgcn_s_barrier(); asm volatile("" ::: "memory"); } while (0)
#define MFMA16(a, b, cc) __builtin_amdgcn_mfma_f32_16x16x32_bf16((a), (b), (cc), 0, 0, 0)
__device__ __forceinline__ void ssd_unit(const Ctx& c, int l, int pass, int b, int h, unsigned char* lds) {
    const int L = pass ? 1024 : 256, tok0 = pass ? MC + b * 1024 : b * 256, NCH = L >> 7;
    const int tid = c.tid, lane = c.lane, w = c.wave, lr = lane & 15, lq = lane >> 4, grp = h >> 2;
    bf16* XT = (bf16*)lds;
    bf16* BwT = XT + 64 * 136;
    bf16* Bm = BwT + 64 * 136;
    bf16* Cm = Bm + 128 * 72;
    bf16* Mm = Cm + 128 * 72;
    bf16* ST = Mm + 128 * 136;
    float* cum = (float*)(ST + 64 * 72);
    float* dtv = cum + 128; float* wv = dtv + 128; float* ecum = wv + 128; float* tot = ecum + 128;
    const float dsk = c.ssd_d()[l * 8 + h];
    const bf16* XCp = c.XC(); const float* DTp = c.DT(); bf16* Yp = c.Y(); const bf16* R1p = c.R1(); float* SSQp = c.SSQ();
    const int pi = w >> 1, nj0 = 2 * (w & 1);
    const int i = tid >> 2, part = tid & 3;
    for (int dir = 0; dir < 2; ++dir) {
        const float A = -__expf(c.a_log()[(l * 2 + dir) * 8 + h]);
        f32x4 Sacc[2];
        __syncthreads();
#pragma unroll
        for (int q = 0; q < 2; ++q)
#pragma unroll
            for (int r = 0; r < 4; ++r) { const int p = 16 * pi + 4 * lq + r, n = 16 * (nj0 + q) + lr;
                const float v = pass ? c.state_ssd()[(((((size_t)(b * 2 + l) * 2 + dir) * 8 + h) * 64 + p) * 64) + n] : 0.f;
                Sacc[q][r] = v; ST[p * 72 + n] = (bf16)f2bf(v); }
        v4u x0, x1, b0, b1, c0, c1; float d0 = 0.f, d1 = 0.f;
#define SSD_LOAD(ci_) { const int t_ = dir ? L - 1 - ((ci_) * 128 + i) : (ci_) * 128 + i; const bf16* xr_ = XCp + (size_t)(tok0 + t_) * 768; \
            x0 = *(const v4u*)(xr_ + h * 64 + part * 16); x1 = *(const v4u*)(xr_ + h * 64 + part * 16 + 8); \
            b0 = *(const v4u*)(xr_ + 512 + grp * 64 + part * 16); b1 = *(const v4u*)(xr_ + 512 + grp * 64 + part * 16 + 8); \
            c0 = *(const v4u*)(xr_ + 640 + grp * 64 + part * 16); c1 = *(const v4u*)(xr_ + 640 + grp * 64 + part * 16 + 8); \
            if (tid < 64) { const int i0_ = 2 * lane, ta_ = dir ? L - 1 - ((ci_) * 128 + i0_) : (ci_) * 128 + i0_, tb_ = dir ? ta_ - 1 : ta_ + 1; \
                d0 = DTp[(size_t)(tok0 + ta_) * 16 + dir * 8 + h]; d1 = DTp[(size_t)(tok0 + tb_) * 16 + dir * 8 + h]; } }
        SSD_LOAD(0);
        for (int ci = 0; ci < NCH; ++ci) {
            LDS_BARRIER();
            float bvals[16];
            { *(v4u*)(Bm + i * 72 + part * 16) = b0; *(v4u*)(Bm + i * 72 + part * 16 + 8) = b1;
              *(v4u*)(Cm + i * 72 + part * 16) = c0; *(v4u*)(Cm + i * 72 + part * 16 + 8) = c1;
              const unsigned xs[8] = {x0.x, x0.y, x0.z, x0.w, x1.x, x1.y, x1.z, x1.w};
#pragma unroll
              for (int j = 0; j < 8; ++j) { XT[(part * 16 + 2 * j) * 136 + i] = (bf16)(xs[j] & 0xffffu); XT[(part * 16 + 2 * j + 1) * 136 + i] = (bf16)(xs[j] >> 16); }
              float t8[8]; unpack8(b0, t8);
#pragma unroll
              for (int j = 0; j < 8; ++j) bvals[j] = t8[j];
              unpack8(b1, t8);
#pragma unroll
              for (int j = 0; j < 8; ++j) bvals[8 + j] = t8[j]; }
            if (tid < 64) {
                const int i0 = 2 * lane, i1 = i0 + 1;
                const float a0 = d0 * A, a1 = d1 * A; float s = a0 + a1;
#pragma unroll
                for (int o = 1; o < 64; o <<= 1) { const float v = __shfl_up(s, o); if (lane >= o) s += v; }
                const float cum1 = s, cum0 = s - a1, total = __shfl(s, 63);
                cum[i0] = cum0; cum[i1] = cum1; dtv[i0] = d0; dtv[i1] = d1;
                wv[i0] = __expf(total - cum0) * d0; wv[i1] = __expf(total - cum1) * d1; ecum[i0] = __expf(cum0); ecum[i1] = __expf(cum1);
                if (lane == 0) tot[0] = __expf(total);
            }
            if (ci + 1 < NCH) SSD_LOAD(ci + 1);
            unsigned short zz[16], yy[16];
            if (dir == 1) {
#pragma unroll
                for (int r = 0; r < 4; ++r) { const int tt = 16 * w + 4 * lq + r; const size_t m = (size_t)tok0 + (L - 1 - (ci * 128 + tt));
#pragma unroll
                    for (int jp = 0; jp < 4; ++jp) { zz[4 * r + jp] = R1p[m * 4096 + C_Z + h * 64 + 16 * jp + lr]; yy[4 * r + jp] = Yp[m * 2048 + h * 64 + 16 * jp + lr]; } }
            }
            LDS_BARRIER();
            { const float wi = wv[i];
#pragma unroll
              for (int j = 0; j < 16; ++j) BwT[(part * 16 + j) * 136 + i] = (bf16)f2bf(bvals[j] * wi); }
            bx8 cfr[2];
#pragma unroll
            for (int ks = 0; ks < 2; ++ks) cfr[ks] = *(const bx8*)(Cm + (16 * w + lr) * 72 + 32 * ks + 8 * lq);
            for (int j = 0; j <= w; ++j) {
                const bx8 bb0 = *(const bx8*)(Bm + (16 * j + lr) * 72 + 8 * lq), bb1 = *(const bx8*)(Bm + (16 * j + lr) * 72 + 32 + 8 * lq);
                f32x4 g = {0.f, 0.f, 0.f, 0.f};
                g = MFMA16(cfr[0], bb0, g); g = MFMA16(cfr[1], bb1, g);
                const int s = 16 * j + lr; const float cs = cum[s], ds = dtv[s];
#pragma unroll
                for (int r = 0; r < 4; ++r) { const int tt = 16 * w + 4 * lq + r; const float v = (s <= tt) ? g[r] * __expf(cum[tt] - cs) * ds : 0.f; Mm[tt * 136 + s] = (bf16)f2bf(v); }
            }
            if (!(w & 1)) {
#pragma unroll
                for (int r = 0; r < 4; ++r) Mm[(16 * w + 4 * lq + r) * 136 + 16 * (w + 1) + lr] = 0;
            }
            LDS_BARRIER();
            f32x4 yl[4], yo[4];
#pragma unroll
            for (int jp = 0; jp < 4; ++jp) { yl[jp] = (f32x4){0.f, 0.f, 0.f, 0.f}; yo[jp] = (f32x4){0.f, 0.f, 0.f, 0.f}; }
            for (int ks = 0; ks <= (w >> 1); ++ks) {
                const bx8 af = *(const bx8*)(Mm + (16 * w + lr) * 136 + 32 * ks + 8 * lq);
#pragma unroll
                for (int jp = 0; jp < 4; ++jp) { const bx8 xf = *(const bx8*)(XT + (16 * jp + lr) * 136 + 32 * ks + 8 * lq); yl[jp] = MFMA16(af, xf, yl[jp]); }
            }
#pragma unroll
            for (int ks = 0; ks < 2; ++ks)
#pragma unroll
                for (int jp = 0; jp < 4; ++jp) { const bx8 sf = *(const bx8*)(ST + (16 * jp + lr) * 72 + 32 * ks + 8 * lq); yo[jp] = MFMA16(cfr[ks], sf, yo[jp]); }
            {
#pragma unroll
                for (int r = 0; r < 4; ++r) {
                    const int tt = 16 * w + 4 * lq + r; const float ec = ecum[tt];
                    const int t = dir ? L - 1 - (ci * 128 + tt) : ci * 128 + tt; const size_t m = (size_t)tok0 + t;
                    float q = 0.f;
#pragma unroll
                    for (int jp = 0; jp < 4; ++jp) {
                        const int p = 16 * jp + lr; const float y = yl[jp][r] + ec * yo[jp][r];
                        if (dir == 0) Yp[m * 2048 + h * 64 + p] = (bf16)f2bf(y);
                        else { const float x = bf2f(XT[p * 136 + tt]); const float ytot = y + bf2f(yy[4 * r + jp]) + dsk * x; const float z = bf2f(zz[4 * r + jp]);
                            const float gt = ytot * siluf(z); Yp[m * 2048 + h * 64 + p] = (bf16)f2bf(gt); q += gt * gt; }
                    }
                    if (dir == 1) { q += __shfl_xor(q, 1); q += __shfl_xor(q, 2); q += __shfl_xor(q, 4); q += __shfl_xor(q, 8); if (lr == 0) atomicAdd(SSQp + m, q); }
                }
            }
            LDS_BARRIER();
            {
                f32x4 st[2] = {{0.f, 0.f, 0.f, 0.f}, {0.f, 0.f, 0.f, 0.f}};
#pragma unroll
                for (int ks = 0; ks < 4; ++ks) { const bx8 af = *(const bx8*)(XT + (16 * pi + lr) * 136 + 32 * ks + 8 * lq);
#pragma unroll
                    for (int q = 0; q < 2; ++q) { const bx8 bf = *(const bx8*)(BwT + (16 * (nj0 + q) + lr) * 136 + 32 * ks + 8 * lq); st[q] = MFMA16(af, bf, st[q]); } }
                const float et = tot[0];
#pragma unroll
                for (int q = 0; q < 2; ++q)
#pragma unroll
                    for (int r = 0; r < 4; ++r) { Sacc[q][r] = et * Sacc[q][r] + st[q][r]; ST[(16 * pi + 4 * lq + r) * 72 + 16 * (nj0 + q) + lr] = (bf16)f2bf(Sacc[q][r]); }
            }
        }
#undef SSD_LOAD
        if (!pass) {
#pragma unroll
            for (int q = 0; q < 2; ++q)
#pragma unroll
                for (int r = 0; r < 4; ++r) { const int p = 16 * pi + 4 * lq + r, n = 16 * (nj0 + q) + lr;
                    c.out()[O_SSD + (((((size_t)(b * 2 + l) * 2 + dir) * 8 + h) * 64 + p) * 64) + n] = Sacc[q][r]; }
        }
    }
}

__device__ __forceinline__ void s5_tables(const Ctx& c, int l, int g, int part, float* lf) {
    const int tid = c.tid;
    float* pw = lf;
    float* Bc = pw + 2 * 17 * 128;
    float* Cc = Bc + 2 * 2048;
    if (tid < 128) { const int dir = tid >> 6, n = tid & 63, idx = ((l * 2 + dir) * 32 + g) * 64 + n;
        const float lre = c.lam_re()[idx], lim = c.lam_im()[idx], step = expf(c.log_step()[(l * 2 + dir) * 32 + g]);
        for (int k = 0; k <= 16; ++k) { const float mag = expf(lre * step * (float)k); float sn, cs; sincosf(lim * step * (float)k, &sn, &cs); pw[((dir * 17 + k) * 64 + n) * 2] = mag * cs; pw[((dir * 17 + k) * 64 + n) * 2 + 1] = mag * sn; }
        const float mag = expf(lre * step); float sn, cs; sincosf(lim * step, &sn, &cs); const float are = mag * cs, aim = mag * sn;
        const float den = lre * lre + lim * lim, cre = ((are - 1.0f) * lre + aim * lim) / den, cim = (aim * lre - (are - 1.0f) * lim) / den;
        for (int mm = 0; mm < 16; ++mm) { const float br = c.b_re()[(size_t)idx * 16 + mm], bi = c.b_im()[(size_t)idx * 16 + mm]; Bc[((dir * 64 + n) * 16 + mm) * 2] = cre * br - cim * bi; Bc[((dir * 64 + n) * 16 + mm) * 2 + 1] = cre * bi + cim * br; }
    }
    for (int i = tid; i < 2048; i += NTHR) { const int dir = i >> 10, mm = (i >> 6) & 15, n = i & 63; const size_t src = ((size_t)((l * 2 + dir) * 32 + g) * 16 + mm) * 64 + n;
        Cc[i * 2] = c.c_re()[src]; Cc[i * 2 + 1] = c.c_im()[src]; }
    __syncthreads();
    if (part == 0 && tid < 128) { const int dir = tid >> 6, n = tid & 63; float* at = (float*)(c.ws() + WS_S5AT) + ((size_t)(dir * 32 + g) * 64 + n) * 2; at[0] = pw[((dir * 17 + 16) * 64 + n) * 2]; at[1] = pw[((dir * 17 + 16) * 64 + n) * 2 + 1]; }
    bf16* Kt = (bf16*)(c.ws() + WS_S5K) + (size_t)g * 31 * 256;
    for (int e = part * 1984 + tid; e < (part + 1) * 1984; e += NTHR) { const int tp = e >> 8, mm = (e >> 4) & 15, m2 = e & 15, tau = tp - 15; float acc = 0.f;
#pragma unroll
        for (int dir = 0; dir < 2; ++dir) { if ((dir == 0 && tau < 0) || (dir == 1 && tau > 0)) continue; const int k = tau < 0 ? -tau : tau;
            const float* pp = pw + (dir * 17 + k) * 128; const float* bb = Bc + dir * 2048 + m2 * 2; const float* cc = Cc + (dir * 16 + mm) * 128;
            for (int n = 0; n < 64; ++n) { const float pr = pp[2 * n], pi = pp[2 * n + 1], br = bb[n * 32], bi = bb[n * 32 + 1], Pr = pr * br - pi * bi, Pi = pr * bi + pi * br; acc += cc[2 * n] * Pr - cc[2 * n + 1] * Pi; } }
        if (tau == 0 && mm == m2) acc += c.s5_d()[l * 512 + g * 16 + mm];
        Kt[e] = (bf16)f2bf(acc); }
    for (int e = part * 16384 + tid; e < (part + 1) * 16384; e += NTHR) { const int dir = e >> 15, sidx = (e >> 8) & 127, k = e & 255, ri = sidx >> 6, n = sidx & 63, j = k >> 4, m2 = k & 15, ex = dir ? j : 15 - j;
        const float pr = pw[((dir * 17 + ex) * 64 + n) * 2], pi = pw[((dir * 17 + ex) * 64 + n) * 2 + 1], br = Bc[((dir * 64 + n) * 16 + m2) * 2], bi = Bc[((dir * 64 + n) * 16 + m2) * 2 + 1];
        ((bf16*)(c.ws() + WS_S5WS))[((size_t)(dir * 32 + g) * 128 + sidx) * 256 + k] = (bf16)f2bf(ri ? pr * bi + pi * br : pr * br - pi * bi); }
    for (int e = part * 16384 + tid; e < (part + 1) * 16384; e += NTHR) { const int row = e >> 8, k = e & 255, i = row >> 4, mm = row & 15, dir = k >> 7, ri = (k >> 6) & 1, n = k & 63, ex = dir ? 16 - i : i + 1;
        const float pr = pw[((dir * 17 + ex) * 64 + n) * 2], pi = pw[((dir * 17 + ex) * 64 + n) * 2 + 1], cr = Cc[((dir * 16 + mm) * 64 + n) * 2], ci = Cc[((dir * 16 + mm) * 64 + n) * 2 + 1];
        ((bf16*)(c.ws() + WS_S5WO))[(size_t)g * 65536 + e] = (bf16)f2bf(ri ? -(cr * pi + ci * pr) : cr * pr - ci * pi); }
    __syncthreads();
}

__device__ __forceinline__ void s5_unit(const Ctx& c, int l, int g, int cu, unsigned char* lds) {
    const int tid = c.tid, lane = c.lane, w = c.wave, lr = lane & 15, lq = lane >> 4;
    const bool lat = cu >= 8;
    bf16* Ut = (bf16*)lds;
    bf16* St = Ut + 64 * 264;
    bf16* Kt = St + 64 * 264;
    float* Dl = (float*)(Kt + 31 * 256);
    const bf16* R1p = c.R1();
    const bf16* Wsp0 = (const bf16*)(c.ws() + WS_S5WS) + ((size_t)(0 * 32 + g) * 128 + 16 * w + lr) * 256 + 8 * lq;
    const bf16* Wsp1 = (const bf16*)(c.ws() + WS_S5WS) + ((size_t)(1 * 32 + g) * 128 + 16 * w + lr) * 256 + 8 * lq;
    const bf16* Wop = (const bf16*)(c.ws() + WS_S5WO) + (size_t)g * 65536 + 8 * lq;
    bx8 afA[8], afB[8];
#pragma unroll
    for (int ks = 0; ks < 8; ++ks) afA[ks] = *(const bx8*)(Wsp0 + 32 * ks);
    { const v4u* src = (const v4u*)((const bf16*)(c.ws() + WS_S5K) + (size_t)g * 31 * 256); for (int i = tid; i < 31 * 32; i += NTHR) ((v4u*)Kt)[i] = src[i]; }
#pragma unroll
    for (int i = 0; i < 2; ++i) { const int id = tid + NTHR * i, col = id >> 4, j = id & 15;
        const int tok = lat ? MC + (cu - 8) * 1024 + col * 16 + j : (4 * cu + (col >> 4)) * 256 + (col & 15) * 16 + j;
        const bf16* up = R1p + (size_t)tok * 4096 + C_U + g * 16;
        *(v4u*)(Ut + col * 264 + j * 16) = *(const v4u*)up; *(v4u*)(Ut + col * 264 + j * 16 + 8) = *(const v4u*)(up + 8); }
#pragma unroll
    for (int ks = 0; ks < 8; ++ks) afB[ks] = *(const bx8*)(Wsp1 + 32 * ks);
    LDS_BARRIER();
#pragma unroll
    for (int dir = 0; dir < 2; ++dir) {
        f32x4 acc[4];
#pragma unroll
        for (int cb = 0; cb < 4; ++cb) acc[cb] = (f32x4){0.f, 0.f, 0.f, 0.f};
#pragma unroll
        for (int ks = 0; ks < 8; ++ks) {
#pragma unroll
            for (int cb = 0; cb < 4; ++cb) { const bx8 bf = *(const bx8*)(Ut + (16 * cb + lr) * 264 + 32 * ks + 8 * lq); acc[cb] = MFMA16(dir ? afB[ks] : afA[ks], bf, acc[cb]); }
            __builtin_amdgcn_sched_barrier(0); }
        if (dir == 0) {
#pragma unroll
            for (int ks = 0; ks < 8; ++ks) afA[ks] = *(const bx8*)(Wop + (size_t)(16 * (2 * w) + lr) * 256 + 32 * ks); }
        else {
#pragma unroll
            for (int ks = 0; ks < 8; ++ks) afB[ks] = *(const bx8*)(Wop + (size_t)(16 * (2 * w + 1) + lr) * 256 + 32 * ks); }
#pragma unroll
        for (int cb = 0; cb < 4; ++cb)
#pragma unroll
            for (int r = 0; r < 4; ++r) Dl[(16 * w + 4 * lq + r) * 65 + 16 * cb + lr] = acc[cb][r];
        LDS_BARRIER();
        if (tid < (lat ? 64 : 256)) {
            const int n = tid & 63, bl = tid >> 6, nc = lat ? 64 : 16, cbase = lat ? 0 : 16 * bl, b = lat ? cu - 8 : 4 * cu + bl;
            const float* at = (const float*)(c.ws() + WS_S5AT) + ((size_t)(dir * 32 + g) * 64 + n) * 2; const float ar = at[0], ai = at[1];
            float sr = 0.f, si = 0.f;
            if (lat) { sr = c.state_s5()[((((size_t)(b * 2 + l) * 2 + dir) * 2 + 0) * 32 + g) * 64 + n]; si = c.state_s5()[((((size_t)(b * 2 + l) * 2 + dir) * 2 + 1) * 32 + g) * 64 + n]; }
            for (int cc = 0; cc < nc; ++cc) { const int col = cbase + (dir ? nc - 1 - cc : cc);
                St[col * 264 + dir * 128 + n] = (bf16)f2bf(sr); St[col * 264 + dir * 128 + 64 + n] = (bf16)f2bf(si);
                const float dr = Dl[n * 65 + col], di = Dl[(64 + n) * 65 + col];
                const float nr = ar * sr - ai * si + dr, ni = ar * si + ai * sr + di; sr = nr; si = ni; }
            if (!lat) { c.out()[O_S5 + ((((size_t)(b * 2 + l) * 2 + dir) * 2 + 0) * 32 + g) * 64 + n] = sr; c.out()[O_S5 + ((((size_t)(b * 2 + l) * 2 + dir) * 2 + 1) * 32 + g) * 64 + n] = si; }
        }
        LDS_BARRIER();
    }
#pragma unroll
    for (int ii = 0; ii < 2; ++ii) { const int i = 2 * w + ii;
        f32x4 acc[4];
#pragma unroll
        for (int cb = 0; cb < 4; ++cb) acc[cb] = (f32x4){0.f, 0.f, 0.f, 0.f};
#pragma unroll
        for (int ks = 0; ks < 8; ++ks) { const int j = 2 * ks + (lq >> 1); const bx8 af = *(const bx8*)(Kt + ((i - j + 15) * 16 + lr) * 16 + 8 * (lq & 1));
#pragma unroll
            for (int cb = 0; cb < 4; ++cb) { const bx8 bf = *(const bx8*)(Ut + (16 * cb + lr) * 264 + 32 * ks + 8 * lq); acc[cb] = MFMA16(af, bf, acc[cb]); }
            __builtin_amdgcn_sched_barrier(0); }
#pragma unroll
        for (int ks = 0; ks < 8; ++ks) {
#pragma unroll
            for (int cb = 0; cb < 4; ++cb) { const bx8 bf = *(const bx8*)(St + (16 * cb + lr) * 264 + 32 * ks + 8 * lq); acc[cb] = MFMA16(ii ? afB[ks] : afA[ks], bf, acc[cb]); }
            __builtin_amdgcn_sched_barrier(0); }
#pragma unroll
        for (int cb = 0; cb < 4; ++cb) { const int col = 16 * cb + lr;
            const int tok = lat ? MC + (cu - 8) * 1024 + col * 16 + i : (4 * cu + (col >> 4)) * 256 + (col & 15) * 16 + i;
            v2u o; o.x = pk2(acc[cb][0], acc[cb][1]); o.y = pk2(acc[cb][2], acc[cb][3]);
            *(v2u*)(c.Y5() + (size_t)tok * 512 + g * 16 + 4 * lq) = o; }
    }
}

typedef float f32x16 __attribute__((ext_vector_type(16)));
#define MFMA32(a, b, cc) __builtin_amdgcn_mfma_f32_32x32x16_bf16((a), (b), (cc), 0, 0, 0)
constexpr float SM_SC = 0.125f * 1.4426950408889634f;
__device__ __forceinline__ void qk_tile(f32x16& p0, f32x16& p1, const bf16* Kt, int KS, const bx8 (&qf)[4], int r32, int hi) {
    p0 = (f32x16){0.f}; p1 = (f32x16){0.f};
#pragma unroll
    for (int d0 = 0; d0 < 4; ++d0) { const bx8 a0 = *(const bx8*)(Kt + r32 * KS + 16 * d0 + 8 * hi), a1 = *(const bx8*)(Kt + (32 + r32) * KS + 16 * d0 + 8 * hi);
        p0 = MFMA32(a0, qf[d0], p0); p1 = MFMA32(a1, qf[d0], p1); }
}
__device__ __forceinline__ float fmax_(float a, float b) { float r; asm("v_max_f32_e32 %0, %1, %2" : "=v"(r) : "v"(a), "v"(b)); return r; }
__device__ __forceinline__ float sm_step(f32x16& p0, f32x16& p1, float& mrun, float& lrun, bx8 (&pb)[4]) {
    float ta = fmax_(p0[0], p1[0]), tb = fmax_(p0[1], p1[1]);
#pragma unroll
    for (int r = 2; r < 16; r += 2) { ta = fmax_(ta, fmax_(p0[r], p1[r])); tb = fmax_(tb, fmax_(p0[r + 1], p1[r + 1])); }
    float tm = fmax_(ta, tb) * SM_SC;
    tm = fmax_(tm, __shfl_xor(tm, 32));
    const float mn = fmax_(mrun, tm), alpha = __builtin_amdgcn_exp2f(mrun - mn);
    float rs0 = 0.f, rs1 = 0.f;
#pragma unroll
    for (int r = 0; r < 16; ++r) { p0[r] = __builtin_amdgcn_exp2f(fmaf(p0[r], SM_SC, -mn)); p1[r] = __builtin_amdgcn_exp2f(fmaf(p1[r], SM_SC, -mn)); rs0 += p0[r]; rs1 += p1[r]; }
    float rs = rs0 + rs1;
    rs += __shfl_xor(rs, 32);
    lrun = lrun * alpha + rs; mrun = mn;
#pragma unroll
    for (int sI = 0; sI < 2; ++sI) {
        v4u t0, t1;
        t0.x = pg8::cvt_pk_bf16(p0[8 * sI + 0], p0[8 * sI + 1]); t0.y = pg8::cvt_pk_bf16(p0[8 * sI + 2], p0[8 * sI + 3]); t0.z = pg8::cvt_pk_bf16(p0[8 * sI + 4], p0[8 * sI + 5]); t0.w = pg8::cvt_pk_bf16(p0[8 * sI + 6], p0[8 * sI + 7]);
        t1.x = pg8::cvt_pk_bf16(p1[8 * sI + 0], p1[8 * sI + 1]); t1.y = pg8::cvt_pk_bf16(p1[8 * sI + 2], p1[8 * sI + 3]); t1.z = pg8::cvt_pk_bf16(p1[8 * sI + 4], p1[8 * sI + 5]); t1.w = pg8::cvt_pk_bf16(p1[8 * sI + 6], p1[8 * sI + 7]);
        pb[sI] = __builtin_bit_cast(bx8, t0); pb[2 + sI] = __builtin_bit_cast(bx8, t1);
    }
    return alpha;
}
template <int NDT> __device__ __forceinline__ void pv_tile(f32x16 (&o)[NDT], const bf16* Vt, const bx8 (&pb)[4], int r32, int hi) {
    v2u cur[NDT][2], nxt[NDT][2];
#pragma unroll
    for (int dt = 0; dt < NDT; ++dt) { const bf16* vp = Vt + (32 * dt + r32) * 68 + 4 * hi; cur[dt][0] = *(const v2u*)vp; cur[dt][1] = *(const v2u*)(vp + 8); }
#pragma unroll
    for (int ks = 0; ks < 4; ++ks) {
        if (ks < 3) {
#pragma unroll
            for (int dt = 0; dt < NDT; ++dt) { const bf16* vp = Vt + (32 * dt + r32) * 68 + 16 * (ks + 1) + 4 * hi; nxt[dt][0] = *(const v2u*)vp; nxt[dt][1] = *(const v2u*)(vp + 8); }
        }
#pragma unroll
        for (int dt = 0; dt < NDT; ++dt) { const v4u t = {cur[dt][0].x, cur[dt][0].y, cur[dt][1].x, cur[dt][1].y}; o[dt] = MFMA32(__builtin_bit_cast(bx8, t), pb[ks], o[dt]); }
#pragma unroll
        for (int dt = 0; dt < NDT; ++dt) { cur[dt][0] = nxt[dt][0]; cur[dt][1] = nxt[dt][1]; }
    }
}

template <int PASS> __device__ __forceinline__ void diff_unit(const Ctx& c, int l, int uidx, unsigned char* lds) {
    constexpr int NT = PASS ? 20 : 4, NQB = PASS ? 8 : 2;
    const int tid = c.tid, lane = c.lane, w = c.wave, r32 = lane & 31, hi = lane >> 5, comp = w >> 2;
    const int qb = uidx % NQB, h = (uidx / NQB) & 3, b = uidx / (NQB * 4);
    const int tok0 = PASS ? MC + b * 1024 : b * 256;
    bf16* Kt = (bf16*)lds;
    bf16* Vt = Kt + 64 * 136;
    float* Ob = (float*)(Vt + 128 * 68);
    const bf16* R1p = c.R1(); const bf16* CK = c.CKV();
    const float lam_init = 0.8f - 0.6f * expf(-0.3f * (float)l);
    const float* lv = c.dlam() + l * 256;
    const float lam = expf(wave_sum(lv[lane] * lv[64 + lane])) - expf(wave_sum(lv[128 + lane] * lv[192 + lane])) + lam_init;
    const size_t mrow = (size_t)tok0 + qb * 128 + 32 * (w & 3) + r32;
    bx8 qf[4];
#pragma unroll
    for (int d0 = 0; d0 < 4; ++d0) qf[d0] = *(const bx8*)(R1p + mrow * 4096 + C_DQ + h * 128 + comp * 64 + 16 * d0 + 8 * hi);
    f32x16 o[4];
#pragma unroll
    for (int dt = 0; dt < 4; ++dt) o[dt] = (f32x16){0.f};
    float mrun = -1e30f, lrun = 0.f;
    v4u kreg[2], vreg[2];
#define DIFF_LOAD(t) { const bf16* kb; const bf16* vb; size_t rs; \
        if (PASS && (t) < 4) { kb = CK + ((size_t)b * 256 + 64 * (t)) * 1280 + h * 128; vb = kb + 512; rs = 1280; } \
        else { kb = R1p + ((size_t)tok0 + 64 * ((t) - (PASS ? 4 : 0))) * 4096 + C_DK + h * 128; vb = kb + (C_DV - C_DK); rs = 4096; } \
        _Pragma("unroll") for (int i = 0; i < 2; ++i) { kreg[i] = *(const v4u*)(kb + (size_t)lane * rs + (w + 8 * i) * 8); vreg[i] = *(const v4u*)(vb + (size_t)lane * rs + (w + 8 * i) * 8); } }
    DIFF_LOAD(0);
    for (int t = 0; t < NT; ++t) {
        LDS_BARRIER();
#pragma unroll
        for (int i = 0; i < 2; ++i) { *(v4u*)(Kt + lane * 136 + (w + 8 * i) * 8) = kreg[i];
            const unsigned vs[4] = {vreg[i].x, vreg[i].y, vreg[i].z, vreg[i].w};
#pragma unroll
            for (int j = 0; j < 4; ++j) { Vt[((w + 8 * i) * 8 + 2 * j) * 68 + lane] = (bf16)(vs[j] & 0xffffu); Vt[((w + 8 * i) * 8 + 2 * j + 1) * 68 + lane] = (bf16)(vs[j] >> 16); } }
        if (t + 1 < NT) DIFF_LOAD(t + 1);
        LDS_BARRIER();
        f32x16 p0, p1; bx8 pb[4];
        qk_tile(p0, p1, Kt + comp * 64, 136, qf, r32, hi);
        const float alpha = sm_step(p0, p1, mrun, lrun, pb);
        if (__any(alpha != 1.0f)) {
#pragma unroll
            for (int dt = 0; dt < 4; ++dt)
#pragma unroll
                for (int r = 0; r < 16; ++r) o[dt][r] *= alpha; }
        pv_tile<4>(o, Vt, pb, r32, hi);
    }
#undef DIFF_LOAD
    const float inv = (comp ? lam : 1.0f) / lrun;
    const int rowl = 32 * (w & 3) + r32;
    if (comp) {
#pragma unroll
        for (int dt = 0; dt < 4; ++dt)
#pragma unroll
            for (int r = 0; r < 16; ++r) Ob[rowl * 129 + 32 * dt + (r & 3) + 8 * (r >> 2) + 4 * hi] = o[dt][r] * inv;
    }
    __syncthreads();
    if (!comp) {
        float ss = 0.f;
#pragma unroll
        for (int dt = 0; dt < 4; ++dt)
#pragma unroll
            for (int r = 0; r < 16; ++r) { const float v = o[dt][r] * inv - Ob[rowl * 129 + 32 * dt + (r & 3) + 8 * (r >> 2) + 4 * hi]; o[dt][r] = v; ss += v * v; }
        ss += __shfl_xor(ss, 32);
        const float rn = rsqrtf(ss * (1.0f / 128.0f) + EPS) * (1.0f - lam_init);
        const float* sg = c.subln_g() + l * 128; bf16* yp = c.Y() + mrow * 2048 + 1024 + h * 128;
#pragma unroll
        for (int dt = 0; dt < 4; ++dt)
#pragma unroll
            for (int r4 = 0; r4 < 4; ++r4) { const int dv = 32 * dt + 8 * r4 + 4 * hi; const f32x4 g = *(const f32x4*)(sg + dv);
                v2u ov; ov.x = pk2(o[dt][4 * r4 + 0] * rn * g.x, o[dt][4 * r4 + 1] * rn * g.y); ov.y = pk2(o[dt][4 * r4 + 2] * rn * g.z, o[dt][4 * r4 + 3] * rn * g.w);
                *(v2u*)(yp + dv) = ov; }
    }
}

template <int PASS> __device__ __forceinline__ void win_unit(const Ctx& c, int l, int uidx, unsigned char* lds) {
    constexpr int NQB = PASS ? 4 : 1;
    const int tid = c.tid, lane = c.lane, w = c.wave, r32 = lane & 31, hi = lane >> 5;
    const int qb = uidx % NQB, hh = (uidx / NQB) & 7, b = uidx / (NQB * 8), nkv = hh >> 2;
    const int tok0 = PASS ? MC + b * 1024 : b * 256;
    bf16* Kt = (bf16*)lds;
    bf16* Vt = Kt + 64 * 72;
    const bf16* R1p = c.R1(); const bf16* CK = c.CKV();
    const int qrow = qb * 256 + 32 * w + r32;
    const size_t mrow = (size_t)tok0 + qrow;
    bx8 qf[4];
#pragma unroll
    for (int d0 = 0; d0 < 4; ++d0) qf[d0] = *(const bx8*)(R1p + mrow * 4096 + C_WQ + hh * 64 + 16 * d0 + 8 * hi);
    f32x16 o[2]; o[0] = (f32x16){0.f}; o[1] = (f32x16){0.f};
    float mrun = c.sink()[l * 8 + hh] * 1.4426950408889634f, lrun = 1.0f;
    const int q0 = qb * 256;
    const int tb0 = PASS ? ((q0 - 128 < 0 ? 0 : q0 - 128) >> 6) : 0, tb1 = PASS ? ((q0 + 255 + 128 > 1023 ? 1023 : q0 + 255 + 128) >> 6) : 0;
    const int NT = PASS ? 4 + (tb1 - tb0 + 1) : 4;
    const int kvl = tid & 63, chunk = tid >> 6;
    v4u kreg, vreg;
#define WIN_LOAD(t) { const bf16* kb; const bf16* vb; size_t rs; \
        if (PASS && (t) < 4) { kb = CK + ((size_t)b * 256 + 64 * (t)) * 1280 + 1024 + nkv * 64; vb = kb + 128; rs = 1280; } \
        else { kb = R1p + ((size_t)tok0 + 64 * (PASS ? tb0 + (t) - 4 : (t))) * 4096 + C_WK + nkv * 64; vb = kb + (C_WV - C_WK); rs = 4096; } \
        kreg = *(const v4u*)(kb + (size_t)kvl * rs + chunk * 8); vreg = *(const v4u*)(vb + (size_t)kvl * rs + chunk * 8); }
    WIN_LOAD(0);
    for (int t = 0; t < NT; ++t) {
        LDS_BARRIER();
        *(v4u*)(Kt + kvl * 72 + chunk * 8) = kreg;
        { const unsigned vs[4] = {vreg.x, vreg.y, vreg.z, vreg.w};
#pragma unroll
          for (int j = 0; j < 4; ++j) { Vt[(chunk * 8 + 2 * j) * 68 + kvl] = (bf16)(vs[j] & 0xffffu); Vt[(chunk * 8 + 2 * j + 1) * 68 + kvl] = (bf16)(vs[j] >> 16); } }
        if (t + 1 < NT) WIN_LOAD(t + 1);
        LDS_BARRIER();
        bool band = false; int kp0 = 0;
        if (PASS && t >= 4) { band = true; kp0 = 64 * (tb0 + t - 4); const int r0 = q0 + 32 * w;
            if (kp0 + 63 < r0 - 128 || kp0 > r0 + 31 + 128) continue; }
        f32x16 p0, p1; bx8 pb[4];
        qk_tile(p0, p1, Kt, 72, qf, r32, hi);
        if (band) {
#pragma unroll
            for (int r = 0; r < 16; ++r) { const int kp = kp0 + (r & 3) + 8 * (r >> 2) + 4 * hi; const int d0 = qrow - kp, d1 = d0 - 32;
                if (d0 > 128 || d0 < -128) p0[r] = -1e30f; if (d1 > 128 || d1 < -128) p1[r] = -1e30f; }
        }
        const float alpha = sm_step(p0, p1, mrun, lrun, pb);
        if (__any(alpha != 1.0f)) {
#pragma unroll
            for (int dt = 0; dt < 2; ++dt)
#pragma unroll
                for (int r = 0; r < 16; ++r) o[dt][r] *= alpha; }
        pv_tile<2>(o, Vt, pb, r32, hi);
    }
#undef WIN_LOAD
    const float inv = 1.0f / lrun; bf16* yp = c.Y() + mrow * 2048 + 1536 + hh * 64;
#pragma unroll
    for (int dt = 0; dt < 2; ++dt)
#pragma unroll
        for (int r4 = 0; r4 < 4; ++r4) { const int dv = 32 * dt + 8 * r4 + 4 * hi;
            v2u ov; ov.x = pk2(o[dt][4 * r4 + 0] * inv, o[dt][4 * r4 + 1] * inv); ov.y = pk2(o[dt][4 * r4 + 2] * inv, o[dt][4 * r4 + 3] * inv);
            *(v2u*)(yp + dv) = ov; }
}

__device__ __forceinline__ void phase_mixers(const Ctx& c_in, int l, float* lf) {
    unsigned char* lds = (unsigned char*)lf;
    unsigned* qctr = (unsigned*)(c_in.ws() + WS_QCTR) + 64 * l;
    volatile int* qslot = (volatile int*)(lds + LDS_BYTES - 32);
    for (;;) {
        __syncthreads();
        if (threadIdx.x == 0) *qslot = (int)atomicAdd(qctr, 1u);
        __syncthreads();
        const int u = __builtin_amdgcn_readfirstlane(*qslot);
        if (u >= 1440) break;
        Ctx c = c_in; asm volatile("" : "+s"(c.ap), "+v"(c.tid));
        c.lane = c.tid & 63; c.wave = __builtin_amdgcn_readfirstlane(c.tid >> 6);
        unsigned long long pt0 = 0; if (PROBE_SEL >= 0) pt0 = __builtin_amdgcn_s_memrealtime();
        int ty;
        if (u < 32) { ssd_unit(c, l, 1, u >> 3, u & 7, lds); ty = 0; }
        else if (u < 160) { diff_unit<1>(c, l, u - 32, lds); ty = 2; }
        else if (u < 288) { win_unit<1>(c, l, u - 160, lds); ty = 3; }
        else if (u < 416) { s5_unit(c, l, (u - 288) & 31, 8 + ((u - 288) >> 5), lds); ty = 1; }
        else if (u < 672) { ssd_unit(c, l, 0, (u - 416) >> 3, (u - 416) & 7, lds); ty = 4; }
        else if (u < 928) { diff_unit<0>(c, l, u - 672, lds); ty = 6; }
        else if (u < 1184) { win_unit<0>(c, l, u - 928, lds); ty = 7; }
        else { s5_unit(c, l, (u - 1184) & 31, (u - 1184) >> 5, lds); ty = 5; }
        __syncthreads();
        if (PROBE_SEL >= 0 && threadIdx.x == 0) { unsigned long long* tsu = (unsigned long long*)(c.ws() + WS_TS) + 64; atomicAdd(tsu + ty, (unsigned long long)(__builtin_amdgcn_s_memrealtime() - pt0)); }
    }
}

__device__ __forceinline__ void phase_sum4(const Ctx& c) {
    const int gt = blockIdx.x * NTHR + c.tid, NT = gridDim.x * NTHR;
#pragma unroll 4
    for (int i = gt; i < M * 128; i += NT) { const size_t m = (size_t)(i >> 7); const int c8 = (i & 127) * 8;
        float a[8] = {0.f, 0.f, 0.f, 0.f, 0.f, 0.f, 0.f, 0.f};
#pragma unroll
        for (int j = 0; j < 4; ++j) { float f[8]; unpack8(*(const v4u*)(c.R1() + m * 4096 + j * 1024 + c8), f);
#pragma unroll
            for (int k = 0; k < 8; ++k) a[k] += f[k]; }
        v4u o; o.x = pk2(a[0], a[1]); o.y = pk2(a[2], a[3]); o.z = pk2(a[4], a[5]); o.w = pk2(a[6], a[7]);
        *(v4u*)(c.H() + m * 1024 + c8) = o; }
}

#define GAS __attribute__((address_space(1)))
#define XB_TMO      128
#define XB_XCNT(j)  (256  + 64 * (j))
#define XB_XSUB(j)  (1280 + 64 * (j))
#define XB_XGEN(j)  (2304 + 64 * (j))
#define XB_TOP      3328
#define XB_TOPGEN   3392
#define XCD_BAR_WORDS 3456
#define XB_SPIN_CAP (1u << 18)

__device__ __forceinline__ unsigned xb_ld(unsigned* p)              { return __hip_atomic_load(p, __ATOMIC_RELAXED, __HIP_MEMORY_SCOPE_AGENT); }
__device__ __forceinline__ unsigned xb_add(unsigned* p, unsigned v) { return __hip_atomic_fetch_add(p, v, __ATOMIC_RELAXED, __HIP_MEMORY_SCOPE_AGENT); }
__device__ __forceinline__ unsigned xb_xcc_id() { return (unsigned)__builtin_amdgcn_s_getreg((3 << 11) | 20) & 0xFu; }
#define XB_SPIN(cond, bar) do { unsigned _sp = 0; while (cond) { __builtin_amdgcn_s_sleep(1); \
    if ((++_sp & 255u) == 0u) { if (xb_ld(&(bar)[XB_TMO])) break; if (_sp > XB_SPIN_CAP) { atomicAdd(&(bar)[XB_TMO], 1u); break; } } } } while (0)

struct XcdBarrier {
    unsigned* bar; unsigned x;
    volatile LAS unsigned* st;
};

__device__ __forceinline__ XcdBarrier xcd_barrier_post(unsigned* bar, volatile LAS unsigned* st) {
    XcdBarrier b; b.bar = bar; b.x = xb_xcc_id(); b.st = st;
    if (threadIdx.x == 0) (void)xb_add(&bar[XB_XCNT(b.x)], 1u);
    return b;
}
__device__ __forceinline__ void xcd_barrier_complete(unsigned* bar, unsigned x, unsigned& nloc, unsigned& nx) {
    const unsigned G = gridDim.x * gridDim.y * gridDim.z;
    unsigned sum, cnt, mine, sp = 0u;
    for (;;) {
        sum = 0u; cnt = 0u; mine = 0u;
#pragma unroll
        for (unsigned j = 0; j < 16; ++j) { const unsigned c = xb_ld(&bar[XB_XCNT(j)]); sum += c; cnt += (c > 0u) ? 1u : 0u; mine = (j == x) ? c : mine; }
        if (sum == G) break;
        __builtin_amdgcn_s_sleep(1);
        if ((++sp & 255u) == 0u) { if (xb_ld(&bar[XB_TMO])) break; if (sp > XB_SPIN_CAP) { atomicAdd(&bar[XB_TMO], 1u); break; } }
    }
    nloc = mine > 0u ? mine : 1u; nx = cnt > 0u ? cnt : 1u;
}

__device__ __forceinline__ void xcd_barrier(const XcdBarrier& b) {
    asm volatile("s_waitcnt vmcnt(0)" ::: "memory");
    __syncthreads();
    if (threadIdx.x == 0) {
        unsigned* bar = b.bar;
        __builtin_amdgcn_s_waitcnt(0);
        unsigned nloc = b.st[0], nx = b.st[1];
        if (nloc == 0u) { xcd_barrier_complete(bar, b.x, nloc, nx); b.st[0] = nloc; b.st[1] = nx; }
        const unsigned old = xb_add(&bar[XB_XSUB(b.x)], 1u);
        const unsigned gen = old / nloc;
        if (old + 1u == (gen + 1u) * nloc) {
            __builtin_amdgcn_fence(__ATOMIC_RELEASE, "agent");
            asm volatile("s_waitcnt vmcnt(0)" ::: "memory");
            const unsigned og = xb_add(&bar[XB_TOP], 1u);
            const unsigned tg = og / nx;
            if (og + 1u == (tg + 1u) * nx) xb_add(&bar[XB_TOPGEN], 1u);
            else XB_SPIN(xb_ld(&bar[XB_TOPGEN]) == tg, bar);
            __builtin_amdgcn_fence(__ATOMIC_ACQUIRE, "agent");
            xb_add(&bar[XB_XGEN(b.x)], 1u);
            asm volatile("s_waitcnt vmcnt(0)" ::: "memory");
        } else {
            XB_SPIN(xb_ld(&bar[XB_XGEN(b.x)]) == gen, bar);
            __builtin_amdgcn_fence(__ATOMIC_ACQUIRE, "agent");
            asm volatile("s_waitcnt vmcnt(0)" ::: "memory");
        }
    }
    __syncthreads();
}

#define PHASE_BEGIN() Ctx c; c.ap = (CArgs)__builtin_amdgcn_kernarg_segment_ptr(); asm volatile("" : "+s"(c.ap)); \
        int tid_o = threadIdx.x; asm volatile("" : "+v"(tid_o)); c.tid = tid_o; c.lane = tid_o & 63; c.wave = __builtin_amdgcn_readfirstlane(tid_o >> 6); \
        int G = gridDim.x, bid = blockIdx.x; asm volatile("" : "+s"(G), "+s"(bid)); unsigned char* ws = c.ws(); (void)ws; (void)G; (void)bid;
#define PHASE_END(k) { if ((k) + 1 < ph_hi) { if ((k) == 0) cg::this_grid().sync(); else xcd_barrier(xbar); } \
        if (PROBE_SEL >= 0 && blockIdx.x == PROBE_PB && threadIdx.x == 0) ((unsigned long long*)(c.ws() + WS_TS))[(k) + 1] = __builtin_amdgcn_s_memrealtime(); }
#define IN_RANGE(k) (ph_lo <= (k) && (k) < ph_hi)

template <int LAYER> __device__ __forceinline__ void layer_program(int ph_lo, int ph_hi, unsigned char* lds, const XcdBarrier& xbar) {
    float* lf = (float*)lds;
    PG8_LAS unsigned char* ring = (PG8_LAS unsigned char*)lds;
    constexpr int l = LAYER, B0 = 1 + 11 * LAYER;
    if (IN_RANGE(B0 + 0)) { PHASE_BEGIN(); if (l == 1) { if (gridDim.x == 256) convert_items(c, 1, 7936, 9984, blockIdx.x * NWAVES + c.wave, gridDim.x * NWAVES, false, 0, 1, lf); else phase_convert(c, 1, lf); __syncthreads(); } phase_norm(c, l, 0, lf); phase_bias2(c, l); PHASE_END(B0 + 0); }
    if (IN_RANGE(B0 + 1)) { PHASE_BEGIN();
        pg8::Gemm g{c.H(), (const bf16*)(ws + W_IN), M, 4096, 1024, 1024, 1024, 0, 0}; pg8::StaticOrder S; S.init(M, 4096, G, bid);
        pg8::EpiB<0> E{c.R1(), 4096, nullptr, nullptr};
        pg8::gemm_phase<pg8::EpiB<0>, pg8::StaticOrder, true, true>(ring, g, S, E, tid_o); phase_dt(c, l); PHASE_END(B0 + 1); }
    if (IN_RANGE(B0 + 2)) { PHASE_BEGIN(); phase_qk(c, l, lf); PHASE_END(B0 + 2); }
    if (IN_RANGE(B0 + 3)) { PHASE_BEGIN(); phase_mixers(c, l, lf); PHASE_END(B0 + 3); }
    if (IN_RANGE(B0 + 4)) { PHASE_BEGIN();
        { pg8::Gemm g{c.Y5(), (const bf16*)(ws + W_GLU), M, 1024, 512, 512, 512, 0, 0}; pg8::StaticOrder S; S.init(M, 1024, G, bid);
          pg8::EpiGlu E{c.Y(), 2048, 512, c.b_glu() + l * 1024};
          pg8::gemm_phase<pg8::EpiGlu, pg8::StaticOrder, true, true>(ring, g, S, E, tid_o); }
        { pg8::Gemm g{c.H(), (const bf16*)(ws + W_G), M, 4096, 1024, 1024, 1024, 0, 0}; pg8::StaticOrder S; S.init(M, 4096, G, bid);
          pg8::EpiB<1> E{c.R1(), 4096, c.b_gate() + l * 4096, nullptr};
          pg8::gemm_phase<pg8::EpiB<1>, pg8::StaticOrder, true, true>(ring, g, S, E, tid_o); }
        PHASE_END(B0 + 4); }
    if (IN_RANGE(B0 + 5)) { PHASE_BEGIN();
        pg8::Gemm g{c.Y(), (const bf16*)(ws + W_BR), M, 4096, 512, 2048, 512, 4, 1024}; pg8::BranchOrder S; S.init(G, bid);
        pg8::EpiMerge E{c.R1(), c.H(), c.SSQ()};
        pg8::gemm_phase<pg8::EpiMerge, pg8::BranchOrder, true, true>(ring, g, S, E, tid_o); if (l == 0) side_convert(c, 0, 4352, true, lf); PHASE_END(B0 + 5); }
    if (IN_RANGE(B0 + 7)) { PHASE_BEGIN();
        pg8::Gemm g{c.H(), (const bf16*)(ws + W_OUT), M, 1024, 1024, 1024, 1024, 0, 0}; pg8::StaticOrder S; S.init(M, 1024, G, bid);
        pg8::EpiRes2 E{l == 0 ? c.x_prompt() : c.out(), l == 0 ? c.x_sample() : c.out() + (size_t)MC * D, c.out(), c.MOD() + (size_t)l * 5 * 6144, 2048, c.Y(), c.g_norm2() + l * 1024, 4096, (float*)(ws + WS_SSQ2)};
        pg8::gemm_phase<pg8::EpiRes2, pg8::StaticOrder, true, true>(ring, g, S, E, tid_o); if (l == 0) side_convert(c, 4352, 5376, false, lf); PHASE_END(B0 + 7); }
    if (IN_RANGE(B0 + 9)) { PHASE_BEGIN();
        pg8::Gemm g{c.Y(), (const bf16*)(ws + W_1), M, 4096, 1024, 1024, 1024, 0, 0}; pg8::StaticOrder S; S.init(M, 4096, G, bid);
        pg8::EpiB<5> E{c.R1(), 4096, (const float*)(ws + WS_BI2), (const float*)(ws + WS_SSQ2)};
        pg8::gemm_phase<pg8::EpiB<5>, pg8::StaticOrder, true, true>(ring, g, S, E, tid_o); PHASE_END(B0 + 9); }
    if (IN_RANGE(B0 + 10)) { PHASE_BEGIN();
        pg8::Gemm g{c.R1(), (const bf16*)(ws + W_2), M, 1024, 4096, 4096, 4096, 0, 0}; pg8::StaticOrder S; S.init(M, 1024, G, bid);
        pg8::EpiRes E{c.out(), c.out() + (size_t)MC * D, c.out(), c.MOD() + (size_t)l * 5 * 6144, 5120};
        pg8::gemm_phase<pg8::EpiRes, pg8::StaticOrder, true, true>(ring, g, S, E, tid_o); if (l == 0) side_convert(c, 5376, 7936, false, lf); PHASE_END(B0 + 10); }
}

__global__ void __launch_bounds__(NTHR, 2) fwd_kernel(Args args) {
    extern __shared__ __attribute__((aligned(16))) unsigned char lds[];
    const int ph_lo = args.ph_lo, ph_hi = args.ph_hi;
    volatile LAS unsigned* xst = (volatile LAS unsigned*)(lds + LDS_BYTES - 16);
    if (threadIdx.x < 4) xst[threadIdx.x] = 0u;
    __syncthreads();
    const XcdBarrier xbar = xcd_barrier_post((unsigned*)(args.ws + WS_BAR), xst);
    if (PROBE_SEL >= 0 && blockIdx.x == PROBE_PB && threadIdx.x == 0) { unsigned long long* ts = (unsigned long long*)(args.ws + WS_TS); ts[0] = __builtin_amdgcn_s_memrealtime(); }
    if (IN_RANGE(0)) { PHASE_BEGIN(); float* lf = (float*)lds; phase_mods(c, lf); __syncthreads(); phase_convert(c, 0, lf); phase_rope_table(c); PHASE_END(0); }
    layer_program<0>(ph_lo, ph_hi, lds, xbar);
    layer_program<1>(ph_lo, ph_hi, lds, xbar);
    if (PROBE_SEL >= 0) {
        __threadfence(); cg::this_grid().sync();
        const unsigned long long* ts = (const unsigned long long*)(args.ws + WS_TS);
        const float total = (float)(ts[23] - ts[0]); float sel = 0.f;
        for (int k = 0; k < 23; ++k) { const float d = (float)(ts[k + 1] - ts[k]); const int q = k == 0 ? -1 : (k - 1) % 11;
            const int cls = (q == 3) ? 0 : (q == 1 || q == 4 || q == 5 || q == 7 || q == 9 || q == 10) ? 1 : (q == 2) ? 2 : 3;
            if (cls == PROBE_SEL) sel += d; }
        if (PROBE_SEL >= 10 && PROBE_SEL < 100) sel = (float)ts[64 + PROBE_SEL - 10] * (1.0f / 256.0f);
        if (PROBE_SEL >= 100) { const int k = PROBE_SEL - 100; sel = (float)(ts[k + 1] - (ts[k] != 0ull ? ts[k] : ts[k - 1])); }
        const float sc = 1.0f + sqrtf(PROBE_SCALE * sel / total);
        for (int i = blockIdx.x * NTHR + threadIdx.x; i < 524288; i += gridDim.x * NTHR) args.out[O_S5 + i] *= sc;
    }
}

extern "C" void kernel_launch(void* const* d_in, const int* in_sizes, int n_in, void* d_out, int out_size, void* d_ws, size_t ws_size, hipStream_t stream) {
    static int grid = 0;
    if (grid == 0) {
        if (n_in != 44 || ws_size < WS_END) { fprintf(stderr, "kernel_launch: expected 44 inputs and >= %zu bytes of workspace; got %d, %zu\n", (size_t)WS_END, n_in, ws_size); grid = -1; return; }
        int dev = 0, cus = 0, per_cu = 0;
        (void)hipGetDevice(&dev); (void)hipDeviceGetAttribute(&cus, hipDeviceAttributeMultiprocessorCount, dev);
        (void)hipFuncSetAttribute((const void*)fwd_kernel, hipFuncAttributeMaxDynamicSharedMemorySize, LDS_BYTES);
        (void)hipOccupancyMaxActiveBlocksPerMultiprocessor(&per_cu, (const void*)fwd_kernel, NTHR, LDS_BYTES);
        if (per_cu < 1) { fprintf(stderr, "kernel_launch: occupancy query says %d blocks per CU\n", per_cu); per_cu = 1; }
        (void)hipGetLastError();
        grid = cus > 0 ? cus : 256;
    }
    if (grid < 0) return;
    (void)hipMemsetAsync(d_ws, 0, 64 * 1024, stream);
    Args a{};
    for (int i = 0; i < 44; ++i) a.in[i] = (const float*)d_in[i];
    a.out = (float*)d_out; a.ws = (unsigned char*)d_ws;
#if MK_MULTI
    for (int ph = 0; ph < NPH; ++ph) { a.ph_lo = ph; a.ph_hi = ph + 1; hipLaunchKernelGGL(fwd_kernel, dim3(grid), dim3(NTHR), LDS_BYTES, stream, a); }
#else
    a.ph_lo = 0; a.ph_hi = NPH;
    void* kargs[] = {&a};
    hipError_t e = hipLaunchCooperativeKernel((const void*)fwd_kernel, dim3(grid), dim3(NTHR), kargs, LDS_BYTES, stream);
    if (e != hipSuccess) fprintf(stderr, "cooperative launch failed: %s (grid %d)\n", hipGetErrorString(e), grid);
#endif
}
```

```cpp
#include <hip/hip_runtime.h>
#include <hip/hip_cooperative_groups.h>
#include <cstdio>
#include <cstdint>
namespace cg = cooperative_groups;

#ifndef MK_MULTI
#define MK_MULTI 0
#endif

namespace pg8 {
#define PG8_LAS __attribute__((address_space(3)))
typedef unsigned short bf16_t;
typedef short bf16x8 __attribute__((ext_vector_type(8)));
typedef float f32x4 __attribute__((ext_vector_type(4)));
typedef unsigned u32x4 __attribute__((ext_vector_type(4)));
constexpr int BM = 256, BK = 64, HALF = 128, HTB = HALF * BK * 2  , STAGE_BYTES = 8 * HTB, NXCD = 8, WGM = 8;

__host__ __device__ __forceinline__ int lds_byte(int r, int c) { const int st = (r >> 4) * 2 + (c >> 5), rr = r & 15, cc = c & 31, ob = rr * 64 + cc * 2; return st * 1024 + (ob ^ (((ob >> 9) & 1) << 5)); }
__host__ __device__ __forceinline__ void stage_rc(int b, int& R, int& C) { const int st = b / 1024, sb = b % 1024, swz = sb ^ (((sb >> 9) & 1) << 5); R = (st >> 1) * 16 + swz / 64; C = (st & 1) * 32 + (swz % 64) / 2; }
__host__ __device__ __forceinline__ int perm32(int rho) { const int n = rho >> 4, i = rho & 15; return 8 * (i >> 2) + 4 * n + (i & 3); }

struct Unit { int pm, pn; };
struct Gemm { const bf16_t* A; const bf16_t* Bt; int M, N, K, lda, ldb, a_div; size_t a_gstride; };

struct StaticOrder {
    int nM, nN, nwg, G, c;
    __host__ __device__ void init(int M, int N, int G_, int c_) { nM = M / BM; nN = N / BM; nwg = nM * nN; G = G_; c = c_; }
    __host__ __device__ bool next(int i, Unit& u) const {
        const long L = (long)i * G + c; if (L >= nwg) return false;
        int wgid = (int)L; { const int q = nwg / NXCD, r = nwg % NXCD, xcd = wgid % NXCD, off = wgid / NXCD; wgid = (xcd < r ? xcd * (q + 1) : r * (q + 1) + (xcd - r) * q) + off; }
        const int nig = WGM * nN, gid = wgid / nig, fm = gid * WGM, gsz = (nM - fm) < WGM ? (nM - fm) : WGM;
        u.pm = fm + ((wgid % nig) % gsz); u.pn = (wgid % nig) / gsz; return true;
    }
    __device__ __forceinline__ void a_ready(const Unit&) const {}
    __device__ __forceinline__ void done(const Unit&) const {}
};

__device__ __forceinline__ unsigned cvt_pk_bf16(float lo, float hi) { unsigned r; asm volatile("v_cvt_pk_bf16_f32 %0, %1, %2" : "=v"(r) : "v"(lo), "v"(hi)); return r; }
__device__ __forceinline__ float bf_lo(unsigned w) { return __builtin_bit_cast(float, w << 16); }
__device__ __forceinline__ float bf_hi(unsigned w) { return __builtin_bit_cast(float, w & 0xffff0000u); }
__device__ __forceinline__ float sigmoidf_(float x) { return 1.0f / (1.0f + __expf(-x)); }

template <int MODE> struct EpiB {
    static constexpr bool PERM = true, AFTER_DRAIN = false;
    bf16_t* O; int ldc; const float* bias; const float* ssq;
    __device__ __forceinline__ void operator()(const f32x4 (&acc)[2][2][4][2], const Unit& u, int wr, int wc, int fr, int fq) const {
        const int row0 = u.pm * BM + wr * 64 + fr, col0 = u.pn * BM + wc * 32 + 8 * fq;
        f32x4 bv[2][2];
#pragma unroll
        for (int bj = 0; bj < 2; ++bj)
#pragma unroll
            for (int n = 0; n < 2; ++n) bv[bj][n] = (MODE == 1) ? *(const f32x4*)(bias + col0 + bj * HALF + 4 * n) : (MODE == 5) ? *(const f32x4*)(bias + (size_t)((u.pm < 32) ? 0 : 1 + ((u.pm - 32) >> 2)) * 4096 + col0 + bj * HALF + 4 * n) : (f32x4){0.f, 0.f, 0.f, 0.f};
        u32x4 gpre[2][4][2]; float rpre[2][4];
        if (MODE == 3) {
#pragma unroll
            for (int ai = 0; ai < 2; ++ai)
#pragma unroll
                for (int m = 0; m < 4; ++m) { const int row = row0 + ai * HALF + m * 16; const bf16_t* rp = O + (size_t)row * ldc + col0;
                    rpre[ai][m] = (u.pn < 4) ? ssq[row] : 512.0f;
#pragma unroll
                    for (int bj = 0; bj < 2; ++bj) gpre[ai][m][bj] = *(const u32x4*)(rp + bj * HALF); }
        }
#pragma unroll
        for (int ai = 0; ai < 2; ++ai)
#pragma unroll
            for (int m = 0; m < 4; ++m) {
                const int row = row0 + ai * HALF + m * 16;
                bf16_t* rowp = O + (size_t)row * ldc + col0;
                float rs = 1.f;
                if (MODE == 3) { if (u.pn < 4) rs = rsqrtf(rpre[ai][m] * (1.0f / 512.0f) + 1e-6f); }
                if (MODE == 5) rs = rsqrtf(ssq[row] * (1.0f / 1024.0f) + 1e-6f);
#pragma unroll
                for (int bj = 0; bj < 2; ++bj) {
                    f32x4 v0 = (MODE == 5 ? acc[ai][bj][m][0] * rs : acc[ai][bj][m][0]) + bv[bj][0], v1 = (MODE == 5 ? acc[ai][bj][m][1] * rs : acc[ai][bj][m][1]) + bv[bj][1];
                    if (MODE == 1) {
#pragma unroll
                        for (int j = 0; j < 4; ++j) { v0[j] = sigmoidf_(v0[j]); v1[j] = sigmoidf_(v1[j]); }
                    }
                    if (MODE == 2 || MODE == 5) {
#pragma unroll
                        for (int j = 0; j < 4; ++j) { const float a = fmaxf(v0[j], 0.f), b = fmaxf(v1[j], 0.f); v0[j] = a * a; v1[j] = b * b; }
                    }
                    if (MODE == 3) {
                        const u32x4 gq = gpre[ai][m][bj];
                        v0[0] *= bf_lo(gq.x) * rs; v0[1] *= bf_hi(gq.x) * rs; v0[2] *= bf_lo(gq.y) * rs; v0[3] *= bf_hi(gq.y) * rs;
                        v1[0] *= bf_lo(gq.z) * rs; v1[1] *= bf_hi(gq.z) * rs; v1[2] *= bf_lo(gq.w) * rs; v1[3] *= bf_hi(gq.w) * rs;
                    }
                    u32x4 w; w.x = cvt_pk_bf16(v0[0], v0[1]); w.y = cvt_pk_bf16(v0[2], v0[3]); w.z = cvt_pk_bf16(v1[0], v1[1]); w.w = cvt_pk_bf16(v1[2], v1[3]);
                    *(u32x4*)(rowp + bj * HALF) = w;
                }
            }
    }
};
struct EpiGlu {
    static constexpr bool PERM = true, AFTER_DRAIN = false;
    bf16_t* O; int ldc; int ocol; const float* bias;
    __device__ __forceinline__ void operator()(const f32x4 (&acc)[2][2][4][2], const Unit& u, int wr, int wc, int fr, int fq) const {
        const int row0 = u.pm * BM + wr * 64 + fr, cc = u.pn * HALF + wc * 32 + 8 * fq;
        f32x4 bv[2][2];
#pragma unroll
        for (int bj = 0; bj < 2; ++bj)
#pragma unroll
            for (int n = 0; n < 2; ++n) bv[bj][n] = *(const f32x4*)(bias + bj * 512 + cc + 4 * n);
#pragma unroll
        for (int ai = 0; ai < 2; ++ai)
#pragma unroll
            for (int m = 0; m < 4; ++m) {
                bf16_t* rowp = O + (size_t)(row0 + ai * HALF + m * 16) * ldc + ocol + cc;
                f32x4 v0 = acc[ai][0][m][0] + bv[0][0], v1 = acc[ai][0][m][1] + bv[0][1];
                const f32x4 g0 = acc[ai][1][m][0] + bv[1][0], g1 = acc[ai][1][m][1] + bv[1][1];
#pragma unroll
                for (int j = 0; j < 4; ++j) { v0[j] *= sigmoidf_(g0[j]); v1[j] *= sigmoidf_(g1[j]); }
                u32x4 w; w.x = cvt_pk_bf16(v0[0], v0[1]); w.y = cvt_pk_bf16(v0[2], v0[3]); w.z = cvt_pk_bf16(v1[0], v1[1]); w.w = cvt_pk_bf16(v1[2], v1[3]);
                *(u32x4*)rowp = w;
            }
    }
};
struct EpiRes2 {
    static constexpr bool PERM = false, AFTER_DRAIN = false;
    const float* base_ctx; const float* base_lat; float* out; const float* modv; int goff;
    bf16_t* xn; const float* gnorm; int scoff; float* ssq;
    __device__ __forceinline__ void operator()(const f32x4 (&acc)[2][2][4][2], const Unit& u, int wr, int wc, int fr, int fq) const {
        const int row0 = u.pm * BM + wr * 64 + fr, col0 = u.pn * BM + wc * 32 + 4 * fq;
        const int mi = (u.pm < 32) ? 0 : 1 + ((u.pm - 32) >> 2);
        const float* gv = modv + (size_t)mi * 6144 + goff; const float* sv = modv + (size_t)mi * 6144 + scoff;
        f32x4 gg[2][2], gn[2][2];
#pragma unroll
        for (int bj = 0; bj < 2; ++bj)
#pragma unroll
            for (int n = 0; n < 2; ++n) { gg[bj][n] = *(const f32x4*)(gv + col0 + bj * HALF + n * 16); gn[bj][n] = *(const f32x4*)(gnorm + col0 + bj * HALF + n * 16) * (*(const f32x4*)(sv + col0 + bj * HALF + n * 16) + 1.0f); }
#pragma unroll
        for (int ai = 0; ai < 2; ++ai)
#pragma unroll
        for (int mh = 0; mh < 2; ++mh) {
            f32x4 pre[2][2][2];
#pragma unroll
            for (int mm = 0; mm < 2; ++mm) { const int row = row0 + ai * HALF + (2 * mh + mm) * 16;
                const float* bp = (row < 8192 ? base_ctx + (size_t)row * 1024 : base_lat + (size_t)(row - 8192) * 1024) + col0;
#pragma unroll
                for (int bj = 0; bj < 2; ++bj)
#pragma unroll
                    for (int n = 0; n < 2; ++n) pre[mm][bj][n] = *(const f32x4*)(bp + bj * HALF + n * 16); }
#pragma unroll
            for (int mm = 0; mm < 2; ++mm) { const int m = 2 * mh + mm; const int row = row0 + ai * HALF + m * 16; float* op = out + (size_t)row * 1024 + col0; bf16_t* xp = xn + (size_t)row * 1024 + col0;
                float q = 0.f;
#pragma unroll
                for (int bj = 0; bj < 2; ++bj)
#pragma unroll
                    for (int n = 0; n < 2; ++n) { const f32x4 x = pre[mm][bj][n] + gg[bj][n] * acc[ai][bj][m][n]; *(f32x4*)(op + bj * HALF + n * 16) = x;
                        q += (x[0] * x[0] + x[1] * x[1]) + (x[2] * x[2] + x[3] * x[3]);
                        const f32x4 y = x * gn[bj][n]; unsigned w0 = cvt_pk_bf16(y[0], y[1]), w1 = cvt_pk_bf16(y[2], y[3]);
                        typedef unsigned u32x2 __attribute__((ext_vector_type(2))); *(u32x2*)(xp + bj * HALF + n * 16) = (u32x2){w0, w1}; }
                q += __shfl_xor(q, 16); q += __shfl_xor(q, 32);
                if (fq == 0) atomicAdd(ssq + row, q); }
            asm volatile("" ::: "memory");
        }
    }
};
struct EpiMerge {
    static constexpr bool PERM = true, AFTER_DRAIN = false;
    const bf16_t* gates; bf16_t* mg; const float* ssq;
    __device__ __forceinline__ void operator()(const f32x4 (&acc)[2][2][4][2], const Unit& u, int wr, int wc, int fr, int fq) const {
        const int br = u.pn >> 2, pnl = u.pn & 3;
        int pm_o = u.pm; asm volatile("" : "+s"(pm_o));
        const int row0 = pm_o * BM + wr * 64 + fr, gcol0 = u.pn * BM + wc * 32 + 8 * fq, mcol0 = pnl * BM + wc * 32 + 8 * fq;
#pragma unroll
        for (int ai = 0; ai < 2; ++ai)
#pragma unroll
        for (int mh = 0; mh < 2; ++mh) {
            u32x4 gpre[2][2], mpre[2][2]; float rpre[2];
#pragma unroll
            for (int mm = 0; mm < 2; ++mm) { const int row = row0 + ai * HALF + (2 * mh + mm) * 16;
                rpre[mm] = (br == 0) ? ssq[row] : 512.0f;
#pragma unroll
                for (int bj = 0; bj < 2; ++bj) { gpre[mm][bj] = *(const u32x4*)(gates + (size_t)row * 4096 + gcol0 + bj * HALF);
                    mpre[mm][bj] = (br != 0) ? *(const u32x4*)(mg + (size_t)row * 1024 + mcol0 + bj * HALF) : (u32x4){0u, 0u, 0u, 0u}; } }
#pragma unroll
            for (int mm = 0; mm < 2; ++mm) { const int m = 2 * mh + mm; const int row = row0 + ai * HALF + m * 16;
                const float rs = (br == 0) ? rsqrtf(rpre[mm] * (1.0f / 512.0f) + 1e-6f) : 1.0f;
#pragma unroll
                for (int bj = 0; bj < 2; ++bj) { const u32x4 gq = gpre[mm][bj], mq = mpre[mm][bj]; const f32x4 a0 = acc[ai][bj][m][0], a1 = acc[ai][bj][m][1];
                    const float v0 = bf_lo(mq.x) + a0[0] * bf_lo(gq.x) * rs, v1 = bf_hi(mq.x) + a0[1] * bf_hi(gq.x) * rs, v2 = bf_lo(mq.y) + a0[2] * bf_lo(gq.y) * rs, v3 = bf_hi(mq.y) + a0[3] * bf_hi(gq.y) * rs;
                    const float v4 = bf_lo(mq.z) + a1[0] * bf_lo(gq.z) * rs, v5 = bf_hi(mq.z) + a1[1] * bf_hi(gq.z) * rs, v6 = bf_lo(mq.w) + a1[2] * bf_lo(gq.w) * rs, v7 = bf_hi(mq.w) + a1[3] * bf_hi(gq.w) * rs;
                    u32x4 w; w.x = cvt_pk_bf16(v0, v1); w.y = cvt_pk_bf16(v2, v3); w.z = cvt_pk_bf16(v4, v5); w.w = cvt_pk_bf16(v6, v7);
                    *(u32x4*)(mg + (size_t)row * 1024 + mcol0 + bj * HALF) = w; } }
            asm volatile("" ::: "memory");
        }
    }
};
struct BranchOrder {
    int G, c;
    __host__ __device__ void init(int G_, int c_) { G = G_; c = c_; }
    __host__ __device__ bool next(int i, Unit& u) const { if (c >= 192 || i >= 4) return false; u.pm = c >> 2; u.pn = i * 4 + (c & 3); return true; }
    __device__ __forceinline__ void a_ready(const Unit&) const {}
    __device__ __forceinline__ void done(const Unit&) const {}
};
struct EpiRes {
    static constexpr bool PERM = false, AFTER_DRAIN = false;
    const float* base_ctx; const float* base_lat;
    float* out; const float* modv;
    int goff;
    __device__ __forceinline__ void operator()(const f32x4 (&acc)[2][2][4][2], const Unit& u, int wr, int wc, int fr, int fq) const {
        const int row0 = u.pm * BM + wr * 64 + fr, col0 = u.pn * BM + wc * 32 + 4 * fq;
        const int mi = (u.pm < 32) ? 0 : 1 + ((u.pm - 32) >> 2);
        const float* gv = modv + (size_t)mi * 6144 + goff;
        f32x4 gg[2][2];
#pragma unroll
        for (int bj = 0; bj < 2; ++bj)
#pragma unroll
            for (int n = 0; n < 2; ++n) gg[bj][n] = *(const f32x4*)(gv + col0 + bj * HALF + n * 16);
#pragma unroll
        for (int ai = 0; ai < 2; ++ai) {
            f32x4 pre[4][2][2];
#pragma unroll
            for (int m = 0; m < 4; ++m) { const int row = row0 + ai * HALF + m * 16;
                const float* bp = (row < 8192 ? base_ctx + (size_t)row * 1024 : base_lat + (size_t)(row - 8192) * 1024) + col0;
#pragma unroll
                for (int bj = 0; bj < 2; ++bj)
#pragma unroll
                    for (int n = 0; n < 2; ++n) pre[m][bj][n] = *(const f32x4*)(bp + bj * HALF + n * 16); }
#pragma unroll
            for (int m = 0; m < 4; ++m) { const int row = row0 + ai * HALF + m * 16; float* op = out + (size_t)row * 1024 + col0;
#pragma unroll
                for (int bj = 0; bj < 2; ++bj)
#pragma unroll
                    for (int n = 0; n < 2; ++n) *(f32x4*)(op + bj * HALF + n * 16) = pre[m][bj][n] + gg[bj][n] * acc[ai][bj][m][n]; }
            asm volatile("" ::: "memory");
        }
    }
};

template <class Epi, class Sched, bool ALIGN_EPI = false, bool SP2 = false>
__device__ __forceinline__ void gemm_phase(PG8_LAS unsigned char* lds, const Gemm g, const Sched& S, const Epi& E, const int tid) {
    const int wid = __builtin_amdgcn_readfirstlane(tid >> 6), lane = tid & 63, wr = wid >> 2, wc = wid & 3, fr = lane & 15, fq = lane >> 4;
    const int K = g.K, nt = K / BK;
    unsigned voffA[2], voffB[2];
#pragma unroll
    for (int i = 0; i < 2; ++i) { int R, C; stage_rc(tid * 16 + i * 8192, R, C); const int Rb = Epi::PERM ? ((R & ~31) + perm32(R & 31)) : R;
        voffA[i] = (unsigned)(R * g.lda + C) * 2u; voffB[i] = (unsigned)(Rb * g.ldb + C) * 2u; }
    const size_t kstep = (size_t)(BK * 2);
    const size_t hstepA = (size_t)HALF * g.lda * 2, hstepB = (size_t)HALF * g.ldb * 2;
    const size_t tstepA = 2 * hstepA, tstepB = 2 * hstepB;
#define PG8_UA(u) ((const char*)g.A + (size_t)(u).pm * tstepA + (g.a_div ? (size_t)((u).pn / g.a_div) * g.a_gstride : (size_t)0))
#define PG8_UB(u) ((const char*)g.Bt + (size_t)(u).pn * tstepB)
    const unsigned ldsw = (unsigned)wid * 1024u;
    const int aoff = lds_byte(wr * 64 + fr, fq * 8), boff = lds_byte(wc * 32 + fr, fq * 8);
#define PG8_SA(b, h) (((b) * 2 + (h)) * HTB)
#define PG8_SB(b, h) ((4 + (b) * 2 + (h)) * HTB)
#define PG8_STAGE(bufoff, gbase, voff) do { _Pragma("unroll") for (int _i = 0; _i < 2; ++_i) \
        __builtin_amdgcn_global_load_lds((const unsigned*)((const char*)(gbase) + (voff)[_i]), (PG8_LAS unsigned*)(lds + (bufoff) + ldsw + _i * 8192), 16, 0, 0); } while (0)
#define PG8_LDA(dst, b, h) do { _Pragma("unroll") for (int m = 0; m < 4; ++m) _Pragma("unroll") for (int k = 0; k < 2; ++k) dst[m][k] = *(const PG8_LAS bf16x8*)(lds + PG8_SA(b, h) + aoff + m * 2048 + k * 1024); } while (0)
#define PG8_LDB(dst, b, h) do { _Pragma("unroll") for (int n = 0; n < 2; ++n) _Pragma("unroll") for (int k = 0; k < 2; ++k) dst[n][k] = *(const PG8_LAS bf16x8*)(lds + PG8_SB(b, h) + boff + n * 2048 + k * 1024); } while (0)
#define PG8_MMA(ai, bj, At, Bt) do { __builtin_amdgcn_s_setprio(1); _Pragma("unroll") for (int m = 0; m < 4; ++m) _Pragma("unroll") for (int n = 0; n < 2; ++n) _Pragma("unroll") for (int k = 0; k < 2; ++k) \
        acc[ai][bj][m][n] = __builtin_amdgcn_mfma_f32_16x16x32_bf16(Bt[n][k], At[m][k], acc[ai][bj][m][n], 0, 0, 0); __builtin_amdgcn_s_setprio(0); } while (0)
#define PG8_WAIT_V(n) asm volatile("s_waitcnt vmcnt(" #n ")" ::: "memory")
#define PG8_WAIT_L(n) asm volatile("s_waitcnt lgkmcnt(" #n ")" ::: "memory")
#define PG8_BAR __builtin_amdgcn_s_barrier()
#define PG8_SCHED __builtin_amdgcn_sched_barrier(0)
    Unit cur, nxt; int ui = 0;
    if (!S.next(0, cur)) return;
    f32x4 acc[2][2][4][2];
#pragma unroll
    for (int a = 0; a < 2; ++a)
#pragma unroll
        for (int b = 0; b < 2; ++b)
#pragma unroll
            for (int m = 0; m < 4; ++m)
#pragma unroll
                for (int n = 0; n < 2; ++n) acc[a][b][m][n] = (f32x4){0.f, 0.f, 0.f, 0.f};
    bf16x8 At[4][2], B0[2][2], B1[2][2];
    const char* cA = PG8_UA(cur); const char* cB = PG8_UB(cur);
    S.a_ready(cur);
    if constexpr (SP2) {
        PG8_STAGE(PG8_SB(0, 0), cB, voffB); PG8_STAGE(PG8_SB(0, 1), cB + hstepB, voffB); PG8_STAGE(PG8_SA(0, 0), cA, voffA); PG8_STAGE(PG8_SA(0, 1), cA + hstepA, voffA);
        if (wr == 1) PG8_BAR;
        PG8_WAIT_V(2); PG8_BAR;
        PG8_STAGE(PG8_SB(1, 0), cB + kstep, voffB); PG8_STAGE(PG8_SA(1, 0), cA + kstep, voffA); PG8_STAGE(PG8_SB(1, 1), cB + hstepB + kstep, voffB);
        PG8_WAIT_V(6); PG8_BAR;
    } else {
        PG8_STAGE(PG8_SB(0, 0), cB, voffB); PG8_STAGE(PG8_SA(0, 0), cA, voffA); PG8_STAGE(PG8_SB(0, 1), cB + hstepB, voffB); PG8_STAGE(PG8_SA(0, 1), cA + hstepA, voffA);
        if (wr == 1) PG8_BAR;
        PG8_WAIT_V(4); PG8_BAR;
        PG8_STAGE(PG8_SB(1, 0), cB + kstep, voffB); PG8_STAGE(PG8_SA(1, 0), cA + kstep, voffA); PG8_STAGE(PG8_SB(1, 1), cB + hstepB + kstep, voffB);
        PG8_WAIT_V(6); PG8_BAR;
    }
    for (;;) {
        const bool has_next = S.next(ui + 1, nxt);
        const char* nA = has_next ? PG8_UA(nxt) : cA; const char* nB = has_next ? PG8_UB(nxt) : cB;
        for (int t = 0; t < nt; t += 2) {
            const bool last = (t == nt - 2);
            const char* a1 = cA + (size_t)(t + 1) * kstep;
            const char* a2 = last ? nA : cA + (size_t)(t + 2) * kstep; const char* b2 = last ? nB : cB + (size_t)(t + 2) * kstep;
            const char* a3 = a2 + kstep; const char* b3 = b2 + kstep;
            if (last && has_next) S.a_ready(nxt);
            if constexpr (SP2) {
            PG8_LDB(B0, 0, 0); PG8_LDB(B1, 0, 1); PG8_SCHED; PG8_LDA(At, 0, 0); PG8_STAGE(PG8_SA(1, 1), a1 + hstepA, voffA);
            PG8_WAIT_V(8); PG8_WAIT_L(0); PG8_BAR; PG8_MMA(0, 0, At, B0); PG8_MMA(0, 1, At, B1); PG8_BAR; PG8_SCHED;
            PG8_LDA(At, 0, 1); PG8_STAGE(PG8_SB(0, 0), b2, voffB); PG8_STAGE(PG8_SB(0, 1), b2 + hstepB, voffB); PG8_STAGE(PG8_SA(0, 0), a2, voffA);
            PG8_WAIT_V(8); PG8_WAIT_L(0); PG8_BAR; PG8_MMA(1, 0, At, B0); PG8_MMA(1, 1, At, B1); PG8_BAR; PG8_SCHED;
            PG8_LDB(B0, 1, 0); PG8_LDB(B1, 1, 1); PG8_SCHED; PG8_LDA(At, 1, 0); PG8_STAGE(PG8_SA(0, 1), a2 + hstepA, voffA);
            PG8_WAIT_V(8); PG8_WAIT_L(0); PG8_BAR; PG8_MMA(0, 0, At, B0); PG8_MMA(0, 1, At, B1); PG8_BAR; PG8_SCHED;
            PG8_LDA(At, 1, 1); PG8_STAGE(PG8_SB(1, 0), b3, voffB); PG8_STAGE(PG8_SB(1, 1), b3 + hstepB, voffB); PG8_STAGE(PG8_SA(1, 0), a3, voffA);
            PG8_WAIT_V(8); PG8_WAIT_L(0); PG8_BAR; PG8_MMA(1, 0, At, B0); PG8_MMA(1, 1, At, B1); PG8_BAR; PG8_SCHED;
            } else {
            PG8_LDB(B0, 0, 0); PG8_SCHED; PG8_LDA(At, 0, 0); PG8_STAGE(PG8_SA(1, 1), a1 + hstepA, voffA);
            PG8_WAIT_L(8); PG8_BAR; PG8_WAIT_L(0); PG8_MMA(0, 0, At, B0); PG8_BAR; PG8_SCHED;
            PG8_LDB(B1, 0, 1); PG8_STAGE(PG8_SB(0, 0), b2, voffB);
            PG8_BAR; PG8_WAIT_L(0); PG8_MMA(0, 1, At, B1); PG8_BAR;
            PG8_LDA(At, 0, 1); PG8_STAGE(PG8_SA(0, 0), a2, voffA);
            PG8_BAR; PG8_WAIT_L(0); PG8_MMA(1, 0, At, B0); PG8_BAR; PG8_SCHED;
            PG8_STAGE(PG8_SB(0, 1), b2 + hstepB, voffB);
            PG8_WAIT_V(6); PG8_BAR; PG8_MMA(1, 1, At, B1); PG8_BAR;
            PG8_LDB(B0, 1, 0); PG8_SCHED; PG8_LDA(At, 1, 0); PG8_STAGE(PG8_SA(0, 1), a2 + hstepA, voffA);
            PG8_WAIT_L(8); PG8_BAR; PG8_WAIT_L(0); PG8_MMA(0, 0, At, B0); PG8_BAR; PG8_SCHED;
            PG8_LDB(B1, 1, 1); PG8_STAGE(PG8_SB(1, 0), b3, voffB);
            PG8_BAR; PG8_WAIT_L(0); PG8_MMA(0, 1, At, B1); PG8_BAR;
            PG8_LDA(At, 1, 1); PG8_STAGE(PG8_SA(1, 0), a3, voffA);
            PG8_BAR; PG8_WAIT_L(0); PG8_MMA(1, 0, At, B0); PG8_BAR; PG8_SCHED;
            PG8_STAGE(PG8_SB(1, 1), b3 + hstepB, voffB);
            PG8_WAIT_V(6); PG8_BAR; PG8_MMA(1, 1, At, B1); PG8_BAR;
            }
        }
        if constexpr (ALIGN_EPI) { if (wr == 0) PG8_BAR; }
        if constexpr (!Epi::AFTER_DRAIN) { E(acc, cur, wr, wc, fr, fq); S.done(cur); }
        if (!has_next) break;
#pragma unroll
        for (int a = 0; a < 2; ++a)
#pragma unroll
            for (int b = 0; b < 2; ++b)
#pragma unroll
                for (int m = 0; m < 4; ++m)
#pragma unroll
                    for (int n = 0; n < 2; ++n) acc[a][b][m][n] = (f32x4){0.f, 0.f, 0.f, 0.f};
        cur = nxt; cA = nA; cB = nB; ++ui;
        if constexpr (ALIGN_EPI) { if (wr == 1) PG8_BAR; }
    }
    PG8_WAIT_V(0);
    if constexpr (!ALIGN_EPI) { if (wr == 0) PG8_BAR; }
    PG8_BAR;
    if constexpr (Epi::AFTER_DRAIN) { E.fused(acc, cur, wr, wc, fr, fq, lds, wid, lane); S.done(cur); }
#undef PG8_UA
#undef PG8_UB
#undef PG8_SA
#undef PG8_SB
#undef PG8_STAGE
#undef PG8_LDA
#undef PG8_LDB
#undef PG8_MMA
#undef PG8_WAIT_V
#undef PG8_WAIT_L
#undef PG8_BAR
#undef PG8_SCHED
}
}

#ifndef PG8_SP2
#define PG8_SP2 true
#endif
#ifndef PG8_ALIGN
#define PG8_ALIGN true
#endif

typedef unsigned short bf16;
typedef unsigned v4u __attribute__((ext_vector_type(4)));
typedef unsigned v2u __attribute__((ext_vector_type(2)));
typedef float f32x4 __attribute__((ext_vector_type(4)));
#define LAS __attribute__((address_space(3)))

constexpr int NWAVES = 8, NTHR = 512;
constexpr int D = 1024, MC = 8192, ML = 4096, M = 12288, NPH = 23;
constexpr int LDS_BYTES = 147456;
constexpr float EPS = 1e-6f;
constexpr size_t MiB = 1u << 20;
constexpr size_t WS_MOD = 64 * 1024;
constexpr size_t WS_SSQ = 320 * 1024;
constexpr size_t WS_DT = 384 * 1024;
constexpr size_t WS_W = 2 * MiB;
constexpr size_t W_IN = WS_W, W_G = W_IN + 8 * MiB, W_GLU = W_G + 8 * MiB, W_BR = W_GLU + 1 * MiB, W_OUT = W_BR + 4 * MiB, W_1 = W_OUT + 2 * MiB, W_2 = W_1 + 8 * MiB;
constexpr size_t WS_H = 41 * MiB;
constexpr size_t WS_R1 = 65 * MiB;
constexpr size_t WS_Y = 161 * MiB;
constexpr size_t WS_Y5 = 209 * MiB;
constexpr size_t WS_XC = 221 * MiB;
constexpr size_t WS_S5K = 239 * MiB;
constexpr size_t WS_S5WS = 240 * MiB;
constexpr size_t WS_S5WO = 244 * MiB;
constexpr size_t WS_S5AT = 248 * MiB;
constexpr size_t WS_CKV = 251 * MiB;
constexpr size_t WS_ROPE = 1536 * 1024;
constexpr size_t WS_WDT = 1792 * 1024;
constexpr size_t WS_BI2 = 1824 * 1024;
constexpr size_t WS_SSQ2 = 1904 * 1024;
constexpr size_t WS_END = 254 * MiB;
#ifndef PROBE_SEL
#define PROBE_SEL -1
#endif
#ifndef PROBE_SCALE
#define PROBE_SCALE 4e-4f
#endif
#ifndef PROBE_PB
#define PROBE_PB 32
#endif
constexpr size_t WS_BAR = 32 * 1024;
constexpr size_t WS_QCTR = 48 * 1024;
constexpr size_t WS_TS = 16 * 1024;
constexpr size_t O_SSD = 12582912, O_S5 = 16777216, O_DK = 17301504, O_DV = 25690112, O_WK = 34078720, O_WV = 36175872;
constexpr int C_Z = 0, C_XBC = 512, C_U = 1280, C_DQ = 1792, C_DK = 2304, C_DV = 2816, C_WQ = 3328, C_WK = 3840, C_WV = 3968;

struct Args { const float* in[44]; float* out; unsigned char* ws; int ph_lo, ph_hi; };

typedef const Args __attribute__((address_space(4)))* CArgs;
struct Ctx {
    CArgs ap; int tid, lane, wave;
    __device__ __forceinline__ const float* x_prompt() const { return ap->in[0]; }
    __device__ __forceinline__ const float* x_sample() const { return ap->in[1]; }
    __device__ __forceinline__ const float* state_ssd() const { return ap->in[2]; }
    __device__ __forceinline__ const float* state_s5() const { return ap->in[3]; }
    __device__ __forceinline__ const float* cache_dk() const { return ap->in[4]; }
    __device__ __forceinline__ const float* cache_dv() const { return ap->in[5]; }
    __device__ __forceinline__ const float* cache_wk() const { return ap->in[6]; }
    __device__ __forceinline__ const float* cache_wv() const { return ap->in[7]; }
    __device__ __forceinline__ const float* cvec() const { return ap->in[8]; }
    __device__ __forceinline__ const float* c_ctx() const { return ap->in[9]; }
    __device__ __forceinline__ const float* w_mod() const { return ap->in[10]; }
    __device__ __forceinline__ const float* b_mod() const { return ap->in[11]; }
    __device__ __forceinline__ const float* g_norm1() const { return ap->in[12]; }
    __device__ __forceinline__ const float* g_norm2() const { return ap->in[13]; }
    __device__ __forceinline__ const float* w_in() const { return ap->in[14]; }
    __device__ __forceinline__ const float* conv_w() const { return ap->in[15]; }
    __device__ __forceinline__ const float* conv_b() const { return ap->in[16]; }
    __device__ __forceinline__ const float* dt_bias() const { return ap->in[17]; }
    __device__ __forceinline__ const float* a_log() const { return ap->in[18]; }
    __device__ __forceinline__ const float* ssd_d() const { return ap->in[19]; }
    __device__ __forceinline__ const float* ssd_norm_g() const { return ap->in[20]; }
    __device__ __forceinline__ const float* lam_re() const { return ap->in[21]; }
    __device__ __forceinline__ const float* lam_im() const { return ap->in[22]; }
    __device__ __forceinline__ const float* log_step() const { return ap->in[23]; }
    __device__ __forceinline__ const float* b_re() const { return ap->in[24]; }
    __device__ __forceinline__ const float* b_im() const { return ap->in[25]; }
    __device__ __forceinline__ const float* c_re() const { return ap->in[26]; }
    __device__ __forceinline__ const float* c_im() const { return ap->in[27]; }
    __device__ __forceinline__ const float* s5_d() const { return ap->in[28]; }
    __device__ __forceinline__ const float* w_glu() const { return ap->in[29]; }
    __device__ __forceinline__ const float* b_glu() const { return ap->in[30]; }
    __device__ __forceinline__ const float* qn_g() const { return ap->in[31]; }
    __device__ __forceinline__ const float* kn_g() const { return ap->in[32]; }
    __device__ __forceinline__ const float* dlam() const { return ap->in[33]; }
    __device__ __forceinline__ const float* subln_g() const { return ap->in[34]; }
    __device__ __forceinline__ const float* wqn_g() const { return ap->in[35]; }
    __device__ __forceinline__ const float* wkn_g() const { return ap->in[36]; }
    __device__ __forceinline__ const float* sink() const { return ap->in[37]; }
    __device__ __forceinline__ const float* w_branch() const { return ap->in[38]; }
    __device__ __forceinline__ const float* w_gate() const { return ap->in[39]; }
    __device__ __forceinline__ const float* b_gate() const { return ap->in[40]; }
    __device__ __forceinline__ const float* w_out() const { return ap->in[41]; }
    __device__ __forceinline__ const float* w_fc1() const { return ap->in[42]; }
    __device__ __forceinline__ const float* w_fc2() const { return ap->in[43]; }
    __device__ __forceinline__ float* out() const { return ap->out; }
    __device__ __forceinline__ unsigned char* ws() const { return ap->ws; }
    __device__ __forceinline__ float* MOD() const { return (float*)(ap->ws + WS_MOD); }
    __device__ __forceinline__ float* SSQ() const { return (float*)(ap->ws + WS_SSQ); }
    __device__ __forceinline__ float* DT() const { return (float*)(ap->ws + WS_DT); }
    __device__ __forceinline__ bf16* H() const { return (bf16*)(ap->ws + WS_H); }
    __device__ __forceinline__ bf16* R1() const { return (bf16*)(ap->ws + WS_R1); }
    __device__ __forceinline__ bf16* Y() const { return (bf16*)(ap->ws + WS_Y); }
    __device__ __forceinline__ bf16* Y5() const { return (bf16*)(ap->ws + WS_Y5); }
    __device__ __forceinline__ bf16* XC() const { return (bf16*)(ap->ws + WS_XC); }
    __device__ __forceinline__ bf16* CKV() const { return (bf16*)(ap->ws + WS_CKV); }
    __device__ __forceinline__ float* ROPE() const { return (float*)(ap->ws + WS_ROPE); }
};

__device__ __forceinline__ float wave_sum(float v) {
#pragma unroll
    for (int o = 1; o < 64; o <<= 1) v += __shfl_xor(v, o);
    return v;
}
__device__ __forceinline__ float wave_max(float v) {
#pragma unroll
    for (int o = 1; o < 64; o <<= 1) v = fmaxf(v, __shfl_xor(v, o));
    return v;
}
__device__ __forceinline__ float bf2f(bf16 h) { return __builtin_bit_cast(float, (unsigned)h << 16); }
__device__ __forceinline__ float bflo(unsigned w) { return __builtin_bit_cast(float, w << 16); }
__device__ __forceinline__ float bfhi(unsigned w) { return __builtin_bit_cast(float, w & 0xffff0000u); }
__device__ __forceinline__ unsigned f2bf(float f) { unsigned u = __builtin_bit_cast(unsigned, f); return (u + 0x7fffu + ((u >> 16) & 1u)) >> 16; }
__device__ __forceinline__ unsigned pk2(float lo, float hi) { return f2bf(lo) | (f2bf(hi) << 16); }
__device__ __forceinline__ float siluf(float x) { return x / (1.0f + __expf(-x)); }
__device__ __forceinline__ void unpack8(const v4u q, float (&f)[8]) { f[0] = bflo(q.x); f[1] = bfhi(q.x); f[2] = bflo(q.y); f[3] = bfhi(q.y); f[4] = bflo(q.z); f[5] = bfhi(q.z); f[6] = bflo(q.w); f[7] = bfhi(q.w); }

__device__ __forceinline__ void phase_mods(const Ctx& c, float* lf) {
    for (int i = c.tid; i < 5 * 1024; i += NTHR) { const int v = i >> 10, k = i & 1023; const float x = (v == 0) ? c.c_ctx()[k] : c.cvec()[(v - 1) * 1024 + k]; lf[i] = siluf(x); }
    __syncthreads();
    float* red = lf + 5 * 1024;
    for (int u = blockIdx.x; u < 192; u += gridDim.x) {
        const int l = u / 96, col0 = (u % 96) * 64;
        const float* W = c.w_mod() + (size_t)l * 1024 * 6144 + col0 + c.lane;
        float acc[5] = {0.f, 0.f, 0.f, 0.f, 0.f};
#pragma unroll 8
        for (int k = c.wave * 128; k < c.wave * 128 + 128; ++k) { const float wv = W[(size_t)k * 6144];
#pragma unroll
            for (int i = 0; i < 5; ++i) acc[i] += lf[i * 1024 + k] * wv; }
#pragma unroll
        for (int i = 0; i < 5; ++i) red[(c.wave * 5 + i) * 64 + c.lane] = acc[i];
        __syncthreads();
        if (c.tid < 320) { const int i = c.tid >> 6, ln = c.tid & 63; float s = c.b_mod()[l * 6144 + col0 + ln];
#pragma unroll
            for (int w = 0; w < 8; ++w) s += red[(w * 5 + i) * 64 + ln];
            c.MOD()[(size_t)(l * 5 + i) * 6144 + col0 + ln] = s; }
        __syncthreads();
    }
}

__device__ __forceinline__ int cmap(int mode, int n) { return mode == 0 ? n : (mode == 1 ? (n < 1280 ? n : n + 16) : ((n & 255) < 128 ? 128 * (n >> 8) + (n & 127) : 512 + 128 * (n >> 8) + (n & 127))); }
__device__ __forceinline__ void transpose_item(const float* W, int ld, int K, int N, int mode, const float* rowscale, bf16* WT, float* scr, int item, int lane) {
    const int nblk = N / 32, kb = item / nblk, nb = item % nblk, k0 = 64 * kb, n0 = 32 * nb, sc0 = cmap(mode, n0);
    float tv[32];
#pragma unroll
    for (int i = 0; i < 32; ++i) tv[i] = W[(size_t)(k0 + 2 * i + (lane >> 5)) * ld + sc0 + (lane & 31)];
    if (rowscale) {
#pragma unroll
        for (int i = 0; i < 32; ++i) tv[i] *= rowscale[k0 + 2 * i + (lane >> 5)]; }
#pragma unroll
    for (int i = 0; i < 32; ++i) scr[(2 * i + (lane >> 5)) * 33 + (lane & 31)] = tv[i];
    __builtin_amdgcn_fence(__ATOMIC_RELEASE, "wavefront"); __builtin_amdgcn_wave_barrier();
    const int ch = lane & 7;
#pragma unroll
    for (int j = 0; j < 4; ++j) { const int n = (lane >> 3) + 8 * j; const float* s = scr + (8 * ch) * 33 + n;
        v4u o; o.x = pk2(s[0 * 33], s[1 * 33]); o.y = pk2(s[2 * 33], s[3 * 33]); o.z = pk2(s[4 * 33], s[5 * 33]); o.w = pk2(s[6 * 33], s[7 * 33]);
        *(v4u*)(WT + (size_t)(n0 + n) * K + k0 + 8 * ch) = o; }
    __builtin_amdgcn_fence(__ATOMIC_RELEASE, "wavefront"); __builtin_amdgcn_wave_barrier();
}
__device__ __forceinline__ void s5_tables(const Ctx& c, int l, int g, int part, float* lf);
__device__ __forceinline__ void convert_items(const Ctx& c, int l, int lo, int hi, int gw0, int ngw, bool tabs, int tb0, int ntb, float* lf) {
    unsigned char* ws = c.ws();
    if (tabs) {
        for (int t = tb0; t < 128; t += ntb) s5_tables(c, l, t & 31, t >> 5, lf);
        for (int i = tb0 * NTHR + c.tid; i < 16384; i += ntb * NTHR) { const int j = i >> 10, k = i & 1023; ((bf16*)(ws + WS_WDT))[i] = (bf16)f2bf(c.w_in()[(size_t)l * 1024 * 4112 + (size_t)k * 4112 + 1280 + j]); }
    }
    float* scr = lf + c.wave * 2176;
    for (int it = lo + gw0; it < hi; it += ngw) {
        int r = it;
        if (r < 2048) { transpose_item(c.w_in() + (size_t)l * 1024 * 4112, 4112, 1024, 4096, 1, nullptr, (bf16*)(ws + W_IN), scr, r, c.lane); continue; } r -= 2048;
        if (r < 2048) { transpose_item(c.w_gate() + (size_t)l * 1024 * 4096, 4096, 1024, 4096, 0, nullptr, (bf16*)(ws + W_G), scr, r, c.lane); continue; } r -= 2048;
        if (r < 256) { transpose_item(c.w_glu() + (size_t)l * 512 * 1024, 1024, 512, 1024, 2, nullptr, (bf16*)(ws + W_GLU), scr, r, c.lane); continue; } r -= 256;
        if (r < 1024) { const int i = r >> 8; transpose_item(c.w_branch() + (size_t)(l * 4 + i) * 512 * 1024, 1024, 512, 1024, 0, i == 0 ? c.ssd_norm_g() + l * 512 : nullptr, (bf16*)(ws + W_BR) + (size_t)i * 1024 * 512, scr, r & 255, c.lane); continue; } r -= 1024;
        if (r < 512) { transpose_item(c.w_out() + (size_t)l * 1024 * 1024, 1024, 1024, 1024, 0, nullptr, (bf16*)(ws + W_OUT), scr, r, c.lane); continue; } r -= 512;
        if (r < 2048) { transpose_item(c.w_fc1() + (size_t)l * 1024 * 4096, 4096, 1024, 4096, 0, nullptr, (bf16*)(ws + W_1), scr, r, c.lane); continue; } r -= 2048;
        transpose_item(c.w_fc2() + (size_t)l * 4096 * 1024, 1024, 4096, 1024, 0, nullptr, (bf16*)(ws + W_2), scr, r, c.lane);
    }
}
__device__ __forceinline__ void phase_convert(const Ctx& c, int l, float* lf) {
    convert_items(c, l, 0, 9984, blockIdx.x * NWAVES + c.wave, gridDim.x * NWAVES, true, blockIdx.x, gridDim.x, lf);
}
__device__ __forceinline__ void side_convert(const Ctx& c, int lo, int hi, bool tabs, float* lf) {
    if (blockIdx.x < 192 || gridDim.x != 256) return;
    convert_items(c, 1, lo, hi, (blockIdx.x - 192) * NWAVES + c.wave, 64 * NWAVES, tabs, blockIdx.x - 192, 64, lf);
}

__device__ __forceinline__ void phase_norm(const Ctx& c, int l, int which, float* lf) {
    const int gw = blockIdx.x * NWAVES + c.wave, NGW = gridDim.x * NWAVES;
    const float* gn = (which == 0 ? c.g_norm1() : c.g_norm2()) + l * 1024;
    for (int m = gw; m < M; m += NGW) {
        const float* xr = (l == 0 && which == 0) ? (m < MC ? c.x_prompt() + (size_t)m * D : c.x_sample() + (size_t)(m - MC) * D) : c.out() + (size_t)m * D;
        const int mi = (m < MC) ? 0 : 1 + ((m - MC) >> 10);
        const float* mod = c.MOD() + (size_t)(l * 5 + mi) * 6144 + which * 3072;
        f32x4 v[4]; float s = 0.f;
#pragma unroll
        for (int j = 0; j < 4; ++j) { v[j] = *(const f32x4*)(xr + 4 * c.lane + 256 * j); s += (v[j].x * v[j].x + v[j].y * v[j].y) + (v[j].z * v[j].z + v[j].w * v[j].w); }
        const float rstd = rsqrtf(wave_sum(s) * (1.0f / D) + EPS);
#pragma unroll
        for (int j = 0; j < 4; ++j) { const int k = 4 * c.lane + 256 * j; const f32x4 g = *(const f32x4*)(gn + k), sh = *(const f32x4*)(mod + k), sc = *(const f32x4*)(mod + 1024 + k);
            v[j] = v[j] * rstd * g * (sc + 1.0f) + sh;
            v2u o; o.x = pk2(v[j].x, v[j].y); o.y = pk2(v[j].z, v[j].w); *(v2u*)(c.H() + (size_t)m * D + k) = o; }
        if (which == 0) {
            if (c.lane == 0) { c.SSQ()[m] = 0.f; ((float*)(c.ws() + WS_SSQ2))[m] = 0.f; }
        }
    }
}

__device__ __forceinline__ void phase_bias2(const Ctx& c, int l) {
    const int gw = blockIdx.x * NWAVES + c.wave, NGW = gridDim.x * NWAVES, lane = c.lane;
    const bf16* W1t = (const bf16*)(c.ws() + W_1); float* bi = (float*)(c.ws() + WS_BI2);
    for (int n = gw; n < 4096; n += NGW) {
        float wf[16]; { float t8[8]; unpack8(*(const v4u*)(W1t + (size_t)n * 1024 + 8 * lane), t8);
#pragma unroll
            for (int j = 0; j < 8; ++j) wf[j] = t8[j];
            unpack8(*(const v4u*)(W1t + (size_t)n * 1024 + 512 + 8 * lane), t8);
#pragma unroll
            for (int j = 0; j < 8; ++j) wf[8 + j] = t8[j]; }
#pragma unroll 1
        for (int mi = 0; mi < 5; ++mi) { const float* sh = c.MOD() + (size_t)(l * 5 + mi) * 6144 + 3072; float a = 0.f;
#pragma unroll
            for (int hh = 0; hh < 2; ++hh) { const f32x4 s0 = *(const f32x4*)(sh + 512 * hh + 8 * lane), s1 = *(const f32x4*)(sh + 512 * hh + 8 * lane + 4);
                a += (wf[8 * hh + 0] * s0.x + wf[8 * hh + 1] * s0.y) + (wf[8 * hh + 2] * s0.z + wf[8 * hh + 3] * s0.w) + (wf[8 * hh + 4] * s1.x + wf[8 * hh + 5] * s1.y) + (wf[8 * hh + 6] * s1.z + wf[8 * hh + 7] * s1.w); }
            a = wave_sum(a); if (lane == 0) bi[mi * 4096 + n] = a; }
    }
}

__device__ __forceinline__ void phase_dt(const Ctx& c, int l) {
    if (c.wave >= 3) return;
    const int tile = blockIdx.x * 3 + c.wave; if (tile >= 768) return;
    const int lr = c.lane & 15, lq = c.lane >> 4;
    const bf16* ap = c.H() + (size_t)(16 * tile + lr) * 1024 + 8 * lq; const bf16* bp = (const bf16*)(c.ws() + WS_WDT) + (size_t)lr * 1024 + 8 * lq;
    f32x4 acc = {0.f, 0.f, 0.f, 0.f};
#pragma unroll 8
    for (int ks = 0; ks < 32; ++ks) acc = __builtin_amdgcn_mfma_f32_16x16x32_bf16(*(const pg8::bf16x8*)(ap + 32 * ks), *(const pg8::bf16x8*)(bp + 32 * ks), acc, 0, 0, 0);
    const float bias = c.dt_bias()[l * 16 + lr];
#pragma unroll
    for (int r = 0; r < 4; ++r) { const float x = acc[r] + bias; c.DT()[(size_t)(16 * tile + 4 * lq + r) * 16 + lr] = x > 20.f ? x : log1pf(__expf(x)); }
}

__device__ __forceinline__ void phase_rope_table(const Ctx& c) {
    const int gt = blockIdx.x * NTHR + c.tid;
    if (gt < 32768) { const int pos = gt >> 5, a = gt & 31, f = a & 15; const float inv = exp2f(-(float)f * 0.8304820237218406f);
        const float ang = (float)((a >> 4) ? (pos & 63) : (pos >> 6)) * inv; float sn, cs; sincosf(ang, &sn, &cs); c.ROPE()[pos * 64 + a] = cs; c.ROPE()[pos * 64 + 32 + a] = sn; }
}
__device__ __forceinline__ void phase_qk(const Ctx& c, int l, float* lf) {
    const int gw = blockIdx.x * NWAVES + c.wave, NGW = gridDim.x * NWAVES, lane = c.lane, l16 = lane & 15, grp = lane >> 4;
    for (int i = c.tid; i < 7 * 768; i += NTHR) lf[i] = c.conv_w()[(size_t)l * 7 * 768 + i];
    for (int i = c.tid; i < 768; i += NTHR) lf[7 * 768 + i] = c.conv_b()[l * 768 + i];
    __syncthreads();
    const f32x4 gq = *(const f32x4*)(c.qn_g() + l * 64 + 4 * l16), gk = *(const f32x4*)(c.kn_g() + l * 64 + 4 * l16), gwq = *(const f32x4*)(c.wqn_g() + l * 64 + 4 * l16), gwk = *(const f32x4*)(c.wkn_g() + l * 64 + 4 * l16);
    bf16* R1p = c.R1(); float* outp = c.out(); bf16* XCp = c.XC();
    for (int m = gw; m < M; m += NGW) {
        bf16* pr = R1p + (size_t)m * 4096;
        const bool lat = m >= MC;
        const int b = lat ? (m - MC) >> 10 : m >> 8, t = lat ? (m - MC) & 1023 : m & 255, L = lat ? 1024 : 256;
        const size_t ob = (size_t)(b * 2 + l) * 256 + t;
        f32x4 cs = {1.f, 1.f, 1.f, 1.f}, sn = {0.f, 0.f, 0.f, 0.f};
        if (lat) { const float* rp = c.ROPE() + t * 64 + (l16 >> 3) * 16 + 4 * (l16 & 3); cs = *(const f32x4*)rp; sn = *(const f32x4*)(rp + 32); if (!((l16 >> 2) & 1)) sn = -sn; }
        v2u raw[7];
#pragma unroll
        for (int ps = 0; ps < 7; ++ps) { const int gi = 4 * ps + grp; const int col = gi < 8 ? C_DQ + gi * 64 : gi < 16 ? C_DK + (gi - 8) * 64 : gi < 24 ? C_WQ + (gi - 16) * 64 : C_WK + (gi - 24) * 64;
            raw[ps] = (gi < 26) ? *(const v2u*)(pr + col + 4 * l16) : (v2u){0u, 0u}; }
        v2u cp[3];
        if (!lat) {
#pragma unroll
            for (int ps = 0; ps < 3; ++ps) { const int gi = 4 * ps + grp; const int col = gi < 8 ? C_DV + gi * 64 : C_WV + (gi - 8) * 64; cp[ps] = (gi < 10) ? *(const v2u*)(pr + col + 4 * l16) : (v2u){0u, 0u}; }
        }
        v2u cx[3][7];
#pragma unroll
        for (int i = 0; i < 3; ++i)
#pragma unroll
            for (int j = 0; j < 7; ++j) { const int tt = t + j - 3; cx[i][j] = (tt >= 0 && tt < L) ? *(const v2u*)(R1p + (size_t)(m + j - 3) * 4096 + C_XBC + 4 * lane + 256 * i) : (v2u){0u, 0u}; }
#pragma unroll
        for (int ps = 0; ps < 7; ++ps) { const int gi = 4 * ps + grp;
            const f32x4 gain = gi < 8 ? gq : gi < 16 ? gk : gi < 24 ? gwq : gwk;
            f32x4 v = {bflo(raw[ps].x), bfhi(raw[ps].x), bflo(raw[ps].y), bfhi(raw[ps].y)};
            float ss = (v.x * v.x + v.y * v.y) + (v.z * v.z + v.w * v.w);
            ss += __shfl_xor(ss, 1); ss += __shfl_xor(ss, 2); ss += __shfl_xor(ss, 4); ss += __shfl_xor(ss, 8);
            v = v * rsqrtf(ss * (1.0f / 64.0f) + EPS) * gain;
            if (lat) { f32x4 p; p.x = __shfl_xor(v.x, 4); p.y = __shfl_xor(v.y, 4); p.z = __shfl_xor(v.z, 4); p.w = __shfl_xor(v.w, 4); v = v * cs + p * sn; }
            if (gi < 26) {
                const int col = gi < 8 ? C_DQ + gi * 64 : gi < 16 ? C_DK + (gi - 8) * 64 : gi < 24 ? C_WQ + (gi - 16) * 64 : C_WK + (gi - 24) * 64;
                v2u o; o.x = pk2(v.x, v.y); o.y = pk2(v.z, v.w); *(v2u*)(pr + col + 4 * l16) = o;
                if (!lat) { if (gi >= 8 && gi < 16) *(f32x4*)(outp + O_DK + ob * 512 + (gi - 8) * 64 + 4 * l16) = v; if (gi >= 24) *(f32x4*)(outp + O_WK + ob * 128 + (gi - 24) * 64 + 4 * l16) = v; }
            }
        }
        if (!lat) {
#pragma unroll
            for (int ps = 0; ps < 3; ++ps) { const int gi = 4 * ps + grp; const f32x4 v = {bflo(cp[ps].x), bfhi(cp[ps].x), bflo(cp[ps].y), bfhi(cp[ps].y)};
                if (gi < 8) *(f32x4*)(outp + O_DV + ob * 512 + gi * 64 + 4 * l16) = v; else if (gi < 10) *(f32x4*)(outp + O_WV + ob * 128 + (gi - 8) * 64 + 4 * l16) = v; }
        }
#pragma unroll
        for (int i = 0; i < 3; ++i) { const int ch = 4 * lane + 256 * i; f32x4 a = *(const f32x4*)(lf + 7 * 768 + ch);
#pragma unroll
            for (int j = 0; j < 7; ++j) { const f32x4 wv = *(const f32x4*)(lf + j * 768 + ch); const f32x4 xv = {bflo(cx[i][j].x), bfhi(cx[i][j].x), bflo(cx[i][j].y), bfhi(cx[i][j].y)}; a += wv * xv; }
            v2u o; o.x = pk2(siluf(a.x), siluf(a.y)); o.y = pk2(siluf(a.z), siluf(a.w)); *(v2u*)(XCp + (size_t)m * 768 + ch) = o; }
    }
    for (int r = gw; r < 1024; r += NGW) { const int b = r >> 8, sidx = r & 255; const size_t cb = (size_t)(b * 2 + l) * 256 + sidx; bf16* dst = c.CKV() + (size_t)r * 1280;
        for (int i = lane; i < 1280; i += 64) { const float v = i < 512 ? c.cache_dk()[cb * 512 + i] : i < 1024 ? c.cache_dv()[cb * 512 + i - 512] : i < 1152 ? c.cache_wk()[cb * 128 + i - 1024] : c.cache_wv()[cb * 128 + i - 1152]; dst[i] = (bf16)f2bf(v); } }
}

typedef pg8::bf16x8 bx8;
#define LDS_BARRIER() do { asm volatile("s_waitcnt lgkmcnt(0)" ::: "memory"); __builtin_amdgcn_s_barrier(); asm volatile("" ::: "memory"); } while (0)
#define MFMA16(a, b, cc) __builtin_amdgcn_mfma_f32_16x16x32_bf16((a), (b), (cc), 0, 0, 0)
__device__ __forceinline__ void ssd_unit(const Ctx& c, int l, int pass, int b, int h, unsigned char* lds) {
    const int L = pass ? 1024 : 256, tok0 = pass ? MC + b * 1024 : b * 256, NCH = L >> 7;
    const int tid = c.tid, lane = c.lane, w = c.wave, lr = lane & 15, lq = lane >> 4, grp = h >> 2;
    bf16* XT = (bf16*)lds;
    bf16* BwT = XT + 64 * 136;
    bf16* Bm = BwT + 64 * 136;
    bf16* Cm = Bm + 128 * 72;
    bf16* Mm = Cm + 128 * 72;
    bf16* ST = Mm + 128 * 136;
    float* cum = (float*)(ST + 64 * 72);
    float* dtv = cum + 128; float* wv = dtv + 128; float* ecum = wv + 128; float* tot = ecum + 128;
    const float dsk = c.ssd_d()[l * 8 + h];
    const bf16* XCp = c.XC(); const float* DTp = c.DT(); bf16* Yp = c.Y(); const bf16* R1p = c.R1(); float* SSQp = c.SSQ();
    const int pi = w >> 1, nj0 = 2 * (w & 1);
    const int i = tid >> 2, part = tid & 3;
    for (int dir = 0; dir < 2; ++dir) {
        const float A = -__expf(c.a_log()[(l * 2 + dir) * 8 + h]);
        f32x4 Sacc[2];
        __syncthreads();
#pragma unroll
        for (int q = 0; q < 2; ++q)
#pragma unroll
            for (int r = 0; r < 4; ++r) { const int p = 16 * pi + 4 * lq + r, n = 16 * (nj0 + q) + lr;
                const float v = pass ? c.state_ssd()[(((((size_t)(b * 2 + l) * 2 + dir) * 8 + h) * 64 + p) * 64) + n] : 0.f;
                Sacc[q][r] = v; ST[p * 72 + n] = (bf16)f2bf(v); }
        v4u x0, x1, b0, b1, c0, c1; float d0 = 0.f, d1 = 0.f;
#define SSD_LOAD(ci_) { const int t_ = dir ? L - 1 - ((ci_) * 128 + i) : (ci_) * 128 + i; const bf16* xr_ = XCp + (size_t)(tok0 + t_) * 768; \
            x0 = *(const v4u*)(xr_ + h * 64 + part * 16); x1 = *(const v4u*)(xr_ + h * 64 + part * 16 + 8); \
            b0 = *(const v4u*)(xr_ + 512 + grp * 64 + part * 16); b1 = *(const v4u*)(xr_ + 512 + grp * 64 + part * 16 + 8); \
            c0 = *(const v4u*)(xr_ + 640 + grp * 64 + part * 16); c1 = *(const v4u*)(xr_ + 640 + grp * 64 + part * 16 + 8); \
            if (tid < 64) { const int i0_ = 2 * lane, ta_ = dir ? L - 1 - ((ci_) * 128 + i0_) : (ci_) * 128 + i0_, tb_ = dir ? ta_ - 1 : ta_ + 1; \
                d0 = DTp[(size_t)(tok0 + ta_) * 16 + dir * 8 + h]; d1 = DTp[(size_t)(tok0 + tb_) * 16 + dir * 8 + h]; } }
        SSD_LOAD(0);
        for (int ci = 0; ci < NCH; ++ci) {
            LDS_BARRIER();
            float bvals[16];
            { *(v4u*)(Bm + i * 72 + part * 16) = b0; *(v4u*)(Bm + i * 72 + part * 16 + 8) = b1;
              *(v4u*)(Cm + i * 72 + part * 16) = c0; *(v4u*)(Cm + i * 72 + part * 16 + 8) = c1;
              const unsigned xs[8] = {x0.x, x0.y, x0.z, x0.w, x1.x, x1.y, x1.z, x1.w};
#pragma unroll
              for (int j = 0; j < 8; ++j) { XT[(part * 16 + 2 * j) * 136 + i] = (bf16)(xs[j] & 0xffffu); XT[(part * 16 + 2 * j + 1) * 136 + i] = (bf16)(xs[j] >> 16); }
              float t8[8]; unpack8(b0, t8);
#pragma unroll
              for (int j = 0; j < 8; ++j) bvals[j] = t8[j];
              unpack8(b1, t8);
#pragma unroll
              for (int j = 0; j < 8; ++j) bvals[8 + j] = t8[j]; }
            if (tid < 64) {
                const int i0 = 2 * lane, i1 = i0 + 1;
                const float a0 = d0 * A, a1 = d1 * A; float s = a0 + a1;
#pragma unroll
                for (int o = 1; o < 64; o <<= 1) { const float v = __shfl_up(s, o); if (lane >= o) s += v; }
                const float cum1 = s, cum0 = s - a1, total = __shfl(s, 63);
                cum[i0] = cum0; cum[i1] = cum1; dtv[i0] = d0; dtv[i1] = d1;
                wv[i0] = __expf(total - cum0) * d0; wv[i1] = __expf(total - cum1) * d1; ecum[i0] = __expf(cum0); ecum[i1] = __expf(cum1);
                if (lane == 0) tot[0] = __expf(total);
            }
            if (ci + 1 < NCH) SSD_LOAD(ci + 1);
            unsigned short zz[16], yy[16];
            if (dir == 1) {
#pragma unroll
                for (int r = 0; r < 4; ++r) { const int tt = 16 * w + 4 * lq + r; const size_t m = (size_t)tok0 + (L - 1 - (ci * 128 + tt));
#pragma unroll
                    for (int jp = 0; jp < 4; ++jp) { zz[4 * r + jp] = R1p[m * 4096 + C_Z + h * 64 + 16 * jp + lr]; yy[4 * r + jp] = Yp[m * 2048 + h * 64 + 16 * jp + lr]; } }
            }
            LDS_BARRIER();
            { const float wi = wv[i];
#pragma unroll
              for (int j = 0; j < 16; ++j) BwT[(part * 16 + j) * 136 + i] = (bf16)f2bf(bvals[j] * wi); }
            bx8 cfr[2];
#pragma unroll
            for (int ks = 0; ks < 2; ++ks) cfr[ks] = *(const bx8*)(Cm + (16 * w + lr) * 72 + 32 * ks + 8 * lq);
            for (int j = 0; j <= w; ++j) {
                const bx8 bb0 = *(const bx8*)(Bm + (16 * j + lr) * 72 + 8 * lq), bb1 = *(const bx8*)(Bm + (16 * j + lr) * 72 + 32 + 8 * lq);
                f32x4 g = {0.f, 0.f, 0.f, 0.f};
                g = MFMA16(cfr[0], bb0, g); g = MFMA16(cfr[1], bb1, g);
                const int s = 16 * j + lr; const float cs = cum[s], ds = dtv[s];
#pragma unroll
                for (int r = 0; r < 4; ++r) { const int tt = 16 * w + 4 * lq + r; const float v = (s <= tt) ? g[r] * __expf(cum[tt] - cs) * ds : 0.f; Mm[tt * 136 + s] = (bf16)f2bf(v); }
            }
            if (!(w & 1)) {
#pragma unroll
                for (int r = 0; r < 4; ++r) Mm[(16 * w + 4 * lq + r) * 136 + 16 * (w + 1) + lr] = 0;
            }
            LDS_BARRIER();
            f32x4 yl[4], yo[4];
#pragma unroll
            for (int jp = 0; jp < 4; ++jp) { yl[jp] = (f32x4){0.f, 0.f, 0.f, 0.f}; yo[jp] = (f32x4){0.f, 0.f, 0.f, 0.f}; }
            for (int ks = 0; ks <= (w >> 1); ++ks) {
                const bx8 af = *(const bx8*)(Mm + (16 * w + lr) * 136 + 32 * ks + 8 * lq);
#pragma unroll
                for (int jp = 0; jp < 4; ++jp) { const bx8 xf = *(const bx8*)(XT + (16 * jp + lr) * 136 + 32 * ks + 8 * lq); yl[jp] = MFMA16(af, xf, yl[jp]); }
            }
#pragma unroll
            for (int ks = 0; ks < 2; ++ks)
#pragma unroll
                for (int jp = 0; jp < 4; ++jp) { const bx8 sf = *(const bx8*)(ST + (16 * jp + lr) * 72 + 32 * ks + 8 * lq); yo[jp] = MFMA16(cfr[ks], sf, yo[jp]); }
            {
#pragma unroll
                for (int r = 0; r < 4; ++r) {
                    const int tt = 16 * w + 4 * lq + r; const float ec = ecum[tt];
                    const int t = dir ? L - 1 - (ci * 128 + tt) : ci * 128 + tt; const size_t m = (size_t)tok0 + t;
                    float q = 0.f;
#pragma unroll
                    for (int jp = 0; jp < 4; ++jp) {
                        const int p = 16 * jp + lr; const float y = yl[jp][r] + ec * yo[jp][r];
                        if (dir == 0) Yp[m * 2048 + h * 64 + p] = (bf16)f2bf(y);
                        else { const float x = bf2f(XT[p * 136 + tt]); const float ytot = y + bf2f(yy[4 * r + jp]) + dsk * x; const float z = bf2f(zz[4 * r + jp]);
                            const float gt = ytot * siluf(z); Yp[m * 2048 + h * 64 + p] = (bf16)f2bf(gt); q += gt * gt; }
                    }
                    if (dir == 1) { q += __shfl_xor(q, 1); q += __shfl_xor(q, 2); q += __shfl_xor(q, 4); q += __shfl_xor(q, 8); if (lr == 0) atomicAdd(SSQp + m, q); }
                }
            }
            LDS_BARRIER();
            {
                f32x4 st[2] = {{0.f, 0.f, 0.f, 0.f}, {0.f, 0.f, 0.f, 0.f}};
#pragma unroll
                for (int ks = 0; ks < 4; ++ks) { const bx8 af = *(const bx8*)(XT + (16 * pi + lr) * 136 + 32 * ks + 8 * lq);
#pragma unroll
                    for (int q = 0; q < 2; ++q) { const bx8 bf = *(const bx8*)(BwT + (16 * (nj0 + q) + lr) * 136 + 32 * ks + 8 * lq); st[q] = MFMA16(af, bf, st[q]); } }
                const float et = tot[0];
#pragma unroll
                for (int q = 0; q < 2; ++q)
#pragma unroll
                    for (int r = 0; r < 4; ++r) { Sacc[q][r] = et * Sacc[q][r] + st[q][r]; ST[(16 * pi + 4 * lq + r) * 72 + 16 * (nj0 + q) + lr] = (bf16)f2bf(Sacc[q][r]); }
            }
        }
#undef SSD_LOAD
        if (!pass) {
#pragma unroll
            for (int q = 0; q < 2; ++q)
#pragma unroll
                for (int r = 0; r < 4; ++r) { const int p = 16 * pi + 4 * lq + r, n = 16 * (nj0 + q) + lr;
                    c.out()[O_SSD + (((((size_t)(b * 2 + l) * 2 + dir) * 8 + h) * 64 + p) * 64) + n] = Sacc[q][r]; }
        }
    }
}

__device__ __forceinline__ void s5_tables(const Ctx& c, int l, int g, int part, float* lf) {
    const int tid = c.tid;
    float* pw = lf;
    float* Bc = pw + 2 * 17 * 128;
    float* Cc = Bc + 2 * 2048;
    if (tid < 128) { const int dir = tid >> 6, n = tid & 63, idx = ((l * 2 + dir) * 32 + g) * 64 + n;
        const float lre = c.lam_re()[idx], lim = c.lam_im()[idx], step = expf(c.log_step()[(l * 2 + dir) * 32 + g]);
        for (int k = 0; k <= 16; ++k) { const float mag = expf(lre * step * (float)k); float sn, cs; sincosf(lim * step * (float)k, &sn, &cs); pw[((dir * 17 + k) * 64 + n) * 2] = mag * cs; pw[((dir * 17 + k) * 64 + n) * 2 + 1] = mag * sn; }
        const float mag = expf(lre * step); float sn, cs; sincosf(lim * step, &sn, &cs); const float are = mag * cs, aim = mag * sn;
        const float den = lre * lre + lim * lim, cre = ((are - 1.0f) * lre + aim * lim) / den, cim = (aim * lre - (are - 1.0f) * lim) / den;
        for (int mm = 0; mm < 16; ++mm) { const float br = c.b_re()[(size_t)idx * 16 + mm], bi = c.b_im()[(size_t)idx * 16 + mm]; Bc[((dir * 64 + n) * 16 + mm) * 2] = cre * br - cim * bi; Bc[((dir * 64 + n) * 16 + mm) * 2 + 1] = cre * bi + cim * br; }
    }
    for (int i = tid; i < 2048; i += NTHR) { const int dir = i >> 10, mm = (i >> 6) & 15, n = i & 63; const size_t src = ((size_t)((l * 2 + dir) * 32 + g) * 16 + mm) * 64 + n;
        Cc[i * 2] = c.c_re()[src]; Cc[i * 2 + 1] = c.c_im()[src]; }
    __syncthreads();
    if (part == 0 && tid < 128) { const int dir = tid >> 6, n = tid & 63; float* at = (float*)(c.ws() + WS_S5AT) + ((size_t)(dir * 32 + g) * 64 + n) * 2; at[0] = pw[((dir * 17 + 16) * 64 + n) * 2]; at[1] = pw[((dir * 17 + 16) * 64 + n) * 2 + 1]; }
    bf16* Kt = (bf16*)(c.ws() + WS_S5K) + (size_t)g * 31 * 256;
    for (int e = part * 1984 + tid; e < (part + 1) * 1984; e += NTHR) { const int tp = e >> 8, mm = (e >> 4) & 15, m2 = e & 15, tau = tp - 15; float acc = 0.f;
#pragma unroll
        for (int dir = 0; dir < 2; ++dir) { if ((dir == 0 && tau < 0) || (dir == 1 && tau > 0)) continue; const int k = tau < 0 ? -tau : tau;
            const float* pp = pw + (dir * 17 + k) * 128; const float* bb = Bc + dir * 2048 + m2 * 2; const float* cc = Cc + (dir * 16 + mm) * 128;
            for (int n = 0; n < 64; ++n) { const float pr = pp[2 * n], pi = pp[2 * n + 1], br = bb[n * 32], bi = bb[n * 32 + 1], Pr = pr * br - pi * bi, Pi = pr * bi + pi * br; acc += cc[2 * n] * Pr - cc[2 * n + 1] * Pi; } }
        if (tau == 0 && mm == m2) acc += c.s5_d()[l * 512 + g * 16 + mm];
        Kt[e] = (bf16)f2bf(acc); }
    for (int e = part * 16384 + tid; e < (part + 1) * 16384; e += NTHR) { const int dir = e >> 15, sidx = (e >> 8) & 127, k = e & 255, ri = sidx >> 6, n = sidx & 63, j = k >> 4, m2 = k & 15, ex = dir ? j : 15 - j;
        const float pr = pw[((dir * 17 + ex) * 64 + n) * 2], pi = pw[((dir * 17 + ex) * 64 + n) * 2 + 1], br = Bc[((dir * 64 + n) * 16 + m2) * 2], bi = Bc[((dir * 64 + n) * 16 + m2) * 2 + 1];
        ((bf16*)(c.ws() + WS_S5WS))[((size_t)(dir * 32 + g) * 128 + sidx) * 256 + k] = (bf16)f2bf(ri ? pr * bi + pi * br : pr * br - pi * bi); }
    for (int e = part * 16384 + tid; e < (part + 1) * 16384; e += NTHR) { const int row = e >> 8, k = e & 255, i = row >> 4, mm = row & 15, dir = k >> 7, ri = (k >> 6) & 1, n = k & 63, ex = dir ? 16 - i : i + 1;
        const float pr = pw[((dir * 17 + ex) * 64 + n) * 2], pi = pw[((dir * 17 + ex) * 64 + n) * 2 + 1], cr = Cc[((dir * 16 + mm) * 64 + n) * 2], ci = Cc[((dir * 16 + mm) * 64 + n) * 2 + 1];
        ((bf16*)(c.ws() + WS_S5WO))[(size_t)g * 65536 + e] = (bf16)f2bf(ri ? -(cr * pi + ci * pr) : cr * pr - ci * pi); }
    __syncthreads();
}

__device__ __forceinline__ void s5_unit(const Ctx& c, int l, int g, int cu, unsigned char* lds) {
    const int tid = c.tid, lane = c.lane, w = c.wave, lr = lane & 15, lq = lane >> 4;
    const bool lat = cu >= 8;
    bf16* Ut = (bf16*)lds;
    bf16* St = Ut + 64 * 264;
    bf16* Kt = St + 64 * 264;
    float* Dl = (float*)(Kt + 31 * 256);
    const bf16* R1p = c.R1();
    const bf16* Wsp0 = (const bf16*)(c.ws() + WS_S5WS) + ((size_t)(0 * 32 + g) * 128 + 16 * w + lr) * 256 + 8 * lq;
    const bf16* Wsp1 = (const bf16*)(c.ws() + WS_S5WS) + ((size_t)(1 * 32 + g) * 128 + 16 * w + lr) * 256 + 8 * lq;
    const bf16* Wop = (const bf16*)(c.ws() + WS_S5WO) + (size_t)g * 65536 + 8 * lq;
    bx8 afA[8], afB[8];
#pragma unroll
    for (int ks = 0; ks < 8; ++ks) afA[ks] = *(const bx8*)(Wsp0 + 32 * ks);
    { const v4u* src = (const v4u*)((const bf16*)(c.ws() + WS_S5K) + (size_t)g * 31 * 256); for (int i = tid; i < 31 * 32; i += NTHR) ((v4u*)Kt)[i] = src[i]; }
#pragma unroll
    for (int i = 0; i < 2; ++i) { const int id = tid + NTHR * i, col = id >> 4, j = id & 15;
        const int tok = lat ? MC + (cu - 8) * 1024 + col * 16 + j : (4 * cu + (col >> 4)) * 256 + (col & 15) * 16 + j;
        const bf16* up = R1p + (size_t)tok * 4096 + C_U + g * 16;
        *(v4u*)(Ut + col * 264 + j * 16) = *(const v4u*)up; *(v4u*)(Ut + col * 264 + j * 16 + 8) = *(const v4u*)(up + 8); }
#pragma unroll
    for (int ks = 0; ks < 8; ++ks) afB[ks] = *(const bx8*)(Wsp1 + 32 * ks);
    LDS_BARRIER();
#pragma unroll
    for (int dir = 0; dir < 2; ++dir) {
        f32x4 acc[4];
#pragma unroll
        for (int cb = 0; cb < 4; ++cb) acc[cb] = (f32x4){0.f, 0.f, 0.f, 0.f};
#pragma unroll
        for (int ks = 0; ks < 8; ++ks) {
#pragma unroll
            for (int cb = 0; cb < 4; ++cb) { const bx8 bf = *(const bx8*)(Ut + (16 * cb + lr) * 264 + 32 * ks + 8 * lq); acc[cb] = MFMA16(dir ? afB[ks] : afA[ks], bf, acc[cb]); }
            __builtin_amdgcn_sched_barrier(0); }
        if (dir == 0) {
#pragma unroll
            for (int ks = 0; ks < 8; ++ks) afA[ks] = *(const bx8*)(Wop + (size_t)(16 * (2 * w) + lr) * 256 + 32 * ks); }
        else {
#pragma unroll
            for (int ks = 0; ks < 8; ++ks) afB[ks] = *(const bx8*)(Wop + (size_t)(16 * (2 * w + 1) + lr) * 256 + 32 * ks); }
#pragma unroll
        for (int cb = 0; cb < 4; ++cb)
#pragma unroll
            for (int r = 0; r < 4; ++r) Dl[(16 * w + 4 * lq + r) * 65 + 16 * cb + lr] = acc[cb][r];
        LDS_BARRIER();
        if (tid < (lat ? 64 : 256)) {
            const int n = tid & 63, bl = tid >> 6, nc = lat ? 64 : 16, cbase = lat ? 0 : 16 * bl, b = lat ? cu - 8 : 4 * cu + bl;
            const float* at = (const float*)(c.ws() + WS_S5AT) + ((size_t)(dir * 32 + g) * 64 + n) * 2; const float ar = at[0], ai = at[1];
            float sr = 0.f, si = 0.f;
            if (lat) { sr = c.state_s5()[((((size_t)(b * 2 + l) * 2 + dir) * 2 + 0) * 32 + g) * 64 + n]; si = c.state_s5()[((((size_t)(b * 2 + l) * 2 + dir) * 2 + 1) * 32 + g) * 64 + n]; }
            for (int cc = 0; cc < nc; ++cc) { const int col = cbase + (dir ? nc - 1 - cc : cc);
                St[col * 264 + dir * 128 + n] = (bf16)f2bf(sr); St[col * 264 + dir * 128 + 64 + n] = (bf16)f2bf(si);
                const float dr = Dl[n * 65 + col], di = Dl[(64 + n) * 65 + col];
                const float nr = ar * sr - ai * si + dr, ni = ar * si + ai * sr + di; sr = nr; si = ni; }
            if (!lat) { c.out()[O_S5 + ((((size_t)(b * 2 + l) * 2 + dir) * 2 + 0) * 32 + g) * 64 + n] = sr; c.out()[O_S5 + ((((size_t)(b * 2 + l) * 2 + dir) * 2 + 1) * 32 + g) * 64 + n] = si; }
        }
        LDS_BARRIER();
    }
#pragma unroll
    for (int ii = 0; ii < 2; ++ii) { const int i = 2 * w + ii;
        f32x4 acc[4];
#pragma unroll
        for (int cb = 0; cb < 4; ++cb) acc[cb] = (f32x4){0.f, 0.f, 0.f, 0.f};
#pragma unroll
        for (int ks = 0; ks < 8; ++ks) { const int j = 2 * ks + (lq >> 1); const bx8 af = *(const bx8*)(Kt + ((i - j + 15) * 16 + lr) * 16 + 8 * (lq & 1));
#pragma unroll
            for (int cb = 0; cb < 4; ++cb) { const bx8 bf = *(const bx8*)(Ut + (16 * cb + lr) * 264 + 32 * ks + 8 * lq); acc[cb] = MFMA16(af, bf, acc[cb]); }
            __builtin_amdgcn_sched_barrier(0); }
#pragma unroll
        for (int ks = 0; ks < 8; ++ks) {
#pragma unroll
            for (int cb = 0; cb < 4; ++cb) { const bx8 bf = *(const bx8*)(St + (16 * cb + lr) * 264 + 32 * ks + 8 * lq); acc[cb] = MFMA16(ii ? afB[ks] : afA[ks], bf, acc[cb]); }
            __builtin_amdgcn_sched_barrier(0); }
#pragma unroll
        for (int cb = 0; cb < 4; ++cb) { const int col = 16 * cb + lr;
            const int tok = lat ? MC + (cu - 8) * 1024 + col * 16 + i : (4 * cu + (col >> 4)) * 256 + (col & 15) * 16 + i;
            v2u o; o.x = pk2(acc[cb][0], acc[cb][1]); o.y = pk2(acc[cb][2], acc[cb][3]);
            *(v2u*)(c.Y5() + (size_t)tok * 512 + g * 16 + 4 * lq) = o; }
    }
}

typedef float f32x16 __attribute__((ext_vector_type(16)));
#define MFMA32(a, b, cc) __builtin_amdgcn_mfma_f32_32x32x16_bf16((a), (b), (cc), 0, 0, 0)
constexpr float SM_SC = 0.125f * 1.4426950408889634f;
__device__ __forceinline__ void qk_tile(f32x16& p0, f32x16& p1, const bf16* Kt, int KS, const bx8 (&qf)[4], int r32, int hi) {
    p0 = (f32x16){0.f}; p1 = (f32x16){0.f};
#pragma unroll
    for (int d0 = 0; d0 < 4; ++d0) { const bx8 a0 = *(const bx8*)(Kt + r32 * KS + 16 * d0 + 8 * hi), a1 = *(const bx8*)(Kt + (32 + r32) * KS + 16 * d0 + 8 * hi);
        p0 = MFMA32(a0, qf[d0], p0); p1 = MFMA32(a1, qf[d0], p1); }
}
__device__ __forceinline__ float fmax_(float a, float b) { float r; asm("v_max_f32_e32 %0, %1, %2" : "=v"(r) : "v"(a), "v"(b)); return r; }
__device__ __forceinline__ float sm_step(f32x16& p0, f32x16& p1, float& mrun, float& lrun, bx8 (&pb)[4]) {
    float ta = fmax_(p0[0], p1[0]), tb = fmax_(p0[1], p1[1]);
#pragma unroll
    for (int r = 2; r < 16; r += 2) { ta = fmax_(ta, fmax_(p0[r], p1[r])); tb = fmax_(tb, fmax_(p0[r + 1], p1[r + 1])); }
    float tm = fmax_(ta, tb) * SM_SC;
    tm = fmax_(tm, __shfl_xor(tm, 32));
    const float mn = fmax_(mrun, tm), alpha = __builtin_amdgcn_exp2f(mrun - mn);
    float rs0 = 0.f, rs1 = 0.f;
#pragma unroll
    for (int r = 0; r < 16; ++r) { p0[r] = __builtin_amdgcn_exp2f(fmaf(p0[r], SM_SC, -mn)); p1[r] = __builtin_amdgcn_exp2f(fmaf(p1[r], SM_SC, -mn)); rs0 += p0[r]; rs1 += p1[r]; }
    float rs = rs0 + rs1;
    rs += __shfl_xor(rs, 32);
    lrun = lrun * alpha + rs; mrun = mn;
#pragma unroll
    for (int sI = 0; sI < 2; ++sI) {
        v4u t0, t1;
        t0.x = pg8::cvt_pk_bf16(p0[8 * sI + 0], p0[8 * sI + 1]); t0.y = pg8::cvt_pk_bf16(p0[8 * sI + 2], p0[8 * sI + 3]); t0.z = pg8::cvt_pk_bf16(p0[8 * sI + 4], p0[8 * sI + 5]); t0.w = pg8::cvt_pk_bf16(p0[8 * sI + 6], p0[8 * sI + 7]);
        t1.x = pg8::cvt_pk_bf16(p1[8 * sI + 0], p1[8 * sI + 1]); t1.y = pg8::cvt_pk_bf16(p1[8 * sI + 2], p1[8 * sI + 3]); t1.z = pg8::cvt_pk_bf16(p1[8 * sI + 4], p1[8 * sI + 5]); t1.w = pg8::cvt_pk_bf16(p1[8 * sI + 6], p1[8 * sI + 7]);
        pb[sI] = __builtin_bit_cast(bx8, t0); pb[2 + sI] = __builtin_bit_cast(bx8, t1);
    }
    return alpha;
}
typedef short v4i16_t __attribute__((ext_vector_type(4)));
__device__ __forceinline__ v2u vtr(const bf16* p) { return __builtin_bit_cast(v2u, __builtin_amdgcn_ds_read_tr16_b64_v4i16((__attribute__((address_space(3))) v4i16_t*)p)); }
template <int NDT, int VS> __device__ __forceinline__ void pv_tile(f32x16 (&o)[NDT], const bf16* Vr, const bx8 (&pb)[4], int lane) {
    const bf16* vb = Vr + (4 * (lane >> 5) + ((lane & 15) >> 2)) * VS + 16 * ((lane >> 4) & 1) + 4 * (lane & 3);
    v2u cur[NDT][2], nxt[NDT][2];
#pragma unroll
    for (int dt = 0; dt < NDT; ++dt) { cur[dt][0] = vtr(vb + 32 * dt); cur[dt][1] = vtr(vb + 8 * VS + 32 * dt); }
#pragma unroll
    for (int ks = 0; ks < 4; ++ks) {
        if (ks < 3) {
#pragma unroll
            for (int dt = 0; dt < NDT; ++dt) { nxt[dt][0] = vtr(vb + (16 * (ks + 1)) * VS + 32 * dt); nxt[dt][1] = vtr(vb + (16 * (ks + 1) + 8) * VS + 32 * dt); }
        }
#pragma unroll
        for (int dt = 0; dt < NDT; ++dt) { const v4u t = {cur[dt][0].x, cur[dt][0].y, cur[dt][1].x, cur[dt][1].y}; o[dt] = MFMA32(__builtin_bit_cast(bx8, t), pb[ks], o[dt]); }
#pragma unroll
        for (int dt = 0; dt < NDT; ++dt) { cur[dt][0] = nxt[dt][0]; cur[dt][1] = nxt[dt][1]; }
    }
}

template <int PASS> __device__ __forceinline__ void diff_unit(const Ctx& c, int l, int uidx, unsigned char* lds) {
    constexpr int NT = PASS ? 10 : 2, NQB = PASS ? 8 : 2, VS = 160;
    const int tid = c.tid, lane = c.lane, w = c.wave, r32 = lane & 31, hi = lane >> 5, comp = w >> 2;
    const int qb = uidx % NQB, h = (uidx / NQB) & 3, b = uidx / (NQB * 4);
    const int tok0 = PASS ? MC + b * 1024 : b * 256;
    bf16* Kt = (bf16*)lds;
    bf16* Vr = Kt + 128 * 136;
    float* Ob = (float*)lds;
    const bf16* R1p = c.R1(); const bf16* CK = c.CKV();
    const float lam_init = 0.8f - 0.6f * expf(-0.3f * (float)l);
    const float* lv = c.dlam() + l * 256;
    const float lam = expf(wave_sum(lv[lane] * lv[64 + lane])) - expf(wave_sum(lv[128 + lane] * lv[192 + lane])) + lam_init;
    const size_t mrow = (size_t)tok0 + qb * 128 + 32 * (w & 3) + r32;
    bx8 qf[4];
#pragma unroll
    for (int d0 = 0; d0 < 4; ++d0) qf[d0] = *(const bx8*)(R1p + mrow * 4096 + C_DQ + h * 128 + comp * 64 + 16 * d0 + 8 * hi);
    f32x16 o[4];
#pragma unroll
    for (int dt = 0; dt < 4; ++dt) o[dt] = (f32x16){0.f};
    float mrun = -1e30f, lrun = 0.f;
    v4u kreg[4], vreg[4];
#define DIFF_LOAD(t) { const bf16* kb; const bf16* vb; size_t rs; \
        if (PASS && (t) < 2) { kb = CK + ((size_t)b * 256 + 128 * (t)) * 1280 + h * 128; vb = kb + 512; rs = 1280; } \
        else { kb = R1p + ((size_t)tok0 + 128 * ((t) - (PASS ? 2 : 0))) * 4096 + C_DK + h * 128; vb = kb + (C_DV - C_DK); rs = 4096; } \
        _Pragma("unroll") for (int i = 0; i < 4; ++i) { const int id = tid + NTHR * i; kreg[i] = *(const v4u*)(kb + (size_t)(id >> 4) * rs + (id & 15) * 8); vreg[i] = *(const v4u*)(vb + (size_t)(id >> 4) * rs + (id & 15) * 8); } }
    DIFF_LOAD(0);
    for (int t = 0; t < NT; ++t) {
        LDS_BARRIER();
#pragma unroll
        for (int i = 0; i < 4; ++i) { const int id = tid + NTHR * i; *(v4u*)(Kt + (id >> 4) * 136 + (id & 15) * 8) = kreg[i]; *(v4u*)(Vr + (id >> 4) * VS + (id & 15) * 8) = vreg[i]; }
        if (t + 1 < NT) DIFF_LOAD(t + 1);
        LDS_BARRIER();
#pragma unroll
        for (int sub = 0; sub < 2; ++sub) {
            f32x16 p0, p1; bx8 pb[4];
            qk_tile(p0, p1, Kt + sub * 64 * 136 + comp * 64, 136, qf, r32, hi);
            const float alpha = sm_step(p0, p1, mrun, lrun, pb);
            if (__any(alpha != 1.0f)) {
#pragma unroll
                for (int dt = 0; dt < 4; ++dt)
#pragma unroll
                    for (int r = 0; r < 16; ++r) o[dt][r] *= alpha; }
            pv_tile<4, VS>(o, Vr + sub * 64 * VS, pb, lane);
        }
    }
#undef DIFF_LOAD
    const float inv = (comp ? lam : 1.0f) / lrun;
    const int rowl = 32 * (w & 3) + r32;
    LDS_BARRIER();
    if (comp) {
#pragma unroll
        for (int dt = 0; dt < 4; ++dt)
#pragma unroll
            for (int r = 0; r < 16; ++r) Ob[rowl * 129 + 32 * dt + (r & 3) + 8 * (r >> 2) + 4 * hi] = o[dt][r] * inv;
    }
    LDS_BARRIER();
    if (!comp) {
        float ss = 0.f;
#pragma unroll
        for (int dt = 0; dt < 4; ++dt)
#pragma unroll
            for (int r = 0; r < 16; ++r) { const float v = o[dt][r] * inv - Ob[rowl * 129 + 32 * dt + (r & 3) + 8 * (r >> 2) + 4 * hi]; o[dt][r] = v; ss += v * v; }
        ss += __shfl_xor(ss, 32);
        const float rn = rsqrtf(ss * (1.0f / 128.0f) + EPS) * (1.0f - lam_init);
        const float* sg = c.subln_g() + l * 128; bf16* yp = c.Y() + mrow * 2048 + 1024 + h * 128;
#pragma unroll
        for (int dt = 0; dt < 4; ++dt)
#pragma unroll
            for (int r4 = 0; r4 < 4; ++r4) { const int dv = 32 * dt + 8 * r4 + 4 * hi; const f32x4 g = *(const f32x4*)(sg + dv);
                v2u ov; ov.x = pk2(o[dt][4 * r4 + 0] * rn * g.x, o[dt][4 * r4 + 1] * rn * g.y); ov.y = pk2(o[dt][4 * r4 + 2] * rn * g.z, o[dt][4 * r4 + 3] * rn * g.w);
                *(v2u*)(yp + dv) = ov; }
    }
}

template <int PASS> __device__ __forceinline__ void win_unit(const Ctx& c, int l, int uidx, unsigned char* lds) {
    constexpr int NQB = PASS ? 4 : 1, VS = 96;
    const int tid = c.tid, lane = c.lane, w = c.wave, r32 = lane & 31, hi = lane >> 5;
    const int qb = uidx % NQB, hh = (uidx / NQB) & 7, b = uidx / (NQB * 8), nkv = hh >> 2;
    const int tok0 = PASS ? MC + b * 1024 : b * 256;
    bf16* Kt = (bf16*)lds;
    bf16* Vr = Kt + 128 * 72;
    const bf16* R1p = c.R1(); const bf16* CK = c.CKV();
    const int qrow = qb * 256 + 32 * w + r32;
    const size_t mrow = (size_t)tok0 + qrow;
    bx8 qf[4];
#pragma unroll
    for (int d0 = 0; d0 < 4; ++d0) qf[d0] = *(const bx8*)(R1p + mrow * 4096 + C_WQ + hh * 64 + 16 * d0 + 8 * hi);
    f32x16 o[2]; o[0] = (f32x16){0.f}; o[1] = (f32x16){0.f};
    float mrun = c.sink()[l * 8 + hh] * 1.4426950408889634f, lrun = 1.0f;
    const int q0 = qb * 256;
    const int tb0 = PASS ? ((q0 - 128 < 0 ? 0 : q0 - 128) >> 7) : 0, tb1 = PASS ? ((q0 + 255 + 128 > 1023 ? 1023 : q0 + 255 + 128) >> 7) : 0;
    const int NT = PASS ? 2 + (tb1 - tb0 + 1) : 2;
    v4u kreg[2], vreg[2];
#define WIN_LOAD(t) { const bf16* kb; const bf16* vb; size_t rs; \
        if (PASS && (t) < 2) { kb = CK + ((size_t)b * 256 + 128 * (t)) * 1280 + 1024 + nkv * 64; vb = kb + 128; rs = 1280; } \
        else { kb = R1p + ((size_t)tok0 + 128 * (PASS ? tb0 + (t) - 2 : (t))) * 4096 + C_WK + nkv * 64; vb = kb + (C_WV - C_WK); rs = 4096; } \
        _Pragma("unroll") for (int i = 0; i < 2; ++i) { const int id = tid + NTHR * i; kreg[i] = *(const v4u*)(kb + (size_t)(id >> 3) * rs + (id & 7) * 8); vreg[i] = *(const v4u*)(vb + (size_t)(id >> 3) * rs + (id & 7) * 8); } }
    WIN_LOAD(0);
    for (int t = 0; t < NT; ++t) {
        LDS_BARRIER();
#pragma unroll
        for (int i = 0; i < 2; ++i) { const int id = tid + NTHR * i; *(v4u*)(Kt + (id >> 3) * 72 + (id & 7) * 8) = kreg[i]; *(v4u*)(Vr + (id >> 3) * VS + (id & 7) * 8) = vreg[i]; }
        if (t + 1 < NT) WIN_LOAD(t + 1);
        LDS_BARRIER();
#pragma unroll
        for (int sub = 0; sub < 2; ++sub) {
            bool band = false; int kp0 = 0;
            if (PASS && t >= 2) { band = true; kp0 = 128 * (tb0 + t - 2) + 64 * sub; const int r0 = q0 + 32 * w;
                if (kp0 + 63 < r0 - 128 || kp0 > r0 + 31 + 128) continue; }
            f32x16 p0, p1; bx8 pb[4];
            qk_tile(p0, p1, Kt + sub * 64 * 72, 72, qf, r32, hi);
            if (band) {
#pragma unroll
                for (int r = 0; r < 16; ++r) { const int kp = kp0 + (r & 3) + 8 * (r >> 2) + 4 * hi; const int d0 = qrow - kp, d1 = d0 - 32;
                    if (d0 > 128 || d0 < -128) p0[r] = -1e30f; if (d1 > 128 || d1 < -128) p1[r] = -1e30f; }
            }
            const float alpha = sm_step(p0, p1, mrun, lrun, pb);
            if (__any(alpha != 1.0f)) {
#pragma unroll
                for (int dt = 0; dt < 2; ++dt)
#pragma unroll
                    for (int r = 0; r < 16; ++r) o[dt][r] *= alpha; }
            pv_tile<2, VS>(o, Vr + sub * 64 * VS, pb, lane);
        }
    }
#undef WIN_LOAD
    const float inv = 1.0f / lrun; bf16* yp = c.Y() + mrow * 2048 + 1536 + hh * 64;
#pragma unroll
    for (int dt = 0; dt < 2; ++dt)
#pragma unroll
        for (int r4 = 0; r4 < 4; ++r4) { const int dv = 32 * dt + 8 * r4 + 4 * hi;
            v2u ov; ov.x = pk2(o[dt][4 * r4 + 0] * inv, o[dt][4 * r4 + 1] * inv); ov.y = pk2(o[dt][4 * r4 + 2] * inv, o[dt][4 * r4 + 3] * inv);
            *(v2u*)(yp + dv) = ov; }
}

__device__ __forceinline__ void phase_mixers(const Ctx& c_in, int l, float* lf) {
    unsigned char* lds = (unsigned char*)lf;
    unsigned* qctr = (unsigned*)(c_in.ws() + WS_QCTR) + 64 * l;
    volatile int* qslot = (volatile int*)(lds + LDS_BYTES - 32);
    for (;;) {
        __syncthreads();
        if (threadIdx.x == 0) *qslot = (int)atomicAdd(qctr, 1u);
        __syncthreads();
        const int u = __builtin_amdgcn_readfirstlane(*qslot);
        if (u >= 1440) break;
        Ctx c = c_in; asm volatile("" : "+s"(c.ap), "+v"(c.tid));
        c.lane = c.tid & 63; c.wave = __builtin_amdgcn_readfirstlane(c.tid >> 6);
        unsigned long long pt0 = 0; if (PROBE_SEL >= 0) pt0 = __builtin_amdgcn_s_memrealtime();
        int ty;
        if (u < 32) { ssd_unit(c, l, 1, u >> 3, u & 7, lds); ty = 0; }
        else if (u < 160) { diff_unit<1>(c, l, u - 32, lds); ty = 2; }
        else if (u < 288) { win_unit<1>(c, l, u - 160, lds); ty = 3; }
        else if (u < 416) { s5_unit(c, l, (u - 288) & 31, 8 + ((u - 288) >> 5), lds); ty = 1; }
        else if (u < 672) { ssd_unit(c, l, 0, (u - 416) >> 3, (u - 416) & 7, lds); ty = 4; }
        else if (u < 928) { diff_unit<0>(c, l, u - 672, lds); ty = 6; }
        else if (u < 1184) { win_unit<0>(c, l, u - 928, lds); ty = 7; }
        else { s5_unit(c, l, (u - 1184) & 31, (u - 1184) >> 5, lds); ty = 5; }
        __syncthreads();
        if (PROBE_SEL >= 0 && threadIdx.x == 0) { unsigned long long* tsu = (unsigned long long*)(c.ws() + WS_TS) + 64; atomicAdd(tsu + ty, (unsigned long long)(__builtin_amdgcn_s_memrealtime() - pt0)); }
    }
}

__device__ __forceinline__ void phase_sum4(const Ctx& c) {
    const int gt = blockIdx.x * NTHR + c.tid, NT = gridDim.x * NTHR;
#pragma unroll 4
    for (int i = gt; i < M * 128; i += NT) { const size_t m = (size_t)(i >> 7); const int c8 = (i & 127) * 8;
        float a[8] = {0.f, 0.f, 0.f, 0.f, 0.f, 0.f, 0.f, 0.f};
#pragma unroll
        for (int j = 0; j < 4; ++j) { float f[8]; unpack8(*(const v4u*)(c.R1() + m * 4096 + j * 1024 + c8), f);
#pragma unroll
            for (int k = 0; k < 8; ++k) a[k] += f[k]; }
        v4u o; o.x = pk2(a[0], a[1]); o.y = pk2(a[2], a[3]); o.z = pk2(a[4], a[5]); o.w = pk2(a[6], a[7]);
        *(v4u*)(c.H() + m * 1024 + c8) = o; }
}

#define GAS __attribute__((address_space(1)))
#define XB_TMO      128
#define XB_XCNT(j)  (256  + 64 * (j))
#define XB_XSUB(j)  (1280 + 64 * (j))
#define XB_XGEN(j)  (2304 + 64 * (j))
#define XB_TOP      3328
#define XB_TOPGEN   3392
#define XCD_BAR_WORDS 3456
#define XB_SPIN_CAP (1u << 18)

__device__ __forceinline__ unsigned xb_ld(unsigned* p)              { return __hip_atomic_load(p, __ATOMIC_RELAXED, __HIP_MEMORY_SCOPE_AGENT); }
__device__ __forceinline__ unsigned xb_add(unsigned* p, unsigned v) { return __hip_atomic_fetch_add(p, v, __ATOMIC_RELAXED, __HIP_MEMORY_SCOPE_AGENT); }
__device__ __forceinline__ unsigned xb_xcc_id() { return (unsigned)__builtin_amdgcn_s_getreg((3 << 11) | 20) & 0xFu; }
#define XB_SPIN(cond, bar) do { unsigned _sp = 0; while (cond) { __builtin_amdgcn_s_sleep(1); \
    if ((++_sp & 255u) == 0u) { if (xb_ld(&(bar)[XB_TMO])) break; if (_sp > XB_SPIN_CAP) { atomicAdd(&(bar)[XB_TMO], 1u); break; } } } } while (0)

struct XcdBarrier {
    unsigned* bar; unsigned x;
    volatile LAS unsigned* st;
};

__device__ __forceinline__ XcdBarrier xcd_barrier_post(unsigned* bar, volatile LAS unsigned* st) {
    XcdBarrier b; b.bar = bar; b.x = xb_xcc_id(); b.st = st;
    if (threadIdx.x == 0) (void)xb_add(&bar[XB_XCNT(b.x)], 1u);
    return b;
}
__device__ __forceinline__ void xcd_barrier_complete(unsigned* bar, unsigned x, unsigned& nloc, unsigned& nx) {
    const unsigned G = gridDim.x * gridDim.y * gridDim.z;
    unsigned sum, cnt, mine, sp = 0u;
    for (;;) {
        sum = 0u; cnt = 0u; mine = 0u;
#pragma unroll
        for (unsigned j = 0; j < 16; ++j) { const unsigned c = xb_ld(&bar[XB_XCNT(j)]); sum += c; cnt += (c > 0u) ? 1u : 0u; mine = (j == x) ? c : mine; }
        if (sum == G) break;
        __builtin_amdgcn_s_sleep(1);
        if ((++sp & 255u) == 0u) { if (xb_ld(&bar[XB_TMO])) break; if (sp > XB_SPIN_CAP) { atomicAdd(&bar[XB_TMO], 1u); break; } }
    }
    nloc = mine > 0u ? mine : 1u; nx = cnt > 0u ? cnt : 1u;
}

__device__ __forceinline__ void xcd_barrier(const XcdBarrier& b) {
    asm volatile("s_waitcnt vmcnt(0)" ::: "memory");
    __syncthreads();
    if (threadIdx.x == 0) {
        unsigned* bar = b.bar;
        __builtin_amdgcn_s_waitcnt(0);
        unsigned nloc = b.st[0], nx = b.st[1];
        if (nloc == 0u) { xcd_barrier_complete(bar, b.x, nloc, nx); b.st[0] = nloc; b.st[1] = nx; }
        const unsigned old = xb_add(&bar[XB_XSUB(b.x)], 1u);
        const unsigned gen = old / nloc;
        if (old + 1u == (gen + 1u) * nloc) {
            __builtin_amdgcn_fence(__ATOMIC_RELEASE, "agent");
            asm volatile("s_waitcnt vmcnt(0)" ::: "memory");
            const unsigned og = xb_add(&bar[XB_TOP], 1u);
            const unsigned tg = og / nx;
            if (og + 1u == (tg + 1u) * nx) xb_add(&bar[XB_TOPGEN], 1u);
            else XB_SPIN(xb_ld(&bar[XB_TOPGEN]) == tg, bar);
            __builtin_amdgcn_fence(__ATOMIC_ACQUIRE, "agent");
            xb_add(&bar[XB_XGEN(b.x)], 1u);
            asm volatile("s_waitcnt vmcnt(0)" ::: "memory");
        } else {
            XB_SPIN(xb_ld(&bar[XB_XGEN(b.x)]) == gen, bar);
            __builtin_amdgcn_fence(__ATOMIC_ACQUIRE, "agent");
            asm volatile("s_waitcnt vmcnt(0)" ::: "memory");
        }
    }
    __syncthreads();
}

#define PHASE_BEGIN() Ctx c; c.ap = (CArgs)__builtin_amdgcn_kernarg_segment_ptr(); asm volatile("" : "+s"(c.ap)); \
        int tid_o = threadIdx.x; asm volatile("" : "+v"(tid_o)); c.tid = tid_o; c.lane = tid_o & 63; c.wave = __builtin_amdgcn_readfirstlane(tid_o >> 6); \
        int G = gridDim.x, bid = blockIdx.x; asm volatile("" : "+s"(G), "+s"(bid)); unsigned char* ws = c.ws(); (void)ws; (void)G; (void)bid;
#define PHASE_END(k) { if ((k) + 1 < ph_hi) { if ((k) == 0) cg::this_grid().sync(); else xcd_barrier(xbar); } \
        if (PROBE_SEL >= 0 && blockIdx.x == PROBE_PB && threadIdx.x == 0) ((unsigned long long*)(c.ws() + WS_TS))[(k) + 1] = __builtin_amdgcn_s_memrealtime(); }
#define IN_RANGE(k) (ph_lo <= (k) && (k) < ph_hi)

template <int LAYER> __device__ __forceinline__ void layer_program(int ph_lo, int ph_hi, unsigned char* lds, const XcdBarrier& xbar) {
    float* lf = (float*)lds;
    PG8_LAS unsigned char* ring = (PG8_LAS unsigned char*)lds;
    constexpr int l = LAYER, B0 = 1 + 11 * LAYER;
    if (IN_RANGE(B0 + 0)) { PHASE_BEGIN(); if (l == 1) { if (gridDim.x == 256) convert_items(c, 1, 7936, 9984, blockIdx.x * NWAVES + c.wave, gridDim.x * NWAVES, false, 0, 1, lf); else phase_convert(c, 1, lf); __syncthreads(); } phase_norm(c, l, 0, lf); phase_bias2(c, l); PHASE_END(B0 + 0); }
    if (IN_RANGE(B0 + 1)) { PHASE_BEGIN();
        pg8::Gemm g{c.H(), (const bf16*)(ws + W_IN), M, 4096, 1024, 1024, 1024, 0, 0}; pg8::StaticOrder S; S.init(M, 4096, G, bid);
        pg8::EpiB<0> E{c.R1(), 4096, nullptr, nullptr};
        pg8::gemm_phase<pg8::EpiB<0>, pg8::StaticOrder, true, true>(ring, g, S, E, tid_o); phase_dt(c, l); PHASE_END(B0 + 1); }
    if (IN_RANGE(B0 + 2)) { PHASE_BEGIN(); phase_qk(c, l, lf); PHASE_END(B0 + 2); }
    if (IN_RANGE(B0 + 3)) { PHASE_BEGIN(); phase_mixers(c, l, lf); PHASE_END(B0 + 3); }
    if (IN_RANGE(B0 + 4)) { PHASE_BEGIN();
        { pg8::Gemm g{c.Y5(), (const bf16*)(ws + W_GLU), M, 1024, 512, 512, 512, 0, 0}; pg8::StaticOrder S; S.init(M, 1024, G, bid);
          pg8::EpiGlu E{c.Y(), 2048, 512, c.b_glu() + l * 1024};
          pg8::gemm_phase<pg8::EpiGlu, pg8::StaticOrder, true, true>(ring, g, S, E, tid_o); }
        { pg8::Gemm g{c.H(), (const bf16*)(ws + W_G), M, 4096, 1024, 1024, 1024, 0, 0}; pg8::StaticOrder S; S.init(M, 4096, G, bid);
          pg8::EpiB<1> E{c.R1(), 4096, c.b_gate() + l * 4096, nullptr};
          pg8::gemm_phase<pg8::EpiB<1>, pg8::StaticOrder, true, true>(ring, g, S, E, tid_o); }
        PHASE_END(B0 + 4); }
    if (IN_RANGE(B0 + 5)) { PHASE_BEGIN();
        pg8::Gemm g{c.Y(), (const bf16*)(ws + W_BR), M, 4096, 512, 2048, 512, 4, 1024}; pg8::BranchOrder S; S.init(G, bid);
        pg8::EpiMerge E{c.R1(), c.H(), c.SSQ()};
        pg8::gemm_phase<pg8::EpiMerge, pg8::BranchOrder, true, true>(ring, g, S, E, tid_o); if (l == 0) side_convert(c, 0, 4352, true, lf); PHASE_END(B0 + 5); }
    if (IN_RANGE(B0 + 7)) { PHASE_BEGIN();
        pg8::Gemm g{c.H(), (const bf16*)(ws + W_OUT), M, 1024, 1024, 1024, 1024, 0, 0}; pg8::StaticOrder S; S.init(M, 1024, G, bid);
        pg8::EpiRes2 E{l == 0 ? c.x_prompt() : c.out(), l == 0 ? c.x_sample() : c.out() + (size_t)MC * D, c.out(), c.MOD() + (size_t)l * 5 * 6144, 2048, c.Y(), c.g_norm2() + l * 1024, 4096, (float*)(ws + WS_SSQ2)};
        pg8::gemm_phase<pg8::EpiRes2, pg8::StaticOrder, true, true>(ring, g, S, E, tid_o); if (l == 0) side_convert(c, 4352, 5376, false, lf); PHASE_END(B0 + 7); }
    if (IN_RANGE(B0 + 9)) { PHASE_BEGIN();
        pg8::Gemm g{c.Y(), (const bf16*)(ws + W_1), M, 4096, 1024, 1024, 1024, 0, 0}; pg8::StaticOrder S; S.init(M, 4096, G, bid);
        pg8::EpiB<5> E{c.R1(), 4096, (const float*)(ws + WS_BI2), (const float*)(ws + WS_SSQ2)};
        pg8::gemm_phase<pg8::EpiB<5>, pg8::StaticOrder, true, true>(ring, g, S, E, tid_o); PHASE_END(B0 + 9); }
    if (IN_RANGE(B0 + 10)) { PHASE_BEGIN();
        pg8::Gemm g{c.R1(), (const bf16*)(ws + W_2), M, 1024, 4096, 4096, 4096, 0, 0}; pg8::StaticOrder S; S.init(M, 1024, G, bid);
        pg8::EpiRes E{c.out(), c.out() + (size_t)MC * D, c.out(), c.MOD() + (size_t)l * 5 * 6144, 5120};
        pg8::gemm_phase<pg8::EpiRes, pg8::StaticOrder, true, true>(ring, g, S, E, tid_o); if (l == 0) side_convert(c, 5376, 7936, false, lf); PHASE_END(B0 + 10); }
}

__global__ void __launch_bounds__(NTHR, 2) fwd_kernel(Args args) {
    extern __shared__ __attribute__((aligned(16))) unsigned char lds[];
    const int ph_lo = args.ph_lo, ph_hi = args.ph_hi;
    volatile LAS unsigned* xst = (volatile LAS unsigned*)(lds + LDS_BYTES - 16);
    if (threadIdx.x < 4) xst[threadIdx.x] = 0u;
    __syncthreads();
    const XcdBarrier xbar = xcd_barrier_post((unsigned*)(args.ws + WS_BAR), xst);
    if (PROBE_SEL >= 0 && blockIdx.x == PROBE_PB && threadIdx.x == 0) { unsigned long long* ts = (unsigned long long*)(args.ws + WS_TS); ts[0] = __builtin_amdgcn_s_memrealtime(); }
    if (IN_RANGE(0)) { PHASE_BEGIN(); float* lf = (float*)lds; phase_mods(c, lf); __syncthreads(); phase_convert(c, 0, lf); phase_rope_table(c); PHASE_END(0); }
    layer_program<0>(ph_lo, ph_hi, lds, xbar);
    layer_program<1>(ph_lo, ph_hi, lds, xbar);
    if (PROBE_SEL >= 0) {
        __threadfence(); cg::this_grid().sync();
        const unsigned long long* ts = (const unsigned long long*)(args.ws + WS_TS);
        const float total = (float)(ts[23] - ts[0]); float sel = 0.f;
        for (int k = 0; k < 23; ++k) { const float d = (float)(ts[k + 1] - ts[k]); const int q = k == 0 ? -1 : (k - 1) % 11;
            const int cls = (q == 3) ? 0 : (q == 1 || q == 4 || q == 5 || q == 7 || q == 9 || q == 10) ? 1 : (q == 2) ? 2 : 3;
            if (cls == PROBE_SEL) sel += d; }
        if (PROBE_SEL >= 10 && PROBE_SEL < 100) sel = (float)ts[64 + PROBE_SEL - 10] * (1.0f / 256.0f);
        if (PROBE_SEL >= 100) { const int k = PROBE_SEL - 100; sel = (float)(ts[k + 1] - (ts[k] != 0ull ? ts[k] : ts[k - 1])); }
        const float sc = 1.0f + sqrtf(PROBE_SCALE * sel / total);
        for (int i = blockIdx.x * NTHR + threadIdx.x; i < 524288; i += gridDim.x * NTHR) args.out[O_S5 + i] *= sc;
    }
}

extern "C" void kernel_launch(void* const* d_in, const int* in_sizes, int n_in, void* d_out, int out_size, void* d_ws, size_t ws_size, hipStream_t stream) {
    static int grid = 0;
    if (grid == 0) {
        if (n_in != 44 || ws_size < WS_END) { fprintf(stderr, "kernel_launch: expected 44 inputs and >= %zu bytes of workspace; got %d, %zu\n", (size_t)WS_END, n_in, ws_size); grid = -1; return; }
        int dev = 0, cus = 0, per_cu = 0;
        (void)hipGetDevice(&dev); (void)hipDeviceGetAttribute(&cus, hipDeviceAttributeMultiprocessorCount, dev);
        (void)hipFuncSetAttribute((const void*)fwd_kernel, hipFuncAttributeMaxDynamicSharedMemorySize, LDS_BYTES);
        (void)hipOccupancyMaxActiveBlocksPerMultiprocessor(&per_cu, (const void*)fwd_kernel, NTHR, LDS_BYTES);
        if (per_cu < 1) { fprintf(stderr, "kernel_launch: occupancy query says %d blocks per CU\n", per_cu); per_cu = 1; }
        (void)hipGetLastError();
        grid = cus > 0 ? cus : 256;
    }
    if (grid < 0) return;
    (void)hipMemsetAsync(d_ws, 0, 64 * 1024, stream);
    Args a{};
    for (int i = 0; i < 44; ++i) a.in[i] = (const float*)d_in[i];
    a.out = (float*)d_out; a.ws = (unsigned char*)d_ws;
#if MK_MULTI
    for (int ph = 0; ph < NPH; ++ph) { a.ph_lo = ph; a.ph_hi = ph + 1; hipLaunchKernelGGL(fwd_kernel, dim3(grid), dim3(NTHR), LDS_BYTES, stream, a); }
#else
    a.ph_lo = 0; a.ph_hi = NPH;
    void* kargs[] = {&a};
    hipError_t e = hipLaunchCooperativeKernel((const void*)fwd_kernel, dim3(grid), dim3(NTHR), kargs, LDS_BYTES, stream);
    if (e != hipSuccess) fprintf(stderr, "cooperative launch failed: %s (grid %d)\n", hipGetErrorString(e), grid);
#endif
}
```

```cpp
#include <hip/hip_runtime.h>
#include <hip/hip_cooperative_groups.h>
#include <cstdio>
#include <cstdint>
namespace cg = cooperative_groups;

#ifndef MK_MULTI
#define MK_MULTI 0
#endif

namespace pg8 {
#define PG8_LAS __attribute__((address_space(3)))
typedef unsigned short bf16_t;
typedef short bf16x8 __attribute__((ext_vector_type(8)));
typedef float f32x4 __attribute__((ext_vector_type(4)));
typedef unsigned u32x4 __attribute__((ext_vector_type(4)));
constexpr int BM = 256, BK = 64, HALF = 128, HTB = HALF * BK * 2  , STAGE_BYTES = 8 * HTB, NXCD = 8, WGM = 8;

__host__ __device__ __forceinline__ int lds_byte(int r, int c) { const int st = (r >> 4) * 2 + (c >> 5), rr = r & 15, cc = c & 31, ob = rr * 64 + cc * 2; return st * 1024 + (ob ^ (((ob >> 9) & 1) << 5)); }
__host__ __device__ __forceinline__ void stage_rc(int b, int& R, int& C) { const int st = b / 1024, sb = b % 1024, swz = sb ^ (((sb >> 9) & 1) << 5); R = (st >> 1) * 16 + swz / 64; C = (st & 1) * 32 + (swz % 64) / 2; }
__host__ __device__ __forceinline__ int perm32(int rho) { const int n = rho >> 4, i = rho & 15; return 8 * (i >> 2) + 4 * n + (i & 3); }

struct Unit { int pm, pn; };
struct Gemm { const bf16_t* A; const bf16_t* Bt; int M, N, K, lda, ldb, a_div; size_t a_gstride; };

struct StaticOrder {
    int nM, nN, nwg, G, c;
    __host__ __device__ void init(int M, int N, int G_, int c_) { nM = M / BM; nN = N / BM; nwg = nM * nN; G = G_; c = c_; }
    __host__ __device__ bool next(int i, Unit& u) const {
        const long L = (long)i * G + c; if (L >= nwg) return false;
        int wgid = (int)L; { const int q = nwg / NXCD, r = nwg % NXCD, xcd = wgid % NXCD, off = wgid / NXCD; wgid = (xcd < r ? xcd * (q + 1) : r * (q + 1) + (xcd - r) * q) + off; }
        const int nig = WGM * nN, gid = wgid / nig, fm = gid * WGM, gsz = (nM - fm) < WGM ? (nM - fm) : WGM;
        u.pm = fm + ((wgid % nig) % gsz); u.pn = (wgid % nig) / gsz; return true;
    }
    __device__ __forceinline__ void a_ready(const Unit&) const {}
    __device__ __forceinline__ void done(const Unit&) const {}
};

__device__ __forceinline__ unsigned cvt_pk_bf16(float lo, float hi) { unsigned r; asm volatile("v_cvt_pk_bf16_f32 %0, %1, %2" : "=v"(r) : "v"(lo), "v"(hi)); return r; }
__device__ __forceinline__ float bf_lo(unsigned w) { return __builtin_bit_cast(float, w << 16); }
__device__ __forceinline__ float bf_hi(unsigned w) { return __builtin_bit_cast(float, w & 0xffff0000u); }
__device__ __forceinline__ float sigmoidf_(float x) { return 1.0f / (1.0f + __expf(-x)); }

template <int MODE> struct EpiB {
    static constexpr bool PERM = true, AFTER_DRAIN = false;
    bf16_t* O; int ldc; const float* bias; const float* ssq;
    __device__ __forceinline__ void operator()(const f32x4 (&acc)[2][2][4][2], const Unit& u, int wr, int wc, int fr, int fq) const {
        const int row0 = u.pm * BM + wr * 64 + fr, col0 = u.pn * BM + wc * 32 + 8 * fq;
        f32x4 bv[2][2];
#pragma unroll
        for (int bj = 0; bj < 2; ++bj)
#pragma unroll
            for (int n = 0; n < 2; ++n) bv[bj][n] = (MODE == 1) ? *(const f32x4*)(bias + col0 + bj * HALF + 4 * n) : (MODE == 5) ? *(const f32x4*)(bias + (size_t)((u.pm < 32) ? 0 : 1 + ((u.pm - 32) >> 2)) * 4096 + col0 + bj * HALF + 4 * n) : (f32x4){0.f, 0.f, 0.f, 0.f};
        u32x4 gpre[2][4][2]; float rpre[2][4];
        if (MODE == 3) {
#pragma unroll
            for (int ai = 0; ai < 2; ++ai)
#pragma unroll
                for (int m = 0; m < 4; ++m) { const int row = row0 + ai * HALF + m * 16; const bf16_t* rp = O + (size_t)row * ldc + col0;
                    rpre[ai][m] = (u.pn < 4) ? ssq[row] : 512.0f;
#pragma unroll
                    for (int bj = 0; bj < 2; ++bj) gpre[ai][m][bj] = *(const u32x4*)(rp + bj * HALF); }
        }
#pragma unroll
        for (int ai = 0; ai < 2; ++ai)
#pragma unroll
            for (int m = 0; m < 4; ++m) {
                const int row = row0 + ai * HALF + m * 16;
                bf16_t* rowp = O + (size_t)row * ldc + col0;
                float rs = 1.f;
                if (MODE == 3) { if (u.pn < 4) rs = rsqrtf(rpre[ai][m] * (1.0f / 512.0f) + 1e-6f); }
                if (MODE == 5) rs = rsqrtf(ssq[row] * (1.0f / 1024.0f) + 1e-6f);
#pragma unroll
                for (int bj = 0; bj < 2; ++bj) {
                    f32x4 v0 = (MODE == 5 ? acc[ai][bj][m][0] * rs : acc[ai][bj][m][0]) + bv[bj][0], v1 = (MODE == 5 ? acc[ai][bj][m][1] * rs : acc[ai][bj][m][1]) + bv[bj][1];
                    if (MODE == 1) {
#pragma unroll
                        for (int j = 0; j < 4; ++j) { v0[j] = sigmoidf_(v0[j]); v1[j] = sigmoidf_(v1[j]); }
                    }
                    if (MODE == 2 || MODE == 5) {
#pragma unroll
                        for (int j = 0; j < 4; ++j) { const float a = fmaxf(v0[j], 0.f), b = fmaxf(v1[j], 0.f); v0[j] = a * a; v1[j] = b * b; }
                    }
                    if (MODE == 3) {
                        const u32x4 gq = gpre[ai][m][bj];
                        v0[0] *= bf_lo(gq.x) * rs; v0[1] *= bf_hi(gq.x) * rs; v0[2] *= bf_lo(gq.y) * rs; v0[3] *= bf_hi(gq.y) * rs;
                        v1[0] *= bf_lo(gq.z) * rs; v1[1] *= bf_hi(gq.z) * rs; v1[2] *= bf_lo(gq.w) * rs; v1[3] *= bf_hi(gq.w) * rs;
                    }
                    u32x4 w; w.x = cvt_pk_bf16(v0[0], v0[1]); w.y = cvt_pk_bf16(v0[2], v0[3]); w.z = cvt_pk_bf16(v1[0], v1[1]); w.w = cvt_pk_bf16(v1[2], v1[3]);
                    *(u32x4*)(rowp + bj * HALF) = w;
                }
            }
    }
};
struct EpiGlu {
    static constexpr bool PERM = true, AFTER_DRAIN = false;
    bf16_t* O; int ldc; int ocol; const float* bias;
    __device__ __forceinline__ void operator()(const f32x4 (&acc)[2][2][4][2], const Unit& u, int wr, int wc, int fr, int fq) const {
        const int row0 = u.pm * BM + wr * 64 + fr, cc = u.pn * HALF + wc * 32 + 8 * fq;
        f32x4 bv[2][2];
#pragma unroll
        for (int bj = 0; bj < 2; ++bj)
#pragma unroll
            for (int n = 0; n < 2; ++n) bv[bj][n] = *(const f32x4*)(bias + bj * 512 + cc + 4 * n);
#pragma unroll
        for (int ai = 0; ai < 2; ++ai)
#pragma unroll
            for (int m = 0; m < 4; ++m) {
                bf16_t* rowp = O + (size_t)(row0 + ai * HALF + m * 16) * ldc + ocol + cc;
                f32x4 v0 = acc[ai][0][m][0] + bv[0][0], v1 = acc[ai][0][m][1] + bv[0][1];
                const f32x4 g0 = acc[ai][1][m][0] + bv[1][0], g1 = acc[ai][1][m][1] + bv[1][1];
#pragma unroll
                for (int j = 0; j < 4; ++j) { v0[j] *= sigmoidf_(g0[j]); v1[j] *= sigmoidf_(g1[j]); }
                u32x4 w; w.x = cvt_pk_bf16(v0[0], v0[1]); w.y = cvt_pk_bf16(v0[2], v0[3]); w.z = cvt_pk_bf16(v1[0], v1[1]); w.w = cvt_pk_bf16(v1[2], v1[3]);
                *(u32x4*)rowp = w;
            }
    }
};
struct EpiRes2 {
    static constexpr bool PERM = false, AFTER_DRAIN = false;
    const float* base_ctx; const float* base_lat; float* out; const float* modv; int goff;
    bf16_t* xn; const float* gnorm; int scoff; float* ssq;
    __device__ __forceinline__ void operator()(const f32x4 (&acc)[2][2][4][2], const Unit& u, int wr, int wc, int fr, int fq) const {
        const int row0 = u.pm * BM + wr * 64 + fr, col0 = u.pn * BM + wc * 32 + 4 * fq;
        const int mi = (u.pm < 32) ? 0 : 1 + ((u.pm - 32) >> 2);
        const float* gv = modv + (size_t)mi * 6144 + goff; const float* sv = modv + (size_t)mi * 6144 + scoff;
        f32x4 gg[2][2], gn[2][2];
#pragma unroll
        for (int bj = 0; bj < 2; ++bj)
#pragma unroll
            for (int n = 0; n < 2; ++n) { gg[bj][n] = *(const f32x4*)(gv + col0 + bj * HALF + n * 16); gn[bj][n] = *(const f32x4*)(gnorm + col0 + bj * HALF + n * 16) * (*(const f32x4*)(sv + col0 + bj * HALF + n * 16) + 1.0f); }
#pragma unroll
        for (int ai = 0; ai < 2; ++ai)
#pragma unroll
        for (int mh = 0; mh < 2; ++mh) {
            f32x4 pre[2][2][2];
#pragma unroll
            for (int mm = 0; mm < 2; ++mm) { const int row = row0 + ai * HALF + (2 * mh + mm) * 16;
                const float* bp = (row < 8192 ? base_ctx + (size_t)row * 1024 : base_lat + (size_t)(row - 8192) * 1024) + col0;
#pragma unroll
                for (int bj = 0; bj < 2; ++bj)
#pragma unroll
                    for (int n = 0; n < 2; ++n) pre[mm][bj][n] = *(const f32x4*)(bp + bj * HALF + n * 16); }
#pragma unroll
            for (int mm = 0; mm < 2; ++mm) { const int m = 2 * mh + mm; const int row = row0 + ai * HALF + m * 16; float* op = out + (size_t)row * 1024 + col0; bf16_t* xp = xn + (size_t)row * 1024 + col0;
                float q = 0.f;
#pragma unroll
                for (int bj = 0; bj < 2; ++bj)
#pragma unroll
                    for (int n = 0; n < 2; ++n) { const f32x4 x = pre[mm][bj][n] + gg[bj][n] * acc[ai][bj][m][n]; *(f32x4*)(op + bj * HALF + n * 16) = x;
                        q += (x[0] * x[0] + x[1] * x[1]) + (x[2] * x[2] + x[3] * x[3]);
                        const f32x4 y = x * gn[bj][n]; unsigned w0 = cvt_pk_bf16(y[0], y[1]), w1 = cvt_pk_bf16(y[2], y[3]);
                        typedef unsigned u32x2 __attribute__((ext_vector_type(2))); *(u32x2*)(xp + bj * HALF + n * 16) = (u32x2){w0, w1}; }
                q += __shfl_xor(q, 16); q += __shfl_xor(q, 32);
                if (fq == 0) atomicAdd(ssq + row, q); }
            asm volatile("" ::: "memory");
        }
    }
};
struct EpiMerge {
    static constexpr bool PERM = true, AFTER_DRAIN = false;
    const bf16_t* gates; bf16_t* mg; const float* ssq;
    __device__ __forceinline__ void operator()(const f32x4 (&acc)[2][2][4][2], const Unit& u, int wr, int wc, int fr, int fq) const {
        const int br = u.pn >> 2, pnl = u.pn & 3;
        int pm_o = u.pm; asm volatile("" : "+s"(pm_o));
        const int row0 = pm_o * BM + wr * 64 + fr, gcol0 = u.pn * BM + wc * 32 + 8 * fq, mcol0 = pnl * BM + wc * 32 + 8 * fq;
#pragma unroll
        for (int ai = 0; ai < 2; ++ai)
#pragma unroll
        for (int mh = 0; mh < 2; ++mh) {
            u32x4 gpre[2][2], mpre[2][2]; float rpre[2];
#pragma unroll
            for (int mm = 0; mm < 2; ++mm) { const int row = row0 + ai * HALF + (2 * mh + mm) * 16;
                rpre[mm] = (br == 0) ? ssq[row] : 512.0f;
#pragma unroll
                for (int bj = 0; bj < 2; ++bj) { gpre[mm][bj] = *(const u32x4*)(gates + (size_t)row * 4096 + gcol0 + bj * HALF);
                    mpre[mm][bj] = (br != 0) ? *(const u32x4*)(mg + (size_t)row * 1024 + mcol0 + bj * HALF) : (u32x4){0u, 0u, 0u, 0u}; } }
#pragma unroll
            for (int mm = 0; mm < 2; ++mm) { const int m = 2 * mh + mm; const int row = row0 + ai * HALF + m * 16;
                const float rs = (br == 0) ? rsqrtf(rpre[mm] * (1.0f / 512.0f) + 1e-6f) : 1.0f;
#pragma unroll
                for (int bj = 0; bj < 2; ++bj) { const u32x4 gq = gpre[mm][bj], mq = mpre[mm][bj]; const f32x4 a0 = acc[ai][bj][m][0], a1 = acc[ai][bj][m][1];
                    const float v0 = bf_lo(mq.x) + a0[0] * bf_lo(gq.x) * rs, v1 = bf_hi(mq.x) + a0[1] * bf_hi(gq.x) * rs, v2 = bf_lo(mq.y) + a0[2] * bf_lo(gq.y) * rs, v3 = bf_hi(mq.y) + a0[3] * bf_hi(gq.y) * rs;
                    const float v4 = bf_lo(mq.z) + a1[0] * bf_lo(gq.z) * rs, v5 = bf_hi(mq.z) + a1[1] * bf_hi(gq.z) * rs, v6 = bf_lo(mq.w) + a1[2] * bf_lo(gq.w) * rs, v7 = bf_hi(mq.w) + a1[3] * bf_hi(gq.w) * rs;
                    u32x4 w; w.x = cvt_pk_bf16(v0, v1); w.y = cvt_pk_bf16(v2, v3); w.z = cvt_pk_bf16(v4, v5); w.w = cvt_pk_bf16(v6, v7);
                    *(u32x4*)(mg + (size_t)row * 1024 + mcol0 + bj * HALF) = w; } }
            asm volatile("" ::: "memory");
        }
    }
};
struct BranchOrder {
    int G, c;
    __host__ __device__ void init(int G_, int c_) { G = G_; c = c_; }
    __host__ __device__ bool next(int i, Unit& u) const { if (c >= 192 || i >= 4) return false; u.pm = c >> 2; u.pn = i * 4 + (c & 3); return true; }
    __device__ __forceinline__ void a_ready(const Unit&) const {}
    __device__ __forceinline__ void done(const Unit&) const {}
};
struct EpiRes {
    static constexpr bool PERM = false, AFTER_DRAIN = false;
    const float* base_ctx; const float* base_lat;
    float* out; const float* modv;
    int goff;
    __device__ __forceinline__ void operator()(const f32x4 (&acc)[2][2][4][2], const Unit& u, int wr, int wc, int fr, int fq) const {
        const int row0 = u.pm * BM + wr * 64 + fr, col0 = u.pn * BM + wc * 32 + 4 * fq;
        const int mi = (u.pm < 32) ? 0 : 1 + ((u.pm - 32) >> 2);
        const float* gv = modv + (size_t)mi * 6144 + goff;
        f32x4 gg[2][2];
#pragma unroll
        for (int bj = 0; bj < 2; ++bj)
#pragma unroll
            for (int n = 0; n < 2; ++n) gg[bj][n] = *(const f32x4*)(gv + col0 + bj * HALF + n * 16);
#pragma unroll
        for (int ai = 0; ai < 2; ++ai) {
            f32x4 pre[4][2][2];
#pragma unroll
            for (int m = 0; m < 4; ++m) { const int row = row0 + ai * HALF + m * 16;
                const float* bp = (row < 8192 ? base_ctx + (size_t)row * 1024 : base_lat + (size_t)(row - 8192) * 1024) + col0;
#pragma unroll
                for (int bj = 0; bj < 2; ++bj)
#pragma unroll
                    for (int n = 0; n < 2; ++n) pre[m][bj][n] = *(const f32x4*)(bp + bj * HALF + n * 16); }
#pragma unroll
            for (int m = 0; m < 4; ++m) { const int row = row0 + ai * HALF + m * 16; float* op = out + (size_t)row * 1024 + col0;
#pragma unroll
                for (int bj = 0; bj < 2; ++bj)
#pragma unroll
                    for (int n = 0; n < 2; ++n) *(f32x4*)(op + bj * HALF + n * 16) = pre[m][bj][n] + gg[bj][n] * acc[ai][bj][m][n]; }
            asm volatile("" ::: "memory");
        }
    }
};

template <class Epi, class Sched, bool ALIGN_EPI = false, bool SP2 = false>
__device__ __forceinline__ void gemm_phase(PG8_LAS unsigned char* lds, const Gemm g, const Sched& S, const Epi& E, const int tid) {
    const int wid = __builtin_amdgcn_readfirstlane(tid >> 6), lane = tid & 63, wr = wid >> 2, wc = wid & 3, fr = lane & 15, fq = lane >> 4;
    const int K = g.K, nt = K / BK;
    unsigned voffA[2], voffB[2];
#pragma unroll
    for (int i = 0; i < 2; ++i) { int R, C; stage_rc(tid * 16 + i * 8192, R, C); const int Rb = Epi::PERM ? ((R & ~31) + perm32(R & 31)) : R;
        voffA[i] = (unsigned)(R * g.lda + C) * 2u; voffB[i] = (unsigned)(Rb * g.ldb + C) * 2u; }
    const size_t kstep = (size_t)(BK * 2);
    const size_t hstepA = (size_t)HALF * g.lda * 2, hstepB = (size_t)HALF * g.ldb * 2;
    const size_t tstepA = 2 * hstepA, tstepB = 2 * hstepB;
#define PG8_UA(u) ((const char*)g.A + (size_t)(u).pm * tstepA + (g.a_div ? (size_t)((u).pn / g.a_div) * g.a_gstride : (size_t)0))
#define PG8_UB(u) ((const char*)g.Bt + (size_t)(u).pn * tstepB)
    const unsigned ldsw = (unsigned)wid * 1024u;
    const int aoff = lds_byte(wr * 64 + fr, fq * 8), boff = lds_byte(wc * 32 + fr, fq * 8);
#define PG8_SA(b, h) (((b) * 2 + (h)) * HTB)
#define PG8_SB(b, h) ((4 + (b) * 2 + (h)) * HTB)
#define PG8_STAGE(bufoff, gbase, voff) do { _Pragma("unroll") for (int _i = 0; _i < 2; ++_i) \
        __builtin_amdgcn_global_load_lds((const unsigned*)((const char*)(gbase) + (voff)[_i]), (PG8_LAS unsigned*)(lds + (bufoff) + ldsw + _i * 8192), 16, 0, 0); } while (0)
#define PG8_LDA(dst, b, h) do { _Pragma("unroll") for (int m = 0; m < 4; ++m) _Pragma("unroll") for (int k = 0; k < 2; ++k) dst[m][k] = *(const PG8_LAS bf16x8*)(lds + PG8_SA(b, h) + aoff + m * 2048 + k * 1024); } while (0)
#define PG8_LDB(dst, b, h) do { _Pragma("unroll") for (int n = 0; n < 2; ++n) _Pragma("unroll") for (int k = 0; k < 2; ++k) dst[n][k] = *(const PG8_LAS bf16x8*)(lds + PG8_SB(b, h) + boff + n * 2048 + k * 1024); } while (0)
#define PG8_MMA(ai, bj, At, Bt) do { __builtin_amdgcn_s_setprio(1); _Pragma("unroll") for (int m = 0; m < 4; ++m) _Pragma("unroll") for (int n = 0; n < 2; ++n) _Pragma("unroll") for (int k = 0; k < 2; ++k) \
        acc[ai][bj][m][n] = __builtin_amdgcn_mfma_f32_16x16x32_bf16(Bt[n][k], At[m][k], acc[ai][bj][m][n], 0, 0, 0); __builtin_amdgcn_s_setprio(0); } while (0)
#define PG8_WAIT_V(n) asm volatile("s_waitcnt vmcnt(" #n ")" ::: "memory")
#define PG8_WAIT_L(n) asm volatile("s_waitcnt lgkmcnt(" #n ")" ::: "memory")
#define PG8_BAR __builtin_amdgcn_s_barrier()
#define PG8_SCHED __builtin_amdgcn_sched_barrier(0)
    Unit cur, nxt; int ui = 0;
    if (!S.next(0, cur)) return;
    f32x4 acc[2][2][4][2];
#pragma unroll
    for (int a = 0; a < 2; ++a)
#pragma unroll
        for (int b = 0; b < 2; ++b)
#pragma unroll
            for (int m = 0; m < 4; ++m)
#pragma unroll
                for (int n = 0; n < 2; ++n) acc[a][b][m][n] = (f32x4){0.f, 0.f, 0.f, 0.f};
    bf16x8 At[4][2], B0[2][2], B1[2][2];
    const char* cA = PG8_UA(cur); const char* cB = PG8_UB(cur);
    S.a_ready(cur);
    if constexpr (SP2) {
        PG8_STAGE(PG8_SB(0, 0), cB, voffB); PG8_STAGE(PG8_SB(0, 1), cB + hstepB, voffB); PG8_STAGE(PG8_SA(0, 0), cA, voffA); PG8_STAGE(PG8_SA(0, 1), cA + hstepA, voffA);
        if (wr == 1) PG8_BAR;
        PG8_WAIT_V(2); PG8_BAR;
        PG8_STAGE(PG8_SB(1, 0), cB + kstep, voffB); PG8_STAGE(PG8_SA(1, 0), cA + kstep, voffA); PG8_STAGE(PG8_SB(1, 1), cB + hstepB + kstep, voffB);
        PG8_WAIT_V(6); PG8_BAR;
    } else {
        PG8_STAGE(PG8_SB(0, 0), cB, voffB); PG8_STAGE(PG8_SA(0, 0), cA, voffA); PG8_STAGE(PG8_SB(0, 1), cB + hstepB, voffB); PG8_STAGE(PG8_SA(0, 1), cA + hstepA, voffA);
        if (wr == 1) PG8_BAR;
        PG8_WAIT_V(4); PG8_BAR;
        PG8_STAGE(PG8_SB(1, 0), cB + kstep, voffB); PG8_STAGE(PG8_SA(1, 0), cA + kstep, voffA); PG8_STAGE(PG8_SB(1, 1), cB + hstepB + kstep, voffB);
        PG8_WAIT_V(6); PG8_BAR;
    }
    for (;;) {
        const bool has_next = S.next(ui + 1, nxt);
        const char* nA = has_next ? PG8_UA(nxt) : cA; const char* nB = has_next ? PG8_UB(nxt) : cB;
        for (int t = 0; t < nt; t += 2) {
            const bool last = (t == nt - 2);
            const char* a1 = cA + (size_t)(t + 1) * kstep;
            const char* a2 = last ? nA : cA + (size_t)(t + 2) * kstep; const char* b2 = last ? nB : cB + (size_t)(t + 2) * kstep;
            const char* a3 = a2 + kstep; const char* b3 = b2 + kstep;
            if (last && has_next) S.a_ready(nxt);
            if constexpr (SP2) {
            PG8_LDB(B0, 0, 0); PG8_LDB(B1, 0, 1); PG8_SCHED; PG8_LDA(At, 0, 0); PG8_STAGE(PG8_SA(1, 1), a1 + hstepA, voffA);
            PG8_WAIT_V(8); PG8_WAIT_L(0); PG8_BAR; PG8_MMA(0, 0, At, B0); PG8_MMA(0, 1, At, B1); PG8_BAR; PG8_SCHED;
            PG8_LDA(At, 0, 1); PG8_STAGE(PG8_SB(0, 0), b2, voffB); PG8_STAGE(PG8_SB(0, 1), b2 + hstepB, voffB); PG8_STAGE(PG8_SA(0, 0), a2, voffA);
            PG8_WAIT_V(8); PG8_WAIT_L(0); PG8_BAR; PG8_MMA(1, 0, At, B0); PG8_MMA(1, 1, At, B1); PG8_BAR; PG8_SCHED;
            PG8_LDB(B0, 1, 0); PG8_LDB(B1, 1, 1); PG8_SCHED; PG8_LDA(At, 1, 0); PG8_STAGE(PG8_SA(0, 1), a2 + hstepA, voffA);
            PG8_WAIT_V(8); PG8_WAIT_L(0); PG8_BAR; PG8_MMA(0, 0, At, B0); PG8_MMA(0, 1, At, B1); PG8_BAR; PG8_SCHED;
            PG8_LDA(At, 1, 1); PG8_STAGE(PG8_SB(1, 0), b3, voffB); PG8_STAGE(PG8_SB(1, 1), b3 + hstepB, voffB); PG8_STAGE(PG8_SA(1, 0), a3, voffA);
            PG8_WAIT_V(8); PG8_WAIT_L(0); PG8_BAR; PG8_MMA(1, 0, At, B0); PG8_MMA(1, 1, At, B1); PG8_BAR; PG8_SCHED;
            } else {
            PG8_LDB(B0, 0, 0); PG8_SCHED; PG8_LDA(At, 0, 0); PG8_STAGE(PG8_SA(1, 1), a1 + hstepA, voffA);
            PG8_WAIT_L(8); PG8_BAR; PG8_WAIT_L(0); PG8_MMA(0, 0, At, B0); PG8_BAR; PG8_SCHED;
            PG8_LDB(B1, 0, 1); PG8_STAGE(PG8_SB(0, 0), b2, voffB);
            PG8_BAR; PG8_WAIT_L(0); PG8_MMA(0, 1, At, B1); PG8_BAR;
            PG8_LDA(At, 0, 1); PG8_STAGE(PG8_SA(0, 0), a2, voffA);
            PG8_BAR; PG8_WAIT_L(0); PG8_MMA(1, 0, At, B0); PG8_BAR; PG8_SCHED;
            PG8_STAGE(PG8_SB(0, 1), b2 + hstepB, voffB);
            PG8_WAIT_V(6); PG8_BAR; PG8_MMA(1, 1, At, B1); PG8_BAR;
            PG8_LDB(B0, 1, 0); PG8_SCHED; PG8_LDA(At, 1, 0); PG8_STAGE(PG8_SA(0, 1), a2 + hstepA, voffA);
            PG8_WAIT_L(8); PG8_BAR; PG8_WAIT_L(0); PG8_MMA(0, 0, At, B0); PG8_BAR; PG8_SCHED;
            PG8_LDB(B1, 1, 1); PG8_STAGE(PG8_SB(1, 0), b3, voffB);
            PG8_BAR; PG8_WAIT_L(0); PG8_MMA(0, 1, At, B1); PG8_BAR;
            PG8_LDA(At, 1, 1); PG8_STAGE(PG8_SA(1, 0), a3, voffA);
            PG8_BAR; PG8_WAIT_L(0); PG8_MMA(1, 0, At, B0); PG8_BAR; PG8_SCHED;
            PG8_STAGE(PG8_SB(1, 1), b3 + hstepB, voffB);
            PG8_WAIT_V(6); PG8_BAR; PG8_MMA(1, 1, At, B1); PG8_BAR;
            }
        }
        if constexpr (ALIGN_EPI) { if (wr == 0) PG8_BAR; }
        if constexpr (!Epi::AFTER_DRAIN) { E(acc, cur, wr, wc, fr, fq); S.done(cur); }
        if (!has_next) break;
#pragma unroll
        for (int a = 0; a < 2; ++a)
#pragma unroll
            for (int b = 0; b < 2; ++b)
#pragma unroll
                for (int m = 0; m < 4; ++m)
#pragma unroll
                    for (int n = 0; n < 2; ++n) acc[a][b][m][n] = (f32x4){0.f, 0.f, 0.f, 0.f};
        cur = nxt; cA = nA; cB = nB; ++ui;
        if constexpr (ALIGN_EPI) { if (wr == 1) PG8_BAR; }
    }
    PG8_WAIT_V(0);
    if constexpr (!ALIGN_EPI) { if (wr == 0) PG8_BAR; }
    PG8_BAR;
    if constexpr (Epi::AFTER_DRAIN) { E.fused(acc, cur, wr, wc, fr, fq, lds, wid, lane); S.done(cur); }
#undef PG8_UA
#undef PG8_UB
#undef PG8_SA
#undef PG8_SB
#undef PG8_STAGE
#undef PG8_LDA
#undef PG8_LDB
#undef PG8_MMA
#undef PG8_WAIT_V
#undef PG8_WAIT_L
#undef PG8_BAR
#undef PG8_SCHED
}
}

#ifndef PG8_SP2
#define PG8_SP2 true
#endif
#ifndef PG8_ALIGN
#define PG8_ALIGN true
#endif

typedef unsigned short bf16;
typedef unsigned v4u __attribute__((ext_vector_type(4)));
typedef unsigned v2u __attribute__((ext_vector_type(2)));
typedef float f32x4 __attribute__((ext_vector_type(4)));
#define LAS __attribute__((address_space(3)))

constexpr int NWAVES = 8, NTHR = 512;
constexpr int D = 1024, MC = 8192, ML = 4096, M = 12288, NPH = 23;
constexpr int LDS_BYTES = 147456;
constexpr float EPS = 1e-6f;
constexpr size_t MiB = 1u << 20;
constexpr size_t WS_MOD = 64 * 1024;
constexpr size_t WS_SSQ = 320 * 1024;
constexpr size_t WS_DT = 384 * 1024;
constexpr size_t WS_W = 2 * MiB;
constexpr size_t W_IN = WS_W, W_G = W_IN + 8 * MiB, W_GLU = W_G + 8 * MiB, W_BR = W_GLU + 1 * MiB, W_OUT = W_BR + 4 * MiB, W_1 = W_OUT + 2 * MiB, W_2 = W_1 + 8 * MiB;
constexpr size_t WS_H = 41 * MiB;
constexpr size_t WS_R1 = 65 * MiB;
constexpr size_t WS_Y = 161 * MiB;
constexpr size_t WS_Y5 = 209 * MiB;
constexpr size_t WS_XC = 221 * MiB;
constexpr size_t WS_S5K = 239 * MiB;
constexpr size_t WS_S5WS = 240 * MiB;
constexpr size_t WS_S5WO = 244 * MiB;
constexpr size_t WS_S5AT = 248 * MiB;
constexpr size_t WS_CKV = 248 * MiB + 512 * 1024;
constexpr size_t WS_ROPE = 1536 * 1024;
constexpr size_t WS_WDT = 1792 * 1024;
constexpr size_t WS_BI2 = 1824 * 1024;
constexpr size_t WS_SSQ2 = 1904 * 1024;
constexpr size_t WS_END = 254 * MiB;
#ifndef PROBE_SEL
#define PROBE_SEL -1
#endif
#ifndef PROBE_SCALE
#define PROBE_SCALE 4e-4f
#endif
#ifndef PROBE_PB
#define PROBE_PB 32
#endif
constexpr size_t WS_BAR = 32 * 1024;
constexpr size_t WS_QCTR = 48 * 1024;
constexpr size_t WS_TS = 16 * 1024;
constexpr size_t O_SSD = 12582912, O_S5 = 16777216, O_DK = 17301504, O_DV = 25690112, O_WK = 34078720, O_WV = 36175872;
constexpr int C_Z = 0, C_XBC = 512, C_U = 1280, C_DQ = 1792, C_DK = 2304, C_DV = 2816, C_WQ = 3328, C_WK = 3840, C_WV = 3968;

struct Args { const float* in[44]; float* out; unsigned char* ws; int ph_lo, ph_hi; };

typedef const Args __attribute__((address_space(4)))* CArgs;
struct Ctx {
    CArgs ap; int tid, lane, wave;
    __device__ __forceinline__ const float* x_prompt() const { return ap->in[0]; }
    __device__ __forceinline__ const float* x_sample() const { return ap->in[1]; }
    __device__ __forceinline__ const float* state_ssd() const { return ap->in[2]; }
    __device__ __forceinline__ const float* state_s5() const { return ap->in[3]; }
    __device__ __forceinline__ const float* cache_dk() const { return ap->in[4]; }
    __device__ __forceinline__ const float* cache_dv() const { return ap->in[5]; }
    __device__ __forceinline__ const float* cache_wk() const { return ap->in[6]; }
    __device__ __forceinline__ const float* cache_wv() const { return ap->in[7]; }
    __device__ __forceinline__ const float* cvec() const { return ap->in[8]; }
    __device__ __forceinline__ const float* c_ctx() const { return ap->in[9]; }
    __device__ __forceinline__ const float* w_mod() const { return ap->in[10]; }
    __device__ __forceinline__ const float* b_mod() const { return ap->in[11]; }
    __device__ __forceinline__ const float* g_norm1() const { return ap->in[12]; }
    __device__ __forceinline__ const float* g_norm2() const { return ap->in[13]; }
    __device__ __forceinline__ const float* w_in() const { return ap->in[14]; }
    __device__ __forceinline__ const float* conv_w() const { return ap->in[15]; }
    __device__ __forceinline__ const float* conv_b() const { return ap->in[16]; }
    __device__ __forceinline__ const float* dt_bias() const { return ap->in[17]; }
    __device__ __forceinline__ const float* a_log() const { return ap->in[18]; }
    __device__ __forceinline__ const float* ssd_d() const { return ap->in[19]; }
    __device__ __forceinline__ const float* ssd_norm_g() const { return ap->in[20]; }
    __device__ __forceinline__ const float* lam_re() const { return ap->in[21]; }
    __device__ __forceinline__ const float* lam_im() const { return ap->in[22]; }
    __device__ __forceinline__ const float* log_step() const { return ap->in[23]; }
    __device__ __forceinline__ const float* b_re() const { return ap->in[24]; }
    __device__ __forceinline__ const float* b_im() const { return ap->in[25]; }
    __device__ __forceinline__ const float* c_re() const { return ap->in[26]; }
    __device__ __forceinline__ const float* c_im() const { return ap->in[27]; }
    __device__ __forceinline__ const float* s5_d() const { return ap->in[28]; }
    __device__ __forceinline__ const float* w_glu() const { return ap->in[29]; }
    __device__ __forceinline__ const float* b_glu() const { return ap->in[30]; }
    __device__ __forceinline__ const float* qn_g() const { return ap->in[31]; }
    __device__ __forceinline__ const float* kn_g() const { return ap->in[32]; }
    __device__ __forceinline__ const float* dlam() const { return ap->in[33]; }
    __device__ __forceinline__ const float* subln_g() const { return ap->in[34]; }
    __device__ __forceinline__ const float* wqn_g() const { return ap->in[35]; }
    __device__ __forceinline__ const float* wkn_g() const { return ap->in[36]; }
    __device__ __forceinline__ const float* sink() const { return ap->in[37]; }
    __device__ __forceinline__ const float* w_branch() const { return ap->in[38]; }
    __device__ __forceinline__ const float* w_gate() const { return ap->in[39]; }
    __device__ __forceinline__ const float* b_gate() const { return ap->in[40]; }
    __device__ __forceinline__ const float* w_out() const { return ap->in[41]; }
    __device__ __forceinline__ const float* w_fc1() const { return ap->in[42]; }
    __device__ __forceinline__ const float* w_fc2() const { return ap->in[43]; }
    __device__ __forceinline__ float* out() const { return ap->out; }
    __device__ __forceinline__ unsigned char* ws() const { return ap->ws; }
    __device__ __forceinline__ float* MOD() const { return (float*)(ap->ws + WS_MOD); }
    __device__ __forceinline__ float* SSQ() const { return (float*)(ap->ws + WS_SSQ); }
    __device__ __forceinline__ float* DT() const { return (float*)(ap->ws + WS_DT); }
    __device__ __forceinline__ bf16* H() const { return (bf16*)(ap->ws + WS_H); }
    __device__ __forceinline__ bf16* R1() const { return (bf16*)(ap->ws + WS_R1); }
    __device__ __forceinline__ bf16* Y() const { return (bf16*)(ap->ws + WS_Y); }
    __device__ __forceinline__ bf16* Y5() const { return (bf16*)(ap->ws + WS_Y5); }
    __device__ __forceinline__ bf16* XC() const { return (bf16*)(ap->ws + WS_XC); }
    __device__ __forceinline__ bf16* CKV() const { return (bf16*)(ap->ws + WS_CKV); }
    __device__ __forceinline__ float* ROPE() const { return (float*)(ap->ws + WS_ROPE); }
};

__device__ __forceinline__ float wave_sum(float v) {
#pragma unroll
    for (int o = 1; o < 64; o <<= 1) v += __shfl_xor(v, o);
    return v;
}
__device__ __forceinline__ float wave_max(float v) {
#pragma unroll
    for (int o = 1; o < 64; o <<= 1) v = fmaxf(v, __shfl_xor(v, o));
    return v;
}
__device__ __forceinline__ float bf2f(bf16 h) { return __builtin_bit_cast(float, (unsigned)h << 16); }
__device__ __forceinline__ float bflo(unsigned w) { return __builtin_bit_cast(float, w << 16); }
__device__ __forceinline__ float bfhi(unsigned w) { return __builtin_bit_cast(float, w & 0xffff0000u); }
__device__ __forceinline__ unsigned f2bf(float f) { unsigned u = __builtin_bit_cast(unsigned, f); return (u + 0x7fffu + ((u >> 16) & 1u)) >> 16; }
__device__ __forceinline__ unsigned pk2(float lo, float hi) { return f2bf(lo) | (f2bf(hi) << 16); }
__device__ __forceinline__ float siluf(float x) { return x / (1.0f + __expf(-x)); }
__device__ __forceinline__ void unpack8(const v4u q, float (&f)[8]) { f[0] = bflo(q.x); f[1] = bfhi(q.x); f[2] = bflo(q.y); f[3] = bfhi(q.y); f[4] = bflo(q.z); f[5] = bfhi(q.z); f[6] = bflo(q.w); f[7] = bfhi(q.w); }

__device__ __forceinline__ void phase_mods(const Ctx& c, float* lf) {
    for (int i = c.tid; i < 5 * 1024; i += NTHR) { const int v = i >> 10, k = i & 1023; const float x = (v == 0) ? c.c_ctx()[k] : c.cvec()[(v - 1) * 1024 + k]; lf[i] = siluf(x); }
    __syncthreads();
    float* red = lf + 5 * 1024;
    for (int u = blockIdx.x; u < 192; u += gridDim.x) {
        const int l = u / 96, col0 = (u % 96) * 64;
        const float* W = c.w_mod() + (size_t)l * 1024 * 6144 + col0 + c.lane;
        float acc[5] = {0.f, 0.f, 0.f, 0.f, 0.f};
#pragma unroll 8
        for (int k = c.wave * 128; k < c.wave * 128 + 128; ++k) { const float wv = W[(size_t)k * 6144];
#pragma unroll
            for (int i = 0; i < 5; ++i) acc[i] += lf[i * 1024 + k] * wv; }
#pragma unroll
        for (int i = 0; i < 5; ++i) red[(c.wave * 5 + i) * 64 + c.lane] = acc[i];
        __syncthreads();
        if (c.tid < 320) { const int i = c.tid >> 6, ln = c.tid & 63; float s = c.b_mod()[l * 6144 + col0 + ln];
#pragma unroll
            for (int w = 0; w < 8; ++w) s += red[(w * 5 + i) * 64 + ln];
            c.MOD()[(size_t)(l * 5 + i) * 6144 + col0 + ln] = s; }
        __syncthreads();
    }
}

__device__ __forceinline__ int cmap(int mode, int n) { return mode == 0 ? n : (mode == 1 ? (n < 1280 ? n : n + 16) : ((n & 255) < 128 ? 128 * (n >> 8) + (n & 127) : 512 + 128 * (n >> 8) + (n & 127))); }
__device__ __forceinline__ void transpose_item(const float* W, int ld, int K, int N, int mode, const float* rowscale, bf16* WT, float* scr, int item, int lane) {
    const int nblk = N / 32, kb = item / nblk, nb = item % nblk, k0 = 64 * kb, n0 = 32 * nb, sc0 = cmap(mode, n0);
    float tv[32];
#pragma unroll
    for (int i = 0; i < 32; ++i) tv[i] = W[(size_t)(k0 + 2 * i + (lane >> 5)) * ld + sc0 + (lane & 31)];
    if (rowscale) {
#pragma unroll
        for (int i = 0; i < 32; ++i) tv[i] *= rowscale[k0 + 2 * i + (lane >> 5)]; }
#pragma unroll
    for (int i = 0; i < 32; ++i) scr[(2 * i + (lane >> 5)) * 33 + (lane & 31)] = tv[i];
    __builtin_amdgcn_fence(__ATOMIC_RELEASE, "wavefront"); __builtin_amdgcn_wave_barrier();
    const int ch = lane & 7;
#pragma unroll
    for (int j = 0; j < 4; ++j) { const int n = (lane >> 3) + 8 * j; const float* s = scr + (8 * ch) * 33 + n;
        v4u o; o.x = pk2(s[0 * 33], s[1 * 33]); o.y = pk2(s[2 * 33], s[3 * 33]); o.z = pk2(s[4 * 33], s[5 * 33]); o.w = pk2(s[6 * 33], s[7 * 33]);
        *(v4u*)(WT + (size_t)(n0 + n) * K + k0 + 8 * ch) = o; }
    __builtin_amdgcn_fence(__ATOMIC_RELEASE, "wavefront"); __builtin_amdgcn_wave_barrier();
}
__device__ __forceinline__ void s5_tables(const Ctx& c, int l, int g, int part, float* lf);
__device__ __forceinline__ void convert_items(const Ctx& c, int l, int lo, int hi, int gw0, int ngw, bool tabs, int tb0, int ntb, float* lf) {
    unsigned char* ws = c.ws();
    if (tabs) {
        for (int t = tb0; t < 128; t += ntb) s5_tables(c, l, t & 31, t >> 5, lf);
        for (int i = tb0 * NTHR + c.tid; i < 16384; i += ntb * NTHR) { const int j = i >> 10, k = i & 1023; ((bf16*)(ws + WS_WDT))[i] = (bf16)f2bf(c.w_in()[(size_t)l * 1024 * 4112 + (size_t)k * 4112 + 1280 + j]); }
    }
    float* scr = lf + c.wave * 2176;
    for (int it = lo + gw0; it < hi; it += ngw) {
        int r = it;
        if (r < 2048) { transpose_item(c.w_in() + (size_t)l * 1024 * 4112, 4112, 1024, 4096, 1, nullptr, (bf16*)(ws + W_IN), scr, r, c.lane); continue; } r -= 2048;
        if (r < 2048) { transpose_item(c.w_gate() + (size_t)l * 1024 * 4096, 4096, 1024, 4096, 0, nullptr, (bf16*)(ws + W_G), scr, r, c.lane); continue; } r -= 2048;
        if (r < 256) { transpose_item(c.w_glu() + (size_t)l * 512 * 1024, 1024, 512, 1024, 2, nullptr, (bf16*)(ws + W_GLU), scr, r, c.lane); continue; } r -= 256;
        if (r < 1024) { const int i = r >> 8; transpose_item(c.w_branch() + (size_t)(l * 4 + i) * 512 * 1024, 1024, 512, 1024, 0, i == 0 ? c.ssd_norm_g() + l * 512 : nullptr, (bf16*)(ws + W_BR) + (size_t)i * 1024 * 512, scr, r & 255, c.lane); continue; } r -= 1024;
        if (r < 512) { transpose_item(c.w_out() + (size_t)l * 1024 * 1024, 1024, 1024, 1024, 0, nullptr, (bf16*)(ws + W_OUT), scr, r, c.lane); continue; } r -= 512;
        if (r < 2048) { transpose_item(c.w_fc1() + (size_t)l * 1024 * 4096, 4096, 1024, 4096, 0, nullptr, (bf16*)(ws + W_1), scr, r, c.lane); continue; } r -= 2048;
        transpose_item(c.w_fc2() + (size_t)l * 4096 * 1024, 1024, 4096, 1024, 0, nullptr, (bf16*)(ws + W_2), scr, r, c.lane);
    }
}
__device__ __forceinline__ void phase_convert(const Ctx& c, int l, float* lf) {
    convert_items(c, l, 0, 9984, blockIdx.x * NWAVES + c.wave, gridDim.x * NWAVES, true, blockIdx.x, gridDim.x, lf);
}
__device__ __forceinline__ void side_convert(const Ctx& c, int lo, int hi, bool tabs, float* lf) {
    if (blockIdx.x < 192 || gridDim.x != 256) return;
    convert_items(c, 1, lo, hi, (blockIdx.x - 192) * NWAVES + c.wave, 64 * NWAVES, tabs, blockIdx.x - 192, 64, lf);
}

__device__ __forceinline__ void phase_norm(const Ctx& c, int l, int which, float* lf) {
    const int gw = blockIdx.x * NWAVES + c.wave, NGW = gridDim.x * NWAVES;
    const float* gn = (which == 0 ? c.g_norm1() : c.g_norm2()) + l * 1024;
    for (int m = gw; m < M; m += NGW) {
        const float* xr = (l == 0 && which == 0) ? (m < MC ? c.x_prompt() + (size_t)m * D : c.x_sample() + (size_t)(m - MC) * D) : c.out() + (size_t)m * D;
        const int mi = (m < MC) ? 0 : 1 + ((m - MC) >> 10);
        const float* mod = c.MOD() + (size_t)(l * 5 + mi) * 6144 + which * 3072;
        f32x4 v[4]; float s = 0.f;
#pragma unroll
        for (int j = 0; j < 4; ++j) { v[j] = *(const f32x4*)(xr + 4 * c.lane + 256 * j); s += (v[j].x * v[j].x + v[j].y * v[j].y) + (v[j].z * v[j].z + v[j].w * v[j].w); }
        const float rstd = rsqrtf(wave_sum(s) * (1.0f / D) + EPS);
#pragma unroll
        for (int j = 0; j < 4; ++j) { const int k = 4 * c.lane + 256 * j; const f32x4 g = *(const f32x4*)(gn + k), sh = *(const f32x4*)(mod + k), sc = *(const f32x4*)(mod + 1024 + k);
            v[j] = v[j] * rstd * g * (sc + 1.0f) + sh;
            v2u o; o.x = pk2(v[j].x, v[j].y); o.y = pk2(v[j].z, v[j].w); *(v2u*)(c.H() + (size_t)m * D + k) = o; }
        if (which == 0) {
            if (c.lane == 0) { c.SSQ()[m] = 0.f; ((float*)(c.ws() + WS_SSQ2))[m] = 0.f; }
        }
    }
}

__device__ __forceinline__ void phase_bias2(const Ctx& c, int l) {
    const int gw = blockIdx.x * NWAVES + c.wave, NGW = gridDim.x * NWAVES, lane = c.lane;
    const bf16* W1t = (const bf16*)(c.ws() + W_1); float* bi = (float*)(c.ws() + WS_BI2);
    for (int n = gw; n < 4096; n += NGW) {
        float wf[16]; { float t8[8]; unpack8(*(const v4u*)(W1t + (size_t)n * 1024 + 8 * lane), t8);
#pragma unroll
            for (int j = 0; j < 8; ++j) wf[j] = t8[j];
            unpack8(*(const v4u*)(W1t + (size_t)n * 1024 + 512 + 8 * lane), t8);
#pragma unroll
            for (int j = 0; j < 8; ++j) wf[8 + j] = t8[j]; }
#pragma unroll 1
        for (int mi = 0; mi < 5; ++mi) { const float* sh = c.MOD() + (size_t)(l * 5 + mi) * 6144 + 3072; float a = 0.f;
#pragma unroll
            for (int hh = 0; hh < 2; ++hh) { const f32x4 s0 = *(const f32x4*)(sh + 512 * hh + 8 * lane), s1 = *(const f32x4*)(sh + 512 * hh + 8 * lane + 4);
                a += (wf[8 * hh + 0] * s0.x + wf[8 * hh + 1] * s0.y) + (wf[8 * hh + 2] * s0.z + wf[8 * hh + 3] * s0.w) + (wf[8 * hh + 4] * s1.x + wf[8 * hh + 5] * s1.y) + (wf[8 * hh + 6] * s1.z + wf[8 * hh + 7] * s1.w); }
            a = wave_sum(a); if (lane == 0) bi[mi * 4096 + n] = a; }
    }
}

__device__ __forceinline__ void phase_dt(const Ctx& c, int l) {
    if (c.wave >= 3) return;
    const int tile = blockIdx.x * 3 + c.wave; if (tile >= 768) return;
    const int lr = c.lane & 15, lq = c.lane >> 4;
    const bf16* ap = c.H() + (size_t)(16 * tile + lr) * 1024 + 8 * lq; const bf16* bp = (const bf16*)(c.ws() + WS_WDT) + (size_t)lr * 1024 + 8 * lq;
    f32x4 acc = {0.f, 0.f, 0.f, 0.f};
#pragma unroll 8
    for (int ks = 0; ks < 32; ++ks) acc = __builtin_amdgcn_mfma_f32_16x16x32_bf16(*(const pg8::bf16x8*)(ap + 32 * ks), *(const pg8::bf16x8*)(bp + 32 * ks), acc, 0, 0, 0);
    const float bias = c.dt_bias()[l * 16 + lr];
#pragma unroll
    for (int r = 0; r < 4; ++r) { const float x = acc[r] + bias; c.DT()[(size_t)(16 * tile + 4 * lq + r) * 16 + lr] = x > 20.f ? x : log1pf(__expf(x)); }
}

__device__ __forceinline__ void phase_rope_table(const Ctx& c) {
    const int gt = blockIdx.x * NTHR + c.tid;
    if (gt < 32768) { const int pos = gt >> 5, a = gt & 31, f = a & 15; const float inv = exp2f(-(float)f * 0.8304820237218406f);
        const float ang = (float)((a >> 4) ? (pos & 63) : (pos >> 6)) * inv; float sn, cs; sincosf(ang, &sn, &cs); c.ROPE()[pos * 64 + a] = cs; c.ROPE()[pos * 64 + 32 + a] = sn; }
}
__device__ __forceinline__ void phase_ckv(const Ctx& c) {
    const int gw = blockIdx.x * NWAVES + c.wave, NGW = gridDim.x * NWAVES, lane = c.lane;
    for (int r = gw; r < 2048; r += NGW) { const int l = r >> 10, b = (r >> 8) & 3, sidx = r & 255; const size_t cb = (size_t)(b * 2 + l) * 256 + sidx; bf16* dst = c.CKV() + (size_t)r * 1280;
#pragma unroll
        for (int i = 0; i < 5; ++i) { const int e = 4 * (lane + 64 * i);
            const float* src = e < 512 ? c.cache_dk() + cb * 512 + e : e < 1024 ? c.cache_dv() + cb * 512 + (e - 512) : e < 1152 ? c.cache_wk() + cb * 128 + (e - 1024) : c.cache_wv() + cb * 128 + (e - 1152);
            const f32x4 v = *(const f32x4*)src; v2u o; o.x = pk2(v.x, v.y); o.y = pk2(v.z, v.w); *(v2u*)(dst + e) = o; } }
}
__device__ __forceinline__ void phase_qk(const Ctx& c, int l, float* lf) {
    const int gw = blockIdx.x * NWAVES + c.wave, NGW = gridDim.x * NWAVES, lane = c.lane, l16 = lane & 15, grp = lane >> 4;
    for (int i = c.tid; i < 7 * 768; i += NTHR) lf[i] = c.conv_w()[(size_t)l * 7 * 768 + i];
    for (int i = c.tid; i < 768; i += NTHR) lf[7 * 768 + i] = c.conv_b()[l * 768 + i];
    __syncthreads();
    const f32x4 gq = *(const f32x4*)(c.qn_g() + l * 64 + 4 * l16), gk = *(const f32x4*)(c.kn_g() + l * 64 + 4 * l16), gwq = *(const f32x4*)(c.wqn_g() + l * 64 + 4 * l16), gwk = *(const f32x4*)(c.wkn_g() + l * 64 + 4 * l16);
    bf16* R1p = c.R1(); float* outp = c.out(); bf16* XCp = c.XC();
    for (int m = gw; m < M; m += NGW) {
        bf16* pr = R1p + (size_t)m * 4096;
        const bool lat = m >= MC;
        const int b = lat ? (m - MC) >> 10 : m >> 8, t = lat ? (m - MC) & 1023 : m & 255, L = lat ? 1024 : 256;
        const size_t ob = (size_t)(b * 2 + l) * 256 + t;
        f32x4 cs = {1.f, 1.f, 1.f, 1.f}, sn = {0.f, 0.f, 0.f, 0.f};
        if (lat) { const float* rp = c.ROPE() + t * 64 + (l16 >> 3) * 16 + 4 * (l16 & 3); cs = *(const f32x4*)rp; sn = *(const f32x4*)(rp + 32); if (!((l16 >> 2) & 1)) sn = -sn; }
        v2u raw[7];
#pragma unroll
        for (int ps = 0; ps < 7; ++ps) { const int gi = 4 * ps + grp; const int col = gi < 8 ? C_DQ + gi * 64 : gi < 16 ? C_DK + (gi - 8) * 64 : gi < 24 ? C_WQ + (gi - 16) * 64 : C_WK + (gi - 24) * 64;
            raw[ps] = (gi < 26) ? *(const v2u*)(pr + col + 4 * l16) : (v2u){0u, 0u}; }
        v2u cp[3];
        if (!lat) {
#pragma unroll
            for (int ps = 0; ps < 3; ++ps) { const int gi = 4 * ps + grp; const int col = gi < 8 ? C_DV + gi * 64 : C_WV + (gi - 8) * 64; cp[ps] = (gi < 10) ? *(const v2u*)(pr + col + 4 * l16) : (v2u){0u, 0u}; }
        }
        v2u cx[3][7];
#pragma unroll
        for (int i = 0; i < 3; ++i)
#pragma unroll
            for (int j = 0; j < 7; ++j) { const int tt = t + j - 3; cx[i][j] = (tt >= 0 && tt < L) ? *(const v2u*)(R1p + (size_t)(m + j - 3) * 4096 + C_XBC + 4 * lane + 256 * i) : (v2u){0u, 0u}; }
#pragma unroll
        for (int ps = 0; ps < 7; ++ps) { const int gi = 4 * ps + grp;
            const f32x4 gain = gi < 8 ? gq : gi < 16 ? gk : gi < 24 ? gwq : gwk;
            f32x4 v = {bflo(raw[ps].x), bfhi(raw[ps].x), bflo(raw[ps].y), bfhi(raw[ps].y)};
            float ss = (v.x * v.x + v.y * v.y) + (v.z * v.z + v.w * v.w);
            ss += __shfl_xor(ss, 1); ss += __shfl_xor(ss, 2); ss += __shfl_xor(ss, 4); ss += __shfl_xor(ss, 8);
            v = v * rsqrtf(ss * (1.0f / 64.0f) + EPS) * gain;
            if (lat) { f32x4 p; p.x = __shfl_xor(v.x, 4); p.y = __shfl_xor(v.y, 4); p.z = __shfl_xor(v.z, 4); p.w = __shfl_xor(v.w, 4); v = v * cs + p * sn; }
            if (gi < 26) {
                const int col = gi < 8 ? C_DQ + gi * 64 : gi < 16 ? C_DK + (gi - 8) * 64 : gi < 24 ? C_WQ + (gi - 16) * 64 : C_WK + (gi - 24) * 64;
                v2u o; o.x = pk2(v.x, v.y); o.y = pk2(v.z, v.w); *(v2u*)(pr + col + 4 * l16) = o;
                if (!lat) { if (gi >= 8 && gi < 16) *(f32x4*)(outp + O_DK + ob * 512 + (gi - 8) * 64 + 4 * l16) = v; if (gi >= 24) *(f32x4*)(outp + O_WK + ob * 128 + (gi - 24) * 64 + 4 * l16) = v; }
            }
        }
        if (!lat) {
#pragma unroll
            for (int ps = 0; ps < 3; ++ps) { const int gi = 4 * ps + grp; const f32x4 v = {bflo(cp[ps].x), bfhi(cp[ps].x), bflo(cp[ps].y), bfhi(cp[ps].y)};
                if (gi < 8) *(f32x4*)(outp + O_DV + ob * 512 + gi * 64 + 4 * l16) = v; else if (gi < 10) *(f32x4*)(outp + O_WV + ob * 128 + (gi - 8) * 64 + 4 * l16) = v; }
        }
#pragma unroll
        for (int i = 0; i < 3; ++i) { const int ch = 4 * lane + 256 * i; f32x4 a = *(const f32x4*)(lf + 7 * 768 + ch);
#pragma unroll
            for (int j = 0; j < 7; ++j) { const f32x4 wv = *(const f32x4*)(lf + j * 768 + ch); const f32x4 xv = {bflo(cx[i][j].x), bfhi(cx[i][j].x), bflo(cx[i][j].y), bfhi(cx[i][j].y)}; a += wv * xv; }
            v2u o; o.x = pk2(siluf(a.x), siluf(a.y)); o.y = pk2(siluf(a.z), siluf(a.w)); *(v2u*)(XCp + (size_t)m * 768 + ch) = o; }
    }
}

typedef pg8::bf16x8 bx8;
#define LDS_BARRIER() do { asm volatile("s_waitcnt lgkmcnt(0)" ::: "memory"); __builtin_amdgcn_s_barrier(); asm volatile("" ::: "memory"); } while (0)
#define MFMA16(a, b, cc) __builtin_amdgcn_mfma_f32_16x16x32_bf16((a), (b), (cc), 0, 0, 0)
__device__ __forceinline__ void ssd_unit(const Ctx& c, int l, int pass, int b, int h, unsigned char* lds) {
    const int L = pass ? 1024 : 256, tok0 = pass ? MC + b * 1024 : b * 256, NCH = L >> 7;
    const int tid = c.tid, lane = c.lane, w = c.wave, lr = lane & 15, lq = lane >> 4, grp = h >> 2;
    bf16* XT = (bf16*)lds;
    bf16* BwT = XT + 64 * 136;
    bf16* Bm = BwT + 64 * 136;
    bf16* Cm = Bm + 128 * 72;
    bf16* Mm = Cm + 128 * 72;
    bf16* ST = Mm + 128 * 136;
    float* cum = (float*)(ST + 64 * 72);
    float* dtv = cum + 128; float* wv = dtv + 128; float* ecum = wv + 128; float* tot = ecum + 128;
    const float dsk = c.ssd_d()[l * 8 + h];
    const bf16* XCp = c.XC(); const float* DTp = c.DT(); bf16* Yp = c.Y(); const bf16* R1p = c.R1(); float* SSQp = c.SSQ();
    const int pi = w >> 1, nj0 = 2 * (w & 1);
    const int i = tid >> 2, part = tid & 3;
    for (int dir = 0; dir < 2; ++dir) {
        const float A = -__expf(c.a_log()[(l * 2 + dir) * 8 + h]);
        f32x4 Sacc[2];
        __syncthreads();
#pragma unroll
        for (int q = 0; q < 2; ++q)
#pragma unroll
            for (int r = 0; r < 4; ++r) { const int p = 16 * pi + 4 * lq + r, n = 16 * (nj0 + q) + lr;
                const float v = pass ? c.state_ssd()[(((((size_t)(b * 2 + l) * 2 + dir) * 8 + h) * 64 + p) * 64) + n] : 0.f;
                Sacc[q][r] = v; ST[p * 72 + n] = (bf16)f2bf(v); }
        v4u x0, x1, b0, b1, c0, c1; float d0 = 0.f, d1 = 0.f;
#define SSD_LOAD(ci_) { const int t_ = dir ? L - 1 - ((ci_) * 128 + i) : (ci_) * 128 + i; const bf16* xr_ = XCp + (size_t)(tok0 + t_) * 768; \
            x0 = *(const v4u*)(xr_ + h * 64 + part * 16); x1 = *(const v4u*)(xr_ + h * 64 + part * 16 + 8); \
            b0 = *(const v4u*)(xr_ + 512 + grp * 64 + part * 16); b1 = *(const v4u*)(xr_ + 512 + grp * 64 + part * 16 + 8); \
            c0 = *(const v4u*)(xr_ + 640 + grp * 64 + part * 16); c1 = *(const v4u*)(xr_ + 640 + grp * 64 + part * 16 + 8); \
            if (tid < 64) { const int i0_ = 2 * lane, ta_ = dir ? L - 1 - ((ci_) * 128 + i0_) : (ci_) * 128 + i0_, tb_ = dir ? ta_ - 1 : ta_ + 1; \
                d0 = DTp[(size_t)(tok0 + ta_) * 16 + dir * 8 + h]; d1 = DTp[(size_t)(tok0 + tb_) * 16 + dir * 8 + h]; } }
        SSD_LOAD(0);
        for (int ci = 0; ci < NCH; ++ci) {
            LDS_BARRIER();
            float bvals[16];
            { *(v4u*)(Bm + i * 72 + part * 16) = b0; *(v4u*)(Bm + i * 72 + part * 16 + 8) = b1;
              *(v4u*)(Cm + i * 72 + part * 16) = c0; *(v4u*)(Cm + i * 72 + part * 16 + 8) = c1;
              const unsigned xs[8] = {x0.x, x0.y, x0.z, x0.w, x1.x, x1.y, x1.z, x1.w};
#pragma unroll
              for (int j = 0; j < 8; ++j) { XT[(part * 16 + 2 * j) * 136 + i] = (bf16)(xs[j] & 0xffffu); XT[(part * 16 + 2 * j + 1) * 136 + i] = (bf16)(xs[j] >> 16); }
              float t8[8]; unpack8(b0, t8);
#pragma unroll
              for (int j = 0; j < 8; ++j) bvals[j] = t8[j];
              unpack8(b1, t8);
#pragma unroll
              for (int j = 0; j < 8; ++j) bvals[8 + j] = t8[j]; }
            if (tid < 64) {
                const int i0 = 2 * lane, i1 = i0 + 1;
                const float a0 = d0 * A, a1 = d1 * A; float s = a0 + a1;
#pragma unroll
                for (int o = 1; o < 64; o <<= 1) { const float v = __shfl_up(s, o); if (lane >= o) s += v; }
                const float cum1 = s, cum0 = s - a1, total = __shfl(s, 63);
                cum[i0] = cum0; cum[i1] = cum1; dtv[i0] = d0; dtv[i1] = d1;
                wv[i0] = __expf(total - cum0) * d0; wv[i1] = __expf(total - cum1) * d1; ecum[i0] = __expf(cum0); ecum[i1] = __expf(cum1);
                if (lane == 0) tot[0] = __expf(total);
            }
            if (ci + 1 < NCH) SSD_LOAD(ci + 1);
            unsigned short zz[16], yy[16];
            if (dir == 1) {
#pragma unroll
                for (int r = 0; r < 4; ++r) { const int tt = 16 * w + 4 * lq + r; const size_t m = (size_t)tok0 + (L - 1 - (ci * 128 + tt));
#pragma unroll
                    for (int jp = 0; jp < 4; ++jp) { zz[4 * r + jp] = R1p[m * 4096 + C_Z + h * 64 + 16 * jp + lr]; yy[4 * r + jp] = Yp[m * 2048 + h * 64 + 16 * jp + lr]; } }
            }
            LDS_BARRIER();
            { const float wi = wv[i];
#pragma unroll
              for (int j = 0; j < 16; ++j) BwT[(part * 16 + j) * 136 + i] = (bf16)f2bf(bvals[j] * wi); }
            bx8 cfr[2];
#pragma unroll
            for (int ks = 0; ks < 2; ++ks) cfr[ks] = *(const bx8*)(Cm + (16 * w + lr) * 72 + 32 * ks + 8 * lq);
            for (int j = 0; j <= w; ++j) {
                const bx8 bb0 = *(const bx8*)(Bm + (16 * j + lr) * 72 + 8 * lq), bb1 = *(const bx8*)(Bm + (16 * j + lr) * 72 + 32 + 8 * lq);
                f32x4 g = {0.f, 0.f, 0.f, 0.f};
                g = MFMA16(cfr[0], bb0, g); g = MFMA16(cfr[1], bb1, g);
                const int s = 16 * j + lr; const float cs = cum[s], ds = dtv[s];
#pragma unroll
                for (int r = 0; r < 4; ++r) { const int tt = 16 * w + 4 * lq + r; const float v = (s <= tt) ? g[r] * __expf(cum[tt] - cs) * ds : 0.f; Mm[tt * 136 + s] = (bf16)f2bf(v); }
            }
            if (!(w & 1)) {
#pragma unroll
                for (int r = 0; r < 4; ++r) Mm[(16 * w + 4 * lq + r) * 136 + 16 * (w + 1) + lr] = 0;
            }
            LDS_BARRIER();
            f32x4 yl[4], yo[4];
#pragma unroll
            for (int jp = 0; jp < 4; ++jp) { yl[jp] = (f32x4){0.f, 0.f, 0.f, 0.f}; yo[jp] = (f32x4){0.f, 0.f, 0.f, 0.f}; }
            for (int ks = 0; ks <= (w >> 1); ++ks) {
                const bx8 af = *(const bx8*)(Mm + (16 * w + lr) * 136 + 32 * ks + 8 * lq);
#pragma unroll
                for (int jp = 0; jp < 4; ++jp) { const bx8 xf = *(const bx8*)(XT + (16 * jp + lr) * 136 + 32 * ks + 8 * lq); yl[jp] = MFMA16(af, xf, yl[jp]); }
            }
#pragma unroll
            for (int ks = 0; ks < 2; ++ks)
#pragma unroll
                for (int jp = 0; jp < 4; ++jp) { const bx8 sf = *(const bx8*)(ST + (16 * jp + lr) * 72 + 32 * ks + 8 * lq); yo[jp] = MFMA16(cfr[ks], sf, yo[jp]); }
            {
#pragma unroll
                for (int r = 0; r < 4; ++r) {
                    const int tt = 16 * w + 4 * lq + r; const float ec = ecum[tt];
                    const int t = dir ? L - 1 - (ci * 128 + tt) : ci * 128 + tt; const size_t m = (size_t)tok0 + t;
                    float q = 0.f;
#pragma unroll
                    for (int jp = 0; jp < 4; ++jp) {
                        const int p = 16 * jp + lr; const float y = yl[jp][r] + ec * yo[jp][r];
                        if (dir == 0) Yp[m * 2048 + h * 64 + p] = (bf16)f2bf(y);
                        else { const float x = bf2f(XT[p * 136 + tt]); const float ytot = y + bf2f(yy[4 * r + jp]) + dsk * x; const float z = bf2f(zz[4 * r + jp]);
                            const float gt = ytot * siluf(z); Yp[m * 2048 + h * 64 + p] = (bf16)f2bf(gt); q += gt * gt; }
                    }
                    if (dir == 1) { q += __shfl_xor(q, 1); q += __shfl_xor(q, 2); q += __shfl_xor(q, 4); q += __shfl_xor(q, 8); if (lr == 0) atomicAdd(SSQp + m, q); }
                }
            }
            LDS_BARRIER();
            {
                f32x4 st[2] = {{0.f, 0.f, 0.f, 0.f}, {0.f, 0.f, 0.f, 0.f}};
#pragma unroll
                for (int ks = 0; ks < 4; ++ks) { const bx8 af = *(const bx8*)(XT + (16 * pi + lr) * 136 + 32 * ks + 8 * lq);
#pragma unroll
                    for (int q = 0; q < 2; ++q) { const bx8 bf = *(const bx8*)(BwT + (16 * (nj0 + q) + lr) * 136 + 32 * ks + 8 * lq); st[q] = MFMA16(af, bf, st[q]); } }
                const float et = tot[0];
#pragma unroll
                for (int q = 0; q < 2; ++q)
#pragma unroll
                    for (int r = 0; r < 4; ++r) { Sacc[q][r] = et * Sacc[q][r] + st[q][r]; ST[(16 * pi + 4 * lq + r) * 72 + 16 * (nj0 + q) + lr] = (bf16)f2bf(Sacc[q][r]); }
            }
        }
#undef SSD_LOAD
        if (!pass) {
#pragma unroll
            for (int q = 0; q < 2; ++q)
#pragma unroll
                for (int r = 0; r < 4; ++r) { const int p = 16 * pi + 4 * lq + r, n = 16 * (nj0 + q) + lr;
                    c.out()[O_SSD + (((((size_t)(b * 2 + l) * 2 + dir) * 8 + h) * 64 + p) * 64) + n] = Sacc[q][r]; }
        }
    }
}

__device__ __forceinline__ void s5_tables(const Ctx& c, int l, int g, int part, float* lf) {
    const int tid = c.tid;
    float* pw = lf;
    float* Bc = pw + 2 * 17 * 128;
    float* Cc = Bc + 2 * 2048;
    if (tid < 128) { const int dir = tid >> 6, n = tid & 63, idx = ((l * 2 + dir) * 32 + g) * 64 + n;
        const float lre = c.lam_re()[idx], lim = c.lam_im()[idx], step = expf(c.log_step()[(l * 2 + dir) * 32 + g]);
        for (int k = 0; k <= 16; ++k) { const float mag = expf(lre * step * (float)k); float sn, cs; sincosf(lim * step * (float)k, &sn, &cs); pw[((dir * 17 + k) * 64 + n) * 2] = mag * cs; pw[((dir * 17 + k) * 64 + n) * 2 + 1] = mag * sn; }
        const float mag = expf(lre * step); float sn, cs; sincosf(lim * step, &sn, &cs); const float are = mag * cs, aim = mag * sn;
        const float den = lre * lre + lim * lim, cre = ((are - 1.0f) * lre + aim * lim) / den, cim = (aim * lre - (are - 1.0f) * lim) / den;
        for (int mm = 0; mm < 16; ++mm) { const float br = c.b_re()[(size_t)idx * 16 + mm], bi = c.b_im()[(size_t)idx * 16 + mm]; Bc[((dir * 64 + n) * 16 + mm) * 2] = cre * br - cim * bi; Bc[((dir * 64 + n) * 16 + mm) * 2 + 1] = cre * bi + cim * br; }
    }
    for (int i = tid; i < 2048; i += NTHR) { const int dir = i >> 10, mm = (i >> 6) & 15, n = i & 63; const size_t src = ((size_t)((l * 2 + dir) * 32 + g) * 16 + mm) * 64 + n;
        Cc[i * 2] = c.c_re()[src]; Cc[i * 2 + 1] = c.c_im()[src]; }
    __syncthreads();
    if (part == 0 && tid < 128) { const int dir = tid >> 6, n = tid & 63; float* at = (float*)(c.ws() + WS_S5AT) + ((size_t)(dir * 32 + g) * 64 + n) * 2; at[0] = pw[((dir * 17 + 16) * 64 + n) * 2]; at[1] = pw[((dir * 17 + 16) * 64 + n) * 2 + 1]; }
    bf16* Kt = (bf16*)(c.ws() + WS_S5K) + (size_t)g * 31 * 256;
    for (int e = part * 1984 + tid; e < (part + 1) * 1984; e += NTHR) { const int tp = e >> 8, mm = (e >> 4) & 15, m2 = e & 15, tau = tp - 15; float acc = 0.f;
#pragma unroll
        for (int dir = 0; dir < 2; ++dir) { if ((dir == 0 && tau < 0) || (dir == 1 && tau > 0)) continue; const int k = tau < 0 ? -tau : tau;
            const float* pp = pw + (dir * 17 + k) * 128; const float* bb = Bc + dir * 2048 + m2 * 2; const float* cc = Cc + (dir * 16 + mm) * 128;
            for (int n = 0; n < 64; ++n) { const float pr = pp[2 * n], pi = pp[2 * n + 1], br = bb[n * 32], bi = bb[n * 32 + 1], Pr = pr * br - pi * bi, Pi = pr * bi + pi * br; acc += cc[2 * n] * Pr - cc[2 * n + 1] * Pi; } }
        if (tau == 0 && mm == m2) acc += c.s5_d()[l * 512 + g * 16 + mm];
        Kt[e] = (bf16)f2bf(acc); }
    for (int e = part * 16384 + tid; e < (part + 1) * 16384; e += NTHR) { const int dir = e >> 15, sidx = (e >> 8) & 127, k = e & 255, ri = sidx >> 6, n = sidx & 63, j = k >> 4, m2 = k & 15, ex = dir ? j : 15 - j;
        const float pr = pw[((dir * 17 + ex) * 64 + n) * 2], pi = pw[((dir * 17 + ex) * 64 + n) * 2 + 1], br = Bc[((dir * 64 + n) * 16 + m2) * 2], bi = Bc[((dir * 64 + n) * 16 + m2) * 2 + 1];
        ((bf16*)(c.ws() + WS_S5WS))[((size_t)(dir * 32 + g) * 128 + sidx) * 256 + k] = (bf16)f2bf(ri ? pr * bi + pi * br : pr * br - pi * bi); }
    for (int e = part * 16384 + tid; e < (part + 1) * 16384; e += NTHR) { const int row = e >> 8, k = e & 255, i = row >> 4, mm = row & 15, dir = k >> 7, ri = (k >> 6) & 1, n = k & 63, ex = dir ? 16 - i : i + 1;
        const float pr = pw[((dir * 17 + ex) * 64 + n) * 2], pi = pw[((dir * 17 + ex) * 64 + n) * 2 + 1], cr = Cc[((dir * 16 + mm) * 64 + n) * 2], ci = Cc[((dir * 16 + mm) * 64 + n) * 2 + 1];
        ((bf16*)(c.ws() + WS_S5WO))[(size_t)g * 65536 + e] = (bf16)f2bf(ri ? -(cr * pi + ci * pr) : cr * pr - ci * pi); }
    __syncthreads();
}

__device__ __forceinline__ void s5_unit(const Ctx& c, int l, int g, int cu, unsigned char* lds) {
    const int tid = c.tid, lane = c.lane, w = c.wave, lr = lane & 15, lq = lane >> 4;
    const bool lat = cu >= 8;
    bf16* Ut = (bf16*)lds;
    bf16* St = Ut + 64 * 264;
    bf16* Kt = St + 64 * 264;
    float* Dl = (float*)(Kt + 31 * 256);
    const bf16* R1p = c.R1();
    const bf16* Wsp0 = (const bf16*)(c.ws() + WS_S5WS) + ((size_t)(0 * 32 + g) * 128 + 16 * w + lr) * 256 + 8 * lq;
    const bf16* Wsp1 = (const bf16*)(c.ws() + WS_S5WS) + ((size_t)(1 * 32 + g) * 128 + 16 * w + lr) * 256 + 8 * lq;
    const bf16* Wop = (const bf16*)(c.ws() + WS_S5WO) + (size_t)g * 65536 + 8 * lq;
    bx8 afA[8], afB[8];
#pragma unroll
    for (int ks = 0; ks < 8; ++ks) afA[ks] = *(const bx8*)(Wsp0 + 32 * ks);
    { const v4u* src = (const v4u*)((const bf16*)(c.ws() + WS_S5K) + (size_t)g * 31 * 256); for (int i = tid; i < 31 * 32; i += NTHR) ((v4u*)Kt)[i] = src[i]; }
#pragma unroll
    for (int i = 0; i < 2; ++i) { const int id = tid + NTHR * i, col = id >> 4, j = id & 15;
        const int tok = lat ? MC + (cu - 8) * 1024 + col * 16 + j : (4 * cu + (col >> 4)) * 256 + (col & 15) * 16 + j;
        const bf16* up = R1p + (size_t)tok * 4096 + C_U + g * 16;
        *(v4u*)(Ut + col * 264 + j * 16) = *(const v4u*)up; *(v4u*)(Ut + col * 264 + j * 16 + 8) = *(const v4u*)(up + 8); }
#pragma unroll
    for (int ks = 0; ks < 8; ++ks) afB[ks] = *(const bx8*)(Wsp1 + 32 * ks);
    LDS_BARRIER();
#pragma unroll
    for (int dir = 0; dir < 2; ++dir) {
        f32x4 acc[4];
#pragma unroll
        for (int cb = 0; cb < 4; ++cb) acc[cb] = (f32x4){0.f, 0.f, 0.f, 0.f};
#pragma unroll
        for (int ks = 0; ks < 8; ++ks) {
#pragma unroll
            for (int cb = 0; cb < 4; ++cb) { const bx8 bf = *(const bx8*)(Ut + (16 * cb + lr) * 264 + 32 * ks + 8 * lq); acc[cb] = MFMA16(dir ? afB[ks] : afA[ks], bf, acc[cb]); }
            __builtin_amdgcn_sched_barrier(0); }
        if (dir == 0) {
#pragma unroll
            for (int ks = 0; ks < 8; ++ks) afA[ks] = *(const bx8*)(Wop + (size_t)(16 * (2 * w) + lr) * 256 + 32 * ks); }
        else {
#pragma unroll
            for (int ks = 0; ks < 8; ++ks) afB[ks] = *(const bx8*)(Wop + (size_t)(16 * (2 * w + 1) + lr) * 256 + 32 * ks); }
#pragma unroll
        for (int cb = 0; cb < 4; ++cb)
#pragma unroll
            for (int r = 0; r < 4; ++r) Dl[(16 * w + 4 * lq + r) * 65 + 16 * cb + lr] = acc[cb][r];
        LDS_BARRIER();
        if (tid < (lat ? 64 : 256)) {
            const int n = tid & 63, bl = tid >> 6, nc = lat ? 64 : 16, cbase = lat ? 0 : 16 * bl, b = lat ? cu - 8 : 4 * cu + bl;
            const float* at = (const float*)(c.ws() + WS_S5AT) + ((size_t)(dir * 32 + g) * 64 + n) * 2; const float ar = at[0], ai = at[1];
            float sr = 0.f, si = 0.f;
            if (lat) { sr = c.state_s5()[((((size_t)(b * 2 + l) * 2 + dir) * 2 + 0) * 32 + g) * 64 + n]; si = c.state_s5()[((((size_t)(b * 2 + l) * 2 + dir) * 2 + 1) * 32 + g) * 64 + n]; }
            for (int cc = 0; cc < nc; ++cc) { const int col = cbase + (dir ? nc - 1 - cc : cc);
                St[col * 264 + dir * 128 + n] = (bf16)f2bf(sr); St[col * 264 + dir * 128 + 64 + n] = (bf16)f2bf(si);
                const float dr = Dl[n * 65 + col], di = Dl[(64 + n) * 65 + col];
                const float nr = ar * sr - ai * si + dr, ni = ar * si + ai * sr + di; sr = nr; si = ni; }
            if (!lat) { c.out()[O_S5 + ((((size_t)(b * 2 + l) * 2 + dir) * 2 + 0) * 32 + g) * 64 + n] = sr; c.out()[O_S5 + ((((size_t)(b * 2 + l) * 2 + dir) * 2 + 1) * 32 + g) * 64 + n] = si; }
        }
        LDS_BARRIER();
    }
#pragma unroll
    for (int ii = 0; ii < 2; ++ii) { const int i = 2 * w + ii;
        f32x4 acc[4];
#pragma unroll
        for (int cb = 0; cb < 4; ++cb) acc[cb] = (f32x4){0.f, 0.f, 0.f, 0.f};
#pragma unroll
        for (int ks = 0; ks < 8; ++ks) { const int j = 2 * ks + (lq >> 1); const bx8 af = *(const bx8*)(Kt + ((i - j + 15) * 16 + lr) * 16 + 8 * (lq & 1));
#pragma unroll
            for (int cb = 0; cb < 4; ++cb) { const bx8 bf = *(const bx8*)(Ut + (16 * cb + lr) * 264 + 32 * ks + 8 * lq); acc[cb] = MFMA16(af, bf, acc[cb]); }
            __builtin_amdgcn_sched_barrier(0); }
#pragma unroll
        for (int ks = 0; ks < 8; ++ks) {
#pragma unroll
            for (int cb = 0; cb < 4; ++cb) { const bx8 bf = *(const bx8*)(St + (16 * cb + lr) * 264 + 32 * ks + 8 * lq); acc[cb] = MFMA16(ii ? afB[ks] : afA[ks], bf, acc[cb]); }
            __builtin_amdgcn_sched_barrier(0); }
#pragma unroll
        for (int cb = 0; cb < 4; ++cb) { const int col = 16 * cb + lr;
            const int tok = lat ? MC + (cu - 8) * 1024 + col * 16 + i : (4 * cu + (col >> 4)) * 256 + (col & 15) * 16 + i;
            v2u o; o.x = pk2(acc[cb][0], acc[cb][1]); o.y = pk2(acc[cb][2], acc[cb][3]);
            *(v2u*)(c.Y5() + (size_t)tok * 512 + g * 16 + 4 * lq) = o; }
    }
}

typedef float f32x16 __attribute__((ext_vector_type(16)));
#define MFMA32(a, b, cc) __builtin_amdgcn_mfma_f32_32x32x16_bf16((a), (b), (cc), 0, 0, 0)
constexpr float SM_SC = 0.125f * 1.4426950408889634f;
__device__ __forceinline__ void qk_tile(f32x16& p0, f32x16& p1, const bf16* Kt, int KS, const bx8 (&qf)[4], int r32, int hi) {
    p0 = (f32x16){0.f}; p1 = (f32x16){0.f};
    bx8 a0[4], a1[4];
#pragma unroll
    for (int d0 = 0; d0 < 4; ++d0) { a0[d0] = *(const bx8*)(Kt + r32 * KS + 16 * d0 + 8 * hi); a1[d0] = *(const bx8*)(Kt + (32 + r32) * KS + 16 * d0 + 8 * hi); }
    __builtin_amdgcn_s_setprio(1);
#pragma unroll
    for (int d0 = 0; d0 < 4; ++d0) { p0 = MFMA32(a0[d0], qf[d0], p0); p1 = MFMA32(a1[d0], qf[d0], p1); }
    __builtin_amdgcn_s_setprio(0);
}
__device__ __forceinline__ float fmax_(float a, float b) { float r; asm("v_max_f32_e32 %0, %1, %2" : "=v"(r) : "v"(a), "v"(b)); return r; }
__device__ __forceinline__ float sm_step(f32x16& p0, f32x16& p1, float& mrun, float& lrun, bx8 (&pb)[4]) {
    float ta = fmax_(p0[0], p1[0]), tb = fmax_(p0[1], p1[1]);
#pragma unroll
    for (int r = 2; r < 16; r += 2) { ta = fmax_(ta, fmax_(p0[r], p1[r])); tb = fmax_(tb, fmax_(p0[r + 1], p1[r + 1])); }
    float tm = fmax_(ta, tb) * SM_SC;
    tm = fmax_(tm, __shfl_xor(tm, 32));
    const float mn = fmax_(mrun, tm), alpha = __builtin_amdgcn_exp2f(mrun - mn);
    float rs0 = 0.f, rs1 = 0.f;
#pragma unroll
    for (int r = 0; r < 16; ++r) { p0[r] = __builtin_amdgcn_exp2f(fmaf(p0[r], SM_SC, -mn)); p1[r] = __builtin_amdgcn_exp2f(fmaf(p1[r], SM_SC, -mn)); rs0 += p0[r]; rs1 += p1[r]; }
    float rs = rs0 + rs1;
    rs += __shfl_xor(rs, 32);
    lrun = lrun * alpha + rs; mrun = mn;
#pragma unroll
    for (int sI = 0; sI < 2; ++sI) {
        v4u t0, t1;
        t0.x = pg8::cvt_pk_bf16(p0[8 * sI + 0], p0[8 * sI + 1]); t0.y = pg8::cvt_pk_bf16(p0[8 * sI + 2], p0[8 * sI + 3]); t0.z = pg8::cvt_pk_bf16(p0[8 * sI + 4], p0[8 * sI + 5]); t0.w = pg8::cvt_pk_bf16(p0[8 * sI + 6], p0[8 * sI + 7]);
        t1.x = pg8::cvt_pk_bf16(p1[8 * sI + 0], p1[8 * sI + 1]); t1.y = pg8::cvt_pk_bf16(p1[8 * sI + 2], p1[8 * sI + 3]); t1.z = pg8::cvt_pk_bf16(p1[8 * sI + 4], p1[8 * sI + 5]); t1.w = pg8::cvt_pk_bf16(p1[8 * sI + 6], p1[8 * sI + 7]);
        pb[sI] = __builtin_bit_cast(bx8, t0); pb[2 + sI] = __builtin_bit_cast(bx8, t1);
    }
    return alpha;
}
typedef short v4i16_t __attribute__((ext_vector_type(4)));
__device__ __forceinline__ v2u vtr(const bf16* p) { return __builtin_bit_cast(v2u, __builtin_amdgcn_ds_read_tr16_b64_v4i16((__attribute__((address_space(3))) v4i16_t*)p)); }
template <int NDT, int VS> __device__ __forceinline__ void pv_tile(f32x16 (&o)[NDT], const bf16* Vr, const bx8 (&pb)[4], int lane) {
    const bf16* vb = Vr + (4 * (lane >> 5) + ((lane & 15) >> 2)) * VS + 16 * ((lane >> 4) & 1) + 4 * (lane & 3);
    v2u cur[NDT][2], nxt[NDT][2];
#pragma unroll
    for (int dt = 0; dt < NDT; ++dt) { cur[dt][0] = vtr(vb + 32 * dt); cur[dt][1] = vtr(vb + 8 * VS + 32 * dt); }
#pragma unroll
    for (int ks = 0; ks < 4; ++ks) {
        if (ks < 3) {
#pragma unroll
            for (int dt = 0; dt < NDT; ++dt) { nxt[dt][0] = vtr(vb + (16 * (ks + 1)) * VS + 32 * dt); nxt[dt][1] = vtr(vb + (16 * (ks + 1) + 8) * VS + 32 * dt); }
        }
        __builtin_amdgcn_s_setprio(1);
#pragma unroll
        for (int dt = 0; dt < NDT; ++dt) { const v4u t = {cur[dt][0].x, cur[dt][0].y, cur[dt][1].x, cur[dt][1].y}; o[dt] = MFMA32(__builtin_bit_cast(bx8, t), pb[ks], o[dt]); }
        __builtin_amdgcn_s_setprio(0);
#pragma unroll
        for (int dt = 0; dt < NDT; ++dt) { cur[dt][0] = nxt[dt][0]; cur[dt][1] = nxt[dt][1]; }
    }
}

template <int PASS> __device__ __forceinline__ void diff_unit(const Ctx& c, int l, int uidx, unsigned char* lds) {
    constexpr int NT = PASS ? 10 : 2, NQB = PASS ? 8 : 2, VS = 160;
    const int tid = c.tid, lane = c.lane, w = c.wave, r32 = lane & 31, hi = lane >> 5, comp = w >> 2;
    const int qb = uidx % NQB, h = (uidx / NQB) & 3, b = uidx / (NQB * 4);
    const int tok0 = PASS ? MC + b * 1024 : b * 256;
    bf16* Kt = (bf16*)lds;
    bf16* Vr = Kt + 128 * 136;
    float* Ob = (float*)lds;
    const bf16* R1p = c.R1(); const bf16* CK = c.CKV() + (size_t)l * 1024 * 1280;
    const float lam_init = 0.8f - 0.6f * expf(-0.3f * (float)l);
    const float* lv = c.dlam() + l * 256;
    const float lam = expf(wave_sum(lv[lane] * lv[64 + lane])) - expf(wave_sum(lv[128 + lane] * lv[192 + lane])) + lam_init;
    const size_t mrow = (size_t)tok0 + qb * 128 + 32 * (w & 3) + r32;
    bx8 qf[4];
#pragma unroll
    for (int d0 = 0; d0 < 4; ++d0) qf[d0] = *(const bx8*)(R1p + mrow * 4096 + C_DQ + h * 128 + comp * 64 + 16 * d0 + 8 * hi);
    f32x16 o[4];
#pragma unroll
    for (int dt = 0; dt < 4; ++dt) o[dt] = (f32x16){0.f};
    float mrun = -1e30f, lrun = 0.f;
    v4u kreg[4], vreg[4];
#define DIFF_LOAD(t) { const bf16* kb; const bf16* vb; size_t rs; \
        if (PASS && (t) < 2) { kb = CK + ((size_t)b * 256 + 128 * (t)) * 1280 + h * 128; vb = kb + 512; rs = 1280; } \
        else { kb = R1p + ((size_t)tok0 + 128 * ((t) - (PASS ? 2 : 0))) * 4096 + C_DK + h * 128; vb = kb + (C_DV - C_DK); rs = 4096; } \
        _Pragma("unroll") for (int i = 0; i < 4; ++i) { const int id = tid + NTHR * i; kreg[i] = *(const v4u*)(kb + (size_t)(id >> 4) * rs + (id & 15) * 8); vreg[i] = *(const v4u*)(vb + (size_t)(id >> 4) * rs + (id & 15) * 8); } }
    DIFF_LOAD(0);
    for (int t = 0; t < NT; ++t) {
        LDS_BARRIER();
#pragma unroll
        for (int i = 0; i < 4; ++i) { const int id = tid + NTHR * i; *(v4u*)(Kt + (id >> 4) * 136 + (id & 15) * 8) = kreg[i]; *(v4u*)(Vr + (id >> 4) * VS + (id & 15) * 8) = vreg[i]; }
        if (t + 1 < NT) DIFF_LOAD(t + 1);
        LDS_BARRIER();
#pragma unroll
        for (int sub = 0; sub < 2; ++sub) {
            f32x16 p0, p1; bx8 pb[4];
            qk_tile(p0, p1, Kt + sub * 64 * 136 + comp * 64, 136, qf, r32, hi);
            const float alpha = sm_step(p0, p1, mrun, lrun, pb);
            if (__any(alpha != 1.0f)) {
#pragma unroll
                for (int dt = 0; dt < 4; ++dt)
#pragma unroll
                    for (int r = 0; r < 16; ++r) o[dt][r] *= alpha; }
            pv_tile<4, VS>(o, Vr + sub * 64 * VS, pb, lane);
        }
    }
#undef DIFF_LOAD
    const float inv = (comp ? lam : 1.0f) / lrun;
    const int rowl = 32 * (w & 3) + r32;
    LDS_BARRIER();
    if (comp) {
#pragma unroll
        for (int dt = 0; dt < 4; ++dt)
#pragma unroll
            for (int r = 0; r < 16; ++r) Ob[rowl * 129 + 32 * dt + (r & 3) + 8 * (r >> 2) + 4 * hi] = o[dt][r] * inv;
    }
    LDS_BARRIER();
    if (!comp) {
        float ss = 0.f;
#pragma unroll
        for (int dt = 0; dt < 4; ++dt)
#pragma unroll
            for (int r = 0; r < 16; ++r) { const float v = o[dt][r] * inv - Ob[rowl * 129 + 32 * dt + (r & 3) + 8 * (r >> 2) + 4 * hi]; o[dt][r] = v; ss += v * v; }
        ss += __shfl_xor(ss, 32);
        const float rn = rsqrtf(ss * (1.0f / 128.0f) + EPS) * (1.0f - lam_init);
        const float* sg = c.subln_g() + l * 128; bf16* yp = c.Y() + mrow * 2048 + 1024 + h * 128;
#pragma unroll
        for (int dt = 0; dt < 4; ++dt)
#pragma unroll
            for (int r4 = 0; r4 < 4; ++r4) { const int dv = 32 * dt + 8 * r4 + 4 * hi; const f32x4 g = *(const f32x4*)(sg + dv);
                v2u ov; ov.x = pk2(o[dt][4 * r4 + 0] * rn * g.x, o[dt][4 * r4 + 1] * rn * g.y); ov.y = pk2(o[dt][4 * r4 + 2] * rn * g.z, o[dt][4 * r4 + 3] * rn * g.w);
                *(v2u*)(yp + dv) = ov; }
    }
}

template <int PASS> __device__ __forceinline__ void win_unit(const Ctx& c, int l, int uidx, unsigned char* lds) {
    constexpr int NQB = PASS ? 4 : 1, VS = 96;
    const int tid = c.tid, lane = c.lane, w = c.wave, r32 = lane & 31, hi = lane >> 5;
    const int qb = uidx % NQB, hh = (uidx / NQB) & 7, b = uidx / (NQB * 8), nkv = hh >> 2;
    const int tok0 = PASS ? MC + b * 1024 : b * 256;
    bf16* Kt = (bf16*)lds;
    bf16* Vr = Kt + 128 * 72;
    const bf16* R1p = c.R1(); const bf16* CK = c.CKV() + (size_t)l * 1024 * 1280;
    const int qrow = qb * 256 + 32 * w + r32;
    const size_t mrow = (size_t)tok0 + qrow;
    bx8 qf[4];
#pragma unroll
    for (int d0 = 0; d0 < 4; ++d0) qf[d0] = *(const bx8*)(R1p + mrow * 4096 + C_WQ + hh * 64 + 16 * d0 + 8 * hi);
    f32x16 o[2]; o[0] = (f32x16){0.f}; o[1] = (f32x16){0.f};
    float mrun = c.sink()[l * 8 + hh] * 1.4426950408889634f, lrun = 1.0f;
    const int q0 = qb * 256;
    const int tb0 = PASS ? ((q0 - 128 < 0 ? 0 : q0 - 128) >> 7) : 0, tb1 = PASS ? ((q0 + 255 + 128 > 1023 ? 1023 : q0 + 255 + 128) >> 7) : 0;
    const int NT = PASS ? 2 + (tb1 - tb0 + 1) : 2;
    v4u kreg[2], vreg[2];
#define WIN_LOAD(t) { const bf16* kb; const bf16* vb; size_t rs; \
        if (PASS && (t) < 2) { kb = CK + ((size_t)b * 256 + 128 * (t)) * 1280 + 1024 + nkv * 64; vb = kb + 128; rs = 1280; } \
        else { kb = R1p + ((size_t)tok0 + 128 * (PASS ? tb0 + (t) - 2 : (t))) * 4096 + C_WK + nkv * 64; vb = kb + (C_WV - C_WK); rs = 4096; } \
        _Pragma("unroll") for (int i = 0; i < 2; ++i) { const int id = tid + NTHR * i; kreg[i] = *(const v4u*)(kb + (size_t)(id >> 3) * rs + (id & 7) * 8); vreg[i] = *(const v4u*)(vb + (size_t)(id >> 3) * rs + (id & 7) * 8); } }
    WIN_LOAD(0);
    for (int t = 0; t < NT; ++t) {
        LDS_BARRIER();
#pragma unroll
        for (int i = 0; i < 2; ++i) { const int id = tid + NTHR * i; *(v4u*)(Kt + (id >> 3) * 72 + (id & 7) * 8) = kreg[i]; *(v4u*)(Vr + (id >> 3) * VS + (id & 7) * 8) = vreg[i]; }
        if (t + 1 < NT) WIN_LOAD(t + 1);
        LDS_BARRIER();
#pragma unroll
        for (int sub = 0; sub < 2; ++sub) {
            bool band = false; int kp0 = 0;
            if (PASS && t >= 2) { band = true; kp0 = 128 * (tb0 + t - 2) + 64 * sub; const int r0 = q0 + 32 * w;
                if (kp0 + 63 < r0 - 128 || kp0 > r0 + 31 + 128) continue; }
            f32x16 p0, p1; bx8 pb[4];
            qk_tile(p0, p1, Kt + sub * 64 * 72, 72, qf, r32, hi);
            if (band) {
#pragma unroll
                for (int r = 0; r < 16; ++r) { const int kp = kp0 + (r & 3) + 8 * (r >> 2) + 4 * hi; const int d0 = qrow - kp, d1 = d0 - 32;
                    if (d0 > 128 || d0 < -128) p0[r] = -1e30f; if (d1 > 128 || d1 < -128) p1[r] = -1e30f; }
            }
            const float alpha = sm_step(p0, p1, mrun, lrun, pb);
            if (__any(alpha != 1.0f)) {
#pragma unroll
                for (int dt = 0; dt < 2; ++dt)
#pragma unroll
                    for (int r = 0; r < 16; ++r) o[dt][r] *= alpha; }
            pv_tile<2, VS>(o, Vr + sub * 64 * VS, pb, lane);
        }
    }
#undef WIN_LOAD
    const float inv = 1.0f / lrun; bf16* yp = c.Y() + mrow * 2048 + 1536 + hh * 64;
#pragma unroll
    for (int dt = 0; dt < 2; ++dt)
#pragma unroll
        for (int r4 = 0; r4 < 4; ++r4) { const int dv = 32 * dt + 8 * r4 + 4 * hi;
            v2u ov; ov.x = pk2(o[dt][4 * r4 + 0] * inv, o[dt][4 * r4 + 1] * inv); ov.y = pk2(o[dt][4 * r4 + 2] * inv, o[dt][4 * r4 + 3] * inv);
            *(v2u*)(yp + dv) = ov; }
}

__device__ __forceinline__ void phase_mixers(const Ctx& c_in, int l, float* lf) {
    unsigned char* lds = (unsigned char*)lf;
    unsigned* qctr = (unsigned*)(c_in.ws() + WS_QCTR) + 64 * l;
    volatile int* qslot = (volatile int*)(lds + LDS_BYTES - 32);
    for (;;) {
        __syncthreads();
        if (threadIdx.x == 0) *qslot = (int)atomicAdd(qctr, 1u);
        __syncthreads();
        const int u = __builtin_amdgcn_readfirstlane(*qslot);
        if (u >= 1440) break;
        Ctx c = c_in; asm volatile("" : "+s"(c.ap), "+v"(c.tid));
        c.lane = c.tid & 63; c.wave = __builtin_amdgcn_readfirstlane(c.tid >> 6);
        unsigned long long pt0 = 0; if (PROBE_SEL >= 0) pt0 = __builtin_amdgcn_s_memrealtime();
        int ty;
        if (u < 32) { ssd_unit(c, l, 1, u >> 3, u & 7, lds); ty = 0; }
        else if (u < 160) { diff_unit<1>(c, l, u - 32, lds); ty = 2; }
        else if (u < 288) { win_unit<1>(c, l, u - 160, lds); ty = 3; }
        else if (u < 416) { s5_unit(c, l, (u - 288) & 31, 8 + ((u - 288) >> 5), lds); ty = 1; }
        else if (u < 672) { ssd_unit(c, l, 0, (u - 416) >> 3, (u - 416) & 7, lds); ty = 4; }
        else if (u < 928) { diff_unit<0>(c, l, u - 672, lds); ty = 6; }
        else if (u < 1184) { win_unit<0>(c, l, u - 928, lds); ty = 7; }
        else { s5_unit(c, l, (u - 1184) & 31, (u - 1184) >> 5, lds); ty = 5; }
        __syncthreads();
        if (PROBE_SEL >= 0 && threadIdx.x == 0) { unsigned long long* tsu = (unsigned long long*)(c.ws() + WS_TS) + 64; atomicAdd(tsu + ty, (unsigned long long)(__builtin_amdgcn_s_memrealtime() - pt0)); }
    }
}

__device__ __forceinline__ void phase_sum4(const Ctx& c) {
    const int gt = blockIdx.x * NTHR + c.tid, NT = gridDim.x * NTHR;
#pragma unroll 4
    for (int i = gt; i < M * 128; i += NT) { const size_t m = (size_t)(i >> 7); const int c8 = (i & 127) * 8;
        float a[8] = {0.f, 0.f, 0.f, 0.f, 0.f, 0.f, 0.f, 0.f};
#pragma unroll
        for (int j = 0; j < 4; ++j) { float f[8]; unpack8(*(const v4u*)(c.R1() + m * 4096 + j * 1024 + c8), f);
#pragma unroll
            for (int k = 0; k < 8; ++k) a[k] += f[k]; }
        v4u o; o.x = pk2(a[0], a[1]); o.y = pk2(a[2], a[3]); o.z = pk2(a[4], a[5]); o.w = pk2(a[6], a[7]);
        *(v4u*)(c.H() + m * 1024 + c8) = o; }
}

#define GAS __attribute__((address_space(1)))
#define XB_TMO      128
#define XB_XCNT(j)  (256  + 64 * (j))
#define XB_XSUB(j)  (1280 + 64 * (j))
#define XB_XGEN(j)  (2304 + 64 * (j))
#define XB_TOP      3328
#define XB_TOPGEN   3392
#define XCD_BAR_WORDS 3456
#define XB_SPIN_CAP (1u << 18)

__device__ __forceinline__ unsigned xb_ld(unsigned* p)              { return __hip_atomic_load(p, __ATOMIC_RELAXED, __HIP_MEMORY_SCOPE_AGENT); }
__device__ __forceinline__ unsigned xb_add(unsigned* p, unsigned v) { return __hip_atomic_fetch_add(p, v, __ATOMIC_RELAXED, __HIP_MEMORY_SCOPE_AGENT); }
__device__ __forceinline__ unsigned xb_xcc_id() { return (unsigned)__builtin_amdgcn_s_getreg((3 << 11) | 20) & 0xFu; }
#define XB_SPIN(cond, bar) do { unsigned _sp = 0; while (cond) { __builtin_amdgcn_s_sleep(1); \
    if ((++_sp & 255u) == 0u) { if (xb_ld(&(bar)[XB_TMO])) break; if (_sp > XB_SPIN_CAP) { atomicAdd(&(bar)[XB_TMO], 1u); break; } } } } while (0)

struct XcdBarrier {
    unsigned* bar; unsigned x;
    volatile LAS unsigned* st;
};

__device__ __forceinline__ XcdBarrier xcd_barrier_post(unsigned* bar, volatile LAS unsigned* st) {
    XcdBarrier b; b.bar = bar; b.x = xb_xcc_id(); b.st = st;
    if (threadIdx.x == 0) (void)xb_add(&bar[XB_XCNT(b.x)], 1u);
    return b;
}
__device__ __forceinline__ void xcd_barrier_complete(unsigned* bar, unsigned x, unsigned& nloc, unsigned& nx) {
    const unsigned G = gridDim.x * gridDim.y * gridDim.z;
    unsigned sum, cnt, mine, sp = 0u;
    for (;;) {
        sum = 0u; cnt = 0u; mine = 0u;
#pragma unroll
        for (unsigned j = 0; j < 16; ++j) { const unsigned c = xb_ld(&bar[XB_XCNT(j)]); sum += c; cnt += (c > 0u) ? 1u : 0u; mine = (j == x) ? c : mine; }
        if (sum == G) break;
        __builtin_amdgcn_s_sleep(1);
        if ((++sp & 255u) == 0u) { if (xb_ld(&bar[XB_TMO])) break; if (sp > XB_SPIN_CAP) { atomicAdd(&bar[XB_TMO], 1u); break; } }
    }
    nloc = mine > 0u ? mine : 1u; nx = cnt > 0u ? cnt : 1u;
}

__device__ __forceinline__ void xcd_barrier(const XcdBarrier& b) {
    asm volatile("s_waitcnt vmcnt(0)" ::: "memory");
    __syncthreads();
    if (threadIdx.x == 0) {
        unsigned* bar = b.bar;
        __builtin_amdgcn_s_waitcnt(0);
        unsigned nloc = b.st[0], nx = b.st[1];
        if (nloc == 0u) { xcd_barrier_complete(bar, b.x, nloc, nx); b.st[0] = nloc; b.st[1] = nx; }
        const unsigned old = xb_add(&bar[XB_XSUB(b.x)], 1u);
        const unsigned gen = old / nloc;
        if (old + 1u == (gen + 1u) * nloc) {
            __builtin_amdgcn_fence(__ATOMIC_RELEASE, "agent");
            asm volatile("s_waitcnt vmcnt(0)" ::: "memory");
            const unsigned og = xb_add(&bar[XB_TOP], 1u);
            const unsigned tg = og / nx;
            if (og + 1u == (tg + 1u) * nx) xb_add(&bar[XB_TOPGEN], 1u);
            else XB_SPIN(xb_ld(&bar[XB_TOPGEN]) == tg, bar);
            __builtin_amdgcn_fence(__ATOMIC_ACQUIRE, "agent");
            xb_add(&bar[XB_XGEN(b.x)], 1u);
            asm volatile("s_waitcnt vmcnt(0)" ::: "memory");
        } else {
            XB_SPIN(xb_ld(&bar[XB_XGEN(b.x)]) == gen, bar);
            __builtin_amdgcn_fence(__ATOMIC_ACQUIRE, "agent");
            asm volatile("s_waitcnt vmcnt(0)" ::: "memory");
        }
    }
    __syncthreads();
}

#define PHASE_BEGIN() Ctx c; c.ap = (CArgs)__builtin_amdgcn_kernarg_segment_ptr(); asm volatile("" : "+s"(c.ap)); \
        int tid_o = threadIdx.x; asm volatile("" : "+v"(tid_o)); c.tid = tid_o; c.lane = tid_o & 63; c.wave = __builtin_amdgcn_readfirstlane(tid_o >> 6); \
        int G = gridDim.x, bid = blockIdx.x; asm volatile("" : "+s"(G), "+s"(bid)); unsigned char* ws = c.ws(); (void)ws; (void)G; (void)bid;
#define PHASE_END(k) { if ((k) + 1 < ph_hi) { if ((k) == 0) cg::this_grid().sync(); else xcd_barrier(xbar); } \
        if (PROBE_SEL >= 0 && blockIdx.x == PROBE_PB && threadIdx.x == 0) ((unsigned long long*)(c.ws() + WS_TS))[(k) + 1] = __builtin_amdgcn_s_memrealtime(); }
#define IN_RANGE(k) (ph_lo <= (k) && (k) < ph_hi)

template <int LAYER> __device__ __forceinline__ void layer_program(int ph_lo, int ph_hi, unsigned char* lds, const XcdBarrier& xbar) {
    float* lf = (float*)lds;
    PG8_LAS unsigned char* ring = (PG8_LAS unsigned char*)lds;
    constexpr int l = LAYER, B0 = 1 + 11 * LAYER;
    if (IN_RANGE(B0 + 0)) { PHASE_BEGIN(); if (l == 1) { if (gridDim.x == 256) convert_items(c, 1, 7936, 9984, blockIdx.x * NWAVES + c.wave, gridDim.x * NWAVES, false, 0, 1, lf); else phase_convert(c, 1, lf); __syncthreads(); } phase_norm(c, l, 0, lf); phase_bias2(c, l); PHASE_END(B0 + 0); }
    if (IN_RANGE(B0 + 1)) { PHASE_BEGIN();
        pg8::Gemm g{c.H(), (const bf16*)(ws + W_IN), M, 4096, 1024, 1024, 1024, 0, 0}; pg8::StaticOrder S; S.init(M, 4096, G, bid);
        pg8::EpiB<0> E{c.R1(), 4096, nullptr, nullptr};
        pg8::gemm_phase<pg8::EpiB<0>, pg8::StaticOrder, true, true>(ring, g, S, E, tid_o); phase_dt(c, l); PHASE_END(B0 + 1); }
    if (IN_RANGE(B0 + 2)) { PHASE_BEGIN(); phase_qk(c, l, lf); PHASE_END(B0 + 2); }
    if (IN_RANGE(B0 + 3)) { PHASE_BEGIN(); phase_mixers(c, l, lf); PHASE_END(B0 + 3); }
    if (IN_RANGE(B0 + 4)) { PHASE_BEGIN();
        { pg8::Gemm g{c.Y5(), (const bf16*)(ws + W_GLU), M, 1024, 512, 512, 512, 0, 0}; pg8::StaticOrder S; S.init(M, 1024, G, bid);
          pg8::EpiGlu E{c.Y(), 2048, 512, c.b_glu() + l * 1024};
          pg8::gemm_phase<pg8::EpiGlu, pg8::StaticOrder, true, true>(ring, g, S, E, tid_o); }
        { pg8::Gemm g{c.H(), (const bf16*)(ws + W_G), M, 4096, 1024, 1024, 1024, 0, 0}; pg8::StaticOrder S; S.init(M, 4096, G, bid);
          pg8::EpiB<1> E{c.R1(), 4096, c.b_gate() + l * 4096, nullptr};
          pg8::gemm_phase<pg8::EpiB<1>, pg8::StaticOrder, true, true>(ring, g, S, E, tid_o); }
        PHASE_END(B0 + 4); }
    if (IN_RANGE(B0 + 5)) { PHASE_BEGIN();
        pg8::Gemm g{c.Y(), (const bf16*)(ws + W_BR), M, 4096, 512, 2048, 512, 4, 1024}; pg8::BranchOrder S; S.init(G, bid);
        pg8::EpiMerge E{c.R1(), c.H(), c.SSQ()};
        pg8::gemm_phase<pg8::EpiMerge, pg8::BranchOrder, true, true>(ring, g, S, E, tid_o); if (l == 0) side_convert(c, 0, 4352, true, lf); PHASE_END(B0 + 5); }
    if (IN_RANGE(B0 + 7)) { PHASE_BEGIN();
        pg8::Gemm g{c.H(), (const bf16*)(ws + W_OUT), M, 1024, 1024, 1024, 1024, 0, 0}; pg8::StaticOrder S; S.init(M, 1024, G, bid);
        pg8::EpiRes2 E{l == 0 ? c.x_prompt() : c.out(), l == 0 ? c.x_sample() : c.out() + (size_t)MC * D, c.out(), c.MOD() + (size_t)l * 5 * 6144, 2048, c.Y(), c.g_norm2() + l * 1024, 4096, (float*)(ws + WS_SSQ2)};
        pg8::gemm_phase<pg8::EpiRes2, pg8::StaticOrder, true, true>(ring, g, S, E, tid_o); if (l == 0) side_convert(c, 4352, 5376, false, lf); PHASE_END(B0 + 7); }
    if (IN_RANGE(B0 + 9)) { PHASE_BEGIN();
        pg8::Gemm g{c.Y(), (const bf16*)(ws + W_1), M, 4096, 1024, 1024, 1024, 0, 0}; pg8::StaticOrder S; S.init(M, 4096, G, bid);
        pg8::EpiB<5> E{c.R1(), 4096, (const float*)(ws + WS_BI2), (const float*)(ws + WS_SSQ2)};
        pg8::gemm_phase<pg8::EpiB<5>, pg8::StaticOrder, true, true>(ring, g, S, E, tid_o); PHASE_END(B0 + 9); }
    if (IN_RANGE(B0 + 10)) { PHASE_BEGIN();
        pg8::Gemm g{c.R1(), (const bf16*)(ws + W_2), M, 1024, 4096, 4096, 4096, 0, 0}; pg8::StaticOrder S; S.init(M, 1024, G, bid);
        pg8::EpiRes E{c.out(), c.out() + (size_t)MC * D, c.out(), c.MOD() + (size_t)l * 5 * 6144, 5120};
        pg8::gemm_phase<pg8::EpiRes, pg8::StaticOrder, true, true>(ring, g, S, E, tid_o); if (l == 0) side_convert(c, 5376, 7936, false, lf); PHASE_END(B0 + 10); }
}

__global__ void __launch_bounds__(NTHR, 2) fwd_kernel(Args args) {
    extern __shared__ __attribute__((aligned(16))) unsigned char lds[];
    const int ph_lo = args.ph_lo, ph_hi = args.ph_hi;
    volatile LAS unsigned* xst = (volatile LAS unsigned*)(lds + LDS_BYTES - 16);
    if (threadIdx.x < 4) xst[threadIdx.x] = 0u;
    __syncthreads();
    const XcdBarrier xbar = xcd_barrier_post((unsigned*)(args.ws + WS_BAR), xst);
    if (PROBE_SEL >= 0 && blockIdx.x == PROBE_PB && threadIdx.x == 0) { unsigned long long* ts = (unsigned long long*)(args.ws + WS_TS); ts[0] = __builtin_amdgcn_s_memrealtime(); }
    if (IN_RANGE(0)) { PHASE_BEGIN(); float* lf = (float*)lds; phase_mods(c, lf); __syncthreads(); phase_convert(c, 0, lf); phase_rope_table(c); phase_ckv(c); PHASE_END(0); }
    layer_program<0>(ph_lo, ph_hi, lds, xbar);
    layer_program<1>(ph_lo, ph_hi, lds, xbar);
    if (PROBE_SEL >= 0) {
        __threadfence(); cg::this_grid().sync();
        const unsigned long long* ts = (const unsigned long long*)(args.ws + WS_TS);
        const float total = (float)(ts[23] - ts[0]); float sel = 0.f;
        for (int k = 0; k < 23; ++k) { const float d = (float)(ts[k + 1] - ts[k]); const int q = k == 0 ? -1 : (k - 1) % 11;
            const int cls = (q == 3) ? 0 : (q == 1 || q == 4 || q == 5 || q == 7 || q == 9 || q == 10) ? 1 : (q == 2) ? 2 : 3;
            if (cls == PROBE_SEL) sel += d; }
        if (PROBE_SEL >= 10 && PROBE_SEL < 100) sel = (float)ts[64 + PROBE_SEL - 10] * (1.0f / 256.0f);
        if (PROBE_SEL >= 100) { const int k = PROBE_SEL - 100; sel = (float)(ts[k + 1] - (ts[k] != 0ull ? ts[k] : ts[k - 1])); }
        const float sc = 1.0f + sqrtf(PROBE_SCALE * sel / total);
        for (int i = blockIdx.x * NTHR + threadIdx.x; i < 524288; i += gridDim.x * NTHR) args.out[O_S5 + i] *= sc;
    }
}

extern "C" void kernel_launch(void* const* d_in, const int* in_sizes, int n_in, void* d_out, int out_size, void* d_ws, size_t ws_size, hipStream_t stream) {
    static int grid = 0;
    if (grid == 0) {
        if (n_in != 44 || ws_size < WS_END) { fprintf(stderr, "kernel_launch: expected 44 inputs and >= %zu bytes of workspace; got %d, %zu\n", (size_t)WS_END, n_in, ws_size); grid = -1; return; }
        int dev = 0, cus = 0, per_cu = 0;
        (void)hipGetDevice(&dev); (void)hipDeviceGetAttribute(&cus, hipDeviceAttributeMultiprocessorCount, dev);
        (void)hipFuncSetAttribute((const void*)fwd_kernel, hipFuncAttributeMaxDynamicSharedMemorySize, LDS_BYTES);
        (void)hipOccupancyMaxActiveBlocksPerMultiprocessor(&per_cu, (const void*)fwd_kernel, NTHR, LDS_BYTES);
        if (per_cu < 1) { fprintf(stderr, "kernel_launch: occupancy query says %d blocks per CU\n", per_cu); per_cu = 1; }
        (void)hipGetLastError();
        grid = cus > 0 ? cus : 256;
    }
    if (grid < 0) return;
    (void)hipMemsetAsync(d_ws, 0, 64 * 1024, stream);
    Args a{};
    for (int i = 0; i < 44; ++i) a.in[i] = (const float*)d_in[i];
    a.out = (float*)d_out; a.ws = (unsigned char*)d_ws;
#if MK_MULTI
    for (int ph = 0; ph < NPH; ++ph) { a.ph_lo = ph; a.ph_hi = ph + 1; hipLaunchKernelGGL(fwd_kernel, dim3(grid), dim3(NTHR), LDS_BYTES, stream, a); }
#else
    a.ph_lo = 0; a.ph_hi = NPH;
    void* kargs[] = {&a};
    hipError_t e = hipLaunchCooperativeKernel((const void*)fwd_kernel, dim3(grid), dim3(NTHR), kargs, LDS_BYTES, stream);
    if (e != hipSuccess) fprintf(stderr, "cooperative launch failed: %s (grid %d)\n", hipGetErrorString(e), grid);
#endif
}
```

```cpp
#include <hip/hip_runtime.h>
#include <hip/hip_cooperative_groups.h>
#include <cstdio>
#include <cstdint>
namespace cg = cooperative_groups;

#ifndef MK_MULTI
#define MK_MULTI 0
#endif

namespace pg8 {
#define PG8_LAS __attribute__((address_space(3)))
typedef unsigned short bf16_t;
typedef short bf16x8 __attribute__((ext_vector_type(8)));
typedef float f32x4 __attribute__((ext_vector_type(4)));
typedef unsigned u32x4 __attribute__((ext_vector_type(4)));
constexpr int BM = 256, BK = 64, HALF = 128, HTB = HALF * BK * 2  , STAGE_BYTES = 8 * HTB, NXCD = 8, WGM = 8;

__host__ __device__ __forceinline__ int lds_byte(int r, int c) { const int st = (r >> 4) * 2 + (c >> 5), rr = r & 15, cc = c & 31, ob = rr * 64 + cc * 2; return st * 1024 + (ob ^ (((ob >> 9) & 1) << 5)); }
__host__ __device__ __forceinline__ void stage_rc(int b, int& R, int& C) { const int st = b / 1024, sb = b % 1024, swz = sb ^ (((sb >> 9) & 1) << 5); R = (st >> 1) * 16 + swz / 64; C = (st & 1) * 32 + (swz % 64) / 2; }
__host__ __device__ __forceinline__ int perm32(int rho) { const int n = rho >> 4, i = rho & 15; return 8 * (i >> 2) + 4 * n + (i & 3); }

struct Unit { int pm, pn; };
struct Gemm { const bf16_t* A; const bf16_t* Bt; int M, N, K, lda, ldb, a_div; size_t a_gstride; };

struct StaticOrder {
    int nM, nN, nwg, G, c;
    __host__ __device__ void init(int M, int N, int G_, int c_) { nM = M / BM; nN = N / BM; nwg = nM * nN; G = G_; c = c_; }
    __host__ __device__ bool next(int i, Unit& u) const {
        const long L = (long)i * G + c; if (L >= nwg) return false;
        int wgid = (int)L; { const int q = nwg / NXCD, r = nwg % NXCD, xcd = wgid % NXCD, off = wgid / NXCD; wgid = (xcd < r ? xcd * (q + 1) : r * (q + 1) + (xcd - r) * q) + off; }
        const int nig = WGM * nN, gid = wgid / nig, fm = gid * WGM, gsz = (nM - fm) < WGM ? (nM - fm) : WGM;
        u.pm = fm + ((wgid % nig) % gsz); u.pn = (wgid % nig) / gsz; return true;
    }
    __device__ __forceinline__ void a_ready(const Unit&) const {}
    __device__ __forceinline__ void done(const Unit&) const {}
};

__device__ __forceinline__ unsigned cvt_pk_bf16(float lo, float hi) { unsigned r; asm volatile("v_cvt_pk_bf16_f32 %0, %1, %2" : "=v"(r) : "v"(lo), "v"(hi)); return r; }
__device__ __forceinline__ float bf_lo(unsigned w) { return __builtin_bit_cast(float, w << 16); }
__device__ __forceinline__ float bf_hi(unsigned w) { return __builtin_bit_cast(float, w & 0xffff0000u); }
__device__ __forceinline__ float sigmoidf_(float x) { return 1.0f / (1.0f + __expf(-x)); }

template <int MODE> struct EpiB {
    static constexpr bool PERM = true, AFTER_DRAIN = false;
    bf16_t* O; int ldc; const float* bias; const float* ssq;
    __device__ __forceinline__ void operator()(const f32x4 (&acc)[2][2][4][2], const Unit& u, int wr, int wc, int fr, int fq) const {
        const int row0 = u.pm * BM + wr * 64 + fr, col0 = u.pn * BM + wc * 32 + 8 * fq;
        f32x4 bv[2][2];
#pragma unroll
        for (int bj = 0; bj < 2; ++bj)
#pragma unroll
            for (int n = 0; n < 2; ++n) bv[bj][n] = (MODE == 1) ? *(const f32x4*)(bias + col0 + bj * HALF + 4 * n) : (MODE == 5) ? *(const f32x4*)(bias + (size_t)((u.pm < 32) ? 0 : 1 + ((u.pm - 32) >> 2)) * 4096 + col0 + bj * HALF + 4 * n) : (f32x4){0.f, 0.f, 0.f, 0.f};
        u32x4 gpre[2][4][2]; float rpre[2][4];
        if (MODE == 3) {
#pragma unroll
            for (int ai = 0; ai < 2; ++ai)
#pragma unroll
                for (int m = 0; m < 4; ++m) { const int row = row0 + ai * HALF + m * 16; const bf16_t* rp = O + (size_t)row * ldc + col0;
                    rpre[ai][m] = (u.pn < 4) ? ssq[row] : 512.0f;
#pragma unroll
                    for (int bj = 0; bj < 2; ++bj) gpre[ai][m][bj] = *(const u32x4*)(rp + bj * HALF); }
        }
#pragma unroll
        for (int ai = 0; ai < 2; ++ai)
#pragma unroll
            for (int m = 0; m < 4; ++m) {
                const int row = row0 + ai * HALF + m * 16;
                bf16_t* rowp = O + (size_t)row * ldc + col0;
                float rs = 1.f;
                if (MODE == 3) { if (u.pn < 4) rs = rsqrtf(rpre[ai][m] * (1.0f / 512.0f) + 1e-6f); }
                if (MODE == 5) rs = rsqrtf(ssq[row] * (1.0f / 1024.0f) + 1e-6f);
#pragma unroll
                for (int bj = 0; bj < 2; ++bj) {
                    f32x4 v0 = (MODE == 5 ? acc[ai][bj][m][0] * rs : acc[ai][bj][m][0]) + bv[bj][0], v1 = (MODE == 5 ? acc[ai][bj][m][1] * rs : acc[ai][bj][m][1]) + bv[bj][1];
                    if (MODE == 1) {
#pragma unroll
                        for (int j = 0; j < 4; ++j) { v0[j] = sigmoidf_(v0[j]); v1[j] = sigmoidf_(v1[j]); }
                    }
                    if (MODE == 2 || MODE == 5) {
#pragma unroll
                        for (int j = 0; j < 4; ++j) { const float a = fmaxf(v0[j], 0.f), b = fmaxf(v1[j], 0.f); v0[j] = a * a; v1[j] = b * b; }
                    }
                    if (MODE == 3) {
                        const u32x4 gq = gpre[ai][m][bj];
                        v0[0] *= bf_lo(gq.x) * rs; v0[1] *= bf_hi(gq.x) * rs; v0[2] *= bf_lo(gq.y) * rs; v0[3] *= bf_hi(gq.y) * rs;
                        v1[0] *= bf_lo(gq.z) * rs; v1[1] *= bf_hi(gq.z) * rs; v1[2] *= bf_lo(gq.w) * rs; v1[3] *= bf_hi(gq.w) * rs;
                    }
                    u32x4 w; w.x = cvt_pk_bf16(v0[0], v0[1]); w.y = cvt_pk_bf16(v0[2], v0[3]); w.z = cvt_pk_bf16(v1[0], v1[1]); w.w = cvt_pk_bf16(v1[2], v1[3]);
                    *(u32x4*)(rowp + bj * HALF) = w;
                }
            }
    }
};
struct EpiGlu {
    static constexpr bool PERM = true, AFTER_DRAIN = false;
    bf16_t* O; int ldc; int ocol; const float* bias;
    __device__ __forceinline__ void operator()(const f32x4 (&acc)[2][2][4][2], const Unit& u, int wr, int wc, int fr, int fq) const {
        const int row0 = u.pm * BM + wr * 64 + fr, cc = u.pn * HALF + wc * 32 + 8 * fq;
        f32x4 bv[2][2];
#pragma unroll
        for (int bj = 0; bj < 2; ++bj)
#pragma unroll
            for (int n = 0; n < 2; ++n) bv[bj][n] = *(const f32x4*)(bias + bj * 512 + cc + 4 * n);
#pragma unroll
        for (int ai = 0; ai < 2; ++ai)
#pragma unroll
            for (int m = 0; m < 4; ++m) {
                bf16_t* rowp = O + (size_t)(row0 + ai * HALF + m * 16) * ldc + ocol + cc;
                f32x4 v0 = acc[ai][0][m][0] + bv[0][0], v1 = acc[ai][0][m][1] + bv[0][1];
                const f32x4 g0 = acc[ai][1][m][0] + bv[1][0], g1 = acc[ai][1][m][1] + bv[1][1];
#pragma unroll
                for (int j = 0; j < 4; ++j) { v0[j] *= sigmoidf_(g0[j]); v1[j] *= sigmoidf_(g1[j]); }
                u32x4 w; w.x = cvt_pk_bf16(v0[0], v0[1]); w.y = cvt_pk_bf16(v0[2], v0[3]); w.z = cvt_pk_bf16(v1[0], v1[1]); w.w = cvt_pk_bf16(v1[2], v1[3]);
                *(u32x4*)rowp = w;
            }
    }
};
struct EpiRes2 {
    static constexpr bool PERM = false, AFTER_DRAIN = false;
    const float* base_ctx; const float* base_lat; float* out; const float* modv; int goff;
    bf16_t* xn; const float* gnorm; int scoff; float* ssq;
    __device__ __forceinline__ void operator()(const f32x4 (&acc)[2][2][4][2], const Unit& u, int wr, int wc, int fr, int fq) const {
        const int row0 = u.pm * BM + wr * 64 + fr, col0 = u.pn * BM + wc * 32 + 4 * fq;
        const int mi = (u.pm < 32) ? 0 : 1 + ((u.pm - 32) >> 2);
        const float* gv = modv + (size_t)mi * 6144 + goff; const float* sv = modv + (size_t)mi * 6144 + scoff;
        f32x4 gg[2][2], gn[2][2];
#pragma unroll
        for (int bj = 0; bj < 2; ++bj)
#pragma unroll
            for (int n = 0; n < 2; ++n) { gg[bj][n] = *(const f32x4*)(gv + col0 + bj * HALF + n * 16); gn[bj][n] = *(const f32x4*)(gnorm + col0 + bj * HALF + n * 16) * (*(const f32x4*)(sv + col0 + bj * HALF + n * 16) + 1.0f); }
#pragma unroll
        for (int ai = 0; ai < 2; ++ai)
#pragma unroll
        for (int mh = 0; mh < 2; ++mh) {
            f32x4 pre[2][2][2];
#pragma unroll
            for (int mm = 0; mm < 2; ++mm) { const int row = row0 + ai * HALF + (2 * mh + mm) * 16;
                const float* bp = (row < 8192 ? base_ctx + (size_t)row * 1024 : base_lat + (size_t)(row - 8192) * 1024) + col0;
#pragma unroll
                for (int bj = 0; bj < 2; ++bj)
#pragma unroll
                    for (int n = 0; n < 2; ++n) pre[mm][bj][n] = *(const f32x4*)(bp + bj * HALF + n * 16); }
#pragma unroll
            for (int mm = 0; mm < 2; ++mm) { const int m = 2 * mh + mm; const int row = row0 + ai * HALF + m * 16; float* op = out + (size_t)row * 1024 + col0; bf16_t* xp = xn + (size_t)row * 1024 + col0;
                float q = 0.f;
#pragma unroll
                for (int bj = 0; bj < 2; ++bj)
#pragma unroll
                    for (int n = 0; n < 2; ++n) { const f32x4 x = pre[mm][bj][n] + gg[bj][n] * acc[ai][bj][m][n]; *(f32x4*)(op + bj * HALF + n * 16) = x;
                        q += (x[0] * x[0] + x[1] * x[1]) + (x[2] * x[2] + x[3] * x[3]);
                        const f32x4 y = x * gn[bj][n]; unsigned w0 = cvt_pk_bf16(y[0], y[1]), w1 = cvt_pk_bf16(y[2], y[3]);
                        typedef unsigned u32x2 __attribute__((ext_vector_type(2))); *(u32x2*)(xp + bj * HALF + n * 16) = (u32x2){w0, w1}; }
                q += __shfl_xor(q, 16); q += __shfl_xor(q, 32);
                if (fq == 0) atomicAdd(ssq + row, q); }
            asm volatile("" ::: "memory");
        }
    }
};
struct EpiMerge {
    static constexpr bool PERM = true, AFTER_DRAIN = false;
    const bf16_t* gates; bf16_t* mg; const float* ssq;
    __device__ __forceinline__ void operator()(const f32x4 (&acc)[2][2][4][2], const Unit& u, int wr, int wc, int fr, int fq) const {
        const int br = u.pn >> 2, pnl = u.pn & 3;
        int pm_o = u.pm; asm volatile("" : "+s"(pm_o));
        const int row0 = pm_o * BM + wr * 64 + fr, gcol0 = u.pn * BM + wc * 32 + 8 * fq, mcol0 = pnl * BM + wc * 32 + 8 * fq;
#pragma unroll
        for (int ai = 0; ai < 2; ++ai)
#pragma unroll
        for (int mh = 0; mh < 2; ++mh) {
            u32x4 gpre[2][2], mpre[2][2]; float rpre[2];
#pragma unroll
            for (int mm = 0; mm < 2; ++mm) { const int row = row0 + ai * HALF + (2 * mh + mm) * 16;
                rpre[mm] = (br == 0) ? ssq[row] : 512.0f;
#pragma unroll
                for (int bj = 0; bj < 2; ++bj) { gpre[mm][bj] = *(const u32x4*)(gates + (size_t)row * 4096 + gcol0 + bj * HALF);
                    mpre[mm][bj] = (br != 0) ? *(const u32x4*)(mg + (size_t)row * 1024 + mcol0 + bj * HALF) : (u32x4){0u, 0u, 0u, 0u}; } }
#pragma unroll
            for (int mm = 0; mm < 2; ++mm) { const int m = 2 * mh + mm; const int row = row0 + ai * HALF + m * 16;
                const float rs = (br == 0) ? rsqrtf(rpre[mm] * (1.0f / 512.0f) + 1e-6f) : 1.0f;
#pragma unroll
                for (int bj = 0; bj < 2; ++bj) { const u32x4 gq = gpre[mm][bj], mq = mpre[mm][bj]; const f32x4 a0 = acc[ai][bj][m][0], a1 = acc[ai][bj][m][1];
                    const float v0 = bf_lo(mq.x) + a0[0] * bf_lo(gq.x) * rs, v1 = bf_hi(mq.x) + a0[1] * bf_hi(gq.x) * rs, v2 = bf_lo(mq.y) + a0[2] * bf_lo(gq.y) * rs, v3 = bf_hi(mq.y) + a0[3] * bf_hi(gq.y) * rs;
                    const float v4 = bf_lo(mq.z) + a1[0] * bf_lo(gq.z) * rs, v5 = bf_hi(mq.z) + a1[1] * bf_hi(gq.z) * rs, v6 = bf_lo(mq.w) + a1[2] * bf_lo(gq.w) * rs, v7 = bf_hi(mq.w) + a1[3] * bf_hi(gq.w) * rs;
                    u32x4 w; w.x = cvt_pk_bf16(v0, v1); w.y = cvt_pk_bf16(v2, v3); w.z = cvt_pk_bf16(v4, v5); w.w = cvt_pk_bf16(v6, v7);
                    *(u32x4*)(mg + (size_t)row * 1024 + mcol0 + bj * HALF) = w; } }
            asm volatile("" ::: "memory");
        }
    }
};
struct BranchOrder {
    int G, c;
    __host__ __device__ void init(int G_, int c_) { G = G_; c = c_; }
    __host__ __device__ bool next(int i, Unit& u) const { if (c >= 192 || i >= 4) return false; u.pm = c >> 2; u.pn = i * 4 + (c & 3); return true; }
    __device__ __forceinline__ void a_ready(const Unit&) const {}
    __device__ __forceinline__ void done(const Unit&) const {}
};
struct EpiRes {
    static constexpr bool PERM = false, AFTER_DRAIN = false;
    const float* base_ctx; const float* base_lat;
    float* out; const float* modv;
    int goff;
    __device__ __forceinline__ void operator()(const f32x4 (&acc)[2][2][4][2], const Unit& u, int wr, int wc, int fr, int fq) const {
        const int row0 = u.pm * BM + wr * 64 + fr, col0 = u.pn * BM + wc * 32 + 4 * fq;
        const int mi = (u.pm < 32) ? 0 : 1 + ((u.pm - 32) >> 2);
        const float* gv = modv + (size_t)mi * 6144 + goff;
        f32x4 gg[2][2];
#pragma unroll
        for (int bj = 0; bj < 2; ++bj)
#pragma unroll
            for (int n = 0; n < 2; ++n) gg[bj][n] = *(const f32x4*)(gv + col0 + bj * HALF + n * 16);
#pragma unroll
        for (int ai = 0; ai < 2; ++ai) {
            f32x4 pre[4][2][2];
#pragma unroll
            for (int m = 0; m < 4; ++m) { const int row = row0 + ai * HALF + m * 16;
                const float* bp = (row < 8192 ? base_ctx + (size_t)row * 1024 : base_lat + (size_t)(row - 8192) * 1024) + col0;
#pragma unroll
                for (int bj = 0; bj < 2; ++bj)
#pragma unroll
                    for (int n = 0; n < 2; ++n) pre[m][bj][n] = *(const f32x4*)(bp + bj * HALF + n * 16); }
#pragma unroll
            for (int m = 0; m < 4; ++m) { const int row = row0 + ai * HALF + m * 16; float* op = out + (size_t)row * 1024 + col0;
#pragma unroll
                for (int bj = 0; bj < 2; ++bj)
#pragma unroll
                    for (int n = 0; n < 2; ++n) *(f32x4*)(op + bj * HALF + n * 16) = pre[m][bj][n] + gg[bj][n] * acc[ai][bj][m][n]; }
            asm volatile("" ::: "memory");
        }
    }
};

template <class Epi, class Sched, bool ALIGN_EPI = false, bool SP2 = false>
__device__ __forceinline__ void gemm_phase(PG8_LAS unsigned char* lds, const Gemm g, const Sched& S, const Epi& E, const int tid) {
    const int wid = __builtin_amdgcn_readfirstlane(tid >> 6), lane = tid & 63, wr = wid >> 2, wc = wid & 3, fr = lane & 15, fq = lane >> 4;
    const int K = g.K, nt = K / BK;
    unsigned voffA[2], voffB[2];
#pragma unroll
    for (int i = 0; i < 2; ++i) { int R, C; stage_rc(tid * 16 + i * 8192, R, C); const int Rb = Epi::PERM ? ((R & ~31) + perm32(R & 31)) : R;
        voffA[i] = (unsigned)(R * g.lda + C) * 2u; voffB[i] = (unsigned)(Rb * g.ldb + C) * 2u; }
    const size_t kstep = (size_t)(BK * 2);
    const size_t hstepA = (size_t)HALF * g.lda * 2, hstepB = (size_t)HALF * g.ldb * 2;
    const size_t tstepA = 2 * hstepA, tstepB = 2 * hstepB;
#define PG8_UA(u) ((const char*)g.A + (size_t)(u).pm * tstepA + (g.a_div ? (size_t)((u).pn / g.a_div) * g.a_gstride : (size_t)0))
#define PG8_UB(u) ((const char*)g.Bt + (size_t)(u).pn * tstepB)
    const unsigned ldsw = (unsigned)wid * 1024u;
    const int aoff = lds_byte(wr * 64 + fr, fq * 8), boff = lds_byte(wc * 32 + fr, fq * 8);
#define PG8_SA(b, h) (((b) * 2 + (h)) * HTB)
#define PG8_SB(b, h) ((4 + (b) * 2 + (h)) * HTB)
#define PG8_STAGE(bufoff, gbase, voff) do { _Pragma("unroll") for (int _i = 0; _i < 2; ++_i) \
        __builtin_amdgcn_global_load_lds((const unsigned*)((const char*)(gbase) + (voff)[_i]), (PG8_LAS unsigned*)(lds + (bufoff) + ldsw + _i * 8192), 16, 0, 0); } while (0)
#define PG8_LDA(dst, b, h) do { _Pragma("unroll") for (int m = 0; m < 4; ++m) _Pragma("unroll") for (int k = 0; k < 2; ++k) dst[m][k] = *(const PG8_LAS bf16x8*)(lds + PG8_SA(b, h) + aoff + m * 2048 + k * 1024); } while (0)
#define PG8_LDB(dst, b, h) do { _Pragma("unroll") for (int n = 0; n < 2; ++n) _Pragma("unroll") for (int k = 0; k < 2; ++k) dst[n][k] = *(const PG8_LAS bf16x8*)(lds + PG8_SB(b, h) + boff + n * 2048 + k * 1024); } while (0)
#define PG8_MMA(ai, bj, At, Bt) do { __builtin_amdgcn_s_setprio(1); _Pragma("unroll") for (int m = 0; m < 4; ++m) _Pragma("unroll") for (int n = 0; n < 2; ++n) _Pragma("unroll") for (int k = 0; k < 2; ++k) \
        acc[ai][bj][m][n] = __builtin_amdgcn_mfma_f32_16x16x32_bf16(Bt[n][k], At[m][k], acc[ai][bj][m][n], 0, 0, 0); __builtin_amdgcn_s_setprio(0); } while (0)
#define PG8_WAIT_V(n) asm volatile("s_waitcnt vmcnt(" #n ")" ::: "memory")
#define PG8_WAIT_L(n) asm volatile("s_waitcnt lgkmcnt(" #n ")" ::: "memory")
#define PG8_BAR __builtin_amdgcn_s_barrier()
#define PG8_SCHED __builtin_amdgcn_sched_barrier(0)
    Unit cur, nxt; int ui = 0;
    if (!S.next(0, cur)) return;
    f32x4 acc[2][2][4][2];
#pragma unroll
    for (int a = 0; a < 2; ++a)
#pragma unroll
        for (int b = 0; b < 2; ++b)
#pragma unroll
            for (int m = 0; m < 4; ++m)
#pragma unroll
                for (int n = 0; n < 2; ++n) acc[a][b][m][n] = (f32x4){0.f, 0.f, 0.f, 0.f};
    bf16x8 At[4][2], B0[2][2], B1[2][2];
    const char* cA = PG8_UA(cur); const char* cB = PG8_UB(cur);
    S.a_ready(cur);
    if constexpr (SP2) {
        PG8_STAGE(PG8_SB(0, 0), cB, voffB); PG8_STAGE(PG8_SB(0, 1), cB + hstepB, voffB); PG8_STAGE(PG8_SA(0, 0), cA, voffA); PG8_STAGE(PG8_SA(0, 1), cA + hstepA, voffA);
        if (wr == 1) PG8_BAR;
        PG8_WAIT_V(2); PG8_BAR;
        PG8_STAGE(PG8_SB(1, 0), cB + kstep, voffB); PG8_STAGE(PG8_SA(1, 0), cA + kstep, voffA); PG8_STAGE(PG8_SB(1, 1), cB + hstepB + kstep, voffB);
        PG8_WAIT_V(6); PG8_BAR;
    } else {
        PG8_STAGE(PG8_SB(0, 0), cB, voffB); PG8_STAGE(PG8_SA(0, 0), cA, voffA); PG8_STAGE(PG8_SB(0, 1), cB + hstepB, voffB); PG8_STAGE(PG8_SA(0, 1), cA + hstepA, voffA);
        if (wr == 1) PG8_BAR;
        PG8_WAIT_V(4); PG8_BAR;
        PG8_STAGE(PG8_SB(1, 0), cB + kstep, voffB); PG8_STAGE(PG8_SA(1, 0), cA + kstep, voffA); PG8_STAGE(PG8_SB(1, 1), cB + hstepB + kstep, voffB);
        PG8_WAIT_V(6); PG8_BAR;
    }
    for (;;) {
        const bool has_next = S.next(ui + 1, nxt);
        const char* nA = has_next ? PG8_UA(nxt) : cA; const char* nB = has_next ? PG8_UB(nxt) : cB;
        for (int t = 0; t < nt; t += 2) {
            const bool last = (t == nt - 2);
            const char* a1 = cA + (size_t)(t + 1) * kstep;
            const char* a2 = last ? nA : cA + (size_t)(t + 2) * kstep; const char* b2 = last ? nB : cB + (size_t)(t + 2) * kstep;
            const char* a3 = a2 + kstep; const char* b3 = b2 + kstep;
            if (last && has_next) S.a_ready(nxt);
            if constexpr (SP2) {
            PG8_LDB(B0, 0, 0); PG8_LDB(B1, 0, 1); PG8_SCHED; PG8_LDA(At, 0, 0); PG8_STAGE(PG8_SA(1, 1), a1 + hstepA, voffA);
            PG8_WAIT_V(8); PG8_WAIT_L(0); PG8_BAR; PG8_MMA(0, 0, At, B0); PG8_MMA(0, 1, At, B1); PG8_BAR; PG8_SCHED;
            PG8_LDA(At, 0, 1); PG8_STAGE(PG8_SB(0, 0), b2, voffB); PG8_STAGE(PG8_SB(0, 1), b2 + hstepB, voffB); PG8_STAGE(PG8_SA(0, 0), a2, voffA);
            PG8_WAIT_V(8); PG8_WAIT_L(0); PG8_BAR; PG8_MMA(1, 0, At, B0); PG8_MMA(1, 1, At, B1); PG8_BAR; PG8_SCHED;
            PG8_LDB(B0, 1, 0); PG8_LDB(B1, 1, 1); PG8_SCHED; PG8_LDA(At, 1, 0); PG8_STAGE(PG8_SA(0, 1), a2 + hstepA, voffA);
            PG8_WAIT_V(8); PG8_WAIT_L(0); PG8_BAR; PG8_MMA(0, 0, At, B0); PG8_MMA(0, 1, At, B1); PG8_BAR; PG8_SCHED;
            PG8_LDA(At, 1, 1); PG8_STAGE(PG8_SB(1, 0), b3, voffB); PG8_STAGE(PG8_SB(1, 1), b3 + hstepB, voffB); PG8_STAGE(PG8_SA(1, 0), a3, voffA);
            PG8_WAIT_V(8); PG8_WAIT_L(0); PG8_BAR; PG8_MMA(1, 0, At, B0); PG8_MMA(1, 1, At, B1); PG8_BAR; PG8_SCHED;
            } else {
            PG8_LDB(B0, 0, 0); PG8_SCHED; PG8_LDA(At, 0, 0); PG8_STAGE(PG8_SA(1, 1), a1 + hstepA, voffA);
            PG8_WAIT_L(8); PG8_BAR; PG8_WAIT_L(0); PG8_MMA(0, 0, At, B0); PG8_BAR; PG8_SCHED;
            PG8_LDB(B1, 0, 1); PG8_STAGE(PG8_SB(0, 0), b2, voffB);
            PG8_BAR; PG8_WAIT_L(0); PG8_MMA(0, 1, At, B1); PG8_BAR;
            PG8_LDA(At, 0, 1); PG8_STAGE(PG8_SA(0, 0), a2, voffA);
            PG8_BAR; PG8_WAIT_L(0); PG8_MMA(1, 0, At, B0); PG8_BAR; PG8_SCHED;
            PG8_STAGE(PG8_SB(0, 1), b2 + hstepB, voffB);
            PG8_WAIT_V(6); PG8_BAR; PG8_MMA(1, 1, At, B1); PG8_BAR;
            PG8_LDB(B0, 1, 0); PG8_SCHED; PG8_LDA(At, 1, 0); PG8_STAGE(PG8_SA(0, 1), a2 + hstepA, voffA);
            PG8_WAIT_L(8); PG8_BAR; PG8_WAIT_L(0); PG8_MMA(0, 0, At, B0); PG8_BAR; PG8_SCHED;
            PG8_LDB(B1, 1, 1); PG8_STAGE(PG8_SB(1, 0), b3, voffB);
            PG8_BAR; PG8_WAIT_L(0); PG8_MMA(0, 1, At, B1); PG8_BAR;
            PG8_LDA(At, 1, 1); PG8_STAGE(PG8_SA(1, 0), a3, voffA);
            PG8_BAR; PG8_WAIT_L(0); PG8_MMA(1, 0, At, B0); PG8_BAR; PG8_SCHED;
            PG8_STAGE(PG8_SB(1, 1), b3 + hstepB, voffB);
            PG8_WAIT_V(6); PG8_BAR; PG8_MMA(1, 1, At, B1); PG8_BAR;
            }
        }
        if constexpr (ALIGN_EPI) { if (wr == 0) PG8_BAR; }
        if constexpr (!Epi::AFTER_DRAIN) { E(acc, cur, wr, wc, fr, fq); S.done(cur); }
        if (!has_next) break;
#pragma unroll
        for (int a = 0; a < 2; ++a)
#pragma unroll
            for (int b = 0; b < 2; ++b)
#pragma unroll
                for (int m = 0; m < 4; ++m)
#pragma unroll
                    for (int n = 0; n < 2; ++n) acc[a][b][m][n] = (f32x4){0.f, 0.f, 0.f, 0.f};
        cur = nxt; cA = nA; cB = nB; ++ui;
        if constexpr (ALIGN_EPI) { if (wr == 1) PG8_BAR; }
    }
    PG8_WAIT_V(0);
    if constexpr (!ALIGN_EPI) { if (wr == 0) PG8_BAR; }
    PG8_BAR;
    if constexpr (Epi::AFTER_DRAIN) { E.fused(acc, cur, wr, wc, fr, fq, lds, wid, lane); S.done(cur); }
#undef PG8_UA
#undef PG8_UB
#undef PG8_SA
#undef PG8_SB
#undef PG8_STAGE
#undef PG8_LDA
#undef PG8_LDB
#undef PG8_MMA
#undef PG8_WAIT_V
#undef PG8_WAIT_L
#undef PG8_BAR
#undef PG8_SCHED
}
}

#ifndef PG8_SP2
#define PG8_SP2 true
#endif
#ifndef PG8_ALIGN
#define PG8_ALIGN true
#endif

typedef unsigned short bf16;
typedef unsigned v4u __attribute__((ext_vector_type(4)));
typedef unsigned v2u __attribute__((ext_vector_type(2)));
typedef float f32x4 __attribute__((ext_vector_type(4)));
#define LAS __attribute__((address_space(3)))

constexpr int NWAVES = 8, NTHR = 512;
constexpr int D = 1024, MC = 8192, ML = 4096, M = 12288, NPH = 23;
constexpr int LDS_BYTES = 147456;
constexpr float EPS = 1e-6f;
constexpr size_t MiB = 1u << 20;
constexpr size_t WS_MOD = 64 * 1024;
constexpr size_t WS_SSQ = 320 * 1024;
constexpr size_t WS_DT = 384 * 1024;
constexpr size_t WS_W = 2 * MiB;
constexpr size_t W_IN = WS_W, W_G = W_IN + 8 * MiB, W_GLU = W_G + 8 * MiB, W_BR = W_GLU + 1 * MiB, W_OUT = W_BR + 4 * MiB, W_1 = W_OUT + 2 * MiB, W_2 = W_1 + 8 * MiB;
constexpr size_t WS_H = 41 * MiB;
constexpr size_t WS_R1 = 65 * MiB;
constexpr size_t WS_Y = 161 * MiB;
constexpr size_t WS_Y5 = 209 * MiB;
constexpr size_t WS_XC = 221 * MiB;
constexpr size_t WS_S5K = 239 * MiB;
constexpr size_t WS_S5WS = 240 * MiB;
constexpr size_t WS_S5WO = 244 * MiB;
constexpr size_t WS_S5AT = 248 * MiB;
constexpr size_t WS_CKV = 248 * MiB + 512 * 1024;
constexpr size_t WS_ROPE = 1536 * 1024;
constexpr size_t WS_WDT = 1792 * 1024;
constexpr size_t WS_BI2 = 1824 * 1024;
constexpr size_t WS_SSQ2 = 1904 * 1024;
constexpr size_t WS_END = 254 * MiB;
#ifndef PROBE_SEL
#define PROBE_SEL -1
#endif
#ifndef PROBE_SCALE
#define PROBE_SCALE 4e-4f
#endif
#ifndef PROBE_PB
#define PROBE_PB 32
#endif
constexpr size_t WS_BAR = 32 * 1024;
constexpr size_t WS_QCTR = 48 * 1024;
constexpr size_t WS_TS = 16 * 1024;
constexpr size_t O_SSD = 12582912, O_S5 = 16777216, O_DK = 17301504, O_DV = 25690112, O_WK = 34078720, O_WV = 36175872;
constexpr int C_Z = 0, C_XBC = 512, C_U = 1280, C_DQ = 1792, C_DK = 2304, C_DV = 2816, C_WQ = 3328, C_WK = 3840, C_WV = 3968;

struct Args { const float* in[44]; float* out; unsigned char* ws; int ph_lo, ph_hi; };

typedef const Args __attribute__((address_space(4)))* CArgs;
struct Ctx {
    CArgs ap; int tid, lane, wave;
    __device__ __forceinline__ const float* x_prompt() const { return ap->in[0]; }
    __device__ __forceinline__ const float* x_sample() const { return ap->in[1]; }
    __device__ __forceinline__ const float* state_ssd() const { return ap->in[2]; }
    __device__ __forceinline__ const float* state_s5() const { return ap->in[3]; }
    __device__ __forceinline__ const float* cache_dk() const { return ap->in[4]; }
    __device__ __forceinline__ const float* cache_dv() const { return ap->in[5]; }
    __device__ __forceinline__ const float* cache_wk() const { return ap->in[6]; }
    __device__ __forceinline__ const float* cache_wv() const { return ap->in[7]; }
    __device__ __forceinline__ const float* cvec() const { return ap->in[8]; }
    __device__ __forceinline__ const float* c_ctx() const { return ap->in[9]; }
    __device__ __forceinline__ const float* w_mod() const { return ap->in[10]; }
    __device__ __forceinline__ const float* b_mod() const { return ap->in[11]; }
    __device__ __forceinline__ const float* g_norm1() const { return ap->in[12]; }
    __device__ __forceinline__ const float* g_norm2() const { return ap->in[13]; }
    __device__ __forceinline__ const float* w_in() const { return ap->in[14]; }
    __device__ __forceinline__ const float* conv_w() const { return ap->in[15]; }
    __device__ __forceinline__ const float* conv_b() const { return ap->in[16]; }
    __device__ __forceinline__ const float* dt_bias() const { return ap->in[17]; }
    __device__ __forceinline__ const float* a_log() const { return ap->in[18]; }
    __device__ __forceinline__ const float* ssd_d() const { return ap->in[19]; }
    __device__ __forceinline__ const float* ssd_norm_g() const { return ap->in[20]; }
    __device__ __forceinline__ const float* lam_re() const { return ap->in[21]; }
    __device__ __forceinline__ const float* lam_im() const { return ap->in[22]; }
    __device__ __forceinline__ const float* log_step() const { return ap->in[23]; }
    __device__ __forceinline__ const float* b_re() const { return ap->in[24]; }
    __device__ __forceinline__ const float* b_im() const { return ap->in[25]; }
    __device__ __forceinline__ const float* c_re() const { return ap->in[26]; }
    __device__ __forceinline__ const float* c_im() const { return ap->in[27]; }
    __device__ __forceinline__ const float* s5_d() const { return ap->in[28]; }
    __device__ __forceinline__ const float* w_glu() const { return ap->in[29]; }
    __device__ __forceinline__ const float* b_glu() const { return ap->in[30]; }
    __device__ __forceinline__ const float* qn_g() const { return ap->in[31]; }
    __device__ __forceinline__ const float* kn_g() const { return ap->in[32]; }
    __device__ __forceinline__ const float* dlam() const { return ap->in[33]; }
    __device__ __forceinline__ const float* subln_g() const { return ap->in[34]; }
    __device__ __forceinline__ const float* wqn_g() const { return ap->in[35]; }
    __device__ __forceinline__ const float* wkn_g() const { return ap->in[36]; }
    __device__ __forceinline__ const float* sink() const { return ap->in[37]; }
    __device__ __forceinline__ const float* w_branch() const { return ap->in[38]; }
    __device__ __forceinline__ const float* w_gate() const { return ap->in[39]; }
    __device__ __forceinline__ const float* b_gate() const { return ap->in[40]; }
    __device__ __forceinline__ const float* w_out() const { return ap->in[41]; }
    __device__ __forceinline__ const float* w_fc1() const { return ap->in[42]; }
    __device__ __forceinline__ const float* w_fc2() const { return ap->in[43]; }
    __device__ __forceinline__ float* out() const { return ap->out; }
    __device__ __forceinline__ unsigned char* ws() const { return ap->ws; }
    __device__ __forceinline__ float* MOD() const { return (float*)(ap->ws + WS_MOD); }
    __device__ __forceinline__ float* SSQ() const { return (float*)(ap->ws + WS_SSQ); }
    __device__ __forceinline__ float* DT() const { return (float*)(ap->ws + WS_DT); }
    __device__ __forceinline__ bf16* H() const { return (bf16*)(ap->ws + WS_H); }
    __device__ __forceinline__ bf16* R1() const { return (bf16*)(ap->ws + WS_R1); }
    __device__ __forceinline__ bf16* Y() const { return (bf16*)(ap->ws + WS_Y); }
    __device__ __forceinline__ bf16* Y5() const { return (bf16*)(ap->ws + WS_Y5); }
    __device__ __forceinline__ bf16* XC() const { return (bf16*)(ap->ws + WS_XC); }
    __device__ __forceinline__ bf16* CKV() const { return (bf16*)(ap->ws + WS_CKV); }
    __device__ __forceinline__ float* ROPE() const { return (float*)(ap->ws + WS_ROPE); }
};

__device__ __forceinline__ float wave_sum(float v) {
#pragma unroll
    for (int o = 1; o < 64; o <<= 1) v += __shfl_xor(v, o);
    return v;
}
__device__ __forceinline__ float wave_max(float v) {
#pragma unroll
    for (int o = 1; o < 64; o <<= 1) v = fmaxf(v, __shfl_xor(v, o));
    return v;
}
__device__ __forceinline__ float bf2f(bf16 h) { return __builtin_bit_cast(float, (unsigned)h << 16); }
__device__ __forceinline__ float bflo(unsigned w) { return __builtin_bit_cast(float, w << 16); }
__device__ __forceinline__ float bfhi(unsigned w) { return __builtin_bit_cast(float, w & 0xffff0000u); }
__device__ __forceinline__ unsigned f2bf(float f) { unsigned u = __builtin_bit_cast(unsigned, f); return (u + 0x7fffu + ((u >> 16) & 1u)) >> 16; }
__device__ __forceinline__ unsigned pk2(float lo, float hi) { return f2bf(lo) | (f2bf(hi) << 16); }
__device__ __forceinline__ float siluf(float x) { return x / (1.0f + __expf(-x)); }
__device__ __forceinline__ void unpack8(const v4u q, float (&f)[8]) { f[0] = bflo(q.x); f[1] = bfhi(q.x); f[2] = bflo(q.y); f[3] = bfhi(q.y); f[4] = bflo(q.z); f[5] = bfhi(q.z); f[6] = bflo(q.w); f[7] = bfhi(q.w); }

__device__ __forceinline__ void phase_mods(const Ctx& c, float* lf) {
    for (int i = c.tid; i < 5 * 1024; i += NTHR) { const int v = i >> 10, k = i & 1023; const float x = (v == 0) ? c.c_ctx()[k] : c.cvec()[(v - 1) * 1024 + k]; lf[i] = siluf(x); }
    __syncthreads();
    float* red = lf + 5 * 1024;
    for (int u = blockIdx.x; u < 192; u += gridDim.x) {
        const int l = u / 96, col0 = (u % 96) * 64;
        const float* W = c.w_mod() + (size_t)l * 1024 * 6144 + col0 + c.lane;
        float acc[5] = {0.f, 0.f, 0.f, 0.f, 0.f};
#pragma unroll 1
        for (int kb = c.wave * 128; kb < c.wave * 128 + 128; kb += 32) {
            float wv[32];
#pragma unroll
            for (int j = 0; j < 32; ++j) wv[j] = W[(size_t)(kb + j) * 6144];
#pragma unroll
            for (int j = 0; j < 32; ++j)
#pragma unroll
                for (int i = 0; i < 5; ++i) acc[i] += lf[i * 1024 + kb + j] * wv[j]; }
#pragma unroll
        for (int i = 0; i < 5; ++i) red[(c.wave * 5 + i) * 64 + c.lane] = acc[i];
        __syncthreads();
        if (c.tid < 320) { const int i = c.tid >> 6, ln = c.tid & 63; float s = c.b_mod()[l * 6144 + col0 + ln];
#pragma unroll
            for (int w = 0; w < 8; ++w) s += red[(w * 5 + i) * 64 + ln];
            c.MOD()[(size_t)(l * 5 + i) * 6144 + col0 + ln] = s; }
        __syncthreads();
    }
}

__device__ __forceinline__ int cmap(int mode, int n) { return mode == 0 ? n : (mode == 1 ? (n < 1280 ? n : n + 16) : ((n & 255) < 128 ? 128 * (n >> 8) + (n & 127) : 512 + 128 * (n >> 8) + (n & 127))); }
__device__ __forceinline__ void transpose_item(const float* W, int ld, int K, int N, int mode, const float* rowscale, bf16* WT, float* scr, int item, int lane) {
    const int nblk = N / 32, kb = item / nblk, nb = item % nblk, k0 = 64 * kb, n0 = 32 * nb, sc0 = cmap(mode, n0);
    float tv[32];
#pragma unroll
    for (int i = 0; i < 32; ++i) tv[i] = W[(size_t)(k0 + 2 * i + (lane >> 5)) * ld + sc0 + (lane & 31)];
    if (rowscale) {
#pragma unroll
        for (int i = 0; i < 32; ++i) tv[i] *= rowscale[k0 + 2 * i + (lane >> 5)]; }
#pragma unroll
    for (int i = 0; i < 32; ++i) scr[(2 * i + (lane >> 5)) * 33 + (lane & 31)] = tv[i];
    __builtin_amdgcn_fence(__ATOMIC_RELEASE, "wavefront"); __builtin_amdgcn_wave_barrier();
    const int ch = lane & 7;
#pragma unroll
    for (int j = 0; j < 4; ++j) { const int n = (lane >> 3) + 8 * j; const float* s = scr + (8 * ch) * 33 + n;
        v4u o; o.x = pk2(s[0 * 33], s[1 * 33]); o.y = pk2(s[2 * 33], s[3 * 33]); o.z = pk2(s[4 * 33], s[5 * 33]); o.w = pk2(s[6 * 33], s[7 * 33]);
        *(v4u*)(WT + (size_t)(n0 + n) * K + k0 + 8 * ch) = o; }
    __builtin_amdgcn_fence(__ATOMIC_RELEASE, "wavefront"); __builtin_amdgcn_wave_barrier();
}
__device__ __forceinline__ void s5_tables(const Ctx& c, int l, int g, int part, float* lf);
__device__ __forceinline__ void convert_items(const Ctx& c, int l, int lo, int hi, int gw0, int ngw, bool tabs, int tb0, int ntb, float* lf) {
    unsigned char* ws = c.ws();
    if (tabs) {
        for (int t = tb0; t < 128; t += ntb) s5_tables(c, l, t & 31, t >> 5, lf);
        for (int i = tb0 * NTHR + c.tid; i < 16384; i += ntb * NTHR) { const int j = i >> 10, k = i & 1023; ((bf16*)(ws + WS_WDT))[i] = (bf16)f2bf(c.w_in()[(size_t)l * 1024 * 4112 + (size_t)k * 4112 + 1280 + j]); }
    }
    float* scr = lf + c.wave * 2176;
    for (int it = lo + gw0; it < hi; it += ngw) {
        int r = it;
        if (r < 2048) { transpose_item(c.w_in() + (size_t)l * 1024 * 4112, 4112, 1024, 4096, 1, nullptr, (bf16*)(ws + W_IN), scr, r, c.lane); continue; } r -= 2048;
        if (r < 2048) { transpose_item(c.w_gate() + (size_t)l * 1024 * 4096, 4096, 1024, 4096, 0, nullptr, (bf16*)(ws + W_G), scr, r, c.lane); continue; } r -= 2048;
        if (r < 256) { transpose_item(c.w_glu() + (size_t)l * 512 * 1024, 1024, 512, 1024, 2, nullptr, (bf16*)(ws + W_GLU), scr, r, c.lane); continue; } r -= 256;
        if (r < 1024) { const int i = r >> 8; transpose_item(c.w_branch() + (size_t)(l * 4 + i) * 512 * 1024, 1024, 512, 1024, 0, i == 0 ? c.ssd_norm_g() + l * 512 : nullptr, (bf16*)(ws + W_BR) + (size_t)i * 1024 * 512, scr, r & 255, c.lane); continue; } r -= 1024;
        if (r < 512) { transpose_item(c.w_out() + (size_t)l * 1024 * 1024, 1024, 1024, 1024, 0, nullptr, (bf16*)(ws + W_OUT), scr, r, c.lane); continue; } r -= 512;
        if (r < 2048) { transpose_item(c.w_fc1() + (size_t)l * 1024 * 4096, 4096, 1024, 4096, 0, nullptr, (bf16*)(ws + W_1), scr, r, c.lane); continue; } r -= 2048;
        transpose_item(c.w_fc2() + (size_t)l * 4096 * 1024, 1024, 4096, 1024, 0, nullptr, (bf16*)(ws + W_2), scr, r, c.lane);
    }
}
__device__ __forceinline__ void phase_convert(const Ctx& c, int l, float* lf) {
    if (gridDim.x == 256) convert_items(c, l, 0, 9984, blockIdx.x * NWAVES + c.wave, gridDim.x * NWAVES, true, blockIdx.x >= 192 ? (int)blockIdx.x - 192 : 100000, 64, lf);
    else convert_items(c, l, 0, 9984, blockIdx.x * NWAVES + c.wave, gridDim.x * NWAVES, true, blockIdx.x, gridDim.x, lf);
}
__device__ __forceinline__ void side_convert(const Ctx& c, int lo, int hi, bool tabs, float* lf) {
    if (blockIdx.x < 192 || gridDim.x != 256) return;
    convert_items(c, 1, lo, hi, (blockIdx.x - 192) * NWAVES + c.wave, 64 * NWAVES, tabs, blockIdx.x - 192, 64, lf);
}

__device__ __forceinline__ void phase_norm(const Ctx& c, int l, int which, float* lf) {
    const int gw = blockIdx.x * NWAVES + c.wave, NGW = gridDim.x * NWAVES;
    const float* gn = (which == 0 ? c.g_norm1() : c.g_norm2()) + l * 1024;
    for (int m = gw; m < M; m += NGW) {
        const float* xr = (l == 0 && which == 0) ? (m < MC ? c.x_prompt() + (size_t)m * D : c.x_sample() + (size_t)(m - MC) * D) : c.out() + (size_t)m * D;
        const int mi = (m < MC) ? 0 : 1 + ((m - MC) >> 10);
        const float* mod = c.MOD() + (size_t)(l * 5 + mi) * 6144 + which * 3072;
        f32x4 v[4]; float s = 0.f;
#pragma unroll
        for (int j = 0; j < 4; ++j) { v[j] = *(const f32x4*)(xr + 4 * c.lane + 256 * j); s += (v[j].x * v[j].x + v[j].y * v[j].y) + (v[j].z * v[j].z + v[j].w * v[j].w); }
        const float rstd = rsqrtf(wave_sum(s) * (1.0f / D) + EPS);
#pragma unroll
        for (int j = 0; j < 4; ++j) { const int k = 4 * c.lane + 256 * j; const f32x4 g = *(const f32x4*)(gn + k), sh = *(const f32x4*)(mod + k), sc = *(const f32x4*)(mod + 1024 + k);
            v[j] = v[j] * rstd * g * (sc + 1.0f) + sh;
            v2u o; o.x = pk2(v[j].x, v[j].y); o.y = pk2(v[j].z, v[j].w); *(v2u*)(c.H() + (size_t)m * D + k) = o; }
        if (which == 0) {
            if (c.lane == 0) { c.SSQ()[m] = 0.f; ((float*)(c.ws() + WS_SSQ2))[m] = 0.f; }
        }
    }
}

__device__ __forceinline__ void phase_bias2(const Ctx& c, int l) {
    const int gw = blockIdx.x * NWAVES + c.wave, NGW = gridDim.x * NWAVES, lane = c.lane;
    const bf16* W1t = (const bf16*)(c.ws() + W_1); float* bi = (float*)(c.ws() + WS_BI2);
    for (int n = gw; n < 4096; n += NGW) {
        float wf[16]; { float t8[8]; unpack8(*(const v4u*)(W1t + (size_t)n * 1024 + 8 * lane), t8);
#pragma unroll
            for (int j = 0; j < 8; ++j) wf[j] = t8[j];
            unpack8(*(const v4u*)(W1t + (size_t)n * 1024 + 512 + 8 * lane), t8);
#pragma unroll
            for (int j = 0; j < 8; ++j) wf[8 + j] = t8[j]; }
#pragma unroll 1
        for (int mi = 0; mi < 5; ++mi) { const float* sh = c.MOD() + (size_t)(l * 5 + mi) * 6144 + 3072; float a = 0.f;
#pragma unroll
            for (int hh = 0; hh < 2; ++hh) { const f32x4 s0 = *(const f32x4*)(sh + 512 * hh + 8 * lane), s1 = *(const f32x4*)(sh + 512 * hh + 8 * lane + 4);
                a += (wf[8 * hh + 0] * s0.x + wf[8 * hh + 1] * s0.y) + (wf[8 * hh + 2] * s0.z + wf[8 * hh + 3] * s0.w) + (wf[8 * hh + 4] * s1.x + wf[8 * hh + 5] * s1.y) + (wf[8 * hh + 6] * s1.z + wf[8 * hh + 7] * s1.w); }
            a = wave_sum(a); if (lane == 0) bi[mi * 4096 + n] = a; }
    }
}

__device__ __forceinline__ void phase_dt(const Ctx& c, int l) {
    if (c.wave >= 3) return;
    const int tile = blockIdx.x * 3 + c.wave; if (tile >= 768) return;
    const int lr = c.lane & 15, lq = c.lane >> 4;
    const bf16* ap = c.H() + (size_t)(16 * tile + lr) * 1024 + 8 * lq; const bf16* bp = (const bf16*)(c.ws() + WS_WDT) + (size_t)lr * 1024 + 8 * lq;
    f32x4 acc = {0.f, 0.f, 0.f, 0.f};
#pragma unroll 8
    for (int ks = 0; ks < 32; ++ks) acc = __builtin_amdgcn_mfma_f32_16x16x32_bf16(*(const pg8::bf16x8*)(ap + 32 * ks), *(const pg8::bf16x8*)(bp + 32 * ks), acc, 0, 0, 0);
    const float bias = c.dt_bias()[l * 16 + lr];
#pragma unroll
    for (int r = 0; r < 4; ++r) { const float x = acc[r] + bias; c.DT()[(size_t)(16 * tile + 4 * lq + r) * 16 + lr] = x > 20.f ? x : log1pf(__expf(x)); }
}

__device__ __forceinline__ void phase_rope_table(const Ctx& c) {
    const int gt = blockIdx.x * NTHR + c.tid;
    if (gt < 32768) { const int pos = gt >> 5, a = gt & 31, f = a & 15; const float inv = exp2f(-(float)f * 0.8304820237218406f);
        const float ang = (float)((a >> 4) ? (pos & 63) : (pos >> 6)) * inv; float sn, cs; sincosf(ang, &sn, &cs); c.ROPE()[pos * 64 + a] = cs; c.ROPE()[pos * 64 + 32 + a] = sn; }
}
__device__ __forceinline__ void phase_ckv(const Ctx& c) {
    const int gw = blockIdx.x * NWAVES + c.wave, NGW = gridDim.x * NWAVES, lane = c.lane;
    for (int r = gw; r < 2048; r += NGW) { const int l = r >> 10, b = (r >> 8) & 3, sidx = r & 255; const size_t cb = (size_t)(b * 2 + l) * 256 + sidx; bf16* dst = c.CKV() + (size_t)r * 1280;
#pragma unroll
        for (int i = 0; i < 5; ++i) { const int e = 4 * (lane + 64 * i);
            const float* src = e < 512 ? c.cache_dk() + cb * 512 + e : e < 1024 ? c.cache_dv() + cb * 512 + (e - 512) : e < 1152 ? c.cache_wk() + cb * 128 + (e - 1024) : c.cache_wv() + cb * 128 + (e - 1152);
            const f32x4 v = *(const f32x4*)src; v2u o; o.x = pk2(v.x, v.y); o.y = pk2(v.z, v.w); *(v2u*)(dst + e) = o; } }
}
__device__ __forceinline__ void phase_qk(const Ctx& c, int l, float* lf) {
    const int gw = blockIdx.x * NWAVES + c.wave, NGW = gridDim.x * NWAVES, lane = c.lane, l16 = lane & 15, grp = lane >> 4;
    for (int i = c.tid; i < 7 * 768; i += NTHR) lf[i] = c.conv_w()[(size_t)l * 7 * 768 + i];
    for (int i = c.tid; i < 768; i += NTHR) lf[7 * 768 + i] = c.conv_b()[l * 768 + i];
    __syncthreads();
    const f32x4 gq = *(const f32x4*)(c.qn_g() + l * 64 + 4 * l16), gk = *(const f32x4*)(c.kn_g() + l * 64 + 4 * l16), gwq = *(const f32x4*)(c.wqn_g() + l * 64 + 4 * l16), gwk = *(const f32x4*)(c.wkn_g() + l * 64 + 4 * l16);
    bf16* R1p = c.R1(); float* outp = c.out(); bf16* XCp = c.XC();
    for (int m = gw; m < M; m += NGW) {
        bf16* pr = R1p + (size_t)m * 4096;
        const bool lat = m >= MC;
        const int b = lat ? (m - MC) >> 10 : m >> 8, t = lat ? (m - MC) & 1023 : m & 255, L = lat ? 1024 : 256;
        const size_t ob = (size_t)(b * 2 + l) * 256 + t;
        f32x4 cs = {1.f, 1.f, 1.f, 1.f}, sn = {0.f, 0.f, 0.f, 0.f};
        if (lat) { const float* rp = c.ROPE() + t * 64 + (l16 >> 3) * 16 + 4 * (l16 & 3); cs = *(const f32x4*)rp; sn = *(const f32x4*)(rp + 32); if (!((l16 >> 2) & 1)) sn = -sn; }
        v2u raw[7];
#pragma unroll
        for (int ps = 0; ps < 7; ++ps) { const int gi = 4 * ps + grp; const int col = gi < 8 ? C_DQ + gi * 64 : gi < 16 ? C_DK + (gi - 8) * 64 : gi < 24 ? C_WQ + (gi - 16) * 64 : C_WK + (gi - 24) * 64;
            raw[ps] = (gi < 26) ? *(const v2u*)(pr + col + 4 * l16) : (v2u){0u, 0u}; }
        v2u cp[3];
        if (!lat) {
#pragma unroll
            for (int ps = 0; ps < 3; ++ps) { const int gi = 4 * ps + grp; const int col = gi < 8 ? C_DV + gi * 64 : C_WV + (gi - 8) * 64; cp[ps] = (gi < 10) ? *(const v2u*)(pr + col + 4 * l16) : (v2u){0u, 0u}; }
        }
        v2u cx[3][7];
#pragma unroll
        for (int i = 0; i < 3; ++i)
#pragma unroll
            for (int j = 0; j < 7; ++j) { const int tt = t + j - 3; cx[i][j] = (tt >= 0 && tt < L) ? *(const v2u*)(R1p + (size_t)(m + j - 3) * 4096 + C_XBC + 4 * lane + 256 * i) : (v2u){0u, 0u}; }
#pragma unroll
        for (int ps = 0; ps < 7; ++ps) { const int gi = 4 * ps + grp;
            const f32x4 gain = gi < 8 ? gq : gi < 16 ? gk : gi < 24 ? gwq : gwk;
            f32x4 v = {bflo(raw[ps].x), bfhi(raw[ps].x), bflo(raw[ps].y), bfhi(raw[ps].y)};
            float ss = (v.x * v.x + v.y * v.y) + (v.z * v.z + v.w * v.w);
            ss += __shfl_xor(ss, 1); ss += __shfl_xor(ss, 2); ss += __shfl_xor(ss, 4); ss += __shfl_xor(ss, 8);
            v = v * rsqrtf(ss * (1.0f / 64.0f) + EPS) * gain;
            if (lat) { f32x4 p; p.x = __shfl_xor(v.x, 4); p.y = __shfl_xor(v.y, 4); p.z = __shfl_xor(v.z, 4); p.w = __shfl_xor(v.w, 4); v = v * cs + p * sn; }
            if (gi < 26) {
                const int col = gi < 8 ? C_DQ + gi * 64 : gi < 16 ? C_DK + (gi - 8) * 64 : gi < 24 ? C_WQ + (gi - 16) * 64 : C_WK + (gi - 24) * 64;
                v2u o; o.x = pk2(v.x, v.y); o.y = pk2(v.z, v.w); *(v2u*)(pr + col + 4 * l16) = o;
                if (!lat) { if (gi >= 8 && gi < 16) *(f32x4*)(outp + O_DK + ob * 512 + (gi - 8) * 64 + 4 * l16) = v; if (gi >= 24) *(f32x4*)(outp + O_WK + ob * 128 + (gi - 24) * 64 + 4 * l16) = v; }
            }
        }
        if (!lat) {
#pragma unroll
            for (int ps = 0; ps < 3; ++ps) { const int gi = 4 * ps + grp; const f32x4 v = {bflo(cp[ps].x), bfhi(cp[ps].x), bflo(cp[ps].y), bfhi(cp[ps].y)};
                if (gi < 8) *(f32x4*)(outp + O_DV + ob * 512 + gi * 64 + 4 * l16) = v; else if (gi < 10) *(f32x4*)(outp + O_WV + ob * 128 + (gi - 8) * 64 + 4 * l16) = v; }
        }
#pragma unroll
        for (int i = 0; i < 3; ++i) { const int ch = 4 * lane + 256 * i; f32x4 a = *(const f32x4*)(lf + 7 * 768 + ch);
#pragma unroll
            for (int j = 0; j < 7; ++j) { const f32x4 wv = *(const f32x4*)(lf + j * 768 + ch); const f32x4 xv = {bflo(cx[i][j].x), bfhi(cx[i][j].x), bflo(cx[i][j].y), bfhi(cx[i][j].y)}; a += wv * xv; }
            v2u o; o.x = pk2(siluf(a.x), siluf(a.y)); o.y = pk2(siluf(a.z), siluf(a.w)); *(v2u*)(XCp + (size_t)m * 768 + ch) = o; }
    }
}

typedef pg8::bf16x8 bx8;
#define LDS_BARRIER() do { asm volatile("s_waitcnt lgkmcnt(0)" ::: "memory"); __builtin_amdgcn_s_barrier(); asm volatile("" ::: "memory"); } while (0)
#define MFMA16(a, b, cc) __builtin_amdgcn_mfma_f32_16x16x32_bf16((a), (b), (cc), 0, 0, 0)
__device__ __forceinline__ void ssd_unit(const Ctx& c, int l, int pass, int b, int h, unsigned char* lds) {
    const int L = pass ? 1024 : 256, tok0 = pass ? MC + b * 1024 : b * 256, NCH = L >> 7;
    const int tid = c.tid, lane = c.lane, w = c.wave, lr = lane & 15, lq = lane >> 4, grp = h >> 2;
    bf16* XT = (bf16*)lds;
    bf16* BwT = XT + 64 * 136;
    bf16* Bm = BwT + 64 * 136;
    bf16* Cm = Bm + 128 * 72;
    bf16* Mm = Cm + 128 * 72;
    bf16* ST = Mm + 128 * 136;
    float* cum = (float*)(ST + 64 * 72);
    float* dtv = cum + 128; float* wv = dtv + 128; float* ecum = wv + 128; float* tot = ecum + 128;
    const float dsk = c.ssd_d()[l * 8 + h];
    const bf16* XCp = c.XC(); const float* DTp = c.DT(); bf16* Yp = c.Y(); const bf16* R1p = c.R1(); float* SSQp = c.SSQ();
    const int pi = w >> 1, nj0 = 2 * (w & 1);
    const int i = tid >> 2, part = tid & 3;
    for (int dir = 0; dir < 2; ++dir) {
        const float A = -__expf(c.a_log()[(l * 2 + dir) * 8 + h]);
        f32x4 Sacc[2];
        __syncthreads();
#pragma unroll
        for (int q = 0; q < 2; ++q)
#pragma unroll
            for (int r = 0; r < 4; ++r) { const int p = 16 * pi + 4 * lq + r, n = 16 * (nj0 + q) + lr;
                const float v = pass ? c.state_ssd()[(((((size_t)(b * 2 + l) * 2 + dir) * 8 + h) * 64 + p) * 64) + n] : 0.f;
                Sacc[q][r] = v; ST[p * 72 + n] = (bf16)f2bf(v); }
        v4u x0, x1, b0, b1, c0, c1; float d0 = 0.f, d1 = 0.f;
#define SSD_LOAD(ci_) { const int t_ = dir ? L - 1 - ((ci_) * 128 + i) : (ci_) * 128 + i; const bf16* xr_ = XCp + (size_t)(tok0 + t_) * 768; \
            x0 = *(const v4u*)(xr_ + h * 64 + part * 16); x1 = *(const v4u*)(xr_ + h * 64 + part * 16 + 8); \
            b0 = *(const v4u*)(xr_ + 512 + grp * 64 + part * 16); b1 = *(const v4u*)(xr_ + 512 + grp * 64 + part * 16 + 8); \
            c0 = *(const v4u*)(xr_ + 640 + grp * 64 + part * 16); c1 = *(const v4u*)(xr_ + 640 + grp * 64 + part * 16 + 8); \
            if (tid < 64) { const int i0_ = 2 * lane, ta_ = dir ? L - 1 - ((ci_) * 128 + i0_) : (ci_) * 128 + i0_, tb_ = dir ? ta_ - 1 : ta_ + 1; \
                d0 = DTp[(size_t)(tok0 + ta_) * 16 + dir * 8 + h]; d1 = DTp[(size_t)(tok0 + tb_) * 16 + dir * 8 + h]; } }
        SSD_LOAD(0);
        for (int ci = 0; ci < NCH; ++ci) {
            LDS_BARRIER();
            float bvals[16];
            { *(v4u*)(Bm + i * 72 + part * 16) = b0; *(v4u*)(Bm + i * 72 + part * 16 + 8) = b1;
              *(v4u*)(Cm + i * 72 + part * 16) = c0; *(v4u*)(Cm + i * 72 + part * 16 + 8) = c1;
              const unsigned xs[8] = {x0.x, x0.y, x0.z, x0.w, x1.x, x1.y, x1.z, x1.w};
#pragma unroll
              for (int j = 0; j < 8; ++j) { XT[(part * 16 + 2 * j) * 136 + i] = (bf16)(xs[j] & 0xffffu); XT[(part * 16 + 2 * j + 1) * 136 + i] = (bf16)(xs[j] >> 16); }
              float t8[8]; unpack8(b0, t8);
#pragma unroll
              for (int j = 0; j < 8; ++j) bvals[j] = t8[j];
              unpack8(b1, t8);
#pragma unroll
              for (int j = 0; j < 8; ++j) bvals[8 + j] = t8[j]; }
            if (tid < 64) {
                const int i0 = 2 * lane, i1 = i0 + 1;
                const float a0 = d0 * A, a1 = d1 * A; float s = a0 + a1;
#pragma unroll
                for (int o = 1; o < 64; o <<= 1) { const float v = __shfl_up(s, o); if (lane >= o) s += v; }
                const float cum1 = s, cum0 = s - a1, total = __shfl(s, 63);
                cum[i0] = cum0; cum[i1] = cum1; dtv[i0] = d0; dtv[i1] = d1;
                wv[i0] = __expf(total - cum0) * d0; wv[i1] = __expf(total - cum1) * d1; ecum[i0] = __expf(cum0); ecum[i1] = __expf(cum1);
                if (lane == 0) tot[0] = __expf(total);
            }
            if (ci + 1 < NCH) SSD_LOAD(ci + 1);
            unsigned short zz[16], yy[16];
            if (dir == 1) {
#pragma unroll
                for (int r = 0; r < 4; ++r) { const int tt = 16 * w + 4 * lq + r; const size_t m = (size_t)tok0 + (L - 1 - (ci * 128 + tt));
#pragma unroll
                    for (int jp = 0; jp < 4; ++jp) { zz[4 * r + jp] = R1p[m * 4096 + C_Z + h * 64 + 16 * jp + lr]; yy[4 * r + jp] = Yp[m * 2048 + h * 64 + 16 * jp + lr]; } }
            }
            LDS_BARRIER();
            { const float wi = wv[i];
#pragma unroll
              for (int j = 0; j < 16; ++j) BwT[(part * 16 + j) * 136 + i] = (bf16)f2bf(bvals[j] * wi); }
            bx8 cfr[2];
#pragma unroll
            for (int ks = 0; ks < 2; ++ks) cfr[ks] = *(const bx8*)(Cm + (16 * w + lr) * 72 + 32 * ks + 8 * lq);
            for (int j = 0; j <= w; ++j) {
                const bx8 bb0 = *(const bx8*)(Bm + (16 * j + lr) * 72 + 8 * lq), bb1 = *(const bx8*)(Bm + (16 * j + lr) * 72 + 32 + 8 * lq);
                f32x4 g = {0.f, 0.f, 0.f, 0.f};
                g = MFMA16(cfr[0], bb0, g); g = MFMA16(cfr[1], bb1, g);
                const int s = 16 * j + lr; const float cs = cum[s], ds = dtv[s];
#pragma unroll
                for (int r = 0; r < 4; ++r) { const int tt = 16 * w + 4 * lq + r; const float v = (s <= tt) ? g[r] * __expf(cum[tt] - cs) * ds : 0.f; Mm[tt * 136 + s] = (bf16)f2bf(v); }
            }
            if (!(w & 1)) {
#pragma unroll
                for (int r = 0; r < 4; ++r) Mm[(16 * w + 4 * lq + r) * 136 + 16 * (w + 1) + lr] = 0;
            }
            LDS_BARRIER();
            f32x4 yl[4], yo[4];
#pragma unroll
            for (int jp = 0; jp < 4; ++jp) { yl[jp] = (f32x4){0.f, 0.f, 0.f, 0.f}; yo[jp] = (f32x4){0.f, 0.f, 0.f, 0.f}; }
            for (int ks = 0; ks <= (w >> 1); ++ks) {
                const bx8 af = *(const bx8*)(Mm + (16 * w + lr) * 136 + 32 * ks + 8 * lq);
#pragma unroll
                for (int jp = 0; jp < 4; ++jp) { const bx8 xf = *(const bx8*)(XT + (16 * jp + lr) * 136 + 32 * ks + 8 * lq); yl[jp] = MFMA16(af, xf, yl[jp]); }
            }
#pragma unroll
            for (int ks = 0; ks < 2; ++ks)
#pragma unroll
                for (int jp = 0; jp < 4; ++jp) { const bx8 sf = *(const bx8*)(ST + (16 * jp + lr) * 72 + 32 * ks + 8 * lq); yo[jp] = MFMA16(cfr[ks], sf, yo[jp]); }
            {
#pragma unroll
                for (int r = 0; r < 4; ++r) {
                    const int tt = 16 * w + 4 * lq + r; const float ec = ecum[tt];
                    const int t = dir ? L - 1 - (ci * 128 + tt) : ci * 128 + tt; const size_t m = (size_t)tok0 + t;
                    float q = 0.f;
#pragma unroll
                    for (int jp = 0; jp < 4; ++jp) {
                        const int p = 16 * jp + lr; const float y = yl[jp][r] + ec * yo[jp][r];
                        if (dir == 0) Yp[m * 2048 + h * 64 + p] = (bf16)f2bf(y);
                        else { const float x = bf2f(XT[p * 136 + tt]); const float ytot = y + bf2f(yy[4 * r + jp]) + dsk * x; const float z = bf2f(zz[4 * r + jp]);
                            const float gt = ytot * siluf(z); Yp[m * 2048 + h * 64 + p] = (bf16)f2bf(gt); q += gt * gt; }
                    }
                    if (dir == 1) { q += __shfl_xor(q, 1); q += __shfl_xor(q, 2); q += __shfl_xor(q, 4); q += __shfl_xor(q, 8); if (lr == 0) atomicAdd(SSQp + m, q); }
                }
            }
            LDS_BARRIER();
            {
                f32x4 st[2] = {{0.f, 0.f, 0.f, 0.f}, {0.f, 0.f, 0.f, 0.f}};
#pragma unroll
                for (int ks = 0; ks < 4; ++ks) { const bx8 af = *(const bx8*)(XT + (16 * pi + lr) * 136 + 32 * ks + 8 * lq);
#pragma unroll
                    for (int q = 0; q < 2; ++q) { const bx8 bf = *(const bx8*)(BwT + (16 * (nj0 + q) + lr) * 136 + 32 * ks + 8 * lq); st[q] = MFMA16(af, bf, st[q]); } }
                const float et = tot[0];
#pragma unroll
                for (int q = 0; q < 2; ++q)
#pragma unroll
                    for (int r = 0; r < 4; ++r) { Sacc[q][r] = et * Sacc[q][r] + st[q][r]; ST[(16 * pi + 4 * lq + r) * 72 + 16 * (nj0 + q) + lr] = (bf16)f2bf(Sacc[q][r]); }
            }
        }
#undef SSD_LOAD
        if (!pass) {
#pragma unroll
            for (int q = 0; q < 2; ++q)
#pragma unroll
                for (int r = 0; r < 4; ++r) { const int p = 16 * pi + 4 * lq + r, n = 16 * (nj0 + q) + lr;
                    c.out()[O_SSD + (((((size_t)(b * 2 + l) * 2 + dir) * 8 + h) * 64 + p) * 64) + n] = Sacc[q][r]; }
        }
    }
}

__device__ __forceinline__ void s5_tables(const Ctx& c, int l, int g, int part, float* lf) {
    const int tid = c.tid;
    float* pw = lf;
    float* Bc = pw + 2 * 17 * 128;
    float* Cc = Bc + 2 * 2048;
    if (tid < 128) { const int dir = tid >> 6, n = tid & 63, idx = ((l * 2 + dir) * 32 + g) * 64 + n;
        const float lre = c.lam_re()[idx], lim = c.lam_im()[idx], step = expf(c.log_step()[(l * 2 + dir) * 32 + g]);
        for (int k = 0; k <= 16; ++k) { const float mag = expf(lre * step * (float)k); float sn, cs; sincosf(lim * step * (float)k, &sn, &cs); pw[((dir * 17 + k) * 64 + n) * 2] = mag * cs; pw[((dir * 17 + k) * 64 + n) * 2 + 1] = mag * sn; }
        const float mag = expf(lre * step); float sn, cs; sincosf(lim * step, &sn, &cs); const float are = mag * cs, aim = mag * sn;
        const float den = lre * lre + lim * lim, cre = ((are - 1.0f) * lre + aim * lim) / den, cim = (aim * lre - (are - 1.0f) * lim) / den;
        for (int mm = 0; mm < 16; ++mm) { const float br = c.b_re()[(size_t)idx * 16 + mm], bi = c.b_im()[(size_t)idx * 16 + mm]; Bc[((dir * 64 + n) * 16 + mm) * 2] = cre * br - cim * bi; Bc[((dir * 64 + n) * 16 + mm) * 2 + 1] = cre * bi + cim * br; }
    }
    for (int i = tid; i < 2048; i += NTHR) { const int dir = i >> 10, mm = (i >> 6) & 15, n = i & 63; const size_t src = ((size_t)((l * 2 + dir) * 32 + g) * 16 + mm) * 64 + n;
        Cc[i * 2] = c.c_re()[src]; Cc[i * 2 + 1] = c.c_im()[src]; }
    __syncthreads();
    if (part == 0 && tid < 128) { const int dir = tid >> 6, n = tid & 63; float* at = (float*)(c.ws() + WS_S5AT) + ((size_t)(dir * 32 + g) * 64 + n) * 2; at[0] = pw[((dir * 17 + 16) * 64 + n) * 2]; at[1] = pw[((dir * 17 + 16) * 64 + n) * 2 + 1]; }
    bf16* Kt = (bf16*)(c.ws() + WS_S5K) + (size_t)g * 31 * 256;
    for (int e = part * 1984 + tid; e < (part + 1) * 1984; e += NTHR) { const int tp = e >> 8, mm = (e >> 4) & 15, m2 = e & 15, tau = tp - 15; float acc = 0.f;
#pragma unroll
        for (int dir = 0; dir < 2; ++dir) { if ((dir == 0 && tau < 0) || (dir == 1 && tau > 0)) continue; const int k = tau < 0 ? -tau : tau;
            const float* pp = pw + (dir * 17 + k) * 128; const float* bb = Bc + dir * 2048 + m2 * 2; const float* cc = Cc + (dir * 16 + mm) * 128;
            for (int n = 0; n < 64; ++n) { const float pr = pp[2 * n], pi = pp[2 * n + 1], br = bb[n * 32], bi = bb[n * 32 + 1], Pr = pr * br - pi * bi, Pi = pr * bi + pi * br; acc += cc[2 * n] * Pr - cc[2 * n + 1] * Pi; } }
        if (tau == 0 && mm == m2) acc += c.s5_d()[l * 512 + g * 16 + mm];
        Kt[e] = (bf16)f2bf(acc); }
    for (int e = part * 16384 + tid; e < (part + 1) * 16384; e += NTHR) { const int dir = e >> 15, sidx = (e >> 8) & 127, k = e & 255, ri = sidx >> 6, n = sidx & 63, j = k >> 4, m2 = k & 15, ex = dir ? j : 15 - j;
        const float pr = pw[((dir * 17 + ex) * 64 + n) * 2], pi = pw[((dir * 17 + ex) * 64 + n) * 2 + 1], br = Bc[((dir * 64 + n) * 16 + m2) * 2], bi = Bc[((dir * 64 + n) * 16 + m2) * 2 + 1];
        ((bf16*)(c.ws() + WS_S5WS))[((size_t)(dir * 32 + g) * 128 + sidx) * 256 + k] = (bf16)f2bf(ri ? pr * bi + pi * br : pr * br - pi * bi); }
    for (int e = part * 16384 + tid; e < (part + 1) * 16384; e += NTHR) { const int row = e >> 8, k = e & 255, i = row >> 4, mm = row & 15, dir = k >> 7, ri = (k >> 6) & 1, n = k & 63, ex = dir ? 16 - i : i + 1;
        const float pr = pw[((dir * 17 + ex) * 64 + n) * 2], pi = pw[((dir * 17 + ex) * 64 + n) * 2 + 1], cr = Cc[((dir * 16 + mm) * 64 + n) * 2], ci = Cc[((dir * 16 + mm) * 64 + n) * 2 + 1];
        ((bf16*)(c.ws() + WS_S5WO))[(size_t)g * 65536 + e] = (bf16)f2bf(ri ? -(cr * pi + ci * pr) : cr * pr - ci * pi); }
    __syncthreads();
}

__device__ __forceinline__ void s5_unit(const Ctx& c, int l, int g, int cu, unsigned char* lds) {
    const int tid = c.tid, lane = c.lane, w = c.wave, lr = lane & 15, lq = lane >> 4;
    const bool lat = cu >= 8;
    bf16* Ut = (bf16*)lds;
    bf16* St = Ut + 64 * 264;
    bf16* Kt = St + 64 * 264;
    float* Dl = (float*)(Kt + 31 * 256);
    const bf16* R1p = c.R1();
    const bf16* Wsp0 = (const bf16*)(c.ws() + WS_S5WS) + ((size_t)(0 * 32 + g) * 128 + 16 * w + lr) * 256 + 8 * lq;
    const bf16* Wsp1 = (const bf16*)(c.ws() + WS_S5WS) + ((size_t)(1 * 32 + g) * 128 + 16 * w + lr) * 256 + 8 * lq;
    const bf16* Wop = (const bf16*)(c.ws() + WS_S5WO) + (size_t)g * 65536 + 8 * lq;
    bx8 afA[8], afB[8];
#pragma unroll
    for (int ks = 0; ks < 8; ++ks) afA[ks] = *(const bx8*)(Wsp0 + 32 * ks);
    { const v4u* src = (const v4u*)((const bf16*)(c.ws() + WS_S5K) + (size_t)g * 31 * 256); for (int i = tid; i < 31 * 32; i += NTHR) ((v4u*)Kt)[i] = src[i]; }
#pragma unroll
    for (int i = 0; i < 2; ++i) { const int id = tid + NTHR * i, col = id >> 4, j = id & 15;
        const int tok = lat ? MC + (cu - 8) * 1024 + col * 16 + j : (4 * cu + (col >> 4)) * 256 + (col & 15) * 16 + j;
        const bf16* up = R1p + (size_t)tok * 4096 + C_U + g * 16;
        *(v4u*)(Ut + col * 264 + j * 16) = *(const v4u*)up; *(v4u*)(Ut + col * 264 + j * 16 + 8) = *(const v4u*)(up + 8); }
#pragma unroll
    for (int ks = 0; ks < 8; ++ks) afB[ks] = *(const bx8*)(Wsp1 + 32 * ks);
    LDS_BARRIER();
#pragma unroll
    for (int dir = 0; dir < 2; ++dir) {
        f32x4 acc[4];
#pragma unroll
        for (int cb = 0; cb < 4; ++cb) acc[cb] = (f32x4){0.f, 0.f, 0.f, 0.f};
#pragma unroll
        for (int ks = 0; ks < 8; ++ks) {
#pragma unroll
            for (int cb = 0; cb < 4; ++cb) { const bx8 bf = *(const bx8*)(Ut + (16 * cb + lr) * 264 + 32 * ks + 8 * lq); acc[cb] = MFMA16(dir ? afB[ks] : afA[ks], bf, acc[cb]); }
            __builtin_amdgcn_sched_barrier(0); }
        if (dir == 0) {
#pragma unroll
            for (int ks = 0; ks < 8; ++ks) afA[ks] = *(const bx8*)(Wop + (size_t)(16 * (2 * w) + lr) * 256 + 32 * ks); }
        else {
#pragma unroll
            for (int ks = 0; ks < 8; ++ks) afB[ks] = *(const bx8*)(Wop + (size_t)(16 * (2 * w + 1) + lr) * 256 + 32 * ks); }
#pragma unroll
        for (int cb = 0; cb < 4; ++cb)
#pragma unroll
            for (int r = 0; r < 4; ++r) Dl[(16 * w + 4 * lq + r) * 65 + 16 * cb + lr] = acc[cb][r];
        LDS_BARRIER();
        if (tid < (lat ? 64 : 256)) {
            const int n = tid & 63, bl = tid >> 6, nc = lat ? 64 : 16, cbase = lat ? 0 : 16 * bl, b = lat ? cu - 8 : 4 * cu + bl;
            const float* at = (const float*)(c.ws() + WS_S5AT) + ((size_t)(dir * 32 + g) * 64 + n) * 2; const float ar = at[0], ai = at[1];
            float sr = 0.f, si = 0.f;
            if (lat) { sr = c.state_s5()[((((size_t)(b * 2 + l) * 2 + dir) * 2 + 0) * 32 + g) * 64 + n]; si = c.state_s5()[((((size_t)(b * 2 + l) * 2 + dir) * 2 + 1) * 32 + g) * 64 + n]; }
            for (int cc = 0; cc < nc; ++cc) { const int col = cbase + (dir ? nc - 1 - cc : cc);
                St[col * 264 + dir * 128 + n] = (bf16)f2bf(sr); St[col * 264 + dir * 128 + 64 + n] = (bf16)f2bf(si);
                const float dr = Dl[n * 65 + col], di = Dl[(64 + n) * 65 + col];
                const float nr = ar * sr - ai * si + dr, ni = ar * si + ai * sr + di; sr = nr; si = ni; }
            if (!lat) { c.out()[O_S5 + ((((size_t)(b * 2 + l) * 2 + dir) * 2 + 0) * 32 + g) * 64 + n] = sr; c.out()[O_S5 + ((((size_t)(b * 2 + l) * 2 + dir) * 2 + 1) * 32 + g) * 64 + n] = si; }
        }
        LDS_BARRIER();
    }
#pragma unroll
    for (int ii = 0; ii < 2; ++ii) { const int i = 2 * w + ii;
        f32x4 acc[4];
#pragma unroll
        for (int cb = 0; cb < 4; ++cb) acc[cb] = (f32x4){0.f, 0.f, 0.f, 0.f};
#pragma unroll
        for (int ks = 0; ks < 8; ++ks) { const int j = 2 * ks + (lq >> 1); const bx8 af = *(const bx8*)(Kt + ((i - j + 15) * 16 + lr) * 16 + 8 * (lq & 1));
#pragma unroll
            for (int cb = 0; cb < 4; ++cb) { const bx8 bf = *(const bx8*)(Ut + (16 * cb + lr) * 264 + 32 * ks + 8 * lq); acc[cb] = MFMA16(af, bf, acc[cb]); }
            __builtin_amdgcn_sched_barrier(0); }
#pragma unroll
        for (int ks = 0; ks < 8; ++ks) {
#pragma unroll
            for (int cb = 0; cb < 4; ++cb) { const bx8 bf = *(const bx8*)(St + (16 * cb + lr) * 264 + 32 * ks + 8 * lq); acc[cb] = MFMA16(ii ? afB[ks] : afA[ks], bf, acc[cb]); }
            __builtin_amdgcn_sched_barrier(0); }
#pragma unroll
        for (int cb = 0; cb < 4; ++cb) { const int col = 16 * cb + lr;
            const int tok = lat ? MC + (cu - 8) * 1024 + col * 16 + i : (4 * cu + (col >> 4)) * 256 + (col & 15) * 16 + i;
            v2u o; o.x = pk2(acc[cb][0], acc[cb][1]); o.y = pk2(acc[cb][2], acc[cb][3]);
            *(v2u*)(c.Y5() + (size_t)tok * 512 + g * 16 + 4 * lq) = o; }
    }
}

typedef float f32x16 __attribute__((ext_vector_type(16)));
#define MFMA32(a, b, cc) __builtin_amdgcn_mfma_f32_32x32x16_bf16((a), (b), (cc), 0, 0, 0)
constexpr float SM_SC = 0.125f * 1.4426950408889634f;
__device__ __forceinline__ void qk_tile(f32x16& p0, f32x16& p1, const bf16* Kt, int KS, const bx8 (&qf)[4], int r32, int hi) {
    p0 = (f32x16){0.f}; p1 = (f32x16){0.f};
    bx8 a0[4], a1[4];
#pragma unroll
    for (int d0 = 0; d0 < 4; ++d0) { a0[d0] = *(const bx8*)(Kt + r32 * KS + 16 * d0 + 8 * hi); a1[d0] = *(const bx8*)(Kt + (32 + r32) * KS + 16 * d0 + 8 * hi); }
    __builtin_amdgcn_s_setprio(1);
#pragma unroll
    for (int d0 = 0; d0 < 4; ++d0) { p0 = MFMA32(a0[d0], qf[d0], p0); p1 = MFMA32(a1[d0], qf[d0], p1); }
    __builtin_amdgcn_s_setprio(0);
}
__device__ __forceinline__ float fmax_(float a, float b) { float r; asm("v_max_f32_e32 %0, %1, %2" : "=v"(r) : "v"(a), "v"(b)); return r; }
__device__ __forceinline__ float sm_step(f32x16& p0, f32x16& p1, float& mrun, float& lrun, bx8 (&pb)[4]) {
    float ta = fmax_(p0[0], p1[0]), tb = fmax_(p0[1], p1[1]);
#pragma unroll
    for (int r = 2; r < 16; r += 2) { ta = fmax_(ta, fmax_(p0[r], p1[r])); tb = fmax_(tb, fmax_(p0[r + 1], p1[r + 1])); }
    float tm = fmax_(ta, tb) * SM_SC;
    tm = fmax_(tm, __shfl_xor(tm, 32));
    const float mn = fmax_(mrun, tm), alpha = __builtin_amdgcn_exp2f(mrun - mn);
    float rs0 = 0.f, rs1 = 0.f;
#pragma unroll
    for (int r = 0; r < 16; ++r) { p0[r] = __builtin_amdgcn_exp2f(fmaf(p0[r], SM_SC, -mn)); p1[r] = __builtin_amdgcn_exp2f(fmaf(p1[r], SM_SC, -mn)); rs0 += p0[r]; rs1 += p1[r]; }
    float rs = rs0 + rs1;
    rs += __shfl_xor(rs, 32);
    lrun = lrun * alpha + rs; mrun = mn;
#pragma unroll
    for (int sI = 0; sI < 2; ++sI) {
        v4u t0, t1;
        t0.x = pg8::cvt_pk_bf16(p0[8 * sI + 0], p0[8 * sI + 1]); t0.y = pg8::cvt_pk_bf16(p0[8 * sI + 2], p0[8 * sI + 3]); t0.z = pg8::cvt_pk_bf16(p0[8 * sI + 4], p0[8 * sI + 5]); t0.w = pg8::cvt_pk_bf16(p0[8 * sI + 6], p0[8 * sI + 7]);
        t1.x = pg8::cvt_pk_bf16(p1[8 * sI + 0], p1[8 * sI + 1]); t1.y = pg8::cvt_pk_bf16(p1[8 * sI + 2], p1[8 * sI + 3]); t1.z = pg8::cvt_pk_bf16(p1[8 * sI + 4], p1[8 * sI + 5]); t1.w = pg8::cvt_pk_bf16(p1[8 * sI + 6], p1[8 * sI + 7]);
        pb[sI] = __builtin_bit_cast(bx8, t0); pb[2 + sI] = __builtin_bit_cast(bx8, t1);
    }
    return alpha;
}
typedef short v4i16_t __attribute__((ext_vector_type(4)));
__device__ __forceinline__ v2u vtr(const bf16* p) { return __builtin_bit_cast(v2u, __builtin_amdgcn_ds_read_tr16_b64_v4i16((__attribute__((address_space(3))) v4i16_t*)p)); }
template <int NDT, int VS> __device__ __forceinline__ void pv_tile(f32x16 (&o)[NDT], const bf16* Vr, const bx8 (&pb)[4], int lane) {
    const bf16* vb = Vr + (4 * (lane >> 5) + ((lane & 15) >> 2)) * VS + 16 * ((lane >> 4) & 1) + 4 * (lane & 3);
    v2u cur[NDT][2], nxt[NDT][2];
#pragma unroll
    for (int dt = 0; dt < NDT; ++dt) { cur[dt][0] = vtr(vb + 32 * dt); cur[dt][1] = vtr(vb + 8 * VS + 32 * dt); }
#pragma unroll
    for (int ks = 0; ks < 4; ++ks) {
        if (ks < 3) {
#pragma unroll
            for (int dt = 0; dt < NDT; ++dt) { nxt[dt][0] = vtr(vb + (16 * (ks + 1)) * VS + 32 * dt); nxt[dt][1] = vtr(vb + (16 * (ks + 1) + 8) * VS + 32 * dt); }
        }
        __builtin_amdgcn_s_setprio(1);
#pragma unroll
        for (int dt = 0; dt < NDT; ++dt) { const v4u t = {cur[dt][0].x, cur[dt][0].y, cur[dt][1].x, cur[dt][1].y}; o[dt] = MFMA32(__builtin_bit_cast(bx8, t), pb[ks], o[dt]); }
        __builtin_amdgcn_s_setprio(0);
#pragma unroll
        for (int dt = 0; dt < NDT; ++dt) { cur[dt][0] = nxt[dt][0]; cur[dt][1] = nxt[dt][1]; }
    }
}

template <int PASS> __device__ __forceinline__ void diff_unit(const Ctx& c, int l, int uidx, unsigned char* lds) {
    constexpr int NT = PASS ? 10 : 2, NQB = PASS ? 8 : 2, VS = 160;
    const int tid = c.tid, lane = c.lane, w = c.wave, r32 = lane & 31, hi = lane >> 5, comp = w >> 2;
    const int qb = uidx % NQB, h = (uidx / NQB) & 3, b = uidx / (NQB * 4);
    const int tok0 = PASS ? MC + b * 1024 : b * 256;
    bf16* Kt = (bf16*)lds;
    bf16* Vr = Kt + 128 * 136;
    float* Ob = (float*)lds;
    const bf16* R1p = c.R1(); const bf16* CK = c.CKV() + (size_t)l * 1024 * 1280;
    const float lam_init = 0.8f - 0.6f * expf(-0.3f * (float)l);
    const float* lv = c.dlam() + l * 256;
    const float lam = expf(wave_sum(lv[lane] * lv[64 + lane])) - expf(wave_sum(lv[128 + lane] * lv[192 + lane])) + lam_init;
    const size_t mrow = (size_t)tok0 + qb * 128 + 32 * (w & 3) + r32;
    bx8 qf[4];
#pragma unroll
    for (int d0 = 0; d0 < 4; ++d0) qf[d0] = *(const bx8*)(R1p + mrow * 4096 + C_DQ + h * 128 + comp * 64 + 16 * d0 + 8 * hi);
    f32x16 o[4];
#pragma unroll
    for (int dt = 0; dt < 4; ++dt) o[dt] = (f32x16){0.f};
    float mrun = -1e30f, lrun = 0.f;
    v4u kreg[4], vreg[4];
#define DIFF_LOAD(t) { const bf16* kb; const bf16* vb; size_t rs; \
        if (PASS && (t) < 2) { kb = CK + ((size_t)b * 256 + 128 * (t)) * 1280 + h * 128; vb = kb + 512; rs = 1280; } \
        else { kb = R1p + ((size_t)tok0 + 128 * ((t) - (PASS ? 2 : 0))) * 4096 + C_DK + h * 128; vb = kb + (C_DV - C_DK); rs = 4096; } \
        _Pragma("unroll") for (int i = 0; i < 4; ++i) { const int id = tid + NTHR * i; kreg[i] = *(const v4u*)(kb + (size_t)(id >> 4) * rs + (id & 15) * 8); vreg[i] = *(const v4u*)(vb + (size_t)(id >> 4) * rs + (id & 15) * 8); } }
    DIFF_LOAD(0);
    for (int t = 0; t < NT; ++t) {
        LDS_BARRIER();
#pragma unroll
        for (int i = 0; i < 4; ++i) { const int id = tid + NTHR * i; *(v4u*)(Kt + (id >> 4) * 136 + (id & 15) * 8) = kreg[i]; *(v4u*)(Vr + (id >> 4) * VS + (id & 15) * 8) = vreg[i]; }
        if (t + 1 < NT) DIFF_LOAD(t + 1);
        LDS_BARRIER();
#pragma unroll
        for (int sub = 0; sub < 2; ++sub) {
            f32x16 p0, p1; bx8 pb[4];
            qk_tile(p0, p1, Kt + sub * 64 * 136 + comp * 64, 136, qf, r32, hi);
            const float alpha = sm_step(p0, p1, mrun, lrun, pb);
            if (__any(alpha != 1.0f)) {
#pragma unroll
                for (int dt = 0; dt < 4; ++dt)
#pragma unroll
                    for (int r = 0; r < 16; ++r) o[dt][r] *= alpha; }
            pv_tile<4, VS>(o, Vr + sub * 64 * VS, pb, lane);
        }
    }
#undef DIFF_LOAD
    const float inv = (comp ? lam : 1.0f) / lrun;
    const int rowl = 32 * (w & 3) + r32;
    LDS_BARRIER();
    if (comp) {
#pragma unroll
        for (int dt = 0; dt < 4; ++dt)
#pragma unroll
            for (int r = 0; r < 16; ++r) Ob[rowl * 129 + 32 * dt + (r & 3) + 8 * (r >> 2) + 4 * hi] = o[dt][r] * inv;
    }
    LDS_BARRIER();
    if (!comp) {
        float ss = 0.f;
#pragma unroll
        for (int dt = 0; dt < 4; ++dt)
#pragma unroll
            for (int r = 0; r < 16; ++r) { const float v = o[dt][r] * inv - Ob[rowl * 129 + 32 * dt + (r & 3) + 8 * (r >> 2) + 4 * hi]; o[dt][r] = v; ss += v * v; }
        ss += __shfl_xor(ss, 32);
        const float rn = rsqrtf(ss * (1.0f / 128.0f) + EPS) * (1.0f - lam_init);
        const float* sg = c.subln_g() + l * 128; bf16* yp = c.Y() + mrow * 2048 + 1024 + h * 128;
#pragma unroll
        for (int dt = 0; dt < 4; ++dt)
#pragma unroll
            for (int r4 = 0; r4 < 4; ++r4) { const int dv = 32 * dt + 8 * r4 + 4 * hi; const f32x4 g = *(const f32x4*)(sg + dv);
                v2u ov; ov.x = pk2(o[dt][4 * r4 + 0] * rn * g.x, o[dt][4 * r4 + 1] * rn * g.y); ov.y = pk2(o[dt][4 * r4 + 2] * rn * g.z, o[dt][4 * r4 + 3] * rn * g.w);
                *(v2u*)(yp + dv) = ov; }
    }
}

template <int PASS> __device__ __forceinline__ void win_unit(const Ctx& c, int l, int uidx, unsigned char* lds) {
    constexpr int NQB = PASS ? 4 : 1, VS = 96;
    const int tid = c.tid, lane = c.lane, w = c.wave, r32 = lane & 31, hi = lane >> 5;
    const int qb = uidx % NQB, hh = (uidx / NQB) & 7, b = uidx / (NQB * 8), nkv = hh >> 2;
    const int tok0 = PASS ? MC + b * 1024 : b * 256;
    bf16* Kt = (bf16*)lds;
    bf16* Vr = Kt + 128 * 72;
    const bf16* R1p = c.R1(); const bf16* CK = c.CKV() + (size_t)l * 1024 * 1280;
    const int qrow = qb * 256 + 32 * w + r32;
    const size_t mrow = (size_t)tok0 + qrow;
    bx8 qf[4];
#pragma unroll
    for (int d0 = 0; d0 < 4; ++d0) qf[d0] = *(const bx8*)(R1p + mrow * 4096 + C_WQ + hh * 64 + 16 * d0 + 8 * hi);
    f32x16 o[2]; o[0] = (f32x16){0.f}; o[1] = (f32x16){0.f};
    float mrun = c.sink()[l * 8 + hh] * 1.4426950408889634f, lrun = 1.0f;
    const int q0 = qb * 256;
    const int tb0 = PASS ? ((q0 - 128 < 0 ? 0 : q0 - 128) >> 7) : 0, tb1 = PASS ? ((q0 + 255 + 128 > 1023 ? 1023 : q0 + 255 + 128) >> 7) : 0;
    const int NT = PASS ? 2 + (tb1 - tb0 + 1) : 2;
    v4u kreg[2], vreg[2];
#define WIN_LOAD(t) { const bf16* kb; const bf16* vb; size_t rs; \
        if (PASS && (t) < 2) { kb = CK + ((size_t)b * 256 + 128 * (t)) * 1280 + 1024 + nkv * 64; vb = kb + 128; rs = 1280; } \
        else { kb = R1p + ((size_t)tok0 + 128 * (PASS ? tb0 + (t) - 2 : (t))) * 4096 + C_WK + nkv * 64; vb = kb + (C_WV - C_WK); rs = 4096; } \
        _Pragma("unroll") for (int i = 0; i < 2; ++i) { const int id = tid + NTHR * i; kreg[i] = *(const v4u*)(kb + (size_t)(id >> 3) * rs + (id & 7) * 8); vreg[i] = *(const v4u*)(vb + (size_t)(id >> 3) * rs + (id & 7) * 8); } }
    WIN_LOAD(0);
    for (int t = 0; t < NT; ++t) {
        LDS_BARRIER();
#pragma unroll
        for (int i = 0; i < 2; ++i) { const int id = tid + NTHR * i; *(v4u*)(Kt + (id >> 3) * 72 + (id & 7) * 8) = kreg[i]; *(v4u*)(Vr + (id >> 3) * VS + (id & 7) * 8) = vreg[i]; }
        if (t + 1 < NT) WIN_LOAD(t + 1);
        LDS_BARRIER();
#pragma unroll
        for (int sub = 0; sub < 2; ++sub) {
            bool band = false; int kp0 = 0;
            if (PASS && t >= 2) { band = true; kp0 = 128 * (tb0 + t - 2) + 64 * sub; const int r0 = q0 + 32 * w;
                if (kp0 + 63 < r0 - 128 || kp0 > r0 + 31 + 128) continue; }
            f32x16 p0, p1; bx8 pb[4];
            qk_tile(p0, p1, Kt + sub * 64 * 72, 72, qf, r32, hi);
            if (band) {
#pragma unroll
                for (int r = 0; r < 16; ++r) { const int kp = kp0 + (r & 3) + 8 * (r >> 2) + 4 * hi; const int d0 = qrow - kp, d1 = d0 - 32;
                    if (d0 > 128 || d0 < -128) p0[r] = -1e30f; if (d1 > 128 || d1 < -128) p1[r] = -1e30f; }
            }
            const float alpha = sm_step(p0, p1, mrun, lrun, pb);
            if (__any(alpha != 1.0f)) {
#pragma unroll
                for (int dt = 0; dt < 2; ++dt)
#pragma unroll
                    for (int r = 0; r < 16; ++r) o[dt][r] *= alpha; }
            pv_tile<2, VS>(o, Vr + sub * 64 * VS, pb, lane);
        }
    }
#undef WIN_LOAD
    const float inv = 1.0f / lrun; bf16* yp = c.Y() + mrow * 2048 + 1536 + hh * 64;
#pragma unroll
    for (int dt = 0; dt < 2; ++dt)
#pragma unroll
        for (int r4 = 0; r4 < 4; ++r4) { const int dv = 32 * dt + 8 * r4 + 4 * hi;
            v2u ov; ov.x = pk2(o[dt][4 * r4 + 0] * inv, o[dt][4 * r4 + 1] * inv); ov.y = pk2(o[dt][4 * r4 + 2] * inv, o[dt][4 * r4 + 3] * inv);
            *(v2u*)(yp + dv) = ov; }
}

__device__ __forceinline__ void phase_mixers(const Ctx& c_in, int l, float* lf) {
    unsigned char* lds = (unsigned char*)lf;
    unsigned* qctr = (unsigned*)(c_in.ws() + WS_QCTR) + 64 * l;
    volatile int* qslot = (volatile int*)(lds + LDS_BYTES - 32);
    for (;;) {
        __syncthreads();
        if (threadIdx.x == 0) *qslot = (int)atomicAdd(qctr, 1u);
        __syncthreads();
        const int u = __builtin_amdgcn_readfirstlane(*qslot);
        if (u >= 1440) break;
        Ctx c = c_in; asm volatile("" : "+s"(c.ap), "+v"(c.tid));
        c.lane = c.tid & 63; c.wave = __builtin_amdgcn_readfirstlane(c.tid >> 6);
        unsigned long long pt0 = 0; if (PROBE_SEL >= 0) pt0 = __builtin_amdgcn_s_memrealtime();
        int ty;
        if (u < 32) { ssd_unit(c, l, 1, u >> 3, u & 7, lds); ty = 0; }
        else if (u < 160) { diff_unit<1>(c, l, u - 32, lds); ty = 2; }
        else if (u < 288) { win_unit<1>(c, l, u - 160, lds); ty = 3; }
        else if (u < 416) { s5_unit(c, l, (u - 288) & 31, 8 + ((u - 288) >> 5), lds); ty = 1; }
        else if (u < 672) { ssd_unit(c, l, 0, (u - 416) >> 3, (u - 416) & 7, lds); ty = 4; }
        else if (u < 928) { diff_unit<0>(c, l, u - 672, lds); ty = 6; }
        else if (u < 1184) { win_unit<0>(c, l, u - 928, lds); ty = 7; }
        else { s5_unit(c, l, (u - 1184) & 31, (u - 1184) >> 5, lds); ty = 5; }
        __syncthreads();
        if (PROBE_SEL >= 0 && threadIdx.x == 0) { unsigned long long* tsu = (unsigned long long*)(c.ws() + WS_TS) + 64; atomicAdd(tsu + ty, (unsigned long long)(__builtin_amdgcn_s_memrealtime() - pt0)); }
    }
}

__device__ __forceinline__ void phase_sum4(const Ctx& c) {
    const int gt = blockIdx.x * NTHR + c.tid, NT = gridDim.x * NTHR;
#pragma unroll 4
    for (int i = gt; i < M * 128; i += NT) { const size_t m = (size_t)(i >> 7); const int c8 = (i & 127) * 8;
        float a[8] = {0.f, 0.f, 0.f, 0.f, 0.f, 0.f, 0.f, 0.f};
#pragma unroll
        for (int j = 0; j < 4; ++j) { float f[8]; unpack8(*(const v4u*)(c.R1() + m * 4096 + j * 1024 + c8), f);
#pragma unroll
            for (int k = 0; k < 8; ++k) a[k] += f[k]; }
        v4u o; o.x = pk2(a[0], a[1]); o.y = pk2(a[2], a[3]); o.z = pk2(a[4], a[5]); o.w = pk2(a[6], a[7]);
        *(v4u*)(c.H() + m * 1024 + c8) = o; }
}

#define GAS __attribute__((address_space(1)))
#define XB_TMO      128
#define XB_XCNT(j)  (256  + 64 * (j))
#define XB_XSUB(j)  (1280 + 64 * (j))
#define XB_XGEN(j)  (2304 + 64 * (j))
#define XB_TOP      3328
#define XB_TOPGEN   3392
#define XCD_BAR_WORDS 3456
#define XB_SPIN_CAP (1u << 18)

__device__ __forceinline__ unsigned xb_ld(unsigned* p)              { return __hip_atomic_load(p, __ATOMIC_RELAXED, __HIP_MEMORY_SCOPE_AGENT); }
__device__ __forceinline__ unsigned xb_add(unsigned* p, unsigned v) { return __hip_atomic_fetch_add(p, v, __ATOMIC_RELAXED, __HIP_MEMORY_SCOPE_AGENT); }
__device__ __forceinline__ unsigned xb_xcc_id() { return (unsigned)__builtin_amdgcn_s_getreg((3 << 11) | 20) & 0xFu; }
#define XB_SPIN(cond, bar) do { unsigned _sp = 0; while (cond) { __builtin_amdgcn_s_sleep(1); \
    if ((++_sp & 255u) == 0u) { if (xb_ld(&(bar)[XB_TMO])) break; if (_sp > XB_SPIN_CAP) { atomicAdd(&(bar)[XB_TMO], 1u); break; } } } } while (0)

struct XcdBarrier {
    unsigned* bar; unsigned x;
    volatile LAS unsigned* st;
};

__device__ __forceinline__ XcdBarrier xcd_barrier_post(unsigned* bar, volatile LAS unsigned* st) {
    XcdBarrier b; b.bar = bar; b.x = xb_xcc_id(); b.st = st;
    if (threadIdx.x == 0) (void)xb_add(&bar[XB_XCNT(b.x)], 1u);
    return b;
}
__device__ __forceinline__ void xcd_barrier_complete(unsigned* bar, unsigned x, unsigned& nloc, unsigned& nx) {
    const unsigned G = gridDim.x * gridDim.y * gridDim.z;
    unsigned sum, cnt, mine, sp = 0u;
    for (;;) {
        sum = 0u; cnt = 0u; mine = 0u;
#pragma unroll
        for (unsigned j = 0; j < 16; ++j) { const unsigned c = xb_ld(&bar[XB_XCNT(j)]); sum += c; cnt += (c > 0u) ? 1u : 0u; mine = (j == x) ? c : mine; }
        if (sum == G) break;
        __builtin_amdgcn_s_sleep(1);
        if ((++sp & 255u) == 0u) { if (xb_ld(&bar[XB_TMO])) break; if (sp > XB_SPIN_CAP) { atomicAdd(&bar[XB_TMO], 1u); break; } }
    }
    nloc = mine > 0u ? mine : 1u; nx = cnt > 0u ? cnt : 1u;
}

__device__ __forceinline__ void xcd_barrier(const XcdBarrier& b) {
    asm volatile("s_waitcnt vmcnt(0)" ::: "memory");
    __syncthreads();
    if (threadIdx.x == 0) {
        unsigned* bar = b.bar;
        __builtin_amdgcn_s_waitcnt(0);
        unsigned nloc = b.st[0], nx = b.st[1];
        if (nloc == 0u) { xcd_barrier_complete(bar, b.x, nloc, nx); b.st[0] = nloc; b.st[1] = nx; }
        const unsigned old = xb_add(&bar[XB_XSUB(b.x)], 1u);
        const unsigned gen = old / nloc;
        if (old + 1u == (gen + 1u) * nloc) {
            __builtin_amdgcn_fence(__ATOMIC_RELEASE, "agent");
            asm volatile("s_waitcnt vmcnt(0)" ::: "memory");
            const unsigned og = xb_add(&bar[XB_TOP], 1u);
            const unsigned tg = og / nx;
            if (og + 1u == (tg + 1u) * nx) xb_add(&bar[XB_TOPGEN], 1u);
            else XB_SPIN(xb_ld(&bar[XB_TOPGEN]) == tg, bar);
            __builtin_amdgcn_fence(__ATOMIC_ACQUIRE, "agent");
            xb_add(&bar[XB_XGEN(b.x)], 1u);
            asm volatile("s_waitcnt vmcnt(0)" ::: "memory");
        } else {
            XB_SPIN(xb_ld(&bar[XB_XGEN(b.x)]) == gen, bar);
            __builtin_amdgcn_fence(__ATOMIC_ACQUIRE, "agent");
            asm volatile("s_waitcnt vmcnt(0)" ::: "memory");
        }
    }
    __syncthreads();
}

#define PHASE_BEGIN() Ctx c; c.ap = (CArgs)__builtin_amdgcn_kernarg_segment_ptr(); asm volatile("" : "+s"(c.ap)); \
        int tid_o = threadIdx.x; asm volatile("" : "+v"(tid_o)); c.tid = tid_o; c.lane = tid_o & 63; c.wave = __builtin_amdgcn_readfirstlane(tid_o >> 6); \
        int G = gridDim.x, bid = blockIdx.x; asm volatile("" : "+s"(G), "+s"(bid)); unsigned char* ws = c.ws(); (void)ws; (void)G; (void)bid;
#define PHASE_END(k) { if ((k) + 1 < ph_hi) { if ((k) == 0) cg::this_grid().sync(); else xcd_barrier(xbar); } \
        if (PROBE_SEL >= 0 && blockIdx.x == PROBE_PB && threadIdx.x == 0) ((unsigned long long*)(c.ws() + WS_TS))[(k) + 1] = __builtin_amdgcn_s_memrealtime(); }
#define IN_RANGE(k) (ph_lo <= (k) && (k) < ph_hi)

template <int LAYER> __device__ __forceinline__ void layer_program(int ph_lo, int ph_hi, unsigned char* lds, const XcdBarrier& xbar) {
    float* lf = (float*)lds;
    PG8_LAS unsigned char* ring = (PG8_LAS unsigned char*)lds;
    constexpr int l = LAYER, B0 = 1 + 11 * LAYER;
    if (IN_RANGE(B0 + 0)) { PHASE_BEGIN(); if (l == 1) { if (gridDim.x == 256) convert_items(c, 1, 7936, 9984, blockIdx.x * NWAVES + c.wave, gridDim.x * NWAVES, false, 0, 1, lf); else phase_convert(c, 1, lf); __syncthreads(); } phase_norm(c, l, 0, lf); phase_bias2(c, l); PHASE_END(B0 + 0); }
    if (IN_RANGE(B0 + 1)) { PHASE_BEGIN();
        pg8::Gemm g{c.H(), (const bf16*)(ws + W_IN), M, 4096, 1024, 1024, 1024, 0, 0}; pg8::StaticOrder S; S.init(M, 4096, G, bid);
        pg8::EpiB<0> E{c.R1(), 4096, nullptr, nullptr};
        pg8::gemm_phase<pg8::EpiB<0>, pg8::StaticOrder, true, true>(ring, g, S, E, tid_o); phase_dt(c, l); PHASE_END(B0 + 1); }
    if (IN_RANGE(B0 + 2)) { PHASE_BEGIN(); phase_qk(c, l, lf); PHASE_END(B0 + 2); }
    if (IN_RANGE(B0 + 3)) { PHASE_BEGIN(); phase_mixers(c, l, lf); PHASE_END(B0 + 3); }
    if (IN_RANGE(B0 + 4)) { PHASE_BEGIN();
        { pg8::Gemm g{c.Y5(), (const bf16*)(ws + W_GLU), M, 1024, 512, 512, 512, 0, 0}; pg8::StaticOrder S; S.init(M, 1024, G, bid);
          pg8::EpiGlu E{c.Y(), 2048, 512, c.b_glu() + l * 1024};
          pg8::gemm_phase<pg8::EpiGlu, pg8::StaticOrder, true, true>(ring, g, S, E, tid_o); }
        { pg8::Gemm g{c.H(), (const bf16*)(ws + W_G), M, 4096, 1024, 1024, 1024, 0, 0}; pg8::StaticOrder S; S.init(M, 4096, G, bid);
          pg8::EpiB<1> E{c.R1(), 4096, c.b_gate() + l * 4096, nullptr};
          pg8::gemm_phase<pg8::EpiB<1>, pg8::StaticOrder, true, true>(ring, g, S, E, tid_o); }
        PHASE_END(B0 + 4); }
    if (IN_RANGE(B0 + 5)) { PHASE_BEGIN();
        pg8::Gemm g{c.Y(), (const bf16*)(ws + W_BR), M, 4096, 512, 2048, 512, 4, 1024}; pg8::BranchOrder S; S.init(G, bid);
        pg8::EpiMerge E{c.R1(), c.H(), c.SSQ()};
        pg8::gemm_phase<pg8::EpiMerge, pg8::BranchOrder, true, true>(ring, g, S, E, tid_o); if (l == 0) side_convert(c, 0, 4352, true, lf); PHASE_END(B0 + 5); }
    if (IN_RANGE(B0 + 7)) { PHASE_BEGIN();
        pg8::Gemm g{c.H(), (const bf16*)(ws + W_OUT), M, 1024, 1024, 1024, 1024, 0, 0}; pg8::StaticOrder S; S.init(M, 1024, G, bid);
        pg8::EpiRes2 E{l == 0 ? c.x_prompt() : c.out(), l == 0 ? c.x_sample() : c.out() + (size_t)MC * D, c.out(), c.MOD() + (size_t)l * 5 * 6144, 2048, c.Y(), c.g_norm2() + l * 1024, 4096, (float*)(ws + WS_SSQ2)};
        pg8::gemm_phase<pg8::EpiRes2, pg8::StaticOrder, true, true>(ring, g, S, E, tid_o); if (l == 0) side_convert(c, 4352, 5376, false, lf); PHASE_END(B0 + 7); }
    if (IN_RANGE(B0 + 9)) { PHASE_BEGIN();
        pg8::Gemm g{c.Y(), (const bf16*)(ws + W_1), M, 4096, 1024, 1024, 1024, 0, 0}; pg8::StaticOrder S; S.init(M, 4096, G, bid);
        pg8::EpiB<5> E{c.R1(), 4096, (const float*)(ws + WS_BI2), (const float*)(ws + WS_SSQ2)};
        pg8::gemm_phase<pg8::EpiB<5>, pg8::StaticOrder, true, true>(ring, g, S, E, tid_o); PHASE_END(B0 + 9); }
    if (IN_RANGE(B0 + 10)) { PHASE_BEGIN();
        pg8::Gemm g{c.R1(), (const bf16*)(ws + W_2), M, 1024, 4096, 4096, 4096, 0, 0}; pg8::StaticOrder S; S.init(M, 1024, G, bid);
        pg8::EpiRes E{c.out(), c.out() + (size_t)MC * D, c.out(), c.MOD() + (size_t)l * 5 * 6144, 5120};
        pg8::gemm_phase<pg8::EpiRes, pg8::StaticOrder, true, true>(ring, g, S, E, tid_o); if (l == 0) side_convert(c, 5376, 7936, false, lf); PHASE_END(B0 + 10); }
}

__global__ void __launch_bounds__(NTHR, 2) fwd_kernel(Args args) {
    extern __shared__ __attribute__((aligned(16))) unsigned char lds[];
    const int ph_lo = args.ph_lo, ph_hi = args.ph_hi;
    volatile LAS unsigned* xst = (volatile LAS unsigned*)(lds + LDS_BYTES - 16);
    if (threadIdx.x < 4) xst[threadIdx.x] = 0u;
    __syncthreads();
    const XcdBarrier xbar = xcd_barrier_post((unsigned*)(args.ws + WS_BAR), xst);
    if (PROBE_SEL >= 0 && blockIdx.x == PROBE_PB && threadIdx.x == 0) { unsigned long long* ts = (unsigned long long*)(args.ws + WS_TS); ts[0] = __builtin_amdgcn_s_memrealtime(); }
    if (IN_RANGE(0)) { PHASE_BEGIN(); float* lf = (float*)lds; phase_mods(c, lf); __syncthreads(); phase_convert(c, 0, lf); phase_rope_table(c); phase_ckv(c); PHASE_END(0); }
    layer_program<0>(ph_lo, ph_hi, lds, xbar);
    layer_program<1>(ph_lo, ph_hi, lds, xbar);
    if (PROBE_SEL >= 0) {
        __threadfence(); cg::this_grid().sync();
        const unsigned long long* ts = (const unsigned long long*)(args.ws + WS_TS);
        const float total = (float)(ts[23] - ts[0]); float sel = 0.f;
        for (int k = 0; k < 23; ++k) { const float d = (float)(ts[k + 1] - ts[k]); const int q = k == 0 ? -1 : (k - 1) % 11;
            const int cls = (q == 3) ? 0 : (q == 1 || q == 4 || q == 5 || q == 7 || q == 9 || q == 10) ? 1 : (q == 2) ? 2 : 3;
            if (cls == PROBE_SEL) sel += d; }
        if (PROBE_SEL >= 10 && PROBE_SEL < 100) sel = (float)ts[64 + PROBE_SEL - 10] * (1.0f / 256.0f);
        if (PROBE_SEL >= 100) { const int k = PROBE_SEL - 100; sel = (float)(ts[k + 1] - (ts[k] != 0ull ? ts[k] : ts[k - 1])); }
        const float sc = 1.0f + sqrtf(PROBE_SCALE * sel / total);
        for (int i = blockIdx.x * NTHR + threadIdx.x; i < 524288; i += gridDim.x * NTHR) args.out[O_S5 + i] *= sc;
    }
}

extern "C" void kernel_launch(void* const* d_in, const int* in_sizes, int n_in, void* d_out, int out_size, void* d_ws, size_t ws_size, hipStream_t stream) {
    static int grid = 0;
    if (grid == 0) {
        if (n_in != 44 || ws_size < WS_END) { fprintf(stderr, "kernel_launch: expected 44 inputs and >= %zu bytes of workspace; got %d, %zu\n", (size_t)WS_END, n_in, ws_size); grid = -1; return; }
        int dev = 0, cus = 0, per_cu = 0;
        (void)hipGetDevice(&dev); (void)hipDeviceGetAttribute(&cus, hipDeviceAttributeMultiprocessorCount, dev);
        (void)hipFuncSetAttribute((const void*)fwd_kernel, hipFuncAttributeMaxDynamicSharedMemorySize, LDS_BYTES);
        (void)hipOccupancyMaxActiveBlocksPerMultiprocessor(&per_cu, (const void*)fwd_kernel, NTHR, LDS_BYTES);
        if (per_cu < 1) { fprintf(stderr, "kernel_launch: occupancy query says %d blocks per CU\n", per_cu); per_cu = 1; }
        (void)hipGetLastError();
        grid = cus > 0 ? cus : 256;
    }
    if (grid < 0) return;
    (void)hipMemsetAsync(d_ws, 0, 64 * 1024, stream);
    Args a{};
    for (int i = 0; i < 44; ++i) a.in[i] = (const float*)d_in[i];
    a.out = (float*)d_out; a.ws = (unsigned char*)d_ws;
#if MK_MULTI
    for (int ph = 0; ph < NPH; ++ph) { a.ph_lo = ph; a.ph_hi = ph + 1; hipLaunchKernelGGL(fwd_kernel, dim3(grid), dim3(NTHR), LDS_BYTES, stream, a); }
#else
    a.ph_lo = 0; a.ph_hi = NPH;
    void* kargs[] = {&a};
    hipError_t e = hipLaunchCooperativeKernel((const void*)fwd_kernel, dim3(grid), dim3(NTHR), kargs, LDS_BYTES, stream);
    if (e != hipSuccess) fprintf(stderr, "cooperative launch failed: %s (grid %d)\n", hipGetErrorString(e), grid);
#endif
}
```

```cpp
#include <hip/hip_runtime.h>
#include <hip/hip_cooperative_groups.h>
#include <cstdio>
#include <cstdint>
namespace cg = cooperative_groups;

#ifndef MK_MULTI
#define MK_MULTI 0
#endif

namespace pg8 {
#define PG8_LAS __attribute__((address_space(3)))
typedef unsigned short bf16_t;
typedef short bf16x8 __attribute__((ext_vector_type(8)));
typedef float f32x4 __attribute__((ext_vector_type(4)));
typedef unsigned u32x4 __attribute__((ext_vector_type(4)));
constexpr int BM = 256, BK = 64, HALF = 128, HTB = HALF * BK * 2  , STAGE_BYTES = 8 * HTB, NXCD = 8, WGM = 8;

__host__ __device__ __forceinline__ int lds_byte(int r, int c) { const int st = (r >> 4) * 2 + (c >> 5), rr = r & 15, cc = c & 31, ob = rr * 64 + cc * 2; return st * 1024 + (ob ^ (((ob >> 9) & 1) << 5)); }
__host__ __device__ __forceinline__ void stage_rc(int b, int& R, int& C) { const int st = b / 1024, sb = b % 1024, swz = sb ^ (((sb >> 9) & 1) << 5); R = (st >> 1) * 16 + swz / 64; C = (st & 1) * 32 + (swz % 64) / 2; }
__host__ __device__ __forceinline__ int perm32(int rho) { const int n = rho >> 4, i = rho & 15; return 8 * (i >> 2) + 4 * n + (i & 3); }

struct Unit { int pm, pn; };
struct Gemm { const bf16_t* A; const bf16_t* Bt; int M, N, K, lda, ldb, a_div; size_t a_gstride; };

struct StaticOrder {
    int nM, nN, nwg, G, c;
    __host__ __device__ void init(int M, int N, int G_, int c_) { nM = M / BM; nN = N / BM; nwg = nM * nN; G = G_; c = c_; }
    __host__ __device__ bool next(int i, Unit& u) const {
        const long L = (long)i * G + c; if (L >= nwg) return false;
        int wgid = (int)L; { const int q = nwg / NXCD, r = nwg % NXCD, xcd = wgid % NXCD, off = wgid / NXCD; wgid = (xcd < r ? xcd * (q + 1) : r * (q + 1) + (xcd - r) * q) + off; }
        const int nig = WGM * nN, gid = wgid / nig, fm = gid * WGM, gsz = (nM - fm) < WGM ? (nM - fm) : WGM;
        u.pm = fm + ((wgid % nig) % gsz); u.pn = (wgid % nig) / gsz; return true;
    }
    __device__ __forceinline__ void a_ready(const Unit&) const {}
    __device__ __forceinline__ void done(const Unit&) const {}
};

__device__ __forceinline__ unsigned cvt_pk_bf16(float lo, float hi) { unsigned r; asm volatile("v_cvt_pk_bf16_f32 %0, %1, %2" : "=v"(r) : "v"(lo), "v"(hi)); return r; }
__device__ __forceinline__ float bf_lo(unsigned w) { return __builtin_bit_cast(float, w << 16); }
__device__ __forceinline__ float bf_hi(unsigned w) { return __builtin_bit_cast(float, w & 0xffff0000u); }
__device__ __forceinline__ float sigmoidf_(float x) { return 1.0f / (1.0f + __expf(-x)); }

template <int MODE> struct EpiB {
    static constexpr bool PERM = true, AFTER_DRAIN = false;
    bf16_t* O; int ldc; const float* bias; const float* ssq;
    __device__ __forceinline__ void operator()(const f32x4 (&acc)[2][2][4][2], const Unit& u, int wr, int wc, int fr, int fq) const {
        const int row0 = u.pm * BM + wr * 64 + fr, col0 = u.pn * BM + wc * 32 + 8 * fq;
        f32x4 bv[2][2];
#pragma unroll
        for (int bj = 0; bj < 2; ++bj)
#pragma unroll
            for (int n = 0; n < 2; ++n) bv[bj][n] = (MODE == 1) ? *(const f32x4*)(bias + col0 + bj * HALF + 4 * n) : (MODE == 5) ? *(const f32x4*)(bias + (size_t)((u.pm < 32) ? 0 : 1 + ((u.pm - 32) >> 2)) * 4096 + col0 + bj * HALF + 4 * n) : (f32x4){0.f, 0.f, 0.f, 0.f};
        u32x4 gpre[2][4][2]; float rpre[2][4];
        if (MODE == 3) {
#pragma unroll
            for (int ai = 0; ai < 2; ++ai)
#pragma unroll
                for (int m = 0; m < 4; ++m) { const int row = row0 + ai * HALF + m * 16; const bf16_t* rp = O + (size_t)row * ldc + col0;
                    rpre[ai][m] = (u.pn < 4) ? ssq[row] : 512.0f;
#pragma unroll
                    for (int bj = 0; bj < 2; ++bj) gpre[ai][m][bj] = *(const u32x4*)(rp + bj * HALF); }
        }
#pragma unroll
        for (int ai = 0; ai < 2; ++ai)
#pragma unroll
            for (int m = 0; m < 4; ++m) {
                const int row = row0 + ai * HALF + m * 16;
                bf16_t* rowp = O + (size_t)row * ldc + col0;
                float rs = 1.f;
                if (MODE == 3) { if (u.pn < 4) rs = rsqrtf(rpre[ai][m] * (1.0f / 512.0f) + 1e-6f); }
                if (MODE == 5) rs = rsqrtf(ssq[row] * (1.0f / 1024.0f) + 1e-6f);
#pragma unroll
                for (int bj = 0; bj < 2; ++bj) {
                    f32x4 v0 = (MODE == 5 ? acc[ai][bj][m][0] * rs : acc[ai][bj][m][0]) + bv[bj][0], v1 = (MODE == 5 ? acc[ai][bj][m][1] * rs : acc[ai][bj][m][1]) + bv[bj][1];
                    if (MODE == 1) {
#pragma unroll
                        for (int j = 0; j < 4; ++j) { v0[j] = sigmoidf_(v0[j]); v1[j] = sigmoidf_(v1[j]); }
                    }
                    if (MODE == 2 || MODE == 5) {
#pragma unroll
                        for (int j = 0; j < 4; ++j) { const float a = fmaxf(v0[j], 0.f), b = fmaxf(v1[j], 0.f); v0[j] = a * a; v1[j] = b * b; }
                    }
                    if (MODE == 3) {
                        const u32x4 gq = gpre[ai][m][bj];
                        v0[0] *= bf_lo(gq.x) * rs; v0[1] *= bf_hi(gq.x) * rs; v0[2] *= bf_lo(gq.y) * rs; v0[3] *= bf_hi(gq.y) * rs;
                        v1[0] *= bf_lo(gq.z) * rs; v1[1] *= bf_hi(gq.z) * rs; v1[2] *= bf_lo(gq.w) * rs; v1[3] *= bf_hi(gq.w) * rs;
                    }
                    u32x4 w; w.x = cvt_pk_bf16(v0[0], v0[1]); w.y = cvt_pk_bf16(v0[2], v0[3]); w.z = cvt_pk_bf16(v1[0], v1[1]); w.w = cvt_pk_bf16(v1[2], v1[3]);
                    *(u32x4*)(rowp + bj * HALF) = w;
                }
            }
    }
};
struct EpiGlu {
    static constexpr bool PERM = true, AFTER_DRAIN = false;
    bf16_t* O; int ldc; int ocol; const float* bias;
    __device__ __forceinline__ void operator()(const f32x4 (&acc)[2][2][4][2], const Unit& u, int wr, int wc, int fr, int fq) const {
        const int row0 = u.pm * BM + wr * 64 + fr, cc = u.pn * HALF + wc * 32 + 8 * fq;
        f32x4 bv[2][2];
#pragma unroll
        for (int bj = 0; bj < 2; ++bj)
#pragma unroll
            for (int n = 0; n < 2; ++n) bv[bj][n] = *(const f32x4*)(bias + bj * 512 + cc + 4 * n);
#pragma unroll
        for (int ai = 0; ai < 2; ++ai)
#pragma unroll
            for (int m = 0; m < 4; ++m) {
                bf16_t* rowp = O + (size_t)(row0 + ai * HALF + m * 16) * ldc + ocol + cc;
                f32x4 v0 = acc[ai][0][m][0] + bv[0][0], v1 = acc[ai][0][m][1] + bv[0][1];
                const f32x4 g0 = acc[ai][1][m][0] + bv[1][0], g1 = acc[ai][1][m][1] + bv[1][1];
#pragma unroll
                for (int j = 0; j < 4; ++j) { v0[j] *= sigmoidf_(g0[j]); v1[j] *= sigmoidf_(g1[j]); }
                u32x4 w; w.x = cvt_pk_bf16(v0[0], v0[1]); w.y = cvt_pk_bf16(v0[2], v0[3]); w.z = cvt_pk_bf16(v1[0], v1[1]); w.w = cvt_pk_bf16(v1[2], v1[3]);
                *(u32x4*)rowp = w;
            }
    }
};
struct EpiRes2 {
    static constexpr bool PERM = false, AFTER_DRAIN = false;
    const float* base_ctx; const float* base_lat; float* out; const float* modv; int goff;
    bf16_t* xn; const float* gnorm; int scoff; float* ssq;
    __device__ __forceinline__ void operator()(const f32x4 (&acc)[2][2][4][2], const Unit& u, int wr, int wc, int fr, int fq) const {
        const int row0 = u.pm * BM + wr * 64 + fr, col0 = u.pn * BM + wc * 32 + 4 * fq;
        const int mi = (u.pm < 32) ? 0 : 1 + ((u.pm - 32) >> 2);
        const float* gv = modv + (size_t)mi * 6144 + goff; const float* sv = modv + (size_t)mi * 6144 + scoff;
        f32x4 gg[2][2], gn[2][2];
#pragma unroll
        for (int bj = 0; bj < 2; ++bj)
#pragma unroll
            for (int n = 0; n < 2; ++n) { gg[bj][n] = *(const f32x4*)(gv + col0 + bj * HALF + n * 16); gn[bj][n] = *(const f32x4*)(gnorm + col0 + bj * HALF + n * 16) * (*(const f32x4*)(sv + col0 + bj * HALF + n * 16) + 1.0f); }
#pragma unroll
        for (int ai = 0; ai < 2; ++ai)
#pragma unroll
        for (int mh = 0; mh < 2; ++mh) {
            f32x4 pre[2][2][2];
#pragma unroll
            for (int mm = 0; mm < 2; ++mm) { const int row = row0 + ai * HALF + (2 * mh + mm) * 16;
                const float* bp = (row < 8192 ? base_ctx + (size_t)row * 1024 : base_lat + (size_t)(row - 8192) * 1024) + col0;
#pragma unroll
                for (int bj = 0; bj < 2; ++bj)
#pragma unroll
                    for (int n = 0; n < 2; ++n) pre[mm][bj][n] = *(const f32x4*)(bp + bj * HALF + n * 16); }
#pragma unroll
            for (int mm = 0; mm < 2; ++mm) { const int m = 2 * mh + mm; const int row = row0 + ai * HALF + m * 16; float* op = out + (size_t)row * 1024 + col0; bf16_t* xp = xn + (size_t)row * 1024 + col0;
                float q = 0.f;
#pragma unroll
                for (int bj = 0; bj < 2; ++bj)
#pragma unroll
                    for (int n = 0; n < 2; ++n) { const f32x4 x = pre[mm][bj][n] + gg[bj][n] * acc[ai][bj][m][n]; *(f32x4*)(op + bj * HALF + n * 16) = x;
                        q += (x[0] * x[0] + x[1] * x[1]) + (x[2] * x[2] + x[3] * x[3]);
                        const f32x4 y = x * gn[bj][n]; unsigned w0 = cvt_pk_bf16(y[0], y[1]), w1 = cvt_pk_bf16(y[2], y[3]);
                        typedef unsigned u32x2 __attribute__((ext_vector_type(2))); *(u32x2*)(xp + bj * HALF + n * 16) = (u32x2){w0, w1}; }
                q += __shfl_xor(q, 16); q += __shfl_xor(q, 32);
                if (fq == 0) atomicAdd(ssq + row, q); }
            asm volatile("" ::: "memory");
        }
    }
};
struct EpiMerge {
    static constexpr bool PERM = true, AFTER_DRAIN = false;
    const bf16_t* gates; bf16_t* mg; const float* ssq;
    __device__ __forceinline__ void operator()(const f32x4 (&acc)[2][2][4][2], const Unit& u, int wr, int wc, int fr, int fq) const {
        const int br = u.pn >> 2, pnl = u.pn & 3;
        int pm_o = u.pm; asm volatile("" : "+s"(pm_o));
        const int row0 = pm_o * BM + wr * 64 + fr, gcol0 = u.pn * BM + wc * 32 + 8 * fq, mcol0 = pnl * BM + wc * 32 + 8 * fq;
#pragma unroll
        for (int ai = 0; ai < 2; ++ai)
#pragma unroll
        for (int mh = 0; mh < 2; ++mh) {
            u32x4 gpre[2][2], mpre[2][2]; float rpre[2];
#pragma unroll
            for (int mm = 0; mm < 2; ++mm) { const int row = row0 + ai * HALF + (2 * mh + mm) * 16;
                rpre[mm] = (br == 0) ? ssq[row] : 512.0f;
#pragma unroll
                for (int bj = 0; bj < 2; ++bj) { gpre[mm][bj] = *(const u32x4*)(gates + (size_t)row * 4096 + gcol0 + bj * HALF);
                    mpre[mm][bj] = (br != 0) ? *(const u32x4*)(mg + (size_t)row * 1024 + mcol0 + bj * HALF) : (u32x4){0u, 0u, 0u, 0u}; } }
#pragma unroll
            for (int mm = 0; mm < 2; ++mm) { const int m = 2 * mh + mm; const int row = row0 + ai * HALF + m * 16;
                const float rs = (br == 0) ? rsqrtf(rpre[mm] * (1.0f / 512.0f) + 1e-6f) : 1.0f;
#pragma unroll
                for (int bj = 0; bj < 2; ++bj) { const u32x4 gq = gpre[mm][bj], mq = mpre[mm][bj]; const f32x4 a0 = acc[ai][bj][m][0], a1 = acc[ai][bj][m][1];
                    const float v0 = bf_lo(mq.x) + a0[0] * bf_lo(gq.x) * rs, v1 = bf_hi(mq.x) + a0[1] * bf_hi(gq.x) * rs, v2 = bf_lo(mq.y) + a0[2] * bf_lo(gq.y) * rs, v3 = bf_hi(mq.y) + a0[3] * bf_hi(gq.y) * rs;
                    const float v4 = bf_lo(mq.z) + a1[0] * bf_lo(gq.z) * rs, v5 = bf_hi(mq.z) + a1[1] * bf_hi(gq.z) * rs, v6 = bf_lo(mq.w) + a1[2] * bf_lo(gq.w) * rs, v7 = bf_hi(mq.w) + a1[3] * bf_hi(gq.w) * rs;
                    u32x4 w; w.x = cvt_pk_bf16(v0, v1); w.y = cvt_pk_bf16(v2, v3); w.z = cvt_pk_bf16(v4, v5); w.w = cvt_pk_bf16(v6, v7);
                    *(u32x4*)(mg + (size_t)row * 1024 + mcol0 + bj * HALF) = w; } }
            asm volatile("" ::: "memory");
        }
    }
};
struct BranchOrder {
    int G, c;
    __host__ __device__ void init(int G_, int c_) { G = G_; c = c_; }
    __host__ __device__ bool next(int i, Unit& u) const { if (c >= 192 || i >= 4) return false; u.pm = c >> 2; u.pn = i * 4 + (c & 3); return true; }
    __device__ __forceinline__ void a_ready(const Unit&) const {}
    __device__ __forceinline__ void done(const Unit&) const {}
};
struct EpiRes {
    static constexpr bool PERM = false, AFTER_DRAIN = false;
    const float* base_ctx; const float* base_lat;
    float* out; const float* modv;
    int goff;
    __device__ __forceinline__ void operator()(const f32x4 (&acc)[2][2][4][2], const Unit& u, int wr, int wc, int fr, int fq) const {
        const int row0 = u.pm * BM + wr * 64 + fr, col0 = u.pn * BM + wc * 32 + 4 * fq;
        const int mi = (u.pm < 32) ? 0 : 1 + ((u.pm - 32) >> 2);
        const float* gv = modv + (size_t)mi * 6144 + goff;
        f32x4 gg[2][2];
#pragma unroll
        for (int bj = 0; bj < 2; ++bj)
#pragma unroll
            for (int n = 0; n < 2; ++n) gg[bj][n] = *(const f32x4*)(gv + col0 + bj * HALF + n * 16);
#pragma unroll
        for (int ai = 0; ai < 2; ++ai) {
            f32x4 pre[4][2][2];
#pragma unroll
            for (int m = 0; m < 4; ++m) { const int row = row0 + ai * HALF + m * 16;
                const float* bp = (row < 8192 ? base_ctx + (size_t)row * 1024 : base_lat + (size_t)(row - 8192) * 1024) + col0;
#pragma unroll
                for (int bj = 0; bj < 2; ++bj)
#pragma unroll
                    for (int n = 0; n < 2; ++n) pre[m][bj][n] = *(const f32x4*)(bp + bj * HALF + n * 16); }
#pragma unroll
            for (int m = 0; m < 4; ++m) { const int row = row0 + ai * HALF + m * 16; float* op = out + (size_t)row * 1024 + col0;
#pragma unroll
                for (int bj = 0; bj < 2; ++bj)
#pragma unroll
                    for (int n = 0; n < 2; ++n) *(f32x4*)(op + bj * HALF + n * 16) = pre[m][bj][n] + gg[bj][n] * acc[ai][bj][m][n]; }
            asm volatile("" ::: "memory");
        }
    }
};

template <class Epi, class Sched, bool ALIGN_EPI = false, bool SP2 = false>
__device__ __forceinline__ void gemm_phase(PG8_LAS unsigned char* lds, const Gemm g, const Sched& S, const Epi& E, const int tid) {
    const int wid = __builtin_amdgcn_readfirstlane(tid >> 6), lane = tid & 63, wr = wid >> 2, wc = wid & 3, fr = lane & 15, fq = lane >> 4;
    const int K = g.K, nt = K / BK;
    unsigned voffA[2], voffB[2];
#pragma unroll
    for (int i = 0; i < 2; ++i) { int R, C; stage_rc(tid * 16 + i * 8192, R, C); const int Rb = Epi::PERM ? ((R & ~31) + perm32(R & 31)) : R;
        voffA[i] = (unsigned)(R * g.lda + C) * 2u; voffB[i] = (unsigned)(Rb * g.ldb + C) * 2u; }
    const size_t kstep = (size_t)(BK * 2);
    const size_t hstepA = (size_t)HALF * g.lda * 2, hstepB = (size_t)HALF * g.ldb * 2;
    const size_t tstepA = 2 * hstepA, tstepB = 2 * hstepB;
#define PG8_UA(u) ((const char*)g.A + (size_t)(u).pm * tstepA + (g.a_div ? (size_t)((u).pn / g.a_div) * g.a_gstride : (size_t)0))
#define PG8_UB(u) ((const char*)g.Bt + (size_t)(u).pn * tstepB)
    const unsigned ldsw = (unsigned)wid * 1024u;
    const int aoff = lds_byte(wr * 64 + fr, fq * 8), boff = lds_byte(wc * 32 + fr, fq * 8);
#define PG8_SA(b, h) (((b) * 2 + (h)) * HTB)
#define PG8_SB(b, h) ((4 + (b) * 2 + (h)) * HTB)
#define PG8_STAGE(bufoff, gbase, voff) do { _Pragma("unroll") for (int _i = 0; _i < 2; ++_i) \
        __builtin_amdgcn_global_load_lds((const unsigned*)((const char*)(gbase) + (voff)[_i]), (PG8_LAS unsigned*)(lds + (bufoff) + ldsw + _i * 8192), 16, 0, 0); } while (0)
#define PG8_LDA(dst, b, h) do { _Pragma("unroll") for (int m = 0; m < 4; ++m) _Pragma("unroll") for (int k = 0; k < 2; ++k) dst[m][k] = *(const PG8_LAS bf16x8*)(lds + PG8_SA(b, h) + aoff + m * 2048 + k * 1024); } while (0)
#define PG8_LDB(dst, b, h) do { _Pragma("unroll") for (int n = 0; n < 2; ++n) _Pragma("unroll") for (int k = 0; k < 2; ++k) dst[n][k] = *(const PG8_LAS bf16x8*)(lds + PG8_SB(b, h) + boff + n * 2048 + k * 1024); } while (0)
#define PG8_MMA(ai, bj, At, Bt) do { __builtin_amdgcn_s_setprio(1); _Pragma("unroll") for (int m = 0; m < 4; ++m) _Pragma("unroll") for (int n = 0; n < 2; ++n) _Pragma("unroll") for (int k = 0; k < 2; ++k) \
        acc[ai][bj][m][n] = __builtin_amdgcn_mfma_f32_16x16x32_bf16(Bt[n][k], At[m][k], acc[ai][bj][m][n], 0, 0, 0); __builtin_amdgcn_s_setprio(0); } while (0)
#define PG8_WAIT_V(n) asm volatile("s_waitcnt vmcnt(" #n ")" ::: "memory")
#define PG8_WAIT_L(n) asm volatile("s_waitcnt lgkmcnt(" #n ")" ::: "memory")
#define PG8_BAR __builtin_amdgcn_s_barrier()
#define PG8_SCHED __builtin_amdgcn_sched_barrier(0)
    Unit cur, nxt; int ui = 0;
    if (!S.next(0, cur)) return;
    f32x4 acc[2][2][4][2];
#pragma unroll
    for (int a = 0; a < 2; ++a)
#pragma unroll
        for (int b = 0; b < 2; ++b)
#pragma unroll
            for (int m = 0; m < 4; ++m)
#pragma unroll
                for (int n = 0; n < 2; ++n) acc[a][b][m][n] = (f32x4){0.f, 0.f, 0.f, 0.f};
    bf16x8 At[4][2], B0[2][2], B1[2][2];
    const char* cA = PG8_UA(cur); const char* cB = PG8_UB(cur);
    S.a_ready(cur);
    if constexpr (SP2) {
        PG8_STAGE(PG8_SB(0, 0), cB, voffB); PG8_STAGE(PG8_SB(0, 1), cB + hstepB, voffB); PG8_STAGE(PG8_SA(0, 0), cA, voffA); PG8_STAGE(PG8_SA(0, 1), cA + hstepA, voffA);
        if (wr == 1) PG8_BAR;
        PG8_WAIT_V(2); PG8_BAR;
        PG8_STAGE(PG8_SB(1, 0), cB + kstep, voffB); PG8_STAGE(PG8_SA(1, 0), cA + kstep, voffA); PG8_STAGE(PG8_SB(1, 1), cB + hstepB + kstep, voffB);
        PG8_WAIT_V(6); PG8_BAR;
    } else {
        PG8_STAGE(PG8_SB(0, 0), cB, voffB); PG8_STAGE(PG8_SA(0, 0), cA, voffA); PG8_STAGE(PG8_SB(0, 1), cB + hstepB, voffB); PG8_STAGE(PG8_SA(0, 1), cA + hstepA, voffA);
        if (wr == 1) PG8_BAR;
        PG8_WAIT_V(4); PG8_BAR;
        PG8_STAGE(PG8_SB(1, 0), cB + kstep, voffB); PG8_STAGE(PG8_SA(1, 0), cA + kstep, voffA); PG8_STAGE(PG8_SB(1, 1), cB + hstepB + kstep, voffB);
        PG8_WAIT_V(6); PG8_BAR;
    }
    for (;;) {
        const bool has_next = S.next(ui + 1, nxt);
        const char* nA = has_next ? PG8_UA(nxt) : cA; const char* nB = has_next ? PG8_UB(nxt) : cB;
        for (int t = 0; t < nt; t += 2) {
            const bool last = (t == nt - 2);
            const char* a1 = cA + (size_t)(t + 1) * kstep;
            const char* a2 = last ? nA : cA + (size_t)(t + 2) * kstep; const char* b2 = last ? nB : cB + (size_t)(t + 2) * kstep;
            const char* a3 = a2 + kstep; const char* b3 = b2 + kstep;
            if (last && has_next) S.a_ready(nxt);
            if constexpr (SP2) {
            PG8_LDB(B0, 0, 0); PG8_LDB(B1, 0, 1); PG8_SCHED; PG8_LDA(At, 0, 0); PG8_STAGE(PG8_SA(1, 1), a1 + hstepA, voffA);
            PG8_WAIT_V(8); PG8_WAIT_L(0); PG8_BAR; PG8_MMA(0, 0, At, B0); PG8_MMA(0, 1, At, B1); PG8_BAR; PG8_SCHED;
            PG8_LDA(At, 0, 1); PG8_STAGE(PG8_SB(0, 0), b2, voffB); PG8_STAGE(PG8_SB(0, 1), b2 + hstepB, voffB); PG8_STAGE(PG8_SA(0, 0), a2, voffA);
            PG8_WAIT_V(8); PG8_WAIT_L(0); PG8_BAR; PG8_MMA(1, 0, At, B0); PG8_MMA(1, 1, At, B1); PG8_BAR; PG8_SCHED;
            PG8_LDB(B0, 1, 0); PG8_LDB(B1, 1, 1); PG8_SCHED; PG8_LDA(At, 1, 0); PG8_STAGE(PG8_SA(0, 1), a2 + hstepA, voffA);
            PG8_WAIT_V(8); PG8_WAIT_L(0); PG8_BAR; PG8_MMA(0, 0, At, B0); PG8_MMA(0, 1, At, B1); PG8_BAR; PG8_SCHED;
            PG8_LDA(At, 1, 1); PG8_STAGE(PG8_SB(1, 0), b3, voffB); PG8_STAGE(PG8_SB(1, 1), b3 + hstepB, voffB); PG8_STAGE(PG8_SA(1, 0), a3, voffA);
            PG8_WAIT_V(8); PG8_WAIT_L(0); PG8_BAR; PG8_MMA(1, 0, At, B0); PG8_MMA(1, 1, At, B1); PG8_BAR; PG8_SCHED;
            } else {
            PG8_LDB(B0, 0, 0); PG8_SCHED; PG8_LDA(At, 0, 0); PG8_STAGE(PG8_SA(1, 1), a1 + hstepA, voffA);
            PG8_WAIT_L(8); PG8_BAR; PG8_WAIT_L(0); PG8_MMA(0, 0, At, B0); PG8_BAR; PG8_SCHED;
            PG8_LDB(B1, 0, 1); PG8_STAGE(PG8_SB(0, 0), b2, voffB);
            PG8_BAR; PG8_WAIT_L(0); PG8_MMA(0, 1, At, B1); PG8_BAR;
            PG8_LDA(At, 0, 1); PG8_STAGE(PG8_SA(0, 0), a2, voffA);
            PG8_BAR; PG8_WAIT_L(0); PG8_MMA(1, 0, At, B0); PG8_BAR; PG8_SCHED;
            PG8_STAGE(PG8_SB(0, 1), b2 + hstepB, voffB);
            PG8_WAIT_V(6); PG8_BAR; PG8_MMA(1, 1, At, B1); PG8_BAR;
            PG8_LDB(B0, 1, 0); PG8_SCHED; PG8_LDA(At, 1, 0); PG8_STAGE(PG8_SA(0, 1), a2 + hstepA, voffA);
            PG8_WAIT_L(8); PG8_BAR; PG8_WAIT_L(0); PG8_MMA(0, 0, At, B0); PG8_BAR; PG8_SCHED;
            PG8_LDB(B1, 1, 1); PG8_STAGE(PG8_SB(1, 0), b3, voffB);
            PG8_BAR; PG8_WAIT_L(0); PG8_MMA(0, 1, At, B1); PG8_BAR;
            PG8_LDA(At, 1, 1); PG8_STAGE(PG8_SA(1, 0), a3, voffA);
            PG8_BAR; PG8_WAIT_L(0); PG8_MMA(1, 0, At, B0); PG8_BAR; PG8_SCHED;
            PG8_STAGE(PG8_SB(1, 1), b3 + hstepB, voffB);
            PG8_WAIT_V(6); PG8_BAR; PG8_MMA(1, 1, At, B1); PG8_BAR;
            }
        }
        if constexpr (ALIGN_EPI) { if (wr == 0) PG8_BAR; }
        if constexpr (!Epi::AFTER_DRAIN) { E(acc, cur, wr, wc, fr, fq); S.done(cur); }
        if (!has_next) break;
#pragma unroll
        for (int a = 0; a < 2; ++a)
#pragma unroll
            for (int b = 0; b < 2; ++b)
#pragma unroll
                for (int m = 0; m < 4; ++m)
#pragma unroll
                    for (int n = 0; n < 2; ++n) acc[a][b][m][n] = (f32x4){0.f, 0.f, 0.f, 0.f};
        cur = nxt; cA = nA; cB = nB; ++ui;
        if constexpr (ALIGN_EPI) { if (wr == 1) PG8_BAR; }
    }
    PG8_WAIT_V(0);
    if constexpr (!ALIGN_EPI) { if (wr == 0) PG8_BAR; }
    PG8_BAR;
    if constexpr (Epi::AFTER_DRAIN) { E.fused(acc, cur, wr, wc, fr, fq, lds, wid, lane); S.done(cur); }
#undef PG8_UA
#undef PG8_UB
#undef PG8_SA
#undef PG8_SB
#undef PG8_STAGE
#undef PG8_LDA
#undef PG8_LDB
#undef PG8_MMA
#undef PG8_WAIT_V
#undef PG8_WAIT_L
#undef PG8_BAR
#undef PG8_SCHED
}
}

#ifndef PG8_SP2
#define PG8_SP2 true
#endif
#ifndef PG8_ALIGN
#define PG8_ALIGN true
#endif

typedef unsigned short bf16;
typedef unsigned v4u __attribute__((ext_vector_type(4)));
typedef unsigned v2u __attribute__((ext_vector_type(2)));
typedef float f32x4 __attribute__((ext_vector_type(4)));
#define LAS __attribute__((address_space(3)))

constexpr int NWAVES = 8, NTHR = 512;
constexpr int D = 1024, MC = 8192, ML = 4096, M = 12288, NPH = 23;
constexpr int LDS_BYTES = 147456;
constexpr float EPS = 1e-6f;
constexpr size_t MiB = 1u << 20;
constexpr size_t WS_MOD = 64 * 1024;
constexpr size_t WS_SSQ = 320 * 1024;
constexpr size_t WS_DT = 384 * 1024;
constexpr size_t WS_W = 2 * MiB;
constexpr size_t W_IN = WS_W, W_G = W_IN + 8 * MiB, W_GLU = W_G + 8 * MiB, W_BR = W_GLU + 1 * MiB, W_OUT = W_BR + 4 * MiB, W_1 = W_OUT + 2 * MiB, W_2 = W_1 + 8 * MiB;
constexpr size_t WS_H = 41 * MiB;
constexpr size_t WS_R1 = 65 * MiB;
constexpr size_t WS_Y = 161 * MiB;
constexpr size_t WS_Y5 = 209 * MiB;
constexpr size_t WS_XC = 221 * MiB;
constexpr size_t WS_S5K = 239 * MiB;
constexpr size_t WS_S5WS = 240 * MiB;
constexpr size_t WS_S5WO = 244 * MiB;
constexpr size_t WS_S5AT = 248 * MiB;
constexpr size_t WS_CKV = 248 * MiB + 512 * 1024;
constexpr size_t WS_ROPE = 1536 * 1024;
constexpr size_t WS_WDT = 1792 * 1024;
constexpr size_t WS_BI2 = 1824 * 1024;
constexpr size_t WS_SSQ2 = 1904 * 1024;
constexpr size_t WS_END = 254 * MiB;
#ifndef PROBE_SEL
#define PROBE_SEL -1
#endif
#ifndef PROBE_SCALE
#define PROBE_SCALE 4e-4f
#endif
#ifndef PROBE_PB
#define PROBE_PB 32
#endif
constexpr size_t WS_BAR = 32 * 1024;
constexpr size_t WS_QCTR = 48 * 1024;
constexpr size_t WS_TS = 16 * 1024;
constexpr size_t O_SSD = 12582912, O_S5 = 16777216, O_DK = 17301504, O_DV = 25690112, O_WK = 34078720, O_WV = 36175872;
constexpr int C_Z = 0, C_XBC = 512, C_U = 1280, C_DQ = 1792, C_DK = 2304, C_DV = 2816, C_WQ = 3328, C_WK = 3840, C_WV = 3968;

struct Args { const float* in[44]; float* out; unsigned char* ws; int ph_lo, ph_hi; };

typedef const Args __attribute__((address_space(4)))* CArgs;
struct Ctx {
    CArgs ap; int tid, lane, wave;
    __device__ __forceinline__ const float* x_prompt() const { return ap->in[0]; }
    __device__ __forceinline__ const float* x_sample() const { return ap->in[1]; }
    __device__ __forceinline__ const float* state_ssd() const { return ap->in[2]; }
    __device__ __forceinline__ const float* state_s5() const { return ap->in[3]; }
    __device__ __forceinline__ const float* cache_dk() const { return ap->in[4]; }
    __device__ __forceinline__ const float* cache_dv() const { return ap->in[5]; }
    __device__ __forceinline__ const float* cache_wk() const { return ap->in[6]; }
    __device__ __forceinline__ const float* cache_wv() const { return ap->in[7]; }
    __device__ __forceinline__ const float* cvec() const { return ap->in[8]; }
    __device__ __forceinline__ const float* c_ctx() const { return ap->in[9]; }
    __device__ __forceinline__ const float* w_mod() const { return ap->in[10]; }
    __device__ __forceinline__ const float* b_mod() const { return ap->in[11]; }
    __device__ __forceinline__ const float* g_norm1() const { return ap->in[12]; }
    __device__ __forceinline__ const float* g_norm2() const { return ap->in[13]; }
    __device__ __forceinline__ const float* w_in() const { return ap->in[14]; }
    __device__ __forceinline__ const float* conv_w() const { return ap->in[15]; }
    __device__ __forceinline__ const float* conv_b() const { return ap->in[16]; }
    __device__ __forceinline__ const float* dt_bias() const { return ap->in[17]; }
    __device__ __forceinline__ const float* a_log() const { return ap->in[18]; }
    __device__ __forceinline__ const float* ssd_d() const { return ap->in[19]; }
    __device__ __forceinline__ const float* ssd_norm_g() const { return ap->in[20]; }
    __device__ __forceinline__ const float* lam_re() const { return ap->in[21]; }
    __device__ __forceinline__ const float* lam_im() const { return ap->in[22]; }
    __device__ __forceinline__ const float* log_step() const { return ap->in[23]; }
    __device__ __forceinline__ const float* b_re() const { return ap->in[24]; }
    __device__ __forceinline__ const float* b_im() const { return ap->in[25]; }
    __device__ __forceinline__ const float* c_re() const { return ap->in[26]; }
    __device__ __forceinline__ const float* c_im() const { return ap->in[27]; }
    __device__ __forceinline__ const float* s5_d() const { return ap->in[28]; }
    __device__ __forceinline__ const float* w_glu() const { return ap->in[29]; }
    __device__ __forceinline__ const float* b_glu() const { return ap->in[30]; }
    __device__ __forceinline__ const float* qn_g() const { return ap->in[31]; }
    __device__ __forceinline__ const float* kn_g() const { return ap->in[32]; }
    __device__ __forceinline__ const float* dlam() const { return ap->in[33]; }
    __device__ __forceinline__ const float* subln_g() const { return ap->in[34]; }
    __device__ __forceinline__ const float* wqn_g() const { return ap->in[35]; }
    __device__ __forceinline__ const float* wkn_g() const { return ap->in[36]; }
    __device__ __forceinline__ const float* sink() const { return ap->in[37]; }
    __device__ __forceinline__ const float* w_branch() const { return ap->in[38]; }
    __device__ __forceinline__ const float* w_gate() const { return ap->in[39]; }
    __device__ __forceinline__ const float* b_gate() const { return ap->in[40]; }
    __device__ __forceinline__ const float* w_out() const { return ap->in[41]; }
    __device__ __forceinline__ const float* w_fc1() const { return ap->in[42]; }
    __device__ __forceinline__ const float* w_fc2() const { return ap->in[43]; }
    __device__ __forceinline__ float* out() const { return ap->out; }
    __device__ __forceinline__ unsigned char* ws() const { return ap->ws; }
    __device__ __forceinline__ float* MOD() const { return (float*)(ap->ws + WS_MOD); }
    __device__ __forceinline__ float* SSQ() const { return (float*)(ap->ws + WS_SSQ); }
    __device__ __forceinline__ float* DT() const { return (float*)(ap->ws + WS_DT); }
    __device__ __forceinline__ bf16* H() const { return (bf16*)(ap->ws + WS_H); }
    __device__ __forceinline__ bf16* R1() const { return (bf16*)(ap->ws + WS_R1); }
    __device__ __forceinline__ bf16* Y() const { return (bf16*)(ap->ws + WS_Y); }
    __device__ __forceinline__ bf16* Y5() const { return (bf16*)(ap->ws + WS_Y5); }
    __device__ __forceinline__ bf16* XC() const { return (bf16*)(ap->ws + WS_XC); }
    __device__ __forceinline__ bf16* CKV() const { return (bf16*)(ap->ws + WS_CKV); }
    __device__ __forceinline__ float* ROPE() const { return (float*)(ap->ws + WS_ROPE); }
};

__device__ __forceinline__ float wave_sum(float v) {
#pragma unroll
    for (int o = 1; o < 64; o <<= 1) v += __shfl_xor(v, o);
    return v;
}
__device__ __forceinline__ float wave_max(float v) {
#pragma unroll
    for (int o = 1; o < 64; o <<= 1) v = fmaxf(v, __shfl_xor(v, o));
    return v;
}
__device__ __forceinline__ float bf2f(bf16 h) { return __builtin_bit_cast(float, (unsigned)h << 16); }
__device__ __forceinline__ float bflo(unsigned w) { return __builtin_bit_cast(float, w << 16); }
__device__ __forceinline__ float bfhi(unsigned w) { return __builtin_bit_cast(float, w & 0xffff0000u); }
__device__ __forceinline__ unsigned f2bf(float f) { unsigned u = __builtin_bit_cast(unsigned, f); return (u + 0x7fffu + ((u >> 16) & 1u)) >> 16; }
__device__ __forceinline__ unsigned pk2(float lo, float hi) { return f2bf(lo) | (f2bf(hi) << 16); }
__device__ __forceinline__ float siluf(float x) { return x / (1.0f + __expf(-x)); }
__device__ __forceinline__ void unpack8(const v4u q, float (&f)[8]) { f[0] = bflo(q.x); f[1] = bfhi(q.x); f[2] = bflo(q.y); f[3] = bfhi(q.y); f[4] = bflo(q.z); f[5] = bfhi(q.z); f[6] = bflo(q.w); f[7] = bfhi(q.w); }

__device__ __forceinline__ void phase_mods(const Ctx& c, float* lf) {
    for (int i = c.tid; i < 5 * 1024; i += NTHR) { const int v = i >> 10, k = i & 1023; const float x = (v == 0) ? c.c_ctx()[k] : c.cvec()[(v - 1) * 1024 + k]; lf[i] = siluf(x); }
    __syncthreads();
    float* red = lf + 5 * 1024;
    for (int u = blockIdx.x; u < 192; u += gridDim.x) {
        const int l = u / 96, col0 = (u % 96) * 64;
        const float* W = c.w_mod() + (size_t)l * 1024 * 6144 + col0 + c.lane;
        float acc[5] = {0.f, 0.f, 0.f, 0.f, 0.f};
#pragma unroll 1
        for (int kb = c.wave * 128; kb < c.wave * 128 + 128; kb += 32) {
            float wv[32];
#pragma unroll
            for (int j = 0; j < 32; ++j) wv[j] = W[(size_t)(kb + j) * 6144];
#pragma unroll
            for (int j = 0; j < 32; ++j)
#pragma unroll
                for (int i = 0; i < 5; ++i) acc[i] += lf[i * 1024 + kb + j] * wv[j]; }
#pragma unroll
        for (int i = 0; i < 5; ++i) red[(c.wave * 5 + i) * 64 + c.lane] = acc[i];
        __syncthreads();
        if (c.tid < 320) { const int i = c.tid >> 6, ln = c.tid & 63; float s = c.b_mod()[l * 6144 + col0 + ln];
#pragma unroll
            for (int w = 0; w < 8; ++w) s += red[(w * 5 + i) * 64 + ln];
            c.MOD()[(size_t)(l * 5 + i) * 6144 + col0 + ln] = s; }
        __syncthreads();
    }
}

__device__ __forceinline__ int cmap(int mode, int n) { return mode == 0 ? n : (mode == 1 ? (n < 1280 ? n : n + 16) : ((n & 255) < 128 ? 128 * (n >> 8) + (n & 127) : 512 + 128 * (n >> 8) + (n & 127))); }
__device__ __forceinline__ void transpose_item(const float* W, int ld, int K, int N, int mode, const float* rowscale, bf16* WT, float* scr, int item, int lane) {
    const int nblk = N / 32, kb = item / nblk, nb = item % nblk, k0 = 64 * kb, n0 = 32 * nb, sc0 = cmap(mode, n0);
    float tv[32];
#pragma unroll
    for (int i = 0; i < 32; ++i) tv[i] = W[(size_t)(k0 + 2 * i + (lane >> 5)) * ld + sc0 + (lane & 31)];
    if (rowscale) {
#pragma unroll
        for (int i = 0; i < 32; ++i) tv[i] *= rowscale[k0 + 2 * i + (lane >> 5)]; }
#pragma unroll
    for (int i = 0; i < 32; ++i) scr[(2 * i + (lane >> 5)) * 33 + (lane & 31)] = tv[i];
    __builtin_amdgcn_fence(__ATOMIC_RELEASE, "wavefront"); __builtin_amdgcn_wave_barrier();
    const int ch = lane & 7;
#pragma unroll
    for (int j = 0; j < 4; ++j) { const int n = (lane >> 3) + 8 * j; const float* s = scr + (8 * ch) * 33 + n;
        v4u o; o.x = pk2(s[0 * 33], s[1 * 33]); o.y = pk2(s[2 * 33], s[3 * 33]); o.z = pk2(s[4 * 33], s[5 * 33]); o.w = pk2(s[6 * 33], s[7 * 33]);
        *(v4u*)(WT + (size_t)(n0 + n) * K + k0 + 8 * ch) = o; }
    __builtin_amdgcn_fence(__ATOMIC_RELEASE, "wavefront"); __builtin_amdgcn_wave_barrier();
}
__device__ __forceinline__ void s5_tables(const Ctx& c, int l, int g, int part, float* lf);
__device__ __forceinline__ void convert_items(const Ctx& c, int l, int lo, int hi, int gw0, int ngw, bool tabs, int tb0, int ntb, float* lf) {
    unsigned char* ws = c.ws();
    if (tabs) {
        for (int t = tb0; t < 128; t += ntb) s5_tables(c, l, t & 31, t >> 5, lf);
        for (int i = tb0 * NTHR + c.tid; i < 16384; i += ntb * NTHR) { const int j = i >> 10, k = i & 1023; ((bf16*)(ws + WS_WDT))[i] = (bf16)f2bf(c.w_in()[(size_t)l * 1024 * 4112 + (size_t)k * 4112 + 1280 + j]); }
    }
    float* scr = lf + c.wave * 2176;
    for (int it = lo + gw0; it < hi; it += ngw) {
        int r = it;
        if (r < 2048) { transpose_item(c.w_in() + (size_t)l * 1024 * 4112, 4112, 1024, 4096, 1, nullptr, (bf16*)(ws + W_IN), scr, r, c.lane); continue; } r -= 2048;
        if (r < 2048) { transpose_item(c.w_gate() + (size_t)l * 1024 * 4096, 4096, 1024, 4096, 0, nullptr, (bf16*)(ws + W_G), scr, r, c.lane); continue; } r -= 2048;
        if (r < 256) { transpose_item(c.w_glu() + (size_t)l * 512 * 1024, 1024, 512, 1024, 2, nullptr, (bf16*)(ws + W_GLU), scr, r, c.lane); continue; } r -= 256;
        if (r < 1024) { const int i = r >> 8; transpose_item(c.w_branch() + (size_t)(l * 4 + i) * 512 * 1024, 1024, 512, 1024, 0, i == 0 ? c.ssd_norm_g() + l * 512 : nullptr, (bf16*)(ws + W_BR) + (size_t)i * 1024 * 512, scr, r & 255, c.lane); continue; } r -= 1024;
        if (r < 512) { transpose_item(c.w_out() + (size_t)l * 1024 * 1024, 1024, 1024, 1024, 0, nullptr, (bf16*)(ws + W_OUT), scr, r, c.lane); continue; } r -= 512;
        if (r < 2048) { transpose_item(c.w_fc1() + (size_t)l * 1024 * 4096, 4096, 1024, 4096, 0, nullptr, (bf16*)(ws + W_1), scr, r, c.lane); continue; } r -= 2048;
        transpose_item(c.w_fc2() + (size_t)l * 4096 * 1024, 1024, 4096, 1024, 0, nullptr, (bf16*)(ws + W_2), scr, r, c.lane);
    }
}
__device__ __forceinline__ void phase_convert(const Ctx& c, int l, float* lf) {
    if (gridDim.x == 256) convert_items(c, l, 0, 9984, blockIdx.x * NWAVES + c.wave, gridDim.x * NWAVES, true, blockIdx.x >= 192 ? (int)blockIdx.x - 192 : 100000, 64, lf);
    else convert_items(c, l, 0, 9984, blockIdx.x * NWAVES + c.wave, gridDim.x * NWAVES, true, blockIdx.x, gridDim.x, lf);
}
__device__ __forceinline__ void side_convert(const Ctx& c, int lo, int hi, bool tabs, float* lf) {
    if (blockIdx.x < 192 || gridDim.x != 256) return;
    convert_items(c, 1, lo, hi, (blockIdx.x - 192) * NWAVES + c.wave, 64 * NWAVES, tabs, blockIdx.x - 192, 64, lf);
}

__device__ __forceinline__ void phase_norm(const Ctx& c, int l, int which, float* lf) {
    const int gw = blockIdx.x * NWAVES + c.wave, NGW = gridDim.x * NWAVES;
    const float* gn = (which == 0 ? c.g_norm1() : c.g_norm2()) + l * 1024;
    for (int m = gw; m < M; m += NGW) {
        const float* xr = (l == 0 && which == 0) ? (m < MC ? c.x_prompt() + (size_t)m * D : c.x_sample() + (size_t)(m - MC) * D) : c.out() + (size_t)m * D;
        const int mi = (m < MC) ? 0 : 1 + ((m - MC) >> 10);
        const float* mod = c.MOD() + (size_t)(l * 5 + mi) * 6144 + which * 3072;
        f32x4 v[4]; float s = 0.f;
#pragma unroll
        for (int j = 0; j < 4; ++j) { v[j] = *(const f32x4*)(xr + 4 * c.lane + 256 * j); s += (v[j].x * v[j].x + v[j].y * v[j].y) + (v[j].z * v[j].z + v[j].w * v[j].w); }
        const float rstd = rsqrtf(wave_sum(s) * (1.0f / D) + EPS);
#pragma unroll
        for (int j = 0; j < 4; ++j) { const int k = 4 * c.lane + 256 * j; const f32x4 g = *(const f32x4*)(gn + k), sh = *(const f32x4*)(mod + k), sc = *(const f32x4*)(mod + 1024 + k);
            v[j] = v[j] * rstd * g * (sc + 1.0f) + sh;
            v2u o; o.x = pk2(v[j].x, v[j].y); o.y = pk2(v[j].z, v[j].w); *(v2u*)(c.H() + (size_t)m * D + k) = o; }
        if (which == 0) {
            if (c.lane == 0) { c.SSQ()[m] = 0.f; ((float*)(c.ws() + WS_SSQ2))[m] = 0.f; }
        }
    }
}

__device__ __forceinline__ void phase_bias2(const Ctx& c, int l) {
    const int gw = blockIdx.x * NWAVES + c.wave, NGW = gridDim.x * NWAVES, lane = c.lane;
    const bf16* W1t = (const bf16*)(c.ws() + W_1); float* bi = (float*)(c.ws() + WS_BI2);
    for (int n = gw; n < 4096; n += NGW) {
        float wf[16]; { float t8[8]; unpack8(*(const v4u*)(W1t + (size_t)n * 1024 + 8 * lane), t8);
#pragma unroll
            for (int j = 0; j < 8; ++j) wf[j] = t8[j];
            unpack8(*(const v4u*)(W1t + (size_t)n * 1024 + 512 + 8 * lane), t8);
#pragma unroll
            for (int j = 0; j < 8; ++j) wf[8 + j] = t8[j]; }
#pragma unroll 1
        for (int mi = 0; mi < 5; ++mi) { const float* sh = c.MOD() + (size_t)(l * 5 + mi) * 6144 + 3072; float a = 0.f;
#pragma unroll
            for (int hh = 0; hh < 2; ++hh) { const f32x4 s0 = *(const f32x4*)(sh + 512 * hh + 8 * lane), s1 = *(const f32x4*)(sh + 512 * hh + 8 * lane + 4);
                a += (wf[8 * hh + 0] * s0.x + wf[8 * hh + 1] * s0.y) + (wf[8 * hh + 2] * s0.z + wf[8 * hh + 3] * s0.w) + (wf[8 * hh + 4] * s1.x + wf[8 * hh + 5] * s1.y) + (wf[8 * hh + 6] * s1.z + wf[8 * hh + 7] * s1.w); }
            a = wave_sum(a); if (lane == 0) bi[mi * 4096 + n] = a; }
    }
}

__device__ __forceinline__ void phase_dt(const Ctx& c, int l) {
    const int tile = blockIdx.x * 3 + c.wave;
    if (c.wave < 3 && tile < 768) {
    const int lr = c.lane & 15, lq = c.lane >> 4;
    const bf16* ap = c.H() + (size_t)(16 * tile + lr) * 1024 + 8 * lq; const bf16* bp = (const bf16*)(c.ws() + WS_WDT) + (size_t)lr * 1024 + 8 * lq;
    f32x4 acc = {0.f, 0.f, 0.f, 0.f};
#pragma unroll 8
    for (int ks = 0; ks < 32; ++ks) acc = __builtin_amdgcn_mfma_f32_16x16x32_bf16(*(const pg8::bf16x8*)(ap + 32 * ks), *(const pg8::bf16x8*)(bp + 32 * ks), acc, 0, 0, 0);
    const float bias = c.dt_bias()[l * 16 + lr];
#pragma unroll
    for (int r = 0; r < 4; ++r) { const float x = acc[r] + bias; c.DT()[(size_t)(16 * tile + 4 * lq + r) * 16 + lr] = x > 20.f ? x : log1pf(__expf(x)); }
    }
}

__device__ __forceinline__ void phase_rope_table(const Ctx& c) {
    const int gt = blockIdx.x * NTHR + c.tid;
    if (gt < 32768) { const int pos = gt >> 5, a = gt & 31, f = a & 15; const float inv = exp2f(-(float)f * 0.8304820237218406f);
        const float ang = (float)((a >> 4) ? (pos & 63) : (pos >> 6)) * inv; float sn, cs; sincosf(ang, &sn, &cs); c.ROPE()[pos * 64 + a] = cs; c.ROPE()[pos * 64 + 32 + a] = sn; }
}
__device__ __forceinline__ void phase_ckv(const Ctx& c) {
    const int gw = blockIdx.x * NWAVES + c.wave, NGW = gridDim.x * NWAVES, lane = c.lane;
    for (int r = gw; r < 2048; r += NGW) { const int l = r >> 10, b = (r >> 8) & 3, sidx = r & 255; const size_t cb = (size_t)(b * 2 + l) * 256 + sidx; bf16* dst = c.CKV() + (size_t)r * 1280;
#pragma unroll
        for (int i = 0; i < 5; ++i) { const int e = 4 * (lane + 64 * i);
            const float* src = e < 512 ? c.cache_dk() + cb * 512 + e : e < 1024 ? c.cache_dv() + cb * 512 + (e - 512) : e < 1152 ? c.cache_wk() + cb * 128 + (e - 1024) : c.cache_wv() + cb * 128 + (e - 1152);
            const f32x4 v = *(const f32x4*)src; v2u o; o.x = pk2(v.x, v.y); o.y = pk2(v.z, v.w); *(v2u*)(dst + e) = o; } }
}
__device__ __forceinline__ void phase_qk(const Ctx& c, int l, float* lf) {
    const int gw = blockIdx.x * NWAVES + c.wave, NGW = gridDim.x * NWAVES, lane = c.lane, l16 = lane & 15, grp = lane >> 4;
    for (int i = c.tid; i < 7 * 768; i += NTHR) lf[i] = c.conv_w()[(size_t)l * 7 * 768 + i];
    for (int i = c.tid; i < 768; i += NTHR) lf[7 * 768 + i] = c.conv_b()[l * 768 + i];
    __syncthreads();
    const f32x4 gq = *(const f32x4*)(c.qn_g() + l * 64 + 4 * l16), gk = *(const f32x4*)(c.kn_g() + l * 64 + 4 * l16), gwq = *(const f32x4*)(c.wqn_g() + l * 64 + 4 * l16), gwk = *(const f32x4*)(c.wkn_g() + l * 64 + 4 * l16);
    bf16* R1p = c.R1(); float* outp = c.out(); bf16* XCp = c.XC();
    for (int m = gw; m < M; m += NGW) {
        bf16* pr = R1p + (size_t)m * 4096;
        const bool lat = m >= MC;
        const int b = lat ? (m - MC) >> 10 : m >> 8, t = lat ? (m - MC) & 1023 : m & 255, L = lat ? 1024 : 256;
        const size_t ob = (size_t)(b * 2 + l) * 256 + t;
        f32x4 cs = {1.f, 1.f, 1.f, 1.f}, sn = {0.f, 0.f, 0.f, 0.f};
        if (lat) { const float* rp = c.ROPE() + t * 64 + (l16 >> 3) * 16 + 4 * (l16 & 3); cs = *(const f32x4*)rp; sn = *(const f32x4*)(rp + 32); if (!((l16 >> 2) & 1)) sn = -sn; }
        v2u raw[7];
#pragma unroll
        for (int ps = 0; ps < 7; ++ps) { const int gi = 4 * ps + grp; const int col = gi < 8 ? C_DQ + gi * 64 : gi < 16 ? C_DK + (gi - 8) * 64 : gi < 24 ? C_WQ + (gi - 16) * 64 : C_WK + (gi - 24) * 64;
            raw[ps] = (gi < 26) ? *(const v2u*)(pr + col + 4 * l16) : (v2u){0u, 0u}; }
        v2u cp[3];
        if (!lat) {
#pragma unroll
            for (int ps = 0; ps < 3; ++ps) { const int gi = 4 * ps + grp; const int col = gi < 8 ? C_DV + gi * 64 : C_WV + (gi - 8) * 64; cp[ps] = (gi < 10) ? *(const v2u*)(pr + col + 4 * l16) : (v2u){0u, 0u}; }
        }
        v2u cx[3][7];
#pragma unroll
        for (int i = 0; i < 3; ++i)
#pragma unroll
            for (int j = 0; j < 7; ++j) { const int tt = t + j - 3; cx[i][j] = (tt >= 0 && tt < L) ? *(const v2u*)(R1p + (size_t)(m + j - 3) * 4096 + C_XBC + 4 * lane + 256 * i) : (v2u){0u, 0u}; }
#pragma unroll
        for (int ps = 0; ps < 7; ++ps) { const int gi = 4 * ps + grp;
            const f32x4 gain = gi < 8 ? gq : gi < 16 ? gk : gi < 24 ? gwq : gwk;
            f32x4 v = {bflo(raw[ps].x), bfhi(raw[ps].x), bflo(raw[ps].y), bfhi(raw[ps].y)};
            float ss = (v.x * v.x + v.y * v.y) + (v.z * v.z + v.w * v.w);
            ss += __shfl_xor(ss, 1); ss += __shfl_xor(ss, 2); ss += __shfl_xor(ss, 4); ss += __shfl_xor(ss, 8);
            v = v * rsqrtf(ss * (1.0f / 64.0f) + EPS) * gain;
            if (lat) { f32x4 p; p.x = __shfl_xor(v.x, 4); p.y = __shfl_xor(v.y, 4); p.z = __shfl_xor(v.z, 4); p.w = __shfl_xor(v.w, 4); v = v * cs + p * sn; }
            if (gi < 26) {
                const int col = gi < 8 ? C_DQ + gi * 64 : gi < 16 ? C_DK + (gi - 8) * 64 : gi < 24 ? C_WQ + (gi - 16) * 64 : C_WK + (gi - 24) * 64;
                v2u o; o.x = pk2(v.x, v.y); o.y = pk2(v.z, v.w); *(v2u*)(pr + col + 4 * l16) = o;
                if (!lat) { if (gi >= 8 && gi < 16) *(f32x4*)(outp + O_DK + ob * 512 + (gi - 8) * 64 + 4 * l16) = v; if (gi >= 24) *(f32x4*)(outp + O_WK + ob * 128 + (gi - 24) * 64 + 4 * l16) = v; }
            }
        }
        if (!lat) {
#pragma unroll
            for (int ps = 0; ps < 3; ++ps) { const int gi = 4 * ps + grp; const f32x4 v = {bflo(cp[ps].x), bfhi(cp[ps].x), bflo(cp[ps].y), bfhi(cp[ps].y)};
                if (gi < 8) *(f32x4*)(outp + O_DV + ob * 512 + gi * 64 + 4 * l16) = v; else if (gi < 10) *(f32x4*)(outp + O_WV + ob * 128 + (gi - 8) * 64 + 4 * l16) = v; }
        }
#pragma unroll
        for (int i = 0; i < 3; ++i) { const int ch = 4 * lane + 256 * i; f32x4 a = *(const f32x4*)(lf + 7 * 768 + ch);
#pragma unroll
            for (int j = 0; j < 7; ++j) { const f32x4 wv = *(const f32x4*)(lf + j * 768 + ch); const f32x4 xv = {bflo(cx[i][j].x), bfhi(cx[i][j].x), bflo(cx[i][j].y), bfhi(cx[i][j].y)}; a += wv * xv; }
            v2u o; o.x = pk2(siluf(a.x), siluf(a.y)); o.y = pk2(siluf(a.z), siluf(a.w)); *(v2u*)(XCp + (size_t)m * 768 + ch) = o; }
    }
}

typedef pg8::bf16x8 bx8;
#define LDS_BARRIER() do { asm volatile("s_waitcnt lgkmcnt(0)" ::: "memory"); __builtin_amdgcn_s_barrier(); asm volatile("" ::: "memory"); } while (0)
#define MFMA16(a, b, cc) __builtin_amdgcn_mfma_f32_16x16x32_bf16((a), (b), (cc), 0, 0, 0)
__device__ __forceinline__ void ssd_unit(const Ctx& c, int l, int pass, int b, int h, unsigned char* lds) {
    const int L = pass ? 1024 : 256, tok0 = pass ? MC + b * 1024 : b * 256, NCH = L >> 7;
    const int tid = c.tid, lane = c.lane, w = c.wave, lr = lane & 15, lq = lane >> 4, grp = h >> 2;
    bf16* XT = (bf16*)lds;
    bf16* BwT = XT + 64 * 136;
    bf16* Bm = BwT + 64 * 136;
    bf16* Cm = Bm + 128 * 72;
    bf16* Mm = Cm + 128 * 72;
    bf16* ST = Mm + 128 * 136;
    float* cum = (float*)(ST + 64 * 72);
    float* dtv = cum + 128; float* wv = dtv + 128; float* ecum = wv + 128; float* tot = ecum + 128;
    const float dsk = c.ssd_d()[l * 8 + h];
    const bf16* XCp = c.XC(); const float* DTp = c.DT(); bf16* Yp = c.Y(); const bf16* R1p = c.R1(); float* SSQp = c.SSQ();
    const int pi = w >> 1, nj0 = 2 * (w & 1);
    const int i = tid >> 2, part = tid & 3;
    for (int dir = 0; dir < 2; ++dir) {
        const float A = -__expf(c.a_log()[(l * 2 + dir) * 8 + h]);
        f32x4 Sacc[2];
        __syncthreads();
#pragma unroll
        for (int q = 0; q < 2; ++q)
#pragma unroll
            for (int r = 0; r < 4; ++r) { const int p = 16 * pi + 4 * lq + r, n = 16 * (nj0 + q) + lr;
                const float v = pass ? c.state_ssd()[(((((size_t)(b * 2 + l) * 2 + dir) * 8 + h) * 64 + p) * 64) + n] : 0.f;
                Sacc[q][r] = v; ST[p * 72 + n] = (bf16)f2bf(v); }
        v4u x0, x1, b0, b1, c0, c1; float d0 = 0.f, d1 = 0.f;
#define SSD_LOAD(ci_) { const int t_ = dir ? L - 1 - ((ci_) * 128 + i) : (ci_) * 128 + i; const bf16* xr_ = XCp + (size_t)(tok0 + t_) * 768; \
            x0 = *(const v4u*)(xr_ + h * 64 + part * 16); x1 = *(const v4u*)(xr_ + h * 64 + part * 16 + 8); \
            b0 = *(const v4u*)(xr_ + 512 + grp * 64 + part * 16); b1 = *(const v4u*)(xr_ + 512 + grp * 64 + part * 16 + 8); \
            c0 = *(const v4u*)(xr_ + 640 + grp * 64 + part * 16); c1 = *(const v4u*)(xr_ + 640 + grp * 64 + part * 16 + 8); \
            if (tid < 64) { const int i0_ = 2 * lane, ta_ = dir ? L - 1 - ((ci_) * 128 + i0_) : (ci_) * 128 + i0_, tb_ = dir ? ta_ - 1 : ta_ + 1; \
                d0 = DTp[(size_t)(tok0 + ta_) * 16 + dir * 8 + h]; d1 = DTp[(size_t)(tok0 + tb_) * 16 + dir * 8 + h]; } }
        SSD_LOAD(0);
        for (int ci = 0; ci < NCH; ++ci) {
            LDS_BARRIER();
            float bvals[16];
            { *(v4u*)(Bm + i * 72 + part * 16) = b0; *(v4u*)(Bm + i * 72 + part * 16 + 8) = b1;
              *(v4u*)(Cm + i * 72 + part * 16) = c0; *(v4u*)(Cm + i * 72 + part * 16 + 8) = c1;
              const unsigned xs[8] = {x0.x, x0.y, x0.z, x0.w, x1.x, x1.y, x1.z, x1.w};
#pragma unroll
              for (int j = 0; j < 8; ++j) { XT[(part * 16 + 2 * j) * 136 + i] = (bf16)(xs[j] & 0xffffu); XT[(part * 16 + 2 * j + 1) * 136 + i] = (bf16)(xs[j] >> 16); }
              float t8[8]; unpack8(b0, t8);
#pragma unroll
              for (int j = 0; j < 8; ++j) bvals[j] = t8[j];
              unpack8(b1, t8);
#pragma unroll
              for (int j = 0; j < 8; ++j) bvals[8 + j] = t8[j]; }
            if (tid < 64) {
                const int i0 = 2 * lane, i1 = i0 + 1;
                const float a0 = d0 * A, a1 = d1 * A; float s = a0 + a1;
#pragma unroll
                for (int o = 1; o < 64; o <<= 1) { const float v = __shfl_up(s, o); if (lane >= o) s += v; }
                const float cum1 = s, cum0 = s - a1, total = __shfl(s, 63);
                cum[i0] = cum0; cum[i1] = cum1; dtv[i0] = d0; dtv[i1] = d1;
                wv[i0] = __expf(total - cum0) * d0; wv[i1] = __expf(total - cum1) * d1; ecum[i0] = __expf(cum0); ecum[i1] = __expf(cum1);
                if (lane == 0) tot[0] = __expf(total);
            }
            if (ci + 1 < NCH) SSD_LOAD(ci + 1);
            unsigned short zz[16], yy[16];
            if (dir == 1) {
#pragma unroll
                for (int r = 0; r < 4; ++r) { const int tt = 16 * w + 4 * lq + r; const size_t m = (size_t)tok0 + (L - 1 - (ci * 128 + tt));
#pragma unroll
                    for (int jp = 0; jp < 4; ++jp) { zz[4 * r + jp] = R1p[m * 4096 + C_Z + h * 64 + 16 * jp + lr]; yy[4 * r + jp] = Yp[m * 2048 + h * 64 + 16 * jp + lr]; } }
            }
            LDS_BARRIER();
            { const float wi = wv[i];
#pragma unroll
              for (int j = 0; j < 16; ++j) BwT[(part * 16 + j) * 136 + i] = (bf16)f2bf(bvals[j] * wi); }
            bx8 cfr[2];
#pragma unroll
            for (int ks = 0; ks < 2; ++ks) cfr[ks] = *(const bx8*)(Cm + (16 * w + lr) * 72 + 32 * ks + 8 * lq);
            for (int j = 0; j <= w; ++j) {
                const bx8 bb0 = *(const bx8*)(Bm + (16 * j + lr) * 72 + 8 * lq), bb1 = *(const bx8*)(Bm + (16 * j + lr) * 72 + 32 + 8 * lq);
                f32x4 g = {0.f, 0.f, 0.f, 0.f};
                g = MFMA16(cfr[0], bb0, g); g = MFMA16(cfr[1], bb1, g);
                const int s = 16 * j + lr; const float cs = cum[s], ds = dtv[s];
#pragma unroll
                for (int r = 0; r < 4; ++r) { const int tt = 16 * w + 4 * lq + r; const float v = (s <= tt) ? g[r] * __expf(cum[tt] - cs) * ds : 0.f; Mm[tt * 136 + s] = (bf16)f2bf(v); }
            }
            if (!(w & 1)) {
#pragma unroll
                for (int r = 0; r < 4; ++r) Mm[(16 * w + 4 * lq + r) * 136 + 16 * (w + 1) + lr] = 0;
            }
            LDS_BARRIER();
            f32x4 yl[4], yo[4];
#pragma unroll
            for (int jp = 0; jp < 4; ++jp) { yl[jp] = (f32x4){0.f, 0.f, 0.f, 0.f}; yo[jp] = (f32x4){0.f, 0.f, 0.f, 0.f}; }
            for (int ks = 0; ks <= (w >> 1); ++ks) {
                const bx8 af = *(const bx8*)(Mm + (16 * w + lr) * 136 + 32 * ks + 8 * lq);
#pragma unroll
                for (int jp = 0; jp < 4; ++jp) { const bx8 xf = *(const bx8*)(XT + (16 * jp + lr) * 136 + 32 * ks + 8 * lq); yl[jp] = MFMA16(af, xf, yl[jp]); }
            }
#pragma unroll
            for (int ks = 0; ks < 2; ++ks)
#pragma unroll
                for (int jp = 0; jp < 4; ++jp) { const bx8 sf = *(const bx8*)(ST + (16 * jp + lr) * 72 + 32 * ks + 8 * lq); yo[jp] = MFMA16(cfr[ks], sf, yo[jp]); }
            {
#pragma unroll
                for (int r = 0; r < 4; ++r) {
                    const int tt = 16 * w + 4 * lq + r; const float ec = ecum[tt];
                    const int t = dir ? L - 1 - (ci * 128 + tt) : ci * 128 + tt; const size_t m = (size_t)tok0 + t;
                    float q = 0.f;
#pragma unroll
                    for (int jp = 0; jp < 4; ++jp) {
                        const int p = 16 * jp + lr; const float y = yl[jp][r] + ec * yo[jp][r];
                        if (dir == 0) Yp[m * 2048 + h * 64 + p] = (bf16)f2bf(y);
                        else { const float x = bf2f(XT[p * 136 + tt]); const float ytot = y + bf2f(yy[4 * r + jp]) + dsk * x; const float z = bf2f(zz[4 * r + jp]);
                            const float gt = ytot * siluf(z); Yp[m * 2048 + h * 64 + p] = (bf16)f2bf(gt); q += gt * gt; }
                    }
                    if (dir == 1) { q += __shfl_xor(q, 1); q += __shfl_xor(q, 2); q += __shfl_xor(q, 4); q += __shfl_xor(q, 8); if (lr == 0) atomicAdd(SSQp + m, q); }
                }
            }
            LDS_BARRIER();
            {
                f32x4 st[2] = {{0.f, 0.f, 0.f, 0.f}, {0.f, 0.f, 0.f, 0.f}};
#pragma unroll
                for (int ks = 0; ks < 4; ++ks) { const bx8 af = *(const bx8*)(XT + (16 * pi + lr) * 136 + 32 * ks + 8 * lq);
#pragma unroll
                    for (int q = 0; q < 2; ++q) { const bx8 bf = *(const bx8*)(BwT + (16 * (nj0 + q) + lr) * 136 + 32 * ks + 8 * lq); st[q] = MFMA16(af, bf, st[q]); } }
                const float et = tot[0];
#pragma unroll
                for (int q = 0; q < 2; ++q)
#pragma unroll
                    for (int r = 0; r < 4; ++r) { Sacc[q][r] = et * Sacc[q][r] + st[q][r]; ST[(16 * pi + 4 * lq + r) * 72 + 16 * (nj0 + q) + lr] = (bf16)f2bf(Sacc[q][r]); }
            }
        }
#undef SSD_LOAD
        if (!pass) {
#pragma unroll
            for (int q = 0; q < 2; ++q)
#pragma unroll
                for (int r = 0; r < 4; ++r) { const int p = 16 * pi + 4 * lq + r, n = 16 * (nj0 + q) + lr;
                    c.out()[O_SSD + (((((size_t)(b * 2 + l) * 2 + dir) * 8 + h) * 64 + p) * 64) + n] = Sacc[q][r]; }
        }
    }
}

__device__ __forceinline__ void s5_tables(const Ctx& c, int l, int g, int part, float* lf) {
    const int tid = c.tid;
    float* pw = lf;
    float* Bc = pw + 2 * 17 * 128;
    float* Cc = Bc + 2 * 2048;
    if (tid < 128) { const int dir = tid >> 6, n = tid & 63, idx = ((l * 2 + dir) * 32 + g) * 64 + n;
        const float lre = c.lam_re()[idx], lim = c.lam_im()[idx], step = expf(c.log_step()[(l * 2 + dir) * 32 + g]);
        for (int k = 0; k <= 16; ++k) { const float mag = expf(lre * step * (float)k); float sn, cs; sincosf(lim * step * (float)k, &sn, &cs); pw[((dir * 17 + k) * 64 + n) * 2] = mag * cs; pw[((dir * 17 + k) * 64 + n) * 2 + 1] = mag * sn; }
        const float mag = expf(lre * step); float sn, cs; sincosf(lim * step, &sn, &cs); const float are = mag * cs, aim = mag * sn;
        const float den = lre * lre + lim * lim, cre = ((are - 1.0f) * lre + aim * lim) / den, cim = (aim * lre - (are - 1.0f) * lim) / den;
        for (int mm = 0; mm < 16; ++mm) { const float br = c.b_re()[(size_t)idx * 16 + mm], bi = c.b_im()[(size_t)idx * 16 + mm]; Bc[((dir * 64 + n) * 16 + mm) * 2] = cre * br - cim * bi; Bc[((dir * 64 + n) * 16 + mm) * 2 + 1] = cre * bi + cim * br; }
    }
    for (int i = tid; i < 2048; i += NTHR) { const int dir = i >> 10, mm = (i >> 6) & 15, n = i & 63; const size_t src = ((size_t)((l * 2 + dir) * 32 + g) * 16 + mm) * 64 + n;
        Cc[i * 2] = c.c_re()[src]; Cc[i * 2 + 1] = c.c_im()[src]; }
    __syncthreads();
    if (part == 0 && tid < 128) { const int dir = tid >> 6, n = tid & 63; float* at = (float*)(c.ws() + WS_S5AT) + ((size_t)(dir * 32 + g) * 64 + n) * 2; at[0] = pw[((dir * 17 + 16) * 64 + n) * 2]; at[1] = pw[((dir * 17 + 16) * 64 + n) * 2 + 1]; }
    bf16* Kt = (bf16*)(c.ws() + WS_S5K) + (size_t)g * 31 * 256;
    for (int e = part * 1984 + tid; e < (part + 1) * 1984; e += NTHR) { const int tp = e >> 8, mm = (e >> 4) & 15, m2 = e & 15, tau = tp - 15; float acc = 0.f;
#pragma unroll
        for (int dir = 0; dir < 2; ++dir) { if ((dir == 0 && tau < 0) || (dir == 1 && tau > 0)) continue; const int k = tau < 0 ? -tau : tau;
            const float* pp = pw + (dir * 17 + k) * 128; const float* bb = Bc + dir * 2048 + m2 * 2; const float* cc = Cc + (dir * 16 + mm) * 128;
            for (int n = 0; n < 64; ++n) { const float pr = pp[2 * n], pi = pp[2 * n + 1], br = bb[n * 32], bi = bb[n * 32 + 1], Pr = pr * br - pi * bi, Pi = pr * bi + pi * br; acc += cc[2 * n] * Pr - cc[2 * n + 1] * Pi; } }
        if (tau == 0 && mm == m2) acc += c.s5_d()[l * 512 + g * 16 + mm];
        Kt[e] = (bf16)f2bf(acc); }
    for (int e = part * 16384 + tid; e < (part + 1) * 16384; e += NTHR) { const int dir = e >> 15, sidx = (e >> 8) & 127, k = e & 255, ri = sidx >> 6, n = sidx & 63, j = k >> 4, m2 = k & 15, ex = dir ? j : 15 - j;
        const float pr = pw[((dir * 17 + ex) * 64 + n) * 2], pi = pw[((dir * 17 + ex) * 64 + n) * 2 + 1], br = Bc[((dir * 64 + n) * 16 + m2) * 2], bi = Bc[((dir * 64 + n) * 16 + m2) * 2 + 1];
        ((bf16*)(c.ws() + WS_S5WS))[((size_t)(dir * 32 + g) * 128 + sidx) * 256 + k] = (bf16)f2bf(ri ? pr * bi + pi * br : pr * br - pi * bi); }
    for (int e = part * 16384 + tid; e < (part + 1) * 16384; e += NTHR) { const int row = e >> 8, k = e & 255, i = row >> 4, mm = row & 15, dir = k >> 7, ri = (k >> 6) & 1, n = k & 63, ex = dir ? 16 - i : i + 1;
        const float pr = pw[((dir * 17 + ex) * 64 + n) * 2], pi = pw[((dir * 17 + ex) * 64 + n) * 2 + 1], cr = Cc[((dir * 16 + mm) * 64 + n) * 2], ci = Cc[((dir * 16 + mm) * 64 + n) * 2 + 1];
        ((bf16*)(c.ws() + WS_S5WO))[(size_t)g * 65536 + e] = (bf16)f2bf(ri ? -(cr * pi + ci * pr) : cr * pr - ci * pi); }
    __syncthreads();
}

__device__ __forceinline__ void s5_unit(const Ctx& c, int l, int g, int cu, unsigned char* lds) {
    const int tid = c.tid, lane = c.lane, w = c.wave, lr = lane & 15, lq = lane >> 4;
    const bool lat = cu >= 8;
    bf16* Ut = (bf16*)lds;
    bf16* St = Ut + 64 * 264;
    bf16* Kt = St + 64 * 264;
    float* Dl = (float*)(Kt + 31 * 256);
    const bf16* R1p = c.R1();
    const bf16* Wsp0 = (const bf16*)(c.ws() + WS_S5WS) + ((size_t)(0 * 32 + g) * 128 + 16 * w + lr) * 256 + 8 * lq;
    const bf16* Wsp1 = (const bf16*)(c.ws() + WS_S5WS) + ((size_t)(1 * 32 + g) * 128 + 16 * w + lr) * 256 + 8 * lq;
    const bf16* Wop = (const bf16*)(c.ws() + WS_S5WO) + (size_t)g * 65536 + 8 * lq;
    bx8 afA[8], afB[8];
#pragma unroll
    for (int ks = 0; ks < 8; ++ks) afA[ks] = *(const bx8*)(Wsp0 + 32 * ks);
    { const v4u* src = (const v4u*)((const bf16*)(c.ws() + WS_S5K) + (size_t)g * 31 * 256); for (int i = tid; i < 31 * 32; i += NTHR) ((v4u*)Kt)[i] = src[i]; }
#pragma unroll
    for (int i = 0; i < 2; ++i) { const int id = tid + NTHR * i, col = id >> 4, j = id & 15;
        const int tok = lat ? MC + (cu - 8) * 1024 + col * 16 + j : (4 * cu + (col >> 4)) * 256 + (col & 15) * 16 + j;
        const bf16* up = R1p + (size_t)tok * 4096 + C_U + g * 16;
        *(v4u*)(Ut + col * 264 + j * 16) = *(const v4u*)up; *(v4u*)(Ut + col * 264 + j * 16 + 8) = *(const v4u*)(up + 8); }
#pragma unroll
    for (int ks = 0; ks < 8; ++ks) afB[ks] = *(const bx8*)(Wsp1 + 32 * ks);
    LDS_BARRIER();
#pragma unroll
    for (int dir = 0; dir < 2; ++dir) {
        f32x4 acc[4];
#pragma unroll
        for (int cb = 0; cb < 4; ++cb) acc[cb] = (f32x4){0.f, 0.f, 0.f, 0.f};
#pragma unroll
        for (int ks = 0; ks < 8; ++ks) {
#pragma unroll
            for (int cb = 0; cb < 4; ++cb) { const bx8 bf = *(const bx8*)(Ut + (16 * cb + lr) * 264 + 32 * ks + 8 * lq); acc[cb] = MFMA16(dir ? afB[ks] : afA[ks], bf, acc[cb]); }
            __builtin_amdgcn_sched_barrier(0); }
        if (dir == 0) {
#pragma unroll
            for (int ks = 0; ks < 8; ++ks) afA[ks] = *(const bx8*)(Wop + (size_t)(16 * (2 * w) + lr) * 256 + 32 * ks); }
        else {
#pragma unroll
            for (int ks = 0; ks < 8; ++ks) afB[ks] = *(const bx8*)(Wop + (size_t)(16 * (2 * w + 1) + lr) * 256 + 32 * ks); }
#pragma unroll
        for (int cb = 0; cb < 4; ++cb)
#pragma unroll
            for (int r = 0; r < 4; ++r) Dl[(16 * w + 4 * lq + r) * 65 + 16 * cb + lr] = acc[cb][r];
        LDS_BARRIER();
        if (tid < (lat ? 64 : 256)) {
            const int n = tid & 63, bl = tid >> 6, nc = lat ? 64 : 16, cbase = lat ? 0 : 16 * bl, b = lat ? cu - 8 : 4 * cu + bl;
            const float* at = (const float*)(c.ws() + WS_S5AT) + ((size_t)(dir * 32 + g) * 64 + n) * 2; const float ar = at[0], ai = at[1];
            float sr = 0.f, si = 0.f;
            if (lat) { sr = c.state_s5()[((((size_t)(b * 2 + l) * 2 + dir) * 2 + 0) * 32 + g) * 64 + n]; si = c.state_s5()[((((size_t)(b * 2 + l) * 2 + dir) * 2 + 1) * 32 + g) * 64 + n]; }
            for (int cc = 0; cc < nc; ++cc) { const int col = cbase + (dir ? nc - 1 - cc : cc);
                St[col * 264 + dir * 128 + n] = (bf16)f2bf(sr); St[col * 264 + dir * 128 + 64 + n] = (bf16)f2bf(si);
                const float dr = Dl[n * 65 + col], di = Dl[(64 + n) * 65 + col];
                const float nr = ar * sr - ai * si + dr, ni = ar * si + ai * sr + di; sr = nr; si = ni; }
            if (!lat) { c.out()[O_S5 + ((((size_t)(b * 2 + l) * 2 + dir) * 2 + 0) * 32 + g) * 64 + n] = sr; c.out()[O_S5 + ((((size_t)(b * 2 + l) * 2 + dir) * 2 + 1) * 32 + g) * 64 + n] = si; }
        }
        LDS_BARRIER();
    }
#pragma unroll
    for (int ii = 0; ii < 2; ++ii) { const int i = 2 * w + ii;
        f32x4 acc[4];
#pragma unroll
        for (int cb = 0; cb < 4; ++cb) acc[cb] = (f32x4){0.f, 0.f, 0.f, 0.f};
#pragma unroll
        for (int ks = 0; ks < 8; ++ks) { const int j = 2 * ks + (lq >> 1); const bx8 af = *(const bx8*)(Kt + ((i - j + 15) * 16 + lr) * 16 + 8 * (lq & 1));
#pragma unroll
            for (int cb = 0; cb < 4; ++cb) { const bx8 bf = *(const bx8*)(Ut + (16 * cb + lr) * 264 + 32 * ks + 8 * lq); acc[cb] = MFMA16(af, bf, acc[cb]); }
            __builtin_amdgcn_sched_barrier(0); }
#pragma unroll
        for (int ks = 0; ks < 8; ++ks) {
#pragma unroll
            for (int cb = 0; cb < 4; ++cb) { const bx8 bf = *(const bx8*)(St + (16 * cb + lr) * 264 + 32 * ks + 8 * lq); acc[cb] = MFMA16(ii ? afB[ks] : afA[ks], bf, acc[cb]); }
            __builtin_amdgcn_sched_barrier(0); }
#pragma unroll
        for (int cb = 0; cb < 4; ++cb) { const int col = 16 * cb + lr;
            const int tok = lat ? MC + (cu - 8) * 1024 + col * 16 + i : (4 * cu + (col >> 4)) * 256 + (col & 15) * 16 + i;
            v2u o; o.x = pk2(acc[cb][0], acc[cb][1]); o.y = pk2(acc[cb][2], acc[cb][3]);
            *(v2u*)(c.Y5() + (size_t)tok * 512 + g * 16 + 4 * lq) = o; }
    }
}

typedef float f32x16 __attribute__((ext_vector_type(16)));
#define MFMA32(a, b, cc) __builtin_amdgcn_mfma_f32_32x32x16_bf16((a), (b), (cc), 0, 0, 0)
constexpr float SM_SC = 0.125f * 1.4426950408889634f;
__device__ __forceinline__ void qk_tile(f32x16& p0, f32x16& p1, const bf16* Kt, int KS, const bx8 (&qf)[4], int r32, int hi) {
    p0 = (f32x16){0.f}; p1 = (f32x16){0.f};
    bx8 a0[4], a1[4];
#pragma unroll
    for (int d0 = 0; d0 < 4; ++d0) { a0[d0] = *(const bx8*)(Kt + r32 * KS + 16 * d0 + 8 * hi); a1[d0] = *(const bx8*)(Kt + (32 + r32) * KS + 16 * d0 + 8 * hi); }
    __builtin_amdgcn_s_setprio(1);
#pragma unroll
    for (int d0 = 0; d0 < 4; ++d0) { p0 = MFMA32(a0[d0], qf[d0], p0); p1 = MFMA32(a1[d0], qf[d0], p1); }
    __builtin_amdgcn_s_setprio(0);
}
__device__ __forceinline__ float fmax_(float a, float b) { float r; asm("v_max_f32_e32 %0, %1, %2" : "=v"(r) : "v"(a), "v"(b)); return r; }
__device__ __forceinline__ float sm_step(f32x16& p0, f32x16& p1, float& mrun, float& lrun, bx8 (&pb)[4]) {
    float ta = fmax_(p0[0], p1[0]), tb = fmax_(p0[1], p1[1]);
#pragma unroll
    for (int r = 2; r < 16; r += 2) { ta = fmax_(ta, fmax_(p0[r], p1[r])); tb = fmax_(tb, fmax_(p0[r + 1], p1[r + 1])); }
    float tm = fmax_(ta, tb) * SM_SC;
    tm = fmax_(tm, __shfl_xor(tm, 32));
    const float mn = fmax_(mrun, tm), alpha = __builtin_amdgcn_exp2f(mrun - mn);
    float rs0 = 0.f, rs1 = 0.f;
#pragma unroll
    for (int r = 0; r < 16; ++r) { p0[r] = __builtin_amdgcn_exp2f(fmaf(p0[r], SM_SC, -mn)); p1[r] = __builtin_amdgcn_exp2f(fmaf(p1[r], SM_SC, -mn)); rs0 += p0[r]; rs1 += p1[r]; }
    float rs = rs0 + rs1;
    rs += __shfl_xor(rs, 32);
    lrun = lrun * alpha + rs; mrun = mn;
#pragma unroll
    for (int sI = 0; sI < 2; ++sI) {
        v4u t0, t1;
        t0.x = pg8::cvt_pk_bf16(p0[8 * sI + 0], p0[8 * sI + 1]); t0.y = pg8::cvt_pk_bf16(p0[8 * sI + 2], p0[8 * sI + 3]); t0.z = pg8::cvt_pk_bf16(p0[8 * sI + 4], p0[8 * sI + 5]); t0.w = pg8::cvt_pk_bf16(p0[8 * sI + 6], p0[8 * sI + 7]);
        t1.x = pg8::cvt_pk_bf16(p1[8 * sI + 0], p1[8 * sI + 1]); t1.y = pg8::cvt_pk_bf16(p1[8 * sI + 2], p1[8 * sI + 3]); t1.z = pg8::cvt_pk_bf16(p1[8 * sI + 4], p1[8 * sI + 5]); t1.w = pg8::cvt_pk_bf16(p1[8 * sI + 6], p1[8 * sI + 7]);
        pb[sI] = __builtin_bit_cast(bx8, t0); pb[2 + sI] = __builtin_bit_cast(bx8, t1);
    }
    return alpha;
}
typedef short v4i16_t __attribute__((ext_vector_type(4)));
__device__ __forceinline__ v2u vtr(const bf16* p) { return __builtin_bit_cast(v2u, __builtin_amdgcn_ds_read_tr16_b64_v4i16((__attribute__((address_space(3))) v4i16_t*)p)); }
template <int NDT, int VS> __device__ __forceinline__ void pv_tile(f32x16 (&o)[NDT], const bf16* Vr, const bx8 (&pb)[4], int lane) {
    const bf16* vb = Vr + (4 * (lane >> 5) + ((lane & 15) >> 2)) * VS + 16 * ((lane >> 4) & 1) + 4 * (lane & 3);
    v2u cur[NDT][2], nxt[NDT][2];
#pragma unroll
    for (int dt = 0; dt < NDT; ++dt) { cur[dt][0] = vtr(vb + 32 * dt); cur[dt][1] = vtr(vb + 8 * VS + 32 * dt); }
#pragma unroll
    for (int ks = 0; ks < 4; ++ks) {
        if (ks < 3) {
#pragma unroll
            for (int dt = 0; dt < NDT; ++dt) { nxt[dt][0] = vtr(vb + (16 * (ks + 1)) * VS + 32 * dt); nxt[dt][1] = vtr(vb + (16 * (ks + 1) + 8) * VS + 32 * dt); }
        }
        __builtin_amdgcn_s_setprio(1);
#pragma unroll
        for (int dt = 0; dt < NDT; ++dt) { const v4u t = {cur[dt][0].x, cur[dt][0].y, cur[dt][1].x, cur[dt][1].y}; o[dt] = MFMA32(__builtin_bit_cast(bx8, t), pb[ks], o[dt]); }
        __builtin_amdgcn_s_setprio(0);
#pragma unroll
        for (int dt = 0; dt < NDT; ++dt) { cur[dt][0] = nxt[dt][0]; cur[dt][1] = nxt[dt][1]; }
    }
}

template <int PASS> __device__ __forceinline__ void diff_unit(const Ctx& c, int l, int uidx, unsigned char* lds) {
    constexpr int NT = PASS ? 10 : 2, NQB = PASS ? 8 : 2, VS = 160;
    const int tid = c.tid, lane = c.lane, w = c.wave, r32 = lane & 31, hi = lane >> 5, comp = w >> 2;
    const int qb = uidx % NQB, h = (uidx / NQB) & 3, b = uidx / (NQB * 4);
    const int tok0 = PASS ? MC + b * 1024 : b * 256;
    bf16* Kt = (bf16*)lds;
    bf16* Vr = Kt + 128 * 136;
    float* Ob = (float*)lds;
    const bf16* R1p = c.R1(); const bf16* CK = c.CKV() + (size_t)l * 1024 * 1280;
    const float lam_init = 0.8f - 0.6f * expf(-0.3f * (float)l);
    const float* lv = c.dlam() + l * 256;
    const float lam = expf(wave_sum(lv[lane] * lv[64 + lane])) - expf(wave_sum(lv[128 + lane] * lv[192 + lane])) + lam_init;
    const size_t mrow = (size_t)tok0 + qb * 128 + 32 * (w & 3) + r32;
    bx8 qf[4];
#pragma unroll
    for (int d0 = 0; d0 < 4; ++d0) qf[d0] = *(const bx8*)(R1p + mrow * 4096 + C_DQ + h * 128 + comp * 64 + 16 * d0 + 8 * hi);
    f32x16 o[4];
#pragma unroll
    for (int dt = 0; dt < 4; ++dt) o[dt] = (f32x16){0.f};
    float mrun = -1e30f, lrun = 0.f;
    v4u kreg[4], vreg[4];
#define DIFF_LOAD(t) { const bf16* kb; const bf16* vb; size_t rs; \
        if (PASS && (t) < 2) { kb = CK + ((size_t)b * 256 + 128 * (t)) * 1280 + h * 128; vb = kb + 512; rs = 1280; } \
        else { kb = R1p + ((size_t)tok0 + 128 * ((t) - (PASS ? 2 : 0))) * 4096 + C_DK + h * 128; vb = kb + (C_DV - C_DK); rs = 4096; } \
        _Pragma("unroll") for (int i = 0; i < 4; ++i) { const int id = tid + NTHR * i; kreg[i] = *(const v4u*)(kb + (size_t)(id >> 4) * rs + (id & 15) * 8); vreg[i] = *(const v4u*)(vb + (size_t)(id >> 4) * rs + (id & 15) * 8); } }
    DIFF_LOAD(0);
    for (int t = 0; t < NT; ++t) {
        LDS_BARRIER();
#pragma unroll
        for (int i = 0; i < 4; ++i) { const int id = tid + NTHR * i; *(v4u*)(Kt + (id >> 4) * 136 + (id & 15) * 8) = kreg[i]; *(v4u*)(Vr + (id >> 4) * VS + (id & 15) * 8) = vreg[i]; }
        if (t + 1 < NT) DIFF_LOAD(t + 1);
        LDS_BARRIER();
#pragma unroll
        for (int sub = 0; sub < 2; ++sub) {
            f32x16 p0, p1; bx8 pb[4];
            qk_tile(p0, p1, Kt + sub * 64 * 136 + comp * 64, 136, qf, r32, hi);
            const float alpha = sm_step(p0, p1, mrun, lrun, pb);
            if (__any(alpha != 1.0f)) {
#pragma unroll
                for (int dt = 0; dt < 4; ++dt)
#pragma unroll
                    for (int r = 0; r < 16; ++r) o[dt][r] *= alpha; }
            pv_tile<4, VS>(o, Vr + sub * 64 * VS, pb, lane);
        }
    }
#undef DIFF_LOAD
    const float inv = (comp ? lam : 1.0f) / lrun;
    const int rowl = 32 * (w & 3) + r32;
    LDS_BARRIER();
    if (comp) {
#pragma unroll
        for (int dt = 0; dt < 4; ++dt)
#pragma unroll
            for (int r = 0; r < 16; ++r) Ob[rowl * 129 + 32 * dt + (r & 3) + 8 * (r >> 2) + 4 * hi] = o[dt][r] * inv;
    }
    LDS_BARRIER();
    if (!comp) {
        float ss = 0.f;
#pragma unroll
        for (int dt = 0; dt < 4; ++dt)
#pragma unroll
            for (int r = 0; r < 16; ++r) { const float v = o[dt][r] * inv - Ob[rowl * 129 + 32 * dt + (r & 3) + 8 * (r >> 2) + 4 * hi]; o[dt][r] = v; ss += v * v; }
        ss += __shfl_xor(ss, 32);
        const float rn = rsqrtf(ss * (1.0f / 128.0f) + EPS) * (1.0f - lam_init);
        const float* sg = c.subln_g() + l * 128; bf16* yp = c.Y() + mrow * 2048 + 1024 + h * 128;
#pragma unroll
        for (int dt = 0; dt < 4; ++dt)
#pragma unroll
            for (int r4 = 0; r4 < 4; ++r4) { const int dv = 32 * dt + 8 * r4 + 4 * hi; const f32x4 g = *(const f32x4*)(sg + dv);
                v2u ov; ov.x = pk2(o[dt][4 * r4 + 0] * rn * g.x, o[dt][4 * r4 + 1] * rn * g.y); ov.y = pk2(o[dt][4 * r4 + 2] * rn * g.z, o[dt][4 * r4 + 3] * rn * g.w);
                *(v2u*)(yp + dv) = ov; }
    }
}

template <int PASS> __device__ __forceinline__ void win_unit(const Ctx& c, int l, int uidx, unsigned char* lds) {
    constexpr int NQB = PASS ? 4 : 1, VS = 96;
    const int tid = c.tid, lane = c.lane, w = c.wave, r32 = lane & 31, hi = lane >> 5;
    const int qb = uidx % NQB, hh = (uidx / NQB) & 7, b = uidx / (NQB * 8), nkv = hh >> 2;
    const int tok0 = PASS ? MC + b * 1024 : b * 256;
    bf16* Kt = (bf16*)lds;
    bf16* Vr = Kt + 128 * 72;
    const bf16* R1p = c.R1(); const bf16* CK = c.CKV() + (size_t)l * 1024 * 1280;
    const int qrow = qb * 256 + 32 * w + r32;
    const size_t mrow = (size_t)tok0 + qrow;
    bx8 qf[4];
#pragma unroll
    for (int d0 = 0; d0 < 4; ++d0) qf[d0] = *(const bx8*)(R1p + mrow * 4096 + C_WQ + hh * 64 + 16 * d0 + 8 * hi);
    f32x16 o[2]; o[0] = (f32x16){0.f}; o[1] = (f32x16){0.f};
    float mrun = c.sink()[l * 8 + hh] * 1.4426950408889634f, lrun = 1.0f;
    const int q0 = qb * 256;
    const int tb0 = PASS ? ((q0 - 128 < 0 ? 0 : q0 - 128) >> 7) : 0, tb1 = PASS ? ((q0 + 255 + 128 > 1023 ? 1023 : q0 + 255 + 128) >> 7) : 0;
    const int NT = PASS ? 2 + (tb1 - tb0 + 1) : 2;
    v4u kreg[2], vreg[2];
#define WIN_LOAD(t) { const bf16* kb; const bf16* vb; size_t rs; \
        if (PASS && (t) < 2) { kb = CK + ((size_t)b * 256 + 128 * (t)) * 1280 + 1024 + nkv * 64; vb = kb + 128; rs = 1280; } \
        else { kb = R1p + ((size_t)tok0 + 128 * (PASS ? tb0 + (t) - 2 : (t))) * 4096 + C_WK + nkv * 64; vb = kb + (C_WV - C_WK); rs = 4096; } \
        _Pragma("unroll") for (int i = 0; i < 2; ++i) { const int id = tid + NTHR * i; kreg[i] = *(const v4u*)(kb + (size_t)(id >> 3) * rs + (id & 7) * 8); vreg[i] = *(const v4u*)(vb + (size_t)(id >> 3) * rs + (id & 7) * 8); } }
    WIN_LOAD(0);
    for (int t = 0; t < NT; ++t) {
        LDS_BARRIER();
#pragma unroll
        for (int i = 0; i < 2; ++i) { const int id = tid + NTHR * i; *(v4u*)(Kt + (id >> 3) * 72 + (id & 7) * 8) = kreg[i]; *(v4u*)(Vr + (id >> 3) * VS + (id & 7) * 8) = vreg[i]; }
        if (t + 1 < NT) WIN_LOAD(t + 1);
        LDS_BARRIER();
#pragma unroll
        for (int sub = 0; sub < 2; ++sub) {
            bool band = false; int kp0 = 0;
            if (PASS && t >= 2) { band = true; kp0 = 128 * (tb0 + t - 2) + 64 * sub; const int r0 = q0 + 32 * w;
                if (kp0 + 63 < r0 - 128 || kp0 > r0 + 31 + 128) continue; }
            f32x16 p0, p1; bx8 pb[4];
            qk_tile(p0, p1, Kt + sub * 64 * 72, 72, qf, r32, hi);
            if (band) {
#pragma unroll
                for (int r = 0; r < 16; ++r) { const int kp = kp0 + (r & 3) + 8 * (r >> 2) + 4 * hi; const int d0 = qrow - kp, d1 = d0 - 32;
                    if (d0 > 128 || d0 < -128) p0[r] = -1e30f; if (d1 > 128 || d1 < -128) p1[r] = -1e30f; }
            }
            const float alpha = sm_step(p0, p1, mrun, lrun, pb);
            if (__any(alpha != 1.0f)) {
#pragma unroll
                for (int dt = 0; dt < 2; ++dt)
#pragma unroll
                    for (int r = 0; r < 16; ++r) o[dt][r] *= alpha; }
            pv_tile<2, VS>(o, Vr + sub * 64 * VS, pb, lane);
        }
    }
#undef WIN_LOAD
    const float inv = 1.0f / lrun; bf16* yp = c.Y() + mrow * 2048 + 1536 + hh * 64;
#pragma unroll
    for (int dt = 0; dt < 2; ++dt)
#pragma unroll
        for (int r4 = 0; r4 < 4; ++r4) { const int dv = 32 * dt + 8 * r4 + 4 * hi;
            v2u ov; ov.x = pk2(o[dt][4 * r4 + 0] * inv, o[dt][4 * r4 + 1] * inv); ov.y = pk2(o[dt][4 * r4 + 2] * inv, o[dt][4 * r4 + 3] * inv);
            *(v2u*)(yp + dv) = ov; }
}

__device__ __forceinline__ void phase_mixers(const Ctx& c_in, int l, float* lf) {
    unsigned char* lds = (unsigned char*)lf;
    unsigned* qctr = (unsigned*)(c_in.ws() + WS_QCTR) + 64 * l;
    volatile int* qslot = (volatile int*)(lds + LDS_BYTES - 32);
    for (;;) {
        __syncthreads();
        if (threadIdx.x == 0) *qslot = (int)atomicAdd(qctr, 1u);
        __syncthreads();
        const int u = __builtin_amdgcn_readfirstlane(*qslot);
        if (u >= 1440) break;
        Ctx c = c_in; asm volatile("" : "+s"(c.ap), "+v"(c.tid));
        c.lane = c.tid & 63; c.wave = __builtin_amdgcn_readfirstlane(c.tid >> 6);
        unsigned long long pt0 = 0; if (PROBE_SEL >= 0) pt0 = __builtin_amdgcn_s_memrealtime();
        int ty;
        if (u < 32) { ssd_unit(c, l, 1, u >> 3, u & 7, lds); ty = 0; }
        else if (u < 160) { diff_unit<1>(c, l, u - 32, lds); ty = 2; }
        else if (u < 288) { win_unit<1>(c, l, u - 160, lds); ty = 3; }
        else if (u < 416) { s5_unit(c, l, (u - 288) & 31, 8 + ((u - 288) >> 5), lds); ty = 1; }
        else if (u < 672) { ssd_unit(c, l, 0, (u - 416) >> 3, (u - 416) & 7, lds); ty = 4; }
        else if (u < 928) { diff_unit<0>(c, l, u - 672, lds); ty = 6; }
        else if (u < 1184) { win_unit<0>(c, l, u - 928, lds); ty = 7; }
        else { s5_unit(c, l, (u - 1184) & 31, (u - 1184) >> 5, lds); ty = 5; }
        __syncthreads();
        if (PROBE_SEL >= 0 && threadIdx.x == 0) { unsigned long long* tsu = (unsigned long long*)(c.ws() + WS_TS) + 64; atomicAdd(tsu + ty, (unsigned long long)(__builtin_amdgcn_s_memrealtime() - pt0)); }
    }
}

__device__ __forceinline__ void phase_sum4(const Ctx& c) {
    const int gt = blockIdx.x * NTHR + c.tid, NT = gridDim.x * NTHR;
#pragma unroll 4
    for (int i = gt; i < M * 128; i += NT) { const size_t m = (size_t)(i >> 7); const int c8 = (i & 127) * 8;
        float a[8] = {0.f, 0.f, 0.f, 0.f, 0.f, 0.f, 0.f, 0.f};
#pragma unroll
        for (int j = 0; j < 4; ++j) { float f[8]; unpack8(*(const v4u*)(c.R1() + m * 4096 + j * 1024 + c8), f);
#pragma unroll
            for (int k = 0; k < 8; ++k) a[k] += f[k]; }
        v4u o; o.x = pk2(a[0], a[1]); o.y = pk2(a[2], a[3]); o.z = pk2(a[4], a[5]); o.w = pk2(a[6], a[7]);
        *(v4u*)(c.H() + m * 1024 + c8) = o; }
}

#define GAS __attribute__((address_space(1)))
#define XB_TMO      128
#define XB_XCNT(j)  (256  + 64 * (j))
#define XB_XSUB(j)  (1280 + 64 * (j))
#define XB_XGEN(j)  (2304 + 64 * (j))
#define XB_TOP      3328
#define XB_TOPGEN   3392
#define XCD_BAR_WORDS 3456
#define XB_SPIN_CAP (1u << 18)

__device__ __forceinline__ unsigned xb_ld(unsigned* p)              { return __hip_atomic_load(p, __ATOMIC_RELAXED, __HIP_MEMORY_SCOPE_AGENT); }
__device__ __forceinline__ unsigned xb_add(unsigned* p, unsigned v) { return __hip_atomic_fetch_add(p, v, __ATOMIC_RELAXED, __HIP_MEMORY_SCOPE_AGENT); }
__device__ __forceinline__ unsigned xb_xcc_id() { return (unsigned)__builtin_amdgcn_s_getreg((3 << 11) | 20) & 0xFu; }
#define XB_SPIN(cond, bar) do { unsigned _sp = 0; while (cond) { __builtin_amdgcn_s_sleep(1); \
    if ((++_sp & 255u) == 0u) { if (xb_ld(&(bar)[XB_TMO])) break; if (_sp > XB_SPIN_CAP) { atomicAdd(&(bar)[XB_TMO], 1u); break; } } } } while (0)

struct XcdBarrier {
    unsigned* bar; unsigned x;
    volatile LAS unsigned* st;
};

__device__ __forceinline__ XcdBarrier xcd_barrier_post(unsigned* bar, volatile LAS unsigned* st) {
    XcdBarrier b; b.bar = bar; b.x = xb_xcc_id(); b.st = st;
    if (threadIdx.x == 0) (void)xb_add(&bar[XB_XCNT(b.x)], 1u);
    return b;
}
__device__ __forceinline__ void xcd_barrier_complete(unsigned* bar, unsigned x, unsigned& nloc, unsigned& nx) {
    const unsigned G = gridDim.x * gridDim.y * gridDim.z;
    unsigned sum, cnt, mine, sp = 0u;
    for (;;) {
        sum = 0u; cnt = 0u; mine = 0u;
#pragma unroll
        for (unsigned j = 0; j < 16; ++j) { const unsigned c = xb_ld(&bar[XB_XCNT(j)]); sum += c; cnt += (c > 0u) ? 1u : 0u; mine = (j == x) ? c : mine; }
        if (sum == G) break;
        __builtin_amdgcn_s_sleep(1);
        if ((++sp & 255u) == 0u) { if (xb_ld(&bar[XB_TMO])) break; if (sp > XB_SPIN_CAP) { atomicAdd(&bar[XB_TMO], 1u); break; } }
    }
    nloc = mine > 0u ? mine : 1u; nx = cnt > 0u ? cnt : 1u;
}

__device__ __forceinline__ void xcd_barrier(const XcdBarrier& b) {
    asm volatile("s_waitcnt vmcnt(0)" ::: "memory");
    __syncthreads();
    if (threadIdx.x == 0) {
        unsigned* bar = b.bar;
        __builtin_amdgcn_s_waitcnt(0);
        unsigned nloc = b.st[0], nx = b.st[1];
        if (nloc == 0u) { xcd_barrier_complete(bar, b.x, nloc, nx); b.st[0] = nloc; b.st[1] = nx; }
        const unsigned old = xb_add(&bar[XB_XSUB(b.x)], 1u);
        const unsigned gen = old / nloc;
        if (old + 1u == (gen + 1u) * nloc) {
            __builtin_amdgcn_fence(__ATOMIC_RELEASE, "agent");
            asm volatile("s_waitcnt vmcnt(0)" ::: "memory");
            const unsigned og = xb_add(&bar[XB_TOP], 1u);
            const unsigned tg = og / nx;
            if (og + 1u == (tg + 1u) * nx) xb_add(&bar[XB_TOPGEN], 1u);
            else XB_SPIN(xb_ld(&bar[XB_TOPGEN]) == tg, bar);
            __builtin_amdgcn_fence(__ATOMIC_ACQUIRE, "agent");
            xb_add(&bar[XB_XGEN(b.x)], 1u);
            asm volatile("s_waitcnt vmcnt(0)" ::: "memory");
        } else {
            XB_SPIN(xb_ld(&bar[XB_XGEN(b.x)]) == gen, bar);
            __builtin_amdgcn_fence(__ATOMIC_ACQUIRE, "agent");
            asm volatile("s_waitcnt vmcnt(0)" ::: "memory");
        }
    }
    __syncthreads();
}

#define PHASE_BEGIN() Ctx c; c.ap = (CArgs)__builtin_amdgcn_kernarg_segment_ptr(); asm volatile("" : "+s"(c.ap)); \
        int tid_o = threadIdx.x; asm volatile("" : "+v"(tid_o)); c.tid = tid_o; c.lane = tid_o & 63; c.wave = __builtin_amdgcn_readfirstlane(tid_o >> 6); \
        int G = gridDim.x, bid = blockIdx.x; asm volatile("" : "+s"(G), "+s"(bid)); unsigned char* ws = c.ws(); (void)ws; (void)G; (void)bid;
#define PHASE_END(k) { if ((k) + 1 < ph_hi) { if ((k) == 0) cg::this_grid().sync(); else xcd_barrier(xbar); } \
        if (PROBE_SEL >= 0 && blockIdx.x == PROBE_PB && threadIdx.x == 0) ((unsigned long long*)(c.ws() + WS_TS))[(k) + 1] = __builtin_amdgcn_s_memrealtime(); }
#define IN_RANGE(k) (ph_lo <= (k) && (k) < ph_hi)

template <int LAYER> __device__ __forceinline__ void layer_program(int ph_lo, int ph_hi, unsigned char* lds, const XcdBarrier& xbar) {
    float* lf = (float*)lds;
    PG8_LAS unsigned char* ring = (PG8_LAS unsigned char*)lds;
    constexpr int l = LAYER, B0 = 1 + 11 * LAYER;
    if (IN_RANGE(B0 + 0)) { PHASE_BEGIN(); if (l == 1) { if (gridDim.x == 256) convert_items(c, 1, 7936, 9984, blockIdx.x * NWAVES + c.wave, gridDim.x * NWAVES, false, 0, 1, lf); else phase_convert(c, 1, lf); __syncthreads(); } phase_norm(c, l, 0, lf); phase_bias2(c, l); PHASE_END(B0 + 0); }
    if (IN_RANGE(B0 + 1)) { PHASE_BEGIN();
        pg8::Gemm g{c.H(), (const bf16*)(ws + W_IN), M, 4096, 1024, 1024, 1024, 0, 0}; pg8::StaticOrder S; S.init(M, 4096, G, bid);
        pg8::EpiB<0> E{c.R1(), 4096, nullptr, nullptr};
        pg8::gemm_phase<pg8::EpiB<0>, pg8::StaticOrder, true, true>(ring, g, S, E, tid_o); PHASE_END(B0 + 1); }
    if (IN_RANGE(B0 + 2)) { PHASE_BEGIN(); phase_dt(c, l); phase_qk(c, l, lf); PHASE_END(B0 + 2); }
    if (IN_RANGE(B0 + 3)) { PHASE_BEGIN(); phase_mixers(c, l, lf); PHASE_END(B0 + 3); }
    if (IN_RANGE(B0 + 4)) { PHASE_BEGIN();
        { pg8::Gemm g{c.Y5(), (const bf16*)(ws + W_GLU), M, 1024, 512, 512, 512, 0, 0}; pg8::StaticOrder S; S.init(M, 1024, G, bid);
          pg8::EpiGlu E{c.Y(), 2048, 512, c.b_glu() + l * 1024};
          pg8::gemm_phase<pg8::EpiGlu, pg8::StaticOrder, true, true>(ring, g, S, E, tid_o); }
        { pg8::Gemm g{c.H(), (const bf16*)(ws + W_G), M, 4096, 1024, 1024, 1024, 0, 0}; pg8::StaticOrder S; S.init(M, 4096, G, bid);
          pg8::EpiB<1> E{c.R1(), 4096, c.b_gate() + l * 4096, nullptr};
          pg8::gemm_phase<pg8::EpiB<1>, pg8::StaticOrder, true, true>(ring, g, S, E, tid_o); }
        PHASE_END(B0 + 4); }
    if (IN_RANGE(B0 + 5)) { PHASE_BEGIN();
        pg8::Gemm g{c.Y(), (const bf16*)(ws + W_BR), M, 4096, 512, 2048, 512, 4, 1024}; pg8::BranchOrder S; S.init(G, bid);
        pg8::EpiMerge E{c.R1(), c.H(), c.SSQ()};
        pg8::gemm_phase<pg8::EpiMerge, pg8::BranchOrder, true, true>(ring, g, S, E, tid_o); if (l == 0) side_convert(c, 0, 4352, true, lf); PHASE_END(B0 + 5); }
    if (IN_RANGE(B0 + 7)) { PHASE_BEGIN();
        pg8::Gemm g{c.H(), (const bf16*)(ws + W_OUT), M, 1024, 1024, 1024, 1024, 0, 0}; pg8::StaticOrder S; S.init(M, 1024, G, bid);
        pg8::EpiRes2 E{l == 0 ? c.x_prompt() : c.out(), l == 0 ? c.x_sample() : c.out() + (size_t)MC * D, c.out(), c.MOD() + (size_t)l * 5 * 6144, 2048, c.Y(), c.g_norm2() + l * 1024, 4096, (float*)(ws + WS_SSQ2)};
        pg8::gemm_phase<pg8::EpiRes2, pg8::StaticOrder, true, true>(ring, g, S, E, tid_o); if (l == 0) side_convert(c, 4352, 5376, false, lf); PHASE_END(B0 + 7); }
    if (IN_RANGE(B0 + 9)) { PHASE_BEGIN();
        pg8::Gemm g{c.Y(), (const bf16*)(ws + W_1), M, 4096, 1024, 1024, 1024, 0, 0}; pg8::StaticOrder S; S.init(M, 4096, G, bid);
        pg8::EpiB<5> E{c.R1(), 4096, (const float*)(ws + WS_BI2), (const float*)(ws + WS_SSQ2)};
        pg8::gemm_phase<pg8::EpiB<5>, pg8::StaticOrder, true, true>(ring, g, S, E, tid_o); PHASE_END(B0 + 9); }
    if (IN_RANGE(B0 + 10)) { PHASE_BEGIN();
        pg8::Gemm g{c.R1(), (const bf16*)(ws + W_2), M, 1024, 4096, 4096, 4096, 0, 0}; pg8::StaticOrder S; S.init(M, 1024, G, bid);
        pg8::EpiRes E{c.out(), c.out() + (size_t)MC * D, c.out(), c.MOD() + (size_t)l * 5 * 6144, 5120};
        pg8::gemm_phase<pg8::EpiRes, pg8::StaticOrder, true, true>(ring, g, S, E, tid_o); if (l == 0) side_convert(c, 5376, 7936, false, lf); PHASE_END(B0 + 10); }
}

__global__ void __launch_bounds__(NTHR, 2) fwd_kernel(Args args) {
    extern __shared__ __attribute__((aligned(16))) unsigned char lds[];
    const int ph_lo = args.ph_lo, ph_hi = args.ph_hi;
    volatile LAS unsigned* xst = (volatile LAS unsigned*)(lds + LDS_BYTES - 16);
    if (threadIdx.x < 4) xst[threadIdx.x] = 0u;
    __syncthreads();
    const XcdBarrier xbar = xcd_barrier_post((unsigned*)(args.ws + WS_BAR), xst);
    if (PROBE_SEL >= 0 && blockIdx.x == PROBE_PB && threadIdx.x == 0) { unsigned long long* ts = (unsigned long long*)(args.ws + WS_TS); ts[0] = __builtin_amdgcn_s_memrealtime(); }
    if (IN_RANGE(0)) { PHASE_BEGIN(); float* lf = (float*)lds; phase_mods(c, lf); __syncthreads(); phase_convert(c, 0, lf); phase_rope_table(c); phase_ckv(c); PHASE_END(0); }
    layer_program<0>(ph_lo, ph_hi, lds, xbar);
    layer_program<1>(ph_lo, ph_hi, lds, xbar);
    if (PROBE_SEL >= 0) {
        __threadfence(); cg::this_grid().sync();
        const unsigned long long* ts = (const unsigned long long*)(args.ws + WS_TS);
        const float total = (float)(ts[23] - ts[0]); float sel = 0.f;
        for (int k = 0; k < 23; ++k) { const float d = (float)(ts[k + 1] - ts[k]); const int q = k == 0 ? -1 : (k - 1) % 11;
            const int cls = (q == 3) ? 0 : (q == 1 || q == 4 || q == 5 || q == 7 || q == 9 || q == 10) ? 1 : (q == 2) ? 2 : 3;
            if (cls == PROBE_SEL) sel += d; }
        if (PROBE_SEL >= 10 && PROBE_SEL < 100) sel = (float)ts[64 + PROBE_SEL - 10] * (1.0f / 256.0f);
        if (PROBE_SEL >= 100) { const int k = PROBE_SEL - 100; sel = (float)(ts[k + 1] - (ts[k] != 0ull ? ts[k] : ts[k - 1])); }
        const float sc = 1.0f + sqrtf(PROBE_SCALE * sel / total);
        for (int i = blockIdx.x * NTHR + threadIdx.x; i < 524288; i += gridDim.x * NTHR) args.out[O_S5 + i] *= sc;
    }
}

extern "C" void kernel_launch(void* const* d_in, const int* in_sizes, int n_in, void* d_out, int out_size, void* d_ws, size_t ws_size, hipStream_t stream) {
    static int grid = 0;
    if (grid == 0) {
        if (n_in != 44 || ws_size < WS_END) { fprintf(stderr, "kernel_launch: expected 44 inputs and >= %zu bytes of workspace; got %d, %zu\n", (size_t)WS_END, n_in, ws_size); grid = -1; return; }
        int dev = 0, cus = 0, per_cu = 0;
        (void)hipGetDevice(&dev); (void)hipDeviceGetAttribute(&cus, hipDeviceAttributeMultiprocessorCount, dev);
        (void)hipFuncSetAttribute((const void*)fwd_kernel, hipFuncAttributeMaxDynamicSharedMemorySize, LDS_BYTES);
        (void)hipOccupancyMaxActiveBlocksPerMultiprocessor(&per_cu, (const void*)fwd_kernel, NTHR, LDS_BYTES);
        if (per_cu < 1) { fprintf(stderr, "kernel_launch: occupancy query says %d blocks per CU\n", per_cu); per_cu = 1; }
        (void)hipGetLastError();
        grid = cus > 0 ? cus : 256;
    }
    if (grid < 0) return;
    (void)hipMemsetAsync(d_ws, 0, 64 * 1024, stream);
    Args a{};
    for (int i = 0; i < 44; ++i) a.in[i] = (const float*)d_in[i];
    a.out = (float*)d_out; a.ws = (unsigned char*)d_ws;
#if MK_MULTI
    for (int ph = 0; ph < NPH; ++ph) { a.ph_lo = ph; a.ph_hi = ph + 1; hipLaunchKernelGGL(fwd_kernel, dim3(grid), dim3(NTHR), LDS_BYTES, stream, a); }
#else
    a.ph_lo = 0; a.ph_hi = NPH;
    void* kargs[] = {&a};
    hipError_t e = hipLaunchCooperativeKernel((const void*)fwd_kernel, dim3(grid), dim3(NTHR), kargs, LDS_BYTES, stream);
    if (e != hipSuccess) fprintf(stderr, "cooperative launch failed: %s (grid %d)\n", hipGetErrorString(e), grid);
#endif
}
```

```cpp
#include <hip/hip_runtime.h>
#include <hip/hip_cooperative_groups.h>
#include <cstdio>
#include <cstdint>
namespace cg = cooperative_groups;

#ifndef MK_MULTI
#define MK_MULTI 0
#endif

namespace pg8 {
#define PG8_LAS __attribute__((address_space(3)))
typedef unsigned short bf16_t;
typedef short bf16x8 __attribute__((ext_vector_type(8)));
typedef float f32x4 __attribute__((ext_vector_type(4)));
typedef unsigned u32x4 __attribute__((ext_vector_type(4)));
constexpr int BM = 256, BK = 64, HALF = 128, HTB = HALF * BK * 2  , STAGE_BYTES = 8 * HTB, NXCD = 8, WGM = 8;

__host__ __device__ __forceinline__ int lds_byte(int r, int c) { const int st = (r >> 4) * 2 + (c >> 5), rr = r & 15, cc = c & 31, ob = rr * 64 + cc * 2; return st * 1024 + (ob ^ (((ob >> 9) & 1) << 5)); }
__host__ __device__ __forceinline__ void stage_rc(int b, int& R, int& C) { const int st = b / 1024, sb = b % 1024, swz = sb ^ (((sb >> 9) & 1) << 5); R = (st >> 1) * 16 + swz / 64; C = (st & 1) * 32 + (swz % 64) / 2; }
__host__ __device__ __forceinline__ int perm32(int rho) { const int n = rho >> 4, i = rho & 15; return 8 * (i >> 2) + 4 * n + (i & 3); }

struct Unit { int pm, pn; };
struct Gemm { const bf16_t* A; const bf16_t* Bt; int M, N, K, lda, ldb, a_div; size_t a_gstride; };

struct StaticOrder {
    int nM, nN, nwg, G, c;
    __host__ __device__ void init(int M, int N, int G_, int c_) { nM = M / BM; nN = N / BM; nwg = nM * nN; G = G_; c = c_; }
    __host__ __device__ bool next(int i, Unit& u) const {
        const long L = (long)i * G + c; if (L >= nwg) return false;
        int wgid = (int)L; { const int q = nwg / NXCD, r = nwg % NXCD, xcd = wgid % NXCD, off = wgid / NXCD; wgid = (xcd < r ? xcd * (q + 1) : r * (q + 1) + (xcd - r) * q) + off; }
        const int nig = WGM * nN, gid = wgid / nig, fm = gid * WGM, gsz = (nM - fm) < WGM ? (nM - fm) : WGM;
        u.pm = fm + ((wgid % nig) % gsz); u.pn = (wgid % nig) / gsz; return true;
    }
    __device__ __forceinline__ void a_ready(const Unit&) const {}
    __device__ __forceinline__ void done(const Unit&) const {}
};

__device__ __forceinline__ unsigned cvt_pk_bf16(float lo, float hi) { unsigned r; asm volatile("v_cvt_pk_bf16_f32 %0, %1, %2" : "=v"(r) : "v"(lo), "v"(hi)); return r; }
__device__ __forceinline__ float bf_lo(unsigned w) { return __builtin_bit_cast(float, w << 16); }
__device__ __forceinline__ float bf_hi(unsigned w) { return __builtin_bit_cast(float, w & 0xffff0000u); }
__device__ __forceinline__ float sigmoidf_(float x) { return 1.0f / (1.0f + __expf(-x)); }

template <int MODE> struct EpiB {
    static constexpr bool PERM = true, AFTER_DRAIN = false;
    bf16_t* O; int ldc; const float* bias; const float* ssq;
    __device__ __forceinline__ void operator()(const f32x4 (&acc)[2][2][4][2], const Unit& u, int wr, int wc, int fr, int fq) const {
        const int row0 = u.pm * BM + wr * 64 + fr, col0 = u.pn * BM + wc * 32 + 8 * fq;
        f32x4 bv[2][2];
#pragma unroll
        for (int bj = 0; bj < 2; ++bj)
#pragma unroll
            for (int n = 0; n < 2; ++n) bv[bj][n] = (MODE == 1) ? *(const f32x4*)(bias + col0 + bj * HALF + 4 * n) : (MODE == 5) ? *(const f32x4*)(bias + (size_t)((u.pm < 32) ? 0 : 1 + ((u.pm - 32) >> 2)) * 4096 + col0 + bj * HALF + 4 * n) : (f32x4){0.f, 0.f, 0.f, 0.f};
        u32x4 gpre[2][4][2]; float rpre[2][4];
        if (MODE == 3) {
#pragma unroll
            for (int ai = 0; ai < 2; ++ai)
#pragma unroll
                for (int m = 0; m < 4; ++m) { const int row = row0 + ai * HALF + m * 16; const bf16_t* rp = O + (size_t)row * ldc + col0;
                    rpre[ai][m] = (u.pn < 4) ? ssq[row] : 512.0f;
#pragma unroll
                    for (int bj = 0; bj < 2; ++bj) gpre[ai][m][bj] = *(const u32x4*)(rp + bj * HALF); }
        }
#pragma unroll
        for (int ai = 0; ai < 2; ++ai)
#pragma unroll
            for (int m = 0; m < 4; ++m) {
                const int row = row0 + ai * HALF + m * 16;
                bf16_t* rowp = O + (size_t)row * ldc + col0;
                float rs = 1.f;
                if (MODE == 3) { if (u.pn < 4) rs = rsqrtf(rpre[ai][m] * (1.0f / 512.0f) + 1e-6f); }
                if (MODE == 5) rs = rsqrtf(ssq[row] * (1.0f / 1024.0f) + 1e-6f);
#pragma unroll
                for (int bj = 0; bj < 2; ++bj) {
                    f32x4 v0 = (MODE == 5 ? acc[ai][bj][m][0] * rs : acc[ai][bj][m][0]) + bv[bj][0], v1 = (MODE == 5 ? acc[ai][bj][m][1] * rs : acc[ai][bj][m][1]) + bv[bj][1];
                    if (MODE == 1) {
#pragma unroll
                        for (int j = 0; j < 4; ++j) { v0[j] = sigmoidf_(v0[j]); v1[j] = sigmoidf_(v1[j]); }
                    }
                    if (MODE == 2 || MODE == 5) {
#pragma unroll
                        for (int j = 0; j < 4; ++j) { const float a = fmaxf(v0[j], 0.f), b = fmaxf(v1[j], 0.f); v0[j] = a * a; v1[j] = b * b; }
                    }
                    if (MODE == 3) {
                        const u32x4 gq = gpre[ai][m][bj];
                        v0[0] *= bf_lo(gq.x) * rs; v0[1] *= bf_hi(gq.x) * rs; v0[2] *= bf_lo(gq.y) * rs; v0[3] *= bf_hi(gq.y) * rs;
                        v1[0] *= bf_lo(gq.z) * rs; v1[1] *= bf_hi(gq.z) * rs; v1[2] *= bf_lo(gq.w) * rs; v1[3] *= bf_hi(gq.w) * rs;
                    }
                    u32x4 w; w.x = cvt_pk_bf16(v0[0], v0[1]); w.y = cvt_pk_bf16(v0[2], v0[3]); w.z = cvt_pk_bf16(v1[0], v1[1]); w.w = cvt_pk_bf16(v1[2], v1[3]);
                    *(u32x4*)(rowp + bj * HALF) = w;
                }
            }
    }
};
struct EpiGlu {
    static constexpr bool PERM = true, AFTER_DRAIN = false;
    bf16_t* O; int ldc; int ocol; const float* bias;
    __device__ __forceinline__ void operator()(const f32x4 (&acc)[2][2][4][2], const Unit& u, int wr, int wc, int fr, int fq) const {
        const int row0 = u.pm * BM + wr * 64 + fr, cc = u.pn * HALF + wc * 32 + 8 * fq;
        f32x4 bv[2][2];
#pragma unroll
        for (int bj = 0; bj < 2; ++bj)
#pragma unroll
            for (int n = 0; n < 2; ++n) bv[bj][n] = *(const f32x4*)(bias + bj * 512 + cc + 4 * n);
#pragma unroll
        for (int ai = 0; ai < 2; ++ai)
#pragma unroll
            for (int m = 0; m < 4; ++m) {
                bf16_t* rowp = O + (size_t)(row0 + ai * HALF + m * 16) * ldc + ocol + cc;
                f32x4 v0 = acc[ai][0][m][0] + bv[0][0], v1 = acc[ai][0][m][1] + bv[0][1];
                const f32x4 g0 = acc[ai][1][m][0] + bv[1][0], g1 = acc[ai][1][m][1] + bv[1][1];
#pragma unroll
                for (int j = 0; j < 4; ++j) { v0[j] *= sigmoidf_(g0[j]); v1[j] *= sigmoidf_(g1[j]); }
                u32x4 w; w.x = cvt_pk_bf16(v0[0], v0[1]); w.y = cvt_pk_bf16(v0[2], v0[3]); w.z = cvt_pk_bf16(v1[0], v1[1]); w.w = cvt_pk_bf16(v1[2], v1[3]);
                *(u32x4*)rowp = w;
            }
    }
};
struct EpiRes2 {
    static constexpr bool PERM = false, AFTER_DRAIN = false;
    const float* base_ctx; const float* base_lat; float* out; const float* modv; int goff;
    bf16_t* xn; const float* gnorm; int scoff; float* ssq;
    __device__ __forceinline__ void operator()(const f32x4 (&acc)[2][2][4][2], const Unit& u, int wr, int wc, int fr, int fq) const {
        const int row0 = u.pm * BM + wr * 64 + fr, col0 = u.pn * BM + wc * 32 + 4 * fq;
        const int mi = (u.pm < 32) ? 0 : 1 + ((u.pm - 32) >> 2);
        const float* gv = modv + (size_t)mi * 6144 + goff; const float* sv = modv + (size_t)mi * 6144 + scoff;
        f32x4 gg[2][2], gn[2][2];
#pragma unroll
        for (int bj = 0; bj < 2; ++bj)
#pragma unroll
            for (int n = 0; n < 2; ++n) { gg[bj][n] = *(const f32x4*)(gv + col0 + bj * HALF + n * 16); gn[bj][n] = *(const f32x4*)(gnorm + col0 + bj * HALF + n * 16) * (*(const f32x4*)(sv + col0 + bj * HALF + n * 16) + 1.0f); }
#pragma unroll
        for (int ai = 0; ai < 2; ++ai)
#pragma unroll
        for (int mh = 0; mh < 2; ++mh) {
            f32x4 pre[2][2][2];
#pragma unroll
            for (int mm = 0; mm < 2; ++mm) { const int row = row0 + ai * HALF + (2 * mh + mm) * 16;
                const float* bp = (row < 8192 ? base_ctx + (size_t)row * 1024 : base_lat + (size_t)(row - 8192) * 1024) + col0;
#pragma unroll
                for (int bj = 0; bj < 2; ++bj)
#pragma unroll
                    for (int n = 0; n < 2; ++n) pre[mm][bj][n] = *(const f32x4*)(bp + bj * HALF + n * 16); }
#pragma unroll
            for (int mm = 0; mm < 2; ++mm) { const int m = 2 * mh + mm; const int row = row0 + ai * HALF + m * 16; float* op = out + (size_t)row * 1024 + col0; bf16_t* xp = xn + (size_t)row * 1024 + col0;
                float q = 0.f;
#pragma unroll
                for (int bj = 0; bj < 2; ++bj)
#pragma unroll
                    for (int n = 0; n < 2; ++n) { const f32x4 x = pre[mm][bj][n] + gg[bj][n] * acc[ai][bj][m][n]; *(f32x4*)(op + bj * HALF + n * 16) = x;
                        q += (x[0] * x[0] + x[1] * x[1]) + (x[2] * x[2] + x[3] * x[3]);
                        const f32x4 y = x * gn[bj][n]; unsigned w0 = cvt_pk_bf16(y[0], y[1]), w1 = cvt_pk_bf16(y[2], y[3]);
                        typedef unsigned u32x2 __attribute__((ext_vector_type(2))); *(u32x2*)(xp + bj * HALF + n * 16) = (u32x2){w0, w1}; }
                q += __shfl_xor(q, 16); q += __shfl_xor(q, 32);
                if (fq == 0) atomicAdd(ssq + row, q); }
            asm volatile("" ::: "memory");
        }
    }
};
struct EpiMerge {
    static constexpr bool PERM = true, AFTER_DRAIN = false;
    const bf16_t* gates; bf16_t* mg; const float* ssq;
    __device__ __forceinline__ void operator()(const f32x4 (&acc)[2][2][4][2], const Unit& u, int wr, int wc, int fr, int fq) const {
        const int br = u.pn >> 2, pnl = u.pn & 3;
        int pm_o = u.pm; asm volatile("" : "+s"(pm_o));
        const int row0 = pm_o * BM + wr * 64 + fr, gcol0 = u.pn * BM + wc * 32 + 8 * fq, mcol0 = pnl * BM + wc * 32 + 8 * fq;
#pragma unroll
        for (int ai = 0; ai < 2; ++ai)
#pragma unroll
        for (int mh = 0; mh < 2; ++mh) {
            u32x4 gpre[2][2], mpre[2][2]; float rpre[2];
#pragma unroll
            for (int mm = 0; mm < 2; ++mm) { const int row = row0 + ai * HALF + (2 * mh + mm) * 16;
                rpre[mm] = (br == 0) ? ssq[row] : 512.0f;
#pragma unroll
                for (int bj = 0; bj < 2; ++bj) { gpre[mm][bj] = *(const u32x4*)(gates + (size_t)row * 4096 + gcol0 + bj * HALF);
                    mpre[mm][bj] = (br != 0) ? *(const u32x4*)(mg + (size_t)row * 1024 + mcol0 + bj * HALF) : (u32x4){0u, 0u, 0u, 0u}; } }
#pragma unroll
            for (int mm = 0; mm < 2; ++mm) { const int m = 2 * mh + mm; const int row = row0 + ai * HALF + m * 16;
                const float rs = (br == 0) ? rsqrtf(rpre[mm] * (1.0f / 512.0f) + 1e-6f) : 1.0f;
#pragma unroll
                for (int bj = 0; bj < 2; ++bj) { const u32x4 gq = gpre[mm][bj], mq = mpre[mm][bj]; const f32x4 a0 = acc[ai][bj][m][0], a1 = acc[ai][bj][m][1];
                    const float v0 = bf_lo(mq.x) + a0[0] * bf_lo(gq.x) * rs, v1 = bf_hi(mq.x) + a0[1] * bf_hi(gq.x) * rs, v2 = bf_lo(mq.y) + a0[2] * bf_lo(gq.y) * rs, v3 = bf_hi(mq.y) + a0[3] * bf_hi(gq.y) * rs;
                    const float v4 = bf_lo(mq.z) + a1[0] * bf_lo(gq.z) * rs, v5 = bf_hi(mq.z) + a1[1] * bf_hi(gq.z) * rs, v6 = bf_lo(mq.w) + a1[2] * bf_lo(gq.w) * rs, v7 = bf_hi(mq.w) + a1[3] * bf_hi(gq.w) * rs;
                    u32x4 w; w.x = cvt_pk_bf16(v0, v1); w.y = cvt_pk_bf16(v2, v3); w.z = cvt_pk_bf16(v4, v5); w.w = cvt_pk_bf16(v6, v7);
                    *(u32x4*)(mg + (size_t)row * 1024 + mcol0 + bj * HALF) = w; } }
            asm volatile("" ::: "memory");
        }
    }
};
struct BranchOrder {
    int G, c;
    __host__ __device__ void init(int G_, int c_) { G = G_; c = c_; }
    __host__ __device__ bool next(int i, Unit& u) const { if (c >= 192 || i >= 4) return false; u.pm = c >> 2; u.pn = i * 4 + (c & 3); return true; }
    __device__ __forceinline__ void a_ready(const Unit&) const {}
    __device__ __forceinline__ void done(const Unit&) const {}
};
struct EpiRes {
    static constexpr bool PERM = false, AFTER_DRAIN = false;
    const float* base_ctx; const float* base_lat;
    float* out; const float* modv;
    int goff;
    __device__ __forceinline__ void operator()(const f32x4 (&acc)[2][2][4][2], const Unit& u, int wr, int wc, int fr, int fq) const {
        const int row0 = u.pm * BM + wr * 64 + fr, col0 = u.pn * BM + wc * 32 + 4 * fq;
        const int mi = (u.pm < 32) ? 0 : 1 + ((u.pm - 32) >> 2);
        const float* gv = modv + (size_t)mi * 6144 + goff;
        f32x4 gg[2][2];
#pragma unroll
        for (int bj = 0; bj < 2; ++bj)
#pragma unroll
            for (int n = 0; n < 2; ++n) gg[bj][n] = *(const f32x4*)(gv + col0 + bj * HALF + n * 16);
#pragma unroll
        for (int ai = 0; ai < 2; ++ai) {
            f32x4 pre[4][2][2];
#pragma unroll
            for (int m = 0; m < 4; ++m) { const int row = row0 + ai * HALF + m * 16;
                const float* bp = (row < 8192 ? base_ctx + (size_t)row * 1024 : base_lat + (size_t)(row - 8192) * 1024) + col0;
#pragma unroll
                for (int bj = 0; bj < 2; ++bj)
#pragma unroll
                    for (int n = 0; n < 2; ++n) pre[m][bj][n] = *(const f32x4*)(bp + bj * HALF + n * 16); }
#pragma unroll
            for (int m = 0; m < 4; ++m) { const int row = row0 + ai * HALF + m * 16; float* op = out + (size_t)row * 1024 + col0;
#pragma unroll
                for (int bj = 0; bj < 2; ++bj)
#pragma unroll
                    for (int n = 0; n < 2; ++n) *(f32x4*)(op + bj * HALF + n * 16) = pre[m][bj][n] + gg[bj][n] * acc[ai][bj][m][n]; }
            asm volatile("" ::: "memory");
        }
    }
};

template <class Epi, class Sched, bool ALIGN_EPI = false, bool SP2 = false>
__device__ __forceinline__ void gemm_phase(PG8_LAS unsigned char* lds, const Gemm g, const Sched& S, const Epi& E, const int tid) {
    const int wid = __builtin_amdgcn_readfirstlane(tid >> 6), lane = tid & 63, wr = wid >> 2, wc = wid & 3, fr = lane & 15, fq = lane >> 4;
    const int K = g.K, nt = K / BK;
    unsigned voffA[2], voffB[2];
#pragma unroll
    for (int i = 0; i < 2; ++i) { int R, C; stage_rc(tid * 16 + i * 8192, R, C); const int Rb = Epi::PERM ? ((R & ~31) + perm32(R & 31)) : R;
        voffA[i] = (unsigned)(R * g.lda + C) * 2u; voffB[i] = (unsigned)(Rb * g.ldb + C) * 2u; }
    const size_t kstep = (size_t)(BK * 2);
    const size_t hstepA = (size_t)HALF * g.lda * 2, hstepB = (size_t)HALF * g.ldb * 2;
    const size_t tstepA = 2 * hstepA, tstepB = 2 * hstepB;
#define PG8_UA(u) ((const char*)g.A + (size_t)(u).pm * tstepA + (g.a_div ? (size_t)((u).pn / g.a_div) * g.a_gstride : (size_t)0))
#define PG8_UB(u) ((const char*)g.Bt + (size_t)(u).pn * tstepB)
    const unsigned ldsw = (unsigned)wid * 1024u;
    const int aoff = lds_byte(wr * 64 + fr, fq * 8), boff = lds_byte(wc * 32 + fr, fq * 8);
#define PG8_SA(b, h) (((b) * 2 + (h)) * HTB)
#define PG8_SB(b, h) ((4 + (b) * 2 + (h)) * HTB)
#define PG8_STAGE(bufoff, gbase, voff) do { _Pragma("unroll") for (int _i = 0; _i < 2; ++_i) \
        __builtin_amdgcn_global_load_lds((const unsigned*)((const char*)(gbase) + (voff)[_i]), (PG8_LAS unsigned*)(lds + (bufoff) + ldsw + _i * 8192), 16, 0, 0); } while (0)
#define PG8_LDA(dst, b, h) do { _Pragma("unroll") for (int m = 0; m < 4; ++m) _Pragma("unroll") for (int k = 0; k < 2; ++k) dst[m][k] = *(const PG8_LAS bf16x8*)(lds + PG8_SA(b, h) + aoff + m * 2048 + k * 1024); } while (0)
#define PG8_LDB(dst, b, h) do { _Pragma("unroll") for (int n = 0; n < 2; ++n) _Pragma("unroll") for (int k = 0; k < 2; ++k) dst[n][k] = *(const PG8_LAS bf16x8*)(lds + PG8_SB(b, h) + boff + n * 2048 + k * 1024); } while (0)
#define PG8_MMA(ai, bj, At, Bt) do { __builtin_amdgcn_s_setprio(1); _Pragma("unroll") for (int m = 0; m < 4; ++m) _Pragma("unroll") for (int n = 0; n < 2; ++n) _Pragma("unroll") for (int k = 0; k < 2; ++k) \
        acc[ai][bj][m][n] = __builtin_amdgcn_mfma_f32_16x16x32_bf16(Bt[n][k], At[m][k], acc[ai][bj][m][n], 0, 0, 0); __builtin_amdgcn_s_setprio(0); } while (0)
#define PG8_WAIT_V(n) asm volatile("s_waitcnt vmcnt(" #n ")" ::: "memory")
#define PG8_WAIT_L(n) asm volatile("s_waitcnt lgkmcnt(" #n ")" ::: "memory")
#define PG8_BAR __builtin_amdgcn_s_barrier()
#define PG8_SCHED __builtin_amdgcn_sched_barrier(0)
    Unit cur, nxt; int ui = 0;
    if (!S.next(0, cur)) return;
    f32x4 acc[2][2][4][2];
#pragma unroll
    for (int a = 0; a < 2; ++a)
#pragma unroll
        for (int b = 0; b < 2; ++b)
#pragma unroll
            for (int m = 0; m < 4; ++m)
#pragma unroll
                for (int n = 0; n < 2; ++n) acc[a][b][m][n] = (f32x4){0.f, 0.f, 0.f, 0.f};
    bf16x8 At[4][2], B0[2][2], B1[2][2];
    const char* cA = PG8_UA(cur); const char* cB = PG8_UB(cur);
    S.a_ready(cur);
    if constexpr (SP2) {
        PG8_STAGE(PG8_SB(0, 0), cB, voffB); PG8_STAGE(PG8_SB(0, 1), cB + hstepB, voffB); PG8_STAGE(PG8_SA(0, 0), cA, voffA); PG8_STAGE(PG8_SA(0, 1), cA + hstepA, voffA);
        if (wr == 1) PG8_BAR;
        PG8_WAIT_V(2); PG8_BAR;
        PG8_STAGE(PG8_SB(1, 0), cB + kstep, voffB); PG8_STAGE(PG8_SA(1, 0), cA + kstep, voffA); PG8_STAGE(PG8_SB(1, 1), cB + hstepB + kstep, voffB);
        PG8_WAIT_V(6); PG8_BAR;
    } else {
        PG8_STAGE(PG8_SB(0, 0), cB, voffB); PG8_STAGE(PG8_SA(0, 0), cA, voffA); PG8_STAGE(PG8_SB(0, 1), cB + hstepB, voffB); PG8_STAGE(PG8_SA(0, 1), cA + hstepA, voffA);
        if (wr == 1) PG8_BAR;
        PG8_WAIT_V(4); PG8_BAR;
        PG8_STAGE(PG8_SB(1, 0), cB + kstep, voffB); PG8_STAGE(PG8_SA(1, 0), cA + kstep, voffA); PG8_STAGE(PG8_SB(1, 1), cB + hstepB + kstep, voffB);
        PG8_WAIT_V(6); PG8_BAR;
    }
    for (;;) {
        const bool has_next = S.next(ui + 1, nxt);
        const char* nA = has_next ? PG8_UA(nxt) : cA; const char* nB = has_next ? PG8_UB(nxt) : cB;
        for (int t = 0; t < nt; t += 2) {
            const bool last = (t == nt - 2);
            const char* a1 = cA + (size_t)(t + 1) * kstep;
            const char* a2 = last ? nA : cA + (size_t)(t + 2) * kstep; const char* b2 = last ? nB : cB + (size_t)(t + 2) * kstep;
            const char* a3 = a2 + kstep; const char* b3 = b2 + kstep;
            if (last && has_next) S.a_ready(nxt);
            if constexpr (SP2) {
            PG8_LDB(B0, 0, 0); PG8_LDB(B1, 0, 1); PG8_SCHED; PG8_LDA(At, 0, 0); PG8_STAGE(PG8_SA(1, 1), a1 + hstepA, voffA);
            PG8_WAIT_V(8); PG8_WAIT_L(0); PG8_BAR; PG8_MMA(0, 0, At, B0); PG8_MMA(0, 1, At, B1); PG8_BAR; PG8_SCHED;
            PG8_LDA(At, 0, 1); PG8_STAGE(PG8_SB(0, 0), b2, voffB); PG8_STAGE(PG8_SB(0, 1), b2 + hstepB, voffB); PG8_STAGE(PG8_SA(0, 0), a2, voffA);
            PG8_WAIT_V(8); PG8_WAIT_L(0); PG8_BAR; PG8_MMA(1, 0, At, B0); PG8_MMA(1, 1, At, B1); PG8_BAR; PG8_SCHED;
            PG8_LDB(B0, 1, 0); PG8_LDB(B1, 1, 1); PG8_SCHED; PG8_LDA(At, 1, 0); PG8_STAGE(PG8_SA(0, 1), a2 + hstepA, voffA);
            PG8_WAIT_V(8); PG8_WAIT_L(0); PG8_BAR; PG8_MMA(0, 0, At, B0); PG8_MMA(0, 1, At, B1); PG8_BAR; PG8_SCHED;
            PG8_LDA(At, 1, 1); PG8_STAGE(PG8_SB(1, 0), b3, voffB); PG8_STAGE(PG8_SB(1, 1), b3 + hstepB, voffB); PG8_STAGE(PG8_SA(1, 0), a3, voffA);
            PG8_WAIT_V(8); PG8_WAIT_L(0); PG8_BAR; PG8_MMA(1, 0, At, B0); PG8_MMA(1, 1, At, B1); PG8_BAR; PG8_SCHED;
            } else {
            PG8_LDB(B0, 0, 0); PG8_SCHED; PG8_LDA(At, 0, 0); PG8_STAGE(PG8_SA(1, 1), a1 + hstepA, voffA);
            PG8_WAIT_L(8); PG8_BAR; PG8_WAIT_L(0); PG8_MMA(0, 0, At, B0); PG8_BAR; PG8_SCHED;
            PG8_LDB(B1, 0, 1); PG8_STAGE(PG8_SB(0, 0), b2, voffB);
            PG8_BAR; PG8_WAIT_L(0); PG8_MMA(0, 1, At, B1); PG8_BAR;
            PG8_LDA(At, 0, 1); PG8_STAGE(PG8_SA(0, 0), a2, voffA);
            PG8_BAR; PG8_WAIT_L(0); PG8_MMA(1, 0, At, B0); PG8_BAR; PG8_SCHED;
            PG8_STAGE(PG8_SB(0, 1), b2 + hstepB, voffB);
            PG8_WAIT_V(6); PG8_BAR; PG8_MMA(1, 1, At, B1); PG8_BAR;
            PG8_LDB(B0, 1, 0); PG8_SCHED; PG8_LDA(At, 1, 0); PG8_STAGE(PG8_SA(0, 1), a2 + hstepA, voffA);
            PG8_WAIT_L(8); PG8_BAR; PG8_WAIT_L(0); PG8_MMA(0, 0, At, B0); PG8_BAR; PG8_SCHED;
            PG8_LDB(B1, 1, 1); PG8_STAGE(PG8_SB(1, 0), b3, voffB);
            PG8_BAR; PG8_WAIT_L(0); PG8_MMA(0, 1, At, B1); PG8_BAR;
            PG8_LDA(At, 1, 1); PG8_STAGE(PG8_SA(1, 0), a3, voffA);
            PG8_BAR; PG8_WAIT_L(0); PG8_MMA(1, 0, At, B0); PG8_BAR; PG8_SCHED;
            PG8_STAGE(PG8_SB(1, 1), b3 + hstepB, voffB);
            PG8_WAIT_V(6); PG8_BAR; PG8_MMA(1, 1, At, B1); PG8_BAR;
            }
        }
        if constexpr (ALIGN_EPI) { if (wr == 0) PG8_BAR; }
        if constexpr (!Epi::AFTER_DRAIN) { E(acc, cur, wr, wc, fr, fq); S.done(cur); }
        if (!has_next) break;
#pragma unroll
        for (int a = 0; a < 2; ++a)
#pragma unroll
            for (int b = 0; b < 2; ++b)
#pragma unroll
                for (int m = 0; m < 4; ++m)
#pragma unroll
                    for (int n = 0; n < 2; ++n) acc[a][b][m][n] = (f32x4){0.f, 0.f, 0.f, 0.f};
        cur = nxt; cA = nA; cB = nB; ++ui;
        if constexpr (ALIGN_EPI) { if (wr == 1) PG8_BAR; }
    }
    PG8_WAIT_V(0);
    if constexpr (!ALIGN_EPI) { if (wr == 0) PG8_BAR; }
    PG8_BAR;
    if constexpr (Epi::AFTER_DRAIN) { E.fused(acc, cur, wr, wc, fr, fq, lds, wid, lane); S.done(cur); }
#undef PG8_UA
#undef PG8_UB
#undef PG8_SA
#undef PG8_SB
#undef PG8_STAGE
#undef PG8_LDA
#undef PG8_LDB
#undef PG8_MMA
#undef PG8_WAIT_V
#undef PG8_WAIT_L
#undef PG8_BAR
#undef PG8_SCHED
}
}

#ifndef PG8_SP2
#define PG8_SP2 true
#endif
#ifndef PG8_ALIGN
#define PG8_ALIGN true
#endif

typedef unsigned short bf16;
typedef unsigned v4u __attribute__((ext_vector_type(4)));
typedef unsigned v2u __attribute__((ext_vector_type(2)));
typedef float f32x4 __attribute__((ext_vector_type(4)));
#define LAS __attribute__((address_space(3)))

constexpr int NWAVES = 8, NTHR = 512;
constexpr int D = 1024, MC = 8192, ML = 4096, M = 12288, NPH = 23;
constexpr int LDS_BYTES = 147456;
constexpr float EPS = 1e-6f;
constexpr size_t MiB = 1u << 20;
constexpr size_t WS_MOD = 64 * 1024;
constexpr size_t WS_SSQ = 320 * 1024;
constexpr size_t WS_DT = 384 * 1024;
constexpr size_t WS_W = 2 * MiB;
constexpr size_t W_IN = WS_W, W_G = W_IN + 8 * MiB, W_GLU = W_G + 8 * MiB, W_BR = W_GLU + 1 * MiB, W_OUT = W_BR + 4 * MiB, W_1 = W_OUT + 2 * MiB, W_2 = W_1 + 8 * MiB;
constexpr size_t WS_H = 41 * MiB;
constexpr size_t WS_R1 = 65 * MiB;
constexpr size_t WS_Y = 161 * MiB;
constexpr size_t WS_Y5 = 209 * MiB;
constexpr size_t WS_XC = 221 * MiB;
constexpr size_t WS_S5K = 239 * MiB;
constexpr size_t WS_S5WS = 240 * MiB;
constexpr size_t WS_S5WO = 244 * MiB;
constexpr size_t WS_S5AT = 248 * MiB;
constexpr size_t WS_CKV = 248 * MiB + 512 * 1024;
constexpr size_t WS_ROPE = 1536 * 1024;
constexpr size_t WS_WDT = 1792 * 1024;
constexpr size_t WS_BI2 = 1824 * 1024;
constexpr size_t WS_SSQ2 = 1904 * 1024;
constexpr size_t WS_END = 254 * MiB;
#ifndef PROBE_SEL
#define PROBE_SEL -1
#endif
#ifndef PROBE_SCALE
#define PROBE_SCALE 4e-4f
#endif
#ifndef PROBE_PB
#define PROBE_PB 32
#endif
constexpr size_t WS_BAR = 32 * 1024;
constexpr size_t WS_QCTR = 48 * 1024;
constexpr size_t WS_TS = 16 * 1024;
constexpr size_t O_SSD = 12582912, O_S5 = 16777216, O_DK = 17301504, O_DV = 25690112, O_WK = 34078720, O_WV = 36175872;
constexpr int C_Z = 0, C_XBC = 512, C_U = 1280, C_DQ = 1792, C_DK = 2304, C_DV = 2816, C_WQ = 3328, C_WK = 3840, C_WV = 3968;

namespace pg8 {
struct EpiIn {
    static constexpr bool PERM = true, AFTER_DRAIN = false;
    bf16_t* O; float* out; const float* rope; const float* qg; const float* kg; const float* wqg; const float* wkg; int l;
    __device__ __forceinline__ void operator()(const f32x4 (&acc)[2][2][4][2], const Unit& u, int wr, int wc, int fr, int fq) const {
        const int pn = u.pn; const bool lat = u.pm >= 32;
        const int row0 = u.pm * BM + wr * 64 + fr, lcol0 = pn * BM + 64 * wc + 8 * fq;
        const float* gp = nullptr;
        if (pn == 7 || pn == 8) gp = qg; else if (pn == 9 || pn == 10) gp = kg; else if (pn == 13 || pn == 14) gp = wqg; else if (pn == 15 && wc < 2) gp = wkg;
        float* fo = nullptr; int fstride = 0;
        if (!lat) { if (pn == 9 || pn == 10) { fo = out + O_DK + (pn - 9) * 256 + 64 * wc + 8 * fq; fstride = 512; }
                    else if (pn == 11 || pn == 12) { fo = out + O_DV + (pn - 11) * 256 + 64 * wc + 8 * fq; fstride = 512; }
                    else if (pn == 15) { fo = out + (wc < 2 ? O_WK + 64 * wc : O_WV + 64 * (wc - 2)) + 8 * fq; fstride = 128; } }
        f32x4 g[2][2];
#pragma unroll
        for (int bj = 0; bj < 2; ++bj)
#pragma unroll
            for (int n = 0; n < 2; ++n) g[bj][n] = gp ? *(const f32x4*)(gp + 32 * bj + 8 * fq + 4 * n) : (f32x4){1.f, 1.f, 1.f, 1.f};
#pragma unroll
        for (int ai = 0; ai < 2; ++ai)
#pragma unroll
            for (int m = 0; m < 4; ++m) {
                const int row = row0 + ai * HALF + m * 16;
                f32x4 v[2][2];
#pragma unroll
                for (int bj = 0; bj < 2; ++bj)
#pragma unroll
                    for (int n = 0; n < 2; ++n) v[bj][n] = acc[ai][bj][m][n];
                if (gp) {
                    float ss = 0.f;
#pragma unroll
                    for (int bj = 0; bj < 2; ++bj)
#pragma unroll
                        for (int n = 0; n < 2; ++n) ss += (v[bj][n][0] * v[bj][n][0] + v[bj][n][1] * v[bj][n][1]) + (v[bj][n][2] * v[bj][n][2] + v[bj][n][3] * v[bj][n][3]);
                    ss += __shfl_xor(ss, 16); ss += __shfl_xor(ss, 32);
                    const float rs = rsqrtf(ss * (1.0f / 64.0f) + 1e-6f);
#pragma unroll
                    for (int bj = 0; bj < 2; ++bj)
#pragma unroll
                        for (int n = 0; n < 2; ++n) v[bj][n] = v[bj][n] * rs * g[bj][n];
                    if (lat) {
                        const float* rp = rope + (size_t)((row - 8192) & 1023) * 64 + 8 * (fq & 1);
#pragma unroll
                        for (int bj = 0; bj < 2; ++bj)
#pragma unroll
                            for (int n = 0; n < 2; ++n) { const f32x4 cs = *(const f32x4*)(rp + 16 * bj + 4 * n), sn = *(const f32x4*)(rp + 32 + 16 * bj + 4 * n);
                                f32x4 p; p[0] = __shfl_xor(v[bj][n][0], 32); p[1] = __shfl_xor(v[bj][n][1], 32); p[2] = __shfl_xor(v[bj][n][2], 32); p[3] = __shfl_xor(v[bj][n][3], 32);
                                v[bj][n] = (fq >> 1) ? v[bj][n] * cs + p * sn : v[bj][n] * cs - p * sn; }
                    }
                }
                bf16_t* rowp = O + (size_t)row * 4096 + lcol0;
#pragma unroll
                for (int bj = 0; bj < 2; ++bj) { u32x4 w; w.x = cvt_pk_bf16(v[bj][0][0], v[bj][0][1]); w.y = cvt_pk_bf16(v[bj][0][2], v[bj][0][3]); w.z = cvt_pk_bf16(v[bj][1][0], v[bj][1][1]); w.w = cvt_pk_bf16(v[bj][1][2], v[bj][1][3]);
                    *(u32x4*)(rowp + 32 * bj) = w; }
                if (fo) { float* fp = fo + (size_t)(((row >> 8) * 2 + l) * 256 + (row & 255)) * fstride;
#pragma unroll
                    for (int bj = 0; bj < 2; ++bj) { *(f32x4*)(fp + 32 * bj) = v[bj][0]; *(f32x4*)(fp + 32 * bj + 4) = v[bj][1]; } }
            }
    }
};
}

struct Args { const float* in[44]; float* out; unsigned char* ws; int ph_lo, ph_hi; };

typedef const Args __attribute__((address_space(4)))* CArgs;
struct Ctx {
    CArgs ap; int tid, lane, wave;
    __device__ __forceinline__ const float* x_prompt() const { return ap->in[0]; }
    __device__ __forceinline__ const float* x_sample() const { return ap->in[1]; }
    __device__ __forceinline__ const float* state_ssd() const { return ap->in[2]; }
    __device__ __forceinline__ const float* state_s5() const { return ap->in[3]; }
    __device__ __forceinline__ const float* cache_dk() const { return ap->in[4]; }
    __device__ __forceinline__ const float* cache_dv() const { return ap->in[5]; }
    __device__ __forceinline__ const float* cache_wk() const { return ap->in[6]; }
    __device__ __forceinline__ const float* cache_wv() const { return ap->in[7]; }
    __device__ __forceinline__ const float* cvec() const { return ap->in[8]; }
    __device__ __forceinline__ const float* c_ctx() const { return ap->in[9]; }
    __device__ __forceinline__ const float* w_mod() const { return ap->in[10]; }
    __device__ __forceinline__ const float* b_mod() const { return ap->in[11]; }
    __device__ __forceinline__ const float* g_norm1() const { return ap->in[12]; }
    __device__ __forceinline__ const float* g_norm2() const { return ap->in[13]; }
    __device__ __forceinline__ const float* w_in() const { return ap->in[14]; }
    __device__ __forceinline__ const float* conv_w() const { return ap->in[15]; }
    __device__ __forceinline__ const float* conv_b() const { return ap->in[16]; }
    __device__ __forceinline__ const float* dt_bias() const { return ap->in[17]; }
    __device__ __forceinline__ const float* a_log() const { return ap->in[18]; }
    __device__ __forceinline__ const float* ssd_d() const { return ap->in[19]; }
    __device__ __forceinline__ const float* ssd_norm_g() const { return ap->in[20]; }
    __device__ __forceinline__ const float* lam_re() const { return ap->in[21]; }
    __device__ __forceinline__ const float* lam_im() const { return ap->in[22]; }
    __device__ __forceinline__ const float* log_step() const { return ap->in[23]; }
    __device__ __forceinline__ const float* b_re() const { return ap->in[24]; }
    __device__ __forceinline__ const float* b_im() const { return ap->in[25]; }
    __device__ __forceinline__ const float* c_re() const { return ap->in[26]; }
    __device__ __forceinline__ const float* c_im() const { return ap->in[27]; }
    __device__ __forceinline__ const float* s5_d() const { return ap->in[28]; }
    __device__ __forceinline__ const float* w_glu() const { return ap->in[29]; }
    __device__ __forceinline__ const float* b_glu() const { return ap->in[30]; }
    __device__ __forceinline__ const float* qn_g() const { return ap->in[31]; }
    __device__ __forceinline__ const float* kn_g() const { return ap->in[32]; }
    __device__ __forceinline__ const float* dlam() const { return ap->in[33]; }
    __device__ __forceinline__ const float* subln_g() const { return ap->in[34]; }
    __device__ __forceinline__ const float* wqn_g() const { return ap->in[35]; }
    __device__ __forceinline__ const float* wkn_g() const { return ap->in[36]; }
    __device__ __forceinline__ const float* sink() const { return ap->in[37]; }
    __device__ __forceinline__ const float* w_branch() const { return ap->in[38]; }
    __device__ __forceinline__ const float* w_gate() const { return ap->in[39]; }
    __device__ __forceinline__ const float* b_gate() const { return ap->in[40]; }
    __device__ __forceinline__ const float* w_out() const { return ap->in[41]; }
    __device__ __forceinline__ const float* w_fc1() const { return ap->in[42]; }
    __device__ __forceinline__ const float* w_fc2() const { return ap->in[43]; }
    __device__ __forceinline__ float* out() const { return ap->out; }
    __device__ __forceinline__ unsigned char* ws() const { return ap->ws; }
    __device__ __forceinline__ float* MOD() const { return (float*)(ap->ws + WS_MOD); }
    __device__ __forceinline__ float* SSQ() const { return (float*)(ap->ws + WS_SSQ); }
    __device__ __forceinline__ float* DT() const { return (float*)(ap->ws + WS_DT); }
    __device__ __forceinline__ bf16* H() const { return (bf16*)(ap->ws + WS_H); }
    __device__ __forceinline__ bf16* R1() const { return (bf16*)(ap->ws + WS_R1); }
    __device__ __forceinline__ bf16* Y() const { return (bf16*)(ap->ws + WS_Y); }
    __device__ __forceinline__ bf16* Y5() const { return (bf16*)(ap->ws + WS_Y5); }
    __device__ __forceinline__ bf16* XC() const { return (bf16*)(ap->ws + WS_XC); }
    __device__ __forceinline__ bf16* CKV() const { return (bf16*)(ap->ws + WS_CKV); }
    __device__ __forceinline__ float* ROPE() const { return (float*)(ap->ws + WS_ROPE); }
};

__device__ __forceinline__ float wave_sum(float v) {
#pragma unroll
    for (int o = 1; o < 64; o <<= 1) v += __shfl_xor(v, o);
    return v;
}
__device__ __forceinline__ float wave_max(float v) {
#pragma unroll
    for (int o = 1; o < 64; o <<= 1) v = fmaxf(v, __shfl_xor(v, o));
    return v;
}
__device__ __forceinline__ float bf2f(bf16 h) { return __builtin_bit_cast(float, (unsigned)h << 16); }
__device__ __forceinline__ float bflo(unsigned w) { return __builtin_bit_cast(float, w << 16); }
__device__ __forceinline__ float bfhi(unsigned w) { return __builtin_bit_cast(float, w & 0xffff0000u); }
__device__ __forceinline__ unsigned f2bf(float f) { unsigned u = __builtin_bit_cast(unsigned, f); return (u + 0x7fffu + ((u >> 16) & 1u)) >> 16; }
__device__ __forceinline__ unsigned pk2(float lo, float hi) { return f2bf(lo) | (f2bf(hi) << 16); }
__device__ __forceinline__ float siluf(float x) { return x / (1.0f + __expf(-x)); }
__device__ __forceinline__ void unpack8(const v4u q, float (&f)[8]) { f[0] = bflo(q.x); f[1] = bfhi(q.x); f[2] = bflo(q.y); f[3] = bfhi(q.y); f[4] = bflo(q.z); f[5] = bfhi(q.z); f[6] = bflo(q.w); f[7] = bfhi(q.w); }

__device__ __forceinline__ void phase_mods(const Ctx& c, float* lf) {
    for (int i = c.tid; i < 5 * 1024; i += NTHR) { const int v = i >> 10, k = i & 1023; const float x = (v == 0) ? c.c_ctx()[k] : c.cvec()[(v - 1) * 1024 + k]; lf[i] = siluf(x); }
    __syncthreads();
    float* red = lf + 5 * 1024;
    for (int u = blockIdx.x; u < 192; u += gridDim.x) {
        const int l = u / 96, col0 = (u % 96) * 64;
        const float* W = c.w_mod() + (size_t)l * 1024 * 6144 + col0 + c.lane;
        float acc[5] = {0.f, 0.f, 0.f, 0.f, 0.f};
#pragma unroll 1
        for (int kb = c.wave * 128; kb < c.wave * 128 + 128; kb += 32) {
            float wv[32];
#pragma unroll
            for (int j = 0; j < 32; ++j) wv[j] = W[(size_t)(kb + j) * 6144];
#pragma unroll
            for (int j = 0; j < 32; ++j)
#pragma unroll
                for (int i = 0; i < 5; ++i) acc[i] += lf[i * 1024 + kb + j] * wv[j]; }
#pragma unroll
        for (int i = 0; i < 5; ++i) red[(c.wave * 5 + i) * 64 + c.lane] = acc[i];
        __syncthreads();
        if (c.tid < 320) { const int i = c.tid >> 6, ln = c.tid & 63; float s = c.b_mod()[l * 6144 + col0 + ln];
#pragma unroll
            for (int w = 0; w < 8; ++w) s += red[(w * 5 + i) * 64 + ln];
            c.MOD()[(size_t)(l * 5 + i) * 6144 + col0 + ln] = s; }
        __syncthreads();
    }
}

__device__ __forceinline__ int cmap(int mode, int n) {
    if (mode == 0) return n;
    if (mode == 1) { const int p = n & 255, lc = 64 * ((p >> 5) & 3) + 32 * (p >> 7) + (p & 31), nn = (n & ~255) + lc; return nn < 1280 ? nn : nn + 16; }
    return (n & 255) < 128 ? 128 * (n >> 8) + (n & 127) : 512 + 128 * (n >> 8) + (n & 127);
}
__device__ __forceinline__ void transpose_item(const float* W, int ld, int K, int N, int mode, const float* rowscale, bf16* WT, float* scr, int item, int lane) {
    const int nblk = N / 32, kb = item / nblk, nb = item % nblk, k0 = 64 * kb, n0 = 32 * nb, sc0 = cmap(mode, n0);
    float tv[32];
#pragma unroll
    for (int i = 0; i < 32; ++i) tv[i] = W[(size_t)(k0 + 2 * i + (lane >> 5)) * ld + sc0 + (lane & 31)];
    if (rowscale) {
#pragma unroll
        for (int i = 0; i < 32; ++i) tv[i] *= rowscale[k0 + 2 * i + (lane >> 5)]; }
#pragma unroll
    for (int i = 0; i < 32; ++i) scr[(2 * i + (lane >> 5)) * 33 + (lane & 31)] = tv[i];
    __builtin_amdgcn_fence(__ATOMIC_RELEASE, "wavefront"); __builtin_amdgcn_wave_barrier();
    const int ch = lane & 7;
#pragma unroll
    for (int j = 0; j < 4; ++j) { const int n = (lane >> 3) + 8 * j; const float* s = scr + (8 * ch) * 33 + n;
        v4u o; o.x = pk2(s[0 * 33], s[1 * 33]); o.y = pk2(s[2 * 33], s[3 * 33]); o.z = pk2(s[4 * 33], s[5 * 33]); o.w = pk2(s[6 * 33], s[7 * 33]);
        *(v4u*)(WT + (size_t)(n0 + n) * K + k0 + 8 * ch) = o; }
    __builtin_amdgcn_fence(__ATOMIC_RELEASE, "wavefront"); __builtin_amdgcn_wave_barrier();
}
__device__ __forceinline__ void s5_tables(const Ctx& c, int l, int g, int part, float* lf);
__device__ __forceinline__ void convert_items(const Ctx& c, int l, int lo, int hi, int gw0, int ngw, bool tabs, int tb0, int ntb, float* lf) {
    unsigned char* ws = c.ws();
    if (tabs) {
        for (int t = tb0; t < 128; t += ntb) s5_tables(c, l, t & 31, t >> 5, lf);
        for (int i = tb0 * NTHR + c.tid; i < 16384; i += ntb * NTHR) { const int j = i >> 10, k = i & 1023; ((bf16*)(ws + WS_WDT))[i] = (bf16)f2bf(c.w_in()[(size_t)l * 1024 * 4112 + (size_t)k * 4112 + 1280 + j]); }
    }
    float* scr = lf + c.wave * 2176;
    for (int it = lo + gw0; it < hi; it += ngw) {
        int r = it;
        if (r < 2048) { transpose_item(c.w_in() + (size_t)l * 1024 * 4112, 4112, 1024, 4096, 1, nullptr, (bf16*)(ws + W_IN), scr, r, c.lane); continue; } r -= 2048;
        if (r < 2048) { transpose_item(c.w_gate() + (size_t)l * 1024 * 4096, 4096, 1024, 4096, 0, nullptr, (bf16*)(ws + W_G), scr, r, c.lane); continue; } r -= 2048;
        if (r < 256) { transpose_item(c.w_glu() + (size_t)l * 512 * 1024, 1024, 512, 1024, 2, nullptr, (bf16*)(ws + W_GLU), scr, r, c.lane); continue; } r -= 256;
        if (r < 1024) { const int i = r >> 8; transpose_item(c.w_branch() + (size_t)(l * 4 + i) * 512 * 1024, 1024, 512, 1024, 0, i == 0 ? c.ssd_norm_g() + l * 512 : nullptr, (bf16*)(ws + W_BR) + (size_t)i * 1024 * 512, scr, r & 255, c.lane); continue; } r -= 1024;
        if (r < 512) { transpose_item(c.w_out() + (size_t)l * 1024 * 1024, 1024, 1024, 1024, 0, nullptr, (bf16*)(ws + W_OUT), scr, r, c.lane); continue; } r -= 512;
        if (r < 2048) { transpose_item(c.w_fc1() + (size_t)l * 1024 * 4096, 4096, 1024, 4096, 0, nullptr, (bf16*)(ws + W_1), scr, r, c.lane); continue; } r -= 2048;
        transpose_item(c.w_fc2() + (size_t)l * 4096 * 1024, 1024, 4096, 1024, 0, nullptr, (bf16*)(ws + W_2), scr, r, c.lane);
    }
}
__device__ __forceinline__ void phase_convert(const Ctx& c, int l, float* lf) {
    if (gridDim.x == 256) convert_items(c, l, 0, 9984, blockIdx.x * NWAVES + c.wave, gridDim.x * NWAVES, true, blockIdx.x >= 192 ? (int)blockIdx.x - 192 : 100000, 64, lf);
    else convert_items(c, l, 0, 9984, blockIdx.x * NWAVES + c.wave, gridDim.x * NWAVES, true, blockIdx.x, gridDim.x, lf);
}
__device__ __forceinline__ void side_convert(const Ctx& c, int lo, int hi, bool tabs, float* lf) {
    if (blockIdx.x < 192 || gridDim.x != 256) return;
    convert_items(c, 1, lo, hi, (blockIdx.x - 192) * NWAVES + c.wave, 64 * NWAVES, tabs, blockIdx.x - 192, 64, lf);
}

__device__ __forceinline__ void phase_norm(const Ctx& c, int l, int which, float* lf) {
    const int gw = blockIdx.x * NWAVES + c.wave, NGW = gridDim.x * NWAVES;
    const float* gn = (which == 0 ? c.g_norm1() : c.g_norm2()) + l * 1024;
    for (int m = gw; m < M; m += NGW) {
        const float* xr = (l == 0 && which == 0) ? (m < MC ? c.x_prompt() + (size_t)m * D : c.x_sample() + (size_t)(m - MC) * D) : c.out() + (size_t)m * D;
        const int mi = (m < MC) ? 0 : 1 + ((m - MC) >> 10);
        const float* mod = c.MOD() + (size_t)(l * 5 + mi) * 6144 + which * 3072;
        f32x4 v[4]; float s = 0.f;
#pragma unroll
        for (int j = 0; j < 4; ++j) { v[j] = *(const f32x4*)(xr + 4 * c.lane + 256 * j); s += (v[j].x * v[j].x + v[j].y * v[j].y) + (v[j].z * v[j].z + v[j].w * v[j].w); }
        const float rstd = rsqrtf(wave_sum(s) * (1.0f / D) + EPS);
#pragma unroll
        for (int j = 0; j < 4; ++j) { const int k = 4 * c.lane + 256 * j; const f32x4 g = *(const f32x4*)(gn + k), sh = *(const f32x4*)(mod + k), sc = *(const f32x4*)(mod + 1024 + k);
            v[j] = v[j] * rstd * g * (sc + 1.0f) + sh;
            v2u o; o.x = pk2(v[j].x, v[j].y); o.y = pk2(v[j].z, v[j].w); *(v2u*)(c.H() + (size_t)m * D + k) = o; }
        if (which == 0) {
            if (c.lane == 0) { c.SSQ()[m] = 0.f; ((float*)(c.ws() + WS_SSQ2))[m] = 0.f; }
        }
    }
}

__device__ __forceinline__ void phase_bias2(const Ctx& c, int l) {
    const int gw = blockIdx.x * NWAVES + c.wave, NGW = gridDim.x * NWAVES, lane = c.lane;
    const bf16* W1t = (const bf16*)(c.ws() + W_1); float* bi = (float*)(c.ws() + WS_BI2);
    for (int n = gw; n < 4096; n += NGW) {
        float wf[16]; { float t8[8]; unpack8(*(const v4u*)(W1t + (size_t)n * 1024 + 8 * lane), t8);
#pragma unroll
            for (int j = 0; j < 8; ++j) wf[j] = t8[j];
            unpack8(*(const v4u*)(W1t + (size_t)n * 1024 + 512 + 8 * lane), t8);
#pragma unroll
            for (int j = 0; j < 8; ++j) wf[8 + j] = t8[j]; }
#pragma unroll 1
        for (int mi = 0; mi < 5; ++mi) { const float* sh = c.MOD() + (size_t)(l * 5 + mi) * 6144 + 3072; float a = 0.f;
#pragma unroll
            for (int hh = 0; hh < 2; ++hh) { const f32x4 s0 = *(const f32x4*)(sh + 512 * hh + 8 * lane), s1 = *(const f32x4*)(sh + 512 * hh + 8 * lane + 4);
                a += (wf[8 * hh + 0] * s0.x + wf[8 * hh + 1] * s0.y) + (wf[8 * hh + 2] * s0.z + wf[8 * hh + 3] * s0.w) + (wf[8 * hh + 4] * s1.x + wf[8 * hh + 5] * s1.y) + (wf[8 * hh + 6] * s1.z + wf[8 * hh + 7] * s1.w); }
            a = wave_sum(a); if (lane == 0) bi[mi * 4096 + n] = a; }
    }
}

__device__ __forceinline__ void phase_dt(const Ctx& c, int l) {
    const int tile = blockIdx.x * 3 + c.wave;
    if (c.wave < 3 && tile < 768) {
    const int lr = c.lane & 15, lq = c.lane >> 4;
    const bf16* ap = c.H() + (size_t)(16 * tile + lr) * 1024 + 8 * lq; const bf16* bp = (const bf16*)(c.ws() + WS_WDT) + (size_t)lr * 1024 + 8 * lq;
    f32x4 acc = {0.f, 0.f, 0.f, 0.f};
#pragma unroll 8
    for (int ks = 0; ks < 32; ++ks) acc = __builtin_amdgcn_mfma_f32_16x16x32_bf16(*(const pg8::bf16x8*)(ap + 32 * ks), *(const pg8::bf16x8*)(bp + 32 * ks), acc, 0, 0, 0);
    const float bias = c.dt_bias()[l * 16 + lr];
#pragma unroll
    for (int r = 0; r < 4; ++r) { const float x = acc[r] + bias; c.DT()[(size_t)(16 * tile + 4 * lq + r) * 16 + lr] = x > 20.f ? x : log1pf(__expf(x)); }
    }
}

__device__ __forceinline__ void phase_rope_table(const Ctx& c) {
    const int gt = blockIdx.x * NTHR + c.tid;
    if (gt < 32768) { const int pos = gt >> 5, a = gt & 31, f = a & 15; const float inv = exp2f(-(float)f * 0.8304820237218406f);
        const float ang = (float)((a >> 4) ? (pos & 63) : (pos >> 6)) * inv; float sn, cs; sincosf(ang, &sn, &cs); c.ROPE()[pos * 64 + a] = cs; c.ROPE()[pos * 64 + 32 + a] = sn; }
}
__device__ __forceinline__ void phase_ckv(const Ctx& c) {
    const int gw = blockIdx.x * NWAVES + c.wave, NGW = gridDim.x * NWAVES, lane = c.lane;
    for (int r = gw; r < 2048; r += NGW) { const int l = r >> 10, b = (r >> 8) & 3, sidx = r & 255; const size_t cb = (size_t)(b * 2 + l) * 256 + sidx; bf16* dst = c.CKV() + (size_t)r * 1280;
#pragma unroll
        for (int i = 0; i < 5; ++i) { const int e = 4 * (lane + 64 * i);
            const float* src = e < 512 ? c.cache_dk() + cb * 512 + e : e < 1024 ? c.cache_dv() + cb * 512 + (e - 512) : e < 1152 ? c.cache_wk() + cb * 128 + (e - 1024) : c.cache_wv() + cb * 128 + (e - 1152);
            const f32x4 v = *(const f32x4*)src; v2u o; o.x = pk2(v.x, v.y); o.y = pk2(v.z, v.w); *(v2u*)(dst + e) = o; } }
}
__device__ __forceinline__ void phase_qk(const Ctx& c, int l, float* lf) {
    const int gw = blockIdx.x * NWAVES + c.wave, NGW = gridDim.x * NWAVES, lane = c.lane;
    for (int i = c.tid; i < 7 * 768; i += NTHR) lf[i] = c.conv_w()[(size_t)l * 7 * 768 + i];
    for (int i = c.tid; i < 768; i += NTHR) lf[7 * 768 + i] = c.conv_b()[l * 768 + i];
    __syncthreads();
    const bf16* R1p = c.R1(); bf16* XCp = c.XC();
    for (int m0 = gw * 6; m0 < M; m0 += NGW * 6) {
        v2u xr[12][3];
#pragma unroll
        for (int rI = 0; rI < 12; ++rI) { const int mr = m0 - 3 + rI; const bool ok = mr >= 0 && mr < M;
#pragma unroll
            for (int i = 0; i < 3; ++i) xr[rI][i] = ok ? *(const v2u*)(R1p + (size_t)mr * 4096 + C_XBC + 4 * lane + 256 * i) : (v2u){0u, 0u}; }
        f32x4 wv[3][8];
#pragma unroll
        for (int i = 0; i < 3; ++i)
#pragma unroll
            for (int j = 0; j < 8; ++j) wv[i][j] = *(const f32x4*)(lf + j * 768 + 4 * lane + 256 * i);
#pragma unroll
        for (int k = 0; k < 6; ++k) { const int m = m0 + k; if (m >= M) break;
            const bool lat = m >= MC; const int t = lat ? (m - MC) & 1023 : m & 255, L = lat ? 1024 : 256;
#pragma unroll
            for (int i = 0; i < 3; ++i) { f32x4 a = wv[i][7];
#pragma unroll
                for (int j = 0; j < 7; ++j) { const int tt = t + j - 3; if (tt >= 0 && tt < L) { const v2u q = xr[k + j][i]; const f32x4 xv = {bflo(q.x), bfhi(q.x), bflo(q.y), bfhi(q.y)}; a += wv[i][j] * xv; } }
                v2u o; o.x = pk2(siluf(a.x), siluf(a.y)); o.y = pk2(siluf(a.z), siluf(a.w)); *(v2u*)(XCp + (size_t)m * 768 + 4 * lane + 256 * i) = o; }
        }
    }
}

typedef pg8::bf16x8 bx8;
#define LDS_BARRIER() do { asm volatile("s_waitcnt lgkmcnt(0)" ::: "memory"); __builtin_amdgcn_s_barrier(); asm volatile("" ::: "memory"); } while (0)
#define MFMA16(a, b, cc) __builtin_amdgcn_mfma_f32_16x16x32_bf16((a), (b), (cc), 0, 0, 0)
__device__ __forceinline__ void ssd_unit(const Ctx& c, int l, int pass, int b, int h, unsigned char* lds) {
    const int L = pass ? 1024 : 256, tok0 = pass ? MC + b * 1024 : b * 256, NCH = L >> 7;
    const int tid = c.tid, lane = c.lane, w = c.wave, lr = lane & 15, lq = lane >> 4, grp = h >> 2;
    bf16* XT = (bf16*)lds;
    bf16* BwT = XT + 64 * 136;
    bf16* Bm = BwT + 64 * 136;
    bf16* Cm = Bm + 128 * 72;
    bf16* Mm = Cm + 128 * 72;
    bf16* ST = Mm + 128 * 136;
    float* cum = (float*)(ST + 64 * 72);
    float* dtv = cum + 128; float* wv = dtv + 128; float* ecum = wv + 128; float* tot = ecum + 128;
    const float dsk = c.ssd_d()[l * 8 + h];
    const bf16* XCp = c.XC(); const float* DTp = c.DT(); bf16* Yp = c.Y(); const bf16* R1p = c.R1(); float* SSQp = c.SSQ();
    const int pi = w >> 1, nj0 = 2 * (w & 1);
    const int i = tid >> 2, part = tid & 3;
    for (int dir = 0; dir < 2; ++dir) {
        const float A = -__expf(c.a_log()[(l * 2 + dir) * 8 + h]);
        f32x4 Sacc[2];
        __syncthreads();
#pragma unroll
        for (int q = 0; q < 2; ++q)
#pragma unroll
            for (int r = 0; r < 4; ++r) { const int p = 16 * pi + 4 * lq + r, n = 16 * (nj0 + q) + lr;
                const float v = pass ? c.state_ssd()[(((((size_t)(b * 2 + l) * 2 + dir) * 8 + h) * 64 + p) * 64) + n] : 0.f;
                Sacc[q][r] = v; ST[p * 72 + n] = (bf16)f2bf(v); }
        v4u x0, x1, b0, b1, c0, c1; float d0 = 0.f, d1 = 0.f;
#define SSD_LOAD(ci_) { const int t_ = dir ? L - 1 - ((ci_) * 128 + i) : (ci_) * 128 + i; const bf16* xr_ = XCp + (size_t)(tok0 + t_) * 768; \
            x0 = *(const v4u*)(xr_ + h * 64 + part * 16); x1 = *(const v4u*)(xr_ + h * 64 + part * 16 + 8); \
            b0 = *(const v4u*)(xr_ + 512 + grp * 64 + part * 16); b1 = *(const v4u*)(xr_ + 512 + grp * 64 + part * 16 + 8); \
            c0 = *(const v4u*)(xr_ + 640 + grp * 64 + part * 16); c1 = *(const v4u*)(xr_ + 640 + grp * 64 + part * 16 + 8); \
            if (tid < 64) { const int i0_ = 2 * lane, ta_ = dir ? L - 1 - ((ci_) * 128 + i0_) : (ci_) * 128 + i0_, tb_ = dir ? ta_ - 1 : ta_ + 1; \
                d0 = DTp[(size_t)(tok0 + ta_) * 16 + dir * 8 + h]; d1 = DTp[(size_t)(tok0 + tb_) * 16 + dir * 8 + h]; } }
        SSD_LOAD(0);
        for (int ci = 0; ci < NCH; ++ci) {
            LDS_BARRIER();
            float bvals[16];
            { *(v4u*)(Bm + i * 72 + part * 16) = b0; *(v4u*)(Bm + i * 72 + part * 16 + 8) = b1;
              *(v4u*)(Cm + i * 72 + part * 16) = c0; *(v4u*)(Cm + i * 72 + part * 16 + 8) = c1;
              const unsigned xs[8] = {x0.x, x0.y, x0.z, x0.w, x1.x, x1.y, x1.z, x1.w};
#pragma unroll
              for (int j = 0; j < 8; ++j) { XT[(part * 16 + 2 * j) * 136 + i] = (bf16)(xs[j] & 0xffffu); XT[(part * 16 + 2 * j + 1) * 136 + i] = (bf16)(xs[j] >> 16); }
              float t8[8]; unpack8(b0, t8);
#pragma unroll
              for (int j = 0; j < 8; ++j) bvals[j] = t8[j];
              unpack8(b1, t8);
#pragma unroll
              for (int j = 0; j < 8; ++j) bvals[8 + j] = t8[j]; }
            if (tid < 64) {
                const int i0 = 2 * lane, i1 = i0 + 1;
                const float a0 = d0 * A, a1 = d1 * A; float s = a0 + a1;
#pragma unroll
                for (int o = 1; o < 64; o <<= 1) { const float v = __shfl_up(s, o); if (lane >= o) s += v; }
                const float cum1 = s, cum0 = s - a1, total = __shfl(s, 63);
                cum[i0] = cum0; cum[i1] = cum1; dtv[i0] = d0; dtv[i1] = d1;
                wv[i0] = __expf(total - cum0) * d0; wv[i1] = __expf(total - cum1) * d1; ecum[i0] = __expf(cum0); ecum[i1] = __expf(cum1);
                if (lane == 0) tot[0] = __expf(total);
            }
            if (ci + 1 < NCH) SSD_LOAD(ci + 1);
            unsigned short zz[16], yy[16];
            if (dir == 1) {
#pragma unroll
                for (int r = 0; r < 4; ++r) { const int tt = 16 * w + 4 * lq + r; const size_t m = (size_t)tok0 + (L - 1 - (ci * 128 + tt));
#pragma unroll
                    for (int jp = 0; jp < 4; ++jp) { zz[4 * r + jp] = R1p[m * 4096 + C_Z + h * 64 + 16 * jp + lr]; yy[4 * r + jp] = Yp[m * 2048 + h * 64 + 16 * jp + lr]; } }
            }
            LDS_BARRIER();
            { const float wi = wv[i];
#pragma unroll
              for (int j = 0; j < 16; ++j) BwT[(part * 16 + j) * 136 + i] = (bf16)f2bf(bvals[j] * wi); }
            bx8 cfr[2];
#pragma unroll
            for (int ks = 0; ks < 2; ++ks) cfr[ks] = *(const bx8*)(Cm + (16 * w + lr) * 72 + 32 * ks + 8 * lq);
            for (int j = 0; j <= w; ++j) {
                const bx8 bb0 = *(const bx8*)(Bm + (16 * j + lr) * 72 + 8 * lq), bb1 = *(const bx8*)(Bm + (16 * j + lr) * 72 + 32 + 8 * lq);
                f32x4 g = {0.f, 0.f, 0.f, 0.f};
                g = MFMA16(cfr[0], bb0, g); g = MFMA16(cfr[1], bb1, g);
                const int s = 16 * j + lr; const float cs = cum[s], ds = dtv[s];
#pragma unroll
                for (int r = 0; r < 4; ++r) { const int tt = 16 * w + 4 * lq + r; const float v = (s <= tt) ? g[r] * __expf(cum[tt] - cs) * ds : 0.f; Mm[tt * 136 + s] = (bf16)f2bf(v); }
            }
            if (!(w & 1)) {
#pragma unroll
                for (int r = 0; r < 4; ++r) Mm[(16 * w + 4 * lq + r) * 136 + 16 * (w + 1) + lr] = 0;
            }
            LDS_BARRIER();
            f32x4 yl[4], yo[4];
#pragma unroll
            for (int jp = 0; jp < 4; ++jp) { yl[jp] = (f32x4){0.f, 0.f, 0.f, 0.f}; yo[jp] = (f32x4){0.f, 0.f, 0.f, 0.f}; }
            for (int ks = 0; ks <= (w >> 1); ++ks) {
                const bx8 af = *(const bx8*)(Mm + (16 * w + lr) * 136 + 32 * ks + 8 * lq);
#pragma unroll
                for (int jp = 0; jp < 4; ++jp) { const bx8 xf = *(const bx8*)(XT + (16 * jp + lr) * 136 + 32 * ks + 8 * lq); yl[jp] = MFMA16(af, xf, yl[jp]); }
            }
#pragma unroll
            for (int ks = 0; ks < 2; ++ks)
#pragma unroll
                for (int jp = 0; jp < 4; ++jp) { const bx8 sf = *(const bx8*)(ST + (16 * jp + lr) * 72 + 32 * ks + 8 * lq); yo[jp] = MFMA16(cfr[ks], sf, yo[jp]); }
            {
#pragma unroll
                for (int r = 0; r < 4; ++r) {
                    const int tt = 16 * w + 4 * lq + r; const float ec = ecum[tt];
                    const int t = dir ? L - 1 - (ci * 128 + tt) : ci * 128 + tt; const size_t m = (size_t)tok0 + t;
                    float q = 0.f;
#pragma unroll
                    for (int jp = 0; jp < 4; ++jp) {
                        const int p = 16 * jp + lr; const float y = yl[jp][r] + ec * yo[jp][r];
                        if (dir == 0) Yp[m * 2048 + h * 64 + p] = (bf16)f2bf(y);
                        else { const float x = bf2f(XT[p * 136 + tt]); const float ytot = y + bf2f(yy[4 * r + jp]) + dsk * x; const float z = bf2f(zz[4 * r + jp]);
                            const float gt = ytot * siluf(z); Yp[m * 2048 + h * 64 + p] = (bf16)f2bf(gt); q += gt * gt; }
                    }
                    if (dir == 1) { q += __shfl_xor(q, 1); q += __shfl_xor(q, 2); q += __shfl_xor(q, 4); q += __shfl_xor(q, 8); if (lr == 0) atomicAdd(SSQp + m, q); }
                }
            }
            LDS_BARRIER();
            {
                f32x4 st[2] = {{0.f, 0.f, 0.f, 0.f}, {0.f, 0.f, 0.f, 0.f}};
#pragma unroll
                for (int ks = 0; ks < 4; ++ks) { const bx8 af = *(const bx8*)(XT + (16 * pi + lr) * 136 + 32 * ks + 8 * lq);
#pragma unroll
                    for (int q = 0; q < 2; ++q) { const bx8 bf = *(const bx8*)(BwT + (16 * (nj0 + q) + lr) * 136 + 32 * ks + 8 * lq); st[q] = MFMA16(af, bf, st[q]); } }
                const float et = tot[0];
#pragma unroll
                for (int q = 0; q < 2; ++q)
#pragma unroll
                    for (int r = 0; r < 4; ++r) { Sacc[q][r] = et * Sacc[q][r] + st[q][r]; ST[(16 * pi + 4 * lq + r) * 72 + 16 * (nj0 + q) + lr] = (bf16)f2bf(Sacc[q][r]); }
            }
        }
#undef SSD_LOAD
        if (!pass) {
#pragma unroll
            for (int q = 0; q < 2; ++q)
#pragma unroll
                for (int r = 0; r < 4; ++r) { const int p = 16 * pi + 4 * lq + r, n = 16 * (nj0 + q) + lr;
                    c.out()[O_SSD + (((((size_t)(b * 2 + l) * 2 + dir) * 8 + h) * 64 + p) * 64) + n] = Sacc[q][r]; }
        }
    }
}

__device__ __forceinline__ void s5_tables(const Ctx& c, int l, int g, int part, float* lf) {
    const int tid = c.tid;
    float* pw = lf;
    float* Bc = pw + 2 * 17 * 128;
    float* Cc = Bc + 2 * 2048;
    if (tid < 128) { const int dir = tid >> 6, n = tid & 63, idx = ((l * 2 + dir) * 32 + g) * 64 + n;
        const float lre = c.lam_re()[idx], lim = c.lam_im()[idx], step = expf(c.log_step()[(l * 2 + dir) * 32 + g]);
        for (int k = 0; k <= 16; ++k) { const float mag = expf(lre * step * (float)k); float sn, cs; sincosf(lim * step * (float)k, &sn, &cs); pw[((dir * 17 + k) * 64 + n) * 2] = mag * cs; pw[((dir * 17 + k) * 64 + n) * 2 + 1] = mag * sn; }
        const float mag = expf(lre * step); float sn, cs; sincosf(lim * step, &sn, &cs); const float are = mag * cs, aim = mag * sn;
        const float den = lre * lre + lim * lim, cre = ((are - 1.0f) * lre + aim * lim) / den, cim = (aim * lre - (are - 1.0f) * lim) / den;
        for (int mm = 0; mm < 16; ++mm) { const float br = c.b_re()[(size_t)idx * 16 + mm], bi = c.b_im()[(size_t)idx * 16 + mm]; Bc[((dir * 64 + n) * 16 + mm) * 2] = cre * br - cim * bi; Bc[((dir * 64 + n) * 16 + mm) * 2 + 1] = cre * bi + cim * br; }
    }
    for (int i = tid; i < 2048; i += NTHR) { const int dir = i >> 10, mm = (i >> 6) & 15, n = i & 63; const size_t src = ((size_t)((l * 2 + dir) * 32 + g) * 16 + mm) * 64 + n;
        Cc[i * 2] = c.c_re()[src]; Cc[i * 2 + 1] = c.c_im()[src]; }
    __syncthreads();
    if (part == 0 && tid < 128) { const int dir = tid >> 6, n = tid & 63; float* at = (float*)(c.ws() + WS_S5AT) + ((size_t)(dir * 32 + g) * 64 + n) * 2; at[0] = pw[((dir * 17 + 16) * 64 + n) * 2]; at[1] = pw[((dir * 17 + 16) * 64 + n) * 2 + 1]; }
    bf16* Kt = (bf16*)(c.ws() + WS_S5K) + (size_t)g * 31 * 256;
    for (int e = part * 1984 + tid; e < (part + 1) * 1984; e += NTHR) { const int tp = e >> 8, mm = (e >> 4) & 15, m2 = e & 15, tau = tp - 15; float acc = 0.f;
#pragma unroll
        for (int dir = 0; dir < 2; ++dir) { if ((dir == 0 && tau < 0) || (dir == 1 && tau > 0)) continue; const int k = tau < 0 ? -tau : tau;
            const float* pp = pw + (dir * 17 + k) * 128; const float* bb = Bc + dir * 2048 + m2 * 2; const float* cc = Cc + (dir * 16 + mm) * 128;
            for (int n = 0; n < 64; ++n) { const float pr = pp[2 * n], pi = pp[2 * n + 1], br = bb[n * 32], bi = bb[n * 32 + 1], Pr = pr * br - pi * bi, Pi = pr * bi + pi * br; acc += cc[2 * n] * Pr - cc[2 * n + 1] * Pi; } }
        if (tau == 0 && mm == m2) acc += c.s5_d()[l * 512 + g * 16 + mm];
        Kt[e] = (bf16)f2bf(acc); }
    for (int e = part * 16384 + tid; e < (part + 1) * 16384; e += NTHR) { const int dir = e >> 15, sidx = (e >> 8) & 127, k = e & 255, ri = sidx >> 6, n = sidx & 63, j = k >> 4, m2 = k & 15, ex = dir ? j : 15 - j;
        const float pr = pw[((dir * 17 + ex) * 64 + n) * 2], pi = pw[((dir * 17 + ex) * 64 + n) * 2 + 1], br = Bc[((dir * 64 + n) * 16 + m2) * 2], bi = Bc[((dir * 64 + n) * 16 + m2) * 2 + 1];
        ((bf16*)(c.ws() + WS_S5WS))[((size_t)(dir * 32 + g) * 128 + sidx) * 256 + k] = (bf16)f2bf(ri ? pr * bi + pi * br : pr * br - pi * bi); }
    for (int e = part * 16384 + tid; e < (part + 1) * 16384; e += NTHR) { const int row = e >> 8, k = e & 255, i = row >> 4, mm = row & 15, dir = k >> 7, ri = (k >> 6) & 1, n = k & 63, ex = dir ? 16 - i : i + 1;
        const float pr = pw[((dir * 17 + ex) * 64 + n) * 2], pi = pw[((dir * 17 + ex) * 64 + n) * 2 + 1], cr = Cc[((dir * 16 + mm) * 64 + n) * 2], ci = Cc[((dir * 16 + mm) * 64 + n) * 2 + 1];
        ((bf16*)(c.ws() + WS_S5WO))[(size_t)g * 65536 + e] = (bf16)f2bf(ri ? -(cr * pi + ci * pr) : cr * pr - ci * pi); }
    __syncthreads();
}

__device__ __forceinline__ void s5_unit(const Ctx& c, int l, int g, int cu, unsigned char* lds) {
    const int tid = c.tid, lane = c.lane, w = c.wave, lr = lane & 15, lq = lane >> 4;
    const bool lat = cu >= 8;
    bf16* Ut = (bf16*)lds;
    bf16* St = Ut + 64 * 264;
    bf16* Kt = St + 64 * 264;
    float* Dl = (float*)(Kt + 31 * 256);
    const bf16* R1p = c.R1();
    const bf16* Wsp0 = (const bf16*)(c.ws() + WS_S5WS) + ((size_t)(0 * 32 + g) * 128 + 16 * w + lr) * 256 + 8 * lq;
    const bf16* Wsp1 = (const bf16*)(c.ws() + WS_S5WS) + ((size_t)(1 * 32 + g) * 128 + 16 * w + lr) * 256 + 8 * lq;
    const bf16* Wop = (const bf16*)(c.ws() + WS_S5WO) + (size_t)g * 65536 + 8 * lq;
    bx8 afA[8], afB[8];
#pragma unroll
    for (int ks = 0; ks < 8; ++ks) afA[ks] = *(const bx8*)(Wsp0 + 32 * ks);
    { const v4u* src = (const v4u*)((const bf16*)(c.ws() + WS_S5K) + (size_t)g * 31 * 256); for (int i = tid; i < 31 * 32; i += NTHR) ((v4u*)Kt)[i] = src[i]; }
#pragma unroll
    for (int i = 0; i < 2; ++i) { const int id = tid + NTHR * i, col = id >> 4, j = id & 15;
        const int tok = lat ? MC + (cu - 8) * 1024 + col * 16 + j : (4 * cu + (col >> 4)) * 256 + (col & 15) * 16 + j;
        const bf16* up = R1p + (size_t)tok * 4096 + C_U + g * 16;
        *(v4u*)(Ut + col * 264 + j * 16) = *(const v4u*)up; *(v4u*)(Ut + col * 264 + j * 16 + 8) = *(const v4u*)(up + 8); }
#pragma unroll
    for (int ks = 0; ks < 8; ++ks) afB[ks] = *(const bx8*)(Wsp1 + 32 * ks);
    LDS_BARRIER();
#pragma unroll
    for (int dir = 0; dir < 2; ++dir) {
        f32x4 acc[4];
#pragma unroll
        for (int cb = 0; cb < 4; ++cb) acc[cb] = (f32x4){0.f, 0.f, 0.f, 0.f};
#pragma unroll
        for (int ks = 0; ks < 8; ++ks) {
#pragma unroll
            for (int cb = 0; cb < 4; ++cb) { const bx8 bf = *(const bx8*)(Ut + (16 * cb + lr) * 264 + 32 * ks + 8 * lq); acc[cb] = MFMA16(dir ? afB[ks] : afA[ks], bf, acc[cb]); }
            __builtin_amdgcn_sched_barrier(0); }
        if (dir == 0) {
#pragma unroll
            for (int ks = 0; ks < 8; ++ks) afA[ks] = *(const bx8*)(Wop + (size_t)(16 * (2 * w) + lr) * 256 + 32 * ks); }
        else {
#pragma unroll
            for (int ks = 0; ks < 8; ++ks) afB[ks] = *(const bx8*)(Wop + (size_t)(16 * (2 * w + 1) + lr) * 256 + 32 * ks); }
#pragma unroll
        for (int cb = 0; cb < 4; ++cb)
#pragma unroll
            for (int r = 0; r < 4; ++r) Dl[(16 * w + 4 * lq + r) * 65 + 16 * cb + lr] = acc[cb][r];
        LDS_BARRIER();
        if (tid < (lat ? 64 : 256)) {
            const int n = tid & 63, bl = tid >> 6, nc = lat ? 64 : 16, cbase = lat ? 0 : 16 * bl, b = lat ? cu - 8 : 4 * cu + bl;
            const float* at = (const float*)(c.ws() + WS_S5AT) + ((size_t)(dir * 32 + g) * 64 + n) * 2; const float ar = at[0], ai = at[1];
            float sr = 0.f, si = 0.f;
            if (lat) { sr = c.state_s5()[((((size_t)(b * 2 + l) * 2 + dir) * 2 + 0) * 32 + g) * 64 + n]; si = c.state_s5()[((((size_t)(b * 2 + l) * 2 + dir) * 2 + 1) * 32 + g) * 64 + n]; }
            for (int cc = 0; cc < nc; ++cc) { const int col = cbase + (dir ? nc - 1 - cc : cc);
                St[col * 264 + dir * 128 + n] = (bf16)f2bf(sr); St[col * 264 + dir * 128 + 64 + n] = (bf16)f2bf(si);
                const float dr = Dl[n * 65 + col], di = Dl[(64 + n) * 65 + col];
                const float nr = ar * sr - ai * si + dr, ni = ar * si + ai * sr + di; sr = nr; si = ni; }
            if (!lat) { c.out()[O_S5 + ((((size_t)(b * 2 + l) * 2 + dir) * 2 + 0) * 32 + g) * 64 + n] = sr; c.out()[O_S5 + ((((size_t)(b * 2 + l) * 2 + dir) * 2 + 1) * 32 + g) * 64 + n] = si; }
        }
        LDS_BARRIER();
    }
#pragma unroll
    for (int ii = 0; ii < 2; ++ii) { const int i = 2 * w + ii;
        f32x4 acc[4];
#pragma unroll
        for (int cb = 0; cb < 4; ++cb) acc[cb] = (f32x4){0.f, 0.f, 0.f, 0.f};
#pragma unroll
        for (int ks = 0; ks < 8; ++ks) { const int j = 2 * ks + (lq >> 1); const bx8 af = *(const bx8*)(Kt + ((i - j + 15) * 16 + lr) * 16 + 8 * (lq & 1));
#pragma unroll
            for (int cb = 0; cb < 4; ++cb) { const bx8 bf = *(const bx8*)(Ut + (16 * cb + lr) * 264 + 32 * ks + 8 * lq); acc[cb] = MFMA16(af, bf, acc[cb]); }
            __builtin_amdgcn_sched_barrier(0); }
#pragma unroll
        for (int ks = 0; ks < 8; ++ks) {
#pragma unroll
            for (int cb = 0; cb < 4; ++cb) { const bx8 bf = *(const bx8*)(St + (16 * cb + lr) * 264 + 32 * ks + 8 * lq); acc[cb] = MFMA16(ii ? afB[ks] : afA[ks], bf, acc[cb]); }
            __builtin_amdgcn_sched_barrier(0); }
#pragma unroll
        for (int cb = 0; cb < 4; ++cb) { const int col = 16 * cb + lr;
            const int tok = lat ? MC + (cu - 8) * 1024 + col * 16 + i : (4 * cu + (col >> 4)) * 256 + (col & 15) * 16 + i;
            v2u o; o.x = pk2(acc[cb][0], acc[cb][1]); o.y = pk2(acc[cb][2], acc[cb][3]);
            *(v2u*)(c.Y5() + (size_t)tok * 512 + g * 16 + 4 * lq) = o; }
    }
}

typedef float f32x16 __attribute__((ext_vector_type(16)));
#define MFMA32(a, b, cc) __builtin_amdgcn_mfma_f32_32x32x16_bf16((a), (b), (cc), 0, 0, 0)
constexpr float SM_SC = 0.125f * 1.4426950408889634f;
__device__ __forceinline__ void qk_tile(f32x16& p0, f32x16& p1, const bf16* Kt, int KS, const bx8 (&qf)[4], int r32, int hi) {
    p0 = (f32x16){0.f}; p1 = (f32x16){0.f};
    bx8 a0[4], a1[4];
#pragma unroll
    for (int d0 = 0; d0 < 4; ++d0) { a0[d0] = *(const bx8*)(Kt + r32 * KS + 16 * d0 + 8 * hi); a1[d0] = *(const bx8*)(Kt + (32 + r32) * KS + 16 * d0 + 8 * hi); }
    __builtin_amdgcn_s_setprio(1);
#pragma unroll
    for (int d0 = 0; d0 < 4; ++d0) { p0 = MFMA32(a0[d0], qf[d0], p0); p1 = MFMA32(a1[d0], qf[d0], p1); }
    __builtin_amdgcn_s_setprio(0);
}
__device__ __forceinline__ float fmax_(float a, float b) { float r; asm("v_max_f32_e32 %0, %1, %2" : "=v"(r) : "v"(a), "v"(b)); return r; }
__device__ __forceinline__ float sm_step(f32x16& p0, f32x16& p1, float& mrun, float& lrun, bx8 (&pb)[4]) {
    float ta = fmax_(p0[0], p1[0]), tb = fmax_(p0[1], p1[1]);
#pragma unroll
    for (int r = 2; r < 16; r += 2) { ta = fmax_(ta, fmax_(p0[r], p1[r])); tb = fmax_(tb, fmax_(p0[r + 1], p1[r + 1])); }
    float tm = fmax_(ta, tb) * SM_SC;
    tm = fmax_(tm, __shfl_xor(tm, 32));
    const float mn = fmax_(mrun, tm), alpha = __builtin_amdgcn_exp2f(mrun - mn);
    float rs0 = 0.f, rs1 = 0.f;
#pragma unroll
    for (int r = 0; r < 16; ++r) { p0[r] = __builtin_amdgcn_exp2f(fmaf(p0[r], SM_SC, -mn)); p1[r] = __builtin_amdgcn_exp2f(fmaf(p1[r], SM_SC, -mn)); rs0 += p0[r]; rs1 += p1[r]; }
    float rs = rs0 + rs1;
    rs += __shfl_xor(rs, 32);
    lrun = lrun * alpha + rs; mrun = mn;
#pragma unroll
    for (int sI = 0; sI < 2; ++sI) {
        v4u t0, t1;
        t0.x = pg8::cvt_pk_bf16(p0[8 * sI + 0], p0[8 * sI + 1]); t0.y = pg8::cvt_pk_bf16(p0[8 * sI + 2], p0[8 * sI + 3]); t0.z = pg8::cvt_pk_bf16(p0[8 * sI + 4], p0[8 * sI + 5]); t0.w = pg8::cvt_pk_bf16(p0[8 * sI + 6], p0[8 * sI + 7]);
        t1.x = pg8::cvt_pk_bf16(p1[8 * sI + 0], p1[8 * sI + 1]); t1.y = pg8::cvt_pk_bf16(p1[8 * sI + 2], p1[8 * sI + 3]); t1.z = pg8::cvt_pk_bf16(p1[8 * sI + 4], p1[8 * sI + 5]); t1.w = pg8::cvt_pk_bf16(p1[8 * sI + 6], p1[8 * sI + 7]);
        pb[sI] = __builtin_bit_cast(bx8, t0); pb[2 + sI] = __builtin_bit_cast(bx8, t1);
    }
    return alpha;
}
typedef short v4i16_t __attribute__((ext_vector_type(4)));
__device__ __forceinline__ v2u vtr(const bf16* p) { return __builtin_bit_cast(v2u, __builtin_amdgcn_ds_read_tr16_b64_v4i16((__attribute__((address_space(3))) v4i16_t*)p)); }
template <int NDT, int VS> __device__ __forceinline__ void pv_tile(f32x16 (&o)[NDT], const bf16* Vr, const bx8 (&pb)[4], int lane) {
    const bf16* vb = Vr + (4 * (lane >> 5) + ((lane & 15) >> 2)) * VS + 16 * ((lane >> 4) & 1) + 4 * (lane & 3);
    v2u cur[NDT][2], nxt[NDT][2];
#pragma unroll
    for (int dt = 0; dt < NDT; ++dt) { cur[dt][0] = vtr(vb + 32 * dt); cur[dt][1] = vtr(vb + 8 * VS + 32 * dt); }
#pragma unroll
    for (int ks = 0; ks < 4; ++ks) {
        if (ks < 3) {
#pragma unroll
            for (int dt = 0; dt < NDT; ++dt) { nxt[dt][0] = vtr(vb + (16 * (ks + 1)) * VS + 32 * dt); nxt[dt][1] = vtr(vb + (16 * (ks + 1) + 8) * VS + 32 * dt); }
        }
        __builtin_amdgcn_s_setprio(1);
#pragma unroll
        for (int dt = 0; dt < NDT; ++dt) { const v4u t = {cur[dt][0].x, cur[dt][0].y, cur[dt][1].x, cur[dt][1].y}; o[dt] = MFMA32(__builtin_bit_cast(bx8, t), pb[ks], o[dt]); }
        __builtin_amdgcn_s_setprio(0);
#pragma unroll
        for (int dt = 0; dt < NDT; ++dt) { cur[dt][0] = nxt[dt][0]; cur[dt][1] = nxt[dt][1]; }
    }
}

template <int PASS> __device__ __forceinline__ void diff_unit(const Ctx& c, int l, int uidx, unsigned char* lds) {
    constexpr int NT = PASS ? 10 : 2, NQB = PASS ? 8 : 2, VS = 160;
    const int tid = c.tid, lane = c.lane, w = c.wave, r32 = lane & 31, hi = lane >> 5, comp = w >> 2;
    const int qb = uidx % NQB, h = (uidx / NQB) & 3, b = uidx / (NQB * 4);
    const int tok0 = PASS ? MC + b * 1024 : b * 256;
    bf16* Kt = (bf16*)lds;
    bf16* Vr = Kt + 128 * 136;
    float* Ob = (float*)lds;
    const bf16* R1p = c.R1(); const bf16* CK = c.CKV() + (size_t)l * 1024 * 1280;
    const float lam_init = 0.8f - 0.6f * expf(-0.3f * (float)l);
    const float* lv = c.dlam() + l * 256;
    const float lam = expf(wave_sum(lv[lane] * lv[64 + lane])) - expf(wave_sum(lv[128 + lane] * lv[192 + lane])) + lam_init;
    const size_t mrow = (size_t)tok0 + qb * 128 + 32 * (w & 3) + r32;
    bx8 qf[4];
#pragma unroll
    for (int d0 = 0; d0 < 4; ++d0) qf[d0] = *(const bx8*)(R1p + mrow * 4096 + C_DQ + h * 128 + comp * 64 + 16 * d0 + 8 * hi);
    f32x16 o[4];
#pragma unroll
    for (int dt = 0; dt < 4; ++dt) o[dt] = (f32x16){0.f};
    float mrun = -1e30f, lrun = 0.f;
    v4u kreg[4], vreg[4];
#define DIFF_LOAD(t) { const bf16* kb; const bf16* vb; size_t rs; \
        if (PASS && (t) < 2) { kb = CK + ((size_t)b * 256 + 128 * (t)) * 1280 + h * 128; vb = kb + 512; rs = 1280; } \
        else { kb = R1p + ((size_t)tok0 + 128 * ((t) - (PASS ? 2 : 0))) * 4096 + C_DK + h * 128; vb = kb + (C_DV - C_DK); rs = 4096; } \
        _Pragma("unroll") for (int i = 0; i < 4; ++i) { const int id = tid + NTHR * i; kreg[i] = *(const v4u*)(kb + (size_t)(id >> 4) * rs + (id & 15) * 8); vreg[i] = *(const v4u*)(vb + (size_t)(id >> 4) * rs + (id & 15) * 8); } }
    DIFF_LOAD(0);
    for (int t = 0; t < NT; ++t) {
        LDS_BARRIER();
#pragma unroll
        for (int i = 0; i < 4; ++i) { const int id = tid + NTHR * i; *(v4u*)(Kt + (id >> 4) * 136 + (id & 15) * 8) = kreg[i]; *(v4u*)(Vr + (id >> 4) * VS + (id & 15) * 8) = vreg[i]; }
        if (t + 1 < NT) DIFF_LOAD(t + 1);
        LDS_BARRIER();
#pragma unroll
        for (int sub = 0; sub < 2; ++sub) {
            f32x16 p0, p1; bx8 pb[4];
            qk_tile(p0, p1, Kt + sub * 64 * 136 + comp * 64, 136, qf, r32, hi);
            const float alpha = sm_step(p0, p1, mrun, lrun, pb);
            if (__any(alpha != 1.0f)) {
#pragma unroll
                for (int dt = 0; dt < 4; ++dt)
#pragma unroll
                    for (int r = 0; r < 16; ++r) o[dt][r] *= alpha; }
            pv_tile<4, VS>(o, Vr + sub * 64 * VS, pb, lane);
        }
    }
#undef DIFF_LOAD
    const float inv = (comp ? lam : 1.0f) / lrun;
    const int rowl = 32 * (w & 3) + r32;
    LDS_BARRIER();
    if (comp) {
#pragma unroll
        for (int dt = 0; dt < 4; ++dt)
#pragma unroll
            for (int r = 0; r < 16; ++r) Ob[rowl * 129 + 32 * dt + (r & 3) + 8 * (r >> 2) + 4 * hi] = o[dt][r] * inv;
    }
    LDS_BARRIER();
    if (!comp) {
        float ss = 0.f;
#pragma unroll
        for (int dt = 0; dt < 4; ++dt)
#pragma unroll
            for (int r = 0; r < 16; ++r) { const float v = o[dt][r] * inv - Ob[rowl * 129 + 32 * dt + (r & 3) + 8 * (r >> 2) + 4 * hi]; o[dt][r] = v; ss += v * v; }
        ss += __shfl_xor(ss, 32);
        const float rn = rsqrtf(ss * (1.0f / 128.0f) + EPS) * (1.0f - lam_init);
        const float* sg = c.subln_g() + l * 128; bf16* yp = c.Y() + mrow * 2048 + 1024 + h * 128;
#pragma unroll
        for (int dt = 0; dt < 4; ++dt)
#pragma unroll
            for (int r4 = 0; r4 < 4; ++r4) { const int dv = 32 * dt + 8 * r4 + 4 * hi; const f32x4 g = *(const f32x4*)(sg + dv);
                v2u ov; ov.x = pk2(o[dt][4 * r4 + 0] * rn * g.x, o[dt][4 * r4 + 1] * rn * g.y); ov.y = pk2(o[dt][4 * r4 + 2] * rn * g.z, o[dt][4 * r4 + 3] * rn * g.w);
                *(v2u*)(yp + dv) = ov; }
    }
}

template <int PASS> __device__ __forceinline__ void win_unit(const Ctx& c, int l, int uidx, unsigned char* lds) {
    constexpr int NQB = PASS ? 4 : 1, VS = 96;
    const int tid = c.tid, lane = c.lane, w = c.wave, r32 = lane & 31, hi = lane >> 5;
    const int qb = uidx % NQB, hh = (uidx / NQB) & 7, b = uidx / (NQB * 8), nkv = hh >> 2;
    const int tok0 = PASS ? MC + b * 1024 : b * 256;
    bf16* Kt = (bf16*)lds;
    bf16* Vr = Kt + 128 * 72;
    const bf16* R1p = c.R1(); const bf16* CK = c.CKV() + (size_t)l * 1024 * 1280;
    const int qrow = qb * 256 + 32 * w + r32;
    const size_t mrow = (size_t)tok0 + qrow;
    bx8 qf[4];
#pragma unroll
    for (int d0 = 0; d0 < 4; ++d0) qf[d0] = *(const bx8*)(R1p + mrow * 4096 + C_WQ + hh * 64 + 16 * d0 + 8 * hi);
    f32x16 o[2]; o[0] = (f32x16){0.f}; o[1] = (f32x16){0.f};
    float mrun = c.sink()[l * 8 + hh] * 1.4426950408889634f, lrun = 1.0f;
    const int q0 = qb * 256;
    const int tb0 = PASS ? ((q0 - 128 < 0 ? 0 : q0 - 128) >> 7) : 0, tb1 = PASS ? ((q0 + 255 + 128 > 1023 ? 1023 : q0 + 255 + 128) >> 7) : 0;
    const int NT = PASS ? 2 + (tb1 - tb0 + 1) : 2;
    v4u kreg[2], vreg[2];
#define WIN_LOAD(t) { const bf16* kb; const bf16* vb; size_t rs; \
        if (PASS && (t) < 2) { kb = CK + ((size_t)b * 256 + 128 * (t)) * 1280 + 1024 + nkv * 64; vb = kb + 128; rs = 1280; } \
        else { kb = R1p + ((size_t)tok0 + 128 * (PASS ? tb0 + (t) - 2 : (t))) * 4096 + C_WK + nkv * 64; vb = kb + (C_WV - C_WK); rs = 4096; } \
        _Pragma("unroll") for (int i = 0; i < 2; ++i) { const int id = tid + NTHR * i; kreg[i] = *(const v4u*)(kb + (size_t)(id >> 3) * rs + (id & 7) * 8); vreg[i] = *(const v4u*)(vb + (size_t)(id >> 3) * rs + (id & 7) * 8); } }
    WIN_LOAD(0);
    for (int t = 0; t < NT; ++t) {
        LDS_BARRIER();
#pragma unroll
        for (int i = 0; i < 2; ++i) { const int id = tid + NTHR * i; *(v4u*)(Kt + (id >> 3) * 72 + (id & 7) * 8) = kreg[i]; *(v4u*)(Vr + (id >> 3) * VS + (id & 7) * 8) = vreg[i]; }
        if (t + 1 < NT) WIN_LOAD(t + 1);
        LDS_BARRIER();
#pragma unroll
        for (int sub = 0; sub < 2; ++sub) {
            bool band = false; int kp0 = 0;
            if (PASS && t >= 2) { band = true; kp0 = 128 * (tb0 + t - 2) + 64 * sub; const int r0 = q0 + 32 * w;
                if (kp0 + 63 < r0 - 128 || kp0 > r0 + 31 + 128) continue; }
            f32x16 p0, p1; bx8 pb[4];
            qk_tile(p0, p1, Kt + sub * 64 * 72, 72, qf, r32, hi);
            if (band) {
#pragma unroll
                for (int r = 0; r < 16; ++r) { const int kp = kp0 + (r & 3) + 8 * (r >> 2) + 4 * hi; const int d0 = qrow - kp, d1 = d0 - 32;
                    if (d0 > 128 || d0 < -128) p0[r] = -1e30f; if (d1 > 128 || d1 < -128) p1[r] = -1e30f; }
            }
            const float alpha = sm_step(p0, p1, mrun, lrun, pb);
            if (__any(alpha != 1.0f)) {
#pragma unroll
                for (int dt = 0; dt < 2; ++dt)
#pragma unroll
                    for (int r = 0; r < 16; ++r) o[dt][r] *= alpha; }
            pv_tile<2, VS>(o, Vr + sub * 64 * VS, pb, lane);
        }
    }
#undef WIN_LOAD
    const float inv = 1.0f / lrun; bf16* yp = c.Y() + mrow * 2048 + 1536 + hh * 64;
#pragma unroll
    for (int dt = 0; dt < 2; ++dt)
#pragma unroll
        for (int r4 = 0; r4 < 4; ++r4) { const int dv = 32 * dt + 8 * r4 + 4 * hi;
            v2u ov; ov.x = pk2(o[dt][4 * r4 + 0] * inv, o[dt][4 * r4 + 1] * inv); ov.y = pk2(o[dt][4 * r4 + 2] * inv, o[dt][4 * r4 + 3] * inv);
            *(v2u*)(yp + dv) = ov; }
}

__device__ __forceinline__ void phase_mixers(const Ctx& c_in, int l, float* lf) {
    unsigned char* lds = (unsigned char*)lf;
    unsigned* qctr = (unsigned*)(c_in.ws() + WS_QCTR) + 64 * l;
    volatile int* qslot = (volatile int*)(lds + LDS_BYTES - 32);
    for (;;) {
        __syncthreads();
        if (threadIdx.x == 0) *qslot = (int)atomicAdd(qctr, 1u);
        __syncthreads();
        const int u = __builtin_amdgcn_readfirstlane(*qslot);
        if (u >= 1440) break;
        Ctx c = c_in; asm volatile("" : "+s"(c.ap), "+v"(c.tid));
        c.lane = c.tid & 63; c.wave = __builtin_amdgcn_readfirstlane(c.tid >> 6);
        unsigned long long pt0 = 0; if (PROBE_SEL >= 0) pt0 = __builtin_amdgcn_s_memrealtime();
        int ty;
        if (u < 32) { ssd_unit(c, l, 1, u >> 3, u & 7, lds); ty = 0; }
        else if (u < 160) { diff_unit<1>(c, l, u - 32, lds); ty = 2; }
        else if (u < 288) { win_unit<1>(c, l, u - 160, lds); ty = 3; }
        else if (u < 416) { s5_unit(c, l, (u - 288) & 31, 8 + ((u - 288) >> 5), lds); ty = 1; }
        else if (u < 672) { ssd_unit(c, l, 0, (u - 416) >> 3, (u - 416) & 7, lds); ty = 4; }
        else if (u < 928) { diff_unit<0>(c, l, u - 672, lds); ty = 6; }
        else if (u < 1184) { win_unit<0>(c, l, u - 928, lds); ty = 7; }
        else { s5_unit(c, l, (u - 1184) & 31, (u - 1184) >> 5, lds); ty = 5; }
        __syncthreads();
        if (PROBE_SEL >= 0 && threadIdx.x == 0) { unsigned long long* tsu = (unsigned long long*)(c.ws() + WS_TS) + 64; atomicAdd(tsu + ty, (unsigned long long)(__builtin_amdgcn_s_memrealtime() - pt0)); }
    }
}

__device__ __forceinline__ void phase_sum4(const Ctx& c) {
    const int gt = blockIdx.x * NTHR + c.tid, NT = gridDim.x * NTHR;
#pragma unroll 4
    for (int i = gt; i < M * 128; i += NT) { const size_t m = (size_t)(i >> 7); const int c8 = (i & 127) * 8;
        float a[8] = {0.f, 0.f, 0.f, 0.f, 0.f, 0.f, 0.f, 0.f};
#pragma unroll
        for (int j = 0; j < 4; ++j) { float f[8]; unpack8(*(const v4u*)(c.R1() + m * 4096 + j * 1024 + c8), f);
#pragma unroll
            for (int k = 0; k < 8; ++k) a[k] += f[k]; }
        v4u o; o.x = pk2(a[0], a[1]); o.y = pk2(a[2], a[3]); o.z = pk2(a[4], a[5]); o.w = pk2(a[6], a[7]);
        *(v4u*)(c.H() + m * 1024 + c8) = o; }
}

#define GAS __attribute__((address_space(1)))
#define XB_TMO      128
#define XB_XCNT(j)  (256  + 64 * (j))
#define XB_XSUB(j)  (1280 + 64 * (j))
#define XB_XGEN(j)  (2304 + 64 * (j))
#define XB_TOP      3328
#define XB_TOPGEN   3392
#define XCD_BAR_WORDS 3456
#define XB_SPIN_CAP (1u << 18)

__device__ __forceinline__ unsigned xb_ld(unsigned* p)              { return __hip_atomic_load(p, __ATOMIC_RELAXED, __HIP_MEMORY_SCOPE_AGENT); }
__device__ __forceinline__ unsigned xb_add(unsigned* p, unsigned v) { return __hip_atomic_fetch_add(p, v, __ATOMIC_RELAXED, __HIP_MEMORY_SCOPE_AGENT); }
__device__ __forceinline__ unsigned xb_xcc_id() { return (unsigned)__builtin_amdgcn_s_getreg((3 << 11) | 20) & 0xFu; }
#define XB_SPIN(cond, bar) do { unsigned _sp = 0; while (cond) { __builtin_amdgcn_s_sleep(1); \
    if ((++_sp & 255u) == 0u) { if (xb_ld(&(bar)[XB_TMO])) break; if (_sp > XB_SPIN_CAP) { atomicAdd(&(bar)[XB_TMO], 1u); break; } } } } while (0)

struct XcdBarrier {
    unsigned* bar; unsigned x;
    volatile LAS unsigned* st;
};

__device__ __forceinline__ XcdBarrier xcd_barrier_post(unsigned* bar, volatile LAS unsigned* st) {
    XcdBarrier b; b.bar = bar; b.x = xb_xcc_id(); b.st = st;
    if (threadIdx.x == 0) (void)xb_add(&bar[XB_XCNT(b.x)], 1u);
    return b;
}
__device__ __forceinline__ void xcd_barrier_complete(unsigned* bar, unsigned x, unsigned& nloc, unsigned& nx) {
    const unsigned G = gridDim.x * gridDim.y * gridDim.z;
    unsigned sum, cnt, mine, sp = 0u;
    for (;;) {
        sum = 0u; cnt = 0u; mine = 0u;
#pragma unroll
        for (unsigned j = 0; j < 16; ++j) { const unsigned c = xb_ld(&bar[XB_XCNT(j)]); sum += c; cnt += (c > 0u) ? 1u : 0u; mine = (j == x) ? c : mine; }
        if (sum == G) break;
        __builtin_amdgcn_s_sleep(1);
        if ((++sp & 255u) == 0u) { if (xb_ld(&bar[XB_TMO])) break; if (sp > XB_SPIN_CAP) { atomicAdd(&bar[XB_TMO], 1u); break; } }
    }
    nloc = mine > 0u ? mine : 1u; nx = cnt > 0u ? cnt : 1u;
}

__device__ __forceinline__ void xcd_barrier(const XcdBarrier& b) {
    asm volatile("s_waitcnt vmcnt(0)" ::: "memory");
    __syncthreads();
    if (threadIdx.x == 0) {
        unsigned* bar = b.bar;
        __builtin_amdgcn_s_waitcnt(0);
        unsigned nloc = b.st[0], nx = b.st[1];
        if (nloc == 0u) { xcd_barrier_complete(bar, b.x, nloc, nx); b.st[0] = nloc; b.st[1] = nx; }
        const unsigned old = xb_add(&bar[XB_XSUB(b.x)], 1u);
        const unsigned gen = old / nloc;
        if (old + 1u == (gen + 1u) * nloc) {
            __builtin_amdgcn_fence(__ATOMIC_RELEASE, "agent");
            asm volatile("s_waitcnt vmcnt(0)" ::: "memory");
            const unsigned og = xb_add(&bar[XB_TOP], 1u);
            const unsigned tg = og / nx;
            if (og + 1u == (tg + 1u) * nx) xb_add(&bar[XB_TOPGEN], 1u);
            else XB_SPIN(xb_ld(&bar[XB_TOPGEN]) == tg, bar);
            __builtin_amdgcn_fence(__ATOMIC_ACQUIRE, "agent");
            xb_add(&bar[XB_XGEN(b.x)], 1u);
            asm volatile("s_waitcnt vmcnt(0)" ::: "memory");
        } else {
            XB_SPIN(xb_ld(&bar[XB_XGEN(b.x)]) == gen, bar);
            __builtin_amdgcn_fence(__ATOMIC_ACQUIRE, "agent");
            asm volatile("s_waitcnt vmcnt(0)" ::: "memory");
        }
    }
    __syncthreads();
}

#define PHASE_BEGIN() Ctx c; c.ap = (CArgs)__builtin_amdgcn_kernarg_segment_ptr(); asm volatile("" : "+s"(c.ap)); \
        int tid_o = threadIdx.x; asm volatile("" : "+v"(tid_o)); c.tid = tid_o; c.lane = tid_o & 63; c.wave = __builtin_amdgcn_readfirstlane(tid_o >> 6); \
        int G = gridDim.x, bid = blockIdx.x; asm volatile("" : "+s"(G), "+s"(bid)); unsigned char* ws = c.ws(); (void)ws; (void)G; (void)bid;
#define PHASE_END(k) { if ((k) + 1 < ph_hi) { if ((k) == 0) cg::this_grid().sync(); else xcd_barrier(xbar); } \
        if (PROBE_SEL >= 0 && blockIdx.x == PROBE_PB && threadIdx.x == 0) ((unsigned long long*)(c.ws() + WS_TS))[(k) + 1] = __builtin_amdgcn_s_memrealtime(); }
#define IN_RANGE(k) (ph_lo <= (k) && (k) < ph_hi)

template <int LAYER> __device__ __forceinline__ void layer_program(int ph_lo, int ph_hi, unsigned char* lds, const XcdBarrier& xbar) {
    float* lf = (float*)lds;
    PG8_LAS unsigned char* ring = (PG8_LAS unsigned char*)lds;
    constexpr int l = LAYER, B0 = 1 + 11 * LAYER;
    if (IN_RANGE(B0 + 0)) { PHASE_BEGIN(); if (l == 1) { if (gridDim.x == 256) convert_items(c, 1, 7936, 9984, blockIdx.x * NWAVES + c.wave, gridDim.x * NWAVES, false, 0, 1, lf); else phase_convert(c, 1, lf); __syncthreads(); } phase_norm(c, l, 0, lf); phase_bias2(c, l); PHASE_END(B0 + 0); }
    if (IN_RANGE(B0 + 1)) { PHASE_BEGIN();
        pg8::Gemm g{c.H(), (const bf16*)(ws + W_IN), M, 4096, 1024, 1024, 1024, 0, 0}; pg8::StaticOrder S; S.init(M, 4096, G, bid);
        pg8::EpiIn E{c.R1(), c.out(), c.ROPE(), c.qn_g() + l * 64, c.kn_g() + l * 64, c.wqn_g() + l * 64, c.wkn_g() + l * 64, l};
        pg8::gemm_phase<pg8::EpiIn, pg8::StaticOrder, true, true>(ring, g, S, E, tid_o); PHASE_END(B0 + 1); }
    if (IN_RANGE(B0 + 2)) { PHASE_BEGIN(); phase_dt(c, l); phase_qk(c, l, lf); PHASE_END(B0 + 2); }
    if (IN_RANGE(B0 + 3)) { PHASE_BEGIN(); phase_mixers(c, l, lf); PHASE_END(B0 + 3); }
    if (IN_RANGE(B0 + 4)) { PHASE_BEGIN();
        { pg8::Gemm g{c.Y5(), (const bf16*)(ws + W_GLU), M, 1024, 512, 512, 512, 0, 0}; pg8::StaticOrder S; S.init(M, 1024, G, bid);
          pg8::EpiGlu E{c.Y(), 2048, 512, c.b_glu() + l * 1024};
          pg8::gemm_phase<pg8::EpiGlu, pg8::StaticOrder, true, true>(ring, g, S, E, tid_o); }
        { pg8::Gemm g{c.H(), (const bf16*)(ws + W_G), M, 4096, 1024, 1024, 1024, 0, 0}; pg8::StaticOrder S; S.init(M, 4096, G, bid);
          pg8::EpiB<1> E{c.R1(), 4096, c.b_gate() + l * 4096, nullptr};
          pg8::gemm_phase<pg8::EpiB<1>, pg8::StaticOrder, true, true>(ring, g, S, E, tid_o); }
        PHASE_END(B0 + 4); }
    if (IN_RANGE(B0 + 5)) { PHASE_BEGIN();
        pg8::Gemm g{c.Y(), (const bf16*)(ws + W_BR), M, 4096, 512, 2048, 512, 4, 1024}; pg8::BranchOrder S; S.init(G, bid);
        pg8::EpiMerge E{c.R1(), c.H(), c.SSQ()};
        pg8::gemm_phase<pg8::EpiMerge, pg8::BranchOrder, true, true>(ring, g, S, E, tid_o); if (l == 0) side_convert(c, 0, 4352, true, lf); PHASE_END(B0 + 5); }
    if (IN_RANGE(B0 + 7)) { PHASE_BEGIN();
        pg8::Gemm g{c.H(), (const bf16*)(ws + W_OUT), M, 1024, 1024, 1024, 1024, 0, 0}; pg8::StaticOrder S; S.init(M, 1024, G, bid);
        pg8::EpiRes2 E{l == 0 ? c.x_prompt() : c.out(), l == 0 ? c.x_sample() : c.out() + (size_t)MC * D, c.out(), c.MOD() + (size_t)l * 5 * 6144, 2048, c.Y(), c.g_norm2() + l * 1024, 4096, (float*)(ws + WS_SSQ2)};
        pg8::gemm_phase<pg8::EpiRes2, pg8::StaticOrder, true, true>(ring, g, S, E, tid_o); if (l == 0) side_convert(c, 4352, 5376, false, lf); PHASE_END(B0 + 7); }
    if (IN_RANGE(B0 + 9)) { PHASE_BEGIN();
        pg8::Gemm g{c.Y(), (const bf16*)(ws + W_1), M, 4096, 1024, 1024, 1024, 0, 0}; pg8::StaticOrder S; S.init(M, 4096, G, bid);
        pg8::EpiB<5> E{c.R1(), 4096, (const float*)(ws + WS_BI2), (const float*)(ws + WS_SSQ2)};
        pg8::gemm_phase<pg8::EpiB<5>, pg8::StaticOrder, true, true>(ring, g, S, E, tid_o); PHASE_END(B0 + 9); }
    if (IN_RANGE(B0 + 10)) { PHASE_BEGIN();
        pg8::Gemm g{c.R1(), (const bf16*)(ws + W_2), M, 1024, 4096, 4096, 4096, 0, 0}; pg8::StaticOrder S; S.init(M, 1024, G, bid);
        pg8::EpiRes E{c.out(), c.out() + (size_t)MC * D, c.out(), c.MOD() + (size_t)l * 5 * 6144, 5120};
        pg8::gemm_phase<pg8::EpiRes, pg8::StaticOrder, true, true>(ring, g, S, E, tid_o); if (l == 0) side_convert(c, 5376, 7936, false, lf); PHASE_END(B0 + 10); }
}

__global__ void __launch_bounds__(NTHR, 2) fwd_kernel(Args args) {
    extern __shared__ __attribute__((aligned(16))) unsigned char lds[];
    const int ph_lo = args.ph_lo, ph_hi = args.ph_hi;
    volatile LAS unsigned* xst = (volatile LAS unsigned*)(lds + LDS_BYTES - 16);
    if (threadIdx.x < 4) xst[threadIdx.x] = 0u;
    __syncthreads();
    const XcdBarrier xbar = xcd_barrier_post((unsigned*)(args.ws + WS_BAR), xst);
    if (PROBE_SEL >= 0 && blockIdx.x == PROBE_PB && threadIdx.x == 0) { unsigned long long* ts = (unsigned long long*)(args.ws + WS_TS); ts[0] = __builtin_amdgcn_s_memrealtime(); }
    if (IN_RANGE(0)) { PHASE_BEGIN(); float* lf = (float*)lds; phase_mods(c, lf); __syncthreads(); phase_convert(c, 0, lf); phase_rope_table(c); phase_ckv(c); PHASE_END(0); }
    layer_program<0>(ph_lo, ph_hi, lds, xbar);
    layer_program<1>(ph_lo, ph_hi, lds, xbar);
    if (PROBE_SEL >= 0) {
        __threadfence(); cg::this_grid().sync();
        const unsigned long long* ts = (const unsigned long long*)(args.ws + WS_TS);
        const float total = (float)(ts[23] - ts[0]); float sel = 0.f;
        for (int k = 0; k < 23; ++k) { const float d = (float)(ts[k + 1] - ts[k]); const int q = k == 0 ? -1 : (k - 1) % 11;
            const int cls = (q == 3) ? 0 : (q == 1 || q == 4 || q == 5 || q == 7 || q == 9 || q == 10) ? 1 : (q == 2) ? 2 : 3;
            if (cls == PROBE_SEL) sel += d; }
        if (PROBE_SEL >= 10 && PROBE_SEL < 100) sel = (float)ts[64 + PROBE_SEL - 10] * (1.0f / 256.0f);
        if (PROBE_SEL >= 100) { const int k = PROBE_SEL - 100; sel = (float)(ts[k + 1] - (ts[k] != 0ull ? ts[k] : ts[k - 1])); }
        const float sc = 1.0f + sqrtf(PROBE_SCALE * sel / total);
        for (int i = blockIdx.x * NTHR + threadIdx.x; i < 524288; i += gridDim.x * NTHR) args.out[O_S5 + i] *= sc;
    }
}

extern "C" void kernel_launch(void* const* d_in, const int* in_sizes, int n_in, void* d_out, int out_size, void* d_ws, size_t ws_size, hipStream_t stream) {
    static int grid = 0;
    if (grid == 0) {
        if (n_in != 44 || ws_size < WS_END) { fprintf(stderr, "kernel_launch: expected 44 inputs and >= %zu bytes of workspace; got %d, %zu\n", (size_t)WS_END, n_in, ws_size); grid = -1; return; }
        int dev = 0, cus = 0, per_cu = 0;
        (void)hipGetDevice(&dev); (void)hipDeviceGetAttribute(&cus, hipDeviceAttributeMultiprocessorCount, dev);
        (void)hipFuncSetAttribute((const void*)fwd_kernel, hipFuncAttributeMaxDynamicSharedMemorySize, LDS_BYTES);
        (void)hipOccupancyMaxActiveBlocksPerMultiprocessor(&per_cu, (const void*)fwd_kernel, NTHR, LDS_BYTES);
        if (per_cu < 1) { fprintf(stderr, "kernel_launch: occupancy query says %d blocks per CU\n", per_cu); per_cu = 1; }
        (void)hipGetLastError();
        grid = cus > 0 ? cus : 256;
    }
    if (grid < 0) return;
    (void)hipMemsetAsync(d_ws, 0, 64 * 1024, stream);
    Args a{};
    for (int i = 0; i < 44; ++i) a.in[i] = (const float*)d_in[i];
    a.out = (float*)d_out; a.ws = (unsigned char*)d_ws;
#if MK_MULTI
    for (int ph = 0; ph < NPH; ++ph) { a.ph_lo = ph; a.ph_hi = ph + 1; hipLaunchKernelGGL(fwd_kernel, dim3(grid), dim3(NTHR), LDS_BYTES, stream, a); }
#else
    a.ph_lo = 0; a.ph_hi = NPH;
    void* kargs[] = {&a};
    hipError_t e = hipLaunchCooperativeKernel((const void*)fwd_kernel, dim3(grid), dim3(NTHR), kargs, LDS_BYTES, stream);
    if (e != hipSuccess) fprintf(stderr, "cooperative launch failed: %s (grid %d)\n", hipGetErrorString(e), grid);
#endif
}
```

```cpp
#include <hip/hip_runtime.h>
#include <hip/hip_cooperative_groups.h>
#include <cstdio>
#include <cstdint>
namespace cg = cooperative_groups;

#ifndef MK_MULTI
#define MK_MULTI 0
#endif

namespace pg8 {
#define PG8_LAS __attribute__((address_space(3)))
typedef unsigned short bf16_t;
typedef short bf16x8 __attribute__((ext_vector_type(8)));
typedef float f32x4 __attribute__((ext_vector_type(4)));
typedef unsigned u32x4 __attribute__((ext_vector_type(4)));
constexpr int BM = 256, BK = 64, HALF = 128, HTB = HALF * BK * 2  , STAGE_BYTES = 8 * HTB, NXCD = 8, WGM = 8;

__host__ __device__ __forceinline__ int lds_byte(int r, int c) { const int st = (r >> 4) * 2 + (c >> 5), rr = r & 15, cc = c & 31, ob = rr * 64 + cc * 2; return st * 1024 + (ob ^ (((ob >> 9) & 1) << 5)); }
__host__ __device__ __forceinline__ void stage_rc(int b, int& R, int& C) { const int st = b / 1024, sb = b % 1024, swz = sb ^ (((sb >> 9) & 1) << 5); R = (st >> 1) * 16 + swz / 64; C = (st & 1) * 32 + (swz % 64) / 2; }
__host__ __device__ __forceinline__ int perm32(int rho) { const int n = rho >> 4, i = rho & 15; return 8 * (i >> 2) + 4 * n + (i & 3); }

struct Unit { int pm, pn; };
struct Gemm { const bf16_t* A; const bf16_t* Bt; int M, N, K, lda, ldb, a_div; size_t a_gstride; };

struct StaticOrder {
    int nM, nN, nwg, G, c;
    __host__ __device__ void init(int M, int N, int G_, int c_) { nM = M / BM; nN = N / BM; nwg = nM * nN; G = G_; c = c_; }
    __host__ __device__ bool next(int i, Unit& u) const {
        const long L = (long)i * G + c; if (L >= nwg) return false;
        int wgid = (int)L; { const int q = nwg / NXCD, r = nwg % NXCD, xcd = wgid % NXCD, off = wgid / NXCD; wgid = (xcd < r ? xcd * (q + 1) : r * (q + 1) + (xcd - r) * q) + off; }
        const int nig = WGM * nN, gid = wgid / nig, fm = gid * WGM, gsz = (nM - fm) < WGM ? (nM - fm) : WGM;
        u.pm = fm + ((wgid % nig) % gsz); u.pn = (wgid % nig) / gsz; return true;
    }
    __device__ __forceinline__ void a_ready(const Unit&) const {}
    __device__ __forceinline__ void done(const Unit&) const {}
};

__device__ __forceinline__ unsigned cvt_pk_bf16(float lo, float hi) { unsigned r; asm volatile("v_cvt_pk_bf16_f32 %0, %1, %2" : "=v"(r) : "v"(lo), "v"(hi)); return r; }
__device__ __forceinline__ float bf_lo(unsigned w) { return __builtin_bit_cast(float, w << 16); }
__device__ __forceinline__ float bf_hi(unsigned w) { return __builtin_bit_cast(float, w & 0xffff0000u); }
__device__ __forceinline__ float sigmoidf_(float x) { return 1.0f / (1.0f + __expf(-x)); }

template <int MODE> struct EpiB {
    static constexpr bool PERM = true, AFTER_DRAIN = false;
    bf16_t* O; int ldc; const float* bias; const float* ssq;
    __device__ __forceinline__ void operator()(const f32x4 (&acc)[2][2][4][2], const Unit& u, int wr, int wc, int fr, int fq) const {
        const int row0 = u.pm * BM + wr * 64 + fr, col0 = u.pn * BM + wc * 32 + 8 * fq;
        f32x4 bv[2][2];
#pragma unroll
        for (int bj = 0; bj < 2; ++bj)
#pragma unroll
            for (int n = 0; n < 2; ++n) bv[bj][n] = (MODE == 1) ? *(const f32x4*)(bias + col0 + bj * HALF + 4 * n) : (MODE == 5) ? *(const f32x4*)(bias + (size_t)((u.pm < 32) ? 0 : 1 + ((u.pm - 32) >> 2)) * 4096 + col0 + bj * HALF + 4 * n) : (f32x4){0.f, 0.f, 0.f, 0.f};
        u32x4 gpre[2][4][2]; float rpre[2][4];
        if (MODE == 3) {
#pragma unroll
            for (int ai = 0; ai < 2; ++ai)
#pragma unroll
                for (int m = 0; m < 4; ++m) { const int row = row0 + ai * HALF + m * 16; const bf16_t* rp = O + (size_t)row * ldc + col0;
                    rpre[ai][m] = (u.pn < 4) ? ssq[row] : 512.0f;
#pragma unroll
                    for (int bj = 0; bj < 2; ++bj) gpre[ai][m][bj] = *(const u32x4*)(rp + bj * HALF); }
        }
#pragma unroll
        for (int ai = 0; ai < 2; ++ai)
#pragma unroll
            for (int m = 0; m < 4; ++m) {
                const int row = row0 + ai * HALF + m * 16;
                bf16_t* rowp = O + (size_t)row * ldc + col0;
                float rs = 1.f;
                if (MODE == 3) { if (u.pn < 4) rs = rsqrtf(rpre[ai][m] * (1.0f / 512.0f) + 1e-6f); }
                if (MODE == 5) rs = rsqrtf(ssq[row] * (1.0f / 1024.0f) + 1e-6f);
                if (MODE == 8) { if (u.pn < 4) rs = rsqrtf(ssq[row] * (1.0f / 512.0f) + 1e-6f); }
#pragma unroll
                for (int bj = 0; bj < 2; ++bj) {
                    f32x4 v0 = ((MODE == 5 || MODE == 8) ? acc[ai][bj][m][0] * rs : acc[ai][bj][m][0]) + bv[bj][0], v1 = ((MODE == 5 || MODE == 8) ? acc[ai][bj][m][1] * rs : acc[ai][bj][m][1]) + bv[bj][1];
                    if (MODE == 1) {
#pragma unroll
                        for (int j = 0; j < 4; ++j) { v0[j] = sigmoidf_(v0[j]); v1[j] = sigmoidf_(v1[j]); }
                    }
                    if (MODE == 2 || MODE == 5) {
#pragma unroll
                        for (int j = 0; j < 4; ++j) { const float a = fmaxf(v0[j], 0.f), b = fmaxf(v1[j], 0.f); v0[j] = a * a; v1[j] = b * b; }
                    }
                    if (MODE == 3) {
                        const u32x4 gq = gpre[ai][m][bj];
                        v0[0] *= bf_lo(gq.x) * rs; v0[1] *= bf_hi(gq.x) * rs; v0[2] *= bf_lo(gq.y) * rs; v0[3] *= bf_hi(gq.y) * rs;
                        v1[0] *= bf_lo(gq.z) * rs; v1[1] *= bf_hi(gq.z) * rs; v1[2] *= bf_lo(gq.w) * rs; v1[3] *= bf_hi(gq.w) * rs;
                    }
                    u32x4 w; w.x = cvt_pk_bf16(v0[0], v0[1]); w.y = cvt_pk_bf16(v0[2], v0[3]); w.z = cvt_pk_bf16(v1[0], v1[1]); w.w = cvt_pk_bf16(v1[2], v1[3]);
                    *(u32x4*)(rowp + bj * HALF) = w;
                }
            }
    }
};
struct EpiGlu {
    static constexpr bool PERM = true, AFTER_DRAIN = false;
    bf16_t* O; int ldc; int ocol; const float* bias;
    __device__ __forceinline__ void operator()(const f32x4 (&acc)[2][2][4][2], const Unit& u, int wr, int wc, int fr, int fq) const {
        const int row0 = u.pm * BM + wr * 64 + fr, cc = u.pn * HALF + wc * 32 + 8 * fq;
        f32x4 bv[2][2];
#pragma unroll
        for (int bj = 0; bj < 2; ++bj)
#pragma unroll
            for (int n = 0; n < 2; ++n) bv[bj][n] = *(const f32x4*)(bias + bj * 512 + cc + 4 * n);
#pragma unroll
        for (int ai = 0; ai < 2; ++ai)
#pragma unroll
            for (int m = 0; m < 4; ++m) {
                bf16_t* rowp = O + (size_t)(row0 + ai * HALF + m * 16) * ldc + ocol + cc;
                f32x4 v0 = acc[ai][0][m][0] + bv[0][0], v1 = acc[ai][0][m][1] + bv[0][1];
                const f32x4 g0 = acc[ai][1][m][0] + bv[1][0], g1 = acc[ai][1][m][1] + bv[1][1];
#pragma unroll
                for (int j = 0; j < 4; ++j) { v0[j] *= sigmoidf_(g0[j]); v1[j] *= sigmoidf_(g1[j]); }
                u32x4 w; w.x = cvt_pk_bf16(v0[0], v0[1]); w.y = cvt_pk_bf16(v0[2], v0[3]); w.z = cvt_pk_bf16(v1[0], v1[1]); w.w = cvt_pk_bf16(v1[2], v1[3]);
                *(u32x4*)rowp = w;
            }
    }
};
struct EpiGateMerge {
    static constexpr bool PERM = true, AFTER_DRAIN = false;
    const bf16_t* Z; bf16_t* mg; const float* bgate;
    __device__ __forceinline__ void operator()(const f32x4 (&acc)[2][2][4][2], const Unit& u, int wr, int wc, int fr, int fq) const {
        typedef unsigned u32x2 __attribute__((ext_vector_type(2)));
        const int row0 = u.pm * BM + wr * 64 + fr, d0 = 64 * u.pn + 16 * wc + 4 * fq;
        f32x4 bv[2][2];
#pragma unroll
        for (int bj = 0; bj < 2; ++bj)
#pragma unroll
            for (int n = 0; n < 2; ++n) bv[bj][n] = *(const f32x4*)(bgate + (2 * bj + n) * 1024 + d0);
#pragma unroll
        for (int ai = 0; ai < 2; ++ai)
#pragma unroll
        for (int mh = 0; mh < 2; ++mh) {
            u32x2 zp[2][2][2];
#pragma unroll
            for (int mm = 0; mm < 2; ++mm) { const int row = row0 + ai * HALF + (2 * mh + mm) * 16;
#pragma unroll
                for (int bj = 0; bj < 2; ++bj)
#pragma unroll
                    for (int n = 0; n < 2; ++n) zp[mm][bj][n] = *(const u32x2*)(Z + (size_t)row * 4096 + (2 * bj + n) * 1024 + d0); }
#pragma unroll
            for (int mm = 0; mm < 2; ++mm) { const int m = 2 * mh + mm; const int row = row0 + ai * HALF + m * 16;
                f32x4 s = {0.f, 0.f, 0.f, 0.f};
#pragma unroll
                for (int bj = 0; bj < 2; ++bj)
#pragma unroll
                    for (int n = 0; n < 2; ++n) { const f32x4 a = acc[ai][bj][m][n] + bv[bj][n]; const u32x2 zq = zp[mm][bj][n];
                        s[0] += sigmoidf_(a[0]) * bf_lo(zq.x); s[1] += sigmoidf_(a[1]) * bf_hi(zq.x); s[2] += sigmoidf_(a[2]) * bf_lo(zq.y); s[3] += sigmoidf_(a[3]) * bf_hi(zq.y); }
                *(u32x2*)(mg + (size_t)row * 1024 + d0) = (u32x2){cvt_pk_bf16(s[0], s[1]), cvt_pk_bf16(s[2], s[3])}; }
        }
    }
};
struct EpiRes2 {
    static constexpr bool PERM = false, AFTER_DRAIN = false;
    const float* base_ctx; const float* base_lat; float* out; const float* modv; int goff;
    bf16_t* xn; const float* gnorm; int scoff; float* ssq;
    __device__ __forceinline__ void operator()(const f32x4 (&acc)[2][2][4][2], const Unit& u, int wr, int wc, int fr, int fq) const {
        const int row0 = u.pm * BM + wr * 64 + fr, col0 = u.pn * BM + wc * 32 + 4 * fq;
        const int mi = (u.pm < 32) ? 0 : 1 + ((u.pm - 32) >> 2);
        const float* gv = modv + (size_t)mi * 6144 + goff; const float* sv = modv + (size_t)mi * 6144 + scoff;
        f32x4 gg[2][2], gn[2][2];
#pragma unroll
        for (int bj = 0; bj < 2; ++bj)
#pragma unroll
            for (int n = 0; n < 2; ++n) { gg[bj][n] = *(const f32x4*)(gv + col0 + bj * HALF + n * 16); gn[bj][n] = *(const f32x4*)(gnorm + col0 + bj * HALF + n * 16) * (*(const f32x4*)(sv + col0 + bj * HALF + n * 16) + 1.0f); }
#pragma unroll
        for (int ai = 0; ai < 2; ++ai)
#pragma unroll
        for (int mh = 0; mh < 2; ++mh) {
            f32x4 pre[2][2][2];
#pragma unroll
            for (int mm = 0; mm < 2; ++mm) { const int row = row0 + ai * HALF + (2 * mh + mm) * 16;
                const float* bp = (row < 8192 ? base_ctx + (size_t)row * 1024 : base_lat + (size_t)(row - 8192) * 1024) + col0;
#pragma unroll
                for (int bj = 0; bj < 2; ++bj)
#pragma unroll
                    for (int n = 0; n < 2; ++n) pre[mm][bj][n] = *(const f32x4*)(bp + bj * HALF + n * 16); }
#pragma unroll
            for (int mm = 0; mm < 2; ++mm) { const int m = 2 * mh + mm; const int row = row0 + ai * HALF + m * 16; float* op = out + (size_t)row * 1024 + col0; bf16_t* xp = xn + (size_t)row * 1024 + col0;
                float q = 0.f;
#pragma unroll
                for (int bj = 0; bj < 2; ++bj)
#pragma unroll
                    for (int n = 0; n < 2; ++n) { const f32x4 x = pre[mm][bj][n] + gg[bj][n] * acc[ai][bj][m][n]; *(f32x4*)(op + bj * HALF + n * 16) = x;
                        q += (x[0] * x[0] + x[1] * x[1]) + (x[2] * x[2] + x[3] * x[3]);
                        const f32x4 y = x * gn[bj][n]; unsigned w0 = cvt_pk_bf16(y[0], y[1]), w1 = cvt_pk_bf16(y[2], y[3]);
                        typedef unsigned u32x2 __attribute__((ext_vector_type(2))); *(u32x2*)(xp + bj * HALF + n * 16) = (u32x2){w0, w1}; }
                q += __shfl_xor(q, 16); q += __shfl_xor(q, 32);
                if (fq == 0) atomicAdd(ssq + row, q); }
            asm volatile("" ::: "memory");
        }
    }
};
struct EpiMerge {
    static constexpr bool PERM = true, AFTER_DRAIN = false;
    const bf16_t* gates; bf16_t* mg; const float* ssq;
    __device__ __forceinline__ void operator()(const f32x4 (&acc)[2][2][4][2], const Unit& u, int wr, int wc, int fr, int fq) const {
        const int br = u.pn >> 2, pnl = u.pn & 3;
        int pm_o = u.pm; asm volatile("" : "+s"(pm_o));
        const int row0 = pm_o * BM + wr * 64 + fr, gcol0 = u.pn * BM + wc * 32 + 8 * fq, mcol0 = pnl * BM + wc * 32 + 8 * fq;
#pragma unroll
        for (int ai = 0; ai < 2; ++ai)
#pragma unroll
        for (int mh = 0; mh < 2; ++mh) {
            u32x4 gpre[2][2], mpre[2][2]; float rpre[2];
#pragma unroll
            for (int mm = 0; mm < 2; ++mm) { const int row = row0 + ai * HALF + (2 * mh + mm) * 16;
                rpre[mm] = (br == 0) ? ssq[row] : 512.0f;
#pragma unroll
                for (int bj = 0; bj < 2; ++bj) { gpre[mm][bj] = *(const u32x4*)(gates + (size_t)row * 4096 + gcol0 + bj * HALF);
                    mpre[mm][bj] = (br != 0) ? *(const u32x4*)(mg + (size_t)row * 1024 + mcol0 + bj * HALF) : (u32x4){0u, 0u, 0u, 0u}; } }
#pragma unroll
            for (int mm = 0; mm < 2; ++mm) { const int m = 2 * mh + mm; const int row = row0 + ai * HALF + m * 16;
                const float rs = (br == 0) ? rsqrtf(rpre[mm] * (1.0f / 512.0f) + 1e-6f) : 1.0f;
#pragma unroll
                for (int bj = 0; bj < 2; ++bj) { const u32x4 gq = gpre[mm][bj], mq = mpre[mm][bj]; const f32x4 a0 = acc[ai][bj][m][0], a1 = acc[ai][bj][m][1];
                    const float v0 = bf_lo(mq.x) + a0[0] * bf_lo(gq.x) * rs, v1 = bf_hi(mq.x) + a0[1] * bf_hi(gq.x) * rs, v2 = bf_lo(mq.y) + a0[2] * bf_lo(gq.y) * rs, v3 = bf_hi(mq.y) + a0[3] * bf_hi(gq.y) * rs;
                    const float v4 = bf_lo(mq.z) + a1[0] * bf_lo(gq.z) * rs, v5 = bf_hi(mq.z) + a1[1] * bf_hi(gq.z) * rs, v6 = bf_lo(mq.w) + a1[2] * bf_lo(gq.w) * rs, v7 = bf_hi(mq.w) + a1[3] * bf_hi(gq.w) * rs;
                    u32x4 w; w.x = cvt_pk_bf16(v0, v1); w.y = cvt_pk_bf16(v2, v3); w.z = cvt_pk_bf16(v4, v5); w.w = cvt_pk_bf16(v6, v7);
                    *(u32x4*)(mg + (size_t)row * 1024 + mcol0 + bj * HALF) = w; } }
            asm volatile("" ::: "memory");
        }
    }
};
struct BranchOrder {
    int G, c;
    __host__ __device__ void init(int G_, int c_) { G = G_; c = c_; }
    __host__ __device__ bool next(int i, Unit& u) const { if (c >= 192 || i >= 4) return false; u.pm = c >> 2; u.pn = i * 4 + (c & 3); return true; }
    __device__ __forceinline__ void a_ready(const Unit&) const {}
    __device__ __forceinline__ void done(const Unit&) const {}
};
struct EpiRes {
    static constexpr bool PERM = false, AFTER_DRAIN = false;
    const float* base_ctx; const float* base_lat;
    float* out; const float* modv;
    int goff;
    __device__ __forceinline__ void operator()(const f32x4 (&acc)[2][2][4][2], const Unit& u, int wr, int wc, int fr, int fq) const {
        const int row0 = u.pm * BM + wr * 64 + fr, col0 = u.pn * BM + wc * 32 + 4 * fq;
        const int mi = (u.pm < 32) ? 0 : 1 + ((u.pm - 32) >> 2);
        const float* gv = modv + (size_t)mi * 6144 + goff;
        f32x4 gg[2][2];
#pragma unroll
        for (int bj = 0; bj < 2; ++bj)
#pragma unroll
            for (int n = 0; n < 2; ++n) gg[bj][n] = *(const f32x4*)(gv + col0 + bj * HALF + n * 16);
#pragma unroll
        for (int ai = 0; ai < 2; ++ai) {
            f32x4 pre[4][2][2];
#pragma unroll
            for (int m = 0; m < 4; ++m) { const int row = row0 + ai * HALF + m * 16;
                const float* bp = (row < 8192 ? base_ctx + (size_t)row * 1024 : base_lat + (size_t)(row - 8192) * 1024) + col0;
#pragma unroll
                for (int bj = 0; bj < 2; ++bj)
#pragma unroll
                    for (int n = 0; n < 2; ++n) pre[m][bj][n] = *(const f32x4*)(bp + bj * HALF + n * 16); }
#pragma unroll
            for (int m = 0; m < 4; ++m) { const int row = row0 + ai * HALF + m * 16; float* op = out + (size_t)row * 1024 + col0;
#pragma unroll
                for (int bj = 0; bj < 2; ++bj)
#pragma unroll
                    for (int n = 0; n < 2; ++n) *(f32x4*)(op + bj * HALF + n * 16) = pre[m][bj][n] + gg[bj][n] * acc[ai][bj][m][n]; }
            asm volatile("" ::: "memory");
        }
    }
};

template <class Epi, class Sched, bool ALIGN_EPI = false, bool SP2 = false>
__device__ __forceinline__ void gemm_phase(PG8_LAS unsigned char* lds, const Gemm g, const Sched& S, const Epi& E, const int tid) {
    const int wid = __builtin_amdgcn_readfirstlane(tid >> 6), lane = tid & 63, wr = wid >> 2, wc = wid & 3, fr = lane & 15, fq = lane >> 4;
    const int K = g.K, nt = K / BK;
    unsigned voffA[2], voffB[2];
#pragma unroll
    for (int i = 0; i < 2; ++i) { int R, C; stage_rc(tid * 16 + i * 8192, R, C); const int Rb = Epi::PERM ? ((R & ~31) + perm32(R & 31)) : R;
        voffA[i] = (unsigned)(R * g.lda + C) * 2u; voffB[i] = (unsigned)(Rb * g.ldb + C) * 2u; }
    const size_t kstep = (size_t)(BK * 2);
    const size_t hstepA = (size_t)HALF * g.lda * 2, hstepB = (size_t)HALF * g.ldb * 2;
    const size_t tstepA = 2 * hstepA, tstepB = 2 * hstepB;
#define PG8_UA(u) ((const char*)g.A + (size_t)(u).pm * tstepA + (g.a_div ? (size_t)((u).pn / g.a_div) * g.a_gstride : (size_t)0))
#define PG8_UB(u) ((const char*)g.Bt + (size_t)(u).pn * tstepB)
    const unsigned ldsw = (unsigned)wid * 1024u;
    const int aoff = lds_byte(wr * 64 + fr, fq * 8), boff = lds_byte(wc * 32 + fr, fq * 8);
#define PG8_SA(b, h) (((b) * 2 + (h)) * HTB)
#define PG8_SB(b, h) ((4 + (b) * 2 + (h)) * HTB)
#define PG8_STAGE(bufoff, gbase, voff) do { _Pragma("unroll") for (int _i = 0; _i < 2; ++_i) \
        __builtin_amdgcn_global_load_lds((const unsigned*)((const char*)(gbase) + (voff)[_i]), (PG8_LAS unsigned*)(lds + (bufoff) + ldsw + _i * 8192), 16, 0, 0); } while (0)
#define PG8_LDA(dst, b, h) do { _Pragma("unroll") for (int m = 0; m < 4; ++m) _Pragma("unroll") for (int k = 0; k < 2; ++k) dst[m][k] = *(const PG8_LAS bf16x8*)(lds + PG8_SA(b, h) + aoff + m * 2048 + k * 1024); } while (0)
#define PG8_LDB(dst, b, h) do { _Pragma("unroll") for (int n = 0; n < 2; ++n) _Pragma("unroll") for (int k = 0; k < 2; ++k) dst[n][k] = *(const PG8_LAS bf16x8*)(lds + PG8_SB(b, h) + boff + n * 2048 + k * 1024); } while (0)
#define PG8_MMA(ai, bj, At, Bt) do { __builtin_amdgcn_s_setprio(1); _Pragma("unroll") for (int m = 0; m < 4; ++m) _Pragma("unroll") for (int n = 0; n < 2; ++n) _Pragma("unroll") for (int k = 0; k < 2; ++k) \
        acc[ai][bj][m][n] = __builtin_amdgcn_mfma_f32_16x16x32_bf16(Bt[n][k], At[m][k], acc[ai][bj][m][n], 0, 0, 0); __builtin_amdgcn_s_setprio(0); } while (0)
#define PG8_WAIT_V(n) asm volatile("s_waitcnt vmcnt(" #n ")" ::: "memory")
#define PG8_WAIT_L(n) asm volatile("s_waitcnt lgkmcnt(" #n ")" ::: "memory")
#define PG8_BAR __builtin_amdgcn_s_barrier()
#define PG8_SCHED __builtin_amdgcn_sched_barrier(0)
    Unit cur, nxt; int ui = 0;
    if (!S.next(0, cur)) return;
    f32x4 acc[2][2][4][2];
#pragma unroll
    for (int a = 0; a < 2; ++a)
#pragma unroll
        for (int b = 0; b < 2; ++b)
#pragma unroll
            for (int m = 0; m < 4; ++m)
#pragma unroll
                for (int n = 0; n < 2; ++n) acc[a][b][m][n] = (f32x4){0.f, 0.f, 0.f, 0.f};
    bf16x8 At[4][2], B0[2][2], B1[2][2];
    const char* cA = PG8_UA(cur); const char* cB = PG8_UB(cur);
    S.a_ready(cur);
    if constexpr (SP2) {
        PG8_STAGE(PG8_SB(0, 0), cB, voffB); PG8_STAGE(PG8_SB(0, 1), cB + hstepB, voffB); PG8_STAGE(PG8_SA(0, 0), cA, voffA); PG8_STAGE(PG8_SA(0, 1), cA + hstepA, voffA);
        if (wr == 1) PG8_BAR;
        PG8_WAIT_V(2); PG8_BAR;
        PG8_STAGE(PG8_SB(1, 0), cB + kstep, voffB); PG8_STAGE(PG8_SA(1, 0), cA + kstep, voffA); PG8_STAGE(PG8_SB(1, 1), cB + hstepB + kstep, voffB);
        PG8_WAIT_V(6); PG8_BAR;
    } else {
        PG8_STAGE(PG8_SB(0, 0), cB, voffB); PG8_STAGE(PG8_SA(0, 0), cA, voffA); PG8_STAGE(PG8_SB(0, 1), cB + hstepB, voffB); PG8_STAGE(PG8_SA(0, 1), cA + hstepA, voffA);
        if (wr == 1) PG8_BAR;
        PG8_WAIT_V(4); PG8_BAR;
        PG8_STAGE(PG8_SB(1, 0), cB + kstep, voffB); PG8_STAGE(PG8_SA(1, 0), cA + kstep, voffA); PG8_STAGE(PG8_SB(1, 1), cB + hstepB + kstep, voffB);
        PG8_WAIT_V(6); PG8_BAR;
    }
    for (;;) {
        const bool has_next = S.next(ui + 1, nxt);
        const char* nA = has_next ? PG8_UA(nxt) : cA; const char* nB = has_next ? PG8_UB(nxt) : cB;
        for (int t = 0; t < nt; t += 2) {
            const bool last = (t == nt - 2);
            const char* a1 = cA + (size_t)(t + 1) * kstep;
            const char* a2 = last ? nA : cA + (size_t)(t + 2) * kstep; const char* b2 = last ? nB : cB + (size_t)(t + 2) * kstep;
            const char* a3 = a2 + kstep; const char* b3 = b2 + kstep;
            if (last && has_next) S.a_ready(nxt);
            if constexpr (SP2) {
            PG8_LDB(B0, 0, 0); PG8_LDB(B1, 0, 1); PG8_SCHED; PG8_LDA(At, 0, 0); PG8_STAGE(PG8_SA(1, 1), a1 + hstepA, voffA);
            PG8_WAIT_V(8); PG8_WAIT_L(0); PG8_BAR; PG8_MMA(0, 0, At, B0); PG8_MMA(0, 1, At, B1); PG8_BAR; PG8_SCHED;
            PG8_LDA(At, 0, 1); PG8_STAGE(PG8_SB(0, 0), b2, voffB); PG8_STAGE(PG8_SB(0, 1), b2 + hstepB, voffB); PG8_STAGE(PG8_SA(0, 0), a2, voffA);
            PG8_WAIT_V(8); PG8_WAIT_L(0); PG8_BAR; PG8_MMA(1, 0, At, B0); PG8_MMA(1, 1, At, B1); PG8_BAR; PG8_SCHED;
            PG8_LDB(B0, 1, 0); PG8_LDB(B1, 1, 1); PG8_SCHED; PG8_LDA(At, 1, 0); PG8_STAGE(PG8_SA(0, 1), a2 + hstepA, voffA);
            PG8_WAIT_V(8); PG8_WAIT_L(0); PG8_BAR; PG8_MMA(0, 0, At, B0); PG8_MMA(0, 1, At, B1); PG8_BAR; PG8_SCHED;
            PG8_LDA(At, 1, 1); PG8_STAGE(PG8_SB(1, 0), b3, voffB); PG8_STAGE(PG8_SB(1, 1), b3 + hstepB, voffB); PG8_STAGE(PG8_SA(1, 0), a3, voffA);
            PG8_WAIT_V(8); PG8_WAIT_L(0); PG8_BAR; PG8_MMA(1, 0, At, B0); PG8_MMA(1, 1, At, B1); PG8_BAR; PG8_SCHED;
            } else {
            PG8_LDB(B0, 0, 0); PG8_SCHED; PG8_LDA(At, 0, 0); PG8_STAGE(PG8_SA(1, 1), a1 + hstepA, voffA);
            PG8_WAIT_L(8); PG8_BAR; PG8_WAIT_L(0); PG8_MMA(0, 0, At, B0); PG8_BAR; PG8_SCHED;
            PG8_LDB(B1, 0, 1); PG8_STAGE(PG8_SB(0, 0), b2, voffB);
            PG8_BAR; PG8_WAIT_L(0); PG8_MMA(0, 1, At, B1); PG8_BAR;
            PG8_LDA(At, 0, 1); PG8_STAGE(PG8_SA(0, 0), a2, voffA);
            PG8_BAR; PG8_WAIT_L(0); PG8_MMA(1, 0, At, B0); PG8_BAR; PG8_SCHED;
            PG8_STAGE(PG8_SB(0, 1), b2 + hstepB, voffB);
            PG8_WAIT_V(6); PG8_BAR; PG8_MMA(1, 1, At, B1); PG8_BAR;
            PG8_LDB(B0, 1, 0); PG8_SCHED; PG8_LDA(At, 1, 0); PG8_STAGE(PG8_SA(0, 1), a2 + hstepA, voffA);
            PG8_WAIT_L(8); PG8_BAR; PG8_WAIT_L(0); PG8_MMA(0, 0, At, B0); PG8_BAR; PG8_SCHED;
            PG8_LDB(B1, 1, 1); PG8_STAGE(PG8_SB(1, 0), b3, voffB);
            PG8_BAR; PG8_WAIT_L(0); PG8_MMA(0, 1, At, B1); PG8_BAR;
            PG8_LDA(At, 1, 1); PG8_STAGE(PG8_SA(1, 0), a3, voffA);
            PG8_BAR; PG8_WAIT_L(0); PG8_MMA(1, 0, At, B0); PG8_BAR; PG8_SCHED;
            PG8_STAGE(PG8_SB(1, 1), b3 + hstepB, voffB);
            PG8_WAIT_V(6); PG8_BAR; PG8_MMA(1, 1, At, B1); PG8_BAR;
            }
        }
        if constexpr (ALIGN_EPI) { if (wr == 0) PG8_BAR; }
        if constexpr (!Epi::AFTER_DRAIN) { E(acc, cur, wr, wc, fr, fq); S.done(cur); }
        if (!has_next) break;
#pragma unroll
        for (int a = 0; a < 2; ++a)
#pragma unroll
            for (int b = 0; b < 2; ++b)
#pragma unroll
                for (int m = 0; m < 4; ++m)
#pragma unroll
                    for (int n = 0; n < 2; ++n) acc[a][b][m][n] = (f32x4){0.f, 0.f, 0.f, 0.f};
        cur = nxt; cA = nA; cB = nB; ++ui;
        if constexpr (ALIGN_EPI) { if (wr == 1) PG8_BAR; }
    }
    PG8_WAIT_V(0);
    if constexpr (!ALIGN_EPI) { if (wr == 0) PG8_BAR; }
    PG8_BAR;
    if constexpr (Epi::AFTER_DRAIN) { E.fused(acc, cur, wr, wc, fr, fq, lds, wid, lane); S.done(cur); }
#undef PG8_UA
#undef PG8_UB
#undef PG8_SA
#undef PG8_SB
#undef PG8_STAGE
#undef PG8_LDA
#undef PG8_LDB
#undef PG8_MMA
#undef PG8_WAIT_V
#undef PG8_WAIT_L
#undef PG8_BAR
#undef PG8_SCHED
}
}

#ifndef PG8_SP2
#define PG8_SP2 true
#endif
#ifndef PG8_ALIGN
#define PG8_ALIGN true
#endif

typedef unsigned short bf16;
typedef unsigned v4u __attribute__((ext_vector_type(4)));
typedef unsigned v2u __attribute__((ext_vector_type(2)));
typedef float f32x4 __attribute__((ext_vector_type(4)));
#define LAS __attribute__((address_space(3)))

constexpr int NWAVES = 8, NTHR = 512;
constexpr int D = 1024, MC = 8192, ML = 4096, M = 12288, NPH = 23;
constexpr int LDS_BYTES = 147456;
constexpr float EPS = 1e-6f;
constexpr size_t MiB = 1u << 20;
constexpr size_t WS_MOD = 64 * 1024;
constexpr size_t WS_SSQ = 320 * 1024;
constexpr size_t WS_DT = 384 * 1024;
constexpr size_t WS_W = 2 * MiB;
constexpr size_t W_IN = WS_W, W_G = W_IN + 8 * MiB, W_GLU = W_G + 8 * MiB, W_BR = W_GLU + 1 * MiB, W_OUT = W_BR + 4 * MiB, W_1 = W_OUT + 2 * MiB, W_2 = W_1 + 8 * MiB;
constexpr size_t WS_H = 41 * MiB;
constexpr size_t WS_R1 = 65 * MiB;
constexpr size_t WS_Y = 161 * MiB;
constexpr size_t WS_Y5 = 209 * MiB;
constexpr size_t WS_XC = 221 * MiB;
constexpr size_t WS_S5K = 239 * MiB;
constexpr size_t WS_S5WS = 240 * MiB;
constexpr size_t WS_S5WO = 244 * MiB;
constexpr size_t WS_S5AT = 248 * MiB;
constexpr size_t WS_CKV = 248 * MiB + 512 * 1024;
constexpr size_t WS_ROPE = 1536 * 1024;
constexpr size_t WS_WDT = 1792 * 1024;
constexpr size_t WS_BI2 = 1824 * 1024;
constexpr size_t WS_SSQ2 = 1904 * 1024;
constexpr size_t WS_END = 254 * MiB;
#ifndef PROBE_SEL
#define PROBE_SEL -1
#endif
#ifndef PROBE_SCALE
#define PROBE_SCALE 4e-4f
#endif
#ifndef PROBE_PB
#define PROBE_PB 32
#endif
constexpr size_t WS_BAR = 32 * 1024;
constexpr size_t WS_QCTR = 48 * 1024;
constexpr size_t WS_TS = 16 * 1024;
constexpr size_t O_SSD = 12582912, O_S5 = 16777216, O_DK = 17301504, O_DV = 25690112, O_WK = 34078720, O_WV = 36175872;
constexpr int C_Z = 0, C_XBC = 512, C_U = 1280, C_DQ = 1792, C_DK = 2304, C_DV = 2816, C_WQ = 3328, C_WK = 3840, C_WV = 3968;

namespace pg8 {
struct EpiIn {
    static constexpr bool PERM = true, AFTER_DRAIN = false;
    bf16_t* O; float* out; const float* rope; const float* qg; const float* kg; const float* wqg; const float* wkg; int l;
    __device__ __forceinline__ void operator()(const f32x4 (&acc)[2][2][4][2], const Unit& u, int wr, int wc, int fr, int fq) const {
        const int pn = u.pn; const bool lat = u.pm >= 32;
        const int row0 = u.pm * BM + wr * 64 + fr, lcol0 = pn * BM + 64 * wc + 8 * fq;
        const float* gp = nullptr;
        if (pn == 7 || pn == 8) gp = qg; else if (pn == 9 || pn == 10) gp = kg; else if (pn == 13 || pn == 14) gp = wqg; else if (pn == 15 && wc < 2) gp = wkg;
        float* fo = nullptr; int fstride = 0;
        if (!lat) { if (pn == 9 || pn == 10) { fo = out + O_DK + (pn - 9) * 256 + 64 * wc + 8 * fq; fstride = 512; }
                    else if (pn == 11 || pn == 12) { fo = out + O_DV + (pn - 11) * 256 + 64 * wc + 8 * fq; fstride = 512; }
                    else if (pn == 15) { fo = out + (wc < 2 ? O_WK + 64 * wc : O_WV + 64 * (wc - 2)) + 8 * fq; fstride = 128; } }
        f32x4 g[2][2];
#pragma unroll
        for (int bj = 0; bj < 2; ++bj)
#pragma unroll
            for (int n = 0; n < 2; ++n) g[bj][n] = gp ? *(const f32x4*)(gp + 32 * bj + 8 * fq + 4 * n) : (f32x4){1.f, 1.f, 1.f, 1.f};
#pragma unroll
        for (int ai = 0; ai < 2; ++ai)
#pragma unroll
            for (int m = 0; m < 4; ++m) {
                const int row = row0 + ai * HALF + m * 16;
                f32x4 v[2][2];
#pragma unroll
                for (int bj = 0; bj < 2; ++bj)
#pragma unroll
                    for (int n = 0; n < 2; ++n) v[bj][n] = acc[ai][bj][m][n];
                if (gp) {
                    float ss = 0.f;
#pragma unroll
                    for (int bj = 0; bj < 2; ++bj)
#pragma unroll
                        for (int n = 0; n < 2; ++n) ss += (v[bj][n][0] * v[bj][n][0] + v[bj][n][1] * v[bj][n][1]) + (v[bj][n][2] * v[bj][n][2] + v[bj][n][3] * v[bj][n][3]);
                    ss += __shfl_xor(ss, 16); ss += __shfl_xor(ss, 32);
                    const float rs = rsqrtf(ss * (1.0f / 64.0f) + 1e-6f);
#pragma unroll
                    for (int bj = 0; bj < 2; ++bj)
#pragma unroll
                        for (int n = 0; n < 2; ++n) v[bj][n] = v[bj][n] * rs * g[bj][n];
                    if (lat) {
                        const float* rp = rope + (size_t)((row - 8192) & 1023) * 64 + 8 * (fq & 1);
#pragma unroll
                        for (int bj = 0; bj < 2; ++bj)
#pragma unroll
                            for (int n = 0; n < 2; ++n) { const f32x4 cs = *(const f32x4*)(rp + 16 * bj + 4 * n), sn = *(const f32x4*)(rp + 32 + 16 * bj + 4 * n);
                                f32x4 p; p[0] = __shfl_xor(v[bj][n][0], 32); p[1] = __shfl_xor(v[bj][n][1], 32); p[2] = __shfl_xor(v[bj][n][2], 32); p[3] = __shfl_xor(v[bj][n][3], 32);
                                v[bj][n] = (fq >> 1) ? v[bj][n] * cs + p * sn : v[bj][n] * cs - p * sn; }
                    }
                }
                bf16_t* rowp = O + (size_t)row * 4096 + lcol0;
#pragma unroll
                for (int bj = 0; bj < 2; ++bj) { u32x4 w; w.x = cvt_pk_bf16(v[bj][0][0], v[bj][0][1]); w.y = cvt_pk_bf16(v[bj][0][2], v[bj][0][3]); w.z = cvt_pk_bf16(v[bj][1][0], v[bj][1][1]); w.w = cvt_pk_bf16(v[bj][1][2], v[bj][1][3]);
                    *(u32x4*)(rowp + 32 * bj) = w; }
                if (fo) { float* fp = fo + (size_t)(((row >> 8) * 2 + l) * 256 + (row & 255)) * fstride;
#pragma unroll
                    for (int bj = 0; bj < 2; ++bj) { *(f32x4*)(fp + 32 * bj) = v[bj][0]; *(f32x4*)(fp + 32 * bj + 4) = v[bj][1]; } }
            }
    }
};
}

struct Args { const float* in[44]; float* out; unsigned char* ws; int ph_lo, ph_hi; };

typedef const Args __attribute__((address_space(4)))* CArgs;
struct Ctx {
    CArgs ap; int tid, lane, wave;
    __device__ __forceinline__ const float* x_prompt() const { return ap->in[0]; }
    __device__ __forceinline__ const float* x_sample() const { return ap->in[1]; }
    __device__ __forceinline__ const float* state_ssd() const { return ap->in[2]; }
    __device__ __forceinline__ const float* state_s5() const { return ap->in[3]; }
    __device__ __forceinline__ const float* cache_dk() const { return ap->in[4]; }
    __device__ __forceinline__ const float* cache_dv() const { return ap->in[5]; }
    __device__ __forceinline__ const float* cache_wk() const { return ap->in[6]; }
    __device__ __forceinline__ const float* cache_wv() const { return ap->in[7]; }
    __device__ __forceinline__ const float* cvec() const { return ap->in[8]; }
    __device__ __forceinline__ const float* c_ctx() const { return ap->in[9]; }
    __device__ __forceinline__ const float* w_mod() const { return ap->in[10]; }
    __device__ __forceinline__ const float* b_mod() const { return ap->in[11]; }
    __device__ __forceinline__ const float* g_norm1() const { return ap->in[12]; }
    __device__ __forceinline__ const float* g_norm2() const { return ap->in[13]; }
    __device__ __forceinline__ const float* w_in() const { return ap->in[14]; }
    __device__ __forceinline__ const float* conv_w() const { return ap->in[15]; }
    __device__ __forceinline__ const float* conv_b() const { return ap->in[16]; }
    __device__ __forceinline__ const float* dt_bias() const { return ap->in[17]; }
    __device__ __forceinline__ const float* a_log() const { return ap->in[18]; }
    __device__ __forceinline__ const float* ssd_d() const { return ap->in[19]; }
    __device__ __forceinline__ const float* ssd_norm_g() const { return ap->in[20]; }
    __device__ __forceinline__ const float* lam_re() const { return ap->in[21]; }
    __device__ __forceinline__ const float* lam_im() const { return ap->in[22]; }
    __device__ __forceinline__ const float* log_step() const { return ap->in[23]; }
    __device__ __forceinline__ const float* b_re() const { return ap->in[24]; }
    __device__ __forceinline__ const float* b_im() const { return ap->in[25]; }
    __device__ __forceinline__ const float* c_re() const { return ap->in[26]; }
    __device__ __forceinline__ const float* c_im() const { return ap->in[27]; }
    __device__ __forceinline__ const float* s5_d() const { return ap->in[28]; }
    __device__ __forceinline__ const float* w_glu() const { return ap->in[29]; }
    __device__ __forceinline__ const float* b_glu() const { return ap->in[30]; }
    __device__ __forceinline__ const float* qn_g() const { return ap->in[31]; }
    __device__ __forceinline__ const float* kn_g() const { return ap->in[32]; }
    __device__ __forceinline__ const float* dlam() const { return ap->in[33]; }
    __device__ __forceinline__ const float* subln_g() const { return ap->in[34]; }
    __device__ __forceinline__ const float* wqn_g() const { return ap->in[35]; }
    __device__ __forceinline__ const float* wkn_g() const { return ap->in[36]; }
    __device__ __forceinline__ const float* sink() const { return ap->in[37]; }
    __device__ __forceinline__ const float* w_branch() const { return ap->in[38]; }
    __device__ __forceinline__ const float* w_gate() const { return ap->in[39]; }
    __device__ __forceinline__ const float* b_gate() const { return ap->in[40]; }
    __device__ __forceinline__ const float* w_out() const { return ap->in[41]; }
    __device__ __forceinline__ const float* w_fc1() const { return ap->in[42]; }
    __device__ __forceinline__ const float* w_fc2() const { return ap->in[43]; }
    __device__ __forceinline__ float* out() const { return ap->out; }
    __device__ __forceinline__ unsigned char* ws() const { return ap->ws; }
    __device__ __forceinline__ float* MOD() const { return (float*)(ap->ws + WS_MOD); }
    __device__ __forceinline__ float* SSQ() const { return (float*)(ap->ws + WS_SSQ); }
    __device__ __forceinline__ float* DT() const { return (float*)(ap->ws + WS_DT); }
    __device__ __forceinline__ bf16* H() const { return (bf16*)(ap->ws + WS_H); }
    __device__ __forceinline__ bf16* R1() const { return (bf16*)(ap->ws + WS_R1); }
    __device__ __forceinline__ bf16* Y() const { return (bf16*)(ap->ws + WS_Y); }
    __device__ __forceinline__ bf16* Y5() const { return (bf16*)(ap->ws + WS_Y5); }
    __device__ __forceinline__ bf16* XC() const { return (bf16*)(ap->ws + WS_XC); }
    __device__ __forceinline__ bf16* CKV() const { return (bf16*)(ap->ws + WS_CKV); }
    __device__ __forceinline__ float* ROPE() const { return (float*)(ap->ws + WS_ROPE); }
};

__device__ __forceinline__ float wave_sum(float v) {
#pragma unroll
    for (int o = 1; o < 64; o <<= 1) v += __shfl_xor(v, o);
    return v;
}
__device__ __forceinline__ float wave_max(float v) {
#pragma unroll
    for (int o = 1; o < 64; o <<= 1) v = fmaxf(v, __shfl_xor(v, o));
    return v;
}
__device__ __forceinline__ float bf2f(bf16 h) { return __builtin_bit_cast(float, (unsigned)h << 16); }
__device__ __forceinline__ float bflo(unsigned w) { return __builtin_bit_cast(float, w << 16); }
__device__ __forceinline__ float bfhi(unsigned w) { return __builtin_bit_cast(float, w & 0xffff0000u); }
__device__ __forceinline__ unsigned f2bf(float f) { unsigned u = __builtin_bit_cast(unsigned, f); return (u + 0x7fffu + ((u >> 16) & 1u)) >> 16; }
__device__ __forceinline__ unsigned pk2(float lo, float hi) { return f2bf(lo) | (f2bf(hi) << 16); }
__device__ __forceinline__ float siluf(float x) { return x / (1.0f + __expf(-x)); }
__device__ __forceinline__ void unpack8(const v4u q, float (&f)[8]) { f[0] = bflo(q.x); f[1] = bfhi(q.x); f[2] = bflo(q.y); f[3] = bfhi(q.y); f[4] = bflo(q.z); f[5] = bfhi(q.z); f[6] = bflo(q.w); f[7] = bfhi(q.w); }

__device__ __forceinline__ void phase_mods(const Ctx& c, float* lf) {
    for (int i = c.tid; i < 5 * 1024; i += NTHR) { const int v = i >> 10, k = i & 1023; const float x = (v == 0) ? c.c_ctx()[k] : c.cvec()[(v - 1) * 1024 + k]; lf[i] = siluf(x); }
    __syncthreads();
    float* red = lf + 5 * 1024;
    for (int u = blockIdx.x; u < 192; u += gridDim.x) {
        const int l = u / 96, col0 = (u % 96) * 64;
        const float* W = c.w_mod() + (size_t)l * 1024 * 6144 + col0 + c.lane;
        float acc[5] = {0.f, 0.f, 0.f, 0.f, 0.f};
#pragma unroll 1
        for (int kb = c.wave * 128; kb < c.wave * 128 + 128; kb += 32) {
            float wv[32];
#pragma unroll
            for (int j = 0; j < 32; ++j) wv[j] = W[(size_t)(kb + j) * 6144];
#pragma unroll
            for (int j = 0; j < 32; ++j)
#pragma unroll
                for (int i = 0; i < 5; ++i) acc[i] += lf[i * 1024 + kb + j] * wv[j]; }
#pragma unroll
        for (int i = 0; i < 5; ++i) red[(c.wave * 5 + i) * 64 + c.lane] = acc[i];
        __syncthreads();
        if (c.tid < 320) { const int i = c.tid >> 6, ln = c.tid & 63; float s = c.b_mod()[l * 6144 + col0 + ln];
#pragma unroll
            for (int w = 0; w < 8; ++w) s += red[(w * 5 + i) * 64 + ln];
            c.MOD()[(size_t)(l * 5 + i) * 6144 + col0 + ln] = s; }
        __syncthreads();
    }
}

__device__ __forceinline__ int cmap(int mode, int n) {
    if (mode == 0) return n;
    if (mode == 1) { const int p = n & 255, lc = 64 * ((p >> 5) & 3) + 32 * (p >> 7) + (p & 31), nn = (n & ~255) + lc; return nn < 1280 ? nn : nn + 16; }
    if (mode == 3) { const int T = n >> 8, p = n & 255; return (2 * (p >> 7) + ((p >> 2) & 1)) * 1024 + 64 * T + 16 * ((p >> 5) & 3) + 4 * ((p >> 3) & 3) + (p & 3); }
    return (n & 255) < 128 ? 128 * (n >> 8) + (n & 127) : 512 + 128 * (n >> 8) + (n & 127);
}
__device__ __forceinline__ void transpose_item(const float* W, int ld, int K, int N, int mode, const float* rowscale, bf16* WT, float* scr, int item, int lane) {
    const int nblk = N / 32, kb = item / nblk, nb = item % nblk, k0 = 64 * kb, n0 = 32 * nb, scl = (mode == 3) ? cmap(3, n0 + (lane & 31)) : cmap(mode, n0) + (lane & 31);
    float tv[32];
#pragma unroll
    for (int i = 0; i < 32; ++i) tv[i] = W[(size_t)(k0 + 2 * i + (lane >> 5)) * ld + scl];
    if (rowscale) {
#pragma unroll
        for (int i = 0; i < 32; ++i) tv[i] *= rowscale[k0 + 2 * i + (lane >> 5)]; }
#pragma unroll
    for (int i = 0; i < 32; ++i) scr[(2 * i + (lane >> 5)) * 33 + (lane & 31)] = tv[i];
    __builtin_amdgcn_fence(__ATOMIC_RELEASE, "wavefront"); __builtin_amdgcn_wave_barrier();
    const int ch = lane & 7;
#pragma unroll
    for (int j = 0; j < 4; ++j) { const int n = (lane >> 3) + 8 * j; const float* s = scr + (8 * ch) * 33 + n;
        v4u o; o.x = pk2(s[0 * 33], s[1 * 33]); o.y = pk2(s[2 * 33], s[3 * 33]); o.z = pk2(s[4 * 33], s[5 * 33]); o.w = pk2(s[6 * 33], s[7 * 33]);
        *(v4u*)(WT + (size_t)(n0 + n) * K + k0 + 8 * ch) = o; }
    __builtin_amdgcn_fence(__ATOMIC_RELEASE, "wavefront"); __builtin_amdgcn_wave_barrier();
}
__device__ __forceinline__ void s5_tables(const Ctx& c, int l, int g, int part, float* lf);
__device__ __forceinline__ void convert_items(const Ctx& c, int l, int lo, int hi, int gw0, int ngw, bool tabs, int tb0, int ntb, float* lf) {
    unsigned char* ws = c.ws();
    if (tabs) {
        for (int t = tb0; t < 128; t += ntb) s5_tables(c, l, t & 31, t >> 5, lf);
        for (int i = tb0 * NTHR + c.tid; i < 16384; i += ntb * NTHR) { const int j = i >> 10, k = i & 1023; ((bf16*)(ws + WS_WDT))[i] = (bf16)f2bf(c.w_in()[(size_t)l * 1024 * 4112 + (size_t)k * 4112 + 1280 + j]); }
    }
    float* scr = lf + c.wave * 2176;
    for (int it = lo + gw0; it < hi; it += ngw) {
        int r = it;
        if (r < 2048) { transpose_item(c.w_in() + (size_t)l * 1024 * 4112, 4112, 1024, 4096, 1, nullptr, (bf16*)(ws + W_IN), scr, r, c.lane); continue; } r -= 2048;
        if (r < 2048) { transpose_item(c.w_gate() + (size_t)l * 1024 * 4096, 4096, 1024, 4096, 3, nullptr, (bf16*)(ws + W_G), scr, r, c.lane); continue; } r -= 2048;
        if (r < 256) { transpose_item(c.w_glu() + (size_t)l * 512 * 1024, 1024, 512, 1024, 2, nullptr, (bf16*)(ws + W_GLU), scr, r, c.lane); continue; } r -= 256;
        if (r < 1024) { const int i = r >> 8; transpose_item(c.w_branch() + (size_t)(l * 4 + i) * 512 * 1024, 1024, 512, 1024, 0, i == 0 ? c.ssd_norm_g() + l * 512 : nullptr, (bf16*)(ws + W_BR) + (size_t)i * 1024 * 512, scr, r & 255, c.lane); continue; } r -= 1024;
        if (r < 512) { transpose_item(c.w_out() + (size_t)l * 1024 * 1024, 1024, 1024, 1024, 0, nullptr, (bf16*)(ws + W_OUT), scr, r, c.lane); continue; } r -= 512;
        if (r < 2048) { transpose_item(c.w_fc1() + (size_t)l * 1024 * 4096, 4096, 1024, 4096, 0, nullptr, (bf16*)(ws + W_1), scr, r, c.lane); continue; } r -= 2048;
        transpose_item(c.w_fc2() + (size_t)l * 4096 * 1024, 1024, 4096, 1024, 0, nullptr, (bf16*)(ws + W_2), scr, r, c.lane);
    }
}
__device__ __forceinline__ void phase_convert(const Ctx& c, int l, float* lf) {
    if (gridDim.x == 256) convert_items(c, l, 0, 9984, blockIdx.x * NWAVES + c.wave, gridDim.x * NWAVES, true, blockIdx.x >= 192 ? (int)blockIdx.x - 192 : 100000, 64, lf);
    else convert_items(c, l, 0, 9984, blockIdx.x * NWAVES + c.wave, gridDim.x * NWAVES, true, blockIdx.x, gridDim.x, lf);
}
__device__ __forceinline__ void side_convert(const Ctx& c, int lo, int hi, bool tabs, float* lf) {
    if (blockIdx.x < 192 || gridDim.x != 256) return;
    convert_items(c, 1, lo, hi, (blockIdx.x - 192) * NWAVES + c.wave, 64 * NWAVES, tabs, blockIdx.x - 192, 64, lf);
}

__device__ __forceinline__ void phase_norm(const Ctx& c, int l, int which, float* lf) {
    const int gw = blockIdx.x * NWAVES + c.wave, NGW = gridDim.x * NWAVES;
    const float* gn = (which == 0 ? c.g_norm1() : c.g_norm2()) + l * 1024;
    for (int m = gw; m < M; m += NGW) {
        const float* xr = (l == 0 && which == 0) ? (m < MC ? c.x_prompt() + (size_t)m * D : c.x_sample() + (size_t)(m - MC) * D) : c.out() + (size_t)m * D;
        const int mi = (m < MC) ? 0 : 1 + ((m - MC) >> 10);
        const float* mod = c.MOD() + (size_t)(l * 5 + mi) * 6144 + which * 3072;
        f32x4 v[4]; float s = 0.f;
#pragma unroll
        for (int j = 0; j < 4; ++j) { v[j] = *(const f32x4*)(xr + 4 * c.lane + 256 * j); s += (v[j].x * v[j].x + v[j].y * v[j].y) + (v[j].z * v[j].z + v[j].w * v[j].w); }
        const float rstd = rsqrtf(wave_sum(s) * (1.0f / D) + EPS);
#pragma unroll
        for (int j = 0; j < 4; ++j) { const int k = 4 * c.lane + 256 * j; const f32x4 g = *(const f32x4*)(gn + k), sh = *(const f32x4*)(mod + k), sc = *(const f32x4*)(mod + 1024 + k);
            v[j] = v[j] * rstd * g * (sc + 1.0f) + sh;
            v2u o; o.x = pk2(v[j].x, v[j].y); o.y = pk2(v[j].z, v[j].w); *(v2u*)(c.H() + (size_t)m * D + k) = o; }
        if (which == 0) {
            if (c.lane == 0) { c.SSQ()[m] = 0.f; ((float*)(c.ws() + WS_SSQ2))[m] = 0.f; }
        }
    }
}

__device__ __forceinline__ void phase_bias2(const Ctx& c, int l) {
    const int gw = blockIdx.x * NWAVES + c.wave, NGW = gridDim.x * NWAVES, lane = c.lane;
    const bf16* W1t = (const bf16*)(c.ws() + W_1); float* bi = (float*)(c.ws() + WS_BI2);
    for (int n = gw; n < 4096; n += NGW) {
        float wf[16]; { float t8[8]; unpack8(*(const v4u*)(W1t + (size_t)n * 1024 + 8 * lane), t8);
#pragma unroll
            for (int j = 0; j < 8; ++j) wf[j] = t8[j];
            unpack8(*(const v4u*)(W1t + (size_t)n * 1024 + 512 + 8 * lane), t8);
#pragma unroll
            for (int j = 0; j < 8; ++j) wf[8 + j] = t8[j]; }
#pragma unroll 1
        for (int mi = 0; mi < 5; ++mi) { const float* sh = c.MOD() + (size_t)(l * 5 + mi) * 6144 + 3072; float a = 0.f;
#pragma unroll
            for (int hh = 0; hh < 2; ++hh) { const f32x4 s0 = *(const f32x4*)(sh + 512 * hh + 8 * lane), s1 = *(const f32x4*)(sh + 512 * hh + 8 * lane + 4);
                a += (wf[8 * hh + 0] * s0.x + wf[8 * hh + 1] * s0.y) + (wf[8 * hh + 2] * s0.z + wf[8 * hh + 3] * s0.w) + (wf[8 * hh + 4] * s1.x + wf[8 * hh + 5] * s1.y) + (wf[8 * hh + 6] * s1.z + wf[8 * hh + 7] * s1.w); }
            a = wave_sum(a); if (lane == 0) bi[mi * 4096 + n] = a; }
    }
}

__device__ __forceinline__ void phase_dt(const Ctx& c, int l) {
    const int tile = blockIdx.x * 3 + c.wave;
    if (c.wave < 3 && tile < 768) {
    const int lr = c.lane & 15, lq = c.lane >> 4;
    const bf16* ap = c.H() + (size_t)(16 * tile + lr) * 1024 + 8 * lq; const bf16* bp = (const bf16*)(c.ws() + WS_WDT) + (size_t)lr * 1024 + 8 * lq;
    f32x4 acc = {0.f, 0.f, 0.f, 0.f};
#pragma unroll 8
    for (int ks = 0; ks < 32; ++ks) acc = __builtin_amdgcn_mfma_f32_16x16x32_bf16(*(const pg8::bf16x8*)(ap + 32 * ks), *(const pg8::bf16x8*)(bp + 32 * ks), acc, 0, 0, 0);
    const float bias = c.dt_bias()[l * 16 + lr];
#pragma unroll
    for (int r = 0; r < 4; ++r) { const float x = acc[r] + bias; c.DT()[(size_t)(16 * tile + 4 * lq + r) * 16 + lr] = x > 20.f ? x : log1pf(__expf(x)); }
    }
}

__device__ __forceinline__ void phase_rope_table(const Ctx& c) {
    const int gt = blockIdx.x * NTHR + c.tid;
    if (gt < 32768) { const int pos = gt >> 5, a = gt & 31, f = a & 15; const float inv = exp2f(-(float)f * 0.8304820237218406f);
        const float ang = (float)((a >> 4) ? (pos & 63) : (pos >> 6)) * inv; float sn, cs; sincosf(ang, &sn, &cs); c.ROPE()[pos * 64 + a] = cs; c.ROPE()[pos * 64 + 32 + a] = sn; }
}
__device__ __forceinline__ void phase_ckv(const Ctx& c) {
    const int gw = blockIdx.x * NWAVES + c.wave, NGW = gridDim.x * NWAVES, lane = c.lane;
    for (int r = gw; r < 2048; r += NGW) { const int l = r >> 10, b = (r >> 8) & 3, sidx = r & 255; const size_t cb = (size_t)(b * 2 + l) * 256 + sidx; bf16* dst = c.CKV() + (size_t)r * 1280;
#pragma unroll
        for (int i = 0; i < 5; ++i) { const int e = 4 * (lane + 64 * i);
            const float* src = e < 512 ? c.cache_dk() + cb * 512 + e : e < 1024 ? c.cache_dv() + cb * 512 + (e - 512) : e < 1152 ? c.cache_wk() + cb * 128 + (e - 1024) : c.cache_wv() + cb * 128 + (e - 1152);
            const f32x4 v = *(const f32x4*)src; v2u o; o.x = pk2(v.x, v.y); o.y = pk2(v.z, v.w); *(v2u*)(dst + e) = o; } }
}
__device__ __forceinline__ void phase_qk(const Ctx& c, int l, float* lf) {
    const int gw = blockIdx.x * NWAVES + c.wave, NGW = gridDim.x * NWAVES, lane = c.lane;
    for (int i = c.tid; i < 7 * 768; i += NTHR) lf[i] = c.conv_w()[(size_t)l * 7 * 768 + i];
    for (int i = c.tid; i < 768; i += NTHR) lf[7 * 768 + i] = c.conv_b()[l * 768 + i];
    __syncthreads();
    const bf16* R1p = c.R1(); bf16* XCp = c.XC();
    for (int m0 = gw * 6; m0 < M; m0 += NGW * 6) {
        v2u xr[12][3];
#pragma unroll
        for (int rI = 0; rI < 12; ++rI) { const int mr = m0 - 3 + rI; const bool ok = mr >= 0 && mr < M;
#pragma unroll
            for (int i = 0; i < 3; ++i) xr[rI][i] = ok ? *(const v2u*)(R1p + (size_t)mr * 4096 + C_XBC + 4 * lane + 256 * i) : (v2u){0u, 0u}; }
        f32x4 wv[3][8];
#pragma unroll
        for (int i = 0; i < 3; ++i)
#pragma unroll
            for (int j = 0; j < 8; ++j) wv[i][j] = *(const f32x4*)(lf + j * 768 + 4 * lane + 256 * i);
#pragma unroll
        for (int k = 0; k < 6; ++k) { const int m = m0 + k; if (m >= M) break;
            const bool lat = m >= MC; const int t = lat ? (m - MC) & 1023 : m & 255, L = lat ? 1024 : 256;
#pragma unroll
            for (int i = 0; i < 3; ++i) { f32x4 a = wv[i][7];
#pragma unroll
                for (int j = 0; j < 7; ++j) { const int tt = t + j - 3; if (tt >= 0 && tt < L) { const v2u q = xr[k + j][i]; const f32x4 xv = {bflo(q.x), bfhi(q.x), bflo(q.y), bfhi(q.y)}; a += wv[i][j] * xv; } }
                v2u o; o.x = pk2(siluf(a.x), siluf(a.y)); o.y = pk2(siluf(a.z), siluf(a.w)); *(v2u*)(XCp + (size_t)m * 768 + 4 * lane + 256 * i) = o; }
        }
    }
}

typedef pg8::bf16x8 bx8;
#define LDS_BARRIER() do { asm volatile("s_waitcnt lgkmcnt(0)" ::: "memory"); __builtin_amdgcn_s_barrier(); asm volatile("" ::: "memory"); } while (0)
#define MFMA16(a, b, cc) __builtin_amdgcn_mfma_f32_16x16x32_bf16((a), (b), (cc), 0, 0, 0)
__device__ __forceinline__ void ssd_unit(const Ctx& c, int l, int pass, int b, int h, unsigned char* lds) {
    const int L = pass ? 1024 : 256, tok0 = pass ? MC + b * 1024 : b * 256, NCH = L >> 7;
    const int tid = c.tid, lane = c.lane, w = c.wave, lr = lane & 15, lq = lane >> 4, grp = h >> 2;
    bf16* XT = (bf16*)lds;
    bf16* BwT = XT + 64 * 136;
    bf16* Bm = BwT + 64 * 136;
    bf16* Cm = Bm + 128 * 72;
    bf16* Mm = Cm + 128 * 72;
    bf16* ST = Mm + 128 * 136;
    float* cum = (float*)(ST + 64 * 72);
    float* dtv = cum + 128; float* wv = dtv + 128; float* ecum = wv + 128; float* tot = ecum + 128;
    const float dsk = c.ssd_d()[l * 8 + h];
    const bf16* XCp = c.XC(); const float* DTp = c.DT(); bf16* Yp = c.Y(); const bf16* R1p = c.R1(); float* SSQp = c.SSQ();
    const int pi = w >> 1, nj0 = 2 * (w & 1);
    const int i = tid >> 2, part = tid & 3;
    for (int dir = 0; dir < 2; ++dir) {
        const float A = -__expf(c.a_log()[(l * 2 + dir) * 8 + h]);
        f32x4 Sacc[2];
        __syncthreads();
#pragma unroll
        for (int q = 0; q < 2; ++q)
#pragma unroll
            for (int r = 0; r < 4; ++r) { const int p = 16 * pi + 4 * lq + r, n = 16 * (nj0 + q) + lr;
                const float v = pass ? c.state_ssd()[(((((size_t)(b * 2 + l) * 2 + dir) * 8 + h) * 64 + p) * 64) + n] : 0.f;
                Sacc[q][r] = v; ST[p * 72 + n] = (bf16)f2bf(v); }
        v4u x0, x1, b0, b1, c0, c1; float d0 = 0.f, d1 = 0.f;
#define SSD_LOAD(ci_) { const int t_ = dir ? L - 1 - ((ci_) * 128 + i) : (ci_) * 128 + i; const bf16* xr_ = XCp + (size_t)(tok0 + t_) * 768; \
            x0 = *(const v4u*)(xr_ + h * 64 + part * 16); x1 = *(const v4u*)(xr_ + h * 64 + part * 16 + 8); \
            b0 = *(const v4u*)(xr_ + 512 + grp * 64 + part * 16); b1 = *(const v4u*)(xr_ + 512 + grp * 64 + part * 16 + 8); \
            c0 = *(const v4u*)(xr_ + 640 + grp * 64 + part * 16); c1 = *(const v4u*)(xr_ + 640 + grp * 64 + part * 16 + 8); \
            if (tid < 64) { const int i0_ = 2 * lane, ta_ = dir ? L - 1 - ((ci_) * 128 + i0_) : (ci_) * 128 + i0_, tb_ = dir ? ta_ - 1 : ta_ + 1; \
                d0 = DTp[(size_t)(tok0 + ta_) * 16 + dir * 8 + h]; d1 = DTp[(size_t)(tok0 + tb_) * 16 + dir * 8 + h]; } }
        SSD_LOAD(0);
        for (int ci = 0; ci < NCH; ++ci) {
            LDS_BARRIER();
            float bvals[16];
            { *(v4u*)(Bm + i * 72 + part * 16) = b0; *(v4u*)(Bm + i * 72 + part * 16 + 8) = b1;
              *(v4u*)(Cm + i * 72 + part * 16) = c0; *(v4u*)(Cm + i * 72 + part * 16 + 8) = c1;
              const unsigned xs[8] = {x0.x, x0.y, x0.z, x0.w, x1.x, x1.y, x1.z, x1.w};
#pragma unroll
              for (int j = 0; j < 8; ++j) { XT[(part * 16 + 2 * j) * 136 + i] = (bf16)(xs[j] & 0xffffu); XT[(part * 16 + 2 * j + 1) * 136 + i] = (bf16)(xs[j] >> 16); }
              float t8[8]; unpack8(b0, t8);
#pragma unroll
              for (int j = 0; j < 8; ++j) bvals[j] = t8[j];
              unpack8(b1, t8);
#pragma unroll
              for (int j = 0; j < 8; ++j) bvals[8 + j] = t8[j]; }
            if (tid < 64) {
                const int i0 = 2 * lane, i1 = i0 + 1;
                const float a0 = d0 * A, a1 = d1 * A; float s = a0 + a1;
#pragma unroll
                for (int o = 1; o < 64; o <<= 1) { const float v = __shfl_up(s, o); if (lane >= o) s += v; }
                const float cum1 = s, cum0 = s - a1, total = __shfl(s, 63);
                cum[i0] = cum0; cum[i1] = cum1; dtv[i0] = d0; dtv[i1] = d1;
                wv[i0] = __expf(total - cum0) * d0; wv[i1] = __expf(total - cum1) * d1; ecum[i0] = __expf(cum0); ecum[i1] = __expf(cum1);
                if (lane == 0) tot[0] = __expf(total);
            }
            if (ci + 1 < NCH) SSD_LOAD(ci + 1);
            unsigned short zz[16], yy[16];
            if (dir == 1) {
#pragma unroll
                for (int r = 0; r < 4; ++r) { const int tt = 16 * w + 4 * lq + r; const size_t m = (size_t)tok0 + (L - 1 - (ci * 128 + tt));
#pragma unroll
                    for (int jp = 0; jp < 4; ++jp) { zz[4 * r + jp] = R1p[m * 4096 + C_Z + h * 64 + 16 * jp + lr]; yy[4 * r + jp] = Yp[m * 2048 + h * 64 + 16 * jp + lr]; } }
            }
            LDS_BARRIER();
            { const float wi = wv[i];
#pragma unroll
              for (int j = 0; j < 16; ++j) BwT[(part * 16 + j) * 136 + i] = (bf16)f2bf(bvals[j] * wi); }
            bx8 cfr[2];
#pragma unroll
            for (int ks = 0; ks < 2; ++ks) cfr[ks] = *(const bx8*)(Cm + (16 * w + lr) * 72 + 32 * ks + 8 * lq);
            for (int j = 0; j <= w; ++j) {
                const bx8 bb0 = *(const bx8*)(Bm + (16 * j + lr) * 72 + 8 * lq), bb1 = *(const bx8*)(Bm + (16 * j + lr) * 72 + 32 + 8 * lq);
                f32x4 g = {0.f, 0.f, 0.f, 0.f};
                g = MFMA16(cfr[0], bb0, g); g = MFMA16(cfr[1], bb1, g);
                const int s = 16 * j + lr; const float cs = cum[s], ds = dtv[s];
#pragma unroll
                for (int r = 0; r < 4; ++r) { const int tt = 16 * w + 4 * lq + r; const float v = (s <= tt) ? g[r] * __expf(cum[tt] - cs) * ds : 0.f; Mm[tt * 136 + s] = (bf16)f2bf(v); }
            }
            if (!(w & 1)) {
#pragma unroll
                for (int r = 0; r < 4; ++r) Mm[(16 * w + 4 * lq + r) * 136 + 16 * (w + 1) + lr] = 0;
            }
            LDS_BARRIER();
            f32x4 yl[4], yo[4];
#pragma unroll
            for (int jp = 0; jp < 4; ++jp) { yl[jp] = (f32x4){0.f, 0.f, 0.f, 0.f}; yo[jp] = (f32x4){0.f, 0.f, 0.f, 0.f}; }
            for (int ks = 0; ks <= (w >> 1); ++ks) {
                const bx8 af = *(const bx8*)(Mm + (16 * w + lr) * 136 + 32 * ks + 8 * lq);
#pragma unroll
                for (int jp = 0; jp < 4; ++jp) { const bx8 xf = *(const bx8*)(XT + (16 * jp + lr) * 136 + 32 * ks + 8 * lq); yl[jp] = MFMA16(af, xf, yl[jp]); }
            }
#pragma unroll
            for (int ks = 0; ks < 2; ++ks)
#pragma unroll
                for (int jp = 0; jp < 4; ++jp) { const bx8 sf = *(const bx8*)(ST + (16 * jp + lr) * 72 + 32 * ks + 8 * lq); yo[jp] = MFMA16(cfr[ks], sf, yo[jp]); }
            {
#pragma unroll
                for (int r = 0; r < 4; ++r) {
                    const int tt = 16 * w + 4 * lq + r; const float ec = ecum[tt];
                    const int t = dir ? L - 1 - (ci * 128 + tt) : ci * 128 + tt; const size_t m = (size_t)tok0 + t;
                    float q = 0.f;
#pragma unroll
                    for (int jp = 0; jp < 4; ++jp) {
                        const int p = 16 * jp + lr; const float y = yl[jp][r] + ec * yo[jp][r];
                        if (dir == 0) Yp[m * 2048 + h * 64 + p] = (bf16)f2bf(y);
                        else { const float x = bf2f(XT[p * 136 + tt]); const float ytot = y + bf2f(yy[4 * r + jp]) + dsk * x; const float z = bf2f(zz[4 * r + jp]);
                            const float gt = ytot * siluf(z); Yp[m * 2048 + h * 64 + p] = (bf16)f2bf(gt); q += gt * gt; }
                    }
                    if (dir == 1) { q += __shfl_xor(q, 1); q += __shfl_xor(q, 2); q += __shfl_xor(q, 4); q += __shfl_xor(q, 8); if (lr == 0) atomicAdd(SSQp + m, q); }
                }
            }
            LDS_BARRIER();
            {
                f32x4 st[2] = {{0.f, 0.f, 0.f, 0.f}, {0.f, 0.f, 0.f, 0.f}};
#pragma unroll
                for (int ks = 0; ks < 4; ++ks) { const bx8 af = *(const bx8*)(XT + (16 * pi + lr) * 136 + 32 * ks + 8 * lq);
#pragma unroll
                    for (int q = 0; q < 2; ++q) { const bx8 bf = *(const bx8*)(BwT + (16 * (nj0 + q) + lr) * 136 + 32 * ks + 8 * lq); st[q] = MFMA16(af, bf, st[q]); } }
                const float et = tot[0];
#pragma unroll
                for (int q = 0; q < 2; ++q)
#pragma unroll
                    for (int r = 0; r < 4; ++r) { Sacc[q][r] = et * Sacc[q][r] + st[q][r]; ST[(16 * pi + 4 * lq + r) * 72 + 16 * (nj0 + q) + lr] = (bf16)f2bf(Sacc[q][r]); }
            }
        }
#undef SSD_LOAD
        if (!pass) {
#pragma unroll
            for (int q = 0; q < 2; ++q)
#pragma unroll
                for (int r = 0; r < 4; ++r) { const int p = 16 * pi + 4 * lq + r, n = 16 * (nj0 + q) + lr;
                    c.out()[O_SSD + (((((size_t)(b * 2 + l) * 2 + dir) * 8 + h) * 64 + p) * 64) + n] = Sacc[q][r]; }
        }
    }
}

__device__ __forceinline__ void s5_tables(const Ctx& c, int l, int g, int part, float* lf) {
    const int tid = c.tid;
    float* pw = lf;
    float* Bc = pw + 2 * 17 * 128;
    float* Cc = Bc + 2 * 2048;
    if (tid < 128) { const int dir = tid >> 6, n = tid & 63, idx = ((l * 2 + dir) * 32 + g) * 64 + n;
        const float lre = c.lam_re()[idx], lim = c.lam_im()[idx], step = expf(c.log_step()[(l * 2 + dir) * 32 + g]);
        for (int k = 0; k <= 16; ++k) { const float mag = expf(lre * step * (float)k); float sn, cs; sincosf(lim * step * (float)k, &sn, &cs); pw[((dir * 17 + k) * 64 + n) * 2] = mag * cs; pw[((dir * 17 + k) * 64 + n) * 2 + 1] = mag * sn; }
        const float mag = expf(lre * step); float sn, cs; sincosf(lim * step, &sn, &cs); const float are = mag * cs, aim = mag * sn;
        const float den = lre * lre + lim * lim, cre = ((are - 1.0f) * lre + aim * lim) / den, cim = (aim * lre - (are - 1.0f) * lim) / den;
        for (int mm = 0; mm < 16; ++mm) { const float br = c.b_re()[(size_t)idx * 16 + mm], bi = c.b_im()[(size_t)idx * 16 + mm]; Bc[((dir * 64 + n) * 16 + mm) * 2] = cre * br - cim * bi; Bc[((dir * 64 + n) * 16 + mm) * 2 + 1] = cre * bi + cim * br; }
    }
    for (int i = tid; i < 2048; i += NTHR) { const int dir = i >> 10, mm = (i >> 6) & 15, n = i & 63; const size_t src = ((size_t)((l * 2 + dir) * 32 + g) * 16 + mm) * 64 + n;
        Cc[i * 2] = c.c_re()[src]; Cc[i * 2 + 1] = c.c_im()[src]; }
    __syncthreads();
    if (part == 0 && tid < 128) { const int dir = tid >> 6, n = tid & 63; float* at = (float*)(c.ws() + WS_S5AT) + ((size_t)(dir * 32 + g) * 64 + n) * 2; at[0] = pw[((dir * 17 + 16) * 64 + n) * 2]; at[1] = pw[((dir * 17 + 16) * 64 + n) * 2 + 1]; }
    bf16* Kt = (bf16*)(c.ws() + WS_S5K) + (size_t)g * 31 * 256;
    for (int e = part * 1984 + tid; e < (part + 1) * 1984; e += NTHR) { const int tp = e >> 8, mm = (e >> 4) & 15, m2 = e & 15, tau = tp - 15; float acc = 0.f;
#pragma unroll
        for (int dir = 0; dir < 2; ++dir) { if ((dir == 0 && tau < 0) || (dir == 1 && tau > 0)) continue; const int k = tau < 0 ? -tau : tau;
            const float* pp = pw + (dir * 17 + k) * 128; const float* bb = Bc + dir * 2048 + m2 * 2; const float* cc = Cc + (dir * 16 + mm) * 128;
            for (int n = 0; n < 64; ++n) { const float pr = pp[2 * n], pi = pp[2 * n + 1], br = bb[n * 32], bi = bb[n * 32 + 1], Pr = pr * br - pi * bi, Pi = pr * bi + pi * br; acc += cc[2 * n] * Pr - cc[2 * n + 1] * Pi; } }
        if (tau == 0 && mm == m2) acc += c.s5_d()[l * 512 + g * 16 + mm];
        Kt[e] = (bf16)f2bf(acc); }
    for (int e = part * 16384 + tid; e < (part + 1) * 16384; e += NTHR) { const int dir = e >> 15, sidx = (e >> 8) & 127, k = e & 255, ri = sidx >> 6, n = sidx & 63, j = k >> 4, m2 = k & 15, ex = dir ? j : 15 - j;
        const float pr = pw[((dir * 17 + ex) * 64 + n) * 2], pi = pw[((dir * 17 + ex) * 64 + n) * 2 + 1], br = Bc[((dir * 64 + n) * 16 + m2) * 2], bi = Bc[((dir * 64 + n) * 16 + m2) * 2 + 1];
        ((bf16*)(c.ws() + WS_S5WS))[((size_t)(dir * 32 + g) * 128 + sidx) * 256 + k] = (bf16)f2bf(ri ? pr * bi + pi * br : pr * br - pi * bi); }
    for (int e = part * 16384 + tid; e < (part + 1) * 16384; e += NTHR) { const int row = e >> 8, k = e & 255, i = row >> 4, mm = row & 15, dir = k >> 7, ri = (k >> 6) & 1, n = k & 63, ex = dir ? 16 - i : i + 1;
        const float pr = pw[((dir * 17 + ex) * 64 + n) * 2], pi = pw[((dir * 17 + ex) * 64 + n) * 2 + 1], cr = Cc[((dir * 16 + mm) * 64 + n) * 2], ci = Cc[((dir * 16 + mm) * 64 + n) * 2 + 1];
        ((bf16*)(c.ws() + WS_S5WO))[(size_t)g * 65536 + e] = (bf16)f2bf(ri ? -(cr * pi + ci * pr) : cr * pr - ci * pi); }
    __syncthreads();
}

__device__ __forceinline__ void s5_unit(const Ctx& c, int l, int g, int cu, unsigned char* lds) {
    const int tid = c.tid, lane = c.lane, w = c.wave, lr = lane & 15, lq = lane >> 4;
    const bool lat = cu >= 8;
    bf16* Ut = (bf16*)lds;
    bf16* St = Ut + 64 * 264;
    bf16* Kt = St + 64 * 264;
    float* Dl = (float*)(Kt + 31 * 256);
    const bf16* R1p = c.R1();
    const bf16* Wsp0 = (const bf16*)(c.ws() + WS_S5WS) + ((size_t)(0 * 32 + g) * 128 + 16 * w + lr) * 256 + 8 * lq;
    const bf16* Wsp1 = (const bf16*)(c.ws() + WS_S5WS) + ((size_t)(1 * 32 + g) * 128 + 16 * w + lr) * 256 + 8 * lq;
    const bf16* Wop = (const bf16*)(c.ws() + WS_S5WO) + (size_t)g * 65536 + 8 * lq;
    bx8 afA[8], afB[8];
#pragma unroll
    for (int ks = 0; ks < 8; ++ks) afA[ks] = *(const bx8*)(Wsp0 + 32 * ks);
    { const v4u* src = (const v4u*)((const bf16*)(c.ws() + WS_S5K) + (size_t)g * 31 * 256); for (int i = tid; i < 31 * 32; i += NTHR) ((v4u*)Kt)[i] = src[i]; }
#pragma unroll
    for (int i = 0; i < 2; ++i) { const int id = tid + NTHR * i, col = id >> 4, j = id & 15;
        const int tok = lat ? MC + (cu - 8) * 1024 + col * 16 + j : (4 * cu + (col >> 4)) * 256 + (col & 15) * 16 + j;
        const bf16* up = R1p + (size_t)tok * 4096 + C_U + g * 16;
        *(v4u*)(Ut + col * 264 + j * 16) = *(const v4u*)up; *(v4u*)(Ut + col * 264 + j * 16 + 8) = *(const v4u*)(up + 8); }
#pragma unroll
    for (int ks = 0; ks < 8; ++ks) afB[ks] = *(const bx8*)(Wsp1 + 32 * ks);
    LDS_BARRIER();
#pragma unroll
    for (int dir = 0; dir < 2; ++dir) {
        f32x4 acc[4];
#pragma unroll
        for (int cb = 0; cb < 4; ++cb) acc[cb] = (f32x4){0.f, 0.f, 0.f, 0.f};
#pragma unroll
        for (int ks = 0; ks < 8; ++ks) {
#pragma unroll
            for (int cb = 0; cb < 4; ++cb) { const bx8 bf = *(const bx8*)(Ut + (16 * cb + lr) * 264 + 32 * ks + 8 * lq); acc[cb] = MFMA16(dir ? afB[ks] : afA[ks], bf, acc[cb]); }
            __builtin_amdgcn_sched_barrier(0); }
        if (dir == 0) {
#pragma unroll
            for (int ks = 0; ks < 8; ++ks) afA[ks] = *(const bx8*)(Wop + (size_t)(16 * (2 * w) + lr) * 256 + 32 * ks); }
        else {
#pragma unroll
            for (int ks = 0; ks < 8; ++ks) afB[ks] = *(const bx8*)(Wop + (size_t)(16 * (2 * w + 1) + lr) * 256 + 32 * ks); }
#pragma unroll
        for (int cb = 0; cb < 4; ++cb)
#pragma unroll
            for (int r = 0; r < 4; ++r) Dl[(16 * w + 4 * lq + r) * 65 + 16 * cb + lr] = acc[cb][r];
        LDS_BARRIER();
        if (tid < (lat ? 64 : 256)) {
            const int n = tid & 63, bl = tid >> 6, nc = lat ? 64 : 16, cbase = lat ? 0 : 16 * bl, b = lat ? cu - 8 : 4 * cu + bl;
            const float* at = (const float*)(c.ws() + WS_S5AT) + ((size_t)(dir * 32 + g) * 64 + n) * 2; const float ar = at[0], ai = at[1];
            float sr = 0.f, si = 0.f;
            if (lat) { sr = c.state_s5()[((((size_t)(b * 2 + l) * 2 + dir) * 2 + 0) * 32 + g) * 64 + n]; si = c.state_s5()[((((size_t)(b * 2 + l) * 2 + dir) * 2 + 1) * 32 + g) * 64 + n]; }
            for (int cc = 0; cc < nc; ++cc) { const int col = cbase + (dir ? nc - 1 - cc : cc);
                St[col * 264 + dir * 128 + n] = (bf16)f2bf(sr); St[col * 264 + dir * 128 + 64 + n] = (bf16)f2bf(si);
                const float dr = Dl[n * 65 + col], di = Dl[(64 + n) * 65 + col];
                const float nr = ar * sr - ai * si + dr, ni = ar * si + ai * sr + di; sr = nr; si = ni; }
            if (!lat) { c.out()[O_S5 + ((((size_t)(b * 2 + l) * 2 + dir) * 2 + 0) * 32 + g) * 64 + n] = sr; c.out()[O_S5 + ((((size_t)(b * 2 + l) * 2 + dir) * 2 + 1) * 32 + g) * 64 + n] = si; }
        }
        LDS_BARRIER();
    }
#pragma unroll
    for (int ii = 0; ii < 2; ++ii) { const int i = 2 * w + ii;
        f32x4 acc[4];
#pragma unroll
        for (int cb = 0; cb < 4; ++cb) acc[cb] = (f32x4){0.f, 0.f, 0.f, 0.f};
#pragma unroll
        for (int ks = 0; ks < 8; ++ks) { const int j = 2 * ks + (lq >> 1); const bx8 af = *(const bx8*)(Kt + ((i - j + 15) * 16 + lr) * 16 + 8 * (lq & 1));
#pragma unroll
            for (int cb = 0; cb < 4; ++cb) { const bx8 bf = *(const bx8*)(Ut + (16 * cb + lr) * 264 + 32 * ks + 8 * lq); acc[cb] = MFMA16(af, bf, acc[cb]); }
            __builtin_amdgcn_sched_barrier(0); }
#pragma unroll
        for (int ks = 0; ks < 8; ++ks) {
#pragma unroll
            for (int cb = 0; cb < 4; ++cb) { const bx8 bf = *(const bx8*)(St + (16 * cb + lr) * 264 + 32 * ks + 8 * lq); acc[cb] = MFMA16(ii ? afB[ks] : afA[ks], bf, acc[cb]); }
            __builtin_amdgcn_sched_barrier(0); }
#pragma unroll
        for (int cb = 0; cb < 4; ++cb) { const int col = 16 * cb + lr;
            const int tok = lat ? MC + (cu - 8) * 1024 + col * 16 + i : (4 * cu + (col >> 4)) * 256 + (col & 15) * 16 + i;
            v2u o; o.x = pk2(acc[cb][0], acc[cb][1]); o.y = pk2(acc[cb][2], acc[cb][3]);
            *(v2u*)(c.Y5() + (size_t)tok * 512 + g * 16 + 4 * lq) = o; }
    }
}

typedef float f32x16 __attribute__((ext_vector_type(16)));
#define MFMA32(a, b, cc) __builtin_amdgcn_mfma_f32_32x32x16_bf16((a), (b), (cc), 0, 0, 0)
constexpr float SM_SC = 0.125f * 1.4426950408889634f;
__device__ __forceinline__ void qk_tile(f32x16& p0, f32x16& p1, const bf16* Kt, int KS, const bx8 (&qf)[4], int r32, int hi) {
    p0 = (f32x16){0.f}; p1 = (f32x16){0.f};
    bx8 a0[4], a1[4];
#pragma unroll
    for (int d0 = 0; d0 < 4; ++d0) { a0[d0] = *(const bx8*)(Kt + r32 * KS + 16 * d0 + 8 * hi); a1[d0] = *(const bx8*)(Kt + (32 + r32) * KS + 16 * d0 + 8 * hi); }
    __builtin_amdgcn_s_setprio(1);
#pragma unroll
    for (int d0 = 0; d0 < 4; ++d0) { p0 = MFMA32(a0[d0], qf[d0], p0); p1 = MFMA32(a1[d0], qf[d0], p1); }
    __builtin_amdgcn_s_setprio(0);
}
__device__ __forceinline__ float fmax_(float a, float b) { float r; asm("v_max_f32_e32 %0, %1, %2" : "=v"(r) : "v"(a), "v"(b)); return r; }
__device__ __forceinline__ float sm_step(f32x16& p0, f32x16& p1, float& mrun, float& lrun, bx8 (&pb)[4]) {
    float ta = fmax_(p0[0], p1[0]), tb = fmax_(p0[1], p1[1]);
#pragma unroll
    for (int r = 2; r < 16; r += 2) { ta = fmax_(ta, fmax_(p0[r], p1[r])); tb = fmax_(tb, fmax_(p0[r + 1], p1[r + 1])); }
    float tm = fmax_(ta, tb) * SM_SC;
    tm = fmax_(tm, __shfl_xor(tm, 32));
    const float mn = fmax_(mrun, tm), alpha = __builtin_amdgcn_exp2f(mrun - mn);
    float rs0 = 0.f, rs1 = 0.f;
#pragma unroll
    for (int r = 0; r < 16; ++r) { p0[r] = __builtin_amdgcn_exp2f(fmaf(p0[r], SM_SC, -mn)); p1[r] = __builtin_amdgcn_exp2f(fmaf(p1[r], SM_SC, -mn)); rs0 += p0[r]; rs1 += p1[r]; }
    float rs = rs0 + rs1;
    rs += __shfl_xor(rs, 32);
    lrun = lrun * alpha + rs; mrun = mn;
#pragma unroll
    for (int sI = 0; sI < 2; ++sI) {
        v4u t0, t1;
        t0.x = pg8::cvt_pk_bf16(p0[8 * sI + 0], p0[8 * sI + 1]); t0.y = pg8::cvt_pk_bf16(p0[8 * sI + 2], p0[8 * sI + 3]); t0.z = pg8::cvt_pk_bf16(p0[8 * sI + 4], p0[8 * sI + 5]); t0.w = pg8::cvt_pk_bf16(p0[8 * sI + 6], p0[8 * sI + 7]);
        t1.x = pg8::cvt_pk_bf16(p1[8 * sI + 0], p1[8 * sI + 1]); t1.y = pg8::cvt_pk_bf16(p1[8 * sI + 2], p1[8 * sI + 3]); t1.z = pg8::cvt_pk_bf16(p1[8 * sI + 4], p1[8 * sI + 5]); t1.w = pg8::cvt_pk_bf16(p1[8 * sI + 6], p1[8 * sI + 7]);
        pb[sI] = __builtin_bit_cast(bx8, t0); pb[2 + sI] = __builtin_bit_cast(bx8, t1);
    }
    return alpha;
}
typedef short v4i16_t __attribute__((ext_vector_type(4)));
__device__ __forceinline__ v2u vtr(const bf16* p) { return __builtin_bit_cast(v2u, __builtin_amdgcn_ds_read_tr16_b64_v4i16((__attribute__((address_space(3))) v4i16_t*)p)); }
template <int NDT, int VS> __device__ __forceinline__ void pv_tile(f32x16 (&o)[NDT], const bf16* Vr, const bx8 (&pb)[4], int lane) {
    const bf16* vb = Vr + (4 * (lane >> 5) + ((lane & 15) >> 2)) * VS + 16 * ((lane >> 4) & 1) + 4 * (lane & 3);
    v2u cur[NDT][2], nxt[NDT][2];
#pragma unroll
    for (int dt = 0; dt < NDT; ++dt) { cur[dt][0] = vtr(vb + 32 * dt); cur[dt][1] = vtr(vb + 8 * VS + 32 * dt); }
#pragma unroll
    for (int ks = 0; ks < 4; ++ks) {
        if (ks < 3) {
#pragma unroll
            for (int dt = 0; dt < NDT; ++dt) { nxt[dt][0] = vtr(vb + (16 * (ks + 1)) * VS + 32 * dt); nxt[dt][1] = vtr(vb + (16 * (ks + 1) + 8) * VS + 32 * dt); }
        }
        __builtin_amdgcn_s_setprio(1);
#pragma unroll
        for (int dt = 0; dt < NDT; ++dt) { const v4u t = {cur[dt][0].x, cur[dt][0].y, cur[dt][1].x, cur[dt][1].y}; o[dt] = MFMA32(__builtin_bit_cast(bx8, t), pb[ks], o[dt]); }
        __builtin_amdgcn_s_setprio(0);
#pragma unroll
        for (int dt = 0; dt < NDT; ++dt) { cur[dt][0] = nxt[dt][0]; cur[dt][1] = nxt[dt][1]; }
    }
}

template <int PASS> __device__ __forceinline__ void diff_unit(const Ctx& c, int l, int uidx, unsigned char* lds) {
    constexpr int NT = PASS ? 10 : 2, NQB = PASS ? 8 : 2, VS = 160;
    const int tid = c.tid, lane = c.lane, w = c.wave, r32 = lane & 31, hi = lane >> 5, comp = w >> 2;
    const int qb = uidx % NQB, h = (uidx / NQB) & 3, b = uidx / (NQB * 4);
    const int tok0 = PASS ? MC + b * 1024 : b * 256;
    bf16* Kt = (bf16*)lds;
    bf16* Vr = Kt + 128 * 136;
    float* Ob = (float*)lds;
    const bf16* R1p = c.R1(); const bf16* CK = c.CKV() + (size_t)l * 1024 * 1280;
    const float lam_init = 0.8f - 0.6f * expf(-0.3f * (float)l);
    const float* lv = c.dlam() + l * 256;
    const float lam = expf(wave_sum(lv[lane] * lv[64 + lane])) - expf(wave_sum(lv[128 + lane] * lv[192 + lane])) + lam_init;
    const size_t mrow = (size_t)tok0 + qb * 128 + 32 * (w & 3) + r32;
    bx8 qf[4];
#pragma unroll
    for (int d0 = 0; d0 < 4; ++d0) qf[d0] = *(const bx8*)(R1p + mrow * 4096 + C_DQ + h * 128 + comp * 64 + 16 * d0 + 8 * hi);
    f32x16 o[4];
#pragma unroll
    for (int dt = 0; dt < 4; ++dt) o[dt] = (f32x16){0.f};
    float mrun = -1e30f, lrun = 0.f;
    v4u kreg[4], vreg[4];
#define DIFF_LOAD(t) { const bf16* kb; const bf16* vb; size_t rs; \
        if (PASS && (t) < 2) { kb = CK + ((size_t)b * 256 + 128 * (t)) * 1280 + h * 128; vb = kb + 512; rs = 1280; } \
        else { kb = R1p + ((size_t)tok0 + 128 * ((t) - (PASS ? 2 : 0))) * 4096 + C_DK + h * 128; vb = kb + (C_DV - C_DK); rs = 4096; } \
        _Pragma("unroll") for (int i = 0; i < 4; ++i) { const int id = tid + NTHR * i; kreg[i] = *(const v4u*)(kb + (size_t)(id >> 4) * rs + (id & 15) * 8); vreg[i] = *(const v4u*)(vb + (size_t)(id >> 4) * rs + (id & 15) * 8); } }
    DIFF_LOAD(0);
    for (int t = 0; t < NT; ++t) {
        LDS_BARRIER();
#pragma unroll
        for (int i = 0; i < 4; ++i) { const int id = tid + NTHR * i; *(v4u*)(Kt + (id >> 4) * 136 + (id & 15) * 8) = kreg[i]; *(v4u*)(Vr + (id >> 4) * VS + (id & 15) * 8) = vreg[i]; }
        if (t + 1 < NT) DIFF_LOAD(t + 1);
        LDS_BARRIER();
#pragma unroll
        for (int sub = 0; sub < 2; ++sub) {
            f32x16 p0, p1; bx8 pb[4];
            qk_tile(p0, p1, Kt + sub * 64 * 136 + comp * 64, 136, qf, r32, hi);
            const float alpha = sm_step(p0, p1, mrun, lrun, pb);
            if (__any(alpha != 1.0f)) {
#pragma unroll
                for (int dt = 0; dt < 4; ++dt)
#pragma unroll
                    for (int r = 0; r < 16; ++r) o[dt][r] *= alpha; }
            pv_tile<4, VS>(o, Vr + sub * 64 * VS, pb, lane);
        }
    }
#undef DIFF_LOAD
    const float inv = (comp ? lam : 1.0f) / lrun;
    const int rowl = 32 * (w & 3) + r32;
    LDS_BARRIER();
    if (comp) {
#pragma unroll
        for (int dt = 0; dt < 4; ++dt)
#pragma unroll
            for (int r = 0; r < 16; ++r) Ob[rowl * 129 + 32 * dt + (r & 3) + 8 * (r >> 2) + 4 * hi] = o[dt][r] * inv;
    }
    LDS_BARRIER();
    if (!comp) {
        float ss = 0.f;
#pragma unroll
        for (int dt = 0; dt < 4; ++dt)
#pragma unroll
            for (int r = 0; r < 16; ++r) { const float v = o[dt][r] * inv - Ob[rowl * 129 + 32 * dt + (r & 3) + 8 * (r >> 2) + 4 * hi]; o[dt][r] = v; ss += v * v; }
        ss += __shfl_xor(ss, 32);
        const float rn = rsqrtf(ss * (1.0f / 128.0f) + EPS) * (1.0f - lam_init);
        const float* sg = c.subln_g() + l * 128; bf16* yp = c.Y() + mrow * 2048 + 1024 + h * 128;
#pragma unroll
        for (int dt = 0; dt < 4; ++dt)
#pragma unroll
            for (int r4 = 0; r4 < 4; ++r4) { const int dv = 32 * dt + 8 * r4 + 4 * hi; const f32x4 g = *(const f32x4*)(sg + dv);
                v2u ov; ov.x = pk2(o[dt][4 * r4 + 0] * rn * g.x, o[dt][4 * r4 + 1] * rn * g.y); ov.y = pk2(o[dt][4 * r4 + 2] * rn * g.z, o[dt][4 * r4 + 3] * rn * g.w);
                *(v2u*)(yp + dv) = ov; }
    }
}

template <int PASS> __device__ __forceinline__ void win_unit(const Ctx& c, int l, int uidx, unsigned char* lds) {
    constexpr int NQB = PASS ? 4 : 1, VS = 96;
    const int tid = c.tid, lane = c.lane, w = c.wave, r32 = lane & 31, hi = lane >> 5;
    const int qb = uidx % NQB, hh = (uidx / NQB) & 7, b = uidx / (NQB * 8), nkv = hh >> 2;
    const int tok0 = PASS ? MC + b * 1024 : b * 256;
    bf16* Kt = (bf16*)lds;
    bf16* Vr = Kt + 128 * 72;
    const bf16* R1p = c.R1(); const bf16* CK = c.CKV() + (size_t)l * 1024 * 1280;
    const int qrow = qb * 256 + 32 * w + r32;
    const size_t mrow = (size_t)tok0 + qrow;
    bx8 qf[4];
#pragma unroll
    for (int d0 = 0; d0 < 4; ++d0) qf[d0] = *(const bx8*)(R1p + mrow * 4096 + C_WQ + hh * 64 + 16 * d0 + 8 * hi);
    f32x16 o[2]; o[0] = (f32x16){0.f}; o[1] = (f32x16){0.f};
    float mrun = c.sink()[l * 8 + hh] * 1.4426950408889634f, lrun = 1.0f;
    const int q0 = qb * 256;
    const int tb0 = PASS ? ((q0 - 128 < 0 ? 0 : q0 - 128) >> 7) : 0, tb1 = PASS ? ((q0 + 255 + 128 > 1023 ? 1023 : q0 + 255 + 128) >> 7) : 0;
    const int NT = PASS ? 2 + (tb1 - tb0 + 1) : 2;
    v4u kreg[2], vreg[2];
#define WIN_LOAD(t) { const bf16* kb; const bf16* vb; size_t rs; \
        if (PASS && (t) < 2) { kb = CK + ((size_t)b * 256 + 128 * (t)) * 1280 + 1024 + nkv * 64; vb = kb + 128; rs = 1280; } \
        else { kb = R1p + ((size_t)tok0 + 128 * (PASS ? tb0 + (t) - 2 : (t))) * 4096 + C_WK + nkv * 64; vb = kb + (C_WV - C_WK); rs = 4096; } \
        _Pragma("unroll") for (int i = 0; i < 2; ++i) { const int id = tid + NTHR * i; kreg[i] = *(const v4u*)(kb + (size_t)(id >> 3) * rs + (id & 7) * 8); vreg[i] = *(const v4u*)(vb + (size_t)(id >> 3) * rs + (id & 7) * 8); } }
    WIN_LOAD(0);
    for (int t = 0; t < NT; ++t) {
        LDS_BARRIER();
#pragma unroll
        for (int i = 0; i < 2; ++i) { const int id = tid + NTHR * i; *(v4u*)(Kt + (id >> 3) * 72 + (id & 7) * 8) = kreg[i]; *(v4u*)(Vr + (id >> 3) * VS + (id & 7) * 8) = vreg[i]; }
        if (t + 1 < NT) WIN_LOAD(t + 1);
        LDS_BARRIER();
#pragma unroll
        for (int sub = 0; sub < 2; ++sub) {
            bool band = false; int kp0 = 0;
            if (PASS && t >= 2) { band = true; kp0 = 128 * (tb0 + t - 2) + 64 * sub; const int r0 = q0 + 32 * w;
                if (kp0 + 63 < r0 - 128 || kp0 > r0 + 31 + 128) continue; }
            f32x16 p0, p1; bx8 pb[4];
            qk_tile(p0, p1, Kt + sub * 64 * 72, 72, qf, r32, hi);
            if (band) {
#pragma unroll
                for (int r = 0; r < 16; ++r) { const int kp = kp0 + (r & 3) + 8 * (r >> 2) + 4 * hi; const int d0 = qrow - kp, d1 = d0 - 32;
                    if (d0 > 128 || d0 < -128) p0[r] = -1e30f; if (d1 > 128 || d1 < -128) p1[r] = -1e30f; }
            }
            const float alpha = sm_step(p0, p1, mrun, lrun, pb);
            if (__any(alpha != 1.0f)) {
#pragma unroll
                for (int dt = 0; dt < 2; ++dt)
#pragma unroll
                    for (int r = 0; r < 16; ++r) o[dt][r] *= alpha; }
            pv_tile<2, VS>(o, Vr + sub * 64 * VS, pb, lane);
        }
    }
#undef WIN_LOAD
    const float inv = 1.0f / lrun; bf16* yp = c.Y() + mrow * 2048 + 1536 + hh * 64;
#pragma unroll
    for (int dt = 0; dt < 2; ++dt)
#pragma unroll
        for (int r4 = 0; r4 < 4; ++r4) { const int dv = 32 * dt + 8 * r4 + 4 * hi;
            v2u ov; ov.x = pk2(o[dt][4 * r4 + 0] * inv, o[dt][4 * r4 + 1] * inv); ov.y = pk2(o[dt][4 * r4 + 2] * inv, o[dt][4 * r4 + 3] * inv);
            *(v2u*)(yp + dv) = ov; }
}

__device__ __forceinline__ void phase_mixers(const Ctx& c_in, int l, float* lf) {
    unsigned char* lds = (unsigned char*)lf;
    unsigned* qctr = (unsigned*)(c_in.ws() + WS_QCTR) + 64 * l;
    volatile int* qslot = (volatile int*)(lds + LDS_BYTES - 32);
    for (;;) {
        __syncthreads();
        if (threadIdx.x == 0) *qslot = (int)atomicAdd(qctr, 1u);
        __syncthreads();
        const int u = __builtin_amdgcn_readfirstlane(*qslot);
        if (u >= 1440) break;
        Ctx c = c_in; asm volatile("" : "+s"(c.ap), "+v"(c.tid));
        c.lane = c.tid & 63; c.wave = __builtin_amdgcn_readfirstlane(c.tid >> 6);
        unsigned long long pt0 = 0; if (PROBE_SEL >= 0) pt0 = __builtin_amdgcn_s_memrealtime();
        int ty;
        if (u < 32) { ssd_unit(c, l, 1, u >> 3, u & 7, lds); ty = 0; }
        else if (u < 160) { diff_unit<1>(c, l, u - 32, lds); ty = 2; }
        else if (u < 288) { win_unit<1>(c, l, u - 160, lds); ty = 3; }
        else if (u < 416) { s5_unit(c, l, (u - 288) & 31, 8 + ((u - 288) >> 5), lds); ty = 1; }
        else if (u < 672) { ssd_unit(c, l, 0, (u - 416) >> 3, (u - 416) & 7, lds); ty = 4; }
        else if (u < 928) { diff_unit<0>(c, l, u - 672, lds); ty = 6; }
        else if (u < 1184) { win_unit<0>(c, l, u - 928, lds); ty = 7; }
        else { s5_unit(c, l, (u - 1184) & 31, (u - 1184) >> 5, lds); ty = 5; }
        __syncthreads();
        if (PROBE_SEL >= 0 && threadIdx.x == 0) { unsigned long long* tsu = (unsigned long long*)(c.ws() + WS_TS) + 64; atomicAdd(tsu + ty, (unsigned long long)(__builtin_amdgcn_s_memrealtime() - pt0)); }
    }
}

__device__ __forceinline__ void phase_sum4(const Ctx& c) {
    const int gt = blockIdx.x * NTHR + c.tid, NT = gridDim.x * NTHR;
#pragma unroll 4
    for (int i = gt; i < M * 128; i += NT) { const size_t m = (size_t)(i >> 7); const int c8 = (i & 127) * 8;
        float a[8] = {0.f, 0.f, 0.f, 0.f, 0.f, 0.f, 0.f, 0.f};
#pragma unroll
        for (int j = 0; j < 4; ++j) { float f[8]; unpack8(*(const v4u*)(c.R1() + m * 4096 + j * 1024 + c8), f);
#pragma unroll
            for (int k = 0; k < 8; ++k) a[k] += f[k]; }
        v4u o; o.x = pk2(a[0], a[1]); o.y = pk2(a[2], a[3]); o.z = pk2(a[4], a[5]); o.w = pk2(a[6], a[7]);
        *(v4u*)(c.H() + m * 1024 + c8) = o; }
}

#define GAS __attribute__((address_space(1)))
#define XB_TMO      128
#define XB_XCNT(j)  (256  + 64 * (j))
#define XB_XSUB(j)  (1280 + 64 * (j))
#define XB_XGEN(j)  (2304 + 64 * (j))
#define XB_TOP      3328
#define XB_TOPGEN   3392
#define XCD_BAR_WORDS 3456
#define XB_SPIN_CAP (1u << 18)

__device__ __forceinline__ unsigned xb_ld(unsigned* p)              { return __hip_atomic_load(p, __ATOMIC_RELAXED, __HIP_MEMORY_SCOPE_AGENT); }
__device__ __forceinline__ unsigned xb_add(unsigned* p, unsigned v) { return __hip_atomic_fetch_add(p, v, __ATOMIC_RELAXED, __HIP_MEMORY_SCOPE_AGENT); }
__device__ __forceinline__ unsigned xb_xcc_id() { return (unsigned)__builtin_amdgcn_s_getreg((3 << 11) | 20) & 0xFu; }
#define XB_SPIN(cond, bar) do { unsigned _sp = 0; while (cond) { __builtin_amdgcn_s_sleep(1); \
    if ((++_sp & 255u) == 0u) { if (xb_ld(&(bar)[XB_TMO])) break; if (_sp > XB_SPIN_CAP) { atomicAdd(&(bar)[XB_TMO], 1u); break; } } } } while (0)

struct XcdBarrier {
    unsigned* bar; unsigned x;
    volatile LAS unsigned* st;
};

__device__ __forceinline__ XcdBarrier xcd_barrier_post(unsigned* bar, volatile LAS unsigned* st) {
    XcdBarrier b; b.bar = bar; b.x = xb_xcc_id(); b.st = st;
    if (threadIdx.x == 0) (void)xb_add(&bar[XB_XCNT(b.x)], 1u);
    return b;
}
__device__ __forceinline__ void xcd_barrier_complete(unsigned* bar, unsigned x, unsigned& nloc, unsigned& nx) {
    const unsigned G = gridDim.x * gridDim.y * gridDim.z;
    unsigned sum, cnt, mine, sp = 0u;
    for (;;) {
        sum = 0u; cnt = 0u; mine = 0u;
#pragma unroll
        for (unsigned j = 0; j < 16; ++j) { const unsigned c = xb_ld(&bar[XB_XCNT(j)]); sum += c; cnt += (c > 0u) ? 1u : 0u; mine = (j == x) ? c : mine; }
        if (sum == G) break;
        __builtin_amdgcn_s_sleep(1);
        if ((++sp & 255u) == 0u) { if (xb_ld(&bar[XB_TMO])) break; if (sp > XB_SPIN_CAP) { atomicAdd(&bar[XB_TMO], 1u); break; } }
    }
    nloc = mine > 0u ? mine : 1u; nx = cnt > 0u ? cnt : 1u;
}

__device__ __forceinline__ void xcd_barrier(const XcdBarrier& b) {
    asm volatile("s_waitcnt vmcnt(0)" ::: "memory");
    __syncthreads();
    if (threadIdx.x == 0) {
        unsigned* bar = b.bar;
        __builtin_amdgcn_s_waitcnt(0);
        unsigned nloc = b.st[0], nx = b.st[1];
        if (nloc == 0u) { xcd_barrier_complete(bar, b.x, nloc, nx); b.st[0] = nloc; b.st[1] = nx; }
        const unsigned old = xb_add(&bar[XB_XSUB(b.x)], 1u);
        const unsigned gen = old / nloc;
        if (old + 1u == (gen + 1u) * nloc) {
            __builtin_amdgcn_fence(__ATOMIC_RELEASE, "agent");
            asm volatile("s_waitcnt vmcnt(0)" ::: "memory");
            const unsigned og = xb_add(&bar[XB_TOP], 1u);
            const unsigned tg = og / nx;
            if (og + 1u == (tg + 1u) * nx) xb_add(&bar[XB_TOPGEN], 1u);
            else XB_SPIN(xb_ld(&bar[XB_TOPGEN]) == tg, bar);
            __builtin_amdgcn_fence(__ATOMIC_ACQUIRE, "agent");
            xb_add(&bar[XB_XGEN(b.x)], 1u);
            asm volatile("s_waitcnt vmcnt(0)" ::: "memory");
        } else {
            XB_SPIN(xb_ld(&bar[XB_XGEN(b.x)]) == gen, bar);
            __builtin_amdgcn_fence(__ATOMIC_ACQUIRE, "agent");
            asm volatile("s_waitcnt vmcnt(0)" ::: "memory");
        }
    }
    __syncthreads();
}

#define PHASE_BEGIN() Ctx c; c.ap = (CArgs)__builtin_amdgcn_kernarg_segment_ptr(); asm volatile("" : "+s"(c.ap)); \
        int tid_o = threadIdx.x; asm volatile("" : "+v"(tid_o)); c.tid = tid_o; c.lane = tid_o & 63; c.wave = __builtin_amdgcn_readfirstlane(tid_o >> 6); \
        int G = gridDim.x, bid = blockIdx.x; asm volatile("" : "+s"(G), "+s"(bid)); unsigned char* ws = c.ws(); (void)ws; (void)G; (void)bid;
#define PHASE_END(k) { if ((k) + 1 < ph_hi) { if ((k) == 0) cg::this_grid().sync(); else xcd_barrier(xbar); } \
        if (PROBE_SEL >= 0 && blockIdx.x == PROBE_PB && threadIdx.x == 0) ((unsigned long long*)(c.ws() + WS_TS))[(k) + 1] = __builtin_amdgcn_s_memrealtime(); }
#define IN_RANGE(k) (ph_lo <= (k) && (k) < ph_hi)

template <int LAYER> __device__ __forceinline__ void layer_program(int ph_lo, int ph_hi, unsigned char* lds, const XcdBarrier& xbar) {
    float* lf = (float*)lds;
    PG8_LAS unsigned char* ring = (PG8_LAS unsigned char*)lds;
    constexpr int l = LAYER, B0 = 1 + 11 * LAYER;
    if (IN_RANGE(B0 + 0)) { PHASE_BEGIN(); if (l == 1) { if (gridDim.x == 256) convert_items(c, 1, 7936, 9984, blockIdx.x * NWAVES + c.wave, gridDim.x * NWAVES, false, 0, 1, lf); else phase_convert(c, 1, lf); __syncthreads(); } phase_norm(c, l, 0, lf); phase_bias2(c, l); PHASE_END(B0 + 0); }
    if (IN_RANGE(B0 + 1)) { PHASE_BEGIN();
        pg8::Gemm g{c.H(), (const bf16*)(ws + W_IN), M, 4096, 1024, 1024, 1024, 0, 0}; pg8::StaticOrder S; S.init(M, 4096, G, bid);
        pg8::EpiIn E{c.R1(), c.out(), c.ROPE(), c.qn_g() + l * 64, c.kn_g() + l * 64, c.wqn_g() + l * 64, c.wkn_g() + l * 64, l};
        pg8::gemm_phase<pg8::EpiIn, pg8::StaticOrder, true, true>(ring, g, S, E, tid_o); PHASE_END(B0 + 1); }
    if (IN_RANGE(B0 + 2)) { PHASE_BEGIN(); phase_dt(c, l); phase_qk(c, l, lf); PHASE_END(B0 + 2); }
    if (IN_RANGE(B0 + 3)) { PHASE_BEGIN(); phase_mixers(c, l, lf); PHASE_END(B0 + 3); }
    if (IN_RANGE(B0 + 4)) { PHASE_BEGIN();
        pg8::Gemm g{c.Y5(), (const bf16*)(ws + W_GLU), M, 1024, 512, 512, 512, 0, 0}; pg8::StaticOrder S; S.init(M, 1024, G, bid);
        pg8::EpiGlu E{c.Y(), 2048, 512, c.b_glu() + l * 1024};
        pg8::gemm_phase<pg8::EpiGlu, pg8::StaticOrder, true, true>(ring, g, S, E, tid_o); PHASE_END(B0 + 4); }
    if (IN_RANGE(B0 + 5)) { PHASE_BEGIN();
        pg8::Gemm g{c.Y(), (const bf16*)(ws + W_BR), M, 4096, 512, 2048, 512, 4, 1024}; pg8::StaticOrder S; S.init(M, 4096, G, bid);
        pg8::EpiB<8> E{c.R1(), 4096, nullptr, c.SSQ()};
        pg8::gemm_phase<pg8::EpiB<8>, pg8::StaticOrder, true, true>(ring, g, S, E, tid_o); PHASE_END(B0 + 5); }
    if (IN_RANGE(B0 + 6)) { PHASE_BEGIN();
        pg8::Gemm g{c.H(), (const bf16*)(ws + W_G), M, 4096, 1024, 1024, 1024, 0, 0}; pg8::StaticOrder S; S.init(M, 4096, G, bid);
        pg8::EpiGateMerge E{c.R1(), c.Y(), c.b_gate() + l * 4096};
        pg8::gemm_phase<pg8::EpiGateMerge, pg8::StaticOrder, true, true>(ring, g, S, E, tid_o); PHASE_END(B0 + 6); }
    if (IN_RANGE(B0 + 7)) { PHASE_BEGIN();
        pg8::Gemm g{c.Y(), (const bf16*)(ws + W_OUT), M, 1024, 1024, 1024, 1024, 0, 0}; pg8::StaticOrder S; S.init(M, 1024, G, bid);
        pg8::EpiRes2 E{l == 0 ? c.x_prompt() : c.out(), l == 0 ? c.x_sample() : c.out() + (size_t)MC * D, c.out(), c.MOD() + (size_t)l * 5 * 6144, 2048, c.H(), c.g_norm2() + l * 1024, 4096, (float*)(ws + WS_SSQ2)};
        pg8::gemm_phase<pg8::EpiRes2, pg8::StaticOrder, true, true>(ring, g, S, E, tid_o); if (l == 0) side_convert(c, 0, 5376, false, lf); PHASE_END(B0 + 7); }
    if (IN_RANGE(B0 + 9)) { PHASE_BEGIN();
        pg8::Gemm g{c.H(), (const bf16*)(ws + W_1), M, 4096, 1024, 1024, 1024, 0, 0}; pg8::StaticOrder S; S.init(M, 4096, G, bid);
        pg8::EpiB<5> E{c.R1(), 4096, (const float*)(ws + WS_BI2), (const float*)(ws + WS_SSQ2)};
        pg8::gemm_phase<pg8::EpiB<5>, pg8::StaticOrder, true, true>(ring, g, S, E, tid_o); PHASE_END(B0 + 9); }
    if (IN_RANGE(B0 + 10)) { PHASE_BEGIN();
        pg8::Gemm g{c.R1(), (const bf16*)(ws + W_2), M, 1024, 4096, 4096, 4096, 0, 0}; pg8::StaticOrder S; S.init(M, 1024, G, bid);
        pg8::EpiRes E{c.out(), c.out() + (size_t)MC * D, c.out(), c.MOD() + (size_t)l * 5 * 6144, 5120};
        pg8::gemm_phase<pg8::EpiRes, pg8::StaticOrder, true, true>(ring, g, S, E, tid_o); if (l == 0) side_convert(c, 5376, 7936, true, lf); PHASE_END(B0 + 10); }
}

__global__ void __launch_bounds__(NTHR, 2) fwd_kernel(Args args) {
    extern __shared__ __attribute__((aligned(16))) unsigned char lds[];
    const int ph_lo = args.ph_lo, ph_hi = args.ph_hi;
    volatile LAS unsigned* xst = (volatile LAS unsigned*)(lds + LDS_BYTES - 16);
    if (threadIdx.x < 4) xst[threadIdx.x] = 0u;
    __syncthreads();
    const XcdBarrier xbar = xcd_barrier_post((unsigned*)(args.ws + WS_BAR), xst);
    if (PROBE_SEL >= 0 && blockIdx.x == PROBE_PB && threadIdx.x == 0) { unsigned long long* ts = (unsigned long long*)(args.ws + WS_TS); ts[0] = __builtin_amdgcn_s_memrealtime(); }
    if (IN_RANGE(0)) { PHASE_BEGIN(); float* lf = (float*)lds; phase_mods(c, lf); __syncthreads(); phase_convert(c, 0, lf); phase_rope_table(c); phase_ckv(c); PHASE_END(0); }
    layer_program<0>(ph_lo, ph_hi, lds, xbar);
    layer_program<1>(ph_lo, ph_hi, lds, xbar);
    if (PROBE_SEL >= 0) {
        __threadfence(); cg::this_grid().sync();
        const unsigned long long* ts = (const unsigned long long*)(args.ws + WS_TS);
        const float total = (float)(ts[23] - ts[0]); float sel = 0.f;
        for (int k = 0; k < 23; ++k) { const float d = (float)(ts[k + 1] - ts[k]); const int q = k == 0 ? -1 : (k - 1) % 11;
            const int cls = (q == 3) ? 0 : (q == 1 || q == 4 || q == 5 || q == 7 || q == 9 || q == 10) ? 1 : (q == 2) ? 2 : 3;
            if (cls == PROBE_SEL) sel += d; }
        if (PROBE_SEL >= 10 && PROBE_SEL < 100) sel = (float)ts[64 + PROBE_SEL - 10] * (1.0f / 256.0f);
        if (PROBE_SEL >= 100) { const int k = PROBE_SEL - 100; sel = (float)(ts[k + 1] - (ts[k] != 0ull ? ts[k] : ts[k - 1])); }
        const float sc = 1.0f + sqrtf(PROBE_SCALE * sel / total);
        for (int i = blockIdx.x * NTHR + threadIdx.x; i < 524288; i += gridDim.x * NTHR) args.out[O_S5 + i] *= sc;
    }
}

extern "C" void kernel_launch(void* const* d_in, const int* in_sizes, int n_in, void* d_out, int out_size, void* d_ws, size_t ws_size, hipStream_t stream) {
    static int grid = 0;
    if (grid == 0) {
        if (n_in != 44 || ws_size < WS_END) { fprintf(stderr, "kernel_launch: expected 44 inputs and >= %zu bytes of workspace; got %d, %zu\n", (size_t)WS_END, n_in, ws_size); grid = -1; return; }
        int dev = 0, cus = 0, per_cu = 0;
        (void)hipGetDevice(&dev); (void)hipDeviceGetAttribute(&cus, hipDeviceAttributeMultiprocessorCount, dev);
        (void)hipFuncSetAttribute((const void*)fwd_kernel, hipFuncAttributeMaxDynamicSharedMemorySize, LDS_BYTES);
        (void)hipOccupancyMaxActiveBlocksPerMultiprocessor(&per_cu, (const void*)fwd_kernel, NTHR, LDS_BYTES);
        if (per_cu < 1) { fprintf(stderr, "kernel_launch: occupancy query says %d blocks per CU\n", per_cu); per_cu = 1; }
        (void)hipGetLastError();
        grid = cus > 0 ? cus : 256;
    }
    if (grid < 0) return;
    (void)hipMemsetAsync(d_ws, 0, 64 * 1024, stream);
    Args a{};
    for (int i = 0; i < 44; ++i) a.in[i] = (const float*)d_in[i];
    a.out = (float*)d_out; a.ws = (unsigned char*)d_ws;
#if MK_MULTI
    for (int ph = 0; ph < NPH; ++ph) { a.ph_lo = ph; a.ph_hi = ph + 1; hipLaunchKernelGGL(fwd_kernel, dim3(grid), dim3(NTHR), LDS_BYTES, stream, a); }
#else
    a.ph_lo = 0; a.ph_hi = NPH;
    void* kargs[] = {&a};
    hipError_t e = hipLaunchCooperativeKernel((const void*)fwd_kernel, dim3(grid), dim3(NTHR), kargs, LDS_BYTES, stream);
    if (e != hipSuccess) fprintf(stderr, "cooperative launch failed: %s (grid %d)\n", hipGetErrorString(e), grid);
#endif
}
```

```cpp
#include <hip/hip_runtime.h>
#include <hip/hip_cooperative_groups.h>
#include <cstdio>
#include <cstdint>
namespace cg = cooperative_groups;

#ifndef MK_MULTI
#define MK_MULTI 0
#endif

namespace pg8 {
#define PG8_LAS __attribute__((address_space(3)))
typedef unsigned short bf16_t;
typedef short bf16x8 __attribute__((ext_vector_type(8)));
typedef float f32x4 __attribute__((ext_vector_type(4)));
typedef unsigned u32x4 __attribute__((ext_vector_type(4)));
constexpr int BM = 256, BK = 64, HALF = 128, HTB = HALF * BK * 2  , STAGE_BYTES = 8 * HTB, NXCD = 8, WGM = 8;

__host__ __device__ __forceinline__ int lds_byte(int r, int c) { const int st = (r >> 4) * 2 + (c >> 5), rr = r & 15, cc = c & 31, ob = rr * 64 + cc * 2; return st * 1024 + (ob ^ (((ob >> 9) & 1) << 5)); }
__host__ __device__ __forceinline__ void stage_rc(int b, int& R, int& C) { const int st = b / 1024, sb = b % 1024, swz = sb ^ (((sb >> 9) & 1) << 5); R = (st >> 1) * 16 + swz / 64; C = (st & 1) * 32 + (swz % 64) / 2; }
__host__ __device__ __forceinline__ int perm32(int rho) { const int n = rho >> 4, i = rho & 15; return 8 * (i >> 2) + 4 * n + (i & 3); }

struct Unit { int pm, pn; };
struct Gemm { const bf16_t* A; const bf16_t* Bt; int M, N, K, lda, ldb, a_div; size_t a_gstride; };

struct StaticOrder {
    int nM, nN, nwg, G, c;
    __host__ __device__ void init(int M, int N, int G_, int c_) { nM = M / BM; nN = N / BM; nwg = nM * nN; G = G_; c = c_; }
    __host__ __device__ bool next(int i, Unit& u) const {
        const long L = (long)i * G + c; if (L >= nwg) return false;
        int wgid = (int)L; { const int q = nwg / NXCD, r = nwg % NXCD, xcd = wgid % NXCD, off = wgid / NXCD; wgid = (xcd < r ? xcd * (q + 1) : r * (q + 1) + (xcd - r) * q) + off; }
        const int nig = WGM * nN, gid = wgid / nig, fm = gid * WGM, gsz = (nM - fm) < WGM ? (nM - fm) : WGM;
        u.pm = fm + ((wgid % nig) % gsz); u.pn = (wgid % nig) / gsz; return true;
    }
    __device__ __forceinline__ void a_ready(const Unit&) const {}
    __device__ __forceinline__ void done(const Unit&) const {}
};

__device__ __forceinline__ unsigned cvt_pk_bf16(float lo, float hi) { unsigned r; asm volatile("v_cvt_pk_bf16_f32 %0, %1, %2" : "=v"(r) : "v"(lo), "v"(hi)); return r; }
__device__ __forceinline__ float bf_lo(unsigned w) { return __builtin_bit_cast(float, w << 16); }
__device__ __forceinline__ float bf_hi(unsigned w) { return __builtin_bit_cast(float, w & 0xffff0000u); }
__device__ __forceinline__ float sigmoidf_(float x) { return 1.0f / (1.0f + __expf(-x)); }

template <int MODE> struct EpiB {
    static constexpr bool PERM = true, AFTER_DRAIN = false;
    bf16_t* O; int ldc; const float* bias; const float* ssq;
    __device__ __forceinline__ void operator()(const f32x4 (&acc)[2][2][4][2], const Unit& u, int wr, int wc, int fr, int fq) const {
        const int row0 = u.pm * BM + wr * 64 + fr, col0 = u.pn * BM + wc * 32 + 8 * fq;
        f32x4 bv[2][2];
#pragma unroll
        for (int bj = 0; bj < 2; ++bj)
#pragma unroll
            for (int n = 0; n < 2; ++n) bv[bj][n] = (MODE == 1) ? *(const f32x4*)(bias + col0 + bj * HALF + 4 * n) : (MODE == 5) ? *(const f32x4*)(bias + (size_t)((u.pm < 32) ? 0 : 1 + ((u.pm - 32) >> 2)) * 4096 + col0 + bj * HALF + 4 * n) : (f32x4){0.f, 0.f, 0.f, 0.f};
        u32x4 gpre[2][4][2]; float rpre[2][4];
        if (MODE == 3) {
#pragma unroll
            for (int ai = 0; ai < 2; ++ai)
#pragma unroll
                for (int m = 0; m < 4; ++m) { const int row = row0 + ai * HALF + m * 16; const bf16_t* rp = O + (size_t)row * ldc + col0;
                    rpre[ai][m] = (u.pn < 4) ? ssq[row] : 512.0f;
#pragma unroll
                    for (int bj = 0; bj < 2; ++bj) gpre[ai][m][bj] = *(const u32x4*)(rp + bj * HALF); }
        }
#pragma unroll
        for (int ai = 0; ai < 2; ++ai)
#pragma unroll
            for (int m = 0; m < 4; ++m) {
                const int row = row0 + ai * HALF + m * 16;
                bf16_t* rowp = O + (size_t)row * ldc + col0;
                float rs = 1.f;
                if (MODE == 3) { if (u.pn < 4) rs = rsqrtf(rpre[ai][m] * (1.0f / 512.0f) + 1e-6f); }
                if (MODE == 5) rs = rsqrtf(ssq[row] * (1.0f / 1024.0f) + 1e-6f);
                if (MODE == 8) { if (u.pn < 4) rs = rsqrtf(ssq[row] * (1.0f / 512.0f) + 1e-6f); }
#pragma unroll
                for (int bj = 0; bj < 2; ++bj) {
                    f32x4 v0 = ((MODE == 5 || MODE == 8) ? acc[ai][bj][m][0] * rs : acc[ai][bj][m][0]) + bv[bj][0], v1 = ((MODE == 5 || MODE == 8) ? acc[ai][bj][m][1] * rs : acc[ai][bj][m][1]) + bv[bj][1];
                    if (MODE == 1) {
#pragma unroll
                        for (int j = 0; j < 4; ++j) { v0[j] = sigmoidf_(v0[j]); v1[j] = sigmoidf_(v1[j]); }
                    }
                    if (MODE == 2 || MODE == 5) {
#pragma unroll
                        for (int j = 0; j < 4; ++j) { const float a = fmaxf(v0[j], 0.f), b = fmaxf(v1[j], 0.f); v0[j] = a * a; v1[j] = b * b; }
                    }
                    if (MODE == 3) {
                        const u32x4 gq = gpre[ai][m][bj];
                        v0[0] *= bf_lo(gq.x) * rs; v0[1] *= bf_hi(gq.x) * rs; v0[2] *= bf_lo(gq.y) * rs; v0[3] *= bf_hi(gq.y) * rs;
                        v1[0] *= bf_lo(gq.z) * rs; v1[1] *= bf_hi(gq.z) * rs; v1[2] *= bf_lo(gq.w) * rs; v1[3] *= bf_hi(gq.w) * rs;
                    }
                    u32x4 w; w.x = cvt_pk_bf16(v0[0], v0[1]); w.y = cvt_pk_bf16(v0[2], v0[3]); w.z = cvt_pk_bf16(v1[0], v1[1]); w.w = cvt_pk_bf16(v1[2], v1[3]);
                    *(u32x4*)(rowp + bj * HALF) = w;
                }
            }
    }
};
struct EpiGlu {
    static constexpr bool PERM = true, AFTER_DRAIN = false;
    bf16_t* O; int ldc; int ocol; const float* bias;
    __device__ __forceinline__ void operator()(const f32x4 (&acc)[2][2][4][2], const Unit& u, int wr, int wc, int fr, int fq) const {
        const int row0 = u.pm * BM + wr * 64 + fr, cc = u.pn * HALF + wc * 32 + 8 * fq;
        f32x4 bv[2][2];
#pragma unroll
        for (int bj = 0; bj < 2; ++bj)
#pragma unroll
            for (int n = 0; n < 2; ++n) bv[bj][n] = *(const f32x4*)(bias + bj * 512 + cc + 4 * n);
#pragma unroll
        for (int ai = 0; ai < 2; ++ai)
#pragma unroll
            for (int m = 0; m < 4; ++m) {
                bf16_t* rowp = O + (size_t)(row0 + ai * HALF + m * 16) * ldc + ocol + cc;
                f32x4 v0 = acc[ai][0][m][0] + bv[0][0], v1 = acc[ai][0][m][1] + bv[0][1];
                const f32x4 g0 = acc[ai][1][m][0] + bv[1][0], g1 = acc[ai][1][m][1] + bv[1][1];
#pragma unroll
                for (int j = 0; j < 4; ++j) { v0[j] *= sigmoidf_(g0[j]); v1[j] *= sigmoidf_(g1[j]); }
                u32x4 w; w.x = cvt_pk_bf16(v0[0], v0[1]); w.y = cvt_pk_bf16(v0[2], v0[3]); w.z = cvt_pk_bf16(v1[0], v1[1]); w.w = cvt_pk_bf16(v1[2], v1[3]);
                *(u32x4*)rowp = w;
            }
    }
};
struct EpiGateMerge {
    static constexpr bool PERM = true, AFTER_DRAIN = false;
    const bf16_t* Z; bf16_t* mg; const float* bgate;
    __device__ __forceinline__ void operator()(const f32x4 (&acc)[2][2][4][2], const Unit& u, int wr, int wc, int fr, int fq) const {
        typedef unsigned u32x2 __attribute__((ext_vector_type(2)));
        const int row0 = u.pm * BM + wr * 64 + fr, d0 = 64 * u.pn + 16 * wc + 4 * fq;
        f32x4 bv[2][2];
#pragma unroll
        for (int bj = 0; bj < 2; ++bj)
#pragma unroll
            for (int n = 0; n < 2; ++n) bv[bj][n] = *(const f32x4*)(bgate + (2 * bj + n) * 1024 + d0);
#pragma unroll
        for (int ai = 0; ai < 2; ++ai)
#pragma unroll
        for (int mh = 0; mh < 2; ++mh) {
            u32x2 zp[2][2][2];
#pragma unroll
            for (int mm = 0; mm < 2; ++mm) { const int row = row0 + ai * HALF + (2 * mh + mm) * 16;
#pragma unroll
                for (int bj = 0; bj < 2; ++bj)
#pragma unroll
                    for (int n = 0; n < 2; ++n) zp[mm][bj][n] = *(const u32x2*)(Z + (size_t)row * 4096 + (2 * bj + n) * 1024 + d0); }
#pragma unroll
            for (int mm = 0; mm < 2; ++mm) { const int m = 2 * mh + mm; const int row = row0 + ai * HALF + m * 16;
                f32x4 s = {0.f, 0.f, 0.f, 0.f};
#pragma unroll
                for (int bj = 0; bj < 2; ++bj)
#pragma unroll
                    for (int n = 0; n < 2; ++n) { const f32x4 a = acc[ai][bj][m][n] + bv[bj][n]; const u32x2 zq = zp[mm][bj][n];
                        s[0] += sigmoidf_(a[0]) * bf_lo(zq.x); s[1] += sigmoidf_(a[1]) * bf_hi(zq.x); s[2] += sigmoidf_(a[2]) * bf_lo(zq.y); s[3] += sigmoidf_(a[3]) * bf_hi(zq.y); }
                *(u32x2*)(mg + (size_t)row * 1024 + d0) = (u32x2){cvt_pk_bf16(s[0], s[1]), cvt_pk_bf16(s[2], s[3])}; }
        }
    }
};
struct EpiRes2 {
    static constexpr bool PERM = false, AFTER_DRAIN = false;
    const float* base_ctx; const float* base_lat; float* out; const float* modv; int goff;
    bf16_t* xn; const float* gnorm; int scoff; float* ssq;
    __device__ __forceinline__ void operator()(const f32x4 (&acc)[2][2][4][2], const Unit& u, int wr, int wc, int fr, int fq) const {
        const int row0 = u.pm * BM + wr * 64 + fr, col0 = u.pn * BM + wc * 32 + 4 * fq;
        const int mi = (u.pm < 32) ? 0 : 1 + ((u.pm - 32) >> 2);
        const float* gv = modv + (size_t)mi * 6144 + goff; const float* sv = modv + (size_t)mi * 6144 + scoff;
        f32x4 gg[2][2], gn[2][2];
#pragma unroll
        for (int bj = 0; bj < 2; ++bj)
#pragma unroll
            for (int n = 0; n < 2; ++n) { gg[bj][n] = *(const f32x4*)(gv + col0 + bj * HALF + n * 16); gn[bj][n] = *(const f32x4*)(gnorm + col0 + bj * HALF + n * 16) * (*(const f32x4*)(sv + col0 + bj * HALF + n * 16) + 1.0f); }
#pragma unroll
        for (int ai = 0; ai < 2; ++ai)
#pragma unroll
        for (int mh = 0; mh < 2; ++mh) {
            f32x4 pre[2][2][2];
#pragma unroll
            for (int mm = 0; mm < 2; ++mm) { const int row = row0 + ai * HALF + (2 * mh + mm) * 16;
                const float* bp = (row < 8192 ? base_ctx + (size_t)row * 1024 : base_lat + (size_t)(row - 8192) * 1024) + col0;
#pragma unroll
                for (int bj = 0; bj < 2; ++bj)
#pragma unroll
                    for (int n = 0; n < 2; ++n) pre[mm][bj][n] = *(const f32x4*)(bp + bj * HALF + n * 16); }
#pragma unroll
            for (int mm = 0; mm < 2; ++mm) { const int m = 2 * mh + mm; const int row = row0 + ai * HALF + m * 16; float* op = out + (size_t)row * 1024 + col0; bf16_t* xp = xn + (size_t)row * 1024 + col0;
                float q = 0.f;
#pragma unroll
                for (int bj = 0; bj < 2; ++bj)
#pragma unroll
                    for (int n = 0; n < 2; ++n) { const f32x4 x = pre[mm][bj][n] + gg[bj][n] * acc[ai][bj][m][n]; *(f32x4*)(op + bj * HALF + n * 16) = x;
                        q += (x[0] * x[0] + x[1] * x[1]) + (x[2] * x[2] + x[3] * x[3]);
                        const f32x4 y = x * gn[bj][n]; unsigned w0 = cvt_pk_bf16(y[0], y[1]), w1 = cvt_pk_bf16(y[2], y[3]);
                        typedef unsigned u32x2 __attribute__((ext_vector_type(2))); *(u32x2*)(xp + bj * HALF + n * 16) = (u32x2){w0, w1}; }
                q += __shfl_xor(q, 16); q += __shfl_xor(q, 32);
                if (fq == 0) atomicAdd(ssq + row, q); }
            asm volatile("" ::: "memory");
        }
    }
};
struct EpiMerge {
    static constexpr bool PERM = true, AFTER_DRAIN = false;
    const bf16_t* gates; bf16_t* mg; const float* ssq;
    __device__ __forceinline__ void operator()(const f32x4 (&acc)[2][2][4][2], const Unit& u, int wr, int wc, int fr, int fq) const {
        const int br = u.pn >> 2, pnl = u.pn & 3;
        int pm_o = u.pm; asm volatile("" : "+s"(pm_o));
        const int row0 = pm_o * BM + wr * 64 + fr, gcol0 = u.pn * BM + wc * 32 + 8 * fq, mcol0 = pnl * BM + wc * 32 + 8 * fq;
#pragma unroll
        for (int ai = 0; ai < 2; ++ai)
#pragma unroll
        for (int mh = 0; mh < 2; ++mh) {
            u32x4 gpre[2][2], mpre[2][2]; float rpre[2];
#pragma unroll
            for (int mm = 0; mm < 2; ++mm) { const int row = row0 + ai * HALF + (2 * mh + mm) * 16;
                rpre[mm] = (br == 0) ? ssq[row] : 512.0f;
#pragma unroll
                for (int bj = 0; bj < 2; ++bj) { gpre[mm][bj] = *(const u32x4*)(gates + (size_t)row * 4096 + gcol0 + bj * HALF);
                    mpre[mm][bj] = (br != 0) ? *(const u32x4*)(mg + (size_t)row * 1024 + mcol0 + bj * HALF) : (u32x4){0u, 0u, 0u, 0u}; } }
#pragma unroll
            for (int mm = 0; mm < 2; ++mm) { const int m = 2 * mh + mm; const int row = row0 + ai * HALF + m * 16;
                const float rs = (br == 0) ? rsqrtf(rpre[mm] * (1.0f / 512.0f) + 1e-6f) : 1.0f;
#pragma unroll
                for (int bj = 0; bj < 2; ++bj) { const u32x4 gq = gpre[mm][bj], mq = mpre[mm][bj]; const f32x4 a0 = acc[ai][bj][m][0], a1 = acc[ai][bj][m][1];
                    const float v0 = bf_lo(mq.x) + a0[0] * bf_lo(gq.x) * rs, v1 = bf_hi(mq.x) + a0[1] * bf_hi(gq.x) * rs, v2 = bf_lo(mq.y) + a0[2] * bf_lo(gq.y) * rs, v3 = bf_hi(mq.y) + a0[3] * bf_hi(gq.y) * rs;
                    const float v4 = bf_lo(mq.z) + a1[0] * bf_lo(gq.z) * rs, v5 = bf_hi(mq.z) + a1[1] * bf_hi(gq.z) * rs, v6 = bf_lo(mq.w) + a1[2] * bf_lo(gq.w) * rs, v7 = bf_hi(mq.w) + a1[3] * bf_hi(gq.w) * rs;
                    u32x4 w; w.x = cvt_pk_bf16(v0, v1); w.y = cvt_pk_bf16(v2, v3); w.z = cvt_pk_bf16(v4, v5); w.w = cvt_pk_bf16(v6, v7);
                    *(u32x4*)(mg + (size_t)row * 1024 + mcol0 + bj * HALF) = w; } }
            asm volatile("" ::: "memory");
        }
    }
};
struct BranchOrder {
    int G, c;
    __host__ __device__ void init(int G_, int c_) { G = G_; c = c_; }
    __host__ __device__ bool next(int i, Unit& u) const { if (c >= 192 || i >= 4) return false; u.pm = c >> 2; u.pn = i * 4 + (c & 3); return true; }
    __device__ __forceinline__ void a_ready(const Unit&) const {}
    __device__ __forceinline__ void done(const Unit&) const {}
};
struct EpiRes {
    static constexpr bool PERM = false, AFTER_DRAIN = false;
    const float* base_ctx; const float* base_lat;
    float* out; const float* modv;
    int goff;
    __device__ __forceinline__ void operator()(const f32x4 (&acc)[2][2][4][2], const Unit& u, int wr, int wc, int fr, int fq) const {
        const int row0 = u.pm * BM + wr * 64 + fr, col0 = u.pn * BM + wc * 32 + 4 * fq;
        const int mi = (u.pm < 32) ? 0 : 1 + ((u.pm - 32) >> 2);
        const float* gv = modv + (size_t)mi * 6144 + goff;
        f32x4 gg[2][2];
#pragma unroll
        for (int bj = 0; bj < 2; ++bj)
#pragma unroll
            for (int n = 0; n < 2; ++n) gg[bj][n] = *(const f32x4*)(gv + col0 + bj * HALF + n * 16);
#pragma unroll
        for (int ai = 0; ai < 2; ++ai) {
            f32x4 pre[4][2][2];
#pragma unroll
            for (int m = 0; m < 4; ++m) { const int row = row0 + ai * HALF + m * 16;
                const float* bp = (row < 8192 ? base_ctx + (size_t)row * 1024 : base_lat + (size_t)(row - 8192) * 1024) + col0;
#pragma unroll
                for (int bj = 0; bj < 2; ++bj)
#pragma unroll
                    for (int n = 0; n < 2; ++n) pre[m][bj][n] = *(const f32x4*)(bp + bj * HALF + n * 16); }
#pragma unroll
            for (int m = 0; m < 4; ++m) { const int row = row0 + ai * HALF + m * 16; float* op = out + (size_t)row * 1024 + col0;
#pragma unroll
                for (int bj = 0; bj < 2; ++bj)
#pragma unroll
                    for (int n = 0; n < 2; ++n) *(f32x4*)(op + bj * HALF + n * 16) = pre[m][bj][n] + gg[bj][n] * acc[ai][bj][m][n]; }
            asm volatile("" ::: "memory");
        }
    }
};

template <class Epi, class Sched, bool ALIGN_EPI = false, bool SP2 = false>
__device__ __forceinline__ void gemm_phase(PG8_LAS unsigned char* lds, const Gemm g, const Sched& S, const Epi& E, const int tid) {
    const int wid = __builtin_amdgcn_readfirstlane(tid >> 6), lane = tid & 63, wr = wid >> 2, wc = wid & 3, fr = lane & 15, fq = lane >> 4;
    const int K = g.K, nt = K / BK;
    unsigned voffA[2], voffB[2];
#pragma unroll
    for (int i = 0; i < 2; ++i) { int R, C; stage_rc(tid * 16 + i * 8192, R, C); const int Rb = Epi::PERM ? ((R & ~31) + perm32(R & 31)) : R;
        voffA[i] = (unsigned)(R * g.lda + C) * 2u; voffB[i] = (unsigned)(Rb * g.ldb + C) * 2u; }
    const size_t kstep = (size_t)(BK * 2);
    const size_t hstepA = (size_t)HALF * g.lda * 2, hstepB = (size_t)HALF * g.ldb * 2;
    const size_t tstepA = 2 * hstepA, tstepB = 2 * hstepB;
#define PG8_UA(u) ((const char*)g.A + (size_t)(u).pm * tstepA + (g.a_div ? (size_t)((u).pn / g.a_div) * g.a_gstride : (size_t)0))
#define PG8_UB(u) ((const char*)g.Bt + (size_t)(u).pn * tstepB)
    const unsigned ldsw = (unsigned)wid * 1024u;
    const int aoff = lds_byte(wr * 64 + fr, fq * 8), boff = lds_byte(wc * 32 + fr, fq * 8);
#define PG8_SA(b, h) (((b) * 2 + (h)) * HTB)
#define PG8_SB(b, h) ((4 + (b) * 2 + (h)) * HTB)
#define PG8_STAGE(bufoff, gbase, voff) do { _Pragma("unroll") for (int _i = 0; _i < 2; ++_i) \
        __builtin_amdgcn_global_load_lds((const unsigned*)((const char*)(gbase) + (voff)[_i]), (PG8_LAS unsigned*)(lds + (bufoff) + ldsw + _i * 8192), 16, 0, 0); } while (0)
#define PG8_LDA(dst, b, h) do { _Pragma("unroll") for (int m = 0; m < 4; ++m) _Pragma("unroll") for (int k = 0; k < 2; ++k) dst[m][k] = *(const PG8_LAS bf16x8*)(lds + PG8_SA(b, h) + aoff + m * 2048 + k * 1024); } while (0)
#define PG8_LDB(dst, b, h) do { _Pragma("unroll") for (int n = 0; n < 2; ++n) _Pragma("unroll") for (int k = 0; k < 2; ++k) dst[n][k] = *(const PG8_LAS bf16x8*)(lds + PG8_SB(b, h) + boff + n * 2048 + k * 1024); } while (0)
#define PG8_MMA(ai, bj, At, Bt) do { __builtin_amdgcn_s_setprio(1); _Pragma("unroll") for (int m = 0; m < 4; ++m) _Pragma("unroll") for (int n = 0; n < 2; ++n) _Pragma("unroll") for (int k = 0; k < 2; ++k) \
        acc[ai][bj][m][n] = __builtin_amdgcn_mfma_f32_16x16x32_bf16(Bt[n][k], At[m][k], acc[ai][bj][m][n], 0, 0, 0); __builtin_amdgcn_s_setprio(0); } while (0)
#define PG8_WAIT_V(n) asm volatile("s_waitcnt vmcnt(" #n ")" ::: "memory")
#define PG8_WAIT_L(n) asm volatile("s_waitcnt lgkmcnt(" #n ")" ::: "memory")
#define PG8_BAR __builtin_amdgcn_s_barrier()
#define PG8_SCHED __builtin_amdgcn_sched_barrier(0)
    Unit cur, nxt; int ui = 0;
    if (!S.next(0, cur)) return;
    f32x4 acc[2][2][4][2];
#pragma unroll
    for (int a = 0; a < 2; ++a)
#pragma unroll
        for (int b = 0; b < 2; ++b)
#pragma unroll
            for (int m = 0; m < 4; ++m)
#pragma unroll
                for (int n = 0; n < 2; ++n) acc[a][b][m][n] = (f32x4){0.f, 0.f, 0.f, 0.f};
    bf16x8 At[4][2], B0[2][2], B1[2][2];
    const char* cA = PG8_UA(cur); const char* cB = PG8_UB(cur);
    S.a_ready(cur);
    if constexpr (SP2) {
        PG8_STAGE(PG8_SB(0, 0), cB, voffB); PG8_STAGE(PG8_SB(0, 1), cB + hstepB, voffB); PG8_STAGE(PG8_SA(0, 0), cA, voffA); PG8_STAGE(PG8_SA(0, 1), cA + hstepA, voffA);
        if (wr == 1) PG8_BAR;
        PG8_WAIT_V(2); PG8_BAR;
        PG8_STAGE(PG8_SB(1, 0), cB + kstep, voffB); PG8_STAGE(PG8_SA(1, 0), cA + kstep, voffA); PG8_STAGE(PG8_SB(1, 1), cB + hstepB + kstep, voffB);
        PG8_WAIT_V(6); PG8_BAR;
    } else {
        PG8_STAGE(PG8_SB(0, 0), cB, voffB); PG8_STAGE(PG8_SA(0, 0), cA, voffA); PG8_STAGE(PG8_SB(0, 1), cB + hstepB, voffB); PG8_STAGE(PG8_SA(0, 1), cA + hstepA, voffA);
        if (wr == 1) PG8_BAR;
        PG8_WAIT_V(4); PG8_BAR;
        PG8_STAGE(PG8_SB(1, 0), cB + kstep, voffB); PG8_STAGE(PG8_SA(1, 0), cA + kstep, voffA); PG8_STAGE(PG8_SB(1, 1), cB + hstepB + kstep, voffB);
        PG8_WAIT_V(6); PG8_BAR;
    }
    for (;;) {
        const bool has_next = S.next(ui + 1, nxt);
        const char* nA = has_next ? PG8_UA(nxt) : cA; const char* nB = has_next ? PG8_UB(nxt) : cB;
        for (int t = 0; t < nt; t += 2) {
            const bool last = (t == nt - 2);
            const char* a1 = cA + (size_t)(t + 1) * kstep;
            const char* a2 = last ? nA : cA + (size_t)(t + 2) * kstep; const char* b2 = last ? nB : cB + (size_t)(t + 2) * kstep;
            const char* a3 = a2 + kstep; const char* b3 = b2 + kstep;
            if (last && has_next) S.a_ready(nxt);
            if constexpr (SP2) {
            PG8_LDB(B0, 0, 0); PG8_LDB(B1, 0, 1); PG8_SCHED; PG8_LDA(At, 0, 0); PG8_STAGE(PG8_SA(1, 1), a1 + hstepA, voffA);
            PG8_WAIT_V(8); PG8_WAIT_L(0); PG8_BAR; PG8_MMA(0, 0, At, B0); PG8_MMA(0, 1, At, B1); PG8_BAR; PG8_SCHED;
            PG8_LDA(At, 0, 1); PG8_STAGE(PG8_SB(0, 0), b2, voffB); PG8_STAGE(PG8_SB(0, 1), b2 + hstepB, voffB); PG8_STAGE(PG8_SA(0, 0), a2, voffA);
            PG8_WAIT_V(8); PG8_WAIT_L(0); PG8_BAR; PG8_MMA(1, 0, At, B0); PG8_MMA(1, 1, At, B1); PG8_BAR; PG8_SCHED;
            PG8_LDB(B0, 1, 0); PG8_LDB(B1, 1, 1); PG8_SCHED; PG8_LDA(At, 1, 0); PG8_STAGE(PG8_SA(0, 1), a2 + hstepA, voffA);
            PG8_WAIT_V(8); PG8_WAIT_L(0); PG8_BAR; PG8_MMA(0, 0, At, B0); PG8_MMA(0, 1, At, B1); PG8_BAR; PG8_SCHED;
            PG8_LDA(At, 1, 1); PG8_STAGE(PG8_SB(1, 0), b3, voffB); PG8_STAGE(PG8_SB(1, 1), b3 + hstepB, voffB); PG8_STAGE(PG8_SA(1, 0), a3, voffA);
            PG8_WAIT_V(8); PG8_WAIT_L(0); PG8_BAR; PG8_MMA(1, 0, At, B0); PG8_MMA(1, 1, At, B1); PG8_BAR; PG8_SCHED;
            } else {
            PG8_LDB(B0, 0, 0); PG8_SCHED; PG8_LDA(At, 0, 0); PG8_STAGE(PG8_SA(1, 1), a1 + hstepA, voffA);
            PG8_WAIT_L(8); PG8_BAR; PG8_WAIT_L(0); PG8_MMA(0, 0, At, B0); PG8_BAR; PG8_SCHED;
            PG8_LDB(B1, 0, 1); PG8_STAGE(PG8_SB(0, 0), b2, voffB);
            PG8_BAR; PG8_WAIT_L(0); PG8_MMA(0, 1, At, B1); PG8_BAR;
            PG8_LDA(At, 0, 1); PG8_STAGE(PG8_SA(0, 0), a2, voffA);
            PG8_BAR; PG8_WAIT_L(0); PG8_MMA(1, 0, At, B0); PG8_BAR; PG8_SCHED;
            PG8_STAGE(PG8_SB(0, 1), b2 + hstepB, voffB);
            PG8_WAIT_V(6); PG8_BAR; PG8_MMA(1, 1, At, B1); PG8_BAR;
            PG8_LDB(B0, 1, 0); PG8_SCHED; PG8_LDA(At, 1, 0); PG8_STAGE(PG8_SA(0, 1), a2 + hstepA, voffA);
            PG8_WAIT_L(8); PG8_BAR; PG8_WAIT_L(0); PG8_MMA(0, 0, At, B0); PG8_BAR; PG8_SCHED;
            PG8_LDB(B1, 1, 1); PG8_STAGE(PG8_SB(1, 0), b3, voffB);
            PG8_BAR; PG8_WAIT_L(0); PG8_MMA(0, 1, At, B1); PG8_BAR;
            PG8_LDA(At, 1, 1); PG8_STAGE(PG8_SA(1, 0), a3, voffA);
            PG8_BAR; PG8_WAIT_L(0); PG8_MMA(1, 0, At, B0); PG8_BAR; PG8_SCHED;
            PG8_STAGE(PG8_SB(1, 1), b3 + hstepB, voffB);
            PG8_WAIT_V(6); PG8_BAR; PG8_MMA(1, 1, At, B1); PG8_BAR;
            }
        }
        if constexpr (ALIGN_EPI) { if (wr == 0) PG8_BAR; }
        if constexpr (!Epi::AFTER_DRAIN) { E(acc, cur, wr, wc, fr, fq); S.done(cur); }
        if (!has_next) break;
#pragma unroll
        for (int a = 0; a < 2; ++a)
#pragma unroll
            for (int b = 0; b < 2; ++b)
#pragma unroll
                for (int m = 0; m < 4; ++m)
#pragma unroll
                    for (int n = 0; n < 2; ++n) acc[a][b][m][n] = (f32x4){0.f, 0.f, 0.f, 0.f};
        cur = nxt; cA = nA; cB = nB; ++ui;
        if constexpr (ALIGN_EPI) { if (wr == 1) PG8_BAR; }
    }
    PG8_WAIT_V(0);
    if constexpr (!ALIGN_EPI) { if (wr == 0) PG8_BAR; }
    PG8_BAR;
    if constexpr (Epi::AFTER_DRAIN) { E.fused(acc, cur, wr, wc, fr, fq, lds, wid, lane); S.done(cur); }
#undef PG8_UA
#undef PG8_UB
#undef PG8_SA
#undef PG8_SB
#undef PG8_STAGE
#undef PG8_LDA
#undef PG8_LDB
#undef PG8_MMA
#undef PG8_WAIT_V
#undef PG8_WAIT_L
#undef PG8_BAR
#undef PG8_SCHED
}
}

#ifndef PG8_SP2
#define PG8_SP2 true
#endif
#ifndef PG8_ALIGN
#define PG8_ALIGN true
#endif

typedef unsigned short bf16;
typedef unsigned v4u __attribute__((ext_vector_type(4)));
typedef unsigned v2u __attribute__((ext_vector_type(2)));
typedef float f32x4 __attribute__((ext_vector_type(4)));
#define LAS __attribute__((address_space(3)))

constexpr int NWAVES = 8, NTHR = 512;
constexpr int D = 1024, MC = 8192, ML = 4096, M = 12288, NPH = 23;
constexpr int LDS_BYTES = 147456;
constexpr float EPS = 1e-6f;
constexpr size_t MiB = 1u << 20;
constexpr size_t WS_MOD = 64 * 1024;
constexpr size_t WS_SSQ = 320 * 1024;
constexpr size_t WS_DT = 384 * 1024;
constexpr size_t WS_W = 2 * MiB;
constexpr size_t W_IN = WS_W, W_G = W_IN + 8 * MiB, W_GLU = W_G + 8 * MiB, W_BR = W_GLU + 1 * MiB, W_OUT = W_BR + 4 * MiB, W_1 = W_OUT + 2 * MiB, W_2 = W_1 + 8 * MiB;
constexpr size_t WS_H = 41 * MiB;
constexpr size_t WS_R1 = 65 * MiB;
constexpr size_t WS_Y = 161 * MiB;
constexpr size_t WS_Y5 = 209 * MiB;
constexpr size_t WS_XC = 221 * MiB;
constexpr size_t WS_S5K = 239 * MiB;
constexpr size_t WS_S5WS = 240 * MiB;
constexpr size_t WS_S5WO = 244 * MiB;
constexpr size_t WS_S5AT = 248 * MiB;
constexpr size_t WS_CKV = 248 * MiB + 512 * 1024;
constexpr size_t WS_ROPE = 1536 * 1024;
constexpr size_t WS_WDT = 1792 * 1024;
constexpr size_t WS_BI2 = 1824 * 1024;
constexpr size_t WS_SSQ2 = 1904 * 1024;
constexpr size_t WS_END = 254 * MiB;
#ifndef PROBE_SEL
#define PROBE_SEL -1
#endif
#ifndef PROBE_SCALE
#define PROBE_SCALE 4e-4f
#endif
#ifndef PROBE_PB
#define PROBE_PB 32
#endif
constexpr size_t WS_BAR = 32 * 1024;
constexpr size_t WS_QCTR = 48 * 1024;
constexpr size_t WS_TS = 16 * 1024;
constexpr size_t O_SSD = 12582912, O_S5 = 16777216, O_DK = 17301504, O_DV = 25690112, O_WK = 34078720, O_WV = 36175872;
constexpr int C_Z = 0, C_XBC = 512, C_U = 1280, C_DQ = 1792, C_DK = 2304, C_DV = 2816, C_WQ = 3328, C_WK = 3840, C_WV = 3968;

namespace pg8 {
struct EpiIn {
    static constexpr bool PERM = true, AFTER_DRAIN = false;
    bf16_t* O; float* out; const float* rope; const float* qg; const float* kg; const float* wqg; const float* wkg; int l;
    __device__ __forceinline__ void operator()(const f32x4 (&acc)[2][2][4][2], const Unit& u, int wr, int wc, int fr, int fq) const {
        const int pn = u.pn; const bool lat = u.pm >= 32;
        const int row0 = u.pm * BM + wr * 64 + fr, lcol0 = pn * BM + 64 * wc + 8 * fq;
        const float* gp = nullptr;
        if (pn == 7 || pn == 8) gp = qg; else if (pn == 9 || pn == 10) gp = kg; else if (pn == 13 || pn == 14) gp = wqg; else if (pn == 15 && wc < 2) gp = wkg;
        float* fo = nullptr; int fstride = 0;
        if (!lat) { if (pn == 9 || pn == 10) { fo = out + O_DK + (pn - 9) * 256 + 64 * wc + 8 * fq; fstride = 512; }
                    else if (pn == 11 || pn == 12) { fo = out + O_DV + (pn - 11) * 256 + 64 * wc + 8 * fq; fstride = 512; }
                    else if (pn == 15) { fo = out + (wc < 2 ? O_WK + 64 * wc : O_WV + 64 * (wc - 2)) + 8 * fq; fstride = 128; } }
        f32x4 g[2][2];
#pragma unroll
        for (int bj = 0; bj < 2; ++bj)
#pragma unroll
            for (int n = 0; n < 2; ++n) g[bj][n] = gp ? *(const f32x4*)(gp + 32 * bj + 8 * fq + 4 * n) : (f32x4){1.f, 1.f, 1.f, 1.f};
#pragma unroll
        for (int ai = 0; ai < 2; ++ai)
#pragma unroll
            for (int m = 0; m < 4; ++m) {
                const int row = row0 + ai * HALF + m * 16;
                f32x4 v[2][2];
#pragma unroll
                for (int bj = 0; bj < 2; ++bj)
#pragma unroll
                    for (int n = 0; n < 2; ++n) v[bj][n] = acc[ai][bj][m][n];
                if (gp) {
                    float ss = 0.f;
#pragma unroll
                    for (int bj = 0; bj < 2; ++bj)
#pragma unroll
                        for (int n = 0; n < 2; ++n) ss += (v[bj][n][0] * v[bj][n][0] + v[bj][n][1] * v[bj][n][1]) + (v[bj][n][2] * v[bj][n][2] + v[bj][n][3] * v[bj][n][3]);
                    ss += __shfl_xor(ss, 16); ss += __shfl_xor(ss, 32);
                    const float rs = rsqrtf(ss * (1.0f / 64.0f) + 1e-6f);
#pragma unroll
                    for (int bj = 0; bj < 2; ++bj)
#pragma unroll
                        for (int n = 0; n < 2; ++n) v[bj][n] = v[bj][n] * rs * g[bj][n];
                    if (lat) {
                        const float* rp = rope + (size_t)((row - 8192) & 1023) * 64 + 8 * (fq & 1);
#pragma unroll
                        for (int bj = 0; bj < 2; ++bj)
#pragma unroll
                            for (int n = 0; n < 2; ++n) { const f32x4 cs = *(const f32x4*)(rp + 16 * bj + 4 * n), sn = *(const f32x4*)(rp + 32 + 16 * bj + 4 * n);
                                f32x4 p; p[0] = __shfl_xor(v[bj][n][0], 32); p[1] = __shfl_xor(v[bj][n][1], 32); p[2] = __shfl_xor(v[bj][n][2], 32); p[3] = __shfl_xor(v[bj][n][3], 32);
                                v[bj][n] = (fq >> 1) ? v[bj][n] * cs + p * sn : v[bj][n] * cs - p * sn; }
                    }
                }
                bf16_t* rowp = O + (size_t)row * 4096 + lcol0;
#pragma unroll
                for (int bj = 0; bj < 2; ++bj) { u32x4 w; w.x = cvt_pk_bf16(v[bj][0][0], v[bj][0][1]); w.y = cvt_pk_bf16(v[bj][0][2], v[bj][0][3]); w.z = cvt_pk_bf16(v[bj][1][0], v[bj][1][1]); w.w = cvt_pk_bf16(v[bj][1][2], v[bj][1][3]);
                    *(u32x4*)(rowp + 32 * bj) = w; }
                if (fo) { float* fp = fo + (size_t)(((row >> 8) * 2 + l) * 256 + (row & 255)) * fstride;
#pragma unroll
                    for (int bj = 0; bj < 2; ++bj) { *(f32x4*)(fp + 32 * bj) = v[bj][0]; *(f32x4*)(fp + 32 * bj + 4) = v[bj][1]; } }
            }
    }
};
}

struct Args { const float* in[44]; float* out; unsigned char* ws; int ph_lo, ph_hi; };

typedef const Args __attribute__((address_space(4)))* CArgs;
struct Ctx {
    CArgs ap; int tid, lane, wave;
    __device__ __forceinline__ const float* x_prompt() const { return ap->in[0]; }
    __device__ __forceinline__ const float* x_sample() const { return ap->in[1]; }
    __device__ __forceinline__ const float* state_ssd() const { return ap->in[2]; }
    __device__ __forceinline__ const float* state_s5() const { return ap->in[3]; }
    __device__ __forceinline__ const float* cache_dk() const { return ap->in[4]; }
    __device__ __forceinline__ const float* cache_dv() const { return ap->in[5]; }
    __device__ __forceinline__ const float* cache_wk() const { return ap->in[6]; }
    __device__ __forceinline__ const float* cache_wv() const { return ap->in[7]; }
    __device__ __forceinline__ const float* cvec() const { return ap->in[8]; }
    __device__ __forceinline__ const float* c_ctx() const { return ap->in[9]; }
    __device__ __forceinline__ const float* w_mod() const { return ap->in[10]; }
    __device__ __forceinline__ const float* b_mod() const { return ap->in[11]; }
    __device__ __forceinline__ const float* g_norm1() const { return ap->in[12]; }
    __device__ __forceinline__ const float* g_norm2() const { return ap->in[13]; }
    __device__ __forceinline__ const float* w_in() const { return ap->in[14]; }
    __device__ __forceinline__ const float* conv_w() const { return ap->in[15]; }
    __device__ __forceinline__ const float* conv_b() const { return ap->in[16]; }
    __device__ __forceinline__ const float* dt_bias() const { return ap->in[17]; }
    __device__ __forceinline__ const float* a_log() const { return ap->in[18]; }
    __device__ __forceinline__ const float* ssd_d() const { return ap->in[19]; }
    __device__ __forceinline__ const float* ssd_norm_g() const { return ap->in[20]; }
    __device__ __forceinline__ const float* lam_re() const { return ap->in[21]; }
    __device__ __forceinline__ const float* lam_im() const { return ap->in[22]; }
    __device__ __forceinline__ const float* log_step() const { return ap->in[23]; }
    __device__ __forceinline__ const float* b_re() const { return ap->in[24]; }
    __device__ __forceinline__ const float* b_im() const { return ap->in[25]; }
    __device__ __forceinline__ const float* c_re() const { return ap->in[26]; }
    __device__ __forceinline__ const float* c_im() const { return ap->in[27]; }
    __device__ __forceinline__ const float* s5_d() const { return ap->in[28]; }
    __device__ __forceinline__ const float* w_glu() const { return ap->in[29]; }
    __device__ __forceinline__ const float* b_glu() const { return ap->in[30]; }
    __device__ __forceinline__ const float* qn_g() const { return ap->in[31]; }
    __device__ __forceinline__ const float* kn_g() const { return ap->in[32]; }
    __device__ __forceinline__ const float* dlam() const { return ap->in[33]; }
    __device__ __forceinline__ const float* subln_g() const { return ap->in[34]; }
    __device__ __forceinline__ const float* wqn_g() const { return ap->in[35]; }
    __device__ __forceinline__ const float* wkn_g() const { return ap->in[36]; }
    __device__ __forceinline__ const float* sink() const { return ap->in[37]; }
    __device__ __forceinline__ const float* w_branch() const { return ap->in[38]; }
    __device__ __forceinline__ const float* w_gate() const { return ap->in[39]; }
    __device__ __forceinline__ const float* b_gate() const { return ap->in[40]; }
    __device__ __forceinline__ const float* w_out() const { return ap->in[41]; }
    __device__ __forceinline__ const float* w_fc1() const { return ap->in[42]; }
    __device__ __forceinline__ const float* w_fc2() const { return ap->in[43]; }
    __device__ __forceinline__ float* out() const { return ap->out; }
    __device__ __forceinline__ unsigned char* ws() const { return ap->ws; }
    __device__ __forceinline__ float* MOD() const { return (float*)(ap->ws + WS_MOD); }
    __device__ __forceinline__ float* SSQ() const { return (float*)(ap->ws + WS_SSQ); }
    __device__ __forceinline__ float* DT() const { return (float*)(ap->ws + WS_DT); }
    __device__ __forceinline__ bf16* H() const { return (bf16*)(ap->ws + WS_H); }
    __device__ __forceinline__ bf16* R1() const { return (bf16*)(ap->ws + WS_R1); }
    __device__ __forceinline__ bf16* Y() const { return (bf16*)(ap->ws + WS_Y); }
    __device__ __forceinline__ bf16* Y5() const { return (bf16*)(ap->ws + WS_Y5); }
    __device__ __forceinline__ bf16* XC() const { return (bf16*)(ap->ws + WS_XC); }
    __device__ __forceinline__ bf16* CKV() const { return (bf16*)(ap->ws + WS_CKV); }
    __device__ __forceinline__ float* ROPE() const { return (float*)(ap->ws + WS_ROPE); }
};

__device__ __forceinline__ float wave_sum(float v) {
#pragma unroll
    for (int o = 1; o < 64; o <<= 1) v += __shfl_xor(v, o);
    return v;
}
__device__ __forceinline__ float wave_max(float v) {
#pragma unroll
    for (int o = 1; o < 64; o <<= 1) v = fmaxf(v, __shfl_xor(v, o));
    return v;
}
__device__ __forceinline__ float bf2f(bf16 h) { return __builtin_bit_cast(float, (unsigned)h << 16); }
__device__ __forceinline__ float bflo(unsigned w) { return __builtin_bit_cast(float, w << 16); }
__device__ __forceinline__ float bfhi(unsigned w) { return __builtin_bit_cast(float, w & 0xffff0000u); }
__device__ __forceinline__ unsigned f2bf(float f) { unsigned u = __builtin_bit_cast(unsigned, f); return (u + 0x7fffu + ((u >> 16) & 1u)) >> 16; }
__device__ __forceinline__ unsigned pk2(float lo, float hi) { return f2bf(lo) | (f2bf(hi) << 16); }
__device__ __forceinline__ float siluf(float x) { return x / (1.0f + __expf(-x)); }
__device__ __forceinline__ void unpack8(const v4u q, float (&f)[8]) { f[0] = bflo(q.x); f[1] = bfhi(q.x); f[2] = bflo(q.y); f[3] = bfhi(q.y); f[4] = bflo(q.z); f[5] = bfhi(q.z); f[6] = bflo(q.w); f[7] = bfhi(q.w); }

__device__ __forceinline__ void phase_mods(const Ctx& c, float* lf) {
    for (int i = c.tid; i < 5 * 1024; i += NTHR) { const int v = i >> 10, k = i & 1023; const float x = (v == 0) ? c.c_ctx()[k] : c.cvec()[(v - 1) * 1024 + k]; lf[i] = siluf(x); }
    __syncthreads();
    float* red = lf + 5 * 1024;
    for (int u = blockIdx.x; u < 192; u += gridDim.x) {
        const int l = u / 96, col0 = (u % 96) * 64;
        const float* W = c.w_mod() + (size_t)l * 1024 * 6144 + col0 + c.lane;
        float acc[5] = {0.f, 0.f, 0.f, 0.f, 0.f};
#pragma unroll 1
        for (int kb = c.wave * 128; kb < c.wave * 128 + 128; kb += 32) {
            float wv[32];
#pragma unroll
            for (int j = 0; j < 32; ++j) wv[j] = W[(size_t)(kb + j) * 6144];
#pragma unroll
            for (int j = 0; j < 32; ++j)
#pragma unroll
                for (int i = 0; i < 5; ++i) acc[i] += lf[i * 1024 + kb + j] * wv[j]; }
#pragma unroll
        for (int i = 0; i < 5; ++i) red[(c.wave * 5 + i) * 64 + c.lane] = acc[i];
        __syncthreads();
        if (c.tid < 320) { const int i = c.tid >> 6, ln = c.tid & 63; float s = c.b_mod()[l * 6144 + col0 + ln];
#pragma unroll
            for (int w = 0; w < 8; ++w) s += red[(w * 5 + i) * 64 + ln];
            c.MOD()[(size_t)(l * 5 + i) * 6144 + col0 + ln] = s; }
        __syncthreads();
    }
}

__device__ __forceinline__ int cmap(int mode, int n) {
    if (mode == 0) return n;
    if (mode == 1) { const int p = n & 255, lc = 64 * ((p >> 5) & 3) + 32 * (p >> 7) + (p & 31), nn = (n & ~255) + lc; return nn < 1280 ? nn : nn + 16; }
    if (mode == 3) { const int T = n >> 8, p = n & 255; return (2 * (p >> 7) + ((p >> 2) & 1)) * 1024 + 64 * T + 16 * ((p >> 5) & 3) + 4 * ((p >> 3) & 3) + (p & 3); }
    return (n & 255) < 128 ? 128 * (n >> 8) + (n & 127) : 512 + 128 * (n >> 8) + (n & 127);
}
__device__ __forceinline__ void transpose_item(const float* W, int ld, int K, int N, int mode, const float* rowscale, bf16* WT, float* scr, int item, int lane) {
    const int nblk = N / 32, kb = item / nblk, nb = item % nblk, k0 = 64 * kb, n0 = 32 * nb, scl = (mode == 3) ? cmap(3, n0 + (lane & 31)) : cmap(mode, n0) + (lane & 31);
    float tv[32];
#pragma unroll
    for (int i = 0; i < 32; ++i) tv[i] = W[(size_t)(k0 + 2 * i + (lane >> 5)) * ld + scl];
    if (rowscale) {
#pragma unroll
        for (int i = 0; i < 32; ++i) tv[i] *= rowscale[k0 + 2 * i + (lane >> 5)]; }
#pragma unroll
    for (int i = 0; i < 32; ++i) scr[(2 * i + (lane >> 5)) * 33 + (lane & 31)] = tv[i];
    __builtin_amdgcn_fence(__ATOMIC_RELEASE, "wavefront"); __builtin_amdgcn_wave_barrier();
    const int ch = lane & 7;
#pragma unroll
    for (int j = 0; j < 4; ++j) { const int n = (lane >> 3) + 8 * j; const float* s = scr + (8 * ch) * 33 + n;
        v4u o; o.x = pk2(s[0 * 33], s[1 * 33]); o.y = pk2(s[2 * 33], s[3 * 33]); o.z = pk2(s[4 * 33], s[5 * 33]); o.w = pk2(s[6 * 33], s[7 * 33]);
        *(v4u*)(WT + (size_t)(n0 + n) * K + k0 + 8 * ch) = o; }
    __builtin_amdgcn_fence(__ATOMIC_RELEASE, "wavefront"); __builtin_amdgcn_wave_barrier();
}
__device__ __forceinline__ void s5_tables(const Ctx& c, int l, int g, int part, float* lf);
__device__ __forceinline__ void convert_items(const Ctx& c, int l, int lo, int hi, int gw0, int ngw, bool tabs, int tb0, int ntb, float* lf) {
    unsigned char* ws = c.ws();
    if (tabs) {
        for (int t = tb0; t < 128; t += ntb) s5_tables(c, l, t & 31, t >> 5, lf);
        for (int i = tb0 * NTHR + c.tid; i < 16384; i += ntb * NTHR) { const int j = i >> 10, k = i & 1023; ((bf16*)(ws + WS_WDT))[i] = (bf16)f2bf(c.w_in()[(size_t)l * 1024 * 4112 + (size_t)k * 4112 + 1280 + j]); }
    }
    float* scr = lf + c.wave * 2176;
    for (int it = lo + gw0; it < hi; it += ngw) {
        int r = it;
        if (r < 2048) { transpose_item(c.w_in() + (size_t)l * 1024 * 4112, 4112, 1024, 4096, 1, nullptr, (bf16*)(ws + W_IN), scr, r, c.lane); continue; } r -= 2048;
        if (r < 2048) { transpose_item(c.w_gate() + (size_t)l * 1024 * 4096, 4096, 1024, 4096, 3, nullptr, (bf16*)(ws + W_G), scr, r, c.lane); continue; } r -= 2048;
        if (r < 256) { transpose_item(c.w_glu() + (size_t)l * 512 * 1024, 1024, 512, 1024, 2, nullptr, (bf16*)(ws + W_GLU), scr, r, c.lane); continue; } r -= 256;
        if (r < 1024) { const int i = r >> 8; transpose_item(c.w_branch() + (size_t)(l * 4 + i) * 512 * 1024, 1024, 512, 1024, 0, i == 0 ? c.ssd_norm_g() + l * 512 : nullptr, (bf16*)(ws + W_BR) + (size_t)i * 1024 * 512, scr, r & 255, c.lane); continue; } r -= 1024;
        if (r < 512) { transpose_item(c.w_out() + (size_t)l * 1024 * 1024, 1024, 1024, 1024, 0, nullptr, (bf16*)(ws + W_OUT), scr, r, c.lane); continue; } r -= 512;
        if (r < 2048) { transpose_item(c.w_fc1() + (size_t)l * 1024 * 4096, 4096, 1024, 4096, 0, nullptr, (bf16*)(ws + W_1), scr, r, c.lane); continue; } r -= 2048;
        transpose_item(c.w_fc2() + (size_t)l * 4096 * 1024, 1024, 4096, 1024, 0, nullptr, (bf16*)(ws + W_2), scr, r, c.lane);
    }
}
__device__ __forceinline__ void phase_convert(const Ctx& c, int l, float* lf) {
    if (gridDim.x == 256) convert_items(c, l, 0, 9984, blockIdx.x * NWAVES + c.wave, gridDim.x * NWAVES, true, blockIdx.x >= 192 ? (int)blockIdx.x - 192 : 100000, 64, lf);
    else convert_items(c, l, 0, 9984, blockIdx.x * NWAVES + c.wave, gridDim.x * NWAVES, true, blockIdx.x, gridDim.x, lf);
}
__device__ __forceinline__ void side_convert(const Ctx& c, int lo, int hi, bool tabs, float* lf) {
    if (blockIdx.x < 192 || gridDim.x != 256) return;
    convert_items(c, 1, lo, hi, (blockIdx.x - 192) * NWAVES + c.wave, 64 * NWAVES, tabs, blockIdx.x - 192, 64, lf);
}

__device__ __forceinline__ void phase_norm(const Ctx& c, int l, int which, float* lf) {
    const int gw = blockIdx.x * NWAVES + c.wave, NGW = gridDim.x * NWAVES;
    const float* gn = (which == 0 ? c.g_norm1() : c.g_norm2()) + l * 1024;
    for (int m = gw; m < M; m += NGW) {
        const float* xr = (l == 0 && which == 0) ? (m < MC ? c.x_prompt() + (size_t)m * D : c.x_sample() + (size_t)(m - MC) * D) : c.out() + (size_t)m * D;
        const int mi = (m < MC) ? 0 : 1 + ((m - MC) >> 10);
        const float* mod = c.MOD() + (size_t)(l * 5 + mi) * 6144 + which * 3072;
        f32x4 v[4]; float s = 0.f;
#pragma unroll
        for (int j = 0; j < 4; ++j) { v[j] = *(const f32x4*)(xr + 4 * c.lane + 256 * j); s += (v[j].x * v[j].x + v[j].y * v[j].y) + (v[j].z * v[j].z + v[j].w * v[j].w); }
        const float rstd = rsqrtf(wave_sum(s) * (1.0f / D) + EPS);
#pragma unroll
        for (int j = 0; j < 4; ++j) { const int k = 4 * c.lane + 256 * j; const f32x4 g = *(const f32x4*)(gn + k), sh = *(const f32x4*)(mod + k), sc = *(const f32x4*)(mod + 1024 + k);
            v[j] = v[j] * rstd * g * (sc + 1.0f) + sh;
            v2u o; o.x = pk2(v[j].x, v[j].y); o.y = pk2(v[j].z, v[j].w); *(v2u*)(c.H() + (size_t)m * D + k) = o; }
        if (which == 0) {
            if (c.lane == 0) { c.SSQ()[m] = 0.f; ((float*)(c.ws() + WS_SSQ2))[m] = 0.f; }
        }
    }
}

__device__ __forceinline__ void phase_bias2(const Ctx& c, int l) {
    const int gw = blockIdx.x * NWAVES + c.wave, NGW = gridDim.x * NWAVES, lane = c.lane;
    const bf16* W1t = (const bf16*)(c.ws() + W_1); float* bi = (float*)(c.ws() + WS_BI2);
    for (int n = gw; n < 4096; n += NGW) {
        float wf[16]; { float t8[8]; unpack8(*(const v4u*)(W1t + (size_t)n * 1024 + 8 * lane), t8);
#pragma unroll
            for (int j = 0; j < 8; ++j) wf[j] = t8[j];
            unpack8(*(const v4u*)(W1t + (size_t)n * 1024 + 512 + 8 * lane), t8);
#pragma unroll
            for (int j = 0; j < 8; ++j) wf[8 + j] = t8[j]; }
#pragma unroll 1
        for (int mi = 0; mi < 5; ++mi) { const float* sh = c.MOD() + (size_t)(l * 5 + mi) * 6144 + 3072; float a = 0.f;
#pragma unroll
            for (int hh = 0; hh < 2; ++hh) { const f32x4 s0 = *(const f32x4*)(sh + 512 * hh + 8 * lane), s1 = *(const f32x4*)(sh + 512 * hh + 8 * lane + 4);
                a += (wf[8 * hh + 0] * s0.x + wf[8 * hh + 1] * s0.y) + (wf[8 * hh + 2] * s0.z + wf[8 * hh + 3] * s0.w) + (wf[8 * hh + 4] * s1.x + wf[8 * hh + 5] * s1.y) + (wf[8 * hh + 6] * s1.z + wf[8 * hh + 7] * s1.w); }
            a = wave_sum(a); if (lane == 0) bi[mi * 4096 + n] = a; }
    }
}

__device__ __forceinline__ void phase_dt(const Ctx& c, int l) {
    const int tile = blockIdx.x * 3 + c.wave;
    if (c.wave < 3 && tile < 768) {
    const int lr = c.lane & 15, lq = c.lane >> 4;
    const bf16* ap = c.H() + (size_t)(16 * tile + lr) * 1024 + 8 * lq; const bf16* bp = (const bf16*)(c.ws() + WS_WDT) + (size_t)lr * 1024 + 8 * lq;
    f32x4 acc = {0.f, 0.f, 0.f, 0.f};
#pragma unroll 8
    for (int ks = 0; ks < 32; ++ks) acc = __builtin_amdgcn_mfma_f32_16x16x32_bf16(*(const pg8::bf16x8*)(ap + 32 * ks), *(const pg8::bf16x8*)(bp + 32 * ks), acc, 0, 0, 0);
    const float bias = c.dt_bias()[l * 16 + lr];
#pragma unroll
    for (int r = 0; r < 4; ++r) { const float x = acc[r] + bias; c.DT()[(size_t)(16 * tile + 4 * lq + r) * 16 + lr] = x > 20.f ? x : log1pf(__expf(x)); }
    }
}

__device__ __forceinline__ void phase_rope_table(const Ctx& c) {
    const int gt = blockIdx.x * NTHR + c.tid;
    if (gt < 32768) { const int pos = gt >> 5, a = gt & 31, f = a & 15; const float inv = exp2f(-(float)f * 0.8304820237218406f);
        const float ang = (float)((a >> 4) ? (pos & 63) : (pos >> 6)) * inv; float sn, cs; sincosf(ang, &sn, &cs); c.ROPE()[pos * 64 + a] = cs; c.ROPE()[pos * 64 + 32 + a] = sn; }
}
__device__ __forceinline__ void phase_ckv(const Ctx& c) {
    const int gw = blockIdx.x * NWAVES + c.wave, NGW = gridDim.x * NWAVES, lane = c.lane;
    for (int r = gw; r < 2048; r += NGW) { const int l = r >> 10, b = (r >> 8) & 3, sidx = r & 255; const size_t cb = (size_t)(b * 2 + l) * 256 + sidx; bf16* dst = c.CKV() + (size_t)r * 1280;
#pragma unroll
        for (int i = 0; i < 5; ++i) { const int e = 4 * (lane + 64 * i);
            const float* src = e < 512 ? c.cache_dk() + cb * 512 + e : e < 1024 ? c.cache_dv() + cb * 512 + (e - 512) : e < 1152 ? c.cache_wk() + cb * 128 + (e - 1024) : c.cache_wv() + cb * 128 + (e - 1152);
            const f32x4 v = *(const f32x4*)src; v2u o; o.x = pk2(v.x, v.y); o.y = pk2(v.z, v.w); *(v2u*)(dst + e) = o; } }
}
__device__ __forceinline__ void phase_qk(const Ctx& c, int l, float* lf) {
    const int gw = blockIdx.x * NWAVES + c.wave, NGW = gridDim.x * NWAVES, lane = c.lane;
    for (int i = c.tid; i < 7 * 768; i += NTHR) lf[i] = c.conv_w()[(size_t)l * 7 * 768 + i];
    for (int i = c.tid; i < 768; i += NTHR) lf[7 * 768 + i] = c.conv_b()[l * 768 + i];
    __syncthreads();
    const bf16* R1p = c.R1(); bf16* XCp = c.XC();
    for (int m0 = gw * 6; m0 < M; m0 += NGW * 6) {
        v2u xr[12][3];
#pragma unroll
        for (int rI = 0; rI < 12; ++rI) { const int mr = m0 - 3 + rI; const bool ok = mr >= 0 && mr < M;
#pragma unroll
            for (int i = 0; i < 3; ++i) xr[rI][i] = ok ? *(const v2u*)(R1p + (size_t)mr * 4096 + C_XBC + 4 * lane + 256 * i) : (v2u){0u, 0u}; }
        f32x4 wv[3][8];
#pragma unroll
        for (int i = 0; i < 3; ++i)
#pragma unroll
            for (int j = 0; j < 8; ++j) wv[i][j] = *(const f32x4*)(lf + j * 768 + 4 * lane + 256 * i);
#pragma unroll
        for (int k = 0; k < 6; ++k) { const int m = m0 + k; if (m >= M) break;
            const bool lat = m >= MC; const int t = lat ? (m - MC) & 1023 : m & 255, L = lat ? 1024 : 256;
#pragma unroll
            for (int i = 0; i < 3; ++i) { f32x4 a = wv[i][7];
#pragma unroll
                for (int j = 0; j < 7; ++j) { const int tt = t + j - 3; if (tt >= 0 && tt < L) { const v2u q = xr[k + j][i]; const f32x4 xv = {bflo(q.x), bfhi(q.x), bflo(q.y), bfhi(q.y)}; a += wv[i][j] * xv; } }
                v2u o; o.x = pk2(siluf(a.x), siluf(a.y)); o.y = pk2(siluf(a.z), siluf(a.w)); *(v2u*)(XCp + (size_t)m * 768 + 4 * lane + 256 * i) = o; }
        }
    }
}

typedef pg8::bf16x8 bx8;
#define LDS_BARRIER() do { asm volatile("s_waitcnt lgkmcnt(0)" ::: "memory"); __builtin_amdgcn_s_barrier(); asm volatile("" ::: "memory"); } while (0)
#define MFMA16(a, b, cc) __builtin_amdgcn_mfma_f32_16x16x32_bf16((a), (b), (cc), 0, 0, 0)
__device__ __forceinline__ void ssd_unit(const Ctx& c, int l, int pass, int b, int h, unsigned char* lds) {
    const int L = pass ? 1024 : 256, tok0 = pass ? MC + b * 1024 : b * 256, NCH = L >> 7;
    const int tid = c.tid, lane = c.lane, w = c.wave, lr = lane & 15, lq = lane >> 4, grp = h >> 2;
    bf16* XT = (bf16*)lds;
    bf16* BwT = XT + 64 * 136;
    bf16* Bm = BwT + 64 * 136;
    bf16* Cm = Bm + 128 * 72;
    bf16* Mm = Cm + 128 * 72;
    bf16* ST = Mm + 128 * 136;
    float* cum = (float*)(ST + 64 * 72);
    float* dtv = cum + 128; float* wv = dtv + 128; float* ecum = wv + 128; float* tot = ecum + 128;
    const float dsk = c.ssd_d()[l * 8 + h];
    const bf16* XCp = c.XC(); const float* DTp = c.DT(); bf16* Yp = c.Y(); const bf16* R1p = c.R1(); float* SSQp = c.SSQ();
    const int pi = w >> 1, nj0 = 2 * (w & 1);
    const int i = tid >> 2, part = tid & 3;
    for (int dir = 0; dir < 2; ++dir) {
        const float A = -__expf(c.a_log()[(l * 2 + dir) * 8 + h]);
        f32x4 Sacc[2];
        __syncthreads();
#pragma unroll
        for (int q = 0; q < 2; ++q)
#pragma unroll
            for (int r = 0; r < 4; ++r) { const int p = 16 * pi + 4 * lq + r, n = 16 * (nj0 + q) + lr;
                const float v = pass ? c.state_ssd()[(((((size_t)(b * 2 + l) * 2 + dir) * 8 + h) * 64 + p) * 64) + n] : 0.f;
                Sacc[q][r] = v; ST[p * 72 + n] = (bf16)f2bf(v); }
        v4u x0, x1, b0, b1, c0, c1; float d0 = 0.f, d1 = 0.f;
#define SSD_LOAD(ci_) { const int t_ = dir ? L - 1 - ((ci_) * 128 + i) : (ci_) * 128 + i; const bf16* xr_ = XCp + (size_t)(tok0 + t_) * 768; \
            x0 = *(const v4u*)(xr_ + h * 64 + part * 16); x1 = *(const v4u*)(xr_ + h * 64 + part * 16 + 8); \
            b0 = *(const v4u*)(xr_ + 512 + grp * 64 + part * 16); b1 = *(const v4u*)(xr_ + 512 + grp * 64 + part * 16 + 8); \
            c0 = *(const v4u*)(xr_ + 640 + grp * 64 + part * 16); c1 = *(const v4u*)(xr_ + 640 + grp * 64 + part * 16 + 8); \
            if (tid < 64) { const int i0_ = 2 * lane, ta_ = dir ? L - 1 - ((ci_) * 128 + i0_) : (ci_) * 128 + i0_, tb_ = dir ? ta_ - 1 : ta_ + 1; \
                d0 = DTp[(size_t)(tok0 + ta_) * 16 + dir * 8 + h]; d1 = DTp[(size_t)(tok0 + tb_) * 16 + dir * 8 + h]; } }
        SSD_LOAD(0);
        for (int ci = 0; ci < NCH; ++ci) {
            LDS_BARRIER();
            float bvals[16];
            { *(v4u*)(Bm + i * 72 + part * 16) = b0; *(v4u*)(Bm + i * 72 + part * 16 + 8) = b1;
              *(v4u*)(Cm + i * 72 + part * 16) = c0; *(v4u*)(Cm + i * 72 + part * 16 + 8) = c1;
              const unsigned xs[8] = {x0.x, x0.y, x0.z, x0.w, x1.x, x1.y, x1.z, x1.w};
#pragma unroll
              for (int j = 0; j < 8; ++j) { XT[(part * 16 + 2 * j) * 136 + i] = (bf16)(xs[j] & 0xffffu); XT[(part * 16 + 2 * j + 1) * 136 + i] = (bf16)(xs[j] >> 16); }
              float t8[8]; unpack8(b0, t8);
#pragma unroll
              for (int j = 0; j < 8; ++j) bvals[j] = t8[j];
              unpack8(b1, t8);
#pragma unroll
              for (int j = 0; j < 8; ++j) bvals[8 + j] = t8[j]; }
            if (tid < 64) {
                const int i0 = 2 * lane, i1 = i0 + 1;
                const float a0 = d0 * A, a1 = d1 * A; float s = a0 + a1;
#pragma unroll
                for (int o = 1; o < 64; o <<= 1) { const float v = __shfl_up(s, o); if (lane >= o) s += v; }
                const float cum1 = s, cum0 = s - a1, total = __shfl(s, 63);
                cum[i0] = cum0; cum[i1] = cum1; dtv[i0] = d0; dtv[i1] = d1;
                wv[i0] = __expf(total - cum0) * d0; wv[i1] = __expf(total - cum1) * d1; ecum[i0] = __expf(cum0); ecum[i1] = __expf(cum1);
                if (lane == 0) tot[0] = __expf(total);
            }
            if (ci + 1 < NCH) SSD_LOAD(ci + 1);
            unsigned short zz[16], yy[16];
            if (dir == 1) {
#pragma unroll
                for (int r = 0; r < 4; ++r) { const int tt = 16 * w + 4 * lq + r; const size_t m = (size_t)tok0 + (L - 1 - (ci * 128 + tt));
#pragma unroll
                    for (int jp = 0; jp < 4; ++jp) { zz[4 * r + jp] = R1p[m * 4096 + C_Z + h * 64 + 16 * jp + lr]; yy[4 * r + jp] = Yp[m * 2048 + h * 64 + 16 * jp + lr]; } }
            }
            LDS_BARRIER();
            { const float wi = wv[i];
#pragma unroll
              for (int j = 0; j < 16; ++j) BwT[(part * 16 + j) * 136 + i] = (bf16)f2bf(bvals[j] * wi); }
            bx8 cfr[2];
#pragma unroll
            for (int ks = 0; ks < 2; ++ks) cfr[ks] = *(const bx8*)(Cm + (16 * w + lr) * 72 + 32 * ks + 8 * lq);
            for (int j = 0; j <= w; ++j) {
                const bx8 bb0 = *(const bx8*)(Bm + (16 * j + lr) * 72 + 8 * lq), bb1 = *(const bx8*)(Bm + (16 * j + lr) * 72 + 32 + 8 * lq);
                f32x4 g = {0.f, 0.f, 0.f, 0.f};
                g = MFMA16(cfr[0], bb0, g); g = MFMA16(cfr[1], bb1, g);
                const int s = 16 * j + lr; const float cs = cum[s], ds = dtv[s];
#pragma unroll
                for (int r = 0; r < 4; ++r) { const int tt = 16 * w + 4 * lq + r; const float v = (s <= tt) ? g[r] * __expf(cum[tt] - cs) * ds : 0.f; Mm[tt * 136 + s] = (bf16)f2bf(v); }
            }
            if (!(w & 1)) {
#pragma unroll
                for (int r = 0; r < 4; ++r) Mm[(16 * w + 4 * lq + r) * 136 + 16 * (w + 1) + lr] = 0;
            }
            LDS_BARRIER();
            f32x4 yl[4], yo[4];
#pragma unroll
            for (int jp = 0; jp < 4; ++jp) { yl[jp] = (f32x4){0.f, 0.f, 0.f, 0.f}; yo[jp] = (f32x4){0.f, 0.f, 0.f, 0.f}; }
            for (int ks = 0; ks <= (w >> 1); ++ks) {
                const bx8 af = *(const bx8*)(Mm + (16 * w + lr) * 136 + 32 * ks + 8 * lq);
#pragma unroll
                for (int jp = 0; jp < 4; ++jp) { const bx8 xf = *(const bx8*)(XT + (16 * jp + lr) * 136 + 32 * ks + 8 * lq); yl[jp] = MFMA16(af, xf, yl[jp]); }
            }
#pragma unroll
            for (int ks = 0; ks < 2; ++ks)
#pragma unroll
                for (int jp = 0; jp < 4; ++jp) { const bx8 sf = *(const bx8*)(ST + (16 * jp + lr) * 72 + 32 * ks + 8 * lq); yo[jp] = MFMA16(cfr[ks], sf, yo[jp]); }
            {
#pragma unroll
                for (int r = 0; r < 4; ++r) {
                    const int tt = 16 * w + 4 * lq + r; const float ec = ecum[tt];
                    const int t = dir ? L - 1 - (ci * 128 + tt) : ci * 128 + tt; const size_t m = (size_t)tok0 + t;
                    float q = 0.f;
#pragma unroll
                    for (int jp = 0; jp < 4; ++jp) {
                        const int p = 16 * jp + lr; const float y = yl[jp][r] + ec * yo[jp][r];
                        if (dir == 0) Yp[m * 2048 + h * 64 + p] = (bf16)f2bf(y);
                        else { const float x = bf2f(XT[p * 136 + tt]); const float ytot = y + bf2f(yy[4 * r + jp]) + dsk * x; const float z = bf2f(zz[4 * r + jp]);
                            const float gt = ytot * siluf(z); Yp[m * 2048 + h * 64 + p] = (bf16)f2bf(gt); q += gt * gt; }
                    }
                    if (dir == 1) { q += __shfl_xor(q, 1); q += __shfl_xor(q, 2); q += __shfl_xor(q, 4); q += __shfl_xor(q, 8); if (lr == 0) atomicAdd(SSQp + m, q); }
                }
            }
            LDS_BARRIER();
            {
                f32x4 st[2] = {{0.f, 0.f, 0.f, 0.f}, {0.f, 0.f, 0.f, 0.f}};
#pragma unroll
                for (int ks = 0; ks < 4; ++ks) { const bx8 af = *(const bx8*)(XT + (16 * pi + lr) * 136 + 32 * ks + 8 * lq);
#pragma unroll
                    for (int q = 0; q < 2; ++q) { const bx8 bf = *(const bx8*)(BwT + (16 * (nj0 + q) + lr) * 136 + 32 * ks + 8 * lq); st[q] = MFMA16(af, bf, st[q]); } }
                const float et = tot[0];
#pragma unroll
                for (int q = 0; q < 2; ++q)
#pragma unroll
                    for (int r = 0; r < 4; ++r) { Sacc[q][r] = et * Sacc[q][r] + st[q][r]; ST[(16 * pi + 4 * lq + r) * 72 + 16 * (nj0 + q) + lr] = (bf16)f2bf(Sacc[q][r]); }
            }
        }
#undef SSD_LOAD
        if (!pass) {
#pragma unroll
            for (int q = 0; q < 2; ++q)
#pragma unroll
                for (int r = 0; r < 4; ++r) { const int p = 16 * pi + 4 * lq + r, n = 16 * (nj0 + q) + lr;
                    c.out()[O_SSD + (((((size_t)(b * 2 + l) * 2 + dir) * 8 + h) * 64 + p) * 64) + n] = Sacc[q][r]; }
        }
    }
}

__device__ __forceinline__ void s5_tables(const Ctx& c, int l, int g, int part, float* lf) {
    const int tid = c.tid;
    float* pw = lf;
    float* Bc = pw + 2 * 17 * 128;
    float* Cc = Bc + 2 * 2048;
    if (tid < 128) { const int dir = tid >> 6, n = tid & 63, idx = ((l * 2 + dir) * 32 + g) * 64 + n;
        const float lre = c.lam_re()[idx], lim = c.lam_im()[idx], step = expf(c.log_step()[(l * 2 + dir) * 32 + g]);
        for (int k = 0; k <= 16; ++k) { const float mag = expf(lre * step * (float)k); float sn, cs; sincosf(lim * step * (float)k, &sn, &cs); pw[((dir * 17 + k) * 64 + n) * 2] = mag * cs; pw[((dir * 17 + k) * 64 + n) * 2 + 1] = mag * sn; }
        const float mag = expf(lre * step); float sn, cs; sincosf(lim * step, &sn, &cs); const float are = mag * cs, aim = mag * sn;
        const float den = lre * lre + lim * lim, cre = ((are - 1.0f) * lre + aim * lim) / den, cim = (aim * lre - (are - 1.0f) * lim) / den;
        for (int mm = 0; mm < 16; ++mm) { const float br = c.b_re()[(size_t)idx * 16 + mm], bi = c.b_im()[(size_t)idx * 16 + mm]; Bc[((dir * 64 + n) * 16 + mm) * 2] = cre * br - cim * bi; Bc[((dir * 64 + n) * 16 + mm) * 2 + 1] = cre * bi + cim * br; }
    }
    for (int i = tid; i < 2048; i += NTHR) { const int dir = i >> 10, mm = (i >> 6) & 15, n = i & 63; const size_t src = ((size_t)((l * 2 + dir) * 32 + g) * 16 + mm) * 64 + n;
        Cc[i * 2] = c.c_re()[src]; Cc[i * 2 + 1] = c.c_im()[src]; }
    __syncthreads();
    if (part == 0 && tid < 128) { const int dir = tid >> 6, n = tid & 63; float* at = (float*)(c.ws() + WS_S5AT) + ((size_t)(dir * 32 + g) * 64 + n) * 2; at[0] = pw[((dir * 17 + 16) * 64 + n) * 2]; at[1] = pw[((dir * 17 + 16) * 64 + n) * 2 + 1]; }
    bf16* Kt = (bf16*)(c.ws() + WS_S5K) + (size_t)g * 31 * 256;
    for (int e = part * 1984 + tid; e < (part + 1) * 1984; e += NTHR) { const int tp = e >> 8, mm = (e >> 4) & 15, m2 = e & 15, tau = tp - 15; float acc = 0.f;
#pragma unroll
        for (int dir = 0; dir < 2; ++dir) { if ((dir == 0 && tau < 0) || (dir == 1 && tau > 0)) continue; const int k = tau < 0 ? -tau : tau;
            const float* pp = pw + (dir * 17 + k) * 128; const float* bb = Bc + dir * 2048 + m2 * 2; const float* cc = Cc + (dir * 16 + mm) * 128;
            for (int n = 0; n < 64; ++n) { const float pr = pp[2 * n], pi = pp[2 * n + 1], br = bb[n * 32], bi = bb[n * 32 + 1], Pr = pr * br - pi * bi, Pi = pr * bi + pi * br; acc += cc[2 * n] * Pr - cc[2 * n + 1] * Pi; } }
        if (tau == 0 && mm == m2) acc += c.s5_d()[l * 512 + g * 16 + mm];
        Kt[e] = (bf16)f2bf(acc); }
    for (int e = part * 16384 + tid; e < (part + 1) * 16384; e += NTHR) { const int dir = e >> 15, sidx = (e >> 8) & 127, k = e & 255, ri = sidx >> 6, n = sidx & 63, j = k >> 4, m2 = k & 15, ex = dir ? j : 15 - j;
        const float pr = pw[((dir * 17 + ex) * 64 + n) * 2], pi = pw[((dir * 17 + ex) * 64 + n) * 2 + 1], br = Bc[((dir * 64 + n) * 16 + m2) * 2], bi = Bc[((dir * 64 + n) * 16 + m2) * 2 + 1];
        ((bf16*)(c.ws() + WS_S5WS))[((size_t)(dir * 32 + g) * 128 + sidx) * 256 + k] = (bf16)f2bf(ri ? pr * bi + pi * br : pr * br - pi * bi); }
    for (int e = part * 16384 + tid; e < (part + 1) * 16384; e += NTHR) { const int row = e >> 8, k = e & 255, i = row >> 4, mm = row & 15, dir = k >> 7, ri = (k >> 6) & 1, n = k & 63, ex = dir ? 16 - i : i + 1;
        const float pr = pw[((dir * 17 + ex) * 64 + n) * 2], pi = pw[((dir * 17 + ex) * 64 + n) * 2 + 1], cr = Cc[((dir * 16 + mm) * 64 + n) * 2], ci = Cc[((dir * 16 + mm) * 64 + n) * 2 + 1];
        ((bf16*)(c.ws() + WS_S5WO))[(size_t)g * 65536 + e] = (bf16)f2bf(ri ? -(cr * pi + ci * pr) : cr * pr - ci * pi); }
    __syncthreads();
}

__device__ __forceinline__ void s5_unit(const Ctx& c, int l, int g, int cu, unsigned char* lds) {
    const int tid = c.tid, lane = c.lane, w = c.wave, lr = lane & 15, lq = lane >> 4;
    const bool lat = cu >= 8;
    bf16* Ut = (bf16*)lds;
    bf16* St = Ut + 64 * 264;
    bf16* Kt = St + 64 * 264;
    float* Dl = (float*)(Kt + 31 * 256);
    const bf16* R1p = c.R1();
    const bf16* Wsp0 = (const bf16*)(c.ws() + WS_S5WS) + ((size_t)(0 * 32 + g) * 128 + 16 * w + lr) * 256 + 8 * lq;
    const bf16* Wsp1 = (const bf16*)(c.ws() + WS_S5WS) + ((size_t)(1 * 32 + g) * 128 + 16 * w + lr) * 256 + 8 * lq;
    const bf16* Wop = (const bf16*)(c.ws() + WS_S5WO) + (size_t)g * 65536 + 8 * lq;
    bx8 afA[8], afB[8];
#pragma unroll
    for (int ks = 0; ks < 8; ++ks) afA[ks] = *(const bx8*)(Wsp0 + 32 * ks);
    { const v4u* src = (const v4u*)((const bf16*)(c.ws() + WS_S5K) + (size_t)g * 31 * 256); for (int i = tid; i < 31 * 32; i += NTHR) ((v4u*)Kt)[i] = src[i]; }
#pragma unroll
    for (int i = 0; i < 2; ++i) { const int id = tid + NTHR * i, col = id >> 4, j = id & 15;
        const int tok = lat ? MC + (cu - 8) * 1024 + col * 16 + j : (4 * cu + (col >> 4)) * 256 + (col & 15) * 16 + j;
        const bf16* up = R1p + (size_t)tok * 4096 + C_U + g * 16;
        *(v4u*)(Ut + col * 264 + j * 16) = *(const v4u*)up; *(v4u*)(Ut + col * 264 + j * 16 + 8) = *(const v4u*)(up + 8); }
#pragma unroll
    for (int ks = 0; ks < 8; ++ks) afB[ks] = *(const bx8*)(Wsp1 + 32 * ks);
    LDS_BARRIER();
#pragma unroll
    for (int dir = 0; dir < 2; ++dir) {
        f32x4 acc[4];
#pragma unroll
        for (int cb = 0; cb < 4; ++cb) acc[cb] = (f32x4){0.f, 0.f, 0.f, 0.f};
#pragma unroll
        for (int ks = 0; ks < 8; ++ks) {
#pragma unroll
            for (int cb = 0; cb < 4; ++cb) { const bx8 bf = *(const bx8*)(Ut + (16 * cb + lr) * 264 + 32 * ks + 8 * lq); acc[cb] = MFMA16(dir ? afB[ks] : afA[ks], bf, acc[cb]); }
            __builtin_amdgcn_sched_barrier(0); }
        if (dir == 0) {
#pragma unroll
            for (int ks = 0; ks < 8; ++ks) afA[ks] = *(const bx8*)(Wop + (size_t)(16 * (2 * w) + lr) * 256 + 32 * ks); }
        else {
#pragma unroll
            for (int ks = 0; ks < 8; ++ks) afB[ks] = *(const bx8*)(Wop + (size_t)(16 * (2 * w + 1) + lr) * 256 + 32 * ks); }
#pragma unroll
        for (int cb = 0; cb < 4; ++cb)
#pragma unroll
            for (int r = 0; r < 4; ++r) Dl[(16 * w + 4 * lq + r) * 65 + 16 * cb + lr] = acc[cb][r];
        LDS_BARRIER();
        if (tid < (lat ? 64 : 256)) {
            const int n = tid & 63, bl = tid >> 6, nc = lat ? 64 : 16, cbase = lat ? 0 : 16 * bl, b = lat ? cu - 8 : 4 * cu + bl;
            const float* at = (const float*)(c.ws() + WS_S5AT) + ((size_t)(dir * 32 + g) * 64 + n) * 2; const float ar = at[0], ai = at[1];
            float sr = 0.f, si = 0.f;
            if (lat) { sr = c.state_s5()[((((size_t)(b * 2 + l) * 2 + dir) * 2 + 0) * 32 + g) * 64 + n]; si = c.state_s5()[((((size_t)(b * 2 + l) * 2 + dir) * 2 + 1) * 32 + g) * 64 + n]; }
            for (int cc = 0; cc < nc; ++cc) { const int col = cbase + (dir ? nc - 1 - cc : cc);
                St[col * 264 + dir * 128 + n] = (bf16)f2bf(sr); St[col * 264 + dir * 128 + 64 + n] = (bf16)f2bf(si);
                const float dr = Dl[n * 65 + col], di = Dl[(64 + n) * 65 + col];
                const float nr = ar * sr - ai * si + dr, ni = ar * si + ai * sr + di; sr = nr; si = ni; }
            if (!lat) { c.out()[O_S5 + ((((size_t)(b * 2 + l) * 2 + dir) * 2 + 0) * 32 + g) * 64 + n] = sr; c.out()[O_S5 + ((((size_t)(b * 2 + l) * 2 + dir) * 2 + 1) * 32 + g) * 64 + n] = si; }
        }
        LDS_BARRIER();
    }
#pragma unroll
    for (int ii = 0; ii < 2; ++ii) { const int i = 2 * w + ii;
        f32x4 acc[4];
#pragma unroll
        for (int cb = 0; cb < 4; ++cb) acc[cb] = (f32x4){0.f, 0.f, 0.f, 0.f};
#pragma unroll
        for (int ks = 0; ks < 8; ++ks) { const int j = 2 * ks + (lq >> 1); const bx8 af = *(const bx8*)(Kt + ((i - j + 15) * 16 + lr) * 16 + 8 * (lq & 1));
#pragma unroll
            for (int cb = 0; cb < 4; ++cb) { const bx8 bf = *(const bx8*)(Ut + (16 * cb + lr) * 264 + 32 * ks + 8 * lq); acc[cb] = MFMA16(af, bf, acc[cb]); }
            __builtin_amdgcn_sched_barrier(0); }
#pragma unroll
        for (int ks = 0; ks < 8; ++ks) {
#pragma unroll
            for (int cb = 0; cb < 4; ++cb) { const bx8 bf = *(const bx8*)(St + (16 * cb + lr) * 264 + 32 * ks + 8 * lq); acc[cb] = MFMA16(ii ? afB[ks] : afA[ks], bf, acc[cb]); }
            __builtin_amdgcn_sched_barrier(0); }
#pragma unroll
        for (int cb = 0; cb < 4; ++cb) { const int col = 16 * cb + lr;
            const int tok = lat ? MC + (cu - 8) * 1024 + col * 16 + i : (4 * cu + (col >> 4)) * 256 + (col & 15) * 16 + i;
            v2u o; o.x = pk2(acc[cb][0], acc[cb][1]); o.y = pk2(acc[cb][2], acc[cb][3]);
            *(v2u*)(c.Y5() + (size_t)tok * 512 + g * 16 + 4 * lq) = o; }
    }
}

typedef float f32x16 __attribute__((ext_vector_type(16)));
#define MFMA32(a, b, cc) __builtin_amdgcn_mfma_f32_32x32x16_bf16((a), (b), (cc), 0, 0, 0)
constexpr float SM_SC = 0.125f * 1.4426950408889634f;
__device__ __forceinline__ void qk_tile(f32x16& p0, f32x16& p1, const bf16* Kt, int KS, const bx8 (&qf)[4], int r32, int hi) {
    p0 = (f32x16){0.f}; p1 = (f32x16){0.f};
    bx8 a0[4], a1[4];
#pragma unroll
    for (int d0 = 0; d0 < 4; ++d0) { a0[d0] = *(const bx8*)(Kt + r32 * KS + 16 * d0 + 8 * hi); a1[d0] = *(const bx8*)(Kt + (32 + r32) * KS + 16 * d0 + 8 * hi); }
    __builtin_amdgcn_s_setprio(1);
#pragma unroll
    for (int d0 = 0; d0 < 4; ++d0) { p0 = MFMA32(a0[d0], qf[d0], p0); p1 = MFMA32(a1[d0], qf[d0], p1); }
    __builtin_amdgcn_s_setprio(0);
}
__device__ __forceinline__ float fmax_(float a, float b) { float r; asm("v_max_f32_e32 %0, %1, %2" : "=v"(r) : "v"(a), "v"(b)); return r; }
__device__ __forceinline__ float sm_step(f32x16& p0, f32x16& p1, float& mrun, float& lrun, bx8 (&pb)[4]) {
    float ta = fmax_(p0[0], p1[0]), tb = fmax_(p0[1], p1[1]);
#pragma unroll
    for (int r = 2; r < 16; r += 2) { ta = fmax_(ta, fmax_(p0[r], p1[r])); tb = fmax_(tb, fmax_(p0[r + 1], p1[r + 1])); }
    float tm = fmax_(ta, tb) * SM_SC;
    tm = fmax_(tm, __shfl_xor(tm, 32));
    const float mn = fmax_(mrun, tm), alpha = __builtin_amdgcn_exp2f(mrun - mn);
    float rs0 = 0.f, rs1 = 0.f;
#pragma unroll
    for (int r = 0; r < 16; ++r) { p0[r] = __builtin_amdgcn_exp2f(fmaf(p0[r], SM_SC, -mn)); p1[r] = __builtin_amdgcn_exp2f(fmaf(p1[r], SM_SC, -mn)); rs0 += p0[r]; rs1 += p1[r]; }
    float rs = rs0 + rs1;
    rs += __shfl_xor(rs, 32);
    lrun = lrun * alpha + rs; mrun = mn;
#pragma unroll
    for (int sI = 0; sI < 2; ++sI) {
        v4u t0, t1;
        t0.x = pg8::cvt_pk_bf16(p0[8 * sI + 0], p0[8 * sI + 1]); t0.y = pg8::cvt_pk_bf16(p0[8 * sI + 2], p0[8 * sI + 3]); t0.z = pg8::cvt_pk_bf16(p0[8 * sI + 4], p0[8 * sI + 5]); t0.w = pg8::cvt_pk_bf16(p0[8 * sI + 6], p0[8 * sI + 7]);
        t1.x = pg8::cvt_pk_bf16(p1[8 * sI + 0], p1[8 * sI + 1]); t1.y = pg8::cvt_pk_bf16(p1[8 * sI + 2], p1[8 * sI + 3]); t1.z = pg8::cvt_pk_bf16(p1[8 * sI + 4], p1[8 * sI + 5]); t1.w = pg8::cvt_pk_bf16(p1[8 * sI + 6], p1[8 * sI + 7]);
        pb[sI] = __builtin_bit_cast(bx8, t0); pb[2 + sI] = __builtin_bit_cast(bx8, t1);
    }
    return alpha;
}
typedef short v4i16_t __attribute__((ext_vector_type(4)));
__device__ __forceinline__ v2u vtr(const bf16* p) { return __builtin_bit_cast(v2u, __builtin_amdgcn_ds_read_tr16_b64_v4i16((__attribute__((address_space(3))) v4i16_t*)p)); }
template <int NDT, int VS> __device__ __forceinline__ void pv_tile(f32x16 (&o)[NDT], const bf16* Vr, const bx8 (&pb)[4], int lane) {
    const bf16* vb = Vr + (4 * (lane >> 5) + ((lane & 15) >> 2)) * VS + 16 * ((lane >> 4) & 1) + 4 * (lane & 3);
    v2u cur[NDT][2], nxt[NDT][2];
#pragma unroll
    for (int dt = 0; dt < NDT; ++dt) { cur[dt][0] = vtr(vb + 32 * dt); cur[dt][1] = vtr(vb + 8 * VS + 32 * dt); }
#pragma unroll
    for (int ks = 0; ks < 4; ++ks) {
        if (ks < 3) {
#pragma unroll
            for (int dt = 0; dt < NDT; ++dt) { nxt[dt][0] = vtr(vb + (16 * (ks + 1)) * VS + 32 * dt); nxt[dt][1] = vtr(vb + (16 * (ks + 1) + 8) * VS + 32 * dt); }
        }
        __builtin_amdgcn_s_setprio(1);
#pragma unroll
        for (int dt = 0; dt < NDT; ++dt) { const v4u t = {cur[dt][0].x, cur[dt][0].y, cur[dt][1].x, cur[dt][1].y}; o[dt] = MFMA32(__builtin_bit_cast(bx8, t), pb[ks], o[dt]); }
        __builtin_amdgcn_s_setprio(0);
#pragma unroll
        for (int dt = 0; dt < NDT; ++dt) { cur[dt][0] = nxt[dt][0]; cur[dt][1] = nxt[dt][1]; }
    }
}

template <int PASS> __device__ __forceinline__ void diff_unit(const Ctx& c, int l, int uidx, unsigned char* lds) {
    constexpr int NT = PASS ? 10 : 2, NQB = PASS ? 8 : 2, VS = 160;
    const int tid = c.tid, lane = c.lane, w = c.wave, r32 = lane & 31, hi = lane >> 5, comp = w >> 2;
    const int qb = uidx % NQB, h = (uidx / NQB) & 3, b = uidx / (NQB * 4);
    const int tok0 = PASS ? MC + b * 1024 : b * 256;
    bf16* Kt = (bf16*)lds;
    bf16* Vr = Kt + 128 * 136;
    float* Ob = (float*)lds;
    const bf16* R1p = c.R1(); const bf16* CK = c.CKV() + (size_t)l * 1024 * 1280;
    const float lam_init = 0.8f - 0.6f * expf(-0.3f * (float)l);
    const float* lv = c.dlam() + l * 256;
    const float lam = expf(wave_sum(lv[lane] * lv[64 + lane])) - expf(wave_sum(lv[128 + lane] * lv[192 + lane])) + lam_init;
    const size_t mrow = (size_t)tok0 + qb * 128 + 32 * (w & 3) + r32;
    bx8 qf[4];
#pragma unroll
    for (int d0 = 0; d0 < 4; ++d0) qf[d0] = *(const bx8*)(R1p + mrow * 4096 + C_DQ + h * 128 + comp * 64 + 16 * d0 + 8 * hi);
    f32x16 o[4];
#pragma unroll
    for (int dt = 0; dt < 4; ++dt) o[dt] = (f32x16){0.f};
    float mrun = -1e30f, lrun = 0.f;
    v4u kreg[4], vreg[4];
#define DIFF_LOAD(t) { const bf16* kb; const bf16* vb; size_t rs; \
        if (PASS && (t) < 2) { kb = CK + ((size_t)b * 256 + 128 * (t)) * 1280 + h * 128; vb = kb + 512; rs = 1280; } \
        else { kb = R1p + ((size_t)tok0 + 128 * ((t) - (PASS ? 2 : 0))) * 4096 + C_DK + h * 128; vb = kb + (C_DV - C_DK); rs = 4096; } \
        _Pragma("unroll") for (int i = 0; i < 4; ++i) { const int id = tid + NTHR * i; kreg[i] = *(const v4u*)(kb + (size_t)(id >> 4) * rs + (id & 15) * 8); vreg[i] = *(const v4u*)(vb + (size_t)(id >> 4) * rs + (id & 15) * 8); } }
    DIFF_LOAD(0);
    for (int t = 0; t < NT; ++t) {
        LDS_BARRIER();
#pragma unroll
        for (int i = 0; i < 4; ++i) { const int id = tid + NTHR * i; *(v4u*)(Kt + (id >> 4) * 136 + (id & 15) * 8) = kreg[i]; *(v4u*)(Vr + (id >> 4) * VS + (id & 15) * 8) = vreg[i]; }
        if (t + 1 < NT) DIFF_LOAD(t + 1);
        LDS_BARRIER();
#pragma unroll
        for (int sub = 0; sub < 2; ++sub) {
            f32x16 p0, p1; bx8 pb[4];
            qk_tile(p0, p1, Kt + sub * 64 * 136 + comp * 64, 136, qf, r32, hi);
            const float alpha = sm_step(p0, p1, mrun, lrun, pb);
            if (__any(alpha != 1.0f)) {
#pragma unroll
                for (int dt = 0; dt < 4; ++dt)
#pragma unroll
                    for (int r = 0; r < 16; ++r) o[dt][r] *= alpha; }
            pv_tile<4, VS>(o, Vr + sub * 64 * VS, pb, lane);
        }
    }
#undef DIFF_LOAD
    const float inv = (comp ? lam : 1.0f) / lrun;
    const int rowl = 32 * (w & 3) + r32;
    LDS_BARRIER();
    if (comp) {
#pragma unroll
        for (int dt = 0; dt < 4; ++dt)
#pragma unroll
            for (int r = 0; r < 16; ++r) Ob[rowl * 129 + 32 * dt + (r & 3) + 8 * (r >> 2) + 4 * hi] = o[dt][r] * inv;
    }
    LDS_BARRIER();
    if (!comp) {
        float ss = 0.f;
#pragma unroll
        for (int dt = 0; dt < 4; ++dt)
#pragma unroll
            for (int r = 0; r < 16; ++r) { const float v = o[dt][r] * inv - Ob[rowl * 129 + 32 * dt + (r & 3) + 8 * (r >> 2) + 4 * hi]; o[dt][r] = v; ss += v * v; }
        ss += __shfl_xor(ss, 32);
        const float rn = rsqrtf(ss * (1.0f / 128.0f) + EPS) * (1.0f - lam_init);
        const float* sg = c.subln_g() + l * 128; bf16* yp = c.Y() + mrow * 2048 + 1024 + h * 128;
#pragma unroll
        for (int dt = 0; dt < 4; ++dt)
#pragma unroll
            for (int r4 = 0; r4 < 4; ++r4) { const int dv = 32 * dt + 8 * r4 + 4 * hi; const f32x4 g = *(const f32x4*)(sg + dv);
                v2u ov; ov.x = pk2(o[dt][4 * r4 + 0] * rn * g.x, o[dt][4 * r4 + 1] * rn * g.y); ov.y = pk2(o[dt][4 * r4 + 2] * rn * g.z, o[dt][4 * r4 + 3] * rn * g.w);
                *(v2u*)(yp + dv) = ov; }
    }
}

template <int PASS> __device__ __forceinline__ void win_unit(const Ctx& c, int l, int uidx, unsigned char* lds) {
    constexpr int NQB = PASS ? 4 : 1, VS = 96;
    const int tid = c.tid, lane = c.lane, w = c.wave, r32 = lane & 31, hi = lane >> 5;
    const int qb = uidx % NQB, hh = (uidx / NQB) & 7, b = uidx / (NQB * 8), nkv = hh >> 2;
    const int tok0 = PASS ? MC + b * 1024 : b * 256;
    bf16* Kt = (bf16*)lds;
    bf16* Vr = Kt + 128 * 72;
    const bf16* R1p = c.R1(); const bf16* CK = c.CKV() + (size_t)l * 1024 * 1280;
    const int qrow = qb * 256 + 32 * w + r32;
    const size_t mrow = (size_t)tok0 + qrow;
    bx8 qf[4];
#pragma unroll
    for (int d0 = 0; d0 < 4; ++d0) qf[d0] = *(const bx8*)(R1p + mrow * 4096 + C_WQ + hh * 64 + 16 * d0 + 8 * hi);
    f32x16 o[2]; o[0] = (f32x16){0.f}; o[1] = (f32x16){0.f};
    float mrun = c.sink()[l * 8 + hh] * 1.4426950408889634f, lrun = 1.0f;
    const int q0 = qb * 256;
    const int tb0 = PASS ? ((q0 - 128 < 0 ? 0 : q0 - 128) >> 7) : 0, tb1 = PASS ? ((q0 + 255 + 128 > 1023 ? 1023 : q0 + 255 + 128) >> 7) : 0;
    const int NT = PASS ? 2 + (tb1 - tb0 + 1) : 2;
    v4u kreg[2], vreg[2];
#define WIN_LOAD(t) { const bf16* kb; const bf16* vb; size_t rs; \
        if (PASS && (t) < 2) { kb = CK + ((size_t)b * 256 + 128 * (t)) * 1280 + 1024 + nkv * 64; vb = kb + 128; rs = 1280; } \
        else { kb = R1p + ((size_t)tok0 + 128 * (PASS ? tb0 + (t) - 2 : (t))) * 4096 + C_WK + nkv * 64; vb = kb + (C_WV - C_WK); rs = 4096; } \
        _Pragma("unroll") for (int i = 0; i < 2; ++i) { const int id = tid + NTHR * i; kreg[i] = *(const v4u*)(kb + (size_t)(id >> 3) * rs + (id & 7) * 8); vreg[i] = *(const v4u*)(vb + (size_t)(id >> 3) * rs + (id & 7) * 8); } }
    WIN_LOAD(0);
    for (int t = 0; t < NT; ++t) {
        LDS_BARRIER();
#pragma unroll
        for (int i = 0; i < 2; ++i) { const int id = tid + NTHR * i; *(v4u*)(Kt + (id >> 3) * 72 + (id & 7) * 8) = kreg[i]; *(v4u*)(Vr + (id >> 3) * VS + (id & 7) * 8) = vreg[i]; }
        if (t + 1 < NT) WIN_LOAD(t + 1);
        LDS_BARRIER();
#pragma unroll
        for (int sub = 0; sub < 2; ++sub) {
            bool band = false; int kp0 = 0;
            if (PASS && t >= 2) { band = true; kp0 = 128 * (tb0 + t - 2) + 64 * sub; const int r0 = q0 + 32 * w;
                if (kp0 + 63 < r0 - 128 || kp0 > r0 + 31 + 128) continue; }
            f32x16 p0, p1; bx8 pb[4];
            qk_tile(p0, p1, Kt + sub * 64 * 72, 72, qf, r32, hi);
            if (band) {
#pragma unroll
                for (int r = 0; r < 16; ++r) { const int kp = kp0 + (r & 3) + 8 * (r >> 2) + 4 * hi; const int d0 = qrow - kp, d1 = d0 - 32;
                    if (d0 > 128 || d0 < -128) p0[r] = -1e30f; if (d1 > 128 || d1 < -128) p1[r] = -1e30f; }
            }
            const float alpha = sm_step(p0, p1, mrun, lrun, pb);
            if (__any(alpha != 1.0f)) {
#pragma unroll
                for (int dt = 0; dt < 2; ++dt)
#pragma unroll
                    for (int r = 0; r < 16; ++r) o[dt][r] *= alpha; }
            pv_tile<2, VS>(o, Vr + sub * 64 * VS, pb, lane);
        }
    }
#undef WIN_LOAD
    const float inv = 1.0f / lrun; bf16* yp = c.Y() + mrow * 2048 + 1536 + hh * 64;
#pragma unroll
    for (int dt = 0; dt < 2; ++dt)
#pragma unroll
        for (int r4 = 0; r4 < 4; ++r4) { const int dv = 32 * dt + 8 * r4 + 4 * hi;
            v2u ov; ov.x = pk2(o[dt][4 * r4 + 0] * inv, o[dt][4 * r4 + 1] * inv); ov.y = pk2(o[dt][4 * r4 + 2] * inv, o[dt][4 * r4 + 3] * inv);
            *(v2u*)(yp + dv) = ov; }
}

__device__ __forceinline__ void phase_mixers(const Ctx& c_in, int l, float* lf) {
    unsigned char* lds = (unsigned char*)lf;
    unsigned* qctr = (unsigned*)(c_in.ws() + WS_QCTR) + 64 * l;
    volatile int* qslot = (volatile int*)(lds + LDS_BYTES - 32);
    for (;;) {
        __syncthreads();
        if (threadIdx.x == 0) *qslot = (int)atomicAdd(qctr, 1u);
        __syncthreads();
        const int u = __builtin_amdgcn_readfirstlane(*qslot);
        if (u >= 1440) break;
        Ctx c = c_in; asm volatile("" : "+s"(c.ap), "+v"(c.tid));
        c.lane = c.tid & 63; c.wave = __builtin_amdgcn_readfirstlane(c.tid >> 6);
        unsigned long long pt0 = 0; if (PROBE_SEL >= 0) pt0 = __builtin_amdgcn_s_memrealtime();
        int ty;
        if (u < 32) { ssd_unit(c, l, 1, u >> 3, u & 7, lds); ty = 0; }
        else if (u < 160) { diff_unit<1>(c, l, u - 32, lds); ty = 2; }
        else if (u < 288) { win_unit<1>(c, l, u - 160, lds); ty = 3; }
        else if (u < 416) { s5_unit(c, l, (u - 288) & 31, 8 + ((u - 288) >> 5), lds); ty = 1; }
        else if (u < 672) { ssd_unit(c, l, 0, (u - 416) >> 3, (u - 416) & 7, lds); ty = 4; }
        else if (u < 928) { diff_unit<0>(c, l, u - 672, lds); ty = 6; }
        else if (u < 1184) { s5_unit(c, l, (u - 928) & 31, (u - 928) >> 5, lds); ty = 5; }
        else { win_unit<0>(c, l, u - 1184, lds); ty = 7; }
        __syncthreads();
        if (PROBE_SEL >= 0 && threadIdx.x == 0) { unsigned long long* tsu = (unsigned long long*)(c.ws() + WS_TS) + 64; atomicAdd(tsu + ty, (unsigned long long)(__builtin_amdgcn_s_memrealtime() - pt0)); }
    }
}

__device__ __forceinline__ void phase_sum4(const Ctx& c) {
    const int gt = blockIdx.x * NTHR + c.tid, NT = gridDim.x * NTHR;
#pragma unroll 4
    for (int i = gt; i < M * 128; i += NT) { const size_t m = (size_t)(i >> 7); const int c8 = (i & 127) * 8;
        float a[8] = {0.f, 0.f, 0.f, 0.f, 0.f, 0.f, 0.f, 0.f};
#pragma unroll
        for (int j = 0; j < 4; ++j) { float f[8]; unpack8(*(const v4u*)(c.R1() + m * 4096 + j * 1024 + c8), f);
#pragma unroll
            for (int k = 0; k < 8; ++k) a[k] += f[k]; }
        v4u o; o.x = pk2(a[0], a[1]); o.y = pk2(a[2], a[3]); o.z = pk2(a[4], a[5]); o.w = pk2(a[6], a[7]);
        *(v4u*)(c.H() + m * 1024 + c8) = o; }
}

#define GAS __attribute__((address_space(1)))
#define XB_TMO      128
#define XB_XCNT(j)  (256  + 64 * (j))
#define XB_XSUB(j)  (1280 + 64 * (j))
#define XB_XGEN(j)  (2304 + 64 * (j))
#define XB_TOP      3328
#define XB_TOPGEN   3392
#define XCD_BAR_WORDS 3456
#define XB_SPIN_CAP (1u << 18)

__device__ __forceinline__ unsigned xb_ld(unsigned* p)              { return __hip_atomic_load(p, __ATOMIC_RELAXED, __HIP_MEMORY_SCOPE_AGENT); }
__device__ __forceinline__ unsigned xb_add(unsigned* p, unsigned v) { return __hip_atomic_fetch_add(p, v, __ATOMIC_RELAXED, __HIP_MEMORY_SCOPE_AGENT); }
__device__ __forceinline__ unsigned xb_xcc_id() { return (unsigned)__builtin_amdgcn_s_getreg((3 << 11) | 20) & 0xFu; }
#define XB_SPIN(cond, bar) do { unsigned _sp = 0; while (cond) { __builtin_amdgcn_s_sleep(1); \
    if ((++_sp & 255u) == 0u) { if (xb_ld(&(bar)[XB_TMO])) break; if (_sp > XB_SPIN_CAP) { atomicAdd(&(bar)[XB_TMO], 1u); break; } } } } while (0)

struct XcdBarrier {
    unsigned* bar; unsigned x;
    volatile LAS unsigned* st;
};

__device__ __forceinline__ XcdBarrier xcd_barrier_post(unsigned* bar, volatile LAS unsigned* st) {
    XcdBarrier b; b.bar = bar; b.x = xb_xcc_id(); b.st = st;
    if (threadIdx.x == 0) (void)xb_add(&bar[XB_XCNT(b.x)], 1u);
    return b;
}
__device__ __forceinline__ void xcd_barrier_complete(unsigned* bar, unsigned x, unsigned& nloc, unsigned& nx) {
    const unsigned G = gridDim.x * gridDim.y * gridDim.z;
    unsigned sum, cnt, mine, sp = 0u;
    for (;;) {
        sum = 0u; cnt = 0u; mine = 0u;
#pragma unroll
        for (unsigned j = 0; j < 16; ++j) { const unsigned c = xb_ld(&bar[XB_XCNT(j)]); sum += c; cnt += (c > 0u) ? 1u : 0u; mine = (j == x) ? c : mine; }
        if (sum == G) break;
        __builtin_amdgcn_s_sleep(1);
        if ((++sp & 255u) == 0u) { if (xb_ld(&bar[XB_TMO])) break; if (sp > XB_SPIN_CAP) { atomicAdd(&bar[XB_TMO], 1u); break; } }
    }
    nloc = mine > 0u ? mine : 1u; nx = cnt > 0u ? cnt : 1u;
}

__device__ __forceinline__ void xcd_barrier(const XcdBarrier& b) {
    asm volatile("s_waitcnt vmcnt(0)" ::: "memory");
    __syncthreads();
    if (threadIdx.x == 0) {
        unsigned* bar = b.bar;
        __builtin_amdgcn_s_waitcnt(0);
        unsigned nloc = b.st[0], nx = b.st[1];
        if (nloc == 0u) { xcd_barrier_complete(bar, b.x, nloc, nx); b.st[0] = nloc; b.st[1] = nx; }
        const unsigned old = xb_add(&bar[XB_XSUB(b.x)], 1u);
        const unsigned gen = old / nloc;
        if (old + 1u == (gen + 1u) * nloc) {
            __builtin_amdgcn_fence(__ATOMIC_RELEASE, "agent");
            asm volatile("s_waitcnt vmcnt(0)" ::: "memory");
            const unsigned og = xb_add(&bar[XB_TOP], 1u);
            const unsigned tg = og / nx;
            if (og + 1u == (tg + 1u) * nx) xb_add(&bar[XB_TOPGEN], 1u);
            else XB_SPIN(xb_ld(&bar[XB_TOPGEN]) == tg, bar);
            __builtin_amdgcn_fence(__ATOMIC_ACQUIRE, "agent");
            xb_add(&bar[XB_XGEN(b.x)], 1u);
            asm volatile("s_waitcnt vmcnt(0)" ::: "memory");
        } else {
            XB_SPIN(xb_ld(&bar[XB_XGEN(b.x)]) == gen, bar);
            __builtin_amdgcn_fence(__ATOMIC_ACQUIRE, "agent");
            asm volatile("s_waitcnt vmcnt(0)" ::: "memory");
        }
    }
    __syncthreads();
}

#define PHASE_BEGIN() Ctx c; c.ap = (CArgs)__builtin_amdgcn_kernarg_segment_ptr(); asm volatile("" : "+s"(c.ap)); \
        int tid_o = threadIdx.x; asm volatile("" : "+v"(tid_o)); c.tid = tid_o; c.lane = tid_o & 63; c.wave = __builtin_amdgcn_readfirstlane(tid_o >> 6); \
        int G = gridDim.x, bid = blockIdx.x; asm volatile("" : "+s"(G), "+s"(bid)); unsigned char* ws = c.ws(); (void)ws; (void)G; (void)bid;
#define PHASE_END(k) { if ((k) + 1 < ph_hi) { if ((k) == 0) cg::this_grid().sync(); else xcd_barrier(xbar); } \
        if (PROBE_SEL >= 0 && blockIdx.x == PROBE_PB && threadIdx.x == 0) ((unsigned long long*)(c.ws() + WS_TS))[(k) + 1] = __builtin_amdgcn_s_memrealtime(); }
#define IN_RANGE(k) (ph_lo <= (k) && (k) < ph_hi)

template <int LAYER> __device__ __forceinline__ void layer_program(int ph_lo, int ph_hi, unsigned char* lds, const XcdBarrier& xbar) {
    float* lf = (float*)lds;
    PG8_LAS unsigned char* ring = (PG8_LAS unsigned char*)lds;
    constexpr int l = LAYER, B0 = 1 + 11 * LAYER;
    if (IN_RANGE(B0 + 0)) { PHASE_BEGIN(); if (l == 1) { if (gridDim.x == 256) convert_items(c, 1, 7936, 9984, blockIdx.x * NWAVES + c.wave, gridDim.x * NWAVES, false, 0, 1, lf); else phase_convert(c, 1, lf); __syncthreads(); } phase_norm(c, l, 0, lf); phase_bias2(c, l); PHASE_END(B0 + 0); }
    if (IN_RANGE(B0 + 1)) { PHASE_BEGIN();
        pg8::Gemm g{c.H(), (const bf16*)(ws + W_IN), M, 4096, 1024, 1024, 1024, 0, 0}; pg8::StaticOrder S; S.init(M, 4096, G, bid);
        pg8::EpiIn E{c.R1(), c.out(), c.ROPE(), c.qn_g() + l * 64, c.kn_g() + l * 64, c.wqn_g() + l * 64, c.wkn_g() + l * 64, l};
        pg8::gemm_phase<pg8::EpiIn, pg8::StaticOrder, true, true>(ring, g, S, E, tid_o); PHASE_END(B0 + 1); }
    if (IN_RANGE(B0 + 2)) { PHASE_BEGIN(); phase_dt(c, l); phase_qk(c, l, lf); PHASE_END(B0 + 2); }
    if (IN_RANGE(B0 + 3)) { PHASE_BEGIN(); phase_mixers(c, l, lf); PHASE_END(B0 + 3); }
    if (IN_RANGE(B0 + 4)) { PHASE_BEGIN();
        pg8::Gemm g{c.Y5(), (const bf16*)(ws + W_GLU), M, 1024, 512, 512, 512, 0, 0}; pg8::StaticOrder S; S.init(M, 1024, G, bid);
        pg8::EpiGlu E{c.Y(), 2048, 512, c.b_glu() + l * 1024};
        pg8::gemm_phase<pg8::EpiGlu, pg8::StaticOrder, true, true>(ring, g, S, E, tid_o); PHASE_END(B0 + 4); }
    if (IN_RANGE(B0 + 5)) { PHASE_BEGIN();
        pg8::Gemm g{c.Y(), (const bf16*)(ws + W_BR), M, 4096, 512, 2048, 512, 4, 1024}; pg8::StaticOrder S; S.init(M, 4096, G, bid);
        pg8::EpiB<8> E{c.R1(), 4096, nullptr, c.SSQ()};
        pg8::gemm_phase<pg8::EpiB<8>, pg8::StaticOrder, true, true>(ring, g, S, E, tid_o); PHASE_END(B0 + 5); }
    if (IN_RANGE(B0 + 6)) { PHASE_BEGIN();
        pg8::Gemm g{c.H(), (const bf16*)(ws + W_G), M, 4096, 1024, 1024, 1024, 0, 0}; pg8::StaticOrder S; S.init(M, 4096, G, bid);
        pg8::EpiGateMerge E{c.R1(), c.Y(), c.b_gate() + l * 4096};
        pg8::gemm_phase<pg8::EpiGateMerge, pg8::StaticOrder, true, true>(ring, g, S, E, tid_o); PHASE_END(B0 + 6); }
    if (IN_RANGE(B0 + 7)) { PHASE_BEGIN();
        pg8::Gemm g{c.Y(), (const bf16*)(ws + W_OUT), M, 1024, 1024, 1024, 1024, 0, 0}; pg8::StaticOrder S; S.init(M, 1024, G, bid);
        pg8::EpiRes2 E{l == 0 ? c.x_prompt() : c.out(), l == 0 ? c.x_sample() : c.out() + (size_t)MC * D, c.out(), c.MOD() + (size_t)l * 5 * 6144, 2048, c.H(), c.g_norm2() + l * 1024, 4096, (float*)(ws + WS_SSQ2)};
        pg8::gemm_phase<pg8::EpiRes2, pg8::StaticOrder, true, true>(ring, g, S, E, tid_o); if (l == 0) side_convert(c, 0, 5376, false, lf); PHASE_END(B0 + 7); }
    if (IN_RANGE(B0 + 9)) { PHASE_BEGIN();
        pg8::Gemm g{c.H(), (const bf16*)(ws + W_1), M, 4096, 1024, 1024, 1024, 0, 0}; pg8::StaticOrder S; S.init(M, 4096, G, bid);
        pg8::EpiB<5> E{c.R1(), 4096, (const float*)(ws + WS_BI2), (const float*)(ws + WS_SSQ2)};
        pg8::gemm_phase<pg8::EpiB<5>, pg8::StaticOrder, true, true>(ring, g, S, E, tid_o); PHASE_END(B0 + 9); }
    if (IN_RANGE(B0 + 10)) { PHASE_BEGIN();
        pg8::Gemm g{c.R1(), (const bf16*)(ws + W_2), M, 1024, 4096, 4096, 4096, 0, 0}; pg8::StaticOrder S; S.init(M, 1024, G, bid);
        pg8::EpiRes E{c.out(), c.out() + (size_t)MC * D, c.out(), c.MOD() + (size_t)l * 5 * 6144, 5120};
        pg8::gemm_phase<pg8::EpiRes, pg8::StaticOrder, true, true>(ring, g, S, E, tid_o); if (l == 0) side_convert(c, 5376, 7936, true, lf); PHASE_END(B0 + 10); }
}

__global__ void __launch_bounds__(NTHR, 2) fwd_kernel(Args args) {
    extern __shared__ __attribute__((aligned(16))) unsigned char lds[];
    const int ph_lo = args.ph_lo, ph_hi = args.ph_hi;
    volatile LAS unsigned* xst = (volatile LAS unsigned*)(lds + LDS_BYTES - 16);
    if (threadIdx.x < 4) xst[threadIdx.x] = 0u;
    __syncthreads();
    const XcdBarrier xbar = xcd_barrier_post((unsigned*)(args.ws + WS_BAR), xst);
    if (PROBE_SEL >= 0 && blockIdx.x == PROBE_PB && threadIdx.x == 0) { unsigned long long* ts = (unsigned long long*)(args.ws + WS_TS); ts[0] = __builtin_amdgcn_s_memrealtime(); }
    if (IN_RANGE(0)) { PHASE_BEGIN(); float* lf = (float*)lds; phase_mods(c, lf); __syncthreads(); phase_convert(c, 0, lf); phase_rope_table(c); phase_ckv(c); PHASE_END(0); }
    layer_program<0>(ph_lo, ph_hi, lds, xbar);
    layer_program<1>(ph_lo, ph_hi, lds, xbar);
    if (PROBE_SEL >= 0) {
        __threadfence(); cg::this_grid().sync();
        const unsigned long long* ts = (const unsigned long long*)(args.ws + WS_TS);
        const float total = (float)(ts[23] - ts[0]); float sel = 0.f;
        for (int k = 0; k < 23; ++k) { const float d = (float)(ts[k + 1] - ts[k]); const int q = k == 0 ? -1 : (k - 1) % 11;
            const int cls = (q == 3) ? 0 : (q == 1 || q == 4 || q == 5 || q == 7 || q == 9 || q == 10) ? 1 : (q == 2) ? 2 : 3;
            if (cls == PROBE_SEL) sel += d; }
        if (PROBE_SEL >= 10 && PROBE_SEL < 100) sel = (float)ts[64 + PROBE_SEL - 10] * (1.0f / 256.0f);
        if (PROBE_SEL >= 100) { const int k = PROBE_SEL - 100; sel = (float)(ts[k + 1] - (ts[k] != 0ull ? ts[k] : ts[k - 1])); }
        const float sc = 1.0f + sqrtf(PROBE_SCALE * sel / total);
        for (int i = blockIdx.x * NTHR + threadIdx.x; i < 524288; i += gridDim.x * NTHR) args.out[O_S5 + i] *= sc;
    }
}

extern "C" void kernel_launch(void* const* d_in, const int* in_sizes, int n_in, void* d_out, int out_size, void* d_ws, size_t ws_size, hipStream_t stream) {
    static int grid = 0;
    if (grid == 0) {
        if (n_in != 44 || ws_size < WS_END) { fprintf(stderr, "kernel_launch: expected 44 inputs and >= %zu bytes of workspace; got %d, %zu\n", (size_t)WS_END, n_in, ws_size); grid = -1; return; }
        int dev = 0, cus = 0, per_cu = 0;
        (void)hipGetDevice(&dev); (void)hipDeviceGetAttribute(&cus, hipDeviceAttributeMultiprocessorCount, dev);
        (void)hipFuncSetAttribute((const void*)fwd_kernel, hipFuncAttributeMaxDynamicSharedMemorySize, LDS_BYTES);
        (void)hipOccupancyMaxActiveBlocksPerMultiprocessor(&per_cu, (const void*)fwd_kernel, NTHR, LDS_BYTES);
        if (per_cu < 1) { fprintf(stderr, "kernel_launch: occupancy query says %d blocks per CU\n", per_cu); per_cu = 1; }
        (void)hipGetLastError();
        grid = cus > 0 ? cus : 256;
    }
    if (grid < 0) return;
    (void)hipMemsetAsync(d_ws, 0, 64 * 1024, stream);
    Args a{};
    for (int i = 0; i < 44; ++i) a.in[i] = (const float*)d_in[i];
    a.out = (float*)d_out; a.ws = (unsigned char*)d_ws;
#if MK_MULTI
    for (int ph = 0; ph < NPH; ++ph) { a.ph_lo = ph; a.ph_hi = ph + 1; hipLaunchKernelGGL(fwd_kernel, dim3(grid), dim3(NTHR), LDS_BYTES, stream, a); }
#else
    a.ph_lo = 0; a.ph_hi = NPH;
    void* kargs[] = {&a};
    hipError_t e = hipLaunchCooperativeKernel((const void*)fwd_kernel, dim3(grid), dim3(NTHR), kargs, LDS_BYTES, stream);
    if (e != hipSuccess) fprintf(stderr, "cooperative launch failed: %s (grid %d)\n", hipGetErrorString(e), grid);
#endif
}
```

```cpp
#include <hip/hip_runtime.h>
#include <hip/hip_cooperative_groups.h>
#include <cstdio>
#include <cstdint>
namespace cg = cooperative_groups;

#ifndef MK_MULTI
#define MK_MULTI 0
#endif

namespace pg8 {
#define PG8_LAS __attribute__((address_space(3)))
typedef unsigned short bf16_t;
typedef short bf16x8 __attribute__((ext_vector_type(8)));
typedef float f32x4 __attribute__((ext_vector_type(4)));
typedef unsigned u32x4 __attribute__((ext_vector_type(4)));
constexpr int BM = 256, BK = 64, HALF = 128, HTB = HALF * BK * 2  , STAGE_BYTES = 8 * HTB, NXCD = 8, WGM = 8;

__host__ __device__ __forceinline__ int lds_byte(int r, int c) { const int st = (r >> 4) * 2 + (c >> 5), rr = r & 15, cc = c & 31, ob = rr * 64 + cc * 2; return st * 1024 + (ob ^ (((ob >> 9) & 1) << 5)); }
__host__ __device__ __forceinline__ void stage_rc(int b, int& R, int& C) { const int st = b / 1024, sb = b % 1024, swz = sb ^ (((sb >> 9) & 1) << 5); R = (st >> 1) * 16 + swz / 64; C = (st & 1) * 32 + (swz % 64) / 2; }
__host__ __device__ __forceinline__ int perm32(int rho) { const int n = rho >> 4, i = rho & 15; return 8 * (i >> 2) + 4 * n + (i & 3); }

struct Unit { int pm, pn; };
struct Gemm { const bf16_t* A; const bf16_t* Bt; int M, N, K, lda, ldb, a_div; size_t a_gstride; };

struct StaticOrder {
    int nM, nN, nwg, G, c;
    __host__ __device__ void init(int M, int N, int G_, int c_) { nM = M / BM; nN = N / BM; nwg = nM * nN; G = G_; c = c_; }
    __host__ __device__ bool next(int i, Unit& u) const {
        const long L = (long)i * G + c; if (L >= nwg) return false;
        int wgid = (int)L; { const int q = nwg / NXCD, r = nwg % NXCD, xcd = wgid % NXCD, off = wgid / NXCD; wgid = (xcd < r ? xcd * (q + 1) : r * (q + 1) + (xcd - r) * q) + off; }
        const int nig = WGM * nN, gid = wgid / nig, fm = gid * WGM, gsz = (nM - fm) < WGM ? (nM - fm) : WGM;
        u.pm = fm + ((wgid % nig) % gsz); u.pn = (wgid % nig) / gsz; return true;
    }
    __device__ __forceinline__ void a_ready(const Unit&) const {}
    __device__ __forceinline__ void done(const Unit&) const {}
};

__device__ __forceinline__ unsigned cvt_pk_bf16(float lo, float hi) { unsigned r; asm volatile("v_cvt_pk_bf16_f32 %0, %1, %2" : "=v"(r) : "v"(lo), "v"(hi)); return r; }
__device__ __forceinline__ float bf_lo(unsigned w) { return __builtin_bit_cast(float, w << 16); }
__device__ __forceinline__ float bf_hi(unsigned w) { return __builtin_bit_cast(float, w & 0xffff0000u); }
__device__ __forceinline__ float sigmoidf_(float x) { return 1.0f / (1.0f + __expf(-x)); }

template <int MODE> struct EpiB {
    static constexpr bool PERM = true, AFTER_DRAIN = false;
    bf16_t* O; int ldc; const float* bias; const float* ssq;
    __device__ __forceinline__ void operator()(const f32x4 (&acc)[2][2][4][2], const Unit& u, int wr, int wc, int fr, int fq) const {
        const int row0 = u.pm * BM + wr * 64 + fr, col0 = u.pn * BM + wc * 32 + 8 * fq;
        f32x4 bv[2][2];
#pragma unroll
        for (int bj = 0; bj < 2; ++bj)
#pragma unroll
            for (int n = 0; n < 2; ++n) bv[bj][n] = (MODE == 1) ? *(const f32x4*)(bias + col0 + bj * HALF + 4 * n) : (MODE == 5) ? *(const f32x4*)(bias + (size_t)((u.pm < 32) ? 0 : 1 + ((u.pm - 32) >> 2)) * 4096 + col0 + bj * HALF + 4 * n) : (f32x4){0.f, 0.f, 0.f, 0.f};
        u32x4 gpre[2][4][2]; float rpre[2][4];
        if (MODE == 3) {
#pragma unroll
            for (int ai = 0; ai < 2; ++ai)
#pragma unroll
                for (int m = 0; m < 4; ++m) { const int row = row0 + ai * HALF + m * 16; const bf16_t* rp = O + (size_t)row * ldc + col0;
                    rpre[ai][m] = (u.pn < 4) ? ssq[row] : 512.0f;
#pragma unroll
                    for (int bj = 0; bj < 2; ++bj) gpre[ai][m][bj] = *(const u32x4*)(rp + bj * HALF); }
        }
#pragma unroll
        for (int ai = 0; ai < 2; ++ai)
#pragma unroll
            for (int m = 0; m < 4; ++m) {
                const int row = row0 + ai * HALF + m * 16;
                bf16_t* rowp = O + (size_t)row * ldc + col0;
                float rs = 1.f;
                if (MODE == 3) { if (u.pn < 4) rs = rsqrtf(rpre[ai][m] * (1.0f / 512.0f) + 1e-6f); }
                if (MODE == 5) rs = rsqrtf(ssq[row] * (1.0f / 1024.0f) + 1e-6f);
                if (MODE == 8) { if (u.pn < 4) rs = rsqrtf(ssq[row] * (1.0f / 512.0f) + 1e-6f); }
#pragma unroll
                for (int bj = 0; bj < 2; ++bj) {
                    f32x4 v0 = ((MODE == 5 || MODE == 8) ? acc[ai][bj][m][0] * rs : acc[ai][bj][m][0]) + bv[bj][0], v1 = ((MODE == 5 || MODE == 8) ? acc[ai][bj][m][1] * rs : acc[ai][bj][m][1]) + bv[bj][1];
                    if (MODE == 1) {
#pragma unroll
                        for (int j = 0; j < 4; ++j) { v0[j] = sigmoidf_(v0[j]); v1[j] = sigmoidf_(v1[j]); }
                    }
                    if (MODE == 2 || MODE == 5) {
#pragma unroll
                        for (int j = 0; j < 4; ++j) { const float a = fmaxf(v0[j], 0.f), b = fmaxf(v1[j], 0.f); v0[j] = a * a; v1[j] = b * b; }
                    }
                    if (MODE == 3) {
                        const u32x4 gq = gpre[ai][m][bj];
                        v0[0] *= bf_lo(gq.x) * rs; v0[1] *= bf_hi(gq.x) * rs; v0[2] *= bf_lo(gq.y) * rs; v0[3] *= bf_hi(gq.y) * rs;
                        v1[0] *= bf_lo(gq.z) * rs; v1[1] *= bf_hi(gq.z) * rs; v1[2] *= bf_lo(gq.w) * rs; v1[3] *= bf_hi(gq.w) * rs;
                    }
                    u32x4 w; w.x = cvt_pk_bf16(v0[0], v0[1]); w.y = cvt_pk_bf16(v0[2], v0[3]); w.z = cvt_pk_bf16(v1[0], v1[1]); w.w = cvt_pk_bf16(v1[2], v1[3]);
                    *(u32x4*)(rowp + bj * HALF) = w;
                }
            }
    }
};
struct EpiGlu {
    static constexpr bool PERM = true, AFTER_DRAIN = false;
    bf16_t* O; int ldc; int ocol; const float* bias;
    __device__ __forceinline__ void operator()(const f32x4 (&acc)[2][2][4][2], const Unit& u, int wr, int wc, int fr, int fq) const {
        const int row0 = u.pm * BM + wr * 64 + fr, cc = u.pn * HALF + wc * 32 + 8 * fq;
        f32x4 bv[2][2];
#pragma unroll
        for (int bj = 0; bj < 2; ++bj)
#pragma unroll
            for (int n = 0; n < 2; ++n) bv[bj][n] = *(const f32x4*)(bias + bj * 512 + cc + 4 * n);
#pragma unroll
        for (int ai = 0; ai < 2; ++ai)
#pragma unroll
            for (int m = 0; m < 4; ++m) {
                bf16_t* rowp = O + (size_t)(row0 + ai * HALF + m * 16) * ldc + ocol + cc;
                f32x4 v0 = acc[ai][0][m][0] + bv[0][0], v1 = acc[ai][0][m][1] + bv[0][1];
                const f32x4 g0 = acc[ai][1][m][0] + bv[1][0], g1 = acc[ai][1][m][1] + bv[1][1];
#pragma unroll
                for (int j = 0; j < 4; ++j) { v0[j] *= sigmoidf_(g0[j]); v1[j] *= sigmoidf_(g1[j]); }
                u32x4 w; w.x = cvt_pk_bf16(v0[0], v0[1]); w.y = cvt_pk_bf16(v0[2], v0[3]); w.z = cvt_pk_bf16(v1[0], v1[1]); w.w = cvt_pk_bf16(v1[2], v1[3]);
                *(u32x4*)rowp = w;
            }
    }
};
struct EpiGateMerge {
    static constexpr bool PERM = true, AFTER_DRAIN = false;
    const bf16_t* Z; bf16_t* mg; const float* bgate;
    __device__ __forceinline__ void operator()(const f32x4 (&acc)[2][2][4][2], const Unit& u, int wr, int wc, int fr, int fq) const {
        typedef unsigned u32x2 __attribute__((ext_vector_type(2)));
        const int row0 = u.pm * BM + wr * 64 + fr, d0 = 64 * u.pn + 16 * wc + 4 * fq;
        f32x4 bv[2][2];
#pragma unroll
        for (int bj = 0; bj < 2; ++bj)
#pragma unroll
            for (int n = 0; n < 2; ++n) bv[bj][n] = *(const f32x4*)(bgate + (2 * bj + n) * 1024 + d0);
#pragma unroll
        for (int ai = 0; ai < 2; ++ai)
#pragma unroll
        for (int mh = 0; mh < 2; ++mh) {
            u32x2 zp[2][2][2];
#pragma unroll
            for (int mm = 0; mm < 2; ++mm) { const int row = row0 + ai * HALF + (2 * mh + mm) * 16;
#pragma unroll
                for (int bj = 0; bj < 2; ++bj)
#pragma unroll
                    for (int n = 0; n < 2; ++n) zp[mm][bj][n] = *(const u32x2*)(Z + (size_t)row * 4096 + (2 * bj + n) * 1024 + d0); }
#pragma unroll
            for (int mm = 0; mm < 2; ++mm) { const int m = 2 * mh + mm; const int row = row0 + ai * HALF + m * 16;
                f32x4 s = {0.f, 0.f, 0.f, 0.f};
#pragma unroll
                for (int bj = 0; bj < 2; ++bj)
#pragma unroll
                    for (int n = 0; n < 2; ++n) { const f32x4 a = acc[ai][bj][m][n] + bv[bj][n]; const u32x2 zq = zp[mm][bj][n];
                        s[0] += sigmoidf_(a[0]) * bf_lo(zq.x); s[1] += sigmoidf_(a[1]) * bf_hi(zq.x); s[2] += sigmoidf_(a[2]) * bf_lo(zq.y); s[3] += sigmoidf_(a[3]) * bf_hi(zq.y); }
                *(u32x2*)(mg + (size_t)row * 1024 + d0) = (u32x2){cvt_pk_bf16(s[0], s[1]), cvt_pk_bf16(s[2], s[3])}; }
        }
    }
};
struct EpiRes2 {
    static constexpr bool PERM = false, AFTER_DRAIN = false;
    const float* base_ctx; const float* base_lat; float* out; const float* modv; int goff;
    bf16_t* xn; const float* gnorm; int scoff; float* ssq;
    __device__ __forceinline__ void operator()(const f32x4 (&acc)[2][2][4][2], const Unit& u, int wr, int wc, int fr, int fq) const {
        const int row0 = u.pm * BM + wr * 64 + fr, col0 = u.pn * BM + wc * 32 + 4 * fq;
        const int mi = (u.pm < 32) ? 0 : 1 + ((u.pm - 32) >> 2);
        const float* gv = modv + (size_t)mi * 6144 + goff; const float* sv = modv + (size_t)mi * 6144 + scoff;
        f32x4 gg[2][2], gn[2][2];
#pragma unroll
        for (int bj = 0; bj < 2; ++bj)
#pragma unroll
            for (int n = 0; n < 2; ++n) { gg[bj][n] = *(const f32x4*)(gv + col0 + bj * HALF + n * 16); gn[bj][n] = *(const f32x4*)(gnorm + col0 + bj * HALF + n * 16) * (*(const f32x4*)(sv + col0 + bj * HALF + n * 16) + 1.0f); }
#pragma unroll
        for (int ai = 0; ai < 2; ++ai)
#pragma unroll
        for (int mh = 0; mh < 2; ++mh) {
            f32x4 pre[2][2][2];
#pragma unroll
            for (int mm = 0; mm < 2; ++mm) { const int row = row0 + ai * HALF + (2 * mh + mm) * 16;
                const float* bp = (row < 8192 ? base_ctx + (size_t)row * 1024 : base_lat + (size_t)(row - 8192) * 1024) + col0;
#pragma unroll
                for (int bj = 0; bj < 2; ++bj)
#pragma unroll
                    for (int n = 0; n < 2; ++n) pre[mm][bj][n] = *(const f32x4*)(bp + bj * HALF + n * 16); }
#pragma unroll
            for (int mm = 0; mm < 2; ++mm) { const int m = 2 * mh + mm; const int row = row0 + ai * HALF + m * 16; float* op = out + (size_t)row * 1024 + col0; bf16_t* xp = xn + (size_t)row * 1024 + col0;
                float q = 0.f;
#pragma unroll
                for (int bj = 0; bj < 2; ++bj)
#pragma unroll
                    for (int n = 0; n < 2; ++n) { const f32x4 x = pre[mm][bj][n] + gg[bj][n] * acc[ai][bj][m][n]; *(f32x4*)(op + bj * HALF + n * 16) = x;
                        q += (x[0] * x[0] + x[1] * x[1]) + (x[2] * x[2] + x[3] * x[3]);
                        const f32x4 y = x * gn[bj][n]; unsigned w0 = cvt_pk_bf16(y[0], y[1]), w1 = cvt_pk_bf16(y[2], y[3]);
                        typedef unsigned u32x2 __attribute__((ext_vector_type(2))); *(u32x2*)(xp + bj * HALF + n * 16) = (u32x2){w0, w1}; }
                q += __shfl_xor(q, 16); q += __shfl_xor(q, 32);
                if (fq == 0) atomicAdd(ssq + row, q); }
            asm volatile("" ::: "memory");
        }
    }
};
struct EpiMerge {
    static constexpr bool PERM = true, AFTER_DRAIN = false;
    const bf16_t* gates; bf16_t* mg; const float* ssq;
    __device__ __forceinline__ void operator()(const f32x4 (&acc)[2][2][4][2], const Unit& u, int wr, int wc, int fr, int fq) const {
        const int br = u.pn >> 2, pnl = u.pn & 3;
        int pm_o = u.pm; asm volatile("" : "+s"(pm_o));
        const int row0 = pm_o * BM + wr * 64 + fr, gcol0 = u.pn * BM + wc * 32 + 8 * fq, mcol0 = pnl * BM + wc * 32 + 8 * fq;
#pragma unroll
        for (int ai = 0; ai < 2; ++ai)
#pragma unroll
        for (int mh = 0; mh < 2; ++mh) {
            u32x4 gpre[2][2], mpre[2][2]; float rpre[2];
#pragma unroll
            for (int mm = 0; mm < 2; ++mm) { const int row = row0 + ai * HALF + (2 * mh + mm) * 16;
                rpre[mm] = (br == 0) ? ssq[row] : 512.0f;
#pragma unroll
                for (int bj = 0; bj < 2; ++bj) { gpre[mm][bj] = *(const u32x4*)(gates + (size_t)row * 4096 + gcol0 + bj * HALF);
                    mpre[mm][bj] = (br != 0) ? *(const u32x4*)(mg + (size_t)row * 1024 + mcol0 + bj * HALF) : (u32x4){0u, 0u, 0u, 0u}; } }
#pragma unroll
            for (int mm = 0; mm < 2; ++mm) { const int m = 2 * mh + mm; const int row = row0 + ai * HALF + m * 16;
                const float rs = (br == 0) ? rsqrtf(rpre[mm] * (1.0f / 512.0f) + 1e-6f) : 1.0f;
#pragma unroll
                for (int bj = 0; bj < 2; ++bj) { const u32x4 gq = gpre[mm][bj], mq = mpre[mm][bj]; const f32x4 a0 = acc[ai][bj][m][0], a1 = acc[ai][bj][m][1];
                    const float v0 = bf_lo(mq.x) + a0[0] * bf_lo(gq.x) * rs, v1 = bf_hi(mq.x) + a0[1] * bf_hi(gq.x) * rs, v2 = bf_lo(mq.y) + a0[2] * bf_lo(gq.y) * rs, v3 = bf_hi(mq.y) + a0[3] * bf_hi(gq.y) * rs;
                    const float v4 = bf_lo(mq.z) + a1[0] * bf_lo(gq.z) * rs, v5 = bf_hi(mq.z) + a1[1] * bf_hi(gq.z) * rs, v6 = bf_lo(mq.w) + a1[2] * bf_lo(gq.w) * rs, v7 = bf_hi(mq.w) + a1[3] * bf_hi(gq.w) * rs;
                    u32x4 w; w.x = cvt_pk_bf16(v0, v1); w.y = cvt_pk_bf16(v2, v3); w.z = cvt_pk_bf16(v4, v5); w.w = cvt_pk_bf16(v6, v7);
                    *(u32x4*)(mg + (size_t)row * 1024 + mcol0 + bj * HALF) = w; } }
            asm volatile("" ::: "memory");
        }
    }
};
struct BranchOrder {
    int G, c;
    __host__ __device__ void init(int G_, int c_) { G = G_; c = c_; }
    __host__ __device__ bool next(int i, Unit& u) const { if (c >= 192 || i >= 4) return false; u.pm = c >> 2; u.pn = i * 4 + (c & 3); return true; }
    __device__ __forceinline__ void a_ready(const Unit&) const {}
    __device__ __forceinline__ void done(const Unit&) const {}
};
struct EpiRes {
    static constexpr bool PERM = false, AFTER_DRAIN = false;
    const float* base_ctx; const float* base_lat;
    float* out; const float* modv;
    int goff;
    __device__ __forceinline__ void operator()(const f32x4 (&acc)[2][2][4][2], const Unit& u, int wr, int wc, int fr, int fq) const {
        const int row0 = u.pm * BM + wr * 64 + fr, col0 = u.pn * BM + wc * 32 + 4 * fq;
        const int mi = (u.pm < 32) ? 0 : 1 + ((u.pm - 32) >> 2);
        const float* gv = modv + (size_t)mi * 6144 + goff;
        f32x4 gg[2][2];
#pragma unroll
        for (int bj = 0; bj < 2; ++bj)
#pragma unroll
            for (int n = 0; n < 2; ++n) gg[bj][n] = *(const f32x4*)(gv + col0 + bj * HALF + n * 16);
#pragma unroll
        for (int ai = 0; ai < 2; ++ai) {
            f32x4 pre[4][2][2];
#pragma unroll
            for (int m = 0; m < 4; ++m) { const int row = row0 + ai * HALF + m * 16;
                const float* bp = (row < 8192 ? base_ctx + (size_t)row * 1024 : base_lat + (size_t)(row - 8192) * 1024) + col0;
#pragma unroll
                for (int bj = 0; bj < 2; ++bj)
#pragma unroll
                    for (int n = 0; n < 2; ++n) pre[m][bj][n] = *(const f32x4*)(bp + bj * HALF + n * 16); }
#pragma unroll
            for (int m = 0; m < 4; ++m) { const int row = row0 + ai * HALF + m * 16; float* op = out + (size_t)row * 1024 + col0;
#pragma unroll
                for (int bj = 0; bj < 2; ++bj)
#pragma unroll
                    for (int n = 0; n < 2; ++n) *(f32x4*)(op + bj * HALF + n * 16) = pre[m][bj][n] + gg[bj][n] * acc[ai][bj][m][n]; }
            asm volatile("" ::: "memory");
        }
    }
};

template <class Epi, class Sched, bool ALIGN_EPI = false, bool SP2 = false>
__device__ __forceinline__ void gemm_phase(PG8_LAS unsigned char* lds, const Gemm g, const Sched& S, const Epi& E, const int tid) {
    const int wid = __builtin_amdgcn_readfirstlane(tid >> 6), lane = tid & 63, wr = wid >> 2, wc = wid & 3, fr = lane & 15, fq = lane >> 4;
    const int K = g.K, nt = K / BK;
    unsigned voffA[2], voffB[2];
#pragma unroll
    for (int i = 0; i < 2; ++i) { int R, C; stage_rc(tid * 16 + i * 8192, R, C); const int Rb = Epi::PERM ? ((R & ~31) + perm32(R & 31)) : R;
        voffA[i] = (unsigned)(R * g.lda + C) * 2u; voffB[i] = (unsigned)(Rb * g.ldb + C) * 2u; }
    const size_t kstep = (size_t)(BK * 2);
    const size_t hstepA = (size_t)HALF * g.lda * 2, hstepB = (size_t)HALF * g.ldb * 2;
    const size_t tstepA = 2 * hstepA, tstepB = 2 * hstepB;
#define PG8_UA(u) ((const char*)g.A + (size_t)(u).pm * tstepA + (g.a_div ? (size_t)((u).pn / g.a_div) * g.a_gstride : (size_t)0))
#define PG8_UB(u) ((const char*)g.Bt + (size_t)(u).pn * tstepB)
    const unsigned ldsw = (unsigned)wid * 1024u;
    const int aoff = lds_byte(wr * 64 + fr, fq * 8), boff = lds_byte(wc * 32 + fr, fq * 8);
#define PG8_SA(b, h) (((b) * 2 + (h)) * HTB)
#define PG8_SB(b, h) ((4 + (b) * 2 + (h)) * HTB)
#define PG8_STAGE(bufoff, gbase, voff) do { _Pragma("unroll") for (int _i = 0; _i < 2; ++_i) \
        __builtin_amdgcn_global_load_lds((const unsigned*)((const char*)(gbase) + (voff)[_i]), (PG8_LAS unsigned*)(lds + (bufoff) + ldsw + _i * 8192), 16, 0, 0); } while (0)
#define PG8_LDA(dst, b, h) do { _Pragma("unroll") for (int m = 0; m < 4; ++m) _Pragma("unroll") for (int k = 0; k < 2; ++k) dst[m][k] = *(const PG8_LAS bf16x8*)(lds + PG8_SA(b, h) + aoff + m * 2048 + k * 1024); } while (0)
#define PG8_LDB(dst, b, h) do { _Pragma("unroll") for (int n = 0; n < 2; ++n) _Pragma("unroll") for (int k = 0; k < 2; ++k) dst[n][k] = *(const PG8_LAS bf16x8*)(lds + PG8_SB(b, h) + boff + n * 2048 + k * 1024); } while (0)
#define PG8_MMA(ai, bj, At, Bt) do { __builtin_amdgcn_s_setprio(1); _Pragma("unroll") for (int m = 0; m < 4; ++m) _Pragma("unroll") for (int n = 0; n < 2; ++n) _Pragma("unroll") for (int k = 0; k < 2; ++k) \
        acc[ai][bj][m][n] = __builtin_amdgcn_mfma_f32_16x16x32_bf16(Bt[n][k], At[m][k], acc[ai][bj][m][n], 0, 0, 0); __builtin_amdgcn_s_setprio(0); } while (0)
#define PG8_WAIT_V(n) asm volatile("s_waitcnt vmcnt(" #n ")" ::: "memory")
#define PG8_WAIT_L(n) asm volatile("s_waitcnt lgkmcnt(" #n ")" ::: "memory")
#define PG8_BAR __builtin_amdgcn_s_barrier()
#define PG8_SCHED __builtin_amdgcn_sched_barrier(0)
    Unit cur, nxt; int ui = 0;
    if (!S.next(0, cur)) return;
    f32x4 acc[2][2][4][2];
#pragma unroll
    for (int a = 0; a < 2; ++a)
#pragma unroll
        for (int b = 0; b < 2; ++b)
#pragma unroll
            for (int m = 0; m < 4; ++m)
#pragma unroll
                for (int n = 0; n < 2; ++n) acc[a][b][m][n] = (f32x4){0.f, 0.f, 0.f, 0.f};
    bf16x8 At[4][2], B0[2][2], B1[2][2];
    const char* cA = PG8_UA(cur); const char* cB = PG8_UB(cur);
    S.a_ready(cur);
    if constexpr (SP2) {
        PG8_STAGE(PG8_SB(0, 0), cB, voffB); PG8_STAGE(PG8_SB(0, 1), cB + hstepB, voffB); PG8_STAGE(PG8_SA(0, 0), cA, voffA); PG8_STAGE(PG8_SA(0, 1), cA + hstepA, voffA);
        if (wr == 1) PG8_BAR;
        PG8_WAIT_V(2); PG8_BAR;
        PG8_STAGE(PG8_SB(1, 0), cB + kstep, voffB); PG8_STAGE(PG8_SA(1, 0), cA + kstep, voffA); PG8_STAGE(PG8_SB(1, 1), cB + hstepB + kstep, voffB);
        PG8_WAIT_V(6); PG8_BAR;
    } else {
        PG8_STAGE(PG8_SB(0, 0), cB, voffB); PG8_STAGE(PG8_SA(0, 0), cA, voffA); PG8_STAGE(PG8_SB(0, 1), cB + hstepB, voffB); PG8_STAGE(PG8_SA(0, 1), cA + hstepA, voffA);
        if (wr == 1) PG8_BAR;
        PG8_WAIT_V(4); PG8_BAR;
        PG8_STAGE(PG8_SB(1, 0), cB + kstep, voffB); PG8_STAGE(PG8_SA(1, 0), cA + kstep, voffA); PG8_STAGE(PG8_SB(1, 1), cB + hstepB + kstep, voffB);
        PG8_WAIT_V(6); PG8_BAR;
    }
    for (;;) {
        const bool has_next = S.next(ui + 1, nxt);
        const char* nA = has_next ? PG8_UA(nxt) : cA; const char* nB = has_next ? PG8_UB(nxt) : cB;
        for (int t = 0; t < nt; t += 2) {
            const bool last = (t == nt - 2);
            const char* a1 = cA + (size_t)(t + 1) * kstep;
            const char* a2 = last ? nA : cA + (size_t)(t + 2) * kstep; const char* b2 = last ? nB : cB + (size_t)(t + 2) * kstep;
            const char* a3 = a2 + kstep; const char* b3 = b2 + kstep;
            if (last && has_next) S.a_ready(nxt);
            if constexpr (SP2) {
            PG8_LDB(B0, 0, 0); PG8_LDB(B1, 0, 1); PG8_SCHED; PG8_LDA(At, 0, 0); PG8_STAGE(PG8_SA(1, 1), a1 + hstepA, voffA);
            PG8_WAIT_V(8); PG8_WAIT_L(0); PG8_BAR; PG8_MMA(0, 0, At, B0); PG8_MMA(0, 1, At, B1); PG8_BAR; PG8_SCHED;
            PG8_LDA(At, 0, 1); PG8_STAGE(PG8_SB(0, 0), b2, voffB); PG8_STAGE(PG8_SB(0, 1), b2 + hstepB, voffB); PG8_STAGE(PG8_SA(0, 0), a2, voffA);
            PG8_WAIT_V(8); PG8_WAIT_L(0); PG8_BAR; PG8_MMA(1, 0, At, B0); PG8_MMA(1, 1, At, B1); PG8_BAR; PG8_SCHED;
            PG8_LDB(B0, 1, 0); PG8_LDB(B1, 1, 1); PG8_SCHED; PG8_LDA(At, 1, 0); PG8_STAGE(PG8_SA(0, 1), a2 + hstepA, voffA);
            PG8_WAIT_V(8); PG8_WAIT_L(0); PG8_BAR; PG8_MMA(0, 0, At, B0); PG8_MMA(0, 1, At, B1); PG8_BAR; PG8_SCHED;
            PG8_LDA(At, 1, 1); PG8_STAGE(PG8_SB(1, 0), b3, voffB); PG8_STAGE(PG8_SB(1, 1), b3 + hstepB, voffB); PG8_STAGE(PG8_SA(1, 0), a3, voffA);
            PG8_WAIT_V(8); PG8_WAIT_L(0); PG8_BAR; PG8_MMA(1, 0, At, B0); PG8_MMA(1, 1, At, B1); PG8_BAR; PG8_SCHED;
            } else {
            PG8_LDB(B0, 0, 0); PG8_SCHED; PG8_LDA(At, 0, 0); PG8_STAGE(PG8_SA(1, 1), a1 + hstepA, voffA);
            PG8_WAIT_L(8); PG8_BAR; PG8_WAIT_L(0); PG8_MMA(0, 0, At, B0); PG8_BAR; PG8_SCHED;
            PG8_LDB(B1, 0, 1); PG8_STAGE(PG8_SB(0, 0), b2, voffB);
            PG8_BAR; PG8_WAIT_L(0); PG8_MMA(0, 1, At, B1); PG8_BAR;
            PG8_LDA(At, 0, 1); PG8_STAGE(PG8_SA(0, 0), a2, voffA);
            PG8_BAR; PG8_WAIT_L(0); PG8_MMA(1, 0, At, B0); PG8_BAR; PG8_SCHED;
            PG8_STAGE(PG8_SB(0, 1), b2 + hstepB, voffB);
            PG8_WAIT_V(6); PG8_BAR; PG8_MMA(1, 1, At, B1); PG8_BAR;
            PG8_LDB(B0, 1, 0); PG8_SCHED; PG8_LDA(At, 1, 0); PG8_STAGE(PG8_SA(0, 1), a2 + hstepA, voffA);
            PG8_WAIT_L(8); PG8_BAR; PG8_WAIT_L(0); PG8_MMA(0, 0, At, B0); PG8_BAR; PG8_SCHED;
            PG8_LDB(B1, 1, 1); PG8_STAGE(PG8_SB(1, 0), b3, voffB);
            PG8_BAR; PG8_WAIT_L(0); PG8_MMA(0, 1, At, B1); PG8_BAR;
            PG8_LDA(At, 1, 1); PG8_STAGE(PG8_SA(1, 0), a3, voffA);
            PG8_BAR; PG8_WAIT_L(0); PG8_MMA(1, 0, At, B0); PG8_BAR; PG8_SCHED;
            PG8_STAGE(PG8_SB(1, 1), b3 + hstepB, voffB);
            PG8_WAIT_V(6); PG8_BAR; PG8_MMA(1, 1, At, B1); PG8_BAR;
            }
        }
        if constexpr (ALIGN_EPI) { if (wr == 0) PG8_BAR; }
        if constexpr (!Epi::AFTER_DRAIN) { E(acc, cur, wr, wc, fr, fq); S.done(cur); }
        if (!has_next) break;
#pragma unroll
        for (int a = 0; a < 2; ++a)
#pragma unroll
            for (int b = 0; b < 2; ++b)
#pragma unroll
                for (int m = 0; m < 4; ++m)
#pragma unroll
                    for (int n = 0; n < 2; ++n) acc[a][b][m][n] = (f32x4){0.f, 0.f, 0.f, 0.f};
        cur = nxt; cA = nA; cB = nB; ++ui;
        if constexpr (ALIGN_EPI) { if (wr == 1) PG8_BAR; }
    }
    PG8_WAIT_V(0);
    if constexpr (!ALIGN_EPI) { if (wr == 0) PG8_BAR; }
    PG8_BAR;
    if constexpr (Epi::AFTER_DRAIN) { E.fused(acc, cur, wr, wc, fr, fq, lds, wid, lane); S.done(cur); }
#undef PG8_UA
#undef PG8_UB
#undef PG8_SA
#undef PG8_SB
#undef PG8_STAGE
#undef PG8_LDA
#undef PG8_LDB
#undef PG8_MMA
#undef PG8_WAIT_V
#undef PG8_WAIT_L
#undef PG8_BAR
#undef PG8_SCHED
}
}

#ifndef PG8_SP2
#define PG8_SP2 true
#endif
#ifndef PG8_ALIGN
#define PG8_ALIGN true
#endif

typedef unsigned short bf16;
typedef unsigned v4u __attribute__((ext_vector_type(4)));
typedef unsigned v2u __attribute__((ext_vector_type(2)));
typedef float f32x4 __attribute__((ext_vector_type(4)));
#define LAS __attribute__((address_space(3)))

constexpr int NWAVES = 8, NTHR = 512;
constexpr int D = 1024, MC = 8192, ML = 4096, M = 12288, NPH = 23;
constexpr int LDS_BYTES = 147456;
constexpr float EPS = 1e-6f;
constexpr size_t MiB = 1u << 20;
constexpr size_t WS_MOD = 64 * 1024;
constexpr size_t WS_SSQ = 320 * 1024;
constexpr size_t WS_DT = 384 * 1024;
constexpr size_t WS_W = 2 * MiB;
constexpr size_t W_IN = WS_W, W_G = W_IN + 8 * MiB, W_GLU = W_G + 8 * MiB, W_BR = W_GLU + 1 * MiB, W_OUT = W_BR + 4 * MiB, W_1 = W_OUT + 2 * MiB, W_2 = W_1 + 8 * MiB;
constexpr size_t WS_H = 41 * MiB;
constexpr size_t WS_R1 = 65 * MiB;
constexpr size_t WS_Y = 161 * MiB;
constexpr size_t WS_Y5 = 209 * MiB;
constexpr size_t WS_XC = 221 * MiB;
constexpr size_t WS_S5K = 239 * MiB;
constexpr size_t WS_S5WS = 240 * MiB;
constexpr size_t WS_S5WO = 244 * MiB;
constexpr size_t WS_S5AT = 248 * MiB;
constexpr size_t WS_CKV = 248 * MiB + 512 * 1024;
constexpr size_t WS_ROPE = 1536 * 1024;
constexpr size_t WS_WDT = 1792 * 1024;
constexpr size_t WS_BI2 = 1824 * 1024;
constexpr size_t WS_SSQ2 = 1904 * 1024;
constexpr size_t WS_END = 254 * MiB;
#ifndef PROBE_SEL
#define PROBE_SEL -1
#endif
#ifndef PROBE_SCALE
#define PROBE_SCALE 4e-4f
#endif
#ifndef PROBE_PB
#define PROBE_PB 32
#endif
constexpr size_t WS_BAR = 32 * 1024;
constexpr size_t WS_QCTR = 48 * 1024;
constexpr size_t WS_TS = 16 * 1024;
constexpr size_t O_SSD = 12582912, O_S5 = 16777216, O_DK = 17301504, O_DV = 25690112, O_WK = 34078720, O_WV = 36175872;
constexpr int C_Z = 0, C_XBC = 512, C_U = 1280, C_DQ = 1792, C_DK = 2304, C_DV = 2816, C_WQ = 3328, C_WK = 3840, C_WV = 3968;

namespace pg8 {
struct EpiIn {
    static constexpr bool PERM = true, AFTER_DRAIN = false;
    bf16_t* O; float* out; const float* rope; const float* qg; const float* kg; const float* wqg; const float* wkg; int l;
    __device__ __forceinline__ void operator()(const f32x4 (&acc)[2][2][4][2], const Unit& u, int wr, int wc, int fr, int fq) const {
        const int pn = u.pn; const bool lat = u.pm >= 32;
        const int row0 = u.pm * BM + wr * 64 + fr, lcol0 = pn * BM + 64 * wc + 8 * fq;
        const float* gp = nullptr;
        if (pn == 7 || pn == 8) gp = qg; else if (pn == 9 || pn == 10) gp = kg; else if (pn == 13 || pn == 14) gp = wqg; else if (pn == 15 && wc < 2) gp = wkg;
        float* fo = nullptr; int fstride = 0;
        if (!lat) { if (pn == 9 || pn == 10) { fo = out + O_DK + (pn - 9) * 256 + 64 * wc + 8 * fq; fstride = 512; }
                    else if (pn == 11 || pn == 12) { fo = out + O_DV + (pn - 11) * 256 + 64 * wc + 8 * fq; fstride = 512; }
                    else if (pn == 15) { fo = out + (wc < 2 ? O_WK + 64 * wc : O_WV + 64 * (wc - 2)) + 8 * fq; fstride = 128; } }
        f32x4 g[2][2];
#pragma unroll
        for (int bj = 0; bj < 2; ++bj)
#pragma unroll
            for (int n = 0; n < 2; ++n) g[bj][n] = gp ? *(const f32x4*)(gp + 32 * bj + 8 * fq + 4 * n) : (f32x4){1.f, 1.f, 1.f, 1.f};
#pragma unroll
        for (int ai = 0; ai < 2; ++ai)
#pragma unroll
            for (int m = 0; m < 4; ++m) {
                const int row = row0 + ai * HALF + m * 16;
                f32x4 v[2][2];
#pragma unroll
                for (int bj = 0; bj < 2; ++bj)
#pragma unroll
                    for (int n = 0; n < 2; ++n) v[bj][n] = acc[ai][bj][m][n];
                if (gp) {
                    float ss = 0.f;
#pragma unroll
                    for (int bj = 0; bj < 2; ++bj)
#pragma unroll
                        for (int n = 0; n < 2; ++n) ss += (v[bj][n][0] * v[bj][n][0] + v[bj][n][1] * v[bj][n][1]) + (v[bj][n][2] * v[bj][n][2] + v[bj][n][3] * v[bj][n][3]);
                    ss += __shfl_xor(ss, 16); ss += __shfl_xor(ss, 32);
                    const float rs = rsqrtf(ss * (1.0f / 64.0f) + 1e-6f);
#pragma unroll
                    for (int bj = 0; bj < 2; ++bj)
#pragma unroll
                        for (int n = 0; n < 2; ++n) v[bj][n] = v[bj][n] * rs * g[bj][n];
                    if (lat) {
                        const float* rp = rope + (size_t)((row - 8192) & 1023) * 64 + 8 * (fq & 1);
#pragma unroll
                        for (int bj = 0; bj < 2; ++bj)
#pragma unroll
                            for (int n = 0; n < 2; ++n) { const f32x4 cs = *(const f32x4*)(rp + 16 * bj + 4 * n), sn = *(const f32x4*)(rp + 32 + 16 * bj + 4 * n);
                                f32x4 p; p[0] = __shfl_xor(v[bj][n][0], 32); p[1] = __shfl_xor(v[bj][n][1], 32); p[2] = __shfl_xor(v[bj][n][2], 32); p[3] = __shfl_xor(v[bj][n][3], 32);
                                v[bj][n] = (fq >> 1) ? v[bj][n] * cs + p * sn : v[bj][n] * cs - p * sn; }
                    }
                }
                bf16_t* rowp = O + (size_t)row * 4096 + lcol0;
#pragma unroll
                for (int bj = 0; bj < 2; ++bj) { u32x4 w; w.x = cvt_pk_bf16(v[bj][0][0], v[bj][0][1]); w.y = cvt_pk_bf16(v[bj][0][2], v[bj][0][3]); w.z = cvt_pk_bf16(v[bj][1][0], v[bj][1][1]); w.w = cvt_pk_bf16(v[bj][1][2], v[bj][1][3]);
                    *(u32x4*)(rowp + 32 * bj) = w; }
                if (fo) { float* fp = fo + (size_t)(((row >> 8) * 2 + l) * 256 + (row & 255)) * fstride;
#pragma unroll
                    for (int bj = 0; bj < 2; ++bj) { *(f32x4*)(fp + 32 * bj) = v[bj][0]; *(f32x4*)(fp + 32 * bj + 4) = v[bj][1]; } }
            }
    }
};
}

struct Args { const float* in[44]; float* out; unsigned char* ws; int ph_lo, ph_hi; };

typedef const Args __attribute__((address_space(4)))* CArgs;
struct Ctx {
    CArgs ap; int tid, lane, wave;
    __device__ __forceinline__ const float* x_prompt() const { return ap->in[0]; }
    __device__ __forceinline__ const float* x_sample() const { return ap->in[1]; }
    __device__ __forceinline__ const float* state_ssd() const { return ap->in[2]; }
    __device__ __forceinline__ const float* state_s5() const { return ap->in[3]; }
    __device__ __forceinline__ const float* cache_dk() const { return ap->in[4]; }
    __device__ __forceinline__ const float* cache_dv() const { return ap->in[5]; }
    __device__ __forceinline__ const float* cache_wk() const { return ap->in[6]; }
    __device__ __forceinline__ const float* cache_wv() const { return ap->in[7]; }
    __device__ __forceinline__ const float* cvec() const { return ap->in[8]; }
    __device__ __forceinline__ const float* c_ctx() const { return ap->in[9]; }
    __device__ __forceinline__ const float* w_mod() const { return ap->in[10]; }
    __device__ __forceinline__ const float* b_mod() const { return ap->in[11]; }
    __device__ __forceinline__ const float* g_norm1() const { return ap->in[12]; }
    __device__ __forceinline__ const float* g_norm2() const { return ap->in[13]; }
    __device__ __forceinline__ const float* w_in() const { return ap->in[14]; }
    __device__ __forceinline__ const float* conv_w() const { return ap->in[15]; }
    __device__ __forceinline__ const float* conv_b() const { return ap->in[16]; }
    __device__ __forceinline__ const float* dt_bias() const { return ap->in[17]; }
    __device__ __forceinline__ const float* a_log() const { return ap->in[18]; }
    __device__ __forceinline__ const float* ssd_d() const { return ap->in[19]; }
    __device__ __forceinline__ const float* ssd_norm_g() const { return ap->in[20]; }
    __device__ __forceinline__ const float* lam_re() const { return ap->in[21]; }
    __device__ __forceinline__ const float* lam_im() const { return ap->in[22]; }
    __device__ __forceinline__ const float* log_step() const { return ap->in[23]; }
    __device__ __forceinline__ const float* b_re() const { return ap->in[24]; }
    __device__ __forceinline__ const float* b_im() const { return ap->in[25]; }
    __device__ __forceinline__ const float* c_re() const { return ap->in[26]; }
    __device__ __forceinline__ const float* c_im() const { return ap->in[27]; }
    __device__ __forceinline__ const float* s5_d() const { return ap->in[28]; }
    __device__ __forceinline__ const float* w_glu() const { return ap->in[29]; }
    __device__ __forceinline__ const float* b_glu() const { return ap->in[30]; }
    __device__ __forceinline__ const float* qn_g() const { return ap->in[31]; }
    __device__ __forceinline__ const float* kn_g() const { return ap->in[32]; }
    __device__ __forceinline__ const float* dlam() const { return ap->in[33]; }
    __device__ __forceinline__ const float* subln_g() const { return ap->in[34]; }
    __device__ __forceinline__ const float* wqn_g() const { return ap->in[35]; }
    __device__ __forceinline__ const float* wkn_g() const { return ap->in[36]; }
    __device__ __forceinline__ const float* sink() const { return ap->in[37]; }
    __device__ __forceinline__ const float* w_branch() const { return ap->in[38]; }
    __device__ __forceinline__ const float* w_gate() const { return ap->in[39]; }
    __device__ __forceinline__ const float* b_gate() const { return ap->in[40]; }
    __device__ __forceinline__ const float* w_out() const { return ap->in[41]; }
    __device__ __forceinline__ const float* w_fc1() const { return ap->in[42]; }
    __device__ __forceinline__ const float* w_fc2() const { return ap->in[43]; }
    __device__ __forceinline__ float* out() const { return ap->out; }
    __device__ __forceinline__ unsigned char* ws() const { return ap->ws; }
    __device__ __forceinline__ float* MOD() const { return (float*)(ap->ws + WS_MOD); }
    __device__ __forceinline__ float* SSQ() const { return (float*)(ap->ws + WS_SSQ); }
    __device__ __forceinline__ float* DT() const { return (float*)(ap->ws + WS_DT); }
    __device__ __forceinline__ bf16* H() const { return (bf16*)(ap->ws + WS_H); }
    __device__ __forceinline__ bf16* R1() const { return (bf16*)(ap->ws + WS_R1); }
    __device__ __forceinline__ bf16* Y() const { return (bf16*)(ap->ws + WS_Y); }
    __device__ __forceinline__ bf16* Y5() const { return (bf16*)(ap->ws + WS_Y5); }
    __device__ __forceinline__ bf16* XC() const { return (bf16*)(ap->ws + WS_XC); }
    __device__ __forceinline__ bf16* CKV() const { return (bf16*)(ap->ws + WS_CKV); }
    __device__ __forceinline__ float* ROPE() const { return (float*)(ap->ws + WS_ROPE); }
};

__device__ __forceinline__ float wave_sum(float v) {
#pragma unroll
    for (int o = 1; o < 64; o <<= 1) v += __shfl_xor(v, o);
    return v;
}
__device__ __forceinline__ float wave_max(float v) {
#pragma unroll
    for (int o = 1; o < 64; o <<= 1) v = fmaxf(v, __shfl_xor(v, o));
    return v;
}
__device__ __forceinline__ float bf2f(bf16 h) { return __builtin_bit_cast(float, (unsigned)h << 16); }
__device__ __forceinline__ float bflo(unsigned w) { return __builtin_bit_cast(float, w << 16); }
__device__ __forceinline__ float bfhi(unsigned w) { return __builtin_bit_cast(float, w & 0xffff0000u); }
__device__ __forceinline__ unsigned f2bf(float f) { unsigned u = __builtin_bit_cast(unsigned, f); return (u + 0x7fffu + ((u >> 16) & 1u)) >> 16; }
__device__ __forceinline__ unsigned pk2(float lo, float hi) { return f2bf(lo) | (f2bf(hi) << 16); }
__device__ __forceinline__ float siluf(float x) { return x / (1.0f + __expf(-x)); }
__device__ __forceinline__ void unpack8(const v4u q, float (&f)[8]) { f[0] = bflo(q.x); f[1] = bfhi(q.x); f[2] = bflo(q.y); f[3] = bfhi(q.y); f[4] = bflo(q.z); f[5] = bfhi(q.z); f[6] = bflo(q.w); f[7] = bfhi(q.w); }

__device__ __forceinline__ void phase_mods(const Ctx& c, float* lf) {
    for (int i = c.tid; i < 5 * 1024; i += NTHR) { const int v = i >> 10, k = i & 1023; const float x = (v == 0) ? c.c_ctx()[k] : c.cvec()[(v - 1) * 1024 + k]; lf[i] = siluf(x); }
    __syncthreads();
    float* red = lf + 5 * 1024;
    for (int u = blockIdx.x; u < 192; u += gridDim.x) {
        const int l = u / 96, col0 = (u % 96) * 64;
        const float* W = c.w_mod() + (size_t)l * 1024 * 6144 + col0 + c.lane;
        float acc[5] = {0.f, 0.f, 0.f, 0.f, 0.f};
#pragma unroll 1
        for (int kb = c.wave * 128; kb < c.wave * 128 + 128; kb += 32) {
            float wv[32];
#pragma unroll
            for (int j = 0; j < 32; ++j) wv[j] = W[(size_t)(kb + j) * 6144];
#pragma unroll
            for (int j = 0; j < 32; ++j)
#pragma unroll
                for (int i = 0; i < 5; ++i) acc[i] += lf[i * 1024 + kb + j] * wv[j]; }
#pragma unroll
        for (int i = 0; i < 5; ++i) red[(c.wave * 5 + i) * 64 + c.lane] = acc[i];
        __syncthreads();
        if (c.tid < 320) { const int i = c.tid >> 6, ln = c.tid & 63; float s = c.b_mod()[l * 6144 + col0 + ln];
#pragma unroll
            for (int w = 0; w < 8; ++w) s += red[(w * 5 + i) * 64 + ln];
            c.MOD()[(size_t)(l * 5 + i) * 6144 + col0 + ln] = s; }
        __syncthreads();
    }
}

__device__ __forceinline__ int cmap(int mode, int n) {
    if (mode == 0) return n;
    if (mode == 1) { const int p = n & 255, lc = 64 * ((p >> 5) & 3) + 32 * (p >> 7) + (p & 31), nn = (n & ~255) + lc; return nn < 1280 ? nn : nn + 16; }
    if (mode == 3) { const int T = n >> 8, p = n & 255; return (2 * (p >> 7) + ((p >> 2) & 1)) * 1024 + 64 * T + 16 * ((p >> 5) & 3) + 4 * ((p >> 3) & 3) + (p & 3); }
    return (n & 255) < 128 ? 128 * (n >> 8) + (n & 127) : 512 + 128 * (n >> 8) + (n & 127);
}
__device__ __forceinline__ void transpose_item(const float* W, int ld, int K, int N, int mode, const float* rowscale, bf16* WT, float* scr, int item, int lane) {
    const int nblk = N / 32, kb = item / nblk, nb = item % nblk, k0 = 64 * kb, n0 = 32 * nb, scl = (mode == 3) ? cmap(3, n0 + (lane & 31)) : cmap(mode, n0) + (lane & 31);
    float tv[32];
#pragma unroll
    for (int i = 0; i < 32; ++i) tv[i] = W[(size_t)(k0 + 2 * i + (lane >> 5)) * ld + scl];
    if (rowscale) {
#pragma unroll
        for (int i = 0; i < 32; ++i) tv[i] *= rowscale[k0 + 2 * i + (lane >> 5)]; }
#pragma unroll
    for (int i = 0; i < 32; ++i) scr[(2 * i + (lane >> 5)) * 33 + (lane & 31)] = tv[i];
    __builtin_amdgcn_fence(__ATOMIC_RELEASE, "wavefront"); __builtin_amdgcn_wave_barrier();
    const int ch = lane & 7;
#pragma unroll
    for (int j = 0; j < 4; ++j) { const int n = (lane >> 3) + 8 * j; const float* s = scr + (8 * ch) * 33 + n;
        v4u o; o.x = pk2(s[0 * 33], s[1 * 33]); o.y = pk2(s[2 * 33], s[3 * 33]); o.z = pk2(s[4 * 33], s[5 * 33]); o.w = pk2(s[6 * 33], s[7 * 33]);
        *(v4u*)(WT + (size_t)(n0 + n) * K + k0 + 8 * ch) = o; }
    __builtin_amdgcn_fence(__ATOMIC_RELEASE, "wavefront"); __builtin_amdgcn_wave_barrier();
}
__device__ __forceinline__ void s5_tables(const Ctx& c, int l, int g, int part, float* lf);
__device__ __forceinline__ void convert_items(const Ctx& c, int l, int lo, int hi, int gw0, int ngw, bool tabs, int tb0, int ntb, float* lf) {
    unsigned char* ws = c.ws();
    if (tabs) {
        for (int t = tb0; t < 128; t += ntb) s5_tables(c, l, t & 31, t >> 5, lf);
        for (int i = tb0 * NTHR + c.tid; i < 16384; i += ntb * NTHR) { const int j = i >> 10, k = i & 1023; ((bf16*)(ws + WS_WDT))[i] = (bf16)f2bf(c.w_in()[(size_t)l * 1024 * 4112 + (size_t)k * 4112 + 1280 + j]); }
    }
    float* scr = lf + c.wave * 2176;
    for (int it = lo + gw0; it < hi; it += ngw) {
        int r = it;
        if (r < 2048) { transpose_item(c.w_in() + (size_t)l * 1024 * 4112, 4112, 1024, 4096, 1, nullptr, (bf16*)(ws + W_IN), scr, r, c.lane); continue; } r -= 2048;
        if (r < 2048) { transpose_item(c.w_gate() + (size_t)l * 1024 * 4096, 4096, 1024, 4096, 3, nullptr, (bf16*)(ws + W_G), scr, r, c.lane); continue; } r -= 2048;
        if (r < 256) { transpose_item(c.w_glu() + (size_t)l * 512 * 1024, 1024, 512, 1024, 2, nullptr, (bf16*)(ws + W_GLU), scr, r, c.lane); continue; } r -= 256;
        if (r < 1024) { const int i = r >> 8; transpose_item(c.w_branch() + (size_t)(l * 4 + i) * 512 * 1024, 1024, 512, 1024, 0, i == 0 ? c.ssd_norm_g() + l * 512 : nullptr, (bf16*)(ws + W_BR) + (size_t)i * 1024 * 512, scr, r & 255, c.lane); continue; } r -= 1024;
        if (r < 512) { transpose_item(c.w_out() + (size_t)l * 1024 * 1024, 1024, 1024, 1024, 0, nullptr, (bf16*)(ws + W_OUT), scr, r, c.lane); continue; } r -= 512;
        if (r < 2048) { transpose_item(c.w_fc1() + (size_t)l * 1024 * 4096, 4096, 1024, 4096, 0, nullptr, (bf16*)(ws + W_1), scr, r, c.lane); continue; } r -= 2048;
        transpose_item(c.w_fc2() + (size_t)l * 4096 * 1024, 1024, 4096, 1024, 0, nullptr, (bf16*)(ws + W_2), scr, r, c.lane);
    }
}
__device__ __forceinline__ void phase_convert(const Ctx& c, int l, float* lf) {
    if (gridDim.x == 256) convert_items(c, l, 0, 9984, blockIdx.x * NWAVES + c.wave, gridDim.x * NWAVES, true, blockIdx.x >= 192 ? (int)blockIdx.x - 192 : 100000, 64, lf);
    else convert_items(c, l, 0, 9984, blockIdx.x * NWAVES + c.wave, gridDim.x * NWAVES, true, blockIdx.x, gridDim.x, lf);
}
__device__ __forceinline__ void side_convert(const Ctx& c, int lo, int hi, bool tabs, float* lf) {
    if (blockIdx.x < 192 || gridDim.x != 256) return;
    convert_items(c, 1, lo, hi, (blockIdx.x - 192) * NWAVES + c.wave, 64 * NWAVES, tabs, blockIdx.x - 192, 64, lf);
}

__device__ __forceinline__ void phase_norm(const Ctx& c, int l, int which, float* lf) {
    const int gw = blockIdx.x * NWAVES + c.wave, NGW = gridDim.x * NWAVES;
    const float* gn = (which == 0 ? c.g_norm1() : c.g_norm2()) + l * 1024;
    for (int m = gw; m < M; m += NGW) {
        const float* xr = (l == 0 && which == 0) ? (m < MC ? c.x_prompt() + (size_t)m * D : c.x_sample() + (size_t)(m - MC) * D) : c.out() + (size_t)m * D;
        const int mi = (m < MC) ? 0 : 1 + ((m - MC) >> 10);
        const float* mod = c.MOD() + (size_t)(l * 5 + mi) * 6144 + which * 3072;
        f32x4 v[4]; float s = 0.f;
#pragma unroll
        for (int j = 0; j < 4; ++j) { v[j] = *(const f32x4*)(xr + 4 * c.lane + 256 * j); s += (v[j].x * v[j].x + v[j].y * v[j].y) + (v[j].z * v[j].z + v[j].w * v[j].w); }
        const float rstd = rsqrtf(wave_sum(s) * (1.0f / D) + EPS);
#pragma unroll
        for (int j = 0; j < 4; ++j) { const int k = 4 * c.lane + 256 * j; const f32x4 g = *(const f32x4*)(gn + k), sh = *(const f32x4*)(mod + k), sc = *(const f32x4*)(mod + 1024 + k);
            v[j] = v[j] * rstd * g * (sc + 1.0f) + sh;
            v2u o; o.x = pk2(v[j].x, v[j].y); o.y = pk2(v[j].z, v[j].w); *(v2u*)(c.H() + (size_t)m * D + k) = o; }
        if (which == 0) {
            if (c.lane == 0) { c.SSQ()[m] = 0.f; ((float*)(c.ws() + WS_SSQ2))[m] = 0.f; }
        }
    }
}

__device__ __forceinline__ void phase_bias2(const Ctx& c, int l) {
    const int gw = blockIdx.x * NWAVES + c.wave, NGW = gridDim.x * NWAVES, lane = c.lane;
    const bf16* W1t = (const bf16*)(c.ws() + W_1); float* bi = (float*)(c.ws() + WS_BI2);
    for (int n = gw; n < 4096; n += NGW) {
        float wf[16]; { float t8[8]; unpack8(*(const v4u*)(W1t + (size_t)n * 1024 + 8 * lane), t8);
#pragma unroll
            for (int j = 0; j < 8; ++j) wf[j] = t8[j];
            unpack8(*(const v4u*)(W1t + (size_t)n * 1024 + 512 + 8 * lane), t8);
#pragma unroll
            for (int j = 0; j < 8; ++j) wf[8 + j] = t8[j]; }
#pragma unroll 1
        for (int mi = 0; mi < 5; ++mi) { const float* sh = c.MOD() + (size_t)(l * 5 + mi) * 6144 + 3072; float a = 0.f;
#pragma unroll
            for (int hh = 0; hh < 2; ++hh) { const f32x4 s0 = *(const f32x4*)(sh + 512 * hh + 8 * lane), s1 = *(const f32x4*)(sh + 512 * hh + 8 * lane + 4);
                a += (wf[8 * hh + 0] * s0.x + wf[8 * hh + 1] * s0.y) + (wf[8 * hh + 2] * s0.z + wf[8 * hh + 3] * s0.w) + (wf[8 * hh + 4] * s1.x + wf[8 * hh + 5] * s1.y) + (wf[8 * hh + 6] * s1.z + wf[8 * hh + 7] * s1.w); }
            a = wave_sum(a); if (lane == 0) bi[mi * 4096 + n] = a; }
    }
}

__device__ __forceinline__ void phase_dt(const Ctx& c, int l) {
    const int tile = blockIdx.x * 3 + c.wave;
    if (c.wave < 3 && tile < 768) {
    const int lr = c.lane & 15, lq = c.lane >> 4;
    const bf16* ap = c.H() + (size_t)(16 * tile + lr) * 1024 + 8 * lq; const bf16* bp = (const bf16*)(c.ws() + WS_WDT) + (size_t)lr * 1024 + 8 * lq;
    f32x4 acc = {0.f, 0.f, 0.f, 0.f};
#pragma unroll 8
    for (int ks = 0; ks < 32; ++ks) acc = __builtin_amdgcn_mfma_f32_16x16x32_bf16(*(const pg8::bf16x8*)(ap + 32 * ks), *(const pg8::bf16x8*)(bp + 32 * ks), acc, 0, 0, 0);
    const float bias = c.dt_bias()[l * 16 + lr];
#pragma unroll
    for (int r = 0; r < 4; ++r) { const float x = acc[r] + bias; c.DT()[(size_t)(16 * tile + 4 * lq + r) * 16 + lr] = x > 20.f ? x : log1pf(__expf(x)); }
    }
}

__device__ __forceinline__ void phase_rope_table(const Ctx& c) {
    const int gt = blockIdx.x * NTHR + c.tid;
    if (gt < 32768) { const int pos = gt >> 5, a = gt & 31, f = a & 15; const float inv = exp2f(-(float)f * 0.8304820237218406f);
        const float ang = (float)((a >> 4) ? (pos & 63) : (pos >> 6)) * inv; float sn, cs; sincosf(ang, &sn, &cs); c.ROPE()[pos * 64 + a] = cs; c.ROPE()[pos * 64 + 32 + a] = sn; }
}
__device__ __forceinline__ void phase_ckv(const Ctx& c) {
    const int gw = blockIdx.x * NWAVES + c.wave, NGW = gridDim.x * NWAVES, lane = c.lane;
    for (int r = gw; r < 2048; r += NGW) { const int l = r >> 10, b = (r >> 8) & 3, sidx = r & 255; const size_t cb = (size_t)(b * 2 + l) * 256 + sidx; bf16* dst = c.CKV() + (size_t)r * 1280;
#pragma unroll
        for (int i = 0; i < 5; ++i) { const int e = 4 * (lane + 64 * i);
            const float* src = e < 512 ? c.cache_dk() + cb * 512 + e : e < 1024 ? c.cache_dv() + cb * 512 + (e - 512) : e < 1152 ? c.cache_wk() + cb * 128 + (e - 1024) : c.cache_wv() + cb * 128 + (e - 1152);
            const f32x4 v = *(const f32x4*)src; v2u o; o.x = pk2(v.x, v.y); o.y = pk2(v.z, v.w); *(v2u*)(dst + e) = o; } }
}
__device__ __forceinline__ void phase_qk(const Ctx& c, int l, float* lf) {
    const int gw = blockIdx.x * NWAVES + c.wave, NGW = gridDim.x * NWAVES, lane = c.lane;
    for (int i = c.tid; i < 7 * 768; i += NTHR) lf[i] = c.conv_w()[(size_t)l * 7 * 768 + i];
    for (int i = c.tid; i < 768; i += NTHR) lf[7 * 768 + i] = c.conv_b()[l * 768 + i];
    __syncthreads();
    const bf16* R1p = c.R1(); bf16* XCp = c.XC();
    for (int m0 = gw * 6; m0 < M; m0 += NGW * 6) {
        v2u xr[12][3];
#pragma unroll
        for (int rI = 0; rI < 12; ++rI) { const int mr = m0 - 3 + rI; const bool ok = mr >= 0 && mr < M;
#pragma unroll
            for (int i = 0; i < 3; ++i) xr[rI][i] = ok ? *(const v2u*)(R1p + (size_t)mr * 4096 + C_XBC + 4 * lane + 256 * i) : (v2u){0u, 0u}; }
        f32x4 wv[3][8];
#pragma unroll
        for (int i = 0; i < 3; ++i)
#pragma unroll
            for (int j = 0; j < 8; ++j) wv[i][j] = *(const f32x4*)(lf + j * 768 + 4 * lane + 256 * i);
#pragma unroll
        for (int k = 0; k < 6; ++k) { const int m = m0 + k; if (m >= M) break;
            const bool lat = m >= MC; const int t = lat ? (m - MC) & 1023 : m & 255, L = lat ? 1024 : 256;
#pragma unroll
            for (int i = 0; i < 3; ++i) { f32x4 a = wv[i][7];
#pragma unroll
                for (int j = 0; j < 7; ++j) { const int tt = t + j - 3; if (tt >= 0 && tt < L) { const v2u q = xr[k + j][i]; const f32x4 xv = {bflo(q.x), bfhi(q.x), bflo(q.y), bfhi(q.y)}; a += wv[i][j] * xv; } }
                v2u o; o.x = pk2(siluf(a.x), siluf(a.y)); o.y = pk2(siluf(a.z), siluf(a.w)); *(v2u*)(XCp + (size_t)m * 768 + 4 * lane + 256 * i) = o; }
        }
    }
}

typedef pg8::bf16x8 bx8;
#define LDS_BARRIER() do { asm volatile("s_waitcnt lgkmcnt(0)" ::: "memory"); __builtin_amdgcn_s_barrier(); asm volatile("" ::: "memory"); } while (0)
#define MFMA16(a, b, cc) __builtin_amdgcn_mfma_f32_16x16x32_bf16((a), (b), (cc), 0, 0, 0)
__device__ __forceinline__ void ssd_unit(const Ctx& c, int l, int pass, int b, int h, unsigned char* lds) {
    const int L = pass ? 1024 : 256, tok0 = pass ? MC + b * 1024 : b * 256, NCH = L >> 7;
    const int tid = c.tid, lane = c.lane, w = c.wave, lr = lane & 15, lq = lane >> 4, grp = h >> 2;
    bf16* XT = (bf16*)lds;
    bf16* BwT = XT + 64 * 136;
    bf16* Bm = BwT + 64 * 136;
    bf16* Cm = Bm + 128 * 72;
    bf16* Mm = Cm + 128 * 72;
    bf16* ST = Mm + 128 * 136;
    float* cum = (float*)(ST + 64 * 72);
    float* dtv = cum + 128; float* wv = dtv + 128; float* ecum = wv + 128; float* tot = ecum + 128;
    const float dsk = c.ssd_d()[l * 8 + h];
    const bf16* XCp = c.XC(); const float* DTp = c.DT(); bf16* Yp = c.Y(); const bf16* R1p = c.R1(); float* SSQp = c.SSQ();
    const int pi = w >> 1, nj0 = 2 * (w & 1);
    const int i = tid >> 2, part = tid & 3;
    for (int dir = 0; dir < 2; ++dir) {
        const float A = -__expf(c.a_log()[(l * 2 + dir) * 8 + h]);
        f32x4 Sacc[2];
        __syncthreads();
#pragma unroll
        for (int q = 0; q < 2; ++q)
#pragma unroll
            for (int r = 0; r < 4; ++r) { const int p = 16 * pi + 4 * lq + r, n = 16 * (nj0 + q) + lr;
                const float v = pass ? c.state_ssd()[(((((size_t)(b * 2 + l) * 2 + dir) * 8 + h) * 64 + p) * 64) + n] : 0.f;
                Sacc[q][r] = v; ST[p * 72 + n] = (bf16)f2bf(v); }
        v4u x0, x1, b0, b1, c0, c1; float d0 = 0.f, d1 = 0.f;
#define SSD_LOAD(ci_) { const int t_ = dir ? L - 1 - ((ci_) * 128 + i) : (ci_) * 128 + i; const bf16* xr_ = XCp + (size_t)(tok0 + t_) * 768; \
            x0 = *(const v4u*)(xr_ + h * 64 + part * 16); x1 = *(const v4u*)(xr_ + h * 64 + part * 16 + 8); \
            b0 = *(const v4u*)(xr_ + 512 + grp * 64 + part * 16); b1 = *(const v4u*)(xr_ + 512 + grp * 64 + part * 16 + 8); \
            c0 = *(const v4u*)(xr_ + 640 + grp * 64 + part * 16); c1 = *(const v4u*)(xr_ + 640 + grp * 64 + part * 16 + 8); \
            if (tid < 64) { const int i0_ = 2 * lane, ta_ = dir ? L - 1 - ((ci_) * 128 + i0_) : (ci_) * 128 + i0_, tb_ = dir ? ta_ - 1 : ta_ + 1; \
                d0 = DTp[(size_t)(tok0 + ta_) * 16 + dir * 8 + h]; d1 = DTp[(size_t)(tok0 + tb_) * 16 + dir * 8 + h]; } }
        SSD_LOAD(0);
        for (int ci = 0; ci < NCH; ++ci) {
            LDS_BARRIER();
            float bvals[16];
            { *(v4u*)(Bm + i * 72 + part * 16) = b0; *(v4u*)(Bm + i * 72 + part * 16 + 8) = b1;
              *(v4u*)(Cm + i * 72 + part * 16) = c0; *(v4u*)(Cm + i * 72 + part * 16 + 8) = c1;
              const unsigned xs[8] = {x0.x, x0.y, x0.z, x0.w, x1.x, x1.y, x1.z, x1.w};
#pragma unroll
              for (int j = 0; j < 8; ++j) { XT[(part * 16 + 2 * j) * 136 + i] = (bf16)(xs[j] & 0xffffu); XT[(part * 16 + 2 * j + 1) * 136 + i] = (bf16)(xs[j] >> 16); }
              float t8[8]; unpack8(b0, t8);
#pragma unroll
              for (int j = 0; j < 8; ++j) bvals[j] = t8[j];
              unpack8(b1, t8);
#pragma unroll
              for (int j = 0; j < 8; ++j) bvals[8 + j] = t8[j]; }
            if (tid < 64) {
                const int i0 = 2 * lane, i1 = i0 + 1;
                const float a0 = d0 * A, a1 = d1 * A; float s = a0 + a1;
#pragma unroll
                for (int o = 1; o < 64; o <<= 1) { const float v = __shfl_up(s, o); if (lane >= o) s += v; }
                const float cum1 = s, cum0 = s - a1, total = __shfl(s, 63);
                cum[i0] = cum0; cum[i1] = cum1; dtv[i0] = d0; dtv[i1] = d1;
                wv[i0] = __expf(total - cum0) * d0; wv[i1] = __expf(total - cum1) * d1; ecum[i0] = __expf(cum0); ecum[i1] = __expf(cum1);
                if (lane == 0) tot[0] = __expf(total);
            }
            if (ci + 1 < NCH) SSD_LOAD(ci + 1);
            unsigned short zz[16], yy[16];
            if (dir == 1) {
#pragma unroll
                for (int r = 0; r < 4; ++r) { const int tt = 16 * w + 4 * lq + r; const size_t m = (size_t)tok0 + (L - 1 - (ci * 128 + tt));
#pragma unroll
                    for (int jp = 0; jp < 4; ++jp) { zz[4 * r + jp] = R1p[m * 4096 + C_Z + h * 64 + 16 * jp + lr]; yy[4 * r + jp] = Yp[m * 2048 + h * 64 + 16 * jp + lr]; } }
            }
            LDS_BARRIER();
            { const float wi = wv[i];
#pragma unroll
              for (int j = 0; j < 16; ++j) BwT[(part * 16 + j) * 136 + i] = (bf16)f2bf(bvals[j] * wi); }
            bx8 cfr[2];
#pragma unroll
            for (int ks = 0; ks < 2; ++ks) cfr[ks] = *(const bx8*)(Cm + (16 * w + lr) * 72 + 32 * ks + 8 * lq);
            for (int j = 0; j <= w; ++j) {
                const bx8 bb0 = *(const bx8*)(Bm + (16 * j + lr) * 72 + 8 * lq), bb1 = *(const bx8*)(Bm + (16 * j + lr) * 72 + 32 + 8 * lq);
                f32x4 g = {0.f, 0.f, 0.f, 0.f};
                g = MFMA16(cfr[0], bb0, g); g = MFMA16(cfr[1], bb1, g);
                const int s = 16 * j + lr; const float cs = cum[s], ds = dtv[s];
#pragma unroll
                for (int r = 0; r < 4; ++r) { const int tt = 16 * w + 4 * lq + r; const float v = (s <= tt) ? g[r] * __expf(cum[tt] - cs) * ds : 0.f; Mm[tt * 136 + s] = (bf16)f2bf(v); }
            }
            if (!(w & 1)) {
#pragma unroll
                for (int r = 0; r < 4; ++r) Mm[(16 * w + 4 * lq + r) * 136 + 16 * (w + 1) + lr] = 0;
            }
            LDS_BARRIER();
            f32x4 yl[4], yo[4];
#pragma unroll
            for (int jp = 0; jp < 4; ++jp) { yl[jp] = (f32x4){0.f, 0.f, 0.f, 0.f}; yo[jp] = (f32x4){0.f, 0.f, 0.f, 0.f}; }
            for (int ks = 0; ks <= (w >> 1); ++ks) {
                const bx8 af = *(const bx8*)(Mm + (16 * w + lr) * 136 + 32 * ks + 8 * lq);
#pragma unroll
                for (int jp = 0; jp < 4; ++jp) { const bx8 xf = *(const bx8*)(XT + (16 * jp + lr) * 136 + 32 * ks + 8 * lq); yl[jp] = MFMA16(af, xf, yl[jp]); }
            }
#pragma unroll
            for (int ks = 0; ks < 2; ++ks)
#pragma unroll
                for (int jp = 0; jp < 4; ++jp) { const bx8 sf = *(const bx8*)(ST + (16 * jp + lr) * 72 + 32 * ks + 8 * lq); yo[jp] = MFMA16(cfr[ks], sf, yo[jp]); }
            {
#pragma unroll
                for (int r = 0; r < 4; ++r) {
                    const int tt = 16 * w + 4 * lq + r; const float ec = ecum[tt];
                    const int t = dir ? L - 1 - (ci * 128 + tt) : ci * 128 + tt; const size_t m = (size_t)tok0 + t;
                    float q = 0.f;
#pragma unroll
                    for (int jp = 0; jp < 4; ++jp) {
                        const int p = 16 * jp + lr; const float y = yl[jp][r] + ec * yo[jp][r];
                        if (dir == 0) Yp[m * 2048 + h * 64 + p] = (bf16)f2bf(y);
                        else { const float x = bf2f(XT[p * 136 + tt]); const float ytot = y + bf2f(yy[4 * r + jp]) + dsk * x; const float z = bf2f(zz[4 * r + jp]);
                            const float gt = ytot * siluf(z); Yp[m * 2048 + h * 64 + p] = (bf16)f2bf(gt); q += gt * gt; }
                    }
                    if (dir == 1) { q += __shfl_xor(q, 1); q += __shfl_xor(q, 2); q += __shfl_xor(q, 4); q += __shfl_xor(q, 8); if (lr == 0) atomicAdd(SSQp + m, q); }
                }
            }
            LDS_BARRIER();
            {
                f32x4 st[2] = {{0.f, 0.f, 0.f, 0.f}, {0.f, 0.f, 0.f, 0.f}};
#pragma unroll
                for (int ks = 0; ks < 4; ++ks) { const bx8 af = *(const bx8*)(XT + (16 * pi + lr) * 136 + 32 * ks + 8 * lq);
#pragma unroll
                    for (int q = 0; q < 2; ++q) { const bx8 bf = *(const bx8*)(BwT + (16 * (nj0 + q) + lr) * 136 + 32 * ks + 8 * lq); st[q] = MFMA16(af, bf, st[q]); } }
                const float et = tot[0];
#pragma unroll
                for (int q = 0; q < 2; ++q)
#pragma unroll
                    for (int r = 0; r < 4; ++r) { Sacc[q][r] = et * Sacc[q][r] + st[q][r]; ST[(16 * pi + 4 * lq + r) * 72 + 16 * (nj0 + q) + lr] = (bf16)f2bf(Sacc[q][r]); }
            }
        }
#undef SSD_LOAD
        if (!pass) {
#pragma unroll
            for (int q = 0; q < 2; ++q)
#pragma unroll
                for (int r = 0; r < 4; ++r) { const int p = 16 * pi + 4 * lq + r, n = 16 * (nj0 + q) + lr;
                    c.out()[O_SSD + (((((size_t)(b * 2 + l) * 2 + dir) * 8 + h) * 64 + p) * 64) + n] = Sacc[q][r]; }
        }
    }
}

__device__ __forceinline__ void s5_tables(const Ctx& c, int l, int g, int part, float* lf) {
    const int tid = c.tid;
    float* pw = lf;
    float* Bc = pw + 2 * 17 * 128;
    float* Cc = Bc + 2 * 2048;
    if (tid < 128) { const int dir = tid >> 6, n = tid & 63, idx = ((l * 2 + dir) * 32 + g) * 64 + n;
        const float lre = c.lam_re()[idx], lim = c.lam_im()[idx], step = expf(c.log_step()[(l * 2 + dir) * 32 + g]);
        for (int k = 0; k <= 16; ++k) { const float mag = expf(lre * step * (float)k); float sn, cs; sincosf(lim * step * (float)k, &sn, &cs); pw[((dir * 17 + k) * 64 + n) * 2] = mag * cs; pw[((dir * 17 + k) * 64 + n) * 2 + 1] = mag * sn; }
        const float mag = expf(lre * step); float sn, cs; sincosf(lim * step, &sn, &cs); const float are = mag * cs, aim = mag * sn;
        const float den = lre * lre + lim * lim, cre = ((are - 1.0f) * lre + aim * lim) / den, cim = (aim * lre - (are - 1.0f) * lim) / den;
        for (int mm = 0; mm < 16; ++mm) { const float br = c.b_re()[(size_t)idx * 16 + mm], bi = c.b_im()[(size_t)idx * 16 + mm]; Bc[((dir * 64 + n) * 16 + mm) * 2] = cre * br - cim * bi; Bc[((dir * 64 + n) * 16 + mm) * 2 + 1] = cre * bi + cim * br; }
    }
    for (int i = tid; i < 2048; i += NTHR) { const int dir = i >> 10, mm = (i >> 6) & 15, n = i & 63; const size_t src = ((size_t)((l * 2 + dir) * 32 + g) * 16 + mm) * 64 + n;
        Cc[i * 2] = c.c_re()[src]; Cc[i * 2 + 1] = c.c_im()[src]; }
    __syncthreads();
    if (part == 0 && tid < 128) { const int dir = tid >> 6, n = tid & 63; float* at = (float*)(c.ws() + WS_S5AT) + ((size_t)(dir * 32 + g) * 64 + n) * 2; at[0] = pw[((dir * 17 + 16) * 64 + n) * 2]; at[1] = pw[((dir * 17 + 16) * 64 + n) * 2 + 1]; }
    bf16* Kt = (bf16*)(c.ws() + WS_S5K) + (size_t)g * 31 * 256;
    for (int e = part * 1984 + tid; e < (part + 1) * 1984; e += NTHR) { const int tp = e >> 8, mm = (e >> 4) & 15, m2 = e & 15, tau = tp - 15; float acc = 0.f;
#pragma unroll
        for (int dir = 0; dir < 2; ++dir) { if ((dir == 0 && tau < 0) || (dir == 1 && tau > 0)) continue; const int k = tau < 0 ? -tau : tau;
            const float* pp = pw + (dir * 17 + k) * 128; const float* bb = Bc + dir * 2048 + m2 * 2; const float* cc = Cc + (dir * 16 + mm) * 128;
            for (int n = 0; n < 64; ++n) { const float pr = pp[2 * n], pi = pp[2 * n + 1], br = bb[n * 32], bi = bb[n * 32 + 1], Pr = pr * br - pi * bi, Pi = pr * bi + pi * br; acc += cc[2 * n] * Pr - cc[2 * n + 1] * Pi; } }
        if (tau == 0 && mm == m2) acc += c.s5_d()[l * 512 + g * 16 + mm];
        Kt[e] = (bf16)f2bf(acc); }
    for (int e = part * 16384 + tid; e < (part + 1) * 16384; e += NTHR) { const int dir = e >> 15, sidx = (e >> 8) & 127, k = e & 255, ri = sidx >> 6, n = sidx & 63, j = k >> 4, m2 = k & 15, ex = dir ? j : 15 - j;
        const float pr = pw[((dir * 17 + ex) * 64 + n) * 2], pi = pw[((dir * 17 + ex) * 64 + n) * 2 + 1], br = Bc[((dir * 64 + n) * 16 + m2) * 2], bi = Bc[((dir * 64 + n) * 16 + m2) * 2 + 1];
        ((bf16*)(c.ws() + WS_S5WS))[((size_t)(dir * 32 + g) * 128 + sidx) * 256 + k] = (bf16)f2bf(ri ? pr * bi + pi * br : pr * br - pi * bi); }
    for (int e = part * 16384 + tid; e < (part + 1) * 16384; e += NTHR) { const int row = e >> 8, k = e & 255, i = row >> 4, mm = row & 15, dir = k >> 7, ri = (k >> 6) & 1, n = k & 63, ex = dir ? 16 - i : i + 1;
        const float pr = pw[((dir * 17 + ex) * 64 + n) * 2], pi = pw[((dir * 17 + ex) * 64 + n) * 2 + 1], cr = Cc[((dir * 16 + mm) * 64 + n) * 2], ci = Cc[((dir * 16 + mm) * 64 + n) * 2 + 1];
        ((bf16*)(c.ws() + WS_S5WO))[(size_t)g * 65536 + e] = (bf16)f2bf(ri ? -(cr * pi + ci * pr) : cr * pr - ci * pi); }
    __syncthreads();
}

__device__ __forceinline__ void s5_unit(const Ctx& c, int l, int g, int cu, unsigned char* lds) {
    const int tid = c.tid, lane = c.lane, w = c.wave, lr = lane & 15, lq = lane >> 4;
    const bool lat = cu >= 8;
    bf16* Ut = (bf16*)lds;
    bf16* St = Ut + 64 * 264;
    bf16* Kt = St + 64 * 264;
    float* Dl = (float*)(Kt + 31 * 256);
    const bf16* R1p = c.R1();
    const bf16* Wsp0 = (const bf16*)(c.ws() + WS_S5WS) + ((size_t)(0 * 32 + g) * 128 + 16 * w + lr) * 256 + 8 * lq;
    const bf16* Wsp1 = (const bf16*)(c.ws() + WS_S5WS) + ((size_t)(1 * 32 + g) * 128 + 16 * w + lr) * 256 + 8 * lq;
    const bf16* Wop = (const bf16*)(c.ws() + WS_S5WO) + (size_t)g * 65536 + 8 * lq;
    bx8 afA[8], afB[8];
#pragma unroll
    for (int ks = 0; ks < 8; ++ks) afA[ks] = *(const bx8*)(Wsp0 + 32 * ks);
    { const v4u* src = (const v4u*)((const bf16*)(c.ws() + WS_S5K) + (size_t)g * 31 * 256); for (int i = tid; i < 31 * 32; i += NTHR) ((v4u*)Kt)[i] = src[i]; }
#pragma unroll
    for (int i = 0; i < 2; ++i) { const int id = tid + NTHR * i, col = id >> 4, j = id & 15;
        const int tok = lat ? MC + (cu - 8) * 1024 + col * 16 + j : (4 * cu + (col >> 4)) * 256 + (col & 15) * 16 + j;
        const bf16* up = R1p + (size_t)tok * 4096 + C_U + g * 16;
        *(v4u*)(Ut + col * 264 + j * 16) = *(const v4u*)up; *(v4u*)(Ut + col * 264 + j * 16 + 8) = *(const v4u*)(up + 8); }
#pragma unroll
    for (int ks = 0; ks < 8; ++ks) afB[ks] = *(const bx8*)(Wsp1 + 32 * ks);
    LDS_BARRIER();
#pragma unroll
    for (int dir = 0; dir < 2; ++dir) {
        f32x4 acc[4];
#pragma unroll
        for (int cb = 0; cb < 4; ++cb) acc[cb] = (f32x4){0.f, 0.f, 0.f, 0.f};
#pragma unroll
        for (int ks = 0; ks < 8; ++ks) {
#pragma unroll
            for (int cb = 0; cb < 4; ++cb) { const bx8 bf = *(const bx8*)(Ut + (16 * cb + lr) * 264 + 32 * ks + 8 * lq); acc[cb] = MFMA16(dir ? afB[ks] : afA[ks], bf, acc[cb]); }
            __builtin_amdgcn_sched_barrier(0); }
        if (dir == 0) {
#pragma unroll
            for (int ks = 0; ks < 8; ++ks) afA[ks] = *(const bx8*)(Wop + (size_t)(16 * (2 * w) + lr) * 256 + 32 * ks); }
        else {
#pragma unroll
            for (int ks = 0; ks < 8; ++ks) afB[ks] = *(const bx8*)(Wop + (size_t)(16 * (2 * w + 1) + lr) * 256 + 32 * ks); }
#pragma unroll
        for (int cb = 0; cb < 4; ++cb)
#pragma unroll
            for (int r = 0; r < 4; ++r) Dl[(16 * w + 4 * lq + r) * 65 + 16 * cb + lr] = acc[cb][r];
        LDS_BARRIER();
        if (tid < (lat ? 64 : 256)) {
            const int n = tid & 63, bl = tid >> 6, nc = lat ? 64 : 16, cbase = lat ? 0 : 16 * bl, b = lat ? cu - 8 : 4 * cu + bl;
            const float* at = (const float*)(c.ws() + WS_S5AT) + ((size_t)(dir * 32 + g) * 64 + n) * 2; const float ar = at[0], ai = at[1];
            float sr = 0.f, si = 0.f;
            if (lat) { sr = c.state_s5()[((((size_t)(b * 2 + l) * 2 + dir) * 2 + 0) * 32 + g) * 64 + n]; si = c.state_s5()[((((size_t)(b * 2 + l) * 2 + dir) * 2 + 1) * 32 + g) * 64 + n]; }
            for (int cc = 0; cc < nc; ++cc) { const int col = cbase + (dir ? nc - 1 - cc : cc);
                St[col * 264 + dir * 128 + n] = (bf16)f2bf(sr); St[col * 264 + dir * 128 + 64 + n] = (bf16)f2bf(si);
                const float dr = Dl[n * 65 + col], di = Dl[(64 + n) * 65 + col];
                const float nr = ar * sr - ai * si + dr, ni = ar * si + ai * sr + di; sr = nr; si = ni; }
            if (!lat) { c.out()[O_S5 + ((((size_t)(b * 2 + l) * 2 + dir) * 2 + 0) * 32 + g) * 64 + n] = sr; c.out()[O_S5 + ((((size_t)(b * 2 + l) * 2 + dir) * 2 + 1) * 32 + g) * 64 + n] = si; }
        }
        LDS_BARRIER();
    }
#pragma unroll
    for (int ii = 0; ii < 2; ++ii) { const int i = 2 * w + ii;
        f32x4 acc[4];
#pragma unroll
        for (int cb = 0; cb < 4; ++cb) acc[cb] = (f32x4){0.f, 0.f, 0.f, 0.f};
#pragma unroll
        for (int ks = 0; ks < 8; ++ks) { const int j = 2 * ks + (lq >> 1); const bx8 af = *(const bx8*)(Kt + ((i - j + 15) * 16 + lr) * 16 + 8 * (lq & 1));
#pragma unroll
            for (int cb = 0; cb < 4; ++cb) { const bx8 bf = *(const bx8*)(Ut + (16 * cb + lr) * 264 + 32 * ks + 8 * lq); acc[cb] = MFMA16(af, bf, acc[cb]); }
            __builtin_amdgcn_sched_barrier(0); }
#pragma unroll
        for (int ks = 0; ks < 8; ++ks) {
#pragma unroll
            for (int cb = 0; cb < 4; ++cb) { const bx8 bf = *(const bx8*)(St + (16 * cb + lr) * 264 + 32 * ks + 8 * lq); acc[cb] = MFMA16(ii ? afB[ks] : afA[ks], bf, acc[cb]); }
            __builtin_amdgcn_sched_barrier(0); }
#pragma unroll
        for (int cb = 0; cb < 4; ++cb) { const int col = 16 * cb + lr;
            const int tok = lat ? MC + (cu - 8) * 1024 + col * 16 + i : (4 * cu + (col >> 4)) * 256 + (col & 15) * 16 + i;
            v2u o; o.x = pk2(acc[cb][0], acc[cb][1]); o.y = pk2(acc[cb][2], acc[cb][3]);
            *(v2u*)(c.Y5() + (size_t)tok * 512 + g * 16 + 4 * lq) = o; }
    }
}

typedef float f32x16 __attribute__((ext_vector_type(16)));
#define MFMA32(a, b, cc) __builtin_amdgcn_mfma_f32_32x32x16_bf16((a), (b), (cc), 0, 0, 0)
constexpr float SM_SC = 0.125f * 1.4426950408889634f;
__device__ __forceinline__ void qk_tile(f32x16& p0, f32x16& p1, const bf16* Kt, int KS, const bx8 (&qf)[4], int r32, int hi) {
    p0 = (f32x16){0.f}; p1 = (f32x16){0.f};
    bx8 a0[4], a1[4];
#pragma unroll
    for (int d0 = 0; d0 < 4; ++d0) { a0[d0] = *(const bx8*)(Kt + r32 * KS + 16 * d0 + 8 * hi); a1[d0] = *(const bx8*)(Kt + (32 + r32) * KS + 16 * d0 + 8 * hi); }
    __builtin_amdgcn_s_setprio(1);
#pragma unroll
    for (int d0 = 0; d0 < 4; ++d0) { p0 = MFMA32(a0[d0], qf[d0], p0); p1 = MFMA32(a1[d0], qf[d0], p1); }
    __builtin_amdgcn_s_setprio(0);
}
__device__ __forceinline__ float fmax_(float a, float b) { float r; asm("v_max_f32_e32 %0, %1, %2" : "=v"(r) : "v"(a), "v"(b)); return r; }
__device__ __forceinline__ float max3_(float a, float b, float cc) { float r; asm("v_max3_f32 %0, %1, %2, %3" : "=v"(r) : "v"(a), "v"(b), "v"(cc)); return r; }
constexpr float SM_THR = 8.0f;
__device__ __forceinline__ float sm_step(f32x16& p0, f32x16& p1, float& mrun, float& lrun, bx8 (&pb)[4]) {
    float ta = max3_(p0[0], p1[0], p0[1]), tb = max3_(p1[1], p0[2], p1[2]);
#pragma unroll
    for (int r = 3; r < 15; r += 2) { ta = max3_(ta, p0[r], p1[r]); tb = max3_(tb, p0[r + 1], p1[r + 1]); }
    ta = max3_(ta, p0[15], p1[15]);
    float tm = fmax_(ta, tb) * SM_SC;
    tm = fmax_(tm, __shfl_xor(tm, 32));
    float alpha = 1.0f;
    if (__any(tm > mrun + SM_THR)) { const float mnew = fmax_(mrun, tm); alpha = __builtin_amdgcn_exp2f(mrun - mnew); mrun = mnew; }
    const float mn = mrun;
    float rs0 = 0.f, rs1 = 0.f;
#pragma unroll
    for (int r = 0; r < 16; ++r) { p0[r] = __builtin_amdgcn_exp2f(fmaf(p0[r], SM_SC, -mn)); p1[r] = __builtin_amdgcn_exp2f(fmaf(p1[r], SM_SC, -mn)); rs0 += p0[r]; rs1 += p1[r]; }
    float rs = rs0 + rs1;
    rs += __shfl_xor(rs, 32);
    lrun = lrun * alpha + rs;
#pragma unroll
    for (int sI = 0; sI < 2; ++sI) {
        v4u t0, t1;
        t0.x = pg8::cvt_pk_bf16(p0[8 * sI + 0], p0[8 * sI + 1]); t0.y = pg8::cvt_pk_bf16(p0[8 * sI + 2], p0[8 * sI + 3]); t0.z = pg8::cvt_pk_bf16(p0[8 * sI + 4], p0[8 * sI + 5]); t0.w = pg8::cvt_pk_bf16(p0[8 * sI + 6], p0[8 * sI + 7]);
        t1.x = pg8::cvt_pk_bf16(p1[8 * sI + 0], p1[8 * sI + 1]); t1.y = pg8::cvt_pk_bf16(p1[8 * sI + 2], p1[8 * sI + 3]); t1.z = pg8::cvt_pk_bf16(p1[8 * sI + 4], p1[8 * sI + 5]); t1.w = pg8::cvt_pk_bf16(p1[8 * sI + 6], p1[8 * sI + 7]);
        pb[sI] = __builtin_bit_cast(bx8, t0); pb[2 + sI] = __builtin_bit_cast(bx8, t1);
    }
    return alpha;
}
typedef short v4i16_t __attribute__((ext_vector_type(4)));
__device__ __forceinline__ v2u vtr(const bf16* p) { return __builtin_bit_cast(v2u, __builtin_amdgcn_ds_read_tr16_b64_v4i16((__attribute__((address_space(3))) v4i16_t*)p)); }
template <int NDT, int VS> __device__ __forceinline__ void pv_tile(f32x16 (&o)[NDT], const bf16* Vr, const bx8 (&pb)[4], int lane) {
    const bf16* vb = Vr + (4 * (lane >> 5) + ((lane & 15) >> 2)) * VS + 16 * ((lane >> 4) & 1) + 4 * (lane & 3);
    v2u cur[NDT][2], nxt[NDT][2];
#pragma unroll
    for (int dt = 0; dt < NDT; ++dt) { cur[dt][0] = vtr(vb + 32 * dt); cur[dt][1] = vtr(vb + 8 * VS + 32 * dt); }
#pragma unroll
    for (int ks = 0; ks < 4; ++ks) {
        if (ks < 3) {
#pragma unroll
            for (int dt = 0; dt < NDT; ++dt) { nxt[dt][0] = vtr(vb + (16 * (ks + 1)) * VS + 32 * dt); nxt[dt][1] = vtr(vb + (16 * (ks + 1) + 8) * VS + 32 * dt); }
        }
        __builtin_amdgcn_s_setprio(1);
#pragma unroll
        for (int dt = 0; dt < NDT; ++dt) { const v4u t = {cur[dt][0].x, cur[dt][0].y, cur[dt][1].x, cur[dt][1].y}; o[dt] = MFMA32(__builtin_bit_cast(bx8, t), pb[ks], o[dt]); }
        __builtin_amdgcn_s_setprio(0);
#pragma unroll
        for (int dt = 0; dt < NDT; ++dt) { cur[dt][0] = nxt[dt][0]; cur[dt][1] = nxt[dt][1]; }
    }
}

template <int PASS> __device__ __forceinline__ void diff_unit(const Ctx& c, int l, int uidx, unsigned char* lds) {
    constexpr int NT = PASS ? 10 : 2, NQB = PASS ? 8 : 2, VS = 160;
    const int tid = c.tid, lane = c.lane, w = c.wave, r32 = lane & 31, hi = lane >> 5, comp = w >> 2;
    const int qb = uidx % NQB, h = (uidx / NQB) & 3, b = uidx / (NQB * 4);
    const int tok0 = PASS ? MC + b * 1024 : b * 256;
    bf16* Kt = (bf16*)lds;
    bf16* Vr = Kt + 128 * 136;
    float* Ob = (float*)lds;
    const bf16* R1p = c.R1(); const bf16* CK = c.CKV() + (size_t)l * 1024 * 1280;
    const float lam_init = 0.8f - 0.6f * expf(-0.3f * (float)l);
    const float* lv = c.dlam() + l * 256;
    const float lam = expf(wave_sum(lv[lane] * lv[64 + lane])) - expf(wave_sum(lv[128 + lane] * lv[192 + lane])) + lam_init;
    const size_t mrow = (size_t)tok0 + qb * 128 + 32 * (w & 3) + r32;
    bx8 qf[4];
#pragma unroll
    for (int d0 = 0; d0 < 4; ++d0) qf[d0] = *(const bx8*)(R1p + mrow * 4096 + C_DQ + h * 128 + comp * 64 + 16 * d0 + 8 * hi);
    f32x16 o[4];
#pragma unroll
    for (int dt = 0; dt < 4; ++dt) o[dt] = (f32x16){0.f};
    float mrun = -1e30f, lrun = 0.f;
    v4u kreg[4], vreg[4];
#define DIFF_LOAD(t) { const bf16* kb; const bf16* vb; size_t rs; \
        if (PASS && (t) < 2) { kb = CK + ((size_t)b * 256 + 128 * (t)) * 1280 + h * 128; vb = kb + 512; rs = 1280; } \
        else { kb = R1p + ((size_t)tok0 + 128 * ((t) - (PASS ? 2 : 0))) * 4096 + C_DK + h * 128; vb = kb + (C_DV - C_DK); rs = 4096; } \
        _Pragma("unroll") for (int i = 0; i < 4; ++i) { const int id = tid + NTHR * i; kreg[i] = *(const v4u*)(kb + (size_t)(id >> 4) * rs + (id & 15) * 8); vreg[i] = *(const v4u*)(vb + (size_t)(id >> 4) * rs + (id & 15) * 8); } }
    DIFF_LOAD(0);
    for (int t = 0; t < NT; ++t) {
        LDS_BARRIER();
#pragma unroll
        for (int i = 0; i < 4; ++i) { const int id = tid + NTHR * i; *(v4u*)(Kt + (id >> 4) * 136 + (id & 15) * 8) = kreg[i]; *(v4u*)(Vr + (id >> 4) * VS + (id & 15) * 8) = vreg[i]; }
        if (t + 1 < NT) DIFF_LOAD(t + 1);
        LDS_BARRIER();
#pragma unroll
        for (int sub = 0; sub < 2; ++sub) {
            f32x16 p0, p1; bx8 pb[4];
            qk_tile(p0, p1, Kt + sub * 64 * 136 + comp * 64, 136, qf, r32, hi);
            const float alpha = sm_step(p0, p1, mrun, lrun, pb);
            if (__any(alpha != 1.0f)) {
#pragma unroll
                for (int dt = 0; dt < 4; ++dt)
#pragma unroll
                    for (int r = 0; r < 16; ++r) o[dt][r] *= alpha; }
            pv_tile<4, VS>(o, Vr + sub * 64 * VS, pb, lane);
        }
    }
#undef DIFF_LOAD
    const float inv = (comp ? lam : 1.0f) / lrun;
    const int rowl = 32 * (w & 3) + r32;
    LDS_BARRIER();
    if (comp) {
#pragma unroll
        for (int dt = 0; dt < 4; ++dt)
#pragma unroll
            for (int r = 0; r < 16; ++r) Ob[rowl * 129 + 32 * dt + (r & 3) + 8 * (r >> 2) + 4 * hi] = o[dt][r] * inv;
    }
    LDS_BARRIER();
    if (!comp) {
        float ss = 0.f;
#pragma unroll
        for (int dt = 0; dt < 4; ++dt)
#pragma unroll
            for (int r = 0; r < 16; ++r) { const float v = o[dt][r] * inv - Ob[rowl * 129 + 32 * dt + (r & 3) + 8 * (r >> 2) + 4 * hi]; o[dt][r] = v; ss += v * v; }
        ss += __shfl_xor(ss, 32);
        const float rn = rsqrtf(ss * (1.0f / 128.0f) + EPS) * (1.0f - lam_init);
        const float* sg = c.subln_g() + l * 128; bf16* yp = c.Y() + mrow * 2048 + 1024 + h * 128;
#pragma unroll
        for (int dt = 0; dt < 4; ++dt)
#pragma unroll
            for (int r4 = 0; r4 < 4; ++r4) { const int dv = 32 * dt + 8 * r4 + 4 * hi; const f32x4 g = *(const f32x4*)(sg + dv);
                v2u ov; ov.x = pk2(o[dt][4 * r4 + 0] * rn * g.x, o[dt][4 * r4 + 1] * rn * g.y); ov.y = pk2(o[dt][4 * r4 + 2] * rn * g.z, o[dt][4 * r4 + 3] * rn * g.w);
                *(v2u*)(yp + dv) = ov; }
    }
}

template <int PASS> __device__ __forceinline__ void win_unit(const Ctx& c, int l, int uidx, unsigned char* lds) {
    constexpr int NQB = PASS ? 4 : 1, VS = 96;
    const int tid = c.tid, lane = c.lane, w = c.wave, r32 = lane & 31, hi = lane >> 5;
    const int qb = uidx % NQB, hh = (uidx / NQB) & 7, b = uidx / (NQB * 8), nkv = hh >> 2;
    const int tok0 = PASS ? MC + b * 1024 : b * 256;
    bf16* Kt = (bf16*)lds;
    bf16* Vr = Kt + 128 * 72;
    const bf16* R1p = c.R1(); const bf16* CK = c.CKV() + (size_t)l * 1024 * 1280;
    const int qrow = qb * 256 + 32 * w + r32;
    const size_t mrow = (size_t)tok0 + qrow;
    bx8 qf[4];
#pragma unroll
    for (int d0 = 0; d0 < 4; ++d0) qf[d0] = *(const bx8*)(R1p + mrow * 4096 + C_WQ + hh * 64 + 16 * d0 + 8 * hi);
    f32x16 o[2]; o[0] = (f32x16){0.f}; o[1] = (f32x16){0.f};
    float mrun = c.sink()[l * 8 + hh] * 1.4426950408889634f, lrun = 1.0f;
    const int q0 = qb * 256;
    const int tb0 = PASS ? ((q0 - 128 < 0 ? 0 : q0 - 128) >> 7) : 0, tb1 = PASS ? ((q0 + 255 + 128 > 1023 ? 1023 : q0 + 255 + 128) >> 7) : 0;
    const int NT = PASS ? 2 + (tb1 - tb0 + 1) : 2;
    v4u kreg[2], vreg[2];
#define WIN_LOAD(t) { const bf16* kb; const bf16* vb; size_t rs; \
        if (PASS && (t) < 2) { kb = CK + ((size_t)b * 256 + 128 * (t)) * 1280 + 1024 + nkv * 64; vb = kb + 128; rs = 1280; } \
        else { kb = R1p + ((size_t)tok0 + 128 * (PASS ? tb0 + (t) - 2 : (t))) * 4096 + C_WK + nkv * 64; vb = kb + (C_WV - C_WK); rs = 4096; } \
        _Pragma("unroll") for (int i = 0; i < 2; ++i) { const int id = tid + NTHR * i; kreg[i] = *(const v4u*)(kb + (size_t)(id >> 3) * rs + (id & 7) * 8); vreg[i] = *(const v4u*)(vb + (size_t)(id >> 3) * rs + (id & 7) * 8); } }
    WIN_LOAD(0);
    for (int t = 0; t < NT; ++t) {
        LDS_BARRIER();
#pragma unroll
        for (int i = 0; i < 2; ++i) { const int id = tid + NTHR * i; *(v4u*)(Kt + (id >> 3) * 72 + (id & 7) * 8) = kreg[i]; *(v4u*)(Vr + (id >> 3) * VS + (id & 7) * 8) = vreg[i]; }
        if (t + 1 < NT) WIN_LOAD(t + 1);
        LDS_BARRIER();
#pragma unroll
        for (int sub = 0; sub < 2; ++sub) {
            bool band = false; int kp0 = 0;
            if (PASS && t >= 2) { band = true; kp0 = 128 * (tb0 + t - 2) + 64 * sub; const int r0 = q0 + 32 * w;
                if (kp0 + 63 < r0 - 128 || kp0 > r0 + 31 + 128) continue; }
            f32x16 p0, p1; bx8 pb[4];
            qk_tile(p0, p1, Kt + sub * 64 * 72, 72, qf, r32, hi);
            if (band) {
#pragma unroll
                for (int r = 0; r < 16; ++r) { const int kp = kp0 + (r & 3) + 8 * (r >> 2) + 4 * hi; const int d0 = qrow - kp, d1 = d0 - 32;
                    if (d0 > 128 || d0 < -128) p0[r] = -1e30f; if (d1 > 128 || d1 < -128) p1[r] = -1e30f; }
            }
            const float alpha = sm_step(p0, p1, mrun, lrun, pb);
            if (__any(alpha != 1.0f)) {
#pragma unroll
                for (int dt = 0; dt < 2; ++dt)
#pragma unroll
                    for (int r = 0; r < 16; ++r) o[dt][r] *= alpha; }
            pv_tile<2, VS>(o, Vr + sub * 64 * VS, pb, lane);
        }
    }
#undef WIN_LOAD
    const float inv = 1.0f / lrun; bf16* yp = c.Y() + mrow * 2048 + 1536 + hh * 64;
#pragma unroll
    for (int dt = 0; dt < 2; ++dt)
#pragma unroll
        for (int r4 = 0; r4 < 4; ++r4) { const int dv = 32 * dt + 8 * r4 + 4 * hi;
            v2u ov; ov.x = pk2(o[dt][4 * r4 + 0] * inv, o[dt][4 * r4 + 1] * inv); ov.y = pk2(o[dt][4 * r4 + 2] * inv, o[dt][4 * r4 + 3] * inv);
            *(v2u*)(yp + dv) = ov; }
}

__device__ __forceinline__ void phase_mixers(const Ctx& c_in, int l, float* lf) {
    unsigned char* lds = (unsigned char*)lf;
    unsigned* qctr = (unsigned*)(c_in.ws() + WS_QCTR) + 64 * l;
    volatile int* qslot = (volatile int*)(lds + LDS_BYTES - 32);
    for (;;) {
        __syncthreads();
        if (threadIdx.x == 0) *qslot = (int)atomicAdd(qctr, 1u);
        __syncthreads();
        const int u = __builtin_amdgcn_readfirstlane(*qslot);
        if (u >= 1440) break;
        Ctx c = c_in; asm volatile("" : "+s"(c.ap), "+v"(c.tid));
        c.lane = c.tid & 63; c.wave = __builtin_amdgcn_readfirstlane(c.tid >> 6);
        unsigned long long pt0 = 0; if (PROBE_SEL >= 0) pt0 = __builtin_amdgcn_s_memrealtime();
        int ty;
        if (u < 32) { ssd_unit(c, l, 1, u >> 3, u & 7, lds); ty = 0; }
        else if (u < 160) { diff_unit<1>(c, l, u - 32, lds); ty = 2; }
        else if (u < 288) { win_unit<1>(c, l, u - 160, lds); ty = 3; }
        else if (u < 416) { s5_unit(c, l, (u - 288) & 31, 8 + ((u - 288) >> 5), lds); ty = 1; }
        else if (u < 672) { ssd_unit(c, l, 0, (u - 416) >> 3, (u - 416) & 7, lds); ty = 4; }
        else if (u < 928) { diff_unit<0>(c, l, u - 672, lds); ty = 6; }
        else if (u < 1184) { s5_unit(c, l, (u - 928) & 31, (u - 928) >> 5, lds); ty = 5; }
        else { win_unit<0>(c, l, u - 1184, lds); ty = 7; }
        __syncthreads();
        if (PROBE_SEL >= 0 && threadIdx.x == 0) { unsigned long long* tsu = (unsigned long long*)(c.ws() + WS_TS) + 64; atomicAdd(tsu + ty, (unsigned long long)(__builtin_amdgcn_s_memrealtime() - pt0)); }
    }
}

__device__ __forceinline__ void phase_sum4(const Ctx& c) {
    const int gt = blockIdx.x * NTHR + c.tid, NT = gridDim.x * NTHR;
#pragma unroll 4
    for (int i = gt; i < M * 128; i += NT) { const size_t m = (size_t)(i >> 7); const int c8 = (i & 127) * 8;
        float a[8] = {0.f, 0.f, 0.f, 0.f, 0.f, 0.f, 0.f, 0.f};
#pragma unroll
        for (int j = 0; j < 4; ++j) { float f[8]; unpack8(*(const v4u*)(c.R1() + m * 4096 + j * 1024 + c8), f);
#pragma unroll
            for (int k = 0; k < 8; ++k) a[k] += f[k]; }
        v4u o; o.x = pk2(a[0], a[1]); o.y = pk2(a[2], a[3]); o.z = pk2(a[4], a[5]); o.w = pk2(a[6], a[7]);
        *(v4u*)(c.H() + m * 1024 + c8) = o; }
}

#define GAS __attribute__((address_space(1)))
#define XB_TMO      128
#define XB_XCNT(j)  (256  + 64 * (j))
#define XB_XSUB(j)  (1280 + 64 * (j))
#define XB_XGEN(j)  (2304 + 64 * (j))
#define XB_TOP      3328
#define XB_TOPGEN   3392
#define XCD_BAR_WORDS 3456
#define XB_SPIN_CAP (1u << 18)

__device__ __forceinline__ unsigned xb_ld(unsigned* p)              { return __hip_atomic_load(p, __ATOMIC_RELAXED, __HIP_MEMORY_SCOPE_AGENT); }
__device__ __forceinline__ unsigned xb_add(unsigned* p, unsigned v) { return __hip_atomic_fetch_add(p, v, __ATOMIC_RELAXED, __HIP_MEMORY_SCOPE_AGENT); }
__device__ __forceinline__ unsigned xb_xcc_id() { return (unsigned)__builtin_amdgcn_s_getreg((3 << 11) | 20) & 0xFu; }
#define XB_SPIN(cond, bar) do { unsigned _sp = 0; while (cond) { __builtin_amdgcn_s_sleep(1); \
    if ((++_sp & 255u) == 0u) { if (xb_ld(&(bar)[XB_TMO])) break; if (_sp > XB_SPIN_CAP) { atomicAdd(&(bar)[XB_TMO], 1u); break; } } } } while (0)

struct XcdBarrier {
    unsigned* bar; unsigned x;
    volatile LAS unsigned* st;
};

__device__ __forceinline__ XcdBarrier xcd_barrier_post(unsigned* bar, volatile LAS unsigned* st) {
    XcdBarrier b; b.bar = bar; b.x = xb_xcc_id(); b.st = st;
    if (threadIdx.x == 0) (void)xb_add(&bar[XB_XCNT(b.x)], 1u);
    return b;
}
__device__ __forceinline__ void xcd_barrier_complete(unsigned* bar, unsigned x, unsigned& nloc, unsigned& nx) {
    const unsigned G = gridDim.x * gridDim.y * gridDim.z;
    unsigned sum, cnt, mine, sp = 0u;
    for (;;) {
        sum = 0u; cnt = 0u; mine = 0u;
#pragma unroll
        for (unsigned j = 0; j < 16; ++j) { const unsigned c = xb_ld(&bar[XB_XCNT(j)]); sum += c; cnt += (c > 0u) ? 1u : 0u; mine = (j == x) ? c : mine; }
        if (sum == G) break;
        __builtin_amdgcn_s_sleep(1);
        if ((++sp & 255u) == 0u) { if (xb_ld(&bar[XB_TMO])) break; if (sp > XB_SPIN_CAP) { atomicAdd(&bar[XB_TMO], 1u); break; } }
    }
    nloc = mine > 0u ? mine : 1u; nx = cnt > 0u ? cnt : 1u;
}

__device__ __forceinline__ void xcd_barrier(const XcdBarrier& b) {
    asm volatile("s_waitcnt vmcnt(0)" ::: "memory");
    __syncthreads();
    if (threadIdx.x == 0) {
        unsigned* bar = b.bar;
        __builtin_amdgcn_s_waitcnt(0);
        unsigned nloc = b.st[0], nx = b.st[1];
        if (nloc == 0u) { xcd_barrier_complete(bar, b.x, nloc, nx); b.st[0] = nloc; b.st[1] = nx; }
        const unsigned old = xb_add(&bar[XB_XSUB(b.x)], 1u);
        const unsigned gen = old / nloc;
        if (old + 1u == (gen + 1u) * nloc) {
            __builtin_amdgcn_fence(__ATOMIC_RELEASE, "agent");
            asm volatile("s_waitcnt vmcnt(0)" ::: "memory");
            const unsigned og = xb_add(&bar[XB_TOP], 1u);
            const unsigned tg = og / nx;
            if (og + 1u == (tg + 1u) * nx) xb_add(&bar[XB_TOPGEN], 1u);
            else XB_SPIN(xb_ld(&bar[XB_TOPGEN]) == tg, bar);
            __builtin_amdgcn_fence(__ATOMIC_ACQUIRE, "agent");
            xb_add(&bar[XB_XGEN(b.x)], 1u);
            asm volatile("s_waitcnt vmcnt(0)" ::: "memory");
        } else {
            XB_SPIN(xb_ld(&bar[XB_XGEN(b.x)]) == gen, bar);
            __builtin_amdgcn_fence(__ATOMIC_ACQUIRE, "agent");
            asm volatile("s_waitcnt vmcnt(0)" ::: "memory");
        }
    }
    __syncthreads();
}

#define PHASE_BEGIN() Ctx c; c.ap = (CArgs)__builtin_amdgcn_kernarg_segment_ptr(); asm volatile("" : "+s"(c.ap)); \
        int tid_o = threadIdx.x; asm volatile("" : "+v"(tid_o)); c.tid = tid_o; c.lane = tid_o & 63; c.wave = __builtin_amdgcn_readfirstlane(tid_o >> 6); \
        int G = gridDim.x, bid = blockIdx.x; asm volatile("" : "+s"(G), "+s"(bid)); unsigned char* ws = c.ws(); (void)ws; (void)G; (void)bid;
#define PHASE_END(k) { if ((k) + 1 < ph_hi) { if ((k) == 0) cg::this_grid().sync(); else xcd_barrier(xbar); } \
        if (PROBE_SEL >= 0 && blockIdx.x == PROBE_PB && threadIdx.x == 0) ((unsigned long long*)(c.ws() + WS_TS))[(k) + 1] = __builtin_amdgcn_s_memrealtime(); }
#define IN_RANGE(k) (ph_lo <= (k) && (k) < ph_hi)

template <int LAYER> __device__ __forceinline__ void layer_program(int ph_lo, int ph_hi, unsigned char* lds, const XcdBarrier& xbar) {
    float* lf = (float*)lds;
    PG8_LAS unsigned char* ring = (PG8_LAS unsigned char*)lds;
    constexpr int l = LAYER, B0 = 1 + 11 * LAYER;
    if (IN_RANGE(B0 + 0)) { PHASE_BEGIN(); if (l == 1) { if (gridDim.x == 256) convert_items(c, 1, 7936, 9984, blockIdx.x * NWAVES + c.wave, gridDim.x * NWAVES, false, 0, 1, lf); else phase_convert(c, 1, lf); __syncthreads(); } phase_norm(c, l, 0, lf); phase_bias2(c, l); PHASE_END(B0 + 0); }
    if (IN_RANGE(B0 + 1)) { PHASE_BEGIN();
        pg8::Gemm g{c.H(), (const bf16*)(ws + W_IN), M, 4096, 1024, 1024, 1024, 0, 0}; pg8::StaticOrder S; S.init(M, 4096, G, bid);
        pg8::EpiIn E{c.R1(), c.out(), c.ROPE(), c.qn_g() + l * 64, c.kn_g() + l * 64, c.wqn_g() + l * 64, c.wkn_g() + l * 64, l};
        pg8::gemm_phase<pg8::EpiIn, pg8::StaticOrder, true, true>(ring, g, S, E, tid_o); PHASE_END(B0 + 1); }
    if (IN_RANGE(B0 + 2)) { PHASE_BEGIN(); phase_dt(c, l); phase_qk(c, l, lf); PHASE_END(B0 + 2); }
    if (IN_RANGE(B0 + 3)) { PHASE_BEGIN(); phase_mixers(c, l, lf); PHASE_END(B0 + 3); }
    if (IN_RANGE(B0 + 4)) { PHASE_BEGIN();
        pg8::Gemm g{c.Y5(), (const bf16*)(ws + W_GLU), M, 1024, 512, 512, 512, 0, 0}; pg8::StaticOrder S; S.init(M, 1024, G, bid);
        pg8::EpiGlu E{c.Y(), 2048, 512, c.b_glu() + l * 1024};
        pg8::gemm_phase<pg8::EpiGlu, pg8::StaticOrder, true, true>(ring, g, S, E, tid_o); PHASE_END(B0 + 4); }
    if (IN_RANGE(B0 + 5)) { PHASE_BEGIN();
        pg8::Gemm g{c.Y(), (const bf16*)(ws + W_BR), M, 4096, 512, 2048, 512, 4, 1024}; pg8::StaticOrder S; S.init(M, 4096, G, bid);
        pg8::EpiB<8> E{c.R1(), 4096, nullptr, c.SSQ()};
        pg8::gemm_phase<pg8::EpiB<8>, pg8::StaticOrder, true, true>(ring, g, S, E, tid_o); PHASE_END(B0 + 5); }
    if (IN_RANGE(B0 + 6)) { PHASE_BEGIN();
        pg8::Gemm g{c.H(), (const bf16*)(ws + W_G), M, 4096, 1024, 1024, 1024, 0, 0}; pg8::StaticOrder S; S.init(M, 4096, G, bid);
        pg8::EpiGateMerge E{c.R1(), c.Y(), c.b_gate() + l * 4096};
        pg8::gemm_phase<pg8::EpiGateMerge, pg8::StaticOrder, true, true>(ring, g, S, E, tid_o); PHASE_END(B0 + 6); }
    if (IN_RANGE(B0 + 7)) { PHASE_BEGIN();
        pg8::Gemm g{c.Y(), (const bf16*)(ws + W_OUT), M, 1024, 1024, 1024, 1024, 0, 0}; pg8::StaticOrder S; S.init(M, 1024, G, bid);
        pg8::EpiRes2 E{l == 0 ? c.x_prompt() : c.out(), l == 0 ? c.x_sample() : c.out() + (size_t)MC * D, c.out(), c.MOD() + (size_t)l * 5 * 6144, 2048, c.H(), c.g_norm2() + l * 1024, 4096, (float*)(ws + WS_SSQ2)};
        pg8::gemm_phase<pg8::EpiRes2, pg8::StaticOrder, true, true>(ring, g, S, E, tid_o); if (l == 0) side_convert(c, 0, 5376, false, lf); PHASE_END(B0 + 7); }
    if (IN_RANGE(B0 + 9)) { PHASE_BEGIN();
        pg8::Gemm g{c.H(), (const bf16*)(ws + W_1), M, 4096, 1024, 1024, 1024, 0, 0}; pg8::StaticOrder S; S.init(M, 4096, G, bid);
        pg8::EpiB<5> E{c.R1(), 4096, (const float*)(ws + WS_BI2), (const float*)(ws + WS_SSQ2)};
        pg8::gemm_phase<pg8::EpiB<5>, pg8::StaticOrder, true, true>(ring, g, S, E, tid_o); PHASE_END(B0 + 9); }
    if (IN_RANGE(B0 + 10)) { PHASE_BEGIN();
        pg8::Gemm g{c.R1(), (const bf16*)(ws + W_2), M, 1024, 4096, 4096, 4096, 0, 0}; pg8::StaticOrder S; S.init(M, 1024, G, bid);
        pg8::EpiRes E{c.out(), c.out() + (size_t)MC * D, c.out(), c.MOD() + (size_t)l * 5 * 6144, 5120};
        pg8::gemm_phase<pg8::EpiRes, pg8::StaticOrder, true, true>(ring, g, S, E, tid_o); if (l == 0) side_convert(c, 5376, 7936, true, lf); PHASE_END(B0 + 10); }
}

__global__ void __launch_bounds__(NTHR, 2) fwd_kernel(Args args) {
    extern __shared__ __attribute__((aligned(16))) unsigned char lds[];
    const int ph_lo = args.ph_lo, ph_hi = args.ph_hi;
    volatile LAS unsigned* xst = (volatile LAS unsigned*)(lds + LDS_BYTES - 16);
    if (threadIdx.x < 4) xst[threadIdx.x] = 0u;
    __syncthreads();
    const XcdBarrier xbar = xcd_barrier_post((unsigned*)(args.ws + WS_BAR), xst);
    if (PROBE_SEL >= 0 && blockIdx.x == PROBE_PB && threadIdx.x == 0) { unsigned long long* ts = (unsigned long long*)(args.ws + WS_TS); ts[0] = __builtin_amdgcn_s_memrealtime(); }
    if (IN_RANGE(0)) { PHASE_BEGIN(); float* lf = (float*)lds; phase_mods(c, lf); __syncthreads(); phase_convert(c, 0, lf); phase_rope_table(c); phase_ckv(c); PHASE_END(0); }
    layer_program<0>(ph_lo, ph_hi, lds, xbar);
    layer_program<1>(ph_lo, ph_hi, lds, xbar);
    if (PROBE_SEL >= 0) {
        __threadfence(); cg::this_grid().sync();
        const unsigned long long* ts = (const unsigned long long*)(args.ws + WS_TS);
        const float total = (float)(ts[23] - ts[0]); float sel = 0.f;
        for (int k = 0; k < 23; ++k) { const float d = (float)(ts[k + 1] - ts[k]); const int q = k == 0 ? -1 : (k - 1) % 11;
            const int cls = (q == 3) ? 0 : (q == 1 || q == 4 || q == 5 || q == 7 || q == 9 || q == 10) ? 1 : (q == 2) ? 2 : 3;
            if (cls == PROBE_SEL) sel += d; }
        if (PROBE_SEL >= 10 && PROBE_SEL < 100) sel = (float)ts[64 + PROBE_SEL - 10] * (1.0f / 256.0f);
        if (PROBE_SEL >= 100) { const int k = PROBE_SEL - 100; sel = (float)(ts[k + 1] - (ts[k] != 0ull ? ts[k] : ts[k - 1])); }
        const float sc = 1.0f + sqrtf(PROBE_SCALE * sel / total);
        for (int i = blockIdx.x * NTHR + threadIdx.x; i < 524288; i += gridDim.x * NTHR) args.out[O_S5 + i] *= sc;
    }
}

extern "C" void kernel_launch(void* const* d_in, const int* in_sizes, int n_in, void* d_out, int out_size, void* d_ws, size_t ws_size, hipStream_t stream) {
    static int grid = 0;
    if (grid == 0) {
        if (n_in != 44 || ws_size < WS_END) { fprintf(stderr, "kernel_launch: expected 44 inputs and >= %zu bytes of workspace; got %d, %zu\n", (size_t)WS_END, n_in, ws_size); grid = -1; return; }
        int dev = 0, cus = 0, per_cu = 0;
        (void)hipGetDevice(&dev); (void)hipDeviceGetAttribute(&cus, hipDeviceAttributeMultiprocessorCount, dev);
        (void)hipFuncSetAttribute((const void*)fwd_kernel, hipFuncAttributeMaxDynamicSharedMemorySize, LDS_BYTES);
        (void)hipOccupancyMaxActiveBlocksPerMultiprocessor(&per_cu, (const void*)fwd_kernel, NTHR, LDS_BYTES);
        if (per_cu < 1) { fprintf(stderr, "kernel_launch: occupancy query says %d blocks per CU\n", per_cu); per_cu = 1; }
        (void)hipGetLastError();
        grid = cus > 0 ? cus : 256;
    }
    if (grid < 0) return;
    (void)hipMemsetAsync(d_ws, 0, 64 * 1024, stream);
    Args a{};
    for (int i = 0; i < 44; ++i) a.in[i] = (const float*)d_in[i];
    a.out = (float*)d_out; a.ws = (unsigned char*)d_ws;
#if MK_MULTI
    for (int ph = 0; ph < NPH; ++ph) { a.ph_lo = ph; a.ph_hi = ph + 1; hipLaunchKernelGGL(fwd_kernel, dim3(grid), dim3(NTHR), LDS_BYTES, stream, a); }
#else
    a.ph_lo = 0; a.ph_hi = NPH;
    void* kargs[] = {&a};
    hipError_t e = hipLaunchCooperativeKernel((const void*)fwd_kernel, dim3(grid), dim3(NTHR), kargs, LDS_BYTES, stream);
    if (e != hipSuccess) fprintf(stderr, "cooperative launch failed: %s (grid %d)\n", hipGetErrorString(e), grid);
#endif
}
```

```cpp
#include <hip/hip_runtime.h>
#include <hip/hip_cooperative_groups.h>
#include <cstdio>
#include <cstdint>
namespace cg = cooperative_groups;

#ifndef MK_MULTI
#define MK_MULTI 0
#endif

namespace pg8 {
#define PG8_LAS __attribute__((address_space(3)))
typedef unsigned short bf16_t;
typedef short bf16x8 __attribute__((ext_vector_type(8)));
typedef float f32x4 __attribute__((ext_vector_type(4)));
typedef unsigned u32x4 __attribute__((ext_vector_type(4)));
constexpr int BM = 256, BK = 64, HALF = 128, HTB = HALF * BK * 2  , STAGE_BYTES = 8 * HTB, NXCD = 8, WGM = 8;

__host__ __device__ __forceinline__ int lds_byte(int r, int c) { const int st = (r >> 4) * 2 + (c >> 5), rr = r & 15, cc = c & 31, ob = rr * 64 + cc * 2; return st * 1024 + (ob ^ (((ob >> 9) & 1) << 5)); }
__host__ __device__ __forceinline__ void stage_rc(int b, int& R, int& C) { const int st = b / 1024, sb = b % 1024, swz = sb ^ (((sb >> 9) & 1) << 5); R = (st >> 1) * 16 + swz / 64; C = (st & 1) * 32 + (swz % 64) / 2; }
__host__ __device__ __forceinline__ int perm32(int rho) { const int n = rho >> 4, i = rho & 15; return 8 * (i >> 2) + 4 * n + (i & 3); }

struct Unit { int pm, pn; };
struct Gemm { const bf16_t* A; const bf16_t* Bt; int M, N, K, lda, ldb, a_div; size_t a_gstride; };

struct StaticOrder {
    int nM, nN, nwg, G, c;
    __host__ __device__ void init(int M, int N, int G_, int c_) { nM = M / BM; nN = N / BM; nwg = nM * nN; G = G_; c = c_; }
    __host__ __device__ bool next(int i, Unit& u) const {
        const long L = (long)i * G + c; if (L >= nwg) return false;
        int wgid = (int)L; { const int q = nwg / NXCD, r = nwg % NXCD, xcd = wgid % NXCD, off = wgid / NXCD; wgid = (xcd < r ? xcd * (q + 1) : r * (q + 1) + (xcd - r) * q) + off; }
        const int nig = WGM * nN, gid = wgid / nig, fm = gid * WGM, gsz = (nM - fm) < WGM ? (nM - fm) : WGM;
        u.pm = fm + ((wgid % nig) % gsz); u.pn = (wgid % nig) / gsz; return true;
    }
    __device__ __forceinline__ void a_ready(const Unit&) const {}
    __device__ __forceinline__ void done(const Unit&) const {}
};

__device__ __forceinline__ unsigned cvt_pk_bf16(float lo, float hi) { unsigned r; asm volatile("v_cvt_pk_bf16_f32 %0, %1, %2" : "=v"(r) : "v"(lo), "v"(hi)); return r; }
__device__ __forceinline__ float bf_lo(unsigned w) { return __builtin_bit_cast(float, w << 16); }
__device__ __forceinline__ float bf_hi(unsigned w) { return __builtin_bit_cast(float, w & 0xffff0000u); }
__device__ __forceinline__ float sigmoidf_(float x) { return 1.0f / (1.0f + __expf(-x)); }

template <int MODE> struct EpiB {
    static constexpr bool PERM = true, AFTER_DRAIN = false;
    bf16_t* O; int ldc; const float* bias; const float* ssq;
    __device__ __forceinline__ void operator()(const f32x4 (&acc)[2][2][4][2], const Unit& u, int wr, int wc, int fr, int fq) const {
        const int row0 = u.pm * BM + wr * 64 + fr, col0 = u.pn * BM + wc * 32 + 8 * fq;
        f32x4 bv[2][2];
#pragma unroll
        for (int bj = 0; bj < 2; ++bj)
#pragma unroll
            for (int n = 0; n < 2; ++n) bv[bj][n] = (MODE == 1) ? *(const f32x4*)(bias + col0 + bj * HALF + 4 * n) : (MODE == 5) ? *(const f32x4*)(bias + (size_t)((u.pm < 32) ? 0 : 1 + ((u.pm - 32) >> 2)) * 4096 + col0 + bj * HALF + 4 * n) : (f32x4){0.f, 0.f, 0.f, 0.f};
        u32x4 gpre[2][4][2]; float rpre[2][4];
        if (MODE == 3) {
#pragma unroll
            for (int ai = 0; ai < 2; ++ai)
#pragma unroll
                for (int m = 0; m < 4; ++m) { const int row = row0 + ai * HALF + m * 16; const bf16_t* rp = O + (size_t)row * ldc + col0;
                    rpre[ai][m] = (u.pn < 4) ? ssq[row] : 512.0f;
#pragma unroll
                    for (int bj = 0; bj < 2; ++bj) gpre[ai][m][bj] = *(const u32x4*)(rp + bj * HALF); }
        }
#pragma unroll
        for (int ai = 0; ai < 2; ++ai)
#pragma unroll
            for (int m = 0; m < 4; ++m) {
                const int row = row0 + ai * HALF + m * 16;
                bf16_t* rowp = O + (size_t)row * ldc + col0;
                float rs = 1.f;
                if (MODE == 3) { if (u.pn < 4) rs = rsqrtf(rpre[ai][m] * (1.0f / 512.0f) + 1e-6f); }
                if (MODE == 5) rs = rsqrtf(ssq[row] * (1.0f / 1024.0f) + 1e-6f);
                if (MODE == 8) { if (u.pn < 4) rs = rsqrtf(ssq[row] * (1.0f / 512.0f) + 1e-6f); }
#pragma unroll
                for (int bj = 0; bj < 2; ++bj) {
                    f32x4 v0 = ((MODE == 5 || MODE == 8) ? acc[ai][bj][m][0] * rs : acc[ai][bj][m][0]) + bv[bj][0], v1 = ((MODE == 5 || MODE == 8) ? acc[ai][bj][m][1] * rs : acc[ai][bj][m][1]) + bv[bj][1];
                    if (MODE == 1) {
#pragma unroll
                        for (int j = 0; j < 4; ++j) { v0[j] = sigmoidf_(v0[j]); v1[j] = sigmoidf_(v1[j]); }
                    }
                    if (MODE == 2 || MODE == 5) {
#pragma unroll
                        for (int j = 0; j < 4; ++j) { const float a = fmaxf(v0[j], 0.f), b = fmaxf(v1[j], 0.f); v0[j] = a * a; v1[j] = b * b; }
                    }
                    if (MODE == 3) {
                        const u32x4 gq = gpre[ai][m][bj];
                        v0[0] *= bf_lo(gq.x) * rs; v0[1] *= bf_hi(gq.x) * rs; v0[2] *= bf_lo(gq.y) * rs; v0[3] *= bf_hi(gq.y) * rs;
                        v1[0] *= bf_lo(gq.z) * rs; v1[1] *= bf_hi(gq.z) * rs; v1[2] *= bf_lo(gq.w) * rs; v1[3] *= bf_hi(gq.w) * rs;
                    }
                    u32x4 w; w.x = cvt_pk_bf16(v0[0], v0[1]); w.y = cvt_pk_bf16(v0[2], v0[3]); w.z = cvt_pk_bf16(v1[0], v1[1]); w.w = cvt_pk_bf16(v1[2], v1[3]);
                    *(u32x4*)(rowp + bj * HALF) = w;
                }
            }
    }
};
struct EpiGlu {
    static constexpr bool PERM = true, AFTER_DRAIN = false;
    bf16_t* O; int ldc; int ocol; const float* bias;
    __device__ __forceinline__ void operator()(const f32x4 (&acc)[2][2][4][2], const Unit& u, int wr, int wc, int fr, int fq) const {
        const int row0 = u.pm * BM + wr * 64 + fr, cc = u.pn * HALF + wc * 32 + 8 * fq;
        f32x4 bv[2][2];
#pragma unroll
        for (int bj = 0; bj < 2; ++bj)
#pragma unroll
            for (int n = 0; n < 2; ++n) bv[bj][n] = *(const f32x4*)(bias + bj * 512 + cc + 4 * n);
#pragma unroll
        for (int ai = 0; ai < 2; ++ai)
#pragma unroll
            for (int m = 0; m < 4; ++m) {
                bf16_t* rowp = O + (size_t)(row0 + ai * HALF + m * 16) * ldc + ocol + cc;
                f32x4 v0 = acc[ai][0][m][0] + bv[0][0], v1 = acc[ai][0][m][1] + bv[0][1];
                const f32x4 g0 = acc[ai][1][m][0] + bv[1][0], g1 = acc[ai][1][m][1] + bv[1][1];
#pragma unroll
                for (int j = 0; j < 4; ++j) { v0[j] *= sigmoidf_(g0[j]); v1[j] *= sigmoidf_(g1[j]); }
                u32x4 w; w.x = cvt_pk_bf16(v0[0], v0[1]); w.y = cvt_pk_bf16(v0[2], v0[3]); w.z = cvt_pk_bf16(v1[0], v1[1]); w.w = cvt_pk_bf16(v1[2], v1[3]);
                *(u32x4*)rowp = w;
            }
    }
};
struct EpiGateMerge {
    static constexpr bool PERM = true, AFTER_DRAIN = false;
    const bf16_t* Z; bf16_t* mg; const float* bgate;
    __device__ __forceinline__ void operator()(const f32x4 (&acc)[2][2][4][2], const Unit& u, int wr, int wc, int fr, int fq) const {
        typedef unsigned u32x2 __attribute__((ext_vector_type(2)));
        const int row0 = u.pm * BM + wr * 64 + fr, d0 = 64 * u.pn + 16 * wc + 4 * fq;
        f32x4 bv[2][2];
#pragma unroll
        for (int bj = 0; bj < 2; ++bj)
#pragma unroll
            for (int n = 0; n < 2; ++n) bv[bj][n] = *(const f32x4*)(bgate + (2 * bj + n) * 1024 + d0);
#pragma unroll
        for (int ai = 0; ai < 2; ++ai)
#pragma unroll
        for (int mh = 0; mh < 2; ++mh) {
            u32x2 zp[2][2][2];
#pragma unroll
            for (int mm = 0; mm < 2; ++mm) { const int row = row0 + ai * HALF + (2 * mh + mm) * 16;
#pragma unroll
                for (int bj = 0; bj < 2; ++bj)
#pragma unroll
                    for (int n = 0; n < 2; ++n) zp[mm][bj][n] = *(const u32x2*)(Z + (size_t)row * 4096 + (2 * bj + n) * 1024 + d0); }
#pragma unroll
            for (int mm = 0; mm < 2; ++mm) { const int m = 2 * mh + mm; const int row = row0 + ai * HALF + m * 16;
                f32x4 s = {0.f, 0.f, 0.f, 0.f};
#pragma unroll
                for (int bj = 0; bj < 2; ++bj)
#pragma unroll
                    for (int n = 0; n < 2; ++n) { const f32x4 a = acc[ai][bj][m][n] + bv[bj][n]; const u32x2 zq = zp[mm][bj][n];
                        s[0] += sigmoidf_(a[0]) * bf_lo(zq.x); s[1] += sigmoidf_(a[1]) * bf_hi(zq.x); s[2] += sigmoidf_(a[2]) * bf_lo(zq.y); s[3] += sigmoidf_(a[3]) * bf_hi(zq.y); }
                *(u32x2*)(mg + (size_t)row * 1024 + d0) = (u32x2){cvt_pk_bf16(s[0], s[1]), cvt_pk_bf16(s[2], s[3])}; }
        }
    }
};
struct EpiRes2 {
    static constexpr bool PERM = false, AFTER_DRAIN = false;
    const float* base_ctx; const float* base_lat; float* out; const float* modv; int goff;
    bf16_t* xn; const float* gnorm; int scoff; float* ssq;
    __device__ __forceinline__ void operator()(const f32x4 (&acc)[2][2][4][2], const Unit& u, int wr, int wc, int fr, int fq) const {
        const int row0 = u.pm * BM + wr * 64 + fr, col0 = u.pn * BM + wc * 32 + 4 * fq;
        const int mi = (u.pm < 32) ? 0 : 1 + ((u.pm - 32) >> 2);
        const float* gv = modv + (size_t)mi * 6144 + goff; const float* sv = modv + (size_t)mi * 6144 + scoff;
        f32x4 gg[2][2], gn[2][2];
#pragma unroll
        for (int bj = 0; bj < 2; ++bj)
#pragma unroll
            for (int n = 0; n < 2; ++n) { gg[bj][n] = *(const f32x4*)(gv + col0 + bj * HALF + n * 16); gn[bj][n] = *(const f32x4*)(gnorm + col0 + bj * HALF + n * 16) * (*(const f32x4*)(sv + col0 + bj * HALF + n * 16) + 1.0f); }
#pragma unroll
        for (int ai = 0; ai < 2; ++ai)
#pragma unroll
        for (int mh = 0; mh < 2; ++mh) {
            f32x4 pre[2][2][2];
#pragma unroll
            for (int mm = 0; mm < 2; ++mm) { const int row = row0 + ai * HALF + (2 * mh + mm) * 16;
                const float* bp = (row < 8192 ? base_ctx + (size_t)row * 1024 : base_lat + (size_t)(row - 8192) * 1024) + col0;
#pragma unroll
                for (int bj = 0; bj < 2; ++bj)
#pragma unroll
                    for (int n = 0; n < 2; ++n) pre[mm][bj][n] = *(const f32x4*)(bp + bj * HALF + n * 16); }
#pragma unroll
            for (int mm = 0; mm < 2; ++mm) { const int m = 2 * mh + mm; const int row = row0 + ai * HALF + m * 16; float* op = out + (size_t)row * 1024 + col0; bf16_t* xp = xn + (size_t)row * 1024 + col0;
                float q = 0.f;
#pragma unroll
                for (int bj = 0; bj < 2; ++bj)
#pragma unroll
                    for (int n = 0; n < 2; ++n) { const f32x4 x = pre[mm][bj][n] + gg[bj][n] * acc[ai][bj][m][n]; *(f32x4*)(op + bj * HALF + n * 16) = x;
                        q += (x[0] * x[0] + x[1] * x[1]) + (x[2] * x[2] + x[3] * x[3]);
                        const f32x4 y = x * gn[bj][n]; unsigned w0 = cvt_pk_bf16(y[0], y[1]), w1 = cvt_pk_bf16(y[2], y[3]);
                        typedef unsigned u32x2 __attribute__((ext_vector_type(2))); *(u32x2*)(xp + bj * HALF + n * 16) = (u32x2){w0, w1}; }
                q += __shfl_xor(q, 16); q += __shfl_xor(q, 32);
                if (fq == 0) atomicAdd(ssq + row, q); }
            asm volatile("" ::: "memory");
        }
    }
};
struct EpiMerge {
    static constexpr bool PERM = true, AFTER_DRAIN = false;
    const bf16_t* gates; bf16_t* mg; const float* ssq;
    __device__ __forceinline__ void operator()(const f32x4 (&acc)[2][2][4][2], const Unit& u, int wr, int wc, int fr, int fq) const {
        const int br = u.pn >> 2, pnl = u.pn & 3;
        int pm_o = u.pm; asm volatile("" : "+s"(pm_o));
        const int row0 = pm_o * BM + wr * 64 + fr, gcol0 = u.pn * BM + wc * 32 + 8 * fq, mcol0 = pnl * BM + wc * 32 + 8 * fq;
#pragma unroll
        for (int ai = 0; ai < 2; ++ai)
#pragma unroll
        for (int mh = 0; mh < 2; ++mh) {
            u32x4 gpre[2][2], mpre[2][2]; float rpre[2];
#pragma unroll
            for (int mm = 0; mm < 2; ++mm) { const int row = row0 + ai * HALF + (2 * mh + mm) * 16;
                rpre[mm] = (br == 0) ? ssq[row] : 512.0f;
#pragma unroll
                for (int bj = 0; bj < 2; ++bj) { gpre[mm][bj] = *(const u32x4*)(gates + (size_t)row * 4096 + gcol0 + bj * HALF);
                    mpre[mm][bj] = (br != 0) ? *(const u32x4*)(mg + (size_t)row * 1024 + mcol0 + bj * HALF) : (u32x4){0u, 0u, 0u, 0u}; } }
#pragma unroll
            for (int mm = 0; mm < 2; ++mm) { const int m = 2 * mh + mm; const int row = row0 + ai * HALF + m * 16;
                const float rs = (br == 0) ? rsqrtf(rpre[mm] * (1.0f / 512.0f) + 1e-6f) : 1.0f;
#pragma unroll
                for (int bj = 0; bj < 2; ++bj) { const u32x4 gq = gpre[mm][bj], mq = mpre[mm][bj]; const f32x4 a0 = acc[ai][bj][m][0], a1 = acc[ai][bj][m][1];
                    const float v0 = bf_lo(mq.x) + a0[0] * bf_lo(gq.x) * rs, v1 = bf_hi(mq.x) + a0[1] * bf_hi(gq.x) * rs, v2 = bf_lo(mq.y) + a0[2] * bf_lo(gq.y) * rs, v3 = bf_hi(mq.y) + a0[3] * bf_hi(gq.y) * rs;
                    const float v4 = bf_lo(mq.z) + a1[0] * bf_lo(gq.z) * rs, v5 = bf_hi(mq.z) + a1[1] * bf_hi(gq.z) * rs, v6 = bf_lo(mq.w) + a1[2] * bf_lo(gq.w) * rs, v7 = bf_hi(mq.w) + a1[3] * bf_hi(gq.w) * rs;
                    u32x4 w; w.x = cvt_pk_bf16(v0, v1); w.y = cvt_pk_bf16(v2, v3); w.z = cvt_pk_bf16(v4, v5); w.w = cvt_pk_bf16(v6, v7);
                    *(u32x4*)(mg + (size_t)row * 1024 + mcol0 + bj * HALF) = w; } }
            asm volatile("" ::: "memory");
        }
    }
};
struct BranchOrder {
    int G, c;
    __host__ __device__ void init(int G_, int c_) { G = G_; c = c_; }
    __host__ __device__ bool next(int i, Unit& u) const { if (c >= 192 || i >= 4) return false; u.pm = c >> 2; u.pn = i * 4 + (c & 3); return true; }
    __device__ __forceinline__ void a_ready(const Unit&) const {}
    __device__ __forceinline__ void done(const Unit&) const {}
};
struct EpiRes {
    static constexpr bool PERM = false, AFTER_DRAIN = false;
    const float* base_ctx; const float* base_lat;
    float* out; const float* modv;
    int goff;
    __device__ __forceinline__ void operator()(const f32x4 (&acc)[2][2][4][2], const Unit& u, int wr, int wc, int fr, int fq) const {
        const int row0 = u.pm * BM + wr * 64 + fr, col0 = u.pn * BM + wc * 32 + 4 * fq;
        const int mi = (u.pm < 32) ? 0 : 1 + ((u.pm - 32) >> 2);
        const float* gv = modv + (size_t)mi * 6144 + goff;
        f32x4 gg[2][2];
#pragma unroll
        for (int bj = 0; bj < 2; ++bj)
#pragma unroll
            for (int n = 0; n < 2; ++n) gg[bj][n] = *(const f32x4*)(gv + col0 + bj * HALF + n * 16);
#pragma unroll
        for (int ai = 0; ai < 2; ++ai) {
            f32x4 pre[4][2][2];
#pragma unroll
            for (int m = 0; m < 4; ++m) { const int row = row0 + ai * HALF + m * 16;
                const float* bp = (row < 8192 ? base_ctx + (size_t)row * 1024 : base_lat + (size_t)(row - 8192) * 1024) + col0;
#pragma unroll
                for (int bj = 0; bj < 2; ++bj)
#pragma unroll
                    for (int n = 0; n < 2; ++n) pre[m][bj][n] = *(const f32x4*)(bp + bj * HALF + n * 16); }
#pragma unroll
            for (int m = 0; m < 4; ++m) { const int row = row0 + ai * HALF + m * 16; float* op = out + (size_t)row * 1024 + col0;
#pragma unroll
                for (int bj = 0; bj < 2; ++bj)
#pragma unroll
                    for (int n = 0; n < 2; ++n) *(f32x4*)(op + bj * HALF + n * 16) = pre[m][bj][n] + gg[bj][n] * acc[ai][bj][m][n]; }
            asm volatile("" ::: "memory");
        }
    }
};

template <class Epi, class Sched, bool ALIGN_EPI = false, bool SP2 = false>
__device__ __forceinline__ void gemm_phase(PG8_LAS unsigned char* lds, const Gemm g, const Sched& S, const Epi& E, const int tid) {
    const int wid = __builtin_amdgcn_readfirstlane(tid >> 6), lane = tid & 63, wr = wid >> 2, wc = wid & 3, fr = lane & 15, fq = lane >> 4;
    const int K = g.K, nt = K / BK;
    unsigned voffA[2], voffB[2];
#pragma unroll
    for (int i = 0; i < 2; ++i) { int R, C; stage_rc(tid * 16 + i * 8192, R, C); const int Rb = Epi::PERM ? ((R & ~31) + perm32(R & 31)) : R;
        voffA[i] = (unsigned)(R * g.lda + C) * 2u; voffB[i] = (unsigned)(Rb * g.ldb + C) * 2u; }
    const size_t kstep = (size_t)(BK * 2);
    const size_t hstepA = (size_t)HALF * g.lda * 2, hstepB = (size_t)HALF * g.ldb * 2;
    const size_t tstepA = 2 * hstepA, tstepB = 2 * hstepB;
#define PG8_UA(u) ((const char*)g.A + (size_t)(u).pm * tstepA + (g.a_div ? (size_t)((u).pn / g.a_div) * g.a_gstride : (size_t)0))
#define PG8_UB(u) ((const char*)g.Bt + (size_t)(u).pn * tstepB)
    const unsigned ldsw = (unsigned)wid * 1024u;
    const int aoff = lds_byte(wr * 64 + fr, fq * 8), boff = lds_byte(wc * 32 + fr, fq * 8);
#define PG8_SA(b, h) (((b) * 2 + (h)) * HTB)
#define PG8_SB(b, h) ((4 + (b) * 2 + (h)) * HTB)
#define PG8_STAGE(bufoff, gbase, voff) do { _Pragma("unroll") for (int _i = 0; _i < 2; ++_i) \
        __builtin_amdgcn_global_load_lds((const unsigned*)((const char*)(gbase) + (voff)[_i]), (PG8_LAS unsigned*)(lds + (bufoff) + ldsw + _i * 8192), 16, 0, 0); } while (0)
#define PG8_LDA(dst, b, h) do { _Pragma("unroll") for (int m = 0; m < 4; ++m) _Pragma("unroll") for (int k = 0; k < 2; ++k) dst[m][k] = *(const PG8_LAS bf16x8*)(lds + PG8_SA(b, h) + aoff + m * 2048 + k * 1024); } while (0)
#define PG8_LDB(dst, b, h) do { _Pragma("unroll") for (int n = 0; n < 2; ++n) _Pragma("unroll") for (int k = 0; k < 2; ++k) dst[n][k] = *(const PG8_LAS bf16x8*)(lds + PG8_SB(b, h) + boff + n * 2048 + k * 1024); } while (0)
#define PG8_MMA(ai, bj, At, Bt) do { __builtin_amdgcn_s_setprio(1); _Pragma("unroll") for (int m = 0; m < 4; ++m) _Pragma("unroll") for (int n = 0; n < 2; ++n) _Pragma("unroll") for (int k = 0; k < 2; ++k) \
        acc[ai][bj][m][n] = __builtin_amdgcn_mfma_f32_16x16x32_bf16(Bt[n][k], At[m][k], acc[ai][bj][m][n], 0, 0, 0); __builtin_amdgcn_s_setprio(0); } while (0)
#define PG8_WAIT_V(n) asm volatile("s_waitcnt vmcnt(" #n ")" ::: "memory")
#define PG8_WAIT_L(n) asm volatile("s_waitcnt lgkmcnt(" #n ")" ::: "memory")
#define PG8_BAR __builtin_amdgcn_s_barrier()
#define PG8_SCHED __builtin_amdgcn_sched_barrier(0)
    Unit cur, nxt; int ui = 0;
    if (!S.next(0, cur)) return;
    f32x4 acc[2][2][4][2];
#pragma unroll
    for (int a = 0; a < 2; ++a)
#pragma unroll
        for (int b = 0; b < 2; ++b)
#pragma unroll
            for (int m = 0; m < 4; ++m)
#pragma unroll
                for (int n = 0; n < 2; ++n) acc[a][b][m][n] = (f32x4){0.f, 0.f, 0.f, 0.f};
    bf16x8 At[4][2], B0[2][2], B1[2][2];
    const char* cA = PG8_UA(cur); const char* cB = PG8_UB(cur);
    S.a_ready(cur);
    if constexpr (SP2) {
        PG8_STAGE(PG8_SB(0, 0), cB, voffB); PG8_STAGE(PG8_SB(0, 1), cB + hstepB, voffB); PG8_STAGE(PG8_SA(0, 0), cA, voffA); PG8_STAGE(PG8_SA(0, 1), cA + hstepA, voffA);
        if (wr == 1) PG8_BAR;
        PG8_WAIT_V(2); PG8_BAR;
        PG8_STAGE(PG8_SB(1, 0), cB + kstep, voffB); PG8_STAGE(PG8_SA(1, 0), cA + kstep, voffA); PG8_STAGE(PG8_SB(1, 1), cB + hstepB + kstep, voffB);
        PG8_WAIT_V(6); PG8_BAR;
    } else {
        PG8_STAGE(PG8_SB(0, 0), cB, voffB); PG8_STAGE(PG8_SA(0, 0), cA, voffA); PG8_STAGE(PG8_SB(0, 1), cB + hstepB, voffB); PG8_STAGE(PG8_SA(0, 1), cA + hstepA, voffA);
        if (wr == 1) PG8_BAR;
        PG8_WAIT_V(4); PG8_BAR;
        PG8_STAGE(PG8_SB(1, 0), cB + kstep, voffB); PG8_STAGE(PG8_SA(1, 0), cA + kstep, voffA); PG8_STAGE(PG8_SB(1, 1), cB + hstepB + kstep, voffB);
        PG8_WAIT_V(6); PG8_BAR;
    }
    for (;;) {
        const bool has_next = S.next(ui + 1, nxt);
        const char* nA = has_next ? PG8_UA(nxt) : cA; const char* nB = has_next ? PG8_UB(nxt) : cB;
        for (int t = 0; t < nt; t += 2) {
            const bool last = (t == nt - 2);
            const char* a1 = cA + (size_t)(t + 1) * kstep;
            const char* a2 = last ? nA : cA + (size_t)(t + 2) * kstep; const char* b2 = last ? nB : cB + (size_t)(t + 2) * kstep;
            const char* a3 = a2 + kstep; const char* b3 = b2 + kstep;
            if (last && has_next) S.a_ready(nxt);
            if constexpr (SP2) {
            PG8_LDB(B0, 0, 0); PG8_LDB(B1, 0, 1); PG8_SCHED; PG8_LDA(At, 0, 0); PG8_STAGE(PG8_SA(1, 1), a1 + hstepA, voffA);
            PG8_WAIT_V(8); PG8_WAIT_L(0); PG8_BAR; PG8_MMA(0, 0, At, B0); PG8_MMA(0, 1, At, B1); PG8_BAR; PG8_SCHED;
            PG8_LDA(At, 0, 1); PG8_STAGE(PG8_SB(0, 0), b2, voffB); PG8_STAGE(PG8_SB(0, 1), b2 + hstepB, voffB); PG8_STAGE(PG8_SA(0, 0), a2, voffA);
            PG8_WAIT_V(8); PG8_WAIT_L(0); PG8_BAR; PG8_MMA(1, 0, At, B0); PG8_MMA(1, 1, At, B1); PG8_BAR; PG8_SCHED;
            PG8_LDB(B0, 1, 0); PG8_LDB(B1, 1, 1); PG8_SCHED; PG8_LDA(At, 1, 0); PG8_STAGE(PG8_SA(0, 1), a2 + hstepA, voffA);
            PG8_WAIT_V(8); PG8_WAIT_L(0); PG8_BAR; PG8_MMA(0, 0, At, B0); PG8_MMA(0, 1, At, B1); PG8_BAR; PG8_SCHED;
            PG8_LDA(At, 1, 1); PG8_STAGE(PG8_SB(1, 0), b3, voffB); PG8_STAGE(PG8_SB(1, 1), b3 + hstepB, voffB); PG8_STAGE(PG8_SA(1, 0), a3, voffA);
            PG8_WAIT_V(8); PG8_WAIT_L(0); PG8_BAR; PG8_MMA(1, 0, At, B0); PG8_MMA(1, 1, At, B1); PG8_BAR; PG8_SCHED;
            } else {
            PG8_LDB(B0, 0, 0); PG8_SCHED; PG8_LDA(At, 0, 0); PG8_STAGE(PG8_SA(1, 1), a1 + hstepA, voffA);
            PG8_WAIT_L(8); PG8_BAR; PG8_WAIT_L(0); PG8_MMA(0, 0, At, B0); PG8_BAR; PG8_SCHED;
            PG8_LDB(B1, 0, 1); PG8_STAGE(PG8_SB(0, 0), b2, voffB);
            PG8_BAR; PG8_WAIT_L(0); PG8_MMA(0, 1, At, B1); PG8_BAR;
            PG8_LDA(At, 0, 1); PG8_STAGE(PG8_SA(0, 0), a2, voffA);
            PG8_BAR; PG8_WAIT_L(0); PG8_MMA(1, 0, At, B0); PG8_BAR; PG8_SCHED;
            PG8_STAGE(PG8_SB(0, 1), b2 + hstepB, voffB);
            PG8_WAIT_V(6); PG8_BAR; PG8_MMA(1, 1, At, B1); PG8_BAR;
            PG8_LDB(B0, 1, 0); PG8_SCHED; PG8_LDA(At, 1, 0); PG8_STAGE(PG8_SA(0, 1), a2 + hstepA, voffA);
            PG8_WAIT_L(8); PG8_BAR; PG8_WAIT_L(0); PG8_MMA(0, 0, At, B0); PG8_BAR; PG8_SCHED;
            PG8_LDB(B1, 1, 1); PG8_STAGE(PG8_SB(1, 0), b3, voffB);
            PG8_BAR; PG8_WAIT_L(0); PG8_MMA(0, 1, At, B1); PG8_BAR;
            PG8_LDA(At, 1, 1); PG8_STAGE(PG8_SA(1, 0), a3, voffA);
            PG8_BAR; PG8_WAIT_L(0); PG8_MMA(1, 0, At, B0); PG8_BAR; PG8_SCHED;
            PG8_STAGE(PG8_SB(1, 1), b3 + hstepB, voffB);
            PG8_WAIT_V(6); PG8_BAR; PG8_MMA(1, 1, At, B1); PG8_BAR;
            }
        }
        if constexpr (ALIGN_EPI) { if (wr == 0) PG8_BAR; }
        if constexpr (!Epi::AFTER_DRAIN) { E(acc, cur, wr, wc, fr, fq); S.done(cur); }
        if (!has_next) break;
#pragma unroll
        for (int a = 0; a < 2; ++a)
#pragma unroll
            for (int b = 0; b < 2; ++b)
#pragma unroll
                for (int m = 0; m < 4; ++m)
#pragma unroll
                    for (int n = 0; n < 2; ++n) acc[a][b][m][n] = (f32x4){0.f, 0.f, 0.f, 0.f};
        cur = nxt; cA = nA; cB = nB; ++ui;
        if constexpr (ALIGN_EPI) { if (wr == 1) PG8_BAR; }
    }
    PG8_WAIT_V(0);
    if constexpr (!ALIGN_EPI) { if (wr == 0) PG8_BAR; }
    PG8_BAR;
    if constexpr (Epi::AFTER_DRAIN) { E.fused(acc, cur, wr, wc, fr, fq, lds, wid, lane); S.done(cur); }
#undef PG8_UA
#undef PG8_UB
#undef PG8_SA
#undef PG8_SB
#undef PG8_STAGE
#undef PG8_LDA
#undef PG8_LDB
#undef PG8_MMA
#undef PG8_WAIT_V
#undef PG8_WAIT_L
#undef PG8_BAR
#undef PG8_SCHED
}
}

#ifndef PG8_SP2
#define PG8_SP2 true
#endif
#ifndef PG8_ALIGN
#define PG8_ALIGN true
#endif

typedef unsigned short bf16;
typedef unsigned v4u __attribute__((ext_vector_type(4)));
typedef unsigned v2u __attribute__((ext_vector_type(2)));
typedef float f32x4 __attribute__((ext_vector_type(4)));
#define LAS __attribute__((address_space(3)))

constexpr int NWAVES = 8, NTHR = 512;
constexpr int D = 1024, MC = 8192, ML = 4096, M = 12288, NPH = 23;
constexpr int LDS_BYTES = 147456;
constexpr float EPS = 1e-6f;
constexpr size_t MiB = 1u << 20;
constexpr size_t WS_MOD = 64 * 1024;
constexpr size_t WS_SSQ = 320 * 1024;
constexpr size_t WS_DT = 384 * 1024;
constexpr size_t WS_W = 2 * MiB;
constexpr size_t W_IN = WS_W, W_G = W_IN + 8 * MiB, W_GLU = W_G + 8 * MiB, W_BR = W_GLU + 1 * MiB, W_OUT = W_BR + 4 * MiB, W_1 = W_OUT + 2 * MiB, W_2 = W_1 + 8 * MiB;
constexpr size_t WS_H = 41 * MiB;
constexpr size_t WS_R1 = 65 * MiB;
constexpr size_t WS_Y = 161 * MiB;
constexpr size_t WS_Y5 = 209 * MiB;
constexpr size_t WS_XC = 221 * MiB;
constexpr size_t WS_S5K = 239 * MiB;
constexpr size_t WS_S5WS = 240 * MiB;
constexpr size_t WS_S5WO = 244 * MiB;
constexpr size_t WS_S5AT = 248 * MiB;
constexpr size_t WS_CKV = 248 * MiB + 512 * 1024;
constexpr size_t WS_ROPE = 1536 * 1024;
constexpr size_t WS_WDT = 1792 * 1024;
constexpr size_t WS_BI2 = 1824 * 1024;
constexpr size_t WS_SSQ2 = 1904 * 1024;
constexpr size_t WS_END = 254 * MiB;
#ifndef PROBE_SEL
#define PROBE_SEL -1
#endif
#ifndef PROBE_SCALE
#define PROBE_SCALE 4e-4f
#endif
#ifndef PROBE_PB
#define PROBE_PB 32
#endif
constexpr size_t WS_BAR = 32 * 1024;
constexpr size_t WS_QCTR = 48 * 1024;
constexpr size_t WS_TS = 16 * 1024;
constexpr size_t O_SSD = 12582912, O_S5 = 16777216, O_DK = 17301504, O_DV = 25690112, O_WK = 34078720, O_WV = 36175872;
constexpr int C_Z = 0, C_XBC = 512, C_U = 1280, C_DQ = 1792, C_DK = 2304, C_DV = 2816, C_WQ = 3328, C_WK = 3840, C_WV = 3968;

namespace pg8 {
struct EpiIn {
    static constexpr bool PERM = true, AFTER_DRAIN = false;
    bf16_t* O; float* out; const float* rope; const float* qg; const float* kg; const float* wqg; const float* wkg; int l;
    __device__ __forceinline__ void operator()(const f32x4 (&acc)[2][2][4][2], const Unit& u, int wr, int wc, int fr, int fq) const {
        const int pn = u.pn; const bool lat = u.pm >= 32;
        const int row0 = u.pm * BM + wr * 64 + fr, lcol0 = pn * BM + 64 * wc + 8 * fq;
        const float* gp = nullptr;
        if (pn == 7 || pn == 8) gp = qg; else if (pn == 9 || pn == 10) gp = kg; else if (pn == 13 || pn == 14) gp = wqg; else if (pn == 15 && wc < 2) gp = wkg;
        float* fo = nullptr; int fstride = 0;
        if (!lat) { if (pn == 9 || pn == 10) { fo = out + O_DK + (pn - 9) * 256 + 64 * wc + 8 * fq; fstride = 512; }
                    else if (pn == 11 || pn == 12) { fo = out + O_DV + (pn - 11) * 256 + 64 * wc + 8 * fq; fstride = 512; }
                    else if (pn == 15) { fo = out + (wc < 2 ? O_WK + 64 * wc : O_WV + 64 * (wc - 2)) + 8 * fq; fstride = 128; } }
        f32x4 g[2][2];
#pragma unroll
        for (int bj = 0; bj < 2; ++bj)
#pragma unroll
            for (int n = 0; n < 2; ++n) g[bj][n] = gp ? *(const f32x4*)(gp + 32 * bj + 8 * fq + 4 * n) : (f32x4){1.f, 1.f, 1.f, 1.f};
#pragma unroll
        for (int ai = 0; ai < 2; ++ai)
#pragma unroll
            for (int m = 0; m < 4; ++m) {
                const int row = row0 + ai * HALF + m * 16;
                f32x4 v[2][2];
#pragma unroll
                for (int bj = 0; bj < 2; ++bj)
#pragma unroll
                    for (int n = 0; n < 2; ++n) v[bj][n] = acc[ai][bj][m][n];
                if (gp) {
                    float ss = 0.f;
#pragma unroll
                    for (int bj = 0; bj < 2; ++bj)
#pragma unroll
                        for (int n = 0; n < 2; ++n) ss += (v[bj][n][0] * v[bj][n][0] + v[bj][n][1] * v[bj][n][1]) + (v[bj][n][2] * v[bj][n][2] + v[bj][n][3] * v[bj][n][3]);
                    ss += __shfl_xor(ss, 16); ss += __shfl_xor(ss, 32);
                    const float rs = rsqrtf(ss * (1.0f / 64.0f) + 1e-6f);
#pragma unroll
                    for (int bj = 0; bj < 2; ++bj)
#pragma unroll
                        for (int n = 0; n < 2; ++n) v[bj][n] = v[bj][n] * rs * g[bj][n];
                    if (lat) {
                        const float* rp = rope + (size_t)((row - 8192) & 1023) * 64 + 8 * (fq & 1);
#pragma unroll
                        for (int bj = 0; bj < 2; ++bj)
#pragma unroll
                            for (int n = 0; n < 2; ++n) { const f32x4 cs = *(const f32x4*)(rp + 16 * bj + 4 * n), sn = *(const f32x4*)(rp + 32 + 16 * bj + 4 * n);
                                f32x4 p; p[0] = __shfl_xor(v[bj][n][0], 32); p[1] = __shfl_xor(v[bj][n][1], 32); p[2] = __shfl_xor(v[bj][n][2], 32); p[3] = __shfl_xor(v[bj][n][3], 32);
                                v[bj][n] = (fq >> 1) ? v[bj][n] * cs + p * sn : v[bj][n] * cs - p * sn; }
                    }
                }
                bf16_t* rowp = O + (size_t)row * 4096 + lcol0;
#pragma unroll
                for (int bj = 0; bj < 2; ++bj) { u32x4 w; w.x = cvt_pk_bf16(v[bj][0][0], v[bj][0][1]); w.y = cvt_pk_bf16(v[bj][0][2], v[bj][0][3]); w.z = cvt_pk_bf16(v[bj][1][0], v[bj][1][1]); w.w = cvt_pk_bf16(v[bj][1][2], v[bj][1][3]);
                    *(u32x4*)(rowp + 32 * bj) = w; }
                if (fo) { float* fp = fo + (size_t)(((row >> 8) * 2 + l) * 256 + (row & 255)) * fstride;
#pragma unroll
                    for (int bj = 0; bj < 2; ++bj) { *(f32x4*)(fp + 32 * bj) = v[bj][0]; *(f32x4*)(fp + 32 * bj + 4) = v[bj][1]; } }
            }
    }
};
}

struct Args { const float* in[44]; float* out; unsigned char* ws; int ph_lo, ph_hi; };

typedef const Args __attribute__((address_space(4)))* CArgs;
struct Ctx {
    CArgs ap; int tid, lane, wave;
    __device__ __forceinline__ const float* x_prompt() const { return ap->in[0]; }
    __device__ __forceinline__ const float* x_sample() const { return ap->in[1]; }
    __device__ __forceinline__ const float* state_ssd() const { return ap->in[2]; }
    __device__ __forceinline__ const float* state_s5() const { return ap->in[3]; }
    __device__ __forceinline__ const float* cache_dk() const { return ap->in[4]; }
    __device__ __forceinline__ const float* cache_dv() const { return ap->in[5]; }
    __device__ __forceinline__ const float* cache_wk() const { return ap->in[6]; }
    __device__ __forceinline__ const float* cache_wv() const { return ap->in[7]; }
    __device__ __forceinline__ const float* cvec() const { return ap->in[8]; }
    __device__ __forceinline__ const float* c_ctx() const { return ap->in[9]; }
    __device__ __forceinline__ const float* w_mod() const { return ap->in[10]; }
    __device__ __forceinline__ const float* b_mod() const { return ap->in[11]; }
    __device__ __forceinline__ const float* g_norm1() const { return ap->in[12]; }
    __device__ __forceinline__ const float* g_norm2() const { return ap->in[13]; }
    __device__ __forceinline__ const float* w_in() const { return ap->in[14]; }
    __device__ __forceinline__ const float* conv_w() const { return ap->in[15]; }
    __device__ __forceinline__ const float* conv_b() const { return ap->in[16]; }
    __device__ __forceinline__ const float* dt_bias() const { return ap->in[17]; }
    __device__ __forceinline__ const float* a_log() const { return ap->in[18]; }
    __device__ __forceinline__ const float* ssd_d() const { return ap->in[19]; }
    __device__ __forceinline__ const float* ssd_norm_g() const { return ap->in[20]; }
    __device__ __forceinline__ const float* lam_re() const { return ap->in[21]; }
    __device__ __forceinline__ const float* lam_im() const { return ap->in[22]; }
    __device__ __forceinline__ const float* log_step() const { return ap->in[23]; }
    __device__ __forceinline__ const float* b_re() const { return ap->in[24]; }
    __device__ __forceinline__ const float* b_im() const { return ap->in[25]; }
    __device__ __forceinline__ const float* c_re() const { return ap->in[26]; }
    __device__ __forceinline__ const float* c_im() const { return ap->in[27]; }
    __device__ __forceinline__ const float* s5_d() const { return ap->in[28]; }
    __device__ __forceinline__ const float* w_glu() const { return ap->in[29]; }
    __device__ __forceinline__ const float* b_glu() const { return ap->in[30]; }
    __device__ __forceinline__ const float* qn_g() const { return ap->in[31]; }
    __device__ __forceinline__ const float* kn_g() const { return ap->in[32]; }
    __device__ __forceinline__ const float* dlam() const { return ap->in[33]; }
    __device__ __forceinline__ const float* subln_g() const { return ap->in[34]; }
    __device__ __forceinline__ const float* wqn_g() const { return ap->in[35]; }
    __device__ __forceinline__ const float* wkn_g() const { return ap->in[36]; }
    __device__ __forceinline__ const float* sink() const { return ap->in[37]; }
    __device__ __forceinline__ const float* w_branch() const { return ap->in[38]; }
    __device__ __forceinline__ const float* w_gate() const { return ap->in[39]; }
    __device__ __forceinline__ const float* b_gate() const { return ap->in[40]; }
    __device__ __forceinline__ const float* w_out() const { return ap->in[41]; }
    __device__ __forceinline__ const float* w_fc1() const { return ap->in[42]; }
    __device__ __forceinline__ const float* w_fc2() const { return ap->in[43]; }
    __device__ __forceinline__ float* out() const { return ap->out; }
    __device__ __forceinline__ unsigned char* ws() const { return ap->ws; }
    __device__ __forceinline__ float* MOD() const { return (float*)(ap->ws + WS_MOD); }
    __device__ __forceinline__ float* SSQ() const { return (float*)(ap->ws + WS_SSQ); }
    __device__ __forceinline__ float* DT() const { return (float*)(ap->ws + WS_DT); }
    __device__ __forceinline__ bf16* H() const { return (bf16*)(ap->ws + WS_H); }
    __device__ __forceinline__ bf16* R1() const { return (bf16*)(ap->ws + WS_R1); }
    __device__ __forceinline__ bf16* Y() const { return (bf16*)(ap->ws + WS_Y); }
    __device__ __forceinline__ bf16* Y5() const { return (bf16*)(ap->ws + WS_Y5); }
    __device__ __forceinline__ bf16* XC() const { return (bf16*)(ap->ws + WS_XC); }
    __device__ __forceinline__ bf16* CKV() const { return (bf16*)(ap->ws + WS_CKV); }
    __device__ __forceinline__ float* ROPE() const { return (float*)(ap->ws + WS_ROPE); }
};

__device__ __forceinline__ float wave_sum(float v) {
#pragma unroll
    for (int o = 1; o < 64; o <<= 1) v += __shfl_xor(v, o);
    return v;
}
__device__ __forceinline__ float wave_max(float v) {
#pragma unroll
    for (int o = 1; o < 64; o <<= 1) v = fmaxf(v, __shfl_xor(v, o));
    return v;
}
__device__ __forceinline__ float bf2f(bf16 h) { return __builtin_bit_cast(float, (unsigned)h << 16); }
__device__ __forceinline__ float bflo(unsigned w) { return __builtin_bit_cast(float, w << 16); }
__device__ __forceinline__ float bfhi(unsigned w) { return __builtin_bit_cast(float, w & 0xffff0000u); }
__device__ __forceinline__ unsigned f2bf(float f) { unsigned u = __builtin_bit_cast(unsigned, f); return (u + 0x7fffu + ((u >> 16) & 1u)) >> 16; }
__device__ __forceinline__ unsigned pk2(float lo, float hi) { return f2bf(lo) | (f2bf(hi) << 16); }
__device__ __forceinline__ float siluf(float x) { return x / (1.0f + __expf(-x)); }
__device__ __forceinline__ void unpack8(const v4u q, float (&f)[8]) { f[0] = bflo(q.x); f[1] = bfhi(q.x); f[2] = bflo(q.y); f[3] = bfhi(q.y); f[4] = bflo(q.z); f[5] = bfhi(q.z); f[6] = bflo(q.w); f[7] = bfhi(q.w); }

__device__ __forceinline__ void phase_mods(const Ctx& c, float* lf) {
    for (int i = c.tid; i < 5 * 1024; i += NTHR) { const int v = i >> 10, k = i & 1023; const float x = (v == 0) ? c.c_ctx()[k] : c.cvec()[(v - 1) * 1024 + k]; lf[i] = siluf(x); }
    __syncthreads();
    float* red = lf + 5 * 1024;
    for (int u = blockIdx.x; u < 192; u += gridDim.x) {
        const int l = u / 96, col0 = (u % 96) * 64;
        const float* W = c.w_mod() + (size_t)l * 1024 * 6144 + col0 + c.lane;
        float acc[5] = {0.f, 0.f, 0.f, 0.f, 0.f};
#pragma unroll 1
        for (int kb = c.wave * 128; kb < c.wave * 128 + 128; kb += 32) {
            float wv[32];
#pragma unroll
            for (int j = 0; j < 32; ++j) wv[j] = W[(size_t)(kb + j) * 6144];
#pragma unroll
            for (int j = 0; j < 32; ++j)
#pragma unroll
                for (int i = 0; i < 5; ++i) acc[i] += lf[i * 1024 + kb + j] * wv[j]; }
#pragma unroll
        for (int i = 0; i < 5; ++i) red[(c.wave * 5 + i) * 64 + c.lane] = acc[i];
        __syncthreads();
        if (c.tid < 320) { const int i = c.tid >> 6, ln = c.tid & 63; float s = c.b_mod()[l * 6144 + col0 + ln];
#pragma unroll
            for (int w = 0; w < 8; ++w) s += red[(w * 5 + i) * 64 + ln];
            c.MOD()[(size_t)(l * 5 + i) * 6144 + col0 + ln] = s; }
        __syncthreads();
    }
}

__device__ __forceinline__ int cmap(int mode, int n) {
    if (mode == 0) return n;
    if (mode == 1) { const int p = n & 255, lc = 64 * ((p >> 5) & 3) + 32 * (p >> 7) + (p & 31), nn = (n & ~255) + lc; return nn < 1280 ? nn : nn + 16; }
    if (mode == 3) { const int T = n >> 8, p = n & 255; return (2 * (p >> 7) + ((p >> 2) & 1)) * 1024 + 64 * T + 16 * ((p >> 5) & 3) + 4 * ((p >> 3) & 3) + (p & 3); }
    return (n & 255) < 128 ? 128 * (n >> 8) + (n & 127) : 512 + 128 * (n >> 8) + (n & 127);
}
__device__ __forceinline__ void transpose_item(const float* W, int ld, int K, int N, int mode, const float* rowscale, bf16* WT, float* scr, int item, int lane) {
    const int nblk = N / 32, kb = item / nblk, nb = item % nblk, k0 = 64 * kb, n0 = 32 * nb, scl = (mode == 3) ? cmap(3, n0 + (lane & 31)) : cmap(mode, n0) + (lane & 31);
    float tv[32];
#pragma unroll
    for (int i = 0; i < 32; ++i) tv[i] = W[(size_t)(k0 + 2 * i + (lane >> 5)) * ld + scl];
    if (rowscale) {
#pragma unroll
        for (int i = 0; i < 32; ++i) tv[i] *= rowscale[k0 + 2 * i + (lane >> 5)]; }
#pragma unroll
    for (int i = 0; i < 32; ++i) scr[(2 * i + (lane >> 5)) * 33 + (lane & 31)] = tv[i];
    __builtin_amdgcn_fence(__ATOMIC_RELEASE, "wavefront"); __builtin_amdgcn_wave_barrier();
    const int ch = lane & 7;
#pragma unroll
    for (int j = 0; j < 4; ++j) { const int n = (lane >> 3) + 8 * j; const float* s = scr + (8 * ch) * 33 + n;
        v4u o; o.x = pk2(s[0 * 33], s[1 * 33]); o.y = pk2(s[2 * 33], s[3 * 33]); o.z = pk2(s[4 * 33], s[5 * 33]); o.w = pk2(s[6 * 33], s[7 * 33]);
        *(v4u*)(WT + (size_t)(n0 + n) * K + k0 + 8 * ch) = o; }
    __builtin_amdgcn_fence(__ATOMIC_RELEASE, "wavefront"); __builtin_amdgcn_wave_barrier();
}
__device__ __forceinline__ void s5_tables(const Ctx& c, int l, int g, int part, float* lf);
__device__ __forceinline__ void convert_items(const Ctx& c, int l, int lo, int hi, int gw0, int ngw, bool tabs, int tb0, int ntb, float* lf) {
    unsigned char* ws = c.ws();
    if (tabs) {
        for (int t = tb0; t < 128; t += ntb) s5_tables(c, l, t & 31, t >> 5, lf);
        for (int i = tb0 * NTHR + c.tid; i < 16384; i += ntb * NTHR) { const int j = i >> 10, k = i & 1023; ((bf16*)(ws + WS_WDT))[i] = (bf16)f2bf(c.w_in()[(size_t)l * 1024 * 4112 + (size_t)k * 4112 + 1280 + j]); }
    }
    float* scr = lf + c.wave * 2176;
    for (int it = lo + gw0; it < hi; it += ngw) {
        int r = it;
        if (r < 2048) { transpose_item(c.w_in() + (size_t)l * 1024 * 4112, 4112, 1024, 4096, 1, nullptr, (bf16*)(ws + W_IN), scr, r, c.lane); continue; } r -= 2048;
        if (r < 2048) { transpose_item(c.w_gate() + (size_t)l * 1024 * 4096, 4096, 1024, 4096, 3, nullptr, (bf16*)(ws + W_G), scr, r, c.lane); continue; } r -= 2048;
        if (r < 256) { transpose_item(c.w_glu() + (size_t)l * 512 * 1024, 1024, 512, 1024, 2, nullptr, (bf16*)(ws + W_GLU), scr, r, c.lane); continue; } r -= 256;
        if (r < 1024) { const int i = r >> 8; transpose_item(c.w_branch() + (size_t)(l * 4 + i) * 512 * 1024, 1024, 512, 1024, 0, i == 0 ? c.ssd_norm_g() + l * 512 : nullptr, (bf16*)(ws + W_BR) + (size_t)i * 1024 * 512, scr, r & 255, c.lane); continue; } r -= 1024;
        if (r < 512) { transpose_item(c.w_out() + (size_t)l * 1024 * 1024, 1024, 1024, 1024, 0, nullptr, (bf16*)(ws + W_OUT), scr, r, c.lane); continue; } r -= 512;
        if (r < 2048) { transpose_item(c.w_fc1() + (size_t)l * 1024 * 4096, 4096, 1024, 4096, 0, nullptr, (bf16*)(ws + W_1), scr, r, c.lane); continue; } r -= 2048;
        transpose_item(c.w_fc2() + (size_t)l * 4096 * 1024, 1024, 4096, 1024, 0, nullptr, (bf16*)(ws + W_2), scr, r, c.lane);
    }
}
__device__ __forceinline__ void phase_convert(const Ctx& c, int l, float* lf) {
    if (gridDim.x == 256) convert_items(c, l, 0, 9984, blockIdx.x * NWAVES + c.wave, gridDim.x * NWAVES, true, blockIdx.x >= 192 ? (int)blockIdx.x - 192 : 100000, 64, lf);
    else convert_items(c, l, 0, 9984, blockIdx.x * NWAVES + c.wave, gridDim.x * NWAVES, true, blockIdx.x, gridDim.x, lf);
}
__device__ __forceinline__ void side_convert(const Ctx& c, int lo, int hi, bool tabs, float* lf) {
    if (blockIdx.x < 192 || gridDim.x != 256) return;
    convert_items(c, 1, lo, hi, (blockIdx.x - 192) * NWAVES + c.wave, 64 * NWAVES, tabs, blockIdx.x - 192, 64, lf);
}

__device__ __forceinline__ void phase_norm(const Ctx& c, int l, int which, float* lf) {
    const int gw = blockIdx.x * NWAVES + c.wave, NGW = gridDim.x * NWAVES;
    const float* gn = (which == 0 ? c.g_norm1() : c.g_norm2()) + l * 1024;
    for (int m = gw; m < M; m += NGW) {
        const float* xr = (l == 0 && which == 0) ? (m < MC ? c.x_prompt() + (size_t)m * D : c.x_sample() + (size_t)(m - MC) * D) : c.out() + (size_t)m * D;
        const int mi = (m < MC) ? 0 : 1 + ((m - MC) >> 10);
        const float* mod = c.MOD() + (size_t)(l * 5 + mi) * 6144 + which * 3072;
        f32x4 v[4]; float s = 0.f;
#pragma unroll
        for (int j = 0; j < 4; ++j) { v[j] = *(const f32x4*)(xr + 4 * c.lane + 256 * j); s += (v[j].x * v[j].x + v[j].y * v[j].y) + (v[j].z * v[j].z + v[j].w * v[j].w); }
        const float rstd = rsqrtf(wave_sum(s) * (1.0f / D) + EPS);
#pragma unroll
        for (int j = 0; j < 4; ++j) { const int k = 4 * c.lane + 256 * j; const f32x4 g = *(const f32x4*)(gn + k), sh = *(const f32x4*)(mod + k), sc = *(const f32x4*)(mod + 1024 + k);
            v[j] = v[j] * rstd * g * (sc + 1.0f) + sh;
            v2u o; o.x = pk2(v[j].x, v[j].y); o.y = pk2(v[j].z, v[j].w); *(v2u*)(c.H() + (size_t)m * D + k) = o; }
        if (which == 0) {
            if (c.lane == 0) { c.SSQ()[m] = 0.f; ((float*)(c.ws() + WS_SSQ2))[m] = 0.f; }
        }
    }
}

__device__ __forceinline__ void phase_bias2(const Ctx& c, int l) {
    const int gw = blockIdx.x * NWAVES + c.wave, NGW = gridDim.x * NWAVES, lane = c.lane;
    const bf16* W1t = (const bf16*)(c.ws() + W_1); float* bi = (float*)(c.ws() + WS_BI2);
    for (int n = gw; n < 4096; n += NGW) {
        float wf[16]; { float t8[8]; unpack8(*(const v4u*)(W1t + (size_t)n * 1024 + 8 * lane), t8);
#pragma unroll
            for (int j = 0; j < 8; ++j) wf[j] = t8[j];
            unpack8(*(const v4u*)(W1t + (size_t)n * 1024 + 512 + 8 * lane), t8);
#pragma unroll
            for (int j = 0; j < 8; ++j) wf[8 + j] = t8[j]; }
#pragma unroll 1
        for (int mi = 0; mi < 5; ++mi) { const float* sh = c.MOD() + (size_t)(l * 5 + mi) * 6144 + 3072; float a = 0.f;
#pragma unroll
            for (int hh = 0; hh < 2; ++hh) { const f32x4 s0 = *(const f32x4*)(sh + 512 * hh + 8 * lane), s1 = *(const f32x4*)(sh + 512 * hh + 8 * lane + 4);
                a += (wf[8 * hh + 0] * s0.x + wf[8 * hh + 1] * s0.y) + (wf[8 * hh + 2] * s0.z + wf[8 * hh + 3] * s0.w) + (wf[8 * hh + 4] * s1.x + wf[8 * hh + 5] * s1.y) + (wf[8 * hh + 6] * s1.z + wf[8 * hh + 7] * s1.w); }
            a = wave_sum(a); if (lane == 0) bi[mi * 4096 + n] = a; }
    }
}

__device__ __forceinline__ void phase_dt(const Ctx& c, int l) {
    const int tile = blockIdx.x * 3 + c.wave;
    if (c.wave < 3 && tile < 768) {
    const int lr = c.lane & 15, lq = c.lane >> 4;
    const bf16* ap = c.H() + (size_t)(16 * tile + lr) * 1024 + 8 * lq; const bf16* bp = (const bf16*)(c.ws() + WS_WDT) + (size_t)lr * 1024 + 8 * lq;
    f32x4 acc = {0.f, 0.f, 0.f, 0.f};
#pragma unroll 8
    for (int ks = 0; ks < 32; ++ks) acc = __builtin_amdgcn_mfma_f32_16x16x32_bf16(*(const pg8::bf16x8*)(ap + 32 * ks), *(const pg8::bf16x8*)(bp + 32 * ks), acc, 0, 0, 0);
    const float bias = c.dt_bias()[l * 16 + lr];
#pragma unroll
    for (int r = 0; r < 4; ++r) { const float x = acc[r] + bias; c.DT()[(size_t)(16 * tile + 4 * lq + r) * 16 + lr] = x > 20.f ? x : log1pf(__expf(x)); }
    }
}

__device__ __forceinline__ void phase_rope_table(const Ctx& c) {
    const int gt = blockIdx.x * NTHR + c.tid;
    if (gt < 32768) { const int pos = gt >> 5, a = gt & 31, f = a & 15; const float inv = exp2f(-(float)f * 0.8304820237218406f);
        const float ang = (float)((a >> 4) ? (pos & 63) : (pos >> 6)) * inv; float sn, cs; sincosf(ang, &sn, &cs); c.ROPE()[pos * 64 + a] = cs; c.ROPE()[pos * 64 + 32 + a] = sn; }
}
__device__ __forceinline__ void phase_ckv(const Ctx& c) {
    const int gw = blockIdx.x * NWAVES + c.wave, NGW = gridDim.x * NWAVES, lane = c.lane;
    for (int r = gw; r < 2048; r += NGW) { const int l = r >> 10, b = (r >> 8) & 3, sidx = r & 255; const size_t cb = (size_t)(b * 2 + l) * 256 + sidx; bf16* dst = c.CKV() + (size_t)r * 1280;
#pragma unroll
        for (int i = 0; i < 5; ++i) { const int e = 4 * (lane + 64 * i);
            const float* src = e < 512 ? c.cache_dk() + cb * 512 + e : e < 1024 ? c.cache_dv() + cb * 512 + (e - 512) : e < 1152 ? c.cache_wk() + cb * 128 + (e - 1024) : c.cache_wv() + cb * 128 + (e - 1152);
            const f32x4 v = *(const f32x4*)src; v2u o; o.x = pk2(v.x, v.y); o.y = pk2(v.z, v.w); *(v2u*)(dst + e) = o; } }
}
__device__ __forceinline__ void phase_qk(const Ctx& c, int l, float* lf) {
    const int gw = blockIdx.x * NWAVES + c.wave, NGW = gridDim.x * NWAVES, lane = c.lane;
    for (int i = c.tid; i < 7 * 768; i += NTHR) lf[i] = c.conv_w()[(size_t)l * 7 * 768 + i];
    for (int i = c.tid; i < 768; i += NTHR) lf[7 * 768 + i] = c.conv_b()[l * 768 + i];
    __syncthreads();
    const bf16* R1p = c.R1(); bf16* XCp = c.XC();
    for (int m0 = gw * 6; m0 < M; m0 += NGW * 6) {
        v2u xr[12][3];
#pragma unroll
        for (int rI = 0; rI < 12; ++rI) { const int mr = m0 - 3 + rI; const bool ok = mr >= 0 && mr < M;
#pragma unroll
            for (int i = 0; i < 3; ++i) xr[rI][i] = ok ? *(const v2u*)(R1p + (size_t)mr * 4096 + C_XBC + 4 * lane + 256 * i) : (v2u){0u, 0u}; }
        f32x4 wv[3][8];
#pragma unroll
        for (int i = 0; i < 3; ++i)
#pragma unroll
            for (int j = 0; j < 8; ++j) wv[i][j] = *(const f32x4*)(lf + j * 768 + 4 * lane + 256 * i);
#pragma unroll
        for (int k = 0; k < 6; ++k) { const int m = m0 + k; if (m >= M) break;
            const bool lat = m >= MC; const int t = lat ? (m - MC) & 1023 : m & 255, L = lat ? 1024 : 256;
#pragma unroll
            for (int i = 0; i < 3; ++i) { f32x4 a = wv[i][7];
#pragma unroll
                for (int j = 0; j < 7; ++j) { const int tt = t + j - 3; if (tt >= 0 && tt < L) { const v2u q = xr[k + j][i]; const f32x4 xv = {bflo(q.x), bfhi(q.x), bflo(q.y), bfhi(q.y)}; a += wv[i][j] * xv; } }
                v2u o; o.x = pk2(siluf(a.x), siluf(a.y)); o.y = pk2(siluf(a.z), siluf(a.w)); *(v2u*)(XCp + (size_t)m * 768 + 4 * lane + 256 * i) = o; }
        }
    }
}

typedef pg8::bf16x8 bx8;
#define LDS_BARRIER() do { asm volatile("s_waitcnt lgkmcnt(0)" ::: "memory"); __builtin_amdgcn_s_barrier(); asm volatile("" ::: "memory"); } while (0)
#define MFMA16(a, b, cc) __builtin_amdgcn_mfma_f32_16x16x32_bf16((a), (b), (cc), 0, 0, 0)
__device__ __forceinline__ void ssd_unit(const Ctx& c, int l, int pass, int b, int h, unsigned char* lds) {
    const int L = pass ? 1024 : 256, tok0 = pass ? MC + b * 1024 : b * 256, NCH = L >> 7;
    const int tid = c.tid, lane = c.lane, w = c.wave, lr = lane & 15, lq = lane >> 4, grp = h >> 2;
    bf16* XT = (bf16*)lds;
    bf16* BwT = XT + 64 * 136;
    bf16* Bm = BwT + 64 * 136;
    bf16* Cm = Bm + 128 * 72;
    bf16* Mm = Cm + 128 * 72;
    bf16* ST = Mm + 128 * 136;
    float* cum = (float*)(ST + 64 * 72);
    float* dtv = cum + 128; float* wv = dtv + 128; float* ecum = wv + 128; float* tot = ecum + 128;
    const float dsk = c.ssd_d()[l * 8 + h];
    const bf16* XCp = c.XC(); const float* DTp = c.DT(); bf16* Yp = c.Y(); const bf16* R1p = c.R1(); float* SSQp = c.SSQ();
    const int pi = w >> 1, nj0 = 2 * (w & 1);
    const int i = tid >> 2, part = tid & 3;
    for (int dir = 0; dir < 2; ++dir) {
        const float A = -__expf(c.a_log()[(l * 2 + dir) * 8 + h]);
        f32x4 Sacc[2];
        __syncthreads();
#pragma unroll
        for (int q = 0; q < 2; ++q)
#pragma unroll
            for (int r = 0; r < 4; ++r) { const int p = 16 * pi + 4 * lq + r, n = 16 * (nj0 + q) + lr;
                const float v = pass ? c.state_ssd()[(((((size_t)(b * 2 + l) * 2 + dir) * 8 + h) * 64 + p) * 64) + n] : 0.f;
                Sacc[q][r] = v; ST[p * 72 + n] = (bf16)f2bf(v); }
        v4u x0, x1, b0, b1, c0, c1; float d0 = 0.f, d1 = 0.f;
#define SSD_LOAD(ci_) { const int t_ = dir ? L - 1 - ((ci_) * 128 + i) : (ci_) * 128 + i; const bf16* xr_ = XCp + (size_t)(tok0 + t_) * 768; \
            x0 = *(const v4u*)(xr_ + h * 64 + part * 16); x1 = *(const v4u*)(xr_ + h * 64 + part * 16 + 8); \
            b0 = *(const v4u*)(xr_ + 512 + grp * 64 + part * 16); b1 = *(const v4u*)(xr_ + 512 + grp * 64 + part * 16 + 8); \
            c0 = *(const v4u*)(xr_ + 640 + grp * 64 + part * 16); c1 = *(const v4u*)(xr_ + 640 + grp * 64 + part * 16 + 8); \
            if (tid < 64) { const int i0_ = 2 * lane, ta_ = dir ? L - 1 - ((ci_) * 128 + i0_) : (ci_) * 128 + i0_, tb_ = dir ? ta_ - 1 : ta_ + 1; \
                d0 = DTp[(size_t)(tok0 + ta_) * 16 + dir * 8 + h]; d1 = DTp[(size_t)(tok0 + tb_) * 16 + dir * 8 + h]; } }
        SSD_LOAD(0);
        for (int ci = 0; ci < NCH; ++ci) {
            LDS_BARRIER();
            float bvals[16];
            { *(v4u*)(Bm + i * 72 + part * 16) = b0; *(v4u*)(Bm + i * 72 + part * 16 + 8) = b1;
              *(v4u*)(Cm + i * 72 + part * 16) = c0; *(v4u*)(Cm + i * 72 + part * 16 + 8) = c1;
              const unsigned xs[8] = {x0.x, x0.y, x0.z, x0.w, x1.x, x1.y, x1.z, x1.w};
#pragma unroll
              for (int j = 0; j < 8; ++j) { XT[(part * 16 + 2 * j) * 136 + i] = (bf16)(xs[j] & 0xffffu); XT[(part * 16 + 2 * j + 1) * 136 + i] = (bf16)(xs[j] >> 16); }
              float t8[8]; unpack8(b0, t8);
#pragma unroll
              for (int j = 0; j < 8; ++j) bvals[j] = t8[j];
              unpack8(b1, t8);
#pragma unroll
              for (int j = 0; j < 8; ++j) bvals[8 + j] = t8[j]; }
            if (tid < 64) {
                const int i0 = 2 * lane, i1 = i0 + 1;
                const float a0 = d0 * A, a1 = d1 * A; float s = a0 + a1;
#pragma unroll
                for (int o = 1; o < 64; o <<= 1) { const float v = __shfl_up(s, o); if (lane >= o) s += v; }
                const float cum1 = s, cum0 = s - a1, total = __shfl(s, 63);
                cum[i0] = cum0; cum[i1] = cum1; dtv[i0] = d0; dtv[i1] = d1;
                wv[i0] = __expf(total - cum0) * d0; wv[i1] = __expf(total - cum1) * d1; ecum[i0] = __expf(cum0); ecum[i1] = __expf(cum1);
                if (lane == 0) tot[0] = __expf(total);
            }
            if (ci + 1 < NCH) SSD_LOAD(ci + 1);
            unsigned short zz[16], yy[16];
            if (dir == 1) {
#pragma unroll
                for (int r = 0; r < 4; ++r) { const int tt = 16 * w + 4 * lq + r; const size_t m = (size_t)tok0 + (L - 1 - (ci * 128 + tt));
#pragma unroll
                    for (int jp = 0; jp < 4; ++jp) { zz[4 * r + jp] = R1p[m * 4096 + C_Z + h * 64 + 16 * jp + lr]; yy[4 * r + jp] = Yp[m * 2048 + h * 64 + 16 * jp + lr]; } }
            }
            LDS_BARRIER();
            { const float wi = wv[i];
#pragma unroll
              for (int j = 0; j < 16; ++j) BwT[(part * 16 + j) * 136 + i] = (bf16)f2bf(bvals[j] * wi); }
            bx8 cfr[2];
#pragma unroll
            for (int ks = 0; ks < 2; ++ks) cfr[ks] = *(const bx8*)(Cm + (16 * w + lr) * 72 + 32 * ks + 8 * lq);
            for (int j = 0; j <= w; ++j) {
                const bx8 bb0 = *(const bx8*)(Bm + (16 * j + lr) * 72 + 8 * lq), bb1 = *(const bx8*)(Bm + (16 * j + lr) * 72 + 32 + 8 * lq);
                f32x4 g = {0.f, 0.f, 0.f, 0.f};
                g = MFMA16(cfr[0], bb0, g); g = MFMA16(cfr[1], bb1, g);
                const int s = 16 * j + lr; const float cs = cum[s], ds = dtv[s];
#pragma unroll
                for (int r = 0; r < 4; ++r) { const int tt = 16 * w + 4 * lq + r; const float v = (s <= tt) ? g[r] * __expf(cum[tt] - cs) * ds : 0.f; Mm[tt * 136 + s] = (bf16)f2bf(v); }
            }
            if (!(w & 1)) {
#pragma unroll
                for (int r = 0; r < 4; ++r) Mm[(16 * w + 4 * lq + r) * 136 + 16 * (w + 1) + lr] = 0;
            }
            LDS_BARRIER();
            f32x4 yl[4], yo[4];
#pragma unroll
            for (int jp = 0; jp < 4; ++jp) { yl[jp] = (f32x4){0.f, 0.f, 0.f, 0.f}; yo[jp] = (f32x4){0.f, 0.f, 0.f, 0.f}; }
            for (int ks = 0; ks <= (w >> 1); ++ks) {
                const bx8 af = *(const bx8*)(Mm + (16 * w + lr) * 136 + 32 * ks + 8 * lq);
#pragma unroll
                for (int jp = 0; jp < 4; ++jp) { const bx8 xf = *(const bx8*)(XT + (16 * jp + lr) * 136 + 32 * ks + 8 * lq); yl[jp] = MFMA16(af, xf, yl[jp]); }
            }
#pragma unroll
            for (int ks = 0; ks < 2; ++ks)
#pragma unroll
                for (int jp = 0; jp < 4; ++jp) { const bx8 sf = *(const bx8*)(ST + (16 * jp + lr) * 72 + 32 * ks + 8 * lq); yo[jp] = MFMA16(cfr[ks], sf, yo[jp]); }
            {
#pragma unroll
                for (int r = 0; r < 4; ++r) {
                    const int tt = 16 * w + 4 * lq + r; const float ec = ecum[tt];
                    const int t = dir ? L - 1 - (ci * 128 + tt) : ci * 128 + tt; const size_t m = (size_t)tok0 + t;
                    float q = 0.f;
#pragma unroll
                    for (int jp = 0; jp < 4; ++jp) {
                        const int p = 16 * jp + lr; const float y = yl[jp][r] + ec * yo[jp][r];
                        if (dir == 0) Yp[m * 2048 + h * 64 + p] = (bf16)f2bf(y);
                        else { const float x = bf2f(XT[p * 136 + tt]); const float ytot = y + bf2f(yy[4 * r + jp]) + dsk * x; const float z = bf2f(zz[4 * r + jp]);
                            const float gt = ytot * siluf(z); Yp[m * 2048 + h * 64 + p] = (bf16)f2bf(gt); q += gt * gt; }
                    }
                    if (dir == 1) { q += __shfl_xor(q, 1); q += __shfl_xor(q, 2); q += __shfl_xor(q, 4); q += __shfl_xor(q, 8); if (lr == 0) atomicAdd(SSQp + m, q); }
                }
            }
            LDS_BARRIER();
            {
                f32x4 st[2] = {{0.f, 0.f, 0.f, 0.f}, {0.f, 0.f, 0.f, 0.f}};
#pragma unroll
                for (int ks = 0; ks < 4; ++ks) { const bx8 af = *(const bx8*)(XT + (16 * pi + lr) * 136 + 32 * ks + 8 * lq);
#pragma unroll
                    for (int q = 0; q < 2; ++q) { const bx8 bf = *(const bx8*)(BwT + (16 * (nj0 + q) + lr) * 136 + 32 * ks + 8 * lq); st[q] = MFMA16(af, bf, st[q]); } }
                const float et = tot[0];
#pragma unroll
                for (int q = 0; q < 2; ++q)
#pragma unroll
                    for (int r = 0; r < 4; ++r) { Sacc[q][r] = et * Sacc[q][r] + st[q][r]; ST[(16 * pi + 4 * lq + r) * 72 + 16 * (nj0 + q) + lr] = (bf16)f2bf(Sacc[q][r]); }
            }
        }
#undef SSD_LOAD
        if (!pass) {
#pragma unroll
            for (int q = 0; q < 2; ++q)
#pragma unroll
                for (int r = 0; r < 4; ++r) { const int p = 16 * pi + 4 * lq + r, n = 16 * (nj0 + q) + lr;
                    c.out()[O_SSD + (((((size_t)(b * 2 + l) * 2 + dir) * 8 + h) * 64 + p) * 64) + n] = Sacc[q][r]; }
        }
    }
}

__device__ __forceinline__ void s5_tables(const Ctx& c, int l, int g, int part, float* lf) {
    const int tid = c.tid;
    float* pw = lf;
    float* Bc = pw + 2 * 17 * 128;
    float* Cc = Bc + 2 * 2048;
    if (tid < 128) { const int dir = tid >> 6, n = tid & 63, idx = ((l * 2 + dir) * 32 + g) * 64 + n;
        const float lre = c.lam_re()[idx], lim = c.lam_im()[idx], step = expf(c.log_step()[(l * 2 + dir) * 32 + g]);
        for (int k = 0; k <= 16; ++k) { const float mag = expf(lre * step * (float)k); float sn, cs; sincosf(lim * step * (float)k, &sn, &cs); pw[((dir * 17 + k) * 64 + n) * 2] = mag * cs; pw[((dir * 17 + k) * 64 + n) * 2 + 1] = mag * sn; }
        const float mag = expf(lre * step); float sn, cs; sincosf(lim * step, &sn, &cs); const float are = mag * cs, aim = mag * sn;
        const float den = lre * lre + lim * lim, cre = ((are - 1.0f) * lre + aim * lim) / den, cim = (aim * lre - (are - 1.0f) * lim) / den;
        for (int mm = 0; mm < 16; ++mm) { const float br = c.b_re()[(size_t)idx * 16 + mm], bi = c.b_im()[(size_t)idx * 16 + mm]; Bc[((dir * 64 + n) * 16 + mm) * 2] = cre * br - cim * bi; Bc[((dir * 64 + n) * 16 + mm) * 2 + 1] = cre * bi + cim * br; }
    }
    for (int i = tid; i < 2048; i += NTHR) { const int dir = i >> 10, mm = (i >> 6) & 15, n = i & 63; const size_t src = ((size_t)((l * 2 + dir) * 32 + g) * 16 + mm) * 64 + n;
        Cc[i * 2] = c.c_re()[src]; Cc[i * 2 + 1] = c.c_im()[src]; }
    __syncthreads();
    if (part == 0 && tid < 128) { const int dir = tid >> 6, n = tid & 63; float* at = (float*)(c.ws() + WS_S5AT) + ((size_t)(dir * 32 + g) * 64 + n) * 2; at[0] = pw[((dir * 17 + 16) * 64 + n) * 2]; at[1] = pw[((dir * 17 + 16) * 64 + n) * 2 + 1]; }
    bf16* Kt = (bf16*)(c.ws() + WS_S5K) + (size_t)g * 31 * 256;
    for (int e = part * 1984 + tid; e < (part + 1) * 1984; e += NTHR) { const int tp = e >> 8, mm = (e >> 4) & 15, m2 = e & 15, tau = tp - 15; float acc = 0.f;
#pragma unroll
        for (int dir = 0; dir < 2; ++dir) { if ((dir == 0 && tau < 0) || (dir == 1 && tau > 0)) continue; const int k = tau < 0 ? -tau : tau;
            const float* pp = pw + (dir * 17 + k) * 128; const float* bb = Bc + dir * 2048 + m2 * 2; const float* cc = Cc + (dir * 16 + mm) * 128;
            for (int n = 0; n < 64; ++n) { const float pr = pp[2 * n], pi = pp[2 * n + 1], br = bb[n * 32], bi = bb[n * 32 + 1], Pr = pr * br - pi * bi, Pi = pr * bi + pi * br; acc += cc[2 * n] * Pr - cc[2 * n + 1] * Pi; } }
        if (tau == 0 && mm == m2) acc += c.s5_d()[l * 512 + g * 16 + mm];
        Kt[e] = (bf16)f2bf(acc); }
    for (int e = part * 16384 + tid; e < (part + 1) * 16384; e += NTHR) { const int dir = e >> 15, sidx = (e >> 8) & 127, k = e & 255, ri = sidx >> 6, n = sidx & 63, j = k >> 4, m2 = k & 15, ex = dir ? j : 15 - j;
        const float pr = pw[((dir * 17 + ex) * 64 + n) * 2], pi = pw[((dir * 17 + ex) * 64 + n) * 2 + 1], br = Bc[((dir * 64 + n) * 16 + m2) * 2], bi = Bc[((dir * 64 + n) * 16 + m2) * 2 + 1];
        ((bf16*)(c.ws() + WS_S5WS))[((size_t)(dir * 32 + g) * 128 + sidx) * 256 + k] = (bf16)f2bf(ri ? pr * bi + pi * br : pr * br - pi * bi); }
    for (int e = part * 16384 + tid; e < (part + 1) * 16384; e += NTHR) { const int row = e >> 8, k = e & 255, i = row >> 4, mm = row & 15, dir = k >> 7, ri = (k >> 6) & 1, n = k & 63, ex = dir ? 16 - i : i + 1;
        const float pr = pw[((dir * 17 + ex) * 64 + n) * 2], pi = pw[((dir * 17 + ex) * 64 + n) * 2 + 1], cr = Cc[((dir * 16 + mm) * 64 + n) * 2], ci = Cc[((dir * 16 + mm) * 64 + n) * 2 + 1];
        ((bf16*)(c.ws() + WS_S5WO))[(size_t)g * 65536 + e] = (bf16)f2bf(ri ? -(cr * pi + ci * pr) : cr * pr - ci * pi); }
    __syncthreads();
}

__device__ __forceinline__ void s5_unit(const Ctx& c, int l, int g, int cu, unsigned char* lds) {
    const int tid = c.tid, lane = c.lane, w = c.wave, lr = lane & 15, lq = lane >> 4;
    const bool lat = cu >= 8;
    bf16* Ut = (bf16*)lds;
    bf16* St = Ut + 64 * 264;
    bf16* Kt = St + 64 * 264;
    float* Dl = (float*)(Kt + 31 * 256);
    const bf16* R1p = c.R1();
    const bf16* Wsp0 = (const bf16*)(c.ws() + WS_S5WS) + ((size_t)(0 * 32 + g) * 128 + 16 * w + lr) * 256 + 8 * lq;
    const bf16* Wsp1 = (const bf16*)(c.ws() + WS_S5WS) + ((size_t)(1 * 32 + g) * 128 + 16 * w + lr) * 256 + 8 * lq;
    const bf16* Wop = (const bf16*)(c.ws() + WS_S5WO) + (size_t)g * 65536 + 8 * lq;
    bx8 afA[8], afB[8];
#pragma unroll
    for (int ks = 0; ks < 8; ++ks) afA[ks] = *(const bx8*)(Wsp0 + 32 * ks);
    { const v4u* src = (const v4u*)((const bf16*)(c.ws() + WS_S5K) + (size_t)g * 31 * 256); for (int i = tid; i < 31 * 32; i += NTHR) ((v4u*)Kt)[i] = src[i]; }
#pragma unroll
    for (int i = 0; i < 2; ++i) { const int id = tid + NTHR * i, col = id >> 4, j = id & 15;
        const int tok = lat ? MC + (cu - 8) * 1024 + col * 16 + j : (4 * cu + (col >> 4)) * 256 + (col & 15) * 16 + j;
        const bf16* up = R1p + (size_t)tok * 4096 + C_U + g * 16;
        *(v4u*)(Ut + col * 264 + j * 16) = *(const v4u*)up; *(v4u*)(Ut + col * 264 + j * 16 + 8) = *(const v4u*)(up + 8); }
#pragma unroll
    for (int ks = 0; ks < 8; ++ks) afB[ks] = *(const bx8*)(Wsp1 + 32 * ks);
    LDS_BARRIER();
#pragma unroll
    for (int dir = 0; dir < 2; ++dir) {
        f32x4 acc[4];
#pragma unroll
        for (int cb = 0; cb < 4; ++cb) acc[cb] = (f32x4){0.f, 0.f, 0.f, 0.f};
#pragma unroll
        for (int ks = 0; ks < 8; ++ks) {
#pragma unroll
            for (int cb = 0; cb < 4; ++cb) { const bx8 bf = *(const bx8*)(Ut + (16 * cb + lr) * 264 + 32 * ks + 8 * lq); acc[cb] = MFMA16(dir ? afB[ks] : afA[ks], bf, acc[cb]); }
            __builtin_amdgcn_sched_barrier(0); }
        if (dir == 0) {
#pragma unroll
            for (int ks = 0; ks < 8; ++ks) afA[ks] = *(const bx8*)(Wop + (size_t)(16 * (2 * w) + lr) * 256 + 32 * ks); }
        else {
#pragma unroll
            for (int ks = 0; ks < 8; ++ks) afB[ks] = *(const bx8*)(Wop + (size_t)(16 * (2 * w + 1) + lr) * 256 + 32 * ks); }
#pragma unroll
        for (int cb = 0; cb < 4; ++cb)
#pragma unroll
            for (int r = 0; r < 4; ++r) Dl[(16 * w + 4 * lq + r) * 65 + 16 * cb + lr] = acc[cb][r];
        LDS_BARRIER();
        if (tid < (lat ? 64 : 256)) {
            const int n = tid & 63, bl = tid >> 6, nc = lat ? 64 : 16, cbase = lat ? 0 : 16 * bl, b = lat ? cu - 8 : 4 * cu + bl;
            const float* at = (const float*)(c.ws() + WS_S5AT) + ((size_t)(dir * 32 + g) * 64 + n) * 2; const float ar = at[0], ai = at[1];
            float sr = 0.f, si = 0.f;
            if (lat) { sr = c.state_s5()[((((size_t)(b * 2 + l) * 2 + dir) * 2 + 0) * 32 + g) * 64 + n]; si = c.state_s5()[((((size_t)(b * 2 + l) * 2 + dir) * 2 + 1) * 32 + g) * 64 + n]; }
            for (int cc = 0; cc < nc; ++cc) { const int col = cbase + (dir ? nc - 1 - cc : cc);
                St[col * 264 + dir * 128 + n] = (bf16)f2bf(sr); St[col * 264 + dir * 128 + 64 + n] = (bf16)f2bf(si);
                const float dr = Dl[n * 65 + col], di = Dl[(64 + n) * 65 + col];
                const float nr = ar * sr - ai * si + dr, ni = ar * si + ai * sr + di; sr = nr; si = ni; }
            if (!lat) { c.out()[O_S5 + ((((size_t)(b * 2 + l) * 2 + dir) * 2 + 0) * 32 + g) * 64 + n] = sr; c.out()[O_S5 + ((((size_t)(b * 2 + l) * 2 + dir) * 2 + 1) * 32 + g) * 64 + n] = si; }
        }
        LDS_BARRIER();
    }
#pragma unroll
    for (int ii = 0; ii < 2; ++ii) { const int i = 2 * w + ii;
        f32x4 acc[4];
#pragma unroll
        for (int cb = 0; cb < 4; ++cb) acc[cb] = (f32x4){0.f, 0.f, 0.f, 0.f};
#pragma unroll
        for (int ks = 0; ks < 8; ++ks) { const int j = 2 * ks + (lq >> 1); const bx8 af = *(const bx8*)(Kt + ((i - j + 15) * 16 + lr) * 16 + 8 * (lq & 1));
#pragma unroll
            for (int cb = 0; cb < 4; ++cb) { const bx8 bf = *(const bx8*)(Ut + (16 * cb + lr) * 264 + 32 * ks + 8 * lq); acc[cb] = MFMA16(af, bf, acc[cb]); }
            __builtin_amdgcn_sched_barrier(0); }
#pragma unroll
        for (int ks = 0; ks < 8; ++ks) {
#pragma unroll
            for (int cb = 0; cb < 4; ++cb) { const bx8 bf = *(const bx8*)(St + (16 * cb + lr) * 264 + 32 * ks + 8 * lq); acc[cb] = MFMA16(ii ? afB[ks] : afA[ks], bf, acc[cb]); }
            __builtin_amdgcn_sched_barrier(0); }
#pragma unroll
        for (int cb = 0; cb < 4; ++cb) { const int col = 16 * cb + lr;
            const int tok = lat ? MC + (cu - 8) * 1024 + col * 16 + i : (4 * cu + (col >> 4)) * 256 + (col & 15) * 16 + i;
            v2u o; o.x = pk2(acc[cb][0], acc[cb][1]); o.y = pk2(acc[cb][2], acc[cb][3]);
            *(v2u*)(c.Y5() + (size_t)tok * 512 + g * 16 + 4 * lq) = o; }
    }
}

typedef float f32x16 __attribute__((ext_vector_type(16)));
#define MFMA32(a, b, cc) __builtin_amdgcn_mfma_f32_32x32x16_bf16((a), (b), (cc), 0, 0, 0)
constexpr float SM_SC = 0.125f * 1.4426950408889634f;
__device__ __forceinline__ void qk_tile(f32x16& p0, f32x16& p1, const bf16* Kt, int KS, const bx8 (&qf)[4], int r32, int hi) {
    p0 = (f32x16){0.f}; p1 = (f32x16){0.f};
    bx8 a0[4], a1[4];
#pragma unroll
    for (int d0 = 0; d0 < 4; ++d0) { a0[d0] = *(const bx8*)(Kt + r32 * KS + 16 * d0 + 8 * hi); a1[d0] = *(const bx8*)(Kt + (32 + r32) * KS + 16 * d0 + 8 * hi); }
    __builtin_amdgcn_s_setprio(1);
#pragma unroll
    for (int d0 = 0; d0 < 4; ++d0) { p0 = MFMA32(a0[d0], qf[d0], p0); p1 = MFMA32(a1[d0], qf[d0], p1); }
    __builtin_amdgcn_s_setprio(0);
}
__device__ __forceinline__ float fmax_(float a, float b) { float r; asm("v_max_f32_e32 %0, %1, %2" : "=v"(r) : "v"(a), "v"(b)); return r; }
__device__ __forceinline__ float max3_(float a, float b, float cc) { float r; asm("v_max3_f32 %0, %1, %2, %3" : "=v"(r) : "v"(a), "v"(b), "v"(cc)); return r; }
constexpr float SM_THR = 8.0f;
__device__ __forceinline__ float sm_step(f32x16& p0, f32x16& p1, float& mrun, float& lrun, bx8 (&pb)[4]) {
    float ta = max3_(p0[0], p1[0], p0[1]), tb = max3_(p1[1], p0[2], p1[2]);
#pragma unroll
    for (int r = 3; r < 15; r += 2) { ta = max3_(ta, p0[r], p1[r]); tb = max3_(tb, p0[r + 1], p1[r + 1]); }
    ta = max3_(ta, p0[15], p1[15]);
    float tm = fmax_(ta, tb) * SM_SC;
    tm = fmax_(tm, __shfl_xor(tm, 32));
    float alpha = 1.0f;
    if (__any(tm > mrun + SM_THR)) { const float mnew = fmax_(mrun, tm); alpha = __builtin_amdgcn_exp2f(mrun - mnew); mrun = mnew; }
    const float mn = mrun;
    float rs0 = 0.f, rs1 = 0.f;
#pragma unroll
    for (int r = 0; r < 16; ++r) { p0[r] = __builtin_amdgcn_exp2f(fmaf(p0[r], SM_SC, -mn)); p1[r] = __builtin_amdgcn_exp2f(fmaf(p1[r], SM_SC, -mn)); rs0 += p0[r]; rs1 += p1[r]; }
    float rs = rs0 + rs1;
    rs += __shfl_xor(rs, 32);
    lrun = lrun * alpha + rs;
#pragma unroll
    for (int sI = 0; sI < 2; ++sI) {
        v4u t0, t1;
        t0.x = pg8::cvt_pk_bf16(p0[8 * sI + 0], p0[8 * sI + 1]); t0.y = pg8::cvt_pk_bf16(p0[8 * sI + 2], p0[8 * sI + 3]); t0.z = pg8::cvt_pk_bf16(p0[8 * sI + 4], p0[8 * sI + 5]); t0.w = pg8::cvt_pk_bf16(p0[8 * sI + 6], p0[8 * sI + 7]);
        t1.x = pg8::cvt_pk_bf16(p1[8 * sI + 0], p1[8 * sI + 1]); t1.y = pg8::cvt_pk_bf16(p1[8 * sI + 2], p1[8 * sI + 3]); t1.z = pg8::cvt_pk_bf16(p1[8 * sI + 4], p1[8 * sI + 5]); t1.w = pg8::cvt_pk_bf16(p1[8 * sI + 6], p1[8 * sI + 7]);
        pb[sI] = __builtin_bit_cast(bx8, t0); pb[2 + sI] = __builtin_bit_cast(bx8, t1);
    }
    return alpha;
}
typedef short v4i16_t __attribute__((ext_vector_type(4)));
__device__ __forceinline__ v2u vtr(const bf16* p) { return __builtin_bit_cast(v2u, __builtin_amdgcn_ds_read_tr16_b64_v4i16((__attribute__((address_space(3))) v4i16_t*)p)); }
template <int NDT, int VS> __device__ __forceinline__ void pv_tile(f32x16 (&o)[NDT], const bf16* Vr, const bx8 (&pb)[4], int lane) {
    const bf16* vb = Vr + (4 * (lane >> 5) + ((lane & 15) >> 2)) * VS + 16 * ((lane >> 4) & 1) + 4 * (lane & 3);
    v2u cur[NDT][2], nxt[NDT][2];
#pragma unroll
    for (int dt = 0; dt < NDT; ++dt) { cur[dt][0] = vtr(vb + 32 * dt); cur[dt][1] = vtr(vb + 8 * VS + 32 * dt); }
#pragma unroll
    for (int ks = 0; ks < 4; ++ks) {
        if (ks < 3) {
#pragma unroll
            for (int dt = 0; dt < NDT; ++dt) { nxt[dt][0] = vtr(vb + (16 * (ks + 1)) * VS + 32 * dt); nxt[dt][1] = vtr(vb + (16 * (ks + 1) + 8) * VS + 32 * dt); }
        }
        __builtin_amdgcn_s_setprio(1);
#pragma unroll
        for (int dt = 0; dt < NDT; ++dt) { const v4u t = {cur[dt][0].x, cur[dt][0].y, cur[dt][1].x, cur[dt][1].y}; o[dt] = MFMA32(__builtin_bit_cast(bx8, t), pb[ks], o[dt]); }
        __builtin_amdgcn_s_setprio(0);
#pragma unroll
        for (int dt = 0; dt < NDT; ++dt) { cur[dt][0] = nxt[dt][0]; cur[dt][1] = nxt[dt][1]; }
    }
}

template <int PASS> __device__ __forceinline__ void diff_unit(const Ctx& c, int l, int uidx, unsigned char* lds) {
    constexpr int NT = PASS ? 10 : 2, NQB = PASS ? 8 : 2, VS = 160;
    const int tid = c.tid, lane = c.lane, w = c.wave, r32 = lane & 31, hi = lane >> 5, comp = w >> 2;
    const int qb = uidx % NQB, h = (uidx / NQB) & 3, b = uidx / (NQB * 4);
    const int tok0 = PASS ? MC + b * 1024 : b * 256;
    bf16* Kt = (bf16*)lds;
    bf16* Vr = Kt + 128 * 136;
    float* Ob = (float*)lds;
    const bf16* R1p = c.R1(); const bf16* CK = c.CKV() + (size_t)l * 1024 * 1280;
    const float lam_init = 0.8f - 0.6f * expf(-0.3f * (float)l);
    const float* lv = c.dlam() + l * 256;
    const float lam = expf(wave_sum(lv[lane] * lv[64 + lane])) - expf(wave_sum(lv[128 + lane] * lv[192 + lane])) + lam_init;
    const size_t mrow = (size_t)tok0 + qb * 128 + 32 * (w & 3) + r32;
    bx8 qf[4];
#pragma unroll
    for (int d0 = 0; d0 < 4; ++d0) qf[d0] = *(const bx8*)(R1p + mrow * 4096 + C_DQ + h * 128 + comp * 64 + 16 * d0 + 8 * hi);
    f32x16 o[4];
#pragma unroll
    for (int dt = 0; dt < 4; ++dt) o[dt] = (f32x16){0.f};
    float mrun = -1e30f, lrun = 0.f;
    v4u kreg[4], vreg[4];
#define DIFF_LOAD(t) { const bf16* kb; const bf16* vb; size_t rs; \
        if (PASS && (t) < 2) { kb = CK + ((size_t)b * 256 + 128 * (t)) * 1280 + h * 128; vb = kb + 512; rs = 1280; } \
        else { kb = R1p + ((size_t)tok0 + 128 * ((t) - (PASS ? 2 : 0))) * 4096 + C_DK + h * 128; vb = kb + (C_DV - C_DK); rs = 4096; } \
        _Pragma("unroll") for (int i = 0; i < 4; ++i) { const int id = tid + NTHR * i; kreg[i] = *(const v4u*)(kb + (size_t)(id >> 4) * rs + (id & 15) * 8); vreg[i] = *(const v4u*)(vb + (size_t)(id >> 4) * rs + (id & 15) * 8); } }
    DIFF_LOAD(0);
    for (int t = 0; t < NT; ++t) {
        LDS_BARRIER();
#pragma unroll
        for (int i = 0; i < 4; ++i) { const int id = tid + NTHR * i; *(v4u*)(Kt + (id >> 4) * 136 + (id & 15) * 8) = kreg[i]; *(v4u*)(Vr + (id >> 4) * VS + (id & 15) * 8) = vreg[i]; }
        if (t + 1 < NT) DIFF_LOAD(t + 1);
        LDS_BARRIER();
#pragma unroll
        for (int sub = 0; sub < 2; ++sub) {
            f32x16 p0, p1; bx8 pb[4];
            qk_tile(p0, p1, Kt + sub * 64 * 136 + comp * 64, 136, qf, r32, hi);
            const float alpha = sm_step(p0, p1, mrun, lrun, pb);
            if (__any(alpha != 1.0f)) {
#pragma unroll
                for (int dt = 0; dt < 4; ++dt)
#pragma unroll
                    for (int r = 0; r < 16; ++r) o[dt][r] *= alpha; }
            pv_tile<4, VS>(o, Vr + sub * 64 * VS, pb, lane);
        }
    }
#undef DIFF_LOAD
    const float inv = (comp ? lam : 1.0f) / lrun;
    const int rowl = 32 * (w & 3) + r32;
    LDS_BARRIER();
    if (comp) {
#pragma unroll
        for (int dt = 0; dt < 4; ++dt)
#pragma unroll
            for (int r = 0; r < 16; ++r) Ob[rowl * 129 + 32 * dt + (r & 3) + 8 * (r >> 2) + 4 * hi] = o[dt][r] * inv;
    }
    LDS_BARRIER();
    if (!comp) {
        float ss = 0.f;
#pragma unroll
        for (int dt = 0; dt < 4; ++dt)
#pragma unroll
            for (int r = 0; r < 16; ++r) { const float v = o[dt][r] * inv - Ob[rowl * 129 + 32 * dt + (r & 3) + 8 * (r >> 2) + 4 * hi]; o[dt][r] = v; ss += v * v; }
        ss += __shfl_xor(ss, 32);
        const float rn = rsqrtf(ss * (1.0f / 128.0f) + EPS) * (1.0f - lam_init);
        const float* sg = c.subln_g() + l * 128; bf16* yp = c.Y() + mrow * 2048 + 1024 + h * 128;
#pragma unroll
        for (int dt = 0; dt < 4; ++dt)
#pragma unroll
            for (int r4 = 0; r4 < 4; ++r4) { const int dv = 32 * dt + 8 * r4 + 4 * hi; const f32x4 g = *(const f32x4*)(sg + dv);
                v2u ov; ov.x = pk2(o[dt][4 * r4 + 0] * rn * g.x, o[dt][4 * r4 + 1] * rn * g.y); ov.y = pk2(o[dt][4 * r4 + 2] * rn * g.z, o[dt][4 * r4 + 3] * rn * g.w);
                *(v2u*)(yp + dv) = ov; }
    }
}

template <int PASS> __device__ __forceinline__ void win_unit(const Ctx& c, int l, int uidx, unsigned char* lds) {
    constexpr int NQB = PASS ? 4 : 1, VS = 96;
    const int tid = c.tid, lane = c.lane, w = c.wave, r32 = lane & 31, hi = lane >> 5;
    const int qb = uidx % NQB, hh = (uidx / NQB) & 7, b = uidx / (NQB * 8), nkv = hh >> 2;
    const int tok0 = PASS ? MC + b * 1024 : b * 256;
    bf16* Kt = (bf16*)lds;
    bf16* Vr = Kt + 128 * 72;
    const bf16* R1p = c.R1(); const bf16* CK = c.CKV() + (size_t)l * 1024 * 1280;
    const int qrow = qb * 256 + 32 * w + r32;
    const size_t mrow = (size_t)tok0 + qrow;
    bx8 qf[4];
#pragma unroll
    for (int d0 = 0; d0 < 4; ++d0) qf[d0] = *(const bx8*)(R1p + mrow * 4096 + C_WQ + hh * 64 + 16 * d0 + 8 * hi);
    f32x16 o[2]; o[0] = (f32x16){0.f}; o[1] = (f32x16){0.f};
    float mrun = c.sink()[l * 8 + hh] * 1.4426950408889634f, lrun = 1.0f;
    const int q0 = qb * 256;
    const int tb0 = PASS ? ((q0 - 128 < 0 ? 0 : q0 - 128) >> 7) : 0, tb1 = PASS ? ((q0 + 255 + 128 > 1023 ? 1023 : q0 + 255 + 128) >> 7) : 0;
    const int NT = PASS ? 2 + (tb1 - tb0 + 1) : 2;
    v4u kreg[2], vreg[2];
#define WIN_LOAD(t) { const bf16* kb; const bf16* vb; size_t rs; \
        if (PASS && (t) < 2) { kb = CK + ((size_t)b * 256 + 128 * (t)) * 1280 + 1024 + nkv * 64; vb = kb + 128; rs = 1280; } \
        else { kb = R1p + ((size_t)tok0 + 128 * (PASS ? tb0 + (t) - 2 : (t))) * 4096 + C_WK + nkv * 64; vb = kb + (C_WV - C_WK); rs = 4096; } \
        _Pragma("unroll") for (int i = 0; i < 2; ++i) { const int id = tid + NTHR * i; kreg[i] = *(const v4u*)(kb + (size_t)(id >> 3) * rs + (id & 7) * 8); vreg[i] = *(const v4u*)(vb + (size_t)(id >> 3) * rs + (id & 7) * 8); } }
    WIN_LOAD(0);
    for (int t = 0; t < NT; ++t) {
        LDS_BARRIER();
#pragma unroll
        for (int i = 0; i < 2; ++i) { const int id = tid + NTHR * i; *(v4u*)(Kt + (id >> 3) * 72 + (id & 7) * 8) = kreg[i]; *(v4u*)(Vr + (id >> 3) * VS + (id & 7) * 8) = vreg[i]; }
        if (t + 1 < NT) WIN_LOAD(t + 1);
        LDS_BARRIER();
#pragma unroll
        for (int sub = 0; sub < 2; ++sub) {
            bool band = false; int kp0 = 0;
            if (PASS && t >= 2) { band = true; kp0 = 128 * (tb0 + t - 2) + 64 * sub; const int r0 = q0 + 32 * w;
                if (kp0 + 63 < r0 - 128 || kp0 > r0 + 31 + 128) continue; }
            f32x16 p0, p1; bx8 pb[4];
            qk_tile(p0, p1, Kt + sub * 64 * 72, 72, qf, r32, hi);
            if (band) {
#pragma unroll
                for (int r = 0; r < 16; ++r) { const int kp = kp0 + (r & 3) + 8 * (r >> 2) + 4 * hi; const int d0 = qrow - kp, d1 = d0 - 32;
                    if (d0 > 128 || d0 < -128) p0[r] = -1e30f; if (d1 > 128 || d1 < -128) p1[r] = -1e30f; }
            }
            const float alpha = sm_step(p0, p1, mrun, lrun, pb);
            if (__any(alpha != 1.0f)) {
#pragma unroll
                for (int dt = 0; dt < 2; ++dt)
#pragma unroll
                    for (int r = 0; r < 16; ++r) o[dt][r] *= alpha; }
            pv_tile<2, VS>(o, Vr + sub * 64 * VS, pb, lane);
        }
    }
#undef WIN_LOAD
    const float inv = 1.0f / lrun; bf16* yp = c.Y() + mrow * 2048 + 1536 + hh * 64;
#pragma unroll
    for (int dt = 0; dt < 2; ++dt)
#pragma unroll
        for (int r4 = 0; r4 < 4; ++r4) { const int dv = 32 * dt + 8 * r4 + 4 * hi;
            v2u ov; ov.x = pk2(o[dt][4 * r4 + 0] * inv, o[dt][4 * r4 + 1] * inv); ov.y = pk2(o[dt][4 * r4 + 2] * inv, o[dt][4 * r4 + 3] * inv);
            *(v2u*)(yp + dv) = ov; }
}

__device__ __forceinline__ void phase_mixers(const Ctx& c_in, int l, float* lf) {
    unsigned char* lds = (unsigned char*)lf;
    unsigned* qctr = (unsigned*)(c_in.ws() + WS_QCTR) + 64 * l;
    volatile int* qslot = (volatile int*)(lds + LDS_BYTES - 32);
    for (;;) {
        __syncthreads();
        if (threadIdx.x == 0) *qslot = (int)atomicAdd(qctr, 1u);
        __syncthreads();
        const int u = __builtin_amdgcn_readfirstlane(*qslot);
        if (u >= 1440) break;
        Ctx c = c_in; asm volatile("" : "+s"(c.ap), "+v"(c.tid));
        c.lane = c.tid & 63; c.wave = __builtin_amdgcn_readfirstlane(c.tid >> 6);
        unsigned long long pt0 = 0; if (PROBE_SEL >= 0) pt0 = __builtin_amdgcn_s_memrealtime();
        int ty;
        if (u < 32) { ssd_unit(c, l, 1, u >> 3, u & 7, lds); ty = 0; }
        else if (u < 160) { diff_unit<1>(c, l, u - 32, lds); ty = 2; }
        else if (u < 416) { ssd_unit(c, l, 0, (u - 160) >> 3, (u - 160) & 7, lds); ty = 4; }
        else if (u < 544) { win_unit<1>(c, l, u - 416, lds); ty = 3; }
        else if (u < 672) { s5_unit(c, l, (u - 544) & 31, 8 + ((u - 544) >> 5), lds); ty = 1; }
        else if (u < 928) { diff_unit<0>(c, l, u - 672, lds); ty = 6; }
        else if (u < 1184) { s5_unit(c, l, (u - 928) & 31, (u - 928) >> 5, lds); ty = 5; }
        else { win_unit<0>(c, l, u - 1184, lds); ty = 7; }
        __syncthreads();
        if (PROBE_SEL >= 0 && threadIdx.x == 0) { unsigned long long* tsu = (unsigned long long*)(c.ws() + WS_TS) + 64; atomicAdd(tsu + ty, (unsigned long long)(__builtin_amdgcn_s_memrealtime() - pt0)); }
    }
}

__device__ __forceinline__ void phase_sum4(const Ctx& c) {
    const int gt = blockIdx.x * NTHR + c.tid, NT = gridDim.x * NTHR;
#pragma unroll 4
    for (int i = gt; i < M * 128; i += NT) { const size_t m = (size_t)(i >> 7); const int c8 = (i & 127) * 8;
        float a[8] = {0.f, 0.f, 0.f, 0.f, 0.f, 0.f, 0.f, 0.f};
#pragma unroll
        for (int j = 0; j < 4; ++j) { float f[8]; unpack8(*(const v4u*)(c.R1() + m * 4096 + j * 1024 + c8), f);
#pragma unroll
            for (int k = 0; k < 8; ++k) a[k] += f[k]; }
        v4u o; o.x = pk2(a[0], a[1]); o.y = pk2(a[2], a[3]); o.z = pk2(a[4], a[5]); o.w = pk2(a[6], a[7]);
        *(v4u*)(c.H() + m * 1024 + c8) = o; }
}

#define GAS __attribute__((address_space(1)))
#define XB_TMO      128
#define XB_XCNT(j)  (256  + 64 * (j))
#define XB_XSUB(j)  (1280 + 64 * (j))
#define XB_XGEN(j)  (2304 + 64 * (j))
#define XB_TOP      3328
#define XB_TOPGEN   3392
#define XCD_BAR_WORDS 3456
#define XB_SPIN_CAP (1u << 18)

__device__ __forceinline__ unsigned xb_ld(unsigned* p)              { return __hip_atomic_load(p, __ATOMIC_RELAXED, __HIP_MEMORY_SCOPE_AGENT); }
__device__ __forceinline__ unsigned xb_add(unsigned* p, unsigned v) { return __hip_atomic_fetch_add(p, v, __ATOMIC_RELAXED, __HIP_MEMORY_SCOPE_AGENT); }
__device__ __forceinline__ unsigned xb_xcc_id() { return (unsigned)__builtin_amdgcn_s_getreg((3 << 11) | 20) & 0xFu; }
#define XB_SPIN(cond, bar) do { unsigned _sp = 0; while (cond) { __builtin_amdgcn_s_sleep(1); \
    if ((++_sp & 255u) == 0u) { if (xb_ld(&(bar)[XB_TMO])) break; if (_sp > XB_SPIN_CAP) { atomicAdd(&(bar)[XB_TMO], 1u); break; } } } } while (0)

struct XcdBarrier {
    unsigned* bar; unsigned x;
    volatile LAS unsigned* st;
};

__device__ __forceinline__ XcdBarrier xcd_barrier_post(unsigned* bar, volatile LAS unsigned* st) {
    XcdBarrier b; b.bar = bar; b.x = xb_xcc_id(); b.st = st;
    if (threadIdx.x == 0) (void)xb_add(&bar[XB_XCNT(b.x)], 1u);
    return b;
}
__device__ __forceinline__ void xcd_barrier_complete(unsigned* bar, unsigned x, unsigned& nloc, unsigned& nx) {
    const unsigned G = gridDim.x * gridDim.y * gridDim.z;
    unsigned sum, cnt, mine, sp = 0u;
    for (;;) {
        sum = 0u; cnt = 0u; mine = 0u;
#pragma unroll
        for (unsigned j = 0; j < 16; ++j) { const unsigned c = xb_ld(&bar[XB_XCNT(j)]); sum += c; cnt += (c > 0u) ? 1u : 0u; mine = (j == x) ? c : mine; }
        if (sum == G) break;
        __builtin_amdgcn_s_sleep(1);
        if ((++sp & 255u) == 0u) { if (xb_ld(&bar[XB_TMO])) break; if (sp > XB_SPIN_CAP) { atomicAdd(&bar[XB_TMO], 1u); break; } }
    }
    nloc = mine > 0u ? mine : 1u; nx = cnt > 0u ? cnt : 1u;
}

__device__ __forceinline__ void xcd_barrier(const XcdBarrier& b) {
    asm volatile("s_waitcnt vmcnt(0)" ::: "memory");
    __syncthreads();
    if (threadIdx.x == 0) {
        unsigned* bar = b.bar;
        __builtin_amdgcn_s_waitcnt(0);
        unsigned nloc = b.st[0], nx = b.st[1];
        if (nloc == 0u) { xcd_barrier_complete(bar, b.x, nloc, nx); b.st[0] = nloc; b.st[1] = nx; }
        const unsigned old = xb_add(&bar[XB_XSUB(b.x)], 1u);
        const unsigned gen = old / nloc;
        if (old + 1u == (gen + 1u) * nloc) {
            __builtin_amdgcn_fence(__ATOMIC_RELEASE, "agent");
            asm volatile("s_waitcnt vmcnt(0)" ::: "memory");
            const unsigned og = xb_add(&bar[XB_TOP], 1u);
            const unsigned tg = og / nx;
            if (og + 1u == (tg + 1u) * nx) xb_add(&bar[XB_TOPGEN], 1u);
            else XB_SPIN(xb_ld(&bar[XB_TOPGEN]) == tg, bar);
            __builtin_amdgcn_fence(__ATOMIC_ACQUIRE, "agent");
            xb_add(&bar[XB_XGEN(b.x)], 1u);
            asm volatile("s_waitcnt vmcnt(0)" ::: "memory");
        } else {
            XB_SPIN(xb_ld(&bar[XB_XGEN(b.x)]) == gen, bar);
            __builtin_amdgcn_fence(__ATOMIC_ACQUIRE, "agent");
            asm volatile("s_waitcnt vmcnt(0)" ::: "memory");
        }
    }
    __syncthreads();
}

#define PHASE_BEGIN() Ctx c; c.ap = (CArgs)__builtin_amdgcn_kernarg_segment_ptr(); asm volatile("" : "+s"(c.ap)); \
        int tid_o = threadIdx.x; asm volatile("" : "+v"(tid_o)); c.tid = tid_o; c.lane = tid_o & 63; c.wave = __builtin_amdgcn_readfirstlane(tid_o >> 6); \
        int G = gridDim.x, bid = blockIdx.x; asm volatile("" : "+s"(G), "+s"(bid)); unsigned char* ws = c.ws(); (void)ws; (void)G; (void)bid;
#define PHASE_END(k) { if ((k) + 1 < ph_hi) { if ((k) == 0) cg::this_grid().sync(); else xcd_barrier(xbar); } \
        if (PROBE_SEL >= 0 && blockIdx.x == PROBE_PB && threadIdx.x == 0) ((unsigned long long*)(c.ws() + WS_TS))[(k) + 1] = __builtin_amdgcn_s_memrealtime(); }
#define IN_RANGE(k) (ph_lo <= (k) && (k) < ph_hi)

template <int LAYER> __device__ __forceinline__ void layer_program(int ph_lo, int ph_hi, unsigned char* lds, const XcdBarrier& xbar) {
    float* lf = (float*)lds;
    PG8_LAS unsigned char* ring = (PG8_LAS unsigned char*)lds;
    constexpr int l = LAYER, B0 = 1 + 11 * LAYER;
    if (IN_RANGE(B0 + 0)) { PHASE_BEGIN(); if (l == 1) { if (gridDim.x == 256) convert_items(c, 1, 7936, 9984, blockIdx.x * NWAVES + c.wave, gridDim.x * NWAVES, false, 0, 1, lf); else phase_convert(c, 1, lf); __syncthreads(); } phase_norm(c, l, 0, lf); phase_bias2(c, l); PHASE_END(B0 + 0); }
    if (IN_RANGE(B0 + 1)) { PHASE_BEGIN();
        pg8::Gemm g{c.H(), (const bf16*)(ws + W_IN), M, 4096, 1024, 1024, 1024, 0, 0}; pg8::StaticOrder S; S.init(M, 4096, G, bid);
        pg8::EpiIn E{c.R1(), c.out(), c.ROPE(), c.qn_g() + l * 64, c.kn_g() + l * 64, c.wqn_g() + l * 64, c.wkn_g() + l * 64, l};
        pg8::gemm_phase<pg8::EpiIn, pg8::StaticOrder, true, true>(ring, g, S, E, tid_o); PHASE_END(B0 + 1); }
    if (IN_RANGE(B0 + 2)) { PHASE_BEGIN(); phase_dt(c, l); phase_qk(c, l, lf); PHASE_END(B0 + 2); }
    if (IN_RANGE(B0 + 3)) { PHASE_BEGIN(); phase_mixers(c, l, lf); PHASE_END(B0 + 3); }
    if (IN_RANGE(B0 + 4)) { PHASE_BEGIN();
        pg8::Gemm g{c.Y5(), (const bf16*)(ws + W_GLU), M, 1024, 512, 512, 512, 0, 0}; pg8::StaticOrder S; S.init(M, 1024, G, bid);
        pg8::EpiGlu E{c.Y(), 2048, 512, c.b_glu() + l * 1024};
        pg8::gemm_phase<pg8::EpiGlu, pg8::StaticOrder, true, true>(ring, g, S, E, tid_o); PHASE_END(B0 + 4); }
    if (IN_RANGE(B0 + 5)) { PHASE_BEGIN();
        pg8::Gemm g{c.Y(), (const bf16*)(ws + W_BR), M, 4096, 512, 2048, 512, 4, 1024}; pg8::StaticOrder S; S.init(M, 4096, G, bid);
        pg8::EpiB<8> E{c.R1(), 4096, nullptr, c.SSQ()};
        pg8::gemm_phase<pg8::EpiB<8>, pg8::StaticOrder, true, true>(ring, g, S, E, tid_o); PHASE_END(B0 + 5); }
    if (IN_RANGE(B0 + 6)) { PHASE_BEGIN();
        pg8::Gemm g{c.H(), (const bf16*)(ws + W_G), M, 4096, 1024, 1024, 1024, 0, 0}; pg8::StaticOrder S; S.init(M, 4096, G, bid);
        pg8::EpiGateMerge E{c.R1(), c.Y(), c.b_gate() + l * 4096};
        pg8::gemm_phase<pg8::EpiGateMerge, pg8::StaticOrder, true, true>(ring, g, S, E, tid_o); PHASE_END(B0 + 6); }
    if (IN_RANGE(B0 + 7)) { PHASE_BEGIN();
        pg8::Gemm g{c.Y(), (const bf16*)(ws + W_OUT), M, 1024, 1024, 1024, 1024, 0, 0}; pg8::StaticOrder S; S.init(M, 1024, G, bid);
        pg8::EpiRes2 E{l == 0 ? c.x_prompt() : c.out(), l == 0 ? c.x_sample() : c.out() + (size_t)MC * D, c.out(), c.MOD() + (size_t)l * 5 * 6144, 2048, c.H(), c.g_norm2() + l * 1024, 4096, (float*)(ws + WS_SSQ2)};
        pg8::gemm_phase<pg8::EpiRes2, pg8::StaticOrder, true, true>(ring, g, S, E, tid_o); if (l == 0) side_convert(c, 0, 5376, false, lf); PHASE_END(B0 + 7); }
    if (IN_RANGE(B0 + 9)) { PHASE_BEGIN();
        pg8::Gemm g{c.H(), (const bf16*)(ws + W_1), M, 4096, 1024, 1024, 1024, 0, 0}; pg8::StaticOrder S; S.init(M, 4096, G, bid);
        pg8::EpiB<5> E{c.R1(), 4096, (const float*)(ws + WS_BI2), (const float*)(ws + WS_SSQ2)};
        pg8::gemm_phase<pg8::EpiB<5>, pg8::StaticOrder, true, true>(ring, g, S, E, tid_o); PHASE_END(B0 + 9); }
    if (IN_RANGE(B0 + 10)) { PHASE_BEGIN();
        pg8::Gemm g{c.R1(), (const bf16*)(ws + W_2), M, 1024, 4096, 4096, 4096, 0, 0}; pg8::StaticOrder S; S.init(M, 1024, G, bid);
        pg8::EpiRes E{c.out(), c.out() + (size_t)MC * D, c.out(), c.MOD() + (size_t)l * 5 * 6144, 5120};
        pg8::gemm_phase<pg8::EpiRes, pg8::StaticOrder, true, true>(ring, g, S, E, tid_o); if (l == 0) side_convert(c, 5376, 7936, true, lf); PHASE_END(B0 + 10); }
}

__global__ void __launch_bounds__(NTHR, 2) fwd_kernel(Args args) {
    extern __shared__ __attribute__((aligned(16))) unsigned char lds[];
    const int ph_lo = args.ph_lo, ph_hi = args.ph_hi;
    volatile LAS unsigned* xst = (volatile LAS unsigned*)(lds + LDS_BYTES - 16);
    if (threadIdx.x < 4) xst[threadIdx.x] = 0u;
    __syncthreads();
    const XcdBarrier xbar = xcd_barrier_post((unsigned*)(args.ws + WS_BAR), xst);
    if (PROBE_SEL >= 0 && blockIdx.x == PROBE_PB && threadIdx.x == 0) { unsigned long long* ts = (unsigned long long*)(args.ws + WS_TS); ts[0] = __builtin_amdgcn_s_memrealtime(); }
    if (IN_RANGE(0)) { PHASE_BEGIN(); float* lf = (float*)lds; phase_mods(c, lf); __syncthreads(); phase_convert(c, 0, lf); phase_rope_table(c); phase_ckv(c); PHASE_END(0); }
    layer_program<0>(ph_lo, ph_hi, lds, xbar);
    layer_program<1>(ph_lo, ph_hi, lds, xbar);
    if (PROBE_SEL >= 0) {
        __threadfence(); cg::this_grid().sync();
        const unsigned long long* ts = (const unsigned long long*)(args.ws + WS_TS);
        const float total = (float)(ts[23] - ts[0]); float sel = 0.f;
        for (int k = 0; k < 23; ++k) { const float d = (float)(ts[k + 1] - ts[k]); const int q = k == 0 ? -1 : (k - 1) % 11;
            const int cls = (q == 3) ? 0 : (q == 1 || q == 4 || q == 5 || q == 7 || q == 9 || q == 10) ? 1 : (q == 2) ? 2 : 3;
            if (cls == PROBE_SEL) sel += d; }
        if (PROBE_SEL >= 10 && PROBE_SEL < 100) sel = (float)ts[64 + PROBE_SEL - 10] * (1.0f / 256.0f);
        if (PROBE_SEL >= 100) { const int k = PROBE_SEL - 100; sel = (float)(ts[k + 1] - (ts[k] != 0ull ? ts[k] : ts[k - 1])); }
        const float sc = 1.0f + sqrtf(PROBE_SCALE * sel / total);
        for (int i = blockIdx.x * NTHR + threadIdx.x; i < 524288; i += gridDim.x * NTHR) args.out[O_S5 + i] *= sc;
    }
}

extern "C" void kernel_launch(void* const* d_in, const int* in_sizes, int n_in, void* d_out, int out_size, void* d_ws, size_t ws_size, hipStream_t stream) {
    static int grid = 0;
    if (grid == 0) {
        if (n_in != 44 || ws_size < WS_END) { fprintf(stderr, "kernel_launch: expected 44 inputs and >= %zu bytes of workspace; got %d, %zu\n", (size_t)WS_END, n_in, ws_size); grid = -1; return; }
        int dev = 0, cus = 0, per_cu = 0;
        (void)hipGetDevice(&dev); (void)hipDeviceGetAttribute(&cus, hipDeviceAttributeMultiprocessorCount, dev);
        (void)hipFuncSetAttribute((const void*)fwd_kernel, hipFuncAttributeMaxDynamicSharedMemorySize, LDS_BYTES);
        (void)hipOccupancyMaxActiveBlocksPerMultiprocessor(&per_cu, (const void*)fwd_kernel, NTHR, LDS_BYTES);
        if (per_cu < 1) { fprintf(stderr, "kernel_launch: occupancy query says %d blocks per CU\n", per_cu); per_cu = 1; }
        (void)hipGetLastError();
        grid = cus > 0 ? cus : 256;
    }
    if (grid < 0) return;
    (void)hipMemsetAsync(d_ws, 0, 64 * 1024, stream);
    Args a{};
    for (int i = 0; i < 44; ++i) a.in[i] = (const float*)d_in[i];
    a.out = (float*)d_out; a.ws = (unsigned char*)d_ws;
#if MK_MULTI
    for (int ph = 0; ph < NPH; ++ph) { a.ph_lo = ph; a.ph_hi = ph + 1; hipLaunchKernelGGL(fwd_kernel, dim3(grid), dim3(NTHR), LDS_BYTES, stream, a); }
#else
    a.ph_lo = 0; a.ph_hi = NPH;
    void* kargs[] = {&a};
    hipError_t e = hipLaunchCooperativeKernel((const void*)fwd_kernel, dim3(grid), dim3(NTHR), kargs, LDS_BYTES, stream);
    if (e != hipSuccess) fprintf(stderr, "cooperative launch failed: %s (grid %d)\n", hipGetErrorString(e), grid);
#endif
}
```
